# Optimizing an MI355X kernel written in HIP

```python
import jax
import jax.numpy as jnp
from jax import lax
import numpy as np

D_MODEL = 1024
BATCH = 4
SEQ = 8192
DEPTH = 1

GRID_W = 64
CTX_LEN = 256

RW_HEAD_DIM = 64
RW_WIDTH = D_MODEL // 2
RW_HEADS = RW_WIDTH // RW_HEAD_DIM
RW_DECAY_RANK = 32
RW_AAA_RANK = 32
RW_GATE_RANK = 96
RW_GN_EPS = 64e-5
RW_SPLITS = (RW_WIDTH, RW_WIDTH, RW_WIDTH, RW_DECAY_RANK, RW_AAA_RANK, RW_GATE_RANK)
RW_COLS = 3 * RW_WIDTH + RW_DECAY_RANK + RW_AAA_RANK + RW_GATE_RANK

GLA_HEADS = 4
GLA_KEY_WIDTH = D_MODEL // 4
GLA_VAL_WIDTH = D_MODEL // 2
GLA_KEY_DIM = GLA_KEY_WIDTH // GLA_HEADS
GLA_VAL_DIM = GLA_VAL_WIDTH // GLA_HEADS
GLA_GATE_RANK = 16
GLA_TAU = 16.0
GLA_CHUNK = 64
CONV_SIZE = 3
GLA_QKV_COLS = 2 * GLA_KEY_WIDTH + GLA_VAL_WIDTH
GLA_COLS = GLA_QKV_COLS + GLA_GATE_RANK + GLA_VAL_WIDTH

MIX_COLS = RW_COLS + GLA_COLS
IN_COLS = MIX_COLS + 2 * D_MODEL

N_EXPERTS = 256
TOP_K = 8
N_GROUPS = 8
TOPK_GROUPS = 4
EXPERT_DIM = D_MODEL // 4
SHARED_DIM = EXPERT_DIM
ROUTED_SCALE = 2.5
EXPERT_BLOCK = 128

LN_EPS = 1e-5
ALPHA = (2 * DEPTH) ** 0.25
BETA = (8 * DEPTH) ** -0.25

kernel_name = 'hybrid_rwkv7_gla_moe_flow_block'


def _split(t, sizes):
    idx, acc = [], 0
    for s in sizes[:-1]:
        acc += s
        idx.append(acc)
    return jnp.split(t, idx, axis=-1)


def _heads(t, n):
    return t.reshape(t.shape[:-1] + (n, t.shape[-1] // n))


def _layer_norm(x, w, b):
    xf = x.astype(jnp.float32)
    mu = jnp.mean(xf, -1, keepdims=True)
    var = jnp.mean(jnp.square(xf - mu), -1, keepdims=True)
    return ((xf - mu) * lax.rsqrt(var + LN_EPS)).astype(x.dtype) * w + b


def _head_norm(y, n_heads, eps):
    yh = _heads(y, n_heads).astype(jnp.float32)
    mu = jnp.mean(yh, -1, keepdims=True)
    var = jnp.mean(jnp.square(yh - mu), -1, keepdims=True)
    return ((yh - mu) * lax.rsqrt(var + eps)).reshape(y.shape)


def _qshift_grid(p, rows):
    B, L, C = p.shape
    g = p.reshape(B, rows, GRID_W, C // 4, 4)
    zc = jnp.zeros_like(g[:, :, :1, :, 0])
    zr = jnp.zeros_like(g[:, :1, :, :, 0])
    left = jnp.concatenate([zc, g[:, :, :-1, :, 0]], axis=2)
    right = jnp.concatenate([g[:, :, 1:, :, 1], zc], axis=2)
    up = jnp.concatenate([zr, g[:, :-1, :, :, 2]], axis=1)
    down = jnp.concatenate([g[:, 1:, :, :, 3], zr], axis=1)
    return jnp.stack([left, right, up, down], axis=-1).reshape(B, L, C)


def _qshift_seq(p):
    B, L, C = p.shape
    g = p.reshape(B, L, C // 4, 4)
    z = jnp.zeros_like(g[:, :1, :, 0])
    prev = lambda a: jnp.concatenate([z, a[:, :-1]], axis=1)
    nxt = lambda a: jnp.concatenate([a[:, 1:], z], axis=1)
    return jnp.stack([prev(g[..., 0]), nxt(g[..., 1]), prev(g[..., 2]), nxt(g[..., 3])], axis=-1).reshape(B, L, C)


def _dwconv(g, w):
    return lax.conv_general_dilated(g, w[:, :, None, :].astype(g.dtype), (1, 1), 'SAME',
                                    dimension_numbers=('NHWC', 'HWIO', 'NHWC'),
                                    feature_group_count=g.shape[-1])


def _stream_features(p_mix, shift_fn, conv_fn, rw_mu):
    p_rw, p_gla = p_mix[..., :RW_COLS], p_mix[..., RW_COLS:]
    p_rw = p_rw + rw_mu * (shift_fn(p_rw) - p_rw)
    r, k, v, pw, pa, pg = _split(p_rw, RW_SPLITS)
    qkv = jax.nn.silu(conv_fn(p_gla[..., :GLA_QKV_COLS]))
    q, kg, vg = _split(qkv, (GLA_KEY_WIDTH, GLA_KEY_WIDTH, GLA_VAL_WIDTH))
    pgl, og = _split(p_gla[..., GLA_QKV_COLS:], (GLA_GATE_RANK, GLA_VAL_WIDTH))
    return {'r': r, 'k': k, 'v': v, 'pw': pw, 'pa': pa, 'pg': pg,
            'q': q, 'kg': kg, 'vg': vg, 'pgl': pgl, 'og': og}


def _rwkv_dir(f, w0, w2, a0, a2, k_k, k_a):
    f32 = jnp.float32
    w_log = -jax.nn.softplus(-(w0 + jnp.tanh(f['pw']) @ w2)) - 0.5
    decay = jnp.exp(-jnp.exp(w_log.astype(f32)))
    a = jax.nn.sigmoid(a0 + f['pa'] @ a2)
    kk = _heads(f['k'] * k_k, RW_HEADS).astype(f32)
    kk = kk / jnp.maximum(jnp.sqrt(jnp.sum(kk * kk, -1, keepdims=True)), 1e-12)
    k_mod = _heads(f['k'] * (1.0 + (a - 1.0) * k_a), RW_HEADS).astype(f32)
    a_h = _heads(a, RW_HEADS).astype(f32)
    return _heads(decay, RW_HEADS), k_mod, -kk, kk * a_h


def _rwkv7_scan(state, r, w, k, v, a, b, emit):
    def step(S, inp):
        r_t, w_t, k_t, v_t, a_t, b_t = inp
        sa = jnp.einsum('bhvk,bhk->bhv', S, a_t)
        S = S * w_t[:, :, None, :] + sa[..., None] * b_t[:, :, None, :] + v_t[..., None] * k_t[:, :, None, :]
        return S, (jnp.einsum('bhvk,bhk->bhv', S, r_t) if emit else None)
    xs = tuple(jnp.moveaxis(t, 1, 0) for t in (r, w, k, v, a, b))
    state, ys = lax.scan(step, state, xs)
    return state, (jnp.moveaxis(ys, 0, 1) if emit else None)


def _gla_scan(state, q, k, v, log_a, emit):
    B, L, H, _ = q.shape
    n = L // GLA_CHUNK
    chunks = lambda t: jnp.moveaxis(t.reshape(B, n, GLA_CHUNK, H, t.shape[-1]), 1, 0)
    causal = jnp.tril(jnp.ones((GLA_CHUNK, GLA_CHUNK), dtype=bool))[None, :, :, None, None]

    def step(S, inp):
        q_c, k_c, v_c, g_c = inp
        b = jnp.cumsum(g_c, axis=1)
        b_last = b[:, -1]
        out = None
        if emit:
            inter = jnp.einsum('bihk,bhkv->bihv', q_c * jnp.exp(b), S)
            decay_ij = jnp.exp(jnp.where(causal, b[:, :, None] - b[:, None, :], -jnp.inf))
            att = jnp.einsum('bihk,bjhk,bijhk->bhij', q_c, k_c, decay_ij)
            out = inter + jnp.einsum('bhij,bjhv->bihv', att, v_c)
        S = S * jnp.exp(b_last)[..., None] + jnp.einsum('bjhk,bjhv->bhkv', k_c * jnp.exp(b_last[:, None] - b), v_c)
        return S, out

    state, o = lax.scan(step, state, tuple(chunks(t) for t in (q, k, v, log_a)))
    return state, (jnp.moveaxis(o, 0, 1).reshape(B, L, H, v.shape[-1]) if emit else None)


def _token_mix(h_lat, h_ctx, rows, need_ctx, lp):
    f32 = jnp.float32
    B, L, _ = h_lat.shape
    w_mix, w_gate = lp['w_in'][:, :MIX_COLS], lp['w_in'][:, MIX_COLS:]
    conv_w = lp['gla_conv']
    lat_conv = lambda t: _dwconv(t.reshape(B, rows, GRID_W, t.shape[-1]), conv_w).reshape(B, L, t.shape[-1])
    ctx_conv = lambda t: _dwconv(t[:, None], conv_w)[:, 0]
    f_lat = _stream_features(h_lat @ w_mix, lambda t: _qshift_grid(t, rows), lat_conv, lp['rw_mu'])
    f_ctx = _stream_features(h_ctx @ w_mix, _qshift_seq, ctx_conv, lp['rw_mu'])

    outs = {'lat': {'rw': [], 'bonus': [], 'gla': []}, 'ctx': {'rw': [], 'bonus': [], 'gla': []}}
    for d in range(2):
        flip = (lambda t: t[:, ::-1]) if d == 1 else (lambda t: t)
        s_rw = jnp.zeros((B, RW_HEADS, RW_HEAD_DIM, RW_HEAD_DIM), f32)
        s_gla = jnp.zeros((B, GLA_HEADS, GLA_KEY_DIM, GLA_VAL_DIM), f32)
        for name, f, emit in (('ctx', f_ctx, need_ctx), ('lat', f_lat, True)):
            decay, k_mod, a_vec, b_vec = _rwkv_dir(f, lp['rw_w0'][d], lp['rw_w2'][d], lp['rw_a0'][d],
                                                   lp['rw_a2'][d], lp['rw_k_k'], lp['rw_k_a'])
            r_h = _heads(f['r'], RW_HEADS).astype(f32)
            v_h = _heads(f['v'], RW_HEADS).astype(f32)
            s_rw, y_rw = _rwkv7_scan(s_rw, *[flip(t) for t in (r_h, decay, k_mod, v_h, a_vec, b_vec)], emit)
            q_h = _heads(f['q'], GLA_HEADS).astype(f32) * GLA_KEY_DIM ** -0.5
            k_h = _heads(f['kg'], GLA_HEADS).astype(f32)
            vg_h = _heads(f['vg'], GLA_HEADS).astype(f32)
            log_a = _heads(jax.nn.log_sigmoid((f['pgl'] @ lp['gla_g2'][d] + lp['gla_gb'][d]).astype(f32)) / GLA_TAU,
                           GLA_HEADS)
            s_gla, y_gla = _gla_scan(s_gla, *[flip(t) for t in (q_h, k_h, vg_h, log_a)], emit)
            if emit:
                outs[name]['rw'].append(flip(y_rw))
                outs[name]['bonus'].append(jnp.sum(r_h * k_mod * lp['rw_r_k'], -1, keepdims=True) * v_h)
                outs[name]['gla'].append(flip(y_gla))

    def merge(h, f, o):
        lead = h.shape[:-1]
        y_rw = _head_norm((o['rw'][0] + o['rw'][1]).reshape(lead + (RW_WIDTH,)), RW_HEADS, RW_GN_EPS)
        y_rw = y_rw * lp['rw_gn_w'] + lp['rw_gn_b'] + (o['bonus'][0] + o['bonus'][1]).reshape(lead + (RW_WIDTH,))
        y_rw = (y_rw * (jax.nn.sigmoid(f['pg']) @ lp['rw_g2'])).astype(h.dtype) @ lp['w_br_rw']
        y_gla = _head_norm((o['gla'][0] + o['gla'][1]).reshape(lead + (GLA_VAL_WIDTH,)), GLA_HEADS, LN_EPS)
        y_gla = ((y_gla * lp['gla_gn_w'] + lp['gla_gn_b']) * jax.nn.silu(f['og'])).astype(h.dtype) @ lp['w_br_gla']
        gate_rw, gate_gla = jnp.split(jax.nn.sigmoid(h @ w_gate), 2, axis=-1)
        return (gate_rw * y_rw + gate_gla * y_gla) @ lp['w_out']

    return merge(h_lat, f_lat, outs['lat']), (merge(h_ctx, f_ctx, outs['ctx']) if need_ctx else None)


def _swiglu(t, w_gu, w_d):
    a, b = jnp.split(t @ w_gu, 2, axis=-1)
    return (jax.nn.silu(a) * b) @ w_d


def _moe(h, router, router_bias, w_gate_up, w_down, sh_gate_up, sh_down):
    shape = h.shape
    t = h.reshape(-1, shape[-1])
    n = t.shape[0]
    f32 = jnp.float32
    per_group = N_EXPERTS // N_GROUPS
    scores = jax.nn.sigmoid((t @ router).astype(f32))
    sel = scores + router_bias.astype(f32)
    group_score = lax.top_k(sel.reshape(n, N_GROUPS, per_group), 2)[0].sum(-1)
    _, top_groups = lax.top_k(group_score, TOPK_GROUPS)
    group_keep = jnp.any(top_groups[:, :, None] == jnp.arange(N_GROUPS), axis=1)
    sel = jnp.where(jnp.repeat(group_keep, per_group, axis=1), sel, -jnp.inf)
    _, experts = lax.top_k(sel, TOP_K)
    gate = jnp.take_along_axis(scores, experts, axis=-1)
    gate = gate / jnp.sum(gate, -1, keepdims=True) * ROUTED_SCALE

    flat_e = experts.reshape(-1)
    nk = flat_e.shape[0]
    order = jnp.argsort(flat_e)
    sorted_e = flat_e[order]
    sizes = jnp.bincount(flat_e, length=N_EXPERTS)
    padded = (sizes + EXPERT_BLOCK - 1) // EXPERT_BLOCK * EXPERT_BLOCK
    start = jnp.cumsum(sizes) - sizes
    pad_end = jnp.cumsum(padded)
    pad_start = pad_end - padded
    dest = pad_start[sorted_e] + jnp.arange(nk) - start[sorted_e]
    n_blocks = (nk + N_EXPERTS * (EXPERT_BLOCK - 1) + EXPERT_BLOCK - 1) // EXPERT_BLOCK
    cap = n_blocks * EXPERT_BLOCK
    row_tok = jnp.full((cap,), n, jnp.int32).at[dest].set((order // TOP_K).astype(jnp.int32))
    row_gate = jnp.zeros((cap,), t.dtype).at[dest].set(gate.reshape(-1)[order].astype(t.dtype))
    block_e = jnp.minimum(jnp.searchsorted(pad_end, jnp.arange(n_blocks) * EXPERT_BLOCK, side='right'),
                          N_EXPERTS - 1)
    t_pad = jnp.concatenate([t, jnp.zeros((1, t.shape[1]), t.dtype)], axis=0)

    def expert_block(args):
        tok, e = args
        return _swiglu(t_pad[tok], w_gate_up[e], w_down[e])

    y = lax.map(expert_block, (row_tok.reshape(n_blocks, EXPERT_BLOCK), block_e)).reshape(cap, -1)
    routed = jax.ops.segment_sum(y * row_gate[:, None], row_tok, num_segments=n + 1)[:n]
    return (routed + _swiglu(t, sh_gate_up, sh_down)).reshape(shape)


def setup_inputs(seed: int = 0) -> dict:
    key = jax.random.key(seed)
    ks = iter(jax.random.split(key, 48))

    def nrm(shape, scale):
        return scale * jax.random.normal(next(ks), shape, jnp.float32)

    def uni(shape, lo, hi):
        return jax.random.uniform(next(ks), shape, jnp.float32, lo, hi)

    Ld, E, F = DEPTH, N_EXPERTS, EXPERT_DIM
    d_inv = D_MODEL ** -0.5
    gla_v0 = RW_COLS + 2 * GLA_KEY_WIDTH
    v_cols = jnp.zeros((IN_COLS,), bool).at[2 * RW_WIDTH:3 * RW_WIDTH].set(True).at[gla_v0:gla_v0 + GLA_VAL_WIDTH].set(True)
    col_scale = jnp.where(v_cols, BETA, 1.0)
    w0_ramp = -6.0 + 5.0 * jnp.linspace(0.0, 1.0, RW_WIDTH) ** 1.5
    return {
        'x': nrm((BATCH, SEQ, D_MODEL), 1.0),
        'c': nrm((BATCH, D_MODEL), 1.0),
        'ctx': nrm((BATCH, CTX_LEN, D_MODEL), 1.0),
        'c_ctx': nrm((D_MODEL,), 1.0),
        'w_ada': nrm((Ld, D_MODEL, 6 * D_MODEL), 0.5 * d_inv),
        'b_ada': nrm((Ld, 6 * D_MODEL), 0.02),
        'w_in': nrm((Ld, D_MODEL, IN_COLS), d_inv) * col_scale,
        'rw_mu': uni((Ld, RW_COLS), 0.0, 1.0),
        'rw_w0': w0_ramp + nrm((Ld, 2, RW_WIDTH), 0.3),
        'rw_w2': nrm((Ld, 2, RW_DECAY_RANK, RW_WIDTH), 0.5 * RW_DECAY_RANK ** -0.5),
        'rw_a0': nrm((Ld, 2, RW_WIDTH), 0.3),
        'rw_a2': nrm((Ld, 2, RW_AAA_RANK, RW_WIDTH), RW_AAA_RANK ** -0.5),
        'rw_g2': nrm((Ld, RW_GATE_RANK, RW_WIDTH), RW_GATE_RANK ** -0.5),
        'rw_k_k': 0.85 + nrm((Ld, RW_WIDTH), 0.05),
        'rw_k_a': 1.0 + nrm((Ld, RW_WIDTH), 0.05),
        'rw_r_k': nrm((Ld, RW_HEADS, RW_HEAD_DIM), 0.1),
        'rw_gn_w': 1.0 + nrm((Ld, RW_WIDTH), 0.02),
        'rw_gn_b': nrm((Ld, RW_WIDTH), 0.02),
        'gla_conv': nrm((Ld, CONV_SIZE, CONV_SIZE, GLA_QKV_COLS), 1.0 / CONV_SIZE),
        'gla_g2': nrm((Ld, 2, GLA_GATE_RANK, GLA_KEY_WIDTH), GLA_GATE_RANK ** -0.5),
        'gla_gb': 1.0 + nrm((Ld, 2, GLA_KEY_WIDTH), 1.0),
        'gla_gn_w': 1.0 + nrm((Ld, GLA_VAL_WIDTH), 0.02),
        'gla_gn_b': nrm((Ld, GLA_VAL_WIDTH), 0.02),
        'w_br_rw': nrm((Ld, RW_WIDTH, D_MODEL), RW_WIDTH ** -0.5),
        'w_br_gla': nrm((Ld, GLA_VAL_WIDTH, D_MODEL), GLA_VAL_WIDTH ** -0.5),
        'w_out': nrm((Ld, D_MODEL, D_MODEL), BETA * d_inv),
        'ln1_w': 1.0 + nrm((Ld, D_MODEL), 0.02),
        'ln1_b': nrm((Ld, D_MODEL), 0.02),
        'router': nrm((Ld, D_MODEL, E), d_inv),
        'router_bias': nrm((Ld, E), 0.01),
        'w_gate_up': nrm((Ld, E, D_MODEL, 2 * F), d_inv),
        'w_down': nrm((Ld, E, F, D_MODEL), BETA * F ** -0.5),
        'sh_gate_up': nrm((Ld, D_MODEL, 2 * SHARED_DIM), d_inv),
        'sh_down': nrm((Ld, SHARED_DIM, D_MODEL), BETA * SHARED_DIM ** -0.5),
        'ln2_w': 1.0 + nrm((Ld, D_MODEL), 0.02),
        'ln2_b': nrm((Ld, D_MODEL), 0.02),
    }


def reference(x, c, ctx, c_ctx, w_ada, b_ada, w_in, rw_mu, rw_w0, rw_w2, rw_a0, rw_a2, rw_g2,
              rw_k_k, rw_k_a, rw_r_k, rw_gn_w, rw_gn_b, gla_conv, gla_g2, gla_gb, gla_gn_w, gla_gn_b,
              w_br_rw, w_br_gla, w_out, ln1_w, ln1_b, router, router_bias, w_gate_up, w_down,
              sh_gate_up, sh_down, ln2_w, ln2_b):
    rows = x.shape[1] // GRID_W
    ctx_s = ctx
    for l in range(DEPTH):
        need_ctx = l < DEPTH - 1
        sh1, sc1, g1, sh2, sc2, g2 = [m[:, None, :] for m in
                                      _split(jax.nn.silu(c) @ w_ada[l] + b_ada[l], (D_MODEL,) * 6)]
        csh1, csc1, cg1, csh2, csc2, cg2 = _split(jax.nn.silu(c_ctx) @ w_ada[l] + b_ada[l], (D_MODEL,) * 6)
        lp = {'w_in': w_in[l], 'rw_mu': rw_mu[l], 'rw_w0': rw_w0[l], 'rw_w2': rw_w2[l], 'rw_a0': rw_a0[l],
              'rw_a2': rw_a2[l], 'rw_g2': rw_g2[l], 'rw_k_k': rw_k_k[l], 'rw_k_a': rw_k_a[l],
              'rw_r_k': rw_r_k[l], 'rw_gn_w': rw_gn_w[l], 'rw_gn_b': rw_gn_b[l], 'gla_conv': gla_conv[l],
              'gla_g2': gla_g2[l], 'gla_gb': gla_gb[l], 'gla_gn_w': gla_gn_w[l], 'gla_gn_b': gla_gn_b[l],
              'w_br_rw': w_br_rw[l], 'w_br_gla': w_br_gla[l], 'w_out': w_out[l]}
        moe_p = (router[l], router_bias[l], w_gate_up[l], w_down[l], sh_gate_up[l], sh_down[l])

        h = x * (1.0 + sc1) + sh1
        hc = ctx_s * (1.0 + csc1) + csh1
        mix, mix_c = _token_mix(h, hc, rows, need_ctx, lp)
        x = _layer_norm(ALPHA * x + g1 * mix, ln1_w[l], ln1_b[l])

        h = x * (1.0 + sc2) + sh2
        x = _layer_norm(ALPHA * x + g2 * _moe(h, *moe_p), ln2_w[l], ln2_b[l])

        if need_ctx:
            ctx_s = _layer_norm(ALPHA * ctx_s + cg1 * mix_c, ln1_w[l], ln1_b[l])
            hc = ctx_s * (1.0 + csc2) + csh2
            ctx_s = _layer_norm(ALPHA * ctx_s + cg2 * _moe(hc, *moe_p), ln2_w[l], ln2_b[l])
    return x
```

```cpp
#include <hip/hip_runtime.h>
#include <cstdio>
#include <cstdint>

#ifndef MS
#define MS 3
#endif

#define GAS __attribute__((address_space(1)))
#define LAS __attribute__((address_space(3)))
typedef unsigned short bf16;
typedef unsigned v4u __attribute__((ext_vector_type(4)));
typedef unsigned v2u __attribute__((ext_vector_type(2)));
typedef float f32x4 __attribute__((ext_vector_type(4)));
typedef float f32x2 __attribute__((ext_vector_type(2)));
typedef short bf16x8 __attribute__((ext_vector_type(8)));
#define LDS_WAIT() asm volatile("s_waitcnt lgkmcnt(0)" ::: "memory")
#define VM_WAIT() asm volatile("s_waitcnt vmcnt(0)" ::: "memory")

constexpr int D = 1024, NB = 4, SEQ = 8192, CTXL = 256, GRIDW = 64, GRIDH = 128;
constexpr int NLAT = NB * SEQ, NCTX = NB * CTXL, MR = NLAT + NCTX;
constexpr int RWW = 512, RWH = 8, HD = 64;
constexpr int C_R = 0, C_K = 512, C_V = 1024, C_PW = 1536, C_PA = 1568, C_PG = 1600, C_Q = 1696, C_KG = 1952, C_VG = 2208, C_PGL = 2720, C_OG = 2736, C_GRW = 3248, C_GGLA = 4272;
constexpr int IN_COLS = 5296, NP = 5376;
constexpr int NE = 256, TOPK = 8, FF = 256;
constexpr float LN_EPS = 1e-5f, RW_GN_EPS = 64e-5f;
constexpr float ALPHA = 1.189207115f;
constexpr int NLORA = 3072, KLORA = 256;
constexpr int MAXTILES = 1280, SH_ROW0 = MAXTILES * 256, NROWS_E = SH_ROW0 + NLAT;

namespace pg8 {
#define PG8_LAS __attribute__((address_space(3)))
typedef unsigned short bf16_t;
typedef unsigned u32x4 __attribute__((ext_vector_type(4)));
typedef unsigned u32x2 __attribute__((ext_vector_type(2)));
constexpr int BM = 256, BK = 64, HALF = 128, HTB = HALF * BK * 2, STAGE_BYTES = 8 * HTB, NXCD = 8, WGM = 8;
constexpr int IDX_OFF = STAGE_BYTES, IDX_UNITS = 12;

__host__ __device__ __forceinline__ int lds_byte(int r, int c) { const int st = (r >> 4) * 2 + (c >> 5), rr = r & 15, cc = c & 31, ob = rr * 64 + cc * 2; return st * 1024 + (ob ^ (((ob >> 9) & 1) << 5)); }
__host__ __device__ __forceinline__ void stage_rc(int b, int& R, int& C) { const int st = b / 1024, sb = b % 1024, swz = sb ^ (((sb >> 9) & 1) << 5); R = (st >> 1) * 16 + swz / 64; C = (st & 1) * 32 + (swz % 64) / 2; }
__host__ __device__ __forceinline__ int perm32(int rho) { const int n = rho >> 4, i = rho & 15; return 8 * (i >> 2) + 4 * n + (i & 3); }

struct Unit { int pm, pn, e, j; };
struct Gemm { const bf16_t* A; const bf16_t* Bt; int M, N, K; const int* rowidx; };

struct StaticOrder {
    int nM, nN, nwg, G, c;
    __host__ __device__ void init(int M, int N, int G_, int c_) { nM = M / BM; nN = N / BM; nwg = nM * nN; G = G_; c = c_; }
    __host__ __device__ bool next(int i, Unit& u) const {
        const long L = (long)i * G + c; if (L >= nwg) return false;
        int wgid = (int)L; { const int q = nwg / NXCD, r = nwg % NXCD, xcd = wgid % NXCD, off = wgid / NXCD; wgid = (xcd < r ? xcd * (q + 1) : r * (q + 1) + (xcd - r) * q) + off; }
        const int nig = WGM * nN, gid = wgid / nig, fm = gid * WGM, gsz = (nM - fm) < WGM ? (nM - fm) : WGM;
        u.pm = fm + ((wgid % nig) % gsz); u.pn = (wgid % nig) / gsz; u.e = 0; u.j = u.pn; return true;
    }
};
struct MoeOrder {
    int nN, G, c, NT; const int* tile_e;
    __device__ bool next(int i, Unit& u) const {
        const int L = i * G + c; const int total = (NT + NLAT / 256) * nN; if (L >= total) return false;
        const int tile = L / nN, j = L - tile * nN; int e, pm;
        if (tile < NT) { e = tile_e[tile]; pm = tile; } else { e = NE; pm = MAXTILES + (tile - NT); }
        u.pm = pm; u.pn = e * nN + j; u.e = e; u.j = j; return true;
    }
};

__device__ __forceinline__ unsigned cvt_pk_bf16(float lo, float hi) { unsigned r; asm volatile("v_cvt_pk_bf16_f32 %0, %1, %2" : "=v"(r) : "v"(lo), "v"(hi)); return r; }

template <class Epi, class Sched, bool ALIGN_EPI, bool SP2, bool GATHER>
__device__ __forceinline__ void gemm_phase(PG8_LAS unsigned char* lds, const Gemm g, const Sched& S, const Epi& E) {
    const int tid = threadIdx.x, wid = __builtin_amdgcn_readfirstlane(tid >> 6), lane = tid & 63, wr = wid >> 2, wc = wid & 3, fr = lane & 15, fq = lane >> 4;
    const int K = g.K, nt = K / BK;
    const size_t kstep = (size_t)(BK * 2);
    const size_t hstep = (size_t)HALF * K * 2;
    const size_t tstep = 2 * hstep;
    unsigned voffB[2]; unsigned va[2][2];
#pragma unroll
    for (int i = 0; i < 2; ++i) { int R, C; stage_rc(tid * 16 + i * 8192, R, C); const int Rb = Epi::PERM ? ((R & ~31) + perm32(R & 31)) : R;
        voffB[i] = (unsigned)(Rb * K + C) * 2u;
        va[0][i] = (unsigned)(R * K + C) * 2u; va[1][i] = va[0][i]; }
    const size_t ah = GATHER ? (size_t)0 : hstep;
#define PG8_GOFF(dst, ub) do { _Pragma("unroll") for (int _h = 0; _h < 2; ++_h) _Pragma("unroll") for (int _i = 0; _i < 2; ++_i) { int _R, _C; stage_rc(tid * 16 + _i * 8192, _R, _C); \
        dst[_h][_i] = (unsigned)(idxt[(ub) * 256 + _h * 128 + _R] * K + _C) * 2u; } } while (0)
    const unsigned ldsw = (unsigned)wid * 1024u;
    const int aoff = lds_byte(wr * 64 + fr, fq * 8), boff = lds_byte(wc * 32 + fr, fq * 8);
    PG8_LAS int* idxt = (PG8_LAS int*)(lds + IDX_OFF);
#define PG8_SA(b, h) (((b) * 2 + (h)) * HTB)
#define PG8_SB(b, h) ((4 + (b) * 2 + (h)) * HTB)
#define PG8_STAGE(bufoff, gbase, voff) do { _Pragma("unroll") for (int _i = 0; _i < 2; ++_i) \
        __builtin_amdgcn_global_load_lds((const unsigned*)((const char*)(gbase) + (voff)[_i]), (PG8_LAS unsigned*)(lds + (bufoff) + ldsw + _i * 8192), 16, 0, 0); } while (0)
#define PG8_LDA(dst, b, h) do { _Pragma("unroll") for (int m = 0; m < 4; ++m) _Pragma("unroll") for (int k = 0; k < 2; ++k) dst[m][k] = *(const PG8_LAS bf16x8*)(lds + PG8_SA(b, h) + aoff + m * 2048 + k * 1024); } while (0)
#define PG8_LDB(dst, b, h) do { _Pragma("unroll") for (int n = 0; n < 2; ++n) _Pragma("unroll") for (int k = 0; k < 2; ++k) dst[n][k] = *(const PG8_LAS bf16x8*)(lds + PG8_SB(b, h) + boff + n * 2048 + k * 1024); } while (0)
#define PG8_MMA(ai, bj, At, Bt) do { __builtin_amdgcn_s_setprio(1); _Pragma("unroll") for (int m = 0; m < 4; ++m) _Pragma("unroll") for (int n = 0; n < 2; ++n) _Pragma("unroll") for (int k = 0; k < 2; ++k) \
        acc[ai][bj][m][n] = __builtin_amdgcn_mfma_f32_16x16x32_bf16(Bt[n][k], At[m][k], acc[ai][bj][m][n], 0, 0, 0); __builtin_amdgcn_s_setprio(0); } while (0)
#define PG8_WAIT_V(n) asm volatile("s_waitcnt vmcnt(" #n ")" ::: "memory")
#define PG8_WAIT_L(n) asm volatile("s_waitcnt lgkmcnt(" #n ")" ::: "memory")
#define PG8_BAR __builtin_amdgcn_s_barrier()
#define PG8_SCHED __builtin_amdgcn_sched_barrier(0)
    Unit cur, nxt; int ui = 0;
    if (!S.next(0, cur)) return;
    if constexpr (GATHER) {
        Unit uu;
        for (int i = 0; i < IDX_UNITS; ++i) { if (!S.next(i, uu)) break; if (tid < 256) idxt[i * 256 + tid] = g.rowidx[(size_t)uu.pm * 256 + tid]; }
        asm volatile("s_waitcnt vmcnt(0) lgkmcnt(0)" ::: "memory"); PG8_BAR; asm volatile("" ::: "memory");
        PG8_GOFF(va, 0);
    }
    f32x4 acc[2][2][4][2];
#pragma unroll
    for (int a = 0; a < 2; ++a)
#pragma unroll
        for (int b = 0; b < 2; ++b)
#pragma unroll
            for (int m = 0; m < 4; ++m)
#pragma unroll
                for (int n = 0; n < 2; ++n) acc[a][b][m][n] = (f32x4){0.f, 0.f, 0.f, 0.f};
    bf16x8 At[4][2], B0[2][2], B1[2][2];
    const char* cA = (const char*)g.A + (GATHER ? (size_t)0 : (size_t)cur.pm * tstep); const char* cB = (const char*)g.Bt + (size_t)cur.pn * tstep;
    if constexpr (SP2) {
        PG8_STAGE(PG8_SB(0, 0), cB, voffB); PG8_STAGE(PG8_SB(0, 1), cB + hstep, voffB); PG8_STAGE(PG8_SA(0, 0), cA, va[0]); PG8_STAGE(PG8_SA(0, 1), cA + ah, va[1]);
        if (wr == 1) PG8_BAR;
        PG8_WAIT_V(2); PG8_BAR;
        PG8_STAGE(PG8_SB(1, 0), cB + kstep, voffB); PG8_STAGE(PG8_SA(1, 0), cA + kstep, va[0]); PG8_STAGE(PG8_SB(1, 1), cB + hstep + kstep, voffB);
        PG8_WAIT_V(6); PG8_BAR;
    } else {
        PG8_STAGE(PG8_SB(0, 0), cB, voffB); PG8_STAGE(PG8_SA(0, 0), cA, va[0]); PG8_STAGE(PG8_SB(0, 1), cB + hstep, voffB); PG8_STAGE(PG8_SA(0, 1), cA + ah, va[1]);
        if (wr == 1) PG8_BAR;
        PG8_WAIT_V(4); PG8_BAR;
        PG8_STAGE(PG8_SB(1, 0), cB + kstep, voffB); PG8_STAGE(PG8_SA(1, 0), cA + kstep, va[0]); PG8_STAGE(PG8_SB(1, 1), cB + hstep + kstep, voffB);
        PG8_WAIT_V(6); PG8_BAR;
    }
    for (;;) {
        const bool has_next = S.next(ui + 1, nxt);
        const char* nA = has_next ? (const char*)g.A + (GATHER ? (size_t)0 : (size_t)nxt.pm * tstep) : cA; const char* nB = has_next ? (const char*)g.Bt + (size_t)nxt.pn * tstep : cB;
        const int ubn = (has_next && ui + 1 < IDX_UNITS) ? (ui + 1) : ui;
#pragma unroll 1
        for (int t = 0; t < nt; t += 2) {
            const bool last = (t == nt - 2);
            const char* a1 = cA + (size_t)(t + 1) * kstep;
            const char* a2 = last ? nA : cA + (size_t)(t + 2) * kstep; const char* b2 = last ? nB : cB + (size_t)(t + 2) * kstep;
            const char* a3 = a2 + kstep; const char* b3 = b2 + kstep;
            unsigned v2[2][2];
#pragma unroll
            for (int h = 0; h < 2; ++h)
#pragma unroll
                for (int i = 0; i < 2; ++i) v2[h][i] = va[h][i];
            if constexpr (GATHER) { if (last) PG8_GOFF(v2, ubn); }
            if constexpr (SP2) {
            PG8_LDB(B0, 0, 0); PG8_LDB(B1, 0, 1); PG8_SCHED; PG8_LDA(At, 0, 0); PG8_STAGE(PG8_SA(1, 1), a1 + ah, va[1]);
            PG8_WAIT_V(8); PG8_WAIT_L(0); PG8_BAR; PG8_MMA(0, 0, At, B0); PG8_MMA(0, 1, At, B1); PG8_BAR; PG8_SCHED;
            PG8_LDA(At, 0, 1); PG8_STAGE(PG8_SB(0, 0), b2, voffB); PG8_STAGE(PG8_SB(0, 1), b2 + hstep, voffB); PG8_STAGE(PG8_SA(0, 0), a2, v2[0]);
            PG8_WAIT_V(8); PG8_WAIT_L(0); PG8_BAR; PG8_MMA(1, 0, At, B0); PG8_MMA(1, 1, At, B1); PG8_BAR; PG8_SCHED;
            PG8_LDB(B0, 1, 0); PG8_LDB(B1, 1, 1); PG8_SCHED; PG8_LDA(At, 1, 0); PG8_STAGE(PG8_SA(0, 1), a2 + ah, v2[1]);
            PG8_WAIT_V(8); PG8_WAIT_L(0); PG8_BAR; PG8_MMA(0, 0, At, B0); PG8_MMA(0, 1, At, B1); PG8_BAR; PG8_SCHED;
            PG8_LDA(At, 1, 1); PG8_STAGE(PG8_SB(1, 0), b3, voffB); PG8_STAGE(PG8_SB(1, 1), b3 + hstep, voffB); PG8_STAGE(PG8_SA(1, 0), a3, v2[0]);
            PG8_WAIT_V(8); PG8_WAIT_L(0); PG8_BAR; PG8_MMA(1, 0, At, B0); PG8_MMA(1, 1, At, B1); PG8_BAR; PG8_SCHED;
            } else {
            PG8_LDB(B0, 0, 0); PG8_SCHED; PG8_LDA(At, 0, 0); PG8_STAGE(PG8_SA(1, 1), a1 + ah, va[1]);
            PG8_WAIT_L(8); PG8_BAR; PG8_WAIT_L(0); PG8_MMA(0, 0, At, B0); PG8_BAR; PG8_SCHED;
            PG8_LDB(B1, 0, 1); PG8_STAGE(PG8_SB(0, 0), b2, voffB);
            PG8_BAR; PG8_WAIT_L(0); PG8_MMA(0, 1, At, B1); PG8_BAR;
            PG8_LDA(At, 0, 1); PG8_STAGE(PG8_SA(0, 0), a2, v2[0]);
            PG8_BAR; PG8_WAIT_L(0); PG8_MMA(1, 0, At, B0); PG8_BAR; PG8_SCHED;
            PG8_STAGE(PG8_SB(0, 1), b2 + hstep, voffB);
            PG8_WAIT_V(6); PG8_BAR; PG8_MMA(1, 1, At, B1); PG8_BAR;
            PG8_LDB(B0, 1, 0); PG8_SCHED; PG8_LDA(At, 1, 0); PG8_STAGE(PG8_SA(0, 1), a2 + ah, v2[1]);
            PG8_WAIT_L(8); PG8_BAR; PG8_WAIT_L(0); PG8_MMA(0, 0, At, B0); PG8_BAR; PG8_SCHED;
            PG8_LDB(B1, 1, 1); PG8_STAGE(PG8_SB(1, 0), b3, voffB);
            PG8_BAR; PG8_WAIT_L(0); PG8_MMA(0, 1, At, B1); PG8_BAR;
            PG8_LDA(At, 1, 1); PG8_STAGE(PG8_SA(1, 0), a3, v2[0]);
            PG8_BAR; PG8_WAIT_L(0); PG8_MMA(1, 0, At, B0); PG8_BAR; PG8_SCHED;
            PG8_STAGE(PG8_SB(1, 1), b3 + hstep, voffB);
            PG8_WAIT_V(6); PG8_BAR; PG8_MMA(1, 1, At, B1); PG8_BAR;
            }
        }
        if constexpr (ALIGN_EPI) { if (wr == 0) PG8_BAR; }
        E(acc, cur, wr, wc, fr, fq);
        if (!has_next) break;
#pragma unroll
        for (int a = 0; a < 2; ++a)
#pragma unroll
            for (int b = 0; b < 2; ++b)
#pragma unroll
                for (int m = 0; m < 4; ++m)
#pragma unroll
                    for (int n = 0; n < 2; ++n) acc[a][b][m][n] = (f32x4){0.f, 0.f, 0.f, 0.f};
        cur = nxt; cA = nA; cB = nB; ++ui;
        if constexpr (GATHER) PG8_GOFF(va, ubn);
        if constexpr (ALIGN_EPI) { if (wr == 1) PG8_BAR; }
    }
    PG8_WAIT_V(0);
    if constexpr (!ALIGN_EPI) { if (wr == 0) PG8_BAR; }
    PG8_BAR;
#undef PG8_SA
#undef PG8_GOFF
#undef PG8_SB
#undef PG8_STAGE
#undef PG8_LDA
#undef PG8_LDB
#undef PG8_MMA
#undef PG8_WAIT_V
#undef PG8_WAIT_L
#undef PG8_BAR
#undef PG8_SCHED
}
}

#define XB_TMO      128
#define XB_XCNT(j)  (256  + 64 * (j))
#define XB_XSUB(j)  (1280 + 64 * (j))
#define XB_XGEN(j)  (2304 + 64 * (j))
#define XB_TOP      3328
#define XB_TOPGEN   3392
#define XCD_BAR_WORDS 3456
#define XB_SPIN_CAP (1u << 18)
__device__ __forceinline__ unsigned xb_ld(unsigned* p)              { return __hip_atomic_load(p, __ATOMIC_RELAXED, __HIP_MEMORY_SCOPE_AGENT); }
__device__ __forceinline__ unsigned xb_add(unsigned* p, unsigned v) { return __hip_atomic_fetch_add(p, v, __ATOMIC_RELAXED, __HIP_MEMORY_SCOPE_AGENT); }
__device__ __forceinline__ unsigned xb_xcc_id() { return (unsigned)__builtin_amdgcn_s_getreg((3 << 11) | 20) & 0xFu; }
#define XB_SPIN(cond, bar) do { unsigned _sp = 0; while (cond) { __builtin_amdgcn_s_sleep(1); \
    if ((++_sp & 255u) == 0u) { if (xb_ld(&(bar)[XB_TMO])) break; if (_sp > XB_SPIN_CAP) { atomicAdd(&(bar)[XB_TMO], 1u); break; } } } } while (0)
struct XcdBarrier { unsigned* bar; unsigned x; volatile LAS unsigned* st; };
__device__ __forceinline__ XcdBarrier xcd_barrier_post(unsigned* bar, volatile LAS unsigned* st) {
    XcdBarrier b; b.bar = bar; b.x = xb_xcc_id(); b.st = st;
    if (threadIdx.x == 0) (void)xb_add(&bar[XB_XCNT(b.x)], 1u);
    return b;
}
__device__ __forceinline__ void xcd_barrier_complete(unsigned* bar, unsigned x, unsigned& nloc, unsigned& nx) {
    const unsigned G = gridDim.x * gridDim.y * gridDim.z;
    unsigned sum, cnt, mine, sp = 0u;
    for (;;) {
        sum = 0u; cnt = 0u; mine = 0u;
#pragma unroll
        for (unsigned j = 0; j < 16; ++j) { const unsigned c = xb_ld(&bar[XB_XCNT(j)]); sum += c; cnt += (c > 0u) ? 1u : 0u; mine = (j == x) ? c : mine; }
        if (sum == G) break;
        __builtin_amdgcn_s_sleep(1);
        if ((++sp & 255u) == 0u) { if (xb_ld(&bar[XB_TMO])) break; if (sp > XB_SPIN_CAP) { atomicAdd(&bar[XB_TMO], 1u); break; } }
    }
    nloc = mine > 0u ? mine : 1u; nx = cnt > 0u ? cnt : 1u;
}
__device__ __forceinline__ void xcd_barrier(const XcdBarrier& b) {
    asm volatile("s_waitcnt vmcnt(0)" ::: "memory");
    __syncthreads();
    if (threadIdx.x == 0) {
        unsigned* bar = b.bar;
        __builtin_amdgcn_s_waitcnt(0);
        unsigned nloc = b.st[0], nx = b.st[1];
        if (nloc == 0u) { xcd_barrier_complete(bar, b.x, nloc, nx); b.st[0] = nloc; b.st[1] = nx; }
        const unsigned old = xb_add(&bar[XB_XSUB(b.x)], 1u);
        const unsigned gen = old / nloc;
        if (old + 1u == (gen + 1u) * nloc) {
            __builtin_amdgcn_fence(__ATOMIC_RELEASE, "agent");
            asm volatile("s_waitcnt vmcnt(0)" ::: "memory");
            const unsigned og = xb_add(&bar[XB_TOP], 1u);
            const unsigned tg = og / nx;
            if (og + 1u == (tg + 1u) * nx) xb_add(&bar[XB_TOPGEN], 1u);
            else XB_SPIN(xb_ld(&bar[XB_TOPGEN]) == tg, bar);
            __builtin_amdgcn_fence(__ATOMIC_ACQUIRE, "agent");
            xb_add(&bar[XB_XGEN(b.x)], 1u);
            asm volatile("s_waitcnt vmcnt(0)" ::: "memory");
        } else {
            XB_SPIN(xb_ld(&bar[XB_XGEN(b.x)]) == gen, bar);
            __builtin_amdgcn_fence(__ATOMIC_ACQUIRE, "agent");
            asm volatile("s_waitcnt vmcnt(0)" ::: "memory");
        }
    }
    __syncthreads();
}

constexpr size_t MiB = 1u << 20;
constexpr size_t al(size_t x) { return (x + 4095) & ~(size_t)4095; }
constexpr size_t WS_CTL = 0, CTL_ZERO_BYTES = 1 * MiB;
constexpr int CW_BAR = 4096;
constexpr int CW_CNT = 16384;
constexpr int CW_NT = 16384 + 512;
constexpr size_t WS_MOD = 1 * MiB;
constexpr size_t WS_TILE_E = WS_MOD + 256 * 1024;
constexpr size_t WS_PADSTART = WS_TILE_E + 16 * 1024;
constexpr size_t WS_ROWTOK = 2 * MiB;
constexpr size_t WS_EIDX = 4 * MiB;
constexpr size_t WS_GATE = 5 * MiB;
constexpr size_t WS_DEST = 6 * MiB;
constexpr size_t WS_WIN = 8 * MiB;
constexpr size_t WS_WLORA = WS_WIN + al((size_t)NP * D * 2);
constexpr size_t WS_WBRRW = WS_WLORA + al((size_t)NLORA * KLORA * 2);
constexpr size_t WS_WBRGLA = WS_WBRRW + al((size_t)D * RWW * 2);
constexpr size_t WS_WOUT = WS_WBRGLA + al((size_t)D * RWW * 2);
constexpr size_t WS_WROUTER = WS_WOUT + al((size_t)D * D * 2);
constexpr size_t WS_WGU = WS_WROUTER + al((size_t)NE * D * 2);
constexpr size_t WS_WD = WS_WGU + al((size_t)(NE + 1) * 512 * D * 2);
constexpr size_t WS_PERSIST_END = WS_WD + al((size_t)(NE + 1) * D * FF * 2);
constexpr size_t WS_REGB = WS_PERSIST_END;
constexpr size_t SZ512F = al((size_t)MR * RWW * 4), SZ256F = al((size_t)MR * 256 * 4), SZ512H = al((size_t)MR * RWW * 2);
constexpr size_t WS_A1 = WS_REGB;
constexpr size_t WS_A2 = WS_A1;
constexpr size_t WS_KSUM = WS_A2 + al((size_t)MR * KLORA * 2);
static_assert(WS_KSUM + SZ512H <= WS_A1 + al((size_t)MR * D * 2), "A2 + KSUM fit in the A1 slot");
constexpr size_t WS_P = WS_A1 + al((size_t)MR * D * 2);
constexpr size_t WS_R = WS_P + al((size_t)MR * NP * 2);
constexpr size_t WS_V = WS_R + SZ512F, WS_KK = WS_V + SZ512F, WS_WF = WS_KK + SZ512F, WS_WB = WS_WF + SZ512F, WS_KMF = WS_WB + SZ512F, WS_KMB = WS_KMF + SZ512F, WS_BVF = WS_KMB + SZ512F, WS_BVB = WS_BVF + SZ512F;
constexpr size_t WS_QG = WS_BVB + SZ512F, WS_KGB = WS_QG + SZ256F, WS_VGB = WS_KGB + SZ256F, WS_GAF = WS_VGB + SZ512F, WS_GAB = WS_GAF + SZ256F;
constexpr size_t WS_RWG = WS_GAB + SZ256F;
constexpr size_t WS_ORWF = WS_RWG + SZ512H, WS_ORWB = WS_ORWF + SZ512H, WS_OGLF = WS_ORWB + SZ512H, WS_OGLB = WS_OGLF + SZ512H;
constexpr size_t WS_END_MIX = WS_OGLB + SZ512H;
constexpr size_t WS_YRW = WS_WF, WS_YGLA = WS_WB, WS_Z = WS_BVF;
constexpr size_t WS_X1 = WS_REGB;
constexpr size_t WS_A3 = WS_X1 + al((size_t)NLAT * D * 4);
constexpr size_t WS_LOGITS = WS_A3 + al((size_t)NLAT * D * 2);
constexpr size_t WS_ACT = WS_LOGITS + al((size_t)NLAT * NE * 4);
constexpr size_t WS_Y = WS_ACT + al((size_t)NROWS_E * FF * 2);
constexpr size_t WS_END_MOE = WS_Y + al((size_t)NROWS_E * D * 2);
constexpr size_t WS_END = WS_END_MIX > WS_END_MOE ? WS_END_MIX : WS_END_MOE;
static_assert(WS_END <= (size_t)2048 * MiB, "workspace map exceeds 2 GiB");

constexpr int RING_BYTES = 131072;
constexpr int IDX_BYTES = pg8::IDX_UNITS * 256 * 4;
constexpr int MISC_OFF = RING_BYTES + IDX_BYTES;
constexpr int LDS_BYTES = MISC_OFF + 256;
static_assert(pg8::IDX_OFF == RING_BYTES, "gather table sits right above the stage buffers");
constexpr int NWAVES = 8, NTHR = 512;

struct Args { const float* in[36]; float* out; unsigned char* ws; int ph_lo, ph_hi; };

struct Frame {
    LAS unsigned char* lds;
    int tid, lane, wave, G, gw, NGW;
    const float* const* in; float* out; unsigned char* ws; unsigned* ctl;
};

__device__ __forceinline__ float wave_sum(float v) {
#pragma unroll
    for (int o = 1; o < 64; o <<= 1) v += __shfl_xor(v, o);
    return v;
}
__device__ __forceinline__ unsigned f2bf(float f) { unsigned u = __builtin_bit_cast(unsigned, f); return (u + 0x7fffu + ((u >> 16) & 1u)) >> 16; }
__device__ __forceinline__ unsigned pk2(float lo, float hi) { return f2bf(lo) | (f2bf(hi) << 16); }
__device__ __forceinline__ float bflo(unsigned w) { return __builtin_bit_cast(float, w << 16); }
__device__ __forceinline__ float bfhi(unsigned w) { return __builtin_bit_cast(float, w & 0xffff0000u); }
__device__ __forceinline__ float sigmoidf_(float x) { return 1.0f / (1.0f + __expf(-x)); }
__device__ __forceinline__ float siluf_(float x) { return x / (1.0f + __expf(-x)); }

__device__ __forceinline__ void ln_stats(const f32x4 (&v)[4], float& mean, float& rstd) {
    float s = 0.f;
#pragma unroll
    for (int j = 0; j < 4; ++j) s += (v[j].x + v[j].y) + (v[j].z + v[j].w);
    mean = wave_sum(s) * (1.f / D); float s2 = 0.f;
#pragma unroll
    for (int j = 0; j < 4; ++j) { const f32x4 d = v[j] - mean; s2 += (d.x * d.x + d.y * d.y) + (d.z * d.z + d.w * d.w); }
    rstd = 1.f / sqrtf(wave_sum(s2) * (1.f / D) + LN_EPS);
}

__device__ __forceinline__ void ph_x1pre_nomix(Frame& F) {
    const float* x = F.in[0];
    for (int m = F.gw; m < NLAT; m += F.NGW) {
        const f32x4* xr = (const f32x4*)(x + (size_t)m * D) + F.lane; f32x4* o = (f32x4*)(F.out + (size_t)m * D) + F.lane;
#pragma unroll
        for (int j = 0; j < 4; ++j) o[64 * j] = xr[64 * j] * ALPHA;
    }
}
__device__ __forceinline__ void ph_ln1(Frame& F) {
    const float* lw = F.in[26]; const float* lb = F.in[27]; const float* mod = (const float*)(F.ws + WS_MOD);
    float* X1 = (float*)(F.ws + WS_X1); bf16* A3 = (bf16*)(F.ws + WS_A3);
    for (int m = F.gw; m < NLAT; m += F.NGW) {
        const int b = m / SEQ;
        const f32x4* pr = (const f32x4*)(F.out + (size_t)m * D) + F.lane;
        f32x4 v[4];
#pragma unroll
        for (int j = 0; j < 4; ++j) v[j] = pr[64 * j];
        float mean, rstd; ln_stats(v, mean, rstd);
        f32x4* xo = (f32x4*)(X1 + (size_t)m * D) + F.lane; v2u* ao = (v2u*)(A3 + (size_t)m * D) + F.lane;
#pragma unroll
        for (int j = 0; j < 4; ++j) {
            const int c = 4 * F.lane + 256 * j;
            const f32x4 w = *(const f32x4*)(lw + c), bb = *(const f32x4*)(lb + c);
            const f32x4 x1 = (v[j] - mean) * rstd * w + bb;
            xo[64 * j] = x1;
#if MS >= 2
            const f32x4 sh = *(const f32x4*)(mod + b * 6144 + 3072 + c), sc = *(const f32x4*)(mod + b * 6144 + 4096 + c);
            const f32x4 h = x1 * (sc + 1.0f) + sh;
            v2u o; o.x = pk2(h.x, h.y); o.y = pk2(h.z, h.w); ao[64 * j] = o;
#endif
        }
    }
}
__device__ __forceinline__ void ph_final(Frame& F) {
    const float* lw = F.in[34]; const float* lb = F.in[35]; const float* mod = (const float*)(F.ws + WS_MOD);
    const float* X1 = (const float*)(F.ws + WS_X1);
    const bf16* Y = (const bf16*)(F.ws + WS_Y); const int* DEST = (const int*)(F.ws + WS_DEST); const float* GATE = (const float*)(F.ws + WS_GATE);
    for (int m = F.gw; m < NLAT; m += F.NGW) {
        const int b = m / SEQ;
        const f32x4* pr = (const f32x4*)(X1 + (size_t)m * D) + F.lane;
        f32x4 v[4];
#pragma unroll
        for (int j = 0; j < 4; ++j) v[j] = pr[64 * j] * ALPHA;
#if MS >= 2
        f32x4 mo[4];
        { const v2u* yr = (const v2u*)(Y + (size_t)(SH_ROW0 + m) * D) + F.lane;
#pragma unroll
          for (int j = 0; j < 4; ++j) { const v2u w = yr[64 * j]; mo[j] = (f32x4){bflo(w.x), bfhi(w.x), bflo(w.y), bfhi(w.y)}; } }
        for (int k = 0; k < TOPK; ++k) {
            const int dr = DEST[m * 8 + k]; const float gt = GATE[m * 8 + k];
            const v2u* yr = (const v2u*)(Y + (size_t)dr * D) + F.lane;
#pragma unroll
            for (int j = 0; j < 4; ++j) { const v2u w = yr[64 * j]; mo[j] += (f32x4){bflo(w.x), bfhi(w.x), bflo(w.y), bfhi(w.y)} * gt; }
        }
#pragma unroll
        for (int j = 0; j < 4; ++j) { const f32x4 g2 = *(const f32x4*)(mod + b * 6144 + 5120 + 4 * F.lane + 256 * j); v[j] += g2 * mo[j]; }
#endif
        float mean, rstd; ln_stats(v, mean, rstd);
        f32x4* o = (f32x4*)(F.out + (size_t)m * D) + F.lane;
#pragma unroll
        for (int j = 0; j < 4; ++j) { const int c = 4 * F.lane + 256 * j; const f32x4 w = *(const f32x4*)(lw + c), bb = *(const f32x4*)(lb + c); o[64 * j] = (v[j] - mean) * rstd * w + bb; }
    }
}


#if MS >= 2
template <int MODE>
__device__ __forceinline__ void cvt_item(const float* W, int Nsrc, int nblk, bf16* WT, int row_off, int dpitch, LAS float* scr, int item, int lane) {
    const int kb = item / nblk, nb = item - kb * nblk, k0 = 64 * kb, n0 = 32 * nb;
    const int nn = n0 + (lane & 31);
#pragma unroll 8
    for (int i = 0; i < 32; ++i) { const int kk = 2 * i + (lane >> 5); scr[kk * 33 + (lane & 31)] = (nn < Nsrc) ? W[(size_t)(k0 + kk) * Nsrc + nn] : 0.f; }
    LDS_WAIT(); asm volatile("" ::: "memory");
    const int c = lane & 7;
#pragma unroll
    for (int j = 0; j < 4; ++j) { const int n = (lane >> 3) + 8 * j; const LAS float* s = scr + (8 * c) * 33 + n;
        v4u o; o.x = pk2(s[0 * 33], s[1 * 33]); o.y = pk2(s[2 * 33], s[3 * 33]); o.z = pk2(s[4 * 33], s[5 * 33]); o.w = pk2(s[6 * 33], s[7 * 33]);
        const int ng = n0 + n; int dr = ng;
        if (MODE == 1) { const int i2 = ng & 255; dr = 8 * (i2 >> 2) + (i2 & 3) + ((ng >= 256) ? 4 : 0); }
        *(v4u*)(WT + (size_t)(row_off + dr) * dpitch + k0 + 8 * c) = o; }
    LDS_WAIT(); asm volatile("" ::: "memory");
}

#if MS >= 3
__device__ __forceinline__ float lora_val(const float* const* in, int n, int k) {
    if (n < 1024) { const int q = n >> 3, e8 = n & 7, dir = e8 >> 2, ch = q * 4 + (e8 & 3); return (k < 32) ? in[9][(size_t)(dir * 32 + k) * 512 + ch] : 0.f; }
    if (n < 2048) { const int m = n - 1024, q = m >> 3, e8 = m & 7, dir = e8 >> 2, ch = q * 4 + (e8 & 3); return (k >= 32 && k < 64) ? in[11][(size_t)(dir * 32 + (k - 32)) * 512 + ch] : 0.f; }
    if (n < 2560) { const int ch = n - 2048; return (k >= 64 && k < 160) ? in[12][(size_t)(k - 64) * 512 + ch] : 0.f; }
    { const int m = n - 2560, q = m >> 3, e8 = m & 7, dir = e8 >> 2, ch = q * 4 + (e8 & 3); return (k >= 160 && k < 176) ? in[19][(size_t)(dir * 16 + (k - 160)) * 256 + ch] : 0.f; }
}
#endif

__device__ __forceinline__ void ph_prologue(Frame& F) {
    {
        const float* c = F.in[1]; const float* cc = F.in[3]; const float* wa = F.in[4]; const float* ba = F.in[5];
        float* MOD = (float*)(F.ws + WS_MOD);
        LAS float* S = (LAS float*)F.lds; LAS float* red = (LAS float*)(F.lds + 32768);
        for (int it = blockIdx.x; it < 96; it += F.G) {
            for (int i = F.tid; i < 5120; i += NTHR) { const int r = i >> 10, k = i & 1023; const float cv = r < 4 ? c[r * 1024 + k] : cc[k]; S[i] = siluf_(cv); }
            __syncthreads();
            const int n = it * 64 + F.lane; float acc[5] = {0.f, 0.f, 0.f, 0.f, 0.f};
            for (int kk = 0; kk < 128; ++kk) { const int k = F.wave * 128 + kk; const float wv = wa[(size_t)k * 6144 + n];
#pragma unroll
                for (int r = 0; r < 5; ++r) acc[r] += S[r * 1024 + k] * wv; }
#pragma unroll
            for (int r = 0; r < 5; ++r) red[(F.wave * 5 + r) * 64 + F.lane] = acc[r];
            __syncthreads();
            if (F.wave == 0) {
#pragma unroll
                for (int r = 0; r < 5; ++r) { float s = 0.f;
#pragma unroll
                    for (int w = 0; w < 8; ++w) s += red[(w * 5 + r) * 64 + F.lane];
                    MOD[r * 6144 + n] = s + ba[n]; }
            }
            __syncthreads();
        }
    }
    {
        LAS float* scr = (LAS float*)(F.lds + F.wave * 16384);
        constexpr int I_IN = 16 * 168, I_BR = 8 * 32, I_OUT = 16 * 32, I_RT = 16 * 8, I_GU = 16 * 16, I_DN = 4 * 32;
        constexpr int T0 = I_IN, T1 = T0 + I_BR, T2 = T1 + I_BR, T3 = T2 + I_OUT, T4 = T3 + I_RT, T5 = T4 + (NE + 1) * I_GU, T6 = T5 + (NE + 1) * I_DN;
        unsigned char* ws = F.ws;
        for (int it = F.gw; it < T6; it += F.NGW) {
#if MS >= 3
            if (it < T0) { cvt_item<0>(F.in[6], IN_COLS, 168, (bf16*)(ws + WS_WIN), 0, D, scr, it, F.lane); continue; }
            if (it < T1) { cvt_item<0>(F.in[23], D, 32, (bf16*)(ws + WS_WBRRW), 0, RWW, scr, it - T0, F.lane); continue; }
            if (it < T2) { cvt_item<0>(F.in[24], D, 32, (bf16*)(ws + WS_WBRGLA), 0, RWW, scr, it - T1, F.lane); continue; }
            if (it < T3) { cvt_item<0>(F.in[25], D, 32, (bf16*)(ws + WS_WOUT), 0, D, scr, it - T2, F.lane); continue; }
#else
            if (it < T3) continue;
#endif
            if (it < T4) { cvt_item<0>(F.in[28], NE, 8, (bf16*)(ws + WS_WROUTER), 0, D, scr, it - T3, F.lane); continue; }
            if (it < T5) { const int r = it - T4, e = r / I_GU, ii = r - e * I_GU;
                const float* src = (e < NE) ? F.in[30] + (size_t)e * D * 512 : F.in[32];
                cvt_item<1>(src, 512, 16, (bf16*)(ws + WS_WGU), e * 512, D, scr, ii, F.lane); continue; }
            { const int r = it - T5, e = r / I_DN, ii = r - e * I_DN;
                const float* src = (e < NE) ? F.in[31] + (size_t)e * FF * D : F.in[33];
                cvt_item<0>(src, D, 32, (bf16*)(ws + WS_WD), e * D, FF, scr, ii, F.lane); }
        }
    }
#if MS >= 3
    {
        bf16* WL = (bf16*)(F.ws + WS_WLORA);
        for (int idx = blockIdx.x * NTHR + F.tid; idx < NLORA * (KLORA / 8); idx += F.G * NTHR) {
            const int n = idx >> 5, k0 = (idx & 31) * 8; float v[8];
#pragma unroll
            for (int e = 0; e < 8; ++e) v[e] = lora_val(F.in, n, k0 + e);
            v4u o; o.x = pk2(v[0], v[1]); o.y = pk2(v[2], v[3]); o.z = pk2(v[4], v[5]); o.w = pk2(v[6], v[7]);
            *(v4u*)(WL + (size_t)n * KLORA + k0) = o;
        }
    }
#endif
}

struct EpiF32 {
    static constexpr bool PERM = false;
    float* C; int ldc;
    __device__ __forceinline__ void operator()(const f32x4 (&acc)[2][2][4][2], const pg8::Unit& u, int wr, int wc, int fr, int fq) const {
        const int row0 = u.pm * 256 + wr * 64 + fr, col0 = u.pn * 256 + wc * 32 + 4 * fq;
#pragma unroll
        for (int ai = 0; ai < 2; ++ai)
#pragma unroll
            for (int m = 0; m < 4; ++m) { float* rowp = C + (size_t)(row0 + ai * 128 + m * 16) * ldc + col0;
#pragma unroll
                for (int bj = 0; bj < 2; ++bj)
#pragma unroll
                    for (int n = 0; n < 2; ++n) *(f32x4*)(rowp + bj * 128 + n * 16) = acc[ai][bj][m][n]; }
    }
};
struct EpiSwiglu {
    static constexpr bool PERM = true;
    bf16* ACT;
    __device__ __forceinline__ void operator()(const f32x4 (&acc)[2][2][4][2], const pg8::Unit& u, int wr, int wc, int fr, int fq) const {
        const int row0 = u.pm * 256 + wr * 64 + fr, h0 = u.j * 128 + wc * 16 + 4 * fq;
#pragma unroll
        for (int ai = 0; ai < 2; ++ai)
#pragma unroll
            for (int m = 0; m < 4; ++m) { bf16* rowp = ACT + (size_t)(row0 + ai * 128 + m * 16) * FF + h0;
#pragma unroll
                for (int bj = 0; bj < 2; ++bj) { const f32x4 a = acc[ai][bj][m][0], b = acc[ai][bj][m][1];
                    v2u o; o.x = pg8::cvt_pk_bf16(siluf_(a[0]) * b[0], siluf_(a[1]) * b[1]); o.y = pg8::cvt_pk_bf16(siluf_(a[2]) * b[2], siluf_(a[3]) * b[3]);
                    *(v2u*)(rowp + bj * 64) = o; } }
    }
};
struct EpiRowsBf16 {
    static constexpr bool PERM = true;
    bf16* O; int ldc;
    __device__ __forceinline__ void operator()(const f32x4 (&acc)[2][2][4][2], const pg8::Unit& u, int wr, int wc, int fr, int fq) const {
        const int row0 = u.pm * 256 + wr * 64 + fr, col0 = u.j * 256 + wc * 32 + 8 * fq;
#pragma unroll
        for (int ai = 0; ai < 2; ++ai)
#pragma unroll
            for (int m = 0; m < 4; ++m) { bf16* rowp = O + (size_t)(row0 + ai * 128 + m * 16) * ldc + col0;
#pragma unroll
                for (int bj = 0; bj < 2; ++bj) { const f32x4 v0 = acc[ai][bj][m][0], v1 = acc[ai][bj][m][1];
                    v4u w; w.x = pg8::cvt_pk_bf16(v0[0], v0[1]); w.y = pg8::cvt_pk_bf16(v0[2], v0[3]); w.z = pg8::cvt_pk_bf16(v1[0], v1[1]); w.w = pg8::cvt_pk_bf16(v1[2], v1[3]);
                    *(v4u*)(rowp + bj * 128) = w; } }
    }
};

__device__ __forceinline__ void ph_router(Frame& F) {
    pg8::Gemm g{(const bf16*)(F.ws + WS_A3), (const bf16*)(F.ws + WS_WROUTER), NLAT, NE, D, nullptr};
    pg8::StaticOrder S; S.init(NLAT, NE, F.G, (int)blockIdx.x);
    EpiF32 E{(float*)(F.ws + WS_LOGITS), NE};
    pg8::gemm_phase<EpiF32, pg8::StaticOrder, true, true, false>(F.lds, g, S, E);
}

__device__ __forceinline__ void ph_route(Frame& F) {
    const float* LOG = (const float*)(F.ws + WS_LOGITS); const float* rb = F.in[29];
    int* EIDX = (int*)(F.ws + WS_EIDX); float* GATE = (float*)(F.ws + WS_GATE); int* DEST = (int*)(F.ws + WS_DEST);
    unsigned* CNT = F.ctl + CW_CNT;
    const f32x4 bias = *(const f32x4*)(rb + 4 * F.lane);
    const float NEG = -3.0e38f;
    for (int m = F.gw; m < NLAT; m += F.NGW) {
        const f32x4 lg = *(const f32x4*)(LOG + (size_t)m * NE + 4 * F.lane);
        float sc[4], sel[4];
#pragma unroll
        for (int i = 0; i < 4; ++i) { sc[i] = sigmoidf_(lg[i]); sel[i] = sc[i] + bias[i]; }
        float m1 = fmaxf(sel[0], sel[1]), m2 = fminf(sel[0], sel[1]);
        { const float a = sel[2]; const float n1 = fmaxf(m1, a); m2 = fmaxf(m2, fminf(m1, a)); m1 = n1; }
        { const float a = sel[3]; const float n1 = fmaxf(m1, a); m2 = fmaxf(m2, fminf(m1, a)); m1 = n1; }
#pragma unroll
        for (int o = 1; o < 8; o <<= 1) { const float b1 = __shfl_xor(m1, o), b2 = __shfl_xor(m2, o); const float n1 = fmaxf(m1, b1); m2 = fmaxf(fminf(m1, b1), fmaxf(m2, b2)); m1 = n1; }
        const float gs = m1 + m2; const int g = F.lane >> 3;
        int rank = 0;
#pragma unroll
        for (int gg = 0; gg < 8; ++gg) { const float og = __shfl(gs, gg * 8); rank += (og > gs || (og == gs && gg < g)) ? 1 : 0; }
        const bool keep = rank < 4;
#pragma unroll
        for (int i = 0; i < 4; ++i) sel[i] = keep ? sel[i] : NEG;
        int my_e = 0; float my_s = 0.f; float ssum = 0.f;
        for (int k = 0; k < TOPK; ++k) {
            float bv = sel[0]; int bi = 0;
#pragma unroll
            for (int i = 1; i < 4; ++i) if (sel[i] > bv) { bv = sel[i]; bi = i; }
            int be = 4 * F.lane + bi; float v = bv; int e = be;
#pragma unroll
            for (int o = 1; o < 64; o <<= 1) { const float ov = __shfl_xor(v, o); const int oe = __shfl_xor(e, o); if (ov > v || (ov == v && oe < e)) { v = ov; e = oe; } }
            const int owner = e >> 2, oi = e & 3;
            float s_own = 0.f;
            if (F.lane == owner) {
#pragma unroll
                for (int i = 0; i < 4; ++i) if (i == oi) { s_own = sc[i]; sel[i] = NEG; }
            }
            const float s = __shfl(s_own, owner);
            ssum += s;
            if (F.lane == k) { my_e = e; my_s = s; }
        }
        if (F.lane < TOPK) {
            const unsigned pos = __hip_atomic_fetch_add(CNT + my_e, 1u, __ATOMIC_RELAXED, __HIP_MEMORY_SCOPE_AGENT);
            EIDX[m * 8 + F.lane] = my_e; GATE[m * 8 + F.lane] = my_s / ssum * 2.5f; DEST[m * 8 + F.lane] = (int)pos;
        }
    }
}

__device__ __forceinline__ void ph_scatter(Frame& F) {
    LAS int* tstart = (LAS int*)F.lds;
    LAS int* scan = (LAS int*)(F.lds + 2048);
    LAS int* cnts = (LAS int*)(F.lds + 4096);
    int* EIDX = (int*)(F.ws + WS_EIDX); int* DEST = (int*)(F.ws + WS_DEST); int* ROWTOK = (int*)(F.ws + WS_ROWTOK); int* TILE_E = (int*)(F.ws + WS_TILE_E);
    unsigned* CNT = F.ctl + CW_CNT;
    int tiles = 0, cnt = 0;
    if (F.tid < NE) { cnt = (int)__hip_atomic_load(CNT + F.tid, __ATOMIC_RELAXED, __HIP_MEMORY_SCOPE_AGENT); tiles = (cnt + 255) >> 8; scan[F.tid] = tiles; cnts[F.tid] = cnt; }
    __syncthreads();
    for (int o = 1; o < NE; o <<= 1) { int v = 0; if (F.tid < NE && F.tid >= o) v = scan[F.tid - o]; __syncthreads(); if (F.tid < NE) scan[F.tid] += v; __syncthreads(); }
    if (F.tid < NE) { tstart[F.tid + 1] = scan[F.tid]; if (F.tid == 0) tstart[0] = 0; }
    __syncthreads();
    const int NT = tstart[NE];
    if (blockIdx.x == 0) {
        if (F.tid == 0) F.ctl[CW_NT] = (unsigned)NT;
        if (F.tid < NE) for (int t = tstart[F.tid]; t < tstart[F.tid + 1]; ++t) TILE_E[t] = F.tid;
    }
    for (int e = blockIdx.x; e < NE; e += F.G) { const int c0 = cnts[e], c1 = (tstart[e + 1] - tstart[e]) * 256, base = tstart[e] * 256;
        for (int p = c0 + F.tid; p < c1; p += NTHR) ROWTOK[base + p] = 0; }
    for (int i = blockIdx.x * NTHR + F.tid; i < NLAT; i += F.G * NTHR) ROWTOK[SH_ROW0 + i] = i;
    for (int i = blockIdx.x * NTHR + F.tid; i < NLAT * TOPK; i += F.G * NTHR) {
        const int e = EIDX[i], pos = DEST[i]; const int dr = tstart[e] * 256 + pos;
        DEST[i] = dr; ROWTOK[dr] = i >> 3;
    }
}

__device__ __forceinline__ void ph_exp1(Frame& F) {
    const int NT = (int)__hip_atomic_load(F.ctl + CW_NT, __ATOMIC_RELAXED, __HIP_MEMORY_SCOPE_AGENT);
    pg8::Gemm g{(const bf16*)(F.ws + WS_A3), (const bf16*)(F.ws + WS_WGU), 0, 0, D, (const int*)(F.ws + WS_ROWTOK)};
    pg8::MoeOrder S{2, F.G, (int)blockIdx.x, NT, (const int*)(F.ws + WS_TILE_E)};
    EpiSwiglu E{(bf16*)(F.ws + WS_ACT)};
    pg8::gemm_phase<EpiSwiglu, pg8::MoeOrder, true, true, true>(F.lds, g, S, E);
}
__device__ __forceinline__ void ph_exp2(Frame& F) {
    const int NT = (int)__hip_atomic_load(F.ctl + CW_NT, __ATOMIC_RELAXED, __HIP_MEMORY_SCOPE_AGENT);
    pg8::Gemm g{(const bf16*)(F.ws + WS_ACT), (const bf16*)(F.ws + WS_WD), 0, 0, FF, nullptr};
    pg8::MoeOrder S{4, F.G, (int)blockIdx.x, NT, (const int*)(F.ws + WS_TILE_E)};
    EpiRowsBf16 E{(bf16*)(F.ws + WS_Y), D};
    pg8::gemm_phase<EpiRowsBf16, pg8::MoeOrder, true, true, false>(F.lds, g, S, E);
}
#endif

#if MS >= 3
__device__ __forceinline__ void unp8(const v4u w, float (&f)[8]) { f[0] = bflo(w.x); f[1] = bfhi(w.x); f[2] = bflo(w.y); f[3] = bfhi(w.y); f[4] = bflo(w.z); f[5] = bfhi(w.z); f[6] = bflo(w.w); f[7] = bfhi(w.w); }
__device__ __forceinline__ v4u pk8(const float (&f)[8]) { v4u o; o.x = pk2(f[0], f[1]); o.y = pk2(f[2], f[3]); o.z = pk2(f[4], f[5]); o.w = pk2(f[6], f[7]); return o; }
__device__ __forceinline__ void st8(float* p, const float (&f)[8]) { *(f32x4*)p = (f32x4){f[0], f[1], f[2], f[3]}; *(f32x4*)(p + 4) = (f32x4){f[4], f[5], f[6], f[7]}; }
__device__ __forceinline__ void ld8(const float* p, float (&f)[8]) { const f32x4 a = *(const f32x4*)p, b = *(const f32x4*)(p + 4); f[0] = a.x; f[1] = a.y; f[2] = a.z; f[3] = a.w; f[4] = b.x; f[5] = b.y; f[6] = b.z; f[7] = b.w; }

__device__ __forceinline__ void ph_a1(Frame& F) {
    const float* mod = (const float*)(F.ws + WS_MOD); bf16* A1 = (bf16*)(F.ws + WS_A1);
    for (int m = F.gw; m < MR; m += F.NGW) {
        const float* src = (m < NLAT) ? F.in[0] + (size_t)m * D : F.in[2] + (size_t)(m - NLAT) * D;
        const int mr = (m < NLAT) ? (m / SEQ) : 4;
        const f32x4* xr = (const f32x4*)src + F.lane; v2u* ao = (v2u*)(A1 + (size_t)m * D) + F.lane;
#pragma unroll
        for (int j = 0; j < 4; ++j) { const int c = 4 * F.lane + 256 * j;
            const f32x4 sh = *(const f32x4*)(mod + mr * 6144 + c), sc = *(const f32x4*)(mod + mr * 6144 + 1024 + c);
            const f32x4 h = xr[64 * j] * (sc + 1.0f) + sh; v2u o; o.x = pk2(h.x, h.y); o.y = pk2(h.z, h.w); ao[64 * j] = o; }
    }
}

__device__ __forceinline__ void ph_inproj(Frame& F) {
    pg8::Gemm g{(const bf16*)(F.ws + WS_A1), (const bf16*)(F.ws + WS_WIN), MR, NP, D, nullptr};
    pg8::StaticOrder S; S.init(MR, NP, F.G, (int)blockIdx.x);
    EpiRowsBf16 E{(bf16*)(F.ws + WS_P), NP};
    pg8::gemm_phase<EpiRowsBf16, pg8::StaticOrder, true, true, false>(F.lds, g, S, E);
}

__device__ __forceinline__ void ph_feat(Frame& F) {
    const bf16* P = (const bf16*)(F.ws + WS_P);
    const float* mu = F.in[7]; const float* kkw = F.in[13]; const float* cw = F.in[18];
    float* R = (float*)(F.ws + WS_R); float* V = (float*)(F.ws + WS_V); float* KK = (float*)(F.ws + WS_KK); float* KP = (float*)(F.ws + WS_KMF);
    float* QG = (float*)(F.ws + WS_QG); float* KGB = (float*)(F.ws + WS_KGB); float* VGB = (float*)(F.ws + WS_VGB);
    bf16* A2 = (bf16*)(F.ws + WS_A2);
    const int lane = F.lane;
    for (int m = F.gw; m < MR; m += F.NGW) {
        int nb[4]; int gr = 0, gc = 0; const bool lat = m < NLAT;
        if (lat) { const int t = m & (SEQ - 1); gr = t >> 6; gc = t & 63;
            nb[0] = gc > 0 ? m - 1 : -1; nb[1] = gc < 63 ? m + 1 : -1; nb[2] = gr > 0 ? m - 64 : -1; nb[3] = gr < 127 ? m + 64 : -1;
        } else { const int t = (m - NLAT) & (CTXL - 1); nb[0] = t > 0 ? m - 1 : -1; nb[1] = t < CTXL - 1 ? m + 1 : -1; nb[2] = nb[0]; nb[3] = nb[1]; }
        const bf16* prow = P + (size_t)m * NP;
#pragma unroll
        for (int p = 0; p < 4; ++p) {
            const int cb = p * 512 + 8 * lane;
            if (p < 3 || lane < 20) {
                float own[8], sh[4][8];
                unp8(*(const v4u*)(prow + cb), own);
#pragma unroll
                for (int q = 0; q < 4; ++q) { v4u w = (v4u){0u, 0u, 0u, 0u}; if (nb[q] >= 0) w = *(const v4u*)(P + (size_t)nb[q] * NP + cb); unp8(w, sh[q]); }
                float muv[8]; ld8(mu + cb, muv);
                float val[8];
#pragma unroll
                for (int e = 0; e < 8; ++e) val[e] = own[e] + muv[e] * (sh[e & 3][e] - own[e]);
                if (p == 0) st8(R + (size_t)m * RWW + 8 * lane, val);
                else if (p == 2) st8(V + (size_t)m * RWW + 8 * lane, val);
                else if (p == 1) {
                    st8(KP + (size_t)m * RWW + 8 * lane, val);
                    float kw[8]; ld8(kkw + 8 * lane, kw); float kkv[8]; float ss = 0.f;
#pragma unroll
                    for (int e = 0; e < 8; ++e) { kkv[e] = val[e] * kw[e]; ss += kkv[e] * kkv[e]; }
                    ss += __shfl_xor(ss, 1); ss += __shfl_xor(ss, 2); ss += __shfl_xor(ss, 4);
                    const float inv = 1.0f / fmaxf(sqrtf(ss), 1e-12f);
#pragma unroll
                    for (int e = 0; e < 8; ++e) kkv[e] *= inv;
                    st8(KK + (size_t)m * RWW + 8 * lane, kkv);
                } else {
                    float o[8];
#pragma unroll
                    for (int e = 0; e < 8; ++e) o[e] = (lane < 4) ? tanhf(val[e]) : ((lane < 8) ? val[e] : sigmoidf_(val[e]));
                    *(v4u*)(A2 + (size_t)m * KLORA + 8 * lane) = pk8(o);
                }
            } else if (p == 3 && lane < 32) {
                v4u w = (v4u){0u, 0u, 0u, 0u};
                if (lane < 22) w = *(const v4u*)(prow + C_PGL + 8 * (lane - 20));
                *(v4u*)(A2 + (size_t)m * KLORA + 8 * lane) = w;
            }
        }
#pragma unroll
        for (int p = 0; p < 2; ++p) {
            const int cq = p * 512 + 8 * lane; const int cb = C_Q + cq;
            float acc[8] = {0.f, 0.f, 0.f, 0.f, 0.f, 0.f, 0.f, 0.f};
#pragma unroll
            for (int dy = -1; dy <= 1; ++dy)
#pragma unroll
                for (int dx = -1; dx <= 1; ++dx) {
                    bool ok; int nr;
                    if (lat) { ok = (gr + dy >= 0) && (gr + dy < GRIDH) && (gc + dx >= 0) && (gc + dx < GRIDW); nr = m + dy * 64 + dx; }
                    else { const int t = (m - NLAT) & (CTXL - 1); ok = (dy == 0) && (t + dx >= 0) && (t + dx < CTXL); nr = m + dx; }
                    if (ok) {
                        float pv[8], wv[8]; unp8(*(const v4u*)(P + (size_t)nr * NP + cb), pv); ld8(cw + ((dy + 1) * 3 + (dx + 1)) * 1024 + cq, wv);
#pragma unroll
                        for (int e = 0; e < 8; ++e) acc[e] += pv[e] * wv[e];
                    }
                }
            float o[8];
#pragma unroll
            for (int e = 0; e < 8; ++e) o[e] = siluf_(acc[e]);
            if (p == 0) {
                if (lane < 32) {
#pragma unroll
                    for (int e = 0; e < 8; ++e) o[e] *= 0.125f;
                    st8(QG + (size_t)m * 256 + cq, o);
                } else st8(KGB + (size_t)m * 256 + (cq - 256), o);
            } else st8(VGB + (size_t)m * RWW + (cq - 512), o);
        }
    }
}

struct EpiLora {
    static constexpr bool PERM = true;
    unsigned char* ws; const float* const* in;
    __device__ __forceinline__ void grp_w(const f32x4 (&acc)[2][2][4][2], int row0, int c0) const {
        float* Wf = (float*)(ws + WS_WF); float* Wb = (float*)(ws + WS_WB);
#pragma unroll
        for (int bj = 0; bj < 2; ++bj) { const int ch = (c0 + bj * 128) >> 1; const f32x4 w0f = *(const f32x4*)(in[8] + ch), w0b = *(const f32x4*)(in[8] + 512 + ch);
#pragma unroll
            for (int ai = 0; ai < 2; ++ai)
#pragma unroll
                for (int m = 0; m < 4; ++m) { const size_t row = (size_t)(row0 + ai * 128 + m * 16);
                    const f32x4 xf = acc[ai][bj][m][0] + w0f, xb = acc[ai][bj][m][1] + w0b; f32x4 df, db;
#pragma unroll
                    for (int e = 0; e < 4; ++e) { df[e] = __expf(-0.60653066f * sigmoidf_(xf[e])); db[e] = __expf(-0.60653066f * sigmoidf_(xb[e])); }
                    *(f32x4*)(Wf + row * RWW + ch) = df; *(f32x4*)(Wb + row * RWW + ch) = db; } }
    }
    __device__ __forceinline__ void grp_a(const f32x4 (&acc)[2][2][4][2], int row0, int c0) const {
        float* KMf = (float*)(ws + WS_KMF); float* KMb = (float*)(ws + WS_KMB); float* BVf = (float*)(ws + WS_BVF); float* BVb = (float*)(ws + WS_BVB);
        const float* KK = (const float*)(ws + WS_KK); bf16* KSUM = (bf16*)(ws + WS_KSUM);
#pragma unroll
        for (int bj = 0; bj < 2; ++bj) { const int ch = (c0 + bj * 128 - 1024) >> 1; const f32x4 a0f = *(const f32x4*)(in[10] + ch), a0b = *(const f32x4*)(in[10] + 512 + ch), ka = *(const f32x4*)(in[14] + ch);
#pragma unroll
            for (int ai = 0; ai < 2; ++ai)
#pragma unroll
                for (int m = 0; m < 4; ++m) { const size_t row = (size_t)(row0 + ai * 128 + m * 16);
                    const f32x4 xf = acc[ai][bj][m][0] + a0f, xb = acc[ai][bj][m][1] + a0b;
                    const f32x4 kp = *(const f32x4*)(KMf + row * RWW + ch), kk = *(const f32x4*)(KK + row * RWW + ch);
                    f32x4 kmf, kmb, bvf, bvb;
#pragma unroll
                    for (int e = 0; e < 4; ++e) { const float af = sigmoidf_(xf[e]), ab = sigmoidf_(xb[e]);
                        kmf[e] = kp[e] * (1.0f + (af - 1.0f) * ka[e]); kmb[e] = kp[e] * (1.0f + (ab - 1.0f) * ka[e]); bvf[e] = kk[e] * af; bvb[e] = kk[e] * ab; }
                    *(f32x4*)(KMf + row * RWW + ch) = kmf; *(f32x4*)(KMb + row * RWW + ch) = kmb; *(f32x4*)(BVf + row * RWW + ch) = bvf; *(f32x4*)(BVb + row * RWW + ch) = bvb;
                    v2u ks; ks.x = pk2(kmf[0] + kmb[0], kmf[1] + kmb[1]); ks.y = pk2(kmf[2] + kmb[2], kmf[3] + kmb[3]); *(v2u*)(KSUM + row * RWW + ch) = ks; } }
    }
    __device__ __forceinline__ void grp_g(const f32x4 (&acc)[2][2][4][2], int row0, int c0) const {
        bf16* RWG = (bf16*)(ws + WS_RWG);
#pragma unroll
        for (int bj = 0; bj < 2; ++bj) { const int ch = c0 + bj * 128 - 2048;
#pragma unroll
            for (int ai = 0; ai < 2; ++ai)
#pragma unroll
                for (int m = 0; m < 4; ++m) { const size_t row = (size_t)(row0 + ai * 128 + m * 16); const f32x4 v0 = acc[ai][bj][m][0], v1 = acc[ai][bj][m][1];
                    v4u w; w.x = pk2(v0[0], v0[1]); w.y = pk2(v0[2], v0[3]); w.z = pk2(v1[0], v1[1]); w.w = pk2(v1[2], v1[3]); *(v4u*)(RWG + row * RWW + ch) = w; } }
    }
    __device__ __forceinline__ void grp_l(const f32x4 (&acc)[2][2][4][2], int row0, int c0) const {
        float* GAf = (float*)(ws + WS_GAF); float* GAb = (float*)(ws + WS_GAB);
#pragma unroll
        for (int bj = 0; bj < 2; ++bj) { const int ch = (c0 + bj * 128 - 2560) >> 1; const f32x4 gbf = *(const f32x4*)(in[20] + ch), gbb = *(const f32x4*)(in[20] + 256 + ch);
#pragma unroll
            for (int ai = 0; ai < 2; ++ai)
#pragma unroll
                for (int m = 0; m < 4; ++m) { const size_t row = (size_t)(row0 + ai * 128 + m * 16);
                    const f32x4 xf = acc[ai][bj][m][0] + gbf, xb = acc[ai][bj][m][1] + gbb; f32x4 af, ab;
#pragma unroll
                    for (int e = 0; e < 4; ++e) { const float lf = fminf(xf[e], 0.f) - log1pf(__expf(-fabsf(xf[e]))), lb = fminf(xb[e], 0.f) - log1pf(__expf(-fabsf(xb[e])));
                        af[e] = __expf(lf * 0.0625f); ab[e] = __expf(lb * 0.0625f); }
                    *(f32x4*)(GAf + row * 256 + ch) = af; *(f32x4*)(GAb + row * 256 + ch) = ab; } }
    }
    __device__ __forceinline__ void operator()(const f32x4 (&acc)[2][2][4][2], const pg8::Unit& u, int wr, int wc, int fr, int fq) const {
        const int row0 = u.pm * 256 + wr * 64 + fr, c0 = u.pn * 256 + wc * 32 + 8 * fq;
        if (u.pn < 4) grp_w(acc, row0, c0); else if (u.pn < 8) grp_a(acc, row0, c0); else if (u.pn < 10) grp_g(acc, row0, c0); else grp_l(acc, row0, c0);
    }
};
__device__ __forceinline__ void ph_lora(Frame& F) {
    pg8::Gemm g{(const bf16*)(F.ws + WS_A2), (const bf16*)(F.ws + WS_WLORA), MR, NLORA, KLORA, nullptr};
    pg8::StaticOrder S; S.init(MR, NLORA, F.G, (int)blockIdx.x);
    EpiLora E{F.ws, F.in};
    pg8::gemm_phase<EpiLora, pg8::StaticOrder, true, true, false>(F.lds, g, S, E);
}

constexpr int ST = 32, RWB = 5 * ST * 256 + ST * 64, GLB = 3 * ST * 256 + ST * 64, SBUF = RWB + GLB, NSTEP = CTXL + SEQ, NBLK = NSTEP / ST;
static_assert(2 * SBUF <= MISC_OFF, "scan staging fits under the LDS control words");
__device__ __forceinline__ float red16(float x) {
    x += __builtin_bit_cast(float, __builtin_amdgcn_update_dpp(0, __builtin_bit_cast(int, x), 0x128, 0xf, 0xf, false));
    x += __builtin_bit_cast(float, __builtin_amdgcn_update_dpp(0, __builtin_bit_cast(int, x), 0x124, 0xf, 0xf, false));
    x += __builtin_bit_cast(float, __builtin_amdgcn_update_dpp(0, __builtin_bit_cast(int, x), 0x122, 0xf, 0xf, false));
    x += __builtin_bit_cast(float, __builtin_amdgcn_update_dpp(0, __builtin_bit_cast(int, x), 0x121, 0xf, 0xf, false));
    return x;
}
__device__ __forceinline__ int scan_row(int s, int b, int dir) {
    if (s < CTXL) return NLAT + b * CTXL + (dir ? (CTXL - 1 - s) : s);
    const int lt = s - CTXL; return b * SEQ + (dir ? (SEQ - 1 - lt) : lt);
}
__device__ __forceinline__ void scan_issue(LAS unsigned char* lds, int blk, int bo, int wave, int lane,
        const float* aR, const float* aW, const float* aK, const float* aA, const float* aB, const float* aV, const float* gQ, const float* gK, const float* gA, const float* gV,
        int rb, int rdir, int rh, int rbase, int gb, int gdir, int gh, int cbase) {
    for (int q = wave; q < 68; q += 8) {
        const float* src; int ldo;
        if (q < 40) { const int vs = q >> 3, j = q & 7; const int s = blk * ST + 4 * j + (lane >> 4); const int row = scan_row(s, rb, rdir);
            const float* arr = vs == 0 ? aR : (vs == 1 ? aW : (vs == 2 ? aK : (vs == 3 ? aA : aB)));
            src = arr + (size_t)row * RWW + rh * 64 + (lane & 15) * 4; ldo = bo + vs * 8192 + j * 1024; }
        else if (q < 42) { const int j = q - 40; const int s = blk * ST + 16 * j + (lane >> 2); const int row = scan_row(s, rb, rdir);
            src = aV + (size_t)row * RWW + rh * 64 + rbase + (lane & 3) * 4; ldo = bo + 5 * 8192 + j * 1024; }
        else if (q < 66) { const int qq = q - 42, vs = qq >> 3, j = qq & 7; const int s = blk * ST + 4 * j + (lane >> 4); const int row = scan_row(s, gb, gdir);
            const float* arr = vs == 0 ? gQ : (vs == 1 ? gK : gA);
            src = arr + (size_t)row * 256 + gh * 64 + (lane & 15) * 4; ldo = bo + RWB + vs * 8192 + j * 1024; }
        else { const int j = q - 66; const int s = blk * ST + 16 * j + (lane >> 2); const int row = scan_row(s, gb, gdir);
            src = gV + (size_t)row * RWW + gh * 128 + cbase + (lane & 3) * 4; ldo = bo + RWB + 3 * 8192 + j * 1024; }
        __builtin_amdgcn_global_load_lds((const unsigned*)src, (LAS unsigned*)(lds + ldo), 16, 0, 0);
    }
}
__device__ __forceinline__ void ph_scan(Frame& F) {
    const int wg = blockIdx.x, lane = F.lane, wave = F.wave;
    const int sr = wg >> 2, rb = sr >> 4, rdir = (sr >> 3) & 1, rh = sr & 7, rbase = 16 * (wg & 3);
    const int sg = wg >> 3, gb = sg >> 3, gdir = (sg >> 2) & 1, gh = sg & 3, cbase = 16 * (wg & 7);
    unsigned char* ws = F.ws;
    const float* aR = (const float*)(ws + WS_R); const float* aW = (const float*)(ws + (rdir ? WS_WB : WS_WF)); const float* aK = (const float*)(ws + (rdir ? WS_KMB : WS_KMF));
    const float* aA = (const float*)(ws + WS_KK); const float* aB = (const float*)(ws + (rdir ? WS_BVB : WS_BVF)); const float* aV = (const float*)(ws + WS_V);
    const float* gQ = (const float*)(ws + WS_QG); const float* gK = (const float*)(ws + WS_KGB); const float* gA = (const float*)(ws + (gdir ? WS_GAB : WS_GAF)); const float* gV = (const float*)(ws + WS_VGB);
    bf16* oRW = (bf16*)(ws + (rdir ? WS_ORWB : WS_ORWF)); bf16* oGL = (bf16*)(ws + (gdir ? WS_OGLB : WS_OGLF));
    LAS unsigned char* lds = F.lds;
#define issue(blk, bo) scan_issue(lds, blk, bo, wave, lane, aR, aW, aK, aA, aB, aV, gQ, gK, gA, gV, rb, rdir, rh, rbase, gb, gdir, gh, cbase)
    f32x4 S = (f32x4){0.f, 0.f, 0.f, 0.f};
    const int ks = lane & 15, rg = lane >> 4;
    issue(0, 0);
    VM_WAIT(); __syncthreads();
    for (int blk = 0; blk < NBLK; ++blk) {
        const int bo = (blk & 1) * SBUF;
        if (blk + 1 < NBLK) issue(blk + 1, SBUF - bo);
        const bool emit = blk >= CTXL / ST;
        if (wave < 4) {
            const LAS f32x4* pv = (const LAS f32x4*)(lds + bo) + ks;
            const LAS float* pvv = (const LAS float*)(lds + bo + 5 * 8192) + 4 * wave + rg;
            bf16* orow = oRW + rh * 64 + rbase + 4 * wave + rg;
#pragma unroll 4
            for (int t = 0; t < ST; ++t) {
                const f32x4 r4 = pv[t * 16], w4 = pv[512 + t * 16], k4 = pv[1024 + t * 16], a4 = pv[1536 + t * 16], b4 = pv[2048 + t * 16];
                const float v = pvv[t * 16];
                float sa = -red16((S.x * a4.x + S.y * a4.y) + (S.z * a4.z + S.w * a4.w));
                S = S * w4 + b4 * sa + k4 * v;
                const float y = red16((S.x * r4.x + S.y * r4.y) + (S.z * r4.z + S.w * r4.w));
                if (emit && ks == 0) { const int row = scan_row(blk * ST + t, rb, rdir); orow[(size_t)row * RWW] = (bf16)f2bf(y); }
            }
        } else {
            const LAS f32x4* pv = (const LAS f32x4*)(lds + bo + RWB) + ks;
            const LAS float* pvv = (const LAS float*)(lds + bo + RWB + 3 * 8192) + 4 * (wave - 4) + rg;
            bf16* orow = oGL + gh * 128 + cbase + 4 * (wave - 4) + rg;
#pragma unroll 4
            for (int t = 0; t < ST; ++t) {
                const f32x4 q4 = pv[t * 16], k4 = pv[512 + t * 16], al = pv[1024 + t * 16];
                const float v = pvv[t * 16];
                S = S * al + k4 * v;
                const float y = red16((S.x * q4.x + S.y * q4.y) + (S.z * q4.z + S.w * q4.w));
                if (emit && ks == 0) { const int row = scan_row(blk * ST + t, gb, gdir); orow[(size_t)row * RWW] = (bf16)f2bf(y); }
            }
        }
        VM_WAIT(); __syncthreads();
    }
#undef issue
}

__device__ __forceinline__ void ph_merge(Frame& F) {
    unsigned char* ws = F.ws; const int lane = F.lane;
    const bf16* ORf = (const bf16*)(ws + WS_ORWF); const bf16* ORb = (const bf16*)(ws + WS_ORWB); const bf16* OGf = (const bf16*)(ws + WS_OGLF); const bf16* OGb = (const bf16*)(ws + WS_OGLB);
    const float* R = (const float*)(ws + WS_R); const float* V = (const float*)(ws + WS_V); const bf16* KSUM = (const bf16*)(ws + WS_KSUM); const bf16* RWG = (const bf16*)(ws + WS_RWG);
    const bf16* P = (const bf16*)(ws + WS_P);
    bf16* YRW = (bf16*)(ws + WS_YRW); bf16* YGLA = (bf16*)(ws + WS_YGLA);
    float rk[8], gw[8], gbv[8], ggw[8], ggb[8];
    ld8(F.in[15] + 8 * lane, rk); ld8(F.in[16] + 8 * lane, gw); ld8(F.in[17] + 8 * lane, gbv); ld8(F.in[21] + 8 * lane, ggw); ld8(F.in[22] + 8 * lane, ggb);
    for (int m = F.gw; m < NLAT; m += F.NGW) {
        const size_t ro = (size_t)m * RWW + 8 * lane;
        {
            float a[8], b[8], o[8]; unp8(*(const v4u*)(ORf + ro), a); unp8(*(const v4u*)(ORb + ro), b);
            float s = 0.f;
#pragma unroll
            for (int e = 0; e < 8; ++e) { o[e] = a[e] + b[e]; s += o[e]; }
            s += __shfl_xor(s, 1); s += __shfl_xor(s, 2); s += __shfl_xor(s, 4);
            const float mean = s * (1.f / 64.f); float q = 0.f;
#pragma unroll
            for (int e = 0; e < 8; ++e) { o[e] -= mean; q += o[e] * o[e]; }
            q += __shfl_xor(q, 1); q += __shfl_xor(q, 2); q += __shfl_xor(q, 4);
            const float rstd = 1.f / sqrtf(q * (1.f / 64.f) + RW_GN_EPS);
            float r[8], v[8], ksm[8], g[8]; ld8(R + ro, r); ld8(V + ro, v); unp8(*(const v4u*)(KSUM + ro), ksm); unp8(*(const v4u*)(RWG + ro), g);
            float bs = 0.f;
#pragma unroll
            for (int e = 0; e < 8; ++e) bs += r[e] * ksm[e] * rk[e];
            bs += __shfl_xor(bs, 1); bs += __shfl_xor(bs, 2); bs += __shfl_xor(bs, 4);
            float y[8];
#pragma unroll
            for (int e = 0; e < 8; ++e) y[e] = (o[e] * rstd * gw[e] + gbv[e] + bs * v[e]) * g[e];
            *(v4u*)(YRW + ro) = pk8(y);
        }
        {
            float a[8], b[8], o[8]; unp8(*(const v4u*)(OGf + ro), a); unp8(*(const v4u*)(OGb + ro), b);
            float s = 0.f;
#pragma unroll
            for (int e = 0; e < 8; ++e) { o[e] = a[e] + b[e]; s += o[e]; }
            s += __shfl_xor(s, 1); s += __shfl_xor(s, 2); s += __shfl_xor(s, 4); s += __shfl_xor(s, 8);
            const float mean = s * (1.f / 128.f); float q = 0.f;
#pragma unroll
            for (int e = 0; e < 8; ++e) { o[e] -= mean; q += o[e] * o[e]; }
            q += __shfl_xor(q, 1); q += __shfl_xor(q, 2); q += __shfl_xor(q, 4); q += __shfl_xor(q, 8);
            const float rstd = 1.f / sqrtf(q * (1.f / 128.f) + LN_EPS);
            float og[8]; unp8(*(const v4u*)(P + (size_t)m * NP + C_OG + 8 * lane), og);
            float y[8];
#pragma unroll
            for (int e = 0; e < 8; ++e) y[e] = (o[e] * rstd * ggw[e] + ggb[e]) * siluf_(og[e]);
            *(v4u*)(YGLA + ro) = pk8(y);
        }
    }
}

template <int WHICH> struct EpiBranch {
    static constexpr bool PERM = true;
    bf16* Z; const bf16* P;
    __device__ __forceinline__ void operator()(const f32x4 (&acc)[2][2][4][2], const pg8::Unit& u, int wr, int wc, int fr, int fq) const {
        const int row0 = u.pm * 256 + wr * 64 + fr, col0 = u.pn * 256 + wc * 32 + 8 * fq;
#pragma unroll
        for (int ai = 0; ai < 2; ++ai)
#pragma unroll
            for (int m = 0; m < 4; ++m) { const size_t row = (size_t)(row0 + ai * 128 + m * 16);
#pragma unroll
                for (int bj = 0; bj < 2; ++bj) { const int c = col0 + bj * 128;
                    float g[8]; unp8(*(const v4u*)(P + row * NP + (WHICH ? C_GGLA : C_GRW) + c), g);
                    const f32x4 v0 = acc[ai][bj][m][0], v1 = acc[ai][bj][m][1];
                    float z[8];
#pragma unroll
                    for (int e = 0; e < 4; ++e) { z[e] = sigmoidf_(g[e]) * v0[e]; z[4 + e] = sigmoidf_(g[4 + e]) * v1[e]; }
                    if (WHICH) { float zo[8]; unp8(*(const v4u*)(Z + row * D + c), zo);
#pragma unroll
                        for (int e = 0; e < 8; ++e) z[e] += zo[e]; }
                    *(v4u*)(Z + row * D + c) = pk8(z); } }
    }
};
__device__ __forceinline__ void ph_branch(Frame& F) {
    pg8::StaticOrder S; S.init(NLAT, D, F.G, (int)blockIdx.x);
    { pg8::Gemm g{(const bf16*)(F.ws + WS_YRW), (const bf16*)(F.ws + WS_WBRRW), NLAT, D, RWW, nullptr};
      EpiBranch<0> E{(bf16*)(F.ws + WS_Z), (const bf16*)(F.ws + WS_P)};
      pg8::gemm_phase<EpiBranch<0>, pg8::StaticOrder, true, true, false>(F.lds, g, S, E); }
    { pg8::Gemm g{(const bf16*)(F.ws + WS_YGLA), (const bf16*)(F.ws + WS_WBRGLA), NLAT, D, RWW, nullptr};
      EpiBranch<1> E{(bf16*)(F.ws + WS_Z), (const bf16*)(F.ws + WS_P)};
      pg8::gemm_phase<EpiBranch<1>, pg8::StaticOrder, true, true, false>(F.lds, g, S, E); }
}
struct EpiOut {
    static constexpr bool PERM = false;
    float* out; const float* x; const float* mod;
    __device__ __forceinline__ void operator()(const f32x4 (&acc)[2][2][4][2], const pg8::Unit& u, int wr, int wc, int fr, int fq) const {
        const int row0 = u.pm * 256 + wr * 64 + fr, col0 = u.pn * 256 + wc * 32 + 4 * fq; const float* g1 = mod + (u.pm / (SEQ / 256)) * 6144 + 2048;
#pragma unroll
        for (int ai = 0; ai < 2; ++ai)
#pragma unroll
            for (int m = 0; m < 4; ++m) { const size_t ro = (size_t)(row0 + ai * 128 + m * 16) * D;
#pragma unroll
                for (int bj = 0; bj < 2; ++bj)
#pragma unroll
                    for (int n = 0; n < 2; ++n) { const int c = col0 + bj * 128 + n * 16;
                        *(f32x4*)(out + ro + c) = *(const f32x4*)(x + ro + c) * ALPHA + *(const f32x4*)(g1 + c) * acc[ai][bj][m][n]; } }
    }
};
__device__ __forceinline__ void ph_outproj(Frame& F) {
    pg8::Gemm g{(const bf16*)(F.ws + WS_Z), (const bf16*)(F.ws + WS_WOUT), NLAT, D, D, nullptr};
    pg8::StaticOrder S; S.init(NLAT, D, F.G, (int)blockIdx.x);
    EpiOut E{F.out, F.in[0], (const float*)(F.ws + WS_MOD)};
    pg8::gemm_phase<EpiOut, pg8::StaticOrder, true, true, false>(F.lds, g, S, E);
}
#endif

#ifndef ML
#define ML 0
#endif
enum Phase { PH_PROLOGUE = 0, PH_A1, PH_INPROJ, PH_FEAT, PH_LORA, PH_SCAN, PH_MERGE, PH_BRANCH, PH_OUTPROJ, PH_LN1, PH_ROUTER, PH_ROUTE, PH_SCATTER, PH_EXP1, PH_EXP2, PH_FINAL, PH_COUNT };

__global__ void __launch_bounds__(NTHR, 2) mega(Args args) {
    extern __shared__ __attribute__((aligned(16))) unsigned char lds_raw[];
    Frame F;
    F.lds = (LAS unsigned char*)lds_raw;
    F.tid = threadIdx.x; F.lane = F.tid & 63; F.wave = __builtin_amdgcn_readfirstlane(F.tid >> 6);
    F.G = gridDim.x; F.gw = blockIdx.x * NWAVES + F.wave; F.NGW = F.G * NWAVES;
    F.in = args.in; F.out = args.out; F.ws = args.ws; F.ctl = (unsigned*)(args.ws + WS_CTL);
    volatile LAS unsigned* MISC = (volatile LAS unsigned*)(F.lds + MISC_OFF);
    if (F.tid < 64) MISC[F.tid] = 0u;
    __syncthreads();
    XcdBarrier bar; bar.bar = F.ctl + CW_BAR; bar.x = 0; bar.st = nullptr;
#if !ML
    bar = xcd_barrier_post(F.ctl + CW_BAR, MISC + 8);
#endif
    const int lo = args.ph_lo, hi = args.ph_hi;
#define IN(k) (lo <= (k) && (k) < hi)
#if ML
#define GRID_BAR() do { } while (0)
#else
#define GRID_BAR() xcd_barrier(bar)
#endif

#if MS >= 2
    if (IN(PH_PROLOGUE)) { ph_prologue(F); GRID_BAR(); }
#endif
#if MS >= 3
    if (IN(PH_A1)) { ph_a1(F); GRID_BAR(); }
    if (IN(PH_INPROJ)) { ph_inproj(F); GRID_BAR(); }
    if (IN(PH_FEAT)) { ph_feat(F); GRID_BAR(); }
    if (IN(PH_LORA)) { ph_lora(F); GRID_BAR(); }
    if (IN(PH_SCAN)) { ph_scan(F); GRID_BAR(); }
    if (IN(PH_MERGE)) { ph_merge(F); GRID_BAR(); }
    if (IN(PH_BRANCH)) { ph_branch(F); GRID_BAR(); }
    if (IN(PH_OUTPROJ)) { ph_outproj(F); GRID_BAR(); }
#else
    if (IN(PH_OUTPROJ)) { ph_x1pre_nomix(F); GRID_BAR(); }
#endif
    if (IN(PH_LN1)) { ph_ln1(F); GRID_BAR(); }
#if MS >= 2
    if (IN(PH_ROUTER)) { ph_router(F); GRID_BAR(); }
    if (IN(PH_ROUTE)) { ph_route(F); GRID_BAR(); }
    if (IN(PH_SCATTER)) { ph_scatter(F); GRID_BAR(); }
    if (IN(PH_EXP1)) { ph_exp1(F); GRID_BAR(); }
    if (IN(PH_EXP2)) { ph_exp2(F); GRID_BAR(); }
#endif
    if (IN(PH_FINAL)) { ph_final(F); }
#undef IN
}

extern "C" void kernel_launch(void* const* d_in, const int* in_sizes, int n_in, void* d_out, int out_size, void* d_ws, size_t ws_size, hipStream_t stream) {
    static int grid = 0;
    if (grid == 0) {
        if (n_in != 36 || out_size != NLAT * D || ws_size < WS_END) { fprintf(stderr, "kernel_launch: unexpected problem shape (n_in %d, out %d)\n", n_in, out_size); grid = -1; return; }
        int dev = 0, cus = 0, per_cu = 0;
        if (hipGetDevice(&dev) != hipSuccess || hipDeviceGetAttribute(&cus, hipDeviceAttributeMultiprocessorCount, dev) != hipSuccess) { grid = -1; return; }
        if (hipFuncSetAttribute((const void*)mega, hipFuncAttributeMaxDynamicSharedMemorySize, LDS_BYTES) != hipSuccess) { fprintf(stderr, "kernel_launch: hipFuncSetAttribute failed\n"); grid = -1; return; }
        if (hipOccupancyMaxActiveBlocksPerMultiprocessor(&per_cu, (const void*)mega, NTHR, LDS_BYTES) != hipSuccess || per_cu < 1) { fprintf(stderr, "kernel_launch: occupancy query says %d\n", per_cu); }
        (void)hipGetLastError();
        grid = cus > 0 ? cus : 256;
        if (grid > 256) grid = 256;
    }
    if (grid < 0) return;
    (void)hipMemsetAsync((char*)d_ws + WS_CTL, 0, CTL_ZERO_BYTES, stream);
    Args a{};
    for (int i = 0; i < 36; ++i) a.in[i] = (const float*)d_in[i];
    a.out = (float*)d_out; a.ws = (unsigned char*)d_ws;
#if ML
    for (int p = 0; p < PH_COUNT; ++p) { a.ph_lo = p; a.ph_hi = p + 1; hipLaunchKernelGGL(mega, dim3(grid), dim3(NTHR), LDS_BYTES, stream, a); }
#else
    a.ph_lo = 0; a.ph_hi = PH_COUNT;
    hipLaunchKernelGGL(mega, dim3(grid), dim3(NTHR), LDS_BYTES, stream, a);
#endif
}
```

```cpp
#include <hip/hip_runtime.h>
#include <cstdio>
#include <cstdint>

#ifndef MS
#define MS 3
#endif

#define GAS __attribute__((address_space(1)))
#define LAS __attribute__((address_space(3)))
typedef unsigned short bf16;
typedef unsigned v4u __attribute__((ext_vector_type(4)));
typedef unsigned v2u __attribute__((ext_vector_type(2)));
typedef float f32x4 __attribute__((ext_vector_type(4)));
typedef float f32x2 __attribute__((ext_vector_type(2)));
typedef short bf16x8 __attribute__((ext_vector_type(8)));
#define LDS_WAIT() asm volatile("s_waitcnt lgkmcnt(0)" ::: "memory")
#define VM_WAIT() asm volatile("s_waitcnt vmcnt(0)" ::: "memory")

constexpr int D = 1024, NB = 4, SEQ = 8192, CTXL = 256, GRIDW = 64, GRIDH = 128;
constexpr int NLAT = NB * SEQ, NCTX = NB * CTXL, MR = NLAT + NCTX;
constexpr int RWW = 512, RWH = 8, HD = 64;
constexpr int C_R = 0, C_K = 512, C_V = 1024, C_PW = 1536, C_PA = 1568, C_PG = 1600, C_Q = 1696, C_KG = 1952, C_VG = 2208, C_PGL = 2720, C_OG = 2736, C_GRW = 3248, C_GGLA = 4272;
constexpr int IN_COLS = 5296, NP = 5376;
constexpr int NE = 256, TOPK = 8, FF = 256;
constexpr float LN_EPS = 1e-5f, RW_GN_EPS = 64e-5f;
constexpr float ALPHA = 1.189207115f;
constexpr int NLORA = 3072, KLORA = 256;
constexpr int MAXTILES = 1280, SH_ROW0 = MAXTILES * 256, NROWS_E = SH_ROW0 + NLAT;

namespace pg8 {
#define PG8_LAS __attribute__((address_space(3)))
typedef unsigned short bf16_t;
typedef unsigned u32x4 __attribute__((ext_vector_type(4)));
typedef unsigned u32x2 __attribute__((ext_vector_type(2)));
constexpr int BM = 256, BK = 64, HALF = 128, HTB = HALF * BK * 2, STAGE_BYTES = 8 * HTB, NXCD = 8, WGM = 8;
constexpr int IDX_OFF = STAGE_BYTES, IDX_UNITS = 12;

__host__ __device__ __forceinline__ int lds_byte(int r, int c) { const int st = (r >> 4) * 2 + (c >> 5), rr = r & 15, cc = c & 31, ob = rr * 64 + cc * 2; return st * 1024 + (ob ^ (((ob >> 9) & 1) << 5)); }
__host__ __device__ __forceinline__ void stage_rc(int b, int& R, int& C) { const int st = b / 1024, sb = b % 1024, swz = sb ^ (((sb >> 9) & 1) << 5); R = (st >> 1) * 16 + swz / 64; C = (st & 1) * 32 + (swz % 64) / 2; }
__host__ __device__ __forceinline__ int perm32(int rho) { const int n = rho >> 4, i = rho & 15; return 8 * (i >> 2) + 4 * n + (i & 3); }

struct Unit { int pm, pn, e, j; };
struct Gemm { const bf16_t* A; const bf16_t* Bt; int M, N, K; const int* rowidx; };

struct StaticOrder {
    int nM, nN, nwg, G, c;
    __host__ __device__ void init(int M, int N, int G_, int c_) { nM = M / BM; nN = N / BM; nwg = nM * nN; G = G_; c = c_; }
    __host__ __device__ bool next(int i, Unit& u) const {
        const long L = (long)i * G + c; if (L >= nwg) return false;
        int wgid = (int)L; { const int q = nwg / NXCD, r = nwg % NXCD, xcd = wgid % NXCD, off = wgid / NXCD; wgid = (xcd < r ? xcd * (q + 1) : r * (q + 1) + (xcd - r) * q) + off; }
        const int nig = WGM * nN, gid = wgid / nig, fm = gid * WGM, gsz = (nM - fm) < WGM ? (nM - fm) : WGM;
        u.pm = fm + ((wgid % nig) % gsz); u.pn = (wgid % nig) / gsz; u.e = 0; u.j = u.pn; return true;
    }
};
struct MoeOrder {
    int nN, G, c, NT; const int* tile_e;
    __device__ bool next(int i, Unit& u) const {
        const int L = i * G + c; const int total = (NT + NLAT / 256) * nN; if (L >= total) return false;
        const int tile = L / nN, j = L - tile * nN; int e, pm;
        if (tile < NT) { e = tile_e[tile]; pm = tile; } else { e = NE; pm = MAXTILES + (tile - NT); }
        u.pm = pm; u.pn = e * nN + j; u.e = e; u.j = j; return true;
    }
};

__device__ __forceinline__ unsigned cvt_pk_bf16(float lo, float hi) { unsigned r; asm volatile("v_cvt_pk_bf16_f32 %0, %1, %2" : "=v"(r) : "v"(lo), "v"(hi)); return r; }

template <class Epi, class Sched, bool ALIGN_EPI, bool SP2, bool GATHER>
__device__ __forceinline__ void gemm_phase(PG8_LAS unsigned char* lds, const Gemm g, const Sched& S, const Epi& E) {
    const int tid = threadIdx.x, wid = __builtin_amdgcn_readfirstlane(tid >> 6), lane = tid & 63, wr = wid >> 2, wc = wid & 3, fr = lane & 15, fq = lane >> 4;
    const int K = g.K, nt = K / BK;
    const size_t kstep = (size_t)(BK * 2);
    const size_t hstep = (size_t)HALF * K * 2;
    const size_t tstep = 2 * hstep;
    unsigned voffB[2]; unsigned va[2][2];
#pragma unroll
    for (int i = 0; i < 2; ++i) { int R, C; stage_rc(tid * 16 + i * 8192, R, C); const int Rb = Epi::PERM ? ((R & ~31) + perm32(R & 31)) : R;
        voffB[i] = (unsigned)(Rb * K + C) * 2u;
        va[0][i] = (unsigned)(R * K + C) * 2u; va[1][i] = va[0][i]; }
    const size_t ah = GATHER ? (size_t)0 : hstep;
#define PG8_GOFF(dst, ub) do { _Pragma("unroll") for (int _h = 0; _h < 2; ++_h) _Pragma("unroll") for (int _i = 0; _i < 2; ++_i) { int _R, _C; stage_rc(tid * 16 + _i * 8192, _R, _C); \
        dst[_h][_i] = (unsigned)(idxt[(ub) * 256 + _h * 128 + _R] * K + _C) * 2u; } } while (0)
    const unsigned ldsw = (unsigned)wid * 1024u;
    const int aoff = lds_byte(wr * 64 + fr, fq * 8), boff = lds_byte(wc * 32 + fr, fq * 8);
    PG8_LAS int* idxt = (PG8_LAS int*)(lds + IDX_OFF);
#define PG8_SA(b, h) (((b) * 2 + (h)) * HTB)
#define PG8_SB(b, h) ((4 + (b) * 2 + (h)) * HTB)
#define PG8_STAGE(bufoff, gbase, voff) do { _Pragma("unroll") for (int _i = 0; _i < 2; ++_i) \
        __builtin_amdgcn_global_load_lds((const unsigned*)((const char*)(gbase) + (voff)[_i]), (PG8_LAS unsigned*)(lds + (bufoff) + ldsw + _i * 8192), 16, 0, 0); } while (0)
#define PG8_LDA(dst, b, h) do { _Pragma("unroll") for (int m = 0; m < 4; ++m) _Pragma("unroll") for (int k = 0; k < 2; ++k) dst[m][k] = *(const PG8_LAS bf16x8*)(lds + PG8_SA(b, h) + aoff + m * 2048 + k * 1024); } while (0)
#define PG8_LDB(dst, b, h) do { _Pragma("unroll") for (int n = 0; n < 2; ++n) _Pragma("unroll") for (int k = 0; k < 2; ++k) dst[n][k] = *(const PG8_LAS bf16x8*)(lds + PG8_SB(b, h) + boff + n * 2048 + k * 1024); } while (0)
#define PG8_MMA(ai, bj, At, Bt) do { __builtin_amdgcn_s_setprio(1); _Pragma("unroll") for (int m = 0; m < 4; ++m) _Pragma("unroll") for (int n = 0; n < 2; ++n) _Pragma("unroll") for (int k = 0; k < 2; ++k) \
        acc[ai][bj][m][n] = __builtin_amdgcn_mfma_f32_16x16x32_bf16(Bt[n][k], At[m][k], acc[ai][bj][m][n], 0, 0, 0); __builtin_amdgcn_s_setprio(0); } while (0)
#define PG8_WAIT_V(n) asm volatile("s_waitcnt vmcnt(" #n ")" ::: "memory")
#define PG8_WAIT_L(n) asm volatile("s_waitcnt lgkmcnt(" #n ")" ::: "memory")
#define PG8_BAR __builtin_amdgcn_s_barrier()
#define PG8_SCHED __builtin_amdgcn_sched_barrier(0)
    Unit cur, nxt; int ui = 0;
    if (!S.next(0, cur)) return;
    if constexpr (GATHER) {
        Unit uu;
        for (int i = 0; i < IDX_UNITS; ++i) { if (!S.next(i, uu)) break; if (tid < 256) idxt[i * 256 + tid] = g.rowidx[(size_t)uu.pm * 256 + tid]; }
        asm volatile("s_waitcnt vmcnt(0) lgkmcnt(0)" ::: "memory"); PG8_BAR; asm volatile("" ::: "memory");
        PG8_GOFF(va, 0);
    }
    f32x4 acc[2][2][4][2];
#pragma unroll
    for (int a = 0; a < 2; ++a)
#pragma unroll
        for (int b = 0; b < 2; ++b)
#pragma unroll
            for (int m = 0; m < 4; ++m)
#pragma unroll
                for (int n = 0; n < 2; ++n) acc[a][b][m][n] = (f32x4){0.f, 0.f, 0.f, 0.f};
    bf16x8 At[4][2], B0[2][2], B1[2][2];
    const char* cA = (const char*)g.A + (GATHER ? (size_t)0 : (size_t)cur.pm * tstep); const char* cB = (const char*)g.Bt + (size_t)cur.pn * tstep;
    if constexpr (SP2) {
        PG8_STAGE(PG8_SB(0, 0), cB, voffB); PG8_STAGE(PG8_SB(0, 1), cB + hstep, voffB); PG8_STAGE(PG8_SA(0, 0), cA, va[0]); PG8_STAGE(PG8_SA(0, 1), cA + ah, va[1]);
        if (wr == 1) PG8_BAR;
        PG8_WAIT_V(2); PG8_BAR;
        PG8_STAGE(PG8_SB(1, 0), cB + kstep, voffB); PG8_STAGE(PG8_SA(1, 0), cA + kstep, va[0]); PG8_STAGE(PG8_SB(1, 1), cB + hstep + kstep, voffB);
        PG8_WAIT_V(6); PG8_BAR;
    } else {
        PG8_STAGE(PG8_SB(0, 0), cB, voffB); PG8_STAGE(PG8_SA(0, 0), cA, va[0]); PG8_STAGE(PG8_SB(0, 1), cB + hstep, voffB); PG8_STAGE(PG8_SA(0, 1), cA + ah, va[1]);
        if (wr == 1) PG8_BAR;
        PG8_WAIT_V(4); PG8_BAR;
        PG8_STAGE(PG8_SB(1, 0), cB + kstep, voffB); PG8_STAGE(PG8_SA(1, 0), cA + kstep, va[0]); PG8_STAGE(PG8_SB(1, 1), cB + hstep + kstep, voffB);
        PG8_WAIT_V(6); PG8_BAR;
    }
    for (;;) {
        const bool has_next = S.next(ui + 1, nxt);
        const char* nA = has_next ? (const char*)g.A + (GATHER ? (size_t)0 : (size_t)nxt.pm * tstep) : cA; const char* nB = has_next ? (const char*)g.Bt + (size_t)nxt.pn * tstep : cB;
        const int ubn = (has_next && ui + 1 < IDX_UNITS) ? (ui + 1) : ui;
#pragma unroll 1
        for (int t = 0; t < nt; t += 2) {
            const bool last = (t == nt - 2);
            const char* a1 = cA + (size_t)(t + 1) * kstep;
            const char* a2 = last ? nA : cA + (size_t)(t + 2) * kstep; const char* b2 = last ? nB : cB + (size_t)(t + 2) * kstep;
            const char* a3 = a2 + kstep; const char* b3 = b2 + kstep;
            unsigned v2[2][2];
#pragma unroll
            for (int h = 0; h < 2; ++h)
#pragma unroll
                for (int i = 0; i < 2; ++i) v2[h][i] = va[h][i];
            if constexpr (GATHER) { if (last) PG8_GOFF(v2, ubn); }
            if constexpr (SP2) {
            PG8_LDB(B0, 0, 0); PG8_LDB(B1, 0, 1); PG8_SCHED; PG8_LDA(At, 0, 0); PG8_STAGE(PG8_SA(1, 1), a1 + ah, va[1]);
            PG8_WAIT_V(8); PG8_WAIT_L(0); PG8_BAR; PG8_MMA(0, 0, At, B0); PG8_MMA(0, 1, At, B1); PG8_BAR; PG8_SCHED;
            PG8_LDA(At, 0, 1); PG8_STAGE(PG8_SB(0, 0), b2, voffB); PG8_STAGE(PG8_SB(0, 1), b2 + hstep, voffB); PG8_STAGE(PG8_SA(0, 0), a2, v2[0]);
            PG8_WAIT_V(8); PG8_WAIT_L(0); PG8_BAR; PG8_MMA(1, 0, At, B0); PG8_MMA(1, 1, At, B1); PG8_BAR; PG8_SCHED;
            PG8_LDB(B0, 1, 0); PG8_LDB(B1, 1, 1); PG8_SCHED; PG8_LDA(At, 1, 0); PG8_STAGE(PG8_SA(0, 1), a2 + ah, v2[1]);
            PG8_WAIT_V(8); PG8_WAIT_L(0); PG8_BAR; PG8_MMA(0, 0, At, B0); PG8_MMA(0, 1, At, B1); PG8_BAR; PG8_SCHED;
            PG8_LDA(At, 1, 1); PG8_STAGE(PG8_SB(1, 0), b3, voffB); PG8_STAGE(PG8_SB(1, 1), b3 + hstep, voffB); PG8_STAGE(PG8_SA(1, 0), a3, v2[0]);
            PG8_WAIT_V(8); PG8_WAIT_L(0); PG8_BAR; PG8_MMA(1, 0, At, B0); PG8_MMA(1, 1, At, B1); PG8_BAR; PG8_SCHED;
            } else {
            PG8_LDB(B0, 0, 0); PG8_SCHED; PG8_LDA(At, 0, 0); PG8_STAGE(PG8_SA(1, 1), a1 + ah, va[1]);
            PG8_WAIT_L(8); PG8_BAR; PG8_WAIT_L(0); PG8_MMA(0, 0, At, B0); PG8_BAR; PG8_SCHED;
            PG8_LDB(B1, 0, 1); PG8_STAGE(PG8_SB(0, 0), b2, voffB);
            PG8_BAR; PG8_WAIT_L(0); PG8_MMA(0, 1, At, B1); PG8_BAR;
            PG8_LDA(At, 0, 1); PG8_STAGE(PG8_SA(0, 0), a2, v2[0]);
            PG8_BAR; PG8_WAIT_L(0); PG8_MMA(1, 0, At, B0); PG8_BAR; PG8_SCHED;
            PG8_STAGE(PG8_SB(0, 1), b2 + hstep, voffB);
            PG8_WAIT_V(6); PG8_BAR; PG8_MMA(1, 1, At, B1); PG8_BAR;
            PG8_LDB(B0, 1, 0); PG8_SCHED; PG8_LDA(At, 1, 0); PG8_STAGE(PG8_SA(0, 1), a2 + ah, v2[1]);
            PG8_WAIT_L(8); PG8_BAR; PG8_WAIT_L(0); PG8_MMA(0, 0, At, B0); PG8_BAR; PG8_SCHED;
            PG8_LDB(B1, 1, 1); PG8_STAGE(PG8_SB(1, 0), b3, voffB);
            PG8_BAR; PG8_WAIT_L(0); PG8_MMA(0, 1, At, B1); PG8_BAR;
            PG8_LDA(At, 1, 1); PG8_STAGE(PG8_SA(1, 0), a3, v2[0]);
            PG8_BAR; PG8_WAIT_L(0); PG8_MMA(1, 0, At, B0); PG8_BAR; PG8_SCHED;
            PG8_STAGE(PG8_SB(1, 1), b3 + hstep, voffB);
            PG8_WAIT_V(6); PG8_BAR; PG8_MMA(1, 1, At, B1); PG8_BAR;
            }
        }
        if constexpr (ALIGN_EPI) { if (wr == 0) PG8_BAR; }
        E(acc, cur, wr, wc, fr, fq);
        if (!has_next) break;
#pragma unroll
        for (int a = 0; a < 2; ++a)
#pragma unroll
            for (int b = 0; b < 2; ++b)
#pragma unroll
                for (int m = 0; m < 4; ++m)
#pragma unroll
                    for (int n = 0; n < 2; ++n) acc[a][b][m][n] = (f32x4){0.f, 0.f, 0.f, 0.f};
        cur = nxt; cA = nA; cB = nB; ++ui;
        if constexpr (GATHER) PG8_GOFF(va, ubn);
        if constexpr (ALIGN_EPI) { if (wr == 1) PG8_BAR; }
    }
    PG8_WAIT_V(0);
    if constexpr (!ALIGN_EPI) { if (wr == 0) PG8_BAR; }
    PG8_BAR;
#undef PG8_SA
#undef PG8_GOFF
#undef PG8_SB
#undef PG8_STAGE
#undef PG8_LDA
#undef PG8_LDB
#undef PG8_MMA
#undef PG8_WAIT_V
#undef PG8_WAIT_L
#undef PG8_BAR
#undef PG8_SCHED
}
}

#define XB_TMO      128
#define XB_XCNT(j)  (256  + 64 * (j))
#define XB_XSUB(j)  (1280 + 64 * (j))
#define XB_XGEN(j)  (2304 + 64 * (j))
#define XB_TOP      3328
#define XB_TOPGEN   3392
#define XCD_BAR_WORDS 3456
#define XB_SPIN_CAP (1u << 18)
__device__ __forceinline__ unsigned xb_ld(unsigned* p)              { return __hip_atomic_load(p, __ATOMIC_RELAXED, __HIP_MEMORY_SCOPE_AGENT); }
__device__ __forceinline__ unsigned xb_add(unsigned* p, unsigned v) { return __hip_atomic_fetch_add(p, v, __ATOMIC_RELAXED, __HIP_MEMORY_SCOPE_AGENT); }
__device__ __forceinline__ unsigned xb_xcc_id() { return (unsigned)__builtin_amdgcn_s_getreg((3 << 11) | 20) & 0xFu; }
#define XB_SPIN(cond, bar) do { unsigned _sp = 0; while (cond) { __builtin_amdgcn_s_sleep(1); \
    if ((++_sp & 255u) == 0u) { if (xb_ld(&(bar)[XB_TMO])) break; if (_sp > XB_SPIN_CAP) { atomicAdd(&(bar)[XB_TMO], 1u); break; } } } } while (0)
struct XcdBarrier { unsigned* bar; unsigned x; volatile LAS unsigned* st; };
__device__ __forceinline__ XcdBarrier xcd_barrier_post(unsigned* bar, volatile LAS unsigned* st) {
    XcdBarrier b; b.bar = bar; b.x = xb_xcc_id(); b.st = st;
    if (threadIdx.x == 0) (void)xb_add(&bar[XB_XCNT(b.x)], 1u);
    return b;
}
__device__ __forceinline__ void xcd_barrier_complete(unsigned* bar, unsigned x, unsigned& nloc, unsigned& nx) {
    const unsigned G = gridDim.x * gridDim.y * gridDim.z;
    unsigned sum, cnt, mine, sp = 0u;
    for (;;) {
        sum = 0u; cnt = 0u; mine = 0u;
#pragma unroll
        for (unsigned j = 0; j < 16; ++j) { const unsigned c = xb_ld(&bar[XB_XCNT(j)]); sum += c; cnt += (c > 0u) ? 1u : 0u; mine = (j == x) ? c : mine; }
        if (sum == G) break;
        __builtin_amdgcn_s_sleep(1);
        if ((++sp & 255u) == 0u) { if (xb_ld(&bar[XB_TMO])) break; if (sp > XB_SPIN_CAP) { atomicAdd(&bar[XB_TMO], 1u); break; } }
    }
    nloc = mine > 0u ? mine : 1u; nx = cnt > 0u ? cnt : 1u;
}
__device__ __forceinline__ void xcd_barrier(const XcdBarrier& b) {
    asm volatile("s_waitcnt vmcnt(0)" ::: "memory");
    __syncthreads();
    if (threadIdx.x == 0) {
        unsigned* bar = b.bar;
        __builtin_amdgcn_s_waitcnt(0);
        unsigned nloc = b.st[0], nx = b.st[1];
        if (nloc == 0u) { xcd_barrier_complete(bar, b.x, nloc, nx); b.st[0] = nloc; b.st[1] = nx; }
        const unsigned old = xb_add(&bar[XB_XSUB(b.x)], 1u);
        const unsigned gen = old / nloc;
        if (old + 1u == (gen + 1u) * nloc) {
            __builtin_amdgcn_fence(__ATOMIC_RELEASE, "agent");
            asm volatile("s_waitcnt vmcnt(0)" ::: "memory");
            const unsigned og = xb_add(&bar[XB_TOP], 1u);
            const unsigned tg = og / nx;
            if (og + 1u == (tg + 1u) * nx) xb_add(&bar[XB_TOPGEN], 1u);
            else XB_SPIN(xb_ld(&bar[XB_TOPGEN]) == tg, bar);
            __builtin_amdgcn_fence(__ATOMIC_ACQUIRE, "agent");
            xb_add(&bar[XB_XGEN(b.x)], 1u);
            asm volatile("s_waitcnt vmcnt(0)" ::: "memory");
        } else {
            XB_SPIN(xb_ld(&bar[XB_XGEN(b.x)]) == gen, bar);
            __builtin_amdgcn_fence(__ATOMIC_ACQUIRE, "agent");
            asm volatile("s_waitcnt vmcnt(0)" ::: "memory");
        }
    }
    __syncthreads();
}

constexpr size_t MiB = 1u << 20;
constexpr size_t al(size_t x) { return (x + 4095) & ~(size_t)4095; }
constexpr size_t WS_CTL = 0, CTL_ZERO_BYTES = 1 * MiB;
constexpr int CW_BAR = 4096;
constexpr int CW_CNT = 16384;
constexpr int CW_NT = 16384 + 512;
constexpr size_t WS_MOD = 1 * MiB;
constexpr size_t WS_TILE_E = WS_MOD + 256 * 1024;
constexpr size_t WS_PADSTART = WS_TILE_E + 16 * 1024;
constexpr size_t WS_ROWTOK = 2 * MiB;
constexpr size_t WS_EIDX = 4 * MiB;
constexpr size_t WS_GATE = 5 * MiB;
constexpr size_t WS_DEST = 6 * MiB;
constexpr size_t WS_WIN = 8 * MiB;
constexpr size_t WS_WLORA = WS_WIN + al((size_t)NP * D * 2);
constexpr size_t WS_WBRRW = WS_WLORA + al((size_t)NLORA * KLORA * 2);
constexpr size_t WS_WBRGLA = WS_WBRRW + al((size_t)D * RWW * 2);
constexpr size_t WS_WOUT = WS_WBRGLA + al((size_t)D * RWW * 2);
constexpr size_t WS_WROUTER = WS_WOUT + al((size_t)D * D * 2);
constexpr size_t WS_WGU = WS_WROUTER + al((size_t)NE * D * 2);
constexpr size_t WS_WD = WS_WGU + al((size_t)(NE + 1) * 512 * D * 2);
constexpr size_t WS_PERSIST_END = WS_WD + al((size_t)(NE + 1) * D * FF * 2);
constexpr size_t WS_REGB = WS_PERSIST_END;
constexpr size_t SZ512F = al((size_t)MR * RWW * 4), SZ256F = al((size_t)MR * 256 * 4), SZ512H = al((size_t)MR * RWW * 2);
constexpr size_t WS_A1 = WS_REGB;
constexpr size_t WS_A2 = WS_A1;
constexpr size_t WS_KSUM = WS_A2 + al((size_t)MR * KLORA * 2);
static_assert(WS_KSUM + SZ512H <= WS_A1 + al((size_t)MR * D * 2), "A2 + KSUM fit in the A1 slot");
constexpr size_t WS_P = WS_A1 + al((size_t)MR * D * 2);
constexpr size_t WS_RB = WS_P + al((size_t)MR * NP * 2);
constexpr size_t WS_VB = WS_RB + SZ512H, WS_KKB = WS_VB + SZ512H, WS_KMF = WS_KKB + SZ512H, WS_KMB = WS_KMF + SZ512H, WS_BVF = WS_KMB + SZ512H, WS_BVB = WS_BVF + SZ512H;
constexpr size_t WS_LWF = WS_BVB + SZ512H, WS_LWB = WS_LWF + SZ512F;
constexpr size_t SZ256H = al((size_t)MR * 256 * 2);
constexpr size_t WS_QGB = WS_LWB + SZ512F, WS_KGB = WS_QGB + SZ256H, WS_VGB = WS_KGB + SZ256H, WS_LAF = WS_VGB + SZ512H, WS_LAB = WS_LAF + SZ256F;
constexpr size_t WS_RWG = WS_LAB + SZ256F;
constexpr size_t WS_ORWF = WS_RWG + SZ512H, WS_ORWB = WS_ORWF + SZ512H, WS_OGLF = WS_ORWB + SZ512H, WS_OGLB = WS_OGLF + SZ512H;
constexpr int CH = 64, NCHUNK = (CTXL + SEQ) / CH, NU_RW = 64 * NCHUNK, NU_GL = 32 * NCHUNK;
constexpr size_t WS_RH = WS_OGLB + SZ512H;
constexpr size_t WS_YL = WS_RH + al((size_t)NU_RW * 4096 * 2);
constexpr size_t WS_HH = WS_YL + al((size_t)NU_RW * 4096 * 2);
constexpr size_t WS_INTRA = WS_HH + al((size_t)NU_RW * 4096 * 4);
constexpr size_t WS_KV = WS_INTRA + al((size_t)NU_GL * 8192 * 2);
constexpr size_t WS_DD = WS_KV + al((size_t)NU_GL * 8192 * 4);
constexpr size_t WS_END_MIX = WS_DD + al((size_t)NU_GL * 64 * 4);
constexpr size_t OUT_GT = 0, OUT_QE = (size_t)NU_RW * 4096 * 2;
static_assert(OUT_QE + (size_t)NU_GL * 4096 * 2 <= (size_t)NLAT * D * 4, "scan scratch fits in d_out");
constexpr size_t WS_YRW = WS_LWF, WS_YGLA = WS_LWB, WS_Z = WS_HH;
constexpr size_t WS_X1 = WS_REGB;
constexpr size_t WS_A3 = WS_X1 + al((size_t)NLAT * D * 4);
constexpr size_t WS_LOGITS = WS_A3 + al((size_t)NLAT * D * 2);
constexpr size_t WS_ACT = WS_LOGITS + al((size_t)NLAT * NE * 4);
constexpr size_t WS_Y = WS_ACT + al((size_t)NROWS_E * FF * 2);
constexpr size_t WS_END_MOE = WS_Y + al((size_t)NROWS_E * D * 2);
constexpr size_t WS_END = WS_END_MIX > WS_END_MOE ? WS_END_MIX : WS_END_MOE;
static_assert(WS_END <= (size_t)2048 * MiB, "workspace map exceeds 2 GiB");

constexpr int RING_BYTES = 131072;
constexpr int IDX_BYTES = pg8::IDX_UNITS * 256 * 4;
constexpr int MISC_OFF = RING_BYTES + IDX_BYTES;
constexpr int LDS_BYTES = MISC_OFF + 256;
static_assert(pg8::IDX_OFF == RING_BYTES, "gather table sits right above the stage buffers");
constexpr int NWAVES = 8, NTHR = 512;

struct Args { const float* in[36]; float* out; unsigned char* ws; int ph_lo, ph_hi; };

struct Frame {
    LAS unsigned char* lds;
    int tid, lane, wave, G, gw, NGW;
    const float* const* in; float* out; unsigned char* ws; unsigned* ctl;
};

__device__ __forceinline__ float wave_sum(float v) {
#pragma unroll
    for (int o = 1; o < 64; o <<= 1) v += __shfl_xor(v, o);
    return v;
}
__device__ __forceinline__ unsigned f2bf(float f) { unsigned u = __builtin_bit_cast(unsigned, f); return (u + 0x7fffu + ((u >> 16) & 1u)) >> 16; }
__device__ __forceinline__ unsigned pk2(float lo, float hi) { return f2bf(lo) | (f2bf(hi) << 16); }
__device__ __forceinline__ float bflo(unsigned w) { return __builtin_bit_cast(float, w << 16); }
__device__ __forceinline__ float bfhi(unsigned w) { return __builtin_bit_cast(float, w & 0xffff0000u); }
__device__ __forceinline__ float sigmoidf_(float x) { return 1.0f / (1.0f + __expf(-x)); }
__device__ __forceinline__ float siluf_(float x) { return x / (1.0f + __expf(-x)); }

__device__ __forceinline__ void ln_stats(const f32x4 (&v)[4], float& mean, float& rstd) {
    float s = 0.f;
#pragma unroll
    for (int j = 0; j < 4; ++j) s += (v[j].x + v[j].y) + (v[j].z + v[j].w);
    mean = wave_sum(s) * (1.f / D); float s2 = 0.f;
#pragma unroll
    for (int j = 0; j < 4; ++j) { const f32x4 d = v[j] - mean; s2 += (d.x * d.x + d.y * d.y) + (d.z * d.z + d.w * d.w); }
    rstd = 1.f / sqrtf(wave_sum(s2) * (1.f / D) + LN_EPS);
}

__device__ __forceinline__ void ph_x1pre_nomix(Frame& F) {
    const float* x = F.in[0];
    for (int m = F.gw; m < NLAT; m += F.NGW) {
        const f32x4* xr = (const f32x4*)(x + (size_t)m * D) + F.lane; f32x4* o = (f32x4*)(F.out + (size_t)m * D) + F.lane;
#pragma unroll
        for (int j = 0; j < 4; ++j) o[64 * j] = xr[64 * j] * ALPHA;
    }
}
__device__ __forceinline__ void ph_ln1(Frame& F) {
    const float* lw = F.in[26]; const float* lb = F.in[27]; const float* mod = (const float*)(F.ws + WS_MOD);
    float* X1 = (float*)(F.ws + WS_X1); bf16* A3 = (bf16*)(F.ws + WS_A3);
    for (int m = F.gw; m < NLAT; m += F.NGW) {
        const int b = m / SEQ;
        const f32x4* pr = (const f32x4*)(F.out + (size_t)m * D) + F.lane;
        f32x4 v[4];
#pragma unroll
        for (int j = 0; j < 4; ++j) v[j] = pr[64 * j];
        float mean, rstd; ln_stats(v, mean, rstd);
        f32x4* xo = (f32x4*)(X1 + (size_t)m * D) + F.lane; v2u* ao = (v2u*)(A3 + (size_t)m * D) + F.lane;
#pragma unroll
        for (int j = 0; j < 4; ++j) {
            const int c = 4 * F.lane + 256 * j;
            const f32x4 w = *(const f32x4*)(lw + c), bb = *(const f32x4*)(lb + c);
            const f32x4 x1 = (v[j] - mean) * rstd * w + bb;
            xo[64 * j] = x1;
#if MS >= 2
            const f32x4 sh = *(const f32x4*)(mod + b * 6144 + 3072 + c), sc = *(const f32x4*)(mod + b * 6144 + 4096 + c);
            const f32x4 h = x1 * (sc + 1.0f) + sh;
            v2u o; o.x = pk2(h.x, h.y); o.y = pk2(h.z, h.w); ao[64 * j] = o;
#endif
        }
    }
}
__device__ __forceinline__ void ph_final(Frame& F) {
    const float* lw = F.in[34]; const float* lb = F.in[35]; const float* mod = (const float*)(F.ws + WS_MOD);
    const float* X1 = (const float*)(F.ws + WS_X1);
    const bf16* Y = (const bf16*)(F.ws + WS_Y); const int* DEST = (const int*)(F.ws + WS_DEST); const float* GATE = (const float*)(F.ws + WS_GATE);
    for (int m = F.gw; m < NLAT; m += F.NGW) {
        const int b = m / SEQ;
        const f32x4* pr = (const f32x4*)(X1 + (size_t)m * D) + F.lane;
        f32x4 v[4];
#pragma unroll
        for (int j = 0; j < 4; ++j) v[j] = pr[64 * j] * ALPHA;
#if MS >= 2
        f32x4 mo[4];
        { const v2u* yr = (const v2u*)(Y + (size_t)(SH_ROW0 + m) * D) + F.lane;
#pragma unroll
          for (int j = 0; j < 4; ++j) { const v2u w = yr[64 * j]; mo[j] = (f32x4){bflo(w.x), bfhi(w.x), bflo(w.y), bfhi(w.y)}; } }
        for (int k = 0; k < TOPK; ++k) {
            const int dr = DEST[m * 8 + k]; const float gt = GATE[m * 8 + k];
            const v2u* yr = (const v2u*)(Y + (size_t)dr * D) + F.lane;
#pragma unroll
            for (int j = 0; j < 4; ++j) { const v2u w = yr[64 * j]; mo[j] += (f32x4){bflo(w.x), bfhi(w.x), bflo(w.y), bfhi(w.y)} * gt; }
        }
#pragma unroll
        for (int j = 0; j < 4; ++j) { const f32x4 g2 = *(const f32x4*)(mod + b * 6144 + 5120 + 4 * F.lane + 256 * j); v[j] += g2 * mo[j]; }
#endif
        float mean, rstd; ln_stats(v, mean, rstd);
        f32x4* o = (f32x4*)(F.out + (size_t)m * D) + F.lane;
#pragma unroll
        for (int j = 0; j < 4; ++j) { const int c = 4 * F.lane + 256 * j; const f32x4 w = *(const f32x4*)(lw + c), bb = *(const f32x4*)(lb + c); o[64 * j] = (v[j] - mean) * rstd * w + bb; }
    }
}


#if MS >= 2
template <int MODE>
__device__ __forceinline__ void cvt_item(const float* W, int Nsrc, int nblk, bf16* WT, int row_off, int dpitch, LAS float* scr, int item, int lane) {
    const int kb = item / nblk, nb = item - kb * nblk, k0 = 64 * kb, n0 = 32 * nb;
    const int nn = n0 + (lane & 31);
#pragma unroll 8
    for (int i = 0; i < 32; ++i) { const int kk = 2 * i + (lane >> 5); scr[kk * 33 + (lane & 31)] = (nn < Nsrc) ? W[(size_t)(k0 + kk) * Nsrc + nn] : 0.f; }
    LDS_WAIT(); asm volatile("" ::: "memory");
    const int c = lane & 7;
#pragma unroll
    for (int j = 0; j < 4; ++j) { const int n = (lane >> 3) + 8 * j; const LAS float* s = scr + (8 * c) * 33 + n;
        v4u o; o.x = pk2(s[0 * 33], s[1 * 33]); o.y = pk2(s[2 * 33], s[3 * 33]); o.z = pk2(s[4 * 33], s[5 * 33]); o.w = pk2(s[6 * 33], s[7 * 33]);
        const int ng = n0 + n; int dr = ng;
        if (MODE == 1) { const int i2 = ng & 255; dr = 8 * (i2 >> 2) + (i2 & 3) + ((ng >= 256) ? 4 : 0); }
        *(v4u*)(WT + (size_t)(row_off + dr) * dpitch + k0 + 8 * c) = o; }
    LDS_WAIT(); asm volatile("" ::: "memory");
}

template <int MODE>
__device__ __forceinline__ void cvt_item_reg(const float* W, int Nsrc, bf16* WT, int row_off, int dpitch, int k0, int n0, int lane) {
    const float* src = W + (size_t)k0 * Nsrc + n0 + 4 * lane;
    f32x4 v[32];
#pragma unroll
    for (int i = 0; i < 32; ++i) v[i] = __builtin_nontemporal_load((const f32x4*)(src + (size_t)i * Nsrc));
#pragma unroll
    for (int j = 0; j < 4; ++j) {
        const int ng = n0 + 4 * lane + j; int dr = ng;
        if (MODE == 1) { const int i2 = ng & 255; dr = 8 * (i2 >> 2) + (i2 & 3) + ((ng >= 256) ? 4 : 0); }
        v4u* dst = (v4u*)(WT + (size_t)(row_off + dr) * dpitch + k0);
#pragma unroll
        for (int q = 0; q < 4; ++q) { v4u o; o.x = pk2(v[8 * q][j], v[8 * q + 1][j]); o.y = pk2(v[8 * q + 2][j], v[8 * q + 3][j]); o.z = pk2(v[8 * q + 4][j], v[8 * q + 5][j]); o.w = pk2(v[8 * q + 6][j], v[8 * q + 7][j]); dst[q] = o; }
    }
}

#if MS >= 3
__device__ __forceinline__ float lora_val(const float* const* in, int n, int k) {
    if (n < 1024) { const int q = n >> 3, e8 = n & 7, dir = e8 >> 2, ch = q * 4 + (e8 & 3); return (k < 32) ? in[9][(size_t)(dir * 32 + k) * 512 + ch] : 0.f; }
    if (n < 2048) { const int m = n - 1024, q = m >> 3, e8 = m & 7, dir = e8 >> 2, ch = q * 4 + (e8 & 3); return (k >= 32 && k < 64) ? in[11][(size_t)(dir * 32 + (k - 32)) * 512 + ch] : 0.f; }
    if (n < 2560) { const int ch = n - 2048; return (k >= 64 && k < 160) ? in[12][(size_t)(k - 64) * 512 + ch] : 0.f; }
    { const int m = n - 2560, q = m >> 3, e8 = m & 7, dir = e8 >> 2, ch = q * 4 + (e8 & 3); return (k >= 160 && k < 176) ? in[19][(size_t)(dir * 16 + (k - 160)) * 256 + ch] : 0.f; }
}
#endif

__device__ __forceinline__ void ph_prologue(Frame& F) {
    {
        const float* c = F.in[1]; const float* cc = F.in[3]; const float* wa = F.in[4]; const float* ba = F.in[5];
        float* MOD = (float*)(F.ws + WS_MOD);
        LAS float* S = (LAS float*)F.lds; LAS float* red = (LAS float*)(F.lds + 32768);
        for (int it = blockIdx.x; it < 96; it += F.G) {
            for (int i = F.tid; i < 5120; i += NTHR) { const int r = i >> 10, k = i & 1023; const float cv = r < 4 ? c[r * 1024 + k] : cc[k]; S[i] = siluf_(cv); }
            __syncthreads();
            const int n = it * 64 + F.lane; float acc[5] = {0.f, 0.f, 0.f, 0.f, 0.f};
            for (int kk = 0; kk < 128; ++kk) { const int k = F.wave * 128 + kk; const float wv = wa[(size_t)k * 6144 + n];
#pragma unroll
                for (int r = 0; r < 5; ++r) acc[r] += S[r * 1024 + k] * wv; }
#pragma unroll
            for (int r = 0; r < 5; ++r) red[(F.wave * 5 + r) * 64 + F.lane] = acc[r];
            __syncthreads();
            if (F.wave == 0) {
#pragma unroll
                for (int r = 0; r < 5; ++r) { float s = 0.f;
#pragma unroll
                    for (int w = 0; w < 8; ++w) s += red[(w * 5 + r) * 64 + F.lane];
                    MOD[r * 6144 + n] = s + ba[n]; }
            }
            __syncthreads();
        }
    }
    {
        LAS float* scr = (LAS float*)(F.lds + F.wave * 16384);
        constexpr int I_IN = 16 * 168, I_BR = 8 * 32, I_OUT = 16 * 32, I_RT = 16 * 8, I_GU = 32 * 2, I_DN = 8 * 4;
        constexpr int T0 = I_IN, T1 = T0 + I_BR, T2 = T1 + I_BR, T3 = T2 + I_OUT, T4 = T3 + I_RT, T5 = T4 + (NE + 1) * I_GU, T6 = T5 + (NE + 1) * I_DN;
        unsigned char* ws = F.ws;
        for (int it = F.gw; it < T6; it += F.NGW) {
#if MS >= 3
            if (it < T0) { cvt_item<0>(F.in[6], IN_COLS, 168, (bf16*)(ws + WS_WIN), 0, D, scr, it, F.lane); continue; }
            if (it < T1) { cvt_item<0>(F.in[23], D, 32, (bf16*)(ws + WS_WBRRW), 0, RWW, scr, it - T0, F.lane); continue; }
            if (it < T2) { cvt_item<0>(F.in[24], D, 32, (bf16*)(ws + WS_WBRGLA), 0, RWW, scr, it - T1, F.lane); continue; }
            if (it < T3) { cvt_item<0>(F.in[25], D, 32, (bf16*)(ws + WS_WOUT), 0, D, scr, it - T2, F.lane); continue; }
#else
            if (it < T3) continue;
#endif
            if (it < T4) { cvt_item<0>(F.in[28], NE, 8, (bf16*)(ws + WS_WROUTER), 0, D, scr, it - T3, F.lane); continue; }
            if (it < T5) { const int r = it - T4, e = r / I_GU, ii = r - e * I_GU;
                const float* src = (e < NE) ? F.in[30] + (size_t)e * D * 512 : F.in[32];
                cvt_item_reg<1>(src, 512, (bf16*)(ws + WS_WGU), e * 512, D, 32 * (ii >> 1), 256 * (ii & 1), F.lane); continue; }
            { const int r = it - T5, e = r / I_DN, ii = r - e * I_DN;
                const float* src = (e < NE) ? F.in[31] + (size_t)e * FF * D : F.in[33];
                cvt_item_reg<0>(src, D, (bf16*)(ws + WS_WD), e * D, FF, 32 * (ii >> 2), 256 * (ii & 3), F.lane); }
        }
    }
#if MS >= 3
    {
        bf16* WL = (bf16*)(F.ws + WS_WLORA);
        for (int idx = blockIdx.x * NTHR + F.tid; idx < NLORA * (KLORA / 8); idx += F.G * NTHR) {
            const int n = idx >> 5, k0 = (idx & 31) * 8; float v[8];
#pragma unroll
            for (int e = 0; e < 8; ++e) v[e] = lora_val(F.in, n, k0 + e);
            v4u o; o.x = pk2(v[0], v[1]); o.y = pk2(v[2], v[3]); o.z = pk2(v[4], v[5]); o.w = pk2(v[6], v[7]);
            *(v4u*)(WL + (size_t)n * KLORA + k0) = o;
        }
    }
#endif
}

struct EpiF32 {
    static constexpr bool PERM = false;
    float* C; int ldc;
    __device__ __forceinline__ void operator()(const f32x4 (&acc)[2][2][4][2], const pg8::Unit& u, int wr, int wc, int fr, int fq) const {
        const int row0 = u.pm * 256 + wr * 64 + fr, col0 = u.pn * 256 + wc * 32 + 4 * fq;
#pragma unroll
        for (int ai = 0; ai < 2; ++ai)
#pragma unroll
            for (int m = 0; m < 4; ++m) { float* rowp = C + (size_t)(row0 + ai * 128 + m * 16) * ldc + col0;
#pragma unroll
                for (int bj = 0; bj < 2; ++bj)
#pragma unroll
                    for (int n = 0; n < 2; ++n) *(f32x4*)(rowp + bj * 128 + n * 16) = acc[ai][bj][m][n]; }
    }
};
struct EpiSwiglu {
    static constexpr bool PERM = true;
    bf16* ACT;
    __device__ __forceinline__ void operator()(const f32x4 (&acc)[2][2][4][2], const pg8::Unit& u, int wr, int wc, int fr, int fq) const {
        const int row0 = u.pm * 256 + wr * 64 + fr, h0 = u.j * 128 + wc * 16 + 4 * fq;
#pragma unroll
        for (int ai = 0; ai < 2; ++ai)
#pragma unroll
            for (int m = 0; m < 4; ++m) { bf16* rowp = ACT + (size_t)(row0 + ai * 128 + m * 16) * FF + h0;
#pragma unroll
                for (int bj = 0; bj < 2; ++bj) { const f32x4 a = acc[ai][bj][m][0], b = acc[ai][bj][m][1];
                    v2u o; o.x = pg8::cvt_pk_bf16(siluf_(a[0]) * b[0], siluf_(a[1]) * b[1]); o.y = pg8::cvt_pk_bf16(siluf_(a[2]) * b[2], siluf_(a[3]) * b[3]);
                    *(v2u*)(rowp + bj * 64) = o; } }
    }
};
struct EpiRowsBf16 {
    static constexpr bool PERM = true;
    bf16* O; int ldc;
    __device__ __forceinline__ void operator()(const f32x4 (&acc)[2][2][4][2], const pg8::Unit& u, int wr, int wc, int fr, int fq) const {
        const int row0 = u.pm * 256 + wr * 64 + fr, col0 = u.j * 256 + wc * 32 + 8 * fq;
#pragma unroll
        for (int ai = 0; ai < 2; ++ai)
#pragma unroll
            for (int m = 0; m < 4; ++m) { bf16* rowp = O + (size_t)(row0 + ai * 128 + m * 16) * ldc + col0;
#pragma unroll
                for (int bj = 0; bj < 2; ++bj) { const f32x4 v0 = acc[ai][bj][m][0], v1 = acc[ai][bj][m][1];
                    v4u w; w.x = pg8::cvt_pk_bf16(v0[0], v0[1]); w.y = pg8::cvt_pk_bf16(v0[2], v0[3]); w.z = pg8::cvt_pk_bf16(v1[0], v1[1]); w.w = pg8::cvt_pk_bf16(v1[2], v1[3]);
                    *(v4u*)(rowp + bj * 128) = w; } }
    }
};

__device__ __forceinline__ void ph_router(Frame& F) {
    pg8::Gemm g{(const bf16*)(F.ws + WS_A3), (const bf16*)(F.ws + WS_WROUTER), NLAT, NE, D, nullptr};
    pg8::StaticOrder S; S.init(NLAT, NE, F.G, (int)blockIdx.x);
    EpiF32 E{(float*)(F.ws + WS_LOGITS), NE};
    pg8::gemm_phase<EpiF32, pg8::StaticOrder, true, true, false>(F.lds, g, S, E);
}

__device__ __forceinline__ void ph_route(Frame& F) {
    const float* LOG = (const float*)(F.ws + WS_LOGITS); const float* rb = F.in[29];
    int* EIDX = (int*)(F.ws + WS_EIDX); float* GATE = (float*)(F.ws + WS_GATE); int* DEST = (int*)(F.ws + WS_DEST);
    unsigned* CNT = F.ctl + CW_CNT;
    const f32x4 bias = *(const f32x4*)(rb + 4 * F.lane);
    const float NEG = -3.0e38f;
    for (int m = F.gw; m < NLAT; m += F.NGW) {
        const f32x4 lg = *(const f32x4*)(LOG + (size_t)m * NE + 4 * F.lane);
        float sc[4], sel[4];
#pragma unroll
        for (int i = 0; i < 4; ++i) { sc[i] = sigmoidf_(lg[i]); sel[i] = sc[i] + bias[i]; }
        float m1 = fmaxf(sel[0], sel[1]), m2 = fminf(sel[0], sel[1]);
        { const float a = sel[2]; const float n1 = fmaxf(m1, a); m2 = fmaxf(m2, fminf(m1, a)); m1 = n1; }
        { const float a = sel[3]; const float n1 = fmaxf(m1, a); m2 = fmaxf(m2, fminf(m1, a)); m1 = n1; }
#pragma unroll
        for (int o = 1; o < 8; o <<= 1) { const float b1 = __shfl_xor(m1, o), b2 = __shfl_xor(m2, o); const float n1 = fmaxf(m1, b1); m2 = fmaxf(fminf(m1, b1), fmaxf(m2, b2)); m1 = n1; }
        const float gs = m1 + m2; const int g = F.lane >> 3;
        int rank = 0;
#pragma unroll
        for (int gg = 0; gg < 8; ++gg) { const float og = __shfl(gs, gg * 8); rank += (og > gs || (og == gs && gg < g)) ? 1 : 0; }
        const bool keep = rank < 4;
#pragma unroll
        for (int i = 0; i < 4; ++i) sel[i] = keep ? sel[i] : NEG;
        int my_e = 0; float my_s = 0.f; float ssum = 0.f;
        for (int k = 0; k < TOPK; ++k) {
            float bv = sel[0]; int bi = 0;
#pragma unroll
            for (int i = 1; i < 4; ++i) if (sel[i] > bv) { bv = sel[i]; bi = i; }
            int be = 4 * F.lane + bi; float v = bv; int e = be;
#pragma unroll
            for (int o = 1; o < 64; o <<= 1) { const float ov = __shfl_xor(v, o); const int oe = __shfl_xor(e, o); if (ov > v || (ov == v && oe < e)) { v = ov; e = oe; } }
            const int owner = e >> 2, oi = e & 3;
            float s_own = 0.f;
            if (F.lane == owner) {
#pragma unroll
                for (int i = 0; i < 4; ++i) if (i == oi) { s_own = sc[i]; sel[i] = NEG; }
            }
            const float s = __shfl(s_own, owner);
            ssum += s;
            if (F.lane == k) { my_e = e; my_s = s; }
        }
        if (F.lane < TOPK) {
            const unsigned pos = __hip_atomic_fetch_add(CNT + my_e, 1u, __ATOMIC_RELAXED, __HIP_MEMORY_SCOPE_AGENT);
            EIDX[m * 8 + F.lane] = my_e; GATE[m * 8 + F.lane] = my_s / ssum * 2.5f; DEST[m * 8 + F.lane] = (int)pos;
        }
    }
}

__device__ __forceinline__ void ph_scatter(Frame& F) {
    LAS int* tstart = (LAS int*)F.lds;
    LAS int* scan = (LAS int*)(F.lds + 2048);
    LAS int* cnts = (LAS int*)(F.lds + 4096);
    int* EIDX = (int*)(F.ws + WS_EIDX); int* DEST = (int*)(F.ws + WS_DEST); int* ROWTOK = (int*)(F.ws + WS_ROWTOK); int* TILE_E = (int*)(F.ws + WS_TILE_E);
    unsigned* CNT = F.ctl + CW_CNT;
    int tiles = 0, cnt = 0;
    if (F.tid < NE) { cnt = (int)__hip_atomic_load(CNT + F.tid, __ATOMIC_RELAXED, __HIP_MEMORY_SCOPE_AGENT); tiles = (cnt + 255) >> 8; scan[F.tid] = tiles; cnts[F.tid] = cnt; }
    __syncthreads();
    for (int o = 1; o < NE; o <<= 1) { int v = 0; if (F.tid < NE && F.tid >= o) v = scan[F.tid - o]; __syncthreads(); if (F.tid < NE) scan[F.tid] += v; __syncthreads(); }
    if (F.tid < NE) { tstart[F.tid + 1] = scan[F.tid]; if (F.tid == 0) tstart[0] = 0; }
    __syncthreads();
    const int NT = tstart[NE];
    if (blockIdx.x == 0) {
        if (F.tid == 0) F.ctl[CW_NT] = (unsigned)NT;
        if (F.tid < NE) for (int t = tstart[F.tid]; t < tstart[F.tid + 1]; ++t) TILE_E[t] = F.tid;
    }
    for (int e = blockIdx.x; e < NE; e += F.G) { const int c0 = cnts[e], c1 = (tstart[e + 1] - tstart[e]) * 256, base = tstart[e] * 256;
        for (int p = c0 + F.tid; p < c1; p += NTHR) ROWTOK[base + p] = 0; }
    for (int i = blockIdx.x * NTHR + F.tid; i < NLAT; i += F.G * NTHR) ROWTOK[SH_ROW0 + i] = i;
    for (int i = blockIdx.x * NTHR + F.tid; i < NLAT * TOPK; i += F.G * NTHR) {
        const int e = EIDX[i], pos = DEST[i]; const int dr = tstart[e] * 256 + pos;
        DEST[i] = dr; ROWTOK[dr] = i >> 3;
    }
}

__device__ __forceinline__ void ph_exp1(Frame& F) {
    const int NT = (int)__hip_atomic_load(F.ctl + CW_NT, __ATOMIC_RELAXED, __HIP_MEMORY_SCOPE_AGENT);
    pg8::Gemm g{(const bf16*)(F.ws + WS_A3), (const bf16*)(F.ws + WS_WGU), 0, 0, D, (const int*)(F.ws + WS_ROWTOK)};
    pg8::MoeOrder S{2, F.G, (int)blockIdx.x, NT, (const int*)(F.ws + WS_TILE_E)};
    EpiSwiglu E{(bf16*)(F.ws + WS_ACT)};
    pg8::gemm_phase<EpiSwiglu, pg8::MoeOrder, true, true, true>(F.lds, g, S, E);
}
__device__ __forceinline__ void ph_exp2(Frame& F) {
    const int NT = (int)__hip_atomic_load(F.ctl + CW_NT, __ATOMIC_RELAXED, __HIP_MEMORY_SCOPE_AGENT);
    pg8::Gemm g{(const bf16*)(F.ws + WS_ACT), (const bf16*)(F.ws + WS_WD), 0, 0, FF, nullptr};
    pg8::MoeOrder S{4, F.G, (int)blockIdx.x, NT, (const int*)(F.ws + WS_TILE_E)};
    EpiRowsBf16 E{(bf16*)(F.ws + WS_Y), D};
    pg8::gemm_phase<EpiRowsBf16, pg8::MoeOrder, true, true, false>(F.lds, g, S, E);
}
#endif

#if MS >= 3
__device__ __forceinline__ void unp8(const v4u w, float (&f)[8]) { f[0] = bflo(w.x); f[1] = bfhi(w.x); f[2] = bflo(w.y); f[3] = bfhi(w.y); f[4] = bflo(w.z); f[5] = bfhi(w.z); f[6] = bflo(w.w); f[7] = bfhi(w.w); }
__device__ __forceinline__ v4u pk8(const float (&f)[8]) { v4u o; o.x = pk2(f[0], f[1]); o.y = pk2(f[2], f[3]); o.z = pk2(f[4], f[5]); o.w = pk2(f[6], f[7]); return o; }
__device__ __forceinline__ void st8(float* p, const float (&f)[8]) { *(f32x4*)p = (f32x4){f[0], f[1], f[2], f[3]}; *(f32x4*)(p + 4) = (f32x4){f[4], f[5], f[6], f[7]}; }
__device__ __forceinline__ void ld8(const float* p, float (&f)[8]) { const f32x4 a = *(const f32x4*)p, b = *(const f32x4*)(p + 4); f[0] = a.x; f[1] = a.y; f[2] = a.z; f[3] = a.w; f[4] = b.x; f[5] = b.y; f[6] = b.z; f[7] = b.w; }

__device__ __forceinline__ void ph_a1(Frame& F) {
    const float* mod = (const float*)(F.ws + WS_MOD); bf16* A1 = (bf16*)(F.ws + WS_A1);
    for (int m = F.gw; m < MR; m += F.NGW) {
        const float* src = (m < NLAT) ? F.in[0] + (size_t)m * D : F.in[2] + (size_t)(m - NLAT) * D;
        const int mr = (m < NLAT) ? (m / SEQ) : 4;
        const f32x4* xr = (const f32x4*)src + F.lane; v2u* ao = (v2u*)(A1 + (size_t)m * D) + F.lane;
#pragma unroll
        for (int j = 0; j < 4; ++j) { const int c = 4 * F.lane + 256 * j;
            const f32x4 sh = *(const f32x4*)(mod + mr * 6144 + c), sc = *(const f32x4*)(mod + mr * 6144 + 1024 + c);
            const f32x4 h = xr[64 * j] * (sc + 1.0f) + sh; v2u o; o.x = pk2(h.x, h.y); o.y = pk2(h.z, h.w); ao[64 * j] = o; }
    }
}

__device__ __forceinline__ void ph_inproj(Frame& F) {
    pg8::Gemm g{(const bf16*)(F.ws + WS_A1), (const bf16*)(F.ws + WS_WIN), MR, NP, D, nullptr};
    pg8::StaticOrder S; S.init(MR, NP, F.G, (int)blockIdx.x);
    EpiRowsBf16 E{(bf16*)(F.ws + WS_P), NP};
    pg8::gemm_phase<EpiRowsBf16, pg8::StaticOrder, true, true, false>(F.lds, g, S, E);
}

__device__ __forceinline__ void ph_feat(Frame& F) {
    const bf16* P = (const bf16*)(F.ws + WS_P);
    const float* mu = F.in[7]; const float* kkw = F.in[13]; const float* cw = F.in[18];
    bf16* R = (bf16*)(F.ws + WS_RB); bf16* V = (bf16*)(F.ws + WS_VB); bf16* KK = (bf16*)(F.ws + WS_KKB); bf16* KP = (bf16*)(F.ws + WS_KMF);
    bf16* QG = (bf16*)(F.ws + WS_QGB); bf16* KGB = (bf16*)(F.ws + WS_KGB); bf16* VGB = (bf16*)(F.ws + WS_VGB);
    bf16* A2 = (bf16*)(F.ws + WS_A2);
    const int lane = F.lane;
    for (int m = F.gw; m < MR; m += F.NGW) {
        int nb[4]; int gr = 0, gc = 0; const bool lat = m < NLAT;
        if (lat) { const int t = m & (SEQ - 1); gr = t >> 6; gc = t & 63;
            nb[0] = gc > 0 ? m - 1 : -1; nb[1] = gc < 63 ? m + 1 : -1; nb[2] = gr > 0 ? m - 64 : -1; nb[3] = gr < 127 ? m + 64 : -1;
        } else { const int t = (m - NLAT) & (CTXL - 1); nb[0] = t > 0 ? m - 1 : -1; nb[1] = t < CTXL - 1 ? m + 1 : -1; nb[2] = nb[0]; nb[3] = nb[1]; }
        const bf16* prow = P + (size_t)m * NP;
#pragma unroll
        for (int p = 0; p < 4; ++p) {
            const int cb = p * 512 + 8 * lane;
            if (p < 3 || lane < 20) {
                float own[8], sh[4][8];
                unp8(*(const v4u*)(prow + cb), own);
#pragma unroll
                for (int q = 0; q < 4; ++q) { v4u w = (v4u){0u, 0u, 0u, 0u}; if (nb[q] >= 0) w = *(const v4u*)(P + (size_t)nb[q] * NP + cb); unp8(w, sh[q]); }
                float muv[8]; ld8(mu + cb, muv);
                float val[8];
#pragma unroll
                for (int e = 0; e < 8; ++e) val[e] = own[e] + muv[e] * (sh[e & 3][e] - own[e]);
                if (p == 0) *(v4u*)(R + (size_t)m * RWW + 8 * lane) = pk8(val);
                else if (p == 2) *(v4u*)(V + (size_t)m * RWW + 8 * lane) = pk8(val);
                else if (p == 1) {
                    *(v4u*)(KP + (size_t)m * RWW + 8 * lane) = pk8(val);
                    float kw[8]; ld8(kkw + 8 * lane, kw); float kkv[8]; float ss = 0.f;
#pragma unroll
                    for (int e = 0; e < 8; ++e) { kkv[e] = val[e] * kw[e]; ss += kkv[e] * kkv[e]; }
                    ss += __shfl_xor(ss, 1); ss += __shfl_xor(ss, 2); ss += __shfl_xor(ss, 4);
                    const float inv = 1.0f / fmaxf(sqrtf(ss), 1e-12f);
#pragma unroll
                    for (int e = 0; e < 8; ++e) kkv[e] *= inv;
                    *(v4u*)(KK + (size_t)m * RWW + 8 * lane) = pk8(kkv);
                } else {
                    float o[8];
#pragma unroll
                    for (int e = 0; e < 8; ++e) o[e] = (lane < 4) ? tanhf(val[e]) : ((lane < 8) ? val[e] : sigmoidf_(val[e]));
                    *(v4u*)(A2 + (size_t)m * KLORA + 8 * lane) = pk8(o);
                }
            } else if (p == 3 && lane < 32) {
                v4u w = (v4u){0u, 0u, 0u, 0u};
                if (lane < 22) w = *(const v4u*)(prow + C_PGL + 8 * (lane - 20));
                *(v4u*)(A2 + (size_t)m * KLORA + 8 * lane) = w;
            }
        }
#pragma unroll
        for (int p = 0; p < 2; ++p) {
            const int cq = p * 512 + 8 * lane; const int cb = C_Q + cq;
            float acc[8] = {0.f, 0.f, 0.f, 0.f, 0.f, 0.f, 0.f, 0.f};
#pragma unroll
            for (int dy = -1; dy <= 1; ++dy)
#pragma unroll
                for (int dx = -1; dx <= 1; ++dx) {
                    bool ok; int nr;
                    if (lat) { ok = (gr + dy >= 0) && (gr + dy < GRIDH) && (gc + dx >= 0) && (gc + dx < GRIDW); nr = m + dy * 64 + dx; }
                    else { const int t = (m - NLAT) & (CTXL - 1); ok = (dy == 0) && (t + dx >= 0) && (t + dx < CTXL); nr = m + dx; }
                    if (ok) {
                        float pv[8], wv[8]; unp8(*(const v4u*)(P + (size_t)nr * NP + cb), pv); ld8(cw + ((dy + 1) * 3 + (dx + 1)) * 1024 + cq, wv);
#pragma unroll
                        for (int e = 0; e < 8; ++e) acc[e] += pv[e] * wv[e];
                    }
                }
            float o[8];
#pragma unroll
            for (int e = 0; e < 8; ++e) o[e] = siluf_(acc[e]);
            if (p == 0) {
                if (lane < 32) {
#pragma unroll
                    for (int e = 0; e < 8; ++e) o[e] *= 0.125f;
                    *(v4u*)(QG + (size_t)m * 256 + cq) = pk8(o);
                } else *(v4u*)(KGB + (size_t)m * 256 + (cq - 256)) = pk8(o);
            } else *(v4u*)(VGB + (size_t)m * RWW + (cq - 512)) = pk8(o);
        }
    }
}

struct EpiLora {
    static constexpr bool PERM = true;
    unsigned char* ws; const float* const* in;
    __device__ __forceinline__ void grp_w(const f32x4 (&acc)[2][2][4][2], int row0, int c0) const {
        float* Wf = (float*)(ws + WS_LWF); float* Wb = (float*)(ws + WS_LWB);
#pragma unroll
        for (int bj = 0; bj < 2; ++bj) { const int ch = (c0 + bj * 128) >> 1; const f32x4 w0f = *(const f32x4*)(in[8] + ch), w0b = *(const f32x4*)(in[8] + 512 + ch);
#pragma unroll
            for (int ai = 0; ai < 2; ++ai)
#pragma unroll
                for (int m = 0; m < 4; ++m) { const size_t row = (size_t)(row0 + ai * 128 + m * 16);
                    const f32x4 xf = acc[ai][bj][m][0] + w0f, xb = acc[ai][bj][m][1] + w0b; f32x4 df, db;
#pragma unroll
                    for (int e = 0; e < 4; ++e) { df[e] = -0.60653066f * sigmoidf_(xf[e]); db[e] = -0.60653066f * sigmoidf_(xb[e]); }
                    *(f32x4*)(Wf + row * RWW + ch) = df; *(f32x4*)(Wb + row * RWW + ch) = db; } }
    }
    __device__ __forceinline__ void grp_a(const f32x4 (&acc)[2][2][4][2], int row0, int c0) const {
        bf16* KMf = (bf16*)(ws + WS_KMF); bf16* KMb = (bf16*)(ws + WS_KMB); bf16* BVf = (bf16*)(ws + WS_BVF); bf16* BVb = (bf16*)(ws + WS_BVB);
        const bf16* KK = (const bf16*)(ws + WS_KKB); bf16* KSUM = (bf16*)(ws + WS_KSUM);
#pragma unroll
        for (int bj = 0; bj < 2; ++bj) { const int ch = (c0 + bj * 128 - 1024) >> 1; const f32x4 a0f = *(const f32x4*)(in[10] + ch), a0b = *(const f32x4*)(in[10] + 512 + ch), ka = *(const f32x4*)(in[14] + ch);
#pragma unroll
            for (int ai = 0; ai < 2; ++ai)
#pragma unroll
                for (int m = 0; m < 4; ++m) { const size_t row = (size_t)(row0 + ai * 128 + m * 16);
                    const f32x4 xf = acc[ai][bj][m][0] + a0f, xb = acc[ai][bj][m][1] + a0b;
                    const v2u kpw = *(const v2u*)(KMf + row * RWW + ch), kkw = *(const v2u*)(KK + row * RWW + ch);
                    const f32x4 kp = (f32x4){bflo(kpw.x), bfhi(kpw.x), bflo(kpw.y), bfhi(kpw.y)}, kk = (f32x4){bflo(kkw.x), bfhi(kkw.x), bflo(kkw.y), bfhi(kkw.y)};
                    f32x4 kmf, kmb, bvf, bvb;
#pragma unroll
                    for (int e = 0; e < 4; ++e) { const float af = sigmoidf_(xf[e]), ab = sigmoidf_(xb[e]);
                        kmf[e] = kp[e] * (1.0f + (af - 1.0f) * ka[e]); kmb[e] = kp[e] * (1.0f + (ab - 1.0f) * ka[e]); bvf[e] = kk[e] * af; bvb[e] = kk[e] * ab; }
                    { v2u o; o.x = pk2(kmf[0], kmf[1]); o.y = pk2(kmf[2], kmf[3]); *(v2u*)(KMf + row * RWW + ch) = o; o.x = pk2(kmb[0], kmb[1]); o.y = pk2(kmb[2], kmb[3]); *(v2u*)(KMb + row * RWW + ch) = o;
                      o.x = pk2(bvf[0], bvf[1]); o.y = pk2(bvf[2], bvf[3]); *(v2u*)(BVf + row * RWW + ch) = o; o.x = pk2(bvb[0], bvb[1]); o.y = pk2(bvb[2], bvb[3]); *(v2u*)(BVb + row * RWW + ch) = o; }
                    v2u ks; ks.x = pk2(kmf[0] + kmb[0], kmf[1] + kmb[1]); ks.y = pk2(kmf[2] + kmb[2], kmf[3] + kmb[3]); *(v2u*)(KSUM + row * RWW + ch) = ks; } }
    }
    __device__ __forceinline__ void grp_g(const f32x4 (&acc)[2][2][4][2], int row0, int c0) const {
        bf16* RWG = (bf16*)(ws + WS_RWG);
#pragma unroll
        for (int bj = 0; bj < 2; ++bj) { const int ch = c0 + bj * 128 - 2048;
#pragma unroll
            for (int ai = 0; ai < 2; ++ai)
#pragma unroll
                for (int m = 0; m < 4; ++m) { const size_t row = (size_t)(row0 + ai * 128 + m * 16); const f32x4 v0 = acc[ai][bj][m][0], v1 = acc[ai][bj][m][1];
                    v4u w; w.x = pk2(v0[0], v0[1]); w.y = pk2(v0[2], v0[3]); w.z = pk2(v1[0], v1[1]); w.w = pk2(v1[2], v1[3]); *(v4u*)(RWG + row * RWW + ch) = w; } }
    }
    __device__ __forceinline__ void grp_l(const f32x4 (&acc)[2][2][4][2], int row0, int c0) const {
        float* GAf = (float*)(ws + WS_LAF); float* GAb = (float*)(ws + WS_LAB);
#pragma unroll
        for (int bj = 0; bj < 2; ++bj) { const int ch = (c0 + bj * 128 - 2560) >> 1; const f32x4 gbf = *(const f32x4*)(in[20] + ch), gbb = *(const f32x4*)(in[20] + 256 + ch);
#pragma unroll
            for (int ai = 0; ai < 2; ++ai)
#pragma unroll
                for (int m = 0; m < 4; ++m) { const size_t row = (size_t)(row0 + ai * 128 + m * 16);
                    const f32x4 xf = acc[ai][bj][m][0] + gbf, xb = acc[ai][bj][m][1] + gbb; f32x4 af, ab;
#pragma unroll
                    for (int e = 0; e < 4; ++e) { const float lf = fminf(xf[e], 0.f) - log1pf(__expf(-fabsf(xf[e]))), lb = fminf(xb[e], 0.f) - log1pf(__expf(-fabsf(xb[e])));
                        af[e] = lf * 0.0625f; ab[e] = lb * 0.0625f; }
                    *(f32x4*)(GAf + row * 256 + ch) = af; *(f32x4*)(GAb + row * 256 + ch) = ab; } }
    }
    __device__ __forceinline__ void operator()(const f32x4 (&acc)[2][2][4][2], const pg8::Unit& u, int wr, int wc, int fr, int fq) const {
        const int row0 = u.pm * 256 + wr * 64 + fr, c0 = u.pn * 256 + wc * 32 + 8 * fq;
        if (u.pn < 4) grp_w(acc, row0, c0); else if (u.pn < 8) grp_a(acc, row0, c0); else if (u.pn < 10) grp_g(acc, row0, c0); else grp_l(acc, row0, c0);
    }
};
__device__ __forceinline__ void ph_lora(Frame& F) {
    pg8::Gemm g{(const bf16*)(F.ws + WS_A2), (const bf16*)(F.ws + WS_WLORA), MR, NLORA, KLORA, nullptr};
    pg8::StaticOrder S; S.init(MR, NLORA, F.G, (int)blockIdx.x);
    EpiLora E{F.ws, F.in};
    pg8::gemm_phase<EpiLora, pg8::StaticOrder, true, true, false>(F.lds, g, S, E);
}

__device__ __forceinline__ void ph_merge(Frame& F) {
    unsigned char* ws = F.ws; const int lane = F.lane;
    const bf16* ORf = (const bf16*)(ws + WS_ORWF); const bf16* ORb = (const bf16*)(ws + WS_ORWB); const bf16* OGf = (const bf16*)(ws + WS_OGLF); const bf16* OGb = (const bf16*)(ws + WS_OGLB);
    const bf16* R = (const bf16*)(ws + WS_RB); const bf16* V = (const bf16*)(ws + WS_VB); const bf16* KSUM = (const bf16*)(ws + WS_KSUM); const bf16* RWG = (const bf16*)(ws + WS_RWG);
    const bf16* P = (const bf16*)(ws + WS_P);
    bf16* YRW = (bf16*)(ws + WS_YRW); bf16* YGLA = (bf16*)(ws + WS_YGLA);
    float rk[8], gw[8], gbv[8], ggw[8], ggb[8];
    ld8(F.in[15] + 8 * lane, rk); ld8(F.in[16] + 8 * lane, gw); ld8(F.in[17] + 8 * lane, gbv); ld8(F.in[21] + 8 * lane, ggw); ld8(F.in[22] + 8 * lane, ggb);
    for (int m = F.gw; m < NLAT; m += F.NGW) {
        const size_t ro = (size_t)m * RWW + 8 * lane;
        {
            float a[8], b[8], o[8]; unp8(*(const v4u*)(ORf + ro), a); unp8(*(const v4u*)(ORb + ro), b);
            float s = 0.f;
#pragma unroll
            for (int e = 0; e < 8; ++e) { o[e] = a[e] + b[e]; s += o[e]; }
            s += __shfl_xor(s, 1); s += __shfl_xor(s, 2); s += __shfl_xor(s, 4);
            const float mean = s * (1.f / 64.f); float q = 0.f;
#pragma unroll
            for (int e = 0; e < 8; ++e) { o[e] -= mean; q += o[e] * o[e]; }
            q += __shfl_xor(q, 1); q += __shfl_xor(q, 2); q += __shfl_xor(q, 4);
            const float rstd = 1.f / sqrtf(q * (1.f / 64.f) + RW_GN_EPS);
            float r[8], v[8], ksm[8], g[8]; unp8(*(const v4u*)(R + ro), r); unp8(*(const v4u*)(V + ro), v); unp8(*(const v4u*)(KSUM + ro), ksm); unp8(*(const v4u*)(RWG + ro), g);
            float bs = 0.f;
#pragma unroll
            for (int e = 0; e < 8; ++e) bs += r[e] * ksm[e] * rk[e];
            bs += __shfl_xor(bs, 1); bs += __shfl_xor(bs, 2); bs += __shfl_xor(bs, 4);
            float y[8];
#pragma unroll
            for (int e = 0; e < 8; ++e) y[e] = (o[e] * rstd * gw[e] + gbv[e] + bs * v[e]) * g[e];
            *(v4u*)(YRW + ro) = pk8(y);
        }
        {
            float a[8], b[8], o[8]; unp8(*(const v4u*)(OGf + ro), a); unp8(*(const v4u*)(OGb + ro), b);
            float s = 0.f;
#pragma unroll
            for (int e = 0; e < 8; ++e) { o[e] = a[e] + b[e]; s += o[e]; }
            s += __shfl_xor(s, 1); s += __shfl_xor(s, 2); s += __shfl_xor(s, 4); s += __shfl_xor(s, 8);
            const float mean = s * (1.f / 128.f); float q = 0.f;
#pragma unroll
            for (int e = 0; e < 8; ++e) { o[e] -= mean; q += o[e] * o[e]; }
            q += __shfl_xor(q, 1); q += __shfl_xor(q, 2); q += __shfl_xor(q, 4); q += __shfl_xor(q, 8);
            const float rstd = 1.f / sqrtf(q * (1.f / 128.f) + LN_EPS);
            float og[8]; unp8(*(const v4u*)(P + (size_t)m * NP + C_OG + 8 * lane), og);
            float y[8];
#pragma unroll
            for (int e = 0; e < 8; ++e) y[e] = (o[e] * rstd * ggw[e] + ggb[e]) * siluf_(og[e]);
            *(v4u*)(YGLA + ro) = pk8(y);
        }
    }
}

template <int WHICH> struct EpiBranch {
    static constexpr bool PERM = true;
    bf16* Z; const bf16* P;
    __device__ __forceinline__ void operator()(const f32x4 (&acc)[2][2][4][2], const pg8::Unit& u, int wr, int wc, int fr, int fq) const {
        const int row0 = u.pm * 256 + wr * 64 + fr, col0 = u.pn * 256 + wc * 32 + 8 * fq;
#pragma unroll
        for (int ai = 0; ai < 2; ++ai)
#pragma unroll
            for (int m = 0; m < 4; ++m) { const size_t row = (size_t)(row0 + ai * 128 + m * 16);
#pragma unroll
                for (int bj = 0; bj < 2; ++bj) { const int c = col0 + bj * 128;
                    float g[8]; unp8(*(const v4u*)(P + row * NP + (WHICH ? C_GGLA : C_GRW) + c), g);
                    const f32x4 v0 = acc[ai][bj][m][0], v1 = acc[ai][bj][m][1];
                    float z[8];
#pragma unroll
                    for (int e = 0; e < 4; ++e) { z[e] = sigmoidf_(g[e]) * v0[e]; z[4 + e] = sigmoidf_(g[4 + e]) * v1[e]; }
                    if (WHICH) { float zo[8]; unp8(*(const v4u*)(Z + row * D + c), zo);
#pragma unroll
                        for (int e = 0; e < 8; ++e) z[e] += zo[e]; }
                    *(v4u*)(Z + row * D + c) = pk8(z); } }
    }
};
__device__ __forceinline__ void ph_branch(Frame& F) {
    pg8::StaticOrder S; S.init(NLAT, D, F.G, (int)blockIdx.x);
    { pg8::Gemm g{(const bf16*)(F.ws + WS_YRW), (const bf16*)(F.ws + WS_WBRRW), NLAT, D, RWW, nullptr};
      EpiBranch<0> E{(bf16*)(F.ws + WS_Z), (const bf16*)(F.ws + WS_P)};
      pg8::gemm_phase<EpiBranch<0>, pg8::StaticOrder, true, true, false>(F.lds, g, S, E); }
    { pg8::Gemm g{(const bf16*)(F.ws + WS_YGLA), (const bf16*)(F.ws + WS_WBRGLA), NLAT, D, RWW, nullptr};
      EpiBranch<1> E{(bf16*)(F.ws + WS_Z), (const bf16*)(F.ws + WS_P)};
      pg8::gemm_phase<EpiBranch<1>, pg8::StaticOrder, true, true, false>(F.lds, g, S, E); }
}
struct EpiOut {
    static constexpr bool PERM = false;
    float* out; const float* x; const float* mod;
    __device__ __forceinline__ void operator()(const f32x4 (&acc)[2][2][4][2], const pg8::Unit& u, int wr, int wc, int fr, int fq) const {
        const int row0 = u.pm * 256 + wr * 64 + fr, col0 = u.pn * 256 + wc * 32 + 4 * fq; const float* g1 = mod + (u.pm / (SEQ / 256)) * 6144 + 2048;
#pragma unroll
        for (int ai = 0; ai < 2; ++ai)
#pragma unroll
            for (int m = 0; m < 4; ++m) { const size_t ro = (size_t)(row0 + ai * 128 + m * 16) * D;
#pragma unroll
                for (int bj = 0; bj < 2; ++bj)
#pragma unroll
                    for (int n = 0; n < 2; ++n) { const int c = col0 + bj * 128 + n * 16;
                        *(f32x4*)(out + ro + c) = *(const f32x4*)(x + ro + c) * ALPHA + *(const f32x4*)(g1 + c) * acc[ai][bj][m][n]; } }
    }
};
__device__ __forceinline__ void ph_outproj(Frame& F) {
    pg8::Gemm g{(const bf16*)(F.ws + WS_Z), (const bf16*)(F.ws + WS_WOUT), NLAT, D, D, nullptr};
    pg8::StaticOrder S; S.init(NLAT, D, F.G, (int)blockIdx.x);
    EpiOut E{F.out, F.in[0], (const float*)(F.ws + WS_MOD)};
    pg8::gemm_phase<EpiOut, pg8::StaticOrder, true, true, false>(F.lds, g, S, E);
}
#endif

#if MS >= 3
constexpr int LP = 72, SLOTB = 64 * LP * 2, LPF = 68, AUX_OFF = 13 * SLOTB;
static_assert(AUX_OFF + 4096 <= MISC_OFF, "scan LDS map");
#define SLOT(n) ((LAS bf16*)(lds + (n) * SLOTB))
__device__ __forceinline__ int scan_row(int s, int b, int dir) {
    if (s < CTXL) return NLAT + b * CTXL + (dir ? (CTXL - 1 - s) : s);
    const int lt = s - CTXL; return b * SEQ + (dir ? (SEQ - 1 - lt) : lt);
}
__device__ __forceinline__ float bf2f(bf16 h) { return __builtin_bit_cast(float, (unsigned)h << 16); }
__device__ __forceinline__ v2u pack4(const f32x4 v) { v2u o; o.x = pk2(v[0], v[1]); o.y = pk2(v[2], v[3]); return o; }
__device__ __forceinline__ f32x4 unpack4(const v2u w) { return (f32x4){bflo(w.x), bfhi(w.x), bflo(w.y), bfhi(w.y)}; }
__device__ __forceinline__ f32x4 mm_tile(const LAS bf16* X, int r0, const LAS bf16* Y, int c0, int lane) {
    const int rr = lane & 15, q = lane >> 4;
    const LAS bf16* xp = X + (r0 + rr) * LP + 8 * q; const LAS bf16* yp = Y + (c0 + rr) * LP + 8 * q;
    const bf16x8 a0 = *(const LAS bf16x8*)xp, a1 = *(const LAS bf16x8*)(xp + 32), b0 = *(const LAS bf16x8*)yp, b1 = *(const LAS bf16x8*)(yp + 32);
    f32x4 acc = (f32x4){0.f, 0.f, 0.f, 0.f};
    acc = __builtin_amdgcn_mfma_f32_16x16x32_bf16(a0, b0, acc, 0, 0, 0);
    acc = __builtin_amdgcn_mfma_f32_16x16x32_bf16(a1, b1, acc, 0, 0, 0);
    return acc;
}
__device__ __forceinline__ float red8(float x) {
    x += __builtin_bit_cast(float, __builtin_amdgcn_update_dpp(0, __builtin_bit_cast(int, x), 0x141, 0xf, 0xf, false));
    x += __builtin_bit_cast(float, __builtin_amdgcn_update_dpp(0, __builtin_bit_cast(int, x), 0xB1, 0xf, 0xf, false));
    x += __builtin_bit_cast(float, __builtin_amdgcn_update_dpp(0, __builtin_bit_cast(int, x), 0x4E, 0xf, 0xf, false));
    return x;
}

__device__ __forceinline__ void s1_rwkv(Frame& F, int u) {
    const int sr = u / NCHUNK, c = u - sr * NCHUNK, rb = sr >> 4, rdir = (sr >> 3) & 1, rh = sr & 7;
    const bool emit = c >= CTXL / CH;
    LAS unsigned char* lds = F.lds; unsigned char* ws = F.ws;
    const int lane = F.lane, wave = F.wave, rr = lane & 15, q = lane >> 4;
    const bf16* RBp = (const bf16*)(ws + WS_RB); const bf16* VBp = (const bf16*)(ws + WS_VB); const bf16* KKp = (const bf16*)(ws + WS_KKB);
    const bf16* KMp = (const bf16*)(ws + (rdir ? WS_KMB : WS_KMF)); const bf16* BVp = (const bf16*)(ws + (rdir ? WS_BVB : WS_BVF)); const float* LWp = (const float*)(ws + (rdir ? WS_LWB : WS_LWF));
    LAS float* tot = (LAS float*)(lds + AUX_OFF); LAS float* gCs = tot + 512;
    {
        float lw[8], xr[8], xk[8], xa[8], xb[8], xv[8];
#pragma unroll
        for (int i = 0; i < 8; ++i) { const int row = scan_row(c * CH + 8 * wave + i, rb, rdir); const size_t base = (size_t)row * RWW + rh * 64 + lane;
            lw[i] = LWp[base]; xr[i] = bf2f(RBp[base]); xk[i] = bf2f(KMp[base]); xa[i] = -bf2f(KKp[base]); xb[i] = bf2f(BVp[base]); xv[i] = bf2f(VBp[base]); }
        float p[8]; p[0] = lw[0];
#pragma unroll
        for (int i = 1; i < 8; ++i) p[i] = p[i - 1] + lw[i];
        tot[wave * 64 + lane] = p[7];
        __syncthreads();
        float off = 0.f, all = 0.f;
#pragma unroll
        for (int w = 0; w < 8; ++w) { const float t = tot[w * 64 + lane]; all += t; off += (w < wave) ? t : 0.f; }
        if (wave == 0) gCs[lane] = __expf(all);
        float at[8], bb[8], kb[8];
#pragma unroll
        for (int i = 0; i < 8; ++i) { const float cum = off + p[i]; const float g = __expf(cum), gi = __expf(-cum), gp = __expf(cum - lw[i]), gc = __expf(all - cum);
            const int t = 8 * wave + i;
            at[i] = xa[i] * gp; bb[i] = xb[i] * gc; kb[i] = xk[i] * gc;
            SLOT(0)[t * LP + lane] = (bf16)f2bf(at[i]);
            SLOT(1)[t * LP + lane] = (bf16)f2bf(xr[i] * g);
            SLOT(2)[t * LP + lane] = (bf16)f2bf(xb[i] * gi);
            SLOT(3)[t * LP + lane] = (bf16)f2bf(xk[i] * gi); }
        *(LAS v4u*)(SLOT(4) + lane * LP + 8 * wave) = pk8(at);
        *(LAS v4u*)(SLOT(5) + lane * LP + 8 * wave) = pk8(xv);
        *(LAS v4u*)(SLOT(6) + lane * LP + 8 * wave) = pk8(bb);
        *(LAS v4u*)(SLOT(7) + lane * LP + 8 * wave) = pk8(kb);
        __syncthreads();
    }
    LAS float* Lp = (LAS float*)(lds + 8 * SLOTB);
#pragma unroll
    for (int tix = 0; tix < 2; ++tix) { const int ti = 2 * wave + tix, r0 = 16 * (ti >> 2), c0 = 16 * (ti & 3), ci = c0 + rr;
        { const f32x4 acc = mm_tile(SLOT(2), r0, SLOT(0), c0, lane);
#pragma unroll
            for (int e = 0; e < 4; ++e) { const int i = r0 + 4 * q + e; Lp[ci * LPF + (i & 7) * 8 + (i >> 3)] = (i < ci) ? acc[e] : 0.f; } }
        { f32x4 acc = mm_tile(SLOT(0), r0, SLOT(3), c0, lane);
#pragma unroll
            for (int e = 0; e < 4; ++e) acc[e] = (ci < r0 + 4 * q + e) ? acc[e] : 0.f;
            *(LAS v2u*)(SLOT(10) + ci * LP + r0 + 4 * q) = pack4(acc); }
        if (emit) {
            { f32x4 acc = mm_tile(SLOT(2), r0, SLOT(1), c0, lane);
#pragma unroll
                for (int e = 0; e < 4; ++e) acc[e] = (r0 + 4 * q + e <= ci) ? acc[e] : 0.f;
                *(LAS v2u*)(SLOT(11) + ci * LP + r0 + 4 * q) = pack4(acc); }
            { f32x4 acc = mm_tile(SLOT(3), r0, SLOT(1), c0, lane);
#pragma unroll
                for (int e = 0; e < 4; ++e) acc[e] = (r0 + 4 * q + e <= ci) ? acc[e] : 0.f;
                *(LAS v2u*)(SLOT(12) + ci * LP + r0 + 4 * q) = pack4(acc); }
        }
    }
    __syncthreads();
    {
        const int j = 8 * wave + (lane >> 3), s = lane & 7;
        float Tr[8] = {0.f, 0.f, 0.f, 0.f, 0.f, 0.f, 0.f, 0.f};
#pragma unroll
        for (int t = 0; t < 64; ++t) {
            const f32x4 l0 = *(const LAS f32x4*)(Lp + t * LPF + s * 8), l1 = *(const LAS f32x4*)(Lp + t * LPF + s * 8 + 4);
            float acc = (l0.x * Tr[0] + l0.y * Tr[1]) + (l0.z * Tr[2] + l0.w * Tr[3]) + ((l1.x * Tr[4] + l1.y * Tr[5]) + (l1.z * Tr[6] + l1.w * Tr[7]));
            acc = red8(acc);
            const float val = acc + ((t == j) ? 1.f : 0.f);
            Tr[t >> 3] = (s == (t & 7)) ? val : Tr[t >> 3];
            SLOT(0)[t * LP + j] = (bf16)f2bf(val);
        }
    }
    __syncthreads();
#pragma unroll
    for (int tix = 0; tix < 2; ++tix) { const int ti = 2 * wave + tix, r0 = 16 * (ti >> 2), c0 = 16 * (ti & 3), ci = c0 + rr;
        { const f32x4 acc = mm_tile(SLOT(0), r0, SLOT(4), c0, lane); *(LAS v2u*)(SLOT(2) + ci * LP + r0 + 4 * q) = pack4(acc); }
        { const f32x4 acc = mm_tile(SLOT(0), r0, SLOT(10), c0, lane); *(LAS v2u*)(SLOT(3) + ci * LP + r0 + 4 * q) = pack4(acc); }
    }
    __syncthreads();
    bf16* RH = (bf16*)(ws + WS_RH) + (size_t)u * 4096; bf16* GT = (bf16*)((unsigned char*)F.out + OUT_GT) + (size_t)u * 4096;
#pragma unroll
    for (int tix = 0; tix < 2; ++tix) { const int ti = 2 * wave + tix, tr = ti >> 2, r0 = 16 * tr, c0 = 16 * (ti & 3), ci = c0 + rr;
        const int pos = (tr >> 1) * 32 + q * 8 + 4 * (tr & 1);
        if (emit) {
            { f32x4 acc = mm_tile(SLOT(2), r0, SLOT(11), c0, lane);
                acc += unpack4(*(const LAS v2u*)(SLOT(1) + ci * LP + r0 + 4 * q));
                *(v2u*)(RH + ci * 64 + pos) = pack4(acc); }
            { f32x4 acc = mm_tile(SLOT(3), r0, SLOT(11), c0, lane);
                acc += unpack4(*(const LAS v2u*)(SLOT(12) + ci * LP + r0 + 4 * q));
                *(LAS v2u*)(SLOT(4) + ci * LP + r0 + 4 * q) = pack4(acc); }
        }
        { f32x4 acc = mm_tile(SLOT(2), r0, SLOT(6), c0, lane);
            const float gc = gCs[ci];
#pragma unroll
            for (int e = 0; e < 4; ++e) acc[e] += (r0 + 4 * q + e == ci) ? gc : 0.f;
            *(v2u*)(GT + ci * 64 + pos) = pack4(acc); }
    }
    __syncthreads();
    bf16* YL = (bf16*)(ws + WS_YL) + (size_t)u * 4096;
#pragma unroll
    for (int tix = 0; tix < 2; ++tix) { const int ti = 2 * wave + tix, r0 = 16 * (ti >> 2), c0 = 16 * (ti & 3), ci = c0 + rr;
        if (emit) { const f32x4 acc = mm_tile(SLOT(5), r0, SLOT(4), c0, lane); *(v2u*)(YL + ci * 64 + r0 + 4 * q) = pack4(acc); }
        { f32x4 acc = mm_tile(SLOT(3), r0, SLOT(6), c0, lane);
            acc += unpack4(*(const LAS v2u*)(SLOT(7) + ci * LP + r0 + 4 * q));
            *(LAS v2u*)(SLOT(8) + ci * LP + r0 + 4 * q) = pack4(acc); }
    }
    __syncthreads();
    float* HH = (float*)(ws + WS_HH) + (size_t)u * 4096;
#pragma unroll
    for (int tix = 0; tix < 2; ++tix) { const int ti = 2 * wave + tix, r0 = 16 * (ti >> 2), c0 = 16 * (ti & 3), ci = c0 + rr;
        const f32x4 acc = mm_tile(SLOT(8), r0, SLOT(5), c0, lane);
        *(f32x4*)(HH + ci * 64 + r0 + 4 * q) = acc; }
    __syncthreads();
}

__device__ __forceinline__ void s1_gla(Frame& F, int u) {
    const int sg = u / NCHUNK, c = u - sg * NCHUNK, gb = sg >> 3, gdir = (sg >> 2) & 1, gh = sg & 3;
    const bool emit = c >= CTXL / CH;
    LAS unsigned char* lds = F.lds; unsigned char* ws = F.ws;
    const int lane = F.lane, wave = F.wave, rr = lane & 15, q = lane >> 4;
    const bf16* Qp = (const bf16*)(ws + WS_QGB); const bf16* Kp = (const bf16*)(ws + WS_KGB); const bf16* Vp = (const bf16*)(ws + WS_VGB); const float* LAp = (const float*)(ws + (gdir ? WS_LAB : WS_LAF));
    LAS float* tot = (LAS float*)(lds + AUX_OFF);
    bf16* QE = (bf16*)((unsigned char*)F.out + OUT_QE) + (size_t)u * 4096;
    {
        float la[8], xq[8], xk[8], v0[8], v1[8];
#pragma unroll
        for (int i = 0; i < 8; ++i) { const int row = scan_row(c * CH + 8 * wave + i, gb, gdir); const size_t b2 = (size_t)row * 256 + gh * 64 + lane, b5 = (size_t)row * RWW + gh * 128 + lane;
            la[i] = LAp[b2]; xq[i] = bf2f(Qp[b2]); xk[i] = bf2f(Kp[b2]); v0[i] = bf2f(Vp[b5]); v1[i] = bf2f(Vp[b5 + 64]); }
        float p[8]; p[0] = la[0];
#pragma unroll
        for (int i = 1; i < 8; ++i) p[i] = p[i - 1] + la[i];
        tot[wave * 64 + lane] = p[7];
        __syncthreads();
        float off = 0.f, all = 0.f;
#pragma unroll
        for (int w = 0; w < 8; ++w) { const float t = tot[w * 64 + lane]; all += t; off += (w < wave) ? t : 0.f; }
        if (wave == 0) ((float*)(ws + WS_DD))[(size_t)u * 64 + lane] = __expf(all);
        float kl[8];
#pragma unroll
        for (int i = 0; i < 8; ++i) { const float cum = off + p[i]; const int t = 8 * wave + i;
            const bf16 qe = (bf16)f2bf(xq[i] * __expf(cum));
            SLOT(0)[t * LP + lane] = qe;
            if (emit) QE[t * 64 + lane] = qe;
            SLOT(1)[t * LP + lane] = (bf16)f2bf(xk[i] * __expf(-cum));
            kl[i] = xk[i] * __expf(all - cum); }
        *(LAS v4u*)(SLOT(2) + lane * LP + 8 * wave) = pk8(kl);
        *(LAS v4u*)(SLOT(3) + lane * LP + 8 * wave) = pk8(v0);
        *(LAS v4u*)(SLOT(3) + (64 + lane) * LP + 8 * wave) = pk8(v1);
        __syncthreads();
    }
    if (emit) {
#pragma unroll
        for (int tix = 0; tix < 2; ++tix) { const int ti = 2 * wave + tix, r0 = 16 * (ti >> 2), c0 = 16 * (ti & 3), ci = c0 + rr;
            f32x4 acc = mm_tile(SLOT(1), r0, SLOT(0), c0, lane);
#pragma unroll
            for (int e = 0; e < 4; ++e) acc[e] = (r0 + 4 * q + e <= ci) ? acc[e] : 0.f;
            *(LAS v2u*)(SLOT(5) + ci * LP + r0 + 4 * q) = pack4(acc); }
    }
    float* KV = (float*)(ws + WS_KV) + (size_t)u * 8192;
#pragma unroll
    for (int tix = 0; tix < 4; ++tix) { const int ti = 4 * wave + tix, r0 = 16 * (ti >> 3), c0 = 16 * (ti & 7), ci = c0 + rr;
        const f32x4 acc = mm_tile(SLOT(2), r0, SLOT(3), c0, lane);
        *(f32x4*)(KV + ci * 64 + r0 + 4 * q) = acc; }
    __syncthreads();
    if (emit) {
        bf16* IN = (bf16*)(ws + WS_INTRA) + (size_t)u * 8192;
#pragma unroll
        for (int tix = 0; tix < 4; ++tix) { const int ti = 4 * wave + tix, r0 = 16 * (ti >> 2), c0 = 16 * (ti & 3), ci = c0 + rr;
            const f32x4 acc = mm_tile(SLOT(3), r0, SLOT(5), c0, lane);
            *(v2u*)(IN + ci * 128 + r0 + 4 * q) = pack4(acc); }
    }
    __syncthreads();
}

__device__ __forceinline__ void ph_scan1(Frame& F) {
    for (int u = blockIdx.x; u < NU_RW; u += F.G) s1_rwkv(F, u);
    for (int u = blockIdx.x; u < NU_GL; u += F.G) s1_gla(F, u);
}

__device__ __forceinline__ bf16x8 pack_frag(const f32x4 lo, const f32x4 hi) {
    v4u w; w.x = pk2(lo[0], lo[1]); w.y = pk2(lo[2], lo[3]); w.z = pk2(hi[0], hi[1]); w.w = pk2(hi[2], hi[3]); return __builtin_bit_cast(bf16x8, w);
}
__device__ __forceinline__ void ph_scan2(Frame& F) {
    const int lane = F.lane, rr = lane & 15, q = lane >> 4; unsigned char* ws = F.ws;
    if (F.wave == 0) {
        const int it = blockIdx.x, sr = it >> 2, v0 = 16 * (it & 3), rb = sr >> 4, rdir = (sr >> 3) & 1, rh = sr & 7;
        const bf16* GTb = (const bf16*)((const unsigned char*)F.out + OUT_GT); const float* HHb = (const float*)(ws + WS_HH);
        const bf16* RHb = (const bf16*)(ws + WS_RH); const bf16* YLb = (const bf16*)(ws + WS_YL);
        bf16* O = (bf16*)(ws + (rdir ? WS_ORWB : WS_ORWF));
        f32x4 S[4];
#pragma unroll
        for (int m = 0; m < 4; ++m) S[m] = (f32x4){0.f, 0.f, 0.f, 0.f};
        bf16x8 Gf[4][2]; f32x4 Hf[4];
        { const size_t ub = (size_t)(sr * NCHUNK) * 4096;
#pragma unroll
          for (int m = 0; m < 4; ++m) { Gf[m][0] = *(const bf16x8*)(GTb + ub + (16 * m + rr) * 64 + q * 8); Gf[m][1] = *(const bf16x8*)(GTb + ub + (16 * m + rr) * 64 + 32 + q * 8);
              Hf[m] = *(const f32x4*)(HHb + ub + (v0 + rr) * 64 + 16 * m + 4 * q); } }
#pragma unroll 1
        for (int c = 0; c < NCHUNK; ++c) {
            const size_t ub = (size_t)(sr * NCHUNK + c) * 4096;
            bf16x8 Gn[4][2]; f32x4 Hn[4];
            { const size_t un = (size_t)(sr * NCHUNK + (c + 1 < NCHUNK ? c + 1 : c)) * 4096;
#pragma unroll
              for (int m = 0; m < 4; ++m) { Gn[m][0] = *(const bf16x8*)(GTb + un + (16 * m + rr) * 64 + q * 8); Gn[m][1] = *(const bf16x8*)(GTb + un + (16 * m + rr) * 64 + 32 + q * 8);
                  Hn[m] = *(const f32x4*)(HHb + un + (v0 + rr) * 64 + 16 * m + 4 * q); } }
            const bf16x8 Sf0 = pack_frag(S[0], S[1]), Sf1 = pack_frag(S[2], S[3]);
            if (c >= CTXL / CH) {
#pragma unroll
                for (int tt = 0; tt < 4; ++tt) {
                    const int t = 16 * tt + rr;
                    const bf16x8 R0 = *(const bf16x8*)(RHb + ub + t * 64 + q * 8), R1 = *(const bf16x8*)(RHb + ub + t * 64 + 32 + q * 8);
                    f32x4 acc = unpack4(*(const v2u*)(YLb + ub + t * 64 + v0 + 4 * q));
                    acc = __builtin_amdgcn_mfma_f32_16x16x32_bf16(Sf0, R0, acc, 0, 0, 0);
                    acc = __builtin_amdgcn_mfma_f32_16x16x32_bf16(Sf1, R1, acc, 0, 0, 0);
                    const int row = scan_row(c * CH + t, rb, rdir);
                    *(v2u*)(O + (size_t)row * RWW + rh * 64 + v0 + 4 * q) = pack4(acc);
                }
            }
#pragma unroll
            for (int m = 0; m < 4; ++m) { f32x4 acc = Hf[m];
                acc = __builtin_amdgcn_mfma_f32_16x16x32_bf16(Gf[m][0], Sf0, acc, 0, 0, 0);
                acc = __builtin_amdgcn_mfma_f32_16x16x32_bf16(Gf[m][1], Sf1, acc, 0, 0, 0);
                S[m] = acc; }
#pragma unroll
            for (int m = 0; m < 4; ++m) { Gf[m][0] = Gn[m][0]; Gf[m][1] = Gn[m][1]; Hf[m] = Hn[m]; }
        }
    } else if (F.wave == 1) {
        const int it = blockIdx.x, sg = it >> 3, v0 = 16 * (it & 7), gb = sg >> 3, gdir = (sg >> 2) & 1, gh = sg & 3;
        const bf16* QEb = (const bf16*)((const unsigned char*)F.out + OUT_QE); const bf16* INb = (const bf16*)(ws + WS_INTRA);
        const float* KVb = (const float*)(ws + WS_KV); const float* DDb = (const float*)(ws + WS_DD);
        bf16* O = (bf16*)(ws + (gdir ? WS_OGLB : WS_OGLF));
        f32x4 S[2][2];
#pragma unroll
        for (int s = 0; s < 2; ++s) { S[s][0] = (f32x4){0.f, 0.f, 0.f, 0.f}; S[s][1] = (f32x4){0.f, 0.f, 0.f, 0.f}; }
#pragma unroll 1
        for (int c = 0; c < NCHUNK; ++c) {
            const size_t ug = (size_t)(sg * NCHUNK + c);
            f32x4 kv[2][2], dd[2][2];
#pragma unroll
            for (int s = 0; s < 2; ++s)
#pragma unroll
                for (int h = 0; h < 2; ++h) { kv[s][h] = *(const f32x4*)(KVb + ug * 8192 + (v0 + rr) * 64 + 32 * s + 8 * q + 4 * h); dd[s][h] = *(const f32x4*)(DDb + ug * 64 + 32 * s + 8 * q + 4 * h); }
            if (c >= CTXL / CH) {
                const bf16x8 Sf0 = pack_frag(S[0][0], S[0][1]), Sf1 = pack_frag(S[1][0], S[1][1]);
#pragma unroll
                for (int tt = 0; tt < 4; ++tt) {
                    const int t = 16 * tt + rr;
                    const bf16x8 Q0 = *(const bf16x8*)(QEb + ug * 4096 + t * 64 + q * 8), Q1 = *(const bf16x8*)(QEb + ug * 4096 + t * 64 + 32 + q * 8);
                    f32x4 acc = unpack4(*(const v2u*)(INb + ug * 8192 + t * 128 + v0 + 4 * q));
                    acc = __builtin_amdgcn_mfma_f32_16x16x32_bf16(Sf0, Q0, acc, 0, 0, 0);
                    acc = __builtin_amdgcn_mfma_f32_16x16x32_bf16(Sf1, Q1, acc, 0, 0, 0);
                    const int row = scan_row(c * CH + t, gb, gdir);
                    *(v2u*)(O + (size_t)row * RWW + gh * 128 + v0 + 4 * q) = pack4(acc);
                }
            }
#pragma unroll
            for (int s = 0; s < 2; ++s)
#pragma unroll
                for (int h = 0; h < 2; ++h) S[s][h] = S[s][h] * dd[s][h] + kv[s][h];
        }
    }
}
#endif

#ifndef ML
#define ML 0
#endif
enum Phase { PH_PROLOGUE = 0, PH_A1, PH_INPROJ, PH_FEAT, PH_LORA, PH_SCAN1, PH_SCAN2, PH_MERGE, PH_BRANCH, PH_OUTPROJ, PH_LN1, PH_ROUTER, PH_ROUTE, PH_SCATTER, PH_EXP1, PH_EXP2, PH_FINAL, PH_COUNT };

__global__ void __launch_bounds__(NTHR, 2) mega(Args args) {
    extern __shared__ __attribute__((aligned(16))) unsigned char lds_raw[];
    Frame F;
    F.lds = (LAS unsigned char*)lds_raw;
    F.tid = threadIdx.x; F.lane = F.tid & 63; F.wave = __builtin_amdgcn_readfirstlane(F.tid >> 6);
    F.G = gridDim.x; F.gw = blockIdx.x * NWAVES + F.wave; F.NGW = F.G * NWAVES;
    F.in = args.in; F.out = args.out; F.ws = args.ws; F.ctl = (unsigned*)(args.ws + WS_CTL);
    volatile LAS unsigned* MISC = (volatile LAS unsigned*)(F.lds + MISC_OFF);
    if (F.tid < 64) MISC[F.tid] = 0u;
    __syncthreads();
    XcdBarrier bar; bar.bar = F.ctl + CW_BAR; bar.x = 0; bar.st = nullptr;
#if !ML
    bar = xcd_barrier_post(F.ctl + CW_BAR, MISC + 8);
#endif
    const int lo = args.ph_lo, hi = args.ph_hi;
#define IN(k) (lo <= (k) && (k) < hi)
#ifndef DUP
#define DUP -1
#endif
#define RUN(k, call) do { if (IN(k)) { call; GRID_BAR(); if (DUP == (k)) { call; GRID_BAR(); } } } while (0)
#if ML
#define GRID_BAR() do { } while (0)
#else
#define GRID_BAR() xcd_barrier(bar)
#endif

#if MS >= 2
    RUN(PH_PROLOGUE, ph_prologue(F));
#endif
#if MS >= 3
    RUN(PH_A1, ph_a1(F));
    RUN(PH_INPROJ, ph_inproj(F));
    RUN(PH_FEAT, ph_feat(F));
    RUN(PH_LORA, ph_lora(F));
    RUN(PH_SCAN1, ph_scan1(F));
    RUN(PH_SCAN2, ph_scan2(F));
    RUN(PH_MERGE, ph_merge(F));
    RUN(PH_BRANCH, ph_branch(F));
    RUN(PH_OUTPROJ, ph_outproj(F));
#else
    RUN(PH_OUTPROJ, ph_x1pre_nomix(F));
#endif
    RUN(PH_LN1, ph_ln1(F));
#if MS >= 2
    RUN(PH_ROUTER, ph_router(F));
    RUN(PH_ROUTE, ph_route(F));
    RUN(PH_SCATTER, ph_scatter(F));
    RUN(PH_EXP1, ph_exp1(F));
    RUN(PH_EXP2, ph_exp2(F));
#endif
    if (IN(PH_FINAL)) { ph_final(F); }
#undef IN
}

extern "C" void kernel_launch(void* const* d_in, const int* in_sizes, int n_in, void* d_out, int out_size, void* d_ws, size_t ws_size, hipStream_t stream) {
    static int grid = 0;
    if (grid == 0) {
        if (n_in != 36 || out_size != NLAT * D || ws_size < WS_END) { fprintf(stderr, "kernel_launch: unexpected problem shape (n_in %d, out %d)\n", n_in, out_size); grid = -1; return; }
        int dev = 0, cus = 0, per_cu = 0;
        if (hipGetDevice(&dev) != hipSuccess || hipDeviceGetAttribute(&cus, hipDeviceAttributeMultiprocessorCount, dev) != hipSuccess) { grid = -1; return; }
        if (hipFuncSetAttribute((const void*)mega, hipFuncAttributeMaxDynamicSharedMemorySize, LDS_BYTES) != hipSuccess) { fprintf(stderr, "kernel_launch: hipFuncSetAttribute failed\n"); grid = -1; return; }
        if (hipOccupancyMaxActiveBlocksPerMultiprocessor(&per_cu, (const void*)mega, NTHR, LDS_BYTES) != hipSuccess || per_cu < 1) { fprintf(stderr, "kernel_launch: occupancy query says %d\n", per_cu); }
        (void)hipGetLastError();
        grid = cus > 0 ? cus : 256;
        if (grid > 256) grid = 256;
    }
    if (grid < 0) return;
    (void)hipMemsetAsync((char*)d_ws + WS_CTL, 0, CTL_ZERO_BYTES, stream);
    Args a{};
    for (int i = 0; i < 36; ++i) a.in[i] = (const float*)d_in[i];
    a.out = (float*)d_out; a.ws = (unsigned char*)d_ws;
#if ML
    for (int p = 0; p < PH_COUNT; ++p) { a.ph_lo = p; a.ph_hi = p + 1; hipLaunchKernelGGL(mega, dim3(grid), dim3(NTHR), LDS_BYTES, stream, a); }
#else
    a.ph_lo = 0; a.ph_hi = PH_COUNT;
    hipLaunchKernelGGL(mega, dim3(grid), dim3(NTHR), LDS_BYTES, stream, a);
#endif
}
```

```cpp
#include <hip/hip_runtime.h>
#include <cstdio>
#include <cstdint>

#ifndef MS
#define MS 3
#endif

#define GAS __attribute__((address_space(1)))
#define LAS __attribute__((address_space(3)))
typedef unsigned short bf16;
typedef unsigned v4u __attribute__((ext_vector_type(4)));
typedef unsigned v2u __attribute__((ext_vector_type(2)));
typedef float f32x4 __attribute__((ext_vector_type(4)));
typedef float f32x2 __attribute__((ext_vector_type(2)));
typedef short bf16x8 __attribute__((ext_vector_type(8)));
#define LDS_WAIT() asm volatile("s_waitcnt lgkmcnt(0)" ::: "memory")
#define VM_WAIT() asm volatile("s_waitcnt vmcnt(0)" ::: "memory")

constexpr int D = 1024, NB = 4, SEQ = 8192, CTXL = 256, GRIDW = 64, GRIDH = 128;
constexpr int NLAT = NB * SEQ, NCTX = NB * CTXL, MR = NLAT + NCTX;
constexpr int RWW = 512, RWH = 8, HD = 64;
constexpr int C_R = 0, C_K = 512, C_V = 1024, C_PW = 1536, C_PA = 1568, C_PG = 1600, C_Q = 1696, C_KG = 1952, C_VG = 2208, C_PGL = 2720, C_OG = 2736, C_GRW = 3248, C_GGLA = 4272;
constexpr int IN_COLS = 5296, NP = 5376;
constexpr int NE = 256, TOPK = 8, FF = 256;
constexpr float LN_EPS = 1e-5f, RW_GN_EPS = 64e-5f;
constexpr float ALPHA = 1.189207115f;
constexpr int NLORA = 3072, KLORA = 256;
constexpr int MAXTILES = 1280, SH_ROW0 = MAXTILES * 256, NROWS_E = SH_ROW0 + NLAT;

namespace pg8 {
#define PG8_LAS __attribute__((address_space(3)))
typedef unsigned short bf16_t;
typedef unsigned u32x4 __attribute__((ext_vector_type(4)));
typedef unsigned u32x2 __attribute__((ext_vector_type(2)));
constexpr int BM = 256, BK = 64, HALF = 128, HTB = HALF * BK * 2, STAGE_BYTES = 8 * HTB, NXCD = 8, WGM = 8;
constexpr int IDX_OFF = STAGE_BYTES, IDX_UNITS = 12;

__host__ __device__ __forceinline__ int lds_byte(int r, int c) { const int st = (r >> 4) * 2 + (c >> 5), rr = r & 15, cc = c & 31, ob = rr * 64 + cc * 2; return st * 1024 + (ob ^ (((ob >> 9) & 1) << 5)); }
__host__ __device__ __forceinline__ void stage_rc(int b, int& R, int& C) { const int st = b / 1024, sb = b % 1024, swz = sb ^ (((sb >> 9) & 1) << 5); R = (st >> 1) * 16 + swz / 64; C = (st & 1) * 32 + (swz % 64) / 2; }
__host__ __device__ __forceinline__ int perm32(int rho) { const int n = rho >> 4, i = rho & 15; return 8 * (i >> 2) + 4 * n + (i & 3); }

struct Unit { int pm, pn, e, j; };
struct Gemm { const bf16_t* A; const bf16_t* Bt; int M, N, K; const int* rowidx; };

struct StaticOrder {
    int nM, nN, nwg, G, c;
    __host__ __device__ void init(int M, int N, int G_, int c_) { nM = M / BM; nN = N / BM; nwg = nM * nN; G = G_; c = c_; }
    __host__ __device__ bool next(int i, Unit& u) const {
        const long L = (long)i * G + c; if (L >= nwg) return false;
        int wgid = (int)L; { const int q = nwg / NXCD, r = nwg % NXCD, xcd = wgid % NXCD, off = wgid / NXCD; wgid = (xcd < r ? xcd * (q + 1) : r * (q + 1) + (xcd - r) * q) + off; }
        const int nig = WGM * nN, gid = wgid / nig, fm = gid * WGM, gsz = (nM - fm) < WGM ? (nM - fm) : WGM;
        u.pm = fm + ((wgid % nig) % gsz); u.pn = (wgid % nig) / gsz; u.e = 0; u.j = u.pn; return true;
    }
};
struct MoeOrder {
    int nN, G, c, NT; const int* tile_e;
    __device__ bool next(int i, Unit& u) const {
        const int L = i * G + c; const int total = (NT + NLAT / 256) * nN; if (L >= total) return false;
        const int tile = L / nN, j = L - tile * nN; int e, pm;
        if (tile < NT) { e = tile_e[tile]; pm = tile; } else { e = NE; pm = MAXTILES + (tile - NT); }
        u.pm = pm; u.pn = e * nN + j; u.e = e; u.j = j; return true;
    }
};

__device__ __forceinline__ unsigned cvt_pk_bf16(float lo, float hi) { unsigned r; asm volatile("v_cvt_pk_bf16_f32 %0, %1, %2" : "=v"(r) : "v"(lo), "v"(hi)); return r; }

template <class Epi, class Sched, bool ALIGN_EPI, bool SP2, bool GATHER>
__device__ __forceinline__ void gemm_phase(PG8_LAS unsigned char* lds, const Gemm g, const Sched& S, const Epi& E) {
    const int tid = threadIdx.x, wid = __builtin_amdgcn_readfirstlane(tid >> 6), lane = tid & 63, wr = wid >> 2, wc = wid & 3, fr = lane & 15, fq = lane >> 4;
    const int K = g.K, nt = K / BK;
    const size_t kstep = (size_t)(BK * 2);
    const size_t hstep = (size_t)HALF * K * 2;
    const size_t tstep = 2 * hstep;
    unsigned voffB[2]; unsigned va[2][2];
#pragma unroll
    for (int i = 0; i < 2; ++i) { int R, C; stage_rc(tid * 16 + i * 8192, R, C); const int Rb = Epi::PERM ? ((R & ~31) + perm32(R & 31)) : R;
        voffB[i] = (unsigned)(Rb * K + C) * 2u;
        va[0][i] = (unsigned)(R * K + C) * 2u; va[1][i] = va[0][i]; }
    const size_t ah = GATHER ? (size_t)0 : hstep;
#define PG8_GOFF(dst, ub) do { _Pragma("unroll") for (int _h = 0; _h < 2; ++_h) _Pragma("unroll") for (int _i = 0; _i < 2; ++_i) { int _R, _C; stage_rc(tid * 16 + _i * 8192, _R, _C); \
        dst[_h][_i] = (unsigned)(idxt[(ub) * 256 + _h * 128 + _R] * K + _C) * 2u; } } while (0)
    const unsigned ldsw = (unsigned)wid * 1024u;
    const int aoff = lds_byte(wr * 64 + fr, fq * 8), boff = lds_byte(wc * 32 + fr, fq * 8);
    PG8_LAS int* idxt = (PG8_LAS int*)(lds + IDX_OFF);
#define PG8_SA(b, h) (((b) * 2 + (h)) * HTB)
#define PG8_SB(b, h) ((4 + (b) * 2 + (h)) * HTB)
#define PG8_STAGE(bufoff, gbase, voff) do { _Pragma("unroll") for (int _i = 0; _i < 2; ++_i) \
        __builtin_amdgcn_global_load_lds((const unsigned*)((const char*)(gbase) + (voff)[_i]), (PG8_LAS unsigned*)(lds + (bufoff) + ldsw + _i * 8192), 16, 0, 0); } while (0)
#define PG8_LDA(dst, b, h) do { _Pragma("unroll") for (int m = 0; m < 4; ++m) _Pragma("unroll") for (int k = 0; k < 2; ++k) dst[m][k] = *(const PG8_LAS bf16x8*)(lds + PG8_SA(b, h) + aoff + m * 2048 + k * 1024); } while (0)
#define PG8_LDB(dst, b, h) do { _Pragma("unroll") for (int n = 0; n < 2; ++n) _Pragma("unroll") for (int k = 0; k < 2; ++k) dst[n][k] = *(const PG8_LAS bf16x8*)(lds + PG8_SB(b, h) + boff + n * 2048 + k * 1024); } while (0)
#define PG8_MMA(ai, bj, At, Bt) do { __builtin_amdgcn_s_setprio(1); _Pragma("unroll") for (int m = 0; m < 4; ++m) _Pragma("unroll") for (int n = 0; n < 2; ++n) _Pragma("unroll") for (int k = 0; k < 2; ++k) \
        acc[ai][bj][m][n] = __builtin_amdgcn_mfma_f32_16x16x32_bf16(Bt[n][k], At[m][k], acc[ai][bj][m][n], 0, 0, 0); __builtin_amdgcn_s_setprio(0); } while (0)
#define PG8_WAIT_V(n) asm volatile("s_waitcnt vmcnt(" #n ")" ::: "memory")
#define PG8_WAIT_L(n) asm volatile("s_waitcnt lgkmcnt(" #n ")" ::: "memory")
#define PG8_BAR __builtin_amdgcn_s_barrier()
#define PG8_SCHED __builtin_amdgcn_sched_barrier(0)
    Unit cur, nxt; int ui = 0;
    if (!S.next(0, cur)) return;
    if constexpr (GATHER) {
        Unit uu;
        for (int i = 0; i < IDX_UNITS; ++i) { if (!S.next(i, uu)) break; if (tid < 256) idxt[i * 256 + tid] = g.rowidx[(size_t)uu.pm * 256 + tid]; }
        asm volatile("s_waitcnt vmcnt(0) lgkmcnt(0)" ::: "memory"); PG8_BAR; asm volatile("" ::: "memory");
        PG8_GOFF(va, 0);
    }
    f32x4 acc[2][2][4][2];
#pragma unroll
    for (int a = 0; a < 2; ++a)
#pragma unroll
        for (int b = 0; b < 2; ++b)
#pragma unroll
            for (int m = 0; m < 4; ++m)
#pragma unroll
                for (int n = 0; n < 2; ++n) acc[a][b][m][n] = (f32x4){0.f, 0.f, 0.f, 0.f};
    bf16x8 At[4][2], B0[2][2], B1[2][2];
    const char* cA = (const char*)g.A + (GATHER ? (size_t)0 : (size_t)cur.pm * tstep); const char* cB = (const char*)g.Bt + (size_t)cur.pn * tstep;
    if constexpr (SP2) {
        PG8_STAGE(PG8_SB(0, 0), cB, voffB); PG8_STAGE(PG8_SB(0, 1), cB + hstep, voffB); PG8_STAGE(PG8_SA(0, 0), cA, va[0]); PG8_STAGE(PG8_SA(0, 1), cA + ah, va[1]);
        if (wr == 1) PG8_BAR;
        PG8_WAIT_V(2); PG8_BAR;
        PG8_STAGE(PG8_SB(1, 0), cB + kstep, voffB); PG8_STAGE(PG8_SA(1, 0), cA + kstep, va[0]); PG8_STAGE(PG8_SB(1, 1), cB + hstep + kstep, voffB);
        PG8_WAIT_V(6); PG8_BAR;
    } else {
        PG8_STAGE(PG8_SB(0, 0), cB, voffB); PG8_STAGE(PG8_SA(0, 0), cA, va[0]); PG8_STAGE(PG8_SB(0, 1), cB + hstep, voffB); PG8_STAGE(PG8_SA(0, 1), cA + ah, va[1]);
        if (wr == 1) PG8_BAR;
        PG8_WAIT_V(4); PG8_BAR;
        PG8_STAGE(PG8_SB(1, 0), cB + kstep, voffB); PG8_STAGE(PG8_SA(1, 0), cA + kstep, va[0]); PG8_STAGE(PG8_SB(1, 1), cB + hstep + kstep, voffB);
        PG8_WAIT_V(6); PG8_BAR;
    }
    for (;;) {
        const bool has_next = S.next(ui + 1, nxt);
        const char* nA = has_next ? (const char*)g.A + (GATHER ? (size_t)0 : (size_t)nxt.pm * tstep) : cA; const char* nB = has_next ? (const char*)g.Bt + (size_t)nxt.pn * tstep : cB;
        const int ubn = (has_next && ui + 1 < IDX_UNITS) ? (ui + 1) : ui;
#pragma unroll 1
        for (int t = 0; t < nt; t += 2) {
            const bool last = (t == nt - 2);
            const char* a1 = cA + (size_t)(t + 1) * kstep;
            const char* a2 = last ? nA : cA + (size_t)(t + 2) * kstep; const char* b2 = last ? nB : cB + (size_t)(t + 2) * kstep;
            const char* a3 = a2 + kstep; const char* b3 = b2 + kstep;
            unsigned v2[2][2];
#pragma unroll
            for (int h = 0; h < 2; ++h)
#pragma unroll
                for (int i = 0; i < 2; ++i) v2[h][i] = va[h][i];
            if constexpr (GATHER) { if (last) PG8_GOFF(v2, ubn); }
            if constexpr (SP2) {
            PG8_LDB(B0, 0, 0); PG8_LDB(B1, 0, 1); PG8_SCHED; PG8_LDA(At, 0, 0); PG8_STAGE(PG8_SA(1, 1), a1 + ah, va[1]);
            PG8_WAIT_V(8); PG8_WAIT_L(0); PG8_BAR; PG8_MMA(0, 0, At, B0); PG8_MMA(0, 1, At, B1); PG8_BAR; PG8_SCHED;
            PG8_LDA(At, 0, 1); PG8_STAGE(PG8_SB(0, 0), b2, voffB); PG8_STAGE(PG8_SB(0, 1), b2 + hstep, voffB); PG8_STAGE(PG8_SA(0, 0), a2, v2[0]);
            PG8_WAIT_V(8); PG8_WAIT_L(0); PG8_BAR; PG8_MMA(1, 0, At, B0); PG8_MMA(1, 1, At, B1); PG8_BAR; PG8_SCHED;
            PG8_LDB(B0, 1, 0); PG8_LDB(B1, 1, 1); PG8_SCHED; PG8_LDA(At, 1, 0); PG8_STAGE(PG8_SA(0, 1), a2 + ah, v2[1]);
            PG8_WAIT_V(8); PG8_WAIT_L(0); PG8_BAR; PG8_MMA(0, 0, At, B0); PG8_MMA(0, 1, At, B1); PG8_BAR; PG8_SCHED;
            PG8_LDA(At, 1, 1); PG8_STAGE(PG8_SB(1, 0), b3, voffB); PG8_STAGE(PG8_SB(1, 1), b3 + hstep, voffB); PG8_STAGE(PG8_SA(1, 0), a3, v2[0]);
            PG8_WAIT_V(8); PG8_WAIT_L(0); PG8_BAR; PG8_MMA(1, 0, At, B0); PG8_MMA(1, 1, At, B1); PG8_BAR; PG8_SCHED;
            } else {
            PG8_LDB(B0, 0, 0); PG8_SCHED; PG8_LDA(At, 0, 0); PG8_STAGE(PG8_SA(1, 1), a1 + ah, va[1]);
            PG8_WAIT_L(8); PG8_BAR; PG8_WAIT_L(0); PG8_MMA(0, 0, At, B0); PG8_BAR; PG8_SCHED;
            PG8_LDB(B1, 0, 1); PG8_STAGE(PG8_SB(0, 0), b2, voffB);
            PG8_BAR; PG8_WAIT_L(0); PG8_MMA(0, 1, At, B1); PG8_BAR;
            PG8_LDA(At, 0, 1); PG8_STAGE(PG8_SA(0, 0), a2, v2[0]);
            PG8_BAR; PG8_WAIT_L(0); PG8_MMA(1, 0, At, B0); PG8_BAR; PG8_SCHED;
            PG8_STAGE(PG8_SB(0, 1), b2 + hstep, voffB);
            PG8_WAIT_V(6); PG8_BAR; PG8_MMA(1, 1, At, B1); PG8_BAR;
            PG8_LDB(B0, 1, 0); PG8_SCHED; PG8_LDA(At, 1, 0); PG8_STAGE(PG8_SA(0, 1), a2 + ah, v2[1]);
            PG8_WAIT_L(8); PG8_BAR; PG8_WAIT_L(0); PG8_MMA(0, 0, At, B0); PG8_BAR; PG8_SCHED;
            PG8_LDB(B1, 1, 1); PG8_STAGE(PG8_SB(1, 0), b3, voffB);
            PG8_BAR; PG8_WAIT_L(0); PG8_MMA(0, 1, At, B1); PG8_BAR;
            PG8_LDA(At, 1, 1); PG8_STAGE(PG8_SA(1, 0), a3, v2[0]);
            PG8_BAR; PG8_WAIT_L(0); PG8_MMA(1, 0, At, B0); PG8_BAR; PG8_SCHED;
            PG8_STAGE(PG8_SB(1, 1), b3 + hstep, voffB);
            PG8_WAIT_V(6); PG8_BAR; PG8_MMA(1, 1, At, B1); PG8_BAR;
            }
        }
        if constexpr (ALIGN_EPI) { if (wr == 0) PG8_BAR; }
        E(acc, cur, wr, wc, fr, fq);
        if (!has_next) break;
#pragma unroll
        for (int a = 0; a < 2; ++a)
#pragma unroll
            for (int b = 0; b < 2; ++b)
#pragma unroll
                for (int m = 0; m < 4; ++m)
#pragma unroll
                    for (int n = 0; n < 2; ++n) acc[a][b][m][n] = (f32x4){0.f, 0.f, 0.f, 0.f};
        cur = nxt; cA = nA; cB = nB; ++ui;
        if constexpr (GATHER) PG8_GOFF(va, ubn);
        if constexpr (ALIGN_EPI) { if (wr == 1) PG8_BAR; }
    }
    PG8_WAIT_V(0);
    if constexpr (!ALIGN_EPI) { if (wr == 0) PG8_BAR; }
    PG8_BAR;
#undef PG8_SA
#undef PG8_GOFF
#undef PG8_SB
#undef PG8_STAGE
#undef PG8_LDA
#undef PG8_LDB
#undef PG8_MMA
#undef PG8_WAIT_V
#undef PG8_WAIT_L
#undef PG8_BAR
#undef PG8_SCHED
}
}

#define XB_TMO      128
#define XB_XCNT(j)  (256  + 64 * (j))
#define XB_XSUB(j)  (1280 + 64 * (j))
#define XB_XGEN(j)  (2304 + 64 * (j))
#define XB_TOP      3328
#define XB_TOPGEN   3392
#define XCD_BAR_WORDS 3456
#define XB_SPIN_CAP (1u << 18)
__device__ __forceinline__ unsigned xb_ld(unsigned* p)              { return __hip_atomic_load(p, __ATOMIC_RELAXED, __HIP_MEMORY_SCOPE_AGENT); }
__device__ __forceinline__ unsigned xb_add(unsigned* p, unsigned v) { return __hip_atomic_fetch_add(p, v, __ATOMIC_RELAXED, __HIP_MEMORY_SCOPE_AGENT); }
__device__ __forceinline__ unsigned xb_xcc_id() { return (unsigned)__builtin_amdgcn_s_getreg((3 << 11) | 20) & 0xFu; }
#define XB_SPIN(cond, bar) do { unsigned _sp = 0; while (cond) { __builtin_amdgcn_s_sleep(1); \
    if ((++_sp & 255u) == 0u) { if (xb_ld(&(bar)[XB_TMO])) break; if (_sp > XB_SPIN_CAP) { atomicAdd(&(bar)[XB_TMO], 1u); break; } } } } while (0)
struct XcdBarrier { unsigned* bar; unsigned x; volatile LAS unsigned* st; };
__device__ __forceinline__ XcdBarrier xcd_barrier_post(unsigned* bar, volatile LAS unsigned* st) {
    XcdBarrier b; b.bar = bar; b.x = xb_xcc_id(); b.st = st;
    if (threadIdx.x == 0) (void)xb_add(&bar[XB_XCNT(b.x)], 1u);
    return b;
}
__device__ __forceinline__ void xcd_barrier_complete(unsigned* bar, unsigned x, unsigned& nloc, unsigned& nx) {
    const unsigned G = gridDim.x * gridDim.y * gridDim.z;
    unsigned sum, cnt, mine, sp = 0u;
    for (;;) {
        sum = 0u; cnt = 0u; mine = 0u;
#pragma unroll
        for (unsigned j = 0; j < 16; ++j) { const unsigned c = xb_ld(&bar[XB_XCNT(j)]); sum += c; cnt += (c > 0u) ? 1u : 0u; mine = (j == x) ? c : mine; }
        if (sum == G) break;
        __builtin_amdgcn_s_sleep(1);
        if ((++sp & 255u) == 0u) { if (xb_ld(&bar[XB_TMO])) break; if (sp > XB_SPIN_CAP) { atomicAdd(&bar[XB_TMO], 1u); break; } }
    }
    nloc = mine > 0u ? mine : 1u; nx = cnt > 0u ? cnt : 1u;
}
__device__ __forceinline__ void xcd_barrier(const XcdBarrier& b) {
    asm volatile("s_waitcnt vmcnt(0)" ::: "memory");
    __syncthreads();
    if (threadIdx.x == 0) {
        unsigned* bar = b.bar;
        __builtin_amdgcn_s_waitcnt(0);
        unsigned nloc = b.st[0], nx = b.st[1];
        if (nloc == 0u) { xcd_barrier_complete(bar, b.x, nloc, nx); b.st[0] = nloc; b.st[1] = nx; }
        const unsigned old = xb_add(&bar[XB_XSUB(b.x)], 1u);
        const unsigned gen = old / nloc;
        if (old + 1u == (gen + 1u) * nloc) {
            __builtin_amdgcn_fence(__ATOMIC_RELEASE, "agent");
            asm volatile("s_waitcnt vmcnt(0)" ::: "memory");
            const unsigned og = xb_add(&bar[XB_TOP], 1u);
            const unsigned tg = og / nx;
            if (og + 1u == (tg + 1u) * nx) xb_add(&bar[XB_TOPGEN], 1u);
            else XB_SPIN(xb_ld(&bar[XB_TOPGEN]) == tg, bar);
            __builtin_amdgcn_fence(__ATOMIC_ACQUIRE, "agent");
            xb_add(&bar[XB_XGEN(b.x)], 1u);
            asm volatile("s_waitcnt vmcnt(0)" ::: "memory");
        } else {
            XB_SPIN(xb_ld(&bar[XB_XGEN(b.x)]) == gen, bar);
            __builtin_amdgcn_fence(__ATOMIC_ACQUIRE, "agent");
            asm volatile("s_waitcnt vmcnt(0)" ::: "memory");
        }
    }
    __syncthreads();
}

constexpr size_t MiB = 1u << 20;
constexpr size_t al(size_t x) { return (x + 4095) & ~(size_t)4095; }
constexpr size_t WS_CTL = 0, CTL_ZERO_BYTES = 1 * MiB;
constexpr int CW_BAR = 4096;
constexpr int CW_CNT = 16384;
constexpr int CW_NT = 16384 + 512;
constexpr size_t WS_MOD = 1 * MiB;
constexpr size_t WS_TILE_E = WS_MOD + 256 * 1024;
constexpr size_t WS_PADSTART = WS_TILE_E + 16 * 1024;
constexpr size_t WS_ROWTOK = 2 * MiB;
constexpr size_t WS_EIDX = 4 * MiB;
constexpr size_t WS_GATE = 5 * MiB;
constexpr size_t WS_DEST = 6 * MiB;
constexpr size_t WS_WIN = 8 * MiB;
constexpr size_t WS_WLORA = WS_WIN + al((size_t)NP * D * 2);
constexpr size_t WS_WBRRW = WS_WLORA + al((size_t)NLORA * KLORA * 2);
constexpr size_t WS_WBRGLA = WS_WBRRW + al((size_t)D * RWW * 2);
constexpr size_t WS_WOUT = WS_WBRGLA + al((size_t)D * RWW * 2);
constexpr size_t WS_WROUTER = WS_WOUT + al((size_t)D * D * 2);
constexpr size_t WS_WGU = WS_WROUTER + al((size_t)NE * D * 2);
constexpr size_t WS_WD = WS_WGU + al((size_t)(NE + 1) * 512 * D * 2);
constexpr size_t WS_PERSIST_END = WS_WD + al((size_t)(NE + 1) * D * FF * 2);
constexpr size_t WS_REGB = WS_PERSIST_END;
constexpr size_t SZ512F = al((size_t)MR * RWW * 4), SZ256F = al((size_t)MR * 256 * 4), SZ512H = al((size_t)MR * RWW * 2);
constexpr size_t WS_A1 = WS_REGB;
constexpr size_t WS_A2 = WS_A1;
constexpr size_t WS_KSUM = WS_A2 + al((size_t)MR * KLORA * 2);
static_assert(WS_KSUM + SZ512H <= WS_A1 + al((size_t)MR * D * 2), "A2 + KSUM fit in the A1 slot");
constexpr size_t WS_P = WS_A1 + al((size_t)MR * D * 2);
constexpr size_t WS_RB = WS_P + al((size_t)MR * NP * 2);
constexpr size_t WS_VB = WS_RB + SZ512H, WS_KKB = WS_VB + SZ512H, WS_KMF = WS_KKB + SZ512H, WS_KMB = WS_KMF + SZ512H, WS_BVF = WS_KMB + SZ512H, WS_BVB = WS_BVF + SZ512H;
constexpr size_t WS_LWF = WS_BVB + SZ512H, WS_LWB = WS_LWF + SZ512F;
constexpr size_t SZ256H = al((size_t)MR * 256 * 2);
constexpr size_t WS_QGB = WS_LWB + SZ512F, WS_KGB = WS_QGB + SZ256H, WS_VGB = WS_KGB + SZ256H, WS_LAF = WS_VGB + SZ512H, WS_LAB = WS_LAF + SZ256F;
constexpr size_t WS_RWG = WS_LAB + SZ256F;
constexpr size_t WS_ORWF = WS_RWG + SZ512H, WS_ORWB = WS_ORWF + SZ512H, WS_OGLF = WS_ORWB + SZ512H, WS_OGLB = WS_OGLF + SZ512H;
constexpr int CH = 64, NCHUNK = (CTXL + SEQ) / CH, NU_RW = 64 * NCHUNK, NU_GL = 32 * NCHUNK;
constexpr size_t WS_RH = WS_OGLB + SZ512H;
constexpr size_t WS_YL = WS_RH + al((size_t)NU_RW * 4096 * 2);
constexpr size_t WS_HH = WS_YL + al((size_t)NU_RW * 4096 * 2);
constexpr size_t WS_INTRA = WS_HH + al((size_t)NU_RW * 4096 * 2);
constexpr size_t WS_KV = WS_INTRA + al((size_t)NU_GL * 8192 * 2);
constexpr size_t WS_DD = WS_KV + al((size_t)NU_GL * 8192 * 2);
constexpr size_t WS_END_MIX = WS_DD + al((size_t)NU_GL * 64 * 4);
constexpr size_t OUT_GT = 0, OUT_QE = (size_t)NU_RW * 4096 * 2;
static_assert(OUT_QE + (size_t)NU_GL * 4096 * 2 <= (size_t)NLAT * D * 4, "scan scratch fits in d_out");
constexpr size_t WS_YRW = WS_LWF, WS_YGLA = WS_LWB, WS_Z = WS_HH;
static_assert((size_t)NLAT * D * 2 <= (size_t)NU_RW * 4096 * 2, "Z fits in the HH slot");
constexpr size_t WS_X1 = WS_REGB;
constexpr size_t WS_A3 = WS_X1 + al((size_t)NLAT * D * 4);
constexpr size_t WS_LOGITS = WS_A3 + al((size_t)NLAT * D * 2);
constexpr size_t WS_ACT = WS_LOGITS + al((size_t)NLAT * NE * 4);
constexpr size_t WS_Y = WS_ACT + al((size_t)NROWS_E * FF * 2);
constexpr size_t WS_END_MOE = WS_Y + al((size_t)NROWS_E * D * 2);
constexpr size_t WS_END = WS_END_MIX > WS_END_MOE ? WS_END_MIX : WS_END_MOE;
static_assert(WS_END <= (size_t)2048 * MiB, "workspace map exceeds 2 GiB");

constexpr int RING_BYTES = 131072;
constexpr int IDX_BYTES = pg8::IDX_UNITS * 256 * 4;
constexpr int MISC_OFF = RING_BYTES + IDX_BYTES;
constexpr int LDS_BYTES = MISC_OFF + 256;
static_assert(pg8::IDX_OFF == RING_BYTES, "gather table sits right above the stage buffers");
constexpr int NWAVES = 8, NTHR = 512;

struct Args { const float* in[36]; float* out; unsigned char* ws; int ph_lo, ph_hi; };

struct Frame {
    LAS unsigned char* lds;
    int tid, lane, wave, G, gw, NGW;
    const float* const* in; float* out; unsigned char* ws; unsigned* ctl;
};

__device__ __forceinline__ float wave_sum(float v) {
#pragma unroll
    for (int o = 1; o < 64; o <<= 1) v += __shfl_xor(v, o);
    return v;
}
__device__ __forceinline__ unsigned f2bf(float f) { unsigned u = __builtin_bit_cast(unsigned, f); return (u + 0x7fffu + ((u >> 16) & 1u)) >> 16; }
__device__ __forceinline__ unsigned pk2(float lo, float hi) { return f2bf(lo) | (f2bf(hi) << 16); }
__device__ __forceinline__ float bflo(unsigned w) { return __builtin_bit_cast(float, w << 16); }
__device__ __forceinline__ float bfhi(unsigned w) { return __builtin_bit_cast(float, w & 0xffff0000u); }
__device__ __forceinline__ float sigmoidf_(float x) { return 1.0f / (1.0f + __expf(-x)); }
__device__ __forceinline__ float siluf_(float x) { return x / (1.0f + __expf(-x)); }

__device__ __forceinline__ void ln_stats(const f32x4 (&v)[4], float& mean, float& rstd) {
    float s = 0.f;
#pragma unroll
    for (int j = 0; j < 4; ++j) s += (v[j].x + v[j].y) + (v[j].z + v[j].w);
    mean = wave_sum(s) * (1.f / D); float s2 = 0.f;
#pragma unroll
    for (int j = 0; j < 4; ++j) { const f32x4 d = v[j] - mean; s2 += (d.x * d.x + d.y * d.y) + (d.z * d.z + d.w * d.w); }
    rstd = 1.f / sqrtf(wave_sum(s2) * (1.f / D) + LN_EPS);
}

__device__ __forceinline__ void ph_x1pre_nomix(Frame& F) {
    const float* x = F.in[0];
    for (int m = F.gw; m < NLAT; m += F.NGW) {
        const f32x4* xr = (const f32x4*)(x + (size_t)m * D) + F.lane; f32x4* o = (f32x4*)(F.out + (size_t)m * D) + F.lane;
#pragma unroll
        for (int j = 0; j < 4; ++j) o[64 * j] = xr[64 * j] * ALPHA;
    }
}
__device__ __forceinline__ void ph_ln1(Frame& F) {
    const float* lw = F.in[26]; const float* lb = F.in[27]; const float* mod = (const float*)(F.ws + WS_MOD);
    float* X1 = (float*)(F.ws + WS_X1); bf16* A3 = (bf16*)(F.ws + WS_A3);
    for (int m = F.gw; m < NLAT; m += F.NGW) {
        const int b = m / SEQ;
        const f32x4* pr = (const f32x4*)(F.out + (size_t)m * D) + F.lane;
        f32x4 v[4];
#pragma unroll
        for (int j = 0; j < 4; ++j) v[j] = pr[64 * j];
        float mean, rstd; ln_stats(v, mean, rstd);
        f32x4* xo = (f32x4*)(X1 + (size_t)m * D) + F.lane; v2u* ao = (v2u*)(A3 + (size_t)m * D) + F.lane;
#pragma unroll
        for (int j = 0; j < 4; ++j) {
            const int c = 4 * F.lane + 256 * j;
            const f32x4 w = *(const f32x4*)(lw + c), bb = *(const f32x4*)(lb + c);
            const f32x4 x1 = (v[j] - mean) * rstd * w + bb;
            xo[64 * j] = x1;
#if MS >= 2
            const f32x4 sh = *(const f32x4*)(mod + b * 6144 + 3072 + c), sc = *(const f32x4*)(mod + b * 6144 + 4096 + c);
            const f32x4 h = x1 * (sc + 1.0f) + sh;
            v2u o; o.x = pk2(h.x, h.y); o.y = pk2(h.z, h.w); ao[64 * j] = o;
#endif
        }
    }
}
__device__ __forceinline__ void ph_final(Frame& F) {
    const float* lw = F.in[34]; const float* lb = F.in[35]; const float* mod = (const float*)(F.ws + WS_MOD);
    const float* X1 = (const float*)(F.ws + WS_X1);
    const bf16* Y = (const bf16*)(F.ws + WS_Y); const int* DEST = (const int*)(F.ws + WS_DEST); const float* GATE = (const float*)(F.ws + WS_GATE);
    for (int m = F.gw; m < NLAT; m += F.NGW) {
        const int b = m / SEQ;
        const f32x4* pr = (const f32x4*)(X1 + (size_t)m * D) + F.lane;
        f32x4 v[4];
#pragma unroll
        for (int j = 0; j < 4; ++j) v[j] = pr[64 * j] * ALPHA;
#if MS >= 2
        f32x4 mo[4];
        { const v2u* yr = (const v2u*)(Y + (size_t)(SH_ROW0 + m) * D) + F.lane;
#pragma unroll
          for (int j = 0; j < 4; ++j) { const v2u w = yr[64 * j]; mo[j] = (f32x4){bflo(w.x), bfhi(w.x), bflo(w.y), bfhi(w.y)}; } }
        for (int k = 0; k < TOPK; ++k) {
            const int dr = DEST[m * 8 + k]; const float gt = GATE[m * 8 + k];
            const v2u* yr = (const v2u*)(Y + (size_t)dr * D) + F.lane;
#pragma unroll
            for (int j = 0; j < 4; ++j) { const v2u w = yr[64 * j]; mo[j] += (f32x4){bflo(w.x), bfhi(w.x), bflo(w.y), bfhi(w.y)} * gt; }
        }
#pragma unroll
        for (int j = 0; j < 4; ++j) { const f32x4 g2 = *(const f32x4*)(mod + b * 6144 + 5120 + 4 * F.lane + 256 * j); v[j] += g2 * mo[j]; }
#endif
        float mean, rstd; ln_stats(v, mean, rstd);
        f32x4* o = (f32x4*)(F.out + (size_t)m * D) + F.lane;
#pragma unroll
        for (int j = 0; j < 4; ++j) { const int c = 4 * F.lane + 256 * j; const f32x4 w = *(const f32x4*)(lw + c), bb = *(const f32x4*)(lb + c); o[64 * j] = (v[j] - mean) * rstd * w + bb; }
    }
}


#if MS >= 2
template <int MODE>
__device__ __forceinline__ void cvt_item(const float* W, int Nsrc, int nblk, bf16* WT, int row_off, int dpitch, LAS float* scr, int item, int lane) {
    const int kb = item / nblk, nb = item - kb * nblk, k0 = 64 * kb, n0 = 32 * nb;
    const int nn = n0 + (lane & 31);
#pragma unroll 8
    for (int i = 0; i < 32; ++i) { const int kk = 2 * i + (lane >> 5); scr[kk * 33 + (lane & 31)] = (nn < Nsrc) ? W[(size_t)(k0 + kk) * Nsrc + nn] : 0.f; }
    LDS_WAIT(); asm volatile("" ::: "memory");
    const int c = lane & 7;
#pragma unroll
    for (int j = 0; j < 4; ++j) { const int n = (lane >> 3) + 8 * j; const LAS float* s = scr + (8 * c) * 33 + n;
        v4u o; o.x = pk2(s[0 * 33], s[1 * 33]); o.y = pk2(s[2 * 33], s[3 * 33]); o.z = pk2(s[4 * 33], s[5 * 33]); o.w = pk2(s[6 * 33], s[7 * 33]);
        const int ng = n0 + n; int dr = ng;
        if (MODE == 1) { const int i2 = ng & 255; dr = 8 * (i2 >> 2) + (i2 & 3) + ((ng >= 256) ? 4 : 0); }
        *(v4u*)(WT + (size_t)(row_off + dr) * dpitch + k0 + 8 * c) = o; }
    LDS_WAIT(); asm volatile("" ::: "memory");
}

template <int MODE>
__device__ __forceinline__ void cvt_item_reg(const float* W, int Nsrc, bf16* WT, int row_off, int dpitch, int k0, int n0, int lane) {
    const float* src = W + (size_t)k0 * Nsrc + n0 + 4 * lane;
    f32x4 v[32];
#pragma unroll
    for (int i = 0; i < 32; ++i) v[i] = __builtin_nontemporal_load((const f32x4*)(src + (size_t)i * Nsrc));
#pragma unroll
    for (int j = 0; j < 4; ++j) {
        const int ng = n0 + 4 * lane + j; int dr = ng;
        if (MODE == 1) { const int i2 = ng & 255; dr = 8 * (i2 >> 2) + (i2 & 3) + ((ng >= 256) ? 4 : 0); }
        v4u* dst = (v4u*)(WT + (size_t)(row_off + dr) * dpitch + k0);
#pragma unroll
        for (int q = 0; q < 4; ++q) { v4u o; o.x = pk2(v[8 * q][j], v[8 * q + 1][j]); o.y = pk2(v[8 * q + 2][j], v[8 * q + 3][j]); o.z = pk2(v[8 * q + 4][j], v[8 * q + 5][j]); o.w = pk2(v[8 * q + 6][j], v[8 * q + 7][j]); dst[q] = o; }
    }
}

#if MS >= 3
__device__ __forceinline__ float lora_val(const float* const* in, int n, int k) {
    if (n < 1024) { const int q = n >> 3, e8 = n & 7, dir = e8 >> 2, ch = q * 4 + (e8 & 3); return (k < 32) ? in[9][(size_t)(dir * 32 + k) * 512 + ch] : 0.f; }
    if (n < 2048) { const int m = n - 1024, q = m >> 3, e8 = m & 7, dir = e8 >> 2, ch = q * 4 + (e8 & 3); return (k >= 32 && k < 64) ? in[11][(size_t)(dir * 32 + (k - 32)) * 512 + ch] : 0.f; }
    if (n < 2560) { const int ch = n - 2048; return (k >= 64 && k < 160) ? in[12][(size_t)(k - 64) * 512 + ch] : 0.f; }
    { const int m = n - 2560, q = m >> 3, e8 = m & 7, dir = e8 >> 2, ch = q * 4 + (e8 & 3); return (k >= 160 && k < 176) ? in[19][(size_t)(dir * 16 + (k - 160)) * 256 + ch] : 0.f; }
}
#endif

__device__ __forceinline__ void ph_prologue(Frame& F) {
    {
        const float* c = F.in[1]; const float* cc = F.in[3]; const float* wa = F.in[4]; const float* ba = F.in[5];
        float* MOD = (float*)(F.ws + WS_MOD);
        LAS float* S = (LAS float*)F.lds; LAS float* red = (LAS float*)(F.lds + 32768);
        for (int it = blockIdx.x; it < 96; it += F.G) {
            for (int i = F.tid; i < 5120; i += NTHR) { const int r = i >> 10, k = i & 1023; const float cv = r < 4 ? c[r * 1024 + k] : cc[k]; S[i] = siluf_(cv); }
            __syncthreads();
            const int n = it * 64 + F.lane; float acc[5] = {0.f, 0.f, 0.f, 0.f, 0.f};
            for (int kk = 0; kk < 128; ++kk) { const int k = F.wave * 128 + kk; const float wv = wa[(size_t)k * 6144 + n];
#pragma unroll
                for (int r = 0; r < 5; ++r) acc[r] += S[r * 1024 + k] * wv; }
#pragma unroll
            for (int r = 0; r < 5; ++r) red[(F.wave * 5 + r) * 64 + F.lane] = acc[r];
            __syncthreads();
            if (F.wave == 0) {
#pragma unroll
                for (int r = 0; r < 5; ++r) { float s = 0.f;
#pragma unroll
                    for (int w = 0; w < 8; ++w) s += red[(w * 5 + r) * 64 + F.lane];
                    MOD[r * 6144 + n] = s + ba[n]; }
            }
            __syncthreads();
        }
    }
    {
        LAS float* scr = (LAS float*)(F.lds + F.wave * 16384);
        constexpr int I_IN = 16 * 168, I_BR = 8 * 32, I_OUT = 16 * 32, I_RT = 16 * 8, I_GU = 32 * 2, I_DN = 8 * 4;
        constexpr int T0 = I_IN, T1 = T0 + I_BR, T2 = T1 + I_BR, T3 = T2 + I_OUT, T4 = T3 + I_RT, T5 = T4 + (NE + 1) * I_GU, T6 = T5 + (NE + 1) * I_DN;
        unsigned char* ws = F.ws;
        for (int it = F.gw; it < T6; it += F.NGW) {
#if MS >= 3
            if (it < T0) { cvt_item<0>(F.in[6], IN_COLS, 168, (bf16*)(ws + WS_WIN), 0, D, scr, it, F.lane); continue; }
            if (it < T1) { cvt_item<0>(F.in[23], D, 32, (bf16*)(ws + WS_WBRRW), 0, RWW, scr, it - T0, F.lane); continue; }
            if (it < T2) { cvt_item<0>(F.in[24], D, 32, (bf16*)(ws + WS_WBRGLA), 0, RWW, scr, it - T1, F.lane); continue; }
            if (it < T3) { cvt_item<0>(F.in[25], D, 32, (bf16*)(ws + WS_WOUT), 0, D, scr, it - T2, F.lane); continue; }
#else
            if (it < T3) continue;
#endif
            if (it < T4) { cvt_item<0>(F.in[28], NE, 8, (bf16*)(ws + WS_WROUTER), 0, D, scr, it - T3, F.lane); continue; }
            if (it < T5) { const int r = it - T4, e = r / I_GU, ii = r - e * I_GU;
                const float* src = (e < NE) ? F.in[30] + (size_t)e * D * 512 : F.in[32];
                cvt_item_reg<1>(src, 512, (bf16*)(ws + WS_WGU), e * 512, D, 32 * (ii >> 1), 256 * (ii & 1), F.lane); continue; }
            { const int r = it - T5, e = r / I_DN, ii = r - e * I_DN;
                const float* src = (e < NE) ? F.in[31] + (size_t)e * FF * D : F.in[33];
                cvt_item_reg<0>(src, D, (bf16*)(ws + WS_WD), e * D, FF, 32 * (ii >> 2), 256 * (ii & 3), F.lane); }
        }
    }
#if MS >= 3
    {
        bf16* WL = (bf16*)(F.ws + WS_WLORA);
        for (int idx = blockIdx.x * NTHR + F.tid; idx < NLORA * (KLORA / 8); idx += F.G * NTHR) {
            const int n = idx >> 5, k0 = (idx & 31) * 8; float v[8];
#pragma unroll
            for (int e = 0; e < 8; ++e) v[e] = lora_val(F.in, n, k0 + e);
            v4u o; o.x = pk2(v[0], v[1]); o.y = pk2(v[2], v[3]); o.z = pk2(v[4], v[5]); o.w = pk2(v[6], v[7]);
            *(v4u*)(WL + (size_t)n * KLORA + k0) = o;
        }
    }
#endif
}

struct EpiF32 {
    static constexpr bool PERM = false;
    float* C; int ldc;
    __device__ __forceinline__ void operator()(const f32x4 (&acc)[2][2][4][2], const pg8::Unit& u, int wr, int wc, int fr, int fq) const {
        const int row0 = u.pm * 256 + wr * 64 + fr, col0 = u.pn * 256 + wc * 32 + 4 * fq;
#pragma unroll
        for (int ai = 0; ai < 2; ++ai)
#pragma unroll
            for (int m = 0; m < 4; ++m) { float* rowp = C + (size_t)(row0 + ai * 128 + m * 16) * ldc + col0;
#pragma unroll
                for (int bj = 0; bj < 2; ++bj)
#pragma unroll
                    for (int n = 0; n < 2; ++n) *(f32x4*)(rowp + bj * 128 + n * 16) = acc[ai][bj][m][n]; }
    }
};
struct EpiSwiglu {
    static constexpr bool PERM = true;
    bf16* ACT;
    __device__ __forceinline__ void operator()(const f32x4 (&acc)[2][2][4][2], const pg8::Unit& u, int wr, int wc, int fr, int fq) const {
        const int row0 = u.pm * 256 + wr * 64 + fr, h0 = u.j * 128 + wc * 16 + 4 * fq;
#pragma unroll
        for (int ai = 0; ai < 2; ++ai)
#pragma unroll
            for (int m = 0; m < 4; ++m) { bf16* rowp = ACT + (size_t)(row0 + ai * 128 + m * 16) * FF + h0;
#pragma unroll
                for (int bj = 0; bj < 2; ++bj) { const f32x4 a = acc[ai][bj][m][0], b = acc[ai][bj][m][1];
                    v2u o; o.x = pg8::cvt_pk_bf16(siluf_(a[0]) * b[0], siluf_(a[1]) * b[1]); o.y = pg8::cvt_pk_bf16(siluf_(a[2]) * b[2], siluf_(a[3]) * b[3]);
                    *(v2u*)(rowp + bj * 64) = o; } }
    }
};
struct EpiRowsBf16 {
    static constexpr bool PERM = true;
    bf16* O; int ldc;
    __device__ __forceinline__ void operator()(const f32x4 (&acc)[2][2][4][2], const pg8::Unit& u, int wr, int wc, int fr, int fq) const {
        const int row0 = u.pm * 256 + wr * 64 + fr, col0 = u.j * 256 + wc * 32 + 8 * fq;
#pragma unroll
        for (int ai = 0; ai < 2; ++ai)
#pragma unroll
            for (int m = 0; m < 4; ++m) { bf16* rowp = O + (size_t)(row0 + ai * 128 + m * 16) * ldc + col0;
#pragma unroll
                for (int bj = 0; bj < 2; ++bj) { const f32x4 v0 = acc[ai][bj][m][0], v1 = acc[ai][bj][m][1];
                    v4u w; w.x = pg8::cvt_pk_bf16(v0[0], v0[1]); w.y = pg8::cvt_pk_bf16(v0[2], v0[3]); w.z = pg8::cvt_pk_bf16(v1[0], v1[1]); w.w = pg8::cvt_pk_bf16(v1[2], v1[3]);
                    *(v4u*)(rowp + bj * 128) = w; } }
    }
};

__device__ __forceinline__ void ph_router(Frame& F) {
    pg8::Gemm g{(const bf16*)(F.ws + WS_A3), (const bf16*)(F.ws + WS_WROUTER), NLAT, NE, D, nullptr};
    pg8::StaticOrder S; S.init(NLAT, NE, F.G, (int)blockIdx.x);
    EpiF32 E{(float*)(F.ws + WS_LOGITS), NE};
    pg8::gemm_phase<EpiF32, pg8::StaticOrder, true, true, false>(F.lds, g, S, E);
}

__device__ __forceinline__ void ph_route(Frame& F) {
    const float* LOG = (const float*)(F.ws + WS_LOGITS); const float* rb = F.in[29];
    int* EIDX = (int*)(F.ws + WS_EIDX); float* GATE = (float*)(F.ws + WS_GATE); int* DEST = (int*)(F.ws + WS_DEST);
    unsigned* CNT = F.ctl + CW_CNT;
    const f32x4 bias = *(const f32x4*)(rb + 4 * F.lane);
    const float NEG = -3.0e38f;
    for (int m = F.gw; m < NLAT; m += F.NGW) {
        const f32x4 lg = *(const f32x4*)(LOG + (size_t)m * NE + 4 * F.lane);
        float sc[4], sel[4];
#pragma unroll
        for (int i = 0; i < 4; ++i) { sc[i] = sigmoidf_(lg[i]); sel[i] = sc[i] + bias[i]; }
        float m1 = fmaxf(sel[0], sel[1]), m2 = fminf(sel[0], sel[1]);
        { const float a = sel[2]; const float n1 = fmaxf(m1, a); m2 = fmaxf(m2, fminf(m1, a)); m1 = n1; }
        { const float a = sel[3]; const float n1 = fmaxf(m1, a); m2 = fmaxf(m2, fminf(m1, a)); m1 = n1; }
#pragma unroll
        for (int o = 1; o < 8; o <<= 1) { const float b1 = __shfl_xor(m1, o), b2 = __shfl_xor(m2, o); const float n1 = fmaxf(m1, b1); m2 = fmaxf(fminf(m1, b1), fmaxf(m2, b2)); m1 = n1; }
        const float gs = m1 + m2; const int g = F.lane >> 3;
        int rank = 0;
#pragma unroll
        for (int gg = 0; gg < 8; ++gg) { const float og = __shfl(gs, gg * 8); rank += (og > gs || (og == gs && gg < g)) ? 1 : 0; }
        const bool keep = rank < 4;
#pragma unroll
        for (int i = 0; i < 4; ++i) sel[i] = keep ? sel[i] : NEG;
        int my_e = 0; float my_s = 0.f; float ssum = 0.f;
        for (int k = 0; k < TOPK; ++k) {
            float bv = sel[0]; int bi = 0;
#pragma unroll
            for (int i = 1; i < 4; ++i) if (sel[i] > bv) { bv = sel[i]; bi = i; }
            int be = 4 * F.lane + bi; float v = bv; int e = be;
#pragma unroll
            for (int o = 1; o < 64; o <<= 1) { const float ov = __shfl_xor(v, o); const int oe = __shfl_xor(e, o); if (ov > v || (ov == v && oe < e)) { v = ov; e = oe; } }
            const int owner = e >> 2, oi = e & 3;
            float s_own = 0.f;
            if (F.lane == owner) {
#pragma unroll
                for (int i = 0; i < 4; ++i) if (i == oi) { s_own = sc[i]; sel[i] = NEG; }
            }
            const float s = __shfl(s_own, owner);
            ssum += s;
            if (F.lane == k) { my_e = e; my_s = s; }
        }
        if (F.lane < TOPK) {
            const unsigned pos = __hip_atomic_fetch_add(CNT + my_e, 1u, __ATOMIC_RELAXED, __HIP_MEMORY_SCOPE_AGENT);
            EIDX[m * 8 + F.lane] = my_e; GATE[m * 8 + F.lane] = my_s / ssum * 2.5f; DEST[m * 8 + F.lane] = (int)pos;
        }
    }
}

__device__ __forceinline__ void ph_scatter(Frame& F) {
    LAS int* tstart = (LAS int*)F.lds;
    LAS int* scan = (LAS int*)(F.lds + 2048);
    LAS int* cnts = (LAS int*)(F.lds + 4096);
    int* EIDX = (int*)(F.ws + WS_EIDX); int* DEST = (int*)(F.ws + WS_DEST); int* ROWTOK = (int*)(F.ws + WS_ROWTOK); int* TILE_E = (int*)(F.ws + WS_TILE_E);
    unsigned* CNT = F.ctl + CW_CNT;
    int tiles = 0, cnt = 0;
    if (F.tid < NE) { cnt = (int)__hip_atomic_load(CNT + F.tid, __ATOMIC_RELAXED, __HIP_MEMORY_SCOPE_AGENT); tiles = (cnt + 255) >> 8; scan[F.tid] = tiles; cnts[F.tid] = cnt; }
    __syncthreads();
    for (int o = 1; o < NE; o <<= 1) { int v = 0; if (F.tid < NE && F.tid >= o) v = scan[F.tid - o]; __syncthreads(); if (F.tid < NE) scan[F.tid] += v; __syncthreads(); }
    if (F.tid < NE) { tstart[F.tid + 1] = scan[F.tid]; if (F.tid == 0) tstart[0] = 0; }
    __syncthreads();
    const int NT = tstart[NE];
    if (blockIdx.x == 0) {
        if (F.tid == 0) F.ctl[CW_NT] = (unsigned)NT;
        if (F.tid < NE) for (int t = tstart[F.tid]; t < tstart[F.tid + 1]; ++t) TILE_E[t] = F.tid;
    }
    for (int e = blockIdx.x; e < NE; e += F.G) { const int c0 = cnts[e], c1 = (tstart[e + 1] - tstart[e]) * 256, base = tstart[e] * 256;
        for (int p = c0 + F.tid; p < c1; p += NTHR) ROWTOK[base + p] = 0; }
    for (int i = blockIdx.x * NTHR + F.tid; i < NLAT; i += F.G * NTHR) ROWTOK[SH_ROW0 + i] = i;
    for (int i = blockIdx.x * NTHR + F.tid; i < NLAT * TOPK; i += F.G * NTHR) {
        const int e = EIDX[i], pos = DEST[i]; const int dr = tstart[e] * 256 + pos;
        DEST[i] = dr; ROWTOK[dr] = i >> 3;
    }
}

__device__ __forceinline__ void ph_exp1(Frame& F) {
    const int NT = (int)__hip_atomic_load(F.ctl + CW_NT, __ATOMIC_RELAXED, __HIP_MEMORY_SCOPE_AGENT);
    pg8::Gemm g{(const bf16*)(F.ws + WS_A3), (const bf16*)(F.ws + WS_WGU), 0, 0, D, (const int*)(F.ws + WS_ROWTOK)};
    pg8::MoeOrder S{2, F.G, (int)blockIdx.x, NT, (const int*)(F.ws + WS_TILE_E)};
    EpiSwiglu E{(bf16*)(F.ws + WS_ACT)};
    pg8::gemm_phase<EpiSwiglu, pg8::MoeOrder, true, true, true>(F.lds, g, S, E);
}
__device__ __forceinline__ void ph_exp2(Frame& F) {
    const int NT = (int)__hip_atomic_load(F.ctl + CW_NT, __ATOMIC_RELAXED, __HIP_MEMORY_SCOPE_AGENT);
    pg8::Gemm g{(const bf16*)(F.ws + WS_ACT), (const bf16*)(F.ws + WS_WD), 0, 0, FF, nullptr};
    pg8::MoeOrder S{4, F.G, (int)blockIdx.x, NT, (const int*)(F.ws + WS_TILE_E)};
    EpiRowsBf16 E{(bf16*)(F.ws + WS_Y), D};
    pg8::gemm_phase<EpiRowsBf16, pg8::MoeOrder, true, true, false>(F.lds, g, S, E);
}
#endif

#if MS >= 3
__device__ __forceinline__ void unp8(const v4u w, float (&f)[8]) { f[0] = bflo(w.x); f[1] = bfhi(w.x); f[2] = bflo(w.y); f[3] = bfhi(w.y); f[4] = bflo(w.z); f[5] = bfhi(w.z); f[6] = bflo(w.w); f[7] = bfhi(w.w); }
__device__ __forceinline__ v4u pk8(const float (&f)[8]) { v4u o; o.x = pk2(f[0], f[1]); o.y = pk2(f[2], f[3]); o.z = pk2(f[4], f[5]); o.w = pk2(f[6], f[7]); return o; }
__device__ __forceinline__ void st8(float* p, const float (&f)[8]) { *(f32x4*)p = (f32x4){f[0], f[1], f[2], f[3]}; *(f32x4*)(p + 4) = (f32x4){f[4], f[5], f[6], f[7]}; }
__device__ __forceinline__ void ld8(const float* p, float (&f)[8]) { const f32x4 a = *(const f32x4*)p, b = *(const f32x4*)(p + 4); f[0] = a.x; f[1] = a.y; f[2] = a.z; f[3] = a.w; f[4] = b.x; f[5] = b.y; f[6] = b.z; f[7] = b.w; }

__device__ __forceinline__ void ph_a1(Frame& F) {
    const float* mod = (const float*)(F.ws + WS_MOD); bf16* A1 = (bf16*)(F.ws + WS_A1);
    for (int m = F.gw; m < MR; m += F.NGW) {
        const float* src = (m < NLAT) ? F.in[0] + (size_t)m * D : F.in[2] + (size_t)(m - NLAT) * D;
        const int mr = (m < NLAT) ? (m / SEQ) : 4;
        const f32x4* xr = (const f32x4*)src + F.lane; v2u* ao = (v2u*)(A1 + (size_t)m * D) + F.lane;
#pragma unroll
        for (int j = 0; j < 4; ++j) { const int c = 4 * F.lane + 256 * j;
            const f32x4 sh = *(const f32x4*)(mod + mr * 6144 + c), sc = *(const f32x4*)(mod + mr * 6144 + 1024 + c);
            const f32x4 h = xr[64 * j] * (sc + 1.0f) + sh; v2u o; o.x = pk2(h.x, h.y); o.y = pk2(h.z, h.w); ao[64 * j] = o; }
    }
}

__device__ __forceinline__ void ph_inproj(Frame& F) {
    pg8::Gemm g{(const bf16*)(F.ws + WS_A1), (const bf16*)(F.ws + WS_WIN), MR, NP, D, nullptr};
    pg8::StaticOrder S; S.init(MR, NP, F.G, (int)blockIdx.x);
    EpiRowsBf16 E{(bf16*)(F.ws + WS_P), NP};
    pg8::gemm_phase<EpiRowsBf16, pg8::StaticOrder, true, true, false>(F.lds, g, S, E);
}

__device__ __forceinline__ void ph_feat(Frame& F) {
    const bf16* P = (const bf16*)(F.ws + WS_P);
    const float* mu = F.in[7]; const float* kkw = F.in[13]; const float* cw = F.in[18];
    bf16* R = (bf16*)(F.ws + WS_RB); bf16* V = (bf16*)(F.ws + WS_VB); bf16* KK = (bf16*)(F.ws + WS_KKB); bf16* KP = (bf16*)(F.ws + WS_KMF);
    bf16* QG = (bf16*)(F.ws + WS_QGB); bf16* KGB = (bf16*)(F.ws + WS_KGB); bf16* VGB = (bf16*)(F.ws + WS_VGB);
    bf16* A2 = (bf16*)(F.ws + WS_A2);
    const int lane = F.lane;
    for (int m = F.gw; m < MR; m += F.NGW) {
        int nb[4]; int gr = 0, gc = 0; const bool lat = m < NLAT;
        if (lat) { const int t = m & (SEQ - 1); gr = t >> 6; gc = t & 63;
            nb[0] = gc > 0 ? m - 1 : -1; nb[1] = gc < 63 ? m + 1 : -1; nb[2] = gr > 0 ? m - 64 : -1; nb[3] = gr < 127 ? m + 64 : -1;
        } else { const int t = (m - NLAT) & (CTXL - 1); nb[0] = t > 0 ? m - 1 : -1; nb[1] = t < CTXL - 1 ? m + 1 : -1; nb[2] = nb[0]; nb[3] = nb[1]; }
        const bf16* prow = P + (size_t)m * NP;
#pragma unroll
        for (int p = 0; p < 4; ++p) {
            const int cb = p * 512 + 8 * lane;
            if (p < 3 || lane < 20) {
                float own[8], sh[4][8];
                unp8(*(const v4u*)(prow + cb), own);
#pragma unroll
                for (int q = 0; q < 4; ++q) { v4u w = (v4u){0u, 0u, 0u, 0u}; if (nb[q] >= 0) w = *(const v4u*)(P + (size_t)nb[q] * NP + cb); unp8(w, sh[q]); }
                float muv[8]; ld8(mu + cb, muv);
                float val[8];
#pragma unroll
                for (int e = 0; e < 8; ++e) val[e] = own[e] + muv[e] * (sh[e & 3][e] - own[e]);
                if (p == 0) *(v4u*)(R + (size_t)m * RWW + 8 * lane) = pk8(val);
                else if (p == 2) *(v4u*)(V + (size_t)m * RWW + 8 * lane) = pk8(val);
                else if (p == 1) {
                    *(v4u*)(KP + (size_t)m * RWW + 8 * lane) = pk8(val);
                    float kw[8]; ld8(kkw + 8 * lane, kw); float kkv[8]; float ss = 0.f;
#pragma unroll
                    for (int e = 0; e < 8; ++e) { kkv[e] = val[e] * kw[e]; ss += kkv[e] * kkv[e]; }
                    ss += __shfl_xor(ss, 1); ss += __shfl_xor(ss, 2); ss += __shfl_xor(ss, 4);
                    const float inv = 1.0f / fmaxf(sqrtf(ss), 1e-12f);
#pragma unroll
                    for (int e = 0; e < 8; ++e) kkv[e] *= inv;
                    *(v4u*)(KK + (size_t)m * RWW + 8 * lane) = pk8(kkv);
                } else {
                    float o[8];
#pragma unroll
                    for (int e = 0; e < 8; ++e) o[e] = (lane < 4) ? tanhf(val[e]) : ((lane < 8) ? val[e] : sigmoidf_(val[e]));
                    *(v4u*)(A2 + (size_t)m * KLORA + 8 * lane) = pk8(o);
                }
            } else if (p == 3 && lane < 32) {
                v4u w = (v4u){0u, 0u, 0u, 0u};
                if (lane < 22) w = *(const v4u*)(prow + C_PGL + 8 * (lane - 20));
                *(v4u*)(A2 + (size_t)m * KLORA + 8 * lane) = w;
            }
        }
#pragma unroll
        for (int p = 0; p < 2; ++p) {
            const int cq = p * 512 + 8 * lane; const int cb = C_Q + cq;
            float acc[8] = {0.f, 0.f, 0.f, 0.f, 0.f, 0.f, 0.f, 0.f};
#pragma unroll
            for (int dy = -1; dy <= 1; ++dy)
#pragma unroll
                for (int dx = -1; dx <= 1; ++dx) {
                    bool ok; int nr;
                    if (lat) { ok = (gr + dy >= 0) && (gr + dy < GRIDH) && (gc + dx >= 0) && (gc + dx < GRIDW); nr = m + dy * 64 + dx; }
                    else { const int t = (m - NLAT) & (CTXL - 1); ok = (dy == 0) && (t + dx >= 0) && (t + dx < CTXL); nr = m + dx; }
                    if (ok) {
                        float pv[8], wv[8]; unp8(*(const v4u*)(P + (size_t)nr * NP + cb), pv); ld8(cw + ((dy + 1) * 3 + (dx + 1)) * 1024 + cq, wv);
#pragma unroll
                        for (int e = 0; e < 8; ++e) acc[e] += pv[e] * wv[e];
                    }
                }
            float o[8];
#pragma unroll
            for (int e = 0; e < 8; ++e) o[e] = siluf_(acc[e]);
            if (p == 0) {
                if (lane < 32) {
#pragma unroll
                    for (int e = 0; e < 8; ++e) o[e] *= 0.125f;
                    *(v4u*)(QG + (size_t)m * 256 + cq) = pk8(o);
                } else *(v4u*)(KGB + (size_t)m * 256 + (cq - 256)) = pk8(o);
            } else *(v4u*)(VGB + (size_t)m * RWW + (cq - 512)) = pk8(o);
        }
    }
}

struct EpiLora {
    static constexpr bool PERM = true;
    unsigned char* ws; const float* const* in;
    __device__ __forceinline__ void grp_w(const f32x4 (&acc)[2][2][4][2], int row0, int c0) const {
        float* Wf = (float*)(ws + WS_LWF); float* Wb = (float*)(ws + WS_LWB);
#pragma unroll
        for (int bj = 0; bj < 2; ++bj) { const int ch = (c0 + bj * 128) >> 1; const f32x4 w0f = *(const f32x4*)(in[8] + ch), w0b = *(const f32x4*)(in[8] + 512 + ch);
#pragma unroll
            for (int ai = 0; ai < 2; ++ai)
#pragma unroll
                for (int m = 0; m < 4; ++m) { const size_t row = (size_t)(row0 + ai * 128 + m * 16);
                    const f32x4 xf = acc[ai][bj][m][0] + w0f, xb = acc[ai][bj][m][1] + w0b; f32x4 df, db;
#pragma unroll
                    for (int e = 0; e < 4; ++e) { df[e] = -0.60653066f * sigmoidf_(xf[e]); db[e] = -0.60653066f * sigmoidf_(xb[e]); }
                    *(f32x4*)(Wf + row * RWW + ch) = df; *(f32x4*)(Wb + row * RWW + ch) = db; } }
    }
    __device__ __forceinline__ void grp_a(const f32x4 (&acc)[2][2][4][2], int row0, int c0) const {
        bf16* KMf = (bf16*)(ws + WS_KMF); bf16* KMb = (bf16*)(ws + WS_KMB); bf16* BVf = (bf16*)(ws + WS_BVF); bf16* BVb = (bf16*)(ws + WS_BVB);
        const bf16* KK = (const bf16*)(ws + WS_KKB); bf16* KSUM = (bf16*)(ws + WS_KSUM);
#pragma unroll
        for (int bj = 0; bj < 2; ++bj) { const int ch = (c0 + bj * 128 - 1024) >> 1; const f32x4 a0f = *(const f32x4*)(in[10] + ch), a0b = *(const f32x4*)(in[10] + 512 + ch), ka = *(const f32x4*)(in[14] + ch);
#pragma unroll
            for (int ai = 0; ai < 2; ++ai)
#pragma unroll
                for (int m = 0; m < 4; ++m) { const size_t row = (size_t)(row0 + ai * 128 + m * 16);
                    const f32x4 xf = acc[ai][bj][m][0] + a0f, xb = acc[ai][bj][m][1] + a0b;
                    const v2u kpw = *(const v2u*)(KMf + row * RWW + ch), kkw = *(const v2u*)(KK + row * RWW + ch);
                    const f32x4 kp = (f32x4){bflo(kpw.x), bfhi(kpw.x), bflo(kpw.y), bfhi(kpw.y)}, kk = (f32x4){bflo(kkw.x), bfhi(kkw.x), bflo(kkw.y), bfhi(kkw.y)};
                    f32x4 kmf, kmb, bvf, bvb;
#pragma unroll
                    for (int e = 0; e < 4; ++e) { const float af = sigmoidf_(xf[e]), ab = sigmoidf_(xb[e]);
                        kmf[e] = kp[e] * (1.0f + (af - 1.0f) * ka[e]); kmb[e] = kp[e] * (1.0f + (ab - 1.0f) * ka[e]); bvf[e] = kk[e] * af; bvb[e] = kk[e] * ab; }
                    { v2u o; o.x = pk2(kmf[0], kmf[1]); o.y = pk2(kmf[2], kmf[3]); *(v2u*)(KMf + row * RWW + ch) = o; o.x = pk2(kmb[0], kmb[1]); o.y = pk2(kmb[2], kmb[3]); *(v2u*)(KMb + row * RWW + ch) = o;
                      o.x = pk2(bvf[0], bvf[1]); o.y = pk2(bvf[2], bvf[3]); *(v2u*)(BVf + row * RWW + ch) = o; o.x = pk2(bvb[0], bvb[1]); o.y = pk2(bvb[2], bvb[3]); *(v2u*)(BVb + row * RWW + ch) = o; }
                    v2u ks; ks.x = pk2(kmf[0] + kmb[0], kmf[1] + kmb[1]); ks.y = pk2(kmf[2] + kmb[2], kmf[3] + kmb[3]); *(v2u*)(KSUM + row * RWW + ch) = ks; } }
    }
    __device__ __forceinline__ void grp_g(const f32x4 (&acc)[2][2][4][2], int row0, int c0) const {
        bf16* RWG = (bf16*)(ws + WS_RWG);
#pragma unroll
        for (int bj = 0; bj < 2; ++bj) { const int ch = c0 + bj * 128 - 2048;
#pragma unroll
            for (int ai = 0; ai < 2; ++ai)
#pragma unroll
                for (int m = 0; m < 4; ++m) { const size_t row = (size_t)(row0 + ai * 128 + m * 16); const f32x4 v0 = acc[ai][bj][m][0], v1 = acc[ai][bj][m][1];
                    v4u w; w.x = pk2(v0[0], v0[1]); w.y = pk2(v0[2], v0[3]); w.z = pk2(v1[0], v1[1]); w.w = pk2(v1[2], v1[3]); *(v4u*)(RWG + row * RWW + ch) = w; } }
    }
    __device__ __forceinline__ void grp_l(const f32x4 (&acc)[2][2][4][2], int row0, int c0) const {
        float* GAf = (float*)(ws + WS_LAF); float* GAb = (float*)(ws + WS_LAB);
#pragma unroll
        for (int bj = 0; bj < 2; ++bj) { const int ch = (c0 + bj * 128 - 2560) >> 1; const f32x4 gbf = *(const f32x4*)(in[20] + ch), gbb = *(const f32x4*)(in[20] + 256 + ch);
#pragma unroll
            for (int ai = 0; ai < 2; ++ai)
#pragma unroll
                for (int m = 0; m < 4; ++m) { const size_t row = (size_t)(row0 + ai * 128 + m * 16);
                    const f32x4 xf = acc[ai][bj][m][0] + gbf, xb = acc[ai][bj][m][1] + gbb; f32x4 af, ab;
#pragma unroll
                    for (int e = 0; e < 4; ++e) { const float lf = fminf(xf[e], 0.f) - log1pf(__expf(-fabsf(xf[e]))), lb = fminf(xb[e], 0.f) - log1pf(__expf(-fabsf(xb[e])));
                        af[e] = lf * 0.0625f; ab[e] = lb * 0.0625f; }
                    *(f32x4*)(GAf + row * 256 + ch) = af; *(f32x4*)(GAb + row * 256 + ch) = ab; } }
    }
    __device__ __forceinline__ void operator()(const f32x4 (&acc)[2][2][4][2], const pg8::Unit& u, int wr, int wc, int fr, int fq) const {
        const int row0 = u.pm * 256 + wr * 64 + fr, c0 = u.pn * 256 + wc * 32 + 8 * fq;
        if (u.pn < 4) grp_w(acc, row0, c0); else if (u.pn < 8) grp_a(acc, row0, c0); else if (u.pn < 10) grp_g(acc, row0, c0); else grp_l(acc, row0, c0);
    }
};
__device__ __forceinline__ void ph_lora(Frame& F) {
    pg8::Gemm g{(const bf16*)(F.ws + WS_A2), (const bf16*)(F.ws + WS_WLORA), MR, NLORA, KLORA, nullptr};
    pg8::StaticOrder S; S.init(MR, NLORA, F.G, (int)blockIdx.x);
    EpiLora E{F.ws, F.in};
    pg8::gemm_phase<EpiLora, pg8::StaticOrder, true, true, false>(F.lds, g, S, E);
}

__device__ __forceinline__ void ph_merge(Frame& F) {
    unsigned char* ws = F.ws; const int lane = F.lane;
    const bf16* ORf = (const bf16*)(ws + WS_ORWF); const bf16* ORb = (const bf16*)(ws + WS_ORWB); const bf16* OGf = (const bf16*)(ws + WS_OGLF); const bf16* OGb = (const bf16*)(ws + WS_OGLB);
    const bf16* R = (const bf16*)(ws + WS_RB); const bf16* V = (const bf16*)(ws + WS_VB); const bf16* KSUM = (const bf16*)(ws + WS_KSUM); const bf16* RWG = (const bf16*)(ws + WS_RWG);
    const bf16* P = (const bf16*)(ws + WS_P);
    bf16* YRW = (bf16*)(ws + WS_YRW); bf16* YGLA = (bf16*)(ws + WS_YGLA);
    float rk[8], gw[8], gbv[8], ggw[8], ggb[8];
    ld8(F.in[15] + 8 * lane, rk); ld8(F.in[16] + 8 * lane, gw); ld8(F.in[17] + 8 * lane, gbv); ld8(F.in[21] + 8 * lane, ggw); ld8(F.in[22] + 8 * lane, ggb);
    for (int m = F.gw; m < NLAT; m += F.NGW) {
        const size_t ro = (size_t)m * RWW + 8 * lane;
        {
            float a[8], b[8], o[8]; unp8(*(const v4u*)(ORf + ro), a); unp8(*(const v4u*)(ORb + ro), b);
            float s = 0.f;
#pragma unroll
            for (int e = 0; e < 8; ++e) { o[e] = a[e] + b[e]; s += o[e]; }
            s += __shfl_xor(s, 1); s += __shfl_xor(s, 2); s += __shfl_xor(s, 4);
            const float mean = s * (1.f / 64.f); float q = 0.f;
#pragma unroll
            for (int e = 0; e < 8; ++e) { o[e] -= mean; q += o[e] * o[e]; }
            q += __shfl_xor(q, 1); q += __shfl_xor(q, 2); q += __shfl_xor(q, 4);
            const float rstd = 1.f / sqrtf(q * (1.f / 64.f) + RW_GN_EPS);
            float r[8], v[8], ksm[8], g[8]; unp8(*(const v4u*)(R + ro), r); unp8(*(const v4u*)(V + ro), v); unp8(*(const v4u*)(KSUM + ro), ksm); unp8(*(const v4u*)(RWG + ro), g);
            float bs = 0.f;
#pragma unroll
            for (int e = 0; e < 8; ++e) bs += r[e] * ksm[e] * rk[e];
            bs += __shfl_xor(bs, 1); bs += __shfl_xor(bs, 2); bs += __shfl_xor(bs, 4);
            float y[8];
#pragma unroll
            for (int e = 0; e < 8; ++e) y[e] = (o[e] * rstd * gw[e] + gbv[e] + bs * v[e]) * g[e];
            *(v4u*)(YRW + ro) = pk8(y);
        }
        {
            float a[8], b[8], o[8]; unp8(*(const v4u*)(OGf + ro), a); unp8(*(const v4u*)(OGb + ro), b);
            float s = 0.f;
#pragma unroll
            for (int e = 0; e < 8; ++e) { o[e] = a[e] + b[e]; s += o[e]; }
            s += __shfl_xor(s, 1); s += __shfl_xor(s, 2); s += __shfl_xor(s, 4); s += __shfl_xor(s, 8);
            const float mean = s * (1.f / 128.f); float q = 0.f;
#pragma unroll
            for (int e = 0; e < 8; ++e) { o[e] -= mean; q += o[e] * o[e]; }
            q += __shfl_xor(q, 1); q += __shfl_xor(q, 2); q += __shfl_xor(q, 4); q += __shfl_xor(q, 8);
            const float rstd = 1.f / sqrtf(q * (1.f / 128.f) + LN_EPS);
            float og[8]; unp8(*(const v4u*)(P + (size_t)m * NP + C_OG + 8 * lane), og);
            float y[8];
#pragma unroll
            for (int e = 0; e < 8; ++e) y[e] = (o[e] * rstd * ggw[e] + ggb[e]) * siluf_(og[e]);
            *(v4u*)(YGLA + ro) = pk8(y);
        }
    }
}

template <int WHICH> struct EpiBranch {
    static constexpr bool PERM = true;
    bf16* Z; const bf16* P;
    __device__ __forceinline__ void operator()(const f32x4 (&acc)[2][2][4][2], const pg8::Unit& u, int wr, int wc, int fr, int fq) const {
        const int row0 = u.pm * 256 + wr * 64 + fr, col0 = u.pn * 256 + wc * 32 + 8 * fq;
#pragma unroll
        for (int ai = 0; ai < 2; ++ai)
#pragma unroll
            for (int m = 0; m < 4; ++m) { const size_t row = (size_t)(row0 + ai * 128 + m * 16);
#pragma unroll
                for (int bj = 0; bj < 2; ++bj) { const int c = col0 + bj * 128;
                    float g[8]; unp8(*(const v4u*)(P + row * NP + (WHICH ? C_GGLA : C_GRW) + c), g);
                    const f32x4 v0 = acc[ai][bj][m][0], v1 = acc[ai][bj][m][1];
                    float z[8];
#pragma unroll
                    for (int e = 0; e < 4; ++e) { z[e] = sigmoidf_(g[e]) * v0[e]; z[4 + e] = sigmoidf_(g[4 + e]) * v1[e]; }
                    if (WHICH) { float zo[8]; unp8(*(const v4u*)(Z + row * D + c), zo);
#pragma unroll
                        for (int e = 0; e < 8; ++e) z[e] += zo[e]; }
                    *(v4u*)(Z + row * D + c) = pk8(z); } }
    }
};
__device__ __forceinline__ void ph_branch(Frame& F) {
    pg8::StaticOrder S; S.init(NLAT, D, F.G, (int)blockIdx.x);
    { pg8::Gemm g{(const bf16*)(F.ws + WS_YRW), (const bf16*)(F.ws + WS_WBRRW), NLAT, D, RWW, nullptr};
      EpiBranch<0> E{(bf16*)(F.ws + WS_Z), (const bf16*)(F.ws + WS_P)};
      pg8::gemm_phase<EpiBranch<0>, pg8::StaticOrder, true, true, false>(F.lds, g, S, E); }
    { pg8::Gemm g{(const bf16*)(F.ws + WS_YGLA), (const bf16*)(F.ws + WS_WBRGLA), NLAT, D, RWW, nullptr};
      EpiBranch<1> E{(bf16*)(F.ws + WS_Z), (const bf16*)(F.ws + WS_P)};
      pg8::gemm_phase<EpiBranch<1>, pg8::StaticOrder, true, true, false>(F.lds, g, S, E); }
}
struct EpiOut {
    static constexpr bool PERM = false;
    float* out; const float* x; const float* mod;
    __device__ __forceinline__ void operator()(const f32x4 (&acc)[2][2][4][2], const pg8::Unit& u, int wr, int wc, int fr, int fq) const {
        const int row0 = u.pm * 256 + wr * 64 + fr, col0 = u.pn * 256 + wc * 32 + 4 * fq; const float* g1 = mod + (u.pm / (SEQ / 256)) * 6144 + 2048;
#pragma unroll
        for (int ai = 0; ai < 2; ++ai)
#pragma unroll
            for (int m = 0; m < 4; ++m) { const size_t ro = (size_t)(row0 + ai * 128 + m * 16) * D;
#pragma unroll
                for (int bj = 0; bj < 2; ++bj)
#pragma unroll
                    for (int n = 0; n < 2; ++n) { const int c = col0 + bj * 128 + n * 16;
                        *(f32x4*)(out + ro + c) = *(const f32x4*)(x + ro + c) * ALPHA + *(const f32x4*)(g1 + c) * acc[ai][bj][m][n]; } }
    }
};
__device__ __forceinline__ void ph_outproj(Frame& F) {
    pg8::Gemm g{(const bf16*)(F.ws + WS_Z), (const bf16*)(F.ws + WS_WOUT), NLAT, D, D, nullptr};
    pg8::StaticOrder S; S.init(NLAT, D, F.G, (int)blockIdx.x);
    EpiOut E{F.out, F.in[0], (const float*)(F.ws + WS_MOD)};
    pg8::gemm_phase<EpiOut, pg8::StaticOrder, true, true, false>(F.lds, g, S, E);
}
#endif

#if MS >= 3
constexpr int LP = 72, SLOTB = 64 * LP * 2, LPF = 68, AUX_OFF = 13 * SLOTB;
static_assert(AUX_OFF + 4096 <= MISC_OFF, "scan LDS map");
#define SLOT(n) ((LAS bf16*)(lds + (n) * SLOTB))
__device__ __forceinline__ int scan_row(int s, int b, int dir) {
    if (s < CTXL) return NLAT + b * CTXL + (dir ? (CTXL - 1 - s) : s);
    const int lt = s - CTXL; return b * SEQ + (dir ? (SEQ - 1 - lt) : lt);
}
__device__ __forceinline__ float bf2f(bf16 h) { return __builtin_bit_cast(float, (unsigned)h << 16); }
__device__ __forceinline__ v2u pack4(const f32x4 v) { v2u o; o.x = pk2(v[0], v[1]); o.y = pk2(v[2], v[3]); return o; }
__device__ __forceinline__ f32x4 unpack4(const v2u w) { return (f32x4){bflo(w.x), bfhi(w.x), bflo(w.y), bfhi(w.y)}; }
__device__ __forceinline__ f32x4 mm_tile(const LAS bf16* X, int r0, const LAS bf16* Y, int c0, int lane) {
    const int rr = lane & 15, q = lane >> 4;
    const LAS bf16* xp = X + (r0 + rr) * LP + 8 * q; const LAS bf16* yp = Y + (c0 + rr) * LP + 8 * q;
    const bf16x8 a0 = *(const LAS bf16x8*)xp, a1 = *(const LAS bf16x8*)(xp + 32), b0 = *(const LAS bf16x8*)yp, b1 = *(const LAS bf16x8*)(yp + 32);
    f32x4 acc = (f32x4){0.f, 0.f, 0.f, 0.f};
    acc = __builtin_amdgcn_mfma_f32_16x16x32_bf16(a0, b0, acc, 0, 0, 0);
    acc = __builtin_amdgcn_mfma_f32_16x16x32_bf16(a1, b1, acc, 0, 0, 0);
    return acc;
}
__device__ __forceinline__ float red8(float x) {
    x += __builtin_bit_cast(float, __builtin_amdgcn_update_dpp(0, __builtin_bit_cast(int, x), 0x141, 0xf, 0xf, false));
    x += __builtin_bit_cast(float, __builtin_amdgcn_update_dpp(0, __builtin_bit_cast(int, x), 0xB1, 0xf, 0xf, false));
    x += __builtin_bit_cast(float, __builtin_amdgcn_update_dpp(0, __builtin_bit_cast(int, x), 0x4E, 0xf, 0xf, false));
    return x;
}

__device__ __forceinline__ void s1_rwkv(Frame& F, int u) {
    const int sr = u / NCHUNK, c = u - sr * NCHUNK, rb = sr >> 4, rdir = (sr >> 3) & 1, rh = sr & 7;
    const bool emit = c >= CTXL / CH;
    LAS unsigned char* lds = F.lds; unsigned char* ws = F.ws;
    const int lane = F.lane, wave = F.wave, rr = lane & 15, q = lane >> 4;
    const bf16* RBp = (const bf16*)(ws + WS_RB); const bf16* VBp = (const bf16*)(ws + WS_VB); const bf16* KKp = (const bf16*)(ws + WS_KKB);
    const bf16* KMp = (const bf16*)(ws + (rdir ? WS_KMB : WS_KMF)); const bf16* BVp = (const bf16*)(ws + (rdir ? WS_BVB : WS_BVF)); const float* LWp = (const float*)(ws + (rdir ? WS_LWB : WS_LWF));
    LAS float* tot = (LAS float*)(lds + AUX_OFF); LAS float* gCs = tot + 512;
    {
        float lw[8], xr[8], xk[8], xa[8], xb[8], xv[8];
#pragma unroll
        for (int i = 0; i < 8; ++i) { const int row = scan_row(c * CH + 8 * wave + i, rb, rdir); const size_t base = (size_t)row * RWW + rh * 64 + lane;
            lw[i] = LWp[base]; xr[i] = bf2f(RBp[base]); xk[i] = bf2f(KMp[base]); xa[i] = -bf2f(KKp[base]); xb[i] = bf2f(BVp[base]); xv[i] = bf2f(VBp[base]); }
        float p[8]; p[0] = lw[0];
#pragma unroll
        for (int i = 1; i < 8; ++i) p[i] = p[i - 1] + lw[i];
        tot[wave * 64 + lane] = p[7];
        __syncthreads();
        float off = 0.f, all = 0.f;
#pragma unroll
        for (int w = 0; w < 8; ++w) { const float t = tot[w * 64 + lane]; all += t; off += (w < wave) ? t : 0.f; }
        if (wave == 0) gCs[lane] = __expf(all);
        float at[8], bb[8], kb[8];
#pragma unroll
        for (int i = 0; i < 8; ++i) { const float cum = off + p[i]; const float g = __expf(cum), gi = __expf(-cum), gp = __expf(cum - lw[i]), gc = __expf(all - cum);
            const int t = 8 * wave + i;
            at[i] = xa[i] * gp; bb[i] = xb[i] * gc; kb[i] = xk[i] * gc;
            SLOT(0)[t * LP + lane] = (bf16)f2bf(at[i]);
            SLOT(1)[t * LP + lane] = (bf16)f2bf(xr[i] * g);
            SLOT(2)[t * LP + lane] = (bf16)f2bf(xb[i] * gi);
            SLOT(3)[t * LP + lane] = (bf16)f2bf(xk[i] * gi); }
        *(LAS v4u*)(SLOT(4) + lane * LP + 8 * wave) = pk8(at);
        *(LAS v4u*)(SLOT(5) + lane * LP + 8 * wave) = pk8(xv);
        *(LAS v4u*)(SLOT(6) + lane * LP + 8 * wave) = pk8(bb);
        *(LAS v4u*)(SLOT(7) + lane * LP + 8 * wave) = pk8(kb);
        __syncthreads();
    }
    LAS float* Lp = (LAS float*)(lds + 8 * SLOTB);
#pragma unroll
    for (int tix = 0; tix < 2; ++tix) { const int ti = 2 * wave + tix, r0 = 16 * (ti >> 2), c0 = 16 * (ti & 3), ci = c0 + rr;
        { const f32x4 acc = mm_tile(SLOT(2), r0, SLOT(0), c0, lane);
#pragma unroll
            for (int e = 0; e < 4; ++e) { const int i = r0 + 4 * q + e; Lp[ci * LPF + (i & 7) * 8 + (i >> 3)] = (i < ci) ? acc[e] : 0.f; } }
        { f32x4 acc = mm_tile(SLOT(0), r0, SLOT(3), c0, lane);
#pragma unroll
            for (int e = 0; e < 4; ++e) acc[e] = (ci < r0 + 4 * q + e) ? acc[e] : 0.f;
            *(LAS v2u*)(SLOT(10) + ci * LP + r0 + 4 * q) = pack4(acc); }
        if (emit) {
            { f32x4 acc = mm_tile(SLOT(2), r0, SLOT(1), c0, lane);
#pragma unroll
                for (int e = 0; e < 4; ++e) acc[e] = (r0 + 4 * q + e <= ci) ? acc[e] : 0.f;
                *(LAS v2u*)(SLOT(11) + ci * LP + r0 + 4 * q) = pack4(acc); }
            { f32x4 acc = mm_tile(SLOT(3), r0, SLOT(1), c0, lane);
#pragma unroll
                for (int e = 0; e < 4; ++e) acc[e] = (r0 + 4 * q + e <= ci) ? acc[e] : 0.f;
                *(LAS v2u*)(SLOT(12) + ci * LP + r0 + 4 * q) = pack4(acc); }
        }
    }
    __syncthreads();
    {
        const int j = 8 * wave + (lane >> 3), s = lane & 7;
        float Tr[8] = {0.f, 0.f, 0.f, 0.f, 0.f, 0.f, 0.f, 0.f};
#pragma unroll
        for (int t = 0; t < 64; ++t) {
            const f32x4 l0 = *(const LAS f32x4*)(Lp + t * LPF + s * 8), l1 = *(const LAS f32x4*)(Lp + t * LPF + s * 8 + 4);
            float acc = (l0.x * Tr[0] + l0.y * Tr[1]) + (l0.z * Tr[2] + l0.w * Tr[3]) + ((l1.x * Tr[4] + l1.y * Tr[5]) + (l1.z * Tr[6] + l1.w * Tr[7]));
            acc = red8(acc);
            const float val = acc + ((t == j) ? 1.f : 0.f);
            Tr[t >> 3] = (s == (t & 7)) ? val : Tr[t >> 3];
            SLOT(0)[t * LP + j] = (bf16)f2bf(val);
        }
    }
    __syncthreads();
#pragma unroll
    for (int tix = 0; tix < 2; ++tix) { const int ti = 2 * wave + tix, r0 = 16 * (ti >> 2), c0 = 16 * (ti & 3), ci = c0 + rr;
        { const f32x4 acc = mm_tile(SLOT(0), r0, SLOT(4), c0, lane); *(LAS v2u*)(SLOT(2) + ci * LP + r0 + 4 * q) = pack4(acc); }
        { const f32x4 acc = mm_tile(SLOT(0), r0, SLOT(10), c0, lane); *(LAS v2u*)(SLOT(3) + ci * LP + r0 + 4 * q) = pack4(acc); }
    }
    __syncthreads();
    bf16* RH = (bf16*)(ws + WS_RH) + (size_t)u * 4096; bf16* GT = (bf16*)((unsigned char*)F.out + OUT_GT) + (size_t)u * 4096;
#pragma unroll
    for (int tix = 0; tix < 2; ++tix) { const int ti = 2 * wave + tix, tr = ti >> 2, r0 = 16 * tr, c0 = 16 * (ti & 3), ci = c0 + rr;
        const int pos = (tr >> 1) * 32 + q * 8 + 4 * (tr & 1);
        if (emit) {
            { f32x4 acc = mm_tile(SLOT(2), r0, SLOT(11), c0, lane);
                acc += unpack4(*(const LAS v2u*)(SLOT(1) + ci * LP + r0 + 4 * q));
                *(v2u*)(RH + ci * 64 + pos) = pack4(acc); }
            { f32x4 acc = mm_tile(SLOT(3), r0, SLOT(11), c0, lane);
                acc += unpack4(*(const LAS v2u*)(SLOT(12) + ci * LP + r0 + 4 * q));
                *(LAS v2u*)(SLOT(4) + ci * LP + r0 + 4 * q) = pack4(acc); }
        }
        { f32x4 acc = mm_tile(SLOT(2), r0, SLOT(6), c0, lane);
            const float gc = gCs[ci];
#pragma unroll
            for (int e = 0; e < 4; ++e) acc[e] += (r0 + 4 * q + e == ci) ? gc : 0.f;
            *(v2u*)(GT + ci * 64 + pos) = pack4(acc); }
    }
    __syncthreads();
    bf16* YL = (bf16*)(ws + WS_YL) + (size_t)u * 4096;
#pragma unroll
    for (int tix = 0; tix < 2; ++tix) { const int ti = 2 * wave + tix, r0 = 16 * (ti >> 2), c0 = 16 * (ti & 3), ci = c0 + rr;
        if (emit) { const f32x4 acc = mm_tile(SLOT(5), r0, SLOT(4), c0, lane); *(v2u*)(YL + ci * 64 + r0 + 4 * q) = pack4(acc); }
        { f32x4 acc = mm_tile(SLOT(3), r0, SLOT(6), c0, lane);
            acc += unpack4(*(const LAS v2u*)(SLOT(7) + ci * LP + r0 + 4 * q));
            *(LAS v2u*)(SLOT(8) + ci * LP + r0 + 4 * q) = pack4(acc); }
    }
    __syncthreads();
    bf16* HH = (bf16*)(ws + WS_HH) + (size_t)u * 4096;
#pragma unroll
    for (int tix = 0; tix < 2; ++tix) { const int ti = 2 * wave + tix, r0 = 16 * (ti >> 2), c0 = 16 * (ti & 3), ci = c0 + rr;
        const f32x4 acc = mm_tile(SLOT(8), r0, SLOT(5), c0, lane);
        *(v2u*)(HH + ci * 64 + r0 + 4 * q) = pack4(acc); }
    __syncthreads();
}

__device__ __forceinline__ void s1_gla(Frame& F, int u) {
    const int sg = u / NCHUNK, c = u - sg * NCHUNK, gb = sg >> 3, gdir = (sg >> 2) & 1, gh = sg & 3;
    const bool emit = c >= CTXL / CH;
    LAS unsigned char* lds = F.lds; unsigned char* ws = F.ws;
    const int lane = F.lane, wave = F.wave, rr = lane & 15, q = lane >> 4;
    const bf16* Qp = (const bf16*)(ws + WS_QGB); const bf16* Kp = (const bf16*)(ws + WS_KGB); const bf16* Vp = (const bf16*)(ws + WS_VGB); const float* LAp = (const float*)(ws + (gdir ? WS_LAB : WS_LAF));
    LAS float* tot = (LAS float*)(lds + AUX_OFF);
    bf16* QE = (bf16*)((unsigned char*)F.out + OUT_QE) + (size_t)u * 4096;
    {
        float la[8], xq[8], xk[8], v0[8], v1[8];
#pragma unroll
        for (int i = 0; i < 8; ++i) { const int row = scan_row(c * CH + 8 * wave + i, gb, gdir); const size_t b2 = (size_t)row * 256 + gh * 64 + lane, b5 = (size_t)row * RWW + gh * 128 + lane;
            la[i] = LAp[b2]; xq[i] = bf2f(Qp[b2]); xk[i] = bf2f(Kp[b2]); v0[i] = bf2f(Vp[b5]); v1[i] = bf2f(Vp[b5 + 64]); }
        float p[8]; p[0] = la[0];
#pragma unroll
        for (int i = 1; i < 8; ++i) p[i] = p[i - 1] + la[i];
        tot[wave * 64 + lane] = p[7];
        __syncthreads();
        float off = 0.f, all = 0.f;
#pragma unroll
        for (int w = 0; w < 8; ++w) { const float t = tot[w * 64 + lane]; all += t; off += (w < wave) ? t : 0.f; }
        if (wave == 0) ((float*)(ws + WS_DD))[(size_t)u * 64 + lane] = __expf(all);
        float kl[8];
#pragma unroll
        for (int i = 0; i < 8; ++i) { const float cum = off + p[i]; const int t = 8 * wave + i;
            const bf16 qe = (bf16)f2bf(xq[i] * __expf(cum));
            SLOT(0)[t * LP + lane] = qe;
            if (emit) QE[t * 64 + lane] = qe;
            SLOT(1)[t * LP + lane] = (bf16)f2bf(xk[i] * __expf(-cum));
            kl[i] = xk[i] * __expf(all - cum); }
        *(LAS v4u*)(SLOT(2) + lane * LP + 8 * wave) = pk8(kl);
        *(LAS v4u*)(SLOT(3) + lane * LP + 8 * wave) = pk8(v0);
        *(LAS v4u*)(SLOT(3) + (64 + lane) * LP + 8 * wave) = pk8(v1);
        __syncthreads();
    }
    if (emit) {
#pragma unroll
        for (int tix = 0; tix < 2; ++tix) { const int ti = 2 * wave + tix, r0 = 16 * (ti >> 2), c0 = 16 * (ti & 3), ci = c0 + rr;
            f32x4 acc = mm_tile(SLOT(1), r0, SLOT(0), c0, lane);
#pragma unroll
            for (int e = 0; e < 4; ++e) acc[e] = (r0 + 4 * q + e <= ci) ? acc[e] : 0.f;
            *(LAS v2u*)(SLOT(5) + ci * LP + r0 + 4 * q) = pack4(acc); }
    }
    bf16* KV = (bf16*)(ws + WS_KV) + (size_t)u * 8192;
#pragma unroll
    for (int tix = 0; tix < 4; ++tix) { const int ti = 4 * wave + tix, r0 = 16 * (ti >> 3), c0 = 16 * (ti & 7), ci = c0 + rr;
        const f32x4 acc = mm_tile(SLOT(2), r0, SLOT(3), c0, lane);
        *(v2u*)(KV + ci * 64 + r0 + 4 * q) = pack4(acc); }
    __syncthreads();
    if (emit) {
        bf16* IN = (bf16*)(ws + WS_INTRA) + (size_t)u * 8192;
#pragma unroll
        for (int tix = 0; tix < 4; ++tix) { const int ti = 4 * wave + tix, r0 = 16 * (ti >> 2), c0 = 16 * (ti & 3), ci = c0 + rr;
            const f32x4 acc = mm_tile(SLOT(3), r0, SLOT(5), c0, lane);
            *(v2u*)(IN + ci * 128 + r0 + 4 * q) = pack4(acc); }
    }
    __syncthreads();
}

__device__ __forceinline__ void ph_scan1(Frame& F) {
    for (int u = blockIdx.x; u < NU_RW; u += F.G) s1_rwkv(F, u);
    for (int u = blockIdx.x; u < NU_GL; u += F.G) s1_gla(F, u);
}

__device__ __forceinline__ bf16x8 pack_frag(const f32x4 lo, const f32x4 hi) {
    v4u w; w.x = pk2(lo[0], lo[1]); w.y = pk2(lo[2], lo[3]); w.z = pk2(hi[0], hi[1]); w.w = pk2(hi[2], hi[3]); return __builtin_bit_cast(bf16x8, w);
}
constexpr int S2_D = 3, S2_R = 4, S2_RW = 8192 + 8192 + 2048 + 2048, S2_GL = 8192 + 2048 + 2048 + 1024, S2_SLOT = S2_RW + S2_GL;
static_assert(S2_R * S2_SLOT <= MISC_OFF, "S2 ring fits in LDS");
__device__ __forceinline__ void s2_issue(LAS unsigned char* lds, int sb, int lw, int lane, size_t ur, size_t ug, int v0r, int v0g,
                                         const unsigned char* GTb, const unsigned char* RHb, const unsigned char* HHb, const unsigned char* YLb,
                                         const unsigned char* QEb, const unsigned char* KVb, const unsigned char* INb, const unsigned char* DDb) {
#pragma unroll
    for (int j = 0; j < 6; ++j) {
        int k = lw * 6 + j; if (k >= 33) k -= 5;
        const unsigned char* src; int ldo;
        if (k < 16) { const int n = k & 7, pu = n * 64 + lane, row = pu >> 3, c16 = (pu & 7) ^ (row & 7);
            src = (k < 8 ? GTb : RHb) + ur * 8192 + row * 128 + c16 * 16; ldo = (k < 8 ? 0 : 8192) + n * 1024; }
        else if (k < 18) { const int n = k - 16, pu = n * 64 + lane, v = pu >> 3, c16 = (pu & 7) ^ (v & 7);
            src = HHb + ur * 8192 + (size_t)(v0r + v) * 128 + c16 * 16; ldo = 16384 + n * 1024; }
        else if (k < 20) { const int n = k - 18, pu = n * 64 + lane, t = pu >> 1;
            src = YLb + ur * 8192 + t * 128 + v0r * 2 + (pu & 1) * 16; ldo = 18432 + n * 1024; }
        else if (k < 28) { const int n = k - 20, pu = n * 64 + lane, row = pu >> 3, c16 = (pu & 7) ^ (row & 7);
            src = QEb + ug * 8192 + row * 128 + c16 * 16; ldo = S2_RW + n * 1024; }
        else if (k < 30) { const int n = k - 28, pu = n * 64 + lane, v = pu >> 3, c16 = (pu & 7) ^ (v & 7);
            src = KVb + ug * 16384 + (size_t)(v0g + v) * 128 + c16 * 16; ldo = S2_RW + 8192 + n * 1024; }
        else if (k < 32) { const int n = k - 30, pu = n * 64 + lane, t = pu >> 1;
            src = INb + ug * 16384 + t * 256 + v0g * 2 + (pu & 1) * 16; ldo = S2_RW + 10240 + n * 1024; }
        else { src = DDb + ug * 256 + (lane & 15) * 16; ldo = S2_RW + 12288; }
        __builtin_amdgcn_global_load_lds((const unsigned*)src, (LAS unsigned*)(lds + sb + ldo), 16, 0, 0);
    }
}
__device__ __forceinline__ void ph_scan2(Frame& F) {
    const int lane = F.lane, wave = F.wave, rr = lane & 15, q = lane >> 4; unsigned char* ws = F.ws; LAS unsigned char* lds = F.lds;
    const int it = (F.G == 256) ? (int)(blockIdx.x & 7) * 32 + (int)(blockIdx.x >> 3) : (int)blockIdx.x;
    const int sr = it >> 2, v0r = 16 * (it & 3), rb = sr >> 4, rdir = (sr >> 3) & 1, rh = sr & 7;
    const int sg = it >> 3, v0g = 16 * (it & 7), gb = sg >> 3, gdir = (sg >> 2) & 1, gh = sg & 3;
#define S2_BAR() do { asm volatile("s_waitcnt lgkmcnt(0)" ::: "memory"); __builtin_amdgcn_s_barrier(); asm volatile("" ::: "memory"); } while (0)
    if (wave >= 2) {
        const unsigned char* GTb = (const unsigned char*)F.out + OUT_GT; const unsigned char* QEb = (const unsigned char*)F.out + OUT_QE;
        const unsigned char* RHb = ws + WS_RH; const unsigned char* YLb = ws + WS_YL; const unsigned char* HHb = ws + WS_HH; const unsigned char* KVb = ws + WS_KV; const unsigned char* INb = ws + WS_INTRA;
        const unsigned char* DDb = ws + WS_DD;
#define S2_ISSUE(cc) s2_issue(lds, ((cc) % S2_R) * S2_SLOT, wave - 2, lane, (size_t)(sr * NCHUNK + ((cc) < NCHUNK ? (cc) : NCHUNK - 1)), (size_t)(sg * NCHUNK + ((cc) < NCHUNK ? (cc) : NCHUNK - 1)), v0r, v0g, GTb, RHb, HHb, YLb, QEb, KVb, INb, DDb)
        S2_ISSUE(0); S2_ISSUE(1); S2_ISSUE(2);
#pragma unroll 1
        for (int c = 0; c < NCHUNK; ++c) {
            asm volatile("s_waitcnt vmcnt(12) ; S2WAIT" ::: "memory");
            S2_BAR();
            S2_ISSUE(c + S2_D);
        }
#undef S2_ISSUE
    } else if (wave == 0) {
        bf16* ORW = (bf16*)(ws + (rdir ? WS_ORWB : WS_ORWF));
        f32x4 S[4];
#pragma unroll
        for (int m = 0; m < 4; ++m) S[m] = (f32x4){0.f, 0.f, 0.f, 0.f};
#pragma unroll 1
        for (int c = 0; c < NCHUNK; ++c) {
            S2_BAR();
            const LAS unsigned char* sl = lds + (c % S2_R) * S2_SLOT;
            const bf16x8 Sf0 = pack_frag(S[0], S[1]), Sf1 = pack_frag(S[2], S[3]);
            if (c >= CTXL / CH) {
#pragma unroll
                for (int tt = 0; tt < 4; ++tt) {
                    const int t = 16 * tt + rr;
                    const bf16x8 R0 = *(const LAS bf16x8*)(sl + 8192 + (t * 8 + (q ^ (t & 7))) * 16), R1 = *(const LAS bf16x8*)(sl + 8192 + (t * 8 + ((4 + q) ^ (t & 7))) * 16);
                    f32x4 acc = unpack4(*(const LAS v2u*)(sl + 18432 + t * 32 + q * 8));
                    acc = __builtin_amdgcn_mfma_f32_16x16x32_bf16(Sf0, R0, acc, 0, 0, 0);
                    acc = __builtin_amdgcn_mfma_f32_16x16x32_bf16(Sf1, R1, acc, 0, 0, 0);
                    const int row = scan_row(c * CH + t, rb, rdir);
                    *(v2u*)(ORW + (size_t)row * RWW + rh * 64 + v0r + 4 * q) = pack4(acc);
                }
            }
#pragma unroll
            for (int m = 0; m < 4; ++m) { const int k2 = 16 * m + rr;
                const bf16x8 G0 = *(const LAS bf16x8*)(sl + (k2 * 8 + (q ^ (k2 & 7))) * 16), G1 = *(const LAS bf16x8*)(sl + (k2 * 8 + ((4 + q) ^ (k2 & 7))) * 16);
                f32x4 acc = unpack4(*(const LAS v2u*)(sl + 16384 + (rr * 8 + ((2 * m + (q >> 1)) ^ (rr & 7))) * 16 + (q & 1) * 8));
                acc = __builtin_amdgcn_mfma_f32_16x16x32_bf16(G0, Sf0, acc, 0, 0, 0);
                acc = __builtin_amdgcn_mfma_f32_16x16x32_bf16(G1, Sf1, acc, 0, 0, 0);
                S[m] = acc; }
        }
    } else {
        bf16* OGL = (bf16*)(ws + (gdir ? WS_OGLB : WS_OGLF));
        f32x4 S[4];
#pragma unroll
        for (int m = 0; m < 4; ++m) S[m] = (f32x4){0.f, 0.f, 0.f, 0.f};
#pragma unroll 1
        for (int c = 0; c < NCHUNK; ++c) {
            S2_BAR();
            const LAS unsigned char* sl = lds + (c % S2_R) * S2_SLOT + S2_RW;
            if (c >= CTXL / CH) {
                const bf16x8 Sf0 = pack_frag(S[0], S[1]), Sf1 = pack_frag(S[2], S[3]);
#pragma unroll
                for (int tt = 0; tt < 4; ++tt) {
                    const int t = 16 * tt + rr;
                    const bf16x8 Q0 = *(const LAS bf16x8*)(sl + (t * 8 + (q ^ (t & 7))) * 16), Q1 = *(const LAS bf16x8*)(sl + (t * 8 + ((4 + q) ^ (t & 7))) * 16);
                    f32x4 acc = unpack4(*(const LAS v2u*)(sl + 10240 + t * 32 + q * 8));
                    acc = __builtin_amdgcn_mfma_f32_16x16x32_bf16(Sf0, Q0, acc, 0, 0, 0);
                    acc = __builtin_amdgcn_mfma_f32_16x16x32_bf16(Sf1, Q1, acc, 0, 0, 0);
                    const int row = scan_row(c * CH + t, gb, gdir);
                    *(v2u*)(OGL + (size_t)row * RWW + gh * 128 + v0g + 4 * q) = pack4(acc);
                }
            }
#pragma unroll
            for (int s2 = 0; s2 < 2; ++s2) { const v4u kw = *(const LAS v4u*)(sl + 8192 + (rr * 8 + ((4 * s2 + q) ^ (rr & 7))) * 16);
                const f32x4 d0 = *(const LAS f32x4*)(sl + 12288 + 128 * s2 + 32 * q), d1 = *(const LAS f32x4*)(sl + 12288 + 128 * s2 + 32 * q + 16);
                S[2 * s2] = S[2 * s2] * d0 + unpack4((v2u){kw.x, kw.y}); S[2 * s2 + 1] = S[2 * s2 + 1] * d1 + unpack4((v2u){kw.z, kw.w}); }
        }
    }
#undef S2_BAR
}
#endif

#ifndef ML
#define ML 0
#endif
enum Phase { PH_PROLOGUE = 0, PH_A1, PH_INPROJ, PH_FEAT, PH_LORA, PH_SCAN1, PH_SCAN2, PH_MERGE, PH_BRANCH, PH_OUTPROJ, PH_LN1, PH_ROUTER, PH_ROUTE, PH_SCATTER, PH_EXP1, PH_EXP2, PH_FINAL, PH_COUNT };

__global__ void __launch_bounds__(NTHR, 2) mega(Args args) {
    extern __shared__ __attribute__((aligned(16))) unsigned char lds_raw[];
    Frame F;
    F.lds = (LAS unsigned char*)lds_raw;
    F.tid = threadIdx.x; F.lane = F.tid & 63; F.wave = __builtin_amdgcn_readfirstlane(F.tid >> 6);
    F.G = gridDim.x; F.gw = blockIdx.x * NWAVES + F.wave; F.NGW = F.G * NWAVES;
    F.in = args.in; F.out = args.out; F.ws = args.ws; F.ctl = (unsigned*)(args.ws + WS_CTL);
    volatile LAS unsigned* MISC = (volatile LAS unsigned*)(F.lds + MISC_OFF);
    if (F.tid < 64) MISC[F.tid] = 0u;
    __syncthreads();
    XcdBarrier bar; bar.bar = F.ctl + CW_BAR; bar.x = 0; bar.st = nullptr;
#if !ML
    bar = xcd_barrier_post(F.ctl + CW_BAR, MISC + 8);
#endif
    const int lo = args.ph_lo, hi = args.ph_hi;
#define IN(k) (lo <= (k) && (k) < hi)
#ifndef DUP
#define DUP -1
#endif
#define RUN(k, call) do { if (IN(k)) { call; GRID_BAR(); if (DUP == (k)) { call; GRID_BAR(); } } } while (0)
#if ML
#define GRID_BAR() do { } while (0)
#else
#define GRID_BAR() xcd_barrier(bar)
#endif

#if MS >= 2
    RUN(PH_PROLOGUE, ph_prologue(F));
#endif
#if MS >= 3
    RUN(PH_A1, ph_a1(F));
    RUN(PH_INPROJ, ph_inproj(F));
    RUN(PH_FEAT, ph_feat(F));
    RUN(PH_LORA, ph_lora(F));
    RUN(PH_SCAN1, ph_scan1(F));
    RUN(PH_SCAN2, ph_scan2(F));
    RUN(PH_MERGE, ph_merge(F));
    RUN(PH_BRANCH, ph_branch(F));
    RUN(PH_OUTPROJ, ph_outproj(F));
#else
    RUN(PH_OUTPROJ, ph_x1pre_nomix(F));
#endif
    RUN(PH_LN1, ph_ln1(F));
#if MS >= 2
    RUN(PH_ROUTER, ph_router(F));
    RUN(PH_ROUTE, ph_route(F));
    RUN(PH_SCATTER, ph_scatter(F));
    RUN(PH_EXP1, ph_exp1(F));
    RUN(PH_EXP2, ph_exp2(F));
#endif
    if (IN(PH_FINAL)) { ph_final(F); }
#undef IN
}

extern "C" void kernel_launch(void* const* d_in, const int* in_sizes, int n_in, void* d_out, int out_size, void* d_ws, size_t ws_size, hipStream_t stream) {
    static int grid = 0;
    if (grid == 0) {
        if (n_in != 36 || out_size != NLAT * D || ws_size < WS_END) { fprintf(stderr, "kernel_launch: unexpected problem shape (n_in %d, out %d)\n", n_in, out_size); grid = -1; return; }
        int dev = 0, cus = 0, per_cu = 0;
        if (hipGetDevice(&dev) != hipSuccess || hipDeviceGetAttribute(&cus, hipDeviceAttributeMultiprocessorCount, dev) != hipSuccess) { grid = -1; return; }
        if (hipFuncSetAttribute((const void*)mega, hipFuncAttributeMaxDynamicSharedMemorySize, LDS_BYTES) != hipSuccess) { fprintf(stderr, "kernel_launch: hipFuncSetAttribute failed\n"); grid = -1; return; }
        if (hipOccupancyMaxActiveBlocksPerMultiprocessor(&per_cu, (const void*)mega, NTHR, LDS_BYTES) != hipSuccess || per_cu < 1) { fprintf(stderr, "kernel_launch: occupancy query says %d\n", per_cu); }
        (void)hipGetLastError();
        grid = cus > 0 ? cus : 256;
        if (grid > 256) grid = 256;
    }
    if (grid < 0) return;
    (void)hipMemsetAsync((char*)d_ws + WS_CTL, 0, CTL_ZERO_BYTES, stream);
    Args a{};
    for (int i = 0; i < 36; ++i) a.in[i] = (const float*)d_in[i];
    a.out = (float*)d_out; a.ws = (unsigned char*)d_ws;
#if ML
    for (int p = 0; p < PH_COUNT; ++p) { a.ph_lo = p; a.ph_hi = p + 1; hipLaunchKernelGGL(mega, dim3(grid), dim3(NTHR), LDS_BYTES, stream, a); }
#else
    a.ph_lo = 0; a.ph_hi = PH_COUNT;
    hipLaunchKernelGGL(mega, dim3(grid), dim3(NTHR), LDS_BYTES, stream, a);
#endif
}
```

```cpp
#include <hip/hip_runtime.h>
#include <cstdio>
#include <cstdint>

#ifndef MS
#define MS 3
#endif

#define GAS __attribute__((address_space(1)))
#define LAS __attribute__((address_space(3)))
typedef unsigned short bf16;
typedef unsigned v4u __attribute__((ext_vector_type(4)));
typedef unsigned v2u __attribute__((ext_vector_type(2)));
typedef float f32x4 __attribute__((ext_vector_type(4)));
typedef float f32x2 __attribute__((ext_vector_type(2)));
typedef short bf16x8 __attribute__((ext_vector_type(8)));
#define LDS_WAIT() asm volatile("s_waitcnt lgkmcnt(0)" ::: "memory")
#define VM_WAIT() asm volatile("s_waitcnt vmcnt(0)" ::: "memory")

constexpr int D = 1024, NB = 4, SEQ = 8192, CTXL = 256, GRIDW = 64, GRIDH = 128;
constexpr int NLAT = NB * SEQ, NCTX = NB * CTXL, MR = NLAT + NCTX;
constexpr int RWW = 512, RWH = 8, HD = 64;
constexpr int C_R = 0, C_K = 512, C_V = 1024, C_PW = 1536, C_PA = 1568, C_PG = 1600, C_Q = 1696, C_KG = 1952, C_VG = 2208, C_PGL = 2720, C_OG = 2736, C_GRW = 3248, C_GGLA = 4272;
constexpr int IN_COLS = 5296, NP = 5376;
constexpr int NE = 256, TOPK = 8, FF = 256;
constexpr float LN_EPS = 1e-5f, RW_GN_EPS = 64e-5f;
constexpr float ALPHA = 1.189207115f;
constexpr int NLORA = 3072, KLORA = 256;
constexpr int MAXTILES = 1280, SH_ROW0 = MAXTILES * 256, NROWS_E = SH_ROW0 + NLAT;

namespace pg8 {
#define PG8_LAS __attribute__((address_space(3)))
typedef unsigned short bf16_t;
typedef unsigned u32x4 __attribute__((ext_vector_type(4)));
typedef unsigned u32x2 __attribute__((ext_vector_type(2)));
constexpr int BM = 256, BK = 64, HALF = 128, HTB = HALF * BK * 2, STAGE_BYTES = 8 * HTB, NXCD = 8, WGM = 8;
constexpr int IDX_OFF = STAGE_BYTES, IDX_UNITS = 12;

__host__ __device__ __forceinline__ int lds_byte(int r, int c) { const int st = (r >> 4) * 2 + (c >> 5), rr = r & 15, cc = c & 31, ob = rr * 64 + cc * 2; return st * 1024 + (ob ^ (((ob >> 9) & 1) << 5)); }
__host__ __device__ __forceinline__ void stage_rc(int b, int& R, int& C) { const int st = b / 1024, sb = b % 1024, swz = sb ^ (((sb >> 9) & 1) << 5); R = (st >> 1) * 16 + swz / 64; C = (st & 1) * 32 + (swz % 64) / 2; }
__host__ __device__ __forceinline__ int perm32(int rho) { const int n = rho >> 4, i = rho & 15; return 8 * (i >> 2) + 4 * n + (i & 3); }

struct Unit { int pm, pn, e, j; };
struct Gemm { const bf16_t* A; const bf16_t* Bt; int M, N, K; const int* rowidx; };

struct StaticOrder {
    int nM, nN, nwg, G, c;
    __host__ __device__ void init(int M, int N, int G_, int c_) { nM = M / BM; nN = N / BM; nwg = nM * nN; G = G_; c = c_; }
    __host__ __device__ bool next(int i, Unit& u) const {
        const long L = (long)i * G + c; if (L >= nwg) return false;
        int wgid = (int)L; { const int q = nwg / NXCD, r = nwg % NXCD, xcd = wgid % NXCD, off = wgid / NXCD; wgid = (xcd < r ? xcd * (q + 1) : r * (q + 1) + (xcd - r) * q) + off; }
        const int nig = WGM * nN, gid = wgid / nig, fm = gid * WGM, gsz = (nM - fm) < WGM ? (nM - fm) : WGM;
        u.pm = fm + ((wgid % nig) % gsz); u.pn = (wgid % nig) / gsz; u.e = 0; u.j = u.pn; return true;
    }
};
struct MoeOrder {
    int nN, G, c, NT; const int* tile_e;
    __device__ bool next(int i, Unit& u) const {
        const int L = i * G + c; const int total = (NT + NLAT / 256) * nN; if (L >= total) return false;
        const int tile = L / nN, j = L - tile * nN; int e, pm;
        if (tile < NT) { e = tile_e[tile]; pm = tile; } else { e = NE; pm = MAXTILES + (tile - NT); }
        u.pm = pm; u.pn = e * nN + j; u.e = e; u.j = j; return true;
    }
};

typedef __bf16 bf16x2n __attribute__((ext_vector_type(2))); typedef float f32x2n __attribute__((ext_vector_type(2)));
__device__ __forceinline__ unsigned cvt_pk_bf16(float lo, float hi) { const f32x2n v = {lo, hi}; return __builtin_bit_cast(unsigned, __builtin_convertvector(v, bf16x2n)); }

template <class Epi, class Sched, bool ALIGN_EPI, bool SP2, bool GATHER>
__device__ __forceinline__ void gemm_phase(PG8_LAS unsigned char* lds, const Gemm g, const Sched& S, const Epi& E) {
    const int tid = threadIdx.x, wid = __builtin_amdgcn_readfirstlane(tid >> 6), lane = tid & 63, wr = wid >> 2, wc = wid & 3, fr = lane & 15, fq = lane >> 4;
    const int K = g.K, nt = K / BK;
    const size_t kstep = (size_t)(BK * 2);
    const size_t hstep = (size_t)HALF * K * 2;
    const size_t tstep = 2 * hstep;
    unsigned voffB[2]; unsigned va[2][2];
#pragma unroll
    for (int i = 0; i < 2; ++i) { int R, C; stage_rc(tid * 16 + i * 8192, R, C); const int Rb = Epi::PERM ? ((R & ~31) + perm32(R & 31)) : R;
        voffB[i] = (unsigned)(Rb * K + C) * 2u;
        va[0][i] = (unsigned)(R * K + C) * 2u; va[1][i] = va[0][i]; }
    const size_t ah = GATHER ? (size_t)0 : hstep;
#define PG8_GOFF(dst, ub) do { _Pragma("unroll") for (int _h = 0; _h < 2; ++_h) _Pragma("unroll") for (int _i = 0; _i < 2; ++_i) { int _R, _C; stage_rc(tid * 16 + _i * 8192, _R, _C); \
        dst[_h][_i] = (unsigned)(idxt[(ub) * 256 + _h * 128 + _R] * K + _C) * 2u; } } while (0)
    const unsigned ldsw = (unsigned)wid * 1024u;
    const int aoff = lds_byte(wr * 64 + fr, fq * 8), boff = lds_byte(wc * 32 + fr, fq * 8);
    PG8_LAS int* idxt = (PG8_LAS int*)(lds + IDX_OFF);
#define PG8_SA(b, h) (((b) * 2 + (h)) * HTB)
#define PG8_SB(b, h) ((4 + (b) * 2 + (h)) * HTB)
#define PG8_STAGE(bufoff, gbase, voff) do { _Pragma("unroll") for (int _i = 0; _i < 2; ++_i) \
        __builtin_amdgcn_global_load_lds((const unsigned*)((const char*)(gbase) + (voff)[_i]), (PG8_LAS unsigned*)(lds + (bufoff) + ldsw + _i * 8192), 16, 0, 0); } while (0)
#define PG8_LDA(dst, b, h) do { _Pragma("unroll") for (int m = 0; m < 4; ++m) _Pragma("unroll") for (int k = 0; k < 2; ++k) dst[m][k] = *(const PG8_LAS bf16x8*)(lds + PG8_SA(b, h) + aoff + m * 2048 + k * 1024); } while (0)
#define PG8_LDB(dst, b, h) do { _Pragma("unroll") for (int n = 0; n < 2; ++n) _Pragma("unroll") for (int k = 0; k < 2; ++k) dst[n][k] = *(const PG8_LAS bf16x8*)(lds + PG8_SB(b, h) + boff + n * 2048 + k * 1024); } while (0)
#define PG8_MMA(ai, bj, At, Bt) do { __builtin_amdgcn_s_setprio(1); _Pragma("unroll") for (int m = 0; m < 4; ++m) _Pragma("unroll") for (int n = 0; n < 2; ++n) _Pragma("unroll") for (int k = 0; k < 2; ++k) \
        acc[ai][bj][m][n] = __builtin_amdgcn_mfma_f32_16x16x32_bf16(Bt[n][k], At[m][k], acc[ai][bj][m][n], 0, 0, 0); __builtin_amdgcn_s_setprio(0); } while (0)
#define PG8_WAIT_V(n) asm volatile("s_waitcnt vmcnt(" #n ")" ::: "memory")
#define PG8_WAIT_L(n) asm volatile("s_waitcnt lgkmcnt(" #n ")" ::: "memory")
#define PG8_BAR __builtin_amdgcn_s_barrier()
#define PG8_SCHED __builtin_amdgcn_sched_barrier(0)
    Unit cur, nxt; int ui = 0;
    if (!S.next(0, cur)) return;
    if constexpr (GATHER) {
        Unit uu;
        for (int i = 0; i < IDX_UNITS; ++i) { if (!S.next(i, uu)) break; if (tid < 256) idxt[i * 256 + tid] = g.rowidx[(size_t)uu.pm * 256 + tid]; }
        asm volatile("s_waitcnt vmcnt(0) lgkmcnt(0)" ::: "memory"); PG8_BAR; asm volatile("" ::: "memory");
        PG8_GOFF(va, 0);
    }
    f32x4 acc[2][2][4][2];
#pragma unroll
    for (int a = 0; a < 2; ++a)
#pragma unroll
        for (int b = 0; b < 2; ++b)
#pragma unroll
            for (int m = 0; m < 4; ++m)
#pragma unroll
                for (int n = 0; n < 2; ++n) acc[a][b][m][n] = (f32x4){0.f, 0.f, 0.f, 0.f};
    bf16x8 At[4][2], B0[2][2], B1[2][2];
    const char* cA = (const char*)g.A + (GATHER ? (size_t)0 : (size_t)cur.pm * tstep); const char* cB = (const char*)g.Bt + (size_t)cur.pn * tstep;
    if constexpr (SP2) {
        PG8_STAGE(PG8_SB(0, 0), cB, voffB); PG8_STAGE(PG8_SB(0, 1), cB + hstep, voffB); PG8_STAGE(PG8_SA(0, 0), cA, va[0]); PG8_STAGE(PG8_SA(0, 1), cA + ah, va[1]);
        if (wr == 1) PG8_BAR;
        PG8_WAIT_V(2); PG8_BAR;
        PG8_STAGE(PG8_SB(1, 0), cB + kstep, voffB); PG8_STAGE(PG8_SA(1, 0), cA + kstep, va[0]); PG8_STAGE(PG8_SB(1, 1), cB + hstep + kstep, voffB);
        PG8_WAIT_V(6); PG8_BAR;
    } else {
        PG8_STAGE(PG8_SB(0, 0), cB, voffB); PG8_STAGE(PG8_SA(0, 0), cA, va[0]); PG8_STAGE(PG8_SB(0, 1), cB + hstep, voffB); PG8_STAGE(PG8_SA(0, 1), cA + ah, va[1]);
        if (wr == 1) PG8_BAR;
        PG8_WAIT_V(4); PG8_BAR;
        PG8_STAGE(PG8_SB(1, 0), cB + kstep, voffB); PG8_STAGE(PG8_SA(1, 0), cA + kstep, va[0]); PG8_STAGE(PG8_SB(1, 1), cB + hstep + kstep, voffB);
        PG8_WAIT_V(6); PG8_BAR;
    }
    for (;;) {
        const bool has_next = S.next(ui + 1, nxt);
        const char* nA = has_next ? (const char*)g.A + (GATHER ? (size_t)0 : (size_t)nxt.pm * tstep) : cA; const char* nB = has_next ? (const char*)g.Bt + (size_t)nxt.pn * tstep : cB;
        const int ubn = (has_next && ui + 1 < IDX_UNITS) ? (ui + 1) : ui;
#pragma unroll 1
        for (int t = 0; t < nt; t += 2) {
            const bool last = (t == nt - 2);
            const char* a1 = cA + (size_t)(t + 1) * kstep;
            const char* a2 = last ? nA : cA + (size_t)(t + 2) * kstep; const char* b2 = last ? nB : cB + (size_t)(t + 2) * kstep;
            const char* a3 = a2 + kstep; const char* b3 = b2 + kstep;
            unsigned v2[2][2];
#pragma unroll
            for (int h = 0; h < 2; ++h)
#pragma unroll
                for (int i = 0; i < 2; ++i) v2[h][i] = va[h][i];
            if constexpr (GATHER) { if (last) PG8_GOFF(v2, ubn); }
            if constexpr (SP2) {
            PG8_LDB(B0, 0, 0); PG8_LDB(B1, 0, 1); PG8_SCHED; PG8_LDA(At, 0, 0); PG8_STAGE(PG8_SA(1, 1), a1 + ah, va[1]);
            PG8_WAIT_V(8); PG8_WAIT_L(0); PG8_BAR; PG8_MMA(0, 0, At, B0); PG8_MMA(0, 1, At, B1); PG8_BAR; PG8_SCHED;
            PG8_LDA(At, 0, 1); PG8_STAGE(PG8_SB(0, 0), b2, voffB); PG8_STAGE(PG8_SB(0, 1), b2 + hstep, voffB); PG8_STAGE(PG8_SA(0, 0), a2, v2[0]);
            PG8_WAIT_V(8); PG8_WAIT_L(0); PG8_BAR; PG8_MMA(1, 0, At, B0); PG8_MMA(1, 1, At, B1); PG8_BAR; PG8_SCHED;
            PG8_LDB(B0, 1, 0); PG8_LDB(B1, 1, 1); PG8_SCHED; PG8_LDA(At, 1, 0); PG8_STAGE(PG8_SA(0, 1), a2 + ah, v2[1]);
            PG8_WAIT_V(8); PG8_WAIT_L(0); PG8_BAR; PG8_MMA(0, 0, At, B0); PG8_MMA(0, 1, At, B1); PG8_BAR; PG8_SCHED;
            PG8_LDA(At, 1, 1); PG8_STAGE(PG8_SB(1, 0), b3, voffB); PG8_STAGE(PG8_SB(1, 1), b3 + hstep, voffB); PG8_STAGE(PG8_SA(1, 0), a3, v2[0]);
            PG8_WAIT_V(8); PG8_WAIT_L(0); PG8_BAR; PG8_MMA(1, 0, At, B0); PG8_MMA(1, 1, At, B1); PG8_BAR; PG8_SCHED;
            } else {
            PG8_LDB(B0, 0, 0); PG8_SCHED; PG8_LDA(At, 0, 0); PG8_STAGE(PG8_SA(1, 1), a1 + ah, va[1]);
            PG8_WAIT_L(8); PG8_BAR; PG8_WAIT_L(0); PG8_MMA(0, 0, At, B0); PG8_BAR; PG8_SCHED;
            PG8_LDB(B1, 0, 1); PG8_STAGE(PG8_SB(0, 0), b2, voffB);
            PG8_BAR; PG8_WAIT_L(0); PG8_MMA(0, 1, At, B1); PG8_BAR;
            PG8_LDA(At, 0, 1); PG8_STAGE(PG8_SA(0, 0), a2, v2[0]);
            PG8_BAR; PG8_WAIT_L(0); PG8_MMA(1, 0, At, B0); PG8_BAR; PG8_SCHED;
            PG8_STAGE(PG8_SB(0, 1), b2 + hstep, voffB);
            PG8_WAIT_V(6); PG8_BAR; PG8_MMA(1, 1, At, B1); PG8_BAR;
            PG8_LDB(B0, 1, 0); PG8_SCHED; PG8_LDA(At, 1, 0); PG8_STAGE(PG8_SA(0, 1), a2 + ah, v2[1]);
            PG8_WAIT_L(8); PG8_BAR; PG8_WAIT_L(0); PG8_MMA(0, 0, At, B0); PG8_BAR; PG8_SCHED;
            PG8_LDB(B1, 1, 1); PG8_STAGE(PG8_SB(1, 0), b3, voffB);
            PG8_BAR; PG8_WAIT_L(0); PG8_MMA(0, 1, At, B1); PG8_BAR;
            PG8_LDA(At, 1, 1); PG8_STAGE(PG8_SA(1, 0), a3, v2[0]);
            PG8_BAR; PG8_WAIT_L(0); PG8_MMA(1, 0, At, B0); PG8_BAR; PG8_SCHED;
            PG8_STAGE(PG8_SB(1, 1), b3 + hstep, voffB);
            PG8_WAIT_V(6); PG8_BAR; PG8_MMA(1, 1, At, B1); PG8_BAR;
            }
        }
        if constexpr (ALIGN_EPI) { if (wr == 0) PG8_BAR; }
        E(acc, cur, wr, wc, fr, fq);
        if (!has_next) break;
#pragma unroll
        for (int a = 0; a < 2; ++a)
#pragma unroll
            for (int b = 0; b < 2; ++b)
#pragma unroll
                for (int m = 0; m < 4; ++m)
#pragma unroll
                    for (int n = 0; n < 2; ++n) acc[a][b][m][n] = (f32x4){0.f, 0.f, 0.f, 0.f};
        cur = nxt; cA = nA; cB = nB; ++ui;
        if constexpr (GATHER) PG8_GOFF(va, ubn);
        if constexpr (ALIGN_EPI) { if (wr == 1) PG8_BAR; }
    }
    PG8_WAIT_V(0);
    if constexpr (!ALIGN_EPI) { if (wr == 0) PG8_BAR; }
    PG8_BAR;
#undef PG8_SA
#undef PG8_GOFF
#undef PG8_SB
#undef PG8_STAGE
#undef PG8_LDA
#undef PG8_LDB
#undef PG8_MMA
#undef PG8_WAIT_V
#undef PG8_WAIT_L
#undef PG8_BAR
#undef PG8_SCHED
}
}

#define XB_TMO      128
#define XB_XCNT(j)  (256  + 64 * (j))
#define XB_XSUB(j)  (1280 + 64 * (j))
#define XB_XGEN(j)  (2304 + 64 * (j))
#define XB_TOP      3328
#define XB_TOPGEN   3392
#define XCD_BAR_WORDS 3456
#define XB_SPIN_CAP (1u << 18)
__device__ __forceinline__ unsigned xb_ld(unsigned* p)              { return __hip_atomic_load(p, __ATOMIC_RELAXED, __HIP_MEMORY_SCOPE_AGENT); }
__device__ __forceinline__ unsigned xb_add(unsigned* p, unsigned v) { return __hip_atomic_fetch_add(p, v, __ATOMIC_RELAXED, __HIP_MEMORY_SCOPE_AGENT); }
__device__ __forceinline__ unsigned xb_xcc_id() { return (unsigned)__builtin_amdgcn_s_getreg((3 << 11) | 20) & 0xFu; }
#define XB_SPIN(cond, bar) do { unsigned _sp = 0; while (cond) { __builtin_amdgcn_s_sleep(1); \
    if ((++_sp & 255u) == 0u) { if (xb_ld(&(bar)[XB_TMO])) break; if (_sp > XB_SPIN_CAP) { atomicAdd(&(bar)[XB_TMO], 1u); break; } } } } while (0)
struct XcdBarrier { unsigned* bar; unsigned x; volatile LAS unsigned* st; };
__device__ __forceinline__ XcdBarrier xcd_barrier_post(unsigned* bar, volatile LAS unsigned* st) {
    XcdBarrier b; b.bar = bar; b.x = xb_xcc_id(); b.st = st;
    if (threadIdx.x == 0) (void)xb_add(&bar[XB_XCNT(b.x)], 1u);
    return b;
}
__device__ __forceinline__ void xcd_barrier_complete(unsigned* bar, unsigned x, unsigned& nloc, unsigned& nx) {
    const unsigned G = gridDim.x * gridDim.y * gridDim.z;
    unsigned sum, cnt, mine, sp = 0u;
    for (;;) {
        sum = 0u; cnt = 0u; mine = 0u;
#pragma unroll
        for (unsigned j = 0; j < 16; ++j) { const unsigned c = xb_ld(&bar[XB_XCNT(j)]); sum += c; cnt += (c > 0u) ? 1u : 0u; mine = (j == x) ? c : mine; }
        if (sum == G) break;
        __builtin_amdgcn_s_sleep(1);
        if ((++sp & 255u) == 0u) { if (xb_ld(&bar[XB_TMO])) break; if (sp > XB_SPIN_CAP) { atomicAdd(&bar[XB_TMO], 1u); break; } }
    }
    nloc = mine > 0u ? mine : 1u; nx = cnt > 0u ? cnt : 1u;
}
__device__ __forceinline__ void xcd_barrier(const XcdBarrier& b) {
    asm volatile("s_waitcnt vmcnt(0)" ::: "memory");
    __syncthreads();
    if (threadIdx.x == 0) {
        unsigned* bar = b.bar;
        __builtin_amdgcn_s_waitcnt(0);
        unsigned nloc = b.st[0], nx = b.st[1];
        if (nloc == 0u) { xcd_barrier_complete(bar, b.x, nloc, nx); b.st[0] = nloc; b.st[1] = nx; }
        const unsigned old = xb_add(&bar[XB_XSUB(b.x)], 1u);
        const unsigned gen = old / nloc;
        if (old + 1u == (gen + 1u) * nloc) {
            __builtin_amdgcn_fence(__ATOMIC_RELEASE, "agent");
            asm volatile("s_waitcnt vmcnt(0)" ::: "memory");
            const unsigned og = xb_add(&bar[XB_TOP], 1u);
            const unsigned tg = og / nx;
            if (og + 1u == (tg + 1u) * nx) xb_add(&bar[XB_TOPGEN], 1u);
            else XB_SPIN(xb_ld(&bar[XB_TOPGEN]) == tg, bar);
            __builtin_amdgcn_fence(__ATOMIC_ACQUIRE, "agent");
            xb_add(&bar[XB_XGEN(b.x)], 1u);
            asm volatile("s_waitcnt vmcnt(0)" ::: "memory");
        } else {
            XB_SPIN(xb_ld(&bar[XB_XGEN(b.x)]) == gen, bar);
            __builtin_amdgcn_fence(__ATOMIC_ACQUIRE, "agent");
            asm volatile("s_waitcnt vmcnt(0)" ::: "memory");
        }
    }
    __syncthreads();
}

constexpr size_t MiB = 1u << 20;
constexpr size_t al(size_t x) { return (x + 4095) & ~(size_t)4095; }
constexpr size_t WS_CTL = 0, CTL_ZERO_BYTES = 1 * MiB;
constexpr int CW_BAR = 4096;
constexpr int CW_CNT = 16384;
constexpr int CW_NT = 16384 + 512;
constexpr size_t WS_MOD = 1 * MiB;
constexpr size_t WS_TILE_E = WS_MOD + 256 * 1024;
constexpr size_t WS_PADSTART = WS_TILE_E + 16 * 1024;
constexpr size_t WS_ROWTOK = 2 * MiB;
constexpr size_t WS_EIDX = 4 * MiB;
constexpr size_t WS_GATE = 5 * MiB;
constexpr size_t WS_DEST = 6 * MiB;
constexpr size_t WS_WIN = 8 * MiB;
constexpr size_t WS_WLORA = WS_WIN + al((size_t)NP * D * 2);
constexpr size_t WS_WBRRW = WS_WLORA + al((size_t)NLORA * KLORA * 2);
constexpr size_t WS_WBRGLA = WS_WBRRW + al((size_t)D * RWW * 2);
constexpr size_t WS_WOUT = WS_WBRGLA + al((size_t)D * RWW * 2);
constexpr size_t WS_WROUTER = WS_WOUT + al((size_t)D * D * 2);
constexpr size_t WS_WGU = WS_WROUTER + al((size_t)NE * D * 2);
constexpr size_t WS_WD = WS_WGU + al((size_t)(NE + 1) * 512 * D * 2);
constexpr size_t WS_PERSIST_END = WS_WD + al((size_t)(NE + 1) * D * FF * 2);
constexpr size_t WS_REGB = WS_PERSIST_END;
constexpr size_t SZ512F = al((size_t)MR * RWW * 4), SZ256F = al((size_t)MR * 256 * 4), SZ512H = al((size_t)MR * RWW * 2);
constexpr size_t WS_A1 = WS_REGB;
constexpr size_t WS_A2 = WS_A1;
constexpr size_t WS_KSUM = WS_A2 + al((size_t)MR * KLORA * 2);
static_assert(WS_KSUM + SZ512H <= WS_A1 + al((size_t)MR * D * 2), "A2 + KSUM fit in the A1 slot");
constexpr size_t WS_P = WS_A1 + al((size_t)MR * D * 2);
constexpr size_t WS_RB = WS_P + al((size_t)MR * NP * 2);
constexpr size_t WS_VB = WS_RB + SZ512H, WS_KKB = WS_VB + SZ512H, WS_KMF = WS_KKB + SZ512H, WS_KMB = WS_KMF + SZ512H, WS_BVF = WS_KMB + SZ512H, WS_BVB = WS_BVF + SZ512H;
constexpr size_t WS_LWF = WS_BVB + SZ512H, WS_LWB = WS_LWF + SZ512F;
constexpr size_t SZ256H = al((size_t)MR * 256 * 2);
constexpr size_t WS_QGB = WS_LWB + SZ512F, WS_KGB = WS_QGB + SZ256H, WS_VGB = WS_KGB + SZ256H, WS_LAF = WS_VGB + SZ512H, WS_LAB = WS_LAF + SZ256F;
constexpr size_t WS_RWG = WS_LAB + SZ256F;
constexpr size_t WS_ORWF = WS_RWG + SZ512H, WS_ORWB = WS_ORWF + SZ512H, WS_OGLF = WS_ORWB + SZ512H, WS_OGLB = WS_OGLF + SZ512H;
constexpr int CH = 64, NCHUNK = (CTXL + SEQ) / CH, NU_RW = 64 * NCHUNK, NU_GL = 32 * NCHUNK;
constexpr size_t WS_RH = WS_OGLB + SZ512H;
constexpr size_t WS_YL = WS_RH + al((size_t)NU_RW * 4096 * 2);
constexpr size_t WS_HH = WS_YL + al((size_t)NU_RW * 4096 * 2);
constexpr size_t WS_INTRA = WS_HH + al((size_t)NU_RW * 4096 * 2);
constexpr size_t WS_KV = WS_INTRA + al((size_t)NU_GL * 8192 * 2);
constexpr size_t WS_DD = WS_KV + al((size_t)NU_GL * 8192 * 2);
constexpr size_t WS_END_MIX = WS_DD + al((size_t)NU_GL * 64 * 4);
constexpr size_t OUT_GT = 0, OUT_QE = (size_t)NU_RW * 4096 * 2;
static_assert(OUT_QE + (size_t)NU_GL * 4096 * 2 <= (size_t)NLAT * D * 4, "scan scratch fits in d_out");
constexpr size_t WS_YRW = WS_LWF, WS_YGLA = WS_LWB, WS_Z = WS_HH;
static_assert((size_t)NLAT * D * 2 <= (size_t)NU_RW * 4096 * 2, "Z fits in the HH slot");
constexpr size_t WS_X1 = WS_REGB;
constexpr size_t WS_A3 = WS_X1 + al((size_t)NLAT * D * 4);
constexpr size_t WS_LOGITS = WS_A3 + al((size_t)NLAT * D * 2);
constexpr size_t WS_ACT = WS_LOGITS + al((size_t)NLAT * NE * 4);
constexpr size_t WS_Y = WS_ACT + al((size_t)NROWS_E * FF * 2);
constexpr size_t WS_END_MOE = WS_Y + al((size_t)NROWS_E * D * 2);
constexpr size_t WS_END = WS_END_MIX > WS_END_MOE ? WS_END_MIX : WS_END_MOE;
static_assert(WS_END <= (size_t)2048 * MiB, "workspace map exceeds 2 GiB");

constexpr int RING_BYTES = 131072;
constexpr int IDX_BYTES = pg8::IDX_UNITS * 256 * 4;
constexpr int MISC_OFF = RING_BYTES + IDX_BYTES;
constexpr int LDS_BYTES = MISC_OFF + 256;
static_assert(pg8::IDX_OFF == RING_BYTES, "gather table sits right above the stage buffers");
constexpr int NWAVES = 8, NTHR = 512;

struct Args { const float* in[36]; float* out; unsigned char* ws; int ph_lo, ph_hi; };

struct Frame {
    LAS unsigned char* lds;
    int tid, lane, wave, G, gw, NGW;
    const float* const* in; float* out; unsigned char* ws; unsigned* ctl;
};

__device__ __forceinline__ float wave_sum(float v) {
#pragma unroll
    for (int o = 1; o < 64; o <<= 1) v += __shfl_xor(v, o);
    return v;
}
__device__ __forceinline__ unsigned f2bf(float f) { unsigned u = __builtin_bit_cast(unsigned, f); return (u + 0x7fffu + ((u >> 16) & 1u)) >> 16; }
typedef __bf16 bf16x2v __attribute__((ext_vector_type(2)));
__device__ __forceinline__ unsigned pk2(float lo, float hi) { const f32x2 v = {lo, hi}; return __builtin_bit_cast(unsigned, __builtin_convertvector(v, bf16x2v)); }
__device__ __forceinline__ float bflo(unsigned w) { return __builtin_bit_cast(float, w << 16); }
__device__ __forceinline__ float bfhi(unsigned w) { return __builtin_bit_cast(float, w & 0xffff0000u); }
__device__ __forceinline__ float sigmoidf_(float x) { return 1.0f / (1.0f + __expf(-x)); }
__device__ __forceinline__ float siluf_(float x) { return x / (1.0f + __expf(-x)); }

__device__ __forceinline__ void ln_stats(const f32x4 (&v)[4], float& mean, float& rstd) {
    float s = 0.f;
#pragma unroll
    for (int j = 0; j < 4; ++j) s += (v[j].x + v[j].y) + (v[j].z + v[j].w);
    mean = wave_sum(s) * (1.f / D); float s2 = 0.f;
#pragma unroll
    for (int j = 0; j < 4; ++j) { const f32x4 d = v[j] - mean; s2 += (d.x * d.x + d.y * d.y) + (d.z * d.z + d.w * d.w); }
    rstd = 1.f / sqrtf(wave_sum(s2) * (1.f / D) + LN_EPS);
}

__device__ __forceinline__ void ph_x1pre_nomix(Frame& F) {
    const float* x = F.in[0];
    for (int m = F.gw; m < NLAT; m += F.NGW) {
        const f32x4* xr = (const f32x4*)(x + (size_t)m * D) + F.lane; f32x4* o = (f32x4*)(F.out + (size_t)m * D) + F.lane;
#pragma unroll
        for (int j = 0; j < 4; ++j) o[64 * j] = xr[64 * j] * ALPHA;
    }
}
__device__ __forceinline__ void ph_ln1(Frame& F) {
    const float* lw = F.in[26]; const float* lb = F.in[27]; const float* mod = (const float*)(F.ws + WS_MOD);
    bf16* A3 = (bf16*)(F.ws + WS_A3);
    for (int m = F.gw; m < NLAT; m += F.NGW) {
        const int b = m / SEQ;
        const f32x4* pr = (const f32x4*)(F.out + (size_t)m * D) + F.lane;
        f32x4 v[4];
#pragma unroll
        for (int j = 0; j < 4; ++j) v[j] = pr[64 * j];
        float mean, rstd; ln_stats(v, mean, rstd);
        v2u* ao = (v2u*)(A3 + (size_t)m * D) + F.lane;
#pragma unroll
        for (int j = 0; j < 4; ++j) {
            const int c = 4 * F.lane + 256 * j;
            const f32x4 w = *(const f32x4*)(lw + c), bb = *(const f32x4*)(lb + c);
            const f32x4 x1 = (v[j] - mean) * rstd * w + bb;
#if MS >= 2
            const f32x4 sh = *(const f32x4*)(mod + b * 6144 + 3072 + c), sc = *(const f32x4*)(mod + b * 6144 + 4096 + c);
            const f32x4 h = x1 * (sc + 1.0f) + sh;
            v2u o; o.x = pk2(h.x, h.y); o.y = pk2(h.z, h.w); ao[64 * j] = o;
#endif
        }
    }
}
__device__ __forceinline__ void ph_final(Frame& F) {
    const float* lw = F.in[34]; const float* lb = F.in[35]; const float* mod = (const float*)(F.ws + WS_MOD);
    const float* lw1 = F.in[26]; const float* lb1 = F.in[27];
    const bf16* Y = (const bf16*)(F.ws + WS_Y); const int* DEST = (const int*)(F.ws + WS_DEST); const float* GATE = (const float*)(F.ws + WS_GATE);
    for (int m = F.gw; m < NLAT; m += F.NGW) {
        const int b = m / SEQ;
        const f32x4* pr = (const f32x4*)(F.out + (size_t)m * D) + F.lane;
        f32x4 v[4];
#pragma unroll
        for (int j = 0; j < 4; ++j) v[j] = pr[64 * j];
        { float mean1, rstd1; ln_stats(v, mean1, rstd1);
#pragma unroll
          for (int j = 0; j < 4; ++j) { const int c = 4 * F.lane + 256 * j; v[j] = ((v[j] - mean1) * rstd1 * *(const f32x4*)(lw1 + c) + *(const f32x4*)(lb1 + c)) * ALPHA; } }
#if MS >= 2
        f32x4 mo[4];
        { const v2u* yr = (const v2u*)(Y + (size_t)(SH_ROW0 + m) * D) + F.lane;
#pragma unroll
          for (int j = 0; j < 4; ++j) { const v2u w = yr[64 * j]; mo[j] = (f32x4){bflo(w.x), bfhi(w.x), bflo(w.y), bfhi(w.y)}; } }
        for (int k = 0; k < TOPK; ++k) {
            const int dr = DEST[m * 8 + k]; const float gt = GATE[m * 8 + k];
            const v2u* yr = (const v2u*)(Y + (size_t)dr * D) + F.lane;
#pragma unroll
            for (int j = 0; j < 4; ++j) { const v2u w = yr[64 * j]; mo[j] += (f32x4){bflo(w.x), bfhi(w.x), bflo(w.y), bfhi(w.y)} * gt; }
        }
#pragma unroll
        for (int j = 0; j < 4; ++j) { const f32x4 g2 = *(const f32x4*)(mod + b * 6144 + 5120 + 4 * F.lane + 256 * j); v[j] += g2 * mo[j]; }
#endif
        float mean, rstd; ln_stats(v, mean, rstd);
        f32x4* o = (f32x4*)(F.out + (size_t)m * D) + F.lane;
#pragma unroll
        for (int j = 0; j < 4; ++j) { const int c = 4 * F.lane + 256 * j; const f32x4 w = *(const f32x4*)(lw + c), bb = *(const f32x4*)(lb + c); o[64 * j] = (v[j] - mean) * rstd * w + bb; }
    }
}


#if MS >= 2
template <int MODE>
__device__ __forceinline__ void cvt_item(const float* W, int Nsrc, int nblk, bf16* WT, int row_off, int dpitch, LAS float* scr, int item, int lane) {
    const int kb = item / nblk, nb = item - kb * nblk, k0 = 64 * kb, n0 = 32 * nb;
    const int nn = n0 + (lane & 31);
#pragma unroll 8
    for (int i = 0; i < 32; ++i) { const int kk = 2 * i + (lane >> 5); scr[kk * 33 + (lane & 31)] = (nn < Nsrc) ? W[(size_t)(k0 + kk) * Nsrc + nn] : 0.f; }
    LDS_WAIT(); asm volatile("" ::: "memory");
    const int c = lane & 7;
#pragma unroll
    for (int j = 0; j < 4; ++j) { const int n = (lane >> 3) + 8 * j; const LAS float* s = scr + (8 * c) * 33 + n;
        v4u o; o.x = pk2(s[0 * 33], s[1 * 33]); o.y = pk2(s[2 * 33], s[3 * 33]); o.z = pk2(s[4 * 33], s[5 * 33]); o.w = pk2(s[6 * 33], s[7 * 33]);
        const int ng = n0 + n; int dr = ng;
        if (MODE == 1) { const int i2 = ng & 255; dr = 8 * (i2 >> 2) + (i2 & 3) + ((ng >= 256) ? 4 : 0); }
        *(v4u*)(WT + (size_t)(row_off + dr) * dpitch + k0 + 8 * c) = o; }
    LDS_WAIT(); asm volatile("" ::: "memory");
}

template <int MODE>
__device__ __forceinline__ void cvt_item_reg(const float* W, int Nsrc, bf16* WT, int row_off, int dpitch, int k0, int n0, int lane) {
    const float* src = W + (size_t)k0 * Nsrc + n0 + 4 * lane;
    f32x4 v[32];
#pragma unroll
    for (int i = 0; i < 32; ++i) v[i] = __builtin_nontemporal_load((const f32x4*)(src + (size_t)i * Nsrc));
#pragma unroll
    for (int j = 0; j < 4; ++j) {
        const int ng = n0 + 4 * lane + j; int dr = ng;
        if (MODE == 1) { const int i2 = ng & 255; dr = 8 * (i2 >> 2) + (i2 & 3) + ((ng >= 256) ? 4 : 0); }
        v4u* dst = (v4u*)(WT + (size_t)(row_off + dr) * dpitch + k0);
#pragma unroll
        for (int q = 0; q < 4; ++q) { v4u o; o.x = pk2(v[8 * q][j], v[8 * q + 1][j]); o.y = pk2(v[8 * q + 2][j], v[8 * q + 3][j]); o.z = pk2(v[8 * q + 4][j], v[8 * q + 5][j]); o.w = pk2(v[8 * q + 6][j], v[8 * q + 7][j]); dst[q] = o; }
    }
}

constexpr int CVK = 16;
__device__ __forceinline__ void cvt_reg_load(const float* W, int Nsrc, int k0, int n0, int lane, f32x4 (&v)[CVK]) {
    const float* src = W + (size_t)k0 * Nsrc + n0 + 4 * lane;
#pragma unroll
    for (int i = 0; i < CVK; ++i) v[i] = __builtin_nontemporal_load((const f32x4*)(src + (size_t)i * Nsrc));
}
template <int MODE>
__device__ __forceinline__ void cvt_reg_store(bf16* WT, int row_off, int dpitch, int k0, int n0, int lane, const f32x4 (&v)[CVK]) {
#pragma unroll
    for (int j = 0; j < 4; ++j) {
        const int ng = n0 + 4 * lane + j; int dr = ng;
        if (MODE == 1) { const int i2 = ng & 255; dr = 8 * (i2 >> 2) + (i2 & 3) + ((ng >= 256) ? 4 : 0); }
        v4u* dst = (v4u*)(WT + (size_t)(row_off + dr) * dpitch + k0);
#pragma unroll
        for (int q = 0; q < CVK / 8; ++q) { v4u o; o.x = pg8::cvt_pk_bf16(v[8 * q][j], v[8 * q + 1][j]); o.y = pg8::cvt_pk_bf16(v[8 * q + 2][j], v[8 * q + 3][j]); o.z = pg8::cvt_pk_bf16(v[8 * q + 4][j], v[8 * q + 5][j]); o.w = pg8::cvt_pk_bf16(v[8 * q + 6][j], v[8 * q + 7][j]); dst[q] = o; }
    }
}
constexpr int CV_GU = (D / CVK) * 2, CV_DN = (FF / CVK) * 4, CV_NGU = (NE + 1) * CV_GU, CV_NITEM = CV_NGU + (NE + 1) * CV_DN;
__device__ __forceinline__ void cvx_load(const float* const* in, int it, int lane, f32x4 (&v)[CVK]) {
    if (it < CV_NGU) { const int e = it / CV_GU, ii = it - e * CV_GU; const float* src = (e < NE) ? in[30] + (size_t)e * D * 512 : in[32];
        cvt_reg_load(src, 512, CVK * (ii >> 1), 256 * (ii & 1), lane, v); }
    else { const int r = it - CV_NGU, e = r / CV_DN, ii = r - e * CV_DN; const float* src = (e < NE) ? in[31] + (size_t)e * FF * D : in[33];
        cvt_reg_load(src, D, CVK * (ii >> 2), 256 * (ii & 3), lane, v); }
}
__device__ __forceinline__ void cvx_store(unsigned char* ws, int it, int lane, const f32x4 (&v)[CVK]) {
    if (it < CV_NGU) { const int e = it / CV_GU, ii = it - e * CV_GU; cvt_reg_store<1>((bf16*)(ws + WS_WGU), e * 512, D, CVK * (ii >> 1), 256 * (ii & 1), lane, v); }
    else { const int r = it - CV_NGU, e = r / CV_DN, ii = r - e * CV_DN; cvt_reg_store<0>((bf16*)(ws + WS_WD), e * D, FF, CVK * (ii >> 2), 256 * (ii & 3), lane, v); }
}

#if MS >= 3
__device__ __forceinline__ float lora_val(const float* const* in, int n, int k) {
    if (n < 1024) { const int q = n >> 3, e8 = n & 7, dir = e8 >> 2, ch = q * 4 + (e8 & 3); return (k < 32) ? in[9][(size_t)(dir * 32 + k) * 512 + ch] : 0.f; }
    if (n < 2048) { const int m = n - 1024, q = m >> 3, e8 = m & 7, dir = e8 >> 2, ch = q * 4 + (e8 & 3); return (k >= 32 && k < 64) ? in[11][(size_t)(dir * 32 + (k - 32)) * 512 + ch] : 0.f; }
    if (n < 2560) { const int ch = n - 2048; return (k >= 64 && k < 160) ? in[12][(size_t)(k - 64) * 512 + ch] : 0.f; }
    { const int m = n - 2560, q = m >> 3, e8 = m & 7, dir = e8 >> 2, ch = q * 4 + (e8 & 3); return (k >= 160 && k < 176) ? in[19][(size_t)(dir * 16 + (k - 160)) * 256 + ch] : 0.f; }
}
#endif

__device__ __forceinline__ void ph_prologue(Frame& F) {
    {
        const float* c = F.in[1]; const float* cc = F.in[3]; const float* wa = F.in[4]; const float* ba = F.in[5];
        float* MOD = (float*)(F.ws + WS_MOD);
        LAS float* S = (LAS float*)F.lds; LAS float* red = (LAS float*)(F.lds + 32768);
        for (int it = blockIdx.x; it < 96; it += F.G) {
            for (int i = F.tid; i < 5120; i += NTHR) { const int r = i >> 10, k = i & 1023; const float cv = r < 4 ? c[r * 1024 + k] : cc[k]; S[i] = siluf_(cv); }
            __syncthreads();
            const int n = it * 64 + F.lane; float acc[5] = {0.f, 0.f, 0.f, 0.f, 0.f};
            for (int kk = 0; kk < 128; ++kk) { const int k = F.wave * 128 + kk; const float wv = wa[(size_t)k * 6144 + n];
#pragma unroll
                for (int r = 0; r < 5; ++r) acc[r] += S[r * 1024 + k] * wv; }
#pragma unroll
            for (int r = 0; r < 5; ++r) red[(F.wave * 5 + r) * 64 + F.lane] = acc[r];
            __syncthreads();
            if (F.wave == 0) {
#pragma unroll
                for (int r = 0; r < 5; ++r) { float s = 0.f;
#pragma unroll
                    for (int w = 0; w < 8; ++w) s += red[(w * 5 + r) * 64 + F.lane];
                    MOD[r * 6144 + n] = s + ba[n]; }
            }
            __syncthreads();
        }
    }
    {
        LAS float* scr = (LAS float*)(F.lds + F.wave * 16384);
        constexpr int I_IN = 16 * 168, I_BR = 8 * 32, I_OUT = 16 * 32, I_RT = 16 * 8, I_GU = 32 * 2, I_DN = 8 * 4;
        constexpr int T0 = I_IN, T1 = T0 + I_BR, T2 = T1 + I_BR, T3 = T2 + I_OUT, T4 = T3 + I_RT, T5 = T4 + (NE + 1) * I_GU, T6 = T5 + (NE + 1) * I_DN;
        unsigned char* ws = F.ws;
        for (int it = F.gw; it < T6; it += F.NGW) {
#if MS >= 3
            if (it < T0) { cvt_item<0>(F.in[6], IN_COLS, 168, (bf16*)(ws + WS_WIN), 0, D, scr, it, F.lane); continue; }
            if (it < T1) { cvt_item<0>(F.in[23], D, 32, (bf16*)(ws + WS_WBRRW), 0, RWW, scr, it - T0, F.lane); continue; }
            if (it < T2) { cvt_item<0>(F.in[24], D, 32, (bf16*)(ws + WS_WBRGLA), 0, RWW, scr, it - T1, F.lane); continue; }
            if (it < T3) { cvt_item<0>(F.in[25], D, 32, (bf16*)(ws + WS_WOUT), 0, D, scr, it - T2, F.lane); continue; }
#else
            if (it < T3) continue;
#endif
            if (it < T4) { cvt_item<0>(F.in[28], NE, 8, (bf16*)(ws + WS_WROUTER), 0, D, scr, it - T3, F.lane); continue; }
#if MS >= 3
            break;
#endif
            if (it < T5) { const int r = it - T4, e = r / I_GU, ii = r - e * I_GU;
                const float* src = (e < NE) ? F.in[30] + (size_t)e * D * 512 : F.in[32];
                cvt_item_reg<1>(src, 512, (bf16*)(ws + WS_WGU), e * 512, D, 32 * (ii >> 1), 256 * (ii & 1), F.lane); continue; }
            { const int r = it - T5, e = r / I_DN, ii = r - e * I_DN;
                const float* src = (e < NE) ? F.in[31] + (size_t)e * FF * D : F.in[33];
                cvt_item_reg<0>(src, D, (bf16*)(ws + WS_WD), e * D, FF, 32 * (ii >> 2), 256 * (ii & 3), F.lane); }
        }
    }
#if MS >= 3
    {
        bf16* WL = (bf16*)(F.ws + WS_WLORA);
        for (int idx = blockIdx.x * NTHR + F.tid; idx < NLORA * (KLORA / 8); idx += F.G * NTHR) {
            const int n = idx >> 5, k0 = (idx & 31) * 8; float v[8];
#pragma unroll
            for (int e = 0; e < 8; ++e) v[e] = lora_val(F.in, n, k0 + e);
            v4u o; o.x = pk2(v[0], v[1]); o.y = pk2(v[2], v[3]); o.z = pk2(v[4], v[5]); o.w = pk2(v[6], v[7]);
            *(v4u*)(WL + (size_t)n * KLORA + k0) = o;
        }
    }
#endif
}

struct EpiF32 {
    static constexpr bool PERM = false;
    float* C; int ldc;
    __device__ __forceinline__ void operator()(const f32x4 (&acc)[2][2][4][2], const pg8::Unit& u, int wr, int wc, int fr, int fq) const {
        const int row0 = u.pm * 256 + wr * 64 + fr, col0 = u.pn * 256 + wc * 32 + 4 * fq;
#pragma unroll
        for (int ai = 0; ai < 2; ++ai)
#pragma unroll
            for (int m = 0; m < 4; ++m) { float* rowp = C + (size_t)(row0 + ai * 128 + m * 16) * ldc + col0;
#pragma unroll
                for (int bj = 0; bj < 2; ++bj)
#pragma unroll
                    for (int n = 0; n < 2; ++n) *(f32x4*)(rowp + bj * 128 + n * 16) = acc[ai][bj][m][n]; }
    }
};
struct EpiSwiglu {
    static constexpr bool PERM = true;
    bf16* ACT;
    __device__ __forceinline__ void operator()(const f32x4 (&acc)[2][2][4][2], const pg8::Unit& u, int wr, int wc, int fr, int fq) const {
        const int row0 = u.pm * 256 + wr * 64 + fr, h0 = u.j * 128 + wc * 16 + 4 * fq;
#pragma unroll
        for (int ai = 0; ai < 2; ++ai)
#pragma unroll
            for (int m = 0; m < 4; ++m) { bf16* rowp = ACT + (size_t)(row0 + ai * 128 + m * 16) * FF + h0;
#pragma unroll
                for (int bj = 0; bj < 2; ++bj) { const f32x4 a = acc[ai][bj][m][0], b = acc[ai][bj][m][1];
                    v2u o; o.x = pg8::cvt_pk_bf16(siluf_(a[0]) * b[0], siluf_(a[1]) * b[1]); o.y = pg8::cvt_pk_bf16(siluf_(a[2]) * b[2], siluf_(a[3]) * b[3]);
                    *(v2u*)(rowp + bj * 64) = o; } }
    }
};
struct EpiRowsBf16 {
    static constexpr bool PERM = true;
    bf16* O; int ldc;
    __device__ __forceinline__ void operator()(const f32x4 (&acc)[2][2][4][2], const pg8::Unit& u, int wr, int wc, int fr, int fq) const {
        const int row0 = u.pm * 256 + wr * 64 + fr, col0 = u.j * 256 + wc * 32 + 8 * fq;
#pragma unroll
        for (int ai = 0; ai < 2; ++ai)
#pragma unroll
            for (int m = 0; m < 4; ++m) { bf16* rowp = O + (size_t)(row0 + ai * 128 + m * 16) * ldc + col0;
#pragma unroll
                for (int bj = 0; bj < 2; ++bj) { const f32x4 v0 = acc[ai][bj][m][0], v1 = acc[ai][bj][m][1];
                    v4u w; w.x = pg8::cvt_pk_bf16(v0[0], v0[1]); w.y = pg8::cvt_pk_bf16(v0[2], v0[3]); w.z = pg8::cvt_pk_bf16(v1[0], v1[1]); w.w = pg8::cvt_pk_bf16(v1[2], v1[3]);
                    *(v4u*)(rowp + bj * 128) = w; } }
    }
};

__device__ __forceinline__ void ph_router(Frame& F) {
    pg8::Gemm g{(const bf16*)(F.ws + WS_A3), (const bf16*)(F.ws + WS_WROUTER), NLAT, NE, D, nullptr};
    pg8::StaticOrder S; S.init(NLAT, NE, F.G, (int)blockIdx.x);
    EpiF32 E{(float*)(F.ws + WS_LOGITS), NE};
    pg8::gemm_phase<EpiF32, pg8::StaticOrder, true, true, false>(F.lds, g, S, E);
}

__device__ __forceinline__ void ph_route(Frame& F) {
    const float* LOG = (const float*)(F.ws + WS_LOGITS); const float* rb = F.in[29];
    int* EIDX = (int*)(F.ws + WS_EIDX); float* GATE = (float*)(F.ws + WS_GATE); int* DEST = (int*)(F.ws + WS_DEST);
    unsigned* CNT = F.ctl + CW_CNT;
    const f32x4 bias = *(const f32x4*)(rb + 4 * F.lane);
    const float NEG = -3.0e38f;
    for (int m = F.gw; m < NLAT; m += F.NGW) {
        const f32x4 lg = *(const f32x4*)(LOG + (size_t)m * NE + 4 * F.lane);
        float sc[4], sel[4];
#pragma unroll
        for (int i = 0; i < 4; ++i) { sc[i] = sigmoidf_(lg[i]); sel[i] = sc[i] + bias[i]; }
        float m1 = fmaxf(sel[0], sel[1]), m2 = fminf(sel[0], sel[1]);
        { const float a = sel[2]; const float n1 = fmaxf(m1, a); m2 = fmaxf(m2, fminf(m1, a)); m1 = n1; }
        { const float a = sel[3]; const float n1 = fmaxf(m1, a); m2 = fmaxf(m2, fminf(m1, a)); m1 = n1; }
#pragma unroll
        for (int o = 1; o < 8; o <<= 1) { const float b1 = __shfl_xor(m1, o), b2 = __shfl_xor(m2, o); const float n1 = fmaxf(m1, b1); m2 = fmaxf(fminf(m1, b1), fmaxf(m2, b2)); m1 = n1; }
        const float gs = m1 + m2; const int g = F.lane >> 3;
        int rank = 0;
#pragma unroll
        for (int gg = 0; gg < 8; ++gg) { const float og = __shfl(gs, gg * 8); rank += (og > gs || (og == gs && gg < g)) ? 1 : 0; }
        const bool keep = rank < 4;
#pragma unroll
        for (int i = 0; i < 4; ++i) sel[i] = keep ? sel[i] : NEG;
        int my_e = 0; float my_s = 0.f; float ssum = 0.f;
        for (int k = 0; k < TOPK; ++k) {
            float bv = sel[0]; int bi = 0;
#pragma unroll
            for (int i = 1; i < 4; ++i) if (sel[i] > bv) { bv = sel[i]; bi = i; }
            int be = 4 * F.lane + bi; float v = bv; int e = be;
#pragma unroll
            for (int o = 1; o < 64; o <<= 1) { const float ov = __shfl_xor(v, o); const int oe = __shfl_xor(e, o); if (ov > v || (ov == v && oe < e)) { v = ov; e = oe; } }
            const int owner = e >> 2, oi = e & 3;
            float s_own = 0.f;
            if (F.lane == owner) {
#pragma unroll
                for (int i = 0; i < 4; ++i) if (i == oi) { s_own = sc[i]; sel[i] = NEG; }
            }
            const float s = __shfl(s_own, owner);
            ssum += s;
            if (F.lane == k) { my_e = e; my_s = s; }
        }
        if (F.lane < TOPK) {
            const unsigned pos = __hip_atomic_fetch_add(CNT + my_e, 1u, __ATOMIC_RELAXED, __HIP_MEMORY_SCOPE_AGENT);
            EIDX[m * 8 + F.lane] = my_e; GATE[m * 8 + F.lane] = my_s / ssum * 2.5f; DEST[m * 8 + F.lane] = (int)pos;
        }
    }
}

__device__ __forceinline__ void ph_scatter(Frame& F) {
    LAS int* tstart = (LAS int*)F.lds;
    LAS int* scan = (LAS int*)(F.lds + 2048);
    LAS int* cnts = (LAS int*)(F.lds + 4096);
    int* EIDX = (int*)(F.ws + WS_EIDX); int* DEST = (int*)(F.ws + WS_DEST); int* ROWTOK = (int*)(F.ws + WS_ROWTOK); int* TILE_E = (int*)(F.ws + WS_TILE_E);
    unsigned* CNT = F.ctl + CW_CNT;
    int tiles = 0, cnt = 0;
    if (F.tid < NE) { cnt = (int)__hip_atomic_load(CNT + F.tid, __ATOMIC_RELAXED, __HIP_MEMORY_SCOPE_AGENT); tiles = (cnt + 255) >> 8; scan[F.tid] = tiles; cnts[F.tid] = cnt; }
    __syncthreads();
    for (int o = 1; o < NE; o <<= 1) { int v = 0; if (F.tid < NE && F.tid >= o) v = scan[F.tid - o]; __syncthreads(); if (F.tid < NE) scan[F.tid] += v; __syncthreads(); }
    if (F.tid < NE) { tstart[F.tid + 1] = scan[F.tid]; if (F.tid == 0) tstart[0] = 0; }
    __syncthreads();
    const int NT = tstart[NE];
    if (blockIdx.x == 0) {
        if (F.tid == 0) F.ctl[CW_NT] = (unsigned)NT;
        if (F.tid < NE) for (int t = tstart[F.tid]; t < tstart[F.tid + 1]; ++t) TILE_E[t] = F.tid;
    }
    for (int e = blockIdx.x; e < NE; e += F.G) { const int c0 = cnts[e], c1 = (tstart[e + 1] - tstart[e]) * 256, base = tstart[e] * 256;
        for (int p = c0 + F.tid; p < c1; p += NTHR) ROWTOK[base + p] = 0; }
    for (int i = blockIdx.x * NTHR + F.tid; i < NLAT; i += F.G * NTHR) ROWTOK[SH_ROW0 + i] = i;
    for (int i = blockIdx.x * NTHR + F.tid; i < NLAT * TOPK; i += F.G * NTHR) {
        const int e = EIDX[i], pos = DEST[i]; const int dr = tstart[e] * 256 + pos;
        DEST[i] = dr; ROWTOK[dr] = i >> 3;
    }
}

__device__ __forceinline__ void ph_exp1(Frame& F) {
    const int NT = (int)__hip_atomic_load(F.ctl + CW_NT, __ATOMIC_RELAXED, __HIP_MEMORY_SCOPE_AGENT);
    pg8::Gemm g{(const bf16*)(F.ws + WS_A3), (const bf16*)(F.ws + WS_WGU), 0, 0, D, (const int*)(F.ws + WS_ROWTOK)};
    pg8::MoeOrder S{2, F.G, (int)blockIdx.x, NT, (const int*)(F.ws + WS_TILE_E)};
    EpiSwiglu E{(bf16*)(F.ws + WS_ACT)};
    pg8::gemm_phase<EpiSwiglu, pg8::MoeOrder, true, true, true>(F.lds, g, S, E);
}
__device__ __forceinline__ void ph_exp2(Frame& F) {
    const int NT = (int)__hip_atomic_load(F.ctl + CW_NT, __ATOMIC_RELAXED, __HIP_MEMORY_SCOPE_AGENT);
    pg8::Gemm g{(const bf16*)(F.ws + WS_ACT), (const bf16*)(F.ws + WS_WD), 0, 0, FF, nullptr};
    pg8::MoeOrder S{4, F.G, (int)blockIdx.x, NT, (const int*)(F.ws + WS_TILE_E)};
    EpiRowsBf16 E{(bf16*)(F.ws + WS_Y), D};
    pg8::gemm_phase<EpiRowsBf16, pg8::MoeOrder, true, true, false>(F.lds, g, S, E);
}
#endif

#if MS >= 3
__device__ __forceinline__ void unp8(const v4u w, float (&f)[8]) { f[0] = bflo(w.x); f[1] = bfhi(w.x); f[2] = bflo(w.y); f[3] = bfhi(w.y); f[4] = bflo(w.z); f[5] = bfhi(w.z); f[6] = bflo(w.w); f[7] = bfhi(w.w); }
__device__ __forceinline__ v4u pk8(const float (&f)[8]) { v4u o; o.x = pk2(f[0], f[1]); o.y = pk2(f[2], f[3]); o.z = pk2(f[4], f[5]); o.w = pk2(f[6], f[7]); return o; }
__device__ __forceinline__ void st8(float* p, const float (&f)[8]) { *(f32x4*)p = (f32x4){f[0], f[1], f[2], f[3]}; *(f32x4*)(p + 4) = (f32x4){f[4], f[5], f[6], f[7]}; }
__device__ __forceinline__ void ld8(const float* p, float (&f)[8]) { const f32x4 a = *(const f32x4*)p, b = *(const f32x4*)(p + 4); f[0] = a.x; f[1] = a.y; f[2] = a.z; f[3] = a.w; f[4] = b.x; f[5] = b.y; f[6] = b.z; f[7] = b.w; }

__device__ __forceinline__ void ph_a1(Frame& F) {
    const float* mod = (const float*)(F.ws + WS_MOD); bf16* A1 = (bf16*)(F.ws + WS_A1);
    for (int m = F.gw; m < MR; m += F.NGW) {
        const float* src = (m < NLAT) ? F.in[0] + (size_t)m * D : F.in[2] + (size_t)(m - NLAT) * D;
        const int mr = (m < NLAT) ? (m / SEQ) : 4;
        const f32x4* xr = (const f32x4*)src + F.lane; v2u* ao = (v2u*)(A1 + (size_t)m * D) + F.lane;
#pragma unroll
        for (int j = 0; j < 4; ++j) { const int c = 4 * F.lane + 256 * j;
            const f32x4 sh = *(const f32x4*)(mod + mr * 6144 + c), sc = *(const f32x4*)(mod + mr * 6144 + 1024 + c);
            const f32x4 h = xr[64 * j] * (sc + 1.0f) + sh; v2u o; o.x = pk2(h.x, h.y); o.y = pk2(h.z, h.w); ao[64 * j] = o; }
    }
}

__device__ __forceinline__ void ph_inproj(Frame& F) {
    pg8::Gemm g{(const bf16*)(F.ws + WS_A1), (const bf16*)(F.ws + WS_WIN), MR, NP, D, nullptr};
    pg8::StaticOrder S; S.init(MR, NP, F.G, (int)blockIdx.x);
    EpiRowsBf16 E{(bf16*)(F.ws + WS_P), NP};
    pg8::gemm_phase<EpiRowsBf16, pg8::StaticOrder, true, true, false>(F.lds, g, S, E);
}

__device__ __forceinline__ void ph_feat(Frame& F) {
    const bf16* P = (const bf16*)(F.ws + WS_P);
    const float* mu = F.in[7]; const float* kkw = F.in[13]; const float* cw = F.in[18];
    bf16* R = (bf16*)(F.ws + WS_RB); bf16* V = (bf16*)(F.ws + WS_VB); bf16* KK = (bf16*)(F.ws + WS_KKB); bf16* KP = (bf16*)(F.ws + WS_KMF);
    bf16* QG = (bf16*)(F.ws + WS_QGB); bf16* KGB = (bf16*)(F.ws + WS_KGB); bf16* VGB = (bf16*)(F.ws + WS_VGB);
    bf16* A2 = (bf16*)(F.ws + WS_A2);
    const int lane = F.lane;
    for (int m = F.gw; m < MR; m += F.NGW) {
        int nb[4]; int gr = 0, gc = 0; const bool lat = m < NLAT;
        if (lat) { const int t = m & (SEQ - 1); gr = t >> 6; gc = t & 63;
            nb[0] = gc > 0 ? m - 1 : -1; nb[1] = gc < 63 ? m + 1 : -1; nb[2] = gr > 0 ? m - 64 : -1; nb[3] = gr < 127 ? m + 64 : -1;
        } else { const int t = (m - NLAT) & (CTXL - 1); nb[0] = t > 0 ? m - 1 : -1; nb[1] = t < CTXL - 1 ? m + 1 : -1; nb[2] = nb[0]; nb[3] = nb[1]; }
        const bf16* prow = P + (size_t)m * NP;
#pragma unroll
        for (int p = 0; p < 4; ++p) {
            const int cb = p * 512 + 8 * lane;
            if (p < 3 || lane < 20) {
                float own[8], sh[4][8];
                unp8(*(const v4u*)(prow + cb), own);
#pragma unroll
                for (int q = 0; q < 4; ++q) { v4u w = (v4u){0u, 0u, 0u, 0u}; if (nb[q] >= 0) w = *(const v4u*)(P + (size_t)nb[q] * NP + cb); unp8(w, sh[q]); }
                float muv[8]; ld8(mu + cb, muv);
                float val[8];
#pragma unroll
                for (int e = 0; e < 8; ++e) val[e] = own[e] + muv[e] * (sh[e & 3][e] - own[e]);
                if (p == 0) *(v4u*)(R + (size_t)m * RWW + 8 * lane) = pk8(val);
                else if (p == 2) *(v4u*)(V + (size_t)m * RWW + 8 * lane) = pk8(val);
                else if (p == 1) {
                    *(v4u*)(KP + (size_t)m * RWW + 8 * lane) = pk8(val);
                    float kw[8]; ld8(kkw + 8 * lane, kw); float kkv[8]; float ss = 0.f;
#pragma unroll
                    for (int e = 0; e < 8; ++e) { kkv[e] = val[e] * kw[e]; ss += kkv[e] * kkv[e]; }
                    ss += __shfl_xor(ss, 1); ss += __shfl_xor(ss, 2); ss += __shfl_xor(ss, 4);
                    const float inv = 1.0f / fmaxf(sqrtf(ss), 1e-12f);
#pragma unroll
                    for (int e = 0; e < 8; ++e) kkv[e] *= inv;
                    *(v4u*)(KK + (size_t)m * RWW + 8 * lane) = pk8(kkv);
                } else {
                    float o[8];
#pragma unroll
                    for (int e = 0; e < 8; ++e) o[e] = (lane < 4) ? tanhf(val[e]) : ((lane < 8) ? val[e] : sigmoidf_(val[e]));
                    *(v4u*)(A2 + (size_t)m * KLORA + 8 * lane) = pk8(o);
                }
            } else if (p == 3 && lane < 32) {
                v4u w = (v4u){0u, 0u, 0u, 0u};
                if (lane < 22) w = *(const v4u*)(prow + C_PGL + 8 * (lane - 20));
                *(v4u*)(A2 + (size_t)m * KLORA + 8 * lane) = w;
            }
        }
#pragma unroll
        for (int p = 0; p < 2; ++p) {
            const int cq = p * 512 + 8 * lane; const int cb = C_Q + cq;
            float acc[8] = {0.f, 0.f, 0.f, 0.f, 0.f, 0.f, 0.f, 0.f};
#pragma unroll
            for (int dy = -1; dy <= 1; ++dy)
#pragma unroll
                for (int dx = -1; dx <= 1; ++dx) {
                    bool ok; int nr;
                    if (lat) { ok = (gr + dy >= 0) && (gr + dy < GRIDH) && (gc + dx >= 0) && (gc + dx < GRIDW); nr = m + dy * 64 + dx; }
                    else { const int t = (m - NLAT) & (CTXL - 1); ok = (dy == 0) && (t + dx >= 0) && (t + dx < CTXL); nr = m + dx; }
                    if (ok) {
                        float pv[8], wv[8]; unp8(*(const v4u*)(P + (size_t)nr * NP + cb), pv); ld8(cw + ((dy + 1) * 3 + (dx + 1)) * 1024 + cq, wv);
#pragma unroll
                        for (int e = 0; e < 8; ++e) acc[e] += pv[e] * wv[e];
                    }
                }
            float o[8];
#pragma unroll
            for (int e = 0; e < 8; ++e) o[e] = siluf_(acc[e]);
            if (p == 0) {
                if (lane < 32) {
#pragma unroll
                    for (int e = 0; e < 8; ++e) o[e] *= 0.125f;
                    *(v4u*)(QG + (size_t)m * 256 + cq) = pk8(o);
                } else *(v4u*)(KGB + (size_t)m * 256 + (cq - 256)) = pk8(o);
            } else *(v4u*)(VGB + (size_t)m * RWW + (cq - 512)) = pk8(o);
        }
    }
}

struct EpiLora {
    static constexpr bool PERM = true;
    unsigned char* ws; const float* const* in;
    __device__ __forceinline__ void grp_w(const f32x4 (&acc)[2][2][4][2], int row0, int c0) const {
        float* Wf = (float*)(ws + WS_LWF); float* Wb = (float*)(ws + WS_LWB);
#pragma unroll
        for (int bj = 0; bj < 2; ++bj) { const int ch = (c0 + bj * 128) >> 1; const f32x4 w0f = *(const f32x4*)(in[8] + ch), w0b = *(const f32x4*)(in[8] + 512 + ch);
#pragma unroll
            for (int ai = 0; ai < 2; ++ai)
#pragma unroll
                for (int m = 0; m < 4; ++m) { const size_t row = (size_t)(row0 + ai * 128 + m * 16);
                    const f32x4 xf = acc[ai][bj][m][0] + w0f, xb = acc[ai][bj][m][1] + w0b; f32x4 df, db;
#pragma unroll
                    for (int e = 0; e < 4; ++e) { df[e] = -0.60653066f * sigmoidf_(xf[e]); db[e] = -0.60653066f * sigmoidf_(xb[e]); }
                    *(f32x4*)(Wf + row * RWW + ch) = df; *(f32x4*)(Wb + row * RWW + ch) = db; } }
    }
    __device__ __forceinline__ void grp_a(const f32x4 (&acc)[2][2][4][2], int row0, int c0) const {
        bf16* KMf = (bf16*)(ws + WS_KMF); bf16* KMb = (bf16*)(ws + WS_KMB); bf16* BVf = (bf16*)(ws + WS_BVF); bf16* BVb = (bf16*)(ws + WS_BVB);
        const bf16* KK = (const bf16*)(ws + WS_KKB); bf16* KSUM = (bf16*)(ws + WS_KSUM);
#pragma unroll
        for (int bj = 0; bj < 2; ++bj) { const int ch = (c0 + bj * 128 - 1024) >> 1; const f32x4 a0f = *(const f32x4*)(in[10] + ch), a0b = *(const f32x4*)(in[10] + 512 + ch), ka = *(const f32x4*)(in[14] + ch);
#pragma unroll
            for (int ai = 0; ai < 2; ++ai)
#pragma unroll
                for (int m = 0; m < 4; ++m) { const size_t row = (size_t)(row0 + ai * 128 + m * 16);
                    const f32x4 xf = acc[ai][bj][m][0] + a0f, xb = acc[ai][bj][m][1] + a0b;
                    const v2u kpw = *(const v2u*)(KMf + row * RWW + ch), kkw = *(const v2u*)(KK + row * RWW + ch);
                    const f32x4 kp = (f32x4){bflo(kpw.x), bfhi(kpw.x), bflo(kpw.y), bfhi(kpw.y)}, kk = (f32x4){bflo(kkw.x), bfhi(kkw.x), bflo(kkw.y), bfhi(kkw.y)};
                    f32x4 kmf, kmb, bvf, bvb;
#pragma unroll
                    for (int e = 0; e < 4; ++e) { const float af = sigmoidf_(xf[e]), ab = sigmoidf_(xb[e]);
                        kmf[e] = kp[e] * (1.0f + (af - 1.0f) * ka[e]); kmb[e] = kp[e] * (1.0f + (ab - 1.0f) * ka[e]); bvf[e] = kk[e] * af; bvb[e] = kk[e] * ab; }
                    { v2u o; o.x = pk2(kmf[0], kmf[1]); o.y = pk2(kmf[2], kmf[3]); *(v2u*)(KMf + row * RWW + ch) = o; o.x = pk2(kmb[0], kmb[1]); o.y = pk2(kmb[2], kmb[3]); *(v2u*)(KMb + row * RWW + ch) = o;
                      o.x = pk2(bvf[0], bvf[1]); o.y = pk2(bvf[2], bvf[3]); *(v2u*)(BVf + row * RWW + ch) = o; o.x = pk2(bvb[0], bvb[1]); o.y = pk2(bvb[2], bvb[3]); *(v2u*)(BVb + row * RWW + ch) = o; }
                    v2u ks; ks.x = pk2(kmf[0] + kmb[0], kmf[1] + kmb[1]); ks.y = pk2(kmf[2] + kmb[2], kmf[3] + kmb[3]); *(v2u*)(KSUM + row * RWW + ch) = ks; } }
    }
    __device__ __forceinline__ void grp_g(const f32x4 (&acc)[2][2][4][2], int row0, int c0) const {
        bf16* RWG = (bf16*)(ws + WS_RWG);
#pragma unroll
        for (int bj = 0; bj < 2; ++bj) { const int ch = c0 + bj * 128 - 2048;
#pragma unroll
            for (int ai = 0; ai < 2; ++ai)
#pragma unroll
                for (int m = 0; m < 4; ++m) { const size_t row = (size_t)(row0 + ai * 128 + m * 16); const f32x4 v0 = acc[ai][bj][m][0], v1 = acc[ai][bj][m][1];
                    v4u w; w.x = pk2(v0[0], v0[1]); w.y = pk2(v0[2], v0[3]); w.z = pk2(v1[0], v1[1]); w.w = pk2(v1[2], v1[3]); *(v4u*)(RWG + row * RWW + ch) = w; } }
    }
    __device__ __forceinline__ void grp_l(const f32x4 (&acc)[2][2][4][2], int row0, int c0) const {
        float* GAf = (float*)(ws + WS_LAF); float* GAb = (float*)(ws + WS_LAB);
#pragma unroll
        for (int bj = 0; bj < 2; ++bj) { const int ch = (c0 + bj * 128 - 2560) >> 1; const f32x4 gbf = *(const f32x4*)(in[20] + ch), gbb = *(const f32x4*)(in[20] + 256 + ch);
#pragma unroll
            for (int ai = 0; ai < 2; ++ai)
#pragma unroll
                for (int m = 0; m < 4; ++m) { const size_t row = (size_t)(row0 + ai * 128 + m * 16);
                    const f32x4 xf = acc[ai][bj][m][0] + gbf, xb = acc[ai][bj][m][1] + gbb; f32x4 af, ab;
#pragma unroll
                    for (int e = 0; e < 4; ++e) { const float lf = fminf(xf[e], 0.f) - log1pf(__expf(-fabsf(xf[e]))), lb = fminf(xb[e], 0.f) - log1pf(__expf(-fabsf(xb[e])));
                        af[e] = lf * 0.0625f; ab[e] = lb * 0.0625f; }
                    *(f32x4*)(GAf + row * 256 + ch) = af; *(f32x4*)(GAb + row * 256 + ch) = ab; } }
    }
    __device__ __forceinline__ void operator()(const f32x4 (&acc)[2][2][4][2], const pg8::Unit& u, int wr, int wc, int fr, int fq) const {
        const int row0 = u.pm * 256 + wr * 64 + fr, c0 = u.pn * 256 + wc * 32 + 8 * fq;
        if (u.pn < 4) grp_w(acc, row0, c0); else if (u.pn < 8) grp_a(acc, row0, c0); else if (u.pn < 10) grp_g(acc, row0, c0); else grp_l(acc, row0, c0);
    }
};
__device__ __forceinline__ void ph_lora(Frame& F) {
    pg8::Gemm g{(const bf16*)(F.ws + WS_A2), (const bf16*)(F.ws + WS_WLORA), MR, NLORA, KLORA, nullptr};
    pg8::StaticOrder S; S.init(MR, NLORA, F.G, (int)blockIdx.x);
    EpiLora E{F.ws, F.in};
    pg8::gemm_phase<EpiLora, pg8::StaticOrder, true, true, false>(F.lds, g, S, E);
}

__device__ __forceinline__ void ph_merge(Frame& F) {
    unsigned char* ws = F.ws; const int lane = F.lane;
    const bf16* ORf = (const bf16*)(ws + WS_ORWF); const bf16* ORb = (const bf16*)(ws + WS_ORWB); const bf16* OGf = (const bf16*)(ws + WS_OGLF); const bf16* OGb = (const bf16*)(ws + WS_OGLB);
    const bf16* R = (const bf16*)(ws + WS_RB); const bf16* V = (const bf16*)(ws + WS_VB); const bf16* KSUM = (const bf16*)(ws + WS_KSUM); const bf16* RWG = (const bf16*)(ws + WS_RWG);
    const bf16* P = (const bf16*)(ws + WS_P);
    bf16* YRW = (bf16*)(ws + WS_YRW); bf16* YGLA = (bf16*)(ws + WS_YGLA);
    float rk[8], gw[8], gbv[8], ggw[8], ggb[8];
    ld8(F.in[15] + 8 * lane, rk); ld8(F.in[16] + 8 * lane, gw); ld8(F.in[17] + 8 * lane, gbv); ld8(F.in[21] + 8 * lane, ggw); ld8(F.in[22] + 8 * lane, ggb);
    for (int m = F.gw; m < NLAT; m += F.NGW) {
        const size_t ro = (size_t)m * RWW + 8 * lane;
        {
            float a[8], b[8], o[8]; unp8(*(const v4u*)(ORf + ro), a); unp8(*(const v4u*)(ORb + ro), b);
            float s = 0.f;
#pragma unroll
            for (int e = 0; e < 8; ++e) { o[e] = a[e] + b[e]; s += o[e]; }
            s += __shfl_xor(s, 1); s += __shfl_xor(s, 2); s += __shfl_xor(s, 4);
            const float mean = s * (1.f / 64.f); float q = 0.f;
#pragma unroll
            for (int e = 0; e < 8; ++e) { o[e] -= mean; q += o[e] * o[e]; }
            q += __shfl_xor(q, 1); q += __shfl_xor(q, 2); q += __shfl_xor(q, 4);
            const float rstd = 1.f / sqrtf(q * (1.f / 64.f) + RW_GN_EPS);
            float r[8], v[8], ksm[8], g[8]; unp8(*(const v4u*)(R + ro), r); unp8(*(const v4u*)(V + ro), v); unp8(*(const v4u*)(KSUM + ro), ksm); unp8(*(const v4u*)(RWG + ro), g);
            float bs = 0.f;
#pragma unroll
            for (int e = 0; e < 8; ++e) bs += r[e] * ksm[e] * rk[e];
            bs += __shfl_xor(bs, 1); bs += __shfl_xor(bs, 2); bs += __shfl_xor(bs, 4);
            float y[8];
#pragma unroll
            for (int e = 0; e < 8; ++e) y[e] = (o[e] * rstd * gw[e] + gbv[e] + bs * v[e]) * g[e];
            *(v4u*)(YRW + ro) = pk8(y);
        }
        {
            float a[8], b[8], o[8]; unp8(*(const v4u*)(OGf + ro), a); unp8(*(const v4u*)(OGb + ro), b);
            float s = 0.f;
#pragma unroll
            for (int e = 0; e < 8; ++e) { o[e] = a[e] + b[e]; s += o[e]; }
            s += __shfl_xor(s, 1); s += __shfl_xor(s, 2); s += __shfl_xor(s, 4); s += __shfl_xor(s, 8);
            const float mean = s * (1.f / 128.f); float q = 0.f;
#pragma unroll
            for (int e = 0; e < 8; ++e) { o[e] -= mean; q += o[e] * o[e]; }
            q += __shfl_xor(q, 1); q += __shfl_xor(q, 2); q += __shfl_xor(q, 4); q += __shfl_xor(q, 8);
            const float rstd = 1.f / sqrtf(q * (1.f / 128.f) + LN_EPS);
            float og[8]; unp8(*(const v4u*)(P + (size_t)m * NP + C_OG + 8 * lane), og);
            float y[8];
#pragma unroll
            for (int e = 0; e < 8; ++e) y[e] = (o[e] * rstd * ggw[e] + ggb[e]) * siluf_(og[e]);
            *(v4u*)(YGLA + ro) = pk8(y);
        }
    }
}

template <int WHICH> struct EpiBranch {
    static constexpr bool PERM = true;
    bf16* Z; const bf16* P;
    __device__ __forceinline__ void operator()(const f32x4 (&acc)[2][2][4][2], const pg8::Unit& u, int wr, int wc, int fr, int fq) const {
        const int row0 = u.pm * 256 + wr * 64 + fr, col0 = u.pn * 256 + wc * 32 + 8 * fq;
#pragma unroll
        for (int ai = 0; ai < 2; ++ai)
#pragma unroll
            for (int m = 0; m < 4; ++m) { const size_t row = (size_t)(row0 + ai * 128 + m * 16);
#pragma unroll
                for (int bj = 0; bj < 2; ++bj) { const int c = col0 + bj * 128;
                    float g[8]; unp8(*(const v4u*)(P + row * NP + (WHICH ? C_GGLA : C_GRW) + c), g);
                    const f32x4 v0 = acc[ai][bj][m][0], v1 = acc[ai][bj][m][1];
                    float z[8];
#pragma unroll
                    for (int e = 0; e < 4; ++e) { z[e] = sigmoidf_(g[e]) * v0[e]; z[4 + e] = sigmoidf_(g[4 + e]) * v1[e]; }
                    if (WHICH) { float zo[8]; unp8(*(const v4u*)(Z + row * D + c), zo);
#pragma unroll
                        for (int e = 0; e < 8; ++e) z[e] += zo[e]; }
                    *(v4u*)(Z + row * D + c) = pk8(z); } }
    }
};
__device__ __forceinline__ void ph_branch(Frame& F) {
    pg8::StaticOrder S; S.init(NLAT, D, F.G, (int)blockIdx.x);
    { pg8::Gemm g{(const bf16*)(F.ws + WS_YRW), (const bf16*)(F.ws + WS_WBRRW), NLAT, D, RWW, nullptr};
      EpiBranch<0> E{(bf16*)(F.ws + WS_Z), (const bf16*)(F.ws + WS_P)};
      pg8::gemm_phase<EpiBranch<0>, pg8::StaticOrder, true, true, false>(F.lds, g, S, E); }
    { pg8::Gemm g{(const bf16*)(F.ws + WS_YGLA), (const bf16*)(F.ws + WS_WBRGLA), NLAT, D, RWW, nullptr};
      EpiBranch<1> E{(bf16*)(F.ws + WS_Z), (const bf16*)(F.ws + WS_P)};
      pg8::gemm_phase<EpiBranch<1>, pg8::StaticOrder, true, true, false>(F.lds, g, S, E); }
}
struct EpiOut {
    static constexpr bool PERM = false;
    float* out; const float* x; const float* mod;
    __device__ __forceinline__ void operator()(const f32x4 (&acc)[2][2][4][2], const pg8::Unit& u, int wr, int wc, int fr, int fq) const {
        const int row0 = u.pm * 256 + wr * 64 + fr, col0 = u.pn * 256 + wc * 32 + 4 * fq; const float* g1 = mod + (u.pm / (SEQ / 256)) * 6144 + 2048;
#pragma unroll
        for (int ai = 0; ai < 2; ++ai)
#pragma unroll
            for (int m = 0; m < 4; ++m) { const size_t ro = (size_t)(row0 + ai * 128 + m * 16) * D;
#pragma unroll
                for (int bj = 0; bj < 2; ++bj)
#pragma unroll
                    for (int n = 0; n < 2; ++n) { const int c = col0 + bj * 128 + n * 16;
                        *(f32x4*)(out + ro + c) = *(const f32x4*)(x + ro + c) * ALPHA + *(const f32x4*)(g1 + c) * acc[ai][bj][m][n]; } }
    }
};
__device__ __forceinline__ void ph_outproj(Frame& F) {
    pg8::Gemm g{(const bf16*)(F.ws + WS_Z), (const bf16*)(F.ws + WS_WOUT), NLAT, D, D, nullptr};
    pg8::StaticOrder S; S.init(NLAT, D, F.G, (int)blockIdx.x);
    EpiOut E{F.out, F.in[0], (const float*)(F.ws + WS_MOD)};
    pg8::gemm_phase<EpiOut, pg8::StaticOrder, true, true, false>(F.lds, g, S, E);
}
#endif

#if MS >= 3
constexpr int LP = 72, SLOTB = 64 * LP * 2, LPF = 68, AUX_OFF = 13 * SLOTB;
static_assert(AUX_OFF + 4096 <= MISC_OFF, "scan LDS map");
#define SLOT(n) ((LAS bf16*)(lds + (n) * SLOTB))
__device__ __forceinline__ int scan_row(int s, int b, int dir) {
    if (s < CTXL) return NLAT + b * CTXL + (dir ? (CTXL - 1 - s) : s);
    const int lt = s - CTXL; return b * SEQ + (dir ? (SEQ - 1 - lt) : lt);
}
__device__ __forceinline__ unsigned pk2z(float x) { return pk2(x, 0.f); }
__device__ __forceinline__ float bf2f(bf16 h) { return __builtin_bit_cast(float, (unsigned)h << 16); }
__device__ __forceinline__ v2u pack4(const f32x4 v) { v2u o; o.x = pk2(v[0], v[1]); o.y = pk2(v[2], v[3]); return o; }
__device__ __forceinline__ f32x4 unpack4(const v2u w) { return (f32x4){bflo(w.x), bfhi(w.x), bflo(w.y), bfhi(w.y)}; }
__device__ __forceinline__ f32x4 mm_tile(const LAS bf16* X, int r0, const LAS bf16* Y, int c0, int lane) {
    const int rr = lane & 15, q = lane >> 4;
    const LAS bf16* xp = X + (r0 + rr) * LP + 8 * q; const LAS bf16* yp = Y + (c0 + rr) * LP + 8 * q;
    const bf16x8 a0 = *(const LAS bf16x8*)xp, a1 = *(const LAS bf16x8*)(xp + 32), b0 = *(const LAS bf16x8*)yp, b1 = *(const LAS bf16x8*)(yp + 32);
    f32x4 acc = (f32x4){0.f, 0.f, 0.f, 0.f};
    acc = __builtin_amdgcn_mfma_f32_16x16x32_bf16(a0, b0, acc, 0, 0, 0);
    acc = __builtin_amdgcn_mfma_f32_16x16x32_bf16(a1, b1, acc, 0, 0, 0);
    return acc;
}
__device__ __forceinline__ float red8(float x) {
    x += __builtin_bit_cast(float, __builtin_amdgcn_update_dpp(0, __builtin_bit_cast(int, x), 0x141, 0xf, 0xf, false));
    x += __builtin_bit_cast(float, __builtin_amdgcn_update_dpp(0, __builtin_bit_cast(int, x), 0xB1, 0xf, 0xf, false));
    x += __builtin_bit_cast(float, __builtin_amdgcn_update_dpp(0, __builtin_bit_cast(int, x), 0x4E, 0xf, 0xf, false));
    return x;
}

#define S1_BAR() do { asm volatile("s_waitcnt lgkmcnt(0)" ::: "memory"); __builtin_amdgcn_s_barrier(); asm volatile("" ::: "memory"); } while (0)
struct RwIn { float lw[8]; bf16 r[8], k[8], a[8], b[8], v[8]; };
__device__ __forceinline__ void s1_rwkv_load(Frame& F, int u, RwIn& I) {
    const int sr = u / NCHUNK, c = u - sr * NCHUNK, rb = sr >> 4, rdir = (sr >> 3) & 1, rh = sr & 7; unsigned char* ws = F.ws;
    const bf16* RBp = (const bf16*)(ws + WS_RB); const bf16* VBp = (const bf16*)(ws + WS_VB); const bf16* KKp = (const bf16*)(ws + WS_KKB);
    const bf16* KMp = (const bf16*)(ws + (rdir ? WS_KMB : WS_KMF)); const bf16* BVp = (const bf16*)(ws + (rdir ? WS_BVB : WS_BVF)); const float* LWp = (const float*)(ws + (rdir ? WS_LWB : WS_LWF));
#pragma unroll
    for (int i = 0; i < 8; ++i) { const int row = scan_row(c * CH + 8 * F.wave + i, rb, rdir); const size_t base = (size_t)row * RWW + rh * 64 + F.lane;
        I.lw[i] = LWp[base]; I.r[i] = RBp[base]; I.k[i] = KMp[base]; I.a[i] = KKp[base]; I.b[i] = BVp[base]; I.v[i] = VBp[base]; }
}
__device__ __forceinline__ void s1_rwkv(Frame& F, int u, const RwIn& I, int un, RwIn& Inext, int cvi) {
    const int sr = u / NCHUNK, c = u - sr * NCHUNK;
    const bool emit = c >= CTXL / CH;
    LAS unsigned char* lds = F.lds; unsigned char* ws = F.ws;
    const int lane = F.lane, wave = F.wave, rr = lane & 15, q = lane >> 4;
    LAS float* tot = (LAS float*)(lds + AUX_OFF); LAS float* gCs = tot + 512;
    {
        float lw[8], xr[8], xk[8], xa[8], xb[8], xv[8];
#pragma unroll
        for (int i = 0; i < 8; ++i) { lw[i] = I.lw[i]; xr[i] = bf2f(I.r[i]); xk[i] = bf2f(I.k[i]); xa[i] = -bf2f(I.a[i]); xb[i] = bf2f(I.b[i]); xv[i] = bf2f(I.v[i]); }
        float p[8]; p[0] = lw[0];
#pragma unroll
        for (int i = 1; i < 8; ++i) p[i] = p[i - 1] + lw[i];
        tot[wave * 64 + lane] = p[7];
        S1_BAR();
        float off = 0.f, all = 0.f;
#pragma unroll
        for (int w = 0; w < 8; ++w) { const float t = tot[w * 64 + lane]; all += t; off += (w < wave) ? t : 0.f; }
        if (wave == 0) gCs[lane] = __expf(all);
        float at[8], bb[8], kb[8];
#pragma unroll
        for (int i = 0; i < 8; ++i) { const float cum = off + p[i]; const float g = __expf(cum), gi = __expf(-cum), gp = __expf(cum - lw[i]), gc = __expf(all - cum);
            const int t = 8 * wave + i;
            at[i] = xa[i] * gp; bb[i] = xb[i] * gc; kb[i] = xk[i] * gc;
            SLOT(0)[t * LP + lane] = (bf16)pk2z(at[i]);
            SLOT(1)[t * LP + lane] = (bf16)pk2z(xr[i] * g);
            SLOT(2)[t * LP + lane] = (bf16)pk2z(xb[i] * gi);
            SLOT(3)[t * LP + lane] = (bf16)pk2z(xk[i] * gi); }
        *(LAS v4u*)(SLOT(4) + lane * LP + 8 * wave) = pk8(at);
        *(LAS v4u*)(SLOT(5) + lane * LP + 8 * wave) = pk8(xv);
        *(LAS v4u*)(SLOT(6) + lane * LP + 8 * wave) = pk8(bb);
        *(LAS v4u*)(SLOT(7) + lane * LP + 8 * wave) = pk8(kb);
        S1_BAR();
    }
    LAS float* Lp = (LAS float*)(lds + 8 * SLOTB);
#pragma unroll
    for (int tix = 0; tix < 2; ++tix) { const int ti = 2 * wave + tix, r0 = 16 * (ti >> 2), c0 = 16 * (ti & 3), ci = c0 + rr;
        { const f32x4 acc = mm_tile(SLOT(2), r0, SLOT(0), c0, lane);
#pragma unroll
            for (int e = 0; e < 4; ++e) { const int i = r0 + 4 * q + e; Lp[ci * LPF + (i & 7) * 8 + (i >> 3)] = (i < ci) ? acc[e] : 0.f; } }
        { f32x4 acc = mm_tile(SLOT(0), r0, SLOT(3), c0, lane);
#pragma unroll
            for (int e = 0; e < 4; ++e) acc[e] = (ci < r0 + 4 * q + e) ? acc[e] : 0.f;
            *(LAS v2u*)(SLOT(10) + ci * LP + r0 + 4 * q) = pack4(acc); }
        if (emit) {
            { f32x4 acc = mm_tile(SLOT(2), r0, SLOT(1), c0, lane);
#pragma unroll
                for (int e = 0; e < 4; ++e) acc[e] = (r0 + 4 * q + e <= ci) ? acc[e] : 0.f;
                *(LAS v2u*)(SLOT(11) + ci * LP + r0 + 4 * q) = pack4(acc); }
            { f32x4 acc = mm_tile(SLOT(3), r0, SLOT(1), c0, lane);
#pragma unroll
                for (int e = 0; e < 4; ++e) acc[e] = (r0 + 4 * q + e <= ci) ? acc[e] : 0.f;
                *(LAS v2u*)(SLOT(12) + ci * LP + r0 + 4 * q) = pack4(acc); }
        }
    }
    S1_BAR();
    f32x4 cv[CVK];
    s1_rwkv_load(F, un, Inext);
    if (cvi >= 0) cvx_load(F.in, cvi, lane, cv);
    {
        const int j = 8 * wave + (lane >> 3), s = lane & 7;
        float Tr[8] = {0.f, 0.f, 0.f, 0.f, 0.f, 0.f, 0.f, 0.f};
        const LAS float* lrow = Lp + s * 8;
        f32x4 la[4], lb[4];
#pragma unroll
        for (int t = 0; t < 3; ++t) { la[t] = *(const LAS f32x4*)(lrow + t * LPF); lb[t] = (f32x4){0.f, 0.f, 0.f, 0.f}; }
#pragma unroll
        for (int t = 0; t < 64; ++t) {
            if (t + 3 < 64) { la[(t + 3) & 3] = *(const LAS f32x4*)(lrow + (t + 3) * LPF); if (t + 3 >= 32) lb[(t + 3) & 3] = *(const LAS f32x4*)(lrow + (t + 3) * LPF + 4); }
            __builtin_amdgcn_sched_barrier(0);
            const f32x4 l0 = la[t & 3], l1 = lb[t & 3];
            float acc = l0.x * Tr[0];
            if (t >= 8) acc += l0.y * Tr[1];
            if (t >= 16) acc += l0.z * Tr[2] + l0.w * Tr[3];
            if (t >= 32) acc += (l1.x * Tr[4] + l1.y * Tr[5]) + (l1.z * Tr[6] + l1.w * Tr[7]);
            acc = red8(acc);
            int jj = j, ss = s; asm volatile("" : "+v"(jj), "+v"(ss));
            const float val = acc + ((t == jj) ? 1.f : 0.f);
            Tr[t >> 3] = (ss == (t & 7)) ? val : Tr[t >> 3];
            SLOT(0)[t * LP + j] = (bf16)pk2z(val);
        }
    }
    if (cvi >= 0) cvx_store(ws, cvi, lane, cv);
    S1_BAR();
#pragma unroll
    for (int tix = 0; tix < 2; ++tix) { const int ti = 2 * wave + tix, r0 = 16 * (ti >> 2), c0 = 16 * (ti & 3), ci = c0 + rr;
        { const f32x4 acc = mm_tile(SLOT(0), r0, SLOT(4), c0, lane); *(LAS v2u*)(SLOT(2) + ci * LP + r0 + 4 * q) = pack4(acc); }
        { const f32x4 acc = mm_tile(SLOT(0), r0, SLOT(10), c0, lane); *(LAS v2u*)(SLOT(3) + ci * LP + r0 + 4 * q) = pack4(acc); }
    }
    S1_BAR();
    bf16* RH = (bf16*)(ws + WS_RH) + (size_t)u * 4096; bf16* GT = (bf16*)((unsigned char*)F.out + OUT_GT) + (size_t)u * 4096;
#pragma unroll
    for (int tix = 0; tix < 2; ++tix) { const int ti = 2 * wave + tix, tr = ti >> 2, r0 = 16 * tr, c0 = 16 * (ti & 3), ci = c0 + rr;
        const int pos = (tr >> 1) * 32 + q * 8 + 4 * (tr & 1);
        if (emit) {
            { f32x4 acc = mm_tile(SLOT(2), r0, SLOT(11), c0, lane);
                acc += unpack4(*(const LAS v2u*)(SLOT(1) + ci * LP + r0 + 4 * q));
                *(v2u*)(RH + ci * 64 + pos) = pack4(acc); }
            { f32x4 acc = mm_tile(SLOT(3), r0, SLOT(11), c0, lane);
                acc += unpack4(*(const LAS v2u*)(SLOT(12) + ci * LP + r0 + 4 * q));
                *(LAS v2u*)(SLOT(4) + ci * LP + r0 + 4 * q) = pack4(acc); }
        }
        { f32x4 acc = mm_tile(SLOT(2), r0, SLOT(6), c0, lane);
            const float gc = gCs[ci];
#pragma unroll
            for (int e = 0; e < 4; ++e) acc[e] += (r0 + 4 * q + e == ci) ? gc : 0.f;
            *(v2u*)(GT + ci * 64 + pos) = pack4(acc); }
    }
    S1_BAR();
    bf16* YL = (bf16*)(ws + WS_YL) + (size_t)u * 4096;
#pragma unroll
    for (int tix = 0; tix < 2; ++tix) { const int ti = 2 * wave + tix, r0 = 16 * (ti >> 2), c0 = 16 * (ti & 3), ci = c0 + rr;
        if (emit) { const f32x4 acc = mm_tile(SLOT(5), r0, SLOT(4), c0, lane); *(v2u*)(YL + ci * 64 + r0 + 4 * q) = pack4(acc); }
        { f32x4 acc = mm_tile(SLOT(3), r0, SLOT(6), c0, lane);
            acc += unpack4(*(const LAS v2u*)(SLOT(7) + ci * LP + r0 + 4 * q));
            *(LAS v2u*)(SLOT(8) + ci * LP + r0 + 4 * q) = pack4(acc); }
    }
    S1_BAR();
    bf16* HH = (bf16*)(ws + WS_HH) + (size_t)u * 4096;
#pragma unroll
    for (int tix = 0; tix < 2; ++tix) { const int ti = 2 * wave + tix, r0 = 16 * (ti >> 2), c0 = 16 * (ti & 3), ci = c0 + rr;
        const f32x4 acc = mm_tile(SLOT(8), r0, SLOT(5), c0, lane);
        *(v2u*)(HH + ci * 64 + r0 + 4 * q) = pack4(acc); }
    S1_BAR();
}

struct GlIn { float la[8]; bf16 q[8], k[8], v0[8], v1[8]; };
__device__ __forceinline__ void s1_gla_load(Frame& F, int u, GlIn& I) {
    const int sg = u / NCHUNK, c = u - sg * NCHUNK, gb = sg >> 3, gdir = (sg >> 2) & 1, gh = sg & 3; unsigned char* ws = F.ws;
    const bf16* Qp = (const bf16*)(ws + WS_QGB); const bf16* Kp = (const bf16*)(ws + WS_KGB); const bf16* Vp = (const bf16*)(ws + WS_VGB); const float* LAp = (const float*)(ws + (gdir ? WS_LAB : WS_LAF));
#pragma unroll
    for (int i = 0; i < 8; ++i) { const int row = scan_row(c * CH + 8 * F.wave + i, gb, gdir); const size_t b2 = (size_t)row * 256 + gh * 64 + F.lane, b5 = (size_t)row * RWW + gh * 128 + F.lane;
        I.la[i] = LAp[b2]; I.q[i] = Qp[b2]; I.k[i] = Kp[b2]; I.v0[i] = Vp[b5]; I.v1[i] = Vp[b5 + 64]; }
}
__device__ __forceinline__ void s1_gla(Frame& F, int u, const GlIn& I) {
    const int sg = u / NCHUNK, c = u - sg * NCHUNK;
    const bool emit = c >= CTXL / CH;
    LAS unsigned char* lds = F.lds; unsigned char* ws = F.ws;
    const int lane = F.lane, wave = F.wave, rr = lane & 15, q = lane >> 4;
    LAS float* tot = (LAS float*)(lds + AUX_OFF);
    bf16* QE = (bf16*)((unsigned char*)F.out + OUT_QE) + (size_t)u * 4096;
    {
        float la[8], xq[8], xk[8], v0[8], v1[8];
#pragma unroll
        for (int i = 0; i < 8; ++i) { la[i] = I.la[i]; xq[i] = bf2f(I.q[i]); xk[i] = bf2f(I.k[i]); v0[i] = bf2f(I.v0[i]); v1[i] = bf2f(I.v1[i]); }
        float p[8]; p[0] = la[0];
#pragma unroll
        for (int i = 1; i < 8; ++i) p[i] = p[i - 1] + la[i];
        tot[wave * 64 + lane] = p[7];
        S1_BAR();
        float off = 0.f, all = 0.f;
#pragma unroll
        for (int w = 0; w < 8; ++w) { const float t = tot[w * 64 + lane]; all += t; off += (w < wave) ? t : 0.f; }
        if (wave == 0) ((float*)(ws + WS_DD))[(size_t)u * 64 + lane] = __expf(all);
        float kl[8];
#pragma unroll
        for (int i = 0; i < 8; ++i) { const float cum = off + p[i]; const int t = 8 * wave + i;
            const bf16 qe = (bf16)pk2z(xq[i] * __expf(cum));
            SLOT(0)[t * LP + lane] = qe;
            if (emit) QE[t * 64 + lane] = qe;
            SLOT(1)[t * LP + lane] = (bf16)pk2z(xk[i] * __expf(-cum));
            kl[i] = xk[i] * __expf(all - cum); }
        *(LAS v4u*)(SLOT(2) + lane * LP + 8 * wave) = pk8(kl);
        *(LAS v4u*)(SLOT(3) + lane * LP + 8 * wave) = pk8(v0);
        *(LAS v4u*)(SLOT(3) + (64 + lane) * LP + 8 * wave) = pk8(v1);
        S1_BAR();
    }
    if (emit) {
#pragma unroll
        for (int tix = 0; tix < 2; ++tix) { const int ti = 2 * wave + tix, r0 = 16 * (ti >> 2), c0 = 16 * (ti & 3), ci = c0 + rr;
            f32x4 acc = mm_tile(SLOT(1), r0, SLOT(0), c0, lane);
#pragma unroll
            for (int e = 0; e < 4; ++e) acc[e] = (r0 + 4 * q + e <= ci) ? acc[e] : 0.f;
            *(LAS v2u*)(SLOT(5) + ci * LP + r0 + 4 * q) = pack4(acc); }
    }
    bf16* KV = (bf16*)(ws + WS_KV) + (size_t)u * 8192;
#pragma unroll
    for (int tix = 0; tix < 4; ++tix) { const int ti = 4 * wave + tix, r0 = 16 * (ti >> 3), c0 = 16 * (ti & 7), ci = c0 + rr;
        const f32x4 acc = mm_tile(SLOT(2), r0, SLOT(3), c0, lane);
        *(v2u*)(KV + ci * 64 + r0 + 4 * q) = pack4(acc); }
    S1_BAR();
    if (emit) {
        bf16* IN = (bf16*)(ws + WS_INTRA) + (size_t)u * 8192;
#pragma unroll
        for (int tix = 0; tix < 4; ++tix) { const int ti = 4 * wave + tix, r0 = 16 * (ti >> 2), c0 = 16 * (ti & 3), ci = c0 + rr;
            const f32x4 acc = mm_tile(SLOT(3), r0, SLOT(5), c0, lane);
            *(v2u*)(IN + ci * 128 + r0 + 4 * q) = pack4(acc); }
    }
    S1_BAR();
}

__device__ __forceinline__ void ph_scan1(Frame& F) {
    { RwIn cur, nxt; if ((int)blockIdx.x < NU_RW) s1_rwkv_load(F, blockIdx.x, cur);
#pragma unroll 1
      for (int u = blockIdx.x; u < NU_RW; u += F.G) { const int un = (u + F.G < NU_RW) ? u + F.G : u; const int cvi = ((u - (int)blockIdx.x) / F.G) * (F.G * NWAVES) + (int)blockIdx.x * NWAVES + F.wave;
          s1_rwkv(F, u, cur, un, nxt, cvi < CV_NITEM ? cvi : -1); cur = nxt; } }
    { GlIn cur, nxt; if ((int)blockIdx.x < NU_GL) s1_gla_load(F, blockIdx.x, cur);
#pragma unroll 1
      for (int u = blockIdx.x; u < NU_GL; u += F.G) { const int un = (u + F.G < NU_GL) ? u + F.G : u; s1_gla_load(F, un, nxt); s1_gla(F, u, cur); cur = nxt; } }
}

__device__ __forceinline__ bf16x8 pack_frag(const f32x4 lo, const f32x4 hi) {
    v4u w; w.x = pk2(lo[0], lo[1]); w.y = pk2(lo[2], lo[3]); w.z = pk2(hi[0], hi[1]); w.w = pk2(hi[2], hi[3]); return __builtin_bit_cast(bf16x8, w);
}
constexpr int S2_D = 3, S2_R = 4, S2_RW = 8192 + 8192 + 2048 + 2048, S2_GL = 8192 + 2048 + 2048 + 1024, S2_SLOT = S2_RW + S2_GL;
static_assert(S2_R * S2_SLOT <= MISC_OFF, "S2 ring fits in LDS");
__device__ __forceinline__ void s2_issue(LAS unsigned char* lds, int sb, int lw, int lane, size_t ur, size_t ug, int v0r, int v0g,
                                         const unsigned char* GTb, const unsigned char* RHb, const unsigned char* HHb, const unsigned char* YLb,
                                         const unsigned char* QEb, const unsigned char* KVb, const unsigned char* INb, const unsigned char* DDb) {
#pragma unroll
    for (int j = 0; j < 6; ++j) {
        int k = lw * 6 + j; if (k >= 33) k -= 5;
        const unsigned char* src; int ldo;
        if (k < 16) { const int n = k & 7, pu = n * 64 + lane, row = pu >> 3, c16 = (pu & 7) ^ (row & 7);
            src = (k < 8 ? GTb : RHb) + ur * 8192 + row * 128 + c16 * 16; ldo = (k < 8 ? 0 : 8192) + n * 1024; }
        else if (k < 18) { const int n = k - 16, pu = n * 64 + lane, v = pu >> 3, c16 = (pu & 7) ^ (v & 7);
            src = HHb + ur * 8192 + (size_t)(v0r + v) * 128 + c16 * 16; ldo = 16384 + n * 1024; }
        else if (k < 20) { const int n = k - 18, pu = n * 64 + lane, t = pu >> 1;
            src = YLb + ur * 8192 + t * 128 + v0r * 2 + (pu & 1) * 16; ldo = 18432 + n * 1024; }
        else if (k < 28) { const int n = k - 20, pu = n * 64 + lane, row = pu >> 3, c16 = (pu & 7) ^ (row & 7);
            src = QEb + ug * 8192 + row * 128 + c16 * 16; ldo = S2_RW + n * 1024; }
        else if (k < 30) { const int n = k - 28, pu = n * 64 + lane, v = pu >> 3, c16 = (pu & 7) ^ (v & 7);
            src = KVb + ug * 16384 + (size_t)(v0g + v) * 128 + c16 * 16; ldo = S2_RW + 8192 + n * 1024; }
        else if (k < 32) { const int n = k - 30, pu = n * 64 + lane, t = pu >> 1;
            src = INb + ug * 16384 + t * 256 + v0g * 2 + (pu & 1) * 16; ldo = S2_RW + 10240 + n * 1024; }
        else { src = DDb + ug * 256 + (lane & 15) * 16; ldo = S2_RW + 12288; }
        __builtin_amdgcn_global_load_lds((const unsigned*)src, (LAS unsigned*)(lds + sb + ldo), 16, 0, 0);
    }
}
__device__ __forceinline__ void ph_scan2(Frame& F) {
    const int lane = F.lane, wave = F.wave, rr = lane & 15, q = lane >> 4; unsigned char* ws = F.ws; LAS unsigned char* lds = F.lds;
    const int it = (F.G == 256) ? (int)(blockIdx.x & 7) * 32 + (int)(blockIdx.x >> 3) : (int)blockIdx.x;
    const int sr = it >> 2, v0r = 16 * (it & 3), rb = sr >> 4, rdir = (sr >> 3) & 1, rh = sr & 7;
    const int sg = it >> 3, v0g = 16 * (it & 7), gb = sg >> 3, gdir = (sg >> 2) & 1, gh = sg & 3;
#define S2_BAR() do { asm volatile("s_waitcnt lgkmcnt(0)" ::: "memory"); __builtin_amdgcn_s_barrier(); asm volatile("" ::: "memory"); } while (0)
    if (wave >= 2) {
        const unsigned char* GTb = (const unsigned char*)F.out + OUT_GT; const unsigned char* QEb = (const unsigned char*)F.out + OUT_QE;
        const unsigned char* RHb = ws + WS_RH; const unsigned char* YLb = ws + WS_YL; const unsigned char* HHb = ws + WS_HH; const unsigned char* KVb = ws + WS_KV; const unsigned char* INb = ws + WS_INTRA;
        const unsigned char* DDb = ws + WS_DD;
#define S2_ISSUE(cc) s2_issue(lds, ((cc) % S2_R) * S2_SLOT, wave - 2, lane, (size_t)(sr * NCHUNK + ((cc) < NCHUNK ? (cc) : NCHUNK - 1)), (size_t)(sg * NCHUNK + ((cc) < NCHUNK ? (cc) : NCHUNK - 1)), v0r, v0g, GTb, RHb, HHb, YLb, QEb, KVb, INb, DDb)
        S2_ISSUE(0); S2_ISSUE(1); S2_ISSUE(2);
#pragma unroll 1
        for (int c = 0; c < NCHUNK; ++c) {
            asm volatile("s_waitcnt vmcnt(12) ; S2WAIT" ::: "memory");
            S2_BAR();
            S2_ISSUE(c + S2_D);
        }
#undef S2_ISSUE
    } else if (wave == 0) {
        bf16* ORW = (bf16*)(ws + (rdir ? WS_ORWB : WS_ORWF));
        f32x4 S[4];
#pragma unroll
        for (int m = 0; m < 4; ++m) S[m] = (f32x4){0.f, 0.f, 0.f, 0.f};
#pragma unroll 1
        for (int c = 0; c < NCHUNK; ++c) {
            S2_BAR();
            const LAS unsigned char* sl = lds + (c % S2_R) * S2_SLOT;
            const bool emit = c >= CTXL / CH;
            bf16x8 G0[4], G1[4], R0[4], R1[4]; v2u Hw[4], Yw[4];
#pragma unroll
            for (int m = 0; m < 4; ++m) { const int k2 = 16 * m + rr;
                G0[m] = *(const LAS bf16x8*)(sl + (k2 * 8 + (q ^ (k2 & 7))) * 16); G1[m] = *(const LAS bf16x8*)(sl + (k2 * 8 + ((4 + q) ^ (k2 & 7))) * 16);
                Hw[m] = *(const LAS v2u*)(sl + 16384 + (rr * 8 + ((2 * m + (q >> 1)) ^ (rr & 7))) * 16 + (q & 1) * 8); }
            if (emit) {
#pragma unroll
                for (int tt = 0; tt < 4; ++tt) { const int t = 16 * tt + rr;
                    R0[tt] = *(const LAS bf16x8*)(sl + 8192 + (t * 8 + (q ^ (t & 7))) * 16); R1[tt] = *(const LAS bf16x8*)(sl + 8192 + (t * 8 + ((4 + q) ^ (t & 7))) * 16);
                    Yw[tt] = *(const LAS v2u*)(sl + 18432 + t * 32 + q * 8); }
            }
            const bf16x8 Sf0 = pack_frag(S[0], S[1]), Sf1 = pack_frag(S[2], S[3]);
            __builtin_amdgcn_sched_barrier(0);
#pragma unroll
            for (int m = 0; m < 4; ++m) { f32x4 acc = unpack4(Hw[m]);
                acc = __builtin_amdgcn_mfma_f32_16x16x32_bf16(G0[m], Sf0, acc, 0, 0, 0);
                acc = __builtin_amdgcn_mfma_f32_16x16x32_bf16(G1[m], Sf1, acc, 0, 0, 0);
                S[m] = acc; }
            if (emit) {
#pragma unroll
                for (int tt = 0; tt < 4; ++tt) { const int t = 16 * tt + rr;
                    f32x4 acc = unpack4(Yw[tt]);
                    acc = __builtin_amdgcn_mfma_f32_16x16x32_bf16(Sf0, R0[tt], acc, 0, 0, 0);
                    acc = __builtin_amdgcn_mfma_f32_16x16x32_bf16(Sf1, R1[tt], acc, 0, 0, 0);
                    const int row = scan_row(c * CH + t, rb, rdir);
                    *(v2u*)(ORW + (size_t)row * RWW + rh * 64 + v0r + 4 * q) = pack4(acc); }
            }
        }
    } else {
        bf16* OGL = (bf16*)(ws + (gdir ? WS_OGLB : WS_OGLF));
        f32x4 S[4];
#pragma unroll
        for (int m = 0; m < 4; ++m) S[m] = (f32x4){0.f, 0.f, 0.f, 0.f};
#pragma unroll 1
        for (int c = 0; c < NCHUNK; ++c) {
            S2_BAR();
            const LAS unsigned char* sl = lds + (c % S2_R) * S2_SLOT + S2_RW;
            const bool emit = c >= CTXL / CH;
            bf16x8 Q0[4], Q1[4]; v2u Iw[4]; v4u kw[2]; f32x4 d0[2], d1[2];
#pragma unroll
            for (int s2 = 0; s2 < 2; ++s2) { kw[s2] = *(const LAS v4u*)(sl + 8192 + (rr * 8 + ((4 * s2 + q) ^ (rr & 7))) * 16);
                d0[s2] = *(const LAS f32x4*)(sl + 12288 + 128 * s2 + 32 * q); d1[s2] = *(const LAS f32x4*)(sl + 12288 + 128 * s2 + 32 * q + 16); }
            if (emit) {
#pragma unroll
                for (int tt = 0; tt < 4; ++tt) { const int t = 16 * tt + rr;
                    Q0[tt] = *(const LAS bf16x8*)(sl + (t * 8 + (q ^ (t & 7))) * 16); Q1[tt] = *(const LAS bf16x8*)(sl + (t * 8 + ((4 + q) ^ (t & 7))) * 16);
                    Iw[tt] = *(const LAS v2u*)(sl + 10240 + t * 32 + q * 8); }
            }
            const bf16x8 Sf0 = pack_frag(S[0], S[1]), Sf1 = pack_frag(S[2], S[3]);
            __builtin_amdgcn_sched_barrier(0);
#pragma unroll
            for (int s2 = 0; s2 < 2; ++s2) { S[2 * s2] = S[2 * s2] * d0[s2] + unpack4((v2u){kw[s2].x, kw[s2].y}); S[2 * s2 + 1] = S[2 * s2 + 1] * d1[s2] + unpack4((v2u){kw[s2].z, kw[s2].w}); }
            if (emit) {
#pragma unroll
                for (int tt = 0; tt < 4; ++tt) { const int t = 16 * tt + rr;
                    f32x4 acc = unpack4(Iw[tt]);
                    acc = __builtin_amdgcn_mfma_f32_16x16x32_bf16(Sf0, Q0[tt], acc, 0, 0, 0);
                    acc = __builtin_amdgcn_mfma_f32_16x16x32_bf16(Sf1, Q1[tt], acc, 0, 0, 0);
                    const int row = scan_row(c * CH + t, gb, gdir);
                    *(v2u*)(OGL + (size_t)row * RWW + gh * 128 + v0g + 4 * q) = pack4(acc); }
            }
        }
    }
#undef S2_BAR
}
#endif

#ifndef ML
#define ML 0
#endif
enum Phase { PH_PROLOGUE = 0, PH_A1, PH_INPROJ, PH_FEAT, PH_LORA, PH_SCAN1, PH_SCAN2, PH_MERGE, PH_BRANCH, PH_OUTPROJ, PH_LN1, PH_ROUTER, PH_ROUTE, PH_SCATTER, PH_EXP1, PH_EXP2, PH_FINAL, PH_COUNT };

__global__ void __launch_bounds__(NTHR, 2) mega(Args args) {
    extern __shared__ __attribute__((aligned(16))) unsigned char lds_raw[];
    Frame F;
    F.lds = (LAS unsigned char*)lds_raw;
    F.tid = threadIdx.x; F.lane = F.tid & 63; F.wave = __builtin_amdgcn_readfirstlane(F.tid >> 6);
    F.G = gridDim.x; F.gw = blockIdx.x * NWAVES + F.wave; F.NGW = F.G * NWAVES;
    F.in = args.in; F.out = args.out; F.ws = args.ws; F.ctl = (unsigned*)(args.ws + WS_CTL);
    volatile LAS unsigned* MISC = (volatile LAS unsigned*)(F.lds + MISC_OFF);
    if (F.tid < 64) MISC[F.tid] = 0u;
    __syncthreads();
    XcdBarrier bar; bar.bar = F.ctl + CW_BAR; bar.x = 0; bar.st = nullptr;
#if !ML
    bar = xcd_barrier_post(F.ctl + CW_BAR, MISC + 8);
#endif
    const int lo = args.ph_lo, hi = args.ph_hi;
#define IN(k) (lo <= (k) && (k) < hi)
#ifndef DUP
#define DUP -1
#endif
#define RUN(k, call) do { if (IN(k)) { call; GRID_BAR(); if (DUP == (k)) { call; GRID_BAR(); } } } while (0)
#if ML
#define GRID_BAR() do { } while (0)
#else
#define GRID_BAR() xcd_barrier(bar)
#endif

#if MS >= 2
    RUN(PH_PROLOGUE, ph_prologue(F));
#endif
#if MS >= 3
    RUN(PH_A1, ph_a1(F));
    RUN(PH_INPROJ, ph_inproj(F));
    RUN(PH_FEAT, ph_feat(F));
    RUN(PH_LORA, ph_lora(F));
    RUN(PH_SCAN1, ph_scan1(F));
    RUN(PH_SCAN2, ph_scan2(F));
    RUN(PH_MERGE, ph_merge(F));
    RUN(PH_BRANCH, ph_branch(F));
    RUN(PH_OUTPROJ, ph_outproj(F));
#else
    RUN(PH_OUTPROJ, ph_x1pre_nomix(F));
#endif
    RUN(PH_LN1, ph_ln1(F));
#if MS >= 2
    RUN(PH_ROUTER, ph_router(F));
    RUN(PH_ROUTE, ph_route(F));
    RUN(PH_SCATTER, ph_scatter(F));
    RUN(PH_EXP1, ph_exp1(F));
    RUN(PH_EXP2, ph_exp2(F));
#endif
    if (IN(PH_FINAL)) { ph_final(F); }
#undef IN
}

extern "C" void kernel_launch(void* const* d_in, const int* in_sizes, int n_in, void* d_out, int out_size, void* d_ws, size_t ws_size, hipStream_t stream) {
    static int grid = 0;
    if (grid == 0) {
        if (n_in != 36 || out_size != NLAT * D || ws_size < WS_END) { fprintf(stderr, "kernel_launch: unexpected problem shape (n_in %d, out %d)\n", n_in, out_size); grid = -1; return; }
        int dev = 0, cus = 0, per_cu = 0;
        if (hipGetDevice(&dev) != hipSuccess || hipDeviceGetAttribute(&cus, hipDeviceAttributeMultiprocessorCount, dev) != hipSuccess) { grid = -1; return; }
        if (hipFuncSetAttribute((const void*)mega, hipFuncAttributeMaxDynamicSharedMemorySize, LDS_BYTES) != hipSuccess) { fprintf(stderr, "kernel_launch: hipFuncSetAttribute failed\n"); grid = -1; return; }
        if (hipOccupancyMaxActiveBlocksPerMultiprocessor(&per_cu, (const void*)mega, NTHR, LDS_BYTES) != hipSuccess || per_cu < 1) { fprintf(stderr, "kernel_launch: occupancy query says %d\n", per_cu); }
        (void)hipGetLastError();
        grid = cus > 0 ? cus : 256;
        if (grid > 256) grid = 256;
    }
    if (grid < 0) return;
    (void)hipMemsetAsync((char*)d_ws + WS_CTL, 0, CTL_ZERO_BYTES, stream);
    Args a{};
    for (int i = 0; i < 36; ++i) a.in[i] = (const float*)d_in[i];
    a.out = (float*)d_out; a.ws = (unsigned char*)d_ws;
#if ML
    for (int p = 0; p < PH_COUNT; ++p) { a.ph_lo = p; a.ph_hi = p + 1; hipLaunchKernelGGL(mega, dim3(grid), dim3(NTHR), LDS_BYTES, stream, a); }
#else
    a.ph_lo = 0; a.ph_hi = PH_COUNT;
    hipLaunchKernelGGL(mega, dim3(grid), dim3(NTHR), LDS_BYTES, stream, a);
#endif
}
```

```cpp
#include <hip/hip_runtime.h>
#include <cstdio>
#include <cstdint>

#ifndef MS
#define MS 3
#endif

#define GAS __attribute__((address_space(1)))
#define LAS __attribute__((address_space(3)))
typedef unsigned short bf16;
typedef unsigned v4u __attribute__((ext_vector_type(4)));
typedef unsigned v2u __attribute__((ext_vector_type(2)));
typedef float f32x4 __attribute__((ext_vector_type(4)));
typedef float f32x2 __attribute__((ext_vector_type(2)));
typedef short bf16x8 __attribute__((ext_vector_type(8)));
#define LDS_WAIT() asm volatile("s_waitcnt lgkmcnt(0)" ::: "memory")
#define VM_WAIT() asm volatile("s_waitcnt vmcnt(0)" ::: "memory")

constexpr int D = 1024, NB = 4, SEQ = 8192, CTXL = 256, GRIDW = 64, GRIDH = 128;
constexpr int NLAT = NB * SEQ, NCTX = NB * CTXL, MR = NLAT + NCTX;
constexpr int RWW = 512, RWH = 8, HD = 64;
constexpr int C_R = 0, C_K = 512, C_V = 1024, C_PW = 1536, C_PA = 1568, C_PG = 1600, C_Q = 1696, C_KG = 1952, C_VG = 2208, C_PGL = 2720, C_OG = 2736, C_GRW = 3248, C_GGLA = 4272;
constexpr int IN_COLS = 5296, NP = 5376;
constexpr int NE = 256, TOPK = 8, FF = 256;
constexpr float LN_EPS = 1e-5f, RW_GN_EPS = 64e-5f;
constexpr float ALPHA = 1.189207115f;
constexpr int NLORA = 3072, KLORA = 256;
constexpr int MAXTILES = 1280, SH_ROW0 = MAXTILES * 256, NROWS_E = SH_ROW0 + NLAT;

namespace pg8 {
#define PG8_LAS __attribute__((address_space(3)))
typedef unsigned short bf16_t;
typedef unsigned u32x4 __attribute__((ext_vector_type(4)));
typedef unsigned u32x2 __attribute__((ext_vector_type(2)));
constexpr int BM = 256, BK = 64, HALF = 128, HTB = HALF * BK * 2, STAGE_BYTES = 8 * HTB, NXCD = 8, WGM = 8;
constexpr int IDX_OFF = STAGE_BYTES, IDX_UNITS = 12;

__host__ __device__ __forceinline__ int lds_byte(int r, int c) { const int st = (r >> 4) * 2 + (c >> 5), rr = r & 15, cc = c & 31, ob = rr * 64 + cc * 2; return st * 1024 + (ob ^ (((ob >> 9) & 1) << 5)); }
__host__ __device__ __forceinline__ void stage_rc(int b, int& R, int& C) { const int st = b / 1024, sb = b % 1024, swz = sb ^ (((sb >> 9) & 1) << 5); R = (st >> 1) * 16 + swz / 64; C = (st & 1) * 32 + (swz % 64) / 2; }
__host__ __device__ __forceinline__ int perm32(int rho) { const int n = rho >> 4, i = rho & 15; return 8 * (i >> 2) + 4 * n + (i & 3); }

struct Unit { int pm, pn, e, j; };
struct Gemm { const bf16_t* A; const bf16_t* Bt; int M, N, K; const int* rowidx; };

struct StaticOrder {
    int nM, nN, nwg, G, c;
    __host__ __device__ void init(int M, int N, int G_, int c_) { nM = M / BM; nN = N / BM; nwg = nM * nN; G = G_; c = c_; }
    __host__ __device__ bool next(int i, Unit& u) const {
        const long L = (long)i * G + c; if (L >= nwg) return false;
        int wgid = (int)L; { const int q = nwg / NXCD, r = nwg % NXCD, xcd = wgid % NXCD, off = wgid / NXCD; wgid = (xcd < r ? xcd * (q + 1) : r * (q + 1) + (xcd - r) * q) + off; }
        const int nig = WGM * nN, gid = wgid / nig, fm = gid * WGM, gsz = (nM - fm) < WGM ? (nM - fm) : WGM;
        u.pm = fm + ((wgid % nig) % gsz); u.pn = (wgid % nig) / gsz; u.e = 0; u.j = u.pn; return true;
    }
};
struct MoeOrder {
    int nN, G, c, NT; const int* tile_e;
    __device__ bool next(int i, Unit& u) const {
        const int L = i * G + c; const int total = (NT + NLAT / 256) * nN; if (L >= total) return false;
        const int tile = L / nN, j = L - tile * nN; int e, pm;
        if (tile < NT) { e = tile_e[tile]; pm = tile; } else { e = NE; pm = MAXTILES + (tile - NT); }
        u.pm = pm; u.pn = e * nN + j; u.e = e; u.j = j; return true;
    }
};

typedef __bf16 bf16x2n __attribute__((ext_vector_type(2))); typedef float f32x2n __attribute__((ext_vector_type(2)));
__device__ __forceinline__ unsigned cvt_pk_bf16(float lo, float hi) { const f32x2n v = {lo, hi}; return __builtin_bit_cast(unsigned, __builtin_convertvector(v, bf16x2n)); }

template <class Epi, class Sched, bool ALIGN_EPI, bool SP2, bool GATHER>
__device__ __forceinline__ void gemm_phase(PG8_LAS unsigned char* lds, const Gemm g, const Sched& S, const Epi& E) {
    const int tid = threadIdx.x, wid = __builtin_amdgcn_readfirstlane(tid >> 6), lane = tid & 63, wr = wid >> 2, wc = wid & 3, fr = lane & 15, fq = lane >> 4;
    const int K = g.K, nt = K / BK;
    const size_t kstep = (size_t)(BK * 2);
    const size_t hstep = (size_t)HALF * K * 2;
    const size_t tstep = 2 * hstep;
    unsigned voffB[2]; unsigned va[2][2];
#pragma unroll
    for (int i = 0; i < 2; ++i) { int R, C; stage_rc(tid * 16 + i * 8192, R, C); const int Rb = Epi::PERM ? ((R & ~31) + perm32(R & 31)) : R;
        voffB[i] = (unsigned)(Rb * K + C) * 2u;
        va[0][i] = (unsigned)(R * K + C) * 2u; va[1][i] = va[0][i]; }
    const size_t ah = GATHER ? (size_t)0 : hstep;
#define PG8_GOFF(dst, ub) do { _Pragma("unroll") for (int _h = 0; _h < 2; ++_h) _Pragma("unroll") for (int _i = 0; _i < 2; ++_i) { int _R, _C; stage_rc(tid * 16 + _i * 8192, _R, _C); \
        dst[_h][_i] = (unsigned)(idxt[(ub) * 256 + _h * 128 + _R] * K + _C) * 2u; } } while (0)
    const unsigned ldsw = (unsigned)wid * 1024u;
    const int aoff = lds_byte(wr * 64 + fr, fq * 8), boff = lds_byte(wc * 32 + fr, fq * 8);
    PG8_LAS int* idxt = (PG8_LAS int*)(lds + IDX_OFF);
#define PG8_SA(b, h) (((b) * 2 + (h)) * HTB)
#define PG8_SB(b, h) ((4 + (b) * 2 + (h)) * HTB)
#define PG8_STAGE(bufoff, gbase, voff) do { _Pragma("unroll") for (int _i = 0; _i < 2; ++_i) \
        __builtin_amdgcn_global_load_lds((const unsigned*)((const char*)(gbase) + (voff)[_i]), (PG8_LAS unsigned*)(lds + (bufoff) + ldsw + _i * 8192), 16, 0, 0); } while (0)
#define PG8_LDA(dst, b, h) do { _Pragma("unroll") for (int m = 0; m < 4; ++m) _Pragma("unroll") for (int k = 0; k < 2; ++k) dst[m][k] = *(const PG8_LAS bf16x8*)(lds + PG8_SA(b, h) + aoff + m * 2048 + k * 1024); } while (0)
#define PG8_LDB(dst, b, h) do { _Pragma("unroll") for (int n = 0; n < 2; ++n) _Pragma("unroll") for (int k = 0; k < 2; ++k) dst[n][k] = *(const PG8_LAS bf16x8*)(lds + PG8_SB(b, h) + boff + n * 2048 + k * 1024); } while (0)
#define PG8_MMA(ai, bj, At, Bt) do { __builtin_amdgcn_s_setprio(1); _Pragma("unroll") for (int m = 0; m < 4; ++m) _Pragma("unroll") for (int n = 0; n < 2; ++n) _Pragma("unroll") for (int k = 0; k < 2; ++k) \
        acc[ai][bj][m][n] = __builtin_amdgcn_mfma_f32_16x16x32_bf16(Bt[n][k], At[m][k], acc[ai][bj][m][n], 0, 0, 0); __builtin_amdgcn_s_setprio(0); } while (0)
#define PG8_WAIT_V(n) asm volatile("s_waitcnt vmcnt(" #n ")" ::: "memory")
#define PG8_WAIT_L(n) asm volatile("s_waitcnt lgkmcnt(" #n ")" ::: "memory")
#define PG8_BAR __builtin_amdgcn_s_barrier()
#define PG8_SCHED __builtin_amdgcn_sched_barrier(0)
    Unit cur, nxt; int ui = 0;
    if (!S.next(0, cur)) return;
    if constexpr (GATHER) {
        Unit uu;
        for (int i = 0; i < IDX_UNITS; ++i) { if (!S.next(i, uu)) break; if (tid < 256) idxt[i * 256 + tid] = g.rowidx[(size_t)uu.pm * 256 + tid]; }
        asm volatile("s_waitcnt vmcnt(0) lgkmcnt(0)" ::: "memory"); PG8_BAR; asm volatile("" ::: "memory");
        PG8_GOFF(va, 0);
    }
    f32x4 acc[2][2][4][2];
#pragma unroll
    for (int a = 0; a < 2; ++a)
#pragma unroll
        for (int b = 0; b < 2; ++b)
#pragma unroll
            for (int m = 0; m < 4; ++m)
#pragma unroll
                for (int n = 0; n < 2; ++n) acc[a][b][m][n] = (f32x4){0.f, 0.f, 0.f, 0.f};
    bf16x8 At[4][2], B0[2][2], B1[2][2];
    const char* cA = (const char*)g.A + (GATHER ? (size_t)0 : (size_t)cur.pm * tstep); const char* cB = (const char*)g.Bt + (size_t)cur.pn * tstep;
    if constexpr (SP2) {
        PG8_STAGE(PG8_SB(0, 0), cB, voffB); PG8_STAGE(PG8_SB(0, 1), cB + hstep, voffB); PG8_STAGE(PG8_SA(0, 0), cA, va[0]); PG8_STAGE(PG8_SA(0, 1), cA + ah, va[1]);
        if (wr == 1) PG8_BAR;
        PG8_WAIT_V(2); PG8_BAR;
        PG8_STAGE(PG8_SB(1, 0), cB + kstep, voffB); PG8_STAGE(PG8_SA(1, 0), cA + kstep, va[0]); PG8_STAGE(PG8_SB(1, 1), cB + hstep + kstep, voffB);
        PG8_WAIT_V(6); PG8_BAR;
    } else {
        PG8_STAGE(PG8_SB(0, 0), cB, voffB); PG8_STAGE(PG8_SA(0, 0), cA, va[0]); PG8_STAGE(PG8_SB(0, 1), cB + hstep, voffB); PG8_STAGE(PG8_SA(0, 1), cA + ah, va[1]);
        if (wr == 1) PG8_BAR;
        PG8_WAIT_V(4); PG8_BAR;
        PG8_STAGE(PG8_SB(1, 0), cB + kstep, voffB); PG8_STAGE(PG8_SA(1, 0), cA + kstep, va[0]); PG8_STAGE(PG8_SB(1, 1), cB + hstep + kstep, voffB);
        PG8_WAIT_V(6); PG8_BAR;
    }
    for (;;) {
        const bool has_next = S.next(ui + 1, nxt);
        const char* nA = has_next ? (const char*)g.A + (GATHER ? (size_t)0 : (size_t)nxt.pm * tstep) : cA; const char* nB = has_next ? (const char*)g.Bt + (size_t)nxt.pn * tstep : cB;
        const int ubn = (has_next && ui + 1 < IDX_UNITS) ? (ui + 1) : ui;
#pragma unroll 1
        for (int t = 0; t < nt; t += 2) {
            const bool last = (t == nt - 2);
            const char* a1 = cA + (size_t)(t + 1) * kstep;
            const char* a2 = last ? nA : cA + (size_t)(t + 2) * kstep; const char* b2 = last ? nB : cB + (size_t)(t + 2) * kstep;
            const char* a3 = a2 + kstep; const char* b3 = b2 + kstep;
            unsigned v2[2][2];
#pragma unroll
            for (int h = 0; h < 2; ++h)
#pragma unroll
                for (int i = 0; i < 2; ++i) v2[h][i] = va[h][i];
            if constexpr (GATHER) { if (last) PG8_GOFF(v2, ubn); }
            if constexpr (SP2) {
            PG8_LDB(B0, 0, 0); PG8_LDB(B1, 0, 1); PG8_SCHED; PG8_LDA(At, 0, 0); PG8_STAGE(PG8_SA(1, 1), a1 + ah, va[1]);
            PG8_WAIT_V(8); PG8_WAIT_L(0); PG8_BAR; PG8_MMA(0, 0, At, B0); PG8_MMA(0, 1, At, B1); PG8_BAR; PG8_SCHED;
            PG8_LDA(At, 0, 1); PG8_STAGE(PG8_SB(0, 0), b2, voffB); PG8_STAGE(PG8_SB(0, 1), b2 + hstep, voffB); PG8_STAGE(PG8_SA(0, 0), a2, v2[0]);
            PG8_WAIT_V(8); PG8_WAIT_L(0); PG8_BAR; PG8_MMA(1, 0, At, B0); PG8_MMA(1, 1, At, B1); PG8_BAR; PG8_SCHED;
            PG8_LDB(B0, 1, 0); PG8_LDB(B1, 1, 1); PG8_SCHED; PG8_LDA(At, 1, 0); PG8_STAGE(PG8_SA(0, 1), a2 + ah, v2[1]);
            PG8_WAIT_V(8); PG8_WAIT_L(0); PG8_BAR; PG8_MMA(0, 0, At, B0); PG8_MMA(0, 1, At, B1); PG8_BAR; PG8_SCHED;
            PG8_LDA(At, 1, 1); PG8_STAGE(PG8_SB(1, 0), b3, voffB); PG8_STAGE(PG8_SB(1, 1), b3 + hstep, voffB); PG8_STAGE(PG8_SA(1, 0), a3, v2[0]);
            PG8_WAIT_V(8); PG8_WAIT_L(0); PG8_BAR; PG8_MMA(1, 0, At, B0); PG8_MMA(1, 1, At, B1); PG8_BAR; PG8_SCHED;
            } else {
            PG8_LDB(B0, 0, 0); PG8_SCHED; PG8_LDA(At, 0, 0); PG8_STAGE(PG8_SA(1, 1), a1 + ah, va[1]);
            PG8_WAIT_L(8); PG8_BAR; PG8_WAIT_L(0); PG8_MMA(0, 0, At, B0); PG8_BAR; PG8_SCHED;
            PG8_LDB(B1, 0, 1); PG8_STAGE(PG8_SB(0, 0), b2, voffB);
            PG8_BAR; PG8_WAIT_L(0); PG8_MMA(0, 1, At, B1); PG8_BAR;
            PG8_LDA(At, 0, 1); PG8_STAGE(PG8_SA(0, 0), a2, v2[0]);
            PG8_BAR; PG8_WAIT_L(0); PG8_MMA(1, 0, At, B0); PG8_BAR; PG8_SCHED;
            PG8_STAGE(PG8_SB(0, 1), b2 + hstep, voffB);
            PG8_WAIT_V(6); PG8_BAR; PG8_MMA(1, 1, At, B1); PG8_BAR;
            PG8_LDB(B0, 1, 0); PG8_SCHED; PG8_LDA(At, 1, 0); PG8_STAGE(PG8_SA(0, 1), a2 + ah, v2[1]);
            PG8_WAIT_L(8); PG8_BAR; PG8_WAIT_L(0); PG8_MMA(0, 0, At, B0); PG8_BAR; PG8_SCHED;
            PG8_LDB(B1, 1, 1); PG8_STAGE(PG8_SB(1, 0), b3, voffB);
            PG8_BAR; PG8_WAIT_L(0); PG8_MMA(0, 1, At, B1); PG8_BAR;
            PG8_LDA(At, 1, 1); PG8_STAGE(PG8_SA(1, 0), a3, v2[0]);
            PG8_BAR; PG8_WAIT_L(0); PG8_MMA(1, 0, At, B0); PG8_BAR; PG8_SCHED;
            PG8_STAGE(PG8_SB(1, 1), b3 + hstep, voffB);
            PG8_WAIT_V(6); PG8_BAR; PG8_MMA(1, 1, At, B1); PG8_BAR;
            }
        }
        if constexpr (ALIGN_EPI) { if (wr == 0) PG8_BAR; }
        E(acc, cur, wr, wc, fr, fq);
        if (!has_next) break;
#pragma unroll
        for (int a = 0; a < 2; ++a)
#pragma unroll
            for (int b = 0; b < 2; ++b)
#pragma unroll
                for (int m = 0; m < 4; ++m)
#pragma unroll
                    for (int n = 0; n < 2; ++n) acc[a][b][m][n] = (f32x4){0.f, 0.f, 0.f, 0.f};
        cur = nxt; cA = nA; cB = nB; ++ui;
        if constexpr (GATHER) PG8_GOFF(va, ubn);
        if constexpr (ALIGN_EPI) { if (wr == 1) PG8_BAR; }
    }
    PG8_WAIT_V(0);
    if constexpr (!ALIGN_EPI) { if (wr == 0) PG8_BAR; }
    PG8_BAR;
#undef PG8_SA
#undef PG8_GOFF
#undef PG8_SB
#undef PG8_STAGE
#undef PG8_LDA
#undef PG8_LDB
#undef PG8_MMA
#undef PG8_WAIT_V
#undef PG8_WAIT_L
#undef PG8_BAR
#undef PG8_SCHED
}
}

#define XB_TMO      128
#define XB_XCNT(j)  (256  + 64 * (j))
#define XB_XSUB(j)  (1280 + 64 * (j))
#define XB_XGEN(j)  (2304 + 64 * (j))
#define XB_TOP      3328
#define XB_TOPGEN   3392
#define XCD_BAR_WORDS 3456
#define XB_SPIN_CAP (1u << 18)
__device__ __forceinline__ unsigned xb_ld(unsigned* p)              { return __hip_atomic_load(p, __ATOMIC_RELAXED, __HIP_MEMORY_SCOPE_AGENT); }
__device__ __forceinline__ unsigned xb_add(unsigned* p, unsigned v) { return __hip_atomic_fetch_add(p, v, __ATOMIC_RELAXED, __HIP_MEMORY_SCOPE_AGENT); }
__device__ __forceinline__ unsigned xb_xcc_id() { return (unsigned)__builtin_amdgcn_s_getreg((3 << 11) | 20) & 0xFu; }
#define XB_SPIN(cond, bar) do { unsigned _sp = 0; while (cond) { __builtin_amdgcn_s_sleep(1); \
    if ((++_sp & 255u) == 0u) { if (xb_ld(&(bar)[XB_TMO])) break; if (_sp > XB_SPIN_CAP) { atomicAdd(&(bar)[XB_TMO], 1u); break; } } } } while (0)
struct XcdBarrier { unsigned* bar; unsigned x; volatile LAS unsigned* st; };
__device__ __forceinline__ XcdBarrier xcd_barrier_post(unsigned* bar, volatile LAS unsigned* st) {
    XcdBarrier b; b.bar = bar; b.x = xb_xcc_id(); b.st = st;
    if (threadIdx.x == 0) (void)xb_add(&bar[XB_XCNT(b.x)], 1u);
    return b;
}
__device__ __forceinline__ void xcd_barrier_complete(unsigned* bar, unsigned x, unsigned& nloc, unsigned& nx) {
    const unsigned G = gridDim.x * gridDim.y * gridDim.z;
    unsigned sum, cnt, mine, sp = 0u;
    for (;;) {
        sum = 0u; cnt = 0u; mine = 0u;
#pragma unroll
        for (unsigned j = 0; j < 16; ++j) { const unsigned c = xb_ld(&bar[XB_XCNT(j)]); sum += c; cnt += (c > 0u) ? 1u : 0u; mine = (j == x) ? c : mine; }
        if (sum == G) break;
        __builtin_amdgcn_s_sleep(1);
        if ((++sp & 255u) == 0u) { if (xb_ld(&bar[XB_TMO])) break; if (sp > XB_SPIN_CAP) { atomicAdd(&bar[XB_TMO], 1u); break; } }
    }
    nloc = mine > 0u ? mine : 1u; nx = cnt > 0u ? cnt : 1u;
}
__device__ __forceinline__ void xcd_barrier(const XcdBarrier& b) {
    asm volatile("s_waitcnt vmcnt(0)" ::: "memory");
    __syncthreads();
    if (threadIdx.x == 0) {
        unsigned* bar = b.bar;
        __builtin_amdgcn_s_waitcnt(0);
        unsigned nloc = b.st[0], nx = b.st[1];
        if (nloc == 0u) { xcd_barrier_complete(bar, b.x, nloc, nx); b.st[0] = nloc; b.st[1] = nx; }
        const unsigned old = xb_add(&bar[XB_XSUB(b.x)], 1u);
        const unsigned gen = old / nloc;
        if (old + 1u == (gen + 1u) * nloc) {
            __builtin_amdgcn_fence(__ATOMIC_RELEASE, "agent");
            asm volatile("s_waitcnt vmcnt(0)" ::: "memory");
            const unsigned og = xb_add(&bar[XB_TOP], 1u);
            const unsigned tg = og / nx;
            if (og + 1u == (tg + 1u) * nx) xb_add(&bar[XB_TOPGEN], 1u);
            else XB_SPIN(xb_ld(&bar[XB_TOPGEN]) == tg, bar);
            __builtin_amdgcn_fence(__ATOMIC_ACQUIRE, "agent");
            xb_add(&bar[XB_XGEN(b.x)], 1u);
            asm volatile("s_waitcnt vmcnt(0)" ::: "memory");
        } else {
            XB_SPIN(xb_ld(&bar[XB_XGEN(b.x)]) == gen, bar);
            __builtin_amdgcn_fence(__ATOMIC_ACQUIRE, "agent");
            asm volatile("s_waitcnt vmcnt(0)" ::: "memory");
        }
    }
    __syncthreads();
}

constexpr size_t MiB = 1u << 20;
constexpr size_t al(size_t x) { return (x + 4095) & ~(size_t)4095; }
constexpr size_t WS_CTL = 0, CTL_ZERO_BYTES = 1 * MiB;
constexpr int CW_BAR = 4096;
constexpr int CW_CNT = 16384;
constexpr int CW_NT = 16384 + 512;
constexpr size_t WS_MOD = 1 * MiB;
constexpr size_t WS_TILE_E = WS_MOD + 256 * 1024;
constexpr size_t WS_PADSTART = WS_TILE_E + 16 * 1024;
constexpr size_t WS_ROWTOK = 2 * MiB;
constexpr size_t WS_EIDX = 4 * MiB;
constexpr size_t WS_GATE = 5 * MiB;
constexpr size_t WS_DEST = 6 * MiB;
constexpr size_t WS_WIN = 8 * MiB;
constexpr size_t WS_WLORA = WS_WIN + al((size_t)NP * D * 2);
constexpr size_t WS_WBRRW = WS_WLORA + al((size_t)NLORA * KLORA * 2);
constexpr size_t WS_WBRGLA = WS_WBRRW + al((size_t)D * RWW * 2);
constexpr size_t WS_WOUT = WS_WBRGLA + al((size_t)D * RWW * 2);
constexpr size_t WS_WROUTER = WS_WOUT + al((size_t)D * D * 2);
constexpr size_t WS_WGU = WS_WROUTER + al((size_t)NE * D * 2);
constexpr size_t WS_WD = WS_WGU + al((size_t)(NE + 1) * 512 * D * 2);
constexpr size_t WS_PERSIST_END = WS_WD + al((size_t)(NE + 1) * D * FF * 2);
constexpr size_t WS_REGB = WS_PERSIST_END;
constexpr size_t SZ512F = al((size_t)MR * RWW * 4), SZ256F = al((size_t)MR * 256 * 4), SZ512H = al((size_t)MR * RWW * 2);
constexpr size_t WS_A1 = WS_REGB;
constexpr size_t WS_A2 = WS_A1;
constexpr size_t WS_KSUM = WS_A2 + al((size_t)MR * KLORA * 2);
static_assert(WS_KSUM + SZ512H <= WS_A1 + al((size_t)MR * D * 2), "A2 + KSUM fit in the A1 slot");
constexpr size_t WS_P = WS_A1 + al((size_t)MR * D * 2);
constexpr size_t WS_RB = WS_P + al((size_t)MR * NP * 2);
constexpr size_t WS_VB = WS_RB + SZ512H, WS_KKB = WS_VB + SZ512H, WS_KMF = WS_KKB + SZ512H, WS_KMB = WS_KMF + SZ512H, WS_BVF = WS_KMB + SZ512H, WS_BVB = WS_BVF + SZ512H;
constexpr size_t WS_LWF = WS_BVB + SZ512H, WS_LWB = WS_LWF + SZ512F;
constexpr size_t SZ256H = al((size_t)MR * 256 * 2);
constexpr size_t WS_QGB = WS_LWB + SZ512F, WS_KGB = WS_QGB + SZ256H, WS_VGB = WS_KGB + SZ256H, WS_LAF = WS_VGB + SZ512H, WS_LAB = WS_LAF + SZ256F;
constexpr size_t WS_RWG = WS_LAB + SZ256F;
constexpr size_t WS_ORWF = WS_RWG + SZ512H, WS_ORWB = WS_ORWF + SZ512H, WS_OGLF = WS_ORWB + SZ512H, WS_OGLB = WS_OGLF + SZ512H;
constexpr int CH = 64, NCHUNK = (CTXL + SEQ) / CH, NU_RW = 64 * NCHUNK, NU_GL = 32 * NCHUNK;
constexpr size_t WS_RH = WS_OGLB + SZ512H;
constexpr size_t WS_YL = WS_RH + al((size_t)NU_RW * 4096 * 2);
constexpr size_t WS_HH = WS_YL + al((size_t)NU_RW * 4096 * 2);
constexpr size_t WS_INTRA = WS_HH + al((size_t)NU_RW * 4096 * 2);
constexpr size_t WS_KV = WS_INTRA + al((size_t)NU_GL * 8192 * 2);
constexpr size_t WS_DD = WS_KV + al((size_t)NU_GL * 8192 * 2);
constexpr size_t WS_END_MIX = WS_DD + al((size_t)NU_GL * 64 * 4);
constexpr size_t OUT_GT = 0, OUT_QE = (size_t)NU_RW * 4096 * 2;
static_assert(OUT_QE + (size_t)NU_GL * 4096 * 2 <= (size_t)NLAT * D * 4, "scan scratch fits in d_out");
constexpr size_t WS_YRW = WS_LWF, WS_YGLA = WS_LWB, WS_Z = WS_HH;
static_assert((size_t)NLAT * D * 2 <= (size_t)NU_RW * 4096 * 2, "Z fits in the HH slot");
constexpr size_t WS_X1 = WS_REGB;
constexpr size_t WS_A3 = WS_X1 + al((size_t)NLAT * D * 4);
constexpr size_t WS_LOGITS = WS_A3 + al((size_t)NLAT * D * 2);
constexpr size_t WS_ACT = WS_LOGITS + al((size_t)NLAT * NE * 4);
constexpr size_t WS_Y = WS_ACT + al((size_t)NROWS_E * FF * 2);
constexpr size_t WS_END_MOE = WS_Y + al((size_t)NROWS_E * D * 2);
constexpr size_t WS_END = WS_END_MIX > WS_END_MOE ? WS_END_MIX : WS_END_MOE;
static_assert(WS_END <= (size_t)2048 * MiB, "workspace map exceeds 2 GiB");

constexpr int RING_BYTES = 131072;
constexpr int IDX_BYTES = pg8::IDX_UNITS * 256 * 4;
constexpr int MISC_OFF = RING_BYTES + IDX_BYTES;
constexpr int LDS_BYTES = MISC_OFF + 256;
static_assert(pg8::IDX_OFF == RING_BYTES, "gather table sits right above the stage buffers");
constexpr int NWAVES = 8, NTHR = 512;

struct Args { const float* in[36]; float* out; unsigned char* ws; int ph_lo, ph_hi; };

struct Frame {
    LAS unsigned char* lds;
    int tid, lane, wave, G, gw, NGW;
    const float* const* in; float* out; unsigned char* ws; unsigned* ctl;
};

__device__ __forceinline__ float wave_sum(float v) {
#pragma unroll
    for (int o = 1; o < 64; o <<= 1) v += __shfl_xor(v, o);
    return v;
}
__device__ __forceinline__ unsigned f2bf(float f) { unsigned u = __builtin_bit_cast(unsigned, f); return (u + 0x7fffu + ((u >> 16) & 1u)) >> 16; }
typedef __bf16 bf16x2v __attribute__((ext_vector_type(2)));
__device__ __forceinline__ unsigned pk2(float lo, float hi) { const f32x2 v = {lo, hi}; return __builtin_bit_cast(unsigned, __builtin_convertvector(v, bf16x2v)); }
__device__ __forceinline__ float bflo(unsigned w) { return __builtin_bit_cast(float, w << 16); }
__device__ __forceinline__ float bfhi(unsigned w) { return __builtin_bit_cast(float, w & 0xffff0000u); }
__device__ __forceinline__ float sigmoidf_(float x) { return 1.0f / (1.0f + __expf(-x)); }
__device__ __forceinline__ float siluf_(float x) { return x / (1.0f + __expf(-x)); }

__device__ __forceinline__ void ln_stats(const f32x4 (&v)[4], float& mean, float& rstd) {
    float s = 0.f;
#pragma unroll
    for (int j = 0; j < 4; ++j) s += (v[j].x + v[j].y) + (v[j].z + v[j].w);
    mean = wave_sum(s) * (1.f / D); float s2 = 0.f;
#pragma unroll
    for (int j = 0; j < 4; ++j) { const f32x4 d = v[j] - mean; s2 += (d.x * d.x + d.y * d.y) + (d.z * d.z + d.w * d.w); }
    rstd = 1.f / sqrtf(wave_sum(s2) * (1.f / D) + LN_EPS);
}

__device__ __forceinline__ void ld_row_bf16(const bf16* row, int lane, f32x4 (&v)[4]) {
    const v4u a = *(const v4u*)(row + 8 * lane), b = *(const v4u*)(row + 512 + 8 * lane);
    v[0] = (f32x4){bflo(a.x), bfhi(a.x), bflo(a.y), bfhi(a.y)}; v[1] = (f32x4){bflo(a.z), bfhi(a.z), bflo(a.w), bfhi(a.w)};
    v[2] = (f32x4){bflo(b.x), bfhi(b.x), bflo(b.y), bfhi(b.y)}; v[3] = (f32x4){bflo(b.z), bfhi(b.z), bflo(b.w), bfhi(b.w)};
}
__device__ __forceinline__ int rowcol(int lane, int j) { return 512 * (j >> 1) + 8 * lane + 4 * (j & 1); }
__device__ __forceinline__ void ph_x1pre_nomix(Frame& F) {
    const float* x = F.in[0];
    for (int m = F.gw; m < NLAT; m += F.NGW) {
        bf16* o = (bf16*)(F.ws + WS_X1) + (size_t)m * D;
#pragma unroll
        for (int h = 0; h < 2; ++h) { const float* xr = x + (size_t)m * D + 512 * h + 8 * F.lane; const f32x4 a = *(const f32x4*)xr * ALPHA, b = *(const f32x4*)(xr + 4) * ALPHA;
            v4u w; w.x = pk2(a.x, a.y); w.y = pk2(a.z, a.w); w.z = pk2(b.x, b.y); w.w = pk2(b.z, b.w); *(v4u*)(o + 512 * h + 8 * F.lane) = w; }
    }
}
__device__ __forceinline__ void ph_ln1(Frame& F) {
    const float* lw = F.in[26]; const float* lb = F.in[27]; const float* mod = (const float*)(F.ws + WS_MOD);
    bf16* A3 = (bf16*)(F.ws + WS_A3); const bf16* X1P = (const bf16*)(F.ws + WS_X1);
    constexpr int NR = 4;
    for (int m0 = F.gw; m0 < NLAT; m0 += NR * F.NGW) {
        v4u w[NR][2];
#pragma unroll
        for (int r = 0; r < NR; ++r) { const int mm = m0 + r * F.NGW; const bf16* row = X1P + (size_t)(mm < NLAT ? mm : m0) * D; w[r][0] = *(const v4u*)(row + 8 * F.lane); w[r][1] = *(const v4u*)(row + 512 + 8 * F.lane); }
        __builtin_amdgcn_sched_barrier(0);
#pragma unroll
        for (int r = 0; r < NR; ++r) { const int mm = m0 + r * F.NGW; const int m = mm < NLAT ? mm : m0; const int b = m / SEQ;
            f32x4 v[4];
            v[0] = (f32x4){bflo(w[r][0].x), bfhi(w[r][0].x), bflo(w[r][0].y), bfhi(w[r][0].y)}; v[1] = (f32x4){bflo(w[r][0].z), bfhi(w[r][0].z), bflo(w[r][0].w), bfhi(w[r][0].w)};
            v[2] = (f32x4){bflo(w[r][1].x), bfhi(w[r][1].x), bflo(w[r][1].y), bfhi(w[r][1].y)}; v[3] = (f32x4){bflo(w[r][1].z), bfhi(w[r][1].z), bflo(w[r][1].w), bfhi(w[r][1].w)};
            float mean, rstd; ln_stats(v, mean, rstd);
#if MS >= 2
            f32x4 h[4];
#pragma unroll
            for (int j = 0; j < 4; ++j) { const int c = rowcol(F.lane, j);
                const f32x4 x1 = (v[j] - mean) * rstd * *(const f32x4*)(lw + c) + *(const f32x4*)(lb + c);
                h[j] = x1 * (*(const f32x4*)(mod + b * 6144 + 4096 + c) + 1.0f) + *(const f32x4*)(mod + b * 6144 + 3072 + c); }
            bf16* ao = A3 + (size_t)m * D;
            { v4u o; o.x = pk2(h[0].x, h[0].y); o.y = pk2(h[0].z, h[0].w); o.z = pk2(h[1].x, h[1].y); o.w = pk2(h[1].z, h[1].w); *(v4u*)(ao + 8 * F.lane) = o;
              o.x = pk2(h[2].x, h[2].y); o.y = pk2(h[2].z, h[2].w); o.z = pk2(h[3].x, h[3].y); o.w = pk2(h[3].z, h[3].w); *(v4u*)(ao + 512 + 8 * F.lane) = o; }
#endif
        }
    }
}
__device__ __forceinline__ void ph_final(Frame& F) {
    const float* lw = F.in[34]; const float* lb = F.in[35]; const float* mod = (const float*)(F.ws + WS_MOD);
    const float* lw1 = F.in[26]; const float* lb1 = F.in[27]; const bf16* X1P = (const bf16*)(F.ws + WS_X1);
    const bf16* Y = (const bf16*)(F.ws + WS_Y); const int* DEST = (const int*)(F.ws + WS_DEST); const float* GATE = (const float*)(F.ws + WS_GATE);
    for (int m0 = F.gw; m0 < NLAT; m0 += 2 * F.NGW) {
        int mm[2]; mm[0] = m0; mm[1] = (m0 + F.NGW < NLAT) ? m0 + F.NGW : m0;
        v4u xw[2][2];
#if MS >= 2
        v4u dw[2][2]; f32x4 gw[2][2];
#pragma unroll
        for (int r = 0; r < 2; ++r) { dw[r][0] = *(const v4u*)(DEST + mm[r] * 8); dw[r][1] = *(const v4u*)(DEST + mm[r] * 8 + 4); gw[r][0] = *(const f32x4*)(GATE + mm[r] * 8); gw[r][1] = *(const f32x4*)(GATE + mm[r] * 8 + 4); }
#endif
#pragma unroll
        for (int r = 0; r < 2; ++r) { const bf16* row = X1P + (size_t)mm[r] * D; xw[r][0] = *(const v4u*)(row + 8 * F.lane); xw[r][1] = *(const v4u*)(row + 512 + 8 * F.lane); }
#if MS >= 2
        v4u yw[2][TOPK + 1][2];
#pragma unroll
        for (int r = 0; r < 2; ++r) {
            int dr[TOPK]; dr[0] = (int)dw[r][0].x; dr[1] = (int)dw[r][0].y; dr[2] = (int)dw[r][0].z; dr[3] = (int)dw[r][0].w; dr[4] = (int)dw[r][1].x; dr[5] = (int)dw[r][1].y; dr[6] = (int)dw[r][1].z; dr[7] = (int)dw[r][1].w;
#pragma unroll
            for (int k = 0; k <= TOPK; ++k) { const bf16* yr = Y + (size_t)(k < TOPK ? dr[k < TOPK ? k : 0] : SH_ROW0 + mm[r]) * D;
                yw[r][k][0] = *(const v4u*)(yr + 8 * F.lane); yw[r][k][1] = *(const v4u*)(yr + 512 + 8 * F.lane); } }
        __builtin_amdgcn_sched_barrier(0);
#endif
#pragma unroll
        for (int r = 0; r < 2; ++r) { const int m = mm[r]; const int b = m / SEQ;
            f32x4 v[4];
            v[0] = (f32x4){bflo(xw[r][0].x), bfhi(xw[r][0].x), bflo(xw[r][0].y), bfhi(xw[r][0].y)}; v[1] = (f32x4){bflo(xw[r][0].z), bfhi(xw[r][0].z), bflo(xw[r][0].w), bfhi(xw[r][0].w)};
            v[2] = (f32x4){bflo(xw[r][1].x), bfhi(xw[r][1].x), bflo(xw[r][1].y), bfhi(xw[r][1].y)}; v[3] = (f32x4){bflo(xw[r][1].z), bfhi(xw[r][1].z), bflo(xw[r][1].w), bfhi(xw[r][1].w)};
            { float mean1, rstd1; ln_stats(v, mean1, rstd1);
#pragma unroll
              for (int j = 0; j < 4; ++j) { const int c = rowcol(F.lane, j); v[j] = ((v[j] - mean1) * rstd1 * *(const f32x4*)(lw1 + c) + *(const f32x4*)(lb1 + c)) * ALPHA; } }
#if MS >= 2
            const float gt[TOPK] = {gw[r][0].x, gw[r][0].y, gw[r][0].z, gw[r][0].w, gw[r][1].x, gw[r][1].y, gw[r][1].z, gw[r][1].w};
#pragma unroll
            for (int hh = 0; hh < 2; ++hh) { const v4u ys = yw[r][TOPK][hh];
                f32x4 m0v = (f32x4){bflo(ys.x), bfhi(ys.x), bflo(ys.y), bfhi(ys.y)}, m1v = (f32x4){bflo(ys.z), bfhi(ys.z), bflo(ys.w), bfhi(ys.w)};
#pragma unroll
                for (int k = 0; k < TOPK; ++k) { const v4u yk = yw[r][k][hh];
                    m0v += (f32x4){bflo(yk.x), bfhi(yk.x), bflo(yk.y), bfhi(yk.y)} * gt[k]; m1v += (f32x4){bflo(yk.z), bfhi(yk.z), bflo(yk.w), bfhi(yk.w)} * gt[k]; }
                v[2 * hh] += *(const f32x4*)(mod + b * 6144 + 5120 + rowcol(F.lane, 2 * hh)) * m0v; v[2 * hh + 1] += *(const f32x4*)(mod + b * 6144 + 5120 + rowcol(F.lane, 2 * hh + 1)) * m1v; }
#endif
            float mean, rstd; ln_stats(v, mean, rstd);
            float* o = F.out + (size_t)m * D;
#pragma unroll
            for (int j = 0; j < 4; ++j) { const int c = rowcol(F.lane, j); *(f32x4*)(o + c) = (v[j] - mean) * rstd * *(const f32x4*)(lw + c) + *(const f32x4*)(lb + c); }
        }
    }
}


#if MS >= 2
template <int MODE>
__device__ __forceinline__ void cvt_item(const float* W, int Nsrc, int nblk, bf16* WT, int row_off, int dpitch, LAS float* scr, int item, int lane) {
    const int kb = item / nblk, nb = item - kb * nblk, k0 = 64 * kb, n0 = 32 * nb;
    const int nn = n0 + (lane & 31);
#pragma unroll 8
    for (int i = 0; i < 32; ++i) { const int kk = 2 * i + (lane >> 5); scr[kk * 33 + (lane & 31)] = (nn < Nsrc) ? W[(size_t)(k0 + kk) * Nsrc + nn] : 0.f; }
    LDS_WAIT(); asm volatile("" ::: "memory");
    const int c = lane & 7;
#pragma unroll
    for (int j = 0; j < 4; ++j) { const int n = (lane >> 3) + 8 * j; const LAS float* s = scr + (8 * c) * 33 + n;
        v4u o; o.x = pk2(s[0 * 33], s[1 * 33]); o.y = pk2(s[2 * 33], s[3 * 33]); o.z = pk2(s[4 * 33], s[5 * 33]); o.w = pk2(s[6 * 33], s[7 * 33]);
        const int ng = n0 + n; int dr = ng;
        if (MODE == 1) { const int i2 = ng & 255; dr = 8 * (i2 >> 2) + (i2 & 3) + ((ng >= 256) ? 4 : 0); }
        *(v4u*)(WT + (size_t)(row_off + dr) * dpitch + k0 + 8 * c) = o; }
    LDS_WAIT(); asm volatile("" ::: "memory");
}

template <int MODE>
__device__ __forceinline__ void cvt_item_reg(const float* W, int Nsrc, bf16* WT, int row_off, int dpitch, int k0, int n0, int lane) {
    const float* src = W + (size_t)k0 * Nsrc + n0 + 4 * lane;
    f32x4 v[32];
#pragma unroll
    for (int i = 0; i < 32; ++i) v[i] = __builtin_nontemporal_load((const f32x4*)(src + (size_t)i * Nsrc));
#pragma unroll
    for (int j = 0; j < 4; ++j) {
        const int ng = n0 + 4 * lane + j; int dr = ng;
        if (MODE == 1) { const int i2 = ng & 255; dr = 8 * (i2 >> 2) + (i2 & 3) + ((ng >= 256) ? 4 : 0); }
        v4u* dst = (v4u*)(WT + (size_t)(row_off + dr) * dpitch + k0);
#pragma unroll
        for (int q = 0; q < 4; ++q) { v4u o; o.x = pk2(v[8 * q][j], v[8 * q + 1][j]); o.y = pk2(v[8 * q + 2][j], v[8 * q + 3][j]); o.z = pk2(v[8 * q + 4][j], v[8 * q + 5][j]); o.w = pk2(v[8 * q + 6][j], v[8 * q + 7][j]); dst[q] = o; }
    }
}

constexpr int CVK = 32;
__device__ __forceinline__ void cvt_reg_load(const float* W, int Nsrc, int k0, int n0, int lane, f32x4 (&v)[CVK]) {
    const float* src = W + (size_t)k0 * Nsrc + n0 + 4 * lane;
#pragma unroll
    for (int i = 0; i < CVK; ++i) v[i] = __builtin_nontemporal_load((const f32x4*)(src + (size_t)i * Nsrc));
}
template <int MODE>
__device__ __forceinline__ void cvt_reg_store(bf16* WT, int row_off, int dpitch, int k0, int n0, int lane, const f32x4 (&v)[CVK]) {
#pragma unroll
    for (int j = 0; j < 4; ++j) {
        const int ng = n0 + 4 * lane + j; int dr = ng;
        if (MODE == 1) { const int i2 = ng & 255; dr = 8 * (i2 >> 2) + (i2 & 3) + ((ng >= 256) ? 4 : 0); }
        v4u* dst = (v4u*)(WT + (size_t)(row_off + dr) * dpitch + k0);
#pragma unroll
        for (int q = 0; q < CVK / 8; ++q) { v4u o; o.x = pg8::cvt_pk_bf16(v[8 * q][j], v[8 * q + 1][j]); o.y = pg8::cvt_pk_bf16(v[8 * q + 2][j], v[8 * q + 3][j]); o.z = pg8::cvt_pk_bf16(v[8 * q + 4][j], v[8 * q + 5][j]); o.w = pg8::cvt_pk_bf16(v[8 * q + 6][j], v[8 * q + 7][j]); dst[q] = o; }
    }
}
constexpr int CV_GU = (D / CVK) * 2, CV_DN = (FF / CVK) * 4, CV_NGU = (NE + 1) * CV_GU, CV_NITEM = CV_NGU + (NE + 1) * CV_DN;
__device__ __forceinline__ void cvx_load(const float* const* in, int it, int lane, f32x4 (&v)[CVK]) {
    if (it < CV_NGU) { const int e = it / CV_GU, ii = it - e * CV_GU; const float* src = (e < NE) ? in[30] + (size_t)e * D * 512 : in[32];
        cvt_reg_load(src, 512, CVK * (ii >> 1), 256 * (ii & 1), lane, v); }
    else { const int r = it - CV_NGU, e = r / CV_DN, ii = r - e * CV_DN; const float* src = (e < NE) ? in[31] + (size_t)e * FF * D : in[33];
        cvt_reg_load(src, D, CVK * (ii >> 2), 256 * (ii & 3), lane, v); }
}
__device__ __forceinline__ void cvx_store(unsigned char* ws, int it, int lane, const f32x4 (&v)[CVK]) {
    if (it < CV_NGU) { const int e = it / CV_GU, ii = it - e * CV_GU; cvt_reg_store<1>((bf16*)(ws + WS_WGU), e * 512, D, CVK * (ii >> 1), 256 * (ii & 1), lane, v); }
    else { const int r = it - CV_NGU, e = r / CV_DN, ii = r - e * CV_DN; cvt_reg_store<0>((bf16*)(ws + WS_WD), e * D, FF, CVK * (ii >> 2), 256 * (ii & 3), lane, v); }
}

#if MS >= 3
__device__ __forceinline__ float lora_val(const float* const* in, int n, int k) {
    if (n < 1024) { const int q = n >> 3, e8 = n & 7, dir = e8 >> 2, ch = q * 4 + (e8 & 3); return (k < 32) ? in[9][(size_t)(dir * 32 + k) * 512 + ch] : 0.f; }
    if (n < 2048) { const int m = n - 1024, q = m >> 3, e8 = m & 7, dir = e8 >> 2, ch = q * 4 + (e8 & 3); return (k >= 32 && k < 64) ? in[11][(size_t)(dir * 32 + (k - 32)) * 512 + ch] : 0.f; }
    if (n < 2560) { const int ch = n - 2048; return (k >= 64 && k < 160) ? in[12][(size_t)(k - 64) * 512 + ch] : 0.f; }
    { const int m = n - 2560, q = m >> 3, e8 = m & 7, dir = e8 >> 2, ch = q * 4 + (e8 & 3); return (k >= 160 && k < 176) ? in[19][(size_t)(dir * 16 + (k - 160)) * 256 + ch] : 0.f; }
}
#endif

__device__ __forceinline__ void ph_prologue(Frame& F) {
    {
        const float* c = F.in[1]; const float* cc = F.in[3]; const float* wa = F.in[4]; const float* ba = F.in[5];
        float* MOD = (float*)(F.ws + WS_MOD);
        LAS float* S = (LAS float*)F.lds; LAS float* red = (LAS float*)(F.lds + 32768);
        for (int it = blockIdx.x; it < 96; it += F.G) {
            for (int i = F.tid; i < 5120; i += NTHR) { const int r = i >> 10, k = i & 1023; const float cv = r < 4 ? c[r * 1024 + k] : cc[k]; S[i] = siluf_(cv); }
            __syncthreads();
            const int n = it * 64 + F.lane; float acc[5] = {0.f, 0.f, 0.f, 0.f, 0.f};
            for (int kk = 0; kk < 128; ++kk) { const int k = F.wave * 128 + kk; const float wv = wa[(size_t)k * 6144 + n];
#pragma unroll
                for (int r = 0; r < 5; ++r) acc[r] += S[r * 1024 + k] * wv; }
#pragma unroll
            for (int r = 0; r < 5; ++r) red[(F.wave * 5 + r) * 64 + F.lane] = acc[r];
            __syncthreads();
            if (F.wave == 0) {
#pragma unroll
                for (int r = 0; r < 5; ++r) { float s = 0.f;
#pragma unroll
                    for (int w = 0; w < 8; ++w) s += red[(w * 5 + r) * 64 + F.lane];
                    MOD[r * 6144 + n] = s + ba[n]; }
            }
            __syncthreads();
        }
    }
    {
        LAS float* scr = (LAS float*)(F.lds + F.wave * 16384);
        constexpr int I_IN = 16 * 168, I_BR = 8 * 32, I_OUT = 16 * 32, I_RT = 16 * 8, I_GU = 32 * 2, I_DN = 8 * 4;
        constexpr int T0 = I_IN, T1 = T0 + I_BR, T2 = T1 + I_BR, T3 = T2 + I_OUT, T4 = T3 + I_RT, T5 = T4 + (NE + 1) * I_GU, T6 = T5 + (NE + 1) * I_DN;
        unsigned char* ws = F.ws;
        for (int it = F.gw; it < T6; it += F.NGW) {
#if MS >= 3
            if (it < T0) { cvt_item<0>(F.in[6], IN_COLS, 168, (bf16*)(ws + WS_WIN), 0, D, scr, it, F.lane); continue; }
            if (it < T1) { cvt_item<0>(F.in[23], D, 32, (bf16*)(ws + WS_WBRRW), 0, RWW, scr, it - T0, F.lane); continue; }
            if (it < T2) { cvt_item<0>(F.in[24], D, 32, (bf16*)(ws + WS_WBRGLA), 0, RWW, scr, it - T1, F.lane); continue; }
            if (it < T3) { cvt_item<0>(F.in[25], D, 32, (bf16*)(ws + WS_WOUT), 0, D, scr, it - T2, F.lane); continue; }
#else
            if (it < T3) continue;
#endif
            if (it < T4) { cvt_item<0>(F.in[28], NE, 8, (bf16*)(ws + WS_WROUTER), 0, D, scr, it - T3, F.lane); continue; }
#if MS >= 3
            break;
#endif
            if (it < T5) { const int r = it - T4, e = r / I_GU, ii = r - e * I_GU;
                const float* src = (e < NE) ? F.in[30] + (size_t)e * D * 512 : F.in[32];
                cvt_item_reg<1>(src, 512, (bf16*)(ws + WS_WGU), e * 512, D, 32 * (ii >> 1), 256 * (ii & 1), F.lane); continue; }
            { const int r = it - T5, e = r / I_DN, ii = r - e * I_DN;
                const float* src = (e < NE) ? F.in[31] + (size_t)e * FF * D : F.in[33];
                cvt_item_reg<0>(src, D, (bf16*)(ws + WS_WD), e * D, FF, 32 * (ii >> 2), 256 * (ii & 3), F.lane); }
        }
    }
#if MS >= 3
    {
        bf16* WL = (bf16*)(F.ws + WS_WLORA);
        for (int idx = blockIdx.x * NTHR + F.tid; idx < NLORA * (KLORA / 8); idx += F.G * NTHR) {
            const int n = idx >> 5, k0 = (idx & 31) * 8; float v[8];
#pragma unroll
            for (int e = 0; e < 8; ++e) v[e] = lora_val(F.in, n, k0 + e);
            v4u o; o.x = pk2(v[0], v[1]); o.y = pk2(v[2], v[3]); o.z = pk2(v[4], v[5]); o.w = pk2(v[6], v[7]);
            *(v4u*)(WL + (size_t)n * KLORA + k0) = o;
        }
    }
#endif
}

struct EpiF32 {
    static constexpr bool PERM = false;
    float* C; int ldc;
    __device__ __forceinline__ void operator()(const f32x4 (&acc)[2][2][4][2], const pg8::Unit& u, int wr, int wc, int fr, int fq) const {
        const int row0 = u.pm * 256 + wr * 64 + fr, col0 = u.pn * 256 + wc * 32 + 4 * fq;
#pragma unroll
        for (int ai = 0; ai < 2; ++ai)
#pragma unroll
            for (int m = 0; m < 4; ++m) { float* rowp = C + (size_t)(row0 + ai * 128 + m * 16) * ldc + col0;
#pragma unroll
                for (int bj = 0; bj < 2; ++bj)
#pragma unroll
                    for (int n = 0; n < 2; ++n) *(f32x4*)(rowp + bj * 128 + n * 16) = acc[ai][bj][m][n]; }
    }
};
struct EpiSwiglu {
    static constexpr bool PERM = true;
    bf16* ACT;
    __device__ __forceinline__ void operator()(const f32x4 (&acc)[2][2][4][2], const pg8::Unit& u, int wr, int wc, int fr, int fq) const {
        const int row0 = u.pm * 256 + wr * 64 + fr, h0 = u.j * 128 + wc * 16 + 4 * fq;
#pragma unroll
        for (int ai = 0; ai < 2; ++ai)
#pragma unroll
            for (int m = 0; m < 4; ++m) { bf16* rowp = ACT + (size_t)(row0 + ai * 128 + m * 16) * FF + h0;
#pragma unroll
                for (int bj = 0; bj < 2; ++bj) { const f32x4 a = acc[ai][bj][m][0], b = acc[ai][bj][m][1];
                    v2u o; o.x = pg8::cvt_pk_bf16(siluf_(a[0]) * b[0], siluf_(a[1]) * b[1]); o.y = pg8::cvt_pk_bf16(siluf_(a[2]) * b[2], siluf_(a[3]) * b[3]);
                    *(v2u*)(rowp + bj * 64) = o; } }
    }
};
struct EpiRowsBf16 {
    static constexpr bool PERM = true;
    bf16* O; int ldc;
    __device__ __forceinline__ void operator()(const f32x4 (&acc)[2][2][4][2], const pg8::Unit& u, int wr, int wc, int fr, int fq) const {
        const int row0 = u.pm * 256 + wr * 64 + fr, col0 = u.j * 256 + wc * 32 + 8 * fq;
#pragma unroll
        for (int ai = 0; ai < 2; ++ai)
#pragma unroll
            for (int m = 0; m < 4; ++m) { bf16* rowp = O + (size_t)(row0 + ai * 128 + m * 16) * ldc + col0;
#pragma unroll
                for (int bj = 0; bj < 2; ++bj) { const f32x4 v0 = acc[ai][bj][m][0], v1 = acc[ai][bj][m][1];
                    v4u w; w.x = pg8::cvt_pk_bf16(v0[0], v0[1]); w.y = pg8::cvt_pk_bf16(v0[2], v0[3]); w.z = pg8::cvt_pk_bf16(v1[0], v1[1]); w.w = pg8::cvt_pk_bf16(v1[2], v1[3]);
                    *(v4u*)(rowp + bj * 128) = w; } }
    }
};

__device__ __forceinline__ void ph_router(Frame& F) {
    pg8::Gemm g{(const bf16*)(F.ws + WS_A3), (const bf16*)(F.ws + WS_WROUTER), NLAT, NE, D, nullptr};
    pg8::StaticOrder S; S.init(NLAT, NE, F.G, (int)blockIdx.x);
    EpiF32 E{(float*)(F.ws + WS_LOGITS), NE};
    pg8::gemm_phase<EpiF32, pg8::StaticOrder, true, true, false>(F.lds, g, S, E);
}

__device__ __forceinline__ void ph_route(Frame& F) {
    const float* LOG = (const float*)(F.ws + WS_LOGITS); const float* rb = F.in[29];
    int* EIDX = (int*)(F.ws + WS_EIDX); float* GATE = (float*)(F.ws + WS_GATE); int* DEST = (int*)(F.ws + WS_DEST);
    unsigned* CNT = F.ctl + CW_CNT;
    const f32x4 bias = *(const f32x4*)(rb + 4 * F.lane);
    const float NEG = -3.0e38f;
    f32x4 lgn = *(const f32x4*)(LOG + (size_t)(F.gw < NLAT ? F.gw : 0) * NE + 4 * F.lane);
    for (int m = F.gw; m < NLAT; m += F.NGW) {
        const f32x4 lg = lgn;
        { const int mn = (m + F.NGW < NLAT) ? m + F.NGW : m; lgn = *(const f32x4*)(LOG + (size_t)mn * NE + 4 * F.lane); }
        float sc[4], sel[4];
#pragma unroll
        for (int i = 0; i < 4; ++i) { sc[i] = sigmoidf_(lg[i]); sel[i] = sc[i] + bias[i]; }
        float m1 = fmaxf(sel[0], sel[1]), m2 = fminf(sel[0], sel[1]);
        { const float a = sel[2]; const float n1 = fmaxf(m1, a); m2 = fmaxf(m2, fminf(m1, a)); m1 = n1; }
        { const float a = sel[3]; const float n1 = fmaxf(m1, a); m2 = fmaxf(m2, fminf(m1, a)); m1 = n1; }
#pragma unroll
        for (int o = 1; o < 8; o <<= 1) { const float b1 = __shfl_xor(m1, o), b2 = __shfl_xor(m2, o); const float n1 = fmaxf(m1, b1); m2 = fmaxf(fminf(m1, b1), fmaxf(m2, b2)); m1 = n1; }
        const float gs = m1 + m2; const int g = F.lane >> 3;
        int rank = 0;
#pragma unroll
        for (int gg = 0; gg < 8; ++gg) { const float og = __shfl(gs, gg * 8); rank += (og > gs || (og == gs && gg < g)) ? 1 : 0; }
        const bool keep = rank < 4;
#pragma unroll
        for (int i = 0; i < 4; ++i) sel[i] = keep ? sel[i] : NEG;
        int my_e = 0; float my_s = 0.f; float ssum = 0.f;
        for (int k = 0; k < TOPK; ++k) {
            float bv = sel[0]; int bi = 0;
#pragma unroll
            for (int i = 1; i < 4; ++i) if (sel[i] > bv) { bv = sel[i]; bi = i; }
            int be = 4 * F.lane + bi; float v = bv; int e = be;
#pragma unroll
            for (int o = 1; o < 64; o <<= 1) { const float ov = __shfl_xor(v, o); const int oe = __shfl_xor(e, o); if (ov > v || (ov == v && oe < e)) { v = ov; e = oe; } }
            const int owner = e >> 2, oi = e & 3;
            float s_own = 0.f;
            if (F.lane == owner) {
#pragma unroll
                for (int i = 0; i < 4; ++i) if (i == oi) { s_own = sc[i]; sel[i] = NEG; }
            }
            const float s = __shfl(s_own, owner);
            ssum += s;
            if (F.lane == k) { my_e = e; my_s = s; }
        }
        if (F.lane < TOPK) {
            const unsigned pos = __hip_atomic_fetch_add(CNT + my_e, 1u, __ATOMIC_RELAXED, __HIP_MEMORY_SCOPE_AGENT);
            EIDX[m * 8 + F.lane] = my_e; GATE[m * 8 + F.lane] = my_s / ssum * 2.5f; DEST[m * 8 + F.lane] = (int)pos;
        }
    }
}

__device__ __forceinline__ void ph_scatter(Frame& F) {
    LAS int* tstart = (LAS int*)F.lds;
    LAS int* scan = (LAS int*)(F.lds + 2048);
    LAS int* cnts = (LAS int*)(F.lds + 4096);
    int* EIDX = (int*)(F.ws + WS_EIDX); int* DEST = (int*)(F.ws + WS_DEST); int* ROWTOK = (int*)(F.ws + WS_ROWTOK); int* TILE_E = (int*)(F.ws + WS_TILE_E);
    unsigned* CNT = F.ctl + CW_CNT;
    int tiles = 0, cnt = 0;
    if (F.tid < NE) { cnt = (int)__hip_atomic_load(CNT + F.tid, __ATOMIC_RELAXED, __HIP_MEMORY_SCOPE_AGENT); tiles = (cnt + 255) >> 8; scan[F.tid] = tiles; cnts[F.tid] = cnt; }
    __syncthreads();
    for (int o = 1; o < NE; o <<= 1) { int v = 0; if (F.tid < NE && F.tid >= o) v = scan[F.tid - o]; __syncthreads(); if (F.tid < NE) scan[F.tid] += v; __syncthreads(); }
    if (F.tid < NE) { tstart[F.tid + 1] = scan[F.tid]; if (F.tid == 0) tstart[0] = 0; }
    __syncthreads();
    const int NT = tstart[NE];
    if (blockIdx.x == 0) {
        if (F.tid == 0) F.ctl[CW_NT] = (unsigned)NT;
        if (F.tid < NE) for (int t = tstart[F.tid]; t < tstart[F.tid + 1]; ++t) TILE_E[t] = F.tid;
    }
    for (int e = blockIdx.x; e < NE; e += F.G) { const int c0 = cnts[e], c1 = (tstart[e + 1] - tstart[e]) * 256, base = tstart[e] * 256;
        for (int p = c0 + F.tid; p < c1; p += NTHR) ROWTOK[base + p] = 0; }
    for (int i = blockIdx.x * NTHR + F.tid; i < NLAT; i += F.G * NTHR) ROWTOK[SH_ROW0 + i] = i;
    for (int i = blockIdx.x * NTHR + F.tid; i < NLAT * TOPK; i += F.G * NTHR) {
        const int e = EIDX[i], pos = DEST[i]; const int dr = tstart[e] * 256 + pos;
        DEST[i] = dr; ROWTOK[dr] = i >> 3;
    }
}

__device__ __forceinline__ void ph_exp1(Frame& F) {
    const int NT = (int)__hip_atomic_load(F.ctl + CW_NT, __ATOMIC_RELAXED, __HIP_MEMORY_SCOPE_AGENT);
    pg8::Gemm g{(const bf16*)(F.ws + WS_A3), (const bf16*)(F.ws + WS_WGU), 0, 0, D, (const int*)(F.ws + WS_ROWTOK)};
    pg8::MoeOrder S{2, F.G, (int)blockIdx.x, NT, (const int*)(F.ws + WS_TILE_E)};
    EpiSwiglu E{(bf16*)(F.ws + WS_ACT)};
    pg8::gemm_phase<EpiSwiglu, pg8::MoeOrder, true, true, true>(F.lds, g, S, E);
}
__device__ __forceinline__ void ph_exp2(Frame& F) {
    const int NT = (int)__hip_atomic_load(F.ctl + CW_NT, __ATOMIC_RELAXED, __HIP_MEMORY_SCOPE_AGENT);
    pg8::Gemm g{(const bf16*)(F.ws + WS_ACT), (const bf16*)(F.ws + WS_WD), 0, 0, FF, nullptr};
    pg8::MoeOrder S{4, F.G, (int)blockIdx.x, NT, (const int*)(F.ws + WS_TILE_E)};
    EpiRowsBf16 E{(bf16*)(F.ws + WS_Y), D};
    pg8::gemm_phase<EpiRowsBf16, pg8::MoeOrder, true, true, false>(F.lds, g, S, E);
}
#endif

#if MS >= 3
__device__ __forceinline__ void unp8(const v4u w, float (&f)[8]) { f[0] = bflo(w.x); f[1] = bfhi(w.x); f[2] = bflo(w.y); f[3] = bfhi(w.y); f[4] = bflo(w.z); f[5] = bfhi(w.z); f[6] = bflo(w.w); f[7] = bfhi(w.w); }
__device__ __forceinline__ v4u pk8(const float (&f)[8]) { v4u o; o.x = pk2(f[0], f[1]); o.y = pk2(f[2], f[3]); o.z = pk2(f[4], f[5]); o.w = pk2(f[6], f[7]); return o; }
__device__ __forceinline__ void st8(float* p, const float (&f)[8]) { *(f32x4*)p = (f32x4){f[0], f[1], f[2], f[3]}; *(f32x4*)(p + 4) = (f32x4){f[4], f[5], f[6], f[7]}; }
__device__ __forceinline__ void ld8(const float* p, float (&f)[8]) { const f32x4 a = *(const f32x4*)p, b = *(const f32x4*)(p + 4); f[0] = a.x; f[1] = a.y; f[2] = a.z; f[3] = a.w; f[4] = b.x; f[5] = b.y; f[6] = b.z; f[7] = b.w; }

__device__ __forceinline__ void ph_a1(Frame& F) {
    const float* mod = (const float*)(F.ws + WS_MOD); bf16* A1 = (bf16*)(F.ws + WS_A1);
    constexpr int NR = 4;
    for (int m0 = F.gw; m0 < MR; m0 += NR * F.NGW) {
        f32x4 xv[NR][4];
#pragma unroll
        for (int r = 0; r < NR; ++r) { const int mm = m0 + r * F.NGW; const int m = mm < MR ? mm : m0;
            const float* src = (m < NLAT) ? F.in[0] + (size_t)m * D : F.in[2] + (size_t)(m - NLAT) * D;
            const f32x4* xr = (const f32x4*)src + F.lane;
#pragma unroll
            for (int j = 0; j < 4; ++j) xv[r][j] = __builtin_nontemporal_load(xr + 64 * j); }
        __builtin_amdgcn_sched_barrier(0);
#pragma unroll
        for (int r = 0; r < NR; ++r) { const int mm = m0 + r * F.NGW; const int m = mm < MR ? mm : m0; const int mr = (m < NLAT) ? (m / SEQ) : 4;
            v2u* ao = (v2u*)(A1 + (size_t)m * D) + F.lane;
#pragma unroll
            for (int j = 0; j < 4; ++j) { const int c = 4 * F.lane + 256 * j;
                const f32x4 sh = *(const f32x4*)(mod + mr * 6144 + c), sc = *(const f32x4*)(mod + mr * 6144 + 1024 + c);
                const f32x4 h = xv[r][j] * (sc + 1.0f) + sh; v2u o; o.x = pk2(h.x, h.y); o.y = pk2(h.z, h.w); ao[64 * j] = o; } }
    }
}

__device__ __forceinline__ void ph_inproj(Frame& F) {
    pg8::Gemm g{(const bf16*)(F.ws + WS_A1), (const bf16*)(F.ws + WS_WIN), MR, NP, D, nullptr};
    pg8::StaticOrder S; S.init(MR, NP, F.G, (int)blockIdx.x);
    EpiRowsBf16 E{(bf16*)(F.ws + WS_P), NP};
    pg8::gemm_phase<EpiRowsBf16, pg8::StaticOrder, true, true, false>(F.lds, g, S, E);
}

__device__ __forceinline__ void ph_feat(Frame& F) {
    const bf16* P = (const bf16*)(F.ws + WS_P);
    const float* mu = F.in[7]; const float* kkw = F.in[13]; const float* cw = F.in[18];
    bf16* R = (bf16*)(F.ws + WS_RB); bf16* V = (bf16*)(F.ws + WS_VB); bf16* KK = (bf16*)(F.ws + WS_KKB); bf16* KP = (bf16*)(F.ws + WS_KMF);
    bf16* QG = (bf16*)(F.ws + WS_QGB); bf16* KGB = (bf16*)(F.ws + WS_KGB); bf16* VGB = (bf16*)(F.ws + WS_VGB);
    bf16* A2 = (bf16*)(F.ws + WS_A2);
    const int lane = F.lane;
    for (int m0 = F.gw; m0 < MR; m0 += 2 * F.NGW) {
        int mm[2]; mm[0] = m0; mm[1] = (m0 + F.NGW < MR) ? m0 + F.NGW : m0;
        int nb[2][4], gr[2], gc[2], tc[2]; bool lat[2];
#pragma unroll
        for (int r = 0; r < 2; ++r) { const int m = mm[r]; lat[r] = m < NLAT; gr[r] = 0; gc[r] = 0; tc[r] = 0;
            if (lat[r]) { const int t = m & (SEQ - 1); gr[r] = t >> 6; gc[r] = t & 63;
                nb[r][0] = gc[r] > 0 ? m - 1 : -1; nb[r][1] = gc[r] < 63 ? m + 1 : -1; nb[r][2] = gr[r] > 0 ? m - 64 : -1; nb[r][3] = gr[r] < 127 ? m + 64 : -1;
            } else { const int t = (m - NLAT) & (CTXL - 1); tc[r] = t; nb[r][0] = t > 0 ? m - 1 : -1; nb[r][1] = t < CTXL - 1 ? m + 1 : -1; nb[r][2] = nb[r][0]; nb[r][3] = nb[r][1]; } }
#pragma unroll
        for (int p = 0; p < 4; ++p) {
            const int cb = p * 512 + 8 * lane;
            const bool act = (p < 3) || lane < 20;
            v4u wo[2], wn[2][4];
#pragma unroll
            for (int r = 0; r < 2; ++r) { wo[r] = (v4u){0u, 0u, 0u, 0u};
#pragma unroll
                for (int q = 0; q < 4; ++q) wn[r][q] = (v4u){0u, 0u, 0u, 0u};
                if (act) { wo[r] = *(const v4u*)(P + (size_t)mm[r] * NP + cb);
#pragma unroll
                    for (int q = 0; q < 4; ++q) if (nb[r][q] >= 0) wn[r][q] = *(const v4u*)(P + (size_t)nb[r][q] * NP + cb); }
                else if (p == 3 && lane >= 20 && lane < 22) wo[r] = *(const v4u*)(P + (size_t)mm[r] * NP + C_PGL + 8 * (lane - 20)); }
            float muv[8] = {0.f, 0.f, 0.f, 0.f, 0.f, 0.f, 0.f, 0.f}; if (act) ld8(mu + cb, muv);
            __builtin_amdgcn_sched_barrier(0);
#pragma unroll
            for (int r = 0; r < 2; ++r) { const size_t m = (size_t)mm[r];
                if (act) {
                    float own[8], sh[4][8], val[8];
                    unp8(wo[r], own);
#pragma unroll
                    for (int q = 0; q < 4; ++q) unp8(wn[r][q], sh[q]);
#pragma unroll
                    for (int e = 0; e < 8; ++e) val[e] = own[e] + muv[e] * (sh[e & 3][e] - own[e]);
                    if (p == 0) *(v4u*)(R + m * RWW + 8 * lane) = pk8(val);
                    else if (p == 2) *(v4u*)(V + m * RWW + 8 * lane) = pk8(val);
                    else if (p == 1) {
                        *(v4u*)(KP + m * RWW + 8 * lane) = pk8(val);
                        float kw[8]; ld8(kkw + 8 * lane, kw); float kkv[8]; float ss = 0.f;
#pragma unroll
                        for (int e = 0; e < 8; ++e) { kkv[e] = val[e] * kw[e]; ss += kkv[e] * kkv[e]; }
                        ss += __shfl_xor(ss, 1); ss += __shfl_xor(ss, 2); ss += __shfl_xor(ss, 4);
                        const float inv = 1.0f / fmaxf(sqrtf(ss), 1e-12f);
#pragma unroll
                        for (int e = 0; e < 8; ++e) kkv[e] *= inv;
                        *(v4u*)(KK + m * RWW + 8 * lane) = pk8(kkv);
                    } else {
                        float o[8];
#pragma unroll
                        for (int e = 0; e < 8; ++e) o[e] = (lane < 4) ? tanhf(val[e]) : ((lane < 8) ? val[e] : sigmoidf_(val[e]));
                        *(v4u*)(A2 + m * KLORA + 8 * lane) = pk8(o);
                    }
                } else if (p == 3 && lane < 32) *(v4u*)(A2 + m * KLORA + 8 * lane) = wo[r];
            }
        }
#pragma unroll
        for (int p = 0; p < 2; ++p) {
            const int cq = p * 512 + 8 * lane; const int cb = C_Q + cq;
            v4u wp[2][9];
#pragma unroll
            for (int r = 0; r < 2; ++r)
#pragma unroll
                for (int dy = -1; dy <= 1; ++dy)
#pragma unroll
                    for (int dx = -1; dx <= 1; ++dx) { const int tp = (dy + 1) * 3 + dx + 1; bool ok; int nr;
                        if (lat[r]) { ok = (gr[r] + dy >= 0) && (gr[r] + dy < GRIDH) && (gc[r] + dx >= 0) && (gc[r] + dx < GRIDW); nr = mm[r] + dy * 64 + dx; }
                        else { ok = (dy == 0) && (tc[r] + dx >= 0) && (tc[r] + dx < CTXL); nr = mm[r] + dx; }
                        wp[r][tp] = (v4u){0u, 0u, 0u, 0u}; if (ok) wp[r][tp] = *(const v4u*)(P + (size_t)nr * NP + cb); }
            __builtin_amdgcn_sched_barrier(0);
            float acc[2][8];
#pragma unroll
            for (int r = 0; r < 2; ++r)
#pragma unroll
                for (int e = 0; e < 8; ++e) acc[r][e] = 0.f;
#pragma unroll
            for (int tp = 0; tp < 9; ++tp) { float wv[8]; ld8(cw + tp * 1024 + cq, wv);
#pragma unroll
                for (int r = 0; r < 2; ++r) { float pv[8]; unp8(wp[r][tp], pv);
#pragma unroll
                    for (int e = 0; e < 8; ++e) acc[r][e] += pv[e] * wv[e]; } }
#pragma unroll
            for (int r = 0; r < 2; ++r) { const size_t m = (size_t)mm[r]; float o[8];
#pragma unroll
                for (int e = 0; e < 8; ++e) o[e] = siluf_(acc[r][e]);
                if (p == 0) {
                    if (lane < 32) {
#pragma unroll
                        for (int e = 0; e < 8; ++e) o[e] *= 0.125f;
                        *(v4u*)(QG + m * 256 + cq) = pk8(o);
                    } else *(v4u*)(KGB + m * 256 + (cq - 256)) = pk8(o);
                } else *(v4u*)(VGB + m * RWW + (cq - 512)) = pk8(o); }
        }
    }
}

struct EpiLora {
    static constexpr bool PERM = true;
    unsigned char* ws; const float* const* in;
    __device__ __forceinline__ void grp_w(const f32x4 (&acc)[2][2][4][2], int row0, int c0) const {
        bf16* Wf = (bf16*)(ws + WS_LWF); bf16* Wb = (bf16*)(ws + WS_LWB);
#pragma unroll
        for (int bj = 0; bj < 2; ++bj) { const int ch = (c0 + bj * 128) >> 1; const f32x4 w0f = *(const f32x4*)(in[8] + ch), w0b = *(const f32x4*)(in[8] + 512 + ch);
#pragma unroll
            for (int ai = 0; ai < 2; ++ai)
#pragma unroll
                for (int m = 0; m < 4; ++m) { const size_t row = (size_t)(row0 + ai * 128 + m * 16);
                    const f32x4 xf = acc[ai][bj][m][0] + w0f, xb = acc[ai][bj][m][1] + w0b; f32x4 df, db;
#pragma unroll
                    for (int e = 0; e < 4; ++e) { df[e] = -0.60653066f * sigmoidf_(xf[e]); db[e] = -0.60653066f * sigmoidf_(xb[e]); }
                    { v2u o; o.x = pk2(df[0], df[1]); o.y = pk2(df[2], df[3]); *(v2u*)(Wf + row * RWW + ch) = o; o.x = pk2(db[0], db[1]); o.y = pk2(db[2], db[3]); *(v2u*)(Wb + row * RWW + ch) = o; } } }
    }
    __device__ __forceinline__ void grp_a(const f32x4 (&acc)[2][2][4][2], int row0, int c0) const {
        bf16* KMf = (bf16*)(ws + WS_KMF); bf16* KMb = (bf16*)(ws + WS_KMB); bf16* BVf = (bf16*)(ws + WS_BVF); bf16* BVb = (bf16*)(ws + WS_BVB);
        const bf16* KK = (const bf16*)(ws + WS_KKB); bf16* KSUM = (bf16*)(ws + WS_KSUM);
#pragma unroll
        for (int bj = 0; bj < 2; ++bj) { const int ch = (c0 + bj * 128 - 1024) >> 1; const f32x4 a0f = *(const f32x4*)(in[10] + ch), a0b = *(const f32x4*)(in[10] + 512 + ch), ka = *(const f32x4*)(in[14] + ch);
#pragma unroll
            for (int ai = 0; ai < 2; ++ai) {
            v2u kpw[2][4], kkw[2][4];
#pragma unroll
                for (int m = 0; m < 4; ++m) { const size_t row = (size_t)(row0 + ai * 128 + m * 16); kpw[ai][m] = *(const v2u*)(KMf + row * RWW + ch); kkw[ai][m] = *(const v2u*)(KK + row * RWW + ch); }
            __builtin_amdgcn_sched_barrier(0);
#pragma unroll
                for (int m = 0; m < 4; ++m) { const size_t row = (size_t)(row0 + ai * 128 + m * 16);
                    const f32x4 xf = acc[ai][bj][m][0] + a0f, xb = acc[ai][bj][m][1] + a0b;
                    const f32x4 kp = (f32x4){bflo(kpw[ai][m].x), bfhi(kpw[ai][m].x), bflo(kpw[ai][m].y), bfhi(kpw[ai][m].y)}, kk = (f32x4){bflo(kkw[ai][m].x), bfhi(kkw[ai][m].x), bflo(kkw[ai][m].y), bfhi(kkw[ai][m].y)};
                    f32x4 kmf, kmb, bvf, bvb;
#pragma unroll
                    for (int e = 0; e < 4; ++e) { const float af = sigmoidf_(xf[e]), ab = sigmoidf_(xb[e]);
                        kmf[e] = kp[e] * (1.0f + (af - 1.0f) * ka[e]); kmb[e] = kp[e] * (1.0f + (ab - 1.0f) * ka[e]); bvf[e] = kk[e] * af; bvb[e] = kk[e] * ab; }
                    { v2u o; o.x = pk2(kmf[0], kmf[1]); o.y = pk2(kmf[2], kmf[3]); *(v2u*)(KMf + row * RWW + ch) = o; o.x = pk2(kmb[0], kmb[1]); o.y = pk2(kmb[2], kmb[3]); *(v2u*)(KMb + row * RWW + ch) = o;
                      o.x = pk2(bvf[0], bvf[1]); o.y = pk2(bvf[2], bvf[3]); *(v2u*)(BVf + row * RWW + ch) = o; o.x = pk2(bvb[0], bvb[1]); o.y = pk2(bvb[2], bvb[3]); *(v2u*)(BVb + row * RWW + ch) = o; }
                    v2u ks; ks.x = pk2(kmf[0] + kmb[0], kmf[1] + kmb[1]); ks.y = pk2(kmf[2] + kmb[2], kmf[3] + kmb[3]); *(v2u*)(KSUM + row * RWW + ch) = ks; } } }
    }
    __device__ __forceinline__ void grp_g(const f32x4 (&acc)[2][2][4][2], int row0, int c0) const {
        bf16* RWG = (bf16*)(ws + WS_RWG);
#pragma unroll
        for (int bj = 0; bj < 2; ++bj) { const int ch = c0 + bj * 128 - 2048;
#pragma unroll
            for (int ai = 0; ai < 2; ++ai)
#pragma unroll
                for (int m = 0; m < 4; ++m) { const size_t row = (size_t)(row0 + ai * 128 + m * 16); const f32x4 v0 = acc[ai][bj][m][0], v1 = acc[ai][bj][m][1];
                    v4u w; w.x = pk2(v0[0], v0[1]); w.y = pk2(v0[2], v0[3]); w.z = pk2(v1[0], v1[1]); w.w = pk2(v1[2], v1[3]); *(v4u*)(RWG + row * RWW + ch) = w; } }
    }
    __device__ __forceinline__ void grp_l(const f32x4 (&acc)[2][2][4][2], int row0, int c0) const {
        bf16* GAf = (bf16*)(ws + WS_LAF); bf16* GAb = (bf16*)(ws + WS_LAB);
#pragma unroll
        for (int bj = 0; bj < 2; ++bj) { const int ch = (c0 + bj * 128 - 2560) >> 1; const f32x4 gbf = *(const f32x4*)(in[20] + ch), gbb = *(const f32x4*)(in[20] + 256 + ch);
#pragma unroll
            for (int ai = 0; ai < 2; ++ai)
#pragma unroll
                for (int m = 0; m < 4; ++m) { const size_t row = (size_t)(row0 + ai * 128 + m * 16);
                    const f32x4 xf = acc[ai][bj][m][0] + gbf, xb = acc[ai][bj][m][1] + gbb; f32x4 af, ab;
#pragma unroll
                    for (int e = 0; e < 4; ++e) { const float lf = fminf(xf[e], 0.f) - log1pf(__expf(-fabsf(xf[e]))), lb = fminf(xb[e], 0.f) - log1pf(__expf(-fabsf(xb[e])));
                        af[e] = lf * 0.0625f; ab[e] = lb * 0.0625f; }
                    { v2u o; o.x = pk2(af[0], af[1]); o.y = pk2(af[2], af[3]); *(v2u*)(GAf + row * 256 + ch) = o; o.x = pk2(ab[0], ab[1]); o.y = pk2(ab[2], ab[3]); *(v2u*)(GAb + row * 256 + ch) = o; } } }
    }
    __device__ __forceinline__ void operator()(const f32x4 (&acc)[2][2][4][2], const pg8::Unit& u, int wr, int wc, int fr, int fq) const {
        const int row0 = u.pm * 256 + wr * 64 + fr, c0 = u.pn * 256 + wc * 32 + 8 * fq;
        if (u.pn < 4) grp_w(acc, row0, c0); else if (u.pn < 8) grp_a(acc, row0, c0); else if (u.pn < 10) grp_g(acc, row0, c0); else grp_l(acc, row0, c0);
    }
};
__device__ __forceinline__ void ph_lora(Frame& F) {
    pg8::Gemm g{(const bf16*)(F.ws + WS_A2), (const bf16*)(F.ws + WS_WLORA), MR, NLORA, KLORA, nullptr};
    pg8::StaticOrder S; S.init(MR, NLORA, F.G, (int)blockIdx.x);
    EpiLora E{F.ws, F.in};
    pg8::gemm_phase<EpiLora, pg8::StaticOrder, true, true, false>(F.lds, g, S, E);
}

__device__ __forceinline__ void ph_merge(Frame& F) {
    unsigned char* ws = F.ws; const int lane = F.lane;
    const bf16* ORf = (const bf16*)(ws + WS_ORWF); const bf16* ORb = (const bf16*)(ws + WS_ORWB); const bf16* OGf = (const bf16*)(ws + WS_OGLF); const bf16* OGb = (const bf16*)(ws + WS_OGLB);
    const bf16* R = (const bf16*)(ws + WS_RB); const bf16* V = (const bf16*)(ws + WS_VB); const bf16* KSUM = (const bf16*)(ws + WS_KSUM); const bf16* RWG = (const bf16*)(ws + WS_RWG);
    const bf16* P = (const bf16*)(ws + WS_P);
    bf16* YRW = (bf16*)(ws + WS_YRW); bf16* YGLA = (bf16*)(ws + WS_YGLA);
    float rk[8], gw[8], gbv[8], ggw[8], ggb[8];
    ld8(F.in[15] + 8 * lane, rk); ld8(F.in[16] + 8 * lane, gw); ld8(F.in[17] + 8 * lane, gbv); ld8(F.in[21] + 8 * lane, ggw); ld8(F.in[22] + 8 * lane, ggb);
    for (int m0 = F.gw; m0 < NLAT; m0 += 2 * F.NGW) {
        const int m1 = (m0 + F.NGW < NLAT) ? m0 + F.NGW : m0;
        v4u wa[2], wb[2], wc[2], wd[2], wr[2], wv[2], wk[2], wg[2], wo[2];
#pragma unroll
        for (int r2 = 0; r2 < 2; ++r2) { const int m = r2 ? m1 : m0; const size_t ro = (size_t)m * RWW + 8 * lane;
            wa[r2] = *(const v4u*)(ORf + ro); wb[r2] = *(const v4u*)(ORb + ro); wc[r2] = *(const v4u*)(OGf + ro); wd[r2] = *(const v4u*)(OGb + ro);
            wr[r2] = *(const v4u*)(R + ro); wv[r2] = *(const v4u*)(V + ro); wk[r2] = *(const v4u*)(KSUM + ro); wg[r2] = *(const v4u*)(RWG + ro);
            wo[r2] = *(const v4u*)(P + (size_t)m * NP + C_OG + 8 * lane); }
#pragma unroll
        for (int r2 = 0; r2 < 2; ++r2) { const int m = r2 ? m1 : m0; const size_t ro = (size_t)m * RWW + 8 * lane;
        {
            float a[8], b[8], o[8]; unp8(wa[r2], a); unp8(wb[r2], b);
            float s = 0.f;
#pragma unroll
            for (int e = 0; e < 8; ++e) { o[e] = a[e] + b[e]; s += o[e]; }
            s += __shfl_xor(s, 1); s += __shfl_xor(s, 2); s += __shfl_xor(s, 4);
            const float mean = s * (1.f / 64.f); float q = 0.f;
#pragma unroll
            for (int e = 0; e < 8; ++e) { o[e] -= mean; q += o[e] * o[e]; }
            q += __shfl_xor(q, 1); q += __shfl_xor(q, 2); q += __shfl_xor(q, 4);
            const float rstd = 1.f / sqrtf(q * (1.f / 64.f) + RW_GN_EPS);
            float r[8], v[8], ksm[8], g[8]; unp8(wr[r2], r); unp8(wv[r2], v); unp8(wk[r2], ksm); unp8(wg[r2], g);
            float bs = 0.f;
#pragma unroll
            for (int e = 0; e < 8; ++e) bs += r[e] * ksm[e] * rk[e];
            bs += __shfl_xor(bs, 1); bs += __shfl_xor(bs, 2); bs += __shfl_xor(bs, 4);
            float y[8];
#pragma unroll
            for (int e = 0; e < 8; ++e) y[e] = (o[e] * rstd * gw[e] + gbv[e] + bs * v[e]) * g[e];
            *(v4u*)(YRW + ro) = pk8(y);
        }
        {
            float a[8], b[8], o[8]; unp8(wc[r2], a); unp8(wd[r2], b);
            float s = 0.f;
#pragma unroll
            for (int e = 0; e < 8; ++e) { o[e] = a[e] + b[e]; s += o[e]; }
            s += __shfl_xor(s, 1); s += __shfl_xor(s, 2); s += __shfl_xor(s, 4); s += __shfl_xor(s, 8);
            const float mean = s * (1.f / 128.f); float q = 0.f;
#pragma unroll
            for (int e = 0; e < 8; ++e) { o[e] -= mean; q += o[e] * o[e]; }
            q += __shfl_xor(q, 1); q += __shfl_xor(q, 2); q += __shfl_xor(q, 4); q += __shfl_xor(q, 8);
            const float rstd = 1.f / sqrtf(q * (1.f / 128.f) + LN_EPS);
            float og[8]; unp8(wo[r2], og);
            float y[8];
#pragma unroll
            for (int e = 0; e < 8; ++e) y[e] = (o[e] * rstd * ggw[e] + ggb[e]) * siluf_(og[e]);
            *(v4u*)(YGLA + ro) = pk8(y);
        }
        }
    }
}

template <int WHICH> struct EpiBranch {
    static constexpr bool PERM = true;
    bf16* Z; const bf16* P;
    __device__ __forceinline__ void operator()(const f32x4 (&acc)[2][2][4][2], const pg8::Unit& u, int wr, int wc, int fr, int fq) const {
        const int row0 = u.pm * 256 + wr * 64 + fr, col0 = u.pn * 256 + wc * 32 + 8 * fq;
#pragma unroll
        for (int ah = 0; ah < 4; ++ah) { const int ai = ah >> 1, mb = 2 * (ah & 1);
            v4u gw[2][2], zw[2][2];
#pragma unroll
            for (int m = 0; m < 2; ++m) { const size_t row = (size_t)(row0 + ai * 128 + (mb + m) * 16);
#pragma unroll
                for (int bj = 0; bj < 2; ++bj) { const int c = col0 + bj * 128;
                    gw[m][bj] = *(const v4u*)(P + row * NP + (WHICH ? C_GGLA : C_GRW) + c);
                    if (WHICH) zw[m][bj] = *(const v4u*)(Z + row * D + c); } }
            __builtin_amdgcn_sched_barrier(0);
#pragma unroll
            for (int m = 0; m < 2; ++m) { const size_t row = (size_t)(row0 + ai * 128 + (mb + m) * 16);
#pragma unroll
                for (int bj = 0; bj < 2; ++bj) { const int c = col0 + bj * 128;
                    float g[8]; unp8(gw[m][bj], g);
                    const f32x4 v0 = acc[ai][bj][mb + m][0], v1 = acc[ai][bj][mb + m][1];
                    float z[8];
#pragma unroll
                    for (int e = 0; e < 4; ++e) { z[e] = sigmoidf_(g[e]) * v0[e]; z[4 + e] = sigmoidf_(g[4 + e]) * v1[e]; }
                    if (WHICH) { float zo[8]; unp8(zw[m][bj], zo);
#pragma unroll
                        for (int e = 0; e < 8; ++e) z[e] += zo[e]; }
                    *(v4u*)(Z + row * D + c) = pk8(z); } }
        }
    }
};
__device__ __forceinline__ void ph_branch(Frame& F) {
    pg8::StaticOrder S; S.init(NLAT, D, F.G, (int)blockIdx.x);
    { pg8::Gemm g{(const bf16*)(F.ws + WS_YRW), (const bf16*)(F.ws + WS_WBRRW), NLAT, D, RWW, nullptr};
      EpiBranch<0> E{(bf16*)(F.ws + WS_Z), (const bf16*)(F.ws + WS_P)};
      pg8::gemm_phase<EpiBranch<0>, pg8::StaticOrder, true, true, false>(F.lds, g, S, E); }
    { pg8::Gemm g{(const bf16*)(F.ws + WS_YGLA), (const bf16*)(F.ws + WS_WBRGLA), NLAT, D, RWW, nullptr};
      EpiBranch<1> E{(bf16*)(F.ws + WS_Z), (const bf16*)(F.ws + WS_P)};
      pg8::gemm_phase<EpiBranch<1>, pg8::StaticOrder, true, true, false>(F.lds, g, S, E); }
}
struct EpiOut {
    static constexpr bool PERM = true;
    bf16* X1P; const float* x; const float* mod;
    __device__ __forceinline__ void operator()(const f32x4 (&acc)[2][2][4][2], const pg8::Unit& u, int wr, int wc, int fr, int fq) const {
        const int row0 = u.pm * 256 + wr * 64 + fr, col0 = u.pn * 256 + wc * 32 + 8 * fq; const float* g1 = mod + (u.pm / (SEQ / 256)) * 6144 + 2048;
        f32x4 gv[2][2];
#pragma unroll
        for (int bj = 0; bj < 2; ++bj)
#pragma unroll
            for (int n = 0; n < 2; ++n) gv[bj][n] = *(const f32x4*)(g1 + col0 + bj * 128 + 4 * n);
#pragma unroll
        for (int ah = 0; ah < 4; ++ah) { const int ai = ah >> 1, mb = 2 * (ah & 1);
            f32x4 xv[2][2][2];
#pragma unroll
            for (int m = 0; m < 2; ++m) { const size_t ro = (size_t)(row0 + ai * 128 + (mb + m) * 16) * D;
#pragma unroll
                for (int bj = 0; bj < 2; ++bj)
#pragma unroll
                    for (int n = 0; n < 2; ++n) xv[m][bj][n] = *(const f32x4*)(x + ro + col0 + bj * 128 + 4 * n); }
            __builtin_amdgcn_sched_barrier(0);
#pragma unroll
            for (int m = 0; m < 2; ++m) { const size_t ro = (size_t)(row0 + ai * 128 + (mb + m) * 16) * D;
#pragma unroll
                for (int bj = 0; bj < 2; ++bj) { const f32x4 a = xv[m][bj][0] * ALPHA + gv[bj][0] * acc[ai][bj][mb + m][0], b = xv[m][bj][1] * ALPHA + gv[bj][1] * acc[ai][bj][mb + m][1];
                    v4u w; w.x = pk2(a.x, a.y); w.y = pk2(a.z, a.w); w.z = pk2(b.x, b.y); w.w = pk2(b.z, b.w); *(v4u*)(X1P + ro + col0 + bj * 128) = w; } }
        }
    }
};
__device__ __forceinline__ void ph_outproj(Frame& F) {
    pg8::Gemm g{(const bf16*)(F.ws + WS_Z), (const bf16*)(F.ws + WS_WOUT), NLAT, D, D, nullptr};
    pg8::StaticOrder S; S.init(NLAT, D, F.G, (int)blockIdx.x);
    EpiOut E{(bf16*)(F.ws + WS_X1), F.in[0], (const float*)(F.ws + WS_MOD)};
    pg8::gemm_phase<EpiOut, pg8::StaticOrder, true, true, false>(F.lds, g, S, E);
}
#endif

#if MS >= 3
constexpr int LP = 72, SLOTB = 64 * LP * 2, LPF = 68, AUX_OFF = 13 * SLOTB;
static_assert(AUX_OFF + 4096 <= MISC_OFF, "scan LDS map");
#define SLOT(n) ((LAS bf16*)(lds + (n) * SLOTB))
__device__ __forceinline__ int scan_row(int s, int b, int dir) {
    if (s < CTXL) return NLAT + b * CTXL + (dir ? (CTXL - 1 - s) : s);
    const int lt = s - CTXL; return b * SEQ + (dir ? (SEQ - 1 - lt) : lt);
}
__device__ __forceinline__ unsigned pk2z(float x) { return pk2(x, 0.f); }
__device__ __forceinline__ float bf2f(bf16 h) { return __builtin_bit_cast(float, (unsigned)h << 16); }
__device__ __forceinline__ v2u pack4(const f32x4 v) { v2u o; o.x = pk2(v[0], v[1]); o.y = pk2(v[2], v[3]); return o; }
__device__ __forceinline__ f32x4 unpack4(const v2u w) { return (f32x4){bflo(w.x), bfhi(w.x), bflo(w.y), bfhi(w.y)}; }
__device__ __forceinline__ f32x4 mm_tile(const LAS bf16* X, int r0, const LAS bf16* Y, int c0, int lane) {
    const int rr = lane & 15, q = lane >> 4;
    const LAS bf16* xp = X + (r0 + rr) * LP + 8 * q; const LAS bf16* yp = Y + (c0 + rr) * LP + 8 * q;
    const bf16x8 a0 = *(const LAS bf16x8*)xp, a1 = *(const LAS bf16x8*)(xp + 32), b0 = *(const LAS bf16x8*)yp, b1 = *(const LAS bf16x8*)(yp + 32);
    f32x4 acc = (f32x4){0.f, 0.f, 0.f, 0.f};
    acc = __builtin_amdgcn_mfma_f32_16x16x32_bf16(a0, b0, acc, 0, 0, 0);
    acc = __builtin_amdgcn_mfma_f32_16x16x32_bf16(a1, b1, acc, 0, 0, 0);
    return acc;
}
__device__ __forceinline__ float red8(float x) {
    x += __builtin_bit_cast(float, __builtin_amdgcn_update_dpp(0, __builtin_bit_cast(int, x), 0x141, 0xf, 0xf, false));
    x += __builtin_bit_cast(float, __builtin_amdgcn_update_dpp(0, __builtin_bit_cast(int, x), 0xB1, 0xf, 0xf, false));
    x += __builtin_bit_cast(float, __builtin_amdgcn_update_dpp(0, __builtin_bit_cast(int, x), 0x4E, 0xf, 0xf, false));
    return x;
}

#define S1_BAR() do { asm volatile("s_waitcnt lgkmcnt(0)" ::: "memory"); __builtin_amdgcn_s_barrier(); asm volatile("" ::: "memory"); } while (0)
struct RwIn { bf16 lw[8], r[8], k[8], a[8], b[8], v[8]; };
__device__ __forceinline__ void s1_rwkv_load(Frame& F, int u, RwIn& I) {
    const int sr = u / NCHUNK, c = u - sr * NCHUNK, rb = sr >> 4, rdir = (sr >> 3) & 1, rh = sr & 7; unsigned char* ws = F.ws;
    const bf16* RBp = (const bf16*)(ws + WS_RB); const bf16* VBp = (const bf16*)(ws + WS_VB); const bf16* KKp = (const bf16*)(ws + WS_KKB);
    const bf16* KMp = (const bf16*)(ws + (rdir ? WS_KMB : WS_KMF)); const bf16* BVp = (const bf16*)(ws + (rdir ? WS_BVB : WS_BVF)); const bf16* LWp = (const bf16*)(ws + (rdir ? WS_LWB : WS_LWF));
#pragma unroll
    for (int i = 0; i < 8; ++i) { const int row = scan_row(c * CH + 8 * F.wave + i, rb, rdir); const size_t base = (size_t)row * RWW + rh * 64 + F.lane;
        I.lw[i] = LWp[base]; I.r[i] = RBp[base]; I.k[i] = KMp[base]; I.a[i] = KKp[base]; I.b[i] = BVp[base]; I.v[i] = VBp[base]; }
}
__device__ __forceinline__ void s1_rwkv(Frame& F, int u, const RwIn& I, int un, RwIn& Inext, int cvi) {
    const int sr = u / NCHUNK, c = u - sr * NCHUNK;
    const bool emit = c >= CTXL / CH;
    LAS unsigned char* lds = F.lds; unsigned char* ws = F.ws;
    int lane_ = F.lane; asm volatile("" : "+v"(lane_));
    const int lane = lane_, wave = F.wave, rr = lane & 15, q = lane >> 4;
    LAS float* tot = (LAS float*)(lds + AUX_OFF); LAS float* gCs = tot + 512;
    {
        float lw[8], xr[8], xk[8], xa[8], xb[8], xv[8];
#pragma unroll
        for (int i = 0; i < 8; ++i) { lw[i] = bf2f(I.lw[i]); xr[i] = bf2f(I.r[i]); xk[i] = bf2f(I.k[i]); xa[i] = -bf2f(I.a[i]); xb[i] = bf2f(I.b[i]); xv[i] = bf2f(I.v[i]); }
        float p[8]; p[0] = lw[0];
#pragma unroll
        for (int i = 1; i < 8; ++i) p[i] = p[i - 1] + lw[i];
        tot[wave * 64 + lane] = p[7];
        S1_BAR();
        float off = 0.f, all = 0.f;
#pragma unroll
        for (int w = 0; w < 8; ++w) { const float t = tot[w * 64 + lane]; all += t; off += (w < wave) ? t : 0.f; }
        if (wave == 0) gCs[lane] = __expf(all);
        float at[8], bb[8], kb[8];
#pragma unroll
        for (int i = 0; i < 8; ++i) { const float cum = off + p[i]; const float g = __expf(cum), gi = __expf(-cum), gp = __expf(cum - lw[i]), gc = __expf(all - cum);
            const int t = 8 * wave + i;
            at[i] = xa[i] * gp; bb[i] = xb[i] * gc; kb[i] = xk[i] * gc;
            SLOT(0)[t * LP + lane] = (bf16)pk2z(at[i]);
            SLOT(1)[t * LP + lane] = (bf16)pk2z(xr[i] * g);
            SLOT(2)[t * LP + lane] = (bf16)pk2z(xb[i] * gi);
            SLOT(3)[t * LP + lane] = (bf16)pk2z(xk[i] * gi); }
        *(LAS v4u*)(SLOT(4) + lane * LP + 8 * wave) = pk8(at);
        *(LAS v4u*)(SLOT(5) + lane * LP + 8 * wave) = pk8(xv);
        *(LAS v4u*)(SLOT(6) + lane * LP + 8 * wave) = pk8(bb);
        *(LAS v4u*)(SLOT(7) + lane * LP + 8 * wave) = pk8(kb);
        S1_BAR();
    }
    s1_rwkv_load(F, un, Inext);
    LAS float* Lp = (LAS float*)(lds + 8 * SLOTB);
#pragma unroll
    for (int tix = 0; tix < 2; ++tix) { const int ti = 2 * wave + tix, r0 = 16 * (ti >> 2), c0 = 16 * (ti & 3), ci = c0 + rr;
        { const f32x4 acc = mm_tile(SLOT(2), r0, SLOT(0), c0, lane);
#pragma unroll
            for (int e = 0; e < 4; ++e) { const int i = r0 + 4 * q + e; Lp[ci * LPF + (i & 3) * 16 + (i >> 2)] = (i < ci) ? acc[e] : 0.f; } }
        { f32x4 acc = mm_tile(SLOT(0), r0, SLOT(3), c0, lane);
#pragma unroll
            for (int e = 0; e < 4; ++e) acc[e] = (ci < r0 + 4 * q + e) ? acc[e] : 0.f;
            *(LAS v2u*)(SLOT(10) + ci * LP + r0 + 4 * q) = pack4(acc); }
        if (emit) {
            { f32x4 acc = mm_tile(SLOT(2), r0, SLOT(1), c0, lane);
#pragma unroll
                for (int e = 0; e < 4; ++e) acc[e] = (r0 + 4 * q + e <= ci) ? acc[e] : 0.f;
                *(LAS v2u*)(SLOT(11) + ci * LP + r0 + 4 * q) = pack4(acc); }
            { f32x4 acc = mm_tile(SLOT(3), r0, SLOT(1), c0, lane);
#pragma unroll
                for (int e = 0; e < 4; ++e) acc[e] = (r0 + 4 * q + e <= ci) ? acc[e] : 0.f;
                *(LAS v2u*)(SLOT(12) + ci * LP + r0 + 4 * q) = pack4(acc); }
        }
    }
    S1_BAR();
    if (wave < 4) {
        const int j = 16 * wave + (lane >> 2), s = lane & 3;
        float Tr[16];
#pragma unroll
        for (int m = 0; m < 16; ++m) Tr[m] = 0.f;
        const LAS float* lrow = Lp + s * 16;
        f32x4 lb[3][4];
#pragma unroll
        for (int t = 0; t < 2; ++t) lb[t][0] = *(const LAS f32x4*)(lrow + t * LPF);
#pragma unroll
        for (int t = 0; t < 64; ++t) {
            if (t + 2 < 64) {
#pragma unroll
                for (int k = 0; k < 4; ++k) if (4 * k <= (t + 2) / 4) lb[(t + 2) % 3][k] = *(const LAS f32x4*)(lrow + (t + 2) * LPF + 4 * k);
            }
            __builtin_amdgcn_sched_barrier(0);
            float acc0 = 0.f, acc1 = 0.f;
#pragma unroll
            for (int m = 0; m < 16; ++m) if (m <= t / 4) { const float lv = lb[t % 3][m >> 2][m & 3]; if (m & 1) acc1 += lv * Tr[m]; else acc0 += lv * Tr[m]; }
            float acc = acc0 + acc1;
            acc += __builtin_bit_cast(float, __builtin_amdgcn_update_dpp(0, __builtin_bit_cast(int, acc), 0xB1, 0xf, 0xf, false));
            acc += __builtin_bit_cast(float, __builtin_amdgcn_update_dpp(0, __builtin_bit_cast(int, acc), 0x4E, 0xf, 0xf, false));
            int jj = j, ss = s; asm volatile("" : "+v"(jj), "+v"(ss));
            const float val = acc + ((t == jj) ? 1.f : 0.f);
            Tr[t >> 2] = (ss == (t & 3)) ? val : Tr[t >> 2];
            SLOT(0)[t * LP + j] = (bf16)pk2z(val);
        }
    } else if (cvi >= 0) { f32x4 cv[CVK]; cvx_load(F.in, cvi, lane, cv); cvx_store(ws, cvi, lane, cv); }
    S1_BAR();
#pragma unroll
    for (int tix = 0; tix < 2; ++tix) { const int ti = 2 * wave + tix, r0 = 16 * (ti >> 2), c0 = 16 * (ti & 3), ci = c0 + rr;
        { const f32x4 acc = mm_tile(SLOT(0), r0, SLOT(4), c0, lane); *(LAS v2u*)(SLOT(2) + ci * LP + r0 + 4 * q) = pack4(acc); }
        { const f32x4 acc = mm_tile(SLOT(0), r0, SLOT(10), c0, lane); *(LAS v2u*)(SLOT(3) + ci * LP + r0 + 4 * q) = pack4(acc); }
    }
    S1_BAR();
    bf16* RH = (bf16*)(ws + WS_RH) + (size_t)u * 4096; bf16* GT = (bf16*)((unsigned char*)F.out + OUT_GT) + (size_t)u * 4096;
#pragma unroll
    for (int tix = 0; tix < 2; ++tix) { const int ti = 2 * wave + tix, tr = ti >> 2, r0 = 16 * tr, c0 = 16 * (ti & 3), ci = c0 + rr;
        const int pos = (tr >> 1) * 32 + q * 8 + 4 * (tr & 1);
        if (emit) {
            { f32x4 acc = mm_tile(SLOT(2), r0, SLOT(11), c0, lane);
                acc += unpack4(*(const LAS v2u*)(SLOT(1) + ci * LP + r0 + 4 * q));
                *(v2u*)(RH + ci * 64 + pos) = pack4(acc); }
            { f32x4 acc = mm_tile(SLOT(3), r0, SLOT(11), c0, lane);
                acc += unpack4(*(const LAS v2u*)(SLOT(12) + ci * LP + r0 + 4 * q));
                *(LAS v2u*)(SLOT(4) + ci * LP + r0 + 4 * q) = pack4(acc); }
        }
        { f32x4 acc = mm_tile(SLOT(2), r0, SLOT(6), c0, lane);
            const float gc = gCs[ci];
#pragma unroll
            for (int e = 0; e < 4; ++e) acc[e] += (r0 + 4 * q + e == ci) ? gc : 0.f;
            *(v2u*)(GT + ci * 64 + pos) = pack4(acc); }
    }
    S1_BAR();
    bf16* YL = (bf16*)(ws + WS_YL) + (size_t)u * 4096;
#pragma unroll
    for (int tix = 0; tix < 2; ++tix) { const int ti = 2 * wave + tix, r0 = 16 * (ti >> 2), c0 = 16 * (ti & 3), ci = c0 + rr;
        if (emit) { const f32x4 acc = mm_tile(SLOT(5), r0, SLOT(4), c0, lane); *(v2u*)(YL + ci * 64 + r0 + 4 * q) = pack4(acc); }
        { f32x4 acc = mm_tile(SLOT(3), r0, SLOT(6), c0, lane);
            acc += unpack4(*(const LAS v2u*)(SLOT(7) + ci * LP + r0 + 4 * q));
            *(LAS v2u*)(SLOT(8) + ci * LP + r0 + 4 * q) = pack4(acc); }
    }
    S1_BAR();
    bf16* HH = (bf16*)(ws + WS_HH) + (size_t)u * 4096;
#pragma unroll
    for (int tix = 0; tix < 2; ++tix) { const int ti = 2 * wave + tix, r0 = 16 * (ti >> 2), c0 = 16 * (ti & 3), ci = c0 + rr;
        const f32x4 acc = mm_tile(SLOT(8), r0, SLOT(5), c0, lane);
        *(v2u*)(HH + ci * 64 + r0 + 4 * q) = pack4(acc); }
    S1_BAR();
}

struct GlIn { bf16 la[8], q[8], k[8], v0[8], v1[8]; };
__device__ __forceinline__ void s1_gla_load(Frame& F, int u, GlIn& I) {
    const int sg = u / NCHUNK, c = u - sg * NCHUNK, gb = sg >> 3, gdir = (sg >> 2) & 1, gh = sg & 3; unsigned char* ws = F.ws;
    const bf16* Qp = (const bf16*)(ws + WS_QGB); const bf16* Kp = (const bf16*)(ws + WS_KGB); const bf16* Vp = (const bf16*)(ws + WS_VGB); const bf16* LAp = (const bf16*)(ws + (gdir ? WS_LAB : WS_LAF));
#pragma unroll
    for (int i = 0; i < 8; ++i) { const int row = scan_row(c * CH + 8 * F.wave + i, gb, gdir); const size_t b2 = (size_t)row * 256 + gh * 64 + F.lane, b5 = (size_t)row * RWW + gh * 128 + F.lane;
        I.la[i] = LAp[b2]; I.q[i] = Qp[b2]; I.k[i] = Kp[b2]; I.v0[i] = Vp[b5]; I.v1[i] = Vp[b5 + 64]; }
}
__device__ __forceinline__ void s1_gla(Frame& F, int u, const GlIn& I) {
    const int sg = u / NCHUNK, c = u - sg * NCHUNK;
    const bool emit = c >= CTXL / CH;
    LAS unsigned char* lds = F.lds; unsigned char* ws = F.ws;
    int lane_ = F.lane; asm volatile("" : "+v"(lane_));
    const int lane = lane_, wave = F.wave, rr = lane & 15, q = lane >> 4;
    LAS float* tot = (LAS float*)(lds + AUX_OFF);
    bf16* QE = (bf16*)((unsigned char*)F.out + OUT_QE) + (size_t)u * 4096;
    {
        float la[8], xq[8], xk[8], v0[8], v1[8];
#pragma unroll
        for (int i = 0; i < 8; ++i) { la[i] = bf2f(I.la[i]); xq[i] = bf2f(I.q[i]); xk[i] = bf2f(I.k[i]); v0[i] = bf2f(I.v0[i]); v1[i] = bf2f(I.v1[i]); }
        float p[8]; p[0] = la[0];
#pragma unroll
        for (int i = 1; i < 8; ++i) p[i] = p[i - 1] + la[i];
        tot[wave * 64 + lane] = p[7];
        S1_BAR();
        float off = 0.f, all = 0.f;
#pragma unroll
        for (int w = 0; w < 8; ++w) { const float t = tot[w * 64 + lane]; all += t; off += (w < wave) ? t : 0.f; }
        if (wave == 0) ((float*)(ws + WS_DD))[(size_t)u * 64 + lane] = __expf(all);
        float kl[8];
#pragma unroll
        for (int i = 0; i < 8; ++i) { const float cum = off + p[i]; const int t = 8 * wave + i;
            const bf16 qe = (bf16)pk2z(xq[i] * __expf(cum));
            SLOT(0)[t * LP + lane] = qe;
            if (emit) QE[t * 64 + lane] = qe;
            SLOT(1)[t * LP + lane] = (bf16)pk2z(xk[i] * __expf(-cum));
            kl[i] = xk[i] * __expf(all - cum); }
        *(LAS v4u*)(SLOT(2) + lane * LP + 8 * wave) = pk8(kl);
        *(LAS v4u*)(SLOT(3) + lane * LP + 8 * wave) = pk8(v0);
        *(LAS v4u*)(SLOT(3) + (64 + lane) * LP + 8 * wave) = pk8(v1);
        S1_BAR();
    }
    if (emit) {
#pragma unroll
        for (int tix = 0; tix < 2; ++tix) { const int ti = 2 * wave + tix, r0 = 16 * (ti >> 2), c0 = 16 * (ti & 3), ci = c0 + rr;
            f32x4 acc = mm_tile(SLOT(1), r0, SLOT(0), c0, lane);
#pragma unroll
            for (int e = 0; e < 4; ++e) acc[e] = (r0 + 4 * q + e <= ci) ? acc[e] : 0.f;
            *(LAS v2u*)(SLOT(5) + ci * LP + r0 + 4 * q) = pack4(acc); }
    }
    bf16* KV = (bf16*)(ws + WS_KV) + (size_t)u * 8192;
#pragma unroll
    for (int tix = 0; tix < 4; ++tix) { const int ti = 4 * wave + tix, r0 = 16 * (ti >> 3), c0 = 16 * (ti & 7), ci = c0 + rr;
        const f32x4 acc = mm_tile(SLOT(2), r0, SLOT(3), c0, lane);
        *(v2u*)(KV + ci * 64 + r0 + 4 * q) = pack4(acc); }
    S1_BAR();
    if (emit) {
        bf16* IN = (bf16*)(ws + WS_INTRA) + (size_t)u * 8192;
#pragma unroll
        for (int tix = 0; tix < 4; ++tix) { const int ti = 4 * wave + tix, r0 = 16 * (ti >> 2), c0 = 16 * (ti & 3), ci = c0 + rr;
            const f32x4 acc = mm_tile(SLOT(3), r0, SLOT(5), c0, lane);
            *(v2u*)(IN + ci * 128 + r0 + 4 * q) = pack4(acc); }
    }
    S1_BAR();
}

__device__ __forceinline__ void ph_scan1(Frame& F) {
    { RwIn cur, nxt; if ((int)blockIdx.x < NU_RW) s1_rwkv_load(F, blockIdx.x, cur);
#pragma unroll 1
      for (int u = blockIdx.x; u < NU_RW; u += F.G) { const int un = (u + F.G < NU_RW) ? u + F.G : u; const int cvi = ((u - (int)blockIdx.x) / F.G) * (F.G * 4) + (int)blockIdx.x * 4 + (F.wave & 3);
          s1_rwkv(F, u, cur, un, nxt, cvi < CV_NITEM ? cvi : -1); cur = nxt; } }
    { GlIn cur, nxt; if ((int)blockIdx.x < NU_GL) s1_gla_load(F, blockIdx.x, cur);
#pragma unroll 1
      for (int u = blockIdx.x; u < NU_GL; u += F.G) { const int un = (u + F.G < NU_GL) ? u + F.G : u; s1_gla_load(F, un, nxt); s1_gla(F, u, cur); cur = nxt; } }
}

__device__ __forceinline__ bf16x8 pack_frag(const f32x4 lo, const f32x4 hi) {
    v4u w; w.x = pk2(lo[0], lo[1]); w.y = pk2(lo[2], lo[3]); w.z = pk2(hi[0], hi[1]); w.w = pk2(hi[2], hi[3]); return __builtin_bit_cast(bf16x8, w);
}
constexpr int S2_D = 3, S2_R = 4, S2_RW = 8192 + 8192 + 2048 + 2048, S2_GL = 8192 + 2048 + 2048 + 1024, S2_SLOT = S2_RW + S2_GL;
static_assert(S2_R * S2_SLOT <= MISC_OFF, "S2 ring fits in LDS");
__device__ __forceinline__ void s2_issue(LAS unsigned char* lds, int sb, int lw, int lane, size_t ur, size_t ug, int v0r, int v0g,
                                         const unsigned char* GTb, const unsigned char* RHb, const unsigned char* HHb, const unsigned char* YLb,
                                         const unsigned char* QEb, const unsigned char* KVb, const unsigned char* INb, const unsigned char* DDb) {
#pragma unroll
    for (int j = 0; j < 6; ++j) {
        int k = lw * 6 + j; if (k >= 33) k -= 5;
        const unsigned char* src; int ldo;
        if (k < 16) { const int n = k & 7, pu = n * 64 + lane, row = pu >> 3, c16 = (pu & 7) ^ (row & 7);
            src = (k < 8 ? GTb : RHb) + ur * 8192 + row * 128 + c16 * 16; ldo = (k < 8 ? 0 : 8192) + n * 1024; }
        else if (k < 18) { const int n = k - 16, pu = n * 64 + lane, v = pu >> 3, c16 = (pu & 7) ^ (v & 7);
            src = HHb + ur * 8192 + (size_t)(v0r + v) * 128 + c16 * 16; ldo = 16384 + n * 1024; }
        else if (k < 20) { const int n = k - 18, pu = n * 64 + lane, t = pu >> 1;
            src = YLb + ur * 8192 + t * 128 + v0r * 2 + (pu & 1) * 16; ldo = 18432 + n * 1024; }
        else if (k < 28) { const int n = k - 20, pu = n * 64 + lane, row = pu >> 3, c16 = (pu & 7) ^ (row & 7);
            src = QEb + ug * 8192 + row * 128 + c16 * 16; ldo = S2_RW + n * 1024; }
        else if (k < 30) { const int n = k - 28, pu = n * 64 + lane, v = pu >> 3, c16 = (pu & 7) ^ (v & 7);
            src = KVb + ug * 16384 + (size_t)(v0g + v) * 128 + c16 * 16; ldo = S2_RW + 8192 + n * 1024; }
        else if (k < 32) { const int n = k - 30, pu = n * 64 + lane, t = pu >> 1;
            src = INb + ug * 16384 + t * 256 + v0g * 2 + (pu & 1) * 16; ldo = S2_RW + 10240 + n * 1024; }
        else { src = DDb + ug * 256 + (lane & 15) * 16; ldo = S2_RW + 12288; }
        __builtin_amdgcn_global_load_lds((const unsigned*)src, (LAS unsigned*)(lds + sb + ldo), 16, 0, 0);
    }
}
__device__ __forceinline__ void ph_scan2(Frame& F) {
    const int lane = F.lane, wave = F.wave, rr = lane & 15, q = lane >> 4; unsigned char* ws = F.ws; LAS unsigned char* lds = F.lds;
    const int it = (F.G == 256) ? (int)(blockIdx.x & 7) * 32 + (int)(blockIdx.x >> 3) : (int)blockIdx.x;
    const int sr = it >> 2, v0r = 16 * (it & 3), rb = sr >> 4, rdir = (sr >> 3) & 1, rh = sr & 7;
    const int sg = it >> 3, v0g = 16 * (it & 7), gb = sg >> 3, gdir = (sg >> 2) & 1, gh = sg & 3;
#define S2_BAR() do { asm volatile("s_waitcnt lgkmcnt(0)" ::: "memory"); __builtin_amdgcn_s_barrier(); asm volatile("" ::: "memory"); } while (0)
    if (wave >= 2) {
        const unsigned char* GTb = (const unsigned char*)F.out + OUT_GT; const unsigned char* QEb = (const unsigned char*)F.out + OUT_QE;
        const unsigned char* RHb = ws + WS_RH; const unsigned char* YLb = ws + WS_YL; const unsigned char* HHb = ws + WS_HH; const unsigned char* KVb = ws + WS_KV; const unsigned char* INb = ws + WS_INTRA;
        const unsigned char* DDb = ws + WS_DD;
#define S2_ISSUE(cc) s2_issue(lds, ((cc) % S2_R) * S2_SLOT, wave - 2, lane, (size_t)(sr * NCHUNK + ((cc) < NCHUNK ? (cc) : NCHUNK - 1)), (size_t)(sg * NCHUNK + ((cc) < NCHUNK ? (cc) : NCHUNK - 1)), v0r, v0g, GTb, RHb, HHb, YLb, QEb, KVb, INb, DDb)
        S2_ISSUE(0); S2_ISSUE(1); S2_ISSUE(2);
#pragma unroll 1
        for (int c = 0; c < NCHUNK; ++c) {
            asm volatile("s_waitcnt vmcnt(12) ; S2WAIT" ::: "memory");
            S2_BAR();
            S2_ISSUE(c + S2_D);
        }
#undef S2_ISSUE
    } else if (wave == 0) {
        bf16* ORW = (bf16*)(ws + (rdir ? WS_ORWB : WS_ORWF));
        f32x4 S[4];
#pragma unroll
        for (int m = 0; m < 4; ++m) S[m] = (f32x4){0.f, 0.f, 0.f, 0.f};
#pragma unroll 1
        for (int c = 0; c < NCHUNK; ++c) {
            S2_BAR();
            const LAS unsigned char* sl = lds + (c % S2_R) * S2_SLOT;
            const bool emit = c >= CTXL / CH;
            bf16x8 G0[4], G1[4], R0[4], R1[4]; v2u Hw[4], Yw[4];
#pragma unroll
            for (int m = 0; m < 4; ++m) { const int k2 = 16 * m + rr;
                G0[m] = *(const LAS bf16x8*)(sl + (k2 * 8 + (q ^ (k2 & 7))) * 16); G1[m] = *(const LAS bf16x8*)(sl + (k2 * 8 + ((4 + q) ^ (k2 & 7))) * 16);
                Hw[m] = *(const LAS v2u*)(sl + 16384 + (rr * 8 + ((2 * m + (q >> 1)) ^ (rr & 7))) * 16 + (q & 1) * 8); }
            if (emit) {
#pragma unroll
                for (int tt = 0; tt < 4; ++tt) { const int t = 16 * tt + rr;
                    R0[tt] = *(const LAS bf16x8*)(sl + 8192 + (t * 8 + (q ^ (t & 7))) * 16); R1[tt] = *(const LAS bf16x8*)(sl + 8192 + (t * 8 + ((4 + q) ^ (t & 7))) * 16);
                    Yw[tt] = *(const LAS v2u*)(sl + 18432 + t * 32 + q * 8); }
            }
            const bf16x8 Sf0 = pack_frag(S[0], S[1]), Sf1 = pack_frag(S[2], S[3]);
            __builtin_amdgcn_sched_barrier(0);
#pragma unroll
            for (int m = 0; m < 4; ++m) { f32x4 acc = unpack4(Hw[m]);
                acc = __builtin_amdgcn_mfma_f32_16x16x32_bf16(G0[m], Sf0, acc, 0, 0, 0);
                acc = __builtin_amdgcn_mfma_f32_16x16x32_bf16(G1[m], Sf1, acc, 0, 0, 0);
                S[m] = acc; }
            if (emit) {
#pragma unroll
                for (int tt = 0; tt < 4; ++tt) { const int t = 16 * tt + rr;
                    f32x4 acc = unpack4(Yw[tt]);
                    acc = __builtin_amdgcn_mfma_f32_16x16x32_bf16(Sf0, R0[tt], acc, 0, 0, 0);
                    acc = __builtin_amdgcn_mfma_f32_16x16x32_bf16(Sf1, R1[tt], acc, 0, 0, 0);
                    const int row = scan_row(c * CH + t, rb, rdir);
                    *(v2u*)(ORW + (size_t)row * RWW + rh * 64 + v0r + 4 * q) = pack4(acc); }
            }
        }
    } else {
        bf16* OGL = (bf16*)(ws + (gdir ? WS_OGLB : WS_OGLF));
        f32x4 S[4];
#pragma unroll
        for (int m = 0; m < 4; ++m) S[m] = (f32x4){0.f, 0.f, 0.f, 0.f};
#pragma unroll 1
        for (int c = 0; c < NCHUNK; ++c) {
            S2_BAR();
            const LAS unsigned char* sl = lds + (c % S2_R) * S2_SLOT + S2_RW;
            const bool emit = c >= CTXL / CH;
            bf16x8 Q0[4], Q1[4]; v2u Iw[4]; v4u kw[2]; f32x4 d0[2], d1[2];
#pragma unroll
            for (int s2 = 0; s2 < 2; ++s2) { kw[s2] = *(const LAS v4u*)(sl + 8192 + (rr * 8 + ((4 * s2 + q) ^ (rr & 7))) * 16);
                d0[s2] = *(const LAS f32x4*)(sl + 12288 + 128 * s2 + 32 * q); d1[s2] = *(const LAS f32x4*)(sl + 12288 + 128 * s2 + 32 * q + 16); }
            if (emit) {
#pragma unroll
                for (int tt = 0; tt < 4; ++tt) { const int t = 16 * tt + rr;
                    Q0[tt] = *(const LAS bf16x8*)(sl + (t * 8 + (q ^ (t & 7))) * 16); Q1[tt] = *(const LAS bf16x8*)(sl + (t * 8 + ((4 + q) ^ (t & 7))) * 16);
                    Iw[tt] = *(const LAS v2u*)(sl + 10240 + t * 32 + q * 8); }
            }
            const bf16x8 Sf0 = pack_frag(S[0], S[1]), Sf1 = pack_frag(S[2], S[3]);
            __builtin_amdgcn_sched_barrier(0);
#pragma unroll
            for (int s2 = 0; s2 < 2; ++s2) { S[2 * s2] = S[2 * s2] * d0[s2] + unpack4((v2u){kw[s2].x, kw[s2].y}); S[2 * s2 + 1] = S[2 * s2 + 1] * d1[s2] + unpack4((v2u){kw[s2].z, kw[s2].w}); }
            if (emit) {
#pragma unroll
                for (int tt = 0; tt < 4; ++tt) { const int t = 16 * tt + rr;
                    f32x4 acc = unpack4(Iw[tt]);
                    acc = __builtin_amdgcn_mfma_f32_16x16x32_bf16(Sf0, Q0[tt], acc, 0, 0, 0);
                    acc = __builtin_amdgcn_mfma_f32_16x16x32_bf16(Sf1, Q1[tt], acc, 0, 0, 0);
                    const int row = scan_row(c * CH + t, gb, gdir);
                    *(v2u*)(OGL + (size_t)row * RWW + gh * 128 + v0g + 4 * q) = pack4(acc); }
            }
        }
    }
#undef S2_BAR
}
#endif

#ifndef ML
#define ML 0
#endif
enum Phase { PH_PROLOGUE = 0, PH_A1, PH_INPROJ, PH_FEAT, PH_LORA, PH_SCAN1, PH_SCAN2, PH_MERGE, PH_BRANCH, PH_OUTPROJ, PH_LN1, PH_ROUTER, PH_ROUTE, PH_SCATTER, PH_EXP1, PH_EXP2, PH_FINAL, PH_COUNT };

__global__ void __launch_bounds__(NTHR, 2) mega(Args args) {
    extern __shared__ __attribute__((aligned(16))) unsigned char lds_raw[];
    Frame F;
    F.lds = (LAS unsigned char*)lds_raw;
    F.tid = threadIdx.x; F.lane = F.tid & 63; F.wave = __builtin_amdgcn_readfirstlane(F.tid >> 6);
    F.G = gridDim.x; F.gw = blockIdx.x * NWAVES + F.wave; F.NGW = F.G * NWAVES;
    F.in = args.in; F.out = args.out; F.ws = args.ws; F.ctl = (unsigned*)(args.ws + WS_CTL);
    volatile LAS unsigned* MISC = (volatile LAS unsigned*)(F.lds + MISC_OFF);
    if (F.tid < 64) MISC[F.tid] = 0u;
    __syncthreads();
    XcdBarrier bar; bar.bar = F.ctl + CW_BAR; bar.x = 0; bar.st = nullptr;
#if !ML
    bar = xcd_barrier_post(F.ctl + CW_BAR, MISC + 8);
#endif
    const int lo = args.ph_lo, hi = args.ph_hi;
#define IN(k) (lo <= (k) && (k) < hi)
#ifndef DUP
#define DUP -1
#endif
#define RUN(k, call) do { if (IN(k)) { call; GRID_BAR(); if (DUP == (k)) { call; GRID_BAR(); } } } while (0)
#if ML
#define GRID_BAR() do { } while (0)
#else
#define GRID_BAR() xcd_barrier(bar)
#endif

#if MS >= 2
    RUN(PH_PROLOGUE, ph_prologue(F));
#endif
#if MS >= 3
    RUN(PH_A1, ph_a1(F));
    RUN(PH_INPROJ, ph_inproj(F));
    RUN(PH_FEAT, ph_feat(F));
    RUN(PH_LORA, ph_lora(F));
    RUN(PH_SCAN1, ph_scan1(F));
    RUN(PH_SCAN2, ph_scan2(F));
    RUN(PH_MERGE, ph_merge(F));
    RUN(PH_BRANCH, ph_branch(F));
    RUN(PH_OUTPROJ, ph_outproj(F));
#else
    RUN(PH_OUTPROJ, ph_x1pre_nomix(F));
#endif
    RUN(PH_LN1, ph_ln1(F));
#if MS >= 2
    RUN(PH_ROUTER, ph_router(F));
    RUN(PH_ROUTE, ph_route(F));
    RUN(PH_SCATTER, ph_scatter(F));
    RUN(PH_EXP1, ph_exp1(F));
    RUN(PH_EXP2, ph_exp2(F));
#endif
    if (IN(PH_FINAL)) { ph_final(F); }
#undef IN
}

extern "C" void kernel_launch(void* const* d_in, const int* in_sizes, int n_in, void* d_out, int out_size, void* d_ws, size_t ws_size, hipStream_t stream) {
    static int grid = 0;
    if (grid == 0) {
        if (n_in != 36 || out_size != NLAT * D || ws_size < WS_END) { fprintf(stderr, "kernel_launch: unexpected problem shape (n_in %d, out %d)\n", n_in, out_size); grid = -1; return; }
        int dev = 0, cus = 0, per_cu = 0;
        if (hipGetDevice(&dev) != hipSuccess || hipDeviceGetAttribute(&cus, hipDeviceAttributeMultiprocessorCount, dev) != hipSuccess) { grid = -1; return; }
        if (hipFuncSetAttribute((const void*)mega, hipFuncAttributeMaxDynamicSharedMemorySize, LDS_BYTES) != hipSuccess) { fprintf(stderr, "kernel_launch: hipFuncSetAttribute failed\n"); grid = -1; return; }
        if (hipOccupancyMaxActiveBlocksPerMultiprocessor(&per_cu, (const void*)mega, NTHR, LDS_BYTES) != hipSuccess || per_cu < 1) { fprintf(stderr, "kernel_launch: occupancy query says %d\n", per_cu); }
        (void)hipGetLastError();
        grid = cus > 0 ? cus : 256;
        if (grid > 256) grid = 256;
    }
    if (grid < 0) return;
    (void)hipMemsetAsync((char*)d_ws + WS_CTL, 0, CTL_ZERO_BYTES, stream);
    Args a{};
    for (int i = 0; i < 36; ++i) a.in[i] = (const float*)d_in[i];
    a.out = (float*)d_out; a.ws = (unsigned char*)d_ws;
#if ML
    for (int p = 0; p < PH_COUNT; ++p) { a.ph_lo = p; a.ph_hi = p + 1; hipLaunchKernelGGL(mega, dim3(grid), dim3(NTHR), LDS_BYTES, stream, a); }
#else
    a.ph_lo = 0; a.ph_hi = PH_COUNT;
    hipLaunchKernelGGL(mega, dim3(grid), dim3(NTHR), LDS_BYTES, stream, a);
#endif
}
```

```cpp
#include <hip/hip_runtime.h>
#include <cstdio>
#include <cstdint>

#ifndef MS
#define MS 3
#endif

#define GAS __attribute__((address_space(1)))
#define LAS __attribute__((address_space(3)))
typedef unsigned short bf16;
typedef unsigned v4u __attribute__((ext_vector_type(4)));
typedef unsigned v2u __attribute__((ext_vector_type(2)));
typedef float f32x4 __attribute__((ext_vector_type(4)));
typedef float f32x2 __attribute__((ext_vector_type(2)));
typedef short bf16x8 __attribute__((ext_vector_type(8)));
#define LDS_WAIT() asm volatile("s_waitcnt lgkmcnt(0)" ::: "memory")
#define VM_WAIT() asm volatile("s_waitcnt vmcnt(0)" ::: "memory")

constexpr int D = 1024, NB = 4, SEQ = 8192, CTXL = 256, GRIDW = 64, GRIDH = 128;
constexpr int NLAT = NB * SEQ, NCTX = NB * CTXL, MR = NLAT + NCTX;
constexpr int RWW = 512, RWH = 8, HD = 64;
constexpr int C_R = 0, C_K = 512, C_V = 1024, C_PW = 1536, C_PA = 1568, C_PG = 1600, C_Q = 1696, C_KG = 1952, C_VG = 2208, C_PGL = 2720, C_OG = 2736, C_GRW = 3248, C_GGLA = 4272;
constexpr int IN_COLS = 5296, NP = 5376;
constexpr int NE = 256, TOPK = 8, FF = 256;
constexpr float LN_EPS = 1e-5f, RW_GN_EPS = 64e-5f;
constexpr float ALPHA = 1.189207115f;
constexpr int NLORA = 3072, KLORA = 256;
constexpr int MAXTILES = 1280, SH_ROW0 = MAXTILES * 256, NROWS_E = SH_ROW0 + NLAT;

namespace pg8 {
#define PG8_LAS __attribute__((address_space(3)))
typedef unsigned short bf16_t;
typedef unsigned u32x4 __attribute__((ext_vector_type(4)));
typedef unsigned u32x2 __attribute__((ext_vector_type(2)));
constexpr int BM = 256, BK = 64, HALF = 128, HTB = HALF * BK * 2, STAGE_BYTES = 8 * HTB, NXCD = 8, WGM = 8;
constexpr int IDX_OFF = STAGE_BYTES, IDX_UNITS = 12;

__host__ __device__ __forceinline__ int lds_byte(int r, int c) { const int st = (r >> 4) * 2 + (c >> 5), rr = r & 15, cc = c & 31, ob = rr * 64 + cc * 2; return st * 1024 + (ob ^ (((ob >> 9) & 1) << 5)); }
__host__ __device__ __forceinline__ void stage_rc(int b, int& R, int& C) { const int st = b / 1024, sb = b % 1024, swz = sb ^ (((sb >> 9) & 1) << 5); R = (st >> 1) * 16 + swz / 64; C = (st & 1) * 32 + (swz % 64) / 2; }
__host__ __device__ __forceinline__ int perm32(int rho) { const int n = rho >> 4, i = rho & 15; return 8 * (i >> 2) + 4 * n + (i & 3); }

struct Unit { int pm, pn, e, j; };
struct Gemm { const bf16_t* A; const bf16_t* Bt; int M, N, K; const int* rowidx; };

struct StaticOrder {
    int nM, nN, nwg, G, c;
    __host__ __device__ void init(int M, int N, int G_, int c_) { nM = M / BM; nN = N / BM; nwg = nM * nN; G = G_; c = c_; }
    __host__ __device__ bool next(int i, Unit& u) const {
        const long L = (long)i * G + c; if (L >= nwg) return false;
        int wgid = (int)L; { const int q = nwg / NXCD, r = nwg % NXCD, xcd = wgid % NXCD, off = wgid / NXCD; wgid = (xcd < r ? xcd * (q + 1) : r * (q + 1) + (xcd - r) * q) + off; }
        const int nig = WGM * nN, gid = wgid / nig, fm = gid * WGM, gsz = (nM - fm) < WGM ? (nM - fm) : WGM;
        u.pm = fm + ((wgid % nig) % gsz); u.pn = (wgid % nig) / gsz; u.e = 0; u.j = u.pn; return true;
    }
};
struct MoeOrder {
    int nN, G, c, NT; const int* tile_e;
    __device__ bool next(int i, Unit& u) const {
        const int L = i * G + c; const int total = (NT + NLAT / 256) * nN; if (L >= total) return false;
        const int tile = L / nN, j = L - tile * nN; int e, pm;
        if (tile < NT) { e = tile_e[tile]; pm = tile; } else { e = NE; pm = MAXTILES + (tile - NT); }
        u.pm = pm; u.pn = e * nN + j; u.e = e; u.j = j; return true;
    }
};

typedef __bf16 bf16x2n __attribute__((ext_vector_type(2))); typedef float f32x2n __attribute__((ext_vector_type(2)));
__device__ __forceinline__ unsigned cvt_pk_bf16(float lo, float hi) { const f32x2n v = {lo, hi}; return __builtin_bit_cast(unsigned, __builtin_convertvector(v, bf16x2n)); }

template <class Epi, class Sched, bool ALIGN_EPI, bool SP2, bool GATHER>
__device__ __forceinline__ void gemm_phase(PG8_LAS unsigned char* lds, const Gemm g, const Sched& S, const Epi& E) {
    const int tid = threadIdx.x, wid = __builtin_amdgcn_readfirstlane(tid >> 6), lane = tid & 63, wr = wid >> 2, wc = wid & 3, fr = lane & 15, fq = lane >> 4;
    const int K = g.K, nt = K / BK;
    const size_t kstep = (size_t)(BK * 2);
    const size_t hstep = (size_t)HALF * K * 2;
    const size_t tstep = 2 * hstep;
    unsigned voffB[2]; unsigned va[2][2];
#pragma unroll
    for (int i = 0; i < 2; ++i) { int R, C; stage_rc(tid * 16 + i * 8192, R, C); const int Rb = Epi::PERM ? ((R & ~31) + perm32(R & 31)) : R;
        voffB[i] = (unsigned)(Rb * K + C) * 2u;
        va[0][i] = (unsigned)(R * K + C) * 2u; va[1][i] = va[0][i]; }
    const size_t ah = GATHER ? (size_t)0 : hstep;
#define PG8_GOFF(dst, ub) do { _Pragma("unroll") for (int _h = 0; _h < 2; ++_h) _Pragma("unroll") for (int _i = 0; _i < 2; ++_i) { int _R, _C; stage_rc(tid * 16 + _i * 8192, _R, _C); \
        dst[_h][_i] = (unsigned)(idxt[(ub) * 256 + _h * 128 + _R] * K + _C) * 2u; } } while (0)
    const unsigned ldsw = (unsigned)wid * 1024u;
    const int aoff = lds_byte(wr * 64 + fr, fq * 8), boff = lds_byte(wc * 32 + fr, fq * 8);
    PG8_LAS int* idxt = (PG8_LAS int*)(lds + IDX_OFF);
#define PG8_SA(b, h) (((b) * 2 + (h)) * HTB)
#define PG8_SB(b, h) ((4 + (b) * 2 + (h)) * HTB)
#define PG8_STAGE(bufoff, gbase, voff) do { _Pragma("unroll") for (int _i = 0; _i < 2; ++_i) \
        __builtin_amdgcn_global_load_lds((const unsigned*)((const char*)(gbase) + (voff)[_i]), (PG8_LAS unsigned*)(lds + (bufoff) + ldsw + _i * 8192), 16, 0, 0); } while (0)
#define PG8_LDA(dst, b, h) do { _Pragma("unroll") for (int m = 0; m < 4; ++m) _Pragma("unroll") for (int k = 0; k < 2; ++k) dst[m][k] = *(const PG8_LAS bf16x8*)(lds + PG8_SA(b, h) + aoff + m * 2048 + k * 1024); } while (0)
#define PG8_LDB(dst, b, h) do { _Pragma("unroll") for (int n = 0; n < 2; ++n) _Pragma("unroll") for (int k = 0; k < 2; ++k) dst[n][k] = *(const PG8_LAS bf16x8*)(lds + PG8_SB(b, h) + boff + n * 2048 + k * 1024); } while (0)
#define PG8_MMA(ai, bj, At, Bt) do { __builtin_amdgcn_s_setprio(1); _Pragma("unroll") for (int m = 0; m < 4; ++m) _Pragma("unroll") for (int n = 0; n < 2; ++n) _Pragma("unroll") for (int k = 0; k < 2; ++k) \
        acc[ai][bj][m][n] = __builtin_amdgcn_mfma_f32_16x16x32_bf16(Bt[n][k], At[m][k], acc[ai][bj][m][n], 0, 0, 0); __builtin_amdgcn_s_setprio(0); } while (0)
#define PG8_WAIT_V(n) asm volatile("s_waitcnt vmcnt(" #n ")" ::: "memory")
#define PG8_WAIT_L(n) asm volatile("s_waitcnt lgkmcnt(" #n ")" ::: "memory")
#define PG8_BAR __builtin_amdgcn_s_barrier()
#define PG8_SCHED __builtin_amdgcn_sched_barrier(0)
    Unit cur, nxt; int ui = 0;
    if (!S.next(0, cur)) return;
    if constexpr (GATHER) {
        Unit uu;
        for (int i = 0; i < IDX_UNITS; ++i) { if (!S.next(i, uu)) break; if (tid < 256) idxt[i * 256 + tid] = g.rowidx[(size_t)uu.pm * 256 + tid]; }
        asm volatile("s_waitcnt vmcnt(0) lgkmcnt(0)" ::: "memory"); PG8_BAR; asm volatile("" ::: "memory");
        PG8_GOFF(va, 0);
    }
    f32x4 acc[2][2][4][2];
#pragma unroll
    for (int a = 0; a < 2; ++a)
#pragma unroll
        for (int b = 0; b < 2; ++b)
#pragma unroll
            for (int m = 0; m < 4; ++m)
#pragma unroll
                for (int n = 0; n < 2; ++n) acc[a][b][m][n] = (f32x4){0.f, 0.f, 0.f, 0.f};
    bf16x8 At[4][2], B0[2][2], B1[2][2];
    const char* cA = (const char*)g.A + (GATHER ? (size_t)0 : (size_t)cur.pm * tstep); const char* cB = (const char*)g.Bt + (size_t)cur.pn * tstep;
    if constexpr (SP2) {
        PG8_STAGE(PG8_SB(0, 0), cB, voffB); PG8_STAGE(PG8_SB(0, 1), cB + hstep, voffB); PG8_STAGE(PG8_SA(0, 0), cA, va[0]); PG8_STAGE(PG8_SA(0, 1), cA + ah, va[1]);
        if (wr == 1) PG8_BAR;
        PG8_WAIT_V(2); PG8_BAR;
        PG8_STAGE(PG8_SB(1, 0), cB + kstep, voffB); PG8_STAGE(PG8_SA(1, 0), cA + kstep, va[0]); PG8_STAGE(PG8_SB(1, 1), cB + hstep + kstep, voffB);
        PG8_WAIT_V(6); PG8_BAR;
    } else {
        PG8_STAGE(PG8_SB(0, 0), cB, voffB); PG8_STAGE(PG8_SA(0, 0), cA, va[0]); PG8_STAGE(PG8_SB(0, 1), cB + hstep, voffB); PG8_STAGE(PG8_SA(0, 1), cA + ah, va[1]);
        if (wr == 1) PG8_BAR;
        PG8_WAIT_V(4); PG8_BAR;
        PG8_STAGE(PG8_SB(1, 0), cB + kstep, voffB); PG8_STAGE(PG8_SA(1, 0), cA + kstep, va[0]); PG8_STAGE(PG8_SB(1, 1), cB + hstep + kstep, voffB);
        PG8_WAIT_V(6); PG8_BAR;
    }
    for (;;) {
        const bool has_next = S.next(ui + 1, nxt);
        const char* nA = has_next ? (const char*)g.A + (GATHER ? (size_t)0 : (size_t)nxt.pm * tstep) : cA; const char* nB = has_next ? (const char*)g.Bt + (size_t)nxt.pn * tstep : cB;
        const int ubn = (has_next && ui + 1 < IDX_UNITS) ? (ui + 1) : ui;
#pragma unroll 1
        for (int t = 0; t < nt; t += 2) {
            const bool last = (t == nt - 2);
            const char* a1 = cA + (size_t)(t + 1) * kstep;
            const char* a2 = last ? nA : cA + (size_t)(t + 2) * kstep; const char* b2 = last ? nB : cB + (size_t)(t + 2) * kstep;
            const char* a3 = a2 + kstep; const char* b3 = b2 + kstep;
            unsigned v2[2][2];
#pragma unroll
            for (int h = 0; h < 2; ++h)
#pragma unroll
                for (int i = 0; i < 2; ++i) v2[h][i] = va[h][i];
            if constexpr (GATHER) { if (last) PG8_GOFF(v2, ubn); }
            if constexpr (SP2) {
            PG8_LDB(B0, 0, 0); PG8_LDB(B1, 0, 1); PG8_SCHED; PG8_LDA(At, 0, 0); PG8_STAGE(PG8_SA(1, 1), a1 + ah, va[1]);
            PG8_WAIT_V(8); PG8_WAIT_L(0); PG8_BAR; PG8_MMA(0, 0, At, B0); PG8_MMA(0, 1, At, B1); PG8_BAR; PG8_SCHED;
            PG8_LDA(At, 0, 1); PG8_STAGE(PG8_SB(0, 0), b2, voffB); PG8_STAGE(PG8_SB(0, 1), b2 + hstep, voffB); PG8_STAGE(PG8_SA(0, 0), a2, v2[0]);
            PG8_WAIT_V(8); PG8_WAIT_L(0); PG8_BAR; PG8_MMA(1, 0, At, B0); PG8_MMA(1, 1, At, B1); PG8_BAR; PG8_SCHED;
            PG8_LDB(B0, 1, 0); PG8_LDB(B1, 1, 1); PG8_SCHED; PG8_LDA(At, 1, 0); PG8_STAGE(PG8_SA(0, 1), a2 + ah, v2[1]);
            PG8_WAIT_V(8); PG8_WAIT_L(0); PG8_BAR; PG8_MMA(0, 0, At, B0); PG8_MMA(0, 1, At, B1); PG8_BAR; PG8_SCHED;
            PG8_LDA(At, 1, 1); PG8_STAGE(PG8_SB(1, 0), b3, voffB); PG8_STAGE(PG8_SB(1, 1), b3 + hstep, voffB); PG8_STAGE(PG8_SA(1, 0), a3, v2[0]);
            PG8_WAIT_V(8); PG8_WAIT_L(0); PG8_BAR; PG8_MMA(1, 0, At, B0); PG8_MMA(1, 1, At, B1); PG8_BAR; PG8_SCHED;
            } else {
            PG8_LDB(B0, 0, 0); PG8_SCHED; PG8_LDA(At, 0, 0); PG8_STAGE(PG8_SA(1, 1), a1 + ah, va[1]);
            PG8_WAIT_L(8); PG8_BAR; PG8_WAIT_L(0); PG8_MMA(0, 0, At, B0); PG8_BAR; PG8_SCHED;
            PG8_LDB(B1, 0, 1); PG8_STAGE(PG8_SB(0, 0), b2, voffB);
            PG8_BAR; PG8_WAIT_L(0); PG8_MMA(0, 1, At, B1); PG8_BAR;
            PG8_LDA(At, 0, 1); PG8_STAGE(PG8_SA(0, 0), a2, v2[0]);
            PG8_BAR; PG8_WAIT_L(0); PG8_MMA(1, 0, At, B0); PG8_BAR; PG8_SCHED;
            PG8_STAGE(PG8_SB(0, 1), b2 + hstep, voffB);
            PG8_WAIT_V(6); PG8_BAR; PG8_MMA(1, 1, At, B1); PG8_BAR;
            PG8_LDB(B0, 1, 0); PG8_SCHED; PG8_LDA(At, 1, 0); PG8_STAGE(PG8_SA(0, 1), a2 + ah, v2[1]);
            PG8_WAIT_L(8); PG8_BAR; PG8_WAIT_L(0); PG8_MMA(0, 0, At, B0); PG8_BAR; PG8_SCHED;
            PG8_LDB(B1, 1, 1); PG8_STAGE(PG8_SB(1, 0), b3, voffB);
            PG8_BAR; PG8_WAIT_L(0); PG8_MMA(0, 1, At, B1); PG8_BAR;
            PG8_LDA(At, 1, 1); PG8_STAGE(PG8_SA(1, 0), a3, v2[0]);
            PG8_BAR; PG8_WAIT_L(0); PG8_MMA(1, 0, At, B0); PG8_BAR; PG8_SCHED;
            PG8_STAGE(PG8_SB(1, 1), b3 + hstep, voffB);
            PG8_WAIT_V(6); PG8_BAR; PG8_MMA(1, 1, At, B1); PG8_BAR;
            }
        }
        if constexpr (ALIGN_EPI) { if (wr == 0) PG8_BAR; }
        E(acc, cur, wr, wc, fr, fq);
        if (!has_next) break;
#pragma unroll
        for (int a = 0; a < 2; ++a)
#pragma unroll
            for (int b = 0; b < 2; ++b)
#pragma unroll
                for (int m = 0; m < 4; ++m)
#pragma unroll
                    for (int n = 0; n < 2; ++n) acc[a][b][m][n] = (f32x4){0.f, 0.f, 0.f, 0.f};
        cur = nxt; cA = nA; cB = nB; ++ui;
        if constexpr (GATHER) PG8_GOFF(va, ubn);
        if constexpr (ALIGN_EPI) { if (wr == 1) PG8_BAR; }
    }
    PG8_WAIT_V(0);
    if constexpr (!ALIGN_EPI) { if (wr == 0) PG8_BAR; }
    PG8_BAR;
#undef PG8_SA
#undef PG8_GOFF
#undef PG8_SB
#undef PG8_STAGE
#undef PG8_LDA
#undef PG8_LDB
#undef PG8_MMA
#undef PG8_WAIT_V
#undef PG8_WAIT_L
#undef PG8_BAR
#undef PG8_SCHED
}
}

#define XB_TMO      128
#define XB_XCNT(j)  (256  + 64 * (j))
#define XB_XSUB(j)  (1280 + 64 * (j))
#define XB_XGEN(j)  (2304 + 64 * (j))
#define XB_TOP      3328
#define XB_TOPGEN   3392
#define XCD_BAR_WORDS 3456
#define XB_SPIN_CAP (1u << 18)
__device__ __forceinline__ unsigned xb_ld(unsigned* p)              { return __hip_atomic_load(p, __ATOMIC_RELAXED, __HIP_MEMORY_SCOPE_AGENT); }
__device__ __forceinline__ unsigned xb_add(unsigned* p, unsigned v) { return __hip_atomic_fetch_add(p, v, __ATOMIC_RELAXED, __HIP_MEMORY_SCOPE_AGENT); }
__device__ __forceinline__ unsigned xb_xcc_id() { return (unsigned)__builtin_amdgcn_s_getreg((3 << 11) | 20) & 0xFu; }
#define XB_SPIN(cond, bar) do { unsigned _sp = 0; while (cond) { __builtin_amdgcn_s_sleep(1); \
    if ((++_sp & 255u) == 0u) { if (xb_ld(&(bar)[XB_TMO])) break; if (_sp > XB_SPIN_CAP) { atomicAdd(&(bar)[XB_TMO], 1u); break; } } } } while (0)
struct XcdBarrier { unsigned* bar; unsigned x; volatile LAS unsigned* st; };
__device__ __forceinline__ XcdBarrier xcd_barrier_post(unsigned* bar, volatile LAS unsigned* st) {
    XcdBarrier b; b.bar = bar; b.x = xb_xcc_id(); b.st = st;
    if (threadIdx.x == 0) (void)xb_add(&bar[XB_XCNT(b.x)], 1u);
    return b;
}
__device__ __forceinline__ void xcd_barrier_complete(unsigned* bar, unsigned x, unsigned& nloc, unsigned& nx) {
    const unsigned G = gridDim.x * gridDim.y * gridDim.z;
    unsigned sum, cnt, mine, sp = 0u;
    for (;;) {
        sum = 0u; cnt = 0u; mine = 0u;
#pragma unroll
        for (unsigned j = 0; j < 16; ++j) { const unsigned c = xb_ld(&bar[XB_XCNT(j)]); sum += c; cnt += (c > 0u) ? 1u : 0u; mine = (j == x) ? c : mine; }
        if (sum == G) break;
        __builtin_amdgcn_s_sleep(1);
        if ((++sp & 255u) == 0u) { if (xb_ld(&bar[XB_TMO])) break; if (sp > XB_SPIN_CAP) { atomicAdd(&bar[XB_TMO], 1u); break; } }
    }
    nloc = mine > 0u ? mine : 1u; nx = cnt > 0u ? cnt : 1u;
}
__device__ __forceinline__ void xcd_barrier(const XcdBarrier& b) {
    asm volatile("s_waitcnt vmcnt(0)" ::: "memory");
    __syncthreads();
    if (threadIdx.x == 0) {
        unsigned* bar = b.bar;
        __builtin_amdgcn_s_waitcnt(0);
        unsigned nloc = b.st[0], nx = b.st[1];
        if (nloc == 0u) { xcd_barrier_complete(bar, b.x, nloc, nx); b.st[0] = nloc; b.st[1] = nx; }
        const unsigned old = xb_add(&bar[XB_XSUB(b.x)], 1u);
        const unsigned gen = old / nloc;
        if (old + 1u == (gen + 1u) * nloc) {
            __builtin_amdgcn_fence(__ATOMIC_RELEASE, "agent");
            asm volatile("s_waitcnt vmcnt(0)" ::: "memory");
            const unsigned og = xb_add(&bar[XB_TOP], 1u);
            const unsigned tg = og / nx;
            if (og + 1u == (tg + 1u) * nx) xb_add(&bar[XB_TOPGEN], 1u);
            else XB_SPIN(xb_ld(&bar[XB_TOPGEN]) == tg, bar);
            __builtin_amdgcn_fence(__ATOMIC_ACQUIRE, "agent");
            xb_add(&bar[XB_XGEN(b.x)], 1u);
            asm volatile("s_waitcnt vmcnt(0)" ::: "memory");
        } else {
            XB_SPIN(xb_ld(&bar[XB_XGEN(b.x)]) == gen, bar);
            __builtin_amdgcn_fence(__ATOMIC_ACQUIRE, "agent");
            asm volatile("s_waitcnt vmcnt(0)" ::: "memory");
        }
    }
    __syncthreads();
}

constexpr size_t MiB = 1u << 20;
constexpr size_t al(size_t x) { return (x + 4095) & ~(size_t)4095; }
constexpr size_t WS_CTL = 0, CTL_ZERO_BYTES = 1 * MiB;
constexpr int CW_BAR = 4096;
constexpr int CW_CNT = 16384;
constexpr int CW_NT = 16384 + 512;
constexpr size_t WS_MOD = 1 * MiB;
constexpr size_t WS_TILE_E = WS_MOD + 256 * 1024;
constexpr size_t WS_PADSTART = WS_TILE_E + 16 * 1024;
constexpr size_t WS_ROWTOK = 2 * MiB;
constexpr size_t WS_EIDX = 4 * MiB;
constexpr size_t WS_GATE = 5 * MiB;
constexpr size_t WS_DEST = 6 * MiB;
constexpr size_t WS_WIN = 8 * MiB;
constexpr size_t WS_WLORA = WS_WIN + al((size_t)NP * D * 2);
constexpr size_t WS_WBRRW = WS_WLORA + al((size_t)NLORA * KLORA * 2);
constexpr size_t WS_WBRGLA = WS_WBRRW + al((size_t)D * RWW * 2);
constexpr size_t WS_WOUT = WS_WBRGLA + al((size_t)D * RWW * 2);
constexpr size_t WS_WROUTER = WS_WOUT + al((size_t)D * D * 2);
constexpr size_t WS_WGU = WS_WROUTER + al((size_t)NE * D * 2);
constexpr size_t WS_WD = WS_WGU + al((size_t)(NE + 1) * 512 * D * 2);
constexpr size_t WS_PERSIST_END = WS_WD + al((size_t)(NE + 1) * D * FF * 2);
constexpr size_t WS_REGB = WS_PERSIST_END;
constexpr size_t SZ512F = al((size_t)MR * RWW * 4), SZ256F = al((size_t)MR * 256 * 4), SZ512H = al((size_t)MR * RWW * 2);
constexpr size_t WS_A1 = WS_REGB;
constexpr size_t WS_A2 = WS_A1;
constexpr size_t WS_KSUM = WS_A2 + al((size_t)MR * KLORA * 2);
static_assert(WS_KSUM + SZ512H <= WS_A1 + al((size_t)MR * D * 2), "A2 + KSUM fit in the A1 slot");
constexpr size_t WS_P = WS_A1 + al((size_t)MR * D * 2);
constexpr size_t WS_RB = WS_P + al((size_t)MR * NP * 2);
constexpr size_t WS_VB = WS_RB + SZ512H, WS_KKB = WS_VB + SZ512H, WS_KMF = WS_KKB + SZ512H, WS_KMB = WS_KMF + SZ512H, WS_BVF = WS_KMB + SZ512H, WS_BVB = WS_BVF + SZ512H;
constexpr size_t WS_LWF = WS_BVB + SZ512H, WS_LWB = WS_LWF + SZ512F;
constexpr size_t SZ256H = al((size_t)MR * 256 * 2);
constexpr size_t WS_QGB = WS_LWB + SZ512F, WS_KGB = WS_QGB + SZ256H, WS_VGB = WS_KGB + SZ256H, WS_LAF = WS_VGB + SZ512H, WS_LAB = WS_LAF + SZ256F;
constexpr size_t WS_RWG = WS_LAB + SZ256F;
constexpr size_t WS_ORWF = WS_RWG + SZ512H, WS_ORWB = WS_ORWF + SZ512H, WS_OGLF = WS_ORWB + SZ512H, WS_OGLB = WS_OGLF + SZ512H;
constexpr int CH = 64, NCHUNK = (CTXL + SEQ) / CH, NU_RW = 64 * NCHUNK, NU_GL = 32 * NCHUNK;
constexpr size_t WS_RH = WS_OGLB + SZ512H;
constexpr size_t WS_YL = WS_RH + al((size_t)NU_RW * 4096 * 2);
constexpr size_t WS_HH = WS_YL + al((size_t)NU_RW * 4096 * 2);
constexpr size_t WS_INTRA = WS_HH + al((size_t)NU_RW * 4096 * 2);
constexpr size_t WS_KV = WS_INTRA + al((size_t)NU_GL * 8192 * 2);
constexpr size_t WS_DD = WS_KV + al((size_t)NU_GL * 8192 * 2);
constexpr size_t WS_END_MIX = WS_DD + al((size_t)NU_GL * 64 * 4);
constexpr size_t OUT_GT = 0, OUT_QE = (size_t)NU_RW * 4096 * 2;
static_assert(OUT_QE + (size_t)NU_GL * 4096 * 2 <= (size_t)NLAT * D * 4, "scan scratch fits in d_out");
constexpr size_t WS_YRW = WS_LWF, WS_YGLA = WS_LWB, WS_Z = WS_HH;
static_assert((size_t)NLAT * D * 2 <= (size_t)NU_RW * 4096 * 2, "Z fits in the HH slot");
constexpr size_t WS_X1 = WS_REGB;
constexpr size_t WS_A3 = WS_X1 + al((size_t)NLAT * D * 4);
constexpr size_t WS_LOGITS = WS_A3 + al((size_t)NLAT * D * 2);
constexpr size_t WS_ACT = WS_LOGITS + al((size_t)NLAT * NE * 4);
constexpr size_t WS_Y = WS_ACT + al((size_t)NROWS_E * FF * 2);
constexpr size_t WS_END_MOE = WS_Y + al((size_t)NROWS_E * D);
constexpr size_t WS_END = WS_END_MIX > WS_END_MOE ? WS_END_MIX : WS_END_MOE;
static_assert(WS_END <= (size_t)2048 * MiB, "workspace map exceeds 2 GiB");

constexpr int RING_BYTES = 131072;
constexpr int IDX_BYTES = pg8::IDX_UNITS * 256 * 4;
constexpr int MISC_OFF = RING_BYTES + IDX_BYTES;
constexpr int LDS_BYTES = MISC_OFF + 256;
static_assert(pg8::IDX_OFF == RING_BYTES, "gather table sits right above the stage buffers");
constexpr int NWAVES = 8, NTHR = 512;

struct Args { const float* in[36]; float* out; unsigned char* ws; int ph_lo, ph_hi; };

struct Frame {
    LAS unsigned char* lds;
    int tid, lane, wave, G, gw, NGW;
    const float* const* in; float* out; unsigned char* ws; unsigned* ctl;
};

__device__ __forceinline__ float wave_sum(float v) {
#pragma unroll
    for (int o = 1; o < 64; o <<= 1) v += __shfl_xor(v, o);
    return v;
}
__device__ __forceinline__ unsigned f2bf(float f) { unsigned u = __builtin_bit_cast(unsigned, f); return (u + 0x7fffu + ((u >> 16) & 1u)) >> 16; }
typedef __bf16 bf16x2v __attribute__((ext_vector_type(2)));
__device__ __forceinline__ unsigned pk2(float lo, float hi) { const f32x2 v = {lo, hi}; return __builtin_bit_cast(unsigned, __builtin_convertvector(v, bf16x2v)); }
__device__ __forceinline__ float bflo(unsigned w) { return __builtin_bit_cast(float, w << 16); }
__device__ __forceinline__ float bfhi(unsigned w) { return __builtin_bit_cast(float, w & 0xffff0000u); }
__device__ __forceinline__ float sigmoidf_(float x) { return 1.0f / (1.0f + __expf(-x)); }
__device__ __forceinline__ float siluf_(float x) { return x / (1.0f + __expf(-x)); }

__device__ __forceinline__ void ln_stats(const f32x4 (&v)[4], float& mean, float& rstd) {
    float s = 0.f;
#pragma unroll
    for (int j = 0; j < 4; ++j) s += (v[j].x + v[j].y) + (v[j].z + v[j].w);
    mean = wave_sum(s) * (1.f / D); float s2 = 0.f;
#pragma unroll
    for (int j = 0; j < 4; ++j) { const f32x4 d = v[j] - mean; s2 += (d.x * d.x + d.y * d.y) + (d.z * d.z + d.w * d.w); }
    rstd = 1.f / sqrtf(wave_sum(s2) * (1.f / D) + LN_EPS);
}

__device__ __forceinline__ void ld_row_bf16(const bf16* row, int lane, f32x4 (&v)[4]) {
    const v4u a = *(const v4u*)(row + 8 * lane), b = *(const v4u*)(row + 512 + 8 * lane);
    v[0] = (f32x4){bflo(a.x), bfhi(a.x), bflo(a.y), bfhi(a.y)}; v[1] = (f32x4){bflo(a.z), bfhi(a.z), bflo(a.w), bfhi(a.w)};
    v[2] = (f32x4){bflo(b.x), bfhi(b.x), bflo(b.y), bfhi(b.y)}; v[3] = (f32x4){bflo(b.z), bfhi(b.z), bflo(b.w), bfhi(b.w)};
}
__device__ __forceinline__ int rowcol(int lane, int j) { return 512 * (j >> 1) + 8 * lane + 4 * (j & 1); }
__device__ __forceinline__ void ph_x1pre_nomix(Frame& F) {
    const float* x = F.in[0];
    for (int m = F.gw; m < NLAT; m += F.NGW) {
        bf16* o = (bf16*)(F.ws + WS_X1) + (size_t)m * D;
#pragma unroll
        for (int h = 0; h < 2; ++h) { const float* xr = x + (size_t)m * D + 512 * h + 8 * F.lane; const f32x4 a = *(const f32x4*)xr * ALPHA, b = *(const f32x4*)(xr + 4) * ALPHA;
            v4u w; w.x = pk2(a.x, a.y); w.y = pk2(a.z, a.w); w.z = pk2(b.x, b.y); w.w = pk2(b.z, b.w); *(v4u*)(o + 512 * h + 8 * F.lane) = w; }
    }
}
__device__ __forceinline__ void ph_ln1(Frame& F) {
    const float* lw = F.in[26]; const float* lb = F.in[27]; const float* mod = (const float*)(F.ws + WS_MOD);
    bf16* A3 = (bf16*)(F.ws + WS_A3); const bf16* X1P = (const bf16*)(F.ws + WS_X1);
    constexpr int NR = 4;
    for (int m0 = F.gw; m0 < NLAT; m0 += NR * F.NGW) {
        v4u w[NR][2];
#pragma unroll
        for (int r = 0; r < NR; ++r) { const int mm = m0 + r * F.NGW; const bf16* row = X1P + (size_t)(mm < NLAT ? mm : m0) * D; w[r][0] = *(const v4u*)(row + 8 * F.lane); w[r][1] = *(const v4u*)(row + 512 + 8 * F.lane); }
        __builtin_amdgcn_sched_barrier(0);
#pragma unroll
        for (int r = 0; r < NR; ++r) { const int mm = m0 + r * F.NGW; const int m = mm < NLAT ? mm : m0; const int b = m / SEQ;
            f32x4 v[4];
            v[0] = (f32x4){bflo(w[r][0].x), bfhi(w[r][0].x), bflo(w[r][0].y), bfhi(w[r][0].y)}; v[1] = (f32x4){bflo(w[r][0].z), bfhi(w[r][0].z), bflo(w[r][0].w), bfhi(w[r][0].w)};
            v[2] = (f32x4){bflo(w[r][1].x), bfhi(w[r][1].x), bflo(w[r][1].y), bfhi(w[r][1].y)}; v[3] = (f32x4){bflo(w[r][1].z), bfhi(w[r][1].z), bflo(w[r][1].w), bfhi(w[r][1].w)};
            float mean, rstd; ln_stats(v, mean, rstd);
#if MS >= 2
            f32x4 h[4];
#pragma unroll
            for (int j = 0; j < 4; ++j) { const int c = rowcol(F.lane, j);
                const f32x4 x1 = (v[j] - mean) * rstd * *(const f32x4*)(lw + c) + *(const f32x4*)(lb + c);
                h[j] = x1 * (*(const f32x4*)(mod + b * 6144 + 4096 + c) + 1.0f) + *(const f32x4*)(mod + b * 6144 + 3072 + c); }
            bf16* ao = A3 + (size_t)m * D;
            { v4u o; o.x = pk2(h[0].x, h[0].y); o.y = pk2(h[0].z, h[0].w); o.z = pk2(h[1].x, h[1].y); o.w = pk2(h[1].z, h[1].w); *(v4u*)(ao + 8 * F.lane) = o;
              o.x = pk2(h[2].x, h[2].y); o.y = pk2(h[2].z, h[2].w); o.z = pk2(h[3].x, h[3].y); o.w = pk2(h[3].z, h[3].w); *(v4u*)(ao + 512 + 8 * F.lane) = o; }
#endif
        }
    }
}
__device__ __forceinline__ f32x4 fp8x4(unsigned w) { const f32x2 lo = __builtin_amdgcn_cvt_pk_f32_fp8((int)w, false), hi = __builtin_amdgcn_cvt_pk_f32_fp8((int)w, true); return (f32x4){lo.x, lo.y, hi.x, hi.y}; }
__device__ __forceinline__ void ph_final(Frame& F) {
    const float* lw = F.in[34]; const float* lb = F.in[35]; const float* mod = (const float*)(F.ws + WS_MOD);
    const float* lw1 = F.in[26]; const float* lb1 = F.in[27]; const bf16* X1P = (const bf16*)(F.ws + WS_X1);
    const unsigned char* Y = F.ws + WS_Y; const int* DEST = (const int*)(F.ws + WS_DEST); const float* GATE = (const float*)(F.ws + WS_GATE);
    const int c0 = 16 * F.lane;
    for (int m0 = F.gw; m0 < NLAT; m0 += 2 * F.NGW) {
        int mm[2]; mm[0] = m0; mm[1] = (m0 + F.NGW < NLAT) ? m0 + F.NGW : m0;
        v4u xw[2][2];
#if MS >= 2
        v4u dw[2][2]; f32x4 gw[2][2];
#pragma unroll
        for (int r = 0; r < 2; ++r) { dw[r][0] = *(const v4u*)(DEST + mm[r] * 8); dw[r][1] = *(const v4u*)(DEST + mm[r] * 8 + 4); gw[r][0] = *(const f32x4*)(GATE + mm[r] * 8); gw[r][1] = *(const f32x4*)(GATE + mm[r] * 8 + 4); }
#endif
#pragma unroll
        for (int r = 0; r < 2; ++r) { const bf16* row = X1P + (size_t)mm[r] * D + c0; xw[r][0] = *(const v4u*)row; xw[r][1] = *(const v4u*)(row + 8); }
#if MS >= 2
        v4u yw[2][TOPK + 1];
#pragma unroll
        for (int r = 0; r < 2; ++r) {
            int dr[TOPK]; dr[0] = (int)dw[r][0].x; dr[1] = (int)dw[r][0].y; dr[2] = (int)dw[r][0].z; dr[3] = (int)dw[r][0].w; dr[4] = (int)dw[r][1].x; dr[5] = (int)dw[r][1].y; dr[6] = (int)dw[r][1].z; dr[7] = (int)dw[r][1].w;
#pragma unroll
            for (int k = 0; k <= TOPK; ++k) yw[r][k] = *(const v4u*)(Y + (size_t)(k < TOPK ? dr[k < TOPK ? k : 0] : SH_ROW0 + mm[r]) * D + c0); }
        __builtin_amdgcn_sched_barrier(0);
#endif
#pragma unroll
        for (int r = 0; r < 2; ++r) { const int m = mm[r]; const int b = m / SEQ;
            f32x4 v[4];
            v[0] = (f32x4){bflo(xw[r][0].x), bfhi(xw[r][0].x), bflo(xw[r][0].y), bfhi(xw[r][0].y)}; v[1] = (f32x4){bflo(xw[r][0].z), bfhi(xw[r][0].z), bflo(xw[r][0].w), bfhi(xw[r][0].w)};
            v[2] = (f32x4){bflo(xw[r][1].x), bfhi(xw[r][1].x), bflo(xw[r][1].y), bfhi(xw[r][1].y)}; v[3] = (f32x4){bflo(xw[r][1].z), bfhi(xw[r][1].z), bflo(xw[r][1].w), bfhi(xw[r][1].w)};
            { float mean1, rstd1; ln_stats(v, mean1, rstd1);
#pragma unroll
              for (int j = 0; j < 4; ++j) { const int c = c0 + 4 * j; v[j] = ((v[j] - mean1) * rstd1 * *(const f32x4*)(lw1 + c) + *(const f32x4*)(lb1 + c)) * ALPHA; } }
#if MS >= 2
            const float gt[TOPK] = {gw[r][0].x * 0.0625f, gw[r][0].y * 0.0625f, gw[r][0].z * 0.0625f, gw[r][0].w * 0.0625f, gw[r][1].x * 0.0625f, gw[r][1].y * 0.0625f, gw[r][1].z * 0.0625f, gw[r][1].w * 0.0625f};
#pragma unroll
            for (int j = 0; j < 4; ++j) { const unsigned ws8 = j == 0 ? yw[r][TOPK].x : (j == 1 ? yw[r][TOPK].y : (j == 2 ? yw[r][TOPK].z : yw[r][TOPK].w));
                f32x4 mo = fp8x4(ws8) * 0.0625f;
#pragma unroll
                for (int k = 0; k < TOPK; ++k) { const unsigned wk = j == 0 ? yw[r][k].x : (j == 1 ? yw[r][k].y : (j == 2 ? yw[r][k].z : yw[r][k].w)); mo += fp8x4(wk) * gt[k]; }
                v[j] += *(const f32x4*)(mod + b * 6144 + 5120 + c0 + 4 * j) * mo; }
#endif
            float mean, rstd; ln_stats(v, mean, rstd);
            float* o = F.out + (size_t)m * D + c0;
#pragma unroll
            for (int j = 0; j < 4; ++j) { const int c = c0 + 4 * j; *(f32x4*)(o + 4 * j) = (v[j] - mean) * rstd * *(const f32x4*)(lw + c) + *(const f32x4*)(lb + c); }
        }
    }
}


#if MS >= 2
template <int MODE>
__device__ __forceinline__ void cvt_item(const float* W, int Nsrc, int nblk, bf16* WT, int row_off, int dpitch, LAS float* scr, int item, int lane) {
    const int kb = item / nblk, nb = item - kb * nblk, k0 = 64 * kb, n0 = 32 * nb;
    const int nn = n0 + (lane & 31);
#pragma unroll 8
    for (int i = 0; i < 32; ++i) { const int kk = 2 * i + (lane >> 5); scr[kk * 33 + (lane & 31)] = (nn < Nsrc) ? W[(size_t)(k0 + kk) * Nsrc + nn] : 0.f; }
    LDS_WAIT(); asm volatile("" ::: "memory");
    const int c = lane & 7;
#pragma unroll
    for (int j = 0; j < 4; ++j) { const int n = (lane >> 3) + 8 * j; const LAS float* s = scr + (8 * c) * 33 + n;
        v4u o; o.x = pk2(s[0 * 33], s[1 * 33]); o.y = pk2(s[2 * 33], s[3 * 33]); o.z = pk2(s[4 * 33], s[5 * 33]); o.w = pk2(s[6 * 33], s[7 * 33]);
        const int ng = n0 + n; int dr = ng;
        if (MODE == 1) { const int i2 = ng & 255; dr = 8 * (i2 >> 2) + (i2 & 3) + ((ng >= 256) ? 4 : 0); }
        *(v4u*)(WT + (size_t)(row_off + dr) * dpitch + k0 + 8 * c) = o; }
    LDS_WAIT(); asm volatile("" ::: "memory");
}

template <int MODE>
__device__ __forceinline__ void cvt_item_reg(const float* W, int Nsrc, bf16* WT, int row_off, int dpitch, int k0, int n0, int lane) {
    const float* src = W + (size_t)k0 * Nsrc + n0 + 4 * lane;
    f32x4 v[32];
#pragma unroll
    for (int i = 0; i < 32; ++i) v[i] = __builtin_nontemporal_load((const f32x4*)(src + (size_t)i * Nsrc));
#pragma unroll
    for (int j = 0; j < 4; ++j) {
        const int ng = n0 + 4 * lane + j; int dr = ng;
        if (MODE == 1) { const int i2 = ng & 255; dr = 8 * (i2 >> 2) + (i2 & 3) + ((ng >= 256) ? 4 : 0); }
        v4u* dst = (v4u*)(WT + (size_t)(row_off + dr) * dpitch + k0);
#pragma unroll
        for (int q = 0; q < 4; ++q) { v4u o; o.x = pk2(v[8 * q][j], v[8 * q + 1][j]); o.y = pk2(v[8 * q + 2][j], v[8 * q + 3][j]); o.z = pk2(v[8 * q + 4][j], v[8 * q + 5][j]); o.w = pk2(v[8 * q + 6][j], v[8 * q + 7][j]); dst[q] = o; }
    }
}

constexpr int CVK = 32;
__device__ __forceinline__ void cvt_reg_load(const float* W, int Nsrc, int k0, int n0, int lane, f32x4 (&v)[CVK]) {
    const float* src = W + (size_t)k0 * Nsrc + n0 + 4 * lane;
#pragma unroll
    for (int i = 0; i < CVK; ++i) v[i] = __builtin_nontemporal_load((const f32x4*)(src + (size_t)i * Nsrc));
}
template <int MODE>
__device__ __forceinline__ void cvt_reg_store(bf16* WT, int row_off, int dpitch, int k0, int n0, int lane, const f32x4 (&v)[CVK]) {
#pragma unroll
    for (int j = 0; j < 4; ++j) {
        const int ng = n0 + 4 * lane + j; int dr = ng;
        if (MODE == 1) { const int i2 = ng & 255; dr = 8 * (i2 >> 2) + (i2 & 3) + ((ng >= 256) ? 4 : 0); }
        v4u* dst = (v4u*)(WT + (size_t)(row_off + dr) * dpitch + k0);
#pragma unroll
        for (int q = 0; q < CVK / 8; ++q) { v4u o; o.x = pg8::cvt_pk_bf16(v[8 * q][j], v[8 * q + 1][j]); o.y = pg8::cvt_pk_bf16(v[8 * q + 2][j], v[8 * q + 3][j]); o.z = pg8::cvt_pk_bf16(v[8 * q + 4][j], v[8 * q + 5][j]); o.w = pg8::cvt_pk_bf16(v[8 * q + 6][j], v[8 * q + 7][j]); dst[q] = o; }
    }
}
constexpr int CV_GU = (D / CVK) * 2, CV_DN = (FF / CVK) * 4, CV_NGU = (NE + 1) * CV_GU, CV_NITEM = CV_NGU + (NE + 1) * CV_DN;
__device__ __forceinline__ void cvx_load(const float* const* in, int it, int lane, f32x4 (&v)[CVK]) {
    if (it < CV_NGU) { const int e = it / CV_GU, ii = it - e * CV_GU; const float* src = (e < NE) ? in[30] + (size_t)e * D * 512 : in[32];
        cvt_reg_load(src, 512, CVK * (ii >> 1), 256 * (ii & 1), lane, v); }
    else { const int r = it - CV_NGU, e = r / CV_DN, ii = r - e * CV_DN; const float* src = (e < NE) ? in[31] + (size_t)e * FF * D : in[33];
        cvt_reg_load(src, D, CVK * (ii >> 2), 256 * (ii & 3), lane, v); }
}
__device__ __forceinline__ void cvx_store(unsigned char* ws, int it, int lane, const f32x4 (&v)[CVK]) {
    if (it < CV_NGU) { const int e = it / CV_GU, ii = it - e * CV_GU; cvt_reg_store<1>((bf16*)(ws + WS_WGU), e * 512, D, CVK * (ii >> 1), 256 * (ii & 1), lane, v); }
    else { const int r = it - CV_NGU, e = r / CV_DN, ii = r - e * CV_DN; cvt_reg_store<0>((bf16*)(ws + WS_WD), e * D, FF, CVK * (ii >> 2), 256 * (ii & 3), lane, v); }
}

#if MS >= 3
__device__ __forceinline__ float lora_val(const float* const* in, int n, int k) {
    if (n < 1024) { const int q = n >> 3, e8 = n & 7, dir = e8 >> 2, ch = q * 4 + (e8 & 3); return (k < 32) ? in[9][(size_t)(dir * 32 + k) * 512 + ch] : 0.f; }
    if (n < 2048) { const int m = n - 1024, q = m >> 3, e8 = m & 7, dir = e8 >> 2, ch = q * 4 + (e8 & 3); return (k >= 32 && k < 64) ? in[11][(size_t)(dir * 32 + (k - 32)) * 512 + ch] : 0.f; }
    if (n < 2560) { const int ch = n - 2048; return (k >= 64 && k < 160) ? in[12][(size_t)(k - 64) * 512 + ch] : 0.f; }
    { const int m = n - 2560, q = m >> 3, e8 = m & 7, dir = e8 >> 2, ch = q * 4 + (e8 & 3); return (k >= 160 && k < 176) ? in[19][(size_t)(dir * 16 + (k - 160)) * 256 + ch] : 0.f; }
}
#endif

__device__ __forceinline__ void ph_prologue(Frame& F) {
    {
        const float* c = F.in[1]; const float* cc = F.in[3]; const float* wa = F.in[4]; const float* ba = F.in[5];
        float* MOD = (float*)(F.ws + WS_MOD);
        LAS float* S = (LAS float*)F.lds; LAS float* red = (LAS float*)(F.lds + 32768);
        for (int it = blockIdx.x; it < 96; it += F.G) {
            for (int i = F.tid; i < 5120; i += NTHR) { const int r = i >> 10, k = i & 1023; const float cv = r < 4 ? c[r * 1024 + k] : cc[k]; S[i] = siluf_(cv); }
            __syncthreads();
            const int n = it * 64 + F.lane; float acc[5] = {0.f, 0.f, 0.f, 0.f, 0.f};
            for (int kk = 0; kk < 128; ++kk) { const int k = F.wave * 128 + kk; const float wv = wa[(size_t)k * 6144 + n];
#pragma unroll
                for (int r = 0; r < 5; ++r) acc[r] += S[r * 1024 + k] * wv; }
#pragma unroll
            for (int r = 0; r < 5; ++r) red[(F.wave * 5 + r) * 64 + F.lane] = acc[r];
            __syncthreads();
            if (F.wave == 0) {
#pragma unroll
                for (int r = 0; r < 5; ++r) { float s = 0.f;
#pragma unroll
                    for (int w = 0; w < 8; ++w) s += red[(w * 5 + r) * 64 + F.lane];
                    MOD[r * 6144 + n] = s + ba[n]; }
            }
            __syncthreads();
        }
    }
    {
        LAS float* scr = (LAS float*)(F.lds + F.wave * 16384);
        constexpr int I_IN = 16 * 168, I_BR = 8 * 32, I_OUT = 16 * 32, I_RT = 16 * 8, I_GU = 32 * 2, I_DN = 8 * 4;
        constexpr int T0 = I_IN, T1 = T0 + I_BR, T2 = T1 + I_BR, T3 = T2 + I_OUT, T4 = T3 + I_RT, T5 = T4 + (NE + 1) * I_GU, T6 = T5 + (NE + 1) * I_DN;
        unsigned char* ws = F.ws;
        for (int it = F.gw; it < T6; it += F.NGW) {
#if MS >= 3
            if (it < T0) { cvt_item<0>(F.in[6], IN_COLS, 168, (bf16*)(ws + WS_WIN), 0, D, scr, it, F.lane); continue; }
            if (it < T1) { cvt_item<0>(F.in[23], D, 32, (bf16*)(ws + WS_WBRRW), 0, RWW, scr, it - T0, F.lane); continue; }
            if (it < T2) { cvt_item<0>(F.in[24], D, 32, (bf16*)(ws + WS_WBRGLA), 0, RWW, scr, it - T1, F.lane); continue; }
            if (it < T3) { cvt_item<0>(F.in[25], D, 32, (bf16*)(ws + WS_WOUT), 0, D, scr, it - T2, F.lane); continue; }
#else
            if (it < T3) continue;
#endif
            if (it < T4) { cvt_item<0>(F.in[28], NE, 8, (bf16*)(ws + WS_WROUTER), 0, D, scr, it - T3, F.lane); continue; }
#if MS >= 3
            break;
#endif
            if (it < T5) { const int r = it - T4, e = r / I_GU, ii = r - e * I_GU;
                const float* src = (e < NE) ? F.in[30] + (size_t)e * D * 512 : F.in[32];
                cvt_item_reg<1>(src, 512, (bf16*)(ws + WS_WGU), e * 512, D, 32 * (ii >> 1), 256 * (ii & 1), F.lane); continue; }
            { const int r = it - T5, e = r / I_DN, ii = r - e * I_DN;
                const float* src = (e < NE) ? F.in[31] + (size_t)e * FF * D : F.in[33];
                cvt_item_reg<0>(src, D, (bf16*)(ws + WS_WD), e * D, FF, 32 * (ii >> 2), 256 * (ii & 3), F.lane); }
        }
    }
#if MS >= 3
    {
        bf16* WL = (bf16*)(F.ws + WS_WLORA);
        for (int idx = blockIdx.x * NTHR + F.tid; idx < NLORA * (KLORA / 8); idx += F.G * NTHR) {
            const int n = idx >> 5, k0 = (idx & 31) * 8; float v[8];
#pragma unroll
            for (int e = 0; e < 8; ++e) v[e] = lora_val(F.in, n, k0 + e);
            v4u o; o.x = pk2(v[0], v[1]); o.y = pk2(v[2], v[3]); o.z = pk2(v[4], v[5]); o.w = pk2(v[6], v[7]);
            *(v4u*)(WL + (size_t)n * KLORA + k0) = o;
        }
    }
#endif
}

struct EpiF32 {
    static constexpr bool PERM = false;
    float* C; int ldc;
    __device__ __forceinline__ void operator()(const f32x4 (&acc)[2][2][4][2], const pg8::Unit& u, int wr, int wc, int fr, int fq) const {
        const int row0 = u.pm * 256 + wr * 64 + fr, col0 = u.pn * 256 + wc * 32 + 4 * fq;
#pragma unroll
        for (int ai = 0; ai < 2; ++ai)
#pragma unroll
            for (int m = 0; m < 4; ++m) { float* rowp = C + (size_t)(row0 + ai * 128 + m * 16) * ldc + col0;
#pragma unroll
                for (int bj = 0; bj < 2; ++bj)
#pragma unroll
                    for (int n = 0; n < 2; ++n) *(f32x4*)(rowp + bj * 128 + n * 16) = acc[ai][bj][m][n]; }
    }
};
struct EpiSwiglu {
    static constexpr bool PERM = true;
    bf16* ACT;
    __device__ __forceinline__ void operator()(const f32x4 (&acc)[2][2][4][2], const pg8::Unit& u, int wr, int wc, int fr, int fq) const {
        const int row0 = u.pm * 256 + wr * 64 + fr, h0 = u.j * 128 + wc * 16 + 4 * fq;
#pragma unroll
        for (int ai = 0; ai < 2; ++ai)
#pragma unroll
            for (int m = 0; m < 4; ++m) { bf16* rowp = ACT + (size_t)(row0 + ai * 128 + m * 16) * FF + h0;
#pragma unroll
                for (int bj = 0; bj < 2; ++bj) { const f32x4 a = acc[ai][bj][m][0], b = acc[ai][bj][m][1];
                    v2u o; o.x = pg8::cvt_pk_bf16(siluf_(a[0]) * b[0], siluf_(a[1]) * b[1]); o.y = pg8::cvt_pk_bf16(siluf_(a[2]) * b[2], siluf_(a[3]) * b[3]);
                    *(v2u*)(rowp + bj * 64) = o; } }
    }
};
struct EpiRowsBf16 {
    static constexpr bool PERM = true;
    bf16* O; int ldc;
    __device__ __forceinline__ void operator()(const f32x4 (&acc)[2][2][4][2], const pg8::Unit& u, int wr, int wc, int fr, int fq) const {
        const int row0 = u.pm * 256 + wr * 64 + fr, col0 = u.j * 256 + wc * 32 + 8 * fq;
#pragma unroll
        for (int ai = 0; ai < 2; ++ai)
#pragma unroll
            for (int m = 0; m < 4; ++m) { bf16* rowp = O + (size_t)(row0 + ai * 128 + m * 16) * ldc + col0;
#pragma unroll
                for (int bj = 0; bj < 2; ++bj) { const f32x4 v0 = acc[ai][bj][m][0], v1 = acc[ai][bj][m][1];
                    v4u w; w.x = pg8::cvt_pk_bf16(v0[0], v0[1]); w.y = pg8::cvt_pk_bf16(v0[2], v0[3]); w.z = pg8::cvt_pk_bf16(v1[0], v1[1]); w.w = pg8::cvt_pk_bf16(v1[2], v1[3]);
                    *(v4u*)(rowp + bj * 128) = w; } }
    }
};

struct EpiRowsFp8 {
    static constexpr bool PERM = true;
    unsigned char* O;
    __device__ __forceinline__ void operator()(const f32x4 (&acc)[2][2][4][2], const pg8::Unit& u, int wr, int wc, int fr, int fq) const {
        const int row0 = u.pm * 256 + wr * 64 + fr, col0 = u.j * 256 + wc * 32 + 8 * fq;
#pragma unroll
        for (int ai = 0; ai < 2; ++ai)
#pragma unroll
            for (int m = 0; m < 4; ++m) { unsigned char* rowp = O + (size_t)(row0 + ai * 128 + m * 16) * D + col0;
#pragma unroll
                for (int bj = 0; bj < 2; ++bj) { const f32x4 v0 = acc[ai][bj][m][0] * 16.0f, v1 = acc[ai][bj][m][1] * 16.0f;
                    int w0 = __builtin_amdgcn_cvt_pk_fp8_f32(v0[0], v0[1], 0, false); w0 = __builtin_amdgcn_cvt_pk_fp8_f32(v0[2], v0[3], w0, true);
                    int w1 = __builtin_amdgcn_cvt_pk_fp8_f32(v1[0], v1[1], 0, false); w1 = __builtin_amdgcn_cvt_pk_fp8_f32(v1[2], v1[3], w1, true);
                    v2u w; w.x = (unsigned)w0; w.y = (unsigned)w1; *(v2u*)(rowp + bj * 128) = w; } }
    }
};

__device__ __forceinline__ void ph_router(Frame& F) {
    pg8::Gemm g{(const bf16*)(F.ws + WS_A3), (const bf16*)(F.ws + WS_WROUTER), NLAT, NE, D, nullptr};
    pg8::StaticOrder S; S.init(NLAT, NE, F.G, (int)blockIdx.x);
    EpiF32 E{(float*)(F.ws + WS_LOGITS), NE};
    pg8::gemm_phase<EpiF32, pg8::StaticOrder, true, true, false>(F.lds, g, S, E);
}

__device__ __forceinline__ void ph_route(Frame& F) {
    const float* LOG = (const float*)(F.ws + WS_LOGITS); const float* rb = F.in[29];
    int* EIDX = (int*)(F.ws + WS_EIDX); float* GATE = (float*)(F.ws + WS_GATE); int* DEST = (int*)(F.ws + WS_DEST);
    unsigned* CNT = F.ctl + CW_CNT;
    const f32x4 bias = *(const f32x4*)(rb + 4 * F.lane);
    const float NEG = -3.0e38f;
    f32x4 lgn = *(const f32x4*)(LOG + (size_t)(F.gw < NLAT ? F.gw : 0) * NE + 4 * F.lane);
    for (int m = F.gw; m < NLAT; m += F.NGW) {
        const f32x4 lg = lgn;
        { const int mn = (m + F.NGW < NLAT) ? m + F.NGW : m; lgn = *(const f32x4*)(LOG + (size_t)mn * NE + 4 * F.lane); }
        float sc[4], sel[4];
#pragma unroll
        for (int i = 0; i < 4; ++i) { sc[i] = sigmoidf_(lg[i]); sel[i] = sc[i] + bias[i]; }
        float m1 = fmaxf(sel[0], sel[1]), m2 = fminf(sel[0], sel[1]);
        { const float a = sel[2]; const float n1 = fmaxf(m1, a); m2 = fmaxf(m2, fminf(m1, a)); m1 = n1; }
        { const float a = sel[3]; const float n1 = fmaxf(m1, a); m2 = fmaxf(m2, fminf(m1, a)); m1 = n1; }
#pragma unroll
        for (int o = 1; o < 8; o <<= 1) { const float b1 = __shfl_xor(m1, o), b2 = __shfl_xor(m2, o); const float n1 = fmaxf(m1, b1); m2 = fmaxf(fminf(m1, b1), fmaxf(m2, b2)); m1 = n1; }
        const float gs = m1 + m2; const int g = F.lane >> 3;
        int rank = 0;
#pragma unroll
        for (int gg = 0; gg < 8; ++gg) { const float og = __shfl(gs, gg * 8); rank += (og > gs || (og == gs && gg < g)) ? 1 : 0; }
        const bool keep = rank < 4;
#pragma unroll
        for (int i = 0; i < 4; ++i) sel[i] = keep ? sel[i] : NEG;
        int my_e = 0; float my_s = 0.f; float ssum = 0.f;
        for (int k = 0; k < TOPK; ++k) {
            float bv = sel[0]; int bi = 0;
#pragma unroll
            for (int i = 1; i < 4; ++i) if (sel[i] > bv) { bv = sel[i]; bi = i; }
            int be = 4 * F.lane + bi; float v = bv; int e = be;
#pragma unroll
            for (int o = 1; o < 64; o <<= 1) { const float ov = __shfl_xor(v, o); const int oe = __shfl_xor(e, o); if (ov > v || (ov == v && oe < e)) { v = ov; e = oe; } }
            const int owner = e >> 2, oi = e & 3;
            float s_own = 0.f;
            if (F.lane == owner) {
#pragma unroll
                for (int i = 0; i < 4; ++i) if (i == oi) { s_own = sc[i]; sel[i] = NEG; }
            }
            const float s = __shfl(s_own, owner);
            ssum += s;
            if (F.lane == k) { my_e = e; my_s = s; }
        }
        if (F.lane < TOPK) {
            const unsigned pos = __hip_atomic_fetch_add(CNT + my_e, 1u, __ATOMIC_RELAXED, __HIP_MEMORY_SCOPE_AGENT);
            EIDX[m * 8 + F.lane] = my_e; GATE[m * 8 + F.lane] = my_s / ssum * 2.5f; DEST[m * 8 + F.lane] = (int)pos;
        }
    }
}

__device__ __forceinline__ void ph_scatter(Frame& F) {
    LAS int* tstart = (LAS int*)F.lds;
    LAS int* scan = (LAS int*)(F.lds + 2048);
    LAS int* cnts = (LAS int*)(F.lds + 4096);
    int* EIDX = (int*)(F.ws + WS_EIDX); int* DEST = (int*)(F.ws + WS_DEST); int* ROWTOK = (int*)(F.ws + WS_ROWTOK); int* TILE_E = (int*)(F.ws + WS_TILE_E);
    unsigned* CNT = F.ctl + CW_CNT;
    int tiles = 0, cnt = 0;
    if (F.tid < NE) { cnt = (int)__hip_atomic_load(CNT + F.tid, __ATOMIC_RELAXED, __HIP_MEMORY_SCOPE_AGENT); tiles = (cnt + 255) >> 8; scan[F.tid] = tiles; cnts[F.tid] = cnt; }
    __syncthreads();
    for (int o = 1; o < NE; o <<= 1) { int v = 0; if (F.tid < NE && F.tid >= o) v = scan[F.tid - o]; __syncthreads(); if (F.tid < NE) scan[F.tid] += v; __syncthreads(); }
    if (F.tid < NE) { tstart[F.tid + 1] = scan[F.tid]; if (F.tid == 0) tstart[0] = 0; }
    __syncthreads();
    const int NT = tstart[NE];
    if (blockIdx.x == 0) {
        if (F.tid == 0) F.ctl[CW_NT] = (unsigned)NT;
        if (F.tid < NE) for (int t = tstart[F.tid]; t < tstart[F.tid + 1]; ++t) TILE_E[t] = F.tid;
    }
    for (int e = blockIdx.x; e < NE; e += F.G) { const int c0 = cnts[e], c1 = (tstart[e + 1] - tstart[e]) * 256, base = tstart[e] * 256;
        for (int p = c0 + F.tid; p < c1; p += NTHR) ROWTOK[base + p] = 0; }
    for (int i = blockIdx.x * NTHR + F.tid; i < NLAT; i += F.G * NTHR) ROWTOK[SH_ROW0 + i] = i;
    for (int i = blockIdx.x * NTHR + F.tid; i < NLAT * TOPK; i += F.G * NTHR) {
        const int e = EIDX[i], pos = DEST[i]; const int dr = tstart[e] * 256 + pos;
        DEST[i] = dr; ROWTOK[dr] = i >> 3;
    }
}

__device__ __forceinline__ void ph_exp1(Frame& F) {
    const int NT = (int)__hip_atomic_load(F.ctl + CW_NT, __ATOMIC_RELAXED, __HIP_MEMORY_SCOPE_AGENT);
    pg8::Gemm g{(const bf16*)(F.ws + WS_A3), (const bf16*)(F.ws + WS_WGU), 0, 0, D, (const int*)(F.ws + WS_ROWTOK)};
    pg8::MoeOrder S{2, F.G, (int)blockIdx.x, NT, (const int*)(F.ws + WS_TILE_E)};
    EpiSwiglu E{(bf16*)(F.ws + WS_ACT)};
    pg8::gemm_phase<EpiSwiglu, pg8::MoeOrder, true, true, true>(F.lds, g, S, E);
}
__device__ __forceinline__ void ph_exp2(Frame& F) {
    const int NT = (int)__hip_atomic_load(F.ctl + CW_NT, __ATOMIC_RELAXED, __HIP_MEMORY_SCOPE_AGENT);
    pg8::Gemm g{(const bf16*)(F.ws + WS_ACT), (const bf16*)(F.ws + WS_WD), 0, 0, FF, nullptr};
    pg8::MoeOrder S{4, F.G, (int)blockIdx.x, NT, (const int*)(F.ws + WS_TILE_E)};
    EpiRowsFp8 E{F.ws + WS_Y};
    pg8::gemm_phase<EpiRowsFp8, pg8::MoeOrder, true, true, false>(F.lds, g, S, E);
}
#endif

#if MS >= 3
__device__ __forceinline__ void unp8(const v4u w, float (&f)[8]) { f[0] = bflo(w.x); f[1] = bfhi(w.x); f[2] = bflo(w.y); f[3] = bfhi(w.y); f[4] = bflo(w.z); f[5] = bfhi(w.z); f[6] = bflo(w.w); f[7] = bfhi(w.w); }
__device__ __forceinline__ v4u pk8(const float (&f)[8]) { v4u o; o.x = pk2(f[0], f[1]); o.y = pk2(f[2], f[3]); o.z = pk2(f[4], f[5]); o.w = pk2(f[6], f[7]); return o; }
__device__ __forceinline__ void st8(float* p, const float (&f)[8]) { *(f32x4*)p = (f32x4){f[0], f[1], f[2], f[3]}; *(f32x4*)(p + 4) = (f32x4){f[4], f[5], f[6], f[7]}; }
__device__ __forceinline__ void ld8(const float* p, float (&f)[8]) { const f32x4 a = *(const f32x4*)p, b = *(const f32x4*)(p + 4); f[0] = a.x; f[1] = a.y; f[2] = a.z; f[3] = a.w; f[4] = b.x; f[5] = b.y; f[6] = b.z; f[7] = b.w; }

__device__ __forceinline__ void ph_a1(Frame& F) {
    const float* mod = (const float*)(F.ws + WS_MOD); bf16* A1 = (bf16*)(F.ws + WS_A1);
    constexpr int NR = 4;
    for (int m0 = F.gw; m0 < MR; m0 += NR * F.NGW) {
        f32x4 xv[NR][4];
#pragma unroll
        for (int r = 0; r < NR; ++r) { const int mm = m0 + r * F.NGW; const int m = mm < MR ? mm : m0;
            const float* src = (m < NLAT) ? F.in[0] + (size_t)m * D : F.in[2] + (size_t)(m - NLAT) * D;
            const f32x4* xr = (const f32x4*)src + F.lane;
#pragma unroll
            for (int j = 0; j < 4; ++j) xv[r][j] = __builtin_nontemporal_load(xr + 64 * j); }
        __builtin_amdgcn_sched_barrier(0);
#pragma unroll
        for (int r = 0; r < NR; ++r) { const int mm = m0 + r * F.NGW; const int m = mm < MR ? mm : m0; const int mr = (m < NLAT) ? (m / SEQ) : 4;
            v2u* ao = (v2u*)(A1 + (size_t)m * D) + F.lane;
#pragma unroll
            for (int j = 0; j < 4; ++j) { const int c = 4 * F.lane + 256 * j;
                const f32x4 sh = *(const f32x4*)(mod + mr * 6144 + c), sc = *(const f32x4*)(mod + mr * 6144 + 1024 + c);
                const f32x4 h = xv[r][j] * (sc + 1.0f) + sh; v2u o; o.x = pk2(h.x, h.y); o.y = pk2(h.z, h.w); ao[64 * j] = o; } }
    }
}

__device__ __forceinline__ void ph_inproj(Frame& F) {
    pg8::Gemm g{(const bf16*)(F.ws + WS_A1), (const bf16*)(F.ws + WS_WIN), MR, NP, D, nullptr};
    pg8::StaticOrder S; S.init(MR, NP, F.G, (int)blockIdx.x);
    EpiRowsBf16 E{(bf16*)(F.ws + WS_P), NP};
    pg8::gemm_phase<EpiRowsBf16, pg8::StaticOrder, true, true, false>(F.lds, g, S, E);
}

__device__ __forceinline__ void ph_feat(Frame& F) {
    const bf16* P = (const bf16*)(F.ws + WS_P);
    const float* mu = F.in[7]; const float* kkw = F.in[13]; const float* cw = F.in[18];
    bf16* R = (bf16*)(F.ws + WS_RB); bf16* V = (bf16*)(F.ws + WS_VB); bf16* KK = (bf16*)(F.ws + WS_KKB); bf16* KP = (bf16*)(F.ws + WS_KMF);
    bf16* QG = (bf16*)(F.ws + WS_QGB); bf16* KGB = (bf16*)(F.ws + WS_KGB); bf16* VGB = (bf16*)(F.ws + WS_VGB);
    bf16* A2 = (bf16*)(F.ws + WS_A2);
    const int lane = F.lane;
    for (int m0 = F.gw; m0 < MR; m0 += 2 * F.NGW) {
        int mm[2]; mm[0] = m0; mm[1] = (m0 + F.NGW < MR) ? m0 + F.NGW : m0;
        int nb[2][4], gr[2], gc[2], tc[2]; bool lat[2];
#pragma unroll
        for (int r = 0; r < 2; ++r) { const int m = mm[r]; lat[r] = m < NLAT; gr[r] = 0; gc[r] = 0; tc[r] = 0;
            if (lat[r]) { const int t = m & (SEQ - 1); gr[r] = t >> 6; gc[r] = t & 63;
                nb[r][0] = gc[r] > 0 ? m - 1 : -1; nb[r][1] = gc[r] < 63 ? m + 1 : -1; nb[r][2] = gr[r] > 0 ? m - 64 : -1; nb[r][3] = gr[r] < 127 ? m + 64 : -1;
            } else { const int t = (m - NLAT) & (CTXL - 1); tc[r] = t; nb[r][0] = t > 0 ? m - 1 : -1; nb[r][1] = t < CTXL - 1 ? m + 1 : -1; nb[r][2] = nb[r][0]; nb[r][3] = nb[r][1]; } }
#pragma unroll
        for (int p = 0; p < 4; ++p) {
            const int cb = p * 512 + 8 * lane;
            const bool act = (p < 3) || lane < 20;
            v4u wo[2], wn[2][4];
#pragma unroll
            for (int r = 0; r < 2; ++r) { wo[r] = (v4u){0u, 0u, 0u, 0u};
#pragma unroll
                for (int q = 0; q < 4; ++q) wn[r][q] = (v4u){0u, 0u, 0u, 0u};
                if (act) { wo[r] = *(const v4u*)(P + (size_t)mm[r] * NP + cb);
#pragma unroll
                    for (int q = 0; q < 4; ++q) if (nb[r][q] >= 0) wn[r][q] = *(const v4u*)(P + (size_t)nb[r][q] * NP + cb); }
                else if (p == 3 && lane >= 20 && lane < 22) wo[r] = *(const v4u*)(P + (size_t)mm[r] * NP + C_PGL + 8 * (lane - 20)); }
            float muv[8] = {0.f, 0.f, 0.f, 0.f, 0.f, 0.f, 0.f, 0.f}; if (act) ld8(mu + cb, muv);
            __builtin_amdgcn_sched_barrier(0);
#pragma unroll
            for (int r = 0; r < 2; ++r) { const size_t m = (size_t)mm[r];
                if (act) {
                    float own[8], sh[4][8], val[8];
                    unp8(wo[r], own);
#pragma unroll
                    for (int q = 0; q < 4; ++q) unp8(wn[r][q], sh[q]);
#pragma unroll
                    for (int e = 0; e < 8; ++e) val[e] = own[e] + muv[e] * (sh[e & 3][e] - own[e]);
                    if (p == 0) *(v4u*)(R + m * RWW + 8 * lane) = pk8(val);
                    else if (p == 2) *(v4u*)(V + m * RWW + 8 * lane) = pk8(val);
                    else if (p == 1) {
                        *(v4u*)(KP + m * RWW + 8 * lane) = pk8(val);
                        float kw[8]; ld8(kkw + 8 * lane, kw); float kkv[8]; float ss = 0.f;
#pragma unroll
                        for (int e = 0; e < 8; ++e) { kkv[e] = val[e] * kw[e]; ss += kkv[e] * kkv[e]; }
                        ss += __shfl_xor(ss, 1); ss += __shfl_xor(ss, 2); ss += __shfl_xor(ss, 4);
                        const float inv = 1.0f / fmaxf(sqrtf(ss), 1e-12f);
#pragma unroll
                        for (int e = 0; e < 8; ++e) kkv[e] *= inv;
                        *(v4u*)(KK + m * RWW + 8 * lane) = pk8(kkv);
                    } else {
                        float o[8];
#pragma unroll
                        for (int e = 0; e < 8; ++e) o[e] = (lane < 4) ? tanhf(val[e]) : ((lane < 8) ? val[e] : sigmoidf_(val[e]));
                        *(v4u*)(A2 + m * KLORA + 8 * lane) = pk8(o);
                    }
                } else if (p == 3 && lane < 32) *(v4u*)(A2 + m * KLORA + 8 * lane) = wo[r];
            }
        }
#pragma unroll
        for (int p = 0; p < 2; ++p) {
            const int cq = p * 512 + 8 * lane; const int cb = C_Q + cq;
            v4u wp[2][9];
#pragma unroll
            for (int r = 0; r < 2; ++r)
#pragma unroll
                for (int dy = -1; dy <= 1; ++dy)
#pragma unroll
                    for (int dx = -1; dx <= 1; ++dx) { const int tp = (dy + 1) * 3 + dx + 1; bool ok; int nr;
                        if (lat[r]) { ok = (gr[r] + dy >= 0) && (gr[r] + dy < GRIDH) && (gc[r] + dx >= 0) && (gc[r] + dx < GRIDW); nr = mm[r] + dy * 64 + dx; }
                        else { ok = (dy == 0) && (tc[r] + dx >= 0) && (tc[r] + dx < CTXL); nr = mm[r] + dx; }
                        wp[r][tp] = (v4u){0u, 0u, 0u, 0u}; if (ok) wp[r][tp] = *(const v4u*)(P + (size_t)nr * NP + cb); }
            __builtin_amdgcn_sched_barrier(0);
            float acc[2][8];
#pragma unroll
            for (int r = 0; r < 2; ++r)
#pragma unroll
                for (int e = 0; e < 8; ++e) acc[r][e] = 0.f;
#pragma unroll
            for (int tp = 0; tp < 9; ++tp) { float wv[8]; ld8(cw + tp * 1024 + cq, wv);
#pragma unroll
                for (int r = 0; r < 2; ++r) { float pv[8]; unp8(wp[r][tp], pv);
#pragma unroll
                    for (int e = 0; e < 8; ++e) acc[r][e] += pv[e] * wv[e]; } }
#pragma unroll
            for (int r = 0; r < 2; ++r) { const size_t m = (size_t)mm[r]; float o[8];
#pragma unroll
                for (int e = 0; e < 8; ++e) o[e] = siluf_(acc[r][e]);
                if (p == 0) {
                    if (lane < 32) {
#pragma unroll
                        for (int e = 0; e < 8; ++e) o[e] *= 0.125f;
                        *(v4u*)(QG + m * 256 + cq) = pk8(o);
                    } else *(v4u*)(KGB + m * 256 + (cq - 256)) = pk8(o);
                } else *(v4u*)(VGB + m * RWW + (cq - 512)) = pk8(o); }
        }
    }
}

struct EpiLora {
    static constexpr bool PERM = true;
    unsigned char* ws; const float* const* in;
    __device__ __forceinline__ void grp_w(const f32x4 (&acc)[2][2][4][2], int row0, int c0) const {
        bf16* Wf = (bf16*)(ws + WS_LWF); bf16* Wb = (bf16*)(ws + WS_LWB);
#pragma unroll
        for (int bj = 0; bj < 2; ++bj) { const int ch = (c0 + bj * 128) >> 1; const f32x4 w0f = *(const f32x4*)(in[8] + ch), w0b = *(const f32x4*)(in[8] + 512 + ch);
#pragma unroll
            for (int ai = 0; ai < 2; ++ai)
#pragma unroll
                for (int m = 0; m < 4; ++m) { const size_t row = (size_t)(row0 + ai * 128 + m * 16);
                    const f32x4 xf = acc[ai][bj][m][0] + w0f, xb = acc[ai][bj][m][1] + w0b; f32x4 df, db;
#pragma unroll
                    for (int e = 0; e < 4; ++e) { df[e] = -0.60653066f * sigmoidf_(xf[e]); db[e] = -0.60653066f * sigmoidf_(xb[e]); }
                    { v2u o; o.x = pk2(df[0], df[1]); o.y = pk2(df[2], df[3]); *(v2u*)(Wf + row * RWW + ch) = o; o.x = pk2(db[0], db[1]); o.y = pk2(db[2], db[3]); *(v2u*)(Wb + row * RWW + ch) = o; } } }
    }
    __device__ __forceinline__ void grp_a(const f32x4 (&acc)[2][2][4][2], int row0, int c0) const {
        bf16* KMf = (bf16*)(ws + WS_KMF); bf16* KMb = (bf16*)(ws + WS_KMB); bf16* BVf = (bf16*)(ws + WS_BVF); bf16* BVb = (bf16*)(ws + WS_BVB);
        const bf16* KK = (const bf16*)(ws + WS_KKB); bf16* KSUM = (bf16*)(ws + WS_KSUM);
#pragma unroll
        for (int bj = 0; bj < 2; ++bj) { const int ch = (c0 + bj * 128 - 1024) >> 1; const f32x4 a0f = *(const f32x4*)(in[10] + ch), a0b = *(const f32x4*)(in[10] + 512 + ch), ka = *(const f32x4*)(in[14] + ch);
#pragma unroll
            for (int ai = 0; ai < 2; ++ai) {
            v2u kpw[2][4], kkw[2][4];
#pragma unroll
                for (int m = 0; m < 4; ++m) { const size_t row = (size_t)(row0 + ai * 128 + m * 16); kpw[ai][m] = *(const v2u*)(KMf + row * RWW + ch); kkw[ai][m] = *(const v2u*)(KK + row * RWW + ch); }
            __builtin_amdgcn_sched_barrier(0);
#pragma unroll
                for (int m = 0; m < 4; ++m) { const size_t row = (size_t)(row0 + ai * 128 + m * 16);
                    const f32x4 xf = acc[ai][bj][m][0] + a0f, xb = acc[ai][bj][m][1] + a0b;
                    const f32x4 kp = (f32x4){bflo(kpw[ai][m].x), bfhi(kpw[ai][m].x), bflo(kpw[ai][m].y), bfhi(kpw[ai][m].y)}, kk = (f32x4){bflo(kkw[ai][m].x), bfhi(kkw[ai][m].x), bflo(kkw[ai][m].y), bfhi(kkw[ai][m].y)};
                    f32x4 kmf, kmb, bvf, bvb;
#pragma unroll
                    for (int e = 0; e < 4; ++e) { const float af = sigmoidf_(xf[e]), ab = sigmoidf_(xb[e]);
                        kmf[e] = kp[e] * (1.0f + (af - 1.0f) * ka[e]); kmb[e] = kp[e] * (1.0f + (ab - 1.0f) * ka[e]); bvf[e] = kk[e] * af; bvb[e] = kk[e] * ab; }
                    { v2u o; o.x = pk2(kmf[0], kmf[1]); o.y = pk2(kmf[2], kmf[3]); *(v2u*)(KMf + row * RWW + ch) = o; o.x = pk2(kmb[0], kmb[1]); o.y = pk2(kmb[2], kmb[3]); *(v2u*)(KMb + row * RWW + ch) = o;
                      o.x = pk2(bvf[0], bvf[1]); o.y = pk2(bvf[2], bvf[3]); *(v2u*)(BVf + row * RWW + ch) = o; o.x = pk2(bvb[0], bvb[1]); o.y = pk2(bvb[2], bvb[3]); *(v2u*)(BVb + row * RWW + ch) = o; }
                    v2u ks; ks.x = pk2(kmf[0] + kmb[0], kmf[1] + kmb[1]); ks.y = pk2(kmf[2] + kmb[2], kmf[3] + kmb[3]); *(v2u*)(KSUM + row * RWW + ch) = ks; } } }
    }
    __device__ __forceinline__ void grp_g(const f32x4 (&acc)[2][2][4][2], int row0, int c0) const {
        bf16* RWG = (bf16*)(ws + WS_RWG);
#pragma unroll
        for (int bj = 0; bj < 2; ++bj) { const int ch = c0 + bj * 128 - 2048;
#pragma unroll
            for (int ai = 0; ai < 2; ++ai)
#pragma unroll
                for (int m = 0; m < 4; ++m) { const size_t row = (size_t)(row0 + ai * 128 + m * 16); const f32x4 v0 = acc[ai][bj][m][0], v1 = acc[ai][bj][m][1];
                    v4u w; w.x = pk2(v0[0], v0[1]); w.y = pk2(v0[2], v0[3]); w.z = pk2(v1[0], v1[1]); w.w = pk2(v1[2], v1[3]); *(v4u*)(RWG + row * RWW + ch) = w; } }
    }
    __device__ __forceinline__ void grp_l(const f32x4 (&acc)[2][2][4][2], int row0, int c0) const {
        bf16* GAf = (bf16*)(ws + WS_LAF); bf16* GAb = (bf16*)(ws + WS_LAB);
#pragma unroll
        for (int bj = 0; bj < 2; ++bj) { const int ch = (c0 + bj * 128 - 2560) >> 1; const f32x4 gbf = *(const f32x4*)(in[20] + ch), gbb = *(const f32x4*)(in[20] + 256 + ch);
#pragma unroll
            for (int ai = 0; ai < 2; ++ai)
#pragma unroll
                for (int m = 0; m < 4; ++m) { const size_t row = (size_t)(row0 + ai * 128 + m * 16);
                    const f32x4 xf = acc[ai][bj][m][0] + gbf, xb = acc[ai][bj][m][1] + gbb; f32x4 af, ab;
#pragma unroll
                    for (int e = 0; e < 4; ++e) { const float lf = fminf(xf[e], 0.f) - log1pf(__expf(-fabsf(xf[e]))), lb = fminf(xb[e], 0.f) - log1pf(__expf(-fabsf(xb[e])));
                        af[e] = lf * 0.0625f; ab[e] = lb * 0.0625f; }
                    { v2u o; o.x = pk2(af[0], af[1]); o.y = pk2(af[2], af[3]); *(v2u*)(GAf + row * 256 + ch) = o; o.x = pk2(ab[0], ab[1]); o.y = pk2(ab[2], ab[3]); *(v2u*)(GAb + row * 256 + ch) = o; } } }
    }
    __device__ __forceinline__ void operator()(const f32x4 (&acc)[2][2][4][2], const pg8::Unit& u, int wr, int wc, int fr, int fq) const {
        const int row0 = u.pm * 256 + wr * 64 + fr, c0 = u.pn * 256 + wc * 32 + 8 * fq;
        if (u.pn < 4) grp_w(acc, row0, c0); else if (u.pn < 8) grp_a(acc, row0, c0); else if (u.pn < 10) grp_g(acc, row0, c0); else grp_l(acc, row0, c0);
    }
};
__device__ __forceinline__ void ph_lora(Frame& F) {
    pg8::Gemm g{(const bf16*)(F.ws + WS_A2), (const bf16*)(F.ws + WS_WLORA), MR, NLORA, KLORA, nullptr};
    pg8::StaticOrder S; S.init(MR, NLORA, F.G, (int)blockIdx.x);
    EpiLora E{F.ws, F.in};
    pg8::gemm_phase<EpiLora, pg8::StaticOrder, true, true, false>(F.lds, g, S, E);
}

__device__ __forceinline__ void ph_merge(Frame& F) {
    unsigned char* ws = F.ws; const int lane = F.lane;
    const bf16* ORf = (const bf16*)(ws + WS_ORWF); const bf16* ORb = (const bf16*)(ws + WS_ORWB); const bf16* OGf = (const bf16*)(ws + WS_OGLF); const bf16* OGb = (const bf16*)(ws + WS_OGLB);
    const bf16* R = (const bf16*)(ws + WS_RB); const bf16* V = (const bf16*)(ws + WS_VB); const bf16* KSUM = (const bf16*)(ws + WS_KSUM); const bf16* RWG = (const bf16*)(ws + WS_RWG);
    const bf16* P = (const bf16*)(ws + WS_P);
    bf16* YRW = (bf16*)(ws + WS_YRW); bf16* YGLA = (bf16*)(ws + WS_YGLA);
    float rk[8], gw[8], gbv[8], ggw[8], ggb[8];
    ld8(F.in[15] + 8 * lane, rk); ld8(F.in[16] + 8 * lane, gw); ld8(F.in[17] + 8 * lane, gbv); ld8(F.in[21] + 8 * lane, ggw); ld8(F.in[22] + 8 * lane, ggb);
    for (int m0 = F.gw; m0 < NLAT; m0 += 2 * F.NGW) {
        const int m1 = (m0 + F.NGW < NLAT) ? m0 + F.NGW : m0;
        v4u wa[2], wb[2], wc[2], wd[2], wr[2], wv[2], wk[2], wg[2], wo[2];
#pragma unroll
        for (int r2 = 0; r2 < 2; ++r2) { const int m = r2 ? m1 : m0; const size_t ro = (size_t)m * RWW + 8 * lane;
            wa[r2] = *(const v4u*)(ORf + ro); wb[r2] = *(const v4u*)(ORb + ro); wc[r2] = *(const v4u*)(OGf + ro); wd[r2] = *(const v4u*)(OGb + ro);
            wr[r2] = *(const v4u*)(R + ro); wv[r2] = *(const v4u*)(V + ro); wk[r2] = *(const v4u*)(KSUM + ro); wg[r2] = *(const v4u*)(RWG + ro);
            wo[r2] = *(const v4u*)(P + (size_t)m * NP + C_OG + 8 * lane); }
#pragma unroll
        for (int r2 = 0; r2 < 2; ++r2) { const int m = r2 ? m1 : m0; const size_t ro = (size_t)m * RWW + 8 * lane;
        {
            float a[8], b[8], o[8]; unp8(wa[r2], a); unp8(wb[r2], b);
            float s = 0.f;
#pragma unroll
            for (int e = 0; e < 8; ++e) { o[e] = a[e] + b[e]; s += o[e]; }
            s += __shfl_xor(s, 1); s += __shfl_xor(s, 2); s += __shfl_xor(s, 4);
            const float mean = s * (1.f / 64.f); float q = 0.f;
#pragma unroll
            for (int e = 0; e < 8; ++e) { o[e] -= mean; q += o[e] * o[e]; }
            q += __shfl_xor(q, 1); q += __shfl_xor(q, 2); q += __shfl_xor(q, 4);
            const float rstd = 1.f / sqrtf(q * (1.f / 64.f) + RW_GN_EPS);
            float r[8], v[8], ksm[8], g[8]; unp8(wr[r2], r); unp8(wv[r2], v); unp8(wk[r2], ksm); unp8(wg[r2], g);
            float bs = 0.f;
#pragma unroll
            for (int e = 0; e < 8; ++e) bs += r[e] * ksm[e] * rk[e];
            bs += __shfl_xor(bs, 1); bs += __shfl_xor(bs, 2); bs += __shfl_xor(bs, 4);
            float y[8];
#pragma unroll
            for (int e = 0; e < 8; ++e) y[e] = (o[e] * rstd * gw[e] + gbv[e] + bs * v[e]) * g[e];
            *(v4u*)(YRW + ro) = pk8(y);
        }
        {
            float a[8], b[8], o[8]; unp8(wc[r2], a); unp8(wd[r2], b);
            float s = 0.f;
#pragma unroll
            for (int e = 0; e < 8; ++e) { o[e] = a[e] + b[e]; s += o[e]; }
            s += __shfl_xor(s, 1); s += __shfl_xor(s, 2); s += __shfl_xor(s, 4); s += __shfl_xor(s, 8);
            const float mean = s * (1.f / 128.f); float q = 0.f;
#pragma unroll
            for (int e = 0; e < 8; ++e) { o[e] -= mean; q += o[e] * o[e]; }
            q += __shfl_xor(q, 1); q += __shfl_xor(q, 2); q += __shfl_xor(q, 4); q += __shfl_xor(q, 8);
            const float rstd = 1.f / sqrtf(q * (1.f / 128.f) + LN_EPS);
            float og[8]; unp8(wo[r2], og);
            float y[8];
#pragma unroll
            for (int e = 0; e < 8; ++e) y[e] = (o[e] * rstd * ggw[e] + ggb[e]) * siluf_(og[e]);
            *(v4u*)(YGLA + ro) = pk8(y);
        }
        }
    }
}

template <int WHICH> struct EpiBranch {
    static constexpr bool PERM = true;
    bf16* Z; const bf16* P;
    __device__ __forceinline__ void operator()(const f32x4 (&acc)[2][2][4][2], const pg8::Unit& u, int wr, int wc, int fr, int fq) const {
        const int row0 = u.pm * 256 + wr * 64 + fr, col0 = u.pn * 256 + wc * 32 + 8 * fq;
#pragma unroll
        for (int ah = 0; ah < 4; ++ah) { const int ai = ah >> 1, mb = 2 * (ah & 1);
            v4u gw[2][2], zw[2][2];
#pragma unroll
            for (int m = 0; m < 2; ++m) { const size_t row = (size_t)(row0 + ai * 128 + (mb + m) * 16);
#pragma unroll
                for (int bj = 0; bj < 2; ++bj) { const int c = col0 + bj * 128;
                    gw[m][bj] = *(const v4u*)(P + row * NP + (WHICH ? C_GGLA : C_GRW) + c);
                    if (WHICH) zw[m][bj] = *(const v4u*)(Z + row * D + c); } }
            __builtin_amdgcn_sched_barrier(0);
#pragma unroll
            for (int m = 0; m < 2; ++m) { const size_t row = (size_t)(row0 + ai * 128 + (mb + m) * 16);
#pragma unroll
                for (int bj = 0; bj < 2; ++bj) { const int c = col0 + bj * 128;
                    float g[8]; unp8(gw[m][bj], g);
                    const f32x4 v0 = acc[ai][bj][mb + m][0], v1 = acc[ai][bj][mb + m][1];
                    float z[8];
#pragma unroll
                    for (int e = 0; e < 4; ++e) { z[e] = sigmoidf_(g[e]) * v0[e]; z[4 + e] = sigmoidf_(g[4 + e]) * v1[e]; }
                    if (WHICH) { float zo[8]; unp8(zw[m][bj], zo);
#pragma unroll
                        for (int e = 0; e < 8; ++e) z[e] += zo[e]; }
                    *(v4u*)(Z + row * D + c) = pk8(z); } }
        }
    }
};
__device__ __forceinline__ void ph_branch(Frame& F) {
    pg8::StaticOrder S; S.init(NLAT, D, F.G, (int)blockIdx.x);
    { pg8::Gemm g{(const bf16*)(F.ws + WS_YRW), (const bf16*)(F.ws + WS_WBRRW), NLAT, D, RWW, nullptr};
      EpiBranch<0> E{(bf16*)(F.ws + WS_Z), (const bf16*)(F.ws + WS_P)};
      pg8::gemm_phase<EpiBranch<0>, pg8::StaticOrder, true, true, false>(F.lds, g, S, E); }
    { pg8::Gemm g{(const bf16*)(F.ws + WS_YGLA), (const bf16*)(F.ws + WS_WBRGLA), NLAT, D, RWW, nullptr};
      EpiBranch<1> E{(bf16*)(F.ws + WS_Z), (const bf16*)(F.ws + WS_P)};
      pg8::gemm_phase<EpiBranch<1>, pg8::StaticOrder, true, true, false>(F.lds, g, S, E); }
}
struct EpiOut {
    static constexpr bool PERM = true;
    bf16* X1P; const float* x; const float* mod;
    __device__ __forceinline__ void operator()(const f32x4 (&acc)[2][2][4][2], const pg8::Unit& u, int wr, int wc, int fr, int fq) const {
        const int row0 = u.pm * 256 + wr * 64 + fr, col0 = u.pn * 256 + wc * 32 + 8 * fq; const float* g1 = mod + (u.pm / (SEQ / 256)) * 6144 + 2048;
        f32x4 gv[2][2];
#pragma unroll
        for (int bj = 0; bj < 2; ++bj)
#pragma unroll
            for (int n = 0; n < 2; ++n) gv[bj][n] = *(const f32x4*)(g1 + col0 + bj * 128 + 4 * n);
#pragma unroll
        for (int ah = 0; ah < 4; ++ah) { const int ai = ah >> 1, mb = 2 * (ah & 1);
            f32x4 xv[2][2][2];
#pragma unroll
            for (int m = 0; m < 2; ++m) { const size_t ro = (size_t)(row0 + ai * 128 + (mb + m) * 16) * D;
#pragma unroll
                for (int bj = 0; bj < 2; ++bj)
#pragma unroll
                    for (int n = 0; n < 2; ++n) xv[m][bj][n] = *(const f32x4*)(x + ro + col0 + bj * 128 + 4 * n); }
            __builtin_amdgcn_sched_barrier(0);
#pragma unroll
            for (int m = 0; m < 2; ++m) { const size_t ro = (size_t)(row0 + ai * 128 + (mb + m) * 16) * D;
#pragma unroll
                for (int bj = 0; bj < 2; ++bj) { const f32x4 a = xv[m][bj][0] * ALPHA + gv[bj][0] * acc[ai][bj][mb + m][0], b = xv[m][bj][1] * ALPHA + gv[bj][1] * acc[ai][bj][mb + m][1];
                    v4u w; w.x = pk2(a.x, a.y); w.y = pk2(a.z, a.w); w.z = pk2(b.x, b.y); w.w = pk2(b.z, b.w); *(v4u*)(X1P + ro + col0 + bj * 128) = w; } }
        }
    }
};
__device__ __forceinline__ void ph_outproj(Frame& F) {
    pg8::Gemm g{(const bf16*)(F.ws + WS_Z), (const bf16*)(F.ws + WS_WOUT), NLAT, D, D, nullptr};
    pg8::StaticOrder S; S.init(NLAT, D, F.G, (int)blockIdx.x);
    EpiOut E{(bf16*)(F.ws + WS_X1), F.in[0], (const float*)(F.ws + WS_MOD)};
    pg8::gemm_phase<EpiOut, pg8::StaticOrder, true, true, false>(F.lds, g, S, E);
}
#endif

#if MS >= 3
constexpr int LP = 72, SLOTB = 64 * LP * 2, LPF = 68, AUX_OFF = 13 * SLOTB;
static_assert(AUX_OFF + 4096 <= MISC_OFF, "scan LDS map");
#define SLOT(n) ((LAS bf16*)(lds + (n) * SLOTB))
__device__ __forceinline__ int scan_row(int s, int b, int dir) {
    if (s < CTXL) return NLAT + b * CTXL + (dir ? (CTXL - 1 - s) : s);
    const int lt = s - CTXL; return b * SEQ + (dir ? (SEQ - 1 - lt) : lt);
}
__device__ __forceinline__ unsigned pk2z(float x) { return pk2(x, 0.f); }
__device__ __forceinline__ float bf2f(bf16 h) { return __builtin_bit_cast(float, (unsigned)h << 16); }
__device__ __forceinline__ v2u pack4(const f32x4 v) { v2u o; o.x = pk2(v[0], v[1]); o.y = pk2(v[2], v[3]); return o; }
__device__ __forceinline__ f32x4 unpack4(const v2u w) { return (f32x4){bflo(w.x), bfhi(w.x), bflo(w.y), bfhi(w.y)}; }
__device__ __forceinline__ f32x4 mm_tile(const LAS bf16* X, int r0, const LAS bf16* Y, int c0, int lane) {
    const int rr = lane & 15, q = lane >> 4;
    const LAS bf16* xp = X + (r0 + rr) * LP + 8 * q; const LAS bf16* yp = Y + (c0 + rr) * LP + 8 * q;
    const bf16x8 a0 = *(const LAS bf16x8*)xp, a1 = *(const LAS bf16x8*)(xp + 32), b0 = *(const LAS bf16x8*)yp, b1 = *(const LAS bf16x8*)(yp + 32);
    f32x4 acc = (f32x4){0.f, 0.f, 0.f, 0.f};
    acc = __builtin_amdgcn_mfma_f32_16x16x32_bf16(a0, b0, acc, 0, 0, 0);
    acc = __builtin_amdgcn_mfma_f32_16x16x32_bf16(a1, b1, acc, 0, 0, 0);
    return acc;
}
__device__ __forceinline__ float red8(float x) {
    x += __builtin_bit_cast(float, __builtin_amdgcn_update_dpp(0, __builtin_bit_cast(int, x), 0x141, 0xf, 0xf, false));
    x += __builtin_bit_cast(float, __builtin_amdgcn_update_dpp(0, __builtin_bit_cast(int, x), 0xB1, 0xf, 0xf, false));
    x += __builtin_bit_cast(float, __builtin_amdgcn_update_dpp(0, __builtin_bit_cast(int, x), 0x4E, 0xf, 0xf, false));
    return x;
}

#define S1_BAR() do { asm volatile("s_waitcnt lgkmcnt(0)" ::: "memory"); __builtin_amdgcn_s_barrier(); asm volatile("" ::: "memory"); } while (0)
struct RwIn { bf16 lw[8], r[8], k[8], a[8], b[8], v[8]; };
__device__ __forceinline__ void s1_rwkv_load(Frame& F, int u, RwIn& I) {
    const int sr = u / NCHUNK, c = u - sr * NCHUNK, rb = sr >> 4, rdir = (sr >> 3) & 1, rh = sr & 7; unsigned char* ws = F.ws;
    const bf16* RBp = (const bf16*)(ws + WS_RB); const bf16* VBp = (const bf16*)(ws + WS_VB); const bf16* KKp = (const bf16*)(ws + WS_KKB);
    const bf16* KMp = (const bf16*)(ws + (rdir ? WS_KMB : WS_KMF)); const bf16* BVp = (const bf16*)(ws + (rdir ? WS_BVB : WS_BVF)); const bf16* LWp = (const bf16*)(ws + (rdir ? WS_LWB : WS_LWF));
#pragma unroll
    for (int i = 0; i < 8; ++i) { const int row = scan_row(c * CH + 8 * F.wave + i, rb, rdir); const size_t base = (size_t)row * RWW + rh * 64 + F.lane;
        I.lw[i] = LWp[base]; I.r[i] = RBp[base]; I.k[i] = KMp[base]; I.a[i] = KKp[base]; I.b[i] = BVp[base]; I.v[i] = VBp[base]; }
}
__device__ __forceinline__ void s1_rwkv(Frame& F, int u, const RwIn& I, int un, RwIn& Inext, int cvi) {
    const int sr = u / NCHUNK, c = u - sr * NCHUNK;
    const bool emit = c >= CTXL / CH;
    LAS unsigned char* lds = F.lds; unsigned char* ws = F.ws;
    int lane_ = F.lane; asm volatile("" : "+v"(lane_));
    const int lane = lane_, wave = F.wave, rr = lane & 15, q = lane >> 4;
    LAS float* tot = (LAS float*)(lds + AUX_OFF); LAS float* gCs = tot + 512;
    {
        float lw[8], xr[8], xk[8], xa[8], xb[8], xv[8];
#pragma unroll
        for (int i = 0; i < 8; ++i) { lw[i] = bf2f(I.lw[i]); xr[i] = bf2f(I.r[i]); xk[i] = bf2f(I.k[i]); xa[i] = -bf2f(I.a[i]); xb[i] = bf2f(I.b[i]); xv[i] = bf2f(I.v[i]); }
        float p[8]; p[0] = lw[0];
#pragma unroll
        for (int i = 1; i < 8; ++i) p[i] = p[i - 1] + lw[i];
        tot[wave * 64 + lane] = p[7];
        S1_BAR();
        float off = 0.f, all = 0.f;
#pragma unroll
        for (int w = 0; w < 8; ++w) { const float t = tot[w * 64 + lane]; all += t; off += (w < wave) ? t : 0.f; }
        if (wave == 0) gCs[lane] = __expf(all);
        float at[8], bb[8], kb[8];
#pragma unroll
        for (int i = 0; i < 8; ++i) { const float cum = off + p[i]; const float g = __expf(cum), gi = __expf(-cum), gp = __expf(cum - lw[i]), gc = __expf(all - cum);
            const int t = 8 * wave + i;
            at[i] = xa[i] * gp; bb[i] = xb[i] * gc; kb[i] = xk[i] * gc;
            SLOT(0)[t * LP + lane] = (bf16)pk2z(at[i]);
            SLOT(1)[t * LP + lane] = (bf16)pk2z(xr[i] * g);
            SLOT(2)[t * LP + lane] = (bf16)pk2z(xb[i] * gi);
            SLOT(3)[t * LP + lane] = (bf16)pk2z(xk[i] * gi); }
        *(LAS v4u*)(SLOT(4) + lane * LP + 8 * wave) = pk8(at);
        *(LAS v4u*)(SLOT(5) + lane * LP + 8 * wave) = pk8(xv);
        *(LAS v4u*)(SLOT(6) + lane * LP + 8 * wave) = pk8(bb);
        *(LAS v4u*)(SLOT(7) + lane * LP + 8 * wave) = pk8(kb);
        S1_BAR();
    }
    s1_rwkv_load(F, un, Inext);
    LAS float* Lp = (LAS float*)(lds + 8 * SLOTB);
#pragma unroll
    for (int tix = 0; tix < 2; ++tix) { const int ti = 2 * wave + tix, r0 = 16 * (ti >> 2), c0 = 16 * (ti & 3), ci = c0 + rr;
        { const f32x4 acc = mm_tile(SLOT(2), r0, SLOT(0), c0, lane);
#pragma unroll
            for (int e = 0; e < 4; ++e) { const int i = r0 + 4 * q + e; Lp[ci * LPF + (i & 3) * 16 + (i >> 2)] = (i < ci) ? acc[e] : 0.f; } }
        { f32x4 acc = mm_tile(SLOT(0), r0, SLOT(3), c0, lane);
#pragma unroll
            for (int e = 0; e < 4; ++e) acc[e] = (ci < r0 + 4 * q + e) ? acc[e] : 0.f;
            *(LAS v2u*)(SLOT(10) + ci * LP + r0 + 4 * q) = pack4(acc); }
        if (emit) {
            { f32x4 acc = mm_tile(SLOT(2), r0, SLOT(1), c0, lane);
#pragma unroll
                for (int e = 0; e < 4; ++e) acc[e] = (r0 + 4 * q + e <= ci) ? acc[e] : 0.f;
                *(LAS v2u*)(SLOT(11) + ci * LP + r0 + 4 * q) = pack4(acc); }
            { f32x4 acc = mm_tile(SLOT(3), r0, SLOT(1), c0, lane);
#pragma unroll
                for (int e = 0; e < 4; ++e) acc[e] = (r0 + 4 * q + e <= ci) ? acc[e] : 0.f;
                *(LAS v2u*)(SLOT(12) + ci * LP + r0 + 4 * q) = pack4(acc); }
        }
    }
    S1_BAR();
    if (wave < 4) {
        const int j = 16 * wave + (lane >> 2), s = lane & 3;
        float Tr[16];
#pragma unroll
        for (int m = 0; m < 16; ++m) Tr[m] = 0.f;
        const LAS float* lrow = Lp + s * 16;
        f32x4 lb[3][4];
#pragma unroll
        for (int t = 0; t < 2; ++t) lb[t][0] = *(const LAS f32x4*)(lrow + t * LPF);
#pragma unroll
        for (int t = 0; t < 64; ++t) {
            if (t + 2 < 64) {
#pragma unroll
                for (int k = 0; k < 4; ++k) if (4 * k <= (t + 2) / 4) lb[(t + 2) % 3][k] = *(const LAS f32x4*)(lrow + (t + 2) * LPF + 4 * k);
            }
            __builtin_amdgcn_sched_barrier(0);
            float acc0 = 0.f, acc1 = 0.f;
#pragma unroll
            for (int m = 0; m < 16; ++m) if (m <= t / 4) { const float lv = lb[t % 3][m >> 2][m & 3]; if (m & 1) acc1 += lv * Tr[m]; else acc0 += lv * Tr[m]; }
            float acc = acc0 + acc1;
            acc += __builtin_bit_cast(float, __builtin_amdgcn_update_dpp(0, __builtin_bit_cast(int, acc), 0xB1, 0xf, 0xf, false));
            acc += __builtin_bit_cast(float, __builtin_amdgcn_update_dpp(0, __builtin_bit_cast(int, acc), 0x4E, 0xf, 0xf, false));
            int jj = j, ss = s; asm volatile("" : "+v"(jj), "+v"(ss));
            const float val = acc + ((t == jj) ? 1.f : 0.f);
            Tr[t >> 2] = (ss == (t & 3)) ? val : Tr[t >> 2];
            SLOT(0)[t * LP + j] = (bf16)pk2z(val);
        }
    } else if (cvi >= 0) { f32x4 cv[CVK]; cvx_load(F.in, cvi, lane, cv); cvx_store(ws, cvi, lane, cv); }
    S1_BAR();
#pragma unroll
    for (int tix = 0; tix < 2; ++tix) { const int ti = 2 * wave + tix, r0 = 16 * (ti >> 2), c0 = 16 * (ti & 3), ci = c0 + rr;
        { const f32x4 acc = mm_tile(SLOT(0), r0, SLOT(4), c0, lane); *(LAS v2u*)(SLOT(2) + ci * LP + r0 + 4 * q) = pack4(acc); }
        { const f32x4 acc = mm_tile(SLOT(0), r0, SLOT(10), c0, lane); *(LAS v2u*)(SLOT(3) + ci * LP + r0 + 4 * q) = pack4(acc); }
    }
    S1_BAR();
    bf16* RH = (bf16*)(ws + WS_RH) + (size_t)u * 4096; bf16* GT = (bf16*)((unsigned char*)F.out + OUT_GT) + (size_t)u * 4096;
#pragma unroll
    for (int tix = 0; tix < 2; ++tix) { const int ti = 2 * wave + tix, tr = ti >> 2, r0 = 16 * tr, c0 = 16 * (ti & 3), ci = c0 + rr;
        const int pos = (tr >> 1) * 32 + q * 8 + 4 * (tr & 1);
        if (emit) {
            { f32x4 acc = mm_tile(SLOT(2), r0, SLOT(11), c0, lane);
                acc += unpack4(*(const LAS v2u*)(SLOT(1) + ci * LP + r0 + 4 * q));
                *(v2u*)(RH + ci * 64 + pos) = pack4(acc); }
            { f32x4 acc = mm_tile(SLOT(3), r0, SLOT(11), c0, lane);
                acc += unpack4(*(const LAS v2u*)(SLOT(12) + ci * LP + r0 + 4 * q));
                *(LAS v2u*)(SLOT(4) + ci * LP + r0 + 4 * q) = pack4(acc); }
        }
        { f32x4 acc = mm_tile(SLOT(2), r0, SLOT(6), c0, lane);
            const float gc = gCs[ci];
#pragma unroll
            for (int e = 0; e < 4; ++e) acc[e] += (r0 + 4 * q + e == ci) ? gc : 0.f;
            *(v2u*)(GT + ci * 64 + pos) = pack4(acc); }
    }
    S1_BAR();
    bf16* YL = (bf16*)(ws + WS_YL) + (size_t)u * 4096;
#pragma unroll
    for (int tix = 0; tix < 2; ++tix) { const int ti = 2 * wave + tix, r0 = 16 * (ti >> 2), c0 = 16 * (ti & 3), ci = c0 + rr;
        if (emit) { const f32x4 acc = mm_tile(SLOT(5), r0, SLOT(4), c0, lane); *(v2u*)(YL + ci * 64 + r0 + 4 * q) = pack4(acc); }
        { f32x4 acc = mm_tile(SLOT(3), r0, SLOT(6), c0, lane);
            acc += unpack4(*(const LAS v2u*)(SLOT(7) + ci * LP + r0 + 4 * q));
            *(LAS v2u*)(SLOT(8) + ci * LP + r0 + 4 * q) = pack4(acc); }
    }
    S1_BAR();
    bf16* HH = (bf16*)(ws + WS_HH) + (size_t)u * 4096;
#pragma unroll
    for (int tix = 0; tix < 2; ++tix) { const int ti = 2 * wave + tix, r0 = 16 * (ti >> 2), c0 = 16 * (ti & 3), ci = c0 + rr;
        const f32x4 acc = mm_tile(SLOT(8), r0, SLOT(5), c0, lane);
        *(v2u*)(HH + ci * 64 + r0 + 4 * q) = pack4(acc); }
    S1_BAR();
}

struct GlIn { bf16 la[8], q[8], k[8], v0[8], v1[8]; };
__device__ __forceinline__ void s1_gla_load(Frame& F, int u, GlIn& I) {
    const int sg = u / NCHUNK, c = u - sg * NCHUNK, gb = sg >> 3, gdir = (sg >> 2) & 1, gh = sg & 3; unsigned char* ws = F.ws;
    const bf16* Qp = (const bf16*)(ws + WS_QGB); const bf16* Kp = (const bf16*)(ws + WS_KGB); const bf16* Vp = (const bf16*)(ws + WS_VGB); const bf16* LAp = (const bf16*)(ws + (gdir ? WS_LAB : WS_LAF));
#pragma unroll
    for (int i = 0; i < 8; ++i) { const int row = scan_row(c * CH + 8 * F.wave + i, gb, gdir); const size_t b2 = (size_t)row * 256 + gh * 64 + F.lane, b5 = (size_t)row * RWW + gh * 128 + F.lane;
        I.la[i] = LAp[b2]; I.q[i] = Qp[b2]; I.k[i] = Kp[b2]; I.v0[i] = Vp[b5]; I.v1[i] = Vp[b5 + 64]; }
}
__device__ __forceinline__ void s1_gla(Frame& F, int u, const GlIn& I) {
    const int sg = u / NCHUNK, c = u - sg * NCHUNK;
    const bool emit = c >= CTXL / CH;
    LAS unsigned char* lds = F.lds; unsigned char* ws = F.ws;
    int lane_ = F.lane; asm volatile("" : "+v"(lane_));
    const int lane = lane_, wave = F.wave, rr = lane & 15, q = lane >> 4;
    LAS float* tot = (LAS float*)(lds + AUX_OFF);
    bf16* QE = (bf16*)((unsigned char*)F.out + OUT_QE) + (size_t)u * 4096;
    {
        float la[8], xq[8], xk[8], v0[8], v1[8];
#pragma unroll
        for (int i = 0; i < 8; ++i) { la[i] = bf2f(I.la[i]); xq[i] = bf2f(I.q[i]); xk[i] = bf2f(I.k[i]); v0[i] = bf2f(I.v0[i]); v1[i] = bf2f(I.v1[i]); }
        float p[8]; p[0] = la[0];
#pragma unroll
        for (int i = 1; i < 8; ++i) p[i] = p[i - 1] + la[i];
        tot[wave * 64 + lane] = p[7];
        S1_BAR();
        float off = 0.f, all = 0.f;
#pragma unroll
        for (int w = 0; w < 8; ++w) { const float t = tot[w * 64 + lane]; all += t; off += (w < wave) ? t : 0.f; }
        if (wave == 0) ((float*)(ws + WS_DD))[(size_t)u * 64 + lane] = __expf(all);
        float kl[8];
#pragma unroll
        for (int i = 0; i < 8; ++i) { const float cum = off + p[i]; const int t = 8 * wave + i;
            const bf16 qe = (bf16)pk2z(xq[i] * __expf(cum));
            SLOT(0)[t * LP + lane] = qe;
            if (emit) QE[t * 64 + lane] = qe;
            SLOT(1)[t * LP + lane] = (bf16)pk2z(xk[i] * __expf(-cum));
            kl[i] = xk[i] * __expf(all - cum); }
        *(LAS v4u*)(SLOT(2) + lane * LP + 8 * wave) = pk8(kl);
        *(LAS v4u*)(SLOT(3) + lane * LP + 8 * wave) = pk8(v0);
        *(LAS v4u*)(SLOT(3) + (64 + lane) * LP + 8 * wave) = pk8(v1);
        S1_BAR();
    }
    if (emit) {
#pragma unroll
        for (int tix = 0; tix < 2; ++tix) { const int ti = 2 * wave + tix, r0 = 16 * (ti >> 2), c0 = 16 * (ti & 3), ci = c0 + rr;
            f32x4 acc = mm_tile(SLOT(1), r0, SLOT(0), c0, lane);
#pragma unroll
            for (int e = 0; e < 4; ++e) acc[e] = (r0 + 4 * q + e <= ci) ? acc[e] : 0.f;
            *(LAS v2u*)(SLOT(5) + ci * LP + r0 + 4 * q) = pack4(acc); }
    }
    bf16* KV = (bf16*)(ws + WS_KV) + (size_t)u * 8192;
#pragma unroll
    for (int tix = 0; tix < 4; ++tix) { const int ti = 4 * wave + tix, r0 = 16 * (ti >> 3), c0 = 16 * (ti & 7), ci = c0 + rr;
        const f32x4 acc = mm_tile(SLOT(2), r0, SLOT(3), c0, lane);
        *(v2u*)(KV + ci * 64 + r0 + 4 * q) = pack4(acc); }
    S1_BAR();
    if (emit) {
        bf16* IN = (bf16*)(ws + WS_INTRA) + (size_t)u * 8192;
#pragma unroll
        for (int tix = 0; tix < 4; ++tix) { const int ti = 4 * wave + tix, r0 = 16 * (ti >> 2), c0 = 16 * (ti & 3), ci = c0 + rr;
            const f32x4 acc = mm_tile(SLOT(3), r0, SLOT(5), c0, lane);
            *(v2u*)(IN + ci * 128 + r0 + 4 * q) = pack4(acc); }
    }
    S1_BAR();
}

__device__ __forceinline__ void ph_scan1(Frame& F) {
    { RwIn cur, nxt; if ((int)blockIdx.x < NU_RW) s1_rwkv_load(F, blockIdx.x, cur);
#pragma unroll 1
      for (int u = blockIdx.x; u < NU_RW; u += F.G) { const int un = (u + F.G < NU_RW) ? u + F.G : u; const int cvi = ((u - (int)blockIdx.x) / F.G) * (F.G * 4) + (int)blockIdx.x * 4 + (F.wave & 3);
          s1_rwkv(F, u, cur, un, nxt, cvi < CV_NITEM ? cvi : -1); cur = nxt; } }
    { GlIn cur, nxt; if ((int)blockIdx.x < NU_GL) s1_gla_load(F, blockIdx.x, cur);
#pragma unroll 1
      for (int u = blockIdx.x; u < NU_GL; u += F.G) { const int un = (u + F.G < NU_GL) ? u + F.G : u; s1_gla_load(F, un, nxt); s1_gla(F, u, cur); cur = nxt; } }
}

__device__ __forceinline__ bf16x8 pack_frag(const f32x4 lo, const f32x4 hi) {
    v4u w; w.x = pk2(lo[0], lo[1]); w.y = pk2(lo[2], lo[3]); w.z = pk2(hi[0], hi[1]); w.w = pk2(hi[2], hi[3]); return __builtin_bit_cast(bf16x8, w);
}
constexpr int S2_D = 3, S2_R = 4, S2_RW = 8192 + 8192 + 2048 + 2048, S2_GL = 8192 + 2048 + 2048 + 1024, S2_SLOT = S2_RW + S2_GL;
static_assert(S2_R * S2_SLOT <= MISC_OFF, "S2 ring fits in LDS");
__device__ __forceinline__ void s2_issue(LAS unsigned char* lds, int sb, int lw, int lane, size_t ur, size_t ug, int v0r, int v0g,
                                         const unsigned char* GTb, const unsigned char* RHb, const unsigned char* HHb, const unsigned char* YLb,
                                         const unsigned char* QEb, const unsigned char* KVb, const unsigned char* INb, const unsigned char* DDb) {
#pragma unroll
    for (int j = 0; j < 6; ++j) {
        int k = lw * 6 + j; if (k >= 33) k -= 5;
        const unsigned char* src; int ldo;
        if (k < 16) { const int n = k & 7, pu = n * 64 + lane, row = pu >> 3, c16 = (pu & 7) ^ (row & 7);
            src = (k < 8 ? GTb : RHb) + ur * 8192 + row * 128 + c16 * 16; ldo = (k < 8 ? 0 : 8192) + n * 1024; }
        else if (k < 18) { const int n = k - 16, pu = n * 64 + lane, v = pu >> 3, c16 = (pu & 7) ^ (v & 7);
            src = HHb + ur * 8192 + (size_t)(v0r + v) * 128 + c16 * 16; ldo = 16384 + n * 1024; }
        else if (k < 20) { const int n = k - 18, pu = n * 64 + lane, t = pu >> 1;
            src = YLb + ur * 8192 + t * 128 + v0r * 2 + (pu & 1) * 16; ldo = 18432 + n * 1024; }
        else if (k < 28) { const int n = k - 20, pu = n * 64 + lane, row = pu >> 3, c16 = (pu & 7) ^ (row & 7);
            src = QEb + ug * 8192 + row * 128 + c16 * 16; ldo = S2_RW + n * 1024; }
        else if (k < 30) { const int n = k - 28, pu = n * 64 + lane, v = pu >> 3, c16 = (pu & 7) ^ (v & 7);
            src = KVb + ug * 16384 + (size_t)(v0g + v) * 128 + c16 * 16; ldo = S2_RW + 8192 + n * 1024; }
        else if (k < 32) { const int n = k - 30, pu = n * 64 + lane, t = pu >> 1;
            src = INb + ug * 16384 + t * 256 + v0g * 2 + (pu & 1) * 16; ldo = S2_RW + 10240 + n * 1024; }
        else { src = DDb + ug * 256 + (lane & 15) * 16; ldo = S2_RW + 12288; }
        __builtin_amdgcn_global_load_lds((const unsigned*)src, (LAS unsigned*)(lds + sb + ldo), 16, 0, 0);
    }
}
__device__ __forceinline__ void ph_scan2(Frame& F) {
    const int lane = F.lane, wave = F.wave, rr = lane & 15, q = lane >> 4; unsigned char* ws = F.ws; LAS unsigned char* lds = F.lds;
    const int it = (F.G == 256) ? (int)(blockIdx.x & 7) * 32 + (int)(blockIdx.x >> 3) : (int)blockIdx.x;
    const int sr = it >> 2, v0r = 16 * (it & 3), rb = sr >> 4, rdir = (sr >> 3) & 1, rh = sr & 7;
    const int sg = it >> 3, v0g = 16 * (it & 7), gb = sg >> 3, gdir = (sg >> 2) & 1, gh = sg & 3;
#define S2_BAR() do { asm volatile("s_waitcnt lgkmcnt(0)" ::: "memory"); __builtin_amdgcn_s_barrier(); asm volatile("" ::: "memory"); } while (0)
    if (wave >= 2) {
        const unsigned char* GTb = (const unsigned char*)F.out + OUT_GT; const unsigned char* QEb = (const unsigned char*)F.out + OUT_QE;
        const unsigned char* RHb = ws + WS_RH; const unsigned char* YLb = ws + WS_YL; const unsigned char* HHb = ws + WS_HH; const unsigned char* KVb = ws + WS_KV; const unsigned char* INb = ws + WS_INTRA;
        const unsigned char* DDb = ws + WS_DD;
#define S2_ISSUE(cc) s2_issue(lds, ((cc) % S2_R) * S2_SLOT, wave - 2, lane, (size_t)(sr * NCHUNK + ((cc) < NCHUNK ? (cc) : NCHUNK - 1)), (size_t)(sg * NCHUNK + ((cc) < NCHUNK ? (cc) : NCHUNK - 1)), v0r, v0g, GTb, RHb, HHb, YLb, QEb, KVb, INb, DDb)
        S2_ISSUE(0); S2_ISSUE(1); S2_ISSUE(2);
#pragma unroll 1
        for (int c = 0; c < NCHUNK; ++c) {
            asm volatile("s_waitcnt vmcnt(12) ; S2WAIT" ::: "memory");
            S2_BAR();
            S2_ISSUE(c + S2_D);
        }
#undef S2_ISSUE
    } else if (wave == 0) {
        bf16* ORW = (bf16*)(ws + (rdir ? WS_ORWB : WS_ORWF));
        f32x4 S[4];
#pragma unroll
        for (int m = 0; m < 4; ++m) S[m] = (f32x4){0.f, 0.f, 0.f, 0.f};
#pragma unroll 1
        for (int c = 0; c < NCHUNK; ++c) {
            S2_BAR();
            const LAS unsigned char* sl = lds + (c % S2_R) * S2_SLOT;
            const bool emit = c >= CTXL / CH;
            bf16x8 G0[4], G1[4], R0[4], R1[4]; v2u Hw[4], Yw[4];
#pragma unroll
            for (int m = 0; m < 4; ++m) { const int k2 = 16 * m + rr;
                G0[m] = *(const LAS bf16x8*)(sl + (k2 * 8 + (q ^ (k2 & 7))) * 16); G1[m] = *(const LAS bf16x8*)(sl + (k2 * 8 + ((4 + q) ^ (k2 & 7))) * 16);
                Hw[m] = *(const LAS v2u*)(sl + 16384 + (rr * 8 + ((2 * m + (q >> 1)) ^ (rr & 7))) * 16 + (q & 1) * 8); }
            if (emit) {
#pragma unroll
                for (int tt = 0; tt < 4; ++tt) { const int t = 16 * tt + rr;
                    R0[tt] = *(const LAS bf16x8*)(sl + 8192 + (t * 8 + (q ^ (t & 7))) * 16); R1[tt] = *(const LAS bf16x8*)(sl + 8192 + (t * 8 + ((4 + q) ^ (t & 7))) * 16);
                    Yw[tt] = *(const LAS v2u*)(sl + 18432 + t * 32 + q * 8); }
            }
            const bf16x8 Sf0 = pack_frag(S[0], S[1]), Sf1 = pack_frag(S[2], S[3]);
            __builtin_amdgcn_sched_barrier(0);
#pragma unroll
            for (int m = 0; m < 4; ++m) { f32x4 acc = unpack4(Hw[m]);
                acc = __builtin_amdgcn_mfma_f32_16x16x32_bf16(G0[m], Sf0, acc, 0, 0, 0);
                acc = __builtin_amdgcn_mfma_f32_16x16x32_bf16(G1[m], Sf1, acc, 0, 0, 0);
                S[m] = acc; }
            if (emit) {
#pragma unroll
                for (int tt = 0; tt < 4; ++tt) { const int t = 16 * tt + rr;
                    f32x4 acc = unpack4(Yw[tt]);
                    acc = __builtin_amdgcn_mfma_f32_16x16x32_bf16(Sf0, R0[tt], acc, 0, 0, 0);
                    acc = __builtin_amdgcn_mfma_f32_16x16x32_bf16(Sf1, R1[tt], acc, 0, 0, 0);
                    const int row = scan_row(c * CH + t, rb, rdir);
                    *(v2u*)(ORW + (size_t)row * RWW + rh * 64 + v0r + 4 * q) = pack4(acc); }
            }
        }
    } else {
        bf16* OGL = (bf16*)(ws + (gdir ? WS_OGLB : WS_OGLF));
        f32x4 S[4];
#pragma unroll
        for (int m = 0; m < 4; ++m) S[m] = (f32x4){0.f, 0.f, 0.f, 0.f};
#pragma unroll 1
        for (int c = 0; c < NCHUNK; ++c) {
            S2_BAR();
            const LAS unsigned char* sl = lds + (c % S2_R) * S2_SLOT + S2_RW;
            const bool emit = c >= CTXL / CH;
            bf16x8 Q0[4], Q1[4]; v2u Iw[4]; v4u kw[2]; f32x4 d0[2], d1[2];
#pragma unroll
            for (int s2 = 0; s2 < 2; ++s2) { kw[s2] = *(const LAS v4u*)(sl + 8192 + (rr * 8 + ((4 * s2 + q) ^ (rr & 7))) * 16);
                d0[s2] = *(const LAS f32x4*)(sl + 12288 + 128 * s2 + 32 * q); d1[s2] = *(const LAS f32x4*)(sl + 12288 + 128 * s2 + 32 * q + 16); }
            if (emit) {
#pragma unroll
                for (int tt = 0; tt < 4; ++tt) { const int t = 16 * tt + rr;
                    Q0[tt] = *(const LAS bf16x8*)(sl + (t * 8 + (q ^ (t & 7))) * 16); Q1[tt] = *(const LAS bf16x8*)(sl + (t * 8 + ((4 + q) ^ (t & 7))) * 16);
                    Iw[tt] = *(const LAS v2u*)(sl + 10240 + t * 32 + q * 8); }
            }
            const bf16x8 Sf0 = pack_frag(S[0], S[1]), Sf1 = pack_frag(S[2], S[3]);
            __builtin_amdgcn_sched_barrier(0);
#pragma unroll
            for (int s2 = 0; s2 < 2; ++s2) { S[2 * s2] = S[2 * s2] * d0[s2] + unpack4((v2u){kw[s2].x, kw[s2].y}); S[2 * s2 + 1] = S[2 * s2 + 1] * d1[s2] + unpack4((v2u){kw[s2].z, kw[s2].w}); }
            if (emit) {
#pragma unroll
                for (int tt = 0; tt < 4; ++tt) { const int t = 16 * tt + rr;
                    f32x4 acc = unpack4(Iw[tt]);
                    acc = __builtin_amdgcn_mfma_f32_16x16x32_bf16(Sf0, Q0[tt], acc, 0, 0, 0);
                    acc = __builtin_amdgcn_mfma_f32_16x16x32_bf16(Sf1, Q1[tt], acc, 0, 0, 0);
                    const int row = scan_row(c * CH + t, gb, gdir);
                    *(v2u*)(OGL + (size_t)row * RWW + gh * 128 + v0g + 4 * q) = pack4(acc); }
            }
        }
    }
#undef S2_BAR
}
#endif

#ifndef ML
#define ML 0
#endif
enum Phase { PH_PROLOGUE = 0, PH_A1, PH_INPROJ, PH_FEAT, PH_LORA, PH_SCAN1, PH_SCAN2, PH_MERGE, PH_BRANCH, PH_OUTPROJ, PH_LN1, PH_ROUTER, PH_ROUTE, PH_SCATTER, PH_EXP1, PH_EXP2, PH_FINAL, PH_COUNT };

__global__ void __launch_bounds__(NTHR, 2) mega(Args args) {
    extern __shared__ __attribute__((aligned(16))) unsigned char lds_raw[];
    Frame F;
    F.lds = (LAS unsigned char*)lds_raw;
    F.tid = threadIdx.x; F.lane = F.tid & 63; F.wave = __builtin_amdgcn_readfirstlane(F.tid >> 6);
    F.G = gridDim.x; F.gw = blockIdx.x * NWAVES + F.wave; F.NGW = F.G * NWAVES;
    F.in = args.in; F.out = args.out; F.ws = args.ws; F.ctl = (unsigned*)(args.ws + WS_CTL);
    volatile LAS unsigned* MISC = (volatile LAS unsigned*)(F.lds + MISC_OFF);
    if (F.tid < 64) MISC[F.tid] = 0u;
    __syncthreads();
    XcdBarrier bar; bar.bar = F.ctl + CW_BAR; bar.x = 0; bar.st = nullptr;
#if !ML
    bar = xcd_barrier_post(F.ctl + CW_BAR, MISC + 8);
#endif
    const int lo = args.ph_lo, hi = args.ph_hi;
#define IN(k) (lo <= (k) && (k) < hi)
#ifndef DUP
#define DUP -1
#endif
#define RUN(k, call) do { if (IN(k)) { call; GRID_BAR(); if (DUP == (k)) { call; GRID_BAR(); } } } while (0)
#if ML
#define GRID_BAR() do { } while (0)
#else
#define GRID_BAR() xcd_barrier(bar)
#endif

#if MS >= 2
    RUN(PH_PROLOGUE, ph_prologue(F));
#endif
#if MS >= 3
    RUN(PH_A1, ph_a1(F));
    RUN(PH_INPROJ, ph_inproj(F));
    RUN(PH_FEAT, ph_feat(F));
    RUN(PH_LORA, ph_lora(F));
    RUN(PH_SCAN1, ph_scan1(F));
    RUN(PH_SCAN2, ph_scan2(F));
    RUN(PH_MERGE, ph_merge(F));
    RUN(PH_BRANCH, ph_branch(F));
    RUN(PH_OUTPROJ, ph_outproj(F));
#else
    RUN(PH_OUTPROJ, ph_x1pre_nomix(F));
#endif
    RUN(PH_LN1, ph_ln1(F));
#if MS >= 2
    RUN(PH_ROUTER, ph_router(F));
    RUN(PH_ROUTE, ph_route(F));
    RUN(PH_SCATTER, ph_scatter(F));
    RUN(PH_EXP1, ph_exp1(F));
    RUN(PH_EXP2, ph_exp2(F));
#endif
    if (IN(PH_FINAL)) { ph_final(F); }
#undef IN
}

extern "C" void kernel_launch(void* const* d_in, const int* in_sizes, int n_in, void* d_out, int out_size, void* d_ws, size_t ws_size, hipStream_t stream) {
    static int grid = 0;
    if (grid == 0) {
        if (n_in != 36 || out_size != NLAT * D || ws_size < WS_END) { fprintf(stderr, "kernel_launch: unexpected problem shape (n_in %d, out %d)\n", n_in, out_size); grid = -1; return; }
        int dev = 0, cus = 0, per_cu = 0;
        if (hipGetDevice(&dev) != hipSuccess || hipDeviceGetAttribute(&cus, hipDeviceAttributeMultiprocessorCount, dev) != hipSuccess) { grid = -1; return; }
        if (hipFuncSetAttribute((const void*)mega, hipFuncAttributeMaxDynamicSharedMemorySize, LDS_BYTES) != hipSuccess) { fprintf(stderr, "kernel_launch: hipFuncSetAttribute failed\n"); grid = -1; return; }
        if (hipOccupancyMaxActiveBlocksPerMultiprocessor(&per_cu, (const void*)mega, NTHR, LDS_BYTES) != hipSuccess || per_cu < 1) { fprintf(stderr, "kernel_launch: occupancy query says %d\n", per_cu); }
        (void)hipGetLastError();
        grid = cus > 0 ? cus : 256;
        if (grid > 256) grid = 256;
    }
    if (grid < 0) return;
    (void)hipMemsetAsync((char*)d_ws + WS_CTL, 0, CTL_ZERO_BYTES, stream);
    Args a{};
    for (int i = 0; i < 36; ++i) a.in[i] = (const float*)d_in[i];
    a.out = (float*)d_out; a.ws = (unsigned char*)d_ws;
#if ML
    for (int p = 0; p < PH_COUNT; ++p) { a.ph_lo = p; a.ph_hi = p + 1; hipLaunchKernelGGL(mega, dim3(grid), dim3(NTHR), LDS_BYTES, stream, a); }
#else
    a.ph_lo = 0; a.ph_hi = PH_COUNT;
    hipLaunchKernelGGL(mega, dim3(grid), dim3(NTHR), LDS_BYTES, stream, a);
#endif
}
```

```cpp
#include <hip/hip_runtime.h>
#include <cstdio>
#include <cstdint>

#ifndef MS
#define MS 3
#endif

#define GAS __attribute__((address_space(1)))
#define LAS __attribute__((address_space(3)))
typedef unsigned short bf16;
typedef unsigned v4u __attribute__((ext_vector_type(4)));
typedef unsigned v2u __attribute__((ext_vector_type(2)));
typedef float f32x4 __attribute__((ext_vector_type(4)));
typedef float f32x2 __attribute__((ext_vector_type(2)));
typedef short bf16x8 __attribute__((ext_vector_type(8)));
#define LDS_WAIT() asm volatile("s_waitcnt lgkmcnt(0)" ::: "memory")
#define VM_WAIT() asm volatile("s_waitcnt vmcnt(0)" ::: "memory")

constexpr int D = 1024, NB = 4, SEQ = 8192, CTXL = 256, GRIDW = 64, GRIDH = 128;
constexpr int NLAT = NB * SEQ, NCTX = NB * CTXL, MR = NLAT + NCTX;
constexpr int RWW = 512, RWH = 8, HD = 64;
constexpr int C_R = 0, C_K = 512, C_V = 1024, C_PW = 1536, C_PA = 1568, C_PG = 1600, C_Q = 1696, C_KG = 1952, C_VG = 2208, C_PGL = 2720, C_OG = 2736, C_GRW = 3248, C_GGLA = 4272;
constexpr int IN_COLS = 5296, NP = 5376;
constexpr int NE = 256, TOPK = 8, FF = 256;
constexpr float LN_EPS = 1e-5f, RW_GN_EPS = 64e-5f;
constexpr float ALPHA = 1.189207115f;
constexpr int NLORA = 3072, KLORA = 256;
constexpr int MAXTILES = 1280, SH_ROW0 = MAXTILES * 256, NROWS_E = SH_ROW0 + NLAT;

namespace pg8 {
#define PG8_LAS __attribute__((address_space(3)))
typedef unsigned short bf16_t;
typedef unsigned u32x4 __attribute__((ext_vector_type(4)));
typedef unsigned u32x2 __attribute__((ext_vector_type(2)));
constexpr int BM = 256, BK = 64, HALF = 128, HTB = HALF * BK * 2, STAGE_BYTES = 8 * HTB, NXCD = 8, WGM = 8;
constexpr int IDX_OFF = STAGE_BYTES, IDX_UNITS = 12;

__host__ __device__ __forceinline__ int lds_byte(int r, int c) { const int st = (r >> 4) * 2 + (c >> 5), rr = r & 15, cc = c & 31, ob = rr * 64 + cc * 2; return st * 1024 + (ob ^ (((ob >> 9) & 1) << 5)); }
__host__ __device__ __forceinline__ void stage_rc(int b, int& R, int& C) { const int st = b / 1024, sb = b % 1024, swz = sb ^ (((sb >> 9) & 1) << 5); R = (st >> 1) * 16 + swz / 64; C = (st & 1) * 32 + (swz % 64) / 2; }
__host__ __device__ __forceinline__ int perm32(int rho) { const int n = rho >> 4, i = rho & 15; return 8 * (i >> 2) + 4 * n + (i & 3); }

struct Unit { int pm, pn, e, j; };
struct Gemm { const bf16_t* A; const bf16_t* Bt; int M, N, K; const int* rowidx; };

struct StaticOrder {
    int nM, nN, nwg, G, c;
    __host__ __device__ void init(int M, int N, int G_, int c_) { nM = M / BM; nN = N / BM; nwg = nM * nN; G = G_; c = c_; }
    __host__ __device__ bool next(int i, Unit& u) const {
        const long L = (long)i * G + c; if (L >= nwg) return false;
        int wgid = (int)L; { const int q = nwg / NXCD, r = nwg % NXCD, xcd = wgid % NXCD, off = wgid / NXCD; wgid = (xcd < r ? xcd * (q + 1) : r * (q + 1) + (xcd - r) * q) + off; }
        const int nig = WGM * nN, gid = wgid / nig, fm = gid * WGM, gsz = (nM - fm) < WGM ? (nM - fm) : WGM;
        u.pm = fm + ((wgid % nig) % gsz); u.pn = (wgid % nig) / gsz; u.e = 0; u.j = u.pn; return true;
    }
};
struct MoeOrder {
    int nN, G, c, NT; const int* tile_e;
    __device__ bool next(int i, Unit& u) const {
        const int L = i * G + c; const int total = (NT + NLAT / 256) * nN; if (L >= total) return false;
        const int tile = L / nN, j = L - tile * nN; int e, pm;
        if (tile < NT) { e = tile_e[tile]; pm = tile; } else { e = NE; pm = MAXTILES + (tile - NT); }
        u.pm = pm; u.pn = e * nN + j; u.e = e; u.j = j; return true;
    }
};

typedef __bf16 bf16x2n __attribute__((ext_vector_type(2))); typedef float f32x2n __attribute__((ext_vector_type(2)));
__device__ __forceinline__ unsigned cvt_pk_bf16(float lo, float hi) { const f32x2n v = {lo, hi}; return __builtin_bit_cast(unsigned, __builtin_convertvector(v, bf16x2n)); }

template <class Epi, class Sched, bool ALIGN_EPI, bool SP2, bool GATHER>
__device__ __forceinline__ void gemm_phase(PG8_LAS unsigned char* lds, const Gemm g, const Sched& S, const Epi& E) {
    const int tid = threadIdx.x, wid = __builtin_amdgcn_readfirstlane(tid >> 6), lane = tid & 63, wr = wid >> 2, wc = wid & 3, fr = lane & 15, fq = lane >> 4;
    const int K = g.K, nt = K / BK;
    const size_t kstep = (size_t)(BK * 2);
    const size_t hstep = (size_t)HALF * K * 2;
    const size_t tstep = 2 * hstep;
    unsigned voffB[2]; unsigned va[2][2];
#pragma unroll
    for (int i = 0; i < 2; ++i) { int R, C; stage_rc(tid * 16 + i * 8192, R, C); const int Rb = Epi::PERM ? ((R & ~31) + perm32(R & 31)) : R;
        voffB[i] = (unsigned)(Rb * K + C) * 2u;
        va[0][i] = (unsigned)(R * K + C) * 2u; va[1][i] = va[0][i]; }
    const size_t ah = GATHER ? (size_t)0 : hstep;
#define PG8_GOFF(dst, ub) do { _Pragma("unroll") for (int _h = 0; _h < 2; ++_h) _Pragma("unroll") for (int _i = 0; _i < 2; ++_i) { int _R, _C; stage_rc(tid * 16 + _i * 8192, _R, _C); \
        dst[_h][_i] = (unsigned)(idxt[(ub) * 256 + _h * 128 + _R] * K + _C) * 2u; } } while (0)
    const unsigned ldsw = (unsigned)wid * 1024u;
    const int aoff = lds_byte(wr * 64 + fr, fq * 8), boff = lds_byte(wc * 32 + fr, fq * 8);
    PG8_LAS int* idxt = (PG8_LAS int*)(lds + IDX_OFF);
#define PG8_SA(b, h) (((b) * 2 + (h)) * HTB)
#define PG8_SB(b, h) ((4 + (b) * 2 + (h)) * HTB)
#define PG8_STAGE(bufoff, gbase, voff) do { _Pragma("unroll") for (int _i = 0; _i < 2; ++_i) \
        __builtin_amdgcn_global_load_lds((const unsigned*)((const char*)(gbase) + (voff)[_i]), (PG8_LAS unsigned*)(lds + (bufoff) + ldsw + _i * 8192), 16, 0, 0); } while (0)
#define PG8_LDA(dst, b, h) do { _Pragma("unroll") for (int m = 0; m < 4; ++m) _Pragma("unroll") for (int k = 0; k < 2; ++k) dst[m][k] = *(const PG8_LAS bf16x8*)(lds + PG8_SA(b, h) + aoff + m * 2048 + k * 1024); } while (0)
#define PG8_LDB(dst, b, h) do { _Pragma("unroll") for (int n = 0; n < 2; ++n) _Pragma("unroll") for (int k = 0; k < 2; ++k) dst[n][k] = *(const PG8_LAS bf16x8*)(lds + PG8_SB(b, h) + boff + n * 2048 + k * 1024); } while (0)
#define PG8_MMA(ai, bj, At, Bt) do { __builtin_amdgcn_s_setprio(1); _Pragma("unroll") for (int m = 0; m < 4; ++m) _Pragma("unroll") for (int n = 0; n < 2; ++n) _Pragma("unroll") for (int k = 0; k < 2; ++k) \
        acc[ai][bj][m][n] = __builtin_amdgcn_mfma_f32_16x16x32_bf16(Bt[n][k], At[m][k], acc[ai][bj][m][n], 0, 0, 0); __builtin_amdgcn_s_setprio(0); } while (0)
#define PG8_WAIT_V(n) asm volatile("s_waitcnt vmcnt(" #n ")" ::: "memory")
#define PG8_WAIT_L(n) asm volatile("s_waitcnt lgkmcnt(" #n ")" ::: "memory")
#define PG8_BAR __builtin_amdgcn_s_barrier()
#define PG8_SCHED __builtin_amdgcn_sched_barrier(0)
    Unit cur, nxt; int ui = 0;
    if (!S.next(0, cur)) return;
    if constexpr (GATHER) {
        Unit uu;
        for (int i = 0; i < IDX_UNITS; ++i) { if (!S.next(i, uu)) break; if (tid < 256) idxt[i * 256 + tid] = g.rowidx[(size_t)uu.pm * 256 + tid]; }
        asm volatile("s_waitcnt vmcnt(0) lgkmcnt(0)" ::: "memory"); PG8_BAR; asm volatile("" ::: "memory");
        PG8_GOFF(va, 0);
    }
    f32x4 acc[2][2][4][2];
#pragma unroll
    for (int a = 0; a < 2; ++a)
#pragma unroll
        for (int b = 0; b < 2; ++b)
#pragma unroll
            for (int m = 0; m < 4; ++m)
#pragma unroll
                for (int n = 0; n < 2; ++n) acc[a][b][m][n] = (f32x4){0.f, 0.f, 0.f, 0.f};
    bf16x8 At[4][2], B0[2][2], B1[2][2];
    const char* cA = (const char*)g.A + (GATHER ? (size_t)0 : (size_t)cur.pm * tstep); const char* cB = (const char*)g.Bt + (size_t)cur.pn * tstep;
    if constexpr (SP2) {
        PG8_STAGE(PG8_SB(0, 0), cB, voffB); PG8_STAGE(PG8_SB(0, 1), cB + hstep, voffB); PG8_STAGE(PG8_SA(0, 0), cA, va[0]); PG8_STAGE(PG8_SA(0, 1), cA + ah, va[1]);
        if (wr == 1) PG8_BAR;
        PG8_WAIT_V(2); PG8_BAR;
        PG8_STAGE(PG8_SB(1, 0), cB + kstep, voffB); PG8_STAGE(PG8_SA(1, 0), cA + kstep, va[0]); PG8_STAGE(PG8_SB(1, 1), cB + hstep + kstep, voffB);
        PG8_WAIT_V(6); PG8_BAR;
    } else {
        PG8_STAGE(PG8_SB(0, 0), cB, voffB); PG8_STAGE(PG8_SA(0, 0), cA, va[0]); PG8_STAGE(PG8_SB(0, 1), cB + hstep, voffB); PG8_STAGE(PG8_SA(0, 1), cA + ah, va[1]);
        if (wr == 1) PG8_BAR;
        PG8_WAIT_V(4); PG8_BAR;
        PG8_STAGE(PG8_SB(1, 0), cB + kstep, voffB); PG8_STAGE(PG8_SA(1, 0), cA + kstep, va[0]); PG8_STAGE(PG8_SB(1, 1), cB + hstep + kstep, voffB);
        PG8_WAIT_V(6); PG8_BAR;
    }
    for (;;) {
        const bool has_next = S.next(ui + 1, nxt);
        const char* nA = has_next ? (const char*)g.A + (GATHER ? (size_t)0 : (size_t)nxt.pm * tstep) : cA; const char* nB = has_next ? (const char*)g.Bt + (size_t)nxt.pn * tstep : cB;
        const int ubn = (has_next && ui + 1 < IDX_UNITS) ? (ui + 1) : ui;
#pragma unroll 1
        for (int t = 0; t < nt; t += 2) {
            const bool last = (t == nt - 2);
            const char* a1 = cA + (size_t)(t + 1) * kstep;
            const char* a2 = last ? nA : cA + (size_t)(t + 2) * kstep; const char* b2 = last ? nB : cB + (size_t)(t + 2) * kstep;
            const char* a3 = a2 + kstep; const char* b3 = b2 + kstep;
            unsigned v2[2][2];
#pragma unroll
            for (int h = 0; h < 2; ++h)
#pragma unroll
                for (int i = 0; i < 2; ++i) v2[h][i] = va[h][i];
            if constexpr (GATHER) { if (last) PG8_GOFF(v2, ubn); }
            if constexpr (SP2) {
            PG8_LDB(B0, 0, 0); PG8_LDB(B1, 0, 1); PG8_SCHED; PG8_LDA(At, 0, 0); PG8_STAGE(PG8_SA(1, 1), a1 + ah, va[1]);
            PG8_WAIT_V(8); PG8_WAIT_L(0); PG8_BAR; PG8_MMA(0, 0, At, B0); PG8_MMA(0, 1, At, B1); PG8_BAR; PG8_SCHED;
            PG8_LDA(At, 0, 1); PG8_STAGE(PG8_SB(0, 0), b2, voffB); PG8_STAGE(PG8_SB(0, 1), b2 + hstep, voffB); PG8_STAGE(PG8_SA(0, 0), a2, v2[0]);
            PG8_WAIT_V(8); PG8_WAIT_L(0); PG8_BAR; PG8_MMA(1, 0, At, B0); PG8_MMA(1, 1, At, B1); PG8_BAR; PG8_SCHED;
            PG8_LDB(B0, 1, 0); PG8_LDB(B1, 1, 1); PG8_SCHED; PG8_LDA(At, 1, 0); PG8_STAGE(PG8_SA(0, 1), a2 + ah, v2[1]);
            PG8_WAIT_V(8); PG8_WAIT_L(0); PG8_BAR; PG8_MMA(0, 0, At, B0); PG8_MMA(0, 1, At, B1); PG8_BAR; PG8_SCHED;
            PG8_LDA(At, 1, 1); PG8_STAGE(PG8_SB(1, 0), b3, voffB); PG8_STAGE(PG8_SB(1, 1), b3 + hstep, voffB); PG8_STAGE(PG8_SA(1, 0), a3, v2[0]);
            PG8_WAIT_V(8); PG8_WAIT_L(0); PG8_BAR; PG8_MMA(1, 0, At, B0); PG8_MMA(1, 1, At, B1); PG8_BAR; PG8_SCHED;
            } else {
            PG8_LDB(B0, 0, 0); PG8_SCHED; PG8_LDA(At, 0, 0); PG8_STAGE(PG8_SA(1, 1), a1 + ah, va[1]);
            PG8_WAIT_L(8); PG8_BAR; PG8_WAIT_L(0); PG8_MMA(0, 0, At, B0); PG8_BAR; PG8_SCHED;
            PG8_LDB(B1, 0, 1); PG8_STAGE(PG8_SB(0, 0), b2, voffB);
            PG8_BAR; PG8_WAIT_L(0); PG8_MMA(0, 1, At, B1); PG8_BAR;
            PG8_LDA(At, 0, 1); PG8_STAGE(PG8_SA(0, 0), a2, v2[0]);
            PG8_BAR; PG8_WAIT_L(0); PG8_MMA(1, 0, At, B0); PG8_BAR; PG8_SCHED;
            PG8_STAGE(PG8_SB(0, 1), b2 + hstep, voffB);
            PG8_WAIT_V(6); PG8_BAR; PG8_MMA(1, 1, At, B1); PG8_BAR;
            PG8_LDB(B0, 1, 0); PG8_SCHED; PG8_LDA(At, 1, 0); PG8_STAGE(PG8_SA(0, 1), a2 + ah, v2[1]);
            PG8_WAIT_L(8); PG8_BAR; PG8_WAIT_L(0); PG8_MMA(0, 0, At, B0); PG8_BAR; PG8_SCHED;
            PG8_LDB(B1, 1, 1); PG8_STAGE(PG8_SB(1, 0), b3, voffB);
            PG8_BAR; PG8_WAIT_L(0); PG8_MMA(0, 1, At, B1); PG8_BAR;
            PG8_LDA(At, 1, 1); PG8_STAGE(PG8_SA(1, 0), a3, v2[0]);
            PG8_BAR; PG8_WAIT_L(0); PG8_MMA(1, 0, At, B0); PG8_BAR; PG8_SCHED;
            PG8_STAGE(PG8_SB(1, 1), b3 + hstep, voffB);
            PG8_WAIT_V(6); PG8_BAR; PG8_MMA(1, 1, At, B1); PG8_BAR;
            }
        }
        if constexpr (ALIGN_EPI) { if (wr == 0) PG8_BAR; }
        E(acc, cur, wr, wc, fr, fq);
        if (!has_next) break;
#pragma unroll
        for (int a = 0; a < 2; ++a)
#pragma unroll
            for (int b = 0; b < 2; ++b)
#pragma unroll
                for (int m = 0; m < 4; ++m)
#pragma unroll
                    for (int n = 0; n < 2; ++n) acc[a][b][m][n] = (f32x4){0.f, 0.f, 0.f, 0.f};
        cur = nxt; cA = nA; cB = nB; ++ui;
        if constexpr (GATHER) PG8_GOFF(va, ubn);
        if constexpr (ALIGN_EPI) { if (wr == 1) PG8_BAR; }
    }
    PG8_WAIT_V(0);
    if constexpr (!ALIGN_EPI) { if (wr == 0) PG8_BAR; }
    PG8_BAR;
#undef PG8_SA
#undef PG8_GOFF
#undef PG8_SB
#undef PG8_STAGE
#undef PG8_LDA
#undef PG8_LDB
#undef PG8_MMA
#undef PG8_WAIT_V
#undef PG8_WAIT_L
#undef PG8_BAR
#undef PG8_SCHED
}
}

#define XB_TMO      128
#define XB_XCNT(j)  (256  + 64 * (j))
#define XB_XSUB(j)  (1280 + 64 * (j))
#define XB_XGEN(j)  (2304 + 64 * (j))
#define XB_TOP      3328
#define XB_TOPGEN   3392
#define XCD_BAR_WORDS 3456
#define XB_SPIN_CAP (1u << 18)
__device__ __forceinline__ unsigned xb_ld(unsigned* p)              { return __hip_atomic_load(p, __ATOMIC_RELAXED, __HIP_MEMORY_SCOPE_AGENT); }
__device__ __forceinline__ unsigned xb_add(unsigned* p, unsigned v) { return __hip_atomic_fetch_add(p, v, __ATOMIC_RELAXED, __HIP_MEMORY_SCOPE_AGENT); }
__device__ __forceinline__ unsigned xb_xcc_id() { return (unsigned)__builtin_amdgcn_s_getreg((3 << 11) | 20) & 0xFu; }
#define XB_SPIN(cond, bar) do { unsigned _sp = 0; while (cond) { __builtin_amdgcn_s_sleep(1); \
    if ((++_sp & 255u) == 0u) { if (xb_ld(&(bar)[XB_TMO])) break; if (_sp > XB_SPIN_CAP) { atomicAdd(&(bar)[XB_TMO], 1u); break; } } } } while (0)
struct XcdBarrier { unsigned* bar; unsigned x; volatile LAS unsigned* st; };
__device__ __forceinline__ XcdBarrier xcd_barrier_post(unsigned* bar, volatile LAS unsigned* st) {
    XcdBarrier b; b.bar = bar; b.x = xb_xcc_id(); b.st = st;
    if (threadIdx.x == 0) (void)xb_add(&bar[XB_XCNT(b.x)], 1u);
    return b;
}
__device__ __forceinline__ void xcd_barrier_complete(unsigned* bar, unsigned x, unsigned& nloc, unsigned& nx) {
    const unsigned G = gridDim.x * gridDim.y * gridDim.z;
    unsigned sum, cnt, mine, sp = 0u;
    for (;;) {
        sum = 0u; cnt = 0u; mine = 0u;
#pragma unroll
        for (unsigned j = 0; j < 16; ++j) { const unsigned c = xb_ld(&bar[XB_XCNT(j)]); sum += c; cnt += (c > 0u) ? 1u : 0u; mine = (j == x) ? c : mine; }
        if (sum == G) break;
        __builtin_amdgcn_s_sleep(1);
        if ((++sp & 255u) == 0u) { if (xb_ld(&bar[XB_TMO])) break; if (sp > XB_SPIN_CAP) { atomicAdd(&bar[XB_TMO], 1u); break; } }
    }
    nloc = mine > 0u ? mine : 1u; nx = cnt > 0u ? cnt : 1u;
}
__device__ __forceinline__ void xcd_barrier(const XcdBarrier& b) {
    asm volatile("s_waitcnt vmcnt(0)" ::: "memory");
    __syncthreads();
    if (threadIdx.x == 0) {
        unsigned* bar = b.bar;
        __builtin_amdgcn_s_waitcnt(0);
        unsigned nloc = b.st[0], nx = b.st[1];
        if (nloc == 0u) { xcd_barrier_complete(bar, b.x, nloc, nx); b.st[0] = nloc; b.st[1] = nx; }
        const unsigned old = xb_add(&bar[XB_XSUB(b.x)], 1u);
        const unsigned gen = old / nloc;
        if (old + 1u == (gen + 1u) * nloc) {
            __builtin_amdgcn_fence(__ATOMIC_RELEASE, "agent");
            asm volatile("s_waitcnt vmcnt(0)" ::: "memory");
            const unsigned og = xb_add(&bar[XB_TOP], 1u);
            const unsigned tg = og / nx;
            if (og + 1u == (tg + 1u) * nx) xb_add(&bar[XB_TOPGEN], 1u);
            else XB_SPIN(xb_ld(&bar[XB_TOPGEN]) == tg, bar);
            __builtin_amdgcn_fence(__ATOMIC_ACQUIRE, "agent");
            xb_add(&bar[XB_XGEN(b.x)], 1u);
            asm volatile("s_waitcnt vmcnt(0)" ::: "memory");
        } else {
            XB_SPIN(xb_ld(&bar[XB_XGEN(b.x)]) == gen, bar);
            __builtin_amdgcn_fence(__ATOMIC_ACQUIRE, "agent");
            asm volatile("s_waitcnt vmcnt(0)" ::: "memory");
        }
    }
    __syncthreads();
}

constexpr size_t MiB = 1u << 20;
constexpr size_t al(size_t x) { return (x + 4095) & ~(size_t)4095; }
constexpr size_t WS_CTL = 0, CTL_ZERO_BYTES = 1 * MiB;
constexpr int CW_BAR = 4096;
constexpr int CW_CNT = 16384;
constexpr int CW_NT = 16384 + 512;
constexpr size_t WS_MOD = 1 * MiB;
constexpr size_t WS_TILE_E = WS_MOD + 256 * 1024;
constexpr size_t WS_PADSTART = WS_TILE_E + 16 * 1024;
constexpr size_t WS_ROWTOK = 2 * MiB;
constexpr size_t WS_EIDX = 4 * MiB;
constexpr size_t WS_GATE = 5 * MiB;
constexpr size_t WS_DEST = 6 * MiB;
constexpr size_t WS_WIN = 8 * MiB;
constexpr size_t WS_WLORA = WS_WIN + al((size_t)NP * D * 2);
constexpr size_t WS_WBRRW = WS_WLORA + al((size_t)NLORA * KLORA * 2);
constexpr size_t WS_WBRGLA = WS_WBRRW + al((size_t)D * RWW * 2);
constexpr size_t WS_WOUT = WS_WBRGLA + al((size_t)D * RWW * 2);
constexpr size_t WS_WROUTER = WS_WOUT + al((size_t)D * D * 2);
constexpr size_t WS_WGU = WS_WROUTER + al((size_t)NE * D * 2);
constexpr size_t WS_WD = WS_WGU + al((size_t)(NE + 1) * 512 * D * 2);
constexpr size_t WS_PERSIST_END = WS_WD + al((size_t)(NE + 1) * D * FF * 2);
constexpr size_t WS_REGB = WS_PERSIST_END;
constexpr size_t SZ512F = al((size_t)MR * RWW * 4), SZ256F = al((size_t)MR * 256 * 4), SZ512H = al((size_t)MR * RWW * 2);
constexpr size_t WS_A1 = WS_REGB;
constexpr size_t WS_A2 = WS_A1;
constexpr size_t WS_KSUM = WS_A2 + al((size_t)MR * KLORA * 2);
static_assert(WS_KSUM + SZ512H <= WS_A1 + al((size_t)MR * D * 2), "A2 + KSUM fit in the A1 slot");
constexpr size_t WS_P = WS_A1 + al((size_t)MR * D * 2);
constexpr size_t WS_RB = WS_P + al((size_t)MR * NP * 2);
constexpr size_t WS_VB = WS_RB + SZ512H, WS_KKB = WS_VB + SZ512H, WS_KMF = WS_KKB + SZ512H, WS_KMB = WS_KMF + SZ512H, WS_BVF = WS_KMB + SZ512H, WS_BVB = WS_BVF + SZ512H;
constexpr size_t WS_LWF = WS_BVB + SZ512H, WS_LWB = WS_LWF + SZ512F;
constexpr size_t SZ256H = al((size_t)MR * 256 * 2);
constexpr size_t WS_QGB = WS_LWB + SZ512F, WS_KGB = WS_QGB + SZ256H, WS_VGB = WS_KGB + SZ256H, WS_LAF = WS_VGB + SZ512H, WS_LAB = WS_LAF + SZ256F;
constexpr size_t WS_RWG = WS_LAB + SZ256F;
constexpr size_t WS_ORWF = WS_RWG + SZ512H, WS_ORWB = WS_ORWF + SZ512H, WS_OGLF = WS_ORWB + SZ512H, WS_OGLB = WS_OGLF + SZ512H;
constexpr int CH = 64, NCHUNK = (CTXL + SEQ) / CH, NU_RW = 64 * NCHUNK, NU_GL = 32 * NCHUNK;
constexpr size_t WS_RH = WS_OGLB + SZ512H;
constexpr size_t WS_YL = WS_RH + al((size_t)NU_RW * 4096 * 2);
constexpr size_t WS_HH = WS_YL + al((size_t)NU_RW * 4096 * 2);
constexpr size_t WS_INTRA = WS_HH + al((size_t)NU_RW * 4096 * 2);
constexpr size_t WS_KV = WS_INTRA + al((size_t)NU_GL * 8192 * 2);
constexpr size_t WS_DD = WS_KV + al((size_t)NU_GL * 8192 * 2);
constexpr size_t WS_END_MIX = WS_DD + al((size_t)NU_GL * 64 * 4);
constexpr size_t OUT_GT = 0, OUT_QE = (size_t)NU_RW * 4096 * 2;
static_assert(OUT_QE + (size_t)NU_GL * 4096 * 2 <= (size_t)NLAT * D * 4, "scan scratch fits in d_out");
constexpr size_t WS_YRW = WS_LWF, WS_YGLA = WS_LWB, WS_Z = WS_HH;
static_assert((size_t)NLAT * D * 2 <= (size_t)NU_RW * 4096 * 2, "Z fits in the HH slot");
constexpr size_t WS_X1 = WS_REGB;
constexpr size_t WS_A3 = WS_X1 + al((size_t)NLAT * D * 4);
constexpr size_t WS_LOGITS = WS_A3 + al((size_t)NLAT * D * 2);
constexpr size_t WS_ACT = WS_LOGITS + al((size_t)NLAT * NE * 4);
constexpr size_t WS_Y = WS_ACT + al((size_t)NROWS_E * FF * 2);
constexpr size_t WS_END_MOE = WS_Y + al((size_t)NROWS_E * D);
constexpr size_t WS_END = WS_END_MIX > WS_END_MOE ? WS_END_MIX : WS_END_MOE;
static_assert(WS_END <= (size_t)2048 * MiB, "workspace map exceeds 2 GiB");

constexpr int RING_BYTES = 131072;
constexpr int IDX_BYTES = pg8::IDX_UNITS * 256 * 4;
constexpr int MISC_OFF = RING_BYTES + IDX_BYTES;
constexpr int LDS_BYTES = MISC_OFF + 256;
static_assert(pg8::IDX_OFF == RING_BYTES, "gather table sits right above the stage buffers");
constexpr int NWAVES = 8, NTHR = 512;

struct Args { const float* in[36]; float* out; unsigned char* ws; int ph_lo, ph_hi; };

struct Frame {
    LAS unsigned char* lds;
    int tid, lane, wave, G, gw, NGW;
    const float* const* in; float* out; unsigned char* ws; unsigned* ctl;
};

__device__ __forceinline__ float wave_sum(float v) {
#pragma unroll
    for (int o = 1; o < 64; o <<= 1) v += __shfl_xor(v, o);
    return v;
}
__device__ __forceinline__ unsigned f2bf(float f) { unsigned u = __builtin_bit_cast(unsigned, f); return (u + 0x7fffu + ((u >> 16) & 1u)) >> 16; }
typedef __bf16 bf16x2v __attribute__((ext_vector_type(2)));
__device__ __forceinline__ unsigned pk2(float lo, float hi) { const f32x2 v = {lo, hi}; return __builtin_bit_cast(unsigned, __builtin_convertvector(v, bf16x2v)); }
__device__ __forceinline__ float bflo(unsigned w) { return __builtin_bit_cast(float, w << 16); }
__device__ __forceinline__ float bfhi(unsigned w) { return __builtin_bit_cast(float, w & 0xffff0000u); }
__device__ __forceinline__ float sigmoidf_(float x) { return 1.0f / (1.0f + __expf(-x)); }
__device__ __forceinline__ float siluf_(float x) { return x / (1.0f + __expf(-x)); }

__device__ __forceinline__ void ln_stats(const f32x4 (&v)[4], float& mean, float& rstd) {
    float s = 0.f;
#pragma unroll
    for (int j = 0; j < 4; ++j) s += (v[j].x + v[j].y) + (v[j].z + v[j].w);
    mean = wave_sum(s) * (1.f / D); float s2 = 0.f;
#pragma unroll
    for (int j = 0; j < 4; ++j) { const f32x4 d = v[j] - mean; s2 += (d.x * d.x + d.y * d.y) + (d.z * d.z + d.w * d.w); }
    rstd = 1.f / sqrtf(wave_sum(s2) * (1.f / D) + LN_EPS);
}

__device__ __forceinline__ void ld_row_bf16(const bf16* row, int lane, f32x4 (&v)[4]) {
    const v4u a = *(const v4u*)(row + 8 * lane), b = *(const v4u*)(row + 512 + 8 * lane);
    v[0] = (f32x4){bflo(a.x), bfhi(a.x), bflo(a.y), bfhi(a.y)}; v[1] = (f32x4){bflo(a.z), bfhi(a.z), bflo(a.w), bfhi(a.w)};
    v[2] = (f32x4){bflo(b.x), bfhi(b.x), bflo(b.y), bfhi(b.y)}; v[3] = (f32x4){bflo(b.z), bfhi(b.z), bflo(b.w), bfhi(b.w)};
}
__device__ __forceinline__ int rowcol(int lane, int j) { return 512 * (j >> 1) + 8 * lane + 4 * (j & 1); }
__device__ __forceinline__ void ph_x1pre_nomix(Frame& F) {
    const float* x = F.in[0];
    for (int m = F.gw; m < NLAT; m += F.NGW) {
        bf16* o = (bf16*)(F.ws + WS_X1) + (size_t)m * D;
#pragma unroll
        for (int h = 0; h < 2; ++h) { const float* xr = x + (size_t)m * D + 512 * h + 8 * F.lane; const f32x4 a = *(const f32x4*)xr * ALPHA, b = *(const f32x4*)(xr + 4) * ALPHA;
            v4u w; w.x = pk2(a.x, a.y); w.y = pk2(a.z, a.w); w.z = pk2(b.x, b.y); w.w = pk2(b.z, b.w); *(v4u*)(o + 512 * h + 8 * F.lane) = w; }
    }
}
__device__ __forceinline__ void ph_ln1(Frame& F) {
    const float* lw = F.in[26]; const float* lb = F.in[27]; const float* mod = (const float*)(F.ws + WS_MOD);
    bf16* A3 = (bf16*)(F.ws + WS_A3); const bf16* X1P = (const bf16*)(F.ws + WS_X1);
    constexpr int NR = 4;
    for (int m0 = F.gw; m0 < NLAT; m0 += NR * F.NGW) {
        v4u w[NR][2];
#pragma unroll
        for (int r = 0; r < NR; ++r) { const int mm = m0 + r * F.NGW; const bf16* row = X1P + (size_t)(mm < NLAT ? mm : m0) * D; w[r][0] = *(const v4u*)(row + 8 * F.lane); w[r][1] = *(const v4u*)(row + 512 + 8 * F.lane); }
        __builtin_amdgcn_sched_barrier(0);
#pragma unroll
        for (int r = 0; r < NR; ++r) { const int mm = m0 + r * F.NGW; const int m = mm < NLAT ? mm : m0; const int b = m / SEQ;
            f32x4 v[4];
            v[0] = (f32x4){bflo(w[r][0].x), bfhi(w[r][0].x), bflo(w[r][0].y), bfhi(w[r][0].y)}; v[1] = (f32x4){bflo(w[r][0].z), bfhi(w[r][0].z), bflo(w[r][0].w), bfhi(w[r][0].w)};
            v[2] = (f32x4){bflo(w[r][1].x), bfhi(w[r][1].x), bflo(w[r][1].y), bfhi(w[r][1].y)}; v[3] = (f32x4){bflo(w[r][1].z), bfhi(w[r][1].z), bflo(w[r][1].w), bfhi(w[r][1].w)};
            float mean, rstd; ln_stats(v, mean, rstd);
#if MS >= 2
            f32x4 h[4];
#pragma unroll
            for (int j = 0; j < 4; ++j) { const int c = rowcol(F.lane, j);
                const f32x4 x1 = (v[j] - mean) * rstd * *(const f32x4*)(lw + c) + *(const f32x4*)(lb + c);
                h[j] = x1 * (*(const f32x4*)(mod + b * 6144 + 4096 + c) + 1.0f) + *(const f32x4*)(mod + b * 6144 + 3072 + c); }
            bf16* ao = A3 + (size_t)m * D;
            { v4u o; o.x = pk2(h[0].x, h[0].y); o.y = pk2(h[0].z, h[0].w); o.z = pk2(h[1].x, h[1].y); o.w = pk2(h[1].z, h[1].w); *(v4u*)(ao + 8 * F.lane) = o;
              o.x = pk2(h[2].x, h[2].y); o.y = pk2(h[2].z, h[2].w); o.z = pk2(h[3].x, h[3].y); o.w = pk2(h[3].z, h[3].w); *(v4u*)(ao + 512 + 8 * F.lane) = o; }
#endif
        }
    }
}
__device__ __forceinline__ f32x4 fp8x4(unsigned w) { const f32x2 lo = __builtin_amdgcn_cvt_pk_f32_fp8((int)w, false), hi = __builtin_amdgcn_cvt_pk_f32_fp8((int)w, true); return (f32x4){lo.x, lo.y, hi.x, hi.y}; }
__device__ __forceinline__ void ph_final(Frame& F) {
    const float* lw = F.in[34]; const float* lb = F.in[35]; const float* mod = (const float*)(F.ws + WS_MOD);
    const float* lw1 = F.in[26]; const float* lb1 = F.in[27]; const bf16* X1P = (const bf16*)(F.ws + WS_X1);
    const unsigned char* Y = F.ws + WS_Y; const int* DEST = (const int*)(F.ws + WS_DEST); const float* GATE = (const float*)(F.ws + WS_GATE);
    const int c0 = 16 * F.lane;
    for (int m0 = F.gw; m0 < NLAT; m0 += 2 * F.NGW) {
        int mm[2]; mm[0] = m0; mm[1] = (m0 + F.NGW < NLAT) ? m0 + F.NGW : m0;
        v4u xw[2][2];
#if MS >= 2
        v4u dw[2][2]; f32x4 gw[2][2];
#pragma unroll
        for (int r = 0; r < 2; ++r) { dw[r][0] = *(const v4u*)(DEST + mm[r] * 8); dw[r][1] = *(const v4u*)(DEST + mm[r] * 8 + 4); gw[r][0] = *(const f32x4*)(GATE + mm[r] * 8); gw[r][1] = *(const f32x4*)(GATE + mm[r] * 8 + 4); }
#endif
#pragma unroll
        for (int r = 0; r < 2; ++r) { const bf16* row = X1P + (size_t)mm[r] * D + c0; xw[r][0] = *(const v4u*)row; xw[r][1] = *(const v4u*)(row + 8); }
#if MS >= 2
        v4u yw[2][TOPK + 1];
#pragma unroll
        for (int r = 0; r < 2; ++r) {
            int dr[TOPK]; dr[0] = (int)dw[r][0].x; dr[1] = (int)dw[r][0].y; dr[2] = (int)dw[r][0].z; dr[3] = (int)dw[r][0].w; dr[4] = (int)dw[r][1].x; dr[5] = (int)dw[r][1].y; dr[6] = (int)dw[r][1].z; dr[7] = (int)dw[r][1].w;
#pragma unroll
            for (int k = 0; k <= TOPK; ++k) yw[r][k] = *(const v4u*)(Y + (size_t)(k < TOPK ? dr[k < TOPK ? k : 0] : SH_ROW0 + mm[r]) * D + c0); }
        __builtin_amdgcn_sched_barrier(0);
#endif
#pragma unroll
        for (int r = 0; r < 2; ++r) { const int m = mm[r]; const int b = m / SEQ;
            f32x4 v[4];
            v[0] = (f32x4){bflo(xw[r][0].x), bfhi(xw[r][0].x), bflo(xw[r][0].y), bfhi(xw[r][0].y)}; v[1] = (f32x4){bflo(xw[r][0].z), bfhi(xw[r][0].z), bflo(xw[r][0].w), bfhi(xw[r][0].w)};
            v[2] = (f32x4){bflo(xw[r][1].x), bfhi(xw[r][1].x), bflo(xw[r][1].y), bfhi(xw[r][1].y)}; v[3] = (f32x4){bflo(xw[r][1].z), bfhi(xw[r][1].z), bflo(xw[r][1].w), bfhi(xw[r][1].w)};
            { float mean1, rstd1; ln_stats(v, mean1, rstd1);
#pragma unroll
              for (int j = 0; j < 4; ++j) { const int c = c0 + 4 * j; v[j] = ((v[j] - mean1) * rstd1 * *(const f32x4*)(lw1 + c) + *(const f32x4*)(lb1 + c)) * ALPHA; } }
#if MS >= 2
            const float gt[TOPK] = {gw[r][0].x * 0.0625f, gw[r][0].y * 0.0625f, gw[r][0].z * 0.0625f, gw[r][0].w * 0.0625f, gw[r][1].x * 0.0625f, gw[r][1].y * 0.0625f, gw[r][1].z * 0.0625f, gw[r][1].w * 0.0625f};
#pragma unroll
            for (int j = 0; j < 4; ++j) { const unsigned ws8 = j == 0 ? yw[r][TOPK].x : (j == 1 ? yw[r][TOPK].y : (j == 2 ? yw[r][TOPK].z : yw[r][TOPK].w));
                f32x4 mo = fp8x4(ws8) * 0.0625f;
#pragma unroll
                for (int k = 0; k < TOPK; ++k) { const unsigned wk = j == 0 ? yw[r][k].x : (j == 1 ? yw[r][k].y : (j == 2 ? yw[r][k].z : yw[r][k].w)); mo += fp8x4(wk) * gt[k]; }
                v[j] += *(const f32x4*)(mod + b * 6144 + 5120 + c0 + 4 * j) * mo; }
#endif
            float mean, rstd; ln_stats(v, mean, rstd);
            float* o = F.out + (size_t)m * D + c0;
#pragma unroll
            for (int j = 0; j < 4; ++j) { const int c = c0 + 4 * j; *(f32x4*)(o + 4 * j) = (v[j] - mean) * rstd * *(const f32x4*)(lw + c) + *(const f32x4*)(lb + c); }
        }
    }
}


#if MS >= 2
template <int MODE>
__device__ __forceinline__ void cvt_item(const float* W, int Nsrc, int nblk, bf16* WT, int row_off, int dpitch, LAS float* scr, int item, int lane) {
    const int kb = item / nblk, nb = item - kb * nblk, k0 = 64 * kb, n0 = 32 * nb;
    const int nn = n0 + (lane & 31);
#pragma unroll 8
    for (int i = 0; i < 32; ++i) { const int kk = 2 * i + (lane >> 5); scr[kk * 33 + (lane & 31)] = (nn < Nsrc) ? W[(size_t)(k0 + kk) * Nsrc + nn] : 0.f; }
    LDS_WAIT(); asm volatile("" ::: "memory");
    const int c = lane & 7;
#pragma unroll
    for (int j = 0; j < 4; ++j) { const int n = (lane >> 3) + 8 * j; const LAS float* s = scr + (8 * c) * 33 + n;
        v4u o; o.x = pk2(s[0 * 33], s[1 * 33]); o.y = pk2(s[2 * 33], s[3 * 33]); o.z = pk2(s[4 * 33], s[5 * 33]); o.w = pk2(s[6 * 33], s[7 * 33]);
        const int ng = n0 + n; int dr = ng;
        if (MODE == 1) { const int i2 = ng & 255; dr = 8 * (i2 >> 2) + (i2 & 3) + ((ng >= 256) ? 4 : 0); }
        *(v4u*)(WT + (size_t)(row_off + dr) * dpitch + k0 + 8 * c) = o; }
    LDS_WAIT(); asm volatile("" ::: "memory");
}

template <int MODE>
__device__ __forceinline__ void cvt_item_reg(const float* W, int Nsrc, bf16* WT, int row_off, int dpitch, int k0, int n0, int lane) {
    const float* src = W + (size_t)k0 * Nsrc + n0 + 4 * lane;
    f32x4 v[32];
#pragma unroll
    for (int i = 0; i < 32; ++i) v[i] = __builtin_nontemporal_load((const f32x4*)(src + (size_t)i * Nsrc));
#pragma unroll
    for (int j = 0; j < 4; ++j) {
        const int ng = n0 + 4 * lane + j; int dr = ng;
        if (MODE == 1) { const int i2 = ng & 255; dr = 8 * (i2 >> 2) + (i2 & 3) + ((ng >= 256) ? 4 : 0); }
        v4u* dst = (v4u*)(WT + (size_t)(row_off + dr) * dpitch + k0);
#pragma unroll
        for (int q = 0; q < 4; ++q) { v4u o; o.x = pk2(v[8 * q][j], v[8 * q + 1][j]); o.y = pk2(v[8 * q + 2][j], v[8 * q + 3][j]); o.z = pk2(v[8 * q + 4][j], v[8 * q + 5][j]); o.w = pk2(v[8 * q + 6][j], v[8 * q + 7][j]); dst[q] = o; }
    }
}

constexpr int CVK = 32;
__device__ __forceinline__ void cvt_reg_load(const float* W, int Nsrc, int k0, int n0, int lane, f32x4 (&v)[CVK]) {
    const float* src = W + (size_t)k0 * Nsrc + n0 + 4 * lane;
#pragma unroll
    for (int i = 0; i < CVK; ++i) v[i] = __builtin_nontemporal_load((const f32x4*)(src + (size_t)i * Nsrc));
}
template <int MODE>
__device__ __forceinline__ void cvt_reg_store(bf16* WT, int row_off, int dpitch, int k0, int n0, int lane, const f32x4 (&v)[CVK]) {
#pragma unroll
    for (int j = 0; j < 4; ++j) {
        const int ng = n0 + 4 * lane + j; int dr = ng;
        if (MODE == 1) { const int i2 = ng & 255; dr = 8 * (i2 >> 2) + (i2 & 3) + ((ng >= 256) ? 4 : 0); }
        v4u* dst = (v4u*)(WT + (size_t)(row_off + dr) * dpitch + k0);
#pragma unroll
        for (int q = 0; q < CVK / 8; ++q) { v4u o; o.x = pg8::cvt_pk_bf16(v[8 * q][j], v[8 * q + 1][j]); o.y = pg8::cvt_pk_bf16(v[8 * q + 2][j], v[8 * q + 3][j]); o.z = pg8::cvt_pk_bf16(v[8 * q + 4][j], v[8 * q + 5][j]); o.w = pg8::cvt_pk_bf16(v[8 * q + 6][j], v[8 * q + 7][j]); dst[q] = o; }
    }
}
constexpr int CV_GU = (D / CVK) * 2, CV_DN = (FF / CVK) * 4, CV_NGU = (NE + 1) * CV_GU, CV_NITEM = CV_NGU + (NE + 1) * CV_DN;
__device__ __forceinline__ void cvx_load(const float* const* in, int it, int lane, f32x4 (&v)[CVK]) {
    if (it < CV_NGU) { const int e = it / CV_GU, ii = it - e * CV_GU; const float* src = (e < NE) ? in[30] + (size_t)e * D * 512 : in[32];
        cvt_reg_load(src, 512, CVK * (ii >> 1), 256 * (ii & 1), lane, v); }
    else { const int r = it - CV_NGU, e = r / CV_DN, ii = r - e * CV_DN; const float* src = (e < NE) ? in[31] + (size_t)e * FF * D : in[33];
        cvt_reg_load(src, D, CVK * (ii >> 2), 256 * (ii & 3), lane, v); }
}
__device__ __forceinline__ void cvx_store(unsigned char* ws, int it, int lane, const f32x4 (&v)[CVK]) {
    if (it < CV_NGU) { const int e = it / CV_GU, ii = it - e * CV_GU; cvt_reg_store<1>((bf16*)(ws + WS_WGU), e * 512, D, CVK * (ii >> 1), 256 * (ii & 1), lane, v); }
    else { const int r = it - CV_NGU, e = r / CV_DN, ii = r - e * CV_DN; cvt_reg_store<0>((bf16*)(ws + WS_WD), e * D, FF, CVK * (ii >> 2), 256 * (ii & 3), lane, v); }
}

#if MS >= 3
__device__ __forceinline__ float lora_val(const float* const* in, int n, int k) {
    if (n < 1024) { const int q = n >> 3, e8 = n & 7, dir = e8 >> 2, ch = q * 4 + (e8 & 3); return (k < 32) ? in[9][(size_t)(dir * 32 + k) * 512 + ch] : 0.f; }
    if (n < 2048) { const int m = n - 1024, q = m >> 3, e8 = m & 7, dir = e8 >> 2, ch = q * 4 + (e8 & 3); return (k >= 32 && k < 64) ? in[11][(size_t)(dir * 32 + (k - 32)) * 512 + ch] : 0.f; }
    if (n < 2560) { const int ch = n - 2048; return (k >= 64 && k < 160) ? in[12][(size_t)(k - 64) * 512 + ch] : 0.f; }
    { const int m = n - 2560, q = m >> 3, e8 = m & 7, dir = e8 >> 2, ch = q * 4 + (e8 & 3); return (k >= 160 && k < 176) ? in[19][(size_t)(dir * 16 + (k - 160)) * 256 + ch] : 0.f; }
}
#endif

__device__ __forceinline__ void ph_prologue(Frame& F) {
    {
        const float* c = F.in[1]; const float* cc = F.in[3]; const float* wa = F.in[4]; const float* ba = F.in[5];
        float* MOD = (float*)(F.ws + WS_MOD);
        LAS float* S = (LAS float*)F.lds; LAS float* red = (LAS float*)(F.lds + 32768);
        for (int it = blockIdx.x; it < 96; it += F.G) {
            for (int i = F.tid; i < 5120; i += NTHR) { const int r = i >> 10, k = i & 1023; const float cv = r < 4 ? c[r * 1024 + k] : cc[k]; S[i] = siluf_(cv); }
            __syncthreads();
            const int n = it * 64 + F.lane; float acc[5] = {0.f, 0.f, 0.f, 0.f, 0.f};
            for (int kk = 0; kk < 128; ++kk) { const int k = F.wave * 128 + kk; const float wv = wa[(size_t)k * 6144 + n];
#pragma unroll
                for (int r = 0; r < 5; ++r) acc[r] += S[r * 1024 + k] * wv; }
#pragma unroll
            for (int r = 0; r < 5; ++r) red[(F.wave * 5 + r) * 64 + F.lane] = acc[r];
            __syncthreads();
            if (F.wave == 0) {
#pragma unroll
                for (int r = 0; r < 5; ++r) { float s = 0.f;
#pragma unroll
                    for (int w = 0; w < 8; ++w) s += red[(w * 5 + r) * 64 + F.lane];
                    MOD[r * 6144 + n] = s + ba[n]; }
            }
            __syncthreads();
        }
    }
    {
        LAS float* scr = (LAS float*)(F.lds + F.wave * 16384);
        constexpr int I_IN = 16 * 168, I_BR = 8 * 32, I_OUT = 16 * 32, I_RT = 16 * 8, I_GU = 32 * 2, I_DN = 8 * 4;
        constexpr int T0 = I_IN, T1 = T0 + I_BR, T2 = T1 + I_BR, T3 = T2 + I_OUT, T4 = T3 + I_RT, T5 = T4 + (NE + 1) * I_GU, T6 = T5 + (NE + 1) * I_DN;
        unsigned char* ws = F.ws;
        for (int it = F.gw; it < T6; it += F.NGW) {
#if MS >= 3
            if (it < T0) { cvt_item<0>(F.in[6], IN_COLS, 168, (bf16*)(ws + WS_WIN), 0, D, scr, it, F.lane); continue; }
            if (it < T1) { cvt_item<0>(F.in[23], D, 32, (bf16*)(ws + WS_WBRRW), 0, RWW, scr, it - T0, F.lane); continue; }
            if (it < T2) { cvt_item<0>(F.in[24], D, 32, (bf16*)(ws + WS_WBRGLA), 0, RWW, scr, it - T1, F.lane); continue; }
            if (it < T3) { cvt_item<0>(F.in[25], D, 32, (bf16*)(ws + WS_WOUT), 0, D, scr, it - T2, F.lane); continue; }
#else
            if (it < T3) continue;
#endif
            if (it < T4) { cvt_item<0>(F.in[28], NE, 8, (bf16*)(ws + WS_WROUTER), 0, D, scr, it - T3, F.lane); continue; }
#if MS >= 3
            break;
#endif
            if (it < T5) { const int r = it - T4, e = r / I_GU, ii = r - e * I_GU;
                const float* src = (e < NE) ? F.in[30] + (size_t)e * D * 512 : F.in[32];
                cvt_item_reg<1>(src, 512, (bf16*)(ws + WS_WGU), e * 512, D, 32 * (ii >> 1), 256 * (ii & 1), F.lane); continue; }
            { const int r = it - T5, e = r / I_DN, ii = r - e * I_DN;
                const float* src = (e < NE) ? F.in[31] + (size_t)e * FF * D : F.in[33];
                cvt_item_reg<0>(src, D, (bf16*)(ws + WS_WD), e * D, FF, 32 * (ii >> 2), 256 * (ii & 3), F.lane); }
        }
    }
#if MS >= 3
    {
        bf16* WL = (bf16*)(F.ws + WS_WLORA);
        for (int idx = blockIdx.x * NTHR + F.tid; idx < NLORA * (KLORA / 8); idx += F.G * NTHR) {
            const int n = idx >> 5, k0 = (idx & 31) * 8; float v[8];
#pragma unroll
            for (int e = 0; e < 8; ++e) v[e] = lora_val(F.in, n, k0 + e);
            v4u o; o.x = pk2(v[0], v[1]); o.y = pk2(v[2], v[3]); o.z = pk2(v[4], v[5]); o.w = pk2(v[6], v[7]);
            *(v4u*)(WL + (size_t)n * KLORA + k0) = o;
        }
    }
#endif
}

struct EpiF32 {
    static constexpr bool PERM = false;
    float* C; int ldc;
    __device__ __forceinline__ void operator()(const f32x4 (&acc)[2][2][4][2], const pg8::Unit& u, int wr, int wc, int fr, int fq) const {
        const int row0 = u.pm * 256 + wr * 64 + fr, col0 = u.pn * 256 + wc * 32 + 4 * fq;
#pragma unroll
        for (int ai = 0; ai < 2; ++ai)
#pragma unroll
            for (int m = 0; m < 4; ++m) { float* rowp = C + (size_t)(row0 + ai * 128 + m * 16) * ldc + col0;
#pragma unroll
                for (int bj = 0; bj < 2; ++bj)
#pragma unroll
                    for (int n = 0; n < 2; ++n) *(f32x4*)(rowp + bj * 128 + n * 16) = acc[ai][bj][m][n]; }
    }
};
struct EpiSwiglu {
    static constexpr bool PERM = true;
    bf16* ACT;
    __device__ __forceinline__ void operator()(const f32x4 (&acc)[2][2][4][2], const pg8::Unit& u, int wr, int wc, int fr, int fq) const {
        const int row0 = u.pm * 256 + wr * 64 + fr, h0 = u.j * 128 + wc * 16 + 4 * fq;
#pragma unroll
        for (int ai = 0; ai < 2; ++ai)
#pragma unroll
            for (int m = 0; m < 4; ++m) { bf16* rowp = ACT + (size_t)(row0 + ai * 128 + m * 16) * FF + h0;
#pragma unroll
                for (int bj = 0; bj < 2; ++bj) { const f32x4 a = acc[ai][bj][m][0], b = acc[ai][bj][m][1];
                    v2u o; o.x = pg8::cvt_pk_bf16(siluf_(a[0]) * b[0], siluf_(a[1]) * b[1]); o.y = pg8::cvt_pk_bf16(siluf_(a[2]) * b[2], siluf_(a[3]) * b[3]);
                    *(v2u*)(rowp + bj * 64) = o; } }
    }
};
struct EpiRowsBf16 {
    static constexpr bool PERM = true;
    bf16* O; int ldc;
    __device__ __forceinline__ void operator()(const f32x4 (&acc)[2][2][4][2], const pg8::Unit& u, int wr, int wc, int fr, int fq) const {
        const int row0 = u.pm * 256 + wr * 64 + fr, col0 = u.j * 256 + wc * 32 + 8 * fq;
#pragma unroll
        for (int ai = 0; ai < 2; ++ai)
#pragma unroll
            for (int m = 0; m < 4; ++m) { bf16* rowp = O + (size_t)(row0 + ai * 128 + m * 16) * ldc + col0;
#pragma unroll
                for (int bj = 0; bj < 2; ++bj) { const f32x4 v0 = acc[ai][bj][m][0], v1 = acc[ai][bj][m][1];
                    v4u w; w.x = pg8::cvt_pk_bf16(v0[0], v0[1]); w.y = pg8::cvt_pk_bf16(v0[2], v0[3]); w.z = pg8::cvt_pk_bf16(v1[0], v1[1]); w.w = pg8::cvt_pk_bf16(v1[2], v1[3]);
                    *(v4u*)(rowp + bj * 128) = w; } }
    }
};

struct EpiRowsFp8 {
    static constexpr bool PERM = true;
    unsigned char* O;
    __device__ __forceinline__ void operator()(const f32x4 (&acc)[2][2][4][2], const pg8::Unit& u, int wr, int wc, int fr, int fq) const {
        const int row0 = u.pm * 256 + wr * 64 + fr, col0 = u.j * 256 + wc * 32 + 8 * fq;
#pragma unroll
        for (int ai = 0; ai < 2; ++ai)
#pragma unroll
            for (int m = 0; m < 4; ++m) { unsigned char* rowp = O + (size_t)(row0 + ai * 128 + m * 16) * D + col0;
#pragma unroll
                for (int bj = 0; bj < 2; ++bj) { f32x4 v0 = acc[ai][bj][m][0] * 16.0f, v1 = acc[ai][bj][m][1] * 16.0f;
#pragma unroll
                    for (int e = 0; e < 4; ++e) { v0[e] = __builtin_amdgcn_fmed3f(v0[e], -448.0f, 448.0f); v1[e] = __builtin_amdgcn_fmed3f(v1[e], -448.0f, 448.0f); }
                    int w0 = __builtin_amdgcn_cvt_pk_fp8_f32(v0[0], v0[1], 0, false); w0 = __builtin_amdgcn_cvt_pk_fp8_f32(v0[2], v0[3], w0, true);
                    int w1 = __builtin_amdgcn_cvt_pk_fp8_f32(v1[0], v1[1], 0, false); w1 = __builtin_amdgcn_cvt_pk_fp8_f32(v1[2], v1[3], w1, true);
                    v2u w; w.x = (unsigned)w0; w.y = (unsigned)w1; *(v2u*)(rowp + bj * 128) = w; } }
    }
};

__device__ __forceinline__ void ph_router(Frame& F) {
    pg8::Gemm g{(const bf16*)(F.ws + WS_A3), (const bf16*)(F.ws + WS_WROUTER), NLAT, NE, D, nullptr};
    pg8::StaticOrder S; S.init(NLAT, NE, F.G, (int)blockIdx.x);
    EpiF32 E{(float*)(F.ws + WS_LOGITS), NE};
    pg8::gemm_phase<EpiF32, pg8::StaticOrder, true, true, false>(F.lds, g, S, E);
}

__device__ __forceinline__ void ph_route(Frame& F) {
    const float* LOG = (const float*)(F.ws + WS_LOGITS); const float* rb = F.in[29];
    int* EIDX = (int*)(F.ws + WS_EIDX); float* GATE = (float*)(F.ws + WS_GATE); int* DEST = (int*)(F.ws + WS_DEST);
    unsigned* CNT = F.ctl + CW_CNT;
    const f32x4 bias = *(const f32x4*)(rb + 4 * F.lane);
    const float NEG = -3.0e38f;
    f32x4 lgn = *(const f32x4*)(LOG + (size_t)(F.gw < NLAT ? F.gw : 0) * NE + 4 * F.lane);
    for (int m = F.gw; m < NLAT; m += F.NGW) {
        const f32x4 lg = lgn;
        { const int mn = (m + F.NGW < NLAT) ? m + F.NGW : m; lgn = *(const f32x4*)(LOG + (size_t)mn * NE + 4 * F.lane); }
        float sc[4], sel[4];
#pragma unroll
        for (int i = 0; i < 4; ++i) { sc[i] = sigmoidf_(lg[i]); sel[i] = sc[i] + bias[i]; }
        float m1 = fmaxf(sel[0], sel[1]), m2 = fminf(sel[0], sel[1]);
        { const float a = sel[2]; const float n1 = fmaxf(m1, a); m2 = fmaxf(m2, fminf(m1, a)); m1 = n1; }
        { const float a = sel[3]; const float n1 = fmaxf(m1, a); m2 = fmaxf(m2, fminf(m1, a)); m1 = n1; }
#pragma unroll
        for (int o = 1; o < 8; o <<= 1) { const float b1 = __shfl_xor(m1, o), b2 = __shfl_xor(m2, o); const float n1 = fmaxf(m1, b1); m2 = fmaxf(fminf(m1, b1), fmaxf(m2, b2)); m1 = n1; }
        const float gs = m1 + m2; const int g = F.lane >> 3;
        int rank = 0;
#pragma unroll
        for (int gg = 0; gg < 8; ++gg) { const float og = __shfl(gs, gg * 8); rank += (og > gs || (og == gs && gg < g)) ? 1 : 0; }
        const bool keep = rank < 4;
#pragma unroll
        for (int i = 0; i < 4; ++i) sel[i] = keep ? sel[i] : NEG;
        int my_e = 0; float my_s = 0.f; float ssum = 0.f;
        for (int k = 0; k < TOPK; ++k) {
            float bv = sel[0]; int bi = 0;
#pragma unroll
            for (int i = 1; i < 4; ++i) if (sel[i] > bv) { bv = sel[i]; bi = i; }
            int be = 4 * F.lane + bi; float v = bv; int e = be;
#pragma unroll
            for (int o = 1; o < 64; o <<= 1) { const float ov = __shfl_xor(v, o); const int oe = __shfl_xor(e, o); if (ov > v || (ov == v && oe < e)) { v = ov; e = oe; } }
            const int owner = e >> 2, oi = e & 3;
            float s_own = 0.f;
            if (F.lane == owner) {
#pragma unroll
                for (int i = 0; i < 4; ++i) if (i == oi) { s_own = sc[i]; sel[i] = NEG; }
            }
            const float s = __shfl(s_own, owner);
            ssum += s;
            if (F.lane == k) { my_e = e; my_s = s; }
        }
        if (F.lane < TOPK) {
            const unsigned pos = __hip_atomic_fetch_add(CNT + my_e, 1u, __ATOMIC_RELAXED, __HIP_MEMORY_SCOPE_AGENT);
            EIDX[m * 8 + F.lane] = my_e; GATE[m * 8 + F.lane] = my_s / ssum * 2.5f; DEST[m * 8 + F.lane] = (int)pos;
        }
    }
}

__device__ __forceinline__ void ph_scatter(Frame& F) {
    LAS int* tstart = (LAS int*)F.lds;
    LAS int* scan = (LAS int*)(F.lds + 2048);
    LAS int* cnts = (LAS int*)(F.lds + 4096);
    int* EIDX = (int*)(F.ws + WS_EIDX); int* DEST = (int*)(F.ws + WS_DEST); int* ROWTOK = (int*)(F.ws + WS_ROWTOK); int* TILE_E = (int*)(F.ws + WS_TILE_E);
    unsigned* CNT = F.ctl + CW_CNT;
    int tiles = 0, cnt = 0;
    if (F.tid < NE) { cnt = (int)__hip_atomic_load(CNT + F.tid, __ATOMIC_RELAXED, __HIP_MEMORY_SCOPE_AGENT); tiles = (cnt + 255) >> 8; scan[F.tid] = tiles; cnts[F.tid] = cnt; }
    __syncthreads();
    for (int o = 1; o < NE; o <<= 1) { int v = 0; if (F.tid < NE && F.tid >= o) v = scan[F.tid - o]; __syncthreads(); if (F.tid < NE) scan[F.tid] += v; __syncthreads(); }
    if (F.tid < NE) { tstart[F.tid + 1] = scan[F.tid]; if (F.tid == 0) tstart[0] = 0; }
    __syncthreads();
    const int NT = tstart[NE];
    if (blockIdx.x == 0) {
        if (F.tid == 0) F.ctl[CW_NT] = (unsigned)NT;
        if (F.tid < NE) for (int t = tstart[F.tid]; t < tstart[F.tid + 1]; ++t) TILE_E[t] = F.tid;
    }
    for (int e = blockIdx.x; e < NE; e += F.G) { const int c0 = cnts[e], c1 = (tstart[e + 1] - tstart[e]) * 256, base = tstart[e] * 256;
        for (int p = c0 + F.tid; p < c1; p += NTHR) ROWTOK[base + p] = 0; }
    for (int i = blockIdx.x * NTHR + F.tid; i < NLAT; i += F.G * NTHR) ROWTOK[SH_ROW0 + i] = i;
    for (int i = blockIdx.x * NTHR + F.tid; i < NLAT * TOPK; i += F.G * NTHR) {
        const int e = EIDX[i], pos = DEST[i]; const int dr = tstart[e] * 256 + pos;
        DEST[i] = dr; ROWTOK[dr] = i >> 3;
    }
}

__device__ __forceinline__ void ph_exp1(Frame& F) {
    const int NT = (int)__hip_atomic_load(F.ctl + CW_NT, __ATOMIC_RELAXED, __HIP_MEMORY_SCOPE_AGENT);
    pg8::Gemm g{(const bf16*)(F.ws + WS_A3), (const bf16*)(F.ws + WS_WGU), 0, 0, D, (const int*)(F.ws + WS_ROWTOK)};
    pg8::MoeOrder S{2, F.G, (int)blockIdx.x, NT, (const int*)(F.ws + WS_TILE_E)};
    EpiSwiglu E{(bf16*)(F.ws + WS_ACT)};
    pg8::gemm_phase<EpiSwiglu, pg8::MoeOrder, true, true, true>(F.lds, g, S, E);
}
__device__ __forceinline__ void ph_exp2(Frame& F) {
    const int NT = (int)__hip_atomic_load(F.ctl + CW_NT, __ATOMIC_RELAXED, __HIP_MEMORY_SCOPE_AGENT);
    pg8::Gemm g{(const bf16*)(F.ws + WS_ACT), (const bf16*)(F.ws + WS_WD), 0, 0, FF, nullptr};
    pg8::MoeOrder S{4, F.G, (int)blockIdx.x, NT, (const int*)(F.ws + WS_TILE_E)};
    EpiRowsFp8 E{F.ws + WS_Y};
    pg8::gemm_phase<EpiRowsFp8, pg8::MoeOrder, true, true, false>(F.lds, g, S, E);
}
#endif

#if MS >= 3
__device__ __forceinline__ void unp8(const v4u w, float (&f)[8]) { f[0] = bflo(w.x); f[1] = bfhi(w.x); f[2] = bflo(w.y); f[3] = bfhi(w.y); f[4] = bflo(w.z); f[5] = bfhi(w.z); f[6] = bflo(w.w); f[7] = bfhi(w.w); }
__device__ __forceinline__ v4u pk8(const float (&f)[8]) { v4u o; o.x = pk2(f[0], f[1]); o.y = pk2(f[2], f[3]); o.z = pk2(f[4], f[5]); o.w = pk2(f[6], f[7]); return o; }
__device__ __forceinline__ void st8(float* p, const float (&f)[8]) { *(f32x4*)p = (f32x4){f[0], f[1], f[2], f[3]}; *(f32x4*)(p + 4) = (f32x4){f[4], f[5], f[6], f[7]}; }
__device__ __forceinline__ void ld8(const float* p, float (&f)[8]) { const f32x4 a = *(const f32x4*)p, b = *(const f32x4*)(p + 4); f[0] = a.x; f[1] = a.y; f[2] = a.z; f[3] = a.w; f[4] = b.x; f[5] = b.y; f[6] = b.z; f[7] = b.w; }

__device__ __forceinline__ void ph_a1(Frame& F) {
    const float* mod = (const float*)(F.ws + WS_MOD); bf16* A1 = (bf16*)(F.ws + WS_A1);
    constexpr int NR = 4;
    for (int m0 = F.gw; m0 < MR; m0 += NR * F.NGW) {
        f32x4 xv[NR][4];
#pragma unroll
        for (int r = 0; r < NR; ++r) { const int mm = m0 + r * F.NGW; const int m = mm < MR ? mm : m0;
            const float* src = (m < NLAT) ? F.in[0] + (size_t)m * D : F.in[2] + (size_t)(m - NLAT) * D;
            const f32x4* xr = (const f32x4*)src + F.lane;
#pragma unroll
            for (int j = 0; j < 4; ++j) xv[r][j] = __builtin_nontemporal_load(xr + 64 * j); }
        __builtin_amdgcn_sched_barrier(0);
#pragma unroll
        for (int r = 0; r < NR; ++r) { const int mm = m0 + r * F.NGW; const int m = mm < MR ? mm : m0; const int mr = (m < NLAT) ? (m / SEQ) : 4;
            v2u* ao = (v2u*)(A1 + (size_t)m * D) + F.lane;
#pragma unroll
            for (int j = 0; j < 4; ++j) { const int c = 4 * F.lane + 256 * j;
                const f32x4 sh = *(const f32x4*)(mod + mr * 6144 + c), sc = *(const f32x4*)(mod + mr * 6144 + 1024 + c);
                const f32x4 h = xv[r][j] * (sc + 1.0f) + sh; v2u o; o.x = pk2(h.x, h.y); o.y = pk2(h.z, h.w); ao[64 * j] = o; } }
    }
}

__device__ __forceinline__ void ph_inproj(Frame& F) {
    pg8::Gemm g{(const bf16*)(F.ws + WS_A1), (const bf16*)(F.ws + WS_WIN), MR, NP, D, nullptr};
    pg8::StaticOrder S; S.init(MR, NP, F.G, (int)blockIdx.x);
    EpiRowsBf16 E{(bf16*)(F.ws + WS_P), NP};
    pg8::gemm_phase<EpiRowsBf16, pg8::StaticOrder, true, true, false>(F.lds, g, S, E);
}

__device__ __forceinline__ void ph_feat(Frame& F) {
    const bf16* P = (const bf16*)(F.ws + WS_P);
    const float* mu = F.in[7]; const float* kkw = F.in[13]; const float* cw = F.in[18];
    bf16* R = (bf16*)(F.ws + WS_RB); bf16* V = (bf16*)(F.ws + WS_VB); bf16* KK = (bf16*)(F.ws + WS_KKB); bf16* KP = (bf16*)(F.ws + WS_KMF);
    bf16* QG = (bf16*)(F.ws + WS_QGB); bf16* KGB = (bf16*)(F.ws + WS_KGB); bf16* VGB = (bf16*)(F.ws + WS_VGB);
    bf16* A2 = (bf16*)(F.ws + WS_A2);
    const int lane = F.lane;
    for (int m0 = F.gw; m0 < MR; m0 += 2 * F.NGW) {
        int mm[2]; mm[0] = m0; mm[1] = (m0 + F.NGW < MR) ? m0 + F.NGW : m0;
        int nb[2][4], gr[2], gc[2], tc[2]; bool lat[2];
#pragma unroll
        for (int r = 0; r < 2; ++r) { const int m = mm[r]; lat[r] = m < NLAT; gr[r] = 0; gc[r] = 0; tc[r] = 0;
            if (lat[r]) { const int t = m & (SEQ - 1); gr[r] = t >> 6; gc[r] = t & 63;
                nb[r][0] = gc[r] > 0 ? m - 1 : -1; nb[r][1] = gc[r] < 63 ? m + 1 : -1; nb[r][2] = gr[r] > 0 ? m - 64 : -1; nb[r][3] = gr[r] < 127 ? m + 64 : -1;
            } else { const int t = (m - NLAT) & (CTXL - 1); tc[r] = t; nb[r][0] = t > 0 ? m - 1 : -1; nb[r][1] = t < CTXL - 1 ? m + 1 : -1; nb[r][2] = nb[r][0]; nb[r][3] = nb[r][1]; } }
#pragma unroll
        for (int p = 0; p < 4; ++p) {
            const int cb = p * 512 + 8 * lane;
            const bool act = (p < 3) || lane < 20;
            v4u wo[2], wn[2][4];
#pragma unroll
            for (int r = 0; r < 2; ++r) { wo[r] = (v4u){0u, 0u, 0u, 0u};
#pragma unroll
                for (int q = 0; q < 4; ++q) wn[r][q] = (v4u){0u, 0u, 0u, 0u};
                if (act) { wo[r] = *(const v4u*)(P + (size_t)mm[r] * NP + cb);
#pragma unroll
                    for (int q = 0; q < 4; ++q) if (nb[r][q] >= 0) wn[r][q] = *(const v4u*)(P + (size_t)nb[r][q] * NP + cb); }
                else if (p == 3 && lane >= 20 && lane < 22) wo[r] = *(const v4u*)(P + (size_t)mm[r] * NP + C_PGL + 8 * (lane - 20)); }
            float muv[8] = {0.f, 0.f, 0.f, 0.f, 0.f, 0.f, 0.f, 0.f}; if (act) ld8(mu + cb, muv);
            __builtin_amdgcn_sched_barrier(0);
#pragma unroll
            for (int r = 0; r < 2; ++r) { const size_t m = (size_t)mm[r];
                if (act) {
                    float own[8], sh[4][8], val[8];
                    unp8(wo[r], own);
#pragma unroll
                    for (int q = 0; q < 4; ++q) unp8(wn[r][q], sh[q]);
#pragma unroll
                    for (int e = 0; e < 8; ++e) val[e] = own[e] + muv[e] * (sh[e & 3][e] - own[e]);
                    if (p == 0) *(v4u*)(R + m * RWW + 8 * lane) = pk8(val);
                    else if (p == 2) *(v4u*)(V + m * RWW + 8 * lane) = pk8(val);
                    else if (p == 1) {
                        *(v4u*)(KP + m * RWW + 8 * lane) = pk8(val);
                        float kw[8]; ld8(kkw + 8 * lane, kw); float kkv[8]; float ss = 0.f;
#pragma unroll
                        for (int e = 0; e < 8; ++e) { kkv[e] = val[e] * kw[e]; ss += kkv[e] * kkv[e]; }
                        ss += __shfl_xor(ss, 1); ss += __shfl_xor(ss, 2); ss += __shfl_xor(ss, 4);
                        const float inv = 1.0f / fmaxf(sqrtf(ss), 1e-12f);
#pragma unroll
                        for (int e = 0; e < 8; ++e) kkv[e] *= inv;
                        *(v4u*)(KK + m * RWW + 8 * lane) = pk8(kkv);
                    } else {
                        float o[8];
#pragma unroll
                        for (int e = 0; e < 8; ++e) o[e] = (lane < 4) ? tanhf(val[e]) : ((lane < 8) ? val[e] : sigmoidf_(val[e]));
                        *(v4u*)(A2 + m * KLORA + 8 * lane) = pk8(o);
                    }
                } else if (p == 3 && lane < 32) *(v4u*)(A2 + m * KLORA + 8 * lane) = wo[r];
            }
        }
#pragma unroll
        for (int p = 0; p < 2; ++p) {
            const int cq = p * 512 + 8 * lane; const int cb = C_Q + cq;
            v4u wp[2][9];
#pragma unroll
            for (int r = 0; r < 2; ++r)
#pragma unroll
                for (int dy = -1; dy <= 1; ++dy)
#pragma unroll
                    for (int dx = -1; dx <= 1; ++dx) { const int tp = (dy + 1) * 3 + dx + 1; bool ok; int nr;
                        if (lat[r]) { ok = (gr[r] + dy >= 0) && (gr[r] + dy < GRIDH) && (gc[r] + dx >= 0) && (gc[r] + dx < GRIDW); nr = mm[r] + dy * 64 + dx; }
                        else { ok = (dy == 0) && (tc[r] + dx >= 0) && (tc[r] + dx < CTXL); nr = mm[r] + dx; }
                        wp[r][tp] = (v4u){0u, 0u, 0u, 0u}; if (ok) wp[r][tp] = *(const v4u*)(P + (size_t)nr * NP + cb); }
            __builtin_amdgcn_sched_barrier(0);
            float acc[2][8];
#pragma unroll
            for (int r = 0; r < 2; ++r)
#pragma unroll
                for (int e = 0; e < 8; ++e) acc[r][e] = 0.f;
#pragma unroll
            for (int tp = 0; tp < 9; ++tp) { float wv[8]; ld8(cw + tp * 1024 + cq, wv);
#pragma unroll
                for (int r = 0; r < 2; ++r) { float pv[8]; unp8(wp[r][tp], pv);
#pragma unroll
                    for (int e = 0; e < 8; ++e) acc[r][e] += pv[e] * wv[e]; } }
#pragma unroll
            for (int r = 0; r < 2; ++r) { const size_t m = (size_t)mm[r]; float o[8];
#pragma unroll
                for (int e = 0; e < 8; ++e) o[e] = siluf_(acc[r][e]);
                if (p == 0) {
                    if (lane < 32) {
#pragma unroll
                        for (int e = 0; e < 8; ++e) o[e] *= 0.125f;
                        *(v4u*)(QG + m * 256 + cq) = pk8(o);
                    } else *(v4u*)(KGB + m * 256 + (cq - 256)) = pk8(o);
                } else *(v4u*)(VGB + m * RWW + (cq - 512)) = pk8(o); }
        }
    }
}

struct EpiLora {
    static constexpr bool PERM = true;
    unsigned char* ws; const float* const* in;
    __device__ __forceinline__ void grp_w(const f32x4 (&acc)[2][2][4][2], int row0, int c0) const {
        bf16* Wf = (bf16*)(ws + WS_LWF); bf16* Wb = (bf16*)(ws + WS_LWB);
#pragma unroll
        for (int bj = 0; bj < 2; ++bj) { const int ch = (c0 + bj * 128) >> 1; const f32x4 w0f = *(const f32x4*)(in[8] + ch), w0b = *(const f32x4*)(in[8] + 512 + ch);
#pragma unroll
            for (int ai = 0; ai < 2; ++ai)
#pragma unroll
                for (int m = 0; m < 4; ++m) { const size_t row = (size_t)(row0 + ai * 128 + m * 16);
                    const f32x4 xf = acc[ai][bj][m][0] + w0f, xb = acc[ai][bj][m][1] + w0b; f32x4 df, db;
#pragma unroll
                    for (int e = 0; e < 4; ++e) { df[e] = -0.60653066f * sigmoidf_(xf[e]); db[e] = -0.60653066f * sigmoidf_(xb[e]); }
                    { v2u o; o.x = pk2(df[0], df[1]); o.y = pk2(df[2], df[3]); *(v2u*)(Wf + row * RWW + ch) = o; o.x = pk2(db[0], db[1]); o.y = pk2(db[2], db[3]); *(v2u*)(Wb + row * RWW + ch) = o; } } }
    }
    __device__ __forceinline__ void grp_a(const f32x4 (&acc)[2][2][4][2], int row0, int c0) const {
        bf16* KMf = (bf16*)(ws + WS_KMF); bf16* KMb = (bf16*)(ws + WS_KMB); bf16* BVf = (bf16*)(ws + WS_BVF); bf16* BVb = (bf16*)(ws + WS_BVB);
        const bf16* KK = (const bf16*)(ws + WS_KKB); bf16* KSUM = (bf16*)(ws + WS_KSUM);
#pragma unroll
        for (int bj = 0; bj < 2; ++bj) { const int ch = (c0 + bj * 128 - 1024) >> 1; const f32x4 a0f = *(const f32x4*)(in[10] + ch), a0b = *(const f32x4*)(in[10] + 512 + ch), ka = *(const f32x4*)(in[14] + ch);
#pragma unroll
            for (int ai = 0; ai < 2; ++ai) {
            v2u kpw[2][4], kkw[2][4];
#pragma unroll
                for (int m = 0; m < 4; ++m) { const size_t row = (size_t)(row0 + ai * 128 + m * 16); kpw[ai][m] = *(const v2u*)(KMf + row * RWW + ch); kkw[ai][m] = *(const v2u*)(KK + row * RWW + ch); }
            __builtin_amdgcn_sched_barrier(0);
#pragma unroll
                for (int m = 0; m < 4; ++m) { const size_t row = (size_t)(row0 + ai * 128 + m * 16);
                    const f32x4 xf = acc[ai][bj][m][0] + a0f, xb = acc[ai][bj][m][1] + a0b;
                    const f32x4 kp = (f32x4){bflo(kpw[ai][m].x), bfhi(kpw[ai][m].x), bflo(kpw[ai][m].y), bfhi(kpw[ai][m].y)}, kk = (f32x4){bflo(kkw[ai][m].x), bfhi(kkw[ai][m].x), bflo(kkw[ai][m].y), bfhi(kkw[ai][m].y)};
                    f32x4 kmf, kmb, bvf, bvb;
#pragma unroll
                    for (int e = 0; e < 4; ++e) { const float af = sigmoidf_(xf[e]), ab = sigmoidf_(xb[e]);
                        kmf[e] = kp[e] * (1.0f + (af - 1.0f) * ka[e]); kmb[e] = kp[e] * (1.0f + (ab - 1.0f) * ka[e]); bvf[e] = kk[e] * af; bvb[e] = kk[e] * ab; }
                    { v2u o; o.x = pk2(kmf[0], kmf[1]); o.y = pk2(kmf[2], kmf[3]); *(v2u*)(KMf + row * RWW + ch) = o; o.x = pk2(kmb[0], kmb[1]); o.y = pk2(kmb[2], kmb[3]); *(v2u*)(KMb + row * RWW + ch) = o;
                      o.x = pk2(bvf[0], bvf[1]); o.y = pk2(bvf[2], bvf[3]); *(v2u*)(BVf + row * RWW + ch) = o; o.x = pk2(bvb[0], bvb[1]); o.y = pk2(bvb[2], bvb[3]); *(v2u*)(BVb + row * RWW + ch) = o; }
                    v2u ks; ks.x = pk2(kmf[0] + kmb[0], kmf[1] + kmb[1]); ks.y = pk2(kmf[2] + kmb[2], kmf[3] + kmb[3]); *(v2u*)(KSUM + row * RWW + ch) = ks; } } }
    }
    __device__ __forceinline__ void grp_g(const f32x4 (&acc)[2][2][4][2], int row0, int c0) const {
        bf16* RWG = (bf16*)(ws + WS_RWG);
#pragma unroll
        for (int bj = 0; bj < 2; ++bj) { const int ch = c0 + bj * 128 - 2048;
#pragma unroll
            for (int ai = 0; ai < 2; ++ai)
#pragma unroll
                for (int m = 0; m < 4; ++m) { const size_t row = (size_t)(row0 + ai * 128 + m * 16); const f32x4 v0 = acc[ai][bj][m][0], v1 = acc[ai][bj][m][1];
                    v4u w; w.x = pk2(v0[0], v0[1]); w.y = pk2(v0[2], v0[3]); w.z = pk2(v1[0], v1[1]); w.w = pk2(v1[2], v1[3]); *(v4u*)(RWG + row * RWW + ch) = w; } }
    }
    __device__ __forceinline__ void grp_l(const f32x4 (&acc)[2][2][4][2], int row0, int c0) const {
        bf16* GAf = (bf16*)(ws + WS_LAF); bf16* GAb = (bf16*)(ws + WS_LAB);
#pragma unroll
        for (int bj = 0; bj < 2; ++bj) { const int ch = (c0 + bj * 128 - 2560) >> 1; const f32x4 gbf = *(const f32x4*)(in[20] + ch), gbb = *(const f32x4*)(in[20] + 256 + ch);
#pragma unroll
            for (int ai = 0; ai < 2; ++ai)
#pragma unroll
                for (int m = 0; m < 4; ++m) { const size_t row = (size_t)(row0 + ai * 128 + m * 16);
                    const f32x4 xf = acc[ai][bj][m][0] + gbf, xb = acc[ai][bj][m][1] + gbb; f32x4 af, ab;
#pragma unroll
                    for (int e = 0; e < 4; ++e) { const float lf = fminf(xf[e], 0.f) - log1pf(__expf(-fabsf(xf[e]))), lb = fminf(xb[e], 0.f) - log1pf(__expf(-fabsf(xb[e])));
                        af[e] = lf * 0.0625f; ab[e] = lb * 0.0625f; }
                    { v2u o; o.x = pk2(af[0], af[1]); o.y = pk2(af[2], af[3]); *(v2u*)(GAf + row * 256 + ch) = o; o.x = pk2(ab[0], ab[1]); o.y = pk2(ab[2], ab[3]); *(v2u*)(GAb + row * 256 + ch) = o; } } }
    }
    __device__ __forceinline__ void operator()(const f32x4 (&acc)[2][2][4][2], const pg8::Unit& u, int wr, int wc, int fr, int fq) const {
        const int row0 = u.pm * 256 + wr * 64 + fr, c0 = u.pn * 256 + wc * 32 + 8 * fq;
        if (u.pn < 4) grp_w(acc, row0, c0); else if (u.pn < 8) grp_a(acc, row0, c0); else if (u.pn < 10) grp_g(acc, row0, c0); else grp_l(acc, row0, c0);
    }
};
__device__ __forceinline__ void ph_lora(Frame& F) {
    pg8::Gemm g{(const bf16*)(F.ws + WS_A2), (const bf16*)(F.ws + WS_WLORA), MR, NLORA, KLORA, nullptr};
    pg8::StaticOrder S; S.init(MR, NLORA, F.G, (int)blockIdx.x);
    EpiLora E{F.ws, F.in};
    pg8::gemm_phase<EpiLora, pg8::StaticOrder, true, true, false>(F.lds, g, S, E);
}

__device__ __forceinline__ void ph_merge(Frame& F) {
    unsigned char* ws = F.ws; const int lane = F.lane;
    const bf16* ORf = (const bf16*)(ws + WS_ORWF); const bf16* ORb = (const bf16*)(ws + WS_ORWB); const bf16* OGf = (const bf16*)(ws + WS_OGLF); const bf16* OGb = (const bf16*)(ws + WS_OGLB);
    const bf16* R = (const bf16*)(ws + WS_RB); const bf16* V = (const bf16*)(ws + WS_VB); const bf16* KSUM = (const bf16*)(ws + WS_KSUM); const bf16* RWG = (const bf16*)(ws + WS_RWG);
    const bf16* P = (const bf16*)(ws + WS_P);
    bf16* YRW = (bf16*)(ws + WS_YRW); bf16* YGLA = (bf16*)(ws + WS_YGLA);
    float rk[8], gw[8], gbv[8], ggw[8], ggb[8];
    ld8(F.in[15] + 8 * lane, rk); ld8(F.in[16] + 8 * lane, gw); ld8(F.in[17] + 8 * lane, gbv); ld8(F.in[21] + 8 * lane, ggw); ld8(F.in[22] + 8 * lane, ggb);
    for (int m0 = F.gw; m0 < NLAT; m0 += 2 * F.NGW) {
        const int m1 = (m0 + F.NGW < NLAT) ? m0 + F.NGW : m0;
        v4u wa[2], wb[2], wc[2], wd[2], wr[2], wv[2], wk[2], wg[2], wo[2];
#pragma unroll
        for (int r2 = 0; r2 < 2; ++r2) { const int m = r2 ? m1 : m0; const size_t ro = (size_t)m * RWW + 8 * lane;
            wa[r2] = *(const v4u*)(ORf + ro); wb[r2] = *(const v4u*)(ORb + ro); wc[r2] = *(const v4u*)(OGf + ro); wd[r2] = *(const v4u*)(OGb + ro);
            wr[r2] = *(const v4u*)(R + ro); wv[r2] = *(const v4u*)(V + ro); wk[r2] = *(const v4u*)(KSUM + ro); wg[r2] = *(const v4u*)(RWG + ro);
            wo[r2] = *(const v4u*)(P + (size_t)m * NP + C_OG + 8 * lane); }
#pragma unroll
        for (int r2 = 0; r2 < 2; ++r2) { const int m = r2 ? m1 : m0; const size_t ro = (size_t)m * RWW + 8 * lane;
        {
            float a[8], b[8], o[8]; unp8(wa[r2], a); unp8(wb[r2], b);
            float s = 0.f;
#pragma unroll
            for (int e = 0; e < 8; ++e) { o[e] = a[e] + b[e]; s += o[e]; }
            s += __shfl_xor(s, 1); s += __shfl_xor(s, 2); s += __shfl_xor(s, 4);
            const float mean = s * (1.f / 64.f); float q = 0.f;
#pragma unroll
            for (int e = 0; e < 8; ++e) { o[e] -= mean; q += o[e] * o[e]; }
            q += __shfl_xor(q, 1); q += __shfl_xor(q, 2); q += __shfl_xor(q, 4);
            const float rstd = 1.f / sqrtf(q * (1.f / 64.f) + RW_GN_EPS);
            float r[8], v[8], ksm[8], g[8]; unp8(wr[r2], r); unp8(wv[r2], v); unp8(wk[r2], ksm); unp8(wg[r2], g);
            float bs = 0.f;
#pragma unroll
            for (int e = 0; e < 8; ++e) bs += r[e] * ksm[e] * rk[e];
            bs += __shfl_xor(bs, 1); bs += __shfl_xor(bs, 2); bs += __shfl_xor(bs, 4);
            float y[8];
#pragma unroll
            for (int e = 0; e < 8; ++e) y[e] = (o[e] * rstd * gw[e] + gbv[e] + bs * v[e]) * g[e];
            *(v4u*)(YRW + ro) = pk8(y);
        }
        {
            float a[8], b[8], o[8]; unp8(wc[r2], a); unp8(wd[r2], b);
            float s = 0.f;
#pragma unroll
            for (int e = 0; e < 8; ++e) { o[e] = a[e] + b[e]; s += o[e]; }
            s += __shfl_xor(s, 1); s += __shfl_xor(s, 2); s += __shfl_xor(s, 4); s += __shfl_xor(s, 8);
            const float mean = s * (1.f / 128.f); float q = 0.f;
#pragma unroll
            for (int e = 0; e < 8; ++e) { o[e] -= mean; q += o[e] * o[e]; }
            q += __shfl_xor(q, 1); q += __shfl_xor(q, 2); q += __shfl_xor(q, 4); q += __shfl_xor(q, 8);
            const float rstd = 1.f / sqrtf(q * (1.f / 128.f) + LN_EPS);
            float og[8]; unp8(wo[r2], og);
            float y[8];
#pragma unroll
            for (int e = 0; e < 8; ++e) y[e] = (o[e] * rstd * ggw[e] + ggb[e]) * siluf_(og[e]);
            *(v4u*)(YGLA + ro) = pk8(y);
        }
        }
    }
}

template <int WHICH> struct EpiBranch {
    static constexpr bool PERM = true;
    bf16* Z; const bf16* P;
    __device__ __forceinline__ void operator()(const f32x4 (&acc)[2][2][4][2], const pg8::Unit& u, int wr, int wc, int fr, int fq) const {
        const int row0 = u.pm * 256 + wr * 64 + fr, col0 = u.pn * 256 + wc * 32 + 8 * fq;
#pragma unroll
        for (int ah = 0; ah < 4; ++ah) { const int ai = ah >> 1, mb = 2 * (ah & 1);
            v4u gw[2][2], zw[2][2];
#pragma unroll
            for (int m = 0; m < 2; ++m) { const size_t row = (size_t)(row0 + ai * 128 + (mb + m) * 16);
#pragma unroll
                for (int bj = 0; bj < 2; ++bj) { const int c = col0 + bj * 128;
                    gw[m][bj] = *(const v4u*)(P + row * NP + (WHICH ? C_GGLA : C_GRW) + c);
                    if (WHICH) zw[m][bj] = *(const v4u*)(Z + row * D + c); } }
            __builtin_amdgcn_sched_barrier(0);
#pragma unroll
            for (int m = 0; m < 2; ++m) { const size_t row = (size_t)(row0 + ai * 128 + (mb + m) * 16);
#pragma unroll
                for (int bj = 0; bj < 2; ++bj) { const int c = col0 + bj * 128;
                    float g[8]; unp8(gw[m][bj], g);
                    const f32x4 v0 = acc[ai][bj][mb + m][0], v1 = acc[ai][bj][mb + m][1];
                    float z[8];
#pragma unroll
                    for (int e = 0; e < 4; ++e) { z[e] = sigmoidf_(g[e]) * v0[e]; z[4 + e] = sigmoidf_(g[4 + e]) * v1[e]; }
                    if (WHICH) { float zo[8]; unp8(zw[m][bj], zo);
#pragma unroll
                        for (int e = 0; e < 8; ++e) z[e] += zo[e]; }
                    *(v4u*)(Z + row * D + c) = pk8(z); } }
        }
    }
};
__device__ __forceinline__ void ph_branch(Frame& F) {
    pg8::StaticOrder S; S.init(NLAT, D, F.G, (int)blockIdx.x);
    { pg8::Gemm g{(const bf16*)(F.ws + WS_YRW), (const bf16*)(F.ws + WS_WBRRW), NLAT, D, RWW, nullptr};
      EpiBranch<0> E{(bf16*)(F.ws + WS_Z), (const bf16*)(F.ws + WS_P)};
      pg8::gemm_phase<EpiBranch<0>, pg8::StaticOrder, true, true, false>(F.lds, g, S, E); }
    { pg8::Gemm g{(const bf16*)(F.ws + WS_YGLA), (const bf16*)(F.ws + WS_WBRGLA), NLAT, D, RWW, nullptr};
      EpiBranch<1> E{(bf16*)(F.ws + WS_Z), (const bf16*)(F.ws + WS_P)};
      pg8::gemm_phase<EpiBranch<1>, pg8::StaticOrder, true, true, false>(F.lds, g, S, E); }
}
struct EpiOut {
    static constexpr bool PERM = true;
    bf16* X1P; const float* x; const float* mod;
    __device__ __forceinline__ void operator()(const f32x4 (&acc)[2][2][4][2], const pg8::Unit& u, int wr, int wc, int fr, int fq) const {
        const int row0 = u.pm * 256 + wr * 64 + fr, col0 = u.pn * 256 + wc * 32 + 8 * fq; const float* g1 = mod + (u.pm / (SEQ / 256)) * 6144 + 2048;
        f32x4 gv[2][2];
#pragma unroll
        for (int bj = 0; bj < 2; ++bj)
#pragma unroll
            for (int n = 0; n < 2; ++n) gv[bj][n] = *(const f32x4*)(g1 + col0 + bj * 128 + 4 * n);
#pragma unroll
        for (int ah = 0; ah < 4; ++ah) { const int ai = ah >> 1, mb = 2 * (ah & 1);
            f32x4 xv[2][2][2];
#pragma unroll
            for (int m = 0; m < 2; ++m) { const size_t ro = (size_t)(row0 + ai * 128 + (mb + m) * 16) * D;
#pragma unroll
                for (int bj = 0; bj < 2; ++bj)
#pragma unroll
                    for (int n = 0; n < 2; ++n) xv[m][bj][n] = *(const f32x4*)(x + ro + col0 + bj * 128 + 4 * n); }
            __builtin_amdgcn_sched_barrier(0);
#pragma unroll
            for (int m = 0; m < 2; ++m) { const size_t ro = (size_t)(row0 + ai * 128 + (mb + m) * 16) * D;
#pragma unroll
                for (int bj = 0; bj < 2; ++bj) { const f32x4 a = xv[m][bj][0] * ALPHA + gv[bj][0] * acc[ai][bj][mb + m][0], b = xv[m][bj][1] * ALPHA + gv[bj][1] * acc[ai][bj][mb + m][1];
                    v4u w; w.x = pk2(a.x, a.y); w.y = pk2(a.z, a.w); w.z = pk2(b.x, b.y); w.w = pk2(b.z, b.w); *(v4u*)(X1P + ro + col0 + bj * 128) = w; } }
        }
    }
};
__device__ __forceinline__ void ph_outproj(Frame& F) {
    pg8::Gemm g{(const bf16*)(F.ws + WS_Z), (const bf16*)(F.ws + WS_WOUT), NLAT, D, D, nullptr};
    pg8::StaticOrder S; S.init(NLAT, D, F.G, (int)blockIdx.x);
    EpiOut E{(bf16*)(F.ws + WS_X1), F.in[0], (const float*)(F.ws + WS_MOD)};
    pg8::gemm_phase<EpiOut, pg8::StaticOrder, true, true, false>(F.lds, g, S, E);
}
#endif

#if MS >= 3
constexpr int LP = 72, SLOTB = 64 * LP * 2, LPF = 68, AUX_OFF = 13 * SLOTB;
static_assert(AUX_OFF + 4096 <= MISC_OFF, "scan LDS map");
#define SLOT(n) ((LAS bf16*)(lds + (n) * SLOTB))
__device__ __forceinline__ int scan_row(int s, int b, int dir) {
    if (s < CTXL) return NLAT + b * CTXL + (dir ? (CTXL - 1 - s) : s);
    const int lt = s - CTXL; return b * SEQ + (dir ? (SEQ - 1 - lt) : lt);
}
__device__ __forceinline__ unsigned pk2z(float x) { return pk2(x, 0.f); }
__device__ __forceinline__ float bf2f(bf16 h) { return __builtin_bit_cast(float, (unsigned)h << 16); }
__device__ __forceinline__ v2u pack4(const f32x4 v) { v2u o; o.x = pk2(v[0], v[1]); o.y = pk2(v[2], v[3]); return o; }
__device__ __forceinline__ float clamp8(float x) { return __builtin_amdgcn_fmed3f(x, -448.0f, 448.0f); }
__device__ __forceinline__ unsigned pack4_fp8(const f32x4 v) { int w = __builtin_amdgcn_cvt_pk_fp8_f32(clamp8(v[0]), clamp8(v[1]), 0, false); return (unsigned)__builtin_amdgcn_cvt_pk_fp8_f32(clamp8(v[2]), clamp8(v[3]), w, true); }
__device__ __forceinline__ f32x4 unpack4_fp8(unsigned w) { const f32x2 lo = __builtin_amdgcn_cvt_pk_f32_fp8((int)w, false), hi = __builtin_amdgcn_cvt_pk_f32_fp8((int)w, true); return (f32x4){lo.x, lo.y, hi.x, hi.y}; }
__device__ __forceinline__ f32x4 unpack4(const v2u w) { return (f32x4){bflo(w.x), bfhi(w.x), bflo(w.y), bfhi(w.y)}; }
__device__ __forceinline__ f32x4 mm_tile(const LAS bf16* X, int r0, const LAS bf16* Y, int c0, int lane) {
    const int rr = lane & 15, q = lane >> 4;
    const LAS bf16* xp = X + (r0 + rr) * LP + 8 * q; const LAS bf16* yp = Y + (c0 + rr) * LP + 8 * q;
    const bf16x8 a0 = *(const LAS bf16x8*)xp, a1 = *(const LAS bf16x8*)(xp + 32), b0 = *(const LAS bf16x8*)yp, b1 = *(const LAS bf16x8*)(yp + 32);
    f32x4 acc = (f32x4){0.f, 0.f, 0.f, 0.f};
    acc = __builtin_amdgcn_mfma_f32_16x16x32_bf16(a0, b0, acc, 0, 0, 0);
    acc = __builtin_amdgcn_mfma_f32_16x16x32_bf16(a1, b1, acc, 0, 0, 0);
    return acc;
}
__device__ __forceinline__ float red8(float x) {
    x += __builtin_bit_cast(float, __builtin_amdgcn_update_dpp(0, __builtin_bit_cast(int, x), 0x141, 0xf, 0xf, false));
    x += __builtin_bit_cast(float, __builtin_amdgcn_update_dpp(0, __builtin_bit_cast(int, x), 0xB1, 0xf, 0xf, false));
    x += __builtin_bit_cast(float, __builtin_amdgcn_update_dpp(0, __builtin_bit_cast(int, x), 0x4E, 0xf, 0xf, false));
    return x;
}

#define S1_BAR() do { asm volatile("s_waitcnt lgkmcnt(0)" ::: "memory"); __builtin_amdgcn_s_barrier(); asm volatile("" ::: "memory"); } while (0)
struct RwIn { bf16 lw[8], r[8], k[8], a[8], b[8], v[8]; };
__device__ __forceinline__ void s1_rwkv_load(Frame& F, int u, RwIn& I) {
    const int sr = u / NCHUNK, c = u - sr * NCHUNK, rb = sr >> 4, rdir = (sr >> 3) & 1, rh = sr & 7; unsigned char* ws = F.ws;
    const bf16* RBp = (const bf16*)(ws + WS_RB); const bf16* VBp = (const bf16*)(ws + WS_VB); const bf16* KKp = (const bf16*)(ws + WS_KKB);
    const bf16* KMp = (const bf16*)(ws + (rdir ? WS_KMB : WS_KMF)); const bf16* BVp = (const bf16*)(ws + (rdir ? WS_BVB : WS_BVF)); const bf16* LWp = (const bf16*)(ws + (rdir ? WS_LWB : WS_LWF));
#pragma unroll
    for (int i = 0; i < 8; ++i) { const int row = scan_row(c * CH + 8 * F.wave + i, rb, rdir); const size_t base = (size_t)row * RWW + rh * 64 + F.lane;
        I.lw[i] = LWp[base]; I.r[i] = RBp[base]; I.k[i] = KMp[base]; I.a[i] = KKp[base]; I.b[i] = BVp[base]; I.v[i] = VBp[base]; }
}
__device__ __forceinline__ void s1_rwkv(Frame& F, int u, const RwIn& I, int un, RwIn& Inext, int cvi) {
    const int sr = u / NCHUNK, c = u - sr * NCHUNK;
    const bool emit = c >= CTXL / CH;
    LAS unsigned char* lds = F.lds; unsigned char* ws = F.ws;
    int lane_ = F.lane; asm volatile("" : "+v"(lane_));
    const int lane = lane_, wave = F.wave, rr = lane & 15, q = lane >> 4;
    LAS float* tot = (LAS float*)(lds + AUX_OFF); LAS float* gCs = tot + 512;
    {
        float lw[8], xr[8], xk[8], xa[8], xb[8], xv[8];
#pragma unroll
        for (int i = 0; i < 8; ++i) { lw[i] = bf2f(I.lw[i]); xr[i] = bf2f(I.r[i]); xk[i] = bf2f(I.k[i]); xa[i] = -bf2f(I.a[i]); xb[i] = bf2f(I.b[i]); xv[i] = bf2f(I.v[i]); }
        float p[8]; p[0] = lw[0];
#pragma unroll
        for (int i = 1; i < 8; ++i) p[i] = p[i - 1] + lw[i];
        tot[wave * 64 + lane] = p[7];
        S1_BAR();
        float off = 0.f, all = 0.f;
#pragma unroll
        for (int w = 0; w < 8; ++w) { const float t = tot[w * 64 + lane]; all += t; off += (w < wave) ? t : 0.f; }
        if (wave == 0) gCs[lane] = __expf(all);
        float at[8], bb[8], kb[8];
#pragma unroll
        for (int i = 0; i < 8; ++i) { const float cum = off + p[i]; const float g = __expf(cum), gi = __expf(-cum), gp = __expf(cum - lw[i]), gc = __expf(all - cum);
            const int t = 8 * wave + i;
            at[i] = xa[i] * gp; bb[i] = xb[i] * gc; kb[i] = xk[i] * gc;
            SLOT(0)[t * LP + lane] = (bf16)pk2z(at[i]);
            SLOT(1)[t * LP + lane] = (bf16)pk2z(xr[i] * g);
            SLOT(2)[t * LP + lane] = (bf16)pk2z(xb[i] * gi);
            SLOT(3)[t * LP + lane] = (bf16)pk2z(xk[i] * gi); }
        *(LAS v4u*)(SLOT(4) + lane * LP + 8 * wave) = pk8(at);
        *(LAS v4u*)(SLOT(5) + lane * LP + 8 * wave) = pk8(xv);
        *(LAS v4u*)(SLOT(6) + lane * LP + 8 * wave) = pk8(bb);
        *(LAS v4u*)(SLOT(7) + lane * LP + 8 * wave) = pk8(kb);
        S1_BAR();
    }
    s1_rwkv_load(F, un, Inext);
    LAS float* Lp = (LAS float*)(lds + 8 * SLOTB);
#pragma unroll
    for (int tix = 0; tix < 2; ++tix) { const int ti = 2 * wave + tix, r0 = 16 * (ti >> 2), c0 = 16 * (ti & 3), ci = c0 + rr;
        { const f32x4 acc = mm_tile(SLOT(2), r0, SLOT(0), c0, lane);
#pragma unroll
            for (int e = 0; e < 4; ++e) { const int i = r0 + 4 * q + e; Lp[ci * LPF + (i & 3) * 16 + (i >> 2)] = (i < ci) ? acc[e] : 0.f; } }
        { f32x4 acc = mm_tile(SLOT(0), r0, SLOT(3), c0, lane);
#pragma unroll
            for (int e = 0; e < 4; ++e) acc[e] = (ci < r0 + 4 * q + e) ? acc[e] : 0.f;
            *(LAS v2u*)(SLOT(10) + ci * LP + r0 + 4 * q) = pack4(acc); }
        if (emit) {
            { f32x4 acc = mm_tile(SLOT(2), r0, SLOT(1), c0, lane);
#pragma unroll
                for (int e = 0; e < 4; ++e) acc[e] = (r0 + 4 * q + e <= ci) ? acc[e] : 0.f;
                *(LAS v2u*)(SLOT(11) + ci * LP + r0 + 4 * q) = pack4(acc); }
            { f32x4 acc = mm_tile(SLOT(3), r0, SLOT(1), c0, lane);
#pragma unroll
                for (int e = 0; e < 4; ++e) acc[e] = (r0 + 4 * q + e <= ci) ? acc[e] : 0.f;
                *(LAS v2u*)(SLOT(12) + ci * LP + r0 + 4 * q) = pack4(acc); }
        }
    }
    S1_BAR();
    if (wave < 4) {
        const int j = 16 * wave + (lane >> 2), s = lane & 3;
        float Tr[16];
#pragma unroll
        for (int m = 0; m < 16; ++m) Tr[m] = 0.f;
        const LAS float* lrow = Lp + s * 16;
        f32x4 lb[3][4];
#pragma unroll
        for (int t = 0; t < 2; ++t) lb[t][0] = *(const LAS f32x4*)(lrow + t * LPF);
#pragma unroll
        for (int t = 0; t < 64; ++t) {
            if (t + 2 < 64) {
#pragma unroll
                for (int k = 0; k < 4; ++k) if (4 * k <= (t + 2) / 4) lb[(t + 2) % 3][k] = *(const LAS f32x4*)(lrow + (t + 2) * LPF + 4 * k);
            }
            __builtin_amdgcn_sched_barrier(0);
            float acc0 = 0.f, acc1 = 0.f;
#pragma unroll
            for (int m = 0; m < 16; ++m) if (m <= t / 4) { const float lv = lb[t % 3][m >> 2][m & 3]; if (m & 1) acc1 += lv * Tr[m]; else acc0 += lv * Tr[m]; }
            float acc = acc0 + acc1;
            acc += __builtin_bit_cast(float, __builtin_amdgcn_update_dpp(0, __builtin_bit_cast(int, acc), 0xB1, 0xf, 0xf, false));
            acc += __builtin_bit_cast(float, __builtin_amdgcn_update_dpp(0, __builtin_bit_cast(int, acc), 0x4E, 0xf, 0xf, false));
            int jj = j, ss = s; asm volatile("" : "+v"(jj), "+v"(ss));
            const float val = acc + ((t == jj) ? 1.f : 0.f);
            Tr[t >> 2] = (ss == (t & 3)) ? val : Tr[t >> 2];
            SLOT(0)[t * LP + j] = (bf16)pk2z(val);
        }
    } else if (cvi >= 0) { f32x4 cv[CVK]; cvx_load(F.in, cvi, lane, cv); cvx_store(ws, cvi, lane, cv); }
    S1_BAR();
#pragma unroll
    for (int tix = 0; tix < 2; ++tix) { const int ti = 2 * wave + tix, r0 = 16 * (ti >> 2), c0 = 16 * (ti & 3), ci = c0 + rr;
        { const f32x4 acc = mm_tile(SLOT(0), r0, SLOT(4), c0, lane); *(LAS v2u*)(SLOT(2) + ci * LP + r0 + 4 * q) = pack4(acc); }
        { const f32x4 acc = mm_tile(SLOT(0), r0, SLOT(10), c0, lane); *(LAS v2u*)(SLOT(3) + ci * LP + r0 + 4 * q) = pack4(acc); }
    }
    S1_BAR();
    unsigned char* RH = ws + WS_RH + (size_t)u * 4096; bf16* GT = (bf16*)((unsigned char*)F.out + OUT_GT) + (size_t)u * 4096;
#pragma unroll
    for (int tix = 0; tix < 2; ++tix) { const int ti = 2 * wave + tix, tr = ti >> 2, r0 = 16 * tr, c0 = 16 * (ti & 3), ci = c0 + rr;
        const int pos = (tr >> 1) * 32 + q * 8 + 4 * (tr & 1);
        if (emit) {
            { f32x4 acc = mm_tile(SLOT(2), r0, SLOT(11), c0, lane);
                acc += unpack4(*(const LAS v2u*)(SLOT(1) + ci * LP + r0 + 4 * q));
                *(unsigned*)(RH + ci * 64 + pos) = pack4_fp8(acc); }
            { f32x4 acc = mm_tile(SLOT(3), r0, SLOT(11), c0, lane);
                acc += unpack4(*(const LAS v2u*)(SLOT(12) + ci * LP + r0 + 4 * q));
                *(LAS v2u*)(SLOT(4) + ci * LP + r0 + 4 * q) = pack4(acc); }
        }
        { f32x4 acc = mm_tile(SLOT(2), r0, SLOT(6), c0, lane);
            const float gc = gCs[ci];
#pragma unroll
            for (int e = 0; e < 4; ++e) acc[e] += (r0 + 4 * q + e == ci) ? gc : 0.f;
            *(v2u*)(GT + ci * 64 + pos) = pack4(acc); }
    }
    S1_BAR();
    unsigned char* YL = ws + WS_YL + (size_t)u * 4096;
#pragma unroll
    for (int tix = 0; tix < 2; ++tix) { const int ti = 2 * wave + tix, r0 = 16 * (ti >> 2), c0 = 16 * (ti & 3), ci = c0 + rr;
        if (emit) { const f32x4 acc = mm_tile(SLOT(5), r0, SLOT(4), c0, lane); *(unsigned*)(YL + ci * 64 + r0 + 4 * q) = pack4_fp8(acc); }
        { f32x4 acc = mm_tile(SLOT(3), r0, SLOT(6), c0, lane);
            acc += unpack4(*(const LAS v2u*)(SLOT(7) + ci * LP + r0 + 4 * q));
            *(LAS v2u*)(SLOT(8) + ci * LP + r0 + 4 * q) = pack4(acc); }
    }
    S1_BAR();
    bf16* HH = (bf16*)(ws + WS_HH) + (size_t)u * 4096;
#pragma unroll
    for (int tix = 0; tix < 2; ++tix) { const int ti = 2 * wave + tix, r0 = 16 * (ti >> 2), c0 = 16 * (ti & 3), ci = c0 + rr;
        const f32x4 acc = mm_tile(SLOT(8), r0, SLOT(5), c0, lane);
        *(v2u*)(HH + ci * 64 + r0 + 4 * q) = pack4(acc); }
    S1_BAR();
}

struct GlIn { bf16 la[8], q[8], k[8], v0[8], v1[8]; };
__device__ __forceinline__ void s1_gla_load(Frame& F, int u, GlIn& I) {
    const int sg = u / NCHUNK, c = u - sg * NCHUNK, gb = sg >> 3, gdir = (sg >> 2) & 1, gh = sg & 3; unsigned char* ws = F.ws;
    const bf16* Qp = (const bf16*)(ws + WS_QGB); const bf16* Kp = (const bf16*)(ws + WS_KGB); const bf16* Vp = (const bf16*)(ws + WS_VGB); const bf16* LAp = (const bf16*)(ws + (gdir ? WS_LAB : WS_LAF));
#pragma unroll
    for (int i = 0; i < 8; ++i) { const int row = scan_row(c * CH + 8 * F.wave + i, gb, gdir); const size_t b2 = (size_t)row * 256 + gh * 64 + F.lane, b5 = (size_t)row * RWW + gh * 128 + F.lane;
        I.la[i] = LAp[b2]; I.q[i] = Qp[b2]; I.k[i] = Kp[b2]; I.v0[i] = Vp[b5]; I.v1[i] = Vp[b5 + 64]; }
}
__device__ __forceinline__ void s1_gla(Frame& F, int u, const GlIn& I) {
    const int sg = u / NCHUNK, c = u - sg * NCHUNK;
    const bool emit = c >= CTXL / CH;
    LAS unsigned char* lds = F.lds; unsigned char* ws = F.ws;
    int lane_ = F.lane; asm volatile("" : "+v"(lane_));
    const int lane = lane_, wave = F.wave, rr = lane & 15, q = lane >> 4;
    LAS float* tot = (LAS float*)(lds + AUX_OFF);
    unsigned char* QE = (unsigned char*)F.out + OUT_QE + (size_t)u * 4096;
    {
        float la[8], xq[8], xk[8], v0[8], v1[8];
#pragma unroll
        for (int i = 0; i < 8; ++i) { la[i] = bf2f(I.la[i]); xq[i] = bf2f(I.q[i]); xk[i] = bf2f(I.k[i]); v0[i] = bf2f(I.v0[i]); v1[i] = bf2f(I.v1[i]); }
        float p[8]; p[0] = la[0];
#pragma unroll
        for (int i = 1; i < 8; ++i) p[i] = p[i - 1] + la[i];
        tot[wave * 64 + lane] = p[7];
        S1_BAR();
        float off = 0.f, all = 0.f;
#pragma unroll
        for (int w = 0; w < 8; ++w) { const float t = tot[w * 64 + lane]; all += t; off += (w < wave) ? t : 0.f; }
        if (wave == 0) ((float*)(ws + WS_DD))[(size_t)u * 64 + lane] = __expf(all);
        float kl[8];
#pragma unroll
        for (int i = 0; i < 8; ++i) { const float cum = off + p[i]; const int t = 8 * wave + i;
            const float qef = xq[i] * __expf(cum);
            SLOT(0)[t * LP + lane] = (bf16)pk2z(qef);
            if (emit) QE[t * 64 + lane] = (unsigned char)__builtin_amdgcn_cvt_pk_fp8_f32(clamp8(qef), 0.f, 0, false);
            SLOT(1)[t * LP + lane] = (bf16)pk2z(xk[i] * __expf(-cum));
            kl[i] = xk[i] * __expf(all - cum); }
        *(LAS v4u*)(SLOT(2) + lane * LP + 8 * wave) = pk8(kl);
        *(LAS v4u*)(SLOT(3) + lane * LP + 8 * wave) = pk8(v0);
        *(LAS v4u*)(SLOT(3) + (64 + lane) * LP + 8 * wave) = pk8(v1);
        S1_BAR();
    }
    if (emit) {
#pragma unroll
        for (int tix = 0; tix < 2; ++tix) { const int ti = 2 * wave + tix, r0 = 16 * (ti >> 2), c0 = 16 * (ti & 3), ci = c0 + rr;
            f32x4 acc = mm_tile(SLOT(1), r0, SLOT(0), c0, lane);
#pragma unroll
            for (int e = 0; e < 4; ++e) acc[e] = (r0 + 4 * q + e <= ci) ? acc[e] : 0.f;
            *(LAS v2u*)(SLOT(5) + ci * LP + r0 + 4 * q) = pack4(acc); }
    }
    bf16* KV = (bf16*)(ws + WS_KV) + (size_t)u * 8192;
#pragma unroll
    for (int tix = 0; tix < 4; ++tix) { const int ti = 4 * wave + tix, r0 = 16 * (ti >> 3), c0 = 16 * (ti & 7), ci = c0 + rr;
        const f32x4 acc = mm_tile(SLOT(2), r0, SLOT(3), c0, lane);
        *(v2u*)(KV + ci * 64 + r0 + 4 * q) = pack4(acc); }
    S1_BAR();
    if (emit) {
        unsigned char* IN = ws + WS_INTRA + (size_t)u * 8192;
#pragma unroll
        for (int tix = 0; tix < 4; ++tix) { const int ti = 4 * wave + tix, r0 = 16 * (ti >> 2), c0 = 16 * (ti & 3), ci = c0 + rr;
            const f32x4 acc = mm_tile(SLOT(3), r0, SLOT(5), c0, lane);
            *(unsigned*)(IN + ci * 128 + r0 + 4 * q) = pack4_fp8(acc); }
    }
    S1_BAR();
}

__device__ __forceinline__ void ph_scan1(Frame& F) {
    { RwIn cur, nxt; if ((int)blockIdx.x < NU_RW) s1_rwkv_load(F, blockIdx.x, cur);
#pragma unroll 1
      for (int u = blockIdx.x; u < NU_RW; u += F.G) { const int un = (u + F.G < NU_RW) ? u + F.G : u; const int cvi = ((u - (int)blockIdx.x) / F.G) * (F.G * 4) + (int)blockIdx.x * 4 + (F.wave & 3);
          s1_rwkv(F, u, cur, un, nxt, cvi < CV_NITEM ? cvi : -1); cur = nxt; } }
    { GlIn cur, nxt; if ((int)blockIdx.x < NU_GL) s1_gla_load(F, blockIdx.x, cur);
#pragma unroll 1
      for (int u = blockIdx.x; u < NU_GL; u += F.G) { const int un = (u + F.G < NU_GL) ? u + F.G : u; s1_gla_load(F, un, nxt); s1_gla(F, u, cur); cur = nxt; } }
}

__device__ __forceinline__ bf16x8 pack_frag(const f32x4 lo, const f32x4 hi) {
    v4u w; w.x = pk2(lo[0], lo[1]); w.y = pk2(lo[2], lo[3]); w.z = pk2(hi[0], hi[1]); w.w = pk2(hi[2], hi[3]); return __builtin_bit_cast(bf16x8, w);
}
constexpr int S2_D = 5, S2_R = 6, S2_RW = 8192 + 4096 + 2048 + 1024, S2_GL = 4096 + 2048 + 1024 + 1024, S2_SLOT = S2_RW + S2_GL;
static_assert(S2_R * S2_SLOT <= MISC_OFF, "S2 ring fits in LDS");
__device__ __forceinline__ void s2_issue(LAS unsigned char* lds, int sb, int lw, int lane, size_t ur, size_t ug, int v0r, int v0g,
                                         const unsigned char* GTb, const unsigned char* RHb, const unsigned char* HHb, const unsigned char* YLb,
                                         const unsigned char* QEb, const unsigned char* KVb, const unsigned char* INb, const unsigned char* DDb) {
#pragma unroll
    for (int j = 0; j < 4; ++j) {
        int k = lw * 4 + j; if (k >= 23) k -= 1;
        const unsigned char* src; int ldo;
        if (k < 8) { const int n = k, pu = n * 64 + lane, row = pu >> 3, c16 = (pu & 7) ^ (row & 7);
            src = GTb + ur * 8192 + row * 128 + c16 * 16; ldo = n * 1024; }
        else if (k < 12) { const int n = k - 8, pu = n * 64 + lane, row = pu >> 2, c16 = (pu & 3) ^ (row & 3);
            src = RHb + ur * 4096 + row * 64 + c16 * 16; ldo = 8192 + n * 1024; }
        else if (k < 14) { const int n = k - 12, pu = n * 64 + lane, v = pu >> 3, c16 = (pu & 7) ^ (v & 7);
            src = HHb + ur * 8192 + (size_t)(v0r + v) * 128 + c16 * 16; ldo = 12288 + n * 1024; }
        else if (k < 15) { const int t = lane;
            src = YLb + ur * 4096 + t * 64 + v0r; ldo = 14336; }
        else if (k < 19) { const int n = k - 15, pu = n * 64 + lane, row = pu >> 2, c16 = (pu & 3) ^ (row & 3);
            src = QEb + ug * 4096 + row * 64 + c16 * 16; ldo = S2_RW + n * 1024; }
        else if (k < 21) { const int n = k - 19, pu = n * 64 + lane, v = pu >> 3, c16 = (pu & 7) ^ (v & 7);
            src = KVb + ug * 16384 + (size_t)(v0g + v) * 128 + c16 * 16; ldo = S2_RW + 4096 + n * 1024; }
        else if (k < 22) { const int t = lane;
            src = INb + ug * 8192 + t * 128 + v0g; ldo = S2_RW + 6144; }
        else { src = DDb + ug * 256 + (lane & 15) * 16; ldo = S2_RW + 7168; }
        __builtin_amdgcn_global_load_lds((const unsigned*)src, (LAS unsigned*)(lds + sb + ldo), 16, 0, 0);
    }
}
__device__ __forceinline__ void ph_scan2(Frame& F) {
    const int lane = F.lane, wave = F.wave, rr = lane & 15, q = lane >> 4; unsigned char* ws = F.ws; LAS unsigned char* lds = F.lds;
    const int it = (F.G == 256) ? (int)(blockIdx.x & 7) * 32 + (int)(blockIdx.x >> 3) : (int)blockIdx.x;
    const int sr = it >> 2, v0r = 16 * (it & 3), rb = sr >> 4, rdir = (sr >> 3) & 1, rh = sr & 7;
    const int sg = it >> 3, v0g = 16 * (it & 7), gb = sg >> 3, gdir = (sg >> 2) & 1, gh = sg & 3;
#define S2_BAR() do { asm volatile("s_waitcnt lgkmcnt(0)" ::: "memory"); __builtin_amdgcn_s_barrier(); asm volatile("" ::: "memory"); } while (0)
    if (wave >= 2) {
        const unsigned char* GTb = (const unsigned char*)F.out + OUT_GT; const unsigned char* QEb = (const unsigned char*)F.out + OUT_QE;
        const unsigned char* RHb = ws + WS_RH; const unsigned char* YLb = ws + WS_YL; const unsigned char* HHb = ws + WS_HH; const unsigned char* KVb = ws + WS_KV; const unsigned char* INb = ws + WS_INTRA;
        const unsigned char* DDb = ws + WS_DD;
#define S2_ISSUE(cc) s2_issue(lds, ((cc) % S2_R) * S2_SLOT, wave - 2, lane, (size_t)(sr * NCHUNK + ((cc) < NCHUNK ? (cc) : NCHUNK - 1)), (size_t)(sg * NCHUNK + ((cc) < NCHUNK ? (cc) : NCHUNK - 1)), v0r, v0g, GTb, RHb, HHb, YLb, QEb, KVb, INb, DDb)
        S2_ISSUE(0); S2_ISSUE(1); S2_ISSUE(2); S2_ISSUE(3); S2_ISSUE(4);
#pragma unroll 1
        for (int c = 0; c < NCHUNK; ++c) {
            asm volatile("s_waitcnt vmcnt(16) ; S2WAIT" ::: "memory");
            S2_BAR();
            S2_ISSUE(c + S2_D);
        }
#undef S2_ISSUE
    } else if (wave == 0) {
        bf16* ORW = (bf16*)(ws + (rdir ? WS_ORWB : WS_ORWF));
        f32x4 S[4];
#pragma unroll
        for (int m = 0; m < 4; ++m) S[m] = (f32x4){0.f, 0.f, 0.f, 0.f};
#pragma unroll 1
        for (int c = 0; c < NCHUNK; ++c) {
            S2_BAR();
            const LAS unsigned char* sl = lds + (c % S2_R) * S2_SLOT;
            const bool emit = c >= CTXL / CH;
            bf16x8 G0[4], G1[4]; v2u Hw[4], Rw0[4], Rw1[4]; unsigned Yw[4];
#pragma unroll
            for (int m = 0; m < 4; ++m) { const int k2 = 16 * m + rr;
                G0[m] = *(const LAS bf16x8*)(sl + (k2 * 8 + (q ^ (k2 & 7))) * 16); G1[m] = *(const LAS bf16x8*)(sl + (k2 * 8 + ((4 + q) ^ (k2 & 7))) * 16);
                Hw[m] = *(const LAS v2u*)(sl + 12288 + (rr * 8 + ((2 * m + (q >> 1)) ^ (rr & 7))) * 16 + (q & 1) * 8); }
            if (emit) {
#pragma unroll
                for (int tt = 0; tt < 4; ++tt) { const int t = 16 * tt + rr;
                    Rw0[tt] = *(const LAS v2u*)(sl + 8192 + (t * 4 + ((q >> 1) ^ (t & 3))) * 16 + (q & 1) * 8); Rw1[tt] = *(const LAS v2u*)(sl + 8192 + (t * 4 + ((2 + (q >> 1)) ^ (t & 3))) * 16 + (q & 1) * 8);
                    Yw[tt] = *(const LAS unsigned*)(sl + 14336 + t * 16 + q * 4); }
            }
            const bf16x8 Sf0 = pack_frag(S[0], S[1]), Sf1 = pack_frag(S[2], S[3]);
            __builtin_amdgcn_sched_barrier(0);
#pragma unroll
            for (int m = 0; m < 4; ++m) { f32x4 acc = unpack4(Hw[m]);
                acc = __builtin_amdgcn_mfma_f32_16x16x32_bf16(G0[m], Sf0, acc, 0, 0, 0);
                acc = __builtin_amdgcn_mfma_f32_16x16x32_bf16(G1[m], Sf1, acc, 0, 0, 0);
                S[m] = acc; }
            if (emit) {
#pragma unroll
                for (int tt = 0; tt < 4; ++tt) { const int t = 16 * tt + rr;
                    const bf16x8 R0 = pack_frag(unpack4_fp8(Rw0[tt].x), unpack4_fp8(Rw0[tt].y)), R1 = pack_frag(unpack4_fp8(Rw1[tt].x), unpack4_fp8(Rw1[tt].y));
                    f32x4 acc = unpack4_fp8(Yw[tt]);
                    acc = __builtin_amdgcn_mfma_f32_16x16x32_bf16(Sf0, R0, acc, 0, 0, 0);
                    acc = __builtin_amdgcn_mfma_f32_16x16x32_bf16(Sf1, R1, acc, 0, 0, 0);
                    const int row = scan_row(c * CH + t, rb, rdir);
                    *(v2u*)(ORW + (size_t)row * RWW + rh * 64 + v0r + 4 * q) = pack4(acc); }
            }
        }
    } else {
        bf16* OGL = (bf16*)(ws + (gdir ? WS_OGLB : WS_OGLF));
        f32x4 S[4];
#pragma unroll
        for (int m = 0; m < 4; ++m) S[m] = (f32x4){0.f, 0.f, 0.f, 0.f};
#pragma unroll 1
        for (int c = 0; c < NCHUNK; ++c) {
            S2_BAR();
            const LAS unsigned char* sl = lds + (c % S2_R) * S2_SLOT + S2_RW;
            const bool emit = c >= CTXL / CH;
            v2u Qw0[4], Qw1[4]; unsigned Iw[4]; v4u kw[2]; f32x4 d0[2], d1[2];
#pragma unroll
            for (int s2 = 0; s2 < 2; ++s2) { kw[s2] = *(const LAS v4u*)(sl + 4096 + (rr * 8 + ((4 * s2 + q) ^ (rr & 7))) * 16);
                d0[s2] = *(const LAS f32x4*)(sl + 7168 + 128 * s2 + 32 * q); d1[s2] = *(const LAS f32x4*)(sl + 7168 + 128 * s2 + 32 * q + 16); }
            if (emit) {
#pragma unroll
                for (int tt = 0; tt < 4; ++tt) { const int t = 16 * tt + rr;
                    Qw0[tt] = *(const LAS v2u*)(sl + (t * 4 + ((q >> 1) ^ (t & 3))) * 16 + (q & 1) * 8); Qw1[tt] = *(const LAS v2u*)(sl + (t * 4 + ((2 + (q >> 1)) ^ (t & 3))) * 16 + (q & 1) * 8);
                    Iw[tt] = *(const LAS unsigned*)(sl + 6144 + t * 16 + q * 4); }
            }
            const bf16x8 Sf0 = pack_frag(S[0], S[1]), Sf1 = pack_frag(S[2], S[3]);
            __builtin_amdgcn_sched_barrier(0);
#pragma unroll
            for (int s2 = 0; s2 < 2; ++s2) { S[2 * s2] = S[2 * s2] * d0[s2] + unpack4((v2u){kw[s2].x, kw[s2].y}); S[2 * s2 + 1] = S[2 * s2 + 1] * d1[s2] + unpack4((v2u){kw[s2].z, kw[s2].w}); }
            if (emit) {
#pragma unroll
                for (int tt = 0; tt < 4; ++tt) { const int t = 16 * tt + rr;
                    const bf16x8 Q0 = pack_frag(unpack4_fp8(Qw0[tt].x), unpack4_fp8(Qw0[tt].y)), Q1 = pack_frag(unpack4_fp8(Qw1[tt].x), unpack4_fp8(Qw1[tt].y));
                    f32x4 acc = unpack4_fp8(Iw[tt]);
                    acc = __builtin_amdgcn_mfma_f32_16x16x32_bf16(Sf0, Q0, acc, 0, 0, 0);
                    acc = __builtin_amdgcn_mfma_f32_16x16x32_bf16(Sf1, Q1, acc, 0, 0, 0);
                    const int row = scan_row(c * CH + t, gb, gdir);
                    *(v2u*)(OGL + (size_t)row * RWW + gh * 128 + v0g + 4 * q) = pack4(acc); }
            }
        }
    }
#undef S2_BAR
}
#endif

#ifndef ML
#define ML 0
#endif
enum Phase { PH_PROLOGUE = 0, PH_A1, PH_INPROJ, PH_FEAT, PH_LORA, PH_SCAN1, PH_SCAN2, PH_MERGE, PH_BRANCH, PH_OUTPROJ, PH_LN1, PH_ROUTER, PH_ROUTE, PH_SCATTER, PH_EXP1, PH_EXP2, PH_FINAL, PH_COUNT };

__global__ void __launch_bounds__(NTHR, 2) mega(Args args) {
    extern __shared__ __attribute__((aligned(16))) unsigned char lds_raw[];
    Frame F;
    F.lds = (LAS unsigned char*)lds_raw;
    F.tid = threadIdx.x; F.lane = F.tid & 63; F.wave = __builtin_amdgcn_readfirstlane(F.tid >> 6);
    F.G = gridDim.x; F.gw = blockIdx.x * NWAVES + F.wave; F.NGW = F.G * NWAVES;
    F.in = args.in; F.out = args.out; F.ws = args.ws; F.ctl = (unsigned*)(args.ws + WS_CTL);
    volatile LAS unsigned* MISC = (volatile LAS unsigned*)(F.lds + MISC_OFF);
    if (F.tid < 64) MISC[F.tid] = 0u;
    __syncthreads();
    XcdBarrier bar; bar.bar = F.ctl + CW_BAR; bar.x = 0; bar.st = nullptr;
#if !ML
    bar = xcd_barrier_post(F.ctl + CW_BAR, MISC + 8);
#endif
    const int lo = args.ph_lo, hi = args.ph_hi;
#define IN(k) (lo <= (k) && (k) < hi)
#ifndef DUP
#define DUP -1
#endif
#define RUN(k, call) do { if (IN(k)) { call; GRID_BAR(); if (DUP == (k)) { call; GRID_BAR(); } } } while (0)
#if ML
#define GRID_BAR() do { } while (0)
#else
#define GRID_BAR() xcd_barrier(bar)
#endif

#if MS >= 2
    RUN(PH_PROLOGUE, ph_prologue(F));
#endif
#if MS >= 3
    RUN(PH_A1, ph_a1(F));
    RUN(PH_INPROJ, ph_inproj(F));
    RUN(PH_FEAT, ph_feat(F));
    RUN(PH_LORA, ph_lora(F));
    RUN(PH_SCAN1, ph_scan1(F));
    RUN(PH_SCAN2, ph_scan2(F));
    RUN(PH_MERGE, ph_merge(F));
    RUN(PH_BRANCH, ph_branch(F));
    RUN(PH_OUTPROJ, ph_outproj(F));
#else
    RUN(PH_OUTPROJ, ph_x1pre_nomix(F));
#endif
    RUN(PH_LN1, ph_ln1(F));
#if MS >= 2
    RUN(PH_ROUTER, ph_router(F));
    RUN(PH_ROUTE, ph_route(F));
    RUN(PH_SCATTER, ph_scatter(F));
    RUN(PH_EXP1, ph_exp1(F));
    RUN(PH_EXP2, ph_exp2(F));
#endif
    if (IN(PH_FINAL)) { ph_final(F); }
#undef IN
}

extern "C" void kernel_launch(void* const* d_in, const int* in_sizes, int n_in, void* d_out, int out_size, void* d_ws, size_t ws_size, hipStream_t stream) {
    static int grid = 0;
    if (grid == 0) {
        if (n_in != 36 || out_size != NLAT * D || ws_size < WS_END) { fprintf(stderr, "kernel_launch: unexpected problem shape (n_in %d, out %d)\n", n_in, out_size); grid = -1; return; }
        int dev = 0, cus = 0, per_cu = 0;
        if (hipGetDevice(&dev) != hipSuccess || hipDeviceGetAttribute(&cus, hipDeviceAttributeMultiprocessorCount, dev) != hipSuccess) { grid = -1; return; }
        if (hipFuncSetAttribute((const void*)mega, hipFuncAttributeMaxDynamicSharedMemorySize, LDS_BYTES) != hipSuccess) { fprintf(stderr, "kernel_launch: hipFuncSetAttribute failed\n"); grid = -1; return; }
        if (hipOccupancyMaxActiveBlocksPerMultiprocessor(&per_cu, (const void*)mega, NTHR, LDS_BYTES) != hipSuccess || per_cu < 1) { fprintf(stderr, "kernel_launch: occupancy query says %d\n", per_cu); }
        (void)hipGetLastError();
        grid = cus > 0 ? cus : 256;
        if (grid > 256) grid = 256;
    }
    if (grid < 0) return;
    (void)hipMemsetAsync((char*)d_ws + WS_CTL, 0, CTL_ZERO_BYTES, stream);
    Args a{};
    for (int i = 0; i < 36; ++i) a.in[i] = (const float*)d_in[i];
    a.out = (float*)d_out; a.ws = (unsigned char*)d_ws;
#if ML
    for (int p = 0; p < PH_COUNT; ++p) { a.ph_lo = p; a.ph_hi = p + 1; hipLaunchKernelGGL(mega, dim3(grid), dim3(NTHR), LDS_BYTES, stream, a); }
#else
    a.ph_lo = 0; a.ph_hi = PH_COUNT;
    hipLaunchKernelGGL(mega, dim3(grid), dim3(NTHR), LDS_BYTES, stream, a);
#endif
}
```

```cpp
#include <hip/hip_runtime.h>
#include <cstdio>
#include <cstdint>

#ifndef MS
#define MS 3
#endif

#define GAS __attribute__((address_space(1)))
#define LAS __attribute__((address_space(3)))
typedef unsigned short bf16;
typedef unsigned v4u __attribute__((ext_vector_type(4)));
typedef unsigned v2u __attribute__((ext_vector_type(2)));
typedef float f32x4 __attribute__((ext_vector_type(4)));
typedef float f32x2 __attribute__((ext_vector_type(2)));
typedef short bf16x8 __attribute__((ext_vector_type(8)));
#define LDS_WAIT() asm volatile("s_waitcnt lgkmcnt(0)" ::: "memory")
#define VM_WAIT() asm volatile("s_waitcnt vmcnt(0)" ::: "memory")

constexpr int D = 1024, NB = 4, SEQ = 8192, CTXL = 256, GRIDW = 64, GRIDH = 128;
constexpr int NLAT = NB * SEQ, NCTX = NB * CTXL, MR = NLAT + NCTX;
constexpr int RWW = 512, RWH = 8, HD = 64;
constexpr int C_R = 0, C_K = 512, C_V = 1024, C_PW = 1536, C_PA = 1568, C_PG = 1600, C_Q = 1696, C_KG = 1952, C_VG = 2208, C_PGL = 2720, C_OG = 2736, C_GRW = 3248, C_GGLA = 4272;
constexpr int IN_COLS = 5296, NP = 5376;
constexpr int NE = 256, TOPK = 8, FF = 256;
constexpr float LN_EPS = 1e-5f, RW_GN_EPS = 64e-5f;
constexpr float ALPHA = 1.189207115f;
constexpr float W8S = 64.0f, W8I = 1.0f / 64.0f;
constexpr int NLORA = 3072, KLORA = 256;
constexpr int MAXTILES = 1280, SH_ROW0 = MAXTILES * 256, NROWS_E = SH_ROW0 + NLAT;

namespace pg8 {
#define PG8_LAS __attribute__((address_space(3)))
typedef unsigned short bf16_t;
typedef unsigned u32x4 __attribute__((ext_vector_type(4)));
typedef unsigned u32x2 __attribute__((ext_vector_type(2)));
typedef long i64x2 __attribute__((ext_vector_type(2)));
constexpr int BM = 256, BK = 64, HALF = 128, HTB = HALF * BK * 2, STAGE_BYTES = 8 * HTB, NXCD = 8, WGM = 8;
constexpr int IDX_OFF = STAGE_BYTES, IDX_UNITS = 12;

__host__ __device__ __forceinline__ int lds_byte(int r, int c) { const int st = (r >> 4) * 2 + (c >> 5), rr = r & 15, cc = c & 31, ob = rr * 64 + cc * 2; return st * 1024 + (ob ^ (((ob >> 9) & 1) << 5)); }
__host__ __device__ __forceinline__ void stage_rc(int b, int& R, int& C) { const int st = b / 1024, sb = b % 1024, swz = sb ^ (((sb >> 9) & 1) << 5); R = (st >> 1) * 16 + swz / 64; C = (st & 1) * 32 + (swz % 64) / 2; }
__host__ __device__ __forceinline__ int perm32(int rho) { const int n = rho >> 4, i = rho & 15; return 8 * (i >> 2) + 4 * n + (i & 3); }

struct Unit { int pm, pn, e, j; };
struct Gemm { const bf16_t* A; const bf16_t* Bt; int M, N, K; const int* rowidx; };

struct StaticOrder {
    int nM, nN, nwg, G, c;
    __host__ __device__ void init(int M, int N, int G_, int c_) { nM = M / BM; nN = N / BM; nwg = nM * nN; G = G_; c = c_; }
    __host__ __device__ bool next(int i, Unit& u) const {
        const long L = (long)i * G + c; if (L >= nwg) return false;
        int wgid = (int)L; { const int q = nwg / NXCD, r = nwg % NXCD, xcd = wgid % NXCD, off = wgid / NXCD; wgid = (xcd < r ? xcd * (q + 1) : r * (q + 1) + (xcd - r) * q) + off; }
        const int nig = WGM * nN, gid = wgid / nig, fm = gid * WGM, gsz = (nM - fm) < WGM ? (nM - fm) : WGM;
        u.pm = fm + ((wgid % nig) % gsz); u.pn = (wgid % nig) / gsz; u.e = 0; u.j = u.pn; return true;
    }
};
struct MoeOrder {
    int nN, G, c, NT; const int* tile_e;
    __device__ bool next(int i, Unit& u) const {
        const int L = i * G + c; const int total = (NT + NLAT / 256) * nN; if (L >= total) return false;
        const int tile = L / nN, j = L - tile * nN; int e, pm;
        if (tile < NT) { e = tile_e[tile]; pm = tile; } else { e = NE; pm = MAXTILES + (tile - NT); }
        u.pm = pm; u.pn = e * nN + j; u.e = e; u.j = j; return true;
    }
};

typedef __bf16 bf16x2n __attribute__((ext_vector_type(2))); typedef float f32x2n __attribute__((ext_vector_type(2)));
__device__ __forceinline__ unsigned cvt_pk_bf16(float lo, float hi) { const f32x2n v = {lo, hi}; return __builtin_bit_cast(unsigned, __builtin_convertvector(v, bf16x2n)); }

template <class Epi, class Sched, bool ALIGN_EPI, bool SP2, bool GATHER, bool FP8 = false>
__device__ __forceinline__ void gemm_phase(PG8_LAS unsigned char* lds, const Gemm g, const Sched& S, const Epi& E) {
    const int tid = threadIdx.x, wid = __builtin_amdgcn_readfirstlane(tid >> 6), lane = tid & 63, wr = wid >> 2, wc = wid & 3, fr = lane & 15, fq = lane >> 4;
    const int K = g.K, nt = K / BK;
    const size_t kstep = (size_t)(BK * 2);
    const size_t hstep = (size_t)HALF * K * 2;
    const size_t tstep = 2 * hstep;
    unsigned voffB[2]; unsigned va[2][2];
#pragma unroll
    for (int i = 0; i < 2; ++i) { int R, C; stage_rc(tid * 16 + i * 8192, R, C); const int Rb = Epi::PERM ? ((R & ~31) + perm32(R & 31)) : R;
        voffB[i] = (unsigned)(Rb * K + C) * 2u;
        va[0][i] = (unsigned)(R * K + C) * 2u; va[1][i] = va[0][i]; }
    const size_t ah = GATHER ? (size_t)0 : hstep;
#define PG8_GOFF(dst, ub) do { _Pragma("unroll") for (int _h = 0; _h < 2; ++_h) _Pragma("unroll") for (int _i = 0; _i < 2; ++_i) { int _R, _C; stage_rc(tid * 16 + _i * 8192, _R, _C); \
        dst[_h][_i] = (unsigned)(idxt[(ub) * 256 + _h * 128 + _R] * K + _C) * 2u; } } while (0)
    const unsigned ldsw = (unsigned)wid * 1024u;
    const int aoff = lds_byte(wr * 64 + fr, fq * 8), boff = lds_byte(wc * 32 + fr, fq * 8);
    PG8_LAS int* idxt = (PG8_LAS int*)(lds + IDX_OFF);
#define PG8_SA(b, h) (((b) * 2 + (h)) * HTB)
#define PG8_SB(b, h) ((4 + (b) * 2 + (h)) * HTB)
#define PG8_STAGE(bufoff, gbase, voff) do { _Pragma("unroll") for (int _i = 0; _i < 2; ++_i) \
        __builtin_amdgcn_global_load_lds((const unsigned*)((const char*)(gbase) + (voff)[_i]), (PG8_LAS unsigned*)(lds + (bufoff) + ldsw + _i * 8192), 16, 0, 0); } while (0)
#define PG8_LDA(dst, b, h) do { _Pragma("unroll") for (int m = 0; m < 4; ++m) _Pragma("unroll") for (int k = 0; k < 2; ++k) dst[m][k] = *(const PG8_LAS bf16x8*)(lds + PG8_SA(b, h) + aoff + m * 2048 + k * 1024); } while (0)
#define PG8_LDB(dst, b, h) do { _Pragma("unroll") for (int n = 0; n < 2; ++n) _Pragma("unroll") for (int k = 0; k < 2; ++k) dst[n][k] = *(const PG8_LAS bf16x8*)(lds + PG8_SB(b, h) + boff + n * 2048 + k * 1024); } while (0)
#define PG8_MMA(ai, bj, At, Bt) do { __builtin_amdgcn_s_setprio(1); _Pragma("unroll") for (int m = 0; m < 4; ++m) _Pragma("unroll") for (int n = 0; n < 2; ++n) _Pragma("unroll") for (int k = 0; k < 2; ++k) { \
        if constexpr (FP8) { const i64x2 _b = __builtin_bit_cast(i64x2, Bt[n][k]), _a = __builtin_bit_cast(i64x2, At[m][k]); \
            acc[ai][bj][m][n] = __builtin_amdgcn_mfma_f32_16x16x32_fp8_fp8(_b[0], _a[0], acc[ai][bj][m][n], 0, 0, 0); acc[ai][bj][m][n] = __builtin_amdgcn_mfma_f32_16x16x32_fp8_fp8(_b[1], _a[1], acc[ai][bj][m][n], 0, 0, 0); } \
        else acc[ai][bj][m][n] = __builtin_amdgcn_mfma_f32_16x16x32_bf16(Bt[n][k], At[m][k], acc[ai][bj][m][n], 0, 0, 0); } __builtin_amdgcn_s_setprio(0); } while (0)
#define PG8_WAIT_V(n) asm volatile("s_waitcnt vmcnt(" #n ")" ::: "memory")
#define PG8_WAIT_L(n) asm volatile("s_waitcnt lgkmcnt(" #n ")" ::: "memory")
#define PG8_BAR __builtin_amdgcn_s_barrier()
#define PG8_SCHED __builtin_amdgcn_sched_barrier(0)
    Unit cur, nxt; int ui = 0;
    if (!S.next(0, cur)) return;
    if constexpr (GATHER) {
        Unit uu;
        for (int i = 0; i < IDX_UNITS; ++i) { if (!S.next(i, uu)) break; if (tid < 256) idxt[i * 256 + tid] = g.rowidx[(size_t)uu.pm * 256 + tid]; }
        asm volatile("s_waitcnt vmcnt(0) lgkmcnt(0)" ::: "memory"); PG8_BAR; asm volatile("" ::: "memory");
        PG8_GOFF(va, 0);
    }
    f32x4 acc[2][2][4][2];
#pragma unroll
    for (int a = 0; a < 2; ++a)
#pragma unroll
        for (int b = 0; b < 2; ++b)
#pragma unroll
            for (int m = 0; m < 4; ++m)
#pragma unroll
                for (int n = 0; n < 2; ++n) acc[a][b][m][n] = (f32x4){0.f, 0.f, 0.f, 0.f};
    bf16x8 At[4][2], B0[2][2], B1[2][2];
    const char* cA = (const char*)g.A + (GATHER ? (size_t)0 : (size_t)cur.pm * tstep); const char* cB = (const char*)g.Bt + (size_t)cur.pn * tstep;
    if constexpr (SP2) {
        PG8_STAGE(PG8_SB(0, 0), cB, voffB); PG8_STAGE(PG8_SB(0, 1), cB + hstep, voffB); PG8_STAGE(PG8_SA(0, 0), cA, va[0]); PG8_STAGE(PG8_SA(0, 1), cA + ah, va[1]);
        if (wr == 1) PG8_BAR;
        PG8_WAIT_V(2); PG8_BAR;
        PG8_STAGE(PG8_SB(1, 0), cB + kstep, voffB); PG8_STAGE(PG8_SA(1, 0), cA + kstep, va[0]); PG8_STAGE(PG8_SB(1, 1), cB + hstep + kstep, voffB);
        PG8_WAIT_V(6); PG8_BAR;
    } else {
        PG8_STAGE(PG8_SB(0, 0), cB, voffB); PG8_STAGE(PG8_SA(0, 0), cA, va[0]); PG8_STAGE(PG8_SB(0, 1), cB + hstep, voffB); PG8_STAGE(PG8_SA(0, 1), cA + ah, va[1]);
        if (wr == 1) PG8_BAR;
        PG8_WAIT_V(4); PG8_BAR;
        PG8_STAGE(PG8_SB(1, 0), cB + kstep, voffB); PG8_STAGE(PG8_SA(1, 0), cA + kstep, va[0]); PG8_STAGE(PG8_SB(1, 1), cB + hstep + kstep, voffB);
        PG8_WAIT_V(6); PG8_BAR;
    }
    for (;;) {
        const bool has_next = S.next(ui + 1, nxt);
        const char* nA = has_next ? (const char*)g.A + (GATHER ? (size_t)0 : (size_t)nxt.pm * tstep) : cA; const char* nB = has_next ? (const char*)g.Bt + (size_t)nxt.pn * tstep : cB;
        const int ubn = (has_next && ui + 1 < IDX_UNITS) ? (ui + 1) : ui;
#pragma unroll 1
        for (int t = 0; t < nt; t += 2) {
            const bool last = (t == nt - 2);
            const char* a1 = cA + (size_t)(t + 1) * kstep;
            const char* a2 = last ? nA : cA + (size_t)(t + 2) * kstep; const char* b2 = last ? nB : cB + (size_t)(t + 2) * kstep;
            const char* a3 = a2 + kstep; const char* b3 = b2 + kstep;
            unsigned v2[2][2];
#pragma unroll
            for (int h = 0; h < 2; ++h)
#pragma unroll
                for (int i = 0; i < 2; ++i) v2[h][i] = va[h][i];
            if constexpr (GATHER) { if (last) PG8_GOFF(v2, ubn); }
            if constexpr (SP2) {
            PG8_LDB(B0, 0, 0); PG8_LDB(B1, 0, 1); PG8_SCHED; PG8_LDA(At, 0, 0); PG8_STAGE(PG8_SA(1, 1), a1 + ah, va[1]);
            PG8_WAIT_V(8); PG8_WAIT_L(0); PG8_BAR; PG8_MMA(0, 0, At, B0); PG8_MMA(0, 1, At, B1); PG8_BAR; PG8_SCHED;
            PG8_LDA(At, 0, 1); PG8_STAGE(PG8_SB(0, 0), b2, voffB); PG8_STAGE(PG8_SB(0, 1), b2 + hstep, voffB); PG8_STAGE(PG8_SA(0, 0), a2, v2[0]);
            PG8_WAIT_V(8); PG8_WAIT_L(0); PG8_BAR; PG8_MMA(1, 0, At, B0); PG8_MMA(1, 1, At, B1); PG8_BAR; PG8_SCHED;
            PG8_LDB(B0, 1, 0); PG8_LDB(B1, 1, 1); PG8_SCHED; PG8_LDA(At, 1, 0); PG8_STAGE(PG8_SA(0, 1), a2 + ah, v2[1]);
            PG8_WAIT_V(8); PG8_WAIT_L(0); PG8_BAR; PG8_MMA(0, 0, At, B0); PG8_MMA(0, 1, At, B1); PG8_BAR; PG8_SCHED;
            PG8_LDA(At, 1, 1); PG8_STAGE(PG8_SB(1, 0), b3, voffB); PG8_STAGE(PG8_SB(1, 1), b3 + hstep, voffB); PG8_STAGE(PG8_SA(1, 0), a3, v2[0]);
            PG8_WAIT_V(8); PG8_WAIT_L(0); PG8_BAR; PG8_MMA(1, 0, At, B0); PG8_MMA(1, 1, At, B1); PG8_BAR; PG8_SCHED;
            } else {
            PG8_LDB(B0, 0, 0); PG8_SCHED; PG8_LDA(At, 0, 0); PG8_STAGE(PG8_SA(1, 1), a1 + ah, va[1]);
            PG8_WAIT_L(8); PG8_BAR; PG8_WAIT_L(0); PG8_MMA(0, 0, At, B0); PG8_BAR; PG8_SCHED;
            PG8_LDB(B1, 0, 1); PG8_STAGE(PG8_SB(0, 0), b2, voffB);
            PG8_BAR; PG8_WAIT_L(0); PG8_MMA(0, 1, At, B1); PG8_BAR;
            PG8_LDA(At, 0, 1); PG8_STAGE(PG8_SA(0, 0), a2, v2[0]);
            PG8_BAR; PG8_WAIT_L(0); PG8_MMA(1, 0, At, B0); PG8_BAR; PG8_SCHED;
            PG8_STAGE(PG8_SB(0, 1), b2 + hstep, voffB);
            PG8_WAIT_V(6); PG8_BAR; PG8_MMA(1, 1, At, B1); PG8_BAR;
            PG8_LDB(B0, 1, 0); PG8_SCHED; PG8_LDA(At, 1, 0); PG8_STAGE(PG8_SA(0, 1), a2 + ah, v2[1]);
            PG8_WAIT_L(8); PG8_BAR; PG8_WAIT_L(0); PG8_MMA(0, 0, At, B0); PG8_BAR; PG8_SCHED;
            PG8_LDB(B1, 1, 1); PG8_STAGE(PG8_SB(1, 0), b3, voffB);
            PG8_BAR; PG8_WAIT_L(0); PG8_MMA(0, 1, At, B1); PG8_BAR;
            PG8_LDA(At, 1, 1); PG8_STAGE(PG8_SA(1, 0), a3, v2[0]);
            PG8_BAR; PG8_WAIT_L(0); PG8_MMA(1, 0, At, B0); PG8_BAR; PG8_SCHED;
            PG8_STAGE(PG8_SB(1, 1), b3 + hstep, voffB);
            PG8_WAIT_V(6); PG8_BAR; PG8_MMA(1, 1, At, B1); PG8_BAR;
            }
        }
        if constexpr (ALIGN_EPI) { if (wr == 0) PG8_BAR; }
        E(acc, cur, wr, wc, fr, fq);
        if (!has_next) break;
#pragma unroll
        for (int a = 0; a < 2; ++a)
#pragma unroll
            for (int b = 0; b < 2; ++b)
#pragma unroll
                for (int m = 0; m < 4; ++m)
#pragma unroll
                    for (int n = 0; n < 2; ++n) acc[a][b][m][n] = (f32x4){0.f, 0.f, 0.f, 0.f};
        cur = nxt; cA = nA; cB = nB; ++ui;
        if constexpr (GATHER) PG8_GOFF(va, ubn);
        if constexpr (ALIGN_EPI) { if (wr == 1) PG8_BAR; }
    }
    PG8_WAIT_V(0);
    if constexpr (!ALIGN_EPI) { if (wr == 0) PG8_BAR; }
    PG8_BAR;
#undef PG8_SA
#undef PG8_GOFF
#undef PG8_SB
#undef PG8_STAGE
#undef PG8_LDA
#undef PG8_LDB
#undef PG8_MMA
#undef PG8_WAIT_V
#undef PG8_WAIT_L
#undef PG8_BAR
#undef PG8_SCHED
}
}

#define XB_TMO      128
#define XB_XCNT(j)  (256  + 64 * (j))
#define XB_XSUB(j)  (1280 + 64 * (j))
#define XB_XGEN(j)  (2304 + 64 * (j))
#define XB_TOP      3328
#define XB_TOPGEN   3392
#define XCD_BAR_WORDS 3456
#define XB_SPIN_CAP (1u << 18)
__device__ __forceinline__ unsigned xb_ld(unsigned* p)              { return __hip_atomic_load(p, __ATOMIC_RELAXED, __HIP_MEMORY_SCOPE_AGENT); }
__device__ __forceinline__ unsigned xb_add(unsigned* p, unsigned v) { return __hip_atomic_fetch_add(p, v, __ATOMIC_RELAXED, __HIP_MEMORY_SCOPE_AGENT); }
__device__ __forceinline__ unsigned xb_xcc_id() { return (unsigned)__builtin_amdgcn_s_getreg((3 << 11) | 20) & 0xFu; }
#define XB_SPIN(cond, bar) do { unsigned _sp = 0; while (cond) { __builtin_amdgcn_s_sleep(1); \
    if ((++_sp & 255u) == 0u) { if (xb_ld(&(bar)[XB_TMO])) break; if (_sp > XB_SPIN_CAP) { atomicAdd(&(bar)[XB_TMO], 1u); break; } } } } while (0)
struct XcdBarrier { unsigned* bar; unsigned x; volatile LAS unsigned* st; };
__device__ __forceinline__ XcdBarrier xcd_barrier_post(unsigned* bar, volatile LAS unsigned* st) {
    XcdBarrier b; b.bar = bar; b.x = xb_xcc_id(); b.st = st;
    if (threadIdx.x == 0) (void)xb_add(&bar[XB_XCNT(b.x)], 1u);
    return b;
}
__device__ __forceinline__ void xcd_barrier_complete(unsigned* bar, unsigned x, unsigned& nloc, unsigned& nx) {
    const unsigned G = gridDim.x * gridDim.y * gridDim.z;
    unsigned sum, cnt, mine, sp = 0u;
    for (;;) {
        sum = 0u; cnt = 0u; mine = 0u;
#pragma unroll
        for (unsigned j = 0; j < 16; ++j) { const unsigned c = xb_ld(&bar[XB_XCNT(j)]); sum += c; cnt += (c > 0u) ? 1u : 0u; mine = (j == x) ? c : mine; }
        if (sum == G) break;
        __builtin_amdgcn_s_sleep(1);
        if ((++sp & 255u) == 0u) { if (xb_ld(&bar[XB_TMO])) break; if (sp > XB_SPIN_CAP) { atomicAdd(&bar[XB_TMO], 1u); break; } }
    }
    nloc = mine > 0u ? mine : 1u; nx = cnt > 0u ? cnt : 1u;
}
__device__ __forceinline__ void xcd_barrier(const XcdBarrier& b) {
    asm volatile("s_waitcnt vmcnt(0)" ::: "memory");
    __syncthreads();
    if (threadIdx.x == 0) {
        unsigned* bar = b.bar;
        __builtin_amdgcn_s_waitcnt(0);
        unsigned nloc = b.st[0], nx = b.st[1];
        if (nloc == 0u) { xcd_barrier_complete(bar, b.x, nloc, nx); b.st[0] = nloc; b.st[1] = nx; }
        const unsigned old = xb_add(&bar[XB_XSUB(b.x)], 1u);
        const unsigned gen = old / nloc;
        if (old + 1u == (gen + 1u) * nloc) {
            __builtin_amdgcn_fence(__ATOMIC_RELEASE, "agent");
            asm volatile("s_waitcnt vmcnt(0)" ::: "memory");
            const unsigned og = xb_add(&bar[XB_TOP], 1u);
            const unsigned tg = og / nx;
            if (og + 1u == (tg + 1u) * nx) xb_add(&bar[XB_TOPGEN], 1u);
            else XB_SPIN(xb_ld(&bar[XB_TOPGEN]) == tg, bar);
            __builtin_amdgcn_fence(__ATOMIC_ACQUIRE, "agent");
            xb_add(&bar[XB_XGEN(b.x)], 1u);
            asm volatile("s_waitcnt vmcnt(0)" ::: "memory");
        } else {
            XB_SPIN(xb_ld(&bar[XB_XGEN(b.x)]) == gen, bar);
            __builtin_amdgcn_fence(__ATOMIC_ACQUIRE, "agent");
            asm volatile("s_waitcnt vmcnt(0)" ::: "memory");
        }
    }
    __syncthreads();
}

constexpr size_t MiB = 1u << 20;
constexpr size_t al(size_t x) { return (x + 4095) & ~(size_t)4095; }
constexpr size_t WS_CTL = 0, CTL_ZERO_BYTES = 1 * MiB;
constexpr int CW_BAR = 4096;
constexpr int CW_CNT = 16384;
constexpr int CW_NT = 16384 + 512;
constexpr size_t WS_MOD = 1 * MiB;
constexpr size_t WS_TILE_E = WS_MOD + 256 * 1024;
constexpr size_t WS_PADSTART = WS_TILE_E + 16 * 1024;
constexpr size_t WS_ROWTOK = 2 * MiB;
constexpr size_t WS_EIDX = 4 * MiB;
constexpr size_t WS_GATE = 5 * MiB;
constexpr size_t WS_DEST = 6 * MiB;
constexpr size_t WS_WIN = 8 * MiB;
constexpr size_t WS_WLORA = WS_WIN + al((size_t)NP * D * 2);
constexpr size_t WS_WBRRW = WS_WLORA + al((size_t)NLORA * KLORA * 2);
constexpr size_t WS_WBRGLA = WS_WBRRW + al((size_t)D * RWW * 2);
constexpr size_t WS_WOUT = WS_WBRGLA + al((size_t)D * RWW * 2);
constexpr size_t WS_WROUTER = WS_WOUT + al((size_t)D * D * 2);
constexpr size_t WS_WGU = WS_WROUTER + al((size_t)NE * D * 2);
constexpr size_t WS_WD = WS_WGU + al((size_t)(NE + 1) * 512 * D * 2);
constexpr size_t WS_PERSIST_END = WS_WD + al((size_t)(NE + 1) * D * FF * 2);
constexpr size_t WS_REGB = WS_PERSIST_END;
constexpr size_t SZ512F = al((size_t)MR * RWW * 4), SZ256F = al((size_t)MR * 256 * 4), SZ512H = al((size_t)MR * RWW * 2);
constexpr size_t WS_A1 = WS_REGB;
constexpr size_t WS_A2 = WS_A1;
constexpr size_t WS_KSUM = WS_A2 + al((size_t)MR * KLORA * 2);
static_assert(WS_KSUM + SZ512H <= WS_A1 + al((size_t)MR * D * 2), "A2 + KSUM fit in the A1 slot");
constexpr size_t WS_P = WS_A1 + al((size_t)MR * D * 2);
constexpr size_t WS_RB = WS_P + al((size_t)MR * NP * 2);
constexpr size_t WS_VB = WS_RB + SZ512H, WS_KKB = WS_VB + SZ512H, WS_KMF = WS_KKB + SZ512H, WS_KMB = WS_KMF + SZ512H, WS_BVF = WS_KMB + SZ512H, WS_BVB = WS_BVF + SZ512H;
constexpr size_t WS_LWF = WS_BVB + SZ512H, WS_LWB = WS_LWF + SZ512F;
constexpr size_t SZ256H = al((size_t)MR * 256 * 2);
constexpr size_t WS_QGB = WS_LWB + SZ512F, WS_KGB = WS_QGB + SZ256H, WS_VGB = WS_KGB + SZ256H, WS_LAF = WS_VGB + SZ512H, WS_LAB = WS_LAF + SZ256F;
constexpr size_t WS_RWG = WS_LAB + SZ256F;
constexpr size_t WS_ORWF = WS_RWG + SZ512H, WS_ORWB = WS_ORWF + SZ512H, WS_OGLF = WS_ORWB + SZ512H, WS_OGLB = WS_OGLF + SZ512H;
constexpr int CH = 64, NCHUNK = (CTXL + SEQ) / CH, NU_RW = 64 * NCHUNK, NU_GL = 32 * NCHUNK;
constexpr size_t WS_RH = WS_OGLB + SZ512H;
constexpr size_t WS_YL = WS_RH + al((size_t)NU_RW * 4096 * 2);
constexpr size_t WS_HH = WS_YL + al((size_t)NU_RW * 4096 * 2);
constexpr size_t WS_INTRA = WS_HH + al((size_t)NU_RW * 4096 * 2);
constexpr size_t WS_KV = WS_INTRA + al((size_t)NU_GL * 8192 * 2);
constexpr size_t WS_DD = WS_KV + al((size_t)NU_GL * 8192 * 2);
constexpr size_t WS_END_MIX = WS_DD + al((size_t)NU_GL * 64 * 4);
constexpr size_t OUT_GT = 0, OUT_QE = (size_t)NU_RW * 4096 * 2;
static_assert(OUT_QE + (size_t)NU_GL * 4096 * 2 <= (size_t)NLAT * D * 4, "scan scratch fits in d_out");
constexpr size_t WS_YRW = WS_LWF, WS_YGLA = WS_LWB, WS_Z = WS_HH;
static_assert((size_t)NLAT * D * 2 <= (size_t)NU_RW * 4096 * 2, "Z fits in the HH slot");
constexpr size_t WS_X1 = WS_REGB;
constexpr size_t WS_A3 = WS_X1 + al((size_t)NLAT * D * 4);
constexpr size_t WS_LOGITS = WS_A3 + al((size_t)NLAT * D * 2);
constexpr size_t WS_ACT = WS_LOGITS + al((size_t)NLAT * NE * 4);
constexpr size_t WS_Y = WS_ACT + al((size_t)NROWS_E * FF * 2);
constexpr size_t WS_A3F = WS_Y + al((size_t)NROWS_E * D);
constexpr size_t WS_END_MOE = WS_A3F + al((size_t)NLAT * D);
constexpr size_t WS_END = WS_END_MIX > WS_END_MOE ? WS_END_MIX : WS_END_MOE;
static_assert(WS_END <= (size_t)2048 * MiB, "workspace map exceeds 2 GiB");

constexpr int RING_BYTES = 131072;
constexpr int IDX_BYTES = pg8::IDX_UNITS * 256 * 4;
constexpr int MISC_OFF = RING_BYTES + IDX_BYTES;
constexpr int LDS_BYTES = MISC_OFF + 256;
static_assert(pg8::IDX_OFF == RING_BYTES, "gather table sits right above the stage buffers");
constexpr int NWAVES = 8, NTHR = 512;

struct Args { const float* in[36]; float* out; unsigned char* ws; int ph_lo, ph_hi; };

struct Frame {
    LAS unsigned char* lds;
    int tid, lane, wave, G, gw, NGW;
    const float* const* in; float* out; unsigned char* ws; unsigned* ctl;
};

__device__ __forceinline__ float wave_sum(float v) {
#pragma unroll
    for (int o = 1; o < 64; o <<= 1) v += __shfl_xor(v, o);
    return v;
}
__device__ __forceinline__ unsigned f2bf(float f) { unsigned u = __builtin_bit_cast(unsigned, f); return (u + 0x7fffu + ((u >> 16) & 1u)) >> 16; }
typedef __bf16 bf16x2v __attribute__((ext_vector_type(2)));
__device__ __forceinline__ unsigned pk2(float lo, float hi) { const f32x2 v = {lo, hi}; return __builtin_bit_cast(unsigned, __builtin_convertvector(v, bf16x2v)); }
__device__ __forceinline__ float bflo(unsigned w) { return __builtin_bit_cast(float, w << 16); }
__device__ __forceinline__ float bfhi(unsigned w) { return __builtin_bit_cast(float, w & 0xffff0000u); }
__device__ __forceinline__ float sigmoidf_(float x) { return 1.0f / (1.0f + __expf(-x)); }
__device__ __forceinline__ float siluf_(float x) { return x / (1.0f + __expf(-x)); }

__device__ __forceinline__ void ln_stats(const f32x4 (&v)[4], float& mean, float& rstd) {
    float s = 0.f;
#pragma unroll
    for (int j = 0; j < 4; ++j) s += (v[j].x + v[j].y) + (v[j].z + v[j].w);
    mean = wave_sum(s) * (1.f / D); float s2 = 0.f;
#pragma unroll
    for (int j = 0; j < 4; ++j) { const f32x4 d = v[j] - mean; s2 += (d.x * d.x + d.y * d.y) + (d.z * d.z + d.w * d.w); }
    rstd = 1.f / sqrtf(wave_sum(s2) * (1.f / D) + LN_EPS);
}

__device__ __forceinline__ unsigned pack_fp8x4(const f32x4 v) {
    int w = __builtin_amdgcn_cvt_pk_fp8_f32(__builtin_amdgcn_fmed3f(v[0], -448.f, 448.f), __builtin_amdgcn_fmed3f(v[1], -448.f, 448.f), 0, false);
    return (unsigned)__builtin_amdgcn_cvt_pk_fp8_f32(__builtin_amdgcn_fmed3f(v[2], -448.f, 448.f), __builtin_amdgcn_fmed3f(v[3], -448.f, 448.f), w, true); }
__device__ __forceinline__ void ld_row_bf16(const bf16* row, int lane, f32x4 (&v)[4]) {
    const v4u a = *(const v4u*)(row + 8 * lane), b = *(const v4u*)(row + 512 + 8 * lane);
    v[0] = (f32x4){bflo(a.x), bfhi(a.x), bflo(a.y), bfhi(a.y)}; v[1] = (f32x4){bflo(a.z), bfhi(a.z), bflo(a.w), bfhi(a.w)};
    v[2] = (f32x4){bflo(b.x), bfhi(b.x), bflo(b.y), bfhi(b.y)}; v[3] = (f32x4){bflo(b.z), bfhi(b.z), bflo(b.w), bfhi(b.w)};
}
__device__ __forceinline__ int rowcol(int lane, int j) { return 512 * (j >> 1) + 8 * lane + 4 * (j & 1); }
__device__ __forceinline__ void ph_x1pre_nomix(Frame& F) {
    const float* x = F.in[0];
    for (int m = F.gw; m < NLAT; m += F.NGW) {
        bf16* o = (bf16*)(F.ws + WS_X1) + (size_t)m * D;
#pragma unroll
        for (int h = 0; h < 2; ++h) { const float* xr = x + (size_t)m * D + 512 * h + 8 * F.lane; const f32x4 a = *(const f32x4*)xr * ALPHA, b = *(const f32x4*)(xr + 4) * ALPHA;
            v4u w; w.x = pk2(a.x, a.y); w.y = pk2(a.z, a.w); w.z = pk2(b.x, b.y); w.w = pk2(b.z, b.w); *(v4u*)(o + 512 * h + 8 * F.lane) = w; }
    }
}
__device__ __forceinline__ void ph_ln1(Frame& F) {
    const float* lw = F.in[26]; const float* lb = F.in[27]; const float* mod = (const float*)(F.ws + WS_MOD);
    bf16* A3 = (bf16*)(F.ws + WS_A3); const bf16* X1P = (const bf16*)(F.ws + WS_X1);
    constexpr int NR = 4;
    for (int m0 = F.gw; m0 < NLAT; m0 += NR * F.NGW) {
        v4u w[NR][2];
#pragma unroll
        for (int r = 0; r < NR; ++r) { const int mm = m0 + r * F.NGW; const bf16* row = X1P + (size_t)(mm < NLAT ? mm : m0) * D; w[r][0] = *(const v4u*)(row + 8 * F.lane); w[r][1] = *(const v4u*)(row + 512 + 8 * F.lane); }
        __builtin_amdgcn_sched_barrier(0);
#pragma unroll
        for (int r = 0; r < NR; ++r) { const int mm = m0 + r * F.NGW; const int m = mm < NLAT ? mm : m0; const int b = m / SEQ;
            f32x4 v[4];
            v[0] = (f32x4){bflo(w[r][0].x), bfhi(w[r][0].x), bflo(w[r][0].y), bfhi(w[r][0].y)}; v[1] = (f32x4){bflo(w[r][0].z), bfhi(w[r][0].z), bflo(w[r][0].w), bfhi(w[r][0].w)};
            v[2] = (f32x4){bflo(w[r][1].x), bfhi(w[r][1].x), bflo(w[r][1].y), bfhi(w[r][1].y)}; v[3] = (f32x4){bflo(w[r][1].z), bfhi(w[r][1].z), bflo(w[r][1].w), bfhi(w[r][1].w)};
            float mean, rstd; ln_stats(v, mean, rstd);
#if MS >= 2
            f32x4 h[4];
#pragma unroll
            for (int j = 0; j < 4; ++j) { const int c = rowcol(F.lane, j);
                const f32x4 x1 = (v[j] - mean) * rstd * *(const f32x4*)(lw + c) + *(const f32x4*)(lb + c);
                h[j] = x1 * (*(const f32x4*)(mod + b * 6144 + 4096 + c) + 1.0f) + *(const f32x4*)(mod + b * 6144 + 3072 + c); }
            bf16* ao = A3 + (size_t)m * D;
            { v4u o; o.x = pk2(h[0].x, h[0].y); o.y = pk2(h[0].z, h[0].w); o.z = pk2(h[1].x, h[1].y); o.w = pk2(h[1].z, h[1].w); *(v4u*)(ao + 8 * F.lane) = o;
              o.x = pk2(h[2].x, h[2].y); o.y = pk2(h[2].z, h[2].w); o.z = pk2(h[3].x, h[3].y); o.w = pk2(h[3].z, h[3].w); *(v4u*)(ao + 512 + 8 * F.lane) = o; }
            { unsigned char* af = F.ws + WS_A3F + (size_t)m * D; v2u o8;
              o8.x = pack_fp8x4(h[0]); o8.y = pack_fp8x4(h[1]); *(v2u*)(af + 8 * F.lane) = o8; o8.x = pack_fp8x4(h[2]); o8.y = pack_fp8x4(h[3]); *(v2u*)(af + 512 + 8 * F.lane) = o8; }
#endif
        }
    }
}
__device__ __forceinline__ f32x4 fp8x4(unsigned w) { const f32x2 lo = __builtin_amdgcn_cvt_pk_f32_fp8((int)w, false), hi = __builtin_amdgcn_cvt_pk_f32_fp8((int)w, true); return (f32x4){lo.x, lo.y, hi.x, hi.y}; }
__device__ __forceinline__ void ph_final(Frame& F) {
    const float* lw = F.in[34]; const float* lb = F.in[35]; const float* mod = (const float*)(F.ws + WS_MOD);
    const float* lw1 = F.in[26]; const float* lb1 = F.in[27]; const bf16* X1P = (const bf16*)(F.ws + WS_X1);
    const unsigned char* Y = F.ws + WS_Y; const int* DEST = (const int*)(F.ws + WS_DEST); const float* GATE = (const float*)(F.ws + WS_GATE);
    const int c0 = 16 * F.lane;
    for (int m0 = F.gw; m0 < NLAT; m0 += 2 * F.NGW) {
        int mm[2]; mm[0] = m0; mm[1] = (m0 + F.NGW < NLAT) ? m0 + F.NGW : m0;
        v4u xw[2][2];
#if MS >= 2
        v4u dw[2][2]; f32x4 gw[2][2];
#pragma unroll
        for (int r = 0; r < 2; ++r) { dw[r][0] = *(const v4u*)(DEST + mm[r] * 8); dw[r][1] = *(const v4u*)(DEST + mm[r] * 8 + 4); gw[r][0] = *(const f32x4*)(GATE + mm[r] * 8); gw[r][1] = *(const f32x4*)(GATE + mm[r] * 8 + 4); }
#endif
#pragma unroll
        for (int r = 0; r < 2; ++r) { const bf16* row = X1P + (size_t)mm[r] * D + c0; xw[r][0] = *(const v4u*)row; xw[r][1] = *(const v4u*)(row + 8); }
#if MS >= 2
        v4u yw[2][TOPK + 1];
#pragma unroll
        for (int r = 0; r < 2; ++r) {
            int dr[TOPK]; dr[0] = (int)dw[r][0].x; dr[1] = (int)dw[r][0].y; dr[2] = (int)dw[r][0].z; dr[3] = (int)dw[r][0].w; dr[4] = (int)dw[r][1].x; dr[5] = (int)dw[r][1].y; dr[6] = (int)dw[r][1].z; dr[7] = (int)dw[r][1].w;
#pragma unroll
            for (int k = 0; k <= TOPK; ++k) yw[r][k] = *(const v4u*)(Y + (size_t)(k < TOPK ? dr[k < TOPK ? k : 0] : SH_ROW0 + mm[r]) * D + c0); }
        __builtin_amdgcn_sched_barrier(0);
#endif
#pragma unroll
        for (int r = 0; r < 2; ++r) { const int m = mm[r]; const int b = m / SEQ;
            f32x4 v[4];
            v[0] = (f32x4){bflo(xw[r][0].x), bfhi(xw[r][0].x), bflo(xw[r][0].y), bfhi(xw[r][0].y)}; v[1] = (f32x4){bflo(xw[r][0].z), bfhi(xw[r][0].z), bflo(xw[r][0].w), bfhi(xw[r][0].w)};
            v[2] = (f32x4){bflo(xw[r][1].x), bfhi(xw[r][1].x), bflo(xw[r][1].y), bfhi(xw[r][1].y)}; v[3] = (f32x4){bflo(xw[r][1].z), bfhi(xw[r][1].z), bflo(xw[r][1].w), bfhi(xw[r][1].w)};
            { float mean1, rstd1; ln_stats(v, mean1, rstd1);
#pragma unroll
              for (int j = 0; j < 4; ++j) { const int c = c0 + 4 * j; v[j] = ((v[j] - mean1) * rstd1 * *(const f32x4*)(lw1 + c) + *(const f32x4*)(lb1 + c)) * ALPHA; } }
#if MS >= 2
            const float gt[TOPK] = {gw[r][0].x * 0.0625f, gw[r][0].y * 0.0625f, gw[r][0].z * 0.0625f, gw[r][0].w * 0.0625f, gw[r][1].x * 0.0625f, gw[r][1].y * 0.0625f, gw[r][1].z * 0.0625f, gw[r][1].w * 0.0625f};
#pragma unroll
            for (int j = 0; j < 4; ++j) { const unsigned ws8 = j == 0 ? yw[r][TOPK].x : (j == 1 ? yw[r][TOPK].y : (j == 2 ? yw[r][TOPK].z : yw[r][TOPK].w));
                f32x4 mo = fp8x4(ws8) * 0.0625f;
#pragma unroll
                for (int k = 0; k < TOPK; ++k) { const unsigned wk = j == 0 ? yw[r][k].x : (j == 1 ? yw[r][k].y : (j == 2 ? yw[r][k].z : yw[r][k].w)); mo += fp8x4(wk) * gt[k]; }
                v[j] += *(const f32x4*)(mod + b * 6144 + 5120 + c0 + 4 * j) * mo; }
#endif
            float mean, rstd; ln_stats(v, mean, rstd);
            float* o = F.out + (size_t)m * D + c0;
#pragma unroll
            for (int j = 0; j < 4; ++j) { const int c = c0 + 4 * j; *(f32x4*)(o + 4 * j) = (v[j] - mean) * rstd * *(const f32x4*)(lw + c) + *(const f32x4*)(lb + c); }
        }
    }
}


#if MS >= 2
template <int MODE, bool FP8 = false>
__device__ __forceinline__ void cvt_item(const float* W, int Nsrc, int nblk, bf16* WT, int row_off, int dpitch, LAS float* scr, int item, int lane) {
    const int kb = item / nblk, nb = item - kb * nblk, k0 = 64 * kb, n0 = 32 * nb;
    const int nn = n0 + (lane & 31);
#pragma unroll 8
    for (int i = 0; i < 32; ++i) { const int kk = 2 * i + (lane >> 5); scr[kk * 33 + (lane & 31)] = (nn < Nsrc) ? W[(size_t)(k0 + kk) * Nsrc + nn] : 0.f; }
    LDS_WAIT(); asm volatile("" ::: "memory");
    const int c = lane & 7;
#pragma unroll
    for (int j = 0; j < 4; ++j) { const int n = (lane >> 3) + 8 * j; const LAS float* s = scr + (8 * c) * 33 + n;
        v4u o; o.x = pk2(s[0 * 33], s[1 * 33]); o.y = pk2(s[2 * 33], s[3 * 33]); o.z = pk2(s[4 * 33], s[5 * 33]); o.w = pk2(s[6 * 33], s[7 * 33]);
        const int ng = n0 + n; int dr = ng;
        if (MODE == 1) { const int i2 = ng & 255; dr = 8 * (i2 >> 2) + (i2 & 3) + ((ng >= 256) ? 4 : 0); }
        if constexpr (FP8) { v2u o8; o8.x = pack_fp8x4((f32x4){s[0 * 33], s[1 * 33], s[2 * 33], s[3 * 33]} * W8S); o8.y = pack_fp8x4((f32x4){s[4 * 33], s[5 * 33], s[6 * 33], s[7 * 33]} * W8S);
            *(v2u*)((unsigned char*)WT + (size_t)(row_off + dr) * dpitch + k0 + 8 * c) = o8; }
        else *(v4u*)(WT + (size_t)(row_off + dr) * dpitch + k0 + 8 * c) = o; }
    LDS_WAIT(); asm volatile("" ::: "memory");
}

template <int MODE>
__device__ __forceinline__ void cvt_item_reg(const float* W, int Nsrc, bf16* WT, int row_off, int dpitch, int k0, int n0, int lane) {
    const float* src = W + (size_t)k0 * Nsrc + n0 + 4 * lane;
    f32x4 v[32];
#pragma unroll
    for (int i = 0; i < 32; ++i) v[i] = __builtin_nontemporal_load((const f32x4*)(src + (size_t)i * Nsrc));
#pragma unroll
    for (int j = 0; j < 4; ++j) {
        const int ng = n0 + 4 * lane + j; int dr = ng;
        if (MODE == 1) { const int i2 = ng & 255; dr = 8 * (i2 >> 2) + (i2 & 3) + ((ng >= 256) ? 4 : 0); }
        v4u* dst = (v4u*)(WT + (size_t)(row_off + dr) * dpitch + k0);
#pragma unroll
        for (int q = 0; q < 4; ++q) { v4u o; o.x = pk2(v[8 * q][j], v[8 * q + 1][j]); o.y = pk2(v[8 * q + 2][j], v[8 * q + 3][j]); o.z = pk2(v[8 * q + 4][j], v[8 * q + 5][j]); o.w = pk2(v[8 * q + 6][j], v[8 * q + 7][j]); dst[q] = o; }
    }
}

constexpr int CVK = 32;
__device__ __forceinline__ void cvt_reg_load(const float* W, int Nsrc, int k0, int n0, int lane, f32x4 (&v)[CVK]) {
    const float* src = W + (size_t)k0 * Nsrc + n0 + 4 * lane;
#pragma unroll
    for (int i = 0; i < CVK; ++i) v[i] = __builtin_nontemporal_load((const f32x4*)(src + (size_t)i * Nsrc));
}
template <int MODE, bool FP8 = false>
__device__ __forceinline__ void cvt_reg_store(bf16* WT, int row_off, int dpitch, int k0, int n0, int lane, const f32x4 (&v)[CVK]) {
#pragma unroll
    for (int j = 0; j < 4; ++j) {
        const int ng = n0 + 4 * lane + j; int dr = ng;
        if (MODE == 1) { const int i2 = ng & 255; dr = 8 * (i2 >> 2) + (i2 & 3) + ((ng >= 256) ? 4 : 0); }
        if constexpr (FP8) { v4u* dst8 = (v4u*)((unsigned char*)WT + (size_t)(row_off + dr) * dpitch + k0);
#pragma unroll
            for (int q = 0; q < CVK / 16; ++q) { v4u o;
                o.x = pack_fp8x4((f32x4){v[16 * q][j], v[16 * q + 1][j], v[16 * q + 2][j], v[16 * q + 3][j]} * W8S); o.y = pack_fp8x4((f32x4){v[16 * q + 4][j], v[16 * q + 5][j], v[16 * q + 6][j], v[16 * q + 7][j]} * W8S);
                o.z = pack_fp8x4((f32x4){v[16 * q + 8][j], v[16 * q + 9][j], v[16 * q + 10][j], v[16 * q + 11][j]} * W8S); o.w = pack_fp8x4((f32x4){v[16 * q + 12][j], v[16 * q + 13][j], v[16 * q + 14][j], v[16 * q + 15][j]} * W8S); dst8[q] = o; }
            continue; }
        v4u* dst = (v4u*)(WT + (size_t)(row_off + dr) * dpitch + k0);
#pragma unroll
        for (int q = 0; q < CVK / 8; ++q) { v4u o; o.x = pg8::cvt_pk_bf16(v[8 * q][j], v[8 * q + 1][j]); o.y = pg8::cvt_pk_bf16(v[8 * q + 2][j], v[8 * q + 3][j]); o.z = pg8::cvt_pk_bf16(v[8 * q + 4][j], v[8 * q + 5][j]); o.w = pg8::cvt_pk_bf16(v[8 * q + 6][j], v[8 * q + 7][j]); dst[q] = o; }
    }
}
constexpr int CV_GU = (D / CVK) * 2, CV_DN = (FF / CVK) * 4, CV_NGU = (NE + 1) * CV_GU, CV_NITEM = CV_NGU + (NE + 1) * CV_DN;
__device__ __forceinline__ void cvx_load(const float* const* in, int it, int lane, f32x4 (&v)[CVK]) {
    if (it < CV_NGU) { const int e = it / CV_GU, ii = it - e * CV_GU; const float* src = (e < NE) ? in[30] + (size_t)e * D * 512 : in[32];
        cvt_reg_load(src, 512, CVK * (ii >> 1), 256 * (ii & 1), lane, v); }
    else { const int r = it - CV_NGU, e = r / CV_DN, ii = r - e * CV_DN; const float* src = (e < NE) ? in[31] + (size_t)e * FF * D : in[33];
        cvt_reg_load(src, D, CVK * (ii >> 2), 256 * (ii & 3), lane, v); }
}
__device__ __forceinline__ void cvx_store(unsigned char* ws, int it, int lane, const f32x4 (&v)[CVK]) {
    if (it < CV_NGU) { const int e = it / CV_GU, ii = it - e * CV_GU; cvt_reg_store<1, true>((bf16*)(ws + WS_WGU), e * 512, D, CVK * (ii >> 1), 256 * (ii & 1), lane, v); }
    else { const int r = it - CV_NGU, e = r / CV_DN, ii = r - e * CV_DN; cvt_reg_store<0, true>((bf16*)(ws + WS_WD), e * D, FF, CVK * (ii >> 2), 256 * (ii & 3), lane, v); }
}

#if MS >= 3
__device__ __forceinline__ float lora_val(const float* const* in, int n, int k) {
    if (n < 1024) { const int q = n >> 3, e8 = n & 7, dir = e8 >> 2, ch = q * 4 + (e8 & 3); return (k < 32) ? in[9][(size_t)(dir * 32 + k) * 512 + ch] : 0.f; }
    if (n < 2048) { const int m = n - 1024, q = m >> 3, e8 = m & 7, dir = e8 >> 2, ch = q * 4 + (e8 & 3); return (k >= 32 && k < 64) ? in[11][(size_t)(dir * 32 + (k - 32)) * 512 + ch] : 0.f; }
    if (n < 2560) { const int ch = n - 2048; return (k >= 64 && k < 160) ? in[12][(size_t)(k - 64) * 512 + ch] : 0.f; }
    { const int m = n - 2560, q = m >> 3, e8 = m & 7, dir = e8 >> 2, ch = q * 4 + (e8 & 3); return (k >= 160 && k < 176) ? in[19][(size_t)(dir * 16 + (k - 160)) * 256 + ch] : 0.f; }
}
#endif

__device__ __forceinline__ void ph_prologue(Frame& F) {
    {
        const float* c = F.in[1]; const float* cc = F.in[3]; const float* wa = F.in[4]; const float* ba = F.in[5];
        float* MOD = (float*)(F.ws + WS_MOD);
        LAS float* S = (LAS float*)F.lds; LAS float* red = (LAS float*)(F.lds + 32768);
        for (int it = blockIdx.x; it < 96; it += F.G) {
            for (int i = F.tid; i < 5120; i += NTHR) { const int r = i >> 10, k = i & 1023; const float cv = r < 4 ? c[r * 1024 + k] : cc[k]; S[i] = siluf_(cv); }
            __syncthreads();
            const int n = it * 64 + F.lane; float acc[5] = {0.f, 0.f, 0.f, 0.f, 0.f};
            for (int kk = 0; kk < 128; ++kk) { const int k = F.wave * 128 + kk; const float wv = wa[(size_t)k * 6144 + n];
#pragma unroll
                for (int r = 0; r < 5; ++r) acc[r] += S[r * 1024 + k] * wv; }
#pragma unroll
            for (int r = 0; r < 5; ++r) red[(F.wave * 5 + r) * 64 + F.lane] = acc[r];
            __syncthreads();
            if (F.wave == 0) {
#pragma unroll
                for (int r = 0; r < 5; ++r) { float s = 0.f;
#pragma unroll
                    for (int w = 0; w < 8; ++w) s += red[(w * 5 + r) * 64 + F.lane];
                    MOD[r * 6144 + n] = s + ba[n]; }
            }
            __syncthreads();
        }
    }
    {
        LAS float* scr = (LAS float*)(F.lds + F.wave * 16384);
        constexpr int I_IN = 16 * 168, I_BR = 8 * 32, I_OUT = 16 * 32, I_RT = 16 * 8, I_GU = 32 * 2, I_DN = 8 * 4;
        constexpr int T0 = I_IN, T1 = T0 + I_BR, T2 = T1 + I_BR, T3 = T2 + I_OUT, T4 = T3 + I_RT, T5 = T4 + (NE + 1) * I_GU, T6 = T5 + (NE + 1) * I_DN;
        unsigned char* ws = F.ws;
        for (int it = F.gw; it < T6; it += F.NGW) {
#if MS >= 3
            if (it < T0) { cvt_item<0, true>(F.in[6], IN_COLS, 168, (bf16*)(ws + WS_WIN), 0, D, scr, it, F.lane); continue; }
            if (it < T1) { cvt_item<0>(F.in[23], D, 32, (bf16*)(ws + WS_WBRRW), 0, RWW, scr, it - T0, F.lane); continue; }
            if (it < T2) { cvt_item<0>(F.in[24], D, 32, (bf16*)(ws + WS_WBRGLA), 0, RWW, scr, it - T1, F.lane); continue; }
            if (it < T3) { cvt_item<0>(F.in[25], D, 32, (bf16*)(ws + WS_WOUT), 0, D, scr, it - T2, F.lane); continue; }
#else
            if (it < T3) continue;
#endif
            if (it < T4) { cvt_item<0>(F.in[28], NE, 8, (bf16*)(ws + WS_WROUTER), 0, D, scr, it - T3, F.lane); continue; }
#if MS >= 3
            break;
#endif
            if (it < T5) { const int r = it - T4, e = r / I_GU, ii = r - e * I_GU;
                const float* src = (e < NE) ? F.in[30] + (size_t)e * D * 512 : F.in[32];
                cvt_item_reg<1>(src, 512, (bf16*)(ws + WS_WGU), e * 512, D, 32 * (ii >> 1), 256 * (ii & 1), F.lane); continue; }
            { const int r = it - T5, e = r / I_DN, ii = r - e * I_DN;
                const float* src = (e < NE) ? F.in[31] + (size_t)e * FF * D : F.in[33];
                cvt_item_reg<0>(src, D, (bf16*)(ws + WS_WD), e * D, FF, 32 * (ii >> 2), 256 * (ii & 3), F.lane); }
        }
    }
#if MS >= 3
    {
        bf16* WL = (bf16*)(F.ws + WS_WLORA);
        for (int idx = blockIdx.x * NTHR + F.tid; idx < NLORA * (KLORA / 8); idx += F.G * NTHR) {
            const int n = idx >> 5, k0 = (idx & 31) * 8; float v[8];
#pragma unroll
            for (int e = 0; e < 8; ++e) v[e] = lora_val(F.in, n, k0 + e);
            v4u o; o.x = pk2(v[0], v[1]); o.y = pk2(v[2], v[3]); o.z = pk2(v[4], v[5]); o.w = pk2(v[6], v[7]);
            *(v4u*)(WL + (size_t)n * KLORA + k0) = o;
        }
    }
#endif
}

struct EpiF32 {
    static constexpr bool PERM = false;
    float* C; int ldc;
    __device__ __forceinline__ void operator()(const f32x4 (&acc)[2][2][4][2], const pg8::Unit& u, int wr, int wc, int fr, int fq) const {
        const int row0 = u.pm * 256 + wr * 64 + fr, col0 = u.pn * 256 + wc * 32 + 4 * fq;
#pragma unroll
        for (int ai = 0; ai < 2; ++ai)
#pragma unroll
            for (int m = 0; m < 4; ++m) { float* rowp = C + (size_t)(row0 + ai * 128 + m * 16) * ldc + col0;
#pragma unroll
                for (int bj = 0; bj < 2; ++bj)
#pragma unroll
                    for (int n = 0; n < 2; ++n) *(f32x4*)(rowp + bj * 128 + n * 16) = acc[ai][bj][m][n]; }
    }
};
struct EpiSwiglu {
    static constexpr bool PERM = true;
    unsigned char* ACT;
    __device__ __forceinline__ void operator()(const f32x4 (&acc)[2][2][4][2], const pg8::Unit& u, int wr, int wc, int fr, int fq) const {
        const int row0 = u.pm * 256 + wr * 64 + fr, h0 = u.j * 128 + wc * 16 + 4 * fq;
#pragma unroll
        for (int ai = 0; ai < 2; ++ai)
#pragma unroll
            for (int m = 0; m < 4; ++m) { unsigned char* rowp = ACT + (size_t)(row0 + ai * 128 + m * 16) * FF + h0;
#pragma unroll
                for (int bj = 0; bj < 2; ++bj) { const f32x4 a = acc[ai][bj][m][0] * W8I, b = acc[ai][bj][m][1] * W8I;
                    *(unsigned*)(rowp + bj * 64) = pack_fp8x4((f32x4){siluf_(a[0]) * b[0], siluf_(a[1]) * b[1], siluf_(a[2]) * b[2], siluf_(a[3]) * b[3]}); } }
    }
};
struct EpiRowsBf16 {
    static constexpr bool PERM = true;
    bf16* O; int ldc; float sc;
    __device__ __forceinline__ void operator()(const f32x4 (&acc)[2][2][4][2], const pg8::Unit& u, int wr, int wc, int fr, int fq) const {
        const int row0 = u.pm * 256 + wr * 64 + fr, col0 = u.j * 256 + wc * 32 + 8 * fq;
#pragma unroll
        for (int ai = 0; ai < 2; ++ai)
#pragma unroll
            for (int m = 0; m < 4; ++m) { bf16* rowp = O + (size_t)(row0 + ai * 128 + m * 16) * ldc + col0;
#pragma unroll
                for (int bj = 0; bj < 2; ++bj) { const f32x4 v0 = acc[ai][bj][m][0] * sc, v1 = acc[ai][bj][m][1] * sc;
                    v4u w; w.x = pg8::cvt_pk_bf16(v0[0], v0[1]); w.y = pg8::cvt_pk_bf16(v0[2], v0[3]); w.z = pg8::cvt_pk_bf16(v1[0], v1[1]); w.w = pg8::cvt_pk_bf16(v1[2], v1[3]);
                    *(v4u*)(rowp + bj * 128) = w; } }
    }
};

struct EpiRowsFp8 {
    static constexpr bool PERM = true;
    unsigned char* O;
    __device__ __forceinline__ void operator()(const f32x4 (&acc)[2][2][4][2], const pg8::Unit& u, int wr, int wc, int fr, int fq) const {
        const int row0 = u.pm * 256 + wr * 64 + fr, col0 = u.j * 256 + wc * 32 + 8 * fq;
#pragma unroll
        for (int ai = 0; ai < 2; ++ai)
#pragma unroll
            for (int m = 0; m < 4; ++m) { unsigned char* rowp = O + (size_t)(row0 + ai * 128 + m * 16) * D + col0;
#pragma unroll
                for (int bj = 0; bj < 2; ++bj) { f32x4 v0 = acc[ai][bj][m][0] * (16.0f * W8I), v1 = acc[ai][bj][m][1] * (16.0f * W8I);
#pragma unroll
                    for (int e = 0; e < 4; ++e) { v0[e] = __builtin_amdgcn_fmed3f(v0[e], -448.0f, 448.0f); v1[e] = __builtin_amdgcn_fmed3f(v1[e], -448.0f, 448.0f); }
                    int w0 = __builtin_amdgcn_cvt_pk_fp8_f32(v0[0], v0[1], 0, false); w0 = __builtin_amdgcn_cvt_pk_fp8_f32(v0[2], v0[3], w0, true);
                    int w1 = __builtin_amdgcn_cvt_pk_fp8_f32(v1[0], v1[1], 0, false); w1 = __builtin_amdgcn_cvt_pk_fp8_f32(v1[2], v1[3], w1, true);
                    v2u w; w.x = (unsigned)w0; w.y = (unsigned)w1; *(v2u*)(rowp + bj * 128) = w; } }
    }
};

__device__ __forceinline__ void ph_router(Frame& F) {
    pg8::Gemm g{(const bf16*)(F.ws + WS_A3), (const bf16*)(F.ws + WS_WROUTER), NLAT, NE, D, nullptr};
    pg8::StaticOrder S; S.init(NLAT, NE, F.G, (int)blockIdx.x);
    EpiF32 E{(float*)(F.ws + WS_LOGITS), NE};
    pg8::gemm_phase<EpiF32, pg8::StaticOrder, true, true, false>(F.lds, g, S, E);
}

__device__ __forceinline__ void ph_route(Frame& F) {
    const float* LOG = (const float*)(F.ws + WS_LOGITS); const float* rb = F.in[29];
    int* EIDX = (int*)(F.ws + WS_EIDX); float* GATE = (float*)(F.ws + WS_GATE); int* DEST = (int*)(F.ws + WS_DEST);
    unsigned* CNT = F.ctl + CW_CNT;
    const f32x4 bias = *(const f32x4*)(rb + 4 * F.lane);
    const float NEG = -3.0e38f;
    f32x4 lgn = *(const f32x4*)(LOG + (size_t)(F.gw < NLAT ? F.gw : 0) * NE + 4 * F.lane);
    for (int m = F.gw; m < NLAT; m += F.NGW) {
        const f32x4 lg = lgn;
        { const int mn = (m + F.NGW < NLAT) ? m + F.NGW : m; lgn = *(const f32x4*)(LOG + (size_t)mn * NE + 4 * F.lane); }
        float sc[4], sel[4];
#pragma unroll
        for (int i = 0; i < 4; ++i) { sc[i] = sigmoidf_(lg[i]); sel[i] = sc[i] + bias[i]; }
        float m1 = fmaxf(sel[0], sel[1]), m2 = fminf(sel[0], sel[1]);
        { const float a = sel[2]; const float n1 = fmaxf(m1, a); m2 = fmaxf(m2, fminf(m1, a)); m1 = n1; }
        { const float a = sel[3]; const float n1 = fmaxf(m1, a); m2 = fmaxf(m2, fminf(m1, a)); m1 = n1; }
#pragma unroll
        for (int o = 1; o < 8; o <<= 1) { const float b1 = __shfl_xor(m1, o), b2 = __shfl_xor(m2, o); const float n1 = fmaxf(m1, b1); m2 = fmaxf(fminf(m1, b1), fmaxf(m2, b2)); m1 = n1; }
        const float gs = m1 + m2; const int g = F.lane >> 3;
        int rank = 0;
#pragma unroll
        for (int gg = 0; gg < 8; ++gg) { const float og = __shfl(gs, gg * 8); rank += (og > gs || (og == gs && gg < g)) ? 1 : 0; }
        const bool keep = rank < 4;
#pragma unroll
        for (int i = 0; i < 4; ++i) sel[i] = keep ? sel[i] : NEG;
        int my_e = 0; float my_s = 0.f; float ssum = 0.f;
        for (int k = 0; k < TOPK; ++k) {
            float bv = sel[0]; int bi = 0;
#pragma unroll
            for (int i = 1; i < 4; ++i) if (sel[i] > bv) { bv = sel[i]; bi = i; }
            int be = 4 * F.lane + bi; float v = bv; int e = be;
#pragma unroll
            for (int o = 1; o < 64; o <<= 1) { const float ov = __shfl_xor(v, o); const int oe = __shfl_xor(e, o); if (ov > v || (ov == v && oe < e)) { v = ov; e = oe; } }
            const int owner = e >> 2, oi = e & 3;
            float s_own = 0.f;
            if (F.lane == owner) {
#pragma unroll
                for (int i = 0; i < 4; ++i) if (i == oi) { s_own = sc[i]; sel[i] = NEG; }
            }
            const float s = __shfl(s_own, owner);
            ssum += s;
            if (F.lane == k) { my_e = e; my_s = s; }
        }
        if (F.lane < TOPK) {
            const unsigned pos = __hip_atomic_fetch_add(CNT + my_e, 1u, __ATOMIC_RELAXED, __HIP_MEMORY_SCOPE_AGENT);
            EIDX[m * 8 + F.lane] = my_e; GATE[m * 8 + F.lane] = my_s / ssum * 2.5f; DEST[m * 8 + F.lane] = (int)pos;
        }
    }
}

__device__ __forceinline__ void ph_scatter(Frame& F) {
    LAS int* tstart = (LAS int*)F.lds;
    LAS int* scan = (LAS int*)(F.lds + 2048);
    LAS int* cnts = (LAS int*)(F.lds + 4096);
    int* EIDX = (int*)(F.ws + WS_EIDX); int* DEST = (int*)(F.ws + WS_DEST); int* ROWTOK = (int*)(F.ws + WS_ROWTOK); int* TILE_E = (int*)(F.ws + WS_TILE_E);
    unsigned* CNT = F.ctl + CW_CNT;
    int tiles = 0, cnt = 0;
    if (F.tid < NE) { cnt = (int)__hip_atomic_load(CNT + F.tid, __ATOMIC_RELAXED, __HIP_MEMORY_SCOPE_AGENT); tiles = (cnt + 255) >> 8; scan[F.tid] = tiles; cnts[F.tid] = cnt; }
    __syncthreads();
    for (int o = 1; o < NE; o <<= 1) { int v = 0; if (F.tid < NE && F.tid >= o) v = scan[F.tid - o]; __syncthreads(); if (F.tid < NE) scan[F.tid] += v; __syncthreads(); }
    if (F.tid < NE) { tstart[F.tid + 1] = scan[F.tid]; if (F.tid == 0) tstart[0] = 0; }
    __syncthreads();
    const int NT = tstart[NE];
    if (blockIdx.x == 0) {
        if (F.tid == 0) F.ctl[CW_NT] = (unsigned)NT;
        if (F.tid < NE) for (int t = tstart[F.tid]; t < tstart[F.tid + 1]; ++t) TILE_E[t] = F.tid;
    }
    for (int e = blockIdx.x; e < NE; e += F.G) { const int c0 = cnts[e], c1 = (tstart[e + 1] - tstart[e]) * 256, base = tstart[e] * 256;
        for (int p = c0 + F.tid; p < c1; p += NTHR) ROWTOK[base + p] = 0; }
    for (int i = blockIdx.x * NTHR + F.tid; i < NLAT; i += F.G * NTHR) ROWTOK[SH_ROW0 + i] = i;
    for (int i = blockIdx.x * NTHR + F.tid; i < NLAT * TOPK; i += F.G * NTHR) {
        const int e = EIDX[i], pos = DEST[i]; const int dr = tstart[e] * 256 + pos;
        DEST[i] = dr; ROWTOK[dr] = i >> 3;
    }
}

__device__ __forceinline__ void ph_exp1(Frame& F) {
    const int NT = (int)__hip_atomic_load(F.ctl + CW_NT, __ATOMIC_RELAXED, __HIP_MEMORY_SCOPE_AGENT);
    pg8::Gemm g{(const bf16*)(F.ws + WS_A3F), (const bf16*)(F.ws + WS_WGU), 0, 0, D / 2, (const int*)(F.ws + WS_ROWTOK)};
    pg8::MoeOrder S{2, F.G, (int)blockIdx.x, NT, (const int*)(F.ws + WS_TILE_E)};
    EpiSwiglu E{F.ws + WS_ACT};
    pg8::gemm_phase<EpiSwiglu, pg8::MoeOrder, true, true, true, true>(F.lds, g, S, E);
}
__device__ __forceinline__ void ph_exp2(Frame& F) {
    const int NT = (int)__hip_atomic_load(F.ctl + CW_NT, __ATOMIC_RELAXED, __HIP_MEMORY_SCOPE_AGENT);
    pg8::Gemm g{(const bf16*)(F.ws + WS_ACT), (const bf16*)(F.ws + WS_WD), 0, 0, FF / 2, nullptr};
    pg8::MoeOrder S{4, F.G, (int)blockIdx.x, NT, (const int*)(F.ws + WS_TILE_E)};
    EpiRowsFp8 E{F.ws + WS_Y};
    pg8::gemm_phase<EpiRowsFp8, pg8::MoeOrder, true, true, false, true>(F.lds, g, S, E);
}
#endif

#if MS >= 3
__device__ __forceinline__ void unp8(const v4u w, float (&f)[8]) { f[0] = bflo(w.x); f[1] = bfhi(w.x); f[2] = bflo(w.y); f[3] = bfhi(w.y); f[4] = bflo(w.z); f[5] = bfhi(w.z); f[6] = bflo(w.w); f[7] = bfhi(w.w); }
__device__ __forceinline__ void unp8f8(const v2u w, float (&f)[8]) { const f32x2 a = __builtin_amdgcn_cvt_pk_f32_fp8((int)w.x, false), b = __builtin_amdgcn_cvt_pk_f32_fp8((int)w.x, true), c = __builtin_amdgcn_cvt_pk_f32_fp8((int)w.y, false), d = __builtin_amdgcn_cvt_pk_f32_fp8((int)w.y, true);
    f[0] = a.x; f[1] = a.y; f[2] = b.x; f[3] = b.y; f[4] = c.x; f[5] = c.y; f[6] = d.x; f[7] = d.y; }
__device__ __forceinline__ v4u pk8(const float (&f)[8]) { v4u o; o.x = pk2(f[0], f[1]); o.y = pk2(f[2], f[3]); o.z = pk2(f[4], f[5]); o.w = pk2(f[6], f[7]); return o; }
__device__ __forceinline__ void st8(float* p, const float (&f)[8]) { *(f32x4*)p = (f32x4){f[0], f[1], f[2], f[3]}; *(f32x4*)(p + 4) = (f32x4){f[4], f[5], f[6], f[7]}; }
__device__ __forceinline__ void ld8(const float* p, float (&f)[8]) { const f32x4 a = *(const f32x4*)p, b = *(const f32x4*)(p + 4); f[0] = a.x; f[1] = a.y; f[2] = a.z; f[3] = a.w; f[4] = b.x; f[5] = b.y; f[6] = b.z; f[7] = b.w; }

__device__ __forceinline__ void ph_a1(Frame& F) {
    const float* mod = (const float*)(F.ws + WS_MOD); unsigned char* A1 = F.ws + WS_A1;
    constexpr int NR = 4;
    for (int m0 = F.gw; m0 < MR; m0 += NR * F.NGW) {
        f32x4 xv[NR][4];
#pragma unroll
        for (int r = 0; r < NR; ++r) { const int mm = m0 + r * F.NGW; const int m = mm < MR ? mm : m0;
            const float* src = (m < NLAT) ? F.in[0] + (size_t)m * D : F.in[2] + (size_t)(m - NLAT) * D;
            const f32x4* xr = (const f32x4*)src + F.lane;
#pragma unroll
            for (int j = 0; j < 4; ++j) xv[r][j] = __builtin_nontemporal_load(xr + 64 * j); }
        __builtin_amdgcn_sched_barrier(0);
#pragma unroll
        for (int r = 0; r < NR; ++r) { const int mm = m0 + r * F.NGW; const int m = mm < MR ? mm : m0; const int mr = (m < NLAT) ? (m / SEQ) : 4;
            unsigned* ao = (unsigned*)(A1 + (size_t)m * D) + F.lane;
#pragma unroll
            for (int j = 0; j < 4; ++j) { const int c = 4 * F.lane + 256 * j;
                const f32x4 sh = *(const f32x4*)(mod + mr * 6144 + c), sc = *(const f32x4*)(mod + mr * 6144 + 1024 + c);
                const f32x4 h = xv[r][j] * (sc + 1.0f) + sh; ao[64 * j] = pack_fp8x4(h); } }
    }
}

__device__ __forceinline__ void ph_inproj(Frame& F) {
    pg8::Gemm g{(const bf16*)(F.ws + WS_A1), (const bf16*)(F.ws + WS_WIN), MR, NP, D / 2, nullptr};
    pg8::StaticOrder S; S.init(MR, NP, F.G, (int)blockIdx.x);
    EpiRowsBf16 E{(bf16*)(F.ws + WS_P), NP, W8I};
    pg8::gemm_phase<EpiRowsBf16, pg8::StaticOrder, true, true, false, true>(F.lds, g, S, E);
}

__device__ __forceinline__ void ph_feat(Frame& F) {
    const bf16* P = (const bf16*)(F.ws + WS_P);
    const float* mu = F.in[7]; const float* kkw = F.in[13]; const float* cw = F.in[18];
    bf16* R = (bf16*)(F.ws + WS_RB); bf16* V = (bf16*)(F.ws + WS_VB); bf16* KK = (bf16*)(F.ws + WS_KKB); bf16* KP = (bf16*)(F.ws + WS_KMF);
    bf16* QG = (bf16*)(F.ws + WS_QGB); bf16* KGB = (bf16*)(F.ws + WS_KGB); bf16* VGB = (bf16*)(F.ws + WS_VGB);
    bf16* A2 = (bf16*)(F.ws + WS_A2);
    const int lane = F.lane;
    for (int m0 = F.gw; m0 < MR; m0 += 2 * F.NGW) {
        int mm[2]; mm[0] = m0; mm[1] = (m0 + F.NGW < MR) ? m0 + F.NGW : m0;
        int nb[2][4], gr[2], gc[2], tc[2]; bool lat[2];
#pragma unroll
        for (int r = 0; r < 2; ++r) { const int m = mm[r]; lat[r] = m < NLAT; gr[r] = 0; gc[r] = 0; tc[r] = 0;
            if (lat[r]) { const int t = m & (SEQ - 1); gr[r] = t >> 6; gc[r] = t & 63;
                nb[r][0] = gc[r] > 0 ? m - 1 : -1; nb[r][1] = gc[r] < 63 ? m + 1 : -1; nb[r][2] = gr[r] > 0 ? m - 64 : -1; nb[r][3] = gr[r] < 127 ? m + 64 : -1;
            } else { const int t = (m - NLAT) & (CTXL - 1); tc[r] = t; nb[r][0] = t > 0 ? m - 1 : -1; nb[r][1] = t < CTXL - 1 ? m + 1 : -1; nb[r][2] = nb[r][0]; nb[r][3] = nb[r][1]; } }
#pragma unroll
        for (int p = 0; p < 4; ++p) {
            const int cb = p * 512 + 8 * lane;
            const bool act = (p < 3) || lane < 20;
            v4u wo[2], wn[2][4];
#pragma unroll
            for (int r = 0; r < 2; ++r) { wo[r] = (v4u){0u, 0u, 0u, 0u};
#pragma unroll
                for (int q = 0; q < 4; ++q) wn[r][q] = (v4u){0u, 0u, 0u, 0u};
                if (act) { wo[r] = *(const v4u*)(P + (size_t)mm[r] * NP + cb);
#pragma unroll
                    for (int q = 0; q < 4; ++q) if (nb[r][q] >= 0) wn[r][q] = *(const v4u*)(P + (size_t)nb[r][q] * NP + cb); }
                else if (p == 3 && lane >= 20 && lane < 22) wo[r] = *(const v4u*)(P + (size_t)mm[r] * NP + C_PGL + 8 * (lane - 20)); }
            float muv[8] = {0.f, 0.f, 0.f, 0.f, 0.f, 0.f, 0.f, 0.f}; if (act) ld8(mu + cb, muv);
            __builtin_amdgcn_sched_barrier(0);
#pragma unroll
            for (int r = 0; r < 2; ++r) { const size_t m = (size_t)mm[r];
                if (act) {
                    float own[8], sh[4][8], val[8];
                    unp8(wo[r], own);
#pragma unroll
                    for (int q = 0; q < 4; ++q) unp8(wn[r][q], sh[q]);
#pragma unroll
                    for (int e = 0; e < 8; ++e) val[e] = own[e] + muv[e] * (sh[e & 3][e] - own[e]);
                    if (p == 0) *(v4u*)(R + m * RWW + 8 * lane) = pk8(val);
                    else if (p == 2) *(v4u*)(V + m * RWW + 8 * lane) = pk8(val);
                    else if (p == 1) {
                        *(v4u*)(KP + m * RWW + 8 * lane) = pk8(val);
                        float kw[8]; ld8(kkw + 8 * lane, kw); float kkv[8]; float ss = 0.f;
#pragma unroll
                        for (int e = 0; e < 8; ++e) { kkv[e] = val[e] * kw[e]; ss += kkv[e] * kkv[e]; }
                        ss += __shfl_xor(ss, 1); ss += __shfl_xor(ss, 2); ss += __shfl_xor(ss, 4);
                        const float inv = 1.0f / fmaxf(sqrtf(ss), 1e-12f);
#pragma unroll
                        for (int e = 0; e < 8; ++e) kkv[e] *= inv;
                        *(v4u*)(KK + m * RWW + 8 * lane) = pk8(kkv);
                    } else {
                        float o[8];
#pragma unroll
                        for (int e = 0; e < 8; ++e) o[e] = (lane < 4) ? tanhf(val[e]) : ((lane < 8) ? val[e] : sigmoidf_(val[e]));
                        *(v4u*)(A2 + m * KLORA + 8 * lane) = pk8(o);
                    }
                } else if (p == 3 && lane < 32) *(v4u*)(A2 + m * KLORA + 8 * lane) = wo[r];
            }
        }
#pragma unroll
        for (int p = 0; p < 2; ++p) {
            const int cq = p * 512 + 8 * lane; const int cb = C_Q + cq;
            v4u wp[2][9];
#pragma unroll
            for (int r = 0; r < 2; ++r)
#pragma unroll
                for (int dy = -1; dy <= 1; ++dy)
#pragma unroll
                    for (int dx = -1; dx <= 1; ++dx) { const int tp = (dy + 1) * 3 + dx + 1; bool ok; int nr;
                        if (lat[r]) { ok = (gr[r] + dy >= 0) && (gr[r] + dy < GRIDH) && (gc[r] + dx >= 0) && (gc[r] + dx < GRIDW); nr = mm[r] + dy * 64 + dx; }
                        else { ok = (dy == 0) && (tc[r] + dx >= 0) && (tc[r] + dx < CTXL); nr = mm[r] + dx; }
                        wp[r][tp] = (v4u){0u, 0u, 0u, 0u}; if (ok) wp[r][tp] = *(const v4u*)(P + (size_t)nr * NP + cb); }
            __builtin_amdgcn_sched_barrier(0);
            float acc[2][8];
#pragma unroll
            for (int r = 0; r < 2; ++r)
#pragma unroll
                for (int e = 0; e < 8; ++e) acc[r][e] = 0.f;
#pragma unroll
            for (int tp = 0; tp < 9; ++tp) { float wv[8]; ld8(cw + tp * 1024 + cq, wv);
#pragma unroll
                for (int r = 0; r < 2; ++r) { float pv[8]; unp8(wp[r][tp], pv);
#pragma unroll
                    for (int e = 0; e < 8; ++e) acc[r][e] += pv[e] * wv[e]; } }
#pragma unroll
            for (int r = 0; r < 2; ++r) { const size_t m = (size_t)mm[r]; float o[8];
#pragma unroll
                for (int e = 0; e < 8; ++e) o[e] = siluf_(acc[r][e]);
                if (p == 0) {
                    if (lane < 32) {
#pragma unroll
                        for (int e = 0; e < 8; ++e) o[e] *= 0.125f;
                        *(v4u*)(QG + m * 256 + cq) = pk8(o);
                    } else *(v4u*)(KGB + m * 256 + (cq - 256)) = pk8(o);
                } else *(v4u*)(VGB + m * RWW + (cq - 512)) = pk8(o); }
        }
    }
}

struct EpiLora {
    static constexpr bool PERM = true;
    unsigned char* ws; const float* const* in;
    __device__ __forceinline__ void grp_w(const f32x4 (&acc)[2][2][4][2], int row0, int c0) const {
        bf16* Wf = (bf16*)(ws + WS_LWF); bf16* Wb = (bf16*)(ws + WS_LWB);
#pragma unroll
        for (int bj = 0; bj < 2; ++bj) { const int ch = (c0 + bj * 128) >> 1; const f32x4 w0f = *(const f32x4*)(in[8] + ch), w0b = *(const f32x4*)(in[8] + 512 + ch);
#pragma unroll
            for (int ai = 0; ai < 2; ++ai)
#pragma unroll
                for (int m = 0; m < 4; ++m) { const size_t row = (size_t)(row0 + ai * 128 + m * 16);
                    const f32x4 xf = acc[ai][bj][m][0] + w0f, xb = acc[ai][bj][m][1] + w0b; f32x4 df, db;
#pragma unroll
                    for (int e = 0; e < 4; ++e) { df[e] = -0.60653066f * sigmoidf_(xf[e]); db[e] = -0.60653066f * sigmoidf_(xb[e]); }
                    { v2u o; o.x = pk2(df[0], df[1]); o.y = pk2(df[2], df[3]); *(v2u*)(Wf + row * RWW + ch) = o; o.x = pk2(db[0], db[1]); o.y = pk2(db[2], db[3]); *(v2u*)(Wb + row * RWW + ch) = o; } } }
    }
    __device__ __forceinline__ void grp_a(const f32x4 (&acc)[2][2][4][2], int row0, int c0) const {
        bf16* KMf = (bf16*)(ws + WS_KMF); bf16* KMb = (bf16*)(ws + WS_KMB); bf16* BVf = (bf16*)(ws + WS_BVF); bf16* BVb = (bf16*)(ws + WS_BVB);
        const bf16* KK = (const bf16*)(ws + WS_KKB); bf16* KSUM = (bf16*)(ws + WS_KSUM);
#pragma unroll
        for (int bj = 0; bj < 2; ++bj) { const int ch = (c0 + bj * 128 - 1024) >> 1; const f32x4 a0f = *(const f32x4*)(in[10] + ch), a0b = *(const f32x4*)(in[10] + 512 + ch), ka = *(const f32x4*)(in[14] + ch);
#pragma unroll
            for (int ai = 0; ai < 2; ++ai) {
            v2u kpw[2][4], kkw[2][4];
#pragma unroll
                for (int m = 0; m < 4; ++m) { const size_t row = (size_t)(row0 + ai * 128 + m * 16); kpw[ai][m] = *(const v2u*)(KMf + row * RWW + ch); kkw[ai][m] = *(const v2u*)(KK + row * RWW + ch); }
            __builtin_amdgcn_sched_barrier(0);
#pragma unroll
                for (int m = 0; m < 4; ++m) { const size_t row = (size_t)(row0 + ai * 128 + m * 16);
                    const f32x4 xf = acc[ai][bj][m][0] + a0f, xb = acc[ai][bj][m][1] + a0b;
                    const f32x4 kp = (f32x4){bflo(kpw[ai][m].x), bfhi(kpw[ai][m].x), bflo(kpw[ai][m].y), bfhi(kpw[ai][m].y)}, kk = (f32x4){bflo(kkw[ai][m].x), bfhi(kkw[ai][m].x), bflo(kkw[ai][m].y), bfhi(kkw[ai][m].y)};
                    f32x4 kmf, kmb, bvf, bvb;
#pragma unroll
                    for (int e = 0; e < 4; ++e) { const float af = sigmoidf_(xf[e]), ab = sigmoidf_(xb[e]);
                        kmf[e] = kp[e] * (1.0f + (af - 1.0f) * ka[e]); kmb[e] = kp[e] * (1.0f + (ab - 1.0f) * ka[e]); bvf[e] = kk[e] * af; bvb[e] = kk[e] * ab; }
                    { v2u o; o.x = pk2(kmf[0], kmf[1]); o.y = pk2(kmf[2], kmf[3]); *(v2u*)(KMf + row * RWW + ch) = o; o.x = pk2(kmb[0], kmb[1]); o.y = pk2(kmb[2], kmb[3]); *(v2u*)(KMb + row * RWW + ch) = o;
                      o.x = pk2(bvf[0], bvf[1]); o.y = pk2(bvf[2], bvf[3]); *(v2u*)(BVf + row * RWW + ch) = o; o.x = pk2(bvb[0], bvb[1]); o.y = pk2(bvb[2], bvb[3]); *(v2u*)(BVb + row * RWW + ch) = o; }
                    v2u ks; ks.x = pk2(kmf[0] + kmb[0], kmf[1] + kmb[1]); ks.y = pk2(kmf[2] + kmb[2], kmf[3] + kmb[3]); *(v2u*)(KSUM + row * RWW + ch) = ks; } } }
    }
    __device__ __forceinline__ void grp_g(const f32x4 (&acc)[2][2][4][2], int row0, int c0) const {
        bf16* RWG = (bf16*)(ws + WS_RWG);
#pragma unroll
        for (int bj = 0; bj < 2; ++bj) { const int ch = c0 + bj * 128 - 2048;
#pragma unroll
            for (int ai = 0; ai < 2; ++ai)
#pragma unroll
                for (int m = 0; m < 4; ++m) { const size_t row = (size_t)(row0 + ai * 128 + m * 16); const f32x4 v0 = acc[ai][bj][m][0], v1 = acc[ai][bj][m][1];
                    v4u w; w.x = pk2(v0[0], v0[1]); w.y = pk2(v0[2], v0[3]); w.z = pk2(v1[0], v1[1]); w.w = pk2(v1[2], v1[3]); *(v4u*)(RWG + row * RWW + ch) = w; } }
    }
    __device__ __forceinline__ void grp_l(const f32x4 (&acc)[2][2][4][2], int row0, int c0) const {
        bf16* GAf = (bf16*)(ws + WS_LAF); bf16* GAb = (bf16*)(ws + WS_LAB);
#pragma unroll
        for (int bj = 0; bj < 2; ++bj) { const int ch = (c0 + bj * 128 - 2560) >> 1; const f32x4 gbf = *(const f32x4*)(in[20] + ch), gbb = *(const f32x4*)(in[20] + 256 + ch);
#pragma unroll
            for (int ai = 0; ai < 2; ++ai)
#pragma unroll
                for (int m = 0; m < 4; ++m) { const size_t row = (size_t)(row0 + ai * 128 + m * 16);
                    const f32x4 xf = acc[ai][bj][m][0] + gbf, xb = acc[ai][bj][m][1] + gbb; f32x4 af, ab;
#pragma unroll
                    for (int e = 0; e < 4; ++e) { const float lf = fminf(xf[e], 0.f) - log1pf(__expf(-fabsf(xf[e]))), lb = fminf(xb[e], 0.f) - log1pf(__expf(-fabsf(xb[e])));
                        af[e] = lf * 0.0625f; ab[e] = lb * 0.0625f; }
                    { v2u o; o.x = pk2(af[0], af[1]); o.y = pk2(af[2], af[3]); *(v2u*)(GAf + row * 256 + ch) = o; o.x = pk2(ab[0], ab[1]); o.y = pk2(ab[2], ab[3]); *(v2u*)(GAb + row * 256 + ch) = o; } } }
    }
    __device__ __forceinline__ void operator()(const f32x4 (&acc)[2][2][4][2], const pg8::Unit& u, int wr, int wc, int fr, int fq) const {
        const int row0 = u.pm * 256 + wr * 64 + fr, c0 = u.pn * 256 + wc * 32 + 8 * fq;
        if (u.pn < 4) grp_w(acc, row0, c0); else if (u.pn < 8) grp_a(acc, row0, c0); else if (u.pn < 10) grp_g(acc, row0, c0); else grp_l(acc, row0, c0);
    }
};
__device__ __forceinline__ void ph_lora(Frame& F) {
    pg8::Gemm g{(const bf16*)(F.ws + WS_A2), (const bf16*)(F.ws + WS_WLORA), MR, NLORA, KLORA, nullptr};
    pg8::StaticOrder S; S.init(MR, NLORA, F.G, (int)blockIdx.x);
    EpiLora E{F.ws, F.in};
    pg8::gemm_phase<EpiLora, pg8::StaticOrder, true, true, false>(F.lds, g, S, E);
}

__device__ __forceinline__ void ph_merge(Frame& F) {
    unsigned char* ws = F.ws; const int lane = F.lane;
    const bf16* ORf = (const bf16*)(ws + WS_ORWF); const bf16* ORb = (const bf16*)(ws + WS_ORWB); const bf16* OGf = (const bf16*)(ws + WS_OGLF); const bf16* OGb = (const bf16*)(ws + WS_OGLB);
    const bf16* R = (const bf16*)(ws + WS_RB); const bf16* V = (const bf16*)(ws + WS_VB); const bf16* KSUM = (const bf16*)(ws + WS_KSUM); const bf16* RWG = (const bf16*)(ws + WS_RWG);
    const bf16* P = (const bf16*)(ws + WS_P);
    bf16* YRW = (bf16*)(ws + WS_YRW); bf16* YGLA = (bf16*)(ws + WS_YGLA);
    float rk[8], gw[8], gbv[8], ggw[8], ggb[8];
    ld8(F.in[15] + 8 * lane, rk); ld8(F.in[16] + 8 * lane, gw); ld8(F.in[17] + 8 * lane, gbv); ld8(F.in[21] + 8 * lane, ggw); ld8(F.in[22] + 8 * lane, ggb);
    for (int m0 = F.gw; m0 < NLAT; m0 += 2 * F.NGW) {
        const int m1 = (m0 + F.NGW < NLAT) ? m0 + F.NGW : m0;
        v4u wa[2], wb[2], wc[2], wd[2], wr[2], wv[2], wk[2], wg[2], wo[2];
#pragma unroll
        for (int r2 = 0; r2 < 2; ++r2) { const int m = r2 ? m1 : m0; const size_t ro = (size_t)m * RWW + 8 * lane;
            wa[r2] = *(const v4u*)(ORf + ro); wb[r2] = *(const v4u*)(ORb + ro); wc[r2] = *(const v4u*)(OGf + ro); wd[r2] = *(const v4u*)(OGb + ro);
            wr[r2] = *(const v4u*)(R + ro); wv[r2] = *(const v4u*)(V + ro); wk[r2] = *(const v4u*)(KSUM + ro); wg[r2] = *(const v4u*)(RWG + ro);
            wo[r2] = *(const v4u*)(P + (size_t)m * NP + C_OG + 8 * lane); }
#pragma unroll
        for (int r2 = 0; r2 < 2; ++r2) { const int m = r2 ? m1 : m0; const size_t ro = (size_t)m * RWW + 8 * lane;
        {
            float a[8], b[8], o[8]; unp8(wa[r2], a); unp8(wb[r2], b);
            float s = 0.f;
#pragma unroll
            for (int e = 0; e < 8; ++e) { o[e] = a[e] + b[e]; s += o[e]; }
            s += __shfl_xor(s, 1); s += __shfl_xor(s, 2); s += __shfl_xor(s, 4);
            const float mean = s * (1.f / 64.f); float q = 0.f;
#pragma unroll
            for (int e = 0; e < 8; ++e) { o[e] -= mean; q += o[e] * o[e]; }
            q += __shfl_xor(q, 1); q += __shfl_xor(q, 2); q += __shfl_xor(q, 4);
            const float rstd = 1.f / sqrtf(q * (1.f / 64.f) + RW_GN_EPS);
            float r[8], v[8], ksm[8], g[8]; unp8(wr[r2], r); unp8(wv[r2], v); unp8(wk[r2], ksm); unp8(wg[r2], g);
            float bs = 0.f;
#pragma unroll
            for (int e = 0; e < 8; ++e) bs += r[e] * ksm[e] * rk[e];
            bs += __shfl_xor(bs, 1); bs += __shfl_xor(bs, 2); bs += __shfl_xor(bs, 4);
            float y[8];
#pragma unroll
            for (int e = 0; e < 8; ++e) y[e] = (o[e] * rstd * gw[e] + gbv[e] + bs * v[e]) * g[e];
            *(v4u*)(YRW + ro) = pk8(y);
        }
        {
            float a[8], b[8], o[8]; unp8(wc[r2], a); unp8(wd[r2], b);
            float s = 0.f;
#pragma unroll
            for (int e = 0; e < 8; ++e) { o[e] = a[e] + b[e]; s += o[e]; }
            s += __shfl_xor(s, 1); s += __shfl_xor(s, 2); s += __shfl_xor(s, 4); s += __shfl_xor(s, 8);
            const float mean = s * (1.f / 128.f); float q = 0.f;
#pragma unroll
            for (int e = 0; e < 8; ++e) { o[e] -= mean; q += o[e] * o[e]; }
            q += __shfl_xor(q, 1); q += __shfl_xor(q, 2); q += __shfl_xor(q, 4); q += __shfl_xor(q, 8);
            const float rstd = 1.f / sqrtf(q * (1.f / 128.f) + LN_EPS);
            float og[8]; unp8(wo[r2], og);
            float y[8];
#pragma unroll
            for (int e = 0; e < 8; ++e) y[e] = (o[e] * rstd * ggw[e] + ggb[e]) * siluf_(og[e]);
            *(v4u*)(YGLA + ro) = pk8(y);
        }
        }
    }
}

template <int WHICH> struct EpiBranch {
    static constexpr bool PERM = true;
    bf16* Z; const bf16* P;
    __device__ __forceinline__ void operator()(const f32x4 (&acc)[2][2][4][2], const pg8::Unit& u, int wr, int wc, int fr, int fq) const {
        const int row0 = u.pm * 256 + wr * 64 + fr, col0 = u.pn * 256 + wc * 32 + 8 * fq;
#pragma unroll
        for (int ah = 0; ah < 4; ++ah) { const int ai = ah >> 1, mb = 2 * (ah & 1);
            v4u gw[2][2], zw[2][2];
#pragma unroll
            for (int m = 0; m < 2; ++m) { const size_t row = (size_t)(row0 + ai * 128 + (mb + m) * 16);
#pragma unroll
                for (int bj = 0; bj < 2; ++bj) { const int c = col0 + bj * 128;
                    gw[m][bj] = *(const v4u*)(P + row * NP + (WHICH ? C_GGLA : C_GRW) + c);
                    if (WHICH) zw[m][bj] = *(const v4u*)(Z + row * D + c); } }
            __builtin_amdgcn_sched_barrier(0);
#pragma unroll
            for (int m = 0; m < 2; ++m) { const size_t row = (size_t)(row0 + ai * 128 + (mb + m) * 16);
#pragma unroll
                for (int bj = 0; bj < 2; ++bj) { const int c = col0 + bj * 128;
                    float g[8]; unp8(gw[m][bj], g);
                    const f32x4 v0 = acc[ai][bj][mb + m][0], v1 = acc[ai][bj][mb + m][1];
                    float z[8];
#pragma unroll
                    for (int e = 0; e < 4; ++e) { z[e] = sigmoidf_(g[e]) * v0[e]; z[4 + e] = sigmoidf_(g[4 + e]) * v1[e]; }
                    if (WHICH) { float zo[8]; unp8(zw[m][bj], zo);
#pragma unroll
                        for (int e = 0; e < 8; ++e) z[e] += zo[e]; }
                    *(v4u*)(Z + row * D + c) = pk8(z); } }
        }
    }
};
__device__ __forceinline__ void ph_branch(Frame& F) {
    pg8::StaticOrder S; S.init(NLAT, D, F.G, (int)blockIdx.x);
    { pg8::Gemm g{(const bf16*)(F.ws + WS_YRW), (const bf16*)(F.ws + WS_WBRRW), NLAT, D, RWW, nullptr};
      EpiBranch<0> E{(bf16*)(F.ws + WS_Z), (const bf16*)(F.ws + WS_P)};
      pg8::gemm_phase<EpiBranch<0>, pg8::StaticOrder, true, true, false>(F.lds, g, S, E); }
    { pg8::Gemm g{(const bf16*)(F.ws + WS_YGLA), (const bf16*)(F.ws + WS_WBRGLA), NLAT, D, RWW, nullptr};
      EpiBranch<1> E{(bf16*)(F.ws + WS_Z), (const bf16*)(F.ws + WS_P)};
      pg8::gemm_phase<EpiBranch<1>, pg8::StaticOrder, true, true, false>(F.lds, g, S, E); }
}
struct EpiOut {
    static constexpr bool PERM = true;
    bf16* X1P; const float* x; const float* mod;
    __device__ __forceinline__ void operator()(const f32x4 (&acc)[2][2][4][2], const pg8::Unit& u, int wr, int wc, int fr, int fq) const {
        const int row0 = u.pm * 256 + wr * 64 + fr, col0 = u.pn * 256 + wc * 32 + 8 * fq; const float* g1 = mod + (u.pm / (SEQ / 256)) * 6144 + 2048;
        f32x4 gv[2][2];
#pragma unroll
        for (int bj = 0; bj < 2; ++bj)
#pragma unroll
            for (int n = 0; n < 2; ++n) gv[bj][n] = *(const f32x4*)(g1 + col0 + bj * 128 + 4 * n);
#pragma unroll
        for (int ah = 0; ah < 4; ++ah) { const int ai = ah >> 1, mb = 2 * (ah & 1);
            f32x4 xv[2][2][2];
#pragma unroll
            for (int m = 0; m < 2; ++m) { const size_t ro = (size_t)(row0 + ai * 128 + (mb + m) * 16) * D;
#pragma unroll
                for (int bj = 0; bj < 2; ++bj)
#pragma unroll
                    for (int n = 0; n < 2; ++n) xv[m][bj][n] = *(const f32x4*)(x + ro + col0 + bj * 128 + 4 * n); }
            __builtin_amdgcn_sched_barrier(0);
#pragma unroll
            for (int m = 0; m < 2; ++m) { const size_t ro = (size_t)(row0 + ai * 128 + (mb + m) * 16) * D;
#pragma unroll
                for (int bj = 0; bj < 2; ++bj) { const f32x4 a = xv[m][bj][0] * ALPHA + gv[bj][0] * acc[ai][bj][mb + m][0], b = xv[m][bj][1] * ALPHA + gv[bj][1] * acc[ai][bj][mb + m][1];
                    v4u w; w.x = pk2(a.x, a.y); w.y = pk2(a.z, a.w); w.z = pk2(b.x, b.y); w.w = pk2(b.z, b.w); *(v4u*)(X1P + ro + col0 + bj * 128) = w; } }
        }
    }
};
__device__ __forceinline__ void ph_outproj(Frame& F) {
    pg8::Gemm g{(const bf16*)(F.ws + WS_Z), (const bf16*)(F.ws + WS_WOUT), NLAT, D, D, nullptr};
    pg8::StaticOrder S; S.init(NLAT, D, F.G, (int)blockIdx.x);
    EpiOut E{(bf16*)(F.ws + WS_X1), F.in[0], (const float*)(F.ws + WS_MOD)};
    pg8::gemm_phase<EpiOut, pg8::StaticOrder, true, true, false>(F.lds, g, S, E);
}
#endif

#if MS >= 3
constexpr int LP = 72, SLOTB = 64 * LP * 2, LPF = 68, AUX_OFF = 13 * SLOTB;
static_assert(AUX_OFF + 4096 <= MISC_OFF, "scan LDS map");
#define SLOT(n) ((LAS bf16*)(lds + (n) * SLOTB))
__device__ __forceinline__ int scan_row(int s, int b, int dir) {
    if (s < CTXL) return NLAT + b * CTXL + (dir ? (CTXL - 1 - s) : s);
    const int lt = s - CTXL; return b * SEQ + (dir ? (SEQ - 1 - lt) : lt);
}
__device__ __forceinline__ unsigned pk2z(float x) { return pk2(x, 0.f); }
__device__ __forceinline__ float bf2f(bf16 h) { return __builtin_bit_cast(float, (unsigned)h << 16); }
__device__ __forceinline__ v2u pack4(const f32x4 v) { v2u o; o.x = pk2(v[0], v[1]); o.y = pk2(v[2], v[3]); return o; }
__device__ __forceinline__ float clamp8(float x) { return __builtin_amdgcn_fmed3f(x, -448.0f, 448.0f); }
__device__ __forceinline__ unsigned pack4_fp8(const f32x4 v) { int w = __builtin_amdgcn_cvt_pk_fp8_f32(clamp8(v[0]), clamp8(v[1]), 0, false); return (unsigned)__builtin_amdgcn_cvt_pk_fp8_f32(clamp8(v[2]), clamp8(v[3]), w, true); }
__device__ __forceinline__ f32x4 unpack4_fp8(unsigned w) { const f32x2 lo = __builtin_amdgcn_cvt_pk_f32_fp8((int)w, false), hi = __builtin_amdgcn_cvt_pk_f32_fp8((int)w, true); return (f32x4){lo.x, lo.y, hi.x, hi.y}; }
__device__ __forceinline__ f32x4 unpack4(const v2u w) { return (f32x4){bflo(w.x), bfhi(w.x), bflo(w.y), bfhi(w.y)}; }
__device__ __forceinline__ f32x4 mm_tile(const LAS bf16* X, int r0, const LAS bf16* Y, int c0, int lane) {
    const int rr = lane & 15, q = lane >> 4;
    const LAS bf16* xp = X + (r0 + rr) * LP + 8 * q; const LAS bf16* yp = Y + (c0 + rr) * LP + 8 * q;
    const bf16x8 a0 = *(const LAS bf16x8*)xp, a1 = *(const LAS bf16x8*)(xp + 32), b0 = *(const LAS bf16x8*)yp, b1 = *(const LAS bf16x8*)(yp + 32);
    f32x4 acc = (f32x4){0.f, 0.f, 0.f, 0.f};
    acc = __builtin_amdgcn_mfma_f32_16x16x32_bf16(a0, b0, acc, 0, 0, 0);
    acc = __builtin_amdgcn_mfma_f32_16x16x32_bf16(a1, b1, acc, 0, 0, 0);
    return acc;
}
__device__ __forceinline__ float red8(float x) {
    x += __builtin_bit_cast(float, __builtin_amdgcn_update_dpp(0, __builtin_bit_cast(int, x), 0x141, 0xf, 0xf, false));
    x += __builtin_bit_cast(float, __builtin_amdgcn_update_dpp(0, __builtin_bit_cast(int, x), 0xB1, 0xf, 0xf, false));
    x += __builtin_bit_cast(float, __builtin_amdgcn_update_dpp(0, __builtin_bit_cast(int, x), 0x4E, 0xf, 0xf, false));
    return x;
}

#define S1_BAR() do { asm volatile("s_waitcnt lgkmcnt(0)" ::: "memory"); __builtin_amdgcn_s_barrier(); asm volatile("" ::: "memory"); } while (0)
struct RwIn { bf16 lw[8], r[8], k[8], a[8], b[8], v[8]; };
__device__ __forceinline__ void s1_rwkv_load(Frame& F, int u, RwIn& I) {
    const int sr = u / NCHUNK, c = u - sr * NCHUNK, rb = sr >> 4, rdir = (sr >> 3) & 1, rh = sr & 7; unsigned char* ws = F.ws;
    const bf16* RBp = (const bf16*)(ws + WS_RB); const bf16* VBp = (const bf16*)(ws + WS_VB); const bf16* KKp = (const bf16*)(ws + WS_KKB);
    const bf16* KMp = (const bf16*)(ws + (rdir ? WS_KMB : WS_KMF)); const bf16* BVp = (const bf16*)(ws + (rdir ? WS_BVB : WS_BVF)); const bf16* LWp = (const bf16*)(ws + (rdir ? WS_LWB : WS_LWF));
#pragma unroll
    for (int i = 0; i < 8; ++i) { const int row = scan_row(c * CH + 8 * F.wave + i, rb, rdir); const size_t base = (size_t)row * RWW + rh * 64 + F.lane;
        I.lw[i] = LWp[base]; I.r[i] = RBp[base]; I.k[i] = KMp[base]; I.a[i] = KKp[base]; I.b[i] = BVp[base]; I.v[i] = VBp[base]; }
}
__device__ __forceinline__ void s1_rwkv(Frame& F, int u, const RwIn& I, int un, RwIn& Inext, int cvi) {
    const int sr = u / NCHUNK, c = u - sr * NCHUNK;
    const bool emit = c >= CTXL / CH;
    LAS unsigned char* lds = F.lds; unsigned char* ws = F.ws;
    int lane_ = F.lane; asm volatile("" : "+v"(lane_));
    const int lane = lane_, wave = F.wave, rr = lane & 15, q = lane >> 4;
    LAS float* tot = (LAS float*)(lds + AUX_OFF); LAS float* gCs = tot + 512;
    {
        float lw[8], xr[8], xk[8], xa[8], xb[8], xv[8];
#pragma unroll
        for (int i = 0; i < 8; ++i) { lw[i] = bf2f(I.lw[i]); xr[i] = bf2f(I.r[i]); xk[i] = bf2f(I.k[i]); xa[i] = -bf2f(I.a[i]); xb[i] = bf2f(I.b[i]); xv[i] = bf2f(I.v[i]); }
        float p[8]; p[0] = lw[0];
#pragma unroll
        for (int i = 1; i < 8; ++i) p[i] = p[i - 1] + lw[i];
        tot[wave * 64 + lane] = p[7];
        S1_BAR();
        float off = 0.f, all = 0.f;
#pragma unroll
        for (int w = 0; w < 8; ++w) { const float t = tot[w * 64 + lane]; all += t; off += (w < wave) ? t : 0.f; }
        if (wave == 0) gCs[lane] = __expf(all);
        float at[8], bb[8], kb[8];
#pragma unroll
        for (int i = 0; i < 8; ++i) { const float cum = off + p[i]; const float g = __expf(cum), gi = __expf(-cum), gp = __expf(cum - lw[i]), gc = __expf(all - cum);
            const int t = 8 * wave + i;
            at[i] = xa[i] * gp; bb[i] = xb[i] * gc; kb[i] = xk[i] * gc;
            SLOT(0)[t * LP + lane] = (bf16)pk2z(at[i]);
            SLOT(1)[t * LP + lane] = (bf16)pk2z(xr[i] * g);
            SLOT(2)[t * LP + lane] = (bf16)pk2z(xb[i] * gi);
            SLOT(3)[t * LP + lane] = (bf16)pk2z(xk[i] * gi); }
        *(LAS v4u*)(SLOT(4) + lane * LP + 8 * wave) = pk8(at);
        *(LAS v4u*)(SLOT(5) + lane * LP + 8 * wave) = pk8(xv);
        *(LAS v4u*)(SLOT(6) + lane * LP + 8 * wave) = pk8(bb);
        *(LAS v4u*)(SLOT(7) + lane * LP + 8 * wave) = pk8(kb);
        S1_BAR();
    }
    s1_rwkv_load(F, un, Inext);
    LAS float* Lp = (LAS float*)(lds + 8 * SLOTB);
#pragma unroll
    for (int tix = 0; tix < 2; ++tix) { const int ti = 2 * wave + tix, r0 = 16 * (ti >> 2), c0 = 16 * (ti & 3), ci = c0 + rr;
        { const f32x4 acc = mm_tile(SLOT(2), r0, SLOT(0), c0, lane);
#pragma unroll
            for (int e = 0; e < 4; ++e) { const int i = r0 + 4 * q + e; Lp[ci * LPF + (i & 3) * 16 + (i >> 2)] = (i < ci) ? acc[e] : 0.f; } }
        { f32x4 acc = mm_tile(SLOT(0), r0, SLOT(3), c0, lane);
#pragma unroll
            for (int e = 0; e < 4; ++e) acc[e] = (ci < r0 + 4 * q + e) ? acc[e] : 0.f;
            *(LAS v2u*)(SLOT(10) + ci * LP + r0 + 4 * q) = pack4(acc); }
        if (emit) {
            { f32x4 acc = mm_tile(SLOT(2), r0, SLOT(1), c0, lane);
#pragma unroll
                for (int e = 0; e < 4; ++e) acc[e] = (r0 + 4 * q + e <= ci) ? acc[e] : 0.f;
                *(LAS v2u*)(SLOT(11) + ci * LP + r0 + 4 * q) = pack4(acc); }
            { f32x4 acc = mm_tile(SLOT(3), r0, SLOT(1), c0, lane);
#pragma unroll
                for (int e = 0; e < 4; ++e) acc[e] = (r0 + 4 * q + e <= ci) ? acc[e] : 0.f;
                *(LAS v2u*)(SLOT(12) + ci * LP + r0 + 4 * q) = pack4(acc); }
        }
    }
    S1_BAR();
    if (wave < 4) {
        const int j = 16 * wave + (lane >> 2), s = lane & 3;
        float Tr[16];
#pragma unroll
        for (int m = 0; m < 16; ++m) Tr[m] = 0.f;
        const LAS float* lrow = Lp + s * 16;
        f32x4 lb[3][4];
#pragma unroll
        for (int t = 0; t < 2; ++t) lb[t][0] = *(const LAS f32x4*)(lrow + t * LPF);
#pragma unroll
        for (int t = 0; t < 64; ++t) {
            if (t + 2 < 64) {
#pragma unroll
                for (int k = 0; k < 4; ++k) if (4 * k <= (t + 2) / 4) lb[(t + 2) % 3][k] = *(const LAS f32x4*)(lrow + (t + 2) * LPF + 4 * k);
            }
            __builtin_amdgcn_sched_barrier(0);
            float acc0 = 0.f, acc1 = 0.f;
#pragma unroll
            for (int m = 0; m < 16; ++m) if (m <= t / 4) { const float lv = lb[t % 3][m >> 2][m & 3]; if (m & 1) acc1 += lv * Tr[m]; else acc0 += lv * Tr[m]; }
            float acc = acc0 + acc1;
            acc += __builtin_bit_cast(float, __builtin_amdgcn_update_dpp(0, __builtin_bit_cast(int, acc), 0xB1, 0xf, 0xf, false));
            acc += __builtin_bit_cast(float, __builtin_amdgcn_update_dpp(0, __builtin_bit_cast(int, acc), 0x4E, 0xf, 0xf, false));
            int jj = j, ss = s; asm volatile("" : "+v"(jj), "+v"(ss));
            const float val = acc + ((t == jj) ? 1.f : 0.f);
            Tr[t >> 2] = (ss == (t & 3)) ? val : Tr[t >> 2];
            SLOT(0)[t * LP + j] = (bf16)pk2z(val);
        }
    } else if (cvi >= 0) { f32x4 cv[CVK]; cvx_load(F.in, cvi, lane, cv); cvx_store(ws, cvi, lane, cv); }
    S1_BAR();
#pragma unroll
    for (int tix = 0; tix < 2; ++tix) { const int ti = 2 * wave + tix, r0 = 16 * (ti >> 2), c0 = 16 * (ti & 3), ci = c0 + rr;
        { const f32x4 acc = mm_tile(SLOT(0), r0, SLOT(4), c0, lane); *(LAS v2u*)(SLOT(2) + ci * LP + r0 + 4 * q) = pack4(acc); }
        { const f32x4 acc = mm_tile(SLOT(0), r0, SLOT(10), c0, lane); *(LAS v2u*)(SLOT(3) + ci * LP + r0 + 4 * q) = pack4(acc); }
    }
    S1_BAR();
    unsigned char* RH = ws + WS_RH + (size_t)u * 4096; bf16* GT = (bf16*)((unsigned char*)F.out + OUT_GT) + (size_t)u * 4096;
#pragma unroll
    for (int tix = 0; tix < 2; ++tix) { const int ti = 2 * wave + tix, tr = ti >> 2, r0 = 16 * tr, c0 = 16 * (ti & 3), ci = c0 + rr;
        const int pos = (tr >> 1) * 32 + q * 8 + 4 * (tr & 1);
        if (emit) {
            { f32x4 acc = mm_tile(SLOT(2), r0, SLOT(11), c0, lane);
                acc += unpack4(*(const LAS v2u*)(SLOT(1) + ci * LP + r0 + 4 * q));
                *(unsigned*)(RH + ci * 64 + pos) = pack4_fp8(acc); }
            { f32x4 acc = mm_tile(SLOT(3), r0, SLOT(11), c0, lane);
                acc += unpack4(*(const LAS v2u*)(SLOT(12) + ci * LP + r0 + 4 * q));
                *(LAS v2u*)(SLOT(4) + ci * LP + r0 + 4 * q) = pack4(acc); }
        }
        { f32x4 acc = mm_tile(SLOT(2), r0, SLOT(6), c0, lane);
            const float gc = gCs[ci];
#pragma unroll
            for (int e = 0; e < 4; ++e) acc[e] += (r0 + 4 * q + e == ci) ? gc : 0.f;
            *(v2u*)(GT + ci * 64 + pos) = pack4(acc); }
    }
    S1_BAR();
    unsigned char* YL = ws + WS_YL + (size_t)u * 4096;
#pragma unroll
    for (int tix = 0; tix < 2; ++tix) { const int ti = 2 * wave + tix, r0 = 16 * (ti >> 2), c0 = 16 * (ti & 3), ci = c0 + rr;
        if (emit) { const f32x4 acc = mm_tile(SLOT(5), r0, SLOT(4), c0, lane); *(unsigned*)(YL + ci * 64 + r0 + 4 * q) = pack4_fp8(acc); }
        { f32x4 acc = mm_tile(SLOT(3), r0, SLOT(6), c0, lane);
            acc += unpack4(*(const LAS v2u*)(SLOT(7) + ci * LP + r0 + 4 * q));
            *(LAS v2u*)(SLOT(8) + ci * LP + r0 + 4 * q) = pack4(acc); }
    }
    S1_BAR();
    bf16* HH = (bf16*)(ws + WS_HH) + (size_t)u * 4096;
#pragma unroll
    for (int tix = 0; tix < 2; ++tix) { const int ti = 2 * wave + tix, r0 = 16 * (ti >> 2), c0 = 16 * (ti & 3), ci = c0 + rr;
        const f32x4 acc = mm_tile(SLOT(8), r0, SLOT(5), c0, lane);
        *(v2u*)(HH + ci * 64 + r0 + 4 * q) = pack4(acc); }
    S1_BAR();
}

struct GlIn { bf16 la[8], q[8], k[8], v0[8], v1[8]; };
__device__ __forceinline__ void s1_gla_load(Frame& F, int u, GlIn& I) {
    const int sg = u / NCHUNK, c = u - sg * NCHUNK, gb = sg >> 3, gdir = (sg >> 2) & 1, gh = sg & 3; unsigned char* ws = F.ws;
    const bf16* Qp = (const bf16*)(ws + WS_QGB); const bf16* Kp = (const bf16*)(ws + WS_KGB); const bf16* Vp = (const bf16*)(ws + WS_VGB); const bf16* LAp = (const bf16*)(ws + (gdir ? WS_LAB : WS_LAF));
#pragma unroll
    for (int i = 0; i < 8; ++i) { const int row = scan_row(c * CH + 8 * F.wave + i, gb, gdir); const size_t b2 = (size_t)row * 256 + gh * 64 + F.lane, b5 = (size_t)row * RWW + gh * 128 + F.lane;
        I.la[i] = LAp[b2]; I.q[i] = Qp[b2]; I.k[i] = Kp[b2]; I.v0[i] = Vp[b5]; I.v1[i] = Vp[b5 + 64]; }
}
__device__ __forceinline__ void s1_gla(Frame& F, int u, const GlIn& I) {
    const int sg = u / NCHUNK, c = u - sg * NCHUNK;
    const bool emit = c >= CTXL / CH;
    LAS unsigned char* lds = F.lds; unsigned char* ws = F.ws;
    int lane_ = F.lane; asm volatile("" : "+v"(lane_));
    const int lane = lane_, wave = F.wave, rr = lane & 15, q = lane >> 4;
    LAS float* tot = (LAS float*)(lds + AUX_OFF);
    unsigned char* QE = (unsigned char*)F.out + OUT_QE + (size_t)u * 4096;
    {
        float la[8], xq[8], xk[8], v0[8], v1[8];
#pragma unroll
        for (int i = 0; i < 8; ++i) { la[i] = bf2f(I.la[i]); xq[i] = bf2f(I.q[i]); xk[i] = bf2f(I.k[i]); v0[i] = bf2f(I.v0[i]); v1[i] = bf2f(I.v1[i]); }
        float p[8]; p[0] = la[0];
#pragma unroll
        for (int i = 1; i < 8; ++i) p[i] = p[i - 1] + la[i];
        tot[wave * 64 + lane] = p[7];
        S1_BAR();
        float off = 0.f, all = 0.f;
#pragma unroll
        for (int w = 0; w < 8; ++w) { const float t = tot[w * 64 + lane]; all += t; off += (w < wave) ? t : 0.f; }
        if (wave == 0) ((float*)(ws + WS_DD))[(size_t)u * 64 + lane] = __expf(all);
        float kl[8];
#pragma unroll
        for (int i = 0; i < 8; ++i) { const float cum = off + p[i]; const int t = 8 * wave + i;
            const float qef = xq[i] * __expf(cum);
            SLOT(0)[t * LP + lane] = (bf16)pk2z(qef);
            if (emit) QE[t * 64 + lane] = (unsigned char)__builtin_amdgcn_cvt_pk_fp8_f32(clamp8(qef), 0.f, 0, false);
            SLOT(1)[t * LP + lane] = (bf16)pk2z(xk[i] * __expf(-cum));
            kl[i] = xk[i] * __expf(all - cum); }
        *(LAS v4u*)(SLOT(2) + lane * LP + 8 * wave) = pk8(kl);
        *(LAS v4u*)(SLOT(3) + lane * LP + 8 * wave) = pk8(v0);
        *(LAS v4u*)(SLOT(3) + (64 + lane) * LP + 8 * wave) = pk8(v1);
        S1_BAR();
    }
    if (emit) {
#pragma unroll
        for (int tix = 0; tix < 2; ++tix) { const int ti = 2 * wave + tix, r0 = 16 * (ti >> 2), c0 = 16 * (ti & 3), ci = c0 + rr;
            f32x4 acc = mm_tile(SLOT(1), r0, SLOT(0), c0, lane);
#pragma unroll
            for (int e = 0; e < 4; ++e) acc[e] = (r0 + 4 * q + e <= ci) ? acc[e] : 0.f;
            *(LAS v2u*)(SLOT(5) + ci * LP + r0 + 4 * q) = pack4(acc); }
    }
    bf16* KV = (bf16*)(ws + WS_KV) + (size_t)u * 8192;
#pragma unroll
    for (int tix = 0; tix < 4; ++tix) { const int ti = 4 * wave + tix, r0 = 16 * (ti >> 3), c0 = 16 * (ti & 7), ci = c0 + rr;
        const f32x4 acc = mm_tile(SLOT(2), r0, SLOT(3), c0, lane);
        *(v2u*)(KV + ci * 64 + r0 + 4 * q) = pack4(acc); }
    S1_BAR();
    if (emit) {
        unsigned char* IN = ws + WS_INTRA + (size_t)u * 8192;
#pragma unroll
        for (int tix = 0; tix < 4; ++tix) { const int ti = 4 * wave + tix, r0 = 16 * (ti >> 2), c0 = 16 * (ti & 3), ci = c0 + rr;
            const f32x4 acc = mm_tile(SLOT(3), r0, SLOT(5), c0, lane);
            *(unsigned*)(IN + ci * 128 + r0 + 4 * q) = pack4_fp8(acc); }
    }
    S1_BAR();
}

__device__ __forceinline__ void ph_scan1(Frame& F) {
    { RwIn cur, nxt; if ((int)blockIdx.x < NU_RW) s1_rwkv_load(F, blockIdx.x, cur);
#pragma unroll 1
      for (int u = blockIdx.x; u < NU_RW; u += F.G) { const int un = (u + F.G < NU_RW) ? u + F.G : u; const int cvi = ((u - (int)blockIdx.x) / F.G) * (F.G * 4) + (int)blockIdx.x * 4 + (F.wave & 3);
          s1_rwkv(F, u, cur, un, nxt, cvi < CV_NITEM ? cvi : -1); cur = nxt; } }
    { GlIn cur, nxt; if ((int)blockIdx.x < NU_GL) s1_gla_load(F, blockIdx.x, cur);
#pragma unroll 1
      for (int u = blockIdx.x; u < NU_GL; u += F.G) { const int un = (u + F.G < NU_GL) ? u + F.G : u; s1_gla_load(F, un, nxt); s1_gla(F, u, cur); cur = nxt; } }
}

__device__ __forceinline__ bf16x8 pack_frag(const f32x4 lo, const f32x4 hi) {
    v4u w; w.x = pk2(lo[0], lo[1]); w.y = pk2(lo[2], lo[3]); w.z = pk2(hi[0], hi[1]); w.w = pk2(hi[2], hi[3]); return __builtin_bit_cast(bf16x8, w);
}
constexpr int S2_D = 5, S2_R = 6, S2_RW = 8192 + 4096 + 2048 + 1024, S2_GL = 4096 + 2048 + 1024 + 1024, S2_SLOT = S2_RW + S2_GL;
static_assert(S2_R * S2_SLOT <= MISC_OFF, "S2 ring fits in LDS");
__device__ __forceinline__ void s2_issue(LAS unsigned char* lds, int sb, int lw, int lane, size_t ur, size_t ug, int v0r, int v0g,
                                         const unsigned char* GTb, const unsigned char* RHb, const unsigned char* HHb, const unsigned char* YLb,
                                         const unsigned char* QEb, const unsigned char* KVb, const unsigned char* INb, const unsigned char* DDb) {
#pragma unroll
    for (int j = 0; j < 4; ++j) {
        int k = lw * 4 + j; if (k >= 23) k -= 1;
        const unsigned char* src; int ldo;
        if (k < 8) { const int n = k, pu = n * 64 + lane, row = pu >> 3, c16 = (pu & 7) ^ (row & 7);
            src = GTb + ur * 8192 + row * 128 + c16 * 16; ldo = n * 1024; }
        else if (k < 12) { const int n = k - 8, pu = n * 64 + lane, row = pu >> 2, c16 = (pu & 3) ^ (row & 3);
            src = RHb + ur * 4096 + row * 64 + c16 * 16; ldo = 8192 + n * 1024; }
        else if (k < 14) { const int n = k - 12, pu = n * 64 + lane, v = pu >> 3, c16 = (pu & 7) ^ (v & 7);
            src = HHb + ur * 8192 + (size_t)(v0r + v) * 128 + c16 * 16; ldo = 12288 + n * 1024; }
        else if (k < 15) { const int t = lane;
            src = YLb + ur * 4096 + t * 64 + v0r; ldo = 14336; }
        else if (k < 19) { const int n = k - 15, pu = n * 64 + lane, row = pu >> 2, c16 = (pu & 3) ^ (row & 3);
            src = QEb + ug * 4096 + row * 64 + c16 * 16; ldo = S2_RW + n * 1024; }
        else if (k < 21) { const int n = k - 19, pu = n * 64 + lane, v = pu >> 3, c16 = (pu & 7) ^ (v & 7);
            src = KVb + ug * 16384 + (size_t)(v0g + v) * 128 + c16 * 16; ldo = S2_RW + 4096 + n * 1024; }
        else if (k < 22) { const int t = lane;
            src = INb + ug * 8192 + t * 128 + v0g; ldo = S2_RW + 6144; }
        else { src = DDb + ug * 256 + (lane & 15) * 16; ldo = S2_RW + 7168; }
        __builtin_amdgcn_global_load_lds((const unsigned*)src, (LAS unsigned*)(lds + sb + ldo), 16, 0, 0);
    }
}
__device__ __forceinline__ void ph_scan2(Frame& F) {
    const int lane = F.lane, wave = F.wave, rr = lane & 15, q = lane >> 4; unsigned char* ws = F.ws; LAS unsigned char* lds = F.lds;
    const int it = (F.G == 256) ? (int)(blockIdx.x & 7) * 32 + (int)(blockIdx.x >> 3) : (int)blockIdx.x;
    const int sr = it >> 2, v0r = 16 * (it & 3), rb = sr >> 4, rdir = (sr >> 3) & 1, rh = sr & 7;
    const int sg = it >> 3, v0g = 16 * (it & 7), gb = sg >> 3, gdir = (sg >> 2) & 1, gh = sg & 3;
#define S2_BAR() do { asm volatile("s_waitcnt lgkmcnt(0)" ::: "memory"); __builtin_amdgcn_s_barrier(); asm volatile("" ::: "memory"); } while (0)
    if (wave >= 2) {
        const unsigned char* GTb = (const unsigned char*)F.out + OUT_GT; const unsigned char* QEb = (const unsigned char*)F.out + OUT_QE;
        const unsigned char* RHb = ws + WS_RH; const unsigned char* YLb = ws + WS_YL; const unsigned char* HHb = ws + WS_HH; const unsigned char* KVb = ws + WS_KV; const unsigned char* INb = ws + WS_INTRA;
        const unsigned char* DDb = ws + WS_DD;
#define S2_ISSUE(cc) s2_issue(lds, ((cc) % S2_R) * S2_SLOT, wave - 2, lane, (size_t)(sr * NCHUNK + ((cc) < NCHUNK ? (cc) : NCHUNK - 1)), (size_t)(sg * NCHUNK + ((cc) < NCHUNK ? (cc) : NCHUNK - 1)), v0r, v0g, GTb, RHb, HHb, YLb, QEb, KVb, INb, DDb)
        S2_ISSUE(0); S2_ISSUE(1); S2_ISSUE(2); S2_ISSUE(3); S2_ISSUE(4);
#pragma unroll 1
        for (int c = 0; c < NCHUNK; ++c) {
            asm volatile("s_waitcnt vmcnt(16) ; S2WAIT" ::: "memory");
            S2_BAR();
            S2_ISSUE(c + S2_D);
        }
#undef S2_ISSUE
    } else if (wave == 0) {
        bf16* ORW = (bf16*)(ws + (rdir ? WS_ORWB : WS_ORWF));
        f32x4 S[4];
#pragma unroll
        for (int m = 0; m < 4; ++m) S[m] = (f32x4){0.f, 0.f, 0.f, 0.f};
#pragma unroll 1
        for (int c = 0; c < NCHUNK; ++c) {
            S2_BAR();
            const LAS unsigned char* sl = lds + (c % S2_R) * S2_SLOT;
            const bool emit = c >= CTXL / CH;
            bf16x8 G0[4], G1[4]; v2u Hw[4], Rw0[4], Rw1[4]; unsigned Yw[4];
#pragma unroll
            for (int m = 0; m < 4; ++m) { const int k2 = 16 * m + rr;
                G0[m] = *(const LAS bf16x8*)(sl + (k2 * 8 + (q ^ (k2 & 7))) * 16); G1[m] = *(const LAS bf16x8*)(sl + (k2 * 8 + ((4 + q) ^ (k2 & 7))) * 16);
                Hw[m] = *(const LAS v2u*)(sl + 12288 + (rr * 8 + ((2 * m + (q >> 1)) ^ (rr & 7))) * 16 + (q & 1) * 8); }
            if (emit) {
#pragma unroll
                for (int tt = 0; tt < 4; ++tt) { const int t = 16 * tt + rr;
                    Rw0[tt] = *(const LAS v2u*)(sl + 8192 + (t * 4 + ((q >> 1) ^ (t & 3))) * 16 + (q & 1) * 8); Rw1[tt] = *(const LAS v2u*)(sl + 8192 + (t * 4 + ((2 + (q >> 1)) ^ (t & 3))) * 16 + (q & 1) * 8);
                    Yw[tt] = *(const LAS unsigned*)(sl + 14336 + t * 16 + q * 4); }
            }
            const bf16x8 Sf0 = pack_frag(S[0], S[1]), Sf1 = pack_frag(S[2], S[3]);
            __builtin_amdgcn_sched_barrier(0);
#pragma unroll
            for (int m = 0; m < 4; ++m) { f32x4 acc = unpack4(Hw[m]);
                acc = __builtin_amdgcn_mfma_f32_16x16x32_bf16(G0[m], Sf0, acc, 0, 0, 0);
                acc = __builtin_amdgcn_mfma_f32_16x16x32_bf16(G1[m], Sf1, acc, 0, 0, 0);
                S[m] = acc; }
            if (emit) {
#pragma unroll
                for (int tt = 0; tt < 4; ++tt) { const int t = 16 * tt + rr;
                    const bf16x8 R0 = pack_frag(unpack4_fp8(Rw0[tt].x), unpack4_fp8(Rw0[tt].y)), R1 = pack_frag(unpack4_fp8(Rw1[tt].x), unpack4_fp8(Rw1[tt].y));
                    f32x4 acc = unpack4_fp8(Yw[tt]);
                    acc = __builtin_amdgcn_mfma_f32_16x16x32_bf16(Sf0, R0, acc, 0, 0, 0);
                    acc = __builtin_amdgcn_mfma_f32_16x16x32_bf16(Sf1, R1, acc, 0, 0, 0);
                    const int row = scan_row(c * CH + t, rb, rdir);
                    *(v2u*)(ORW + (size_t)row * RWW + rh * 64 + v0r + 4 * q) = pack4(acc); }
            }
        }
    } else {
        bf16* OGL = (bf16*)(ws + (gdir ? WS_OGLB : WS_OGLF));
        f32x4 S[4];
#pragma unroll
        for (int m = 0; m < 4; ++m) S[m] = (f32x4){0.f, 0.f, 0.f, 0.f};
#pragma unroll 1
        for (int c = 0; c < NCHUNK; ++c) {
            S2_BAR();
            const LAS unsigned char* sl = lds + (c % S2_R) * S2_SLOT + S2_RW;
            const bool emit = c >= CTXL / CH;
            v2u Qw0[4], Qw1[4]; unsigned Iw[4]; v4u kw[2]; f32x4 d0[2], d1[2];
#pragma unroll
            for (int s2 = 0; s2 < 2; ++s2) { kw[s2] = *(const LAS v4u*)(sl + 4096 + (rr * 8 + ((4 * s2 + q) ^ (rr & 7))) * 16);
                d0[s2] = *(const LAS f32x4*)(sl + 7168 + 128 * s2 + 32 * q); d1[s2] = *(const LAS f32x4*)(sl + 7168 + 128 * s2 + 32 * q + 16); }
            if (emit) {
#pragma unroll
                for (int tt = 0; tt < 4; ++tt) { const int t = 16 * tt + rr;
                    Qw0[tt] = *(const LAS v2u*)(sl + (t * 4 + ((q >> 1) ^ (t & 3))) * 16 + (q & 1) * 8); Qw1[tt] = *(const LAS v2u*)(sl + (t * 4 + ((2 + (q >> 1)) ^ (t & 3))) * 16 + (q & 1) * 8);
                    Iw[tt] = *(const LAS unsigned*)(sl + 6144 + t * 16 + q * 4); }
            }
            const bf16x8 Sf0 = pack_frag(S[0], S[1]), Sf1 = pack_frag(S[2], S[3]);
            __builtin_amdgcn_sched_barrier(0);
#pragma unroll
            for (int s2 = 0; s2 < 2; ++s2) { S[2 * s2] = S[2 * s2] * d0[s2] + unpack4((v2u){kw[s2].x, kw[s2].y}); S[2 * s2 + 1] = S[2 * s2 + 1] * d1[s2] + unpack4((v2u){kw[s2].z, kw[s2].w}); }
            if (emit) {
#pragma unroll
                for (int tt = 0; tt < 4; ++tt) { const int t = 16 * tt + rr;
                    const bf16x8 Q0 = pack_frag(unpack4_fp8(Qw0[tt].x), unpack4_fp8(Qw0[tt].y)), Q1 = pack_frag(unpack4_fp8(Qw1[tt].x), unpack4_fp8(Qw1[tt].y));
                    f32x4 acc = unpack4_fp8(Iw[tt]);
                    acc = __builtin_amdgcn_mfma_f32_16x16x32_bf16(Sf0, Q0, acc, 0, 0, 0);
                    acc = __builtin_amdgcn_mfma_f32_16x16x32_bf16(Sf1, Q1, acc, 0, 0, 0);
                    const int row = scan_row(c * CH + t, gb, gdir);
                    *(v2u*)(OGL + (size_t)row * RWW + gh * 128 + v0g + 4 * q) = pack4(acc); }
            }
        }
    }
#undef S2_BAR
}
#endif

#ifndef ML
#define ML 0
#endif
enum Phase { PH_PROLOGUE = 0, PH_A1, PH_INPROJ, PH_FEAT, PH_LORA, PH_SCAN1, PH_SCAN2, PH_MERGE, PH_BRANCH, PH_OUTPROJ, PH_LN1, PH_ROUTER, PH_ROUTE, PH_SCATTER, PH_EXP1, PH_EXP2, PH_FINAL, PH_COUNT };

__global__ void __launch_bounds__(NTHR, 2) mega(Args args) {
    extern __shared__ __attribute__((aligned(16))) unsigned char lds_raw[];
    Frame F;
    F.lds = (LAS unsigned char*)lds_raw;
    F.tid = threadIdx.x; F.lane = F.tid & 63; F.wave = __builtin_amdgcn_readfirstlane(F.tid >> 6);
    F.G = gridDim.x; F.gw = blockIdx.x * NWAVES + F.wave; F.NGW = F.G * NWAVES;
    F.in = args.in; F.out = args.out; F.ws = args.ws; F.ctl = (unsigned*)(args.ws + WS_CTL);
    volatile LAS unsigned* MISC = (volatile LAS unsigned*)(F.lds + MISC_OFF);
    if (F.tid < 64) MISC[F.tid] = 0u;
    __syncthreads();
    XcdBarrier bar; bar.bar = F.ctl + CW_BAR; bar.x = 0; bar.st = nullptr;
#if !ML
    bar = xcd_barrier_post(F.ctl + CW_BAR, MISC + 8);
#endif
    const int lo = args.ph_lo, hi = args.ph_hi;
#define IN(k) (lo <= (k) && (k) < hi)
#ifndef DUP
#define DUP -1
#endif
#define RUN(k, call) do { if (IN(k)) { call; GRID_BAR(); if (DUP == (k)) { call; GRID_BAR(); } } } while (0)
#if ML
#define GRID_BAR() do { } while (0)
#else
#define GRID_BAR() xcd_barrier(bar)
#endif

#if MS >= 2
    RUN(PH_PROLOGUE, ph_prologue(F));
#endif
#if MS >= 3
    RUN(PH_A1, ph_a1(F));
    RUN(PH_INPROJ, ph_inproj(F));
    RUN(PH_FEAT, ph_feat(F));
    RUN(PH_LORA, ph_lora(F));
    RUN(PH_SCAN1, ph_scan1(F));
    RUN(PH_SCAN2, ph_scan2(F));
    RUN(PH_MERGE, ph_merge(F));
    RUN(PH_BRANCH, ph_branch(F));
    RUN(PH_OUTPROJ, ph_outproj(F));
#else
    RUN(PH_OUTPROJ, ph_x1pre_nomix(F));
#endif
    RUN(PH_LN1, ph_ln1(F));
#if MS >= 2
    RUN(PH_ROUTER, ph_router(F));
    RUN(PH_ROUTE, ph_route(F));
    RUN(PH_SCATTER, ph_scatter(F));
    RUN(PH_EXP1, ph_exp1(F));
    RUN(PH_EXP2, ph_exp2(F));
#endif
    if (IN(PH_FINAL)) { ph_final(F); }
#undef IN
}

extern "C" void kernel_launch(void* const* d_in, const int* in_sizes, int n_in, void* d_out, int out_size, void* d_ws, size_t ws_size, hipStream_t stream) {
    static int grid = 0;
    if (grid == 0) {
        if (n_in != 36 || out_size != NLAT * D || ws_size < WS_END) { fprintf(stderr, "kernel_launch: unexpected problem shape (n_in %d, out %d)\n", n_in, out_size); grid = -1; return; }
        int dev = 0, cus = 0, per_cu = 0;
        if (hipGetDevice(&dev) != hipSuccess || hipDeviceGetAttribute(&cus, hipDeviceAttributeMultiprocessorCount, dev) != hipSuccess) { grid = -1; return; }
        if (hipFuncSetAttribute((const void*)mega, hipFuncAttributeMaxDynamicSharedMemorySize, LDS_BYTES) != hipSuccess) { fprintf(stderr, "kernel_launch: hipFuncSetAttribute failed\n"); grid = -1; return; }
        if (hipOccupancyMaxActiveBlocksPerMultiprocessor(&per_cu, (const void*)mega, NTHR, LDS_BYTES) != hipSuccess || per_cu < 1) { fprintf(stderr, "kernel_launch: occupancy query says %d\n", per_cu); }
        (void)hipGetLastError();
        grid = cus > 0 ? cus : 256;
        if (grid > 256) grid = 256;
    }
    if (grid < 0) return;
    (void)hipMemsetAsync((char*)d_ws + WS_CTL, 0, CTL_ZERO_BYTES, stream);
    Args a{};
    for (int i = 0; i < 36; ++i) a.in[i] = (const float*)d_in[i];
    a.out = (float*)d_out; a.ws = (unsigned char*)d_ws;
#if ML
    for (int p = 0; p < PH_COUNT; ++p) { a.ph_lo = p; a.ph_hi = p + 1; hipLaunchKernelGGL(mega, dim3(grid), dim3(NTHR), LDS_BYTES, stream, a); }
#else
    a.ph_lo = 0; a.ph_hi = PH_COUNT;
    hipLaunchKernelGGL(mega, dim3(grid), dim3(NTHR), LDS_BYTES, stream, a);
#endif
}
```

```cpp
#include <hip/hip_runtime.h>
#include <cstdio>
#include <cstdint>

#ifndef MS
#define MS 3
#endif

#define GAS __attribute__((address_space(1)))
#define LAS __attribute__((address_space(3)))
typedef unsigned short bf16;
typedef unsigned v4u __attribute__((ext_vector_type(4)));
typedef unsigned v2u __attribute__((ext_vector_type(2)));
typedef float f32x4 __attribute__((ext_vector_type(4)));
typedef float f32x2 __attribute__((ext_vector_type(2)));
typedef short bf16x8 __attribute__((ext_vector_type(8)));
#define LDS_WAIT() asm volatile("s_waitcnt lgkmcnt(0)" ::: "memory")
#define VM_WAIT() asm volatile("s_waitcnt vmcnt(0)" ::: "memory")

constexpr int D = 1024, NB = 4, SEQ = 8192, CTXL = 256, GRIDW = 64, GRIDH = 128;
constexpr int NLAT = NB * SEQ, NCTX = NB * CTXL, MR = NLAT + NCTX;
constexpr int RWW = 512, RWH = 8, HD = 64;
constexpr int C_R = 0, C_K = 512, C_V = 1024, C_PW = 1536, C_PA = 1568, C_PG = 1600, C_Q = 1696, C_KG = 1952, C_VG = 2208, C_PGL = 2720, C_OG = 2736, C_GRW = 3248, C_GGLA = 4272;
constexpr int IN_COLS = 5296, NP = 5376;
constexpr int NE = 256, TOPK = 8, FF = 256;
constexpr float LN_EPS = 1e-5f, RW_GN_EPS = 64e-5f;
constexpr float ALPHA = 1.189207115f;
constexpr float W8S = 64.0f, W8I = 1.0f / 64.0f;
constexpr int NLORA = 3072, KLORA = 256;
constexpr int MAXTILES = 1280, SH_ROW0 = MAXTILES * 256, NROWS_E = SH_ROW0 + NLAT;

namespace pg8 {
#define PG8_LAS __attribute__((address_space(3)))
typedef unsigned short bf16_t;
typedef unsigned u32x4 __attribute__((ext_vector_type(4)));
typedef unsigned u32x2 __attribute__((ext_vector_type(2)));
typedef long i64x2 __attribute__((ext_vector_type(2)));
constexpr int BM = 256, BK = 64, HALF = 128, HTB = HALF * BK * 2, STAGE_BYTES = 8 * HTB, NXCD = 8, WGM = 8;
constexpr int IDX_OFF = STAGE_BYTES, IDX_UNITS = 12;

__host__ __device__ __forceinline__ int lds_byte(int r, int c) { const int st = (r >> 4) * 2 + (c >> 5), rr = r & 15, cc = c & 31, ob = rr * 64 + cc * 2; return st * 1024 + (ob ^ (((ob >> 9) & 1) << 5)); }
__host__ __device__ __forceinline__ void stage_rc(int b, int& R, int& C) { const int st = b / 1024, sb = b % 1024, swz = sb ^ (((sb >> 9) & 1) << 5); R = (st >> 1) * 16 + swz / 64; C = (st & 1) * 32 + (swz % 64) / 2; }
__host__ __device__ __forceinline__ int perm32(int rho) { const int n = rho >> 4, i = rho & 15; return 8 * (i >> 2) + 4 * n + (i & 3); }

struct Unit { int pm, pn, e, j; };
struct Gemm { const bf16_t* A; const bf16_t* Bt; int M, N, K; const int* rowidx; };

struct StaticOrder {
    int nM, nN, nwg, G, c;
    __host__ __device__ void init(int M, int N, int G_, int c_) { nM = M / BM; nN = N / BM; nwg = nM * nN; G = G_; c = c_; }
    __host__ __device__ bool next(int i, Unit& u) const {
        const long L = (long)i * G + c; if (L >= nwg) return false;
        int wgid = (int)L; { const int q = nwg / NXCD, r = nwg % NXCD, xcd = wgid % NXCD, off = wgid / NXCD; wgid = (xcd < r ? xcd * (q + 1) : r * (q + 1) + (xcd - r) * q) + off; }
        const int nig = WGM * nN, gid = wgid / nig, fm = gid * WGM, gsz = (nM - fm) < WGM ? (nM - fm) : WGM;
        u.pm = fm + ((wgid % nig) % gsz); u.pn = (wgid % nig) / gsz; u.e = 0; u.j = u.pn; return true;
    }
};
struct MoeOrder {
    int nN, G, c, NT; const int* tile_e;
    __device__ bool next(int i, Unit& u) const {
        const int L = i * G + c; const int total = (NT + NLAT / 256) * nN; if (L >= total) return false;
        const int tile = L / nN, j = L - tile * nN; int e, pm;
        if (tile < NT) { e = tile_e[tile]; pm = tile; } else { e = NE; pm = MAXTILES + (tile - NT); }
        u.pm = pm; u.pn = e * nN + j; u.e = e; u.j = j; return true;
    }
};

typedef __bf16 bf16x2n __attribute__((ext_vector_type(2))); typedef float f32x2n __attribute__((ext_vector_type(2)));
__device__ __forceinline__ unsigned cvt_pk_bf16(float lo, float hi) { const f32x2n v = {lo, hi}; return __builtin_bit_cast(unsigned, __builtin_convertvector(v, bf16x2n)); }

template <class Epi, class Sched, bool ALIGN_EPI, bool SP2, bool GATHER, bool FP8 = false>
__device__ __forceinline__ void gemm_phase(PG8_LAS unsigned char* lds, const Gemm g, const Sched& S, const Epi& E) {
    const int tid = threadIdx.x, wid = __builtin_amdgcn_readfirstlane(tid >> 6), lane = tid & 63, wr = wid >> 2, wc = wid & 3, fr = lane & 15, fq = lane >> 4;
    const int K = g.K, nt = K / BK;
    const size_t kstep = (size_t)(BK * 2);
    const size_t hstep = (size_t)HALF * K * 2;
    const size_t tstep = 2 * hstep;
    unsigned voffB[2]; unsigned va[2][2];
#pragma unroll
    for (int i = 0; i < 2; ++i) { int R, C; stage_rc(tid * 16 + i * 8192, R, C); const int Rb = Epi::PERM ? ((R & ~31) + perm32(R & 31)) : R;
        voffB[i] = (unsigned)(Rb * K + C) * 2u;
        va[0][i] = (unsigned)(R * K + C) * 2u; va[1][i] = va[0][i]; }
    const size_t ah = GATHER ? (size_t)0 : hstep;
#define PG8_GOFF(dst, ub) do { _Pragma("unroll") for (int _h = 0; _h < 2; ++_h) _Pragma("unroll") for (int _i = 0; _i < 2; ++_i) { int _R, _C; stage_rc(tid * 16 + _i * 8192, _R, _C); \
        dst[_h][_i] = (unsigned)(idxt[(ub) * 256 + _h * 128 + _R] * K + _C) * 2u; } } while (0)
    const unsigned ldsw = (unsigned)wid * 1024u;
    const int aoff = lds_byte(wr * 64 + fr, fq * 8), boff = lds_byte(wc * 32 + fr, fq * 8);
    PG8_LAS int* idxt = (PG8_LAS int*)(lds + IDX_OFF);
#define PG8_SA(b, h) (((b) * 2 + (h)) * HTB)
#define PG8_SB(b, h) ((4 + (b) * 2 + (h)) * HTB)
#define PG8_STAGE(bufoff, gbase, voff) do { _Pragma("unroll") for (int _i = 0; _i < 2; ++_i) \
        __builtin_amdgcn_global_load_lds((const unsigned*)((const char*)(gbase) + (voff)[_i]), (PG8_LAS unsigned*)(lds + (bufoff) + ldsw + _i * 8192), 16, 0, 0); } while (0)
#define PG8_LDA(dst, b, h) do { _Pragma("unroll") for (int m = 0; m < 4; ++m) _Pragma("unroll") for (int k = 0; k < 2; ++k) dst[m][k] = *(const PG8_LAS bf16x8*)(lds + PG8_SA(b, h) + aoff + m * 2048 + k * 1024); } while (0)
#define PG8_LDB(dst, b, h) do { _Pragma("unroll") for (int n = 0; n < 2; ++n) _Pragma("unroll") for (int k = 0; k < 2; ++k) dst[n][k] = *(const PG8_LAS bf16x8*)(lds + PG8_SB(b, h) + boff + n * 2048 + k * 1024); } while (0)
#define PG8_MMA(ai, bj, At, Bt) do { __builtin_amdgcn_s_setprio(1); _Pragma("unroll") for (int m = 0; m < 4; ++m) _Pragma("unroll") for (int n = 0; n < 2; ++n) _Pragma("unroll") for (int k = 0; k < 2; ++k) { \
        if constexpr (FP8) { const i64x2 _b = __builtin_bit_cast(i64x2, Bt[n][k]), _a = __builtin_bit_cast(i64x2, At[m][k]); \
            acc[ai][bj][m][n] = __builtin_amdgcn_mfma_f32_16x16x32_fp8_fp8(_b[0], _a[0], acc[ai][bj][m][n], 0, 0, 0); acc[ai][bj][m][n] = __builtin_amdgcn_mfma_f32_16x16x32_fp8_fp8(_b[1], _a[1], acc[ai][bj][m][n], 0, 0, 0); } \
        else acc[ai][bj][m][n] = __builtin_amdgcn_mfma_f32_16x16x32_bf16(Bt[n][k], At[m][k], acc[ai][bj][m][n], 0, 0, 0); } __builtin_amdgcn_s_setprio(0); } while (0)
#define PG8_WAIT_V(n) asm volatile("s_waitcnt vmcnt(" #n ")" ::: "memory")
#define PG8_WAIT_L(n) asm volatile("s_waitcnt lgkmcnt(" #n ")" ::: "memory")
#define PG8_BAR __builtin_amdgcn_s_barrier()
#define PG8_SCHED __builtin_amdgcn_sched_barrier(0)
    Unit cur, nxt; int ui = 0;
    if (!S.next(0, cur)) return;
#ifdef GEMM_STAGGER
    if constexpr (FP8) {
        const unsigned long long t0 = __builtin_amdgcn_s_memrealtime(); const unsigned long long dl = (unsigned long long)(blockIdx.x & 3) * GEMM_STAGGER;
        while (__builtin_amdgcn_s_memrealtime() - t0 < dl) __builtin_amdgcn_s_sleep(8);
    }
#endif
    if constexpr (GATHER) {
        Unit uu;
        for (int i = 0; i < IDX_UNITS; ++i) { if (!S.next(i, uu)) break; if (tid < 256) idxt[i * 256 + tid] = g.rowidx[(size_t)uu.pm * 256 + tid]; }
        asm volatile("s_waitcnt vmcnt(0) lgkmcnt(0)" ::: "memory"); PG8_BAR; asm volatile("" ::: "memory");
        PG8_GOFF(va, 0);
    }
    f32x4 acc[2][2][4][2];
#pragma unroll
    for (int a = 0; a < 2; ++a)
#pragma unroll
        for (int b = 0; b < 2; ++b)
#pragma unroll
            for (int m = 0; m < 4; ++m)
#pragma unroll
                for (int n = 0; n < 2; ++n) acc[a][b][m][n] = (f32x4){0.f, 0.f, 0.f, 0.f};
    bf16x8 At[4][2], B0[2][2], B1[2][2];
    const char* cA = (const char*)g.A + (GATHER ? (size_t)0 : (size_t)cur.pm * tstep); const char* cB = (const char*)g.Bt + (size_t)cur.pn * tstep;
    if constexpr (SP2) {
        PG8_STAGE(PG8_SB(0, 0), cB, voffB); PG8_STAGE(PG8_SB(0, 1), cB + hstep, voffB); PG8_STAGE(PG8_SA(0, 0), cA, va[0]); PG8_STAGE(PG8_SA(0, 1), cA + ah, va[1]);
        if (wr == 1) PG8_BAR;
        PG8_WAIT_V(2); PG8_BAR;
        PG8_STAGE(PG8_SB(1, 0), cB + kstep, voffB); PG8_STAGE(PG8_SA(1, 0), cA + kstep, va[0]); PG8_STAGE(PG8_SB(1, 1), cB + hstep + kstep, voffB);
        PG8_WAIT_V(6); PG8_BAR;
    } else {
        PG8_STAGE(PG8_SB(0, 0), cB, voffB); PG8_STAGE(PG8_SA(0, 0), cA, va[0]); PG8_STAGE(PG8_SB(0, 1), cB + hstep, voffB); PG8_STAGE(PG8_SA(0, 1), cA + ah, va[1]);
        if (wr == 1) PG8_BAR;
        PG8_WAIT_V(4); PG8_BAR;
        PG8_STAGE(PG8_SB(1, 0), cB + kstep, voffB); PG8_STAGE(PG8_SA(1, 0), cA + kstep, va[0]); PG8_STAGE(PG8_SB(1, 1), cB + hstep + kstep, voffB);
        PG8_WAIT_V(6); PG8_BAR;
    }
    for (;;) {
        const bool has_next = S.next(ui + 1, nxt);
        const char* nA = has_next ? (const char*)g.A + (GATHER ? (size_t)0 : (size_t)nxt.pm * tstep) : cA; const char* nB = has_next ? (const char*)g.Bt + (size_t)nxt.pn * tstep : cB;
        const int ubn = (has_next && ui + 1 < IDX_UNITS) ? (ui + 1) : ui;
#pragma unroll 1
        for (int t = 0; t < nt; t += 2) {
            const bool last = (t == nt - 2);
            const char* a1 = cA + (size_t)(t + 1) * kstep;
            const char* a2 = last ? nA : cA + (size_t)(t + 2) * kstep; const char* b2 = last ? nB : cB + (size_t)(t + 2) * kstep;
            const char* a3 = a2 + kstep; const char* b3 = b2 + kstep;
            unsigned v2[2][2];
#pragma unroll
            for (int h = 0; h < 2; ++h)
#pragma unroll
                for (int i = 0; i < 2; ++i) v2[h][i] = va[h][i];
            if constexpr (GATHER) { if (last) PG8_GOFF(v2, ubn); }
            if constexpr (SP2) {
            PG8_LDB(B0, 0, 0); PG8_LDB(B1, 0, 1); PG8_SCHED; PG8_LDA(At, 0, 0); PG8_STAGE(PG8_SA(1, 1), a1 + ah, va[1]);
            PG8_WAIT_V(8); PG8_WAIT_L(0); PG8_BAR; PG8_MMA(0, 0, At, B0); PG8_MMA(0, 1, At, B1); PG8_BAR; PG8_SCHED;
            PG8_LDA(At, 0, 1); PG8_STAGE(PG8_SB(0, 0), b2, voffB); PG8_STAGE(PG8_SB(0, 1), b2 + hstep, voffB); PG8_STAGE(PG8_SA(0, 0), a2, v2[0]);
            PG8_WAIT_V(8); PG8_WAIT_L(0); PG8_BAR; PG8_MMA(1, 0, At, B0); PG8_MMA(1, 1, At, B1); PG8_BAR; PG8_SCHED;
            PG8_LDB(B0, 1, 0); PG8_LDB(B1, 1, 1); PG8_SCHED; PG8_LDA(At, 1, 0); PG8_STAGE(PG8_SA(0, 1), a2 + ah, v2[1]);
            PG8_WAIT_V(8); PG8_WAIT_L(0); PG8_BAR; PG8_MMA(0, 0, At, B0); PG8_MMA(0, 1, At, B1); PG8_BAR; PG8_SCHED;
            PG8_LDA(At, 1, 1); PG8_STAGE(PG8_SB(1, 0), b3, voffB); PG8_STAGE(PG8_SB(1, 1), b3 + hstep, voffB); PG8_STAGE(PG8_SA(1, 0), a3, v2[0]);
            PG8_WAIT_V(8); PG8_WAIT_L(0); PG8_BAR; PG8_MMA(1, 0, At, B0); PG8_MMA(1, 1, At, B1); PG8_BAR; PG8_SCHED;
            } else {
            PG8_LDB(B0, 0, 0); PG8_SCHED; PG8_LDA(At, 0, 0); PG8_STAGE(PG8_SA(1, 1), a1 + ah, va[1]);
            PG8_WAIT_L(8); PG8_BAR; PG8_WAIT_L(0); PG8_MMA(0, 0, At, B0); PG8_BAR; PG8_SCHED;
            PG8_LDB(B1, 0, 1); PG8_STAGE(PG8_SB(0, 0), b2, voffB);
            PG8_BAR; PG8_WAIT_L(0); PG8_MMA(0, 1, At, B1); PG8_BAR;
            PG8_LDA(At, 0, 1); PG8_STAGE(PG8_SA(0, 0), a2, v2[0]);
            PG8_BAR; PG8_WAIT_L(0); PG8_MMA(1, 0, At, B0); PG8_BAR; PG8_SCHED;
            PG8_STAGE(PG8_SB(0, 1), b2 + hstep, voffB);
            PG8_WAIT_V(6); PG8_BAR; PG8_MMA(1, 1, At, B1); PG8_BAR;
            PG8_LDB(B0, 1, 0); PG8_SCHED; PG8_LDA(At, 1, 0); PG8_STAGE(PG8_SA(0, 1), a2 + ah, v2[1]);
            PG8_WAIT_L(8); PG8_BAR; PG8_WAIT_L(0); PG8_MMA(0, 0, At, B0); PG8_BAR; PG8_SCHED;
            PG8_LDB(B1, 1, 1); PG8_STAGE(PG8_SB(1, 0), b3, voffB);
            PG8_BAR; PG8_WAIT_L(0); PG8_MMA(0, 1, At, B1); PG8_BAR;
            PG8_LDA(At, 1, 1); PG8_STAGE(PG8_SA(1, 0), a3, v2[0]);
            PG8_BAR; PG8_WAIT_L(0); PG8_MMA(1, 0, At, B0); PG8_BAR; PG8_SCHED;
            PG8_STAGE(PG8_SB(1, 1), b3 + hstep, voffB);
            PG8_WAIT_V(6); PG8_BAR; PG8_MMA(1, 1, At, B1); PG8_BAR;
            }
        }
        if constexpr (ALIGN_EPI) { if (wr == 0) PG8_BAR; }
        E(acc, cur, wr, wc, fr, fq);
        if (!has_next) break;
#pragma unroll
        for (int a = 0; a < 2; ++a)
#pragma unroll
            for (int b = 0; b < 2; ++b)
#pragma unroll
                for (int m = 0; m < 4; ++m)
#pragma unroll
                    for (int n = 0; n < 2; ++n) acc[a][b][m][n] = (f32x4){0.f, 0.f, 0.f, 0.f};
        cur = nxt; cA = nA; cB = nB; ++ui;
        if constexpr (GATHER) PG8_GOFF(va, ubn);
        if constexpr (ALIGN_EPI) { if (wr == 1) PG8_BAR; }
    }
    PG8_WAIT_V(0);
    if constexpr (!ALIGN_EPI) { if (wr == 0) PG8_BAR; }
    PG8_BAR;
#undef PG8_SA
#undef PG8_GOFF
#undef PG8_SB
#undef PG8_STAGE
#undef PG8_LDA
#undef PG8_LDB
#undef PG8_MMA
#undef PG8_WAIT_V
#undef PG8_WAIT_L
#undef PG8_BAR
#undef PG8_SCHED
}
}

#define XB_TMO      128
#define XB_XCNT(j)  (256  + 64 * (j))
#define XB_XSUB(j)  (1280 + 64 * (j))
#define XB_XGEN(j)  (2304 + 64 * (j))
#define XB_TOP      3328
#define XB_TOPGEN   3392
#define XCD_BAR_WORDS 3456
#define XB_SPIN_CAP (1u << 18)
__device__ __forceinline__ unsigned xb_ld(unsigned* p)              { return __hip_atomic_load(p, __ATOMIC_RELAXED, __HIP_MEMORY_SCOPE_AGENT); }
__device__ __forceinline__ unsigned xb_add(unsigned* p, unsigned v) { return __hip_atomic_fetch_add(p, v, __ATOMIC_RELAXED, __HIP_MEMORY_SCOPE_AGENT); }
__device__ __forceinline__ unsigned xb_xcc_id() { return (unsigned)__builtin_amdgcn_s_getreg((3 << 11) | 20) & 0xFu; }
#define XB_SPIN(cond, bar) do { unsigned _sp = 0; while (cond) { __builtin_amdgcn_s_sleep(1); \
    if ((++_sp & 255u) == 0u) { if (xb_ld(&(bar)[XB_TMO])) break; if (_sp > XB_SPIN_CAP) { atomicAdd(&(bar)[XB_TMO], 1u); break; } } } } while (0)
struct XcdBarrier { unsigned* bar; unsigned x; volatile LAS unsigned* st; };
__device__ __forceinline__ XcdBarrier xcd_barrier_post(unsigned* bar, volatile LAS unsigned* st) {
    XcdBarrier b; b.bar = bar; b.x = xb_xcc_id(); b.st = st;
    if (threadIdx.x == 0) (void)xb_add(&bar[XB_XCNT(b.x)], 1u);
    return b;
}
__device__ __forceinline__ void xcd_barrier_complete(unsigned* bar, unsigned x, unsigned& nloc, unsigned& nx) {
    const unsigned G = gridDim.x * gridDim.y * gridDim.z;
    unsigned sum, cnt, mine, sp = 0u;
    for (;;) {
        sum = 0u; cnt = 0u; mine = 0u;
#pragma unroll
        for (unsigned j = 0; j < 16; ++j) { const unsigned c = xb_ld(&bar[XB_XCNT(j)]); sum += c; cnt += (c > 0u) ? 1u : 0u; mine = (j == x) ? c : mine; }
        if (sum == G) break;
        __builtin_amdgcn_s_sleep(1);
        if ((++sp & 255u) == 0u) { if (xb_ld(&bar[XB_TMO])) break; if (sp > XB_SPIN_CAP) { atomicAdd(&bar[XB_TMO], 1u); break; } }
    }
    nloc = mine > 0u ? mine : 1u; nx = cnt > 0u ? cnt : 1u;
}
__device__ __forceinline__ void xcd_barrier(const XcdBarrier& b) {
    asm volatile("s_waitcnt vmcnt(0)" ::: "memory");
    __syncthreads();
    if (threadIdx.x == 0) {
        unsigned* bar = b.bar;
        __builtin_amdgcn_s_waitcnt(0);
        unsigned nloc = b.st[0], nx = b.st[1];
        if (nloc == 0u) { xcd_barrier_complete(bar, b.x, nloc, nx); b.st[0] = nloc; b.st[1] = nx; }
        const unsigned old = xb_add(&bar[XB_XSUB(b.x)], 1u);
        const unsigned gen = old / nloc;
        if (old + 1u == (gen + 1u) * nloc) {
            __builtin_amdgcn_fence(__ATOMIC_RELEASE, "agent");
            asm volatile("s_waitcnt vmcnt(0)" ::: "memory");
            const unsigned og = xb_add(&bar[XB_TOP], 1u);
            const unsigned tg = og / nx;
            if (og + 1u == (tg + 1u) * nx) xb_add(&bar[XB_TOPGEN], 1u);
            else XB_SPIN(xb_ld(&bar[XB_TOPGEN]) == tg, bar);
            __builtin_amdgcn_fence(__ATOMIC_ACQUIRE, "agent");
            xb_add(&bar[XB_XGEN(b.x)], 1u);
            asm volatile("s_waitcnt vmcnt(0)" ::: "memory");
        } else {
            XB_SPIN(xb_ld(&bar[XB_XGEN(b.x)]) == gen, bar);
            __builtin_amdgcn_fence(__ATOMIC_ACQUIRE, "agent");
            asm volatile("s_waitcnt vmcnt(0)" ::: "memory");
        }
    }
    __syncthreads();
}

constexpr size_t MiB = 1u << 20;
constexpr size_t al(size_t x) { return (x + 4095) & ~(size_t)4095; }
constexpr size_t WS_CTL = 0, CTL_ZERO_BYTES = 1 * MiB;
constexpr int CW_BAR = 4096;
constexpr int CW_CNT = 16384;
constexpr int CW_NT = 16384 + 512;
constexpr size_t WS_MOD = 1 * MiB;
constexpr size_t WS_TILE_E = WS_MOD + 256 * 1024;
constexpr size_t WS_PADSTART = WS_TILE_E + 16 * 1024;
constexpr size_t WS_ROWTOK = 2 * MiB;
constexpr size_t WS_EIDX = 4 * MiB;
constexpr size_t WS_GATE = 5 * MiB;
constexpr size_t WS_DEST = 6 * MiB;
constexpr size_t WS_WIN = 8 * MiB;
constexpr size_t WS_WLORA = WS_WIN + al((size_t)NP * D * 2);
constexpr size_t WS_WBRRW = WS_WLORA + al((size_t)NLORA * KLORA * 2);
constexpr size_t WS_WBRGLA = WS_WBRRW + al((size_t)D * RWW * 2);
constexpr size_t WS_WOUT = WS_WBRGLA + al((size_t)D * RWW * 2);
constexpr size_t WS_WROUTER = WS_WOUT + al((size_t)D * D * 2);
constexpr size_t WS_WGU = WS_WROUTER + al((size_t)NE * D * 2);
constexpr size_t WS_WD = WS_WGU + al((size_t)(NE + 1) * 512 * D * 2);
constexpr size_t WS_PERSIST_END = WS_WD + al((size_t)(NE + 1) * D * FF * 2);
constexpr size_t WS_REGB = WS_PERSIST_END;
constexpr size_t SZ512F = al((size_t)MR * RWW * 4), SZ256F = al((size_t)MR * 256 * 4), SZ512H = al((size_t)MR * RWW * 2);
constexpr size_t WS_A1 = WS_REGB;
constexpr size_t WS_A2 = WS_A1;
constexpr size_t WS_KSUM = WS_A2 + al((size_t)MR * KLORA * 2);
static_assert(WS_KSUM + SZ512H <= WS_A1 + al((size_t)MR * D * 2), "A2 + KSUM fit in the A1 slot");
constexpr size_t WS_P = WS_A1 + al((size_t)MR * D * 2);
constexpr size_t WS_RB = WS_P + al((size_t)MR * NP * 2);
constexpr size_t WS_VB = WS_RB + SZ512H, WS_KKB = WS_VB + SZ512H, WS_KMF = WS_KKB + SZ512H, WS_KMB = WS_KMF + SZ512H, WS_BVF = WS_KMB + SZ512H, WS_BVB = WS_BVF + SZ512H;
constexpr size_t WS_LWF = WS_BVB + SZ512H, WS_LWB = WS_LWF + SZ512F;
constexpr size_t SZ256H = al((size_t)MR * 256 * 2);
constexpr size_t WS_QGB = WS_LWB + SZ512F, WS_KGB = WS_QGB + SZ256H, WS_VGB = WS_KGB + SZ256H, WS_LAF = WS_VGB + SZ512H, WS_LAB = WS_LAF + SZ256F;
constexpr size_t WS_RWG = WS_LAB + SZ256F;
constexpr size_t WS_ORWF = WS_RWG + SZ512H, WS_ORWB = WS_ORWF + SZ512H, WS_OGLF = WS_ORWB + SZ512H, WS_OGLB = WS_OGLF + SZ512H;
constexpr int CH = 64, NCHUNK = (CTXL + SEQ) / CH, NU_RW = 64 * NCHUNK, NU_GL = 32 * NCHUNK;
constexpr size_t WS_RH = WS_OGLB + SZ512H;
constexpr size_t WS_YL = WS_RH + al((size_t)NU_RW * 4096 * 2);
constexpr size_t WS_HH = WS_YL + al((size_t)NU_RW * 4096 * 2);
constexpr size_t WS_INTRA = WS_HH + al((size_t)NU_RW * 4096 * 2);
constexpr size_t WS_KV = WS_INTRA + al((size_t)NU_GL * 8192 * 2);
constexpr size_t WS_DD = WS_KV + al((size_t)NU_GL * 8192 * 2);
constexpr size_t WS_END_MIX = WS_DD + al((size_t)NU_GL * 64 * 4);
constexpr size_t OUT_GT = 0, OUT_QE = (size_t)NU_RW * 4096 * 2;
static_assert(OUT_QE + (size_t)NU_GL * 4096 * 2 <= (size_t)NLAT * D * 4, "scan scratch fits in d_out");
constexpr size_t WS_YRW = WS_LWF, WS_YGLA = WS_LWB, WS_Z = WS_HH;
static_assert((size_t)NLAT * D * 2 <= (size_t)NU_RW * 4096 * 2, "Z fits in the HH slot");
constexpr size_t WS_X1 = WS_REGB;
constexpr size_t WS_A3 = WS_X1 + al((size_t)NLAT * D * 4);
constexpr size_t WS_LOGITS = WS_A3 + al((size_t)NLAT * D * 2);
constexpr size_t WS_ACT = WS_LOGITS + al((size_t)NLAT * NE * 4);
constexpr size_t WS_Y = WS_ACT + al((size_t)NROWS_E * FF * 2);
constexpr size_t WS_A3F = WS_Y + al((size_t)NROWS_E * D);
constexpr size_t WS_END_MOE = WS_A3F + al((size_t)NLAT * D);
constexpr size_t WS_END = WS_END_MIX > WS_END_MOE ? WS_END_MIX : WS_END_MOE;
static_assert(WS_END <= (size_t)2048 * MiB, "workspace map exceeds 2 GiB");

constexpr int RING_BYTES = 131072;
constexpr int IDX_BYTES = pg8::IDX_UNITS * 256 * 4;
constexpr int MISC_OFF = RING_BYTES + IDX_BYTES;
constexpr int LDS_BYTES = MISC_OFF + 256;
static_assert(pg8::IDX_OFF == RING_BYTES, "gather table sits right above the stage buffers");
constexpr int NWAVES = 8, NTHR = 512;

struct Args { const float* in[36]; float* out; unsigned char* ws; int ph_lo, ph_hi; };

struct Frame {
    LAS unsigned char* lds;
    int tid, lane, wave, G, gw, NGW;
    const float* const* in; float* out; unsigned char* ws; unsigned* ctl;
};

__device__ __forceinline__ float wave_sum(float v) {
#pragma unroll
    for (int o = 1; o < 64; o <<= 1) v += __shfl_xor(v, o);
    return v;
}
__device__ __forceinline__ unsigned f2bf(float f) { unsigned u = __builtin_bit_cast(unsigned, f); return (u + 0x7fffu + ((u >> 16) & 1u)) >> 16; }
typedef __bf16 bf16x2v __attribute__((ext_vector_type(2)));
__device__ __forceinline__ unsigned pk2(float lo, float hi) { const f32x2 v = {lo, hi}; return __builtin_bit_cast(unsigned, __builtin_convertvector(v, bf16x2v)); }
__device__ __forceinline__ float bflo(unsigned w) { return __builtin_bit_cast(float, w << 16); }
__device__ __forceinline__ float bfhi(unsigned w) { return __builtin_bit_cast(float, w & 0xffff0000u); }
__device__ __forceinline__ float sigmoidf_(float x) { return 1.0f / (1.0f + __expf(-x)); }
__device__ __forceinline__ float siluf_(float x) { return x / (1.0f + __expf(-x)); }

__device__ __forceinline__ void ln_stats(const f32x4 (&v)[4], float& mean, float& rstd) {
    float s = 0.f;
#pragma unroll
    for (int j = 0; j < 4; ++j) s += (v[j].x + v[j].y) + (v[j].z + v[j].w);
    mean = wave_sum(s) * (1.f / D); float s2 = 0.f;
#pragma unroll
    for (int j = 0; j < 4; ++j) { const f32x4 d = v[j] - mean; s2 += (d.x * d.x + d.y * d.y) + (d.z * d.z + d.w * d.w); }
    rstd = 1.f / sqrtf(wave_sum(s2) * (1.f / D) + LN_EPS);
}

__device__ __forceinline__ unsigned pack_fp8x4(const f32x4 v) {
    int w = __builtin_amdgcn_cvt_pk_fp8_f32(__builtin_amdgcn_fmed3f(v[0], -448.f, 448.f), __builtin_amdgcn_fmed3f(v[1], -448.f, 448.f), 0, false);
    return (unsigned)__builtin_amdgcn_cvt_pk_fp8_f32(__builtin_amdgcn_fmed3f(v[2], -448.f, 448.f), __builtin_amdgcn_fmed3f(v[3], -448.f, 448.f), w, true); }
__device__ __forceinline__ void ld_row_bf16(const bf16* row, int lane, f32x4 (&v)[4]) {
    const v4u a = *(const v4u*)(row + 8 * lane), b = *(const v4u*)(row + 512 + 8 * lane);
    v[0] = (f32x4){bflo(a.x), bfhi(a.x), bflo(a.y), bfhi(a.y)}; v[1] = (f32x4){bflo(a.z), bfhi(a.z), bflo(a.w), bfhi(a.w)};
    v[2] = (f32x4){bflo(b.x), bfhi(b.x), bflo(b.y), bfhi(b.y)}; v[3] = (f32x4){bflo(b.z), bfhi(b.z), bflo(b.w), bfhi(b.w)};
}
__device__ __forceinline__ int rowcol(int lane, int j) { return 512 * (j >> 1) + 8 * lane + 4 * (j & 1); }
__device__ __forceinline__ void ph_x1pre_nomix(Frame& F) {
    const float* x = F.in[0];
    for (int m = F.gw; m < NLAT; m += F.NGW) {
        bf16* o = (bf16*)(F.ws + WS_X1) + (size_t)m * D;
#pragma unroll
        for (int h = 0; h < 2; ++h) { const float* xr = x + (size_t)m * D + 512 * h + 8 * F.lane; const f32x4 a = *(const f32x4*)xr * ALPHA, b = *(const f32x4*)(xr + 4) * ALPHA;
            v4u w; w.x = pk2(a.x, a.y); w.y = pk2(a.z, a.w); w.z = pk2(b.x, b.y); w.w = pk2(b.z, b.w); *(v4u*)(o + 512 * h + 8 * F.lane) = w; }
    }
}
__device__ __forceinline__ void ph_ln1(Frame& F) {
    const float* lw = F.in[26]; const float* lb = F.in[27]; const float* mod = (const float*)(F.ws + WS_MOD);
    bf16* A3 = (bf16*)(F.ws + WS_A3); const bf16* X1P = (const bf16*)(F.ws + WS_X1);
    constexpr int NR = 4;
    for (int m0 = F.gw; m0 < NLAT; m0 += NR * F.NGW) {
        v4u w[NR][2];
#pragma unroll
        for (int r = 0; r < NR; ++r) { const int mm = m0 + r * F.NGW; const bf16* row = X1P + (size_t)(mm < NLAT ? mm : m0) * D; w[r][0] = *(const v4u*)(row + 8 * F.lane); w[r][1] = *(const v4u*)(row + 512 + 8 * F.lane); }
        __builtin_amdgcn_sched_barrier(0);
#pragma unroll
        for (int r = 0; r < NR; ++r) { const int mm = m0 + r * F.NGW; const int m = mm < NLAT ? mm : m0; const int b = m / SEQ;
            f32x4 v[4];
            v[0] = (f32x4){bflo(w[r][0].x), bfhi(w[r][0].x), bflo(w[r][0].y), bfhi(w[r][0].y)}; v[1] = (f32x4){bflo(w[r][0].z), bfhi(w[r][0].z), bflo(w[r][0].w), bfhi(w[r][0].w)};
            v[2] = (f32x4){bflo(w[r][1].x), bfhi(w[r][1].x), bflo(w[r][1].y), bfhi(w[r][1].y)}; v[3] = (f32x4){bflo(w[r][1].z), bfhi(w[r][1].z), bflo(w[r][1].w), bfhi(w[r][1].w)};
            float mean, rstd; ln_stats(v, mean, rstd);
#if MS >= 2
            f32x4 h[4];
#pragma unroll
            for (int j = 0; j < 4; ++j) { const int c = rowcol(F.lane, j);
                const f32x4 x1 = (v[j] - mean) * rstd * *(const f32x4*)(lw + c) + *(const f32x4*)(lb + c);
                h[j] = x1 * (*(const f32x4*)(mod + b * 6144 + 4096 + c) + 1.0f) + *(const f32x4*)(mod + b * 6144 + 3072 + c); }
            bf16* ao = A3 + (size_t)m * D;
            { v4u o; o.x = pk2(h[0].x, h[0].y); o.y = pk2(h[0].z, h[0].w); o.z = pk2(h[1].x, h[1].y); o.w = pk2(h[1].z, h[1].w); *(v4u*)(ao + 8 * F.lane) = o;
              o.x = pk2(h[2].x, h[2].y); o.y = pk2(h[2].z, h[2].w); o.z = pk2(h[3].x, h[3].y); o.w = pk2(h[3].z, h[3].w); *(v4u*)(ao + 512 + 8 * F.lane) = o; }
            { unsigned char* af = F.ws + WS_A3F + (size_t)m * D; v2u o8;
              o8.x = pack_fp8x4(h[0]); o8.y = pack_fp8x4(h[1]); *(v2u*)(af + 8 * F.lane) = o8; o8.x = pack_fp8x4(h[2]); o8.y = pack_fp8x4(h[3]); *(v2u*)(af + 512 + 8 * F.lane) = o8; }
#endif
        }
    }
}
__device__ __forceinline__ f32x4 fp8x4(unsigned w) { const f32x2 lo = __builtin_amdgcn_cvt_pk_f32_fp8((int)w, false), hi = __builtin_amdgcn_cvt_pk_f32_fp8((int)w, true); return (f32x4){lo.x, lo.y, hi.x, hi.y}; }
__device__ __forceinline__ void ph_final(Frame& F) {
    const float* lw = F.in[34]; const float* lb = F.in[35]; const float* mod = (const float*)(F.ws + WS_MOD);
    const float* lw1 = F.in[26]; const float* lb1 = F.in[27]; const bf16* X1P = (const bf16*)(F.ws + WS_X1);
    const unsigned char* Y = F.ws + WS_Y; const int* DEST = (const int*)(F.ws + WS_DEST); const float* GATE = (const float*)(F.ws + WS_GATE);
    const int c0 = 16 * F.lane;
    for (int m0 = F.gw; m0 < NLAT; m0 += 2 * F.NGW) {
        int mm[2]; mm[0] = m0; mm[1] = (m0 + F.NGW < NLAT) ? m0 + F.NGW : m0;
        v4u xw[2][2];
#if MS >= 2
        v4u dw[2][2]; f32x4 gw[2][2];
#pragma unroll
        for (int r = 0; r < 2; ++r) { dw[r][0] = *(const v4u*)(DEST + mm[r] * 8); dw[r][1] = *(const v4u*)(DEST + mm[r] * 8 + 4); gw[r][0] = *(const f32x4*)(GATE + mm[r] * 8); gw[r][1] = *(const f32x4*)(GATE + mm[r] * 8 + 4); }
#endif
#pragma unroll
        for (int r = 0; r < 2; ++r) { const bf16* row = X1P + (size_t)mm[r] * D + c0; xw[r][0] = *(const v4u*)row; xw[r][1] = *(const v4u*)(row + 8); }
#if MS >= 2
        v4u yw[2][TOPK + 1];
#pragma unroll
        for (int r = 0; r < 2; ++r) {
            int dr[TOPK]; dr[0] = (int)dw[r][0].x; dr[1] = (int)dw[r][0].y; dr[2] = (int)dw[r][0].z; dr[3] = (int)dw[r][0].w; dr[4] = (int)dw[r][1].x; dr[5] = (int)dw[r][1].y; dr[6] = (int)dw[r][1].z; dr[7] = (int)dw[r][1].w;
#pragma unroll
            for (int k = 0; k <= TOPK; ++k) yw[r][k] = *(const v4u*)(Y + (size_t)(k < TOPK ? dr[k < TOPK ? k : 0] : SH_ROW0 + mm[r]) * D + c0); }
        __builtin_amdgcn_sched_barrier(0);
#endif
#pragma unroll
        for (int r = 0; r < 2; ++r) { const int m = mm[r]; const int b = m / SEQ;
            f32x4 v[4];
            v[0] = (f32x4){bflo(xw[r][0].x), bfhi(xw[r][0].x), bflo(xw[r][0].y), bfhi(xw[r][0].y)}; v[1] = (f32x4){bflo(xw[r][0].z), bfhi(xw[r][0].z), bflo(xw[r][0].w), bfhi(xw[r][0].w)};
            v[2] = (f32x4){bflo(xw[r][1].x), bfhi(xw[r][1].x), bflo(xw[r][1].y), bfhi(xw[r][1].y)}; v[3] = (f32x4){bflo(xw[r][1].z), bfhi(xw[r][1].z), bflo(xw[r][1].w), bfhi(xw[r][1].w)};
            { float mean1, rstd1; ln_stats(v, mean1, rstd1);
#pragma unroll
              for (int j = 0; j < 4; ++j) { const int c = c0 + 4 * j; v[j] = ((v[j] - mean1) * rstd1 * *(const f32x4*)(lw1 + c) + *(const f32x4*)(lb1 + c)) * ALPHA; } }
#if MS >= 2
            const float gt[TOPK] = {gw[r][0].x * 0.0625f, gw[r][0].y * 0.0625f, gw[r][0].z * 0.0625f, gw[r][0].w * 0.0625f, gw[r][1].x * 0.0625f, gw[r][1].y * 0.0625f, gw[r][1].z * 0.0625f, gw[r][1].w * 0.0625f};
#pragma unroll
            for (int j = 0; j < 4; ++j) { const unsigned ws8 = j == 0 ? yw[r][TOPK].x : (j == 1 ? yw[r][TOPK].y : (j == 2 ? yw[r][TOPK].z : yw[r][TOPK].w));
                f32x4 mo = fp8x4(ws8) * 0.0625f;
#pragma unroll
                for (int k = 0; k < TOPK; ++k) { const unsigned wk = j == 0 ? yw[r][k].x : (j == 1 ? yw[r][k].y : (j == 2 ? yw[r][k].z : yw[r][k].w)); mo += fp8x4(wk) * gt[k]; }
                v[j] += *(const f32x4*)(mod + b * 6144 + 5120 + c0 + 4 * j) * mo; }
#endif
            float mean, rstd; ln_stats(v, mean, rstd);
            float* o = F.out + (size_t)m * D + c0;
#pragma unroll
            for (int j = 0; j < 4; ++j) { const int c = c0 + 4 * j; *(f32x4*)(o + 4 * j) = (v[j] - mean) * rstd * *(const f32x4*)(lw + c) + *(const f32x4*)(lb + c); }
        }
    }
}


#if MS >= 2
template <int MODE, bool FP8 = false>
__device__ __forceinline__ void cvt_item(const float* W, int Nsrc, int nblk, bf16* WT, int row_off, int dpitch, LAS float* scr, int item, int lane) {
    const int kb = item / nblk, nb = item - kb * nblk, k0 = 64 * kb, n0 = 32 * nb;
    const int nn = n0 + (lane & 31);
#pragma unroll 8
    for (int i = 0; i < 32; ++i) { const int kk = 2 * i + (lane >> 5); scr[kk * 33 + (lane & 31)] = (nn < Nsrc) ? W[(size_t)(k0 + kk) * Nsrc + nn] : 0.f; }
    LDS_WAIT(); asm volatile("" ::: "memory");
    const int c = lane & 7;
#pragma unroll
    for (int j = 0; j < 4; ++j) { const int n = (lane >> 3) + 8 * j; const LAS float* s = scr + (8 * c) * 33 + n;
        v4u o; o.x = pk2(s[0 * 33], s[1 * 33]); o.y = pk2(s[2 * 33], s[3 * 33]); o.z = pk2(s[4 * 33], s[5 * 33]); o.w = pk2(s[6 * 33], s[7 * 33]);
        const int ng = n0 + n; int dr = ng;
        if (MODE == 1) { const int i2 = ng & 255; dr = 8 * (i2 >> 2) + (i2 & 3) + ((ng >= 256) ? 4 : 0); }
        if constexpr (FP8) { v2u o8; o8.x = pack_fp8x4((f32x4){s[0 * 33], s[1 * 33], s[2 * 33], s[3 * 33]} * W8S); o8.y = pack_fp8x4((f32x4){s[4 * 33], s[5 * 33], s[6 * 33], s[7 * 33]} * W8S);
            *(v2u*)((unsigned char*)WT + (size_t)(row_off + dr) * dpitch + k0 + 8 * c) = o8; }
        else *(v4u*)(WT + (size_t)(row_off + dr) * dpitch + k0 + 8 * c) = o; }
    LDS_WAIT(); asm volatile("" ::: "memory");
}

template <int MODE>
__device__ __forceinline__ void cvt_item_reg(const float* W, int Nsrc, bf16* WT, int row_off, int dpitch, int k0, int n0, int lane) {
    const float* src = W + (size_t)k0 * Nsrc + n0 + 4 * lane;
    f32x4 v[32];
#pragma unroll
    for (int i = 0; i < 32; ++i) v[i] = __builtin_nontemporal_load((const f32x4*)(src + (size_t)i * Nsrc));
#pragma unroll
    for (int j = 0; j < 4; ++j) {
        const int ng = n0 + 4 * lane + j; int dr = ng;
        if (MODE == 1) { const int i2 = ng & 255; dr = 8 * (i2 >> 2) + (i2 & 3) + ((ng >= 256) ? 4 : 0); }
        v4u* dst = (v4u*)(WT + (size_t)(row_off + dr) * dpitch + k0);
#pragma unroll
        for (int q = 0; q < 4; ++q) { v4u o; o.x = pk2(v[8 * q][j], v[8 * q + 1][j]); o.y = pk2(v[8 * q + 2][j], v[8 * q + 3][j]); o.z = pk2(v[8 * q + 4][j], v[8 * q + 5][j]); o.w = pk2(v[8 * q + 6][j], v[8 * q + 7][j]); dst[q] = o; }
    }
}

constexpr int CVK = 32;
__device__ __forceinline__ void cvt_reg_load(const float* W, int Nsrc, int k0, int n0, int lane, f32x4 (&v)[CVK]) {
    const float* src = W + (size_t)k0 * Nsrc + n0 + 4 * lane;
#pragma unroll
    for (int i = 0; i < CVK; ++i) v[i] = __builtin_nontemporal_load((const f32x4*)(src + (size_t)i * Nsrc));
}
template <int MODE, bool FP8 = false>
__device__ __forceinline__ void cvt_reg_store(bf16* WT, int row_off, int dpitch, int k0, int n0, int lane, const f32x4 (&v)[CVK]) {
#pragma unroll
    for (int j = 0; j < 4; ++j) {
        const int ng = n0 + 4 * lane + j; int dr = ng;
        if (MODE == 1) { const int i2 = ng & 255; dr = 8 * (i2 >> 2) + (i2 & 3) + ((ng >= 256) ? 4 : 0); }
        if constexpr (FP8) { v4u* dst8 = (v4u*)((unsigned char*)WT + (size_t)(row_off + dr) * dpitch + k0);
#pragma unroll
            for (int q = 0; q < CVK / 16; ++q) { v4u o;
                o.x = pack_fp8x4((f32x4){v[16 * q][j], v[16 * q + 1][j], v[16 * q + 2][j], v[16 * q + 3][j]} * W8S); o.y = pack_fp8x4((f32x4){v[16 * q + 4][j], v[16 * q + 5][j], v[16 * q + 6][j], v[16 * q + 7][j]} * W8S);
                o.z = pack_fp8x4((f32x4){v[16 * q + 8][j], v[16 * q + 9][j], v[16 * q + 10][j], v[16 * q + 11][j]} * W8S); o.w = pack_fp8x4((f32x4){v[16 * q + 12][j], v[16 * q + 13][j], v[16 * q + 14][j], v[16 * q + 15][j]} * W8S); dst8[q] = o; }
            continue; }
        v4u* dst = (v4u*)(WT + (size_t)(row_off + dr) * dpitch + k0);
#pragma unroll
        for (int q = 0; q < CVK / 8; ++q) { v4u o; o.x = pg8::cvt_pk_bf16(v[8 * q][j], v[8 * q + 1][j]); o.y = pg8::cvt_pk_bf16(v[8 * q + 2][j], v[8 * q + 3][j]); o.z = pg8::cvt_pk_bf16(v[8 * q + 4][j], v[8 * q + 5][j]); o.w = pg8::cvt_pk_bf16(v[8 * q + 6][j], v[8 * q + 7][j]); dst[q] = o; }
    }
}
constexpr int CV_GU = (D / CVK) * 2, CV_DN = (FF / CVK) * 4, CV_NGU = (NE + 1) * CV_GU, CV_NITEM = CV_NGU + (NE + 1) * CV_DN;
__device__ __forceinline__ void cvx_load(const float* const* in, int it, int lane, f32x4 (&v)[CVK]) {
    if (it < CV_NGU) { const int e = it / CV_GU, ii = it - e * CV_GU; const float* src = (e < NE) ? in[30] + (size_t)e * D * 512 : in[32];
        cvt_reg_load(src, 512, CVK * (ii >> 1), 256 * (ii & 1), lane, v); }
    else { const int r = it - CV_NGU, e = r / CV_DN, ii = r - e * CV_DN; const float* src = (e < NE) ? in[31] + (size_t)e * FF * D : in[33];
        cvt_reg_load(src, D, CVK * (ii >> 2), 256 * (ii & 3), lane, v); }
}
__device__ __forceinline__ void cvx_store(unsigned char* ws, int it, int lane, const f32x4 (&v)[CVK]) {
    if (it < CV_NGU) { const int e = it / CV_GU, ii = it - e * CV_GU; cvt_reg_store<1, true>((bf16*)(ws + WS_WGU), e * 512, D, CVK * (ii >> 1), 256 * (ii & 1), lane, v); }
    else { const int r = it - CV_NGU, e = r / CV_DN, ii = r - e * CV_DN; cvt_reg_store<0, true>((bf16*)(ws + WS_WD), e * D, FF, CVK * (ii >> 2), 256 * (ii & 3), lane, v); }
}

#if MS >= 3
__device__ __forceinline__ float lora_val(const float* const* in, int n, int k) {
    if (n < 1024) { const int q = n >> 3, e8 = n & 7, dir = e8 >> 2, ch = q * 4 + (e8 & 3); return (k < 32) ? in[9][(size_t)(dir * 32 + k) * 512 + ch] : 0.f; }
    if (n < 2048) { const int m = n - 1024, q = m >> 3, e8 = m & 7, dir = e8 >> 2, ch = q * 4 + (e8 & 3); return (k >= 32 && k < 64) ? in[11][(size_t)(dir * 32 + (k - 32)) * 512 + ch] : 0.f; }
    if (n < 2560) { const int ch = n - 2048; return (k >= 64 && k < 160) ? in[12][(size_t)(k - 64) * 512 + ch] : 0.f; }
    { const int m = n - 2560, q = m >> 3, e8 = m & 7, dir = e8 >> 2, ch = q * 4 + (e8 & 3); return (k >= 160 && k < 176) ? in[19][(size_t)(dir * 16 + (k - 160)) * 256 + ch] : 0.f; }
}
#endif

__device__ __forceinline__ void ph_prologue(Frame& F) {
    {
        const float* c = F.in[1]; const float* cc = F.in[3]; const float* wa = F.in[4]; const float* ba = F.in[5];
        float* MOD = (float*)(F.ws + WS_MOD);
        LAS float* S = (LAS float*)F.lds; LAS float* red = (LAS float*)(F.lds + 32768);
        for (int it = blockIdx.x; it < 96; it += F.G) {
            for (int i = F.tid; i < 5120; i += NTHR) { const int r = i >> 10, k = i & 1023; const float cv = r < 4 ? c[r * 1024 + k] : cc[k]; S[i] = siluf_(cv); }
            __syncthreads();
            const int n = it * 64 + F.lane; float acc[5] = {0.f, 0.f, 0.f, 0.f, 0.f};
            for (int kk = 0; kk < 128; ++kk) { const int k = F.wave * 128 + kk; const float wv = wa[(size_t)k * 6144 + n];
#pragma unroll
                for (int r = 0; r < 5; ++r) acc[r] += S[r * 1024 + k] * wv; }
#pragma unroll
            for (int r = 0; r < 5; ++r) red[(F.wave * 5 + r) * 64 + F.lane] = acc[r];
            __syncthreads();
            if (F.wave == 0) {
#pragma unroll
                for (int r = 0; r < 5; ++r) { float s = 0.f;
#pragma unroll
                    for (int w = 0; w < 8; ++w) s += red[(w * 5 + r) * 64 + F.lane];
                    MOD[r * 6144 + n] = s + ba[n]; }
            }
            __syncthreads();
        }
    }
    {
        LAS float* scr = (LAS float*)(F.lds + F.wave * 16384);
        constexpr int I_IN = 16 * 168, I_BR = 8 * 32, I_OUT = 16 * 32, I_RT = 16 * 8, I_GU = 32 * 2, I_DN = 8 * 4;
        constexpr int T0 = I_IN, T1 = T0 + I_BR, T2 = T1 + I_BR, T3 = T2 + I_OUT, T4 = T3 + I_RT, T5 = T4 + (NE + 1) * I_GU, T6 = T5 + (NE + 1) * I_DN;
        unsigned char* ws = F.ws;
        for (int it = F.gw; it < T6; it += F.NGW) {
#if MS >= 3
            if (it < T0) { cvt_item<0, true>(F.in[6], IN_COLS, 168, (bf16*)(ws + WS_WIN), 0, D, scr, it, F.lane); continue; }
            if (it < T1) { cvt_item<0>(F.in[23], D, 32, (bf16*)(ws + WS_WBRRW), 0, RWW, scr, it - T0, F.lane); continue; }
            if (it < T2) { cvt_item<0>(F.in[24], D, 32, (bf16*)(ws + WS_WBRGLA), 0, RWW, scr, it - T1, F.lane); continue; }
            if (it < T3) { cvt_item<0>(F.in[25], D, 32, (bf16*)(ws + WS_WOUT), 0, D, scr, it - T2, F.lane); continue; }
#else
            if (it < T3) continue;
#endif
            if (it < T4) { cvt_item<0>(F.in[28], NE, 8, (bf16*)(ws + WS_WROUTER), 0, D, scr, it - T3, F.lane); continue; }
#if MS >= 3
            break;
#endif
            if (it < T5) { const int r = it - T4, e = r / I_GU, ii = r - e * I_GU;
                const float* src = (e < NE) ? F.in[30] + (size_t)e * D * 512 : F.in[32];
                cvt_item_reg<1>(src, 512, (bf16*)(ws + WS_WGU), e * 512, D, 32 * (ii >> 1), 256 * (ii & 1), F.lane); continue; }
            { const int r = it - T5, e = r / I_DN, ii = r - e * I_DN;
                const float* src = (e < NE) ? F.in[31] + (size_t)e * FF * D : F.in[33];
                cvt_item_reg<0>(src, D, (bf16*)(ws + WS_WD), e * D, FF, 32 * (ii >> 2), 256 * (ii & 3), F.lane); }
        }
    }
#if MS >= 3
    {
        bf16* WL = (bf16*)(F.ws + WS_WLORA);
        for (int idx = blockIdx.x * NTHR + F.tid; idx < NLORA * (KLORA / 8); idx += F.G * NTHR) {
            const int n = idx >> 5, k0 = (idx & 31) * 8; float v[8];
#pragma unroll
            for (int e = 0; e < 8; ++e) v[e] = lora_val(F.in, n, k0 + e);
            v4u o; o.x = pk2(v[0], v[1]); o.y = pk2(v[2], v[3]); o.z = pk2(v[4], v[5]); o.w = pk2(v[6], v[7]);
            *(v4u*)(WL + (size_t)n * KLORA + k0) = o;
        }
    }
#endif
}

struct EpiF32 {
    static constexpr bool PERM = false;
    float* C; int ldc;
    __device__ __forceinline__ void operator()(const f32x4 (&acc)[2][2][4][2], const pg8::Unit& u, int wr, int wc, int fr, int fq) const {
        const int row0 = u.pm * 256 + wr * 64 + fr, col0 = u.pn * 256 + wc * 32 + 4 * fq;
#pragma unroll
        for (int ai = 0; ai < 2; ++ai)
#pragma unroll
            for (int m = 0; m < 4; ++m) { float* rowp = C + (size_t)(row0 + ai * 128 + m * 16) * ldc + col0;
#pragma unroll
                for (int bj = 0; bj < 2; ++bj)
#pragma unroll
                    for (int n = 0; n < 2; ++n) *(f32x4*)(rowp + bj * 128 + n * 16) = acc[ai][bj][m][n]; }
    }
};
struct EpiSwiglu {
    static constexpr bool PERM = true;
    unsigned char* ACT;
    __device__ __forceinline__ void operator()(const f32x4 (&acc)[2][2][4][2], const pg8::Unit& u, int wr, int wc, int fr, int fq) const {
        const int row0 = u.pm * 256 + wr * 64 + fr, h0 = u.j * 128 + wc * 16 + 4 * fq;
#pragma unroll
        for (int ai = 0; ai < 2; ++ai)
#pragma unroll
            for (int m = 0; m < 4; ++m) { unsigned char* rowp = ACT + (size_t)(row0 + ai * 128 + m * 16) * FF + h0;
#pragma unroll
                for (int bj = 0; bj < 2; ++bj) { const f32x4 a = acc[ai][bj][m][0] * W8I, b = acc[ai][bj][m][1] * W8I;
                    *(unsigned*)(rowp + bj * 64) = pack_fp8x4((f32x4){siluf_(a[0]) * b[0], siluf_(a[1]) * b[1], siluf_(a[2]) * b[2], siluf_(a[3]) * b[3]}); } }
    }
};
struct EpiRowsBf16 {
    static constexpr bool PERM = true;
    bf16* O; int ldc; float sc;
    __device__ __forceinline__ void operator()(const f32x4 (&acc)[2][2][4][2], const pg8::Unit& u, int wr, int wc, int fr, int fq) const {
        const int row0 = u.pm * 256 + wr * 64 + fr, col0 = u.j * 256 + wc * 32 + 8 * fq;
#pragma unroll
        for (int ai = 0; ai < 2; ++ai)
#pragma unroll
            for (int m = 0; m < 4; ++m) { bf16* rowp = O + (size_t)(row0 + ai * 128 + m * 16) * ldc + col0;
#pragma unroll
                for (int bj = 0; bj < 2; ++bj) { const f32x4 v0 = acc[ai][bj][m][0] * sc, v1 = acc[ai][bj][m][1] * sc;
                    v4u w; w.x = pg8::cvt_pk_bf16(v0[0], v0[1]); w.y = pg8::cvt_pk_bf16(v0[2], v0[3]); w.z = pg8::cvt_pk_bf16(v1[0], v1[1]); w.w = pg8::cvt_pk_bf16(v1[2], v1[3]);
                    *(v4u*)(rowp + bj * 128) = w;
#ifdef PROBE_ST2
                    asm volatile("" ::: "memory"); *(volatile v4u*)(rowp + bj * 128) = w;
#endif
                    } }
    }
};

struct EpiRowsFp8 {
    static constexpr bool PERM = true;
    unsigned char* O;
    __device__ __forceinline__ void operator()(const f32x4 (&acc)[2][2][4][2], const pg8::Unit& u, int wr, int wc, int fr, int fq) const {
        const int row0 = u.pm * 256 + wr * 64 + fr, col0 = u.j * 256 + wc * 32 + 8 * fq;
#pragma unroll
        for (int ai = 0; ai < 2; ++ai)
#pragma unroll
            for (int m = 0; m < 4; ++m) { unsigned char* rowp = O + (size_t)(row0 + ai * 128 + m * 16) * D + col0;
#pragma unroll
                for (int bj = 0; bj < 2; ++bj) { f32x4 v0 = acc[ai][bj][m][0] * (16.0f * W8I), v1 = acc[ai][bj][m][1] * (16.0f * W8I);
#pragma unroll
                    for (int e = 0; e < 4; ++e) { v0[e] = __builtin_amdgcn_fmed3f(v0[e], -448.0f, 448.0f); v1[e] = __builtin_amdgcn_fmed3f(v1[e], -448.0f, 448.0f); }
                    int w0 = __builtin_amdgcn_cvt_pk_fp8_f32(v0[0], v0[1], 0, false); w0 = __builtin_amdgcn_cvt_pk_fp8_f32(v0[2], v0[3], w0, true);
                    int w1 = __builtin_amdgcn_cvt_pk_fp8_f32(v1[0], v1[1], 0, false); w1 = __builtin_amdgcn_cvt_pk_fp8_f32(v1[2], v1[3], w1, true);
                    v2u w; w.x = (unsigned)w0; w.y = (unsigned)w1; *(v2u*)(rowp + bj * 128) = w; } }
    }
};

__device__ __forceinline__ void ph_router(Frame& F) {
    pg8::Gemm g{(const bf16*)(F.ws + WS_A3), (const bf16*)(F.ws + WS_WROUTER), NLAT, NE, D, nullptr};
    pg8::StaticOrder S; S.init(NLAT, NE, F.G, (int)blockIdx.x);
    EpiF32 E{(float*)(F.ws + WS_LOGITS), NE};
    pg8::gemm_phase<EpiF32, pg8::StaticOrder, true, true, false>(F.lds, g, S, E);
}

__device__ __forceinline__ void ph_route(Frame& F) {
    const float* LOG = (const float*)(F.ws + WS_LOGITS); const float* rb = F.in[29];
    int* EIDX = (int*)(F.ws + WS_EIDX); float* GATE = (float*)(F.ws + WS_GATE); int* DEST = (int*)(F.ws + WS_DEST);
    unsigned* CNT = F.ctl + CW_CNT;
    const f32x4 bias = *(const f32x4*)(rb + 4 * F.lane);
    const float NEG = -3.0e38f;
    f32x4 lgn = *(const f32x4*)(LOG + (size_t)(F.gw < NLAT ? F.gw : 0) * NE + 4 * F.lane);
    for (int m = F.gw; m < NLAT; m += F.NGW) {
        const f32x4 lg = lgn;
        { const int mn = (m + F.NGW < NLAT) ? m + F.NGW : m; lgn = *(const f32x4*)(LOG + (size_t)mn * NE + 4 * F.lane); }
        float sc[4], sel[4];
#pragma unroll
        for (int i = 0; i < 4; ++i) { sc[i] = sigmoidf_(lg[i]); sel[i] = sc[i] + bias[i]; }
        float m1 = fmaxf(sel[0], sel[1]), m2 = fminf(sel[0], sel[1]);
        { const float a = sel[2]; const float n1 = fmaxf(m1, a); m2 = fmaxf(m2, fminf(m1, a)); m1 = n1; }
        { const float a = sel[3]; const float n1 = fmaxf(m1, a); m2 = fmaxf(m2, fminf(m1, a)); m1 = n1; }
#pragma unroll
        for (int o = 1; o < 8; o <<= 1) { const float b1 = __shfl_xor(m1, o), b2 = __shfl_xor(m2, o); const float n1 = fmaxf(m1, b1); m2 = fmaxf(fminf(m1, b1), fmaxf(m2, b2)); m1 = n1; }
        const float gs = m1 + m2; const int g = F.lane >> 3;
        int rank = 0;
#pragma unroll
        for (int gg = 0; gg < 8; ++gg) { const float og = __shfl(gs, gg * 8); rank += (og > gs || (og == gs && gg < g)) ? 1 : 0; }
        const bool keep = rank < 4;
#pragma unroll
        for (int i = 0; i < 4; ++i) sel[i] = keep ? sel[i] : NEG;
        int my_e = 0; float my_s = 0.f; float ssum = 0.f;
        for (int k = 0; k < TOPK; ++k) {
            float bv = sel[0]; int bi = 0;
#pragma unroll
            for (int i = 1; i < 4; ++i) if (sel[i] > bv) { bv = sel[i]; bi = i; }
            int be = 4 * F.lane + bi; float v = bv; int e = be;
#pragma unroll
            for (int o = 1; o < 64; o <<= 1) { const float ov = __shfl_xor(v, o); const int oe = __shfl_xor(e, o); if (ov > v || (ov == v && oe < e)) { v = ov; e = oe; } }
            const int owner = e >> 2, oi = e & 3;
            float s_own = 0.f;
            if (F.lane == owner) {
#pragma unroll
                for (int i = 0; i < 4; ++i) if (i == oi) { s_own = sc[i]; sel[i] = NEG; }
            }
            const float s = __shfl(s_own, owner);
            ssum += s;
            if (F.lane == k) { my_e = e; my_s = s; }
        }
        if (F.lane < TOPK) {
            const unsigned pos = __hip_atomic_fetch_add(CNT + my_e, 1u, __ATOMIC_RELAXED, __HIP_MEMORY_SCOPE_AGENT);
            EIDX[m * 8 + F.lane] = my_e; GATE[m * 8 + F.lane] = my_s / ssum * 2.5f; DEST[m * 8 + F.lane] = (int)pos;
        }
    }
}

__device__ __forceinline__ void ph_scatter(Frame& F) {
    LAS int* tstart = (LAS int*)F.lds;
    LAS int* scan = (LAS int*)(F.lds + 2048);
    LAS int* cnts = (LAS int*)(F.lds + 4096);
    int* EIDX = (int*)(F.ws + WS_EIDX); int* DEST = (int*)(F.ws + WS_DEST); int* ROWTOK = (int*)(F.ws + WS_ROWTOK); int* TILE_E = (int*)(F.ws + WS_TILE_E);
    unsigned* CNT = F.ctl + CW_CNT;
    int tiles = 0, cnt = 0;
    if (F.tid < NE) { cnt = (int)__hip_atomic_load(CNT + F.tid, __ATOMIC_RELAXED, __HIP_MEMORY_SCOPE_AGENT); tiles = (cnt + 255) >> 8; scan[F.tid] = tiles; cnts[F.tid] = cnt; }
    __syncthreads();
    for (int o = 1; o < NE; o <<= 1) { int v = 0; if (F.tid < NE && F.tid >= o) v = scan[F.tid - o]; __syncthreads(); if (F.tid < NE) scan[F.tid] += v; __syncthreads(); }
    if (F.tid < NE) { tstart[F.tid + 1] = scan[F.tid]; if (F.tid == 0) tstart[0] = 0; }
    __syncthreads();
    const int NT = tstart[NE];
    if (blockIdx.x == 0) {
        if (F.tid == 0) F.ctl[CW_NT] = (unsigned)NT;
        if (F.tid < NE) for (int t = tstart[F.tid]; t < tstart[F.tid + 1]; ++t) TILE_E[t] = F.tid;
    }
    for (int e = blockIdx.x; e < NE; e += F.G) { const int c0 = cnts[e], c1 = (tstart[e + 1] - tstart[e]) * 256, base = tstart[e] * 256;
        for (int p = c0 + F.tid; p < c1; p += NTHR) ROWTOK[base + p] = 0; }
    for (int i = blockIdx.x * NTHR + F.tid; i < NLAT; i += F.G * NTHR) ROWTOK[SH_ROW0 + i] = i;
    for (int i = blockIdx.x * NTHR + F.tid; i < NLAT * TOPK; i += F.G * NTHR) {
        const int e = EIDX[i], pos = DEST[i]; const int dr = tstart[e] * 256 + pos;
        DEST[i] = dr; ROWTOK[dr] = i >> 3;
    }
}

__device__ __forceinline__ void ph_exp1(Frame& F) {
    const int NT = (int)__hip_atomic_load(F.ctl + CW_NT, __ATOMIC_RELAXED, __HIP_MEMORY_SCOPE_AGENT);
    pg8::Gemm g{(const bf16*)(F.ws + WS_A3F), (const bf16*)(F.ws + WS_WGU), 0, 0, D / 2, (const int*)(F.ws + WS_ROWTOK)};
    pg8::MoeOrder S{2, F.G, (int)blockIdx.x, NT, (const int*)(F.ws + WS_TILE_E)};
    EpiSwiglu E{F.ws + WS_ACT};
    pg8::gemm_phase<EpiSwiglu, pg8::MoeOrder, true, true, true, true>(F.lds, g, S, E);
}
__device__ __forceinline__ void ph_exp2(Frame& F) {
    const int NT = (int)__hip_atomic_load(F.ctl + CW_NT, __ATOMIC_RELAXED, __HIP_MEMORY_SCOPE_AGENT);
    pg8::Gemm g{(const bf16*)(F.ws + WS_ACT), (const bf16*)(F.ws + WS_WD), 0, 0, FF / 2, nullptr};
    pg8::MoeOrder S{4, F.G, (int)blockIdx.x, NT, (const int*)(F.ws + WS_TILE_E)};
    EpiRowsFp8 E{F.ws + WS_Y};
    pg8::gemm_phase<EpiRowsFp8, pg8::MoeOrder, true, true, false, true>(F.lds, g, S, E);
}
#endif

#if MS >= 3
__device__ __forceinline__ void unp8(const v4u w, float (&f)[8]) { f[0] = bflo(w.x); f[1] = bfhi(w.x); f[2] = bflo(w.y); f[3] = bfhi(w.y); f[4] = bflo(w.z); f[5] = bfhi(w.z); f[6] = bflo(w.w); f[7] = bfhi(w.w); }
__device__ __forceinline__ void unp8f8(const v2u w, float (&f)[8]) { const f32x2 a = __builtin_amdgcn_cvt_pk_f32_fp8((int)w.x, false), b = __builtin_amdgcn_cvt_pk_f32_fp8((int)w.x, true), c = __builtin_amdgcn_cvt_pk_f32_fp8((int)w.y, false), d = __builtin_amdgcn_cvt_pk_f32_fp8((int)w.y, true);
    f[0] = a.x; f[1] = a.y; f[2] = b.x; f[3] = b.y; f[4] = c.x; f[5] = c.y; f[6] = d.x; f[7] = d.y; }
__device__ __forceinline__ v4u pk8(const float (&f)[8]) { v4u o; o.x = pk2(f[0], f[1]); o.y = pk2(f[2], f[3]); o.z = pk2(f[4], f[5]); o.w = pk2(f[6], f[7]); return o; }
__device__ __forceinline__ void st8(float* p, const float (&f)[8]) { *(f32x4*)p = (f32x4){f[0], f[1], f[2], f[3]}; *(f32x4*)(p + 4) = (f32x4){f[4], f[5], f[6], f[7]}; }
__device__ __forceinline__ void ld8(const float* p, float (&f)[8]) { const f32x4 a = *(const f32x4*)p, b = *(const f32x4*)(p + 4); f[0] = a.x; f[1] = a.y; f[2] = a.z; f[3] = a.w; f[4] = b.x; f[5] = b.y; f[6] = b.z; f[7] = b.w; }

__device__ __forceinline__ void ph_a1(Frame& F) {
    const float* mod = (const float*)(F.ws + WS_MOD); unsigned char* A1 = F.ws + WS_A1;
    constexpr int NR = 4;
    for (int m0 = F.gw; m0 < MR; m0 += NR * F.NGW) {
        f32x4 xv[NR][4];
#pragma unroll
        for (int r = 0; r < NR; ++r) { const int mm = m0 + r * F.NGW; const int m = mm < MR ? mm : m0;
            const float* src = (m < NLAT) ? F.in[0] + (size_t)m * D : F.in[2] + (size_t)(m - NLAT) * D;
            const f32x4* xr = (const f32x4*)src + F.lane;
#pragma unroll
            for (int j = 0; j < 4; ++j) xv[r][j] = __builtin_nontemporal_load(xr + 64 * j); }
        __builtin_amdgcn_sched_barrier(0);
#pragma unroll
        for (int r = 0; r < NR; ++r) { const int mm = m0 + r * F.NGW; const int m = mm < MR ? mm : m0; const int mr = (m < NLAT) ? (m / SEQ) : 4;
            unsigned* ao = (unsigned*)(A1 + (size_t)m * D) + F.lane;
#pragma unroll
            for (int j = 0; j < 4; ++j) { const int c = 4 * F.lane + 256 * j;
                const f32x4 sh = *(const f32x4*)(mod + mr * 6144 + c), sc = *(const f32x4*)(mod + mr * 6144 + 1024 + c);
                const f32x4 h = xv[r][j] * (sc + 1.0f) + sh; ao[64 * j] = pack_fp8x4(h); } }
    }
}

__device__ __forceinline__ void ph_inproj(Frame& F) {
    pg8::Gemm g{(const bf16*)(F.ws + WS_A1), (const bf16*)(F.ws + WS_WIN), MR, NP, D / 2, nullptr};
    pg8::StaticOrder S; S.init(MR, NP, F.G, (int)blockIdx.x);
    EpiRowsBf16 E{(bf16*)(F.ws + WS_P), NP, W8I};
    pg8::gemm_phase<EpiRowsBf16, pg8::StaticOrder, true, true, false, true>(F.lds, g, S, E);
}

struct FeatOut { bf16 *R, *V, *KK, *KP, *QG, *KGB, *VGB, *A2; const float *mu, *kkw, *cw; };
__device__ __forceinline__ void feat_rw(const FeatOut& O, int p, size_t m, int lane, const v4u own_w, const v4u (&nbw)[4], const float (&muv)[8]) {
    float own[8], sh[4][8], val[8];
    unp8(own_w, own);
#pragma unroll
    for (int q = 0; q < 4; ++q) unp8(nbw[q], sh[q]);
#pragma unroll
    for (int e = 0; e < 8; ++e) val[e] = own[e] + muv[e] * (sh[e & 3][e] - own[e]);
    if (p == 0) *(v4u*)(O.R + m * RWW + 8 * lane) = pk8(val);
    else if (p == 2) *(v4u*)(O.V + m * RWW + 8 * lane) = pk8(val);
    else if (p == 1) {
        *(v4u*)(O.KP + m * RWW + 8 * lane) = pk8(val);
        float kw[8]; ld8(O.kkw + 8 * lane, kw); float kkv[8]; float ss = 0.f;
#pragma unroll
        for (int e = 0; e < 8; ++e) { kkv[e] = val[e] * kw[e]; ss += kkv[e] * kkv[e]; }
        ss += __shfl_xor(ss, 1); ss += __shfl_xor(ss, 2); ss += __shfl_xor(ss, 4);
        const float inv = 1.0f / fmaxf(sqrtf(ss), 1e-12f);
#pragma unroll
        for (int e = 0; e < 8; ++e) kkv[e] *= inv;
        *(v4u*)(O.KK + m * RWW + 8 * lane) = pk8(kkv);
    } else {
        float o[8];
#pragma unroll
        for (int e = 0; e < 8; ++e) o[e] = (lane < 4) ? tanhf(val[e]) : ((lane < 8) ? val[e] : sigmoidf_(val[e]));
        *(v4u*)(O.A2 + m * KLORA + 8 * lane) = pk8(o);
    }
}
__device__ __forceinline__ void feat_gla_store(const FeatOut& O, int p, size_t m, int lane, const float (&acc)[8]) {
    const int cq = p * 512 + 8 * lane; float o[8];
#pragma unroll
    for (int e = 0; e < 8; ++e) o[e] = siluf_(acc[e]);
    if (p == 0) {
        if (lane < 32) {
#pragma unroll
            for (int e = 0; e < 8; ++e) o[e] *= 0.125f;
            *(v4u*)(O.QG + m * 256 + cq) = pk8(o);
        } else *(v4u*)(O.KGB + m * 256 + (cq - 256)) = pk8(o);
    } else *(v4u*)(O.VGB + m * RWW + (cq - 512)) = pk8(o);
}
__device__ __forceinline__ void ph_feat(Frame& F) {
    const bf16* P = (const bf16*)(F.ws + WS_P);
    FeatOut O{(bf16*)(F.ws + WS_RB), (bf16*)(F.ws + WS_VB), (bf16*)(F.ws + WS_KKB), (bf16*)(F.ws + WS_KMF), (bf16*)(F.ws + WS_QGB), (bf16*)(F.ws + WS_KGB), (bf16*)(F.ws + WS_VGB), (bf16*)(F.ws + WS_A2), F.in[7], F.in[13], F.in[18]};
    const v4u Z4 = (v4u){0u, 0u, 0u, 0u};
    for (int blk = F.gw; blk < NB * (GRIDH / 2) * (GRIDW / 2); blk += F.NGW) {
        int lane = F.lane; asm volatile("" : "+v"(lane));
        const int b = blk >> 11, r0 = 2 * ((blk >> 5) & 63), c0 = 2 * (blk & 31); const int mb = b * SEQ + r0 * GRIDW + c0;
        const bool vu = r0 > 0, vd = r0 + 2 < GRIDH, vl = c0 > 0, vr = c0 + 2 < GRIDW;
#pragma unroll
        for (int p = 0; p < 4; ++p) {
            const int cb = p * 512 + 8 * lane; const bool act = (p < 3) || lane < 20;
            v4u own[2][2], up[2], dn[2], lf[2], rt[2];
#pragma unroll
            for (int i = 0; i < 2; ++i) { up[i] = Z4; dn[i] = Z4; lf[i] = Z4; rt[i] = Z4; own[i][0] = Z4; own[i][1] = Z4; }
            if (act) {
#pragma unroll
                for (int i = 0; i < 2; ++i) {
#pragma unroll
                    for (int j = 0; j < 2; ++j) own[i][j] = *(const v4u*)(P + (size_t)(mb + 64 * i + j) * NP + cb);
                    if (vu) up[i] = *(const v4u*)(P + (size_t)(mb - 64 + i) * NP + cb);
                    if (vd) dn[i] = *(const v4u*)(P + (size_t)(mb + 128 + i) * NP + cb);
                    if (vl) lf[i] = *(const v4u*)(P + (size_t)(mb + 64 * i - 1) * NP + cb);
                    if (vr) rt[i] = *(const v4u*)(P + (size_t)(mb + 64 * i + 2) * NP + cb); }
            } else if (p == 3 && lane >= 20 && lane < 22) {
#pragma unroll
                for (int i = 0; i < 2; ++i)
#pragma unroll
                    for (int j = 0; j < 2; ++j) own[i][j] = *(const v4u*)(P + (size_t)(mb + 64 * i + j) * NP + C_PGL + 8 * (lane - 20));
            }
            float muv[8] = {0.f, 0.f, 0.f, 0.f, 0.f, 0.f, 0.f, 0.f}; if (act) ld8(O.mu + cb, muv);
            __builtin_amdgcn_sched_barrier(0);
#pragma unroll
            for (int i = 0; i < 2; ++i)
#pragma unroll
                for (int j = 0; j < 2; ++j) { const size_t m = (size_t)(mb + 64 * i + j);
                    if (act) { const v4u nbw[4] = {j == 0 ? lf[i] : own[i][0], j == 1 ? rt[i] : own[i][1], i == 0 ? up[j] : own[0][j], i == 1 ? dn[j] : own[1][j]};
                        feat_rw(O, p, m, lane, own[i][j], nbw, muv); }
                    else if (p == 3 && lane < 32) *(v4u*)(O.A2 + m * KLORA + 8 * lane) = own[i][j]; }
        }
#pragma unroll
        for (int p = 0; p < 2; ++p) {
            const int cq = p * 512 + 8 * lane, cb = C_Q + cq;
            v4u g[4][4];
#pragma unroll
            for (int a2 = 0; a2 < 4; ++a2)
#pragma unroll
                for (int b2 = 0; b2 < 4; ++b2) { const bool ok = (a2 == 0 ? vu : (a2 == 3 ? vd : true)) && (b2 == 0 ? vl : (b2 == 3 ? vr : true));
                    g[a2][b2] = Z4; if (ok) g[a2][b2] = *(const v4u*)(P + (size_t)(mb + 64 * (a2 - 1) + (b2 - 1)) * NP + cb); }
            __builtin_amdgcn_sched_barrier(0);
            float acc[2][2][8];
#pragma unroll
            for (int i = 0; i < 2; ++i)
#pragma unroll
                for (int j = 0; j < 2; ++j)
#pragma unroll
                    for (int e = 0; e < 8; ++e) acc[i][j][e] = 0.f;
#pragma unroll
            for (int dy = 0; dy < 3; ++dy)
#pragma unroll
                for (int dx = 0; dx < 3; ++dx) { float wv[8]; ld8(O.cw + (dy * 3 + dx) * 1024 + cq, wv);
#pragma unroll
                    for (int i = 0; i < 2; ++i)
#pragma unroll
                        for (int j = 0; j < 2; ++j) { float pv[8]; unp8(g[i + dy][j + dx], pv);
#pragma unroll
                            for (int e = 0; e < 8; ++e) acc[i][j][e] += pv[e] * wv[e]; } }
#pragma unroll
            for (int i = 0; i < 2; ++i)
#pragma unroll
                for (int j = 0; j < 2; ++j) feat_gla_store(O, p, (size_t)(mb + 64 * i + j), lane, acc[i][j]);
        }
    }
    for (int m = NLAT + F.gw; m < MR; m += F.NGW) {
        int lane = F.lane; asm volatile("" : "+v"(lane));
        const int t = (m - NLAT) & (CTXL - 1); const bool vp = t > 0, vn = t < CTXL - 1;
#pragma unroll
        for (int p = 0; p < 4; ++p) {
            const int cb = p * 512 + 8 * lane; const bool act = (p < 3) || lane < 20;
            if (act) { const v4u own = *(const v4u*)(P + (size_t)m * NP + cb); v4u pv = Z4, nv = Z4;
                if (vp) pv = *(const v4u*)(P + (size_t)(m - 1) * NP + cb); if (vn) nv = *(const v4u*)(P + (size_t)(m + 1) * NP + cb);
                float muv[8]; ld8(O.mu + cb, muv); const v4u nbw[4] = {pv, nv, pv, nv};
                feat_rw(O, p, (size_t)m, lane, own, nbw, muv); }
            else if (p == 3 && lane < 32) { v4u w = Z4; if (lane < 22) w = *(const v4u*)(P + (size_t)m * NP + C_PGL + 8 * (lane - 20)); *(v4u*)(O.A2 + (size_t)m * KLORA + 8 * lane) = w; }
        }
#pragma unroll
        for (int p = 0; p < 2; ++p) {
            const int cq = p * 512 + 8 * lane, cb = C_Q + cq; float acc[8] = {0.f, 0.f, 0.f, 0.f, 0.f, 0.f, 0.f, 0.f};
#pragma unroll
            for (int dx = -1; dx <= 1; ++dx) { const bool ok = (dx < 0) ? vp : ((dx > 0) ? vn : true);
                if (ok) { float pv[8], wv[8]; unp8(*(const v4u*)(P + (size_t)(m + dx) * NP + cb), pv); ld8(O.cw + (3 + dx + 1) * 1024 + cq, wv);
#pragma unroll
                    for (int e = 0; e < 8; ++e) acc[e] += pv[e] * wv[e]; } }
            feat_gla_store(O, p, (size_t)m, lane, acc);
        }
    }
}

struct EpiLora {
    static constexpr bool PERM = true;
    unsigned char* ws; const float* const* in;
    __device__ __forceinline__ void grp_w(const f32x4 (&acc)[2][2][4][2], int row0, int c0) const {
        bf16* Wf = (bf16*)(ws + WS_LWF); bf16* Wb = (bf16*)(ws + WS_LWB);
#pragma unroll
        for (int bj = 0; bj < 2; ++bj) { const int ch = (c0 + bj * 128) >> 1; const f32x4 w0f = *(const f32x4*)(in[8] + ch), w0b = *(const f32x4*)(in[8] + 512 + ch);
#pragma unroll
            for (int ai = 0; ai < 2; ++ai)
#pragma unroll
                for (int m = 0; m < 4; ++m) { const size_t row = (size_t)(row0 + ai * 128 + m * 16);
                    const f32x4 xf = acc[ai][bj][m][0] + w0f, xb = acc[ai][bj][m][1] + w0b; f32x4 df, db;
#pragma unroll
                    for (int e = 0; e < 4; ++e) { df[e] = -0.60653066f * sigmoidf_(xf[e]); db[e] = -0.60653066f * sigmoidf_(xb[e]); }
                    { v2u o; o.x = pk2(df[0], df[1]); o.y = pk2(df[2], df[3]); *(v2u*)(Wf + row * RWW + ch) = o; o.x = pk2(db[0], db[1]); o.y = pk2(db[2], db[3]); *(v2u*)(Wb + row * RWW + ch) = o; } } }
    }
    __device__ __forceinline__ void grp_a(const f32x4 (&acc)[2][2][4][2], int row0, int c0) const {
        bf16* KMf = (bf16*)(ws + WS_KMF); bf16* KMb = (bf16*)(ws + WS_KMB); bf16* BVf = (bf16*)(ws + WS_BVF); bf16* BVb = (bf16*)(ws + WS_BVB);
        const bf16* KK = (const bf16*)(ws + WS_KKB); bf16* KSUM = (bf16*)(ws + WS_KSUM);
#pragma unroll
        for (int bj = 0; bj < 2; ++bj) { const int ch = (c0 + bj * 128 - 1024) >> 1; const f32x4 a0f = *(const f32x4*)(in[10] + ch), a0b = *(const f32x4*)(in[10] + 512 + ch), ka = *(const f32x4*)(in[14] + ch);
#pragma unroll
            for (int ai = 0; ai < 2; ++ai) {
            v2u kpw[2][4], kkw[2][4];
#pragma unroll
                for (int m = 0; m < 4; ++m) { const size_t row = (size_t)(row0 + ai * 128 + m * 16); kpw[ai][m] = *(const v2u*)(KMf + row * RWW + ch); kkw[ai][m] = *(const v2u*)(KK + row * RWW + ch); }
            __builtin_amdgcn_sched_barrier(0);
#pragma unroll
                for (int m = 0; m < 4; ++m) { const size_t row = (size_t)(row0 + ai * 128 + m * 16);
                    const f32x4 xf = acc[ai][bj][m][0] + a0f, xb = acc[ai][bj][m][1] + a0b;
                    const f32x4 kp = (f32x4){bflo(kpw[ai][m].x), bfhi(kpw[ai][m].x), bflo(kpw[ai][m].y), bfhi(kpw[ai][m].y)}, kk = (f32x4){bflo(kkw[ai][m].x), bfhi(kkw[ai][m].x), bflo(kkw[ai][m].y), bfhi(kkw[ai][m].y)};
                    f32x4 kmf, kmb, bvf, bvb;
#pragma unroll
                    for (int e = 0; e < 4; ++e) { const float af = sigmoidf_(xf[e]), ab = sigmoidf_(xb[e]);
                        kmf[e] = kp[e] * (1.0f + (af - 1.0f) * ka[e]); kmb[e] = kp[e] * (1.0f + (ab - 1.0f) * ka[e]); bvf[e] = kk[e] * af; bvb[e] = kk[e] * ab; }
                    { v2u o; o.x = pk2(kmf[0], kmf[1]); o.y = pk2(kmf[2], kmf[3]); *(v2u*)(KMf + row * RWW + ch) = o; o.x = pk2(kmb[0], kmb[1]); o.y = pk2(kmb[2], kmb[3]); *(v2u*)(KMb + row * RWW + ch) = o;
                      o.x = pk2(bvf[0], bvf[1]); o.y = pk2(bvf[2], bvf[3]); *(v2u*)(BVf + row * RWW + ch) = o; o.x = pk2(bvb[0], bvb[1]); o.y = pk2(bvb[2], bvb[3]); *(v2u*)(BVb + row * RWW + ch) = o; }
                    v2u ks; ks.x = pk2(kmf[0] + kmb[0], kmf[1] + kmb[1]); ks.y = pk2(kmf[2] + kmb[2], kmf[3] + kmb[3]); *(v2u*)(KSUM + row * RWW + ch) = ks; } } }
    }
    __device__ __forceinline__ void grp_g(const f32x4 (&acc)[2][2][4][2], int row0, int c0) const {
        bf16* RWG = (bf16*)(ws + WS_RWG);
#pragma unroll
        for (int bj = 0; bj < 2; ++bj) { const int ch = c0 + bj * 128 - 2048;
#pragma unroll
            for (int ai = 0; ai < 2; ++ai)
#pragma unroll
                for (int m = 0; m < 4; ++m) { const size_t row = (size_t)(row0 + ai * 128 + m * 16); const f32x4 v0 = acc[ai][bj][m][0], v1 = acc[ai][bj][m][1];
                    v4u w; w.x = pk2(v0[0], v0[1]); w.y = pk2(v0[2], v0[3]); w.z = pk2(v1[0], v1[1]); w.w = pk2(v1[2], v1[3]); *(v4u*)(RWG + row * RWW + ch) = w; } }
    }
    __device__ __forceinline__ void grp_l(const f32x4 (&acc)[2][2][4][2], int row0, int c0) const {
        bf16* GAf = (bf16*)(ws + WS_LAF); bf16* GAb = (bf16*)(ws + WS_LAB);
#pragma unroll
        for (int bj = 0; bj < 2; ++bj) { const int ch = (c0 + bj * 128 - 2560) >> 1; const f32x4 gbf = *(const f32x4*)(in[20] + ch), gbb = *(const f32x4*)(in[20] + 256 + ch);
#pragma unroll
            for (int ai = 0; ai < 2; ++ai)
#pragma unroll
                for (int m = 0; m < 4; ++m) { const size_t row = (size_t)(row0 + ai * 128 + m * 16);
                    const f32x4 xf = acc[ai][bj][m][0] + gbf, xb = acc[ai][bj][m][1] + gbb; f32x4 af, ab;
#pragma unroll
                    for (int e = 0; e < 4; ++e) { const float lf = fminf(xf[e], 0.f) - log1pf(__expf(-fabsf(xf[e]))), lb = fminf(xb[e], 0.f) - log1pf(__expf(-fabsf(xb[e])));
                        af[e] = lf * 0.0625f; ab[e] = lb * 0.0625f; }
                    { v2u o; o.x = pk2(af[0], af[1]); o.y = pk2(af[2], af[3]); *(v2u*)(GAf + row * 256 + ch) = o; o.x = pk2(ab[0], ab[1]); o.y = pk2(ab[2], ab[3]); *(v2u*)(GAb + row * 256 + ch) = o; } } }
    }
    __device__ __forceinline__ void operator()(const f32x4 (&acc)[2][2][4][2], const pg8::Unit& u, int wr, int wc, int fr, int fq) const {
        const int row0 = u.pm * 256 + wr * 64 + fr, c0 = u.pn * 256 + wc * 32 + 8 * fq;
        if (u.pn < 4) grp_w(acc, row0, c0); else if (u.pn < 8) grp_a(acc, row0, c0); else if (u.pn < 10) grp_g(acc, row0, c0); else grp_l(acc, row0, c0);
    }
};
__device__ __forceinline__ void ph_lora(Frame& F) {
    pg8::Gemm g{(const bf16*)(F.ws + WS_A2), (const bf16*)(F.ws + WS_WLORA), MR, NLORA, KLORA, nullptr};
    pg8::StaticOrder S; S.init(MR, NLORA, F.G, (int)blockIdx.x);
    EpiLora E{F.ws, F.in};
    pg8::gemm_phase<EpiLora, pg8::StaticOrder, true, true, false>(F.lds, g, S, E);
}

__device__ __forceinline__ void ph_merge(Frame& F) {
    unsigned char* ws = F.ws; const int lane = F.lane;
    const bf16* ORf = (const bf16*)(ws + WS_ORWF); const bf16* ORb = (const bf16*)(ws + WS_ORWB); const bf16* OGf = (const bf16*)(ws + WS_OGLF); const bf16* OGb = (const bf16*)(ws + WS_OGLB);
    const bf16* R = (const bf16*)(ws + WS_RB); const bf16* V = (const bf16*)(ws + WS_VB); const bf16* KSUM = (const bf16*)(ws + WS_KSUM); const bf16* RWG = (const bf16*)(ws + WS_RWG);
    const bf16* P = (const bf16*)(ws + WS_P);
    bf16* YRW = (bf16*)(ws + WS_YRW); bf16* YGLA = (bf16*)(ws + WS_YGLA);
    float rk[8], gw[8], gbv[8], ggw[8], ggb[8];
    ld8(F.in[15] + 8 * lane, rk); ld8(F.in[16] + 8 * lane, gw); ld8(F.in[17] + 8 * lane, gbv); ld8(F.in[21] + 8 * lane, ggw); ld8(F.in[22] + 8 * lane, ggb);
    for (int m0 = F.gw; m0 < NLAT; m0 += 2 * F.NGW) {
        const int m1 = (m0 + F.NGW < NLAT) ? m0 + F.NGW : m0;
        v4u wa[2], wb[2], wc[2], wd[2], wr[2], wv[2], wk[2], wg[2], wo[2];
#pragma unroll
        for (int r2 = 0; r2 < 2; ++r2) { const int m = r2 ? m1 : m0; const size_t ro = (size_t)m * RWW + 8 * lane;
            wa[r2] = *(const v4u*)(ORf + ro); wb[r2] = *(const v4u*)(ORb + ro); wc[r2] = *(const v4u*)(OGf + ro); wd[r2] = *(const v4u*)(OGb + ro);
            wr[r2] = *(const v4u*)(R + ro); wv[r2] = *(const v4u*)(V + ro); wk[r2] = *(const v4u*)(KSUM + ro); wg[r2] = *(const v4u*)(RWG + ro);
            wo[r2] = *(const v4u*)(P + (size_t)m * NP + C_OG + 8 * lane); }
#pragma unroll
        for (int r2 = 0; r2 < 2; ++r2) { const int m = r2 ? m1 : m0; const size_t ro = (size_t)m * RWW + 8 * lane;
        {
            float a[8], b[8], o[8]; unp8(wa[r2], a); unp8(wb[r2], b);
            float s = 0.f;
#pragma unroll
            for (int e = 0; e < 8; ++e) { o[e] = a[e] + b[e]; s += o[e]; }
            s += __shfl_xor(s, 1); s += __shfl_xor(s, 2); s += __shfl_xor(s, 4);
            const float mean = s * (1.f / 64.f); float q = 0.f;
#pragma unroll
            for (int e = 0; e < 8; ++e) { o[e] -= mean; q += o[e] * o[e]; }
            q += __shfl_xor(q, 1); q += __shfl_xor(q, 2); q += __shfl_xor(q, 4);
            const float rstd = 1.f / sqrtf(q * (1.f / 64.f) + RW_GN_EPS);
            float r[8], v[8], ksm[8], g[8]; unp8(wr[r2], r); unp8(wv[r2], v); unp8(wk[r2], ksm); unp8(wg[r2], g);
            float bs = 0.f;
#pragma unroll
            for (int e = 0; e < 8; ++e) bs += r[e] * ksm[e] * rk[e];
            bs += __shfl_xor(bs, 1); bs += __shfl_xor(bs, 2); bs += __shfl_xor(bs, 4);
            float y[8];
#pragma unroll
            for (int e = 0; e < 8; ++e) y[e] = (o[e] * rstd * gw[e] + gbv[e] + bs * v[e]) * g[e];
            *(v4u*)(YRW + ro) = pk8(y);
        }
        {
            float a[8], b[8], o[8]; unp8(wc[r2], a); unp8(wd[r2], b);
            float s = 0.f;
#pragma unroll
            for (int e = 0; e < 8; ++e) { o[e] = a[e] + b[e]; s += o[e]; }
            s += __shfl_xor(s, 1); s += __shfl_xor(s, 2); s += __shfl_xor(s, 4); s += __shfl_xor(s, 8);
            const float mean = s * (1.f / 128.f); float q = 0.f;
#pragma unroll
            for (int e = 0; e < 8; ++e) { o[e] -= mean; q += o[e] * o[e]; }
            q += __shfl_xor(q, 1); q += __shfl_xor(q, 2); q += __shfl_xor(q, 4); q += __shfl_xor(q, 8);
            const float rstd = 1.f / sqrtf(q * (1.f / 128.f) + LN_EPS);
            float og[8]; unp8(wo[r2], og);
            float y[8];
#pragma unroll
            for (int e = 0; e < 8; ++e) y[e] = (o[e] * rstd * ggw[e] + ggb[e]) * siluf_(og[e]);
            *(v4u*)(YGLA + ro) = pk8(y);
        }
        }
    }
}

template <int WHICH> struct EpiBranch {
    static constexpr bool PERM = true;
    bf16* Z; const bf16* P;
    __device__ __forceinline__ void operator()(const f32x4 (&acc)[2][2][4][2], const pg8::Unit& u, int wr, int wc, int fr, int fq) const {
        const int row0 = u.pm * 256 + wr * 64 + fr, col0 = u.pn * 256 + wc * 32 + 8 * fq;
#pragma unroll
        for (int ah = 0; ah < 4; ++ah) { const int ai = ah >> 1, mb = 2 * (ah & 1);
            v4u gw[2][2], zw[2][2];
#pragma unroll
            for (int m = 0; m < 2; ++m) { const size_t row = (size_t)(row0 + ai * 128 + (mb + m) * 16);
#pragma unroll
                for (int bj = 0; bj < 2; ++bj) { const int c = col0 + bj * 128;
                    gw[m][bj] = *(const v4u*)(P + row * NP + (WHICH ? C_GGLA : C_GRW) + c);
                    if (WHICH) zw[m][bj] = *(const v4u*)(Z + row * D + c); } }
            __builtin_amdgcn_sched_barrier(0);
#pragma unroll
            for (int m = 0; m < 2; ++m) { const size_t row = (size_t)(row0 + ai * 128 + (mb + m) * 16);
#pragma unroll
                for (int bj = 0; bj < 2; ++bj) { const int c = col0 + bj * 128;
                    float g[8]; unp8(gw[m][bj], g);
                    const f32x4 v0 = acc[ai][bj][mb + m][0], v1 = acc[ai][bj][mb + m][1];
                    float z[8];
#pragma unroll
                    for (int e = 0; e < 4; ++e) { z[e] = sigmoidf_(g[e]) * v0[e]; z[4 + e] = sigmoidf_(g[4 + e]) * v1[e]; }
                    if (WHICH) { float zo[8]; unp8(zw[m][bj], zo);
#pragma unroll
                        for (int e = 0; e < 8; ++e) z[e] += zo[e]; }
                    *(v4u*)(Z + row * D + c) = pk8(z); } }
        }
    }
};
__device__ __forceinline__ void ph_branch(Frame& F) {
    pg8::StaticOrder S; S.init(NLAT, D, F.G, (int)blockIdx.x);
    { pg8::Gemm g{(const bf16*)(F.ws + WS_YRW), (const bf16*)(F.ws + WS_WBRRW), NLAT, D, RWW, nullptr};
      EpiBranch<0> E{(bf16*)(F.ws + WS_Z), (const bf16*)(F.ws + WS_P)};
      pg8::gemm_phase<EpiBranch<0>, pg8::StaticOrder, true, true, false>(F.lds, g, S, E); }
    { pg8::Gemm g{(const bf16*)(F.ws + WS_YGLA), (const bf16*)(F.ws + WS_WBRGLA), NLAT, D, RWW, nullptr};
      EpiBranch<1> E{(bf16*)(F.ws + WS_Z), (const bf16*)(F.ws + WS_P)};
      pg8::gemm_phase<EpiBranch<1>, pg8::StaticOrder, true, true, false>(F.lds, g, S, E); }
}
struct EpiOut {
    static constexpr bool PERM = true;
    bf16* X1P; const float* x; const float* mod;
    __device__ __forceinline__ void operator()(const f32x4 (&acc)[2][2][4][2], const pg8::Unit& u, int wr, int wc, int fr, int fq) const {
        const int row0 = u.pm * 256 + wr * 64 + fr, col0 = u.pn * 256 + wc * 32 + 8 * fq; const float* g1 = mod + (u.pm / (SEQ / 256)) * 6144 + 2048;
        f32x4 gv[2][2];
#pragma unroll
        for (int bj = 0; bj < 2; ++bj)
#pragma unroll
            for (int n = 0; n < 2; ++n) gv[bj][n] = *(const f32x4*)(g1 + col0 + bj * 128 + 4 * n);
#pragma unroll
        for (int ah = 0; ah < 4; ++ah) { const int ai = ah >> 1, mb = 2 * (ah & 1);
            f32x4 xv[2][2][2];
#pragma unroll
            for (int m = 0; m < 2; ++m) { const size_t ro = (size_t)(row0 + ai * 128 + (mb + m) * 16) * D;
#pragma unroll
                for (int bj = 0; bj < 2; ++bj)
#pragma unroll
                    for (int n = 0; n < 2; ++n) xv[m][bj][n] = *(const f32x4*)(x + ro + col0 + bj * 128 + 4 * n); }
            __builtin_amdgcn_sched_barrier(0);
#pragma unroll
            for (int m = 0; m < 2; ++m) { const size_t ro = (size_t)(row0 + ai * 128 + (mb + m) * 16) * D;
#pragma unroll
                for (int bj = 0; bj < 2; ++bj) { const f32x4 a = xv[m][bj][0] * ALPHA + gv[bj][0] * acc[ai][bj][mb + m][0], b = xv[m][bj][1] * ALPHA + gv[bj][1] * acc[ai][bj][mb + m][1];
                    v4u w; w.x = pk2(a.x, a.y); w.y = pk2(a.z, a.w); w.z = pk2(b.x, b.y); w.w = pk2(b.z, b.w); *(v4u*)(X1P + ro + col0 + bj * 128) = w; } }
        }
    }
};
__device__ __forceinline__ void ph_outproj(Frame& F) {
    pg8::Gemm g{(const bf16*)(F.ws + WS_Z), (const bf16*)(F.ws + WS_WOUT), NLAT, D, D, nullptr};
    pg8::StaticOrder S; S.init(NLAT, D, F.G, (int)blockIdx.x);
    EpiOut E{(bf16*)(F.ws + WS_X1), F.in[0], (const float*)(F.ws + WS_MOD)};
    pg8::gemm_phase<EpiOut, pg8::StaticOrder, true, true, false>(F.lds, g, S, E);
}
#endif

#if MS >= 3
constexpr int LP = 72, SLOTB = 64 * LP * 2, LPF = 68, AUX_OFF = 13 * SLOTB;
static_assert(AUX_OFF + 4096 <= MISC_OFF, "scan LDS map");
#define SLOT(n) ((LAS bf16*)(lds + (n) * SLOTB))
__device__ __forceinline__ int scan_row(int s, int b, int dir) {
    if (s < CTXL) return NLAT + b * CTXL + (dir ? (CTXL - 1 - s) : s);
    const int lt = s - CTXL; return b * SEQ + (dir ? (SEQ - 1 - lt) : lt);
}
__device__ __forceinline__ unsigned pk2z(float x) { return pk2(x, 0.f); }
__device__ __forceinline__ float bf2f(bf16 h) { return __builtin_bit_cast(float, (unsigned)h << 16); }
__device__ __forceinline__ v2u pack4(const f32x4 v) { v2u o; o.x = pk2(v[0], v[1]); o.y = pk2(v[2], v[3]); return o; }
__device__ __forceinline__ float clamp8(float x) { return __builtin_amdgcn_fmed3f(x, -448.0f, 448.0f); }
__device__ __forceinline__ unsigned pack4_fp8(const f32x4 v) { int w = __builtin_amdgcn_cvt_pk_fp8_f32(clamp8(v[0]), clamp8(v[1]), 0, false); return (unsigned)__builtin_amdgcn_cvt_pk_fp8_f32(clamp8(v[2]), clamp8(v[3]), w, true); }
__device__ __forceinline__ f32x4 unpack4_fp8(unsigned w) { const f32x2 lo = __builtin_amdgcn_cvt_pk_f32_fp8((int)w, false), hi = __builtin_amdgcn_cvt_pk_f32_fp8((int)w, true); return (f32x4){lo.x, lo.y, hi.x, hi.y}; }
__device__ __forceinline__ f32x4 unpack4(const v2u w) { return (f32x4){bflo(w.x), bfhi(w.x), bflo(w.y), bfhi(w.y)}; }
__device__ __forceinline__ f32x4 mm_tile(const LAS bf16* X, int r0, const LAS bf16* Y, int c0, int lane) {
    const int rr = lane & 15, q = lane >> 4;
    const LAS bf16* xp = X + (r0 + rr) * LP + 8 * q; const LAS bf16* yp = Y + (c0 + rr) * LP + 8 * q;
    const bf16x8 a0 = *(const LAS bf16x8*)xp, a1 = *(const LAS bf16x8*)(xp + 32), b0 = *(const LAS bf16x8*)yp, b1 = *(const LAS bf16x8*)(yp + 32);
    f32x4 acc = (f32x4){0.f, 0.f, 0.f, 0.f};
    acc = __builtin_amdgcn_mfma_f32_16x16x32_bf16(a0, b0, acc, 0, 0, 0);
    acc = __builtin_amdgcn_mfma_f32_16x16x32_bf16(a1, b1, acc, 0, 0, 0);
    return acc;
}
__device__ __forceinline__ float red8(float x) {
    x += __builtin_bit_cast(float, __builtin_amdgcn_update_dpp(0, __builtin_bit_cast(int, x), 0x141, 0xf, 0xf, false));
    x += __builtin_bit_cast(float, __builtin_amdgcn_update_dpp(0, __builtin_bit_cast(int, x), 0xB1, 0xf, 0xf, false));
    x += __builtin_bit_cast(float, __builtin_amdgcn_update_dpp(0, __builtin_bit_cast(int, x), 0x4E, 0xf, 0xf, false));
    return x;
}

#define S1_BAR() do { asm volatile("s_waitcnt lgkmcnt(0)" ::: "memory"); __builtin_amdgcn_s_barrier(); asm volatile("" ::: "memory"); } while (0)
struct RwIn { bf16 lw[8], r[8], k[8], a[8], b[8], v[8]; };
__device__ __forceinline__ void s1_rwkv_load(Frame& F, int u, RwIn& I) {
    const int sr = u / NCHUNK, c = u - sr * NCHUNK, rb = sr >> 4, rdir = (sr >> 3) & 1, rh = sr & 7; unsigned char* ws = F.ws;
    const bf16* RBp = (const bf16*)(ws + WS_RB); const bf16* VBp = (const bf16*)(ws + WS_VB); const bf16* KKp = (const bf16*)(ws + WS_KKB);
    const bf16* KMp = (const bf16*)(ws + (rdir ? WS_KMB : WS_KMF)); const bf16* BVp = (const bf16*)(ws + (rdir ? WS_BVB : WS_BVF)); const bf16* LWp = (const bf16*)(ws + (rdir ? WS_LWB : WS_LWF));
#pragma unroll
    for (int i = 0; i < 8; ++i) { const int row = scan_row(c * CH + 8 * F.wave + i, rb, rdir); const size_t base = (size_t)row * RWW + rh * 64 + F.lane;
        I.lw[i] = LWp[base]; I.r[i] = RBp[base]; I.k[i] = KMp[base]; I.a[i] = KKp[base]; I.b[i] = BVp[base]; I.v[i] = VBp[base]; }
}
__device__ __forceinline__ void s1_rwkv(Frame& F, int u, const RwIn& I, int un, RwIn& Inext, int cvi) {
    const int sr = u / NCHUNK, c = u - sr * NCHUNK;
    const bool emit = c >= CTXL / CH;
    LAS unsigned char* lds = F.lds; unsigned char* ws = F.ws;
    int lane_ = F.lane; asm volatile("" : "+v"(lane_));
    const int lane = lane_, wave = F.wave, rr = lane & 15, q = lane >> 4;
    LAS float* tot = (LAS float*)(lds + AUX_OFF); LAS float* gCs = tot + 512;
    {
        float lw[8], xr[8], xk[8], xa[8], xb[8], xv[8];
#pragma unroll
        for (int i = 0; i < 8; ++i) { lw[i] = bf2f(I.lw[i]); xr[i] = bf2f(I.r[i]); xk[i] = bf2f(I.k[i]); xa[i] = -bf2f(I.a[i]); xb[i] = bf2f(I.b[i]); xv[i] = bf2f(I.v[i]); }
        float p[8]; p[0] = lw[0];
#pragma unroll
        for (int i = 1; i < 8; ++i) p[i] = p[i - 1] + lw[i];
        tot[wave * 64 + lane] = p[7];
        S1_BAR();
        float off = 0.f, all = 0.f;
#pragma unroll
        for (int w = 0; w < 8; ++w) { const float t = tot[w * 64 + lane]; all += t; off += (w < wave) ? t : 0.f; }
        if (wave == 0) gCs[lane] = __expf(all);
        float at[8], bb[8], kb[8];
#pragma unroll
        for (int i = 0; i < 8; ++i) { const float cum = off + p[i]; const float g = __expf(cum), gi = __expf(-cum), gp = __expf(cum - lw[i]), gc = __expf(all - cum);
            const int t = 8 * wave + i;
            at[i] = xa[i] * gp; bb[i] = xb[i] * gc; kb[i] = xk[i] * gc;
            SLOT(0)[t * LP + lane] = (bf16)pk2z(at[i]);
            SLOT(1)[t * LP + lane] = (bf16)pk2z(xr[i] * g);
            SLOT(2)[t * LP + lane] = (bf16)pk2z(xb[i] * gi);
            SLOT(3)[t * LP + lane] = (bf16)pk2z(xk[i] * gi); }
        *(LAS v4u*)(SLOT(4) + lane * LP + 8 * wave) = pk8(at);
        *(LAS v4u*)(SLOT(5) + lane * LP + 8 * wave) = pk8(xv);
        *(LAS v4u*)(SLOT(6) + lane * LP + 8 * wave) = pk8(bb);
        *(LAS v4u*)(SLOT(7) + lane * LP + 8 * wave) = pk8(kb);
        S1_BAR();
    }
    s1_rwkv_load(F, un, Inext);
    LAS float* Lp = (LAS float*)(lds + 8 * SLOTB);
#pragma unroll
    for (int tix = 0; tix < 2; ++tix) { const int ti = 2 * wave + tix, r0 = 16 * (ti >> 2), c0 = 16 * (ti & 3), ci = c0 + rr;
        { const f32x4 acc = mm_tile(SLOT(2), r0, SLOT(0), c0, lane);
#pragma unroll
            for (int e = 0; e < 4; ++e) { const int i = r0 + 4 * q + e; Lp[ci * LPF + (i & 3) * 16 + (i >> 2)] = (i < ci) ? acc[e] : 0.f; } }
        { f32x4 acc = mm_tile(SLOT(0), r0, SLOT(3), c0, lane);
#pragma unroll
            for (int e = 0; e < 4; ++e) acc[e] = (ci < r0 + 4 * q + e) ? acc[e] : 0.f;
            *(LAS v2u*)(SLOT(10) + ci * LP + r0 + 4 * q) = pack4(acc); }
        if (emit) {
            { f32x4 acc = mm_tile(SLOT(2), r0, SLOT(1), c0, lane);
#pragma unroll
                for (int e = 0; e < 4; ++e) acc[e] = (r0 + 4 * q + e <= ci) ? acc[e] : 0.f;
                *(LAS v2u*)(SLOT(11) + ci * LP + r0 + 4 * q) = pack4(acc); }
            { f32x4 acc = mm_tile(SLOT(3), r0, SLOT(1), c0, lane);
#pragma unroll
                for (int e = 0; e < 4; ++e) acc[e] = (r0 + 4 * q + e <= ci) ? acc[e] : 0.f;
                *(LAS v2u*)(SLOT(12) + ci * LP + r0 + 4 * q) = pack4(acc); }
        }
    }
    S1_BAR();
    if (wave < 4) {
        const int j = 16 * wave + (lane >> 2), s = lane & 3;
        float Tr[16];
#pragma unroll
        for (int m = 0; m < 16; ++m) Tr[m] = 0.f;
        const LAS float* lrow = Lp + s * 16;
        f32x4 lb[3][4];
#pragma unroll
        for (int t = 0; t < 2; ++t) lb[t][0] = *(const LAS f32x4*)(lrow + t * LPF);
#pragma unroll
        for (int t = 0; t < 64; ++t) {
            if (t + 2 < 64) {
#pragma unroll
                for (int k = 0; k < 4; ++k) if (4 * k <= (t + 2) / 4) lb[(t + 2) % 3][k] = *(const LAS f32x4*)(lrow + (t + 2) * LPF + 4 * k);
            }
            __builtin_amdgcn_sched_barrier(0);
            float acc0 = 0.f, acc1 = 0.f;
#pragma unroll
            for (int m = 0; m < 16; ++m) if (m <= t / 4) { const float lv = lb[t % 3][m >> 2][m & 3]; if (m & 1) acc1 += lv * Tr[m]; else acc0 += lv * Tr[m]; }
            float acc = acc0 + acc1;
            acc += __builtin_bit_cast(float, __builtin_amdgcn_update_dpp(0, __builtin_bit_cast(int, acc), 0xB1, 0xf, 0xf, false));
            acc += __builtin_bit_cast(float, __builtin_amdgcn_update_dpp(0, __builtin_bit_cast(int, acc), 0x4E, 0xf, 0xf, false));
            int jj = j, ss = s; asm volatile("" : "+v"(jj), "+v"(ss));
            const float val = acc + ((t == jj) ? 1.f : 0.f);
            Tr[t >> 2] = (ss == (t & 3)) ? val : Tr[t >> 2];
            SLOT(0)[t * LP + j] = (bf16)pk2z(val);
        }
    } else if (cvi >= 0) { f32x4 cv[CVK]; cvx_load(F.in, cvi, lane, cv); cvx_store(ws, cvi, lane, cv); }
    S1_BAR();
#pragma unroll
    for (int tix = 0; tix < 2; ++tix) { const int ti = 2 * wave + tix, r0 = 16 * (ti >> 2), c0 = 16 * (ti & 3), ci = c0 + rr;
        { const f32x4 acc = mm_tile(SLOT(0), r0, SLOT(4), c0, lane); *(LAS v2u*)(SLOT(2) + ci * LP + r0 + 4 * q) = pack4(acc); }
        { const f32x4 acc = mm_tile(SLOT(0), r0, SLOT(10), c0, lane); *(LAS v2u*)(SLOT(3) + ci * LP + r0 + 4 * q) = pack4(acc); }
    }
    S1_BAR();
    unsigned char* RH = ws + WS_RH + (size_t)u * 4096; bf16* GT = (bf16*)((unsigned char*)F.out + OUT_GT) + (size_t)u * 4096;
#pragma unroll
    for (int tix = 0; tix < 2; ++tix) { const int ti = 2 * wave + tix, tr = ti >> 2, r0 = 16 * tr, c0 = 16 * (ti & 3), ci = c0 + rr;
        const int pos = (tr >> 1) * 32 + q * 8 + 4 * (tr & 1);
        if (emit) {
            { f32x4 acc = mm_tile(SLOT(2), r0, SLOT(11), c0, lane);
                acc += unpack4(*(const LAS v2u*)(SLOT(1) + ci * LP + r0 + 4 * q));
                *(unsigned*)(RH + ci * 64 + pos) = pack4_fp8(acc); }
            { f32x4 acc = mm_tile(SLOT(3), r0, SLOT(11), c0, lane);
                acc += unpack4(*(const LAS v2u*)(SLOT(12) + ci * LP + r0 + 4 * q));
                *(LAS v2u*)(SLOT(4) + ci * LP + r0 + 4 * q) = pack4(acc); }
        }
        { f32x4 acc = mm_tile(SLOT(2), r0, SLOT(6), c0, lane);
            const float gc = gCs[ci];
#pragma unroll
            for (int e = 0; e < 4; ++e) acc[e] += (r0 + 4 * q + e == ci) ? gc : 0.f;
            *(v2u*)(GT + ci * 64 + pos) = pack4(acc); }
    }
    S1_BAR();
    unsigned char* YL = ws + WS_YL + (size_t)u * 4096;
#pragma unroll
    for (int tix = 0; tix < 2; ++tix) { const int ti = 2 * wave + tix, r0 = 16 * (ti >> 2), c0 = 16 * (ti & 3), ci = c0 + rr;
        if (emit) { const f32x4 acc = mm_tile(SLOT(5), r0, SLOT(4), c0, lane); *(unsigned*)(YL + ci * 64 + r0 + 4 * q) = pack4_fp8(acc); }
        { f32x4 acc = mm_tile(SLOT(3), r0, SLOT(6), c0, lane);
            acc += unpack4(*(const LAS v2u*)(SLOT(7) + ci * LP + r0 + 4 * q));
            *(LAS v2u*)(SLOT(8) + ci * LP + r0 + 4 * q) = pack4(acc); }
    }
    S1_BAR();
    bf16* HH = (bf16*)(ws + WS_HH) + (size_t)u * 4096;
#pragma unroll
    for (int tix = 0; tix < 2; ++tix) { const int ti = 2 * wave + tix, r0 = 16 * (ti >> 2), c0 = 16 * (ti & 3), ci = c0 + rr;
        const f32x4 acc = mm_tile(SLOT(8), r0, SLOT(5), c0, lane);
        *(v2u*)(HH + ci * 64 + r0 + 4 * q) = pack4(acc); }
    S1_BAR();
}

struct GlIn { bf16 la[8], q[8], k[8], v0[8], v1[8]; };
__device__ __forceinline__ void s1_gla_load(Frame& F, int u, GlIn& I) {
    const int sg = u / NCHUNK, c = u - sg * NCHUNK, gb = sg >> 3, gdir = (sg >> 2) & 1, gh = sg & 3; unsigned char* ws = F.ws;
    const bf16* Qp = (const bf16*)(ws + WS_QGB); const bf16* Kp = (const bf16*)(ws + WS_KGB); const bf16* Vp = (const bf16*)(ws + WS_VGB); const bf16* LAp = (const bf16*)(ws + (gdir ? WS_LAB : WS_LAF));
#pragma unroll
    for (int i = 0; i < 8; ++i) { const int row = scan_row(c * CH + 8 * F.wave + i, gb, gdir); const size_t b2 = (size_t)row * 256 + gh * 64 + F.lane, b5 = (size_t)row * RWW + gh * 128 + F.lane;
        I.la[i] = LAp[b2]; I.q[i] = Qp[b2]; I.k[i] = Kp[b2]; I.v0[i] = Vp[b5]; I.v1[i] = Vp[b5 + 64]; }
}
__device__ __forceinline__ void s1_gla(Frame& F, int u, const GlIn& I) {
    const int sg = u / NCHUNK, c = u - sg * NCHUNK;
    const bool emit = c >= CTXL / CH;
    LAS unsigned char* lds = F.lds; unsigned char* ws = F.ws;
    int lane_ = F.lane; asm volatile("" : "+v"(lane_));
    const int lane = lane_, wave = F.wave, rr = lane & 15, q = lane >> 4;
    LAS float* tot = (LAS float*)(lds + AUX_OFF);
    unsigned char* QE = (unsigned char*)F.out + OUT_QE + (size_t)u * 4096;
    {
        float la[8], xq[8], xk[8], v0[8], v1[8];
#pragma unroll
        for (int i = 0; i < 8; ++i) { la[i] = bf2f(I.la[i]); xq[i] = bf2f(I.q[i]); xk[i] = bf2f(I.k[i]); v0[i] = bf2f(I.v0[i]); v1[i] = bf2f(I.v1[i]); }
        float p[8]; p[0] = la[0];
#pragma unroll
        for (int i = 1; i < 8; ++i) p[i] = p[i - 1] + la[i];
        tot[wave * 64 + lane] = p[7];
        S1_BAR();
        float off = 0.f, all = 0.f;
#pragma unroll
        for (int w = 0; w < 8; ++w) { const float t = tot[w * 64 + lane]; all += t; off += (w < wave) ? t : 0.f; }
        if (wave == 0) ((float*)(ws + WS_DD))[(size_t)u * 64 + lane] = __expf(all);
        float kl[8];
#pragma unroll
        for (int i = 0; i < 8; ++i) { const float cum = off + p[i]; const int t = 8 * wave + i;
            const float qef = xq[i] * __expf(cum);
            SLOT(0)[t * LP + lane] = (bf16)pk2z(qef);
            if (emit) QE[t * 64 + lane] = (unsigned char)__builtin_amdgcn_cvt_pk_fp8_f32(clamp8(qef), 0.f, 0, false);
            SLOT(1)[t * LP + lane] = (bf16)pk2z(xk[i] * __expf(-cum));
            kl[i] = xk[i] * __expf(all - cum); }
        *(LAS v4u*)(SLOT(2) + lane * LP + 8 * wave) = pk8(kl);
        *(LAS v4u*)(SLOT(3) + lane * LP + 8 * wave) = pk8(v0);
        *(LAS v4u*)(SLOT(3) + (64 + lane) * LP + 8 * wave) = pk8(v1);
        S1_BAR();
    }
    if (emit) {
#pragma unroll
        for (int tix = 0; tix < 2; ++tix) { const int ti = 2 * wave + tix, r0 = 16 * (ti >> 2), c0 = 16 * (ti & 3), ci = c0 + rr;
            f32x4 acc = mm_tile(SLOT(1), r0, SLOT(0), c0, lane);
#pragma unroll
            for (int e = 0; e < 4; ++e) acc[e] = (r0 + 4 * q + e <= ci) ? acc[e] : 0.f;
            *(LAS v2u*)(SLOT(5) + ci * LP + r0 + 4 * q) = pack4(acc); }
    }
    bf16* KV = (bf16*)(ws + WS_KV) + (size_t)u * 8192;
#pragma unroll
    for (int tix = 0; tix < 4; ++tix) { const int ti = 4 * wave + tix, r0 = 16 * (ti >> 3), c0 = 16 * (ti & 7), ci = c0 + rr;
        const f32x4 acc = mm_tile(SLOT(2), r0, SLOT(3), c0, lane);
        *(v2u*)(KV + ci * 64 + r0 + 4 * q) = pack4(acc); }
    S1_BAR();
    if (emit) {
        unsigned char* IN = ws + WS_INTRA + (size_t)u * 8192;
#pragma unroll
        for (int tix = 0; tix < 4; ++tix) { const int ti = 4 * wave + tix, r0 = 16 * (ti >> 2), c0 = 16 * (ti & 3), ci = c0 + rr;
            const f32x4 acc = mm_tile(SLOT(3), r0, SLOT(5), c0, lane);
            *(unsigned*)(IN + ci * 128 + r0 + 4 * q) = pack4_fp8(acc); }
    }
    S1_BAR();
}

__device__ __forceinline__ void ph_scan1(Frame& F) {
    { RwIn cur, nxt; if ((int)blockIdx.x < NU_RW) s1_rwkv_load(F, blockIdx.x, cur);
#pragma unroll 1
      for (int u = blockIdx.x; u < NU_RW; u += F.G) { const int un = (u + F.G < NU_RW) ? u + F.G : u; const int cvi = ((u - (int)blockIdx.x) / F.G) * (F.G * 4) + (int)blockIdx.x * 4 + (F.wave & 3);
          s1_rwkv(F, u, cur, un, nxt, cvi < CV_NITEM ? cvi : -1); cur = nxt; } }
    { GlIn cur, nxt; if ((int)blockIdx.x < NU_GL) s1_gla_load(F, blockIdx.x, cur);
#pragma unroll 1
      for (int u = blockIdx.x; u < NU_GL; u += F.G) { const int un = (u + F.G < NU_GL) ? u + F.G : u; s1_gla_load(F, un, nxt); s1_gla(F, u, cur); cur = nxt; } }
}

__device__ __forceinline__ bf16x8 pack_frag(const f32x4 lo, const f32x4 hi) {
    v4u w; w.x = pk2(lo[0], lo[1]); w.y = pk2(lo[2], lo[3]); w.z = pk2(hi[0], hi[1]); w.w = pk2(hi[2], hi[3]); return __builtin_bit_cast(bf16x8, w);
}
constexpr int S2_D = 5, S2_R = 6, S2_RW = 8192 + 4096 + 2048 + 1024, S2_GL = 4096 + 2048 + 1024 + 1024, S2_SLOT = S2_RW + S2_GL;
static_assert(S2_R * S2_SLOT <= MISC_OFF, "S2 ring fits in LDS");
__device__ __forceinline__ void s2_issue(LAS unsigned char* lds, int sb, int lw, int lane, size_t ur, size_t ug, int v0r, int v0g,
                                         const unsigned char* GTb, const unsigned char* RHb, const unsigned char* HHb, const unsigned char* YLb,
                                         const unsigned char* QEb, const unsigned char* KVb, const unsigned char* INb, const unsigned char* DDb) {
#pragma unroll
    for (int j = 0; j < 4; ++j) {
        int k = lw * 4 + j; if (k >= 23) k -= 1;
        const unsigned char* src; int ldo;
        if (k < 8) { const int n = k, pu = n * 64 + lane, row = pu >> 3, c16 = (pu & 7) ^ (row & 7);
            src = GTb + ur * 8192 + row * 128 + c16 * 16; ldo = n * 1024; }
        else if (k < 12) { const int n = k - 8, pu = n * 64 + lane, row = pu >> 2, c16 = (pu & 3) ^ (row & 3);
            src = RHb + ur * 4096 + row * 64 + c16 * 16; ldo = 8192 + n * 1024; }
        else if (k < 14) { const int n = k - 12, pu = n * 64 + lane, v = pu >> 3, c16 = (pu & 7) ^ (v & 7);
            src = HHb + ur * 8192 + (size_t)(v0r + v) * 128 + c16 * 16; ldo = 12288 + n * 1024; }
        else if (k < 15) { const int t = lane;
            src = YLb + ur * 4096 + t * 64 + v0r; ldo = 14336; }
        else if (k < 19) { const int n = k - 15, pu = n * 64 + lane, row = pu >> 2, c16 = (pu & 3) ^ (row & 3);
            src = QEb + ug * 4096 + row * 64 + c16 * 16; ldo = S2_RW + n * 1024; }
        else if (k < 21) { const int n = k - 19, pu = n * 64 + lane, v = pu >> 3, c16 = (pu & 7) ^ (v & 7);
            src = KVb + ug * 16384 + (size_t)(v0g + v) * 128 + c16 * 16; ldo = S2_RW + 4096 + n * 1024; }
        else if (k < 22) { const int t = lane;
            src = INb + ug * 8192 + t * 128 + v0g; ldo = S2_RW + 6144; }
        else { src = DDb + ug * 256 + (lane & 15) * 16; ldo = S2_RW + 7168; }
        __builtin_amdgcn_global_load_lds((const unsigned*)src, (LAS unsigned*)(lds + sb + ldo), 16, 0, 0);
    }
}
__device__ __forceinline__ void ph_scan2(Frame& F) {
    const int lane = F.lane, wave = F.wave, rr = lane & 15, q = lane >> 4; unsigned char* ws = F.ws; LAS unsigned char* lds = F.lds;
    const int it = (F.G == 256) ? (int)(blockIdx.x & 7) * 32 + (int)(blockIdx.x >> 3) : (int)blockIdx.x;
    const int sr = it >> 2, v0r = 16 * (it & 3), rb = sr >> 4, rdir = (sr >> 3) & 1, rh = sr & 7;
    const int sg = it >> 3, v0g = 16 * (it & 7), gb = sg >> 3, gdir = (sg >> 2) & 1, gh = sg & 3;
#define S2_BAR() do { asm volatile("s_waitcnt lgkmcnt(0)" ::: "memory"); __builtin_amdgcn_s_barrier(); asm volatile("" ::: "memory"); } while (0)
    if (wave >= 2) {
        const unsigned char* GTb = (const unsigned char*)F.out + OUT_GT; const unsigned char* QEb = (const unsigned char*)F.out + OUT_QE;
        const unsigned char* RHb = ws + WS_RH; const unsigned char* YLb = ws + WS_YL; const unsigned char* HHb = ws + WS_HH; const unsigned char* KVb = ws + WS_KV; const unsigned char* INb = ws + WS_INTRA;
        const unsigned char* DDb = ws + WS_DD;
#define S2_ISSUE(cc) s2_issue(lds, ((cc) % S2_R) * S2_SLOT, wave - 2, lane, (size_t)(sr * NCHUNK + ((cc) < NCHUNK ? (cc) : NCHUNK - 1)), (size_t)(sg * NCHUNK + ((cc) < NCHUNK ? (cc) : NCHUNK - 1)), v0r, v0g, GTb, RHb, HHb, YLb, QEb, KVb, INb, DDb)
        S2_ISSUE(0); S2_ISSUE(1); S2_ISSUE(2); S2_ISSUE(3); S2_ISSUE(4);
#pragma unroll 1
        for (int c = 0; c < NCHUNK; ++c) {
            asm volatile("s_waitcnt vmcnt(16) ; S2WAIT" ::: "memory");
            S2_BAR();
            S2_ISSUE(c + S2_D);
        }
#undef S2_ISSUE
    } else if (wave == 0) {
        bf16* ORW = (bf16*)(ws + (rdir ? WS_ORWB : WS_ORWF));
        f32x4 S[4];
#pragma unroll
        for (int m = 0; m < 4; ++m) S[m] = (f32x4){0.f, 0.f, 0.f, 0.f};
#pragma unroll 1
        for (int c = 0; c < NCHUNK; ++c) {
            S2_BAR();
            const LAS unsigned char* sl = lds + (c % S2_R) * S2_SLOT;
            const bool emit = c >= CTXL / CH;
            bf16x8 G0[4], G1[4]; v2u Hw[4], Rw0[4], Rw1[4]; unsigned Yw[4];
#pragma unroll
            for (int m = 0; m < 4; ++m) { const int k2 = 16 * m + rr;
                G0[m] = *(const LAS bf16x8*)(sl + (k2 * 8 + (q ^ (k2 & 7))) * 16); G1[m] = *(const LAS bf16x8*)(sl + (k2 * 8 + ((4 + q) ^ (k2 & 7))) * 16);
                Hw[m] = *(const LAS v2u*)(sl + 12288 + (rr * 8 + ((2 * m + (q >> 1)) ^ (rr & 7))) * 16 + (q & 1) * 8); }
            if (emit) {
#pragma unroll
                for (int tt = 0; tt < 4; ++tt) { const int t = 16 * tt + rr;
                    Rw0[tt] = *(const LAS v2u*)(sl + 8192 + (t * 4 + ((q >> 1) ^ (t & 3))) * 16 + (q & 1) * 8); Rw1[tt] = *(const LAS v2u*)(sl + 8192 + (t * 4 + ((2 + (q >> 1)) ^ (t & 3))) * 16 + (q & 1) * 8);
                    Yw[tt] = *(const LAS unsigned*)(sl + 14336 + t * 16 + q * 4); }
            }
            const bf16x8 Sf0 = pack_frag(S[0], S[1]), Sf1 = pack_frag(S[2], S[3]);
            __builtin_amdgcn_sched_barrier(0);
#pragma unroll
            for (int m = 0; m < 4; ++m) { f32x4 acc = unpack4(Hw[m]);
                acc = __builtin_amdgcn_mfma_f32_16x16x32_bf16(G0[m], Sf0, acc, 0, 0, 0);
                acc = __builtin_amdgcn_mfma_f32_16x16x32_bf16(G1[m], Sf1, acc, 0, 0, 0);
                S[m] = acc; }
            if (emit) {
#pragma unroll
                for (int tt = 0; tt < 4; ++tt) { const int t = 16 * tt + rr;
                    const bf16x8 R0 = pack_frag(unpack4_fp8(Rw0[tt].x), unpack4_fp8(Rw0[tt].y)), R1 = pack_frag(unpack4_fp8(Rw1[tt].x), unpack4_fp8(Rw1[tt].y));
                    f32x4 acc = unpack4_fp8(Yw[tt]);
                    acc = __builtin_amdgcn_mfma_f32_16x16x32_bf16(Sf0, R0, acc, 0, 0, 0);
                    acc = __builtin_amdgcn_mfma_f32_16x16x32_bf16(Sf1, R1, acc, 0, 0, 0);
                    const int row = scan_row(c * CH + t, rb, rdir);
                    *(v2u*)(ORW + (size_t)row * RWW + rh * 64 + v0r + 4 * q) = pack4(acc); }
            }
        }
    } else {
        bf16* OGL = (bf16*)(ws + (gdir ? WS_OGLB : WS_OGLF));
        f32x4 S[4];
#pragma unroll
        for (int m = 0; m < 4; ++m) S[m] = (f32x4){0.f, 0.f, 0.f, 0.f};
#pragma unroll 1
        for (int c = 0; c < NCHUNK; ++c) {
            S2_BAR();
            const LAS unsigned char* sl = lds + (c % S2_R) * S2_SLOT + S2_RW;
            const bool emit = c >= CTXL / CH;
            v2u Qw0[4], Qw1[4]; unsigned Iw[4]; v4u kw[2]; f32x4 d0[2], d1[2];
#pragma unroll
            for (int s2 = 0; s2 < 2; ++s2) { kw[s2] = *(const LAS v4u*)(sl + 4096 + (rr * 8 + ((4 * s2 + q) ^ (rr & 7))) * 16);
                d0[s2] = *(const LAS f32x4*)(sl + 7168 + 128 * s2 + 32 * q); d1[s2] = *(const LAS f32x4*)(sl + 7168 + 128 * s2 + 32 * q + 16); }
            if (emit) {
#pragma unroll
                for (int tt = 0; tt < 4; ++tt) { const int t = 16 * tt + rr;
                    Qw0[tt] = *(const LAS v2u*)(sl + (t * 4 + ((q >> 1) ^ (t & 3))) * 16 + (q & 1) * 8); Qw1[tt] = *(const LAS v2u*)(sl + (t * 4 + ((2 + (q >> 1)) ^ (t & 3))) * 16 + (q & 1) * 8);
                    Iw[tt] = *(const LAS unsigned*)(sl + 6144 + t * 16 + q * 4); }
            }
            const bf16x8 Sf0 = pack_frag(S[0], S[1]), Sf1 = pack_frag(S[2], S[3]);
            __builtin_amdgcn_sched_barrier(0);
#pragma unroll
            for (int s2 = 0; s2 < 2; ++s2) { S[2 * s2] = S[2 * s2] * d0[s2] + unpack4((v2u){kw[s2].x, kw[s2].y}); S[2 * s2 + 1] = S[2 * s2 + 1] * d1[s2] + unpack4((v2u){kw[s2].z, kw[s2].w}); }
            if (emit) {
#pragma unroll
                for (int tt = 0; tt < 4; ++tt) { const int t = 16 * tt + rr;
                    const bf16x8 Q0 = pack_frag(unpack4_fp8(Qw0[tt].x), unpack4_fp8(Qw0[tt].y)), Q1 = pack_frag(unpack4_fp8(Qw1[tt].x), unpack4_fp8(Qw1[tt].y));
                    f32x4 acc = unpack4_fp8(Iw[tt]);
                    acc = __builtin_amdgcn_mfma_f32_16x16x32_bf16(Sf0, Q0, acc, 0, 0, 0);
                    acc = __builtin_amdgcn_mfma_f32_16x16x32_bf16(Sf1, Q1, acc, 0, 0, 0);
                    const int row = scan_row(c * CH + t, gb, gdir);
                    *(v2u*)(OGL + (size_t)row * RWW + gh * 128 + v0g + 4 * q) = pack4(acc); }
            }
        }
    }
#undef S2_BAR
}
#endif

#ifndef ML
#define ML 0
#endif
enum Phase { PH_PROLOGUE = 0, PH_A1, PH_INPROJ, PH_FEAT, PH_LORA, PH_SCAN1, PH_SCAN2, PH_MERGE, PH_BRANCH, PH_OUTPROJ, PH_LN1, PH_ROUTER, PH_ROUTE, PH_SCATTER, PH_EXP1, PH_EXP2, PH_FINAL, PH_COUNT };

__global__ void __launch_bounds__(NTHR, 2) mega(Args args) {
    extern __shared__ __attribute__((aligned(16))) unsigned char lds_raw[];
    Frame F;
    F.lds = (LAS unsigned char*)lds_raw;
    F.tid = threadIdx.x; F.lane = F.tid & 63; F.wave = __builtin_amdgcn_readfirstlane(F.tid >> 6);
    F.G = gridDim.x; F.gw = blockIdx.x * NWAVES + F.wave; F.NGW = F.G * NWAVES;
    F.in = args.in; F.out = args.out; F.ws = args.ws; F.ctl = (unsigned*)(args.ws + WS_CTL);
    volatile LAS unsigned* MISC = (volatile LAS unsigned*)(F.lds + MISC_OFF);
    if (F.tid < 64) MISC[F.tid] = 0u;
    __syncthreads();
    XcdBarrier bar; bar.bar = F.ctl + CW_BAR; bar.x = 0; bar.st = nullptr;
#if !ML
    bar = xcd_barrier_post(F.ctl + CW_BAR, MISC + 8);
#endif
    const int lo = args.ph_lo, hi = args.ph_hi;
#define IN(k) (lo <= (k) && (k) < hi)
#ifndef DUP
#define DUP -1
#endif
#define RUN(k, call) do { if (IN(k)) { call; GRID_BAR(); if (DUP == (k)) { call; GRID_BAR(); } } } while (0)
#if ML
#define GRID_BAR() do { } while (0)
#else
#define GRID_BAR() xcd_barrier(bar)
#endif

#if MS >= 2
    RUN(PH_PROLOGUE, ph_prologue(F));
#endif
#if MS >= 3
    RUN(PH_A1, ph_a1(F));
    RUN(PH_INPROJ, ph_inproj(F));
    RUN(PH_FEAT, ph_feat(F));
    RUN(PH_LORA, ph_lora(F));
    RUN(PH_SCAN1, ph_scan1(F));
    RUN(PH_SCAN2, ph_scan2(F));
    RUN(PH_MERGE, ph_merge(F));
    RUN(PH_BRANCH, ph_branch(F));
    RUN(PH_OUTPROJ, ph_outproj(F));
#else
    RUN(PH_OUTPROJ, ph_x1pre_nomix(F));
#endif
    RUN(PH_LN1, ph_ln1(F));
#if MS >= 2
    RUN(PH_ROUTER, ph_router(F));
    RUN(PH_ROUTE, ph_route(F));
    RUN(PH_SCATTER, ph_scatter(F));
    RUN(PH_EXP1, ph_exp1(F));
    RUN(PH_EXP2, ph_exp2(F));
#endif
    if (IN(PH_FINAL)) { ph_final(F); }
#undef IN
}

extern "C" void kernel_launch(void* const* d_in, const int* in_sizes, int n_in, void* d_out, int out_size, void* d_ws, size_t ws_size, hipStream_t stream) {
    static int grid = 0;
    if (grid == 0) {
        if (n_in != 36 || out_size != NLAT * D || ws_size < WS_END) { fprintf(stderr, "kernel_launch: unexpected problem shape (n_in %d, out %d)\n", n_in, out_size); grid = -1; return; }
        int dev = 0, cus = 0, per_cu = 0;
        if (hipGetDevice(&dev) != hipSuccess || hipDeviceGetAttribute(&cus, hipDeviceAttributeMultiprocessorCount, dev) != hipSuccess) { grid = -1; return; }
        if (hipFuncSetAttribute((const void*)mega, hipFuncAttributeMaxDynamicSharedMemorySize, LDS_BYTES) != hipSuccess) { fprintf(stderr, "kernel_launch: hipFuncSetAttribute failed\n"); grid = -1; return; }
        if (hipOccupancyMaxActiveBlocksPerMultiprocessor(&per_cu, (const void*)mega, NTHR, LDS_BYTES) != hipSuccess || per_cu < 1) { fprintf(stderr, "kernel_launch: occupancy query says %d\n", per_cu); }
        (void)hipGetLastError();
        grid = cus > 0 ? cus : 256;
        if (grid > 256) grid = 256;
    }
    if (grid < 0) return;
    (void)hipMemsetAsync((char*)d_ws + WS_CTL, 0, CTL_ZERO_BYTES, stream);
    Args a{};
    for (int i = 0; i < 36; ++i) a.in[i] = (const float*)d_in[i];
    a.out = (float*)d_out; a.ws = (unsigned char*)d_ws;
#if ML
    for (int p = 0; p < PH_COUNT; ++p) { a.ph_lo = p; a.ph_hi = p + 1; hipLaunchKernelGGL(mega, dim3(grid), dim3(NTHR), LDS_BYTES, stream, a); }
#else
    a.ph_lo = 0; a.ph_hi = PH_COUNT;
    hipLaunchKernelGGL(mega, dim3(grid), dim3(NTHR), LDS_BYTES, stream, a);
#endif
}
```

```cpp
#include <hip/hip_runtime.h>
#include <cstdio>
#include <cstdint>

#ifndef MS
#define MS 3
#endif

#define GAS __attribute__((address_space(1)))
#define LAS __attribute__((address_space(3)))
typedef unsigned short bf16;
typedef unsigned v4u __attribute__((ext_vector_type(4)));
typedef unsigned v2u __attribute__((ext_vector_type(2)));
typedef float f32x4 __attribute__((ext_vector_type(4)));
typedef float f32x2 __attribute__((ext_vector_type(2)));
typedef short bf16x8 __attribute__((ext_vector_type(8)));
#define LDS_WAIT() asm volatile("s_waitcnt lgkmcnt(0)" ::: "memory")
#define VM_WAIT() asm volatile("s_waitcnt vmcnt(0)" ::: "memory")

constexpr int D = 1024, NB = 4, SEQ = 8192, CTXL = 256, GRIDW = 64, GRIDH = 128;
constexpr int NLAT = NB * SEQ, NCTX = NB * CTXL, MR = NLAT + NCTX;
constexpr int RWW = 512, RWH = 8, HD = 64;
constexpr int C_R = 0, C_K = 512, C_V = 1024, C_PW = 1536, C_PA = 1568, C_PG = 1600, C_Q = 1696, C_KG = 1952, C_VG = 2208, C_PGL = 2720, C_OG = 2736, C_GRW = 3248, C_GGLA = 4272;
constexpr int IN_COLS = 5296, NP = 5376;
constexpr int NE = 256, TOPK = 8, FF = 256;
constexpr float LN_EPS = 1e-5f, RW_GN_EPS = 64e-5f;
constexpr float ALPHA = 1.189207115f;
constexpr float W8S = 64.0f, W8I = 1.0f / 64.0f;
constexpr int NLORA = 3072, KLORA = 256;
constexpr int MAXTILES = 1280, SH_ROW0 = MAXTILES * 256, NROWS_E = SH_ROW0 + NLAT;

namespace pg8 {
#define PG8_LAS __attribute__((address_space(3)))
typedef unsigned short bf16_t;
typedef unsigned u32x4 __attribute__((ext_vector_type(4)));
typedef unsigned u32x2 __attribute__((ext_vector_type(2)));
typedef long i64x2 __attribute__((ext_vector_type(2)));
constexpr int BM = 256, BK = 64, HALF = 128, HTB = HALF * BK * 2, STAGE_BYTES = 8 * HTB, NXCD = 8, WGM = 8;
constexpr int IDX_OFF = STAGE_BYTES, IDX_UNITS = 12;

__host__ __device__ __forceinline__ int lds_byte(int r, int c) { const int st = (r >> 4) * 2 + (c >> 5), rr = r & 15, cc = c & 31, ob = rr * 64 + cc * 2; return st * 1024 + (ob ^ (((ob >> 9) & 1) << 5)); }
__host__ __device__ __forceinline__ void stage_rc(int b, int& R, int& C) { const int st = b / 1024, sb = b % 1024, swz = sb ^ (((sb >> 9) & 1) << 5); R = (st >> 1) * 16 + swz / 64; C = (st & 1) * 32 + (swz % 64) / 2; }
__host__ __device__ __forceinline__ int perm32(int rho) { const int n = rho >> 4, i = rho & 15; return 8 * (i >> 2) + 4 * n + (i & 3); }

struct Unit { int pm, pn, e, j; };
struct Gemm { const bf16_t* A; const bf16_t* Bt; int M, N, K; const int* rowidx; };

struct StaticOrder {
    int nM, nN, nwg, G, c;
    __host__ __device__ void init(int M, int N, int G_, int c_) { nM = M / BM; nN = N / BM; nwg = nM * nN; G = G_; c = c_; }
    __host__ __device__ bool next(int i, Unit& u) const {
        const long L = (long)i * G + c; if (L >= nwg) return false;
        int wgid = (int)L; { const int q = nwg / NXCD, r = nwg % NXCD, xcd = wgid % NXCD, off = wgid / NXCD; wgid = (xcd < r ? xcd * (q + 1) : r * (q + 1) + (xcd - r) * q) + off; }
        const int nig = WGM * nN, gid = wgid / nig, fm = gid * WGM, gsz = (nM - fm) < WGM ? (nM - fm) : WGM;
        u.pm = fm + ((wgid % nig) % gsz); u.pn = (wgid % nig) / gsz; u.e = 0; u.j = u.pn; return true;
    }
};
struct MoeOrder {
    int nN, G, c, NT; const int* tile_e;
    __device__ bool next(int i, Unit& u) const {
        const int L = i * G + c; const int total = (NT + NLAT / 256) * nN; if (L >= total) return false;
        const int tile = L / nN, j = L - tile * nN; int e, pm;
        if (tile < NT) { e = tile_e[tile]; pm = tile; } else { e = NE; pm = MAXTILES + (tile - NT); }
        u.pm = pm; u.pn = e * nN + j; u.e = e; u.j = j; return true;
    }
};

typedef __bf16 bf16x2n __attribute__((ext_vector_type(2))); typedef float f32x2n __attribute__((ext_vector_type(2)));
__device__ __forceinline__ unsigned cvt_pk_bf16(float lo, float hi) { const f32x2n v = {lo, hi}; return __builtin_bit_cast(unsigned, __builtin_convertvector(v, bf16x2n)); }

template <class Epi, class Sched, bool ALIGN_EPI, bool SP2, bool GATHER, bool FP8 = false>
__device__ __forceinline__ void gemm_phase(PG8_LAS unsigned char* lds, const Gemm g, const Sched& S, const Epi& E) {
    const int tid = threadIdx.x, wid = __builtin_amdgcn_readfirstlane(tid >> 6), lane = tid & 63, wr = wid >> 2, wc = wid & 3, fr = lane & 15, fq = lane >> 4;
    const int K = g.K, nt = K / BK;
    const size_t kstep = (size_t)(BK * 2);
    const size_t hstep = (size_t)HALF * K * 2;
    const size_t tstep = 2 * hstep;
    unsigned voffB[2]; unsigned va[2][2];
#pragma unroll
    for (int i = 0; i < 2; ++i) { int R, C; stage_rc(tid * 16 + i * 8192, R, C); const int Rb = Epi::PERM ? ((R & ~31) + perm32(R & 31)) : R;
        voffB[i] = (unsigned)(Rb * K + C) * 2u;
        va[0][i] = (unsigned)(R * K + C) * 2u; va[1][i] = va[0][i]; }
    const size_t ah = GATHER ? (size_t)0 : hstep;
#define PG8_GOFF(dst, ub) do { _Pragma("unroll") for (int _h = 0; _h < 2; ++_h) _Pragma("unroll") for (int _i = 0; _i < 2; ++_i) { int _R, _C; stage_rc(tid * 16 + _i * 8192, _R, _C); \
        dst[_h][_i] = (unsigned)(idxt[(ub) * 256 + _h * 128 + _R] * K + _C) * 2u; } } while (0)
    const unsigned ldsw = (unsigned)wid * 1024u;
    const int aoff = lds_byte(wr * 64 + fr, fq * 8), boff = lds_byte(wc * 32 + fr, fq * 8);
    PG8_LAS int* idxt = (PG8_LAS int*)(lds + IDX_OFF);
#define PG8_SA(b, h) (((b) * 2 + (h)) * HTB)
#define PG8_SB(b, h) ((4 + (b) * 2 + (h)) * HTB)
#define PG8_STAGE(bufoff, gbase, voff) do { _Pragma("unroll") for (int _i = 0; _i < 2; ++_i) \
        __builtin_amdgcn_global_load_lds((const unsigned*)((const char*)(gbase) + (voff)[_i]), (PG8_LAS unsigned*)(lds + (bufoff) + ldsw + _i * 8192), 16, 0, 0); } while (0)
#define PG8_LDA(dst, b, h) do { _Pragma("unroll") for (int m = 0; m < 4; ++m) _Pragma("unroll") for (int k = 0; k < 2; ++k) dst[m][k] = *(const PG8_LAS bf16x8*)(lds + PG8_SA(b, h) + aoff + m * 2048 + k * 1024); } while (0)
#define PG8_LDB(dst, b, h) do { _Pragma("unroll") for (int n = 0; n < 2; ++n) _Pragma("unroll") for (int k = 0; k < 2; ++k) dst[n][k] = *(const PG8_LAS bf16x8*)(lds + PG8_SB(b, h) + boff + n * 2048 + k * 1024); } while (0)
#define PG8_MMA(ai, bj, At, Bt) do { __builtin_amdgcn_s_setprio(1); _Pragma("unroll") for (int m = 0; m < 4; ++m) _Pragma("unroll") for (int n = 0; n < 2; ++n) _Pragma("unroll") for (int k = 0; k < 2; ++k) { \
        if constexpr (FP8) { const i64x2 _b = __builtin_bit_cast(i64x2, Bt[n][k]), _a = __builtin_bit_cast(i64x2, At[m][k]); \
            acc[ai][bj][m][n] = __builtin_amdgcn_mfma_f32_16x16x32_fp8_fp8(_b[0], _a[0], acc[ai][bj][m][n], 0, 0, 0); acc[ai][bj][m][n] = __builtin_amdgcn_mfma_f32_16x16x32_fp8_fp8(_b[1], _a[1], acc[ai][bj][m][n], 0, 0, 0); } \
        else acc[ai][bj][m][n] = __builtin_amdgcn_mfma_f32_16x16x32_bf16(Bt[n][k], At[m][k], acc[ai][bj][m][n], 0, 0, 0); } __builtin_amdgcn_s_setprio(0); } while (0)
#define PG8_WAIT_V(n) asm volatile("s_waitcnt vmcnt(" #n ")" ::: "memory")
#define PG8_WAIT_L(n) asm volatile("s_waitcnt lgkmcnt(" #n ")" ::: "memory")
#define PG8_BAR __builtin_amdgcn_s_barrier()
#define PG8_SCHED __builtin_amdgcn_sched_barrier(0)
    Unit cur, nxt; int ui = 0;
    if (!S.next(0, cur)) return;
#ifdef GEMM_STAGGER
    if constexpr (FP8) {
        const unsigned long long t0 = __builtin_amdgcn_s_memrealtime(); const unsigned long long dl = (unsigned long long)(blockIdx.x & 3) * GEMM_STAGGER;
        while (__builtin_amdgcn_s_memrealtime() - t0 < dl) __builtin_amdgcn_s_sleep(8);
    }
#endif
    if constexpr (GATHER) {
        Unit uu;
        for (int i = 0; i < IDX_UNITS; ++i) { if (!S.next(i, uu)) break; if (tid < 256) idxt[i * 256 + tid] = g.rowidx[(size_t)uu.pm * 256 + tid]; }
        asm volatile("s_waitcnt vmcnt(0) lgkmcnt(0)" ::: "memory"); PG8_BAR; asm volatile("" ::: "memory");
        PG8_GOFF(va, 0);
    }
    f32x4 acc[2][2][4][2];
#pragma unroll
    for (int a = 0; a < 2; ++a)
#pragma unroll
        for (int b = 0; b < 2; ++b)
#pragma unroll
            for (int m = 0; m < 4; ++m)
#pragma unroll
                for (int n = 0; n < 2; ++n) acc[a][b][m][n] = (f32x4){0.f, 0.f, 0.f, 0.f};
    bf16x8 At[4][2], B0[2][2], B1[2][2];
    const char* cA = (const char*)g.A + (GATHER ? (size_t)0 : (size_t)cur.pm * tstep); const char* cB = (const char*)g.Bt + (size_t)cur.pn * tstep;
    if constexpr (SP2) {
        PG8_STAGE(PG8_SB(0, 0), cB, voffB); PG8_STAGE(PG8_SB(0, 1), cB + hstep, voffB); PG8_STAGE(PG8_SA(0, 0), cA, va[0]); PG8_STAGE(PG8_SA(0, 1), cA + ah, va[1]);
        if (wr == 1) PG8_BAR;
        PG8_WAIT_V(2); PG8_BAR;
        PG8_STAGE(PG8_SB(1, 0), cB + kstep, voffB); PG8_STAGE(PG8_SA(1, 0), cA + kstep, va[0]); PG8_STAGE(PG8_SB(1, 1), cB + hstep + kstep, voffB);
        PG8_WAIT_V(6); PG8_BAR;
    } else {
        PG8_STAGE(PG8_SB(0, 0), cB, voffB); PG8_STAGE(PG8_SA(0, 0), cA, va[0]); PG8_STAGE(PG8_SB(0, 1), cB + hstep, voffB); PG8_STAGE(PG8_SA(0, 1), cA + ah, va[1]);
        if (wr == 1) PG8_BAR;
        PG8_WAIT_V(4); PG8_BAR;
        PG8_STAGE(PG8_SB(1, 0), cB + kstep, voffB); PG8_STAGE(PG8_SA(1, 0), cA + kstep, va[0]); PG8_STAGE(PG8_SB(1, 1), cB + hstep + kstep, voffB);
        PG8_WAIT_V(6); PG8_BAR;
    }
    for (;;) {
        const bool has_next = S.next(ui + 1, nxt);
        const char* nA = has_next ? (const char*)g.A + (GATHER ? (size_t)0 : (size_t)nxt.pm * tstep) : cA; const char* nB = has_next ? (const char*)g.Bt + (size_t)nxt.pn * tstep : cB;
        const int ubn = (has_next && ui + 1 < IDX_UNITS) ? (ui + 1) : ui;
#pragma unroll 1
        for (int t = 0; t < nt; t += 2) {
            const bool last = (t == nt - 2);
            const char* a1 = cA + (size_t)(t + 1) * kstep;
            const char* a2 = last ? nA : cA + (size_t)(t + 2) * kstep; const char* b2 = last ? nB : cB + (size_t)(t + 2) * kstep;
            const char* a3 = a2 + kstep; const char* b3 = b2 + kstep;
            unsigned v2[2][2];
#pragma unroll
            for (int h = 0; h < 2; ++h)
#pragma unroll
                for (int i = 0; i < 2; ++i) v2[h][i] = va[h][i];
            if constexpr (GATHER) { if (last) PG8_GOFF(v2, ubn); }
            if constexpr (SP2) {
            PG8_LDB(B0, 0, 0); PG8_LDB(B1, 0, 1); PG8_SCHED; PG8_LDA(At, 0, 0); PG8_STAGE(PG8_SA(1, 1), a1 + ah, va[1]);
            PG8_WAIT_V(8); PG8_WAIT_L(0); PG8_BAR; PG8_MMA(0, 0, At, B0); PG8_MMA(0, 1, At, B1); PG8_BAR; PG8_SCHED;
            PG8_LDA(At, 0, 1); PG8_STAGE(PG8_SB(0, 0), b2, voffB); PG8_STAGE(PG8_SB(0, 1), b2 + hstep, voffB); PG8_STAGE(PG8_SA(0, 0), a2, v2[0]);
            PG8_WAIT_V(8); PG8_WAIT_L(0); PG8_BAR; PG8_MMA(1, 0, At, B0); PG8_MMA(1, 1, At, B1); PG8_BAR; PG8_SCHED;
            PG8_LDB(B0, 1, 0); PG8_LDB(B1, 1, 1); PG8_SCHED; PG8_LDA(At, 1, 0); PG8_STAGE(PG8_SA(0, 1), a2 + ah, v2[1]);
            PG8_WAIT_V(8); PG8_WAIT_L(0); PG8_BAR; PG8_MMA(0, 0, At, B0); PG8_MMA(0, 1, At, B1); PG8_BAR; PG8_SCHED;
            PG8_LDA(At, 1, 1); PG8_STAGE(PG8_SB(1, 0), b3, voffB); PG8_STAGE(PG8_SB(1, 1), b3 + hstep, voffB); PG8_STAGE(PG8_SA(1, 0), a3, v2[0]);
            PG8_WAIT_V(8); PG8_WAIT_L(0); PG8_BAR; PG8_MMA(1, 0, At, B0); PG8_MMA(1, 1, At, B1); PG8_BAR; PG8_SCHED;
            } else {
            PG8_LDB(B0, 0, 0); PG8_SCHED; PG8_LDA(At, 0, 0); PG8_STAGE(PG8_SA(1, 1), a1 + ah, va[1]);
            PG8_WAIT_L(8); PG8_BAR; PG8_WAIT_L(0); PG8_MMA(0, 0, At, B0); PG8_BAR; PG8_SCHED;
            PG8_LDB(B1, 0, 1); PG8_STAGE(PG8_SB(0, 0), b2, voffB);
            PG8_BAR; PG8_WAIT_L(0); PG8_MMA(0, 1, At, B1); PG8_BAR;
            PG8_LDA(At, 0, 1); PG8_STAGE(PG8_SA(0, 0), a2, v2[0]);
            PG8_BAR; PG8_WAIT_L(0); PG8_MMA(1, 0, At, B0); PG8_BAR; PG8_SCHED;
            PG8_STAGE(PG8_SB(0, 1), b2 + hstep, voffB);
            PG8_WAIT_V(6); PG8_BAR; PG8_MMA(1, 1, At, B1); PG8_BAR;
            PG8_LDB(B0, 1, 0); PG8_SCHED; PG8_LDA(At, 1, 0); PG8_STAGE(PG8_SA(0, 1), a2 + ah, v2[1]);
            PG8_WAIT_L(8); PG8_BAR; PG8_WAIT_L(0); PG8_MMA(0, 0, At, B0); PG8_BAR; PG8_SCHED;
            PG8_LDB(B1, 1, 1); PG8_STAGE(PG8_SB(1, 0), b3, voffB);
            PG8_BAR; PG8_WAIT_L(0); PG8_MMA(0, 1, At, B1); PG8_BAR;
            PG8_LDA(At, 1, 1); PG8_STAGE(PG8_SA(1, 0), a3, v2[0]);
            PG8_BAR; PG8_WAIT_L(0); PG8_MMA(1, 0, At, B0); PG8_BAR; PG8_SCHED;
            PG8_STAGE(PG8_SB(1, 1), b3 + hstep, voffB);
            PG8_WAIT_V(6); PG8_BAR; PG8_MMA(1, 1, At, B1); PG8_BAR;
            }
        }
        if constexpr (ALIGN_EPI) { if (wr == 0) PG8_BAR; }
        E(acc, cur, wr, wc, fr, fq);
        if (!has_next) break;
#pragma unroll
        for (int a = 0; a < 2; ++a)
#pragma unroll
            for (int b = 0; b < 2; ++b)
#pragma unroll
                for (int m = 0; m < 4; ++m)
#pragma unroll
                    for (int n = 0; n < 2; ++n) acc[a][b][m][n] = (f32x4){0.f, 0.f, 0.f, 0.f};
        cur = nxt; cA = nA; cB = nB; ++ui;
        if constexpr (GATHER) PG8_GOFF(va, ubn);
        if constexpr (ALIGN_EPI) { if (wr == 1) PG8_BAR; }
    }
    PG8_WAIT_V(0);
    if constexpr (!ALIGN_EPI) { if (wr == 0) PG8_BAR; }
    PG8_BAR;
#undef PG8_SA
#undef PG8_GOFF
#undef PG8_SB
#undef PG8_STAGE
#undef PG8_LDA
#undef PG8_LDB
#undef PG8_MMA
#undef PG8_WAIT_V
#undef PG8_WAIT_L
#undef PG8_BAR
#undef PG8_SCHED
}
}

#define XB_TMO      128
#define XB_XCNT(j)  (256  + 64 * (j))
#define XB_XSUB(j)  (1280 + 64 * (j))
#define XB_XGEN(j)  (2304 + 64 * (j))
#define XB_TOP      3328
#define XB_TOPGEN   3392
#define XCD_BAR_WORDS 3456
#define XB_SPIN_CAP (1u << 18)
__device__ __forceinline__ unsigned xb_ld(unsigned* p)              { return __hip_atomic_load(p, __ATOMIC_RELAXED, __HIP_MEMORY_SCOPE_AGENT); }
__device__ __forceinline__ unsigned xb_add(unsigned* p, unsigned v) { return __hip_atomic_fetch_add(p, v, __ATOMIC_RELAXED, __HIP_MEMORY_SCOPE_AGENT); }
__device__ __forceinline__ unsigned xb_xcc_id() { return (unsigned)__builtin_amdgcn_s_getreg((3 << 11) | 20) & 0xFu; }
#define XB_SPIN(cond, bar) do { unsigned _sp = 0; while (cond) { __builtin_amdgcn_s_sleep(1); \
    if ((++_sp & 255u) == 0u) { if (xb_ld(&(bar)[XB_TMO])) break; if (_sp > XB_SPIN_CAP) { atomicAdd(&(bar)[XB_TMO], 1u); break; } } } } while (0)
struct XcdBarrier { unsigned* bar; unsigned x; volatile LAS unsigned* st; };
__device__ __forceinline__ XcdBarrier xcd_barrier_post(unsigned* bar, volatile LAS unsigned* st) {
    XcdBarrier b; b.bar = bar; b.x = xb_xcc_id(); b.st = st;
    if (threadIdx.x == 0) (void)xb_add(&bar[XB_XCNT(b.x)], 1u);
    return b;
}
__device__ __forceinline__ void xcd_barrier_complete(unsigned* bar, unsigned x, unsigned& nloc, unsigned& nx) {
    const unsigned G = gridDim.x * gridDim.y * gridDim.z;
    unsigned sum, cnt, mine, sp = 0u;
    for (;;) {
        sum = 0u; cnt = 0u; mine = 0u;
#pragma unroll
        for (unsigned j = 0; j < 16; ++j) { const unsigned c = xb_ld(&bar[XB_XCNT(j)]); sum += c; cnt += (c > 0u) ? 1u : 0u; mine = (j == x) ? c : mine; }
        if (sum == G) break;
        __builtin_amdgcn_s_sleep(1);
        if ((++sp & 255u) == 0u) { if (xb_ld(&bar[XB_TMO])) break; if (sp > XB_SPIN_CAP) { atomicAdd(&bar[XB_TMO], 1u); break; } }
    }
    nloc = mine > 0u ? mine : 1u; nx = cnt > 0u ? cnt : 1u;
}
__device__ __forceinline__ void xcd_barrier(const XcdBarrier& b) {
    asm volatile("s_waitcnt vmcnt(0)" ::: "memory");
    __syncthreads();
    if (threadIdx.x == 0) {
        unsigned* bar = b.bar;
        __builtin_amdgcn_s_waitcnt(0);
        unsigned nloc = b.st[0], nx = b.st[1];
        if (nloc == 0u) { xcd_barrier_complete(bar, b.x, nloc, nx); b.st[0] = nloc; b.st[1] = nx; }
        const unsigned old = xb_add(&bar[XB_XSUB(b.x)], 1u);
        const unsigned gen = old / nloc;
        if (old + 1u == (gen + 1u) * nloc) {
            __builtin_amdgcn_fence(__ATOMIC_RELEASE, "agent");
            asm volatile("s_waitcnt vmcnt(0)" ::: "memory");
            const unsigned og = xb_add(&bar[XB_TOP], 1u);
            const unsigned tg = og / nx;
            if (og + 1u == (tg + 1u) * nx) xb_add(&bar[XB_TOPGEN], 1u);
            else XB_SPIN(xb_ld(&bar[XB_TOPGEN]) == tg, bar);
            __builtin_amdgcn_fence(__ATOMIC_ACQUIRE, "agent");
            xb_add(&bar[XB_XGEN(b.x)], 1u);
            asm volatile("s_waitcnt vmcnt(0)" ::: "memory");
        } else {
            XB_SPIN(xb_ld(&bar[XB_XGEN(b.x)]) == gen, bar);
            __builtin_amdgcn_fence(__ATOMIC_ACQUIRE, "agent");
            asm volatile("s_waitcnt vmcnt(0)" ::: "memory");
        }
    }
    __syncthreads();
}

constexpr size_t MiB = 1u << 20;
constexpr size_t al(size_t x) { return (x + 4095) & ~(size_t)4095; }
constexpr size_t WS_CTL = 0, CTL_ZERO_BYTES = 1 * MiB;
constexpr int CW_BAR = 4096;
constexpr int CW_CNT = 16384, CNT_STRIDE = 64;
constexpr int CW_NT = CW_CNT + NE * CNT_STRIDE + 64;
static_assert((CW_NT + 1) * 4 <= (int)CTL_ZERO_BYTES, "control words inside the per-call memset");
constexpr size_t WS_MOD = 1 * MiB;
constexpr size_t WS_TILE_E = WS_MOD + 256 * 1024;
constexpr size_t WS_PADSTART = WS_TILE_E + 16 * 1024;
constexpr size_t WS_ROWTOK = 2 * MiB;
constexpr size_t WS_EIDX = 4 * MiB;
constexpr size_t WS_GATE = 5 * MiB;
constexpr size_t WS_DEST = 6 * MiB;
constexpr size_t WS_WIN = 8 * MiB;
constexpr size_t WS_WLORA = WS_WIN + al((size_t)NP * D * 2);
constexpr size_t WS_WBRRW = WS_WLORA + al((size_t)NLORA * KLORA * 2);
constexpr size_t WS_WBRGLA = WS_WBRRW + al((size_t)D * RWW * 2);
constexpr size_t WS_WOUT = WS_WBRGLA + al((size_t)D * RWW * 2);
constexpr size_t WS_WROUTER = WS_WOUT + al((size_t)D * D * 2);
constexpr size_t WS_WGU = WS_WROUTER + al((size_t)NE * D * 2);
constexpr size_t WS_WD = WS_WGU + al((size_t)(NE + 1) * 512 * D * 2);
constexpr size_t WS_PERSIST_END = WS_WD + al((size_t)(NE + 1) * D * FF * 2);
constexpr size_t WS_REGB = WS_PERSIST_END;
constexpr size_t SZ512F = al((size_t)MR * RWW * 4), SZ256F = al((size_t)MR * 256 * 4), SZ512H = al((size_t)MR * RWW * 2);
constexpr size_t WS_A1 = WS_REGB;
constexpr size_t WS_A2 = WS_A1;
constexpr size_t WS_KSUM = WS_A2 + al((size_t)MR * KLORA * 2);
static_assert(WS_KSUM + SZ512H <= WS_A1 + al((size_t)MR * D * 2), "A2 + KSUM fit in the A1 slot");
constexpr size_t WS_P = WS_A1 + al((size_t)MR * D * 2);
constexpr size_t WS_RB = WS_P + al((size_t)MR * NP * 2);
constexpr size_t WS_VB = WS_RB + SZ512H, WS_KKB = WS_VB + SZ512H, WS_KMF = WS_KKB + SZ512H, WS_KMB = WS_KMF + SZ512H, WS_BVF = WS_KMB + SZ512H, WS_BVB = WS_BVF + SZ512H;
constexpr size_t WS_LWF = WS_BVB + SZ512H, WS_LWB = WS_LWF + SZ512F;
constexpr size_t SZ256H = al((size_t)MR * 256 * 2);
constexpr size_t WS_QGB = WS_LWB + SZ512F, WS_KGB = WS_QGB + SZ256H, WS_VGB = WS_KGB + SZ256H, WS_LAF = WS_VGB + SZ512H, WS_LAB = WS_LAF + SZ256F;
constexpr size_t WS_RWG = WS_LAB + SZ256F;
constexpr size_t WS_ORWF = WS_RWG + SZ512H, WS_ORWB = WS_ORWF + SZ512H, WS_OGLF = WS_ORWB + SZ512H, WS_OGLB = WS_OGLF + SZ512H;
constexpr int CH = 64, NCHUNK = (CTXL + SEQ) / CH, NU_RW = 64 * NCHUNK, NU_GL = 32 * NCHUNK;
constexpr size_t WS_RH = WS_OGLB + SZ512H;
constexpr size_t WS_YL = WS_RH + al((size_t)NU_RW * 4096 * 2);
constexpr size_t WS_HH = WS_YL + al((size_t)NU_RW * 4096 * 2);
constexpr size_t WS_INTRA = WS_HH + al((size_t)NU_RW * 4096 * 2);
constexpr size_t WS_KV = WS_INTRA + al((size_t)NU_GL * 8192 * 2);
constexpr size_t WS_DD = WS_KV + al((size_t)NU_GL * 8192 * 2);
constexpr size_t WS_END_MIX = WS_DD + al((size_t)NU_GL * 64 * 4);
constexpr size_t OUT_GT = 0, OUT_QE = (size_t)NU_RW * 4096 * 2;
static_assert(OUT_QE + (size_t)NU_GL * 4096 * 2 <= (size_t)NLAT * D * 4, "scan scratch fits in d_out");
constexpr size_t WS_YRW = WS_LWF, WS_YGLA = WS_LWB, WS_Z = WS_HH;
static_assert((size_t)NLAT * D * 2 <= (size_t)NU_RW * 4096 * 2, "Z fits in the HH slot");
constexpr size_t WS_X1 = WS_REGB;
constexpr size_t WS_A3 = WS_X1 + al((size_t)NLAT * D * 4);
constexpr size_t WS_LOGITS = WS_A3 + al((size_t)NLAT * D * 2);
constexpr size_t WS_ACT = WS_LOGITS + al((size_t)NLAT * NE * 4);
constexpr size_t WS_Y = WS_ACT + al((size_t)NROWS_E * FF * 2);
constexpr size_t WS_A3F = WS_Y + al((size_t)NROWS_E * D);
constexpr size_t WS_END_MOE = WS_A3F + al((size_t)NLAT * D);
constexpr size_t WS_END = WS_END_MIX > WS_END_MOE ? WS_END_MIX : WS_END_MOE;
static_assert(WS_END <= (size_t)2048 * MiB, "workspace map exceeds 2 GiB");

constexpr int RING_BYTES = 131072;
constexpr int IDX_BYTES = pg8::IDX_UNITS * 256 * 4;
constexpr int MISC_OFF = RING_BYTES + IDX_BYTES;
constexpr int LDS_BYTES = MISC_OFF + 256;
static_assert(pg8::IDX_OFF == RING_BYTES, "gather table sits right above the stage buffers");
constexpr int NWAVES = 8, NTHR = 512;

struct Args { const float* in[36]; float* out; unsigned char* ws; int ph_lo, ph_hi; };

struct Frame {
    LAS unsigned char* lds;
    int tid, lane, wave, G, gw, NGW;
    const float* const* in; float* out; unsigned char* ws; unsigned* ctl;
};

__device__ __forceinline__ float wave_sum(float v) {
#pragma unroll
    for (int o = 1; o < 64; o <<= 1) v += __shfl_xor(v, o);
    return v;
}
__device__ __forceinline__ unsigned f2bf(float f) { unsigned u = __builtin_bit_cast(unsigned, f); return (u + 0x7fffu + ((u >> 16) & 1u)) >> 16; }
typedef __bf16 bf16x2v __attribute__((ext_vector_type(2)));
__device__ __forceinline__ unsigned pk2(float lo, float hi) { const f32x2 v = {lo, hi}; return __builtin_bit_cast(unsigned, __builtin_convertvector(v, bf16x2v)); }
__device__ __forceinline__ float bflo(unsigned w) { return __builtin_bit_cast(float, w << 16); }
__device__ __forceinline__ float bfhi(unsigned w) { return __builtin_bit_cast(float, w & 0xffff0000u); }
__device__ __forceinline__ float sigmoidf_(float x) { return 1.0f / (1.0f + __expf(-x)); }
__device__ __forceinline__ float siluf_(float x) { return x / (1.0f + __expf(-x)); }

__device__ __forceinline__ void ln_stats(const f32x4 (&v)[4], float& mean, float& rstd) {
    float s = 0.f;
#pragma unroll
    for (int j = 0; j < 4; ++j) s += (v[j].x + v[j].y) + (v[j].z + v[j].w);
    mean = wave_sum(s) * (1.f / D); float s2 = 0.f;
#pragma unroll
    for (int j = 0; j < 4; ++j) { const f32x4 d = v[j] - mean; s2 += (d.x * d.x + d.y * d.y) + (d.z * d.z + d.w * d.w); }
    rstd = 1.f / sqrtf(wave_sum(s2) * (1.f / D) + LN_EPS);
}

__device__ __forceinline__ unsigned pack_fp8x4(const f32x4 v) {
    int w = __builtin_amdgcn_cvt_pk_fp8_f32(__builtin_amdgcn_fmed3f(v[0], -448.f, 448.f), __builtin_amdgcn_fmed3f(v[1], -448.f, 448.f), 0, false);
    return (unsigned)__builtin_amdgcn_cvt_pk_fp8_f32(__builtin_amdgcn_fmed3f(v[2], -448.f, 448.f), __builtin_amdgcn_fmed3f(v[3], -448.f, 448.f), w, true); }
__device__ __forceinline__ void ld_row_bf16(const bf16* row, int lane, f32x4 (&v)[4]) {
    const v4u a = *(const v4u*)(row + 8 * lane), b = *(const v4u*)(row + 512 + 8 * lane);
    v[0] = (f32x4){bflo(a.x), bfhi(a.x), bflo(a.y), bfhi(a.y)}; v[1] = (f32x4){bflo(a.z), bfhi(a.z), bflo(a.w), bfhi(a.w)};
    v[2] = (f32x4){bflo(b.x), bfhi(b.x), bflo(b.y), bfhi(b.y)}; v[3] = (f32x4){bflo(b.z), bfhi(b.z), bflo(b.w), bfhi(b.w)};
}
__device__ __forceinline__ int rowcol(int lane, int j) { return 512 * (j >> 1) + 8 * lane + 4 * (j & 1); }
__device__ __forceinline__ void ph_x1pre_nomix(Frame& F) {
    const float* x = F.in[0];
    for (int m = F.gw; m < NLAT; m += F.NGW) {
        bf16* o = (bf16*)(F.ws + WS_X1) + (size_t)m * D;
#pragma unroll
        for (int h = 0; h < 2; ++h) { const float* xr = x + (size_t)m * D + 512 * h + 8 * F.lane; const f32x4 a = *(const f32x4*)xr * ALPHA, b = *(const f32x4*)(xr + 4) * ALPHA;
            v4u w; w.x = pk2(a.x, a.y); w.y = pk2(a.z, a.w); w.z = pk2(b.x, b.y); w.w = pk2(b.z, b.w); *(v4u*)(o + 512 * h + 8 * F.lane) = w; }
    }
}
__device__ __forceinline__ void ph_ln1(Frame& F) {
    const float* lw = F.in[26]; const float* lb = F.in[27]; const float* mod = (const float*)(F.ws + WS_MOD);
    bf16* A3 = (bf16*)(F.ws + WS_A3); const bf16* X1P = (const bf16*)(F.ws + WS_X1);
    constexpr int NR = 4;
    for (int m0 = F.gw; m0 < NLAT; m0 += NR * F.NGW) {
        v4u w[NR][2];
#pragma unroll
        for (int r = 0; r < NR; ++r) { const int mm = m0 + r * F.NGW; const bf16* row = X1P + (size_t)(mm < NLAT ? mm : m0) * D; w[r][0] = *(const v4u*)(row + 8 * F.lane); w[r][1] = *(const v4u*)(row + 512 + 8 * F.lane); }
        __builtin_amdgcn_sched_barrier(0);
#pragma unroll
        for (int r = 0; r < NR; ++r) { const int mm = m0 + r * F.NGW; const int m = mm < NLAT ? mm : m0; const int b = m / SEQ;
            f32x4 v[4];
            v[0] = (f32x4){bflo(w[r][0].x), bfhi(w[r][0].x), bflo(w[r][0].y), bfhi(w[r][0].y)}; v[1] = (f32x4){bflo(w[r][0].z), bfhi(w[r][0].z), bflo(w[r][0].w), bfhi(w[r][0].w)};
            v[2] = (f32x4){bflo(w[r][1].x), bfhi(w[r][1].x), bflo(w[r][1].y), bfhi(w[r][1].y)}; v[3] = (f32x4){bflo(w[r][1].z), bfhi(w[r][1].z), bflo(w[r][1].w), bfhi(w[r][1].w)};
            float mean, rstd; ln_stats(v, mean, rstd);
#if MS >= 2
            f32x4 h[4];
#pragma unroll
            for (int j = 0; j < 4; ++j) { const int c = rowcol(F.lane, j);
                const f32x4 x1 = (v[j] - mean) * rstd * *(const f32x4*)(lw + c) + *(const f32x4*)(lb + c);
                h[j] = x1 * (*(const f32x4*)(mod + b * 6144 + 4096 + c) + 1.0f) + *(const f32x4*)(mod + b * 6144 + 3072 + c); }
            bf16* ao = A3 + (size_t)m * D;
            { v4u o; o.x = pk2(h[0].x, h[0].y); o.y = pk2(h[0].z, h[0].w); o.z = pk2(h[1].x, h[1].y); o.w = pk2(h[1].z, h[1].w); *(v4u*)(ao + 8 * F.lane) = o;
              o.x = pk2(h[2].x, h[2].y); o.y = pk2(h[2].z, h[2].w); o.z = pk2(h[3].x, h[3].y); o.w = pk2(h[3].z, h[3].w); *(v4u*)(ao + 512 + 8 * F.lane) = o; }
            { unsigned char* af = F.ws + WS_A3F + (size_t)m * D; v2u o8;
              o8.x = pack_fp8x4(h[0]); o8.y = pack_fp8x4(h[1]); *(v2u*)(af + 8 * F.lane) = o8; o8.x = pack_fp8x4(h[2]); o8.y = pack_fp8x4(h[3]); *(v2u*)(af + 512 + 8 * F.lane) = o8; }
#endif
        }
    }
}
__device__ __forceinline__ f32x4 fp8x4(unsigned w) { const f32x2 lo = __builtin_amdgcn_cvt_pk_f32_fp8((int)w, false), hi = __builtin_amdgcn_cvt_pk_f32_fp8((int)w, true); return (f32x4){lo.x, lo.y, hi.x, hi.y}; }
__device__ __forceinline__ void ph_final(Frame& F) {
    const float* lw = F.in[34]; const float* lb = F.in[35]; const float* mod = (const float*)(F.ws + WS_MOD);
    const float* lw1 = F.in[26]; const float* lb1 = F.in[27]; const bf16* X1P = (const bf16*)(F.ws + WS_X1);
    const unsigned char* Y = F.ws + WS_Y; const int* DEST = (const int*)(F.ws + WS_DEST); const float* GATE = (const float*)(F.ws + WS_GATE);
    const int c0 = 16 * F.lane;
    for (int m0 = F.gw; m0 < NLAT; m0 += 2 * F.NGW) {
        int mm[2]; mm[0] = m0; mm[1] = (m0 + F.NGW < NLAT) ? m0 + F.NGW : m0;
        v4u xw[2][2];
#if MS >= 2
        v4u dw[2][2]; f32x4 gw[2][2];
#pragma unroll
        for (int r = 0; r < 2; ++r) { dw[r][0] = *(const v4u*)(DEST + mm[r] * 8); dw[r][1] = *(const v4u*)(DEST + mm[r] * 8 + 4); gw[r][0] = *(const f32x4*)(GATE + mm[r] * 8); gw[r][1] = *(const f32x4*)(GATE + mm[r] * 8 + 4); }
#endif
#pragma unroll
        for (int r = 0; r < 2; ++r) { const bf16* row = X1P + (size_t)mm[r] * D + c0; xw[r][0] = *(const v4u*)row; xw[r][1] = *(const v4u*)(row + 8); }
#if MS >= 2
        v4u yw[2][TOPK + 1];
#pragma unroll
        for (int r = 0; r < 2; ++r) {
            int dr[TOPK]; dr[0] = (int)dw[r][0].x; dr[1] = (int)dw[r][0].y; dr[2] = (int)dw[r][0].z; dr[3] = (int)dw[r][0].w; dr[4] = (int)dw[r][1].x; dr[5] = (int)dw[r][1].y; dr[6] = (int)dw[r][1].z; dr[7] = (int)dw[r][1].w;
#pragma unroll
            for (int k = 0; k <= TOPK; ++k) yw[r][k] = *(const v4u*)(Y + (size_t)(k < TOPK ? dr[k < TOPK ? k : 0] : SH_ROW0 + mm[r]) * D + c0); }
        __builtin_amdgcn_sched_barrier(0);
#endif
#pragma unroll
        for (int r = 0; r < 2; ++r) { const int m = mm[r]; const int b = m / SEQ;
            f32x4 v[4];
            v[0] = (f32x4){bflo(xw[r][0].x), bfhi(xw[r][0].x), bflo(xw[r][0].y), bfhi(xw[r][0].y)}; v[1] = (f32x4){bflo(xw[r][0].z), bfhi(xw[r][0].z), bflo(xw[r][0].w), bfhi(xw[r][0].w)};
            v[2] = (f32x4){bflo(xw[r][1].x), bfhi(xw[r][1].x), bflo(xw[r][1].y), bfhi(xw[r][1].y)}; v[3] = (f32x4){bflo(xw[r][1].z), bfhi(xw[r][1].z), bflo(xw[r][1].w), bfhi(xw[r][1].w)};
            { float mean1, rstd1; ln_stats(v, mean1, rstd1);
#pragma unroll
              for (int j = 0; j < 4; ++j) { const int c = c0 + 4 * j; v[j] = ((v[j] - mean1) * rstd1 * *(const f32x4*)(lw1 + c) + *(const f32x4*)(lb1 + c)) * ALPHA; } }
#if MS >= 2
            const float gt[TOPK] = {gw[r][0].x * 0.0625f, gw[r][0].y * 0.0625f, gw[r][0].z * 0.0625f, gw[r][0].w * 0.0625f, gw[r][1].x * 0.0625f, gw[r][1].y * 0.0625f, gw[r][1].z * 0.0625f, gw[r][1].w * 0.0625f};
#pragma unroll
            for (int j = 0; j < 4; ++j) { const unsigned ws8 = j == 0 ? yw[r][TOPK].x : (j == 1 ? yw[r][TOPK].y : (j == 2 ? yw[r][TOPK].z : yw[r][TOPK].w));
                f32x4 mo = fp8x4(ws8) * 0.0625f;
#pragma unroll
                for (int k = 0; k < TOPK; ++k) { const unsigned wk = j == 0 ? yw[r][k].x : (j == 1 ? yw[r][k].y : (j == 2 ? yw[r][k].z : yw[r][k].w)); mo += fp8x4(wk) * gt[k]; }
                v[j] += *(const f32x4*)(mod + b * 6144 + 5120 + c0 + 4 * j) * mo; }
#endif
            float mean, rstd; ln_stats(v, mean, rstd);
            float* o = F.out + (size_t)m * D + c0;
#pragma unroll
            for (int j = 0; j < 4; ++j) { const int c = c0 + 4 * j; *(f32x4*)(o + 4 * j) = (v[j] - mean) * rstd * *(const f32x4*)(lw + c) + *(const f32x4*)(lb + c); }
        }
    }
}


#if MS >= 2
template <int MODE, bool FP8 = false>
__device__ __forceinline__ void cvt_item(const float* W, int Nsrc, int nblk, bf16* WT, int row_off, int dpitch, LAS float* scr, int item, int lane) {
    const int kb = item / nblk, nb = item - kb * nblk, k0 = 64 * kb, n0 = 32 * nb;
    const int nn = n0 + (lane & 31);
#pragma unroll 8
    for (int i = 0; i < 32; ++i) { const int kk = 2 * i + (lane >> 5); scr[kk * 33 + (lane & 31)] = (nn < Nsrc) ? W[(size_t)(k0 + kk) * Nsrc + nn] : 0.f; }
    LDS_WAIT(); asm volatile("" ::: "memory");
    const int c = lane & 7;
#pragma unroll
    for (int j = 0; j < 4; ++j) { const int n = (lane >> 3) + 8 * j; const LAS float* s = scr + (8 * c) * 33 + n;
        v4u o; o.x = pk2(s[0 * 33], s[1 * 33]); o.y = pk2(s[2 * 33], s[3 * 33]); o.z = pk2(s[4 * 33], s[5 * 33]); o.w = pk2(s[6 * 33], s[7 * 33]);
        const int ng = n0 + n; int dr = ng;
        if (MODE == 1) { const int i2 = ng & 255; dr = 8 * (i2 >> 2) + (i2 & 3) + ((ng >= 256) ? 4 : 0); }
        if constexpr (FP8) { v2u o8; o8.x = pack_fp8x4((f32x4){s[0 * 33], s[1 * 33], s[2 * 33], s[3 * 33]} * W8S); o8.y = pack_fp8x4((f32x4){s[4 * 33], s[5 * 33], s[6 * 33], s[7 * 33]} * W8S);
            *(v2u*)((unsigned char*)WT + (size_t)(row_off + dr) * dpitch + k0 + 8 * c) = o8; }
        else *(v4u*)(WT + (size_t)(row_off + dr) * dpitch + k0 + 8 * c) = o; }
    LDS_WAIT(); asm volatile("" ::: "memory");
}

template <int MODE>
__device__ __forceinline__ void cvt_item_reg(const float* W, int Nsrc, bf16* WT, int row_off, int dpitch, int k0, int n0, int lane) {
    const float* src = W + (size_t)k0 * Nsrc + n0 + 4 * lane;
    f32x4 v[32];
#pragma unroll
    for (int i = 0; i < 32; ++i) v[i] = __builtin_nontemporal_load((const f32x4*)(src + (size_t)i * Nsrc));
#pragma unroll
    for (int j = 0; j < 4; ++j) {
        const int ng = n0 + 4 * lane + j; int dr = ng;
        if (MODE == 1) { const int i2 = ng & 255; dr = 8 * (i2 >> 2) + (i2 & 3) + ((ng >= 256) ? 4 : 0); }
        v4u* dst = (v4u*)(WT + (size_t)(row_off + dr) * dpitch + k0);
#pragma unroll
        for (int q = 0; q < 4; ++q) { v4u o; o.x = pk2(v[8 * q][j], v[8 * q + 1][j]); o.y = pk2(v[8 * q + 2][j], v[8 * q + 3][j]); o.z = pk2(v[8 * q + 4][j], v[8 * q + 5][j]); o.w = pk2(v[8 * q + 6][j], v[8 * q + 7][j]); dst[q] = o; }
    }
}

constexpr int CVK = 32;
__device__ __forceinline__ void cvt_reg_load(const float* W, int Nsrc, int k0, int n0, int lane, f32x4 (&v)[CVK]) {
    const float* src = W + (size_t)k0 * Nsrc + n0 + 4 * lane;
#pragma unroll
    for (int i = 0; i < CVK; ++i) v[i] = __builtin_nontemporal_load((const f32x4*)(src + (size_t)i * Nsrc));
}
template <int MODE, bool FP8 = false>
__device__ __forceinline__ void cvt_reg_store(bf16* WT, int row_off, int dpitch, int k0, int n0, int lane, const f32x4 (&v)[CVK]) {
#pragma unroll
    for (int j = 0; j < 4; ++j) {
        const int ng = n0 + 4 * lane + j; int dr = ng;
        if (MODE == 1) { const int i2 = ng & 255; dr = 8 * (i2 >> 2) + (i2 & 3) + ((ng >= 256) ? 4 : 0); }
        if constexpr (FP8) { v4u* dst8 = (v4u*)((unsigned char*)WT + (size_t)(row_off + dr) * dpitch + k0);
#pragma unroll
            for (int q = 0; q < CVK / 16; ++q) { v4u o;
                o.x = pack_fp8x4((f32x4){v[16 * q][j], v[16 * q + 1][j], v[16 * q + 2][j], v[16 * q + 3][j]} * W8S); o.y = pack_fp8x4((f32x4){v[16 * q + 4][j], v[16 * q + 5][j], v[16 * q + 6][j], v[16 * q + 7][j]} * W8S);
                o.z = pack_fp8x4((f32x4){v[16 * q + 8][j], v[16 * q + 9][j], v[16 * q + 10][j], v[16 * q + 11][j]} * W8S); o.w = pack_fp8x4((f32x4){v[16 * q + 12][j], v[16 * q + 13][j], v[16 * q + 14][j], v[16 * q + 15][j]} * W8S); dst8[q] = o; }
            continue; }
        v4u* dst = (v4u*)(WT + (size_t)(row_off + dr) * dpitch + k0);
#pragma unroll
        for (int q = 0; q < CVK / 8; ++q) { v4u o; o.x = pg8::cvt_pk_bf16(v[8 * q][j], v[8 * q + 1][j]); o.y = pg8::cvt_pk_bf16(v[8 * q + 2][j], v[8 * q + 3][j]); o.z = pg8::cvt_pk_bf16(v[8 * q + 4][j], v[8 * q + 5][j]); o.w = pg8::cvt_pk_bf16(v[8 * q + 6][j], v[8 * q + 7][j]); dst[q] = o; }
    }
}
constexpr int CV_GU = (D / CVK) * 2, CV_DN = (FF / CVK) * 4, CV_NGU = (NE + 1) * CV_GU, CV_NITEM = CV_NGU + (NE + 1) * CV_DN;
__device__ __forceinline__ void cvx_load(const float* const* in, int it, int lane, f32x4 (&v)[CVK]) {
    if (it < CV_NGU) { const int e = it / CV_GU, ii = it - e * CV_GU; const float* src = (e < NE) ? in[30] + (size_t)e * D * 512 : in[32];
        cvt_reg_load(src, 512, CVK * (ii >> 1), 256 * (ii & 1), lane, v); }
    else { const int r = it - CV_NGU, e = r / CV_DN, ii = r - e * CV_DN; const float* src = (e < NE) ? in[31] + (size_t)e * FF * D : in[33];
        cvt_reg_load(src, D, CVK * (ii >> 2), 256 * (ii & 3), lane, v); }
}
__device__ __forceinline__ void cvx_store(unsigned char* ws, int it, int lane, const f32x4 (&v)[CVK]) {
    if (it < CV_NGU) { const int e = it / CV_GU, ii = it - e * CV_GU; cvt_reg_store<1, true>((bf16*)(ws + WS_WGU), e * 512, D, CVK * (ii >> 1), 256 * (ii & 1), lane, v); }
    else { const int r = it - CV_NGU, e = r / CV_DN, ii = r - e * CV_DN; cvt_reg_store<0, true>((bf16*)(ws + WS_WD), e * D, FF, CVK * (ii >> 2), 256 * (ii & 3), lane, v); }
}

#if MS >= 3
__device__ __forceinline__ float lora_val(const float* const* in, int n, int k) {
    if (n < 1024) { const int q = n >> 3, e8 = n & 7, dir = e8 >> 2, ch = q * 4 + (e8 & 3); return (k < 32) ? in[9][(size_t)(dir * 32 + k) * 512 + ch] : 0.f; }
    if (n < 2048) { const int m = n - 1024, q = m >> 3, e8 = m & 7, dir = e8 >> 2, ch = q * 4 + (e8 & 3); return (k >= 32 && k < 64) ? in[11][(size_t)(dir * 32 + (k - 32)) * 512 + ch] : 0.f; }
    if (n < 2560) { const int ch = n - 2048; return (k >= 64 && k < 160) ? in[12][(size_t)(k - 64) * 512 + ch] : 0.f; }
    { const int m = n - 2560, q = m >> 3, e8 = m & 7, dir = e8 >> 2, ch = q * 4 + (e8 & 3); return (k >= 160 && k < 176) ? in[19][(size_t)(dir * 16 + (k - 160)) * 256 + ch] : 0.f; }
}
#endif

__device__ __forceinline__ void ph_prologue(Frame& F) {
    {
        const float* c = F.in[1]; const float* cc = F.in[3]; const float* wa = F.in[4]; const float* ba = F.in[5];
        float* MOD = (float*)(F.ws + WS_MOD);
        LAS float* S = (LAS float*)F.lds; LAS float* red = (LAS float*)(F.lds + 32768);
        for (int it = blockIdx.x; it < 96; it += F.G) {
            for (int i = F.tid; i < 5120; i += NTHR) { const int r = i >> 10, k = i & 1023; const float cv = r < 4 ? c[r * 1024 + k] : cc[k]; S[i] = siluf_(cv); }
            __syncthreads();
            const int n = it * 64 + F.lane; float acc[5] = {0.f, 0.f, 0.f, 0.f, 0.f};
            for (int kk = 0; kk < 128; ++kk) { const int k = F.wave * 128 + kk; const float wv = wa[(size_t)k * 6144 + n];
#pragma unroll
                for (int r = 0; r < 5; ++r) acc[r] += S[r * 1024 + k] * wv; }
#pragma unroll
            for (int r = 0; r < 5; ++r) red[(F.wave * 5 + r) * 64 + F.lane] = acc[r];
            __syncthreads();
            if (F.wave == 0) {
#pragma unroll
                for (int r = 0; r < 5; ++r) { float s = 0.f;
#pragma unroll
                    for (int w = 0; w < 8; ++w) s += red[(w * 5 + r) * 64 + F.lane];
                    MOD[r * 6144 + n] = s + ba[n]; }
            }
            __syncthreads();
        }
    }
    {
        LAS float* scr = (LAS float*)(F.lds + F.wave * 16384);
        constexpr int I_IN = 16 * 168, I_BR = 8 * 32, I_OUT = 16 * 32, I_RT = 16 * 8, I_GU = 32 * 2, I_DN = 8 * 4;
        constexpr int T0 = I_IN, T1 = T0 + I_BR, T2 = T1 + I_BR, T3 = T2 + I_OUT, T4 = T3 + I_RT, T5 = T4 + (NE + 1) * I_GU, T6 = T5 + (NE + 1) * I_DN;
        unsigned char* ws = F.ws;
        for (int it = F.gw; it < T6; it += F.NGW) {
#if MS >= 3
            if (it < T0) { cvt_item<0, true>(F.in[6], IN_COLS, 168, (bf16*)(ws + WS_WIN), 0, D, scr, it, F.lane); continue; }
            if (it < T1) { cvt_item<0>(F.in[23], D, 32, (bf16*)(ws + WS_WBRRW), 0, RWW, scr, it - T0, F.lane); continue; }
            if (it < T2) { cvt_item<0>(F.in[24], D, 32, (bf16*)(ws + WS_WBRGLA), 0, RWW, scr, it - T1, F.lane); continue; }
            if (it < T3) { cvt_item<0>(F.in[25], D, 32, (bf16*)(ws + WS_WOUT), 0, D, scr, it - T2, F.lane); continue; }
#else
            if (it < T3) continue;
#endif
            if (it < T4) { cvt_item<0>(F.in[28], NE, 8, (bf16*)(ws + WS_WROUTER), 0, D, scr, it - T3, F.lane); continue; }
#if MS >= 3
            break;
#endif
            if (it < T5) { const int r = it - T4, e = r / I_GU, ii = r - e * I_GU;
                const float* src = (e < NE) ? F.in[30] + (size_t)e * D * 512 : F.in[32];
                cvt_item_reg<1>(src, 512, (bf16*)(ws + WS_WGU), e * 512, D, 32 * (ii >> 1), 256 * (ii & 1), F.lane); continue; }
            { const int r = it - T5, e = r / I_DN, ii = r - e * I_DN;
                const float* src = (e < NE) ? F.in[31] + (size_t)e * FF * D : F.in[33];
                cvt_item_reg<0>(src, D, (bf16*)(ws + WS_WD), e * D, FF, 32 * (ii >> 2), 256 * (ii & 3), F.lane); }
        }
    }
#if MS >= 3
    {
        bf16* WL = (bf16*)(F.ws + WS_WLORA);
        for (int idx = blockIdx.x * NTHR + F.tid; idx < NLORA * (KLORA / 8); idx += F.G * NTHR) {
            const int n = idx >> 5, k0 = (idx & 31) * 8; float v[8];
#pragma unroll
            for (int e = 0; e < 8; ++e) v[e] = lora_val(F.in, n, k0 + e);
            v4u o; o.x = pk2(v[0], v[1]); o.y = pk2(v[2], v[3]); o.z = pk2(v[4], v[5]); o.w = pk2(v[6], v[7]);
            *(v4u*)(WL + (size_t)n * KLORA + k0) = o;
        }
    }
#endif
}

struct EpiF32 {
    static constexpr bool PERM = false;
    float* C; int ldc;
    __device__ __forceinline__ void operator()(const f32x4 (&acc)[2][2][4][2], const pg8::Unit& u, int wr, int wc, int fr, int fq) const {
        const int row0 = u.pm * 256 + wr * 64 + fr, col0 = u.pn * 256 + wc * 32 + 4 * fq;
#pragma unroll
        for (int ai = 0; ai < 2; ++ai)
#pragma unroll
            for (int m = 0; m < 4; ++m) { float* rowp = C + (size_t)(row0 + ai * 128 + m * 16) * ldc + col0;
#pragma unroll
                for (int bj = 0; bj < 2; ++bj)
#pragma unroll
                    for (int n = 0; n < 2; ++n) *(f32x4*)(rowp + bj * 128 + n * 16) = acc[ai][bj][m][n]; }
    }
};
struct EpiSwiglu {
    static constexpr bool PERM = true;
    unsigned char* ACT;
    __device__ __forceinline__ void operator()(const f32x4 (&acc)[2][2][4][2], const pg8::Unit& u, int wr, int wc, int fr, int fq) const {
        const int row0 = u.pm * 256 + wr * 64 + fr, h0 = u.j * 128 + wc * 16 + 4 * fq;
#pragma unroll
        for (int ai = 0; ai < 2; ++ai)
#pragma unroll
            for (int m = 0; m < 4; ++m) { unsigned char* rowp = ACT + (size_t)(row0 + ai * 128 + m * 16) * FF + h0;
#pragma unroll
                for (int bj = 0; bj < 2; ++bj) { const f32x4 a = acc[ai][bj][m][0] * W8I, b = acc[ai][bj][m][1] * W8I;
                    *(unsigned*)(rowp + bj * 64) = pack_fp8x4((f32x4){siluf_(a[0]) * b[0], siluf_(a[1]) * b[1], siluf_(a[2]) * b[2], siluf_(a[3]) * b[3]}); } }
    }
};
struct EpiRowsBf16 {
    static constexpr bool PERM = true;
    bf16* O; int ldc; float sc;
    __device__ __forceinline__ void operator()(const f32x4 (&acc)[2][2][4][2], const pg8::Unit& u, int wr, int wc, int fr, int fq) const {
        const int row0 = u.pm * 256 + wr * 64 + fr, col0 = u.j * 256 + wc * 32 + 8 * fq;
#pragma unroll
        for (int ai = 0; ai < 2; ++ai)
#pragma unroll
            for (int m = 0; m < 4; ++m) { bf16* rowp = O + (size_t)(row0 + ai * 128 + m * 16) * ldc + col0;
#pragma unroll
                for (int bj = 0; bj < 2; ++bj) { const f32x4 v0 = acc[ai][bj][m][0] * sc, v1 = acc[ai][bj][m][1] * sc;
                    v4u w; w.x = pg8::cvt_pk_bf16(v0[0], v0[1]); w.y = pg8::cvt_pk_bf16(v0[2], v0[3]); w.z = pg8::cvt_pk_bf16(v1[0], v1[1]); w.w = pg8::cvt_pk_bf16(v1[2], v1[3]);
                    *(v4u*)(rowp + bj * 128) = w;
#ifdef PROBE_ST2
                    asm volatile("" ::: "memory"); *(volatile v4u*)(rowp + bj * 128) = w;
#endif
                    } }
    }
};

struct EpiRowsFp8 {
    static constexpr bool PERM = true;
    unsigned char* O;
    __device__ __forceinline__ void operator()(const f32x4 (&acc)[2][2][4][2], const pg8::Unit& u, int wr, int wc, int fr, int fq) const {
        const int row0 = u.pm * 256 + wr * 64 + fr, col0 = u.j * 256 + wc * 32 + 8 * fq;
#pragma unroll
        for (int ai = 0; ai < 2; ++ai)
#pragma unroll
            for (int m = 0; m < 4; ++m) { unsigned char* rowp = O + (size_t)(row0 + ai * 128 + m * 16) * D + col0;
#pragma unroll
                for (int bj = 0; bj < 2; ++bj) { f32x4 v0 = acc[ai][bj][m][0] * (16.0f * W8I), v1 = acc[ai][bj][m][1] * (16.0f * W8I);
#pragma unroll
                    for (int e = 0; e < 4; ++e) { v0[e] = __builtin_amdgcn_fmed3f(v0[e], -448.0f, 448.0f); v1[e] = __builtin_amdgcn_fmed3f(v1[e], -448.0f, 448.0f); }
                    int w0 = __builtin_amdgcn_cvt_pk_fp8_f32(v0[0], v0[1], 0, false); w0 = __builtin_amdgcn_cvt_pk_fp8_f32(v0[2], v0[3], w0, true);
                    int w1 = __builtin_amdgcn_cvt_pk_fp8_f32(v1[0], v1[1], 0, false); w1 = __builtin_amdgcn_cvt_pk_fp8_f32(v1[2], v1[3], w1, true);
                    v2u w; w.x = (unsigned)w0; w.y = (unsigned)w1; *(v2u*)(rowp + bj * 128) = w; } }
    }
};

__device__ __forceinline__ void ph_router(Frame& F) {
    pg8::Gemm g{(const bf16*)(F.ws + WS_A3), (const bf16*)(F.ws + WS_WROUTER), NLAT, NE, D, nullptr};
    pg8::StaticOrder S; S.init(NLAT, NE, F.G, (int)blockIdx.x);
    EpiF32 E{(float*)(F.ws + WS_LOGITS), NE};
    pg8::gemm_phase<EpiF32, pg8::StaticOrder, true, true, false>(F.lds, g, S, E);
}

__device__ __forceinline__ void ph_route(Frame& F) {
    const float* LOG = (const float*)(F.ws + WS_LOGITS); const float* rb = F.in[29];
    int* EIDX = (int*)(F.ws + WS_EIDX); float* GATE = (float*)(F.ws + WS_GATE); int* DEST = (int*)(F.ws + WS_DEST);
    unsigned* CNT = F.ctl + CW_CNT;
    const f32x4 bias = *(const f32x4*)(rb + 4 * F.lane);
    const float NEG = -3.0e38f;
    f32x4 lgn = *(const f32x4*)(LOG + (size_t)(F.gw < NLAT ? F.gw : 0) * NE + 4 * F.lane);
    for (int m = F.gw; m < NLAT; m += F.NGW) {
        const f32x4 lg = lgn;
        { const int mn = (m + F.NGW < NLAT) ? m + F.NGW : m; lgn = *(const f32x4*)(LOG + (size_t)mn * NE + 4 * F.lane); }
        float sc[4], sel[4];
#pragma unroll
        for (int i = 0; i < 4; ++i) { sc[i] = sigmoidf_(lg[i]); sel[i] = sc[i] + bias[i]; }
        float m1 = fmaxf(sel[0], sel[1]), m2 = fminf(sel[0], sel[1]);
        { const float a = sel[2]; const float n1 = fmaxf(m1, a); m2 = fmaxf(m2, fminf(m1, a)); m1 = n1; }
        { const float a = sel[3]; const float n1 = fmaxf(m1, a); m2 = fmaxf(m2, fminf(m1, a)); m1 = n1; }
#pragma unroll
        for (int o = 1; o < 8; o <<= 1) { const float b1 = __shfl_xor(m1, o), b2 = __shfl_xor(m2, o); const float n1 = fmaxf(m1, b1); m2 = fmaxf(fminf(m1, b1), fmaxf(m2, b2)); m1 = n1; }
        const float gs = m1 + m2; const int g = F.lane >> 3;
        int rank = 0;
#pragma unroll
        for (int gg = 0; gg < 8; ++gg) { const float og = __shfl(gs, gg * 8); rank += (og > gs || (og == gs && gg < g)) ? 1 : 0; }
        const bool keep = rank < 4;
#pragma unroll
        for (int i = 0; i < 4; ++i) sel[i] = keep ? sel[i] : NEG;
        int my_e = 0; float my_s = 0.f; float ssum = 0.f;
        for (int k = 0; k < TOPK; ++k) {
            float bv = sel[0]; int bi = 0;
#pragma unroll
            for (int i = 1; i < 4; ++i) if (sel[i] > bv) { bv = sel[i]; bi = i; }
            int be = 4 * F.lane + bi; float v = bv; int e = be;
#pragma unroll
            for (int o = 1; o < 64; o <<= 1) { const float ov = __shfl_xor(v, o); const int oe = __shfl_xor(e, o); if (ov > v || (ov == v && oe < e)) { v = ov; e = oe; } }
            const int owner = e >> 2, oi = e & 3;
            float s_own = 0.f;
            if (F.lane == owner) {
#pragma unroll
                for (int i = 0; i < 4; ++i) if (i == oi) { s_own = sc[i]; sel[i] = NEG; }
            }
            const float s = __shfl(s_own, owner);
            ssum += s;
            if (F.lane == k) { my_e = e; my_s = s; }
        }
        if (F.lane < TOPK) {
            const unsigned pos = __hip_atomic_fetch_add(CNT + my_e * CNT_STRIDE, 1u, __ATOMIC_RELAXED, __HIP_MEMORY_SCOPE_AGENT);
            EIDX[m * 8 + F.lane] = my_e; GATE[m * 8 + F.lane] = my_s / ssum * 2.5f; DEST[m * 8 + F.lane] = (int)pos;
        }
    }
}

__device__ __forceinline__ void ph_scatter(Frame& F) {
    LAS int* tstart = (LAS int*)F.lds;
    LAS int* scan = (LAS int*)(F.lds + 2048);
    LAS int* cnts = (LAS int*)(F.lds + 4096);
    int* EIDX = (int*)(F.ws + WS_EIDX); int* DEST = (int*)(F.ws + WS_DEST); int* ROWTOK = (int*)(F.ws + WS_ROWTOK); int* TILE_E = (int*)(F.ws + WS_TILE_E);
    unsigned* CNT = F.ctl + CW_CNT;
    int tiles = 0, cnt = 0;
    if (F.tid < NE) { cnt = (int)__hip_atomic_load(CNT + F.tid * CNT_STRIDE, __ATOMIC_RELAXED, __HIP_MEMORY_SCOPE_AGENT); tiles = (cnt + 255) >> 8; scan[F.tid] = tiles; cnts[F.tid] = cnt; }
    __syncthreads();
    for (int o = 1; o < NE; o <<= 1) { int v = 0; if (F.tid < NE && F.tid >= o) v = scan[F.tid - o]; __syncthreads(); if (F.tid < NE) scan[F.tid] += v; __syncthreads(); }
    if (F.tid < NE) { tstart[F.tid + 1] = scan[F.tid]; if (F.tid == 0) tstart[0] = 0; }
    __syncthreads();
    const int NT = tstart[NE];
    if (blockIdx.x == 0) {
        if (F.tid == 0) F.ctl[CW_NT] = (unsigned)NT;
        if (F.tid < NE) for (int t = tstart[F.tid]; t < tstart[F.tid + 1]; ++t) TILE_E[t] = F.tid;
    }
    for (int e = blockIdx.x; e < NE; e += F.G) { const int c0 = cnts[e], c1 = (tstart[e + 1] - tstart[e]) * 256, base = tstart[e] * 256;
        for (int p = c0 + F.tid; p < c1; p += NTHR) ROWTOK[base + p] = 0; }
    for (int i = blockIdx.x * NTHR + F.tid; i < NLAT; i += F.G * NTHR) ROWTOK[SH_ROW0 + i] = i;
    for (int i = blockIdx.x * NTHR + F.tid; i < NLAT * TOPK; i += F.G * NTHR) {
        const int e = EIDX[i], pos = DEST[i]; const int dr = tstart[e] * 256 + pos;
        DEST[i] = dr; ROWTOK[dr] = i >> 3;
    }
}

__device__ __forceinline__ void ph_exp1(Frame& F) {
    const int NT = (int)__hip_atomic_load(F.ctl + CW_NT, __ATOMIC_RELAXED, __HIP_MEMORY_SCOPE_AGENT);
    pg8::Gemm g{(const bf16*)(F.ws + WS_A3F), (const bf16*)(F.ws + WS_WGU), 0, 0, D / 2, (const int*)(F.ws + WS_ROWTOK)};
    pg8::MoeOrder S{2, F.G, (int)blockIdx.x, NT, (const int*)(F.ws + WS_TILE_E)};
    EpiSwiglu E{F.ws + WS_ACT};
    pg8::gemm_phase<EpiSwiglu, pg8::MoeOrder, true, true, true, true>(F.lds, g, S, E);
}
__device__ __forceinline__ void ph_exp2(Frame& F) {
    const int NT = (int)__hip_atomic_load(F.ctl + CW_NT, __ATOMIC_RELAXED, __HIP_MEMORY_SCOPE_AGENT);
    pg8::Gemm g{(const bf16*)(F.ws + WS_ACT), (const bf16*)(F.ws + WS_WD), 0, 0, FF / 2, nullptr};
    pg8::MoeOrder S{4, F.G, (int)blockIdx.x, NT, (const int*)(F.ws + WS_TILE_E)};
    EpiRowsFp8 E{F.ws + WS_Y};
    pg8::gemm_phase<EpiRowsFp8, pg8::MoeOrder, true, true, false, true>(F.lds, g, S, E);
}
#endif

#if MS >= 3
__device__ __forceinline__ void unp8(const v4u w, float (&f)[8]) { f[0] = bflo(w.x); f[1] = bfhi(w.x); f[2] = bflo(w.y); f[3] = bfhi(w.y); f[4] = bflo(w.z); f[5] = bfhi(w.z); f[6] = bflo(w.w); f[7] = bfhi(w.w); }
__device__ __forceinline__ void unp8f8(const v2u w, float (&f)[8]) { const f32x2 a = __builtin_amdgcn_cvt_pk_f32_fp8((int)w.x, false), b = __builtin_amdgcn_cvt_pk_f32_fp8((int)w.x, true), c = __builtin_amdgcn_cvt_pk_f32_fp8((int)w.y, false), d = __builtin_amdgcn_cvt_pk_f32_fp8((int)w.y, true);
    f[0] = a.x; f[1] = a.y; f[2] = b.x; f[3] = b.y; f[4] = c.x; f[5] = c.y; f[6] = d.x; f[7] = d.y; }
__device__ __forceinline__ v4u pk8(const float (&f)[8]) { v4u o; o.x = pk2(f[0], f[1]); o.y = pk2(f[2], f[3]); o.z = pk2(f[4], f[5]); o.w = pk2(f[6], f[7]); return o; }
__device__ __forceinline__ void st8(float* p, const float (&f)[8]) { *(f32x4*)p = (f32x4){f[0], f[1], f[2], f[3]}; *(f32x4*)(p + 4) = (f32x4){f[4], f[5], f[6], f[7]}; }
__device__ __forceinline__ void ld8(const float* p, float (&f)[8]) { const f32x4 a = *(const f32x4*)p, b = *(const f32x4*)(p + 4); f[0] = a.x; f[1] = a.y; f[2] = a.z; f[3] = a.w; f[4] = b.x; f[5] = b.y; f[6] = b.z; f[7] = b.w; }

__device__ __forceinline__ void ph_a1(Frame& F) {
    const float* mod = (const float*)(F.ws + WS_MOD); unsigned char* A1 = F.ws + WS_A1;
    constexpr int NR = 4;
    for (int m0 = F.gw; m0 < MR; m0 += NR * F.NGW) {
        f32x4 xv[NR][4];
#pragma unroll
        for (int r = 0; r < NR; ++r) { const int mm = m0 + r * F.NGW; const int m = mm < MR ? mm : m0;
            const float* src = (m < NLAT) ? F.in[0] + (size_t)m * D : F.in[2] + (size_t)(m - NLAT) * D;
            const f32x4* xr = (const f32x4*)src + F.lane;
#pragma unroll
            for (int j = 0; j < 4; ++j) xv[r][j] = __builtin_nontemporal_load(xr + 64 * j); }
        __builtin_amdgcn_sched_barrier(0);
#pragma unroll
        for (int r = 0; r < NR; ++r) { const int mm = m0 + r * F.NGW; const int m = mm < MR ? mm : m0; const int mr = (m < NLAT) ? (m / SEQ) : 4;
            unsigned* ao = (unsigned*)(A1 + (size_t)m * D) + F.lane;
#pragma unroll
            for (int j = 0; j < 4; ++j) { const int c = 4 * F.lane + 256 * j;
                const f32x4 sh = *(const f32x4*)(mod + mr * 6144 + c), sc = *(const f32x4*)(mod + mr * 6144 + 1024 + c);
                const f32x4 h = xv[r][j] * (sc + 1.0f) + sh; ao[64 * j] = pack_fp8x4(h); } }
    }
}

__device__ __forceinline__ void ph_inproj(Frame& F) {
    pg8::Gemm g{(const bf16*)(F.ws + WS_A1), (const bf16*)(F.ws + WS_WIN), MR, NP, D / 2, nullptr};
    pg8::StaticOrder S; S.init(MR, NP, F.G, (int)blockIdx.x);
    EpiRowsBf16 E{(bf16*)(F.ws + WS_P), NP, W8I};
    pg8::gemm_phase<EpiRowsBf16, pg8::StaticOrder, true, true, false, true>(F.lds, g, S, E);
}

struct FeatOut { bf16 *R, *V, *KK, *KP, *QG, *KGB, *VGB, *A2; const float *mu, *kkw, *cw; };
__device__ __forceinline__ void feat_rw(const FeatOut& O, int p, size_t m, int lane, const v4u own_w, const v4u (&nbw)[4], const float (&muv)[8]) {
    float own[8], sh[4][8], val[8];
    unp8(own_w, own);
#pragma unroll
    for (int q = 0; q < 4; ++q) unp8(nbw[q], sh[q]);
#pragma unroll
    for (int e = 0; e < 8; ++e) val[e] = own[e] + muv[e] * (sh[e & 3][e] - own[e]);
    if (p == 0) *(v4u*)(O.R + m * RWW + 8 * lane) = pk8(val);
    else if (p == 2) *(v4u*)(O.V + m * RWW + 8 * lane) = pk8(val);
    else if (p == 1) {
        *(v4u*)(O.KP + m * RWW + 8 * lane) = pk8(val);
        float kw[8]; ld8(O.kkw + 8 * lane, kw); float kkv[8]; float ss = 0.f;
#pragma unroll
        for (int e = 0; e < 8; ++e) { kkv[e] = val[e] * kw[e]; ss += kkv[e] * kkv[e]; }
        ss += __shfl_xor(ss, 1); ss += __shfl_xor(ss, 2); ss += __shfl_xor(ss, 4);
        const float inv = 1.0f / fmaxf(sqrtf(ss), 1e-12f);
#pragma unroll
        for (int e = 0; e < 8; ++e) kkv[e] *= inv;
        *(v4u*)(O.KK + m * RWW + 8 * lane) = pk8(kkv);
    } else {
        float o[8];
#pragma unroll
        for (int e = 0; e < 8; ++e) o[e] = (lane < 4) ? tanhf(val[e]) : ((lane < 8) ? val[e] : sigmoidf_(val[e]));
        *(v4u*)(O.A2 + m * KLORA + 8 * lane) = pk8(o);
    }
}
__device__ __forceinline__ void feat_gla_store(const FeatOut& O, int p, size_t m, int lane, const float (&acc)[8]) {
    const int cq = p * 512 + 8 * lane; float o[8];
#pragma unroll
    for (int e = 0; e < 8; ++e) o[e] = siluf_(acc[e]);
    if (p == 0) {
        if (lane < 32) {
#pragma unroll
            for (int e = 0; e < 8; ++e) o[e] *= 0.125f;
            *(v4u*)(O.QG + m * 256 + cq) = pk8(o);
        } else *(v4u*)(O.KGB + m * 256 + (cq - 256)) = pk8(o);
    } else *(v4u*)(O.VGB + m * RWW + (cq - 512)) = pk8(o);
}
__device__ __forceinline__ void ph_feat(Frame& F) {
    const bf16* P = (const bf16*)(F.ws + WS_P);
    FeatOut O{(bf16*)(F.ws + WS_RB), (bf16*)(F.ws + WS_VB), (bf16*)(F.ws + WS_KKB), (bf16*)(F.ws + WS_KMF), (bf16*)(F.ws + WS_QGB), (bf16*)(F.ws + WS_KGB), (bf16*)(F.ws + WS_VGB), (bf16*)(F.ws + WS_A2), F.in[7], F.in[13], F.in[18]};
    const v4u Z4 = (v4u){0u, 0u, 0u, 0u};
    for (int blk = F.gw; blk < NB * (GRIDH / 2) * (GRIDW / 2); blk += F.NGW) {
        int lane = F.lane; asm volatile("" : "+v"(lane));
        const int b = blk >> 11, r0 = 2 * ((blk >> 5) & 63), c0 = 2 * (blk & 31); const int mb = b * SEQ + r0 * GRIDW + c0;
        const bool vu = r0 > 0, vd = r0 + 2 < GRIDH, vl = c0 > 0, vr = c0 + 2 < GRIDW;
#pragma unroll
        for (int p = 0; p < 4; ++p) {
            const int cb = p * 512 + 8 * lane; const bool act = (p < 3) || lane < 20;
            v4u own[2][2], up[2], dn[2], lf[2], rt[2];
#pragma unroll
            for (int i = 0; i < 2; ++i) { up[i] = Z4; dn[i] = Z4; lf[i] = Z4; rt[i] = Z4; own[i][0] = Z4; own[i][1] = Z4; }
            if (act) {
#pragma unroll
                for (int i = 0; i < 2; ++i) {
#pragma unroll
                    for (int j = 0; j < 2; ++j) own[i][j] = *(const v4u*)(P + (size_t)(mb + 64 * i + j) * NP + cb);
                    if (vu) up[i] = *(const v4u*)(P + (size_t)(mb - 64 + i) * NP + cb);
                    if (vd) dn[i] = *(const v4u*)(P + (size_t)(mb + 128 + i) * NP + cb);
                    if (vl) lf[i] = *(const v4u*)(P + (size_t)(mb + 64 * i - 1) * NP + cb);
                    if (vr) rt[i] = *(const v4u*)(P + (size_t)(mb + 64 * i + 2) * NP + cb); }
            } else if (p == 3 && lane >= 20 && lane < 22) {
#pragma unroll
                for (int i = 0; i < 2; ++i)
#pragma unroll
                    for (int j = 0; j < 2; ++j) own[i][j] = *(const v4u*)(P + (size_t)(mb + 64 * i + j) * NP + C_PGL + 8 * (lane - 20));
            }
            float muv[8] = {0.f, 0.f, 0.f, 0.f, 0.f, 0.f, 0.f, 0.f}; if (act) ld8(O.mu + cb, muv);
            __builtin_amdgcn_sched_barrier(0);
#pragma unroll
            for (int i = 0; i < 2; ++i)
#pragma unroll
                for (int j = 0; j < 2; ++j) { const size_t m = (size_t)(mb + 64 * i + j);
                    if (act) { const v4u nbw[4] = {j == 0 ? lf[i] : own[i][0], j == 1 ? rt[i] : own[i][1], i == 0 ? up[j] : own[0][j], i == 1 ? dn[j] : own[1][j]};
                        feat_rw(O, p, m, lane, own[i][j], nbw, muv); }
                    else if (p == 3 && lane < 32) *(v4u*)(O.A2 + m * KLORA + 8 * lane) = own[i][j]; }
        }
#pragma unroll
        for (int p = 0; p < 2; ++p) {
            const int cq = p * 512 + 8 * lane, cb = C_Q + cq;
            v4u g[4][4];
#pragma unroll
            for (int a2 = 0; a2 < 4; ++a2)
#pragma unroll
                for (int b2 = 0; b2 < 4; ++b2) { const bool ok = (a2 == 0 ? vu : (a2 == 3 ? vd : true)) && (b2 == 0 ? vl : (b2 == 3 ? vr : true));
                    g[a2][b2] = Z4; if (ok) g[a2][b2] = *(const v4u*)(P + (size_t)(mb + 64 * (a2 - 1) + (b2 - 1)) * NP + cb); }
            __builtin_amdgcn_sched_barrier(0);
            float acc[2][2][8];
#pragma unroll
            for (int i = 0; i < 2; ++i)
#pragma unroll
                for (int j = 0; j < 2; ++j)
#pragma unroll
                    for (int e = 0; e < 8; ++e) acc[i][j][e] = 0.f;
#pragma unroll
            for (int dy = 0; dy < 3; ++dy)
#pragma unroll
                for (int dx = 0; dx < 3; ++dx) { float wv[8]; ld8(O.cw + (dy * 3 + dx) * 1024 + cq, wv);
#pragma unroll
                    for (int i = 0; i < 2; ++i)
#pragma unroll
                        for (int j = 0; j < 2; ++j) { float pv[8]; unp8(g[i + dy][j + dx], pv);
#pragma unroll
                            for (int e = 0; e < 8; ++e) acc[i][j][e] += pv[e] * wv[e]; } }
#pragma unroll
            for (int i = 0; i < 2; ++i)
#pragma unroll
                for (int j = 0; j < 2; ++j) feat_gla_store(O, p, (size_t)(mb + 64 * i + j), lane, acc[i][j]);
        }
    }
    for (int m = NLAT + F.gw; m < MR; m += F.NGW) {
        int lane = F.lane; asm volatile("" : "+v"(lane));
        const int t = (m - NLAT) & (CTXL - 1); const bool vp = t > 0, vn = t < CTXL - 1;
#pragma unroll
        for (int p = 0; p < 4; ++p) {
            const int cb = p * 512 + 8 * lane; const bool act = (p < 3) || lane < 20;
            if (act) { const v4u own = *(const v4u*)(P + (size_t)m * NP + cb); v4u pv = Z4, nv = Z4;
                if (vp) pv = *(const v4u*)(P + (size_t)(m - 1) * NP + cb); if (vn) nv = *(const v4u*)(P + (size_t)(m + 1) * NP + cb);
                float muv[8]; ld8(O.mu + cb, muv); const v4u nbw[4] = {pv, nv, pv, nv};
                feat_rw(O, p, (size_t)m, lane, own, nbw, muv); }
            else if (p == 3 && lane < 32) { v4u w = Z4; if (lane < 22) w = *(const v4u*)(P + (size_t)m * NP + C_PGL + 8 * (lane - 20)); *(v4u*)(O.A2 + (size_t)m * KLORA + 8 * lane) = w; }
        }
#pragma unroll
        for (int p = 0; p < 2; ++p) {
            const int cq = p * 512 + 8 * lane, cb = C_Q + cq; float acc[8] = {0.f, 0.f, 0.f, 0.f, 0.f, 0.f, 0.f, 0.f};
#pragma unroll
            for (int dx = -1; dx <= 1; ++dx) { const bool ok = (dx < 0) ? vp : ((dx > 0) ? vn : true);
                if (ok) { float pv[8], wv[8]; unp8(*(const v4u*)(P + (size_t)(m + dx) * NP + cb), pv); ld8(O.cw + (3 + dx + 1) * 1024 + cq, wv);
#pragma unroll
                    for (int e = 0; e < 8; ++e) acc[e] += pv[e] * wv[e]; } }
            feat_gla_store(O, p, (size_t)m, lane, acc);
        }
    }
}

struct EpiLora {
    static constexpr bool PERM = true;
    unsigned char* ws; const float* const* in;
    __device__ __forceinline__ void grp_w(const f32x4 (&acc)[2][2][4][2], int row0, int c0) const {
        bf16* Wf = (bf16*)(ws + WS_LWF); bf16* Wb = (bf16*)(ws + WS_LWB);
#pragma unroll
        for (int bj = 0; bj < 2; ++bj) { const int ch = (c0 + bj * 128) >> 1; const f32x4 w0f = *(const f32x4*)(in[8] + ch), w0b = *(const f32x4*)(in[8] + 512 + ch);
#pragma unroll
            for (int ai = 0; ai < 2; ++ai)
#pragma unroll
                for (int m = 0; m < 4; ++m) { const size_t row = (size_t)(row0 + ai * 128 + m * 16);
                    const f32x4 xf = acc[ai][bj][m][0] + w0f, xb = acc[ai][bj][m][1] + w0b; f32x4 df, db;
#pragma unroll
                    for (int e = 0; e < 4; ++e) { df[e] = -0.60653066f * sigmoidf_(xf[e]); db[e] = -0.60653066f * sigmoidf_(xb[e]); }
                    { v2u o; o.x = pk2(df[0], df[1]); o.y = pk2(df[2], df[3]); *(v2u*)(Wf + row * RWW + ch) = o; o.x = pk2(db[0], db[1]); o.y = pk2(db[2], db[3]); *(v2u*)(Wb + row * RWW + ch) = o; } } }
    }
    __device__ __forceinline__ void grp_a(const f32x4 (&acc)[2][2][4][2], int row0, int c0) const {
        bf16* KMf = (bf16*)(ws + WS_KMF); bf16* KMb = (bf16*)(ws + WS_KMB); bf16* BVf = (bf16*)(ws + WS_BVF); bf16* BVb = (bf16*)(ws + WS_BVB);
        const bf16* KK = (const bf16*)(ws + WS_KKB); bf16* KSUM = (bf16*)(ws + WS_KSUM);
#pragma unroll
        for (int bj = 0; bj < 2; ++bj) { const int ch = (c0 + bj * 128 - 1024) >> 1; const f32x4 a0f = *(const f32x4*)(in[10] + ch), a0b = *(const f32x4*)(in[10] + 512 + ch), ka = *(const f32x4*)(in[14] + ch);
#pragma unroll
            for (int ai = 0; ai < 2; ++ai) {
            v2u kpw[2][4], kkw[2][4];
#pragma unroll
                for (int m = 0; m < 4; ++m) { const size_t row = (size_t)(row0 + ai * 128 + m * 16); kpw[ai][m] = *(const v2u*)(KMf + row * RWW + ch); kkw[ai][m] = *(const v2u*)(KK + row * RWW + ch); }
            __builtin_amdgcn_sched_barrier(0);
#pragma unroll
                for (int m = 0; m < 4; ++m) { const size_t row = (size_t)(row0 + ai * 128 + m * 16);
                    const f32x4 xf = acc[ai][bj][m][0] + a0f, xb = acc[ai][bj][m][1] + a0b;
                    const f32x4 kp = (f32x4){bflo(kpw[ai][m].x), bfhi(kpw[ai][m].x), bflo(kpw[ai][m].y), bfhi(kpw[ai][m].y)}, kk = (f32x4){bflo(kkw[ai][m].x), bfhi(kkw[ai][m].x), bflo(kkw[ai][m].y), bfhi(kkw[ai][m].y)};
                    f32x4 kmf, kmb, bvf, bvb;
#pragma unroll
                    for (int e = 0; e < 4; ++e) { const float af = sigmoidf_(xf[e]), ab = sigmoidf_(xb[e]);
                        kmf[e] = kp[e] * (1.0f + (af - 1.0f) * ka[e]); kmb[e] = kp[e] * (1.0f + (ab - 1.0f) * ka[e]); bvf[e] = kk[e] * af; bvb[e] = kk[e] * ab; }
                    { v2u o; o.x = pk2(kmf[0], kmf[1]); o.y = pk2(kmf[2], kmf[3]); *(v2u*)(KMf + row * RWW + ch) = o; o.x = pk2(kmb[0], kmb[1]); o.y = pk2(kmb[2], kmb[3]); *(v2u*)(KMb + row * RWW + ch) = o;
                      o.x = pk2(bvf[0], bvf[1]); o.y = pk2(bvf[2], bvf[3]); *(v2u*)(BVf + row * RWW + ch) = o; o.x = pk2(bvb[0], bvb[1]); o.y = pk2(bvb[2], bvb[3]); *(v2u*)(BVb + row * RWW + ch) = o; }
                    v2u ks; ks.x = pk2(kmf[0] + kmb[0], kmf[1] + kmb[1]); ks.y = pk2(kmf[2] + kmb[2], kmf[3] + kmb[3]); *(v2u*)(KSUM + row * RWW + ch) = ks; } } }
    }
    __device__ __forceinline__ void grp_g(const f32x4 (&acc)[2][2][4][2], int row0, int c0) const {
        bf16* RWG = (bf16*)(ws + WS_RWG);
#pragma unroll
        for (int bj = 0; bj < 2; ++bj) { const int ch = c0 + bj * 128 - 2048;
#pragma unroll
            for (int ai = 0; ai < 2; ++ai)
#pragma unroll
                for (int m = 0; m < 4; ++m) { const size_t row = (size_t)(row0 + ai * 128 + m * 16); const f32x4 v0 = acc[ai][bj][m][0], v1 = acc[ai][bj][m][1];
                    v4u w; w.x = pk2(v0[0], v0[1]); w.y = pk2(v0[2], v0[3]); w.z = pk2(v1[0], v1[1]); w.w = pk2(v1[2], v1[3]); *(v4u*)(RWG + row * RWW + ch) = w; } }
    }
    __device__ __forceinline__ void grp_l(const f32x4 (&acc)[2][2][4][2], int row0, int c0) const {
        bf16* GAf = (bf16*)(ws + WS_LAF); bf16* GAb = (bf16*)(ws + WS_LAB);
#pragma unroll
        for (int bj = 0; bj < 2; ++bj) { const int ch = (c0 + bj * 128 - 2560) >> 1; const f32x4 gbf = *(const f32x4*)(in[20] + ch), gbb = *(const f32x4*)(in[20] + 256 + ch);
#pragma unroll
            for (int ai = 0; ai < 2; ++ai)
#pragma unroll
                for (int m = 0; m < 4; ++m) { const size_t row = (size_t)(row0 + ai * 128 + m * 16);
                    const f32x4 xf = acc[ai][bj][m][0] + gbf, xb = acc[ai][bj][m][1] + gbb; f32x4 af, ab;
#pragma unroll
                    for (int e = 0; e < 4; ++e) { const float lf = fminf(xf[e], 0.f) - log1pf(__expf(-fabsf(xf[e]))), lb = fminf(xb[e], 0.f) - log1pf(__expf(-fabsf(xb[e])));
                        af[e] = lf * 0.0625f; ab[e] = lb * 0.0625f; }
                    { v2u o; o.x = pk2(af[0], af[1]); o.y = pk2(af[2], af[3]); *(v2u*)(GAf + row * 256 + ch) = o; o.x = pk2(ab[0], ab[1]); o.y = pk2(ab[2], ab[3]); *(v2u*)(GAb + row * 256 + ch) = o; } } }
    }
    __device__ __forceinline__ void operator()(const f32x4 (&acc)[2][2][4][2], const pg8::Unit& u, int wr, int wc, int fr, int fq) const {
        const int row0 = u.pm * 256 + wr * 64 + fr, c0 = u.pn * 256 + wc * 32 + 8 * fq;
        if (u.pn < 4) grp_w(acc, row0, c0); else if (u.pn < 8) grp_a(acc, row0, c0); else if (u.pn < 10) grp_g(acc, row0, c0); else grp_l(acc, row0, c0);
    }
};
__device__ __forceinline__ void ph_lora(Frame& F) {
    pg8::Gemm g{(const bf16*)(F.ws + WS_A2), (const bf16*)(F.ws + WS_WLORA), MR, NLORA, KLORA, nullptr};
    pg8::StaticOrder S; S.init(MR, NLORA, F.G, (int)blockIdx.x);
    EpiLora E{F.ws, F.in};
    pg8::gemm_phase<EpiLora, pg8::StaticOrder, true, true, false>(F.lds, g, S, E);
}

__device__ __forceinline__ void ph_merge(Frame& F) {
    unsigned char* ws = F.ws; const int lane = F.lane;
    const bf16* ORf = (const bf16*)(ws + WS_ORWF); const bf16* ORb = (const bf16*)(ws + WS_ORWB); const bf16* OGf = (const bf16*)(ws + WS_OGLF); const bf16* OGb = (const bf16*)(ws + WS_OGLB);
    const bf16* R = (const bf16*)(ws + WS_RB); const bf16* V = (const bf16*)(ws + WS_VB); const bf16* KSUM = (const bf16*)(ws + WS_KSUM); const bf16* RWG = (const bf16*)(ws + WS_RWG);
    const bf16* P = (const bf16*)(ws + WS_P);
    bf16* YRW = (bf16*)(ws + WS_YRW); bf16* YGLA = (bf16*)(ws + WS_YGLA);
    float rk[8], gw[8], gbv[8], ggw[8], ggb[8];
    ld8(F.in[15] + 8 * lane, rk); ld8(F.in[16] + 8 * lane, gw); ld8(F.in[17] + 8 * lane, gbv); ld8(F.in[21] + 8 * lane, ggw); ld8(F.in[22] + 8 * lane, ggb);
    for (int m0 = F.gw; m0 < NLAT; m0 += 2 * F.NGW) {
        const int m1 = (m0 + F.NGW < NLAT) ? m0 + F.NGW : m0;
        v4u wa[2], wb[2], wc[2], wd[2], wr[2], wv[2], wk[2], wg[2], wo[2];
#pragma unroll
        for (int r2 = 0; r2 < 2; ++r2) { const int m = r2 ? m1 : m0; const size_t ro = (size_t)m * RWW + 8 * lane;
            wa[r2] = *(const v4u*)(ORf + ro); wb[r2] = *(const v4u*)(ORb + ro); wc[r2] = *(const v4u*)(OGf + ro); wd[r2] = *(const v4u*)(OGb + ro);
            wr[r2] = *(const v4u*)(R + ro); wv[r2] = *(const v4u*)(V + ro); wk[r2] = *(const v4u*)(KSUM + ro); wg[r2] = *(const v4u*)(RWG + ro);
            wo[r2] = *(const v4u*)(P + (size_t)m * NP + C_OG + 8 * lane); }
#pragma unroll
        for (int r2 = 0; r2 < 2; ++r2) { const int m = r2 ? m1 : m0; const size_t ro = (size_t)m * RWW + 8 * lane;
        {
            float a[8], b[8], o[8]; unp8(wa[r2], a); unp8(wb[r2], b);
            float s = 0.f;
#pragma unroll
            for (int e = 0; e < 8; ++e) { o[e] = a[e] + b[e]; s += o[e]; }
            s += __shfl_xor(s, 1); s += __shfl_xor(s, 2); s += __shfl_xor(s, 4);
            const float mean = s * (1.f / 64.f); float q = 0.f;
#pragma unroll
            for (int e = 0; e < 8; ++e) { o[e] -= mean; q += o[e] * o[e]; }
            q += __shfl_xor(q, 1); q += __shfl_xor(q, 2); q += __shfl_xor(q, 4);
            const float rstd = 1.f / sqrtf(q * (1.f / 64.f) + RW_GN_EPS);
            float r[8], v[8], ksm[8], g[8]; unp8(wr[r2], r); unp8(wv[r2], v); unp8(wk[r2], ksm); unp8(wg[r2], g);
            float bs = 0.f;
#pragma unroll
            for (int e = 0; e < 8; ++e) bs += r[e] * ksm[e] * rk[e];
            bs += __shfl_xor(bs, 1); bs += __shfl_xor(bs, 2); bs += __shfl_xor(bs, 4);
            float y[8];
#pragma unroll
            for (int e = 0; e < 8; ++e) y[e] = (o[e] * rstd * gw[e] + gbv[e] + bs * v[e]) * g[e];
            *(v4u*)(YRW + ro) = pk8(y);
        }
        {
            float a[8], b[8], o[8]; unp8(wc[r2], a); unp8(wd[r2], b);
            float s = 0.f;
#pragma unroll
            for (int e = 0; e < 8; ++e) { o[e] = a[e] + b[e]; s += o[e]; }
            s += __shfl_xor(s, 1); s += __shfl_xor(s, 2); s += __shfl_xor(s, 4); s += __shfl_xor(s, 8);
            const float mean = s * (1.f / 128.f); float q = 0.f;
#pragma unroll
            for (int e = 0; e < 8; ++e) { o[e] -= mean; q += o[e] * o[e]; }
            q += __shfl_xor(q, 1); q += __shfl_xor(q, 2); q += __shfl_xor(q, 4); q += __shfl_xor(q, 8);
            const float rstd = 1.f / sqrtf(q * (1.f / 128.f) + LN_EPS);
            float og[8]; unp8(wo[r2], og);
            float y[8];
#pragma unroll
            for (int e = 0; e < 8; ++e) y[e] = (o[e] * rstd * ggw[e] + ggb[e]) * siluf_(og[e]);
            *(v4u*)(YGLA + ro) = pk8(y);
        }
        }
    }
}

template <int WHICH> struct EpiBranch {
    static constexpr bool PERM = true;
    bf16* Z; const bf16* P;
    __device__ __forceinline__ void operator()(const f32x4 (&acc)[2][2][4][2], const pg8::Unit& u, int wr, int wc, int fr, int fq) const {
        const int row0 = u.pm * 256 + wr * 64 + fr, col0 = u.pn * 256 + wc * 32 + 8 * fq;
#pragma unroll
        for (int ah = 0; ah < 4; ++ah) { const int ai = ah >> 1, mb = 2 * (ah & 1);
            v4u gw[2][2], zw[2][2];
#pragma unroll
            for (int m = 0; m < 2; ++m) { const size_t row = (size_t)(row0 + ai * 128 + (mb + m) * 16);
#pragma unroll
                for (int bj = 0; bj < 2; ++bj) { const int c = col0 + bj * 128;
                    gw[m][bj] = *(const v4u*)(P + row * NP + (WHICH ? C_GGLA : C_GRW) + c);
                    if (WHICH) zw[m][bj] = *(const v4u*)(Z + row * D + c); } }
            __builtin_amdgcn_sched_barrier(0);
#pragma unroll
            for (int m = 0; m < 2; ++m) { const size_t row = (size_t)(row0 + ai * 128 + (mb + m) * 16);
#pragma unroll
                for (int bj = 0; bj < 2; ++bj) { const int c = col0 + bj * 128;
                    float g[8]; unp8(gw[m][bj], g);
                    const f32x4 v0 = acc[ai][bj][mb + m][0], v1 = acc[ai][bj][mb + m][1];
                    float z[8];
#pragma unroll
                    for (int e = 0; e < 4; ++e) { z[e] = sigmoidf_(g[e]) * v0[e]; z[4 + e] = sigmoidf_(g[4 + e]) * v1[e]; }
                    if (WHICH) { float zo[8]; unp8(zw[m][bj], zo);
#pragma unroll
                        for (int e = 0; e < 8; ++e) z[e] += zo[e]; }
                    *(v4u*)(Z + row * D + c) = pk8(z); } }
        }
    }
};
__device__ __forceinline__ void ph_branch(Frame& F) {
    pg8::StaticOrder S; S.init(NLAT, D, F.G, (int)blockIdx.x);
    { pg8::Gemm g{(const bf16*)(F.ws + WS_YRW), (const bf16*)(F.ws + WS_WBRRW), NLAT, D, RWW, nullptr};
      EpiBranch<0> E{(bf16*)(F.ws + WS_Z), (const bf16*)(F.ws + WS_P)};
      pg8::gemm_phase<EpiBranch<0>, pg8::StaticOrder, true, true, false>(F.lds, g, S, E); }
    { pg8::Gemm g{(const bf16*)(F.ws + WS_YGLA), (const bf16*)(F.ws + WS_WBRGLA), NLAT, D, RWW, nullptr};
      EpiBranch<1> E{(bf16*)(F.ws + WS_Z), (const bf16*)(F.ws + WS_P)};
      pg8::gemm_phase<EpiBranch<1>, pg8::StaticOrder, true, true, false>(F.lds, g, S, E); }
}
struct EpiOut {
    static constexpr bool PERM = true;
    bf16* X1P; const float* x; const float* mod;
    __device__ __forceinline__ void operator()(const f32x4 (&acc)[2][2][4][2], const pg8::Unit& u, int wr, int wc, int fr, int fq) const {
        const int row0 = u.pm * 256 + wr * 64 + fr, col0 = u.pn * 256 + wc * 32 + 8 * fq; const float* g1 = mod + (u.pm / (SEQ / 256)) * 6144 + 2048;
        f32x4 gv[2][2];
#pragma unroll
        for (int bj = 0; bj < 2; ++bj)
#pragma unroll
            for (int n = 0; n < 2; ++n) gv[bj][n] = *(const f32x4*)(g1 + col0 + bj * 128 + 4 * n);
#pragma unroll
        for (int ah = 0; ah < 4; ++ah) { const int ai = ah >> 1, mb = 2 * (ah & 1);
            f32x4 xv[2][2][2];
#pragma unroll
            for (int m = 0; m < 2; ++m) { const size_t ro = (size_t)(row0 + ai * 128 + (mb + m) * 16) * D;
#pragma unroll
                for (int bj = 0; bj < 2; ++bj)
#pragma unroll
                    for (int n = 0; n < 2; ++n) xv[m][bj][n] = *(const f32x4*)(x + ro + col0 + bj * 128 + 4 * n); }
            __builtin_amdgcn_sched_barrier(0);
#pragma unroll
            for (int m = 0; m < 2; ++m) { const size_t ro = (size_t)(row0 + ai * 128 + (mb + m) * 16) * D;
#pragma unroll
                for (int bj = 0; bj < 2; ++bj) { const f32x4 a = xv[m][bj][0] * ALPHA + gv[bj][0] * acc[ai][bj][mb + m][0], b = xv[m][bj][1] * ALPHA + gv[bj][1] * acc[ai][bj][mb + m][1];
                    v4u w; w.x = pk2(a.x, a.y); w.y = pk2(a.z, a.w); w.z = pk2(b.x, b.y); w.w = pk2(b.z, b.w); *(v4u*)(X1P + ro + col0 + bj * 128) = w; } }
        }
    }
};
__device__ __forceinline__ void ph_outproj(Frame& F) {
    pg8::Gemm g{(const bf16*)(F.ws + WS_Z), (const bf16*)(F.ws + WS_WOUT), NLAT, D, D, nullptr};
    pg8::StaticOrder S; S.init(NLAT, D, F.G, (int)blockIdx.x);
    EpiOut E{(bf16*)(F.ws + WS_X1), F.in[0], (const float*)(F.ws + WS_MOD)};
    pg8::gemm_phase<EpiOut, pg8::StaticOrder, true, true, false>(F.lds, g, S, E);
}
#endif

#if MS >= 3
constexpr int LP = 72, SLOTB = 64 * LP * 2, LPF = 68, AUX_OFF = 13 * SLOTB;
static_assert(AUX_OFF + 4096 <= MISC_OFF, "scan LDS map");
#define SLOT(n) ((LAS bf16*)(lds + (n) * SLOTB))
__device__ __forceinline__ int scan_row(int s, int b, int dir) {
    if (s < CTXL) return NLAT + b * CTXL + (dir ? (CTXL - 1 - s) : s);
    const int lt = s - CTXL; return b * SEQ + (dir ? (SEQ - 1 - lt) : lt);
}
__device__ __forceinline__ unsigned pk2z(float x) { return pk2(x, 0.f); }
__device__ __forceinline__ float bf2f(bf16 h) { return __builtin_bit_cast(float, (unsigned)h << 16); }
__device__ __forceinline__ v2u pack4(const f32x4 v) { v2u o; o.x = pk2(v[0], v[1]); o.y = pk2(v[2], v[3]); return o; }
__device__ __forceinline__ float clamp8(float x) { return __builtin_amdgcn_fmed3f(x, -448.0f, 448.0f); }
__device__ __forceinline__ unsigned pack4_fp8(const f32x4 v) { int w = __builtin_amdgcn_cvt_pk_fp8_f32(clamp8(v[0]), clamp8(v[1]), 0, false); return (unsigned)__builtin_amdgcn_cvt_pk_fp8_f32(clamp8(v[2]), clamp8(v[3]), w, true); }
__device__ __forceinline__ f32x4 unpack4_fp8(unsigned w) { const f32x2 lo = __builtin_amdgcn_cvt_pk_f32_fp8((int)w, false), hi = __builtin_amdgcn_cvt_pk_f32_fp8((int)w, true); return (f32x4){lo.x, lo.y, hi.x, hi.y}; }
__device__ __forceinline__ f32x4 unpack4(const v2u w) { return (f32x4){bflo(w.x), bfhi(w.x), bflo(w.y), bfhi(w.y)}; }
__device__ __forceinline__ f32x4 mm_tile(const LAS bf16* X, int r0, const LAS bf16* Y, int c0, int lane) {
    const int rr = lane & 15, q = lane >> 4;
    const LAS bf16* xp = X + (r0 + rr) * LP + 8 * q; const LAS bf16* yp = Y + (c0 + rr) * LP + 8 * q;
    const bf16x8 a0 = *(const LAS bf16x8*)xp, a1 = *(const LAS bf16x8*)(xp + 32), b0 = *(const LAS bf16x8*)yp, b1 = *(const LAS bf16x8*)(yp + 32);
    f32x4 acc = (f32x4){0.f, 0.f, 0.f, 0.f};
    acc = __builtin_amdgcn_mfma_f32_16x16x32_bf16(a0, b0, acc, 0, 0, 0);
    acc = __builtin_amdgcn_mfma_f32_16x16x32_bf16(a1, b1, acc, 0, 0, 0);
    return acc;
}
__device__ __forceinline__ float red8(float x) {
    x += __builtin_bit_cast(float, __builtin_amdgcn_update_dpp(0, __builtin_bit_cast(int, x), 0x141, 0xf, 0xf, false));
    x += __builtin_bit_cast(float, __builtin_amdgcn_update_dpp(0, __builtin_bit_cast(int, x), 0xB1, 0xf, 0xf, false));
    x += __builtin_bit_cast(float, __builtin_amdgcn_update_dpp(0, __builtin_bit_cast(int, x), 0x4E, 0xf, 0xf, false));
    return x;
}

#define S1_BAR() do { asm volatile("s_waitcnt lgkmcnt(0)" ::: "memory"); __builtin_amdgcn_s_barrier(); asm volatile("" ::: "memory"); } while (0)
struct RwIn { bf16 lw[8], r[8], k[8], a[8], b[8], v[8]; };
__device__ __forceinline__ void s1_rwkv_load(Frame& F, int u, RwIn& I) {
    const int sr = u / NCHUNK, c = u - sr * NCHUNK, rb = sr >> 4, rdir = (sr >> 3) & 1, rh = sr & 7; unsigned char* ws = F.ws;
    const bf16* RBp = (const bf16*)(ws + WS_RB); const bf16* VBp = (const bf16*)(ws + WS_VB); const bf16* KKp = (const bf16*)(ws + WS_KKB);
    const bf16* KMp = (const bf16*)(ws + (rdir ? WS_KMB : WS_KMF)); const bf16* BVp = (const bf16*)(ws + (rdir ? WS_BVB : WS_BVF)); const bf16* LWp = (const bf16*)(ws + (rdir ? WS_LWB : WS_LWF));
#pragma unroll
    for (int i = 0; i < 8; ++i) { const int row = scan_row(c * CH + 8 * F.wave + i, rb, rdir); const size_t base = (size_t)row * RWW + rh * 64 + F.lane;
        I.lw[i] = LWp[base]; I.r[i] = RBp[base]; I.k[i] = KMp[base]; I.a[i] = KKp[base]; I.b[i] = BVp[base]; I.v[i] = VBp[base]; }
}
__device__ __forceinline__ void s1_rwkv(Frame& F, int u, const RwIn& I, int un, RwIn& Inext, int cvi) {
    const int sr = u / NCHUNK, c = u - sr * NCHUNK;
    const bool emit = c >= CTXL / CH;
    LAS unsigned char* lds = F.lds; unsigned char* ws = F.ws;
    int lane_ = F.lane; asm volatile("" : "+v"(lane_));
    const int lane = lane_, wave = F.wave, rr = lane & 15, q = lane >> 4;
    LAS float* tot = (LAS float*)(lds + AUX_OFF); LAS float* gCs = tot + 512;
    {
        float lw[8], xr[8], xk[8], xa[8], xb[8], xv[8];
#pragma unroll
        for (int i = 0; i < 8; ++i) { lw[i] = bf2f(I.lw[i]); xr[i] = bf2f(I.r[i]); xk[i] = bf2f(I.k[i]); xa[i] = -bf2f(I.a[i]); xb[i] = bf2f(I.b[i]); xv[i] = bf2f(I.v[i]); }
        float p[8]; p[0] = lw[0];
#pragma unroll
        for (int i = 1; i < 8; ++i) p[i] = p[i - 1] + lw[i];
        tot[wave * 64 + lane] = p[7];
        S1_BAR();
        float off = 0.f, all = 0.f;
#pragma unroll
        for (int w = 0; w < 8; ++w) { const float t = tot[w * 64 + lane]; all += t; off += (w < wave) ? t : 0.f; }
        if (wave == 0) gCs[lane] = __expf(all);
        float at[8], bb[8], kb[8];
#pragma unroll
        for (int i = 0; i < 8; ++i) { const float cum = off + p[i]; const float g = __expf(cum), gi = __expf(-cum), gp = __expf(cum - lw[i]), gc = __expf(all - cum);
            const int t = 8 * wave + i;
            at[i] = xa[i] * gp; bb[i] = xb[i] * gc; kb[i] = xk[i] * gc;
            SLOT(0)[t * LP + lane] = (bf16)pk2z(at[i]);
            SLOT(1)[t * LP + lane] = (bf16)pk2z(xr[i] * g);
            SLOT(2)[t * LP + lane] = (bf16)pk2z(xb[i] * gi);
            SLOT(3)[t * LP + lane] = (bf16)pk2z(xk[i] * gi); }
        *(LAS v4u*)(SLOT(4) + lane * LP + 8 * wave) = pk8(at);
        *(LAS v4u*)(SLOT(5) + lane * LP + 8 * wave) = pk8(xv);
        *(LAS v4u*)(SLOT(6) + lane * LP + 8 * wave) = pk8(bb);
        *(LAS v4u*)(SLOT(7) + lane * LP + 8 * wave) = pk8(kb);
        S1_BAR();
    }
    s1_rwkv_load(F, un, Inext);
    LAS float* Lp = (LAS float*)(lds + 8 * SLOTB);
#pragma unroll
    for (int tix = 0; tix < 2; ++tix) { const int ti = 2 * wave + tix, r0 = 16 * (ti >> 2), c0 = 16 * (ti & 3), ci = c0 + rr;
        { const f32x4 acc = mm_tile(SLOT(2), r0, SLOT(0), c0, lane);
#pragma unroll
            for (int e = 0; e < 4; ++e) { const int i = r0 + 4 * q + e; Lp[ci * LPF + (i & 3) * 16 + (i >> 2)] = (i < ci) ? acc[e] : 0.f; } }
        { f32x4 acc = mm_tile(SLOT(0), r0, SLOT(3), c0, lane);
#pragma unroll
            for (int e = 0; e < 4; ++e) acc[e] = (ci < r0 + 4 * q + e) ? acc[e] : 0.f;
            *(LAS v2u*)(SLOT(10) + ci * LP + r0 + 4 * q) = pack4(acc); }
        if (emit) {
            { f32x4 acc = mm_tile(SLOT(2), r0, SLOT(1), c0, lane);
#pragma unroll
                for (int e = 0; e < 4; ++e) acc[e] = (r0 + 4 * q + e <= ci) ? acc[e] : 0.f;
                *(LAS v2u*)(SLOT(11) + ci * LP + r0 + 4 * q) = pack4(acc); }
            { f32x4 acc = mm_tile(SLOT(3), r0, SLOT(1), c0, lane);
#pragma unroll
                for (int e = 0; e < 4; ++e) acc[e] = (r0 + 4 * q + e <= ci) ? acc[e] : 0.f;
                *(LAS v2u*)(SLOT(12) + ci * LP + r0 + 4 * q) = pack4(acc); }
        }
    }
    S1_BAR();
    if (wave < 4) {
        const int j = 16 * wave + (lane >> 2), s = lane & 3;
        float Tr[16];
#pragma unroll
        for (int m = 0; m < 16; ++m) Tr[m] = 0.f;
        const LAS float* lrow = Lp + s * 16;
        f32x4 lb[3][4];
#pragma unroll
        for (int t = 0; t < 2; ++t) lb[t][0] = *(const LAS f32x4*)(lrow + t * LPF);
#pragma unroll
        for (int t = 0; t < 64; ++t) {
            if (t + 2 < 64) {
#pragma unroll
                for (int k = 0; k < 4; ++k) if (4 * k <= (t + 2) / 4) lb[(t + 2) % 3][k] = *(const LAS f32x4*)(lrow + (t + 2) * LPF + 4 * k);
            }
            __builtin_amdgcn_sched_barrier(0);
            float acc0 = 0.f, acc1 = 0.f;
#pragma unroll
            for (int m = 0; m < 16; ++m) if (m <= t / 4) { const float lv = lb[t % 3][m >> 2][m & 3]; if (m & 1) acc1 += lv * Tr[m]; else acc0 += lv * Tr[m]; }
            float acc = acc0 + acc1;
            acc += __builtin_bit_cast(float, __builtin_amdgcn_update_dpp(0, __builtin_bit_cast(int, acc), 0xB1, 0xf, 0xf, false));
            acc += __builtin_bit_cast(float, __builtin_amdgcn_update_dpp(0, __builtin_bit_cast(int, acc), 0x4E, 0xf, 0xf, false));
            int jj = j, ss = s; asm volatile("" : "+v"(jj), "+v"(ss));
            const float val = acc + ((t == jj) ? 1.f : 0.f);
            Tr[t >> 2] = (ss == (t & 3)) ? val : Tr[t >> 2];
            SLOT(0)[t * LP + j] = (bf16)pk2z(val);
        }
    } else if (cvi >= 0) { f32x4 cv[CVK]; cvx_load(F.in, cvi, lane, cv); cvx_store(ws, cvi, lane, cv); }
    S1_BAR();
#pragma unroll
    for (int tix = 0; tix < 2; ++tix) { const int ti = 2 * wave + tix, r0 = 16 * (ti >> 2), c0 = 16 * (ti & 3), ci = c0 + rr;
        { const f32x4 acc = mm_tile(SLOT(0), r0, SLOT(4), c0, lane); *(LAS v2u*)(SLOT(2) + ci * LP + r0 + 4 * q) = pack4(acc); }
        { const f32x4 acc = mm_tile(SLOT(0), r0, SLOT(10), c0, lane); *(LAS v2u*)(SLOT(3) + ci * LP + r0 + 4 * q) = pack4(acc); }
    }
    S1_BAR();
    unsigned char* RH = ws + WS_RH + (size_t)u * 4096; bf16* GT = (bf16*)((unsigned char*)F.out + OUT_GT) + (size_t)u * 4096;
#pragma unroll
    for (int tix = 0; tix < 2; ++tix) { const int ti = 2 * wave + tix, tr = ti >> 2, r0 = 16 * tr, c0 = 16 * (ti & 3), ci = c0 + rr;
        const int pos = (tr >> 1) * 32 + q * 8 + 4 * (tr & 1);
        if (emit) {
            { f32x4 acc = mm_tile(SLOT(2), r0, SLOT(11), c0, lane);
                acc += unpack4(*(const LAS v2u*)(SLOT(1) + ci * LP + r0 + 4 * q));
                *(unsigned*)(RH + ci * 64 + pos) = pack4_fp8(acc); }
            { f32x4 acc = mm_tile(SLOT(3), r0, SLOT(11), c0, lane);
                acc += unpack4(*(const LAS v2u*)(SLOT(12) + ci * LP + r0 + 4 * q));
                *(LAS v2u*)(SLOT(4) + ci * LP + r0 + 4 * q) = pack4(acc); }
        }
        { f32x4 acc = mm_tile(SLOT(2), r0, SLOT(6), c0, lane);
            const float gc = gCs[ci];
#pragma unroll
            for (int e = 0; e < 4; ++e) acc[e] += (r0 + 4 * q + e == ci) ? gc : 0.f;
            *(v2u*)(GT + ci * 64 + pos) = pack4(acc); }
    }
    S1_BAR();
    unsigned char* YL = ws + WS_YL + (size_t)u * 4096;
#pragma unroll
    for (int tix = 0; tix < 2; ++tix) { const int ti = 2 * wave + tix, r0 = 16 * (ti >> 2), c0 = 16 * (ti & 3), ci = c0 + rr;
        if (emit) { const f32x4 acc = mm_tile(SLOT(5), r0, SLOT(4), c0, lane); *(unsigned*)(YL + ci * 64 + r0 + 4 * q) = pack4_fp8(acc); }
        { f32x4 acc = mm_tile(SLOT(3), r0, SLOT(6), c0, lane);
            acc += unpack4(*(const LAS v2u*)(SLOT(7) + ci * LP + r0 + 4 * q));
            *(LAS v2u*)(SLOT(8) + ci * LP + r0 + 4 * q) = pack4(acc); }
    }
    S1_BAR();
    bf16* HH = (bf16*)(ws + WS_HH) + (size_t)u * 4096;
#pragma unroll
    for (int tix = 0; tix < 2; ++tix) { const int ti = 2 * wave + tix, r0 = 16 * (ti >> 2), c0 = 16 * (ti & 3), ci = c0 + rr;
        const f32x4 acc = mm_tile(SLOT(8), r0, SLOT(5), c0, lane);
        *(v2u*)(HH + ci * 64 + r0 + 4 * q) = pack4(acc); }
    S1_BAR();
}

struct GlIn { bf16 la[8], q[8], k[8], v0[8], v1[8]; };
__device__ __forceinline__ void s1_gla_load(Frame& F, int u, GlIn& I) {
    const int sg = u / NCHUNK, c = u - sg * NCHUNK, gb = sg >> 3, gdir = (sg >> 2) & 1, gh = sg & 3; unsigned char* ws = F.ws;
    const bf16* Qp = (const bf16*)(ws + WS_QGB); const bf16* Kp = (const bf16*)(ws + WS_KGB); const bf16* Vp = (const bf16*)(ws + WS_VGB); const bf16* LAp = (const bf16*)(ws + (gdir ? WS_LAB : WS_LAF));
#pragma unroll
    for (int i = 0; i < 8; ++i) { const int row = scan_row(c * CH + 8 * F.wave + i, gb, gdir); const size_t b2 = (size_t)row * 256 + gh * 64 + F.lane, b5 = (size_t)row * RWW + gh * 128 + F.lane;
        I.la[i] = LAp[b2]; I.q[i] = Qp[b2]; I.k[i] = Kp[b2]; I.v0[i] = Vp[b5]; I.v1[i] = Vp[b5 + 64]; }
}
__device__ __forceinline__ void s1_gla(Frame& F, int u, const GlIn& I) {
    const int sg = u / NCHUNK, c = u - sg * NCHUNK;
    const bool emit = c >= CTXL / CH;
    LAS unsigned char* lds = F.lds; unsigned char* ws = F.ws;
    int lane_ = F.lane; asm volatile("" : "+v"(lane_));
    const int lane = lane_, wave = F.wave, rr = lane & 15, q = lane >> 4;
    LAS float* tot = (LAS float*)(lds + AUX_OFF);
    unsigned char* QE = (unsigned char*)F.out + OUT_QE + (size_t)u * 4096;
    {
        float la[8], xq[8], xk[8], v0[8], v1[8];
#pragma unroll
        for (int i = 0; i < 8; ++i) { la[i] = bf2f(I.la[i]); xq[i] = bf2f(I.q[i]); xk[i] = bf2f(I.k[i]); v0[i] = bf2f(I.v0[i]); v1[i] = bf2f(I.v1[i]); }
        float p[8]; p[0] = la[0];
#pragma unroll
        for (int i = 1; i < 8; ++i) p[i] = p[i - 1] + la[i];
        tot[wave * 64 + lane] = p[7];
        S1_BAR();
        float off = 0.f, all = 0.f;
#pragma unroll
        for (int w = 0; w < 8; ++w) { const float t = tot[w * 64 + lane]; all += t; off += (w < wave) ? t : 0.f; }
        if (wave == 0) ((float*)(ws + WS_DD))[(size_t)u * 64 + lane] = __expf(all);
        float kl[8];
#pragma unroll
        for (int i = 0; i < 8; ++i) { const float cum = off + p[i]; const int t = 8 * wave + i;
            const float qef = xq[i] * __expf(cum);
            SLOT(0)[t * LP + lane] = (bf16)pk2z(qef);
            if (emit) QE[t * 64 + lane] = (unsigned char)__builtin_amdgcn_cvt_pk_fp8_f32(clamp8(qef), 0.f, 0, false);
            SLOT(1)[t * LP + lane] = (bf16)pk2z(xk[i] * __expf(-cum));
            kl[i] = xk[i] * __expf(all - cum); }
        *(LAS v4u*)(SLOT(2) + lane * LP + 8 * wave) = pk8(kl);
        *(LAS v4u*)(SLOT(3) + lane * LP + 8 * wave) = pk8(v0);
        *(LAS v4u*)(SLOT(3) + (64 + lane) * LP + 8 * wave) = pk8(v1);
        S1_BAR();
    }
    if (emit) {
#pragma unroll
        for (int tix = 0; tix < 2; ++tix) { const int ti = 2 * wave + tix, r0 = 16 * (ti >> 2), c0 = 16 * (ti & 3), ci = c0 + rr;
            f32x4 acc = mm_tile(SLOT(1), r0, SLOT(0), c0, lane);
#pragma unroll
            for (int e = 0; e < 4; ++e) acc[e] = (r0 + 4 * q + e <= ci) ? acc[e] : 0.f;
            *(LAS v2u*)(SLOT(5) + ci * LP + r0 + 4 * q) = pack4(acc); }
    }
    bf16* KV = (bf16*)(ws + WS_KV) + (size_t)u * 8192;
#pragma unroll
    for (int tix = 0; tix < 4; ++tix) { const int ti = 4 * wave + tix, r0 = 16 * (ti >> 3), c0 = 16 * (ti & 7), ci = c0 + rr;
        const f32x4 acc = mm_tile(SLOT(2), r0, SLOT(3), c0, lane);
        *(v2u*)(KV + ci * 64 + r0 + 4 * q) = pack4(acc); }
    S1_BAR();
    if (emit) {
        unsigned char* IN = ws + WS_INTRA + (size_t)u * 8192;
#pragma unroll
        for (int tix = 0; tix < 4; ++tix) { const int ti = 4 * wave + tix, r0 = 16 * (ti >> 2), c0 = 16 * (ti & 3), ci = c0 + rr;
            const f32x4 acc = mm_tile(SLOT(3), r0, SLOT(5), c0, lane);
            *(unsigned*)(IN + ci * 128 + r0 + 4 * q) = pack4_fp8(acc); }
    }
    S1_BAR();
}

__device__ __forceinline__ void ph_scan1(Frame& F) {
    { RwIn cur, nxt; if ((int)blockIdx.x < NU_RW) s1_rwkv_load(F, blockIdx.x, cur);
#pragma unroll 1
      for (int u = blockIdx.x; u < NU_RW; u += F.G) { const int un = (u + F.G < NU_RW) ? u + F.G : u; const int cvi = ((u - (int)blockIdx.x) / F.G) * (F.G * 4) + (int)blockIdx.x * 4 + (F.wave & 3);
          s1_rwkv(F, u, cur, un, nxt, cvi < CV_NITEM ? cvi : -1); cur = nxt; } }
    { GlIn cur, nxt; if ((int)blockIdx.x < NU_GL) s1_gla_load(F, blockIdx.x, cur);
#pragma unroll 1
      for (int u = blockIdx.x; u < NU_GL; u += F.G) { const int un = (u + F.G < NU_GL) ? u + F.G : u; s1_gla_load(F, un, nxt); s1_gla(F, u, cur); cur = nxt; } }
}

__device__ __forceinline__ bf16x8 pack_frag(const f32x4 lo, const f32x4 hi) {
    v4u w; w.x = pk2(lo[0], lo[1]); w.y = pk2(lo[2], lo[3]); w.z = pk2(hi[0], hi[1]); w.w = pk2(hi[2], hi[3]); return __builtin_bit_cast(bf16x8, w);
}
constexpr int S2_D = 5, S2_R = 6, S2_RW = 8192 + 4096 + 2048 + 1024, S2_GL = 4096 + 2048 + 1024 + 1024, S2_SLOT = S2_RW + S2_GL;
static_assert(S2_R * S2_SLOT <= MISC_OFF, "S2 ring fits in LDS");
__device__ __forceinline__ void s2_issue(LAS unsigned char* lds, int sb, int lw, int lane, size_t ur, size_t ug, int v0r, int v0g,
                                         const unsigned char* GTb, const unsigned char* RHb, const unsigned char* HHb, const unsigned char* YLb,
                                         const unsigned char* QEb, const unsigned char* KVb, const unsigned char* INb, const unsigned char* DDb) {
#pragma unroll
    for (int j = 0; j < 4; ++j) {
        int k = lw * 4 + j; if (k >= 23) k -= 1;
        const unsigned char* src; int ldo;
        if (k < 8) { const int n = k, pu = n * 64 + lane, row = pu >> 3, c16 = (pu & 7) ^ (row & 7);
            src = GTb + ur * 8192 + row * 128 + c16 * 16; ldo = n * 1024; }
        else if (k < 12) { const int n = k - 8, pu = n * 64 + lane, row = pu >> 2, c16 = (pu & 3) ^ (row & 3);
            src = RHb + ur * 4096 + row * 64 + c16 * 16; ldo = 8192 + n * 1024; }
        else if (k < 14) { const int n = k - 12, pu = n * 64 + lane, v = pu >> 3, c16 = (pu & 7) ^ (v & 7);
            src = HHb + ur * 8192 + (size_t)(v0r + v) * 128 + c16 * 16; ldo = 12288 + n * 1024; }
        else if (k < 15) { const int t = lane;
            src = YLb + ur * 4096 + t * 64 + v0r; ldo = 14336; }
        else if (k < 19) { const int n = k - 15, pu = n * 64 + lane, row = pu >> 2, c16 = (pu & 3) ^ (row & 3);
            src = QEb + ug * 4096 + row * 64 + c16 * 16; ldo = S2_RW + n * 1024; }
        else if (k < 21) { const int n = k - 19, pu = n * 64 + lane, v = pu >> 3, c16 = (pu & 7) ^ (v & 7);
            src = KVb + ug * 16384 + (size_t)(v0g + v) * 128 + c16 * 16; ldo = S2_RW + 4096 + n * 1024; }
        else if (k < 22) { const int t = lane;
            src = INb + ug * 8192 + t * 128 + v0g; ldo = S2_RW + 6144; }
        else { src = DDb + ug * 256 + (lane & 15) * 16; ldo = S2_RW + 7168; }
        __builtin_amdgcn_global_load_lds((const unsigned*)src, (LAS unsigned*)(lds + sb + ldo), 16, 0, 0);
    }
}
__device__ __forceinline__ void ph_scan2(Frame& F) {
    const int lane = F.lane, wave = F.wave, rr = lane & 15, q = lane >> 4; unsigned char* ws = F.ws; LAS unsigned char* lds = F.lds;
    const int it = (F.G == 256) ? (int)(blockIdx.x & 7) * 32 + (int)(blockIdx.x >> 3) : (int)blockIdx.x;
    const int sr = it >> 2, v0r = 16 * (it & 3), rb = sr >> 4, rdir = (sr >> 3) & 1, rh = sr & 7;
    const int sg = it >> 3, v0g = 16 * (it & 7), gb = sg >> 3, gdir = (sg >> 2) & 1, gh = sg & 3;
#define S2_BAR() do { asm volatile("s_waitcnt lgkmcnt(0)" ::: "memory"); __builtin_amdgcn_s_barrier(); asm volatile("" ::: "memory"); } while (0)
    if (wave >= 2) {
        const unsigned char* GTb = (const unsigned char*)F.out + OUT_GT; const unsigned char* QEb = (const unsigned char*)F.out + OUT_QE;
        const unsigned char* RHb = ws + WS_RH; const unsigned char* YLb = ws + WS_YL; const unsigned char* HHb = ws + WS_HH; const unsigned char* KVb = ws + WS_KV; const unsigned char* INb = ws + WS_INTRA;
        const unsigned char* DDb = ws + WS_DD;
#define S2_ISSUE(cc) s2_issue(lds, ((cc) % S2_R) * S2_SLOT, wave - 2, lane, (size_t)(sr * NCHUNK + ((cc) < NCHUNK ? (cc) : NCHUNK - 1)), (size_t)(sg * NCHUNK + ((cc) < NCHUNK ? (cc) : NCHUNK - 1)), v0r, v0g, GTb, RHb, HHb, YLb, QEb, KVb, INb, DDb)
        S2_ISSUE(0); S2_ISSUE(1); S2_ISSUE(2); S2_ISSUE(3); S2_ISSUE(4);
#pragma unroll 1
        for (int c = 0; c < NCHUNK; ++c) {
            asm volatile("s_waitcnt vmcnt(16) ; S2WAIT" ::: "memory");
            S2_BAR();
            S2_ISSUE(c + S2_D);
        }
#undef S2_ISSUE
    } else if (wave == 0) {
        bf16* ORW = (bf16*)(ws + (rdir ? WS_ORWB : WS_ORWF));
        f32x4 S[4];
#pragma unroll
        for (int m = 0; m < 4; ++m) S[m] = (f32x4){0.f, 0.f, 0.f, 0.f};
#pragma unroll 1
        for (int c = 0; c < NCHUNK; ++c) {
            S2_BAR();
            const LAS unsigned char* sl = lds + (c % S2_R) * S2_SLOT;
            const bool emit = c >= CTXL / CH;
            bf16x8 G0[4], G1[4]; v2u Hw[4], Rw0[4], Rw1[4]; unsigned Yw[4];
#pragma unroll
            for (int m = 0; m < 4; ++m) { const int k2 = 16 * m + rr;
                G0[m] = *(const LAS bf16x8*)(sl + (k2 * 8 + (q ^ (k2 & 7))) * 16); G1[m] = *(const LAS bf16x8*)(sl + (k2 * 8 + ((4 + q) ^ (k2 & 7))) * 16);
                Hw[m] = *(const LAS v2u*)(sl + 12288 + (rr * 8 + ((2 * m + (q >> 1)) ^ (rr & 7))) * 16 + (q & 1) * 8); }
            if (emit) {
#pragma unroll
                for (int tt = 0; tt < 4; ++tt) { const int t = 16 * tt + rr;
                    Rw0[tt] = *(const LAS v2u*)(sl + 8192 + (t * 4 + ((q >> 1) ^ (t & 3))) * 16 + (q & 1) * 8); Rw1[tt] = *(const LAS v2u*)(sl + 8192 + (t * 4 + ((2 + (q >> 1)) ^ (t & 3))) * 16 + (q & 1) * 8);
                    Yw[tt] = *(const LAS unsigned*)(sl + 14336 + t * 16 + q * 4); }
            }
            const bf16x8 Sf0 = pack_frag(S[0], S[1]), Sf1 = pack_frag(S[2], S[3]);
            __builtin_amdgcn_sched_barrier(0);
#pragma unroll
            for (int m = 0; m < 4; ++m) { f32x4 acc = unpack4(Hw[m]);
                acc = __builtin_amdgcn_mfma_f32_16x16x32_bf16(G0[m], Sf0, acc, 0, 0, 0);
                acc = __builtin_amdgcn_mfma_f32_16x16x32_bf16(G1[m], Sf1, acc, 0, 0, 0);
                S[m] = acc; }
            if (emit) {
#pragma unroll
                for (int tt = 0; tt < 4; ++tt) { const int t = 16 * tt + rr;
                    const bf16x8 R0 = pack_frag(unpack4_fp8(Rw0[tt].x), unpack4_fp8(Rw0[tt].y)), R1 = pack_frag(unpack4_fp8(Rw1[tt].x), unpack4_fp8(Rw1[tt].y));
                    f32x4 acc = unpack4_fp8(Yw[tt]);
                    acc = __builtin_amdgcn_mfma_f32_16x16x32_bf16(Sf0, R0, acc, 0, 0, 0);
                    acc = __builtin_amdgcn_mfma_f32_16x16x32_bf16(Sf1, R1, acc, 0, 0, 0);
                    const int row = scan_row(c * CH + t, rb, rdir);
                    *(v2u*)(ORW + (size_t)row * RWW + rh * 64 + v0r + 4 * q) = pack4(acc); }
            }
        }
    } else {
        bf16* OGL = (bf16*)(ws + (gdir ? WS_OGLB : WS_OGLF));
        f32x4 S[4];
#pragma unroll
        for (int m = 0; m < 4; ++m) S[m] = (f32x4){0.f, 0.f, 0.f, 0.f};
#pragma unroll 1
        for (int c = 0; c < NCHUNK; ++c) {
            S2_BAR();
            const LAS unsigned char* sl = lds + (c % S2_R) * S2_SLOT + S2_RW;
            const bool emit = c >= CTXL / CH;
            v2u Qw0[4], Qw1[4]; unsigned Iw[4]; v4u kw[2]; f32x4 d0[2], d1[2];
#pragma unroll
            for (int s2 = 0; s2 < 2; ++s2) { kw[s2] = *(const LAS v4u*)(sl + 4096 + (rr * 8 + ((4 * s2 + q) ^ (rr & 7))) * 16);
                d0[s2] = *(const LAS f32x4*)(sl + 7168 + 128 * s2 + 32 * q); d1[s2] = *(const LAS f32x4*)(sl + 7168 + 128 * s2 + 32 * q + 16); }
            if (emit) {
#pragma unroll
                for (int tt = 0; tt < 4; ++tt) { const int t = 16 * tt + rr;
                    Qw0[tt] = *(const LAS v2u*)(sl + (t * 4 + ((q >> 1) ^ (t & 3))) * 16 + (q & 1) * 8); Qw1[tt] = *(const LAS v2u*)(sl + (t * 4 + ((2 + (q >> 1)) ^ (t & 3))) * 16 + (q & 1) * 8);
                    Iw[tt] = *(const LAS unsigned*)(sl + 6144 + t * 16 + q * 4); }
            }
            const bf16x8 Sf0 = pack_frag(S[0], S[1]), Sf1 = pack_frag(S[2], S[3]);
            __builtin_amdgcn_sched_barrier(0);
#pragma unroll
            for (int s2 = 0; s2 < 2; ++s2) { S[2 * s2] = S[2 * s2] * d0[s2] + unpack4((v2u){kw[s2].x, kw[s2].y}); S[2 * s2 + 1] = S[2 * s2 + 1] * d1[s2] + unpack4((v2u){kw[s2].z, kw[s2].w}); }
            if (emit) {
#pragma unroll
                for (int tt = 0; tt < 4; ++tt) { const int t = 16 * tt + rr;
                    const bf16x8 Q0 = pack_frag(unpack4_fp8(Qw0[tt].x), unpack4_fp8(Qw0[tt].y)), Q1 = pack_frag(unpack4_fp8(Qw1[tt].x), unpack4_fp8(Qw1[tt].y));
                    f32x4 acc = unpack4_fp8(Iw[tt]);
                    acc = __builtin_amdgcn_mfma_f32_16x16x32_bf16(Sf0, Q0, acc, 0, 0, 0);
                    acc = __builtin_amdgcn_mfma_f32_16x16x32_bf16(Sf1, Q1, acc, 0, 0, 0);
                    const int row = scan_row(c * CH + t, gb, gdir);
                    *(v2u*)(OGL + (size_t)row * RWW + gh * 128 + v0g + 4 * q) = pack4(acc); }
            }
        }
    }
#undef S2_BAR
}
#endif

#ifndef ML
#define ML 0
#endif
enum Phase { PH_PROLOGUE = 0, PH_A1, PH_INPROJ, PH_FEAT, PH_LORA, PH_SCAN1, PH_SCAN2, PH_MERGE, PH_BRANCH, PH_OUTPROJ, PH_LN1, PH_ROUTER, PH_ROUTE, PH_SCATTER, PH_EXP1, PH_EXP2, PH_FINAL, PH_COUNT };

__global__ void __launch_bounds__(NTHR, 2) mega(Args args) {
    extern __shared__ __attribute__((aligned(16))) unsigned char lds_raw[];
    Frame F;
    F.lds = (LAS unsigned char*)lds_raw;
    F.tid = threadIdx.x; F.lane = F.tid & 63; F.wave = __builtin_amdgcn_readfirstlane(F.tid >> 6);
    F.G = gridDim.x; F.gw = blockIdx.x * NWAVES + F.wave; F.NGW = F.G * NWAVES;
    F.in = args.in; F.out = args.out; F.ws = args.ws; F.ctl = (unsigned*)(args.ws + WS_CTL);
    volatile LAS unsigned* MISC = (volatile LAS unsigned*)(F.lds + MISC_OFF);
    if (F.tid < 64) MISC[F.tid] = 0u;
    __syncthreads();
    XcdBarrier bar; bar.bar = F.ctl + CW_BAR; bar.x = 0; bar.st = nullptr;
#if !ML
    bar = xcd_barrier_post(F.ctl + CW_BAR, MISC + 8);
#endif
    const int lo = args.ph_lo, hi = args.ph_hi;
#define IN(k) (lo <= (k) && (k) < hi)
#ifndef DUP
#define DUP -1
#endif
#define RUN(k, call) do { if (IN(k)) { call; GRID_BAR(); if (DUP == (k)) { call; GRID_BAR(); } } } while (0)
#if ML
#define GRID_BAR() do { } while (0)
#else
#define GRID_BAR() xcd_barrier(bar)
#endif

#if MS >= 2
    RUN(PH_PROLOGUE, ph_prologue(F));
#endif
#if MS >= 3
    RUN(PH_A1, ph_a1(F));
    RUN(PH_INPROJ, ph_inproj(F));
    RUN(PH_FEAT, ph_feat(F));
    RUN(PH_LORA, ph_lora(F));
    RUN(PH_SCAN1, ph_scan1(F));
    RUN(PH_SCAN2, ph_scan2(F));
    RUN(PH_MERGE, ph_merge(F));
    RUN(PH_BRANCH, ph_branch(F));
    RUN(PH_OUTPROJ, ph_outproj(F));
#else
    RUN(PH_OUTPROJ, ph_x1pre_nomix(F));
#endif
    RUN(PH_LN1, ph_ln1(F));
#if MS >= 2
    RUN(PH_ROUTER, ph_router(F));
    RUN(PH_ROUTE, ph_route(F));
    RUN(PH_SCATTER, ph_scatter(F));
    RUN(PH_EXP1, ph_exp1(F));
    RUN(PH_EXP2, ph_exp2(F));
#endif
    if (IN(PH_FINAL)) { ph_final(F); }
#undef IN
}

extern "C" void kernel_launch(void* const* d_in, const int* in_sizes, int n_in, void* d_out, int out_size, void* d_ws, size_t ws_size, hipStream_t stream) {
    static int grid = 0;
    if (grid == 0) {
        if (n_in != 36 || out_size != NLAT * D || ws_size < WS_END) { fprintf(stderr, "kernel_launch: unexpected problem shape (n_in %d, out %d)\n", n_in, out_size); grid = -1; return; }
        int dev = 0, cus = 0, per_cu = 0;
        if (hipGetDevice(&dev) != hipSuccess || hipDeviceGetAttribute(&cus, hipDeviceAttributeMultiprocessorCount, dev) != hipSuccess) { grid = -1; return; }
        if (hipFuncSetAttribute((const void*)mega, hipFuncAttributeMaxDynamicSharedMemorySize, LDS_BYTES) != hipSuccess) { fprintf(stderr, "kernel_launch: hipFuncSetAttribute failed\n"); grid = -1; return; }
        if (hipOccupancyMaxActiveBlocksPerMultiprocessor(&per_cu, (const void*)mega, NTHR, LDS_BYTES) != hipSuccess || per_cu < 1) { fprintf(stderr, "kernel_launch: occupancy query says %d\n", per_cu); }
        (void)hipGetLastError();
        grid = cus > 0 ? cus : 256;
        if (grid > 256) grid = 256;
    }
    if (grid < 0) return;
    (void)hipMemsetAsync((char*)d_ws + WS_CTL, 0, CTL_ZERO_BYTES, stream);
    Args a{};
    for (int i = 0; i < 36; ++i) a.in[i] = (const float*)d_in[i];
    a.out = (float*)d_out; a.ws = (unsigned char*)d_ws;
#if ML
    for (int p = 0; p < PH_COUNT; ++p) { a.ph_lo = p; a.ph_hi = p + 1; hipLaunchKernelGGL(mega, dim3(grid), dim3(NTHR), LDS_BYTES, stream, a); }
#else
    a.ph_lo = 0; a.ph_hi = PH_COUNT;
    hipLaunchKernelGGL(mega, dim3(grid), dim3(NTHR), LDS_BYTES, stream, a);
#endif
}
```

```cpp
#include <hip/hip_runtime.h>
#include <cstdio>
#include <cstdint>

#ifndef MS
#define MS 3
#endif

#define GAS __attribute__((address_space(1)))
#define LAS __attribute__((address_space(3)))
typedef unsigned short bf16;
typedef unsigned v4u __attribute__((ext_vector_type(4)));
typedef unsigned v2u __attribute__((ext_vector_type(2)));
typedef float f32x4 __attribute__((ext_vector_type(4)));
typedef float f32x2 __attribute__((ext_vector_type(2)));
typedef short bf16x8 __attribute__((ext_vector_type(8)));
#define LDS_WAIT() asm volatile("s_waitcnt lgkmcnt(0)" ::: "memory")
#define VM_WAIT() asm volatile("s_waitcnt vmcnt(0)" ::: "memory")

constexpr int D = 1024, NB = 4, SEQ = 8192, CTXL = 256, GRIDW = 64, GRIDH = 128;
constexpr int NLAT = NB * SEQ, NCTX = NB * CTXL, MR = NLAT + NCTX;
constexpr int RWW = 512, RWH = 8, HD = 64;
constexpr int C_R = 0, C_K = 512, C_V = 1024, C_PW = 1536, C_PA = 1568, C_PG = 1600, C_Q = 1696, C_KG = 1952, C_VG = 2208, C_PGL = 2720, C_OG = 2736, C_GRW = 3248, C_GGLA = 4272;
constexpr int IN_COLS = 5296, NP = 5376;
constexpr int NE = 256, TOPK = 8, FF = 256;
constexpr float LN_EPS = 1e-5f, RW_GN_EPS = 64e-5f;
constexpr float ALPHA = 1.189207115f;
constexpr float W8S = 64.0f, W8I = 1.0f / 64.0f;
constexpr int NLORA = 3072, KLORA = 256;
constexpr int MAXTILES = 1280, SH_ROW0 = MAXTILES * 256, NROWS_E = SH_ROW0 + NLAT;

namespace pg8 {
#define PG8_LAS __attribute__((address_space(3)))
typedef unsigned short bf16_t;
typedef unsigned u32x4 __attribute__((ext_vector_type(4)));
typedef unsigned u32x2 __attribute__((ext_vector_type(2)));
typedef long i64x2 __attribute__((ext_vector_type(2)));
constexpr int BM = 256, BK = 64, HALF = 128, HTB = HALF * BK * 2, STAGE_BYTES = 8 * HTB, NXCD = 8, WGM = 8;
constexpr int IDX_OFF = STAGE_BYTES, IDX_UNITS = 12;

__host__ __device__ __forceinline__ int lds_byte(int r, int c) { const int st = (r >> 4) * 2 + (c >> 5), rr = r & 15, cc = c & 31, ob = rr * 64 + cc * 2; return st * 1024 + (ob ^ (((ob >> 9) & 1) << 5)); }
__host__ __device__ __forceinline__ void stage_rc(int b, int& R, int& C) { const int st = b / 1024, sb = b % 1024, swz = sb ^ (((sb >> 9) & 1) << 5); R = (st >> 1) * 16 + swz / 64; C = (st & 1) * 32 + (swz % 64) / 2; }
__host__ __device__ __forceinline__ int perm32(int rho) { const int n = rho >> 4, i = rho & 15; return 8 * (i >> 2) + 4 * n + (i & 3); }

struct Unit { int pm, pn, e, j; };
struct Gemm { const bf16_t* A; const bf16_t* Bt; int M, N, K; const int* rowidx; };

struct StaticOrder {
    int nM, nN, nwg, G, c;
    __host__ __device__ void init(int M, int N, int G_, int c_) { nM = M / BM; nN = N / BM; nwg = nM * nN; G = G_; c = c_; }
    __host__ __device__ bool next(int i, Unit& u) const {
        const long L = (long)i * G + c; if (L >= nwg) return false;
        int wgid = (int)L; { const int q = nwg / NXCD, r = nwg % NXCD, xcd = wgid % NXCD, off = wgid / NXCD; wgid = (xcd < r ? xcd * (q + 1) : r * (q + 1) + (xcd - r) * q) + off; }
        const int nig = WGM * nN, gid = wgid / nig, fm = gid * WGM, gsz = (nM - fm) < WGM ? (nM - fm) : WGM;
        u.pm = fm + ((wgid % nig) % gsz); u.pn = (wgid % nig) / gsz; u.e = 0; u.j = u.pn; return true;
    }
};
struct MoeOrder {
    int nN, G, c, NT; const int* tile_e;
    __device__ bool next(int i, Unit& u) const {
        const int L = i * G + c; const int total = (NT + NLAT / 256) * nN; if (L >= total) return false;
        const int tile = L / nN, j = L - tile * nN; int e, pm;
        if (tile < NT) { e = tile_e[tile]; pm = tile; } else { e = NE; pm = MAXTILES + (tile - NT); }
        u.pm = pm; u.pn = e * nN + j; u.e = e; u.j = j; return true;
    }
};

typedef __bf16 bf16x2n __attribute__((ext_vector_type(2))); typedef float f32x2n __attribute__((ext_vector_type(2)));
__device__ __forceinline__ unsigned cvt_pk_bf16(float lo, float hi) { const f32x2n v = {lo, hi}; return __builtin_bit_cast(unsigned, __builtin_convertvector(v, bf16x2n)); }

template <class Epi, class Sched, bool ALIGN_EPI, bool SP2, bool GATHER, bool FP8 = false>
__device__ __forceinline__ void gemm_phase(PG8_LAS unsigned char* lds, const Gemm g, const Sched& S, const Epi& E) {
    const int tid = threadIdx.x, wid = __builtin_amdgcn_readfirstlane(tid >> 6), lane = tid & 63, wr = wid >> 2, wc = wid & 3, fr = lane & 15, fq = lane >> 4;
    const int K = g.K, nt = K / BK;
    const size_t kstep = (size_t)(BK * 2);
    const size_t hstep = (size_t)HALF * K * 2;
    const size_t tstep = 2 * hstep;
    unsigned voffB[2]; unsigned va[2][2];
#pragma unroll
    for (int i = 0; i < 2; ++i) { int R, C; stage_rc(tid * 16 + i * 8192, R, C); const int Rb = Epi::PERM ? ((R & ~31) + perm32(R & 31)) : R;
        voffB[i] = (unsigned)(Rb * K + C) * 2u;
        va[0][i] = (unsigned)(R * K + C) * 2u; va[1][i] = va[0][i]; }
    const size_t ah = GATHER ? (size_t)0 : hstep;
#define PG8_GOFF(dst, ub) do { _Pragma("unroll") for (int _h = 0; _h < 2; ++_h) _Pragma("unroll") for (int _i = 0; _i < 2; ++_i) { int _R, _C; stage_rc(tid * 16 + _i * 8192, _R, _C); \
        dst[_h][_i] = (unsigned)(idxt[(ub) * 256 + _h * 128 + _R] * K + _C) * 2u; } } while (0)
    const unsigned ldsw = (unsigned)wid * 1024u;
    const int aoff = lds_byte(wr * 64 + fr, fq * 8), boff = lds_byte(wc * 32 + fr, fq * 8);
    PG8_LAS int* idxt = (PG8_LAS int*)(lds + IDX_OFF);
#define PG8_SA(b, h) (((b) * 2 + (h)) * HTB)
#define PG8_SB(b, h) ((4 + (b) * 2 + (h)) * HTB)
#define PG8_STAGE(bufoff, gbase, voff) do { _Pragma("unroll") for (int _i = 0; _i < 2; ++_i) \
        __builtin_amdgcn_global_load_lds((const unsigned*)((const char*)(gbase) + (voff)[_i]), (PG8_LAS unsigned*)(lds + (bufoff) + ldsw + _i * 8192), 16, 0, 0); } while (0)
#define PG8_LDA(dst, b, h) do { _Pragma("unroll") for (int m = 0; m < 4; ++m) _Pragma("unroll") for (int k = 0; k < 2; ++k) dst[m][k] = *(const PG8_LAS bf16x8*)(lds + PG8_SA(b, h) + aoff + m * 2048 + k * 1024); } while (0)
#define PG8_LDB(dst, b, h) do { _Pragma("unroll") for (int n = 0; n < 2; ++n) _Pragma("unroll") for (int k = 0; k < 2; ++k) dst[n][k] = *(const PG8_LAS bf16x8*)(lds + PG8_SB(b, h) + boff + n * 2048 + k * 1024); } while (0)
#define PG8_MMA(ai, bj, At, Bt) do { __builtin_amdgcn_s_setprio(1); _Pragma("unroll") for (int m = 0; m < 4; ++m) _Pragma("unroll") for (int n = 0; n < 2; ++n) _Pragma("unroll") for (int k = 0; k < 2; ++k) { \
        if constexpr (FP8) { const i64x2 _b = __builtin_bit_cast(i64x2, Bt[n][k]), _a = __builtin_bit_cast(i64x2, At[m][k]); \
            acc[ai][bj][m][n] = __builtin_amdgcn_mfma_f32_16x16x32_fp8_fp8(_b[0], _a[0], acc[ai][bj][m][n], 0, 0, 0); acc[ai][bj][m][n] = __builtin_amdgcn_mfma_f32_16x16x32_fp8_fp8(_b[1], _a[1], acc[ai][bj][m][n], 0, 0, 0); } \
        else acc[ai][bj][m][n] = __builtin_amdgcn_mfma_f32_16x16x32_bf16(Bt[n][k], At[m][k], acc[ai][bj][m][n], 0, 0, 0); } __builtin_amdgcn_s_setprio(0); } while (0)
#define PG8_WAIT_V(n) asm volatile("s_waitcnt vmcnt(" #n ")" ::: "memory")
#define PG8_WAIT_L(n) asm volatile("s_waitcnt lgkmcnt(" #n ")" ::: "memory")
#define PG8_BAR __builtin_amdgcn_s_barrier()
#define PG8_SCHED __builtin_amdgcn_sched_barrier(0)
    Unit cur, nxt; int ui = 0;
    if (!S.next(0, cur)) return;
#ifdef GEMM_STAGGER
    if constexpr (FP8) {
        const unsigned long long t0 = __builtin_amdgcn_s_memrealtime(); const unsigned long long dl = (unsigned long long)(blockIdx.x & 3) * GEMM_STAGGER;
        while (__builtin_amdgcn_s_memrealtime() - t0 < dl) __builtin_amdgcn_s_sleep(8);
    }
#endif
    if constexpr (GATHER) {
        Unit uu;
        for (int i = 0; i < IDX_UNITS; ++i) { if (!S.next(i, uu)) break; if (tid < 256) idxt[i * 256 + tid] = g.rowidx[(size_t)uu.pm * 256 + tid]; }
        asm volatile("s_waitcnt vmcnt(0) lgkmcnt(0)" ::: "memory"); PG8_BAR; asm volatile("" ::: "memory");
        PG8_GOFF(va, 0);
    }
    f32x4 acc[2][2][4][2];
#pragma unroll
    for (int a = 0; a < 2; ++a)
#pragma unroll
        for (int b = 0; b < 2; ++b)
#pragma unroll
            for (int m = 0; m < 4; ++m)
#pragma unroll
                for (int n = 0; n < 2; ++n) acc[a][b][m][n] = (f32x4){0.f, 0.f, 0.f, 0.f};
    bf16x8 At[4][2], B0[2][2], B1[2][2];
    const char* cA = (const char*)g.A + (GATHER ? (size_t)0 : (size_t)cur.pm * tstep); const char* cB = (const char*)g.Bt + (size_t)cur.pn * tstep;
    if constexpr (SP2) {
        PG8_STAGE(PG8_SB(0, 0), cB, voffB); PG8_STAGE(PG8_SB(0, 1), cB + hstep, voffB); PG8_STAGE(PG8_SA(0, 0), cA, va[0]); PG8_STAGE(PG8_SA(0, 1), cA + ah, va[1]);
        if (wr == 1) PG8_BAR;
        PG8_WAIT_V(2); PG8_BAR;
        PG8_STAGE(PG8_SB(1, 0), cB + kstep, voffB); PG8_STAGE(PG8_SA(1, 0), cA + kstep, va[0]); PG8_STAGE(PG8_SB(1, 1), cB + hstep + kstep, voffB);
        PG8_WAIT_V(6); PG8_BAR;
    } else {
        PG8_STAGE(PG8_SB(0, 0), cB, voffB); PG8_STAGE(PG8_SA(0, 0), cA, va[0]); PG8_STAGE(PG8_SB(0, 1), cB + hstep, voffB); PG8_STAGE(PG8_SA(0, 1), cA + ah, va[1]);
        if (wr == 1) PG8_BAR;
        PG8_WAIT_V(4); PG8_BAR;
        PG8_STAGE(PG8_SB(1, 0), cB + kstep, voffB); PG8_STAGE(PG8_SA(1, 0), cA + kstep, va[0]); PG8_STAGE(PG8_SB(1, 1), cB + hstep + kstep, voffB);
        PG8_WAIT_V(6); PG8_BAR;
    }
    for (;;) {
        const bool has_next = S.next(ui + 1, nxt);
        const char* nA = has_next ? (const char*)g.A + (GATHER ? (size_t)0 : (size_t)nxt.pm * tstep) : cA; const char* nB = has_next ? (const char*)g.Bt + (size_t)nxt.pn * tstep : cB;
        const int ubn = (has_next && ui + 1 < IDX_UNITS) ? (ui + 1) : ui;
#pragma unroll 1
        for (int t = 0; t < nt; t += 2) {
            const bool last = (t == nt - 2);
            const char* a1 = cA + (size_t)(t + 1) * kstep;
            const char* a2 = last ? nA : cA + (size_t)(t + 2) * kstep; const char* b2 = last ? nB : cB + (size_t)(t + 2) * kstep;
            const char* a3 = a2 + kstep; const char* b3 = b2 + kstep;
            unsigned v2[2][2];
#pragma unroll
            for (int h = 0; h < 2; ++h)
#pragma unroll
                for (int i = 0; i < 2; ++i) v2[h][i] = va[h][i];
            if constexpr (GATHER) { if (last) PG8_GOFF(v2, ubn); }
            if constexpr (SP2) {
            PG8_LDB(B0, 0, 0); PG8_LDB(B1, 0, 1); PG8_SCHED; PG8_LDA(At, 0, 0); PG8_STAGE(PG8_SA(1, 1), a1 + ah, va[1]);
            PG8_WAIT_V(8); PG8_WAIT_L(0); PG8_BAR; PG8_MMA(0, 0, At, B0); PG8_MMA(0, 1, At, B1); PG8_BAR; PG8_SCHED;
            PG8_LDA(At, 0, 1); PG8_STAGE(PG8_SB(0, 0), b2, voffB); PG8_STAGE(PG8_SB(0, 1), b2 + hstep, voffB); PG8_STAGE(PG8_SA(0, 0), a2, v2[0]);
            PG8_WAIT_V(8); PG8_WAIT_L(0); PG8_BAR; PG8_MMA(1, 0, At, B0); PG8_MMA(1, 1, At, B1); PG8_BAR; PG8_SCHED;
            PG8_LDB(B0, 1, 0); PG8_LDB(B1, 1, 1); PG8_SCHED; PG8_LDA(At, 1, 0); PG8_STAGE(PG8_SA(0, 1), a2 + ah, v2[1]);
            PG8_WAIT_V(8); PG8_WAIT_L(0); PG8_BAR; PG8_MMA(0, 0, At, B0); PG8_MMA(0, 1, At, B1); PG8_BAR; PG8_SCHED;
            PG8_LDA(At, 1, 1); PG8_STAGE(PG8_SB(1, 0), b3, voffB); PG8_STAGE(PG8_SB(1, 1), b3 + hstep, voffB); PG8_STAGE(PG8_SA(1, 0), a3, v2[0]);
            PG8_WAIT_V(8); PG8_WAIT_L(0); PG8_BAR; PG8_MMA(1, 0, At, B0); PG8_MMA(1, 1, At, B1); PG8_BAR; PG8_SCHED;
            } else {
            PG8_LDB(B0, 0, 0); PG8_SCHED; PG8_LDA(At, 0, 0); PG8_STAGE(PG8_SA(1, 1), a1 + ah, va[1]);
            PG8_WAIT_L(8); PG8_BAR; PG8_WAIT_L(0); PG8_MMA(0, 0, At, B0); PG8_BAR; PG8_SCHED;
            PG8_LDB(B1, 0, 1); PG8_STAGE(PG8_SB(0, 0), b2, voffB);
            PG8_BAR; PG8_WAIT_L(0); PG8_MMA(0, 1, At, B1); PG8_BAR;
            PG8_LDA(At, 0, 1); PG8_STAGE(PG8_SA(0, 0), a2, v2[0]);
            PG8_BAR; PG8_WAIT_L(0); PG8_MMA(1, 0, At, B0); PG8_BAR; PG8_SCHED;
            PG8_STAGE(PG8_SB(0, 1), b2 + hstep, voffB);
            PG8_WAIT_V(6); PG8_BAR; PG8_MMA(1, 1, At, B1); PG8_BAR;
            PG8_LDB(B0, 1, 0); PG8_SCHED; PG8_LDA(At, 1, 0); PG8_STAGE(PG8_SA(0, 1), a2 + ah, v2[1]);
            PG8_WAIT_L(8); PG8_BAR; PG8_WAIT_L(0); PG8_MMA(0, 0, At, B0); PG8_BAR; PG8_SCHED;
            PG8_LDB(B1, 1, 1); PG8_STAGE(PG8_SB(1, 0), b3, voffB);
            PG8_BAR; PG8_WAIT_L(0); PG8_MMA(0, 1, At, B1); PG8_BAR;
            PG8_LDA(At, 1, 1); PG8_STAGE(PG8_SA(1, 0), a3, v2[0]);
            PG8_BAR; PG8_WAIT_L(0); PG8_MMA(1, 0, At, B0); PG8_BAR; PG8_SCHED;
            PG8_STAGE(PG8_SB(1, 1), b3 + hstep, voffB);
            PG8_WAIT_V(6); PG8_BAR; PG8_MMA(1, 1, At, B1); PG8_BAR;
            }
        }
        if constexpr (ALIGN_EPI) { if (wr == 0) PG8_BAR; }
        E(acc, cur, wr, wc, fr, fq);
        if (!has_next) break;
#pragma unroll
        for (int a = 0; a < 2; ++a)
#pragma unroll
            for (int b = 0; b < 2; ++b)
#pragma unroll
                for (int m = 0; m < 4; ++m)
#pragma unroll
                    for (int n = 0; n < 2; ++n) acc[a][b][m][n] = (f32x4){0.f, 0.f, 0.f, 0.f};
        cur = nxt; cA = nA; cB = nB; ++ui;
        if constexpr (GATHER) PG8_GOFF(va, ubn);
        if constexpr (ALIGN_EPI) { if (wr == 1) PG8_BAR; }
    }
    PG8_WAIT_V(0);
    if constexpr (!ALIGN_EPI) { if (wr == 0) PG8_BAR; }
    PG8_BAR;
#undef PG8_SA
#undef PG8_GOFF
#undef PG8_SB
#undef PG8_STAGE
#undef PG8_LDA
#undef PG8_LDB
#undef PG8_MMA
#undef PG8_WAIT_V
#undef PG8_WAIT_L
#undef PG8_BAR
#undef PG8_SCHED
}
}

#define XB_TMO      128
#define XB_XCNT(j)  (256  + 64 * (j))
#define XB_XSUB(j)  (1280 + 64 * (j))
#define XB_XGEN(j)  (2304 + 64 * (j))
#define XB_TOP      3328
#define XB_TOPGEN   3392
#define XCD_BAR_WORDS 3456
#define XB_SPIN_CAP (1u << 18)
__device__ __forceinline__ unsigned xb_ld(unsigned* p)              { return __hip_atomic_load(p, __ATOMIC_RELAXED, __HIP_MEMORY_SCOPE_AGENT); }
__device__ __forceinline__ unsigned xb_add(unsigned* p, unsigned v) { return __hip_atomic_fetch_add(p, v, __ATOMIC_RELAXED, __HIP_MEMORY_SCOPE_AGENT); }
__device__ __forceinline__ unsigned xb_xcc_id() { return (unsigned)__builtin_amdgcn_s_getreg((3 << 11) | 20) & 0xFu; }
#define XB_SPIN(cond, bar) do { unsigned _sp = 0; while (cond) { __builtin_amdgcn_s_sleep(1); \
    if ((++_sp & 255u) == 0u) { if (xb_ld(&(bar)[XB_TMO])) break; if (_sp > XB_SPIN_CAP) { atomicAdd(&(bar)[XB_TMO], 1u); break; } } } } while (0)
struct XcdBarrier { unsigned* bar; unsigned x; volatile LAS unsigned* st; };
__device__ __forceinline__ XcdBarrier xcd_barrier_post(unsigned* bar, volatile LAS unsigned* st) {
    XcdBarrier b; b.bar = bar; b.x = xb_xcc_id(); b.st = st;
    if (threadIdx.x == 0) (void)xb_add(&bar[XB_XCNT(b.x)], 1u);
    return b;
}
__device__ __forceinline__ void xcd_barrier_complete(unsigned* bar, unsigned x, unsigned& nloc, unsigned& nx) {
    const unsigned G = gridDim.x * gridDim.y * gridDim.z;
    unsigned sum, cnt, mine, sp = 0u;
    for (;;) {
        sum = 0u; cnt = 0u; mine = 0u;
#pragma unroll
        for (unsigned j = 0; j < 16; ++j) { const unsigned c = xb_ld(&bar[XB_XCNT(j)]); sum += c; cnt += (c > 0u) ? 1u : 0u; mine = (j == x) ? c : mine; }
        if (sum == G) break;
        __builtin_amdgcn_s_sleep(1);
        if ((++sp & 255u) == 0u) { if (xb_ld(&bar[XB_TMO])) break; if (sp > XB_SPIN_CAP) { atomicAdd(&bar[XB_TMO], 1u); break; } }
    }
    nloc = mine > 0u ? mine : 1u; nx = cnt > 0u ? cnt : 1u;
}
__device__ __forceinline__ void xcd_barrier(const XcdBarrier& b) {
    asm volatile("s_waitcnt vmcnt(0)" ::: "memory");
    __syncthreads();
    if (threadIdx.x == 0) {
        unsigned* bar = b.bar;
        __builtin_amdgcn_s_waitcnt(0);
        unsigned nloc = b.st[0], nx = b.st[1];
        if (nloc == 0u) { xcd_barrier_complete(bar, b.x, nloc, nx); b.st[0] = nloc; b.st[1] = nx; }
        const unsigned old = xb_add(&bar[XB_XSUB(b.x)], 1u);
        const unsigned gen = old / nloc;
        if (old + 1u == (gen + 1u) * nloc) {
            __builtin_amdgcn_fence(__ATOMIC_RELEASE, "agent");
            asm volatile("s_waitcnt vmcnt(0)" ::: "memory");
            const unsigned og = xb_add(&bar[XB_TOP], 1u);
            const unsigned tg = og / nx;
            if (og + 1u == (tg + 1u) * nx) xb_add(&bar[XB_TOPGEN], 1u);
            else XB_SPIN(xb_ld(&bar[XB_TOPGEN]) == tg, bar);
            __builtin_amdgcn_fence(__ATOMIC_ACQUIRE, "agent");
            xb_add(&bar[XB_XGEN(b.x)], 1u);
            asm volatile("s_waitcnt vmcnt(0)" ::: "memory");
        } else {
            XB_SPIN(xb_ld(&bar[XB_XGEN(b.x)]) == gen, bar);
            __builtin_amdgcn_fence(__ATOMIC_ACQUIRE, "agent");
            asm volatile("s_waitcnt vmcnt(0)" ::: "memory");
        }
    }
    __syncthreads();
}

constexpr size_t MiB = 1u << 20;
constexpr size_t al(size_t x) { return (x + 4095) & ~(size_t)4095; }
constexpr size_t WS_CTL = 0, CTL_ZERO_BYTES = 1 * MiB;
constexpr int CW_BAR = 4096;
constexpr int CW_CNT = 16384, CNT_STRIDE = 64;
constexpr int CW_NT = CW_CNT + NE * CNT_STRIDE + 64;
static_assert((CW_NT + 1) * 4 <= (int)CTL_ZERO_BYTES, "control words inside the per-call memset");
constexpr size_t WS_MOD = 1 * MiB;
constexpr size_t WS_TILE_E = WS_MOD + 256 * 1024;
constexpr size_t WS_PADSTART = WS_TILE_E + 16 * 1024;
constexpr size_t WS_ROWTOK = 2 * MiB;
constexpr size_t WS_EIDX = 4 * MiB;
constexpr size_t WS_GATE = 5 * MiB;
constexpr size_t WS_DEST = 6 * MiB;
constexpr size_t WS_WIN = 8 * MiB;
constexpr size_t WS_WLORA = WS_WIN + al((size_t)NP * D * 2);
constexpr size_t WS_WBRRW = WS_WLORA + al((size_t)NLORA * KLORA * 2);
constexpr size_t WS_WBRGLA = WS_WBRRW + al((size_t)D * RWW * 2);
constexpr size_t WS_WOUT = WS_WBRGLA + al((size_t)D * RWW * 2);
constexpr size_t WS_WROUTER = WS_WOUT + al((size_t)D * D * 2);
constexpr size_t WS_WGU = WS_WROUTER + al((size_t)NE * D * 2);
constexpr size_t WS_WD = WS_WGU + al((size_t)(NE + 1) * 512 * D * 2);
constexpr size_t WS_PERSIST_END = WS_WD + al((size_t)(NE + 1) * D * FF * 2);
constexpr size_t WS_REGB = WS_PERSIST_END;
constexpr size_t SZ512F = al((size_t)MR * RWW * 4), SZ256F = al((size_t)MR * 256 * 4), SZ512H = al((size_t)MR * RWW * 2);
constexpr size_t WS_A1 = WS_REGB;
constexpr size_t WS_A2 = WS_A1;
constexpr size_t WS_KSUM = WS_A2 + al((size_t)MR * KLORA * 2);
static_assert(WS_KSUM + SZ512H <= WS_A1 + al((size_t)MR * D * 2), "A2 + KSUM fit in the A1 slot");
constexpr size_t WS_P = WS_A1 + al((size_t)MR * D * 2);
constexpr size_t WS_RB = WS_P + al((size_t)MR * NP * 2);
constexpr size_t WS_VB = WS_RB + SZ512H, WS_KKB = WS_VB + SZ512H, WS_KMF = WS_KKB + SZ512H, WS_KMB = WS_KMF + SZ512H, WS_BVF = WS_KMB + SZ512H, WS_BVB = WS_BVF + SZ512H;
constexpr size_t WS_LWF = WS_BVB + SZ512H, WS_LWB = WS_LWF + SZ512F;
constexpr size_t SZ256H = al((size_t)MR * 256 * 2);
constexpr size_t WS_QGB = WS_LWB + SZ512F, WS_KGB = WS_QGB + SZ256H, WS_VGB = WS_KGB + SZ256H, WS_LAF = WS_VGB + SZ512H, WS_LAB = WS_LAF + SZ256F;
constexpr size_t WS_RWG = WS_LAB + SZ256F;
constexpr size_t WS_ORWF = WS_RWG + SZ512H, WS_ORWB = WS_ORWF + SZ512H, WS_OGLF = WS_ORWB + SZ512H, WS_OGLB = WS_OGLF + SZ512H;
constexpr int CH = 64, NCHUNK = (CTXL + SEQ) / CH, NU_RW = 64 * NCHUNK, NU_GL = 32 * NCHUNK;
constexpr size_t WS_RH = WS_OGLB + SZ512H;
constexpr size_t WS_YL = WS_RH + al((size_t)NU_RW * 4096 * 2);
constexpr size_t WS_HH = WS_YL + al((size_t)NU_RW * 4096 * 2);
constexpr size_t WS_INTRA = WS_HH + al((size_t)NU_RW * 4096 * 2);
constexpr size_t WS_KV = WS_INTRA + al((size_t)NU_GL * 8192 * 2);
constexpr size_t WS_DD = WS_KV + al((size_t)NU_GL * 8192 * 2);
constexpr size_t WS_END_MIX = WS_DD + al((size_t)NU_GL * 64 * 4);
constexpr size_t OUT_GT = 0, OUT_QE = (size_t)NU_RW * 4096 * 2;
static_assert(OUT_QE + (size_t)NU_GL * 4096 * 2 <= (size_t)NLAT * D * 4, "scan scratch fits in d_out");
constexpr size_t WS_YRW = WS_LWF, WS_YGLA = WS_LWB, WS_Z = WS_HH;
static_assert((size_t)NLAT * D * 2 <= (size_t)NU_RW * 4096 * 2, "Z fits in the HH slot");
constexpr size_t WS_X1 = WS_REGB;
constexpr size_t WS_A3 = WS_X1 + al((size_t)NLAT * D * 4);
constexpr size_t WS_LOGITS = WS_A3 + al((size_t)NLAT * D * 2);
constexpr size_t WS_ACT = WS_LOGITS + al((size_t)NLAT * NE * 4);
constexpr size_t WS_Y = WS_ACT + al((size_t)NROWS_E * FF * 2);
constexpr size_t WS_A3F = WS_Y + al((size_t)NROWS_E * D);
constexpr size_t WS_END_MOE = WS_A3F + al((size_t)NLAT * D);
constexpr size_t WS_END = WS_END_MIX > WS_END_MOE ? WS_END_MIX : WS_END_MOE;
static_assert(WS_END <= (size_t)2048 * MiB, "workspace map exceeds 2 GiB");

constexpr int RING_BYTES = 131072;
constexpr int IDX_BYTES = pg8::IDX_UNITS * 256 * 4;
constexpr int MISC_OFF = RING_BYTES + IDX_BYTES;
constexpr int LDS_BYTES = MISC_OFF + 256;
static_assert(pg8::IDX_OFF == RING_BYTES, "gather table sits right above the stage buffers");
constexpr int NWAVES = 8, NTHR = 512;

struct Args { const float* in[36]; float* out; unsigned char* ws; int ph_lo, ph_hi; };

struct Frame {
    LAS unsigned char* lds;
    int tid, lane, wave, G, gw, NGW;
    const float* const* in; float* out; unsigned char* ws; unsigned* ctl;
};

__device__ __forceinline__ float wave_sum(float v) {
#pragma unroll
    for (int o = 1; o < 64; o <<= 1) v += __shfl_xor(v, o);
    return v;
}
__device__ __forceinline__ unsigned f2bf(float f) { unsigned u = __builtin_bit_cast(unsigned, f); return (u + 0x7fffu + ((u >> 16) & 1u)) >> 16; }
typedef __bf16 bf16x2v __attribute__((ext_vector_type(2)));
__device__ __forceinline__ unsigned pk2(float lo, float hi) { const f32x2 v = {lo, hi}; return __builtin_bit_cast(unsigned, __builtin_convertvector(v, bf16x2v)); }
__device__ __forceinline__ float bflo(unsigned w) { return __builtin_bit_cast(float, w << 16); }
__device__ __forceinline__ float bfhi(unsigned w) { return __builtin_bit_cast(float, w & 0xffff0000u); }
__device__ __forceinline__ float sigmoidf_(float x) { return __builtin_amdgcn_rcpf(1.0f + __expf(-x)); }
__device__ __forceinline__ float siluf_(float x) { return x * __builtin_amdgcn_rcpf(1.0f + __expf(-x)); }
__device__ __forceinline__ float tanhf_(float x) { return 1.0f - 2.0f * __builtin_amdgcn_rcpf(1.0f + __expf(2.0f * x)); }
__device__ __forceinline__ float logsigmoidf_(float x) { return fminf(x, 0.f) - __logf(1.0f + __expf(-fabsf(x))); }

__device__ __forceinline__ void ln_stats(const f32x4 (&v)[4], float& mean, float& rstd) {
    float s = 0.f;
#pragma unroll
    for (int j = 0; j < 4; ++j) s += (v[j].x + v[j].y) + (v[j].z + v[j].w);
    mean = wave_sum(s) * (1.f / D); float s2 = 0.f;
#pragma unroll
    for (int j = 0; j < 4; ++j) { const f32x4 d = v[j] - mean; s2 += (d.x * d.x + d.y * d.y) + (d.z * d.z + d.w * d.w); }
    rstd = __builtin_amdgcn_rsqf(wave_sum(s2) * (1.f / D) + LN_EPS);
}

__device__ __forceinline__ unsigned pack_fp8x4(const f32x4 v) {
    int w = __builtin_amdgcn_cvt_pk_fp8_f32(__builtin_amdgcn_fmed3f(v[0], -448.f, 448.f), __builtin_amdgcn_fmed3f(v[1], -448.f, 448.f), 0, false);
    return (unsigned)__builtin_amdgcn_cvt_pk_fp8_f32(__builtin_amdgcn_fmed3f(v[2], -448.f, 448.f), __builtin_amdgcn_fmed3f(v[3], -448.f, 448.f), w, true); }
__device__ __forceinline__ void ld_row_bf16(const bf16* row, int lane, f32x4 (&v)[4]) {
    const v4u a = *(const v4u*)(row + 8 * lane), b = *(const v4u*)(row + 512 + 8 * lane);
    v[0] = (f32x4){bflo(a.x), bfhi(a.x), bflo(a.y), bfhi(a.y)}; v[1] = (f32x4){bflo(a.z), bfhi(a.z), bflo(a.w), bfhi(a.w)};
    v[2] = (f32x4){bflo(b.x), bfhi(b.x), bflo(b.y), bfhi(b.y)}; v[3] = (f32x4){bflo(b.z), bfhi(b.z), bflo(b.w), bfhi(b.w)};
}
__device__ __forceinline__ int rowcol(int lane, int j) { return 512 * (j >> 1) + 8 * lane + 4 * (j & 1); }
__device__ __forceinline__ void ph_x1pre_nomix(Frame& F) {
    const float* x = F.in[0];
    for (int m = F.gw; m < NLAT; m += F.NGW) {
        bf16* o = (bf16*)(F.ws + WS_X1) + (size_t)m * D;
#pragma unroll
        for (int h = 0; h < 2; ++h) { const float* xr = x + (size_t)m * D + 512 * h + 8 * F.lane; const f32x4 a = *(const f32x4*)xr * ALPHA, b = *(const f32x4*)(xr + 4) * ALPHA;
            v4u w; w.x = pk2(a.x, a.y); w.y = pk2(a.z, a.w); w.z = pk2(b.x, b.y); w.w = pk2(b.z, b.w); *(v4u*)(o + 512 * h + 8 * F.lane) = w; }
    }
}
__device__ __forceinline__ void ph_ln1(Frame& F) {
    const float* lw = F.in[26]; const float* lb = F.in[27]; const float* mod = (const float*)(F.ws + WS_MOD);
    bf16* A3 = (bf16*)(F.ws + WS_A3); const bf16* X1P = (const bf16*)(F.ws + WS_X1);
    constexpr int NR = 4;
    for (int m0 = F.gw; m0 < NLAT; m0 += NR * F.NGW) {
        v4u w[NR][2];
#pragma unroll
        for (int r = 0; r < NR; ++r) { const int mm = m0 + r * F.NGW; const bf16* row = X1P + (size_t)(mm < NLAT ? mm : m0) * D; w[r][0] = *(const v4u*)(row + 8 * F.lane); w[r][1] = *(const v4u*)(row + 512 + 8 * F.lane); }
        __builtin_amdgcn_sched_barrier(0);
#pragma unroll
        for (int r = 0; r < NR; ++r) { const int mm = m0 + r * F.NGW; const int m = mm < NLAT ? mm : m0; const int b = m / SEQ;
            f32x4 v[4];
            v[0] = (f32x4){bflo(w[r][0].x), bfhi(w[r][0].x), bflo(w[r][0].y), bfhi(w[r][0].y)}; v[1] = (f32x4){bflo(w[r][0].z), bfhi(w[r][0].z), bflo(w[r][0].w), bfhi(w[r][0].w)};
            v[2] = (f32x4){bflo(w[r][1].x), bfhi(w[r][1].x), bflo(w[r][1].y), bfhi(w[r][1].y)}; v[3] = (f32x4){bflo(w[r][1].z), bfhi(w[r][1].z), bflo(w[r][1].w), bfhi(w[r][1].w)};
            float mean, rstd; ln_stats(v, mean, rstd);
#if MS >= 2
            f32x4 h[4];
#pragma unroll
            for (int j = 0; j < 4; ++j) { const int c = rowcol(F.lane, j);
                const f32x4 x1 = (v[j] - mean) * rstd * *(const f32x4*)(lw + c) + *(const f32x4*)(lb + c);
                h[j] = x1 * (*(const f32x4*)(mod + b * 6144 + 4096 + c) + 1.0f) + *(const f32x4*)(mod + b * 6144 + 3072 + c); }
            bf16* ao = A3 + (size_t)m * D;
            { v4u o; o.x = pk2(h[0].x, h[0].y); o.y = pk2(h[0].z, h[0].w); o.z = pk2(h[1].x, h[1].y); o.w = pk2(h[1].z, h[1].w); *(v4u*)(ao + 8 * F.lane) = o;
              o.x = pk2(h[2].x, h[2].y); o.y = pk2(h[2].z, h[2].w); o.z = pk2(h[3].x, h[3].y); o.w = pk2(h[3].z, h[3].w); *(v4u*)(ao + 512 + 8 * F.lane) = o; }
            { unsigned char* af = F.ws + WS_A3F + (size_t)m * D; v2u o8;
              o8.x = pack_fp8x4(h[0]); o8.y = pack_fp8x4(h[1]); *(v2u*)(af + 8 * F.lane) = o8; o8.x = pack_fp8x4(h[2]); o8.y = pack_fp8x4(h[3]); *(v2u*)(af + 512 + 8 * F.lane) = o8; }
#endif
        }
    }
}
__device__ __forceinline__ f32x4 fp8x4(unsigned w) { const f32x2 lo = __builtin_amdgcn_cvt_pk_f32_fp8((int)w, false), hi = __builtin_amdgcn_cvt_pk_f32_fp8((int)w, true); return (f32x4){lo.x, lo.y, hi.x, hi.y}; }
__device__ __forceinline__ void ph_final(Frame& F) {
    const float* lw = F.in[34]; const float* lb = F.in[35]; const float* mod = (const float*)(F.ws + WS_MOD);
    const float* lw1 = F.in[26]; const float* lb1 = F.in[27]; const bf16* X1P = (const bf16*)(F.ws + WS_X1);
    const unsigned char* Y = F.ws + WS_Y; const int* DEST = (const int*)(F.ws + WS_DEST); const float* GATE = (const float*)(F.ws + WS_GATE);
    const int c0 = 16 * F.lane;
    for (int m0 = F.gw; m0 < NLAT; m0 += 2 * F.NGW) {
        int mm[2]; mm[0] = m0; mm[1] = (m0 + F.NGW < NLAT) ? m0 + F.NGW : m0;
        v4u xw[2][2];
#if MS >= 2
        v4u dw[2][2]; f32x4 gw[2][2];
#pragma unroll
        for (int r = 0; r < 2; ++r) { dw[r][0] = *(const v4u*)(DEST + mm[r] * 8); dw[r][1] = *(const v4u*)(DEST + mm[r] * 8 + 4); gw[r][0] = *(const f32x4*)(GATE + mm[r] * 8); gw[r][1] = *(const f32x4*)(GATE + mm[r] * 8 + 4); }
#endif
#pragma unroll
        for (int r = 0; r < 2; ++r) { const bf16* row = X1P + (size_t)mm[r] * D + c0; xw[r][0] = *(const v4u*)row; xw[r][1] = *(const v4u*)(row + 8); }
#if MS >= 2
        v4u yw[2][TOPK + 1];
#pragma unroll
        for (int r = 0; r < 2; ++r) {
            int dr[TOPK]; dr[0] = (int)dw[r][0].x; dr[1] = (int)dw[r][0].y; dr[2] = (int)dw[r][0].z; dr[3] = (int)dw[r][0].w; dr[4] = (int)dw[r][1].x; dr[5] = (int)dw[r][1].y; dr[6] = (int)dw[r][1].z; dr[7] = (int)dw[r][1].w;
#pragma unroll
            for (int k = 0; k <= TOPK; ++k) yw[r][k] = *(const v4u*)(Y + (size_t)(k < TOPK ? dr[k < TOPK ? k : 0] : SH_ROW0 + mm[r]) * D + c0); }
        __builtin_amdgcn_sched_barrier(0);
#endif
#pragma unroll
        for (int r = 0; r < 2; ++r) { const int m = mm[r]; const int b = m / SEQ;
            f32x4 v[4];
            v[0] = (f32x4){bflo(xw[r][0].x), bfhi(xw[r][0].x), bflo(xw[r][0].y), bfhi(xw[r][0].y)}; v[1] = (f32x4){bflo(xw[r][0].z), bfhi(xw[r][0].z), bflo(xw[r][0].w), bfhi(xw[r][0].w)};
            v[2] = (f32x4){bflo(xw[r][1].x), bfhi(xw[r][1].x), bflo(xw[r][1].y), bfhi(xw[r][1].y)}; v[3] = (f32x4){bflo(xw[r][1].z), bfhi(xw[r][1].z), bflo(xw[r][1].w), bfhi(xw[r][1].w)};
            { float mean1, rstd1; ln_stats(v, mean1, rstd1);
#pragma unroll
              for (int j = 0; j < 4; ++j) { const int c = c0 + 4 * j; v[j] = ((v[j] - mean1) * rstd1 * *(const f32x4*)(lw1 + c) + *(const f32x4*)(lb1 + c)) * ALPHA; } }
#if MS >= 2
            const float gt[TOPK] = {gw[r][0].x * 0.0625f, gw[r][0].y * 0.0625f, gw[r][0].z * 0.0625f, gw[r][0].w * 0.0625f, gw[r][1].x * 0.0625f, gw[r][1].y * 0.0625f, gw[r][1].z * 0.0625f, gw[r][1].w * 0.0625f};
#pragma unroll
            for (int j = 0; j < 4; ++j) { const unsigned ws8 = j == 0 ? yw[r][TOPK].x : (j == 1 ? yw[r][TOPK].y : (j == 2 ? yw[r][TOPK].z : yw[r][TOPK].w));
                f32x4 mo = fp8x4(ws8) * 0.0625f;
#pragma unroll
                for (int k = 0; k < TOPK; ++k) { const unsigned wk = j == 0 ? yw[r][k].x : (j == 1 ? yw[r][k].y : (j == 2 ? yw[r][k].z : yw[r][k].w)); mo += fp8x4(wk) * gt[k]; }
                v[j] += *(const f32x4*)(mod + b * 6144 + 5120 + c0 + 4 * j) * mo; }
#endif
            float mean, rstd; ln_stats(v, mean, rstd);
            float* o = F.out + (size_t)m * D + c0;
#pragma unroll
            for (int j = 0; j < 4; ++j) { const int c = c0 + 4 * j; *(f32x4*)(o + 4 * j) = (v[j] - mean) * rstd * *(const f32x4*)(lw + c) + *(const f32x4*)(lb + c); }
        }
    }
}


#if MS >= 2
template <int MODE, bool FP8 = false>
__device__ __forceinline__ void cvt_item(const float* W, int Nsrc, int nblk, bf16* WT, int row_off, int dpitch, LAS float* scr, int item, int lane) {
    const int kb = item / nblk, nb = item - kb * nblk, k0 = 64 * kb, n0 = 32 * nb;
    const int nn = n0 + (lane & 31);
#pragma unroll 8
    for (int i = 0; i < 32; ++i) { const int kk = 2 * i + (lane >> 5); scr[kk * 33 + (lane & 31)] = (nn < Nsrc) ? W[(size_t)(k0 + kk) * Nsrc + nn] : 0.f; }
    LDS_WAIT(); asm volatile("" ::: "memory");
    const int c = lane & 7;
#pragma unroll
    for (int j = 0; j < 4; ++j) { const int n = (lane >> 3) + 8 * j; const LAS float* s = scr + (8 * c) * 33 + n;
        v4u o; o.x = pk2(s[0 * 33], s[1 * 33]); o.y = pk2(s[2 * 33], s[3 * 33]); o.z = pk2(s[4 * 33], s[5 * 33]); o.w = pk2(s[6 * 33], s[7 * 33]);
        const int ng = n0 + n; int dr = ng;
        if (MODE == 1) { const int i2 = ng & 255; dr = 8 * (i2 >> 2) + (i2 & 3) + ((ng >= 256) ? 4 : 0); }
        if constexpr (FP8) { v2u o8; o8.x = pack_fp8x4((f32x4){s[0 * 33], s[1 * 33], s[2 * 33], s[3 * 33]} * W8S); o8.y = pack_fp8x4((f32x4){s[4 * 33], s[5 * 33], s[6 * 33], s[7 * 33]} * W8S);
            *(v2u*)((unsigned char*)WT + (size_t)(row_off + dr) * dpitch + k0 + 8 * c) = o8; }
        else *(v4u*)(WT + (size_t)(row_off + dr) * dpitch + k0 + 8 * c) = o; }
    LDS_WAIT(); asm volatile("" ::: "memory");
}

template <int MODE>
__device__ __forceinline__ void cvt_item_reg(const float* W, int Nsrc, bf16* WT, int row_off, int dpitch, int k0, int n0, int lane) {
    const float* src = W + (size_t)k0 * Nsrc + n0 + 4 * lane;
    f32x4 v[32];
#pragma unroll
    for (int i = 0; i < 32; ++i) v[i] = __builtin_nontemporal_load((const f32x4*)(src + (size_t)i * Nsrc));
#pragma unroll
    for (int j = 0; j < 4; ++j) {
        const int ng = n0 + 4 * lane + j; int dr = ng;
        if (MODE == 1) { const int i2 = ng & 255; dr = 8 * (i2 >> 2) + (i2 & 3) + ((ng >= 256) ? 4 : 0); }
        v4u* dst = (v4u*)(WT + (size_t)(row_off + dr) * dpitch + k0);
#pragma unroll
        for (int q = 0; q < 4; ++q) { v4u o; o.x = pk2(v[8 * q][j], v[8 * q + 1][j]); o.y = pk2(v[8 * q + 2][j], v[8 * q + 3][j]); o.z = pk2(v[8 * q + 4][j], v[8 * q + 5][j]); o.w = pk2(v[8 * q + 6][j], v[8 * q + 7][j]); dst[q] = o; }
    }
}

constexpr int CVK = 32;
__device__ __forceinline__ void cvt_reg_load(const float* W, int Nsrc, int k0, int n0, int lane, f32x4 (&v)[CVK]) {
    const float* src = W + (size_t)k0 * Nsrc + n0 + 4 * lane;
#pragma unroll
    for (int i = 0; i < CVK; ++i) v[i] = __builtin_nontemporal_load((const f32x4*)(src + (size_t)i * Nsrc));
}
template <int MODE, bool FP8 = false>
__device__ __forceinline__ void cvt_reg_store(bf16* WT, int row_off, int dpitch, int k0, int n0, int lane, const f32x4 (&v)[CVK]) {
#pragma unroll
    for (int j = 0; j < 4; ++j) {
        const int ng = n0 + 4 * lane + j; int dr = ng;
        if (MODE == 1) { const int i2 = ng & 255; dr = 8 * (i2 >> 2) + (i2 & 3) + ((ng >= 256) ? 4 : 0); }
        if constexpr (FP8) { v4u* dst8 = (v4u*)((unsigned char*)WT + (size_t)(row_off + dr) * dpitch + k0);
#pragma unroll
            for (int q = 0; q < CVK / 16; ++q) { v4u o;
                o.x = pack_fp8x4((f32x4){v[16 * q][j], v[16 * q + 1][j], v[16 * q + 2][j], v[16 * q + 3][j]} * W8S); o.y = pack_fp8x4((f32x4){v[16 * q + 4][j], v[16 * q + 5][j], v[16 * q + 6][j], v[16 * q + 7][j]} * W8S);
                o.z = pack_fp8x4((f32x4){v[16 * q + 8][j], v[16 * q + 9][j], v[16 * q + 10][j], v[16 * q + 11][j]} * W8S); o.w = pack_fp8x4((f32x4){v[16 * q + 12][j], v[16 * q + 13][j], v[16 * q + 14][j], v[16 * q + 15][j]} * W8S); dst8[q] = o; }
            continue; }
        v4u* dst = (v4u*)(WT + (size_t)(row_off + dr) * dpitch + k0);
#pragma unroll
        for (int q = 0; q < CVK / 8; ++q) { v4u o; o.x = pg8::cvt_pk_bf16(v[8 * q][j], v[8 * q + 1][j]); o.y = pg8::cvt_pk_bf16(v[8 * q + 2][j], v[8 * q + 3][j]); o.z = pg8::cvt_pk_bf16(v[8 * q + 4][j], v[8 * q + 5][j]); o.w = pg8::cvt_pk_bf16(v[8 * q + 6][j], v[8 * q + 7][j]); dst[q] = o; }
    }
}
constexpr int CV_GU = (D / CVK) * 2, CV_DN = (FF / CVK) * 4, CV_NGU = (NE + 1) * CV_GU, CV_NITEM = CV_NGU + (NE + 1) * CV_DN;
__device__ __forceinline__ void cvx_load(const float* const* in, int it, int lane, f32x4 (&v)[CVK]) {
    if (it < CV_NGU) { const int e = it / CV_GU, ii = it - e * CV_GU; const float* src = (e < NE) ? in[30] + (size_t)e * D * 512 : in[32];
        cvt_reg_load(src, 512, CVK * (ii >> 1), 256 * (ii & 1), lane, v); }
    else { const int r = it - CV_NGU, e = r / CV_DN, ii = r - e * CV_DN; const float* src = (e < NE) ? in[31] + (size_t)e * FF * D : in[33];
        cvt_reg_load(src, D, CVK * (ii >> 2), 256 * (ii & 3), lane, v); }
}
__device__ __forceinline__ void cvx_store(unsigned char* ws, int it, int lane, const f32x4 (&v)[CVK]) {
    if (it < CV_NGU) { const int e = it / CV_GU, ii = it - e * CV_GU; cvt_reg_store<1, true>((bf16*)(ws + WS_WGU), e * 512, D, CVK * (ii >> 1), 256 * (ii & 1), lane, v); }
    else { const int r = it - CV_NGU, e = r / CV_DN, ii = r - e * CV_DN; cvt_reg_store<0, true>((bf16*)(ws + WS_WD), e * D, FF, CVK * (ii >> 2), 256 * (ii & 3), lane, v); }
}

#if MS >= 3
__device__ __forceinline__ float lora_val(const float* const* in, int n, int k) {
    if (n < 1024) { const int q = n >> 3, e8 = n & 7, dir = e8 >> 2, ch = q * 4 + (e8 & 3); return (k < 32) ? in[9][(size_t)(dir * 32 + k) * 512 + ch] : 0.f; }
    if (n < 2048) { const int m = n - 1024, q = m >> 3, e8 = m & 7, dir = e8 >> 2, ch = q * 4 + (e8 & 3); return (k >= 32 && k < 64) ? in[11][(size_t)(dir * 32 + (k - 32)) * 512 + ch] : 0.f; }
    if (n < 2560) { const int ch = n - 2048; return (k >= 64 && k < 160) ? in[12][(size_t)(k - 64) * 512 + ch] : 0.f; }
    { const int m = n - 2560, q = m >> 3, e8 = m & 7, dir = e8 >> 2, ch = q * 4 + (e8 & 3); return (k >= 160 && k < 176) ? in[19][(size_t)(dir * 16 + (k - 160)) * 256 + ch] : 0.f; }
}
#endif

__device__ __forceinline__ void ph_prologue(Frame& F) {
    {
        const float* c = F.in[1]; const float* cc = F.in[3]; const float* wa = F.in[4]; const float* ba = F.in[5];
        float* MOD = (float*)(F.ws + WS_MOD);
        LAS float* S = (LAS float*)F.lds; LAS float* red = (LAS float*)(F.lds + 32768);
        for (int it = blockIdx.x; it < 96; it += F.G) {
            for (int i = F.tid; i < 5120; i += NTHR) { const int r = i >> 10, k = i & 1023; const float cv = r < 4 ? c[r * 1024 + k] : cc[k]; S[i] = siluf_(cv); }
            __syncthreads();
            const int n = it * 64 + F.lane; float acc[5] = {0.f, 0.f, 0.f, 0.f, 0.f};
            for (int kk = 0; kk < 128; ++kk) { const int k = F.wave * 128 + kk; const float wv = wa[(size_t)k * 6144 + n];
#pragma unroll
                for (int r = 0; r < 5; ++r) acc[r] += S[r * 1024 + k] * wv; }
#pragma unroll
            for (int r = 0; r < 5; ++r) red[(F.wave * 5 + r) * 64 + F.lane] = acc[r];
            __syncthreads();
            if (F.wave == 0) {
#pragma unroll
                for (int r = 0; r < 5; ++r) { float s = 0.f;
#pragma unroll
                    for (int w = 0; w < 8; ++w) s += red[(w * 5 + r) * 64 + F.lane];
                    MOD[r * 6144 + n] = s + ba[n]; }
            }
            __syncthreads();
        }
    }
    {
        LAS float* scr = (LAS float*)(F.lds + F.wave * 16384);
        constexpr int I_IN = 16 * 168, I_BR = 8 * 32, I_OUT = 16 * 32, I_RT = 16 * 8, I_GU = 32 * 2, I_DN = 8 * 4;
        constexpr int T0 = I_IN, T1 = T0 + I_BR, T2 = T1 + I_BR, T3 = T2 + I_OUT, T4 = T3 + I_RT, T5 = T4 + (NE + 1) * I_GU, T6 = T5 + (NE + 1) * I_DN;
        unsigned char* ws = F.ws;
        for (int it = F.gw; it < T6; it += F.NGW) {
#if MS >= 3
            if (it < T0) { cvt_item<0, true>(F.in[6], IN_COLS, 168, (bf16*)(ws + WS_WIN), 0, D, scr, it, F.lane); continue; }
            if (it < T1) { cvt_item<0>(F.in[23], D, 32, (bf16*)(ws + WS_WBRRW), 0, RWW, scr, it - T0, F.lane); continue; }
            if (it < T2) { cvt_item<0>(F.in[24], D, 32, (bf16*)(ws + WS_WBRGLA), 0, RWW, scr, it - T1, F.lane); continue; }
            if (it < T3) { cvt_item<0>(F.in[25], D, 32, (bf16*)(ws + WS_WOUT), 0, D, scr, it - T2, F.lane); continue; }
#else
            if (it < T3) continue;
#endif
            if (it < T4) { cvt_item<0>(F.in[28], NE, 8, (bf16*)(ws + WS_WROUTER), 0, D, scr, it - T3, F.lane); continue; }
#if MS >= 3
            break;
#endif
            if (it < T5) { const int r = it - T4, e = r / I_GU, ii = r - e * I_GU;
                const float* src = (e < NE) ? F.in[30] + (size_t)e * D * 512 : F.in[32];
                cvt_item_reg<1>(src, 512, (bf16*)(ws + WS_WGU), e * 512, D, 32 * (ii >> 1), 256 * (ii & 1), F.lane); continue; }
            { const int r = it - T5, e = r / I_DN, ii = r - e * I_DN;
                const float* src = (e < NE) ? F.in[31] + (size_t)e * FF * D : F.in[33];
                cvt_item_reg<0>(src, D, (bf16*)(ws + WS_WD), e * D, FF, 32 * (ii >> 2), 256 * (ii & 3), F.lane); }
        }
    }
#if MS >= 3
    {
        bf16* WL = (bf16*)(F.ws + WS_WLORA);
        for (int idx = blockIdx.x * NTHR + F.tid; idx < NLORA * (KLORA / 8); idx += F.G * NTHR) {
            const int n = idx >> 5, k0 = (idx & 31) * 8; float v[8];
#pragma unroll
            for (int e = 0; e < 8; ++e) v[e] = lora_val(F.in, n, k0 + e);
            v4u o; o.x = pk2(v[0], v[1]); o.y = pk2(v[2], v[3]); o.z = pk2(v[4], v[5]); o.w = pk2(v[6], v[7]);
            *(v4u*)(WL + (size_t)n * KLORA + k0) = o;
        }
    }
#endif
}

struct EpiF32 {
    static constexpr bool PERM = false;
    float* C; int ldc;
    __device__ __forceinline__ void operator()(const f32x4 (&acc)[2][2][4][2], const pg8::Unit& u, int wr, int wc, int fr, int fq) const {
        const int row0 = u.pm * 256 + wr * 64 + fr, col0 = u.pn * 256 + wc * 32 + 4 * fq;
#pragma unroll
        for (int ai = 0; ai < 2; ++ai)
#pragma unroll
            for (int m = 0; m < 4; ++m) { float* rowp = C + (size_t)(row0 + ai * 128 + m * 16) * ldc + col0;
#pragma unroll
                for (int bj = 0; bj < 2; ++bj)
#pragma unroll
                    for (int n = 0; n < 2; ++n) *(f32x4*)(rowp + bj * 128 + n * 16) = acc[ai][bj][m][n]; }
    }
};
struct EpiSwiglu {
    static constexpr bool PERM = true;
    unsigned char* ACT;
    __device__ __forceinline__ void operator()(const f32x4 (&acc)[2][2][4][2], const pg8::Unit& u, int wr, int wc, int fr, int fq) const {
        const int row0 = u.pm * 256 + wr * 64 + fr, h0 = u.j * 128 + wc * 16 + 4 * fq;
#pragma unroll
        for (int ai = 0; ai < 2; ++ai)
#pragma unroll
            for (int m = 0; m < 4; ++m) { unsigned char* rowp = ACT + (size_t)(row0 + ai * 128 + m * 16) * FF + h0;
#pragma unroll
                for (int bj = 0; bj < 2; ++bj) { const f32x4 a = acc[ai][bj][m][0] * W8I, b = acc[ai][bj][m][1] * W8I;
                    *(unsigned*)(rowp + bj * 64) = pack_fp8x4((f32x4){siluf_(a[0]) * b[0], siluf_(a[1]) * b[1], siluf_(a[2]) * b[2], siluf_(a[3]) * b[3]}); } }
    }
};
struct EpiRowsBf16 {
    static constexpr bool PERM = true;
    bf16* O; int ldc; float sc;
    __device__ __forceinline__ void operator()(const f32x4 (&acc)[2][2][4][2], const pg8::Unit& u, int wr, int wc, int fr, int fq) const {
        const int row0 = u.pm * 256 + wr * 64 + fr, col0 = u.j * 256 + wc * 32 + 8 * fq;
#pragma unroll
        for (int ai = 0; ai < 2; ++ai)
#pragma unroll
            for (int m = 0; m < 4; ++m) { bf16* rowp = O + (size_t)(row0 + ai * 128 + m * 16) * ldc + col0;
#pragma unroll
                for (int bj = 0; bj < 2; ++bj) { const f32x4 v0 = acc[ai][bj][m][0] * sc, v1 = acc[ai][bj][m][1] * sc;
                    v4u w; w.x = pg8::cvt_pk_bf16(v0[0], v0[1]); w.y = pg8::cvt_pk_bf16(v0[2], v0[3]); w.z = pg8::cvt_pk_bf16(v1[0], v1[1]); w.w = pg8::cvt_pk_bf16(v1[2], v1[3]);
                    *(v4u*)(rowp + bj * 128) = w;
#ifdef PROBE_ST2
                    asm volatile("" ::: "memory"); *(volatile v4u*)(rowp + bj * 128) = w;
#endif
                    } }
    }
};

struct EpiRowsFp8 {
    static constexpr bool PERM = true;
    unsigned char* O;
    __device__ __forceinline__ void operator()(const f32x4 (&acc)[2][2][4][2], const pg8::Unit& u, int wr, int wc, int fr, int fq) const {
        const int row0 = u.pm * 256 + wr * 64 + fr, col0 = u.j * 256 + wc * 32 + 8 * fq;
#pragma unroll
        for (int ai = 0; ai < 2; ++ai)
#pragma unroll
            for (int m = 0; m < 4; ++m) { unsigned char* rowp = O + (size_t)(row0 + ai * 128 + m * 16) * D + col0;
#pragma unroll
                for (int bj = 0; bj < 2; ++bj) { f32x4 v0 = acc[ai][bj][m][0] * (16.0f * W8I), v1 = acc[ai][bj][m][1] * (16.0f * W8I);
#pragma unroll
                    for (int e = 0; e < 4; ++e) { v0[e] = __builtin_amdgcn_fmed3f(v0[e], -448.0f, 448.0f); v1[e] = __builtin_amdgcn_fmed3f(v1[e], -448.0f, 448.0f); }
                    int w0 = __builtin_amdgcn_cvt_pk_fp8_f32(v0[0], v0[1], 0, false); w0 = __builtin_amdgcn_cvt_pk_fp8_f32(v0[2], v0[3], w0, true);
                    int w1 = __builtin_amdgcn_cvt_pk_fp8_f32(v1[0], v1[1], 0, false); w1 = __builtin_amdgcn_cvt_pk_fp8_f32(v1[2], v1[3], w1, true);
                    v2u w; w.x = (unsigned)w0; w.y = (unsigned)w1; *(v2u*)(rowp + bj * 128) = w; } }
    }
};

__device__ __forceinline__ void ph_router(Frame& F) {
    pg8::Gemm g{(const bf16*)(F.ws + WS_A3), (const bf16*)(F.ws + WS_WROUTER), NLAT, NE, D, nullptr};
    pg8::StaticOrder S; S.init(NLAT, NE, F.G, (int)blockIdx.x);
    EpiF32 E{(float*)(F.ws + WS_LOGITS), NE};
    pg8::gemm_phase<EpiF32, pg8::StaticOrder, true, true, false>(F.lds, g, S, E);
}

__device__ __forceinline__ void ph_route(Frame& F) {
    const float* LOG = (const float*)(F.ws + WS_LOGITS); const float* rb = F.in[29];
    int* EIDX = (int*)(F.ws + WS_EIDX); float* GATE = (float*)(F.ws + WS_GATE); int* DEST = (int*)(F.ws + WS_DEST);
    unsigned* CNT = F.ctl + CW_CNT;
    const f32x4 bias = *(const f32x4*)(rb + 4 * F.lane);
    const float NEG = -3.0e38f;
    f32x4 lgn = *(const f32x4*)(LOG + (size_t)(F.gw < NLAT ? F.gw : 0) * NE + 4 * F.lane);
    for (int m = F.gw; m < NLAT; m += F.NGW) {
        const f32x4 lg = lgn;
        { const int mn = (m + F.NGW < NLAT) ? m + F.NGW : m; lgn = *(const f32x4*)(LOG + (size_t)mn * NE + 4 * F.lane); }
        float sc[4], sel[4];
#pragma unroll
        for (int i = 0; i < 4; ++i) { sc[i] = sigmoidf_(lg[i]); sel[i] = sc[i] + bias[i]; }
        float m1 = fmaxf(sel[0], sel[1]), m2 = fminf(sel[0], sel[1]);
        { const float a = sel[2]; const float n1 = fmaxf(m1, a); m2 = fmaxf(m2, fminf(m1, a)); m1 = n1; }
        { const float a = sel[3]; const float n1 = fmaxf(m1, a); m2 = fmaxf(m2, fminf(m1, a)); m1 = n1; }
#pragma unroll
        for (int o = 1; o < 8; o <<= 1) { const float b1 = __shfl_xor(m1, o), b2 = __shfl_xor(m2, o); const float n1 = fmaxf(m1, b1); m2 = fmaxf(fminf(m1, b1), fmaxf(m2, b2)); m1 = n1; }
        const float gs = m1 + m2; const int g = F.lane >> 3;
        int rank = 0;
#pragma unroll
        for (int gg = 0; gg < 8; ++gg) { const float og = __shfl(gs, gg * 8); rank += (og > gs || (og == gs && gg < g)) ? 1 : 0; }
        const bool keep = rank < 4;
#pragma unroll
        for (int i = 0; i < 4; ++i) sel[i] = keep ? sel[i] : NEG;
        int my_e = 0; float my_s = 0.f; float ssum = 0.f;
        for (int k = 0; k < TOPK; ++k) {
            float bv = sel[0]; int bi = 0;
#pragma unroll
            for (int i = 1; i < 4; ++i) if (sel[i] > bv) { bv = sel[i]; bi = i; }
            int be = 4 * F.lane + bi; float v = bv; int e = be;
#pragma unroll
            for (int o = 1; o < 64; o <<= 1) { const float ov = __shfl_xor(v, o); const int oe = __shfl_xor(e, o); if (ov > v || (ov == v && oe < e)) { v = ov; e = oe; } }
            const int owner = e >> 2, oi = e & 3;
            float s_own = 0.f;
            if (F.lane == owner) {
#pragma unroll
                for (int i = 0; i < 4; ++i) if (i == oi) { s_own = sc[i]; sel[i] = NEG; }
            }
            const float s = __shfl(s_own, owner);
            ssum += s;
            if (F.lane == k) { my_e = e; my_s = s; }
        }
        if (F.lane < TOPK) {
            const unsigned pos = __hip_atomic_fetch_add(CNT + my_e * CNT_STRIDE, 1u, __ATOMIC_RELAXED, __HIP_MEMORY_SCOPE_AGENT);
            EIDX[m * 8 + F.lane] = my_e; GATE[m * 8 + F.lane] = my_s / ssum * 2.5f; DEST[m * 8 + F.lane] = (int)pos;
        }
    }
}

__device__ __forceinline__ void ph_scatter(Frame& F) {
    LAS int* tstart = (LAS int*)F.lds;
    LAS int* scan = (LAS int*)(F.lds + 2048);
    LAS int* cnts = (LAS int*)(F.lds + 4096);
    int* EIDX = (int*)(F.ws + WS_EIDX); int* DEST = (int*)(F.ws + WS_DEST); int* ROWTOK = (int*)(F.ws + WS_ROWTOK); int* TILE_E = (int*)(F.ws + WS_TILE_E);
    unsigned* CNT = F.ctl + CW_CNT;
    int tiles = 0, cnt = 0;
    if (F.tid < NE) { cnt = (int)__hip_atomic_load(CNT + F.tid * CNT_STRIDE, __ATOMIC_RELAXED, __HIP_MEMORY_SCOPE_AGENT); tiles = (cnt + 255) >> 8; scan[F.tid] = tiles; cnts[F.tid] = cnt; }
    __syncthreads();
    for (int o = 1; o < NE; o <<= 1) { int v = 0; if (F.tid < NE && F.tid >= o) v = scan[F.tid - o]; __syncthreads(); if (F.tid < NE) scan[F.tid] += v; __syncthreads(); }
    if (F.tid < NE) { tstart[F.tid + 1] = scan[F.tid]; if (F.tid == 0) tstart[0] = 0; }
    __syncthreads();
    const int NT = tstart[NE];
    if (blockIdx.x == 0) {
        if (F.tid == 0) F.ctl[CW_NT] = (unsigned)NT;
        if (F.tid < NE) for (int t = tstart[F.tid]; t < tstart[F.tid + 1]; ++t) TILE_E[t] = F.tid;
    }
    for (int e = blockIdx.x; e < NE; e += F.G) { const int c0 = cnts[e], c1 = (tstart[e + 1] - tstart[e]) * 256, base = tstart[e] * 256;
        for (int p = c0 + F.tid; p < c1; p += NTHR) ROWTOK[base + p] = 0; }
    for (int i = blockIdx.x * NTHR + F.tid; i < NLAT; i += F.G * NTHR) ROWTOK[SH_ROW0 + i] = i;
    for (int i = blockIdx.x * NTHR + F.tid; i < NLAT * TOPK; i += F.G * NTHR) {
        const int e = EIDX[i], pos = DEST[i]; const int dr = tstart[e] * 256 + pos;
        DEST[i] = dr; ROWTOK[dr] = i >> 3;
    }
}

__device__ __forceinline__ void ph_exp1(Frame& F) {
    const int NT = (int)__hip_atomic_load(F.ctl + CW_NT, __ATOMIC_RELAXED, __HIP_MEMORY_SCOPE_AGENT);
    pg8::Gemm g{(const bf16*)(F.ws + WS_A3F), (const bf16*)(F.ws + WS_WGU), 0, 0, D / 2, (const int*)(F.ws + WS_ROWTOK)};
    pg8::MoeOrder S{2, F.G, (int)blockIdx.x, NT, (const int*)(F.ws + WS_TILE_E)};
    EpiSwiglu E{F.ws + WS_ACT};
    pg8::gemm_phase<EpiSwiglu, pg8::MoeOrder, true, true, true, true>(F.lds, g, S, E);
}
__device__ __forceinline__ void ph_exp2(Frame& F) {
    const int NT = (int)__hip_atomic_load(F.ctl + CW_NT, __ATOMIC_RELAXED, __HIP_MEMORY_SCOPE_AGENT);
    pg8::Gemm g{(const bf16*)(F.ws + WS_ACT), (const bf16*)(F.ws + WS_WD), 0, 0, FF / 2, nullptr};
    pg8::MoeOrder S{4, F.G, (int)blockIdx.x, NT, (const int*)(F.ws + WS_TILE_E)};
    EpiRowsFp8 E{F.ws + WS_Y};
    pg8::gemm_phase<EpiRowsFp8, pg8::MoeOrder, true, true, false, true>(F.lds, g, S, E);
}
#endif

#if MS >= 3
__device__ __forceinline__ void unp8(const v4u w, float (&f)[8]) { f[0] = bflo(w.x); f[1] = bfhi(w.x); f[2] = bflo(w.y); f[3] = bfhi(w.y); f[4] = bflo(w.z); f[5] = bfhi(w.z); f[6] = bflo(w.w); f[7] = bfhi(w.w); }
__device__ __forceinline__ void unp8f8(const v2u w, float (&f)[8]) { const f32x2 a = __builtin_amdgcn_cvt_pk_f32_fp8((int)w.x, false), b = __builtin_amdgcn_cvt_pk_f32_fp8((int)w.x, true), c = __builtin_amdgcn_cvt_pk_f32_fp8((int)w.y, false), d = __builtin_amdgcn_cvt_pk_f32_fp8((int)w.y, true);
    f[0] = a.x; f[1] = a.y; f[2] = b.x; f[3] = b.y; f[4] = c.x; f[5] = c.y; f[6] = d.x; f[7] = d.y; }
__device__ __forceinline__ v4u pk8(const float (&f)[8]) { v4u o; o.x = pk2(f[0], f[1]); o.y = pk2(f[2], f[3]); o.z = pk2(f[4], f[5]); o.w = pk2(f[6], f[7]); return o; }
__device__ __forceinline__ void st8(float* p, const float (&f)[8]) { *(f32x4*)p = (f32x4){f[0], f[1], f[2], f[3]}; *(f32x4*)(p + 4) = (f32x4){f[4], f[5], f[6], f[7]}; }
__device__ __forceinline__ void ld8(const float* p, float (&f)[8]) { const f32x4 a = *(const f32x4*)p, b = *(const f32x4*)(p + 4); f[0] = a.x; f[1] = a.y; f[2] = a.z; f[3] = a.w; f[4] = b.x; f[5] = b.y; f[6] = b.z; f[7] = b.w; }

__device__ __forceinline__ void ph_a1(Frame& F) {
    const float* mod = (const float*)(F.ws + WS_MOD); unsigned char* A1 = F.ws + WS_A1;
    constexpr int NR = 4;
    for (int m0 = F.gw; m0 < MR; m0 += NR * F.NGW) {
        f32x4 xv[NR][4];
#pragma unroll
        for (int r = 0; r < NR; ++r) { const int mm = m0 + r * F.NGW; const int m = mm < MR ? mm : m0;
            const float* src = (m < NLAT) ? F.in[0] + (size_t)m * D : F.in[2] + (size_t)(m - NLAT) * D;
            const f32x4* xr = (const f32x4*)src + F.lane;
#pragma unroll
            for (int j = 0; j < 4; ++j) xv[r][j] = __builtin_nontemporal_load(xr + 64 * j); }
        __builtin_amdgcn_sched_barrier(0);
#pragma unroll
        for (int r = 0; r < NR; ++r) { const int mm = m0 + r * F.NGW; const int m = mm < MR ? mm : m0; const int mr = (m < NLAT) ? (m / SEQ) : 4;
            unsigned* ao = (unsigned*)(A1 + (size_t)m * D) + F.lane;
#pragma unroll
            for (int j = 0; j < 4; ++j) { const int c = 4 * F.lane + 256 * j;
                const f32x4 sh = *(const f32x4*)(mod + mr * 6144 + c), sc = *(const f32x4*)(mod + mr * 6144 + 1024 + c);
                const f32x4 h = xv[r][j] * (sc + 1.0f) + sh; ao[64 * j] = pack_fp8x4(h); } }
    }
}

__device__ __forceinline__ void ph_inproj(Frame& F) {
    pg8::Gemm g{(const bf16*)(F.ws + WS_A1), (const bf16*)(F.ws + WS_WIN), MR, NP, D / 2, nullptr};
    pg8::StaticOrder S; S.init(MR, NP, F.G, (int)blockIdx.x);
    EpiRowsBf16 E{(bf16*)(F.ws + WS_P), NP, W8I};
    pg8::gemm_phase<EpiRowsBf16, pg8::StaticOrder, true, true, false, true>(F.lds, g, S, E);
}

struct FeatOut { bf16 *R, *V, *KK, *KP, *QG, *KGB, *VGB, *A2; const float *mu, *kkw, *cw; };
__device__ __forceinline__ void feat_rw(const FeatOut& O, int p, size_t m, int lane, const v4u own_w, const v4u (&nbw)[4], const float (&muv)[8]) {
    float own[8], sh[4][8], val[8];
    unp8(own_w, own);
#pragma unroll
    for (int q = 0; q < 4; ++q) unp8(nbw[q], sh[q]);
#pragma unroll
    for (int e = 0; e < 8; ++e) val[e] = own[e] + muv[e] * (sh[e & 3][e] - own[e]);
    if (p == 0) *(v4u*)(O.R + m * RWW + 8 * lane) = pk8(val);
    else if (p == 2) *(v4u*)(O.V + m * RWW + 8 * lane) = pk8(val);
    else if (p == 1) {
        *(v4u*)(O.KP + m * RWW + 8 * lane) = pk8(val);
        float kw[8]; ld8(O.kkw + 8 * lane, kw); float kkv[8]; float ss = 0.f;
#pragma unroll
        for (int e = 0; e < 8; ++e) { kkv[e] = val[e] * kw[e]; ss += kkv[e] * kkv[e]; }
        ss += __shfl_xor(ss, 1); ss += __shfl_xor(ss, 2); ss += __shfl_xor(ss, 4);
        const float inv = 1.0f / fmaxf(sqrtf(ss), 1e-12f);
#pragma unroll
        for (int e = 0; e < 8; ++e) kkv[e] *= inv;
        *(v4u*)(O.KK + m * RWW + 8 * lane) = pk8(kkv);
    } else {
        float o[8];
#pragma unroll
        for (int e = 0; e < 8; ++e) o[e] = (lane < 4) ? tanhf_(val[e]) : ((lane < 8) ? val[e] : sigmoidf_(val[e]));
        *(v4u*)(O.A2 + m * KLORA + 8 * lane) = pk8(o);
    }
}
__device__ __forceinline__ void feat_gla_store(const FeatOut& O, int p, size_t m, int lane, const float (&acc)[8]) {
    const int cq = p * 512 + 8 * lane; float o[8];
#pragma unroll
    for (int e = 0; e < 8; ++e) o[e] = siluf_(acc[e]);
    if (p == 0) {
        if (lane < 32) {
#pragma unroll
            for (int e = 0; e < 8; ++e) o[e] *= 0.125f;
            *(v4u*)(O.QG + m * 256 + cq) = pk8(o);
        } else *(v4u*)(O.KGB + m * 256 + (cq - 256)) = pk8(o);
    } else *(v4u*)(O.VGB + m * RWW + (cq - 512)) = pk8(o);
}
__device__ __forceinline__ void ph_feat(Frame& F) {
    const bf16* P = (const bf16*)(F.ws + WS_P);
    FeatOut O{(bf16*)(F.ws + WS_RB), (bf16*)(F.ws + WS_VB), (bf16*)(F.ws + WS_KKB), (bf16*)(F.ws + WS_KMF), (bf16*)(F.ws + WS_QGB), (bf16*)(F.ws + WS_KGB), (bf16*)(F.ws + WS_VGB), (bf16*)(F.ws + WS_A2), F.in[7], F.in[13], F.in[18]};
    const v4u Z4 = (v4u){0u, 0u, 0u, 0u};
    for (int blk = F.gw; blk < NB * (GRIDH / 2) * (GRIDW / 2); blk += F.NGW) {
        int lane = F.lane; asm volatile("" : "+v"(lane));
        const int b = blk >> 11, r0 = 2 * ((blk >> 5) & 63), c0 = 2 * (blk & 31); const int mb = b * SEQ + r0 * GRIDW + c0;
        const bool vu = r0 > 0, vd = r0 + 2 < GRIDH, vl = c0 > 0, vr = c0 + 2 < GRIDW;
#pragma unroll
        for (int p = 0; p < 4; ++p) {
            const int cb = p * 512 + 8 * lane; const bool act = (p < 3) || lane < 20;
            v4u own[2][2], up[2], dn[2], lf[2], rt[2];
#pragma unroll
            for (int i = 0; i < 2; ++i) { up[i] = Z4; dn[i] = Z4; lf[i] = Z4; rt[i] = Z4; own[i][0] = Z4; own[i][1] = Z4; }
            if (act) {
#pragma unroll
                for (int i = 0; i < 2; ++i) {
#pragma unroll
                    for (int j = 0; j < 2; ++j) own[i][j] = *(const v4u*)(P + (size_t)(mb + 64 * i + j) * NP + cb);
                    if (vu) up[i] = *(const v4u*)(P + (size_t)(mb - 64 + i) * NP + cb);
                    if (vd) dn[i] = *(const v4u*)(P + (size_t)(mb + 128 + i) * NP + cb);
                    if (vl) lf[i] = *(const v4u*)(P + (size_t)(mb + 64 * i - 1) * NP + cb);
                    if (vr) rt[i] = *(const v4u*)(P + (size_t)(mb + 64 * i + 2) * NP + cb); }
            } else if (p == 3 && lane >= 20 && lane < 22) {
#pragma unroll
                for (int i = 0; i < 2; ++i)
#pragma unroll
                    for (int j = 0; j < 2; ++j) own[i][j] = *(const v4u*)(P + (size_t)(mb + 64 * i + j) * NP + C_PGL + 8 * (lane - 20));
            }
            float muv[8] = {0.f, 0.f, 0.f, 0.f, 0.f, 0.f, 0.f, 0.f}; if (act) ld8(O.mu + cb, muv);
            __builtin_amdgcn_sched_barrier(0);
#pragma unroll
            for (int i = 0; i < 2; ++i)
#pragma unroll
                for (int j = 0; j < 2; ++j) { const size_t m = (size_t)(mb + 64 * i + j);
                    if (act) { const v4u nbw[4] = {j == 0 ? lf[i] : own[i][0], j == 1 ? rt[i] : own[i][1], i == 0 ? up[j] : own[0][j], i == 1 ? dn[j] : own[1][j]};
                        feat_rw(O, p, m, lane, own[i][j], nbw, muv); }
                    else if (p == 3 && lane < 32) *(v4u*)(O.A2 + m * KLORA + 8 * lane) = own[i][j]; }
        }
#pragma unroll
        for (int p = 0; p < 2; ++p) {
            const int cq = p * 512 + 8 * lane, cb = C_Q + cq;
            v4u g[4][4];
#pragma unroll
            for (int a2 = 0; a2 < 4; ++a2)
#pragma unroll
                for (int b2 = 0; b2 < 4; ++b2) { const bool ok = (a2 == 0 ? vu : (a2 == 3 ? vd : true)) && (b2 == 0 ? vl : (b2 == 3 ? vr : true));
                    g[a2][b2] = Z4; if (ok) g[a2][b2] = *(const v4u*)(P + (size_t)(mb + 64 * (a2 - 1) + (b2 - 1)) * NP + cb); }
            __builtin_amdgcn_sched_barrier(0);
            float acc[2][2][8];
#pragma unroll
            for (int i = 0; i < 2; ++i)
#pragma unroll
                for (int j = 0; j < 2; ++j)
#pragma unroll
                    for (int e = 0; e < 8; ++e) acc[i][j][e] = 0.f;
#pragma unroll
            for (int dy = 0; dy < 3; ++dy)
#pragma unroll
                for (int dx = 0; dx < 3; ++dx) { float wv[8]; ld8(O.cw + (dy * 3 + dx) * 1024 + cq, wv);
#pragma unroll
                    for (int i = 0; i < 2; ++i)
#pragma unroll
                        for (int j = 0; j < 2; ++j) { float pv[8]; unp8(g[i + dy][j + dx], pv);
#pragma unroll
                            for (int e = 0; e < 8; ++e) acc[i][j][e] += pv[e] * wv[e]; } }
#pragma unroll
            for (int i = 0; i < 2; ++i)
#pragma unroll
                for (int j = 0; j < 2; ++j) feat_gla_store(O, p, (size_t)(mb + 64 * i + j), lane, acc[i][j]);
        }
    }
    for (int m = NLAT + F.gw; m < MR; m += F.NGW) {
        int lane = F.lane; asm volatile("" : "+v"(lane));
        const int t = (m - NLAT) & (CTXL - 1); const bool vp = t > 0, vn = t < CTXL - 1;
#pragma unroll
        for (int p = 0; p < 4; ++p) {
            const int cb = p * 512 + 8 * lane; const bool act = (p < 3) || lane < 20;
            if (act) { const v4u own = *(const v4u*)(P + (size_t)m * NP + cb); v4u pv = Z4, nv = Z4;
                if (vp) pv = *(const v4u*)(P + (size_t)(m - 1) * NP + cb); if (vn) nv = *(const v4u*)(P + (size_t)(m + 1) * NP + cb);
                float muv[8]; ld8(O.mu + cb, muv); const v4u nbw[4] = {pv, nv, pv, nv};
                feat_rw(O, p, (size_t)m, lane, own, nbw, muv); }
            else if (p == 3 && lane < 32) { v4u w = Z4; if (lane < 22) w = *(const v4u*)(P + (size_t)m * NP + C_PGL + 8 * (lane - 20)); *(v4u*)(O.A2 + (size_t)m * KLORA + 8 * lane) = w; }
        }
#pragma unroll
        for (int p = 0; p < 2; ++p) {
            const int cq = p * 512 + 8 * lane, cb = C_Q + cq; float acc[8] = {0.f, 0.f, 0.f, 0.f, 0.f, 0.f, 0.f, 0.f};
#pragma unroll
            for (int dx = -1; dx <= 1; ++dx) { const bool ok = (dx < 0) ? vp : ((dx > 0) ? vn : true);
                if (ok) { float pv[8], wv[8]; unp8(*(const v4u*)(P + (size_t)(m + dx) * NP + cb), pv); ld8(O.cw + (3 + dx + 1) * 1024 + cq, wv);
#pragma unroll
                    for (int e = 0; e < 8; ++e) acc[e] += pv[e] * wv[e]; } }
            feat_gla_store(O, p, (size_t)m, lane, acc);
        }
    }
}

struct EpiLora {
    static constexpr bool PERM = true;
    unsigned char* ws; const float* const* in;
    __device__ __forceinline__ void grp_w(const f32x4 (&acc)[2][2][4][2], int row0, int c0) const {
        bf16* Wf = (bf16*)(ws + WS_LWF); bf16* Wb = (bf16*)(ws + WS_LWB);
#pragma unroll
        for (int bj = 0; bj < 2; ++bj) { const int ch = (c0 + bj * 128) >> 1; const f32x4 w0f = *(const f32x4*)(in[8] + ch), w0b = *(const f32x4*)(in[8] + 512 + ch);
#pragma unroll
            for (int ai = 0; ai < 2; ++ai)
#pragma unroll
                for (int m = 0; m < 4; ++m) { const size_t row = (size_t)(row0 + ai * 128 + m * 16);
                    const f32x4 xf = acc[ai][bj][m][0] + w0f, xb = acc[ai][bj][m][1] + w0b; f32x4 df, db;
#pragma unroll
                    for (int e = 0; e < 4; ++e) { df[e] = -0.60653066f * sigmoidf_(xf[e]); db[e] = -0.60653066f * sigmoidf_(xb[e]); }
                    { v2u o; o.x = pk2(df[0], df[1]); o.y = pk2(df[2], df[3]); *(v2u*)(Wf + row * RWW + ch) = o; o.x = pk2(db[0], db[1]); o.y = pk2(db[2], db[3]); *(v2u*)(Wb + row * RWW + ch) = o; } } }
    }
    __device__ __forceinline__ void grp_a(const f32x4 (&acc)[2][2][4][2], int row0, int c0) const {
        bf16* KMf = (bf16*)(ws + WS_KMF); bf16* KMb = (bf16*)(ws + WS_KMB); bf16* BVf = (bf16*)(ws + WS_BVF); bf16* BVb = (bf16*)(ws + WS_BVB);
        const bf16* KK = (const bf16*)(ws + WS_KKB); bf16* KSUM = (bf16*)(ws + WS_KSUM);
#pragma unroll
        for (int bj = 0; bj < 2; ++bj) { const int ch = (c0 + bj * 128 - 1024) >> 1; const f32x4 a0f = *(const f32x4*)(in[10] + ch), a0b = *(const f32x4*)(in[10] + 512 + ch), ka = *(const f32x4*)(in[14] + ch);
#pragma unroll
            for (int ai = 0; ai < 2; ++ai) {
            v2u kpw[2][4], kkw[2][4];
#pragma unroll
                for (int m = 0; m < 4; ++m) { const size_t row = (size_t)(row0 + ai * 128 + m * 16); kpw[ai][m] = *(const v2u*)(KMf + row * RWW + ch); kkw[ai][m] = *(const v2u*)(KK + row * RWW + ch); }
            __builtin_amdgcn_sched_barrier(0);
#pragma unroll
                for (int m = 0; m < 4; ++m) { const size_t row = (size_t)(row0 + ai * 128 + m * 16);
                    const f32x4 xf = acc[ai][bj][m][0] + a0f, xb = acc[ai][bj][m][1] + a0b;
                    const f32x4 kp = (f32x4){bflo(kpw[ai][m].x), bfhi(kpw[ai][m].x), bflo(kpw[ai][m].y), bfhi(kpw[ai][m].y)}, kk = (f32x4){bflo(kkw[ai][m].x), bfhi(kkw[ai][m].x), bflo(kkw[ai][m].y), bfhi(kkw[ai][m].y)};
                    f32x4 kmf, kmb, bvf, bvb;
#pragma unroll
                    for (int e = 0; e < 4; ++e) { const float af = sigmoidf_(xf[e]), ab = sigmoidf_(xb[e]);
                        kmf[e] = kp[e] * (1.0f + (af - 1.0f) * ka[e]); kmb[e] = kp[e] * (1.0f + (ab - 1.0f) * ka[e]); bvf[e] = kk[e] * af; bvb[e] = kk[e] * ab; }
                    { v2u o; o.x = pk2(kmf[0], kmf[1]); o.y = pk2(kmf[2], kmf[3]); *(v2u*)(KMf + row * RWW + ch) = o; o.x = pk2(kmb[0], kmb[1]); o.y = pk2(kmb[2], kmb[3]); *(v2u*)(KMb + row * RWW + ch) = o;
                      o.x = pk2(bvf[0], bvf[1]); o.y = pk2(bvf[2], bvf[3]); *(v2u*)(BVf + row * RWW + ch) = o; o.x = pk2(bvb[0], bvb[1]); o.y = pk2(bvb[2], bvb[3]); *(v2u*)(BVb + row * RWW + ch) = o; }
                    v2u ks; ks.x = pk2(kmf[0] + kmb[0], kmf[1] + kmb[1]); ks.y = pk2(kmf[2] + kmb[2], kmf[3] + kmb[3]); *(v2u*)(KSUM + row * RWW + ch) = ks; } } }
    }
    __device__ __forceinline__ void grp_g(const f32x4 (&acc)[2][2][4][2], int row0, int c0) const {
        bf16* RWG = (bf16*)(ws + WS_RWG);
#pragma unroll
        for (int bj = 0; bj < 2; ++bj) { const int ch = c0 + bj * 128 - 2048;
#pragma unroll
            for (int ai = 0; ai < 2; ++ai)
#pragma unroll
                for (int m = 0; m < 4; ++m) { const size_t row = (size_t)(row0 + ai * 128 + m * 16); const f32x4 v0 = acc[ai][bj][m][0], v1 = acc[ai][bj][m][1];
                    v4u w; w.x = pk2(v0[0], v0[1]); w.y = pk2(v0[2], v0[3]); w.z = pk2(v1[0], v1[1]); w.w = pk2(v1[2], v1[3]); *(v4u*)(RWG + row * RWW + ch) = w; } }
    }
    __device__ __forceinline__ void grp_l(const f32x4 (&acc)[2][2][4][2], int row0, int c0) const {
        bf16* GAf = (bf16*)(ws + WS_LAF); bf16* GAb = (bf16*)(ws + WS_LAB);
#pragma unroll
        for (int bj = 0; bj < 2; ++bj) { const int ch = (c0 + bj * 128 - 2560) >> 1; const f32x4 gbf = *(const f32x4*)(in[20] + ch), gbb = *(const f32x4*)(in[20] + 256 + ch);
#pragma unroll
            for (int ai = 0; ai < 2; ++ai)
#pragma unroll
                for (int m = 0; m < 4; ++m) { const size_t row = (size_t)(row0 + ai * 128 + m * 16);
                    const f32x4 xf = acc[ai][bj][m][0] + gbf, xb = acc[ai][bj][m][1] + gbb; f32x4 af, ab;
#pragma unroll
                    for (int e = 0; e < 4; ++e) { const float lf = logsigmoidf_(xf[e]), lb = logsigmoidf_(xb[e]);
                        af[e] = lf * 0.0625f; ab[e] = lb * 0.0625f; }
                    { v2u o; o.x = pk2(af[0], af[1]); o.y = pk2(af[2], af[3]); *(v2u*)(GAf + row * 256 + ch) = o; o.x = pk2(ab[0], ab[1]); o.y = pk2(ab[2], ab[3]); *(v2u*)(GAb + row * 256 + ch) = o; } } }
    }
    __device__ __forceinline__ void operator()(const f32x4 (&acc)[2][2][4][2], const pg8::Unit& u, int wr, int wc, int fr, int fq) const {
        const int row0 = u.pm * 256 + wr * 64 + fr, c0 = u.pn * 256 + wc * 32 + 8 * fq;
        if (u.pn < 4) grp_w(acc, row0, c0); else if (u.pn < 8) grp_a(acc, row0, c0); else if (u.pn < 10) grp_g(acc, row0, c0); else grp_l(acc, row0, c0);
    }
};
__device__ __forceinline__ void ph_lora(Frame& F) {
    pg8::Gemm g{(const bf16*)(F.ws + WS_A2), (const bf16*)(F.ws + WS_WLORA), MR, NLORA, KLORA, nullptr};
    pg8::StaticOrder S; S.init(MR, NLORA, F.G, (int)blockIdx.x);
    EpiLora E{F.ws, F.in};
    pg8::gemm_phase<EpiLora, pg8::StaticOrder, true, true, false>(F.lds, g, S, E);
}

__device__ __forceinline__ void ph_merge(Frame& F) {
    unsigned char* ws = F.ws; const int lane = F.lane;
    const bf16* ORf = (const bf16*)(ws + WS_ORWF); const bf16* ORb = (const bf16*)(ws + WS_ORWB); const bf16* OGf = (const bf16*)(ws + WS_OGLF); const bf16* OGb = (const bf16*)(ws + WS_OGLB);
    const bf16* R = (const bf16*)(ws + WS_RB); const bf16* V = (const bf16*)(ws + WS_VB); const bf16* KSUM = (const bf16*)(ws + WS_KSUM); const bf16* RWG = (const bf16*)(ws + WS_RWG);
    const bf16* P = (const bf16*)(ws + WS_P);
    bf16* YRW = (bf16*)(ws + WS_YRW); bf16* YGLA = (bf16*)(ws + WS_YGLA);
    float rk[8], gw[8], gbv[8], ggw[8], ggb[8];
    ld8(F.in[15] + 8 * lane, rk); ld8(F.in[16] + 8 * lane, gw); ld8(F.in[17] + 8 * lane, gbv); ld8(F.in[21] + 8 * lane, ggw); ld8(F.in[22] + 8 * lane, ggb);
    for (int m0 = F.gw; m0 < NLAT; m0 += 2 * F.NGW) {
        const int m1 = (m0 + F.NGW < NLAT) ? m0 + F.NGW : m0;
        v4u wa[2], wb[2], wc[2], wd[2], wr[2], wv[2], wk[2], wg[2], wo[2];
#pragma unroll
        for (int r2 = 0; r2 < 2; ++r2) { const int m = r2 ? m1 : m0; const size_t ro = (size_t)m * RWW + 8 * lane;
            wa[r2] = *(const v4u*)(ORf + ro); wb[r2] = *(const v4u*)(ORb + ro); wc[r2] = *(const v4u*)(OGf + ro); wd[r2] = *(const v4u*)(OGb + ro);
            wr[r2] = *(const v4u*)(R + ro); wv[r2] = *(const v4u*)(V + ro); wk[r2] = *(const v4u*)(KSUM + ro); wg[r2] = *(const v4u*)(RWG + ro);
            wo[r2] = *(const v4u*)(P + (size_t)m * NP + C_OG + 8 * lane); }
#pragma unroll
        for (int r2 = 0; r2 < 2; ++r2) { const int m = r2 ? m1 : m0; const size_t ro = (size_t)m * RWW + 8 * lane;
        {
            float a[8], b[8], o[8]; unp8(wa[r2], a); unp8(wb[r2], b);
            float s = 0.f;
#pragma unroll
            for (int e = 0; e < 8; ++e) { o[e] = a[e] + b[e]; s += o[e]; }
            s += __shfl_xor(s, 1); s += __shfl_xor(s, 2); s += __shfl_xor(s, 4);
            const float mean = s * (1.f / 64.f); float q = 0.f;
#pragma unroll
            for (int e = 0; e < 8; ++e) { o[e] -= mean; q += o[e] * o[e]; }
            q += __shfl_xor(q, 1); q += __shfl_xor(q, 2); q += __shfl_xor(q, 4);
            const float rstd = __builtin_amdgcn_rsqf(q * (1.f / 64.f) + RW_GN_EPS);
            float r[8], v[8], ksm[8], g[8]; unp8(wr[r2], r); unp8(wv[r2], v); unp8(wk[r2], ksm); unp8(wg[r2], g);
            float bs = 0.f;
#pragma unroll
            for (int e = 0; e < 8; ++e) bs += r[e] * ksm[e] * rk[e];
            bs += __shfl_xor(bs, 1); bs += __shfl_xor(bs, 2); bs += __shfl_xor(bs, 4);
            float y[8];
#pragma unroll
            for (int e = 0; e < 8; ++e) y[e] = (o[e] * rstd * gw[e] + gbv[e] + bs * v[e]) * g[e];
            *(v4u*)(YRW + ro) = pk8(y);
        }
        {
            float a[8], b[8], o[8]; unp8(wc[r2], a); unp8(wd[r2], b);
            float s = 0.f;
#pragma unroll
            for (int e = 0; e < 8; ++e) { o[e] = a[e] + b[e]; s += o[e]; }
            s += __shfl_xor(s, 1); s += __shfl_xor(s, 2); s += __shfl_xor(s, 4); s += __shfl_xor(s, 8);
            const float mean = s * (1.f / 128.f); float q = 0.f;
#pragma unroll
            for (int e = 0; e < 8; ++e) { o[e] -= mean; q += o[e] * o[e]; }
            q += __shfl_xor(q, 1); q += __shfl_xor(q, 2); q += __shfl_xor(q, 4); q += __shfl_xor(q, 8);
            const float rstd = __builtin_amdgcn_rsqf(q * (1.f / 128.f) + LN_EPS);
            float og[8]; unp8(wo[r2], og);
            float y[8];
#pragma unroll
            for (int e = 0; e < 8; ++e) y[e] = (o[e] * rstd * ggw[e] + ggb[e]) * siluf_(og[e]);
            *(v4u*)(YGLA + ro) = pk8(y);
        }
        }
    }
}

template <int WHICH> struct EpiBranch {
    static constexpr bool PERM = true;
    bf16* Z; const bf16* P;
    __device__ __forceinline__ void operator()(const f32x4 (&acc)[2][2][4][2], const pg8::Unit& u, int wr, int wc, int fr, int fq) const {
        const int row0 = u.pm * 256 + wr * 64 + fr, col0 = u.pn * 256 + wc * 32 + 8 * fq;
#pragma unroll
        for (int ah = 0; ah < 4; ++ah) { const int ai = ah >> 1, mb = 2 * (ah & 1);
            v4u gw[2][2], zw[2][2];
#pragma unroll
            for (int m = 0; m < 2; ++m) { const size_t row = (size_t)(row0 + ai * 128 + (mb + m) * 16);
#pragma unroll
                for (int bj = 0; bj < 2; ++bj) { const int c = col0 + bj * 128;
                    gw[m][bj] = *(const v4u*)(P + row * NP + (WHICH ? C_GGLA : C_GRW) + c);
                    if (WHICH) zw[m][bj] = *(const v4u*)(Z + row * D + c); } }
            __builtin_amdgcn_sched_barrier(0);
#pragma unroll
            for (int m = 0; m < 2; ++m) { const size_t row = (size_t)(row0 + ai * 128 + (mb + m) * 16);
#pragma unroll
                for (int bj = 0; bj < 2; ++bj) { const int c = col0 + bj * 128;
                    float g[8]; unp8(gw[m][bj], g);
                    const f32x4 v0 = acc[ai][bj][mb + m][0], v1 = acc[ai][bj][mb + m][1];
                    float z[8];
#pragma unroll
                    for (int e = 0; e < 4; ++e) { z[e] = sigmoidf_(g[e]) * v0[e]; z[4 + e] = sigmoidf_(g[4 + e]) * v1[e]; }
                    if (WHICH) { float zo[8]; unp8(zw[m][bj], zo);
#pragma unroll
                        for (int e = 0; e < 8; ++e) z[e] += zo[e]; }
                    *(v4u*)(Z + row * D + c) = pk8(z); } }
        }
    }
};
__device__ __forceinline__ void ph_branch(Frame& F) {
    pg8::StaticOrder S; S.init(NLAT, D, F.G, (int)blockIdx.x);
    { pg8::Gemm g{(const bf16*)(F.ws + WS_YRW), (const bf16*)(F.ws + WS_WBRRW), NLAT, D, RWW, nullptr};
      EpiBranch<0> E{(bf16*)(F.ws + WS_Z), (const bf16*)(F.ws + WS_P)};
      pg8::gemm_phase<EpiBranch<0>, pg8::StaticOrder, true, true, false>(F.lds, g, S, E); }
    { pg8::Gemm g{(const bf16*)(F.ws + WS_YGLA), (const bf16*)(F.ws + WS_WBRGLA), NLAT, D, RWW, nullptr};
      EpiBranch<1> E{(bf16*)(F.ws + WS_Z), (const bf16*)(F.ws + WS_P)};
      pg8::gemm_phase<EpiBranch<1>, pg8::StaticOrder, true, true, false>(F.lds, g, S, E); }
}
struct EpiOut {
    static constexpr bool PERM = true;
    bf16* X1P; const float* x; const float* mod;
    __device__ __forceinline__ void operator()(const f32x4 (&acc)[2][2][4][2], const pg8::Unit& u, int wr, int wc, int fr, int fq) const {
        const int row0 = u.pm * 256 + wr * 64 + fr, col0 = u.pn * 256 + wc * 32 + 8 * fq; const float* g1 = mod + (u.pm / (SEQ / 256)) * 6144 + 2048;
        f32x4 gv[2][2];
#pragma unroll
        for (int bj = 0; bj < 2; ++bj)
#pragma unroll
            for (int n = 0; n < 2; ++n) gv[bj][n] = *(const f32x4*)(g1 + col0 + bj * 128 + 4 * n);
#pragma unroll
        for (int ah = 0; ah < 4; ++ah) { const int ai = ah >> 1, mb = 2 * (ah & 1);
            f32x4 xv[2][2][2];
#pragma unroll
            for (int m = 0; m < 2; ++m) { const size_t ro = (size_t)(row0 + ai * 128 + (mb + m) * 16) * D;
#pragma unroll
                for (int bj = 0; bj < 2; ++bj)
#pragma unroll
                    for (int n = 0; n < 2; ++n) xv[m][bj][n] = *(const f32x4*)(x + ro + col0 + bj * 128 + 4 * n); }
            __builtin_amdgcn_sched_barrier(0);
#pragma unroll
            for (int m = 0; m < 2; ++m) { const size_t ro = (size_t)(row0 + ai * 128 + (mb + m) * 16) * D;
#pragma unroll
                for (int bj = 0; bj < 2; ++bj) { const f32x4 a = xv[m][bj][0] * ALPHA + gv[bj][0] * acc[ai][bj][mb + m][0], b = xv[m][bj][1] * ALPHA + gv[bj][1] * acc[ai][bj][mb + m][1];
                    v4u w; w.x = pk2(a.x, a.y); w.y = pk2(a.z, a.w); w.z = pk2(b.x, b.y); w.w = pk2(b.z, b.w); *(v4u*)(X1P + ro + col0 + bj * 128) = w; } }
        }
    }
};
__device__ __forceinline__ void ph_outproj(Frame& F) {
    pg8::Gemm g{(const bf16*)(F.ws + WS_Z), (const bf16*)(F.ws + WS_WOUT), NLAT, D, D, nullptr};
    pg8::StaticOrder S; S.init(NLAT, D, F.G, (int)blockIdx.x);
    EpiOut E{(bf16*)(F.ws + WS_X1), F.in[0], (const float*)(F.ws + WS_MOD)};
    pg8::gemm_phase<EpiOut, pg8::StaticOrder, true, true, false>(F.lds, g, S, E);
}
#endif

#if MS >= 3
constexpr int LP = 72, SLOTB = 64 * LP * 2, LPF = 68, AUX_OFF = 13 * SLOTB;
static_assert(AUX_OFF + 4096 <= MISC_OFF, "scan LDS map");
#define SLOT(n) ((LAS bf16*)(lds + (n) * SLOTB))
__device__ __forceinline__ int scan_row(int s, int b, int dir) {
    if (s < CTXL) return NLAT + b * CTXL + (dir ? (CTXL - 1 - s) : s);
    const int lt = s - CTXL; return b * SEQ + (dir ? (SEQ - 1 - lt) : lt);
}
__device__ __forceinline__ unsigned pk2z(float x) { return pk2(x, 0.f); }
__device__ __forceinline__ float bf2f(bf16 h) { return __builtin_bit_cast(float, (unsigned)h << 16); }
__device__ __forceinline__ v2u pack4(const f32x4 v) { v2u o; o.x = pk2(v[0], v[1]); o.y = pk2(v[2], v[3]); return o; }
__device__ __forceinline__ float clamp8(float x) { return __builtin_amdgcn_fmed3f(x, -448.0f, 448.0f); }
__device__ __forceinline__ unsigned pack4_fp8(const f32x4 v) { int w = __builtin_amdgcn_cvt_pk_fp8_f32(clamp8(v[0]), clamp8(v[1]), 0, false); return (unsigned)__builtin_amdgcn_cvt_pk_fp8_f32(clamp8(v[2]), clamp8(v[3]), w, true); }
__device__ __forceinline__ f32x4 unpack4_fp8(unsigned w) { const f32x2 lo = __builtin_amdgcn_cvt_pk_f32_fp8((int)w, false), hi = __builtin_amdgcn_cvt_pk_f32_fp8((int)w, true); return (f32x4){lo.x, lo.y, hi.x, hi.y}; }
__device__ __forceinline__ f32x4 unpack4(const v2u w) { return (f32x4){bflo(w.x), bfhi(w.x), bflo(w.y), bfhi(w.y)}; }
__device__ __forceinline__ f32x4 mm_tile(const LAS bf16* X, int r0, const LAS bf16* Y, int c0, int lane) {
    const int rr = lane & 15, q = lane >> 4;
    const LAS bf16* xp = X + (r0 + rr) * LP + 8 * q; const LAS bf16* yp = Y + (c0 + rr) * LP + 8 * q;
    const bf16x8 a0 = *(const LAS bf16x8*)xp, a1 = *(const LAS bf16x8*)(xp + 32), b0 = *(const LAS bf16x8*)yp, b1 = *(const LAS bf16x8*)(yp + 32);
    f32x4 acc = (f32x4){0.f, 0.f, 0.f, 0.f};
    acc = __builtin_amdgcn_mfma_f32_16x16x32_bf16(a0, b0, acc, 0, 0, 0);
    acc = __builtin_amdgcn_mfma_f32_16x16x32_bf16(a1, b1, acc, 0, 0, 0);
    return acc;
}
__device__ __forceinline__ float red8(float x) {
    x += __builtin_bit_cast(float, __builtin_amdgcn_update_dpp(0, __builtin_bit_cast(int, x), 0x141, 0xf, 0xf, false));
    x += __builtin_bit_cast(float, __builtin_amdgcn_update_dpp(0, __builtin_bit_cast(int, x), 0xB1, 0xf, 0xf, false));
    x += __builtin_bit_cast(float, __builtin_amdgcn_update_dpp(0, __builtin_bit_cast(int, x), 0x4E, 0xf, 0xf, false));
    return x;
}

#define S1_BAR() do { asm volatile("s_waitcnt lgkmcnt(0)" ::: "memory"); __builtin_amdgcn_s_barrier(); asm volatile("" ::: "memory"); } while (0)
struct RwIn { bf16 lw[8], r[8], k[8], a[8], b[8], v[8]; };
__device__ __forceinline__ void s1_rwkv_load(Frame& F, int u, RwIn& I) {
    const int sr = u / NCHUNK, c = u - sr * NCHUNK, rb = sr >> 4, rdir = (sr >> 3) & 1, rh = sr & 7; unsigned char* ws = F.ws;
    const bf16* RBp = (const bf16*)(ws + WS_RB); const bf16* VBp = (const bf16*)(ws + WS_VB); const bf16* KKp = (const bf16*)(ws + WS_KKB);
    const bf16* KMp = (const bf16*)(ws + (rdir ? WS_KMB : WS_KMF)); const bf16* BVp = (const bf16*)(ws + (rdir ? WS_BVB : WS_BVF)); const bf16* LWp = (const bf16*)(ws + (rdir ? WS_LWB : WS_LWF));
#pragma unroll
    for (int i = 0; i < 8; ++i) { const int row = scan_row(c * CH + 8 * F.wave + i, rb, rdir); const size_t base = (size_t)row * RWW + rh * 64 + F.lane;
        I.lw[i] = LWp[base]; I.r[i] = RBp[base]; I.k[i] = KMp[base]; I.a[i] = KKp[base]; I.b[i] = BVp[base]; I.v[i] = VBp[base]; }
}
__device__ __forceinline__ void s1_rwkv(Frame& F, int u, const RwIn& I, int un, RwIn& Inext, int cvi) {
    const int sr = u / NCHUNK, c = u - sr * NCHUNK;
    const bool emit = c >= CTXL / CH;
    LAS unsigned char* lds = F.lds; unsigned char* ws = F.ws;
    int lane_ = F.lane; asm volatile("" : "+v"(lane_));
    const int lane = lane_, wave = F.wave, rr = lane & 15, q = lane >> 4;
    LAS float* tot = (LAS float*)(lds + AUX_OFF); LAS float* gCs = tot + 512;
    {
        float lw[8], xr[8], xk[8], xa[8], xb[8], xv[8];
#pragma unroll
        for (int i = 0; i < 8; ++i) { lw[i] = bf2f(I.lw[i]); xr[i] = bf2f(I.r[i]); xk[i] = bf2f(I.k[i]); xa[i] = -bf2f(I.a[i]); xb[i] = bf2f(I.b[i]); xv[i] = bf2f(I.v[i]); }
        float p[8]; p[0] = lw[0];
#pragma unroll
        for (int i = 1; i < 8; ++i) p[i] = p[i - 1] + lw[i];
        tot[wave * 64 + lane] = p[7];
        S1_BAR();
        float off = 0.f, all = 0.f;
#pragma unroll
        for (int w = 0; w < 8; ++w) { const float t = tot[w * 64 + lane]; all += t; off += (w < wave) ? t : 0.f; }
        if (wave == 0) gCs[lane] = __expf(all);
        float at[8], bb[8], kb[8];
#pragma unroll
        for (int i = 0; i < 8; ++i) { const float cum = off + p[i]; const float g = __expf(cum), gi = __expf(-cum), gp = __expf(cum - lw[i]), gc = __expf(all - cum);
            const int t = 8 * wave + i;
            at[i] = xa[i] * gp; bb[i] = xb[i] * gc; kb[i] = xk[i] * gc;
            SLOT(0)[t * LP + lane] = (bf16)pk2z(at[i]);
            SLOT(1)[t * LP + lane] = (bf16)pk2z(xr[i] * g);
            SLOT(2)[t * LP + lane] = (bf16)pk2z(xb[i] * gi);
            SLOT(3)[t * LP + lane] = (bf16)pk2z(xk[i] * gi); }
        *(LAS v4u*)(SLOT(4) + lane * LP + 8 * wave) = pk8(at);
        *(LAS v4u*)(SLOT(5) + lane * LP + 8 * wave) = pk8(xv);
        *(LAS v4u*)(SLOT(6) + lane * LP + 8 * wave) = pk8(bb);
        *(LAS v4u*)(SLOT(7) + lane * LP + 8 * wave) = pk8(kb);
        S1_BAR();
    }
    s1_rwkv_load(F, un, Inext);
    LAS float* Lp = (LAS float*)(lds + 8 * SLOTB);
#pragma unroll
    for (int tix = 0; tix < 2; ++tix) { const int ti = 2 * wave + tix, r0 = 16 * (ti >> 2), c0 = 16 * (ti & 3), ci = c0 + rr;
        { const f32x4 acc = mm_tile(SLOT(2), r0, SLOT(0), c0, lane);
#pragma unroll
            for (int e = 0; e < 4; ++e) { const int i = r0 + 4 * q + e; Lp[ci * LPF + (i & 3) * 16 + (i >> 2)] = (i < ci) ? acc[e] : 0.f; } }
        { f32x4 acc = mm_tile(SLOT(0), r0, SLOT(3), c0, lane);
#pragma unroll
            for (int e = 0; e < 4; ++e) acc[e] = (ci < r0 + 4 * q + e) ? acc[e] : 0.f;
            *(LAS v2u*)(SLOT(10) + ci * LP + r0 + 4 * q) = pack4(acc); }
        if (emit) {
            { f32x4 acc = mm_tile(SLOT(2), r0, SLOT(1), c0, lane);
#pragma unroll
                for (int e = 0; e < 4; ++e) acc[e] = (r0 + 4 * q + e <= ci) ? acc[e] : 0.f;
                *(LAS v2u*)(SLOT(11) + ci * LP + r0 + 4 * q) = pack4(acc); }
            { f32x4 acc = mm_tile(SLOT(3), r0, SLOT(1), c0, lane);
#pragma unroll
                for (int e = 0; e < 4; ++e) acc[e] = (r0 + 4 * q + e <= ci) ? acc[e] : 0.f;
                *(LAS v2u*)(SLOT(12) + ci * LP + r0 + 4 * q) = pack4(acc); }
        }
    }
    S1_BAR();
    if (wave < 4) {
        const int j = 16 * wave + (lane >> 2), s = lane & 3;
        float Tr[16];
#pragma unroll
        for (int m = 0; m < 16; ++m) Tr[m] = 0.f;
        const LAS float* lrow = Lp + s * 16;
        f32x4 lb[3][4];
#pragma unroll
        for (int t = 0; t < 2; ++t) lb[t][0] = *(const LAS f32x4*)(lrow + t * LPF);
#pragma unroll
        for (int t = 0; t < 64; ++t) {
            if (t + 2 < 64) {
#pragma unroll
                for (int k = 0; k < 4; ++k) if (4 * k <= (t + 2) / 4) lb[(t + 2) % 3][k] = *(const LAS f32x4*)(lrow + (t + 2) * LPF + 4 * k);
            }
            __builtin_amdgcn_sched_barrier(0);
            float acc0 = 0.f, acc1 = 0.f;
#pragma unroll
            for (int m = 0; m < 16; ++m) if (m <= t / 4) { const float lv = lb[t % 3][m >> 2][m & 3]; if (m & 1) acc1 += lv * Tr[m]; else acc0 += lv * Tr[m]; }
            float acc = acc0 + acc1;
            acc += __builtin_bit_cast(float, __builtin_amdgcn_update_dpp(0, __builtin_bit_cast(int, acc), 0xB1, 0xf, 0xf, false));
            acc += __builtin_bit_cast(float, __builtin_amdgcn_update_dpp(0, __builtin_bit_cast(int, acc), 0x4E, 0xf, 0xf, false));
            int jj = j, ss = s; asm volatile("" : "+v"(jj), "+v"(ss));
            const float val = acc + ((t == jj) ? 1.f : 0.f);
            Tr[t >> 2] = (ss == (t & 3)) ? val : Tr[t >> 2];
            SLOT(0)[t * LP + j] = (bf16)pk2z(val);
        }
    } else if (cvi >= 0) { f32x4 cv[CVK]; cvx_load(F.in, cvi, lane, cv); cvx_store(ws, cvi, lane, cv); }
    S1_BAR();
#pragma unroll
    for (int tix = 0; tix < 2; ++tix) { const int ti = 2 * wave + tix, r0 = 16 * (ti >> 2), c0 = 16 * (ti & 3), ci = c0 + rr;
        { const f32x4 acc = mm_tile(SLOT(0), r0, SLOT(4), c0, lane); *(LAS v2u*)(SLOT(2) + ci * LP + r0 + 4 * q) = pack4(acc); }
        { const f32x4 acc = mm_tile(SLOT(0), r0, SLOT(10), c0, lane); *(LAS v2u*)(SLOT(3) + ci * LP + r0 + 4 * q) = pack4(acc); }
    }
    S1_BAR();
    unsigned char* RH = ws + WS_RH + (size_t)u * 4096; bf16* GT = (bf16*)((unsigned char*)F.out + OUT_GT) + (size_t)u * 4096;
#pragma unroll
    for (int tix = 0; tix < 2; ++tix) { const int ti = 2 * wave + tix, tr = ti >> 2, r0 = 16 * tr, c0 = 16 * (ti & 3), ci = c0 + rr;
        const int pos = (tr >> 1) * 32 + q * 8 + 4 * (tr & 1);
        if (emit) {
            { f32x4 acc = mm_tile(SLOT(2), r0, SLOT(11), c0, lane);
                acc += unpack4(*(const LAS v2u*)(SLOT(1) + ci * LP + r0 + 4 * q));
                *(unsigned*)(RH + ci * 64 + pos) = pack4_fp8(acc); }
            { f32x4 acc = mm_tile(SLOT(3), r0, SLOT(11), c0, lane);
                acc += unpack4(*(const LAS v2u*)(SLOT(12) + ci * LP + r0 + 4 * q));
                *(LAS v2u*)(SLOT(4) + ci * LP + r0 + 4 * q) = pack4(acc); }
        }
        { f32x4 acc = mm_tile(SLOT(2), r0, SLOT(6), c0, lane);
            const float gc = gCs[ci];
#pragma unroll
            for (int e = 0; e < 4; ++e) acc[e] += (r0 + 4 * q + e == ci) ? gc : 0.f;
            *(v2u*)(GT + ci * 64 + pos) = pack4(acc); }
    }
    S1_BAR();
    unsigned char* YL = ws + WS_YL + (size_t)u * 4096;
#pragma unroll
    for (int tix = 0; tix < 2; ++tix) { const int ti = 2 * wave + tix, r0 = 16 * (ti >> 2), c0 = 16 * (ti & 3), ci = c0 + rr;
        if (emit) { const f32x4 acc = mm_tile(SLOT(5), r0, SLOT(4), c0, lane); *(unsigned*)(YL + ci * 64 + r0 + 4 * q) = pack4_fp8(acc); }
        { f32x4 acc = mm_tile(SLOT(3), r0, SLOT(6), c0, lane);
            acc += unpack4(*(const LAS v2u*)(SLOT(7) + ci * LP + r0 + 4 * q));
            *(LAS v2u*)(SLOT(8) + ci * LP + r0 + 4 * q) = pack4(acc); }
    }
    S1_BAR();
    bf16* HH = (bf16*)(ws + WS_HH) + (size_t)u * 4096;
#pragma unroll
    for (int tix = 0; tix < 2; ++tix) { const int ti = 2 * wave + tix, r0 = 16 * (ti >> 2), c0 = 16 * (ti & 3), ci = c0 + rr;
        const f32x4 acc = mm_tile(SLOT(8), r0, SLOT(5), c0, lane);
        *(v2u*)(HH + ci * 64 + r0 + 4 * q) = pack4(acc); }
    S1_BAR();
}

struct GlIn { bf16 la[8], q[8], k[8], v0[8], v1[8]; };
__device__ __forceinline__ void s1_gla_load(Frame& F, int u, GlIn& I) {
    const int sg = u / NCHUNK, c = u - sg * NCHUNK, gb = sg >> 3, gdir = (sg >> 2) & 1, gh = sg & 3; unsigned char* ws = F.ws;
    const bf16* Qp = (const bf16*)(ws + WS_QGB); const bf16* Kp = (const bf16*)(ws + WS_KGB); const bf16* Vp = (const bf16*)(ws + WS_VGB); const bf16* LAp = (const bf16*)(ws + (gdir ? WS_LAB : WS_LAF));
#pragma unroll
    for (int i = 0; i < 8; ++i) { const int row = scan_row(c * CH + 8 * F.wave + i, gb, gdir); const size_t b2 = (size_t)row * 256 + gh * 64 + F.lane, b5 = (size_t)row * RWW + gh * 128 + F.lane;
        I.la[i] = LAp[b2]; I.q[i] = Qp[b2]; I.k[i] = Kp[b2]; I.v0[i] = Vp[b5]; I.v1[i] = Vp[b5 + 64]; }
}
__device__ __forceinline__ void s1_gla(Frame& F, int u, const GlIn& I) {
    const int sg = u / NCHUNK, c = u - sg * NCHUNK;
    const bool emit = c >= CTXL / CH;
    LAS unsigned char* lds = F.lds; unsigned char* ws = F.ws;
    int lane_ = F.lane; asm volatile("" : "+v"(lane_));
    const int lane = lane_, wave = F.wave, rr = lane & 15, q = lane >> 4;
    LAS float* tot = (LAS float*)(lds + AUX_OFF);
    unsigned char* QE = (unsigned char*)F.out + OUT_QE + (size_t)u * 4096;
    {
        float la[8], xq[8], xk[8], v0[8], v1[8];
#pragma unroll
        for (int i = 0; i < 8; ++i) { la[i] = bf2f(I.la[i]); xq[i] = bf2f(I.q[i]); xk[i] = bf2f(I.k[i]); v0[i] = bf2f(I.v0[i]); v1[i] = bf2f(I.v1[i]); }
        float p[8]; p[0] = la[0];
#pragma unroll
        for (int i = 1; i < 8; ++i) p[i] = p[i - 1] + la[i];
        tot[wave * 64 + lane] = p[7];
        S1_BAR();
        float off = 0.f, all = 0.f;
#pragma unroll
        for (int w = 0; w < 8; ++w) { const float t = tot[w * 64 + lane]; all += t; off += (w < wave) ? t : 0.f; }
        if (wave == 0) ((float*)(ws + WS_DD))[(size_t)u * 64 + lane] = __expf(all);
        float kl[8];
#pragma unroll
        for (int i = 0; i < 8; ++i) { const float cum = off + p[i]; const int t = 8 * wave + i;
            const float qef = xq[i] * __expf(cum);
            SLOT(0)[t * LP + lane] = (bf16)pk2z(qef);
            if (emit) QE[t * 64 + lane] = (unsigned char)__builtin_amdgcn_cvt_pk_fp8_f32(clamp8(qef), 0.f, 0, false);
            SLOT(1)[t * LP + lane] = (bf16)pk2z(xk[i] * __expf(-cum));
            kl[i] = xk[i] * __expf(all - cum); }
        *(LAS v4u*)(SLOT(2) + lane * LP + 8 * wave) = pk8(kl);
        *(LAS v4u*)(SLOT(3) + lane * LP + 8 * wave) = pk8(v0);
        *(LAS v4u*)(SLOT(3) + (64 + lane) * LP + 8 * wave) = pk8(v1);
        S1_BAR();
    }
    if (emit) {
#pragma unroll
        for (int tix = 0; tix < 2; ++tix) { const int ti = 2 * wave + tix, r0 = 16 * (ti >> 2), c0 = 16 * (ti & 3), ci = c0 + rr;
            f32x4 acc = mm_tile(SLOT(1), r0, SLOT(0), c0, lane);
#pragma unroll
            for (int e = 0; e < 4; ++e) acc[e] = (r0 + 4 * q + e <= ci) ? acc[e] : 0.f;
            *(LAS v2u*)(SLOT(5) + ci * LP + r0 + 4 * q) = pack4(acc); }
    }
    bf16* KV = (bf16*)(ws + WS_KV) + (size_t)u * 8192;
#pragma unroll
    for (int tix = 0; tix < 4; ++tix) { const int ti = 4 * wave + tix, r0 = 16 * (ti >> 3), c0 = 16 * (ti & 7), ci = c0 + rr;
        const f32x4 acc = mm_tile(SLOT(2), r0, SLOT(3), c0, lane);
        *(v2u*)(KV + ci * 64 + r0 + 4 * q) = pack4(acc); }
    S1_BAR();
    if (emit) {
        unsigned char* IN = ws + WS_INTRA + (size_t)u * 8192;
#pragma unroll
        for (int tix = 0; tix < 4; ++tix) { const int ti = 4 * wave + tix, r0 = 16 * (ti >> 2), c0 = 16 * (ti & 3), ci = c0 + rr;
            const f32x4 acc = mm_tile(SLOT(3), r0, SLOT(5), c0, lane);
            *(unsigned*)(IN + ci * 128 + r0 + 4 * q) = pack4_fp8(acc); }
    }
    S1_BAR();
}

__device__ __forceinline__ void ph_scan1(Frame& F) {
    { RwIn cur, nxt; if ((int)blockIdx.x < NU_RW) s1_rwkv_load(F, blockIdx.x, cur);
#pragma unroll 1
      for (int u = blockIdx.x; u < NU_RW; u += F.G) { const int un = (u + F.G < NU_RW) ? u + F.G : u; const int cvi = ((u - (int)blockIdx.x) / F.G) * (F.G * 4) + (int)blockIdx.x * 4 + (F.wave & 3);
          s1_rwkv(F, u, cur, un, nxt, cvi < CV_NITEM ? cvi : -1); cur = nxt; } }
    { GlIn cur, nxt; if ((int)blockIdx.x < NU_GL) s1_gla_load(F, blockIdx.x, cur);
#pragma unroll 1
      for (int u = blockIdx.x; u < NU_GL; u += F.G) { const int un = (u + F.G < NU_GL) ? u + F.G : u; s1_gla_load(F, un, nxt); s1_gla(F, u, cur); cur = nxt; } }
}

__device__ __forceinline__ bf16x8 pack_frag(const f32x4 lo, const f32x4 hi) {
    v4u w; w.x = pk2(lo[0], lo[1]); w.y = pk2(lo[2], lo[3]); w.z = pk2(hi[0], hi[1]); w.w = pk2(hi[2], hi[3]); return __builtin_bit_cast(bf16x8, w);
}
constexpr int S2_D = 5, S2_R = 6, S2_RW = 8192 + 4096 + 2048 + 1024, S2_GL = 4096 + 2048 + 1024 + 1024, S2_SLOT = S2_RW + S2_GL;
static_assert(S2_R * S2_SLOT <= MISC_OFF, "S2 ring fits in LDS");
__device__ __forceinline__ void s2_issue(LAS unsigned char* lds, int sb, int lw, int lane, size_t ur, size_t ug, int v0r, int v0g,
                                         const unsigned char* GTb, const unsigned char* RHb, const unsigned char* HHb, const unsigned char* YLb,
                                         const unsigned char* QEb, const unsigned char* KVb, const unsigned char* INb, const unsigned char* DDb) {
#pragma unroll
    for (int j = 0; j < 4; ++j) {
        int k = lw * 4 + j; if (k >= 23) k -= 1;
        const unsigned char* src; int ldo;
        if (k < 8) { const int n = k, pu = n * 64 + lane, row = pu >> 3, c16 = (pu & 7) ^ (row & 7);
            src = GTb + ur * 8192 + row * 128 + c16 * 16; ldo = n * 1024; }
        else if (k < 12) { const int n = k - 8, pu = n * 64 + lane, row = pu >> 2, c16 = (pu & 3) ^ (row & 3);
            src = RHb + ur * 4096 + row * 64 + c16 * 16; ldo = 8192 + n * 1024; }
        else if (k < 14) { const int n = k - 12, pu = n * 64 + lane, v = pu >> 3, c16 = (pu & 7) ^ (v & 7);
            src = HHb + ur * 8192 + (size_t)(v0r + v) * 128 + c16 * 16; ldo = 12288 + n * 1024; }
        else if (k < 15) { const int t = lane;
            src = YLb + ur * 4096 + t * 64 + v0r; ldo = 14336; }
        else if (k < 19) { const int n = k - 15, pu = n * 64 + lane, row = pu >> 2, c16 = (pu & 3) ^ (row & 3);
            src = QEb + ug * 4096 + row * 64 + c16 * 16; ldo = S2_RW + n * 1024; }
        else if (k < 21) { const int n = k - 19, pu = n * 64 + lane, v = pu >> 3, c16 = (pu & 7) ^ (v & 7);
            src = KVb + ug * 16384 + (size_t)(v0g + v) * 128 + c16 * 16; ldo = S2_RW + 4096 + n * 1024; }
        else if (k < 22) { const int t = lane;
            src = INb + ug * 8192 + t * 128 + v0g; ldo = S2_RW + 6144; }
        else { src = DDb + ug * 256 + (lane & 15) * 16; ldo = S2_RW + 7168; }
        __builtin_amdgcn_global_load_lds((const unsigned*)src, (LAS unsigned*)(lds + sb + ldo), 16, 0, 0);
    }
}
__device__ __forceinline__ void ph_scan2(Frame& F) {
    const int lane = F.lane, wave = F.wave, rr = lane & 15, q = lane >> 4; unsigned char* ws = F.ws; LAS unsigned char* lds = F.lds;
    const int it = (F.G == 256) ? (int)(blockIdx.x & 7) * 32 + (int)(blockIdx.x >> 3) : (int)blockIdx.x;
    const int sr = it >> 2, v0r = 16 * (it & 3), rb = sr >> 4, rdir = (sr >> 3) & 1, rh = sr & 7;
    const int sg = it >> 3, v0g = 16 * (it & 7), gb = sg >> 3, gdir = (sg >> 2) & 1, gh = sg & 3;
#define S2_BAR() do { asm volatile("s_waitcnt lgkmcnt(0)" ::: "memory"); __builtin_amdgcn_s_barrier(); asm volatile("" ::: "memory"); } while (0)
    if (wave >= 2) {
        const unsigned char* GTb = (const unsigned char*)F.out + OUT_GT; const unsigned char* QEb = (const unsigned char*)F.out + OUT_QE;
        const unsigned char* RHb = ws + WS_RH; const unsigned char* YLb = ws + WS_YL; const unsigned char* HHb = ws + WS_HH; const unsigned char* KVb = ws + WS_KV; const unsigned char* INb = ws + WS_INTRA;
        const unsigned char* DDb = ws + WS_DD;
#define S2_ISSUE(cc) s2_issue(lds, ((cc) % S2_R) * S2_SLOT, wave - 2, lane, (size_t)(sr * NCHUNK + ((cc) < NCHUNK ? (cc) : NCHUNK - 1)), (size_t)(sg * NCHUNK + ((cc) < NCHUNK ? (cc) : NCHUNK - 1)), v0r, v0g, GTb, RHb, HHb, YLb, QEb, KVb, INb, DDb)
        S2_ISSUE(0); S2_ISSUE(1); S2_ISSUE(2); S2_ISSUE(3); S2_ISSUE(4);
#pragma unroll 1
        for (int c = 0; c < NCHUNK; ++c) {
            asm volatile("s_waitcnt vmcnt(16) ; S2WAIT" ::: "memory");
            S2_BAR();
            S2_ISSUE(c + S2_D);
        }
#undef S2_ISSUE
    } else if (wave == 0) {
        bf16* ORW = (bf16*)(ws + (rdir ? WS_ORWB : WS_ORWF));
        f32x4 S[4];
#pragma unroll
        for (int m = 0; m < 4; ++m) S[m] = (f32x4){0.f, 0.f, 0.f, 0.f};
#pragma unroll 1
        for (int c = 0; c < NCHUNK; ++c) {
            S2_BAR();
            const LAS unsigned char* sl = lds + (c % S2_R) * S2_SLOT;
            const bool emit = c >= CTXL / CH;
            bf16x8 G0[4], G1[4]; v2u Hw[4], Rw0[4], Rw1[4]; unsigned Yw[4];
#pragma unroll
            for (int m = 0; m < 4; ++m) { const int k2 = 16 * m + rr;
                G0[m] = *(const LAS bf16x8*)(sl + (k2 * 8 + (q ^ (k2 & 7))) * 16); G1[m] = *(const LAS bf16x8*)(sl + (k2 * 8 + ((4 + q) ^ (k2 & 7))) * 16);
                Hw[m] = *(const LAS v2u*)(sl + 12288 + (rr * 8 + ((2 * m + (q >> 1)) ^ (rr & 7))) * 16 + (q & 1) * 8); }
            if (emit) {
#pragma unroll
                for (int tt = 0; tt < 4; ++tt) { const int t = 16 * tt + rr;
                    Rw0[tt] = *(const LAS v2u*)(sl + 8192 + (t * 4 + ((q >> 1) ^ (t & 3))) * 16 + (q & 1) * 8); Rw1[tt] = *(const LAS v2u*)(sl + 8192 + (t * 4 + ((2 + (q >> 1)) ^ (t & 3))) * 16 + (q & 1) * 8);
                    Yw[tt] = *(const LAS unsigned*)(sl + 14336 + t * 16 + q * 4); }
            }
            const bf16x8 Sf0 = pack_frag(S[0], S[1]), Sf1 = pack_frag(S[2], S[3]);
            __builtin_amdgcn_sched_barrier(0);
#pragma unroll
            for (int m = 0; m < 4; ++m) { f32x4 acc = unpack4(Hw[m]);
                acc = __builtin_amdgcn_mfma_f32_16x16x32_bf16(G0[m], Sf0, acc, 0, 0, 0);
                acc = __builtin_amdgcn_mfma_f32_16x16x32_bf16(G1[m], Sf1, acc, 0, 0, 0);
                S[m] = acc; }
            if (emit) {
#pragma unroll
                for (int tt = 0; tt < 4; ++tt) { const int t = 16 * tt + rr;
                    const bf16x8 R0 = pack_frag(unpack4_fp8(Rw0[tt].x), unpack4_fp8(Rw0[tt].y)), R1 = pack_frag(unpack4_fp8(Rw1[tt].x), unpack4_fp8(Rw1[tt].y));
                    f32x4 acc = unpack4_fp8(Yw[tt]);
                    acc = __builtin_amdgcn_mfma_f32_16x16x32_bf16(Sf0, R0, acc, 0, 0, 0);
                    acc = __builtin_amdgcn_mfma_f32_16x16x32_bf16(Sf1, R1, acc, 0, 0, 0);
                    const int row = scan_row(c * CH + t, rb, rdir);
                    *(v2u*)(ORW + (size_t)row * RWW + rh * 64 + v0r + 4 * q) = pack4(acc); }
            }
        }
    } else {
        bf16* OGL = (bf16*)(ws + (gdir ? WS_OGLB : WS_OGLF));
        f32x4 S[4];
#pragma unroll
        for (int m = 0; m < 4; ++m) S[m] = (f32x4){0.f, 0.f, 0.f, 0.f};
#pragma unroll 1
        for (int c = 0; c < NCHUNK; ++c) {
            S2_BAR();
            const LAS unsigned char* sl = lds + (c % S2_R) * S2_SLOT + S2_RW;
            const bool emit = c >= CTXL / CH;
            v2u Qw0[4], Qw1[4]; unsigned Iw[4]; v4u kw[2]; f32x4 d0[2], d1[2];
#pragma unroll
            for (int s2 = 0; s2 < 2; ++s2) { kw[s2] = *(const LAS v4u*)(sl + 4096 + (rr * 8 + ((4 * s2 + q) ^ (rr & 7))) * 16);
                d0[s2] = *(const LAS f32x4*)(sl + 7168 + 128 * s2 + 32 * q); d1[s2] = *(const LAS f32x4*)(sl + 7168 + 128 * s2 + 32 * q + 16); }
            if (emit) {
#pragma unroll
                for (int tt = 0; tt < 4; ++tt) { const int t = 16 * tt + rr;
                    Qw0[tt] = *(const LAS v2u*)(sl + (t * 4 + ((q >> 1) ^ (t & 3))) * 16 + (q & 1) * 8); Qw1[tt] = *(const LAS v2u*)(sl + (t * 4 + ((2 + (q >> 1)) ^ (t & 3))) * 16 + (q & 1) * 8);
                    Iw[tt] = *(const LAS unsigned*)(sl + 6144 + t * 16 + q * 4); }
            }
            const bf16x8 Sf0 = pack_frag(S[0], S[1]), Sf1 = pack_frag(S[2], S[3]);
            __builtin_amdgcn_sched_barrier(0);
#pragma unroll
            for (int s2 = 0; s2 < 2; ++s2) { S[2 * s2] = S[2 * s2] * d0[s2] + unpack4((v2u){kw[s2].x, kw[s2].y}); S[2 * s2 + 1] = S[2 * s2 + 1] * d1[s2] + unpack4((v2u){kw[s2].z, kw[s2].w}); }
            if (emit) {
#pragma unroll
                for (int tt = 0; tt < 4; ++tt) { const int t = 16 * tt + rr;
                    const bf16x8 Q0 = pack_frag(unpack4_fp8(Qw0[tt].x), unpack4_fp8(Qw0[tt].y)), Q1 = pack_frag(unpack4_fp8(Qw1[tt].x), unpack4_fp8(Qw1[tt].y));
                    f32x4 acc = unpack4_fp8(Iw[tt]);
                    acc = __builtin_amdgcn_mfma_f32_16x16x32_bf16(Sf0, Q0, acc, 0, 0, 0);
                    acc = __builtin_amdgcn_mfma_f32_16x16x32_bf16(Sf1, Q1, acc, 0, 0, 0);
                    const int row = scan_row(c * CH + t, gb, gdir);
                    *(v2u*)(OGL + (size_t)row * RWW + gh * 128 + v0g + 4 * q) = pack4(acc); }
            }
        }
    }
#undef S2_BAR
}
#endif

#ifndef ML
#define ML 0
#endif
enum Phase { PH_PROLOGUE = 0, PH_A1, PH_INPROJ, PH_FEAT, PH_LORA, PH_SCAN1, PH_SCAN2, PH_MERGE, PH_BRANCH, PH_OUTPROJ, PH_LN1, PH_ROUTER, PH_ROUTE, PH_SCATTER, PH_EXP1, PH_EXP2, PH_FINAL, PH_COUNT };

__global__ void __launch_bounds__(NTHR, 2) mega(Args args) {
    extern __shared__ __attribute__((aligned(16))) unsigned char lds_raw[];
    Frame F;
    F.lds = (LAS unsigned char*)lds_raw;
    F.tid = threadIdx.x; F.lane = F.tid & 63; F.wave = __builtin_amdgcn_readfirstlane(F.tid >> 6);
    F.G = gridDim.x; F.gw = blockIdx.x * NWAVES + F.wave; F.NGW = F.G * NWAVES;
    F.in = args.in; F.out = args.out; F.ws = args.ws; F.ctl = (unsigned*)(args.ws + WS_CTL);
    volatile LAS unsigned* MISC = (volatile LAS unsigned*)(F.lds + MISC_OFF);
    if (F.tid < 64) MISC[F.tid] = 0u;
    __syncthreads();
    XcdBarrier bar; bar.bar = F.ctl + CW_BAR; bar.x = 0; bar.st = nullptr;
#if !ML
    bar = xcd_barrier_post(F.ctl + CW_BAR, MISC + 8);
#endif
    const int lo = args.ph_lo, hi = args.ph_hi;
#define IN(k) (lo <= (k) && (k) < hi)
#ifndef DUP
#define DUP -1
#endif
#define RUN(k, call) do { if (IN(k)) { call; GRID_BAR(); if (DUP == (k)) { call; GRID_BAR(); } } } while (0)
#if ML
#define GRID_BAR() do { } while (0)
#else
#define GRID_BAR() xcd_barrier(bar)
#endif

#if MS >= 2
    RUN(PH_PROLOGUE, ph_prologue(F));
#endif
#if MS >= 3
    RUN(PH_A1, ph_a1(F));
    RUN(PH_INPROJ, ph_inproj(F));
    RUN(PH_FEAT, ph_feat(F));
    RUN(PH_LORA, ph_lora(F));
    RUN(PH_SCAN1, ph_scan1(F));
    RUN(PH_SCAN2, ph_scan2(F));
    RUN(PH_MERGE, ph_merge(F));
    RUN(PH_BRANCH, ph_branch(F));
    RUN(PH_OUTPROJ, ph_outproj(F));
#else
    RUN(PH_OUTPROJ, ph_x1pre_nomix(F));
#endif
    RUN(PH_LN1, ph_ln1(F));
#if MS >= 2
    RUN(PH_ROUTER, ph_router(F));
    RUN(PH_ROUTE, ph_route(F));
    RUN(PH_SCATTER, ph_scatter(F));
    RUN(PH_EXP1, ph_exp1(F));
    RUN(PH_EXP2, ph_exp2(F));
#endif
    if (IN(PH_FINAL)) { ph_final(F); }
#undef IN
}

extern "C" void kernel_launch(void* const* d_in, const int* in_sizes, int n_in, void* d_out, int out_size, void* d_ws, size_t ws_size, hipStream_t stream) {
    static int grid = 0;
    if (grid == 0) {
        if (n_in != 36 || out_size != NLAT * D || ws_size < WS_END) { fprintf(stderr, "kernel_launch: unexpected problem shape (n_in %d, out %d)\n", n_in, out_size); grid = -1; return; }
        int dev = 0, cus = 0, per_cu = 0;
        if (hipGetDevice(&dev) != hipSuccess || hipDeviceGetAttribute(&cus, hipDeviceAttributeMultiprocessorCount, dev) != hipSuccess) { grid = -1; return; }
        if (hipFuncSetAttribute((const void*)mega, hipFuncAttributeMaxDynamicSharedMemorySize, LDS_BYTES) != hipSuccess) { fprintf(stderr, "kernel_launch: hipFuncSetAttribute failed\n"); grid = -1; return; }
        if (hipOccupancyMaxActiveBlocksPerMultiprocessor(&per_cu, (const void*)mega, NTHR, LDS_BYTES) != hipSuccess || per_cu < 1) { fprintf(stderr, "kernel_launch: occupancy query says %d\n", per_cu); }
        (void)hipGetLastError();
        grid = cus > 0 ? cus : 256;
        if (grid > 256) grid = 256;
    }
    if (grid < 0) return;
    (void)hipMemsetAsync((char*)d_ws + WS_CTL, 0, CTL_ZERO_BYTES, stream);
    Args a{};
    for (int i = 0; i < 36; ++i) a.in[i] = (const float*)d_in[i];
    a.out = (float*)d_out; a.ws = (unsigned char*)d_ws;
#if ML
    for (int p = 0; p < PH_COUNT; ++p) { a.ph_lo = p; a.ph_hi = p + 1; hipLaunchKernelGGL(mega, dim3(grid), dim3(NTHR), LDS_BYTES, stream, a); }
#else
    a.ph_lo = 0; a.ph_hi = PH_COUNT;
    hipLaunchKernelGGL(mega, dim3(grid), dim3(NTHR), LDS_BYTES, stream, a);
#endif
}
```

```cpp
#include <hip/hip_runtime.h>
#include <cstdio>
#include <cstdint>

#ifndef MS
#define MS 3
#endif

#define GAS __attribute__((address_space(1)))
#define LAS __attribute__((address_space(3)))
typedef unsigned short bf16;
typedef unsigned v4u __attribute__((ext_vector_type(4)));
typedef unsigned v2u __attribute__((ext_vector_type(2)));
typedef float f32x4 __attribute__((ext_vector_type(4)));
typedef float f32x2 __attribute__((ext_vector_type(2)));
typedef short bf16x8 __attribute__((ext_vector_type(8)));
#define LDS_WAIT() asm volatile("s_waitcnt lgkmcnt(0)" ::: "memory")
#define VM_WAIT() asm volatile("s_waitcnt vmcnt(0)" ::: "memory")

constexpr int D = 1024, NB = 4, SEQ = 8192, CTXL = 256, GRIDW = 64, GRIDH = 128;
constexpr int NLAT = NB * SEQ, NCTX = NB * CTXL, MR = NLAT + NCTX;
constexpr int RWW = 512, RWH = 8, HD = 64;
constexpr int C_R = 0, C_K = 512, C_V = 1024, C_PW = 1536, C_PA = 1568, C_PG = 1600, C_Q = 1696, C_KG = 1952, C_VG = 2208, C_PGL = 2720, C_OG = 2736, C_GRW = 3248, C_GGLA = 4272;
constexpr int IN_COLS = 5296, NP = 5376;
constexpr int NE = 256, TOPK = 8, FF = 256;
constexpr float LN_EPS = 1e-5f, RW_GN_EPS = 64e-5f;
constexpr float ALPHA = 1.189207115f;
constexpr float W8S = 64.0f, W8I = 1.0f / 64.0f;
constexpr int NLORA = 3072, KLORA = 256;
constexpr int MAXTILES = 1280, SH_ROW0 = MAXTILES * 256, NROWS_E = SH_ROW0 + NLAT;

namespace pg8 {
#define PG8_LAS __attribute__((address_space(3)))
typedef unsigned short bf16_t;
typedef unsigned u32x4 __attribute__((ext_vector_type(4)));
typedef unsigned u32x2 __attribute__((ext_vector_type(2)));
typedef long i64x2 __attribute__((ext_vector_type(2)));
constexpr int BM = 256, BK = 64, HALF = 128, HTB = HALF * BK * 2, STAGE_BYTES = 8 * HTB, NXCD = 8, WGM = 8;
constexpr int IDX_OFF = STAGE_BYTES, IDX_UNITS = 12;

__host__ __device__ __forceinline__ int lds_byte(int r, int c) { const int st = (r >> 4) * 2 + (c >> 5), rr = r & 15, cc = c & 31, ob = rr * 64 + cc * 2; return st * 1024 + (ob ^ (((ob >> 9) & 1) << 5)); }
__host__ __device__ __forceinline__ void stage_rc(int b, int& R, int& C) { const int st = b / 1024, sb = b % 1024, swz = sb ^ (((sb >> 9) & 1) << 5); R = (st >> 1) * 16 + swz / 64; C = (st & 1) * 32 + (swz % 64) / 2; }
__host__ __device__ __forceinline__ int perm32(int rho) { const int n = rho >> 4, i = rho & 15; return 8 * (i >> 2) + 4 * n + (i & 3); }

struct Unit { int pm, pn, e, j; };
struct Gemm { const bf16_t* A; const bf16_t* Bt; int M, N, K; const int* rowidx; };

struct StaticOrder {
    int nM, nN, nwg, G, c;
    __host__ __device__ void init(int M, int N, int G_, int c_) { nM = M / BM; nN = N / BM; nwg = nM * nN; G = G_; c = c_; }
    __host__ __device__ bool next(int i, Unit& u) const {
        const long L = (long)i * G + c; if (L >= nwg) return false;
        int wgid = (int)L; { const int q = nwg / NXCD, r = nwg % NXCD, xcd = wgid % NXCD, off = wgid / NXCD; wgid = (xcd < r ? xcd * (q + 1) : r * (q + 1) + (xcd - r) * q) + off; }
        const int nig = WGM * nN, gid = wgid / nig, fm = gid * WGM, gsz = (nM - fm) < WGM ? (nM - fm) : WGM;
        u.pm = fm + ((wgid % nig) % gsz); u.pn = (wgid % nig) / gsz; u.e = 0; u.j = u.pn; return true;
    }
};
struct MoeOrder {
    int nN, G, c, NT; const int* tile_e;
    __device__ bool next(int i, Unit& u) const {
        const int L = i * G + c; const int total = (NT + NLAT / 256) * nN; if (L >= total) return false;
        const int tile = L / nN, j = L - tile * nN; int e, pm;
        if (tile < NT) { e = tile_e[tile]; pm = tile; } else { e = NE; pm = MAXTILES + (tile - NT); }
        u.pm = pm; u.pn = e * nN + j; u.e = e; u.j = j; return true;
    }
};

typedef __bf16 bf16x2n __attribute__((ext_vector_type(2))); typedef float f32x2n __attribute__((ext_vector_type(2)));
__device__ __forceinline__ unsigned cvt_pk_bf16(float lo, float hi) { const f32x2n v = {lo, hi}; return __builtin_bit_cast(unsigned, __builtin_convertvector(v, bf16x2n)); }

template <class Epi, class Sched, bool ALIGN_EPI, bool SP2, bool GATHER, bool FP8 = false>
__device__ __forceinline__ void gemm_phase(PG8_LAS unsigned char* lds, const Gemm g, const Sched& S, const Epi& E) {
    const int tid = threadIdx.x, wid = __builtin_amdgcn_readfirstlane(tid >> 6), lane = tid & 63, wr = wid >> 2, wc = wid & 3, fr = lane & 15, fq = lane >> 4;
    const int K = g.K, nt = K / BK;
    const size_t kstep = (size_t)(BK * 2);
    const size_t hstep = (size_t)HALF * K * 2;
    const size_t tstep = 2 * hstep;
    unsigned voffB[2]; unsigned va[2][2];
#pragma unroll
    for (int i = 0; i < 2; ++i) { int R, C; stage_rc(tid * 16 + i * 8192, R, C); const int Rb = Epi::PERM ? ((R & ~31) + perm32(R & 31)) : R;
        voffB[i] = (unsigned)(Rb * K + C) * 2u;
        va[0][i] = (unsigned)(R * K + C) * 2u; va[1][i] = va[0][i]; }
    const size_t ah = GATHER ? (size_t)0 : hstep;
#define PG8_GOFF(dst, ub) do { _Pragma("unroll") for (int _h = 0; _h < 2; ++_h) _Pragma("unroll") for (int _i = 0; _i < 2; ++_i) { int _R, _C; stage_rc(tid * 16 + _i * 8192, _R, _C); \
        dst[_h][_i] = (unsigned)(idxt[(ub) * 256 + _h * 128 + _R] * K + _C) * 2u; } } while (0)
    const unsigned ldsw = (unsigned)wid * 1024u;
    const int aoff = lds_byte(wr * 64 + fr, fq * 8), boff = lds_byte(wc * 32 + fr, fq * 8);
    PG8_LAS int* idxt = (PG8_LAS int*)(lds + IDX_OFF);
#define PG8_SA(b, h) (((b) * 2 + (h)) * HTB)
#define PG8_SB(b, h) ((4 + (b) * 2 + (h)) * HTB)
#define PG8_STAGE(bufoff, gbase, voff) do { _Pragma("unroll") for (int _i = 0; _i < 2; ++_i) \
        __builtin_amdgcn_global_load_lds((const unsigned*)((const char*)(gbase) + (voff)[_i]), (PG8_LAS unsigned*)(lds + (bufoff) + ldsw + _i * 8192), 16, 0, 0); } while (0)
#define PG8_LDA(dst, b, h) do { _Pragma("unroll") for (int m = 0; m < 4; ++m) _Pragma("unroll") for (int k = 0; k < 2; ++k) dst[m][k] = *(const PG8_LAS bf16x8*)(lds + PG8_SA(b, h) + aoff + m * 2048 + k * 1024); } while (0)
#define PG8_LDB(dst, b, h) do { _Pragma("unroll") for (int n = 0; n < 2; ++n) _Pragma("unroll") for (int k = 0; k < 2; ++k) dst[n][k] = *(const PG8_LAS bf16x8*)(lds + PG8_SB(b, h) + boff + n * 2048 + k * 1024); } while (0)
#define PG8_MMA(ai, bj, At, Bt) do { __builtin_amdgcn_s_setprio(1); _Pragma("unroll") for (int m = 0; m < 4; ++m) _Pragma("unroll") for (int n = 0; n < 2; ++n) _Pragma("unroll") for (int k = 0; k < 2; ++k) { \
        if constexpr (FP8) { const i64x2 _b = __builtin_bit_cast(i64x2, Bt[n][k]), _a = __builtin_bit_cast(i64x2, At[m][k]); \
            acc[ai][bj][m][n] = __builtin_amdgcn_mfma_f32_16x16x32_fp8_fp8(_b[0], _a[0], acc[ai][bj][m][n], 0, 0, 0); acc[ai][bj][m][n] = __builtin_amdgcn_mfma_f32_16x16x32_fp8_fp8(_b[1], _a[1], acc[ai][bj][m][n], 0, 0, 0); } \
        else acc[ai][bj][m][n] = __builtin_amdgcn_mfma_f32_16x16x32_bf16(Bt[n][k], At[m][k], acc[ai][bj][m][n], 0, 0, 0); } __builtin_amdgcn_s_setprio(0); } while (0)
#define PG8_WAIT_V(n) asm volatile("s_waitcnt vmcnt(" #n ")" ::: "memory")
#define PG8_WAIT_L(n) asm volatile("s_waitcnt lgkmcnt(" #n ")" ::: "memory")
#define PG8_BAR __builtin_amdgcn_s_barrier()
#define PG8_SCHED __builtin_amdgcn_sched_barrier(0)
    Unit cur, nxt; int ui = 0;
    if (!S.next(0, cur)) return;
#ifdef GEMM_STAGGER
    if constexpr (FP8) {
        const unsigned long long t0 = __builtin_amdgcn_s_memrealtime(); const unsigned long long dl = (unsigned long long)(blockIdx.x & 3) * GEMM_STAGGER;
        while (__builtin_amdgcn_s_memrealtime() - t0 < dl) __builtin_amdgcn_s_sleep(8);
    }
#endif
    if constexpr (GATHER) {
        Unit uu;
        for (int i = 0; i < IDX_UNITS; ++i) { if (!S.next(i, uu)) break; if (tid < 256) idxt[i * 256 + tid] = g.rowidx[(size_t)uu.pm * 256 + tid]; }
        asm volatile("s_waitcnt vmcnt(0) lgkmcnt(0)" ::: "memory"); PG8_BAR; asm volatile("" ::: "memory");
        PG8_GOFF(va, 0);
    }
    f32x4 acc[2][2][4][2];
#pragma unroll
    for (int a = 0; a < 2; ++a)
#pragma unroll
        for (int b = 0; b < 2; ++b)
#pragma unroll
            for (int m = 0; m < 4; ++m)
#pragma unroll
                for (int n = 0; n < 2; ++n) acc[a][b][m][n] = (f32x4){0.f, 0.f, 0.f, 0.f};
    bf16x8 At[4][2], B0[2][2], B1[2][2];
    const char* cA = (const char*)g.A + (GATHER ? (size_t)0 : (size_t)cur.pm * tstep); const char* cB = (const char*)g.Bt + (size_t)cur.pn * tstep;
    if constexpr (SP2) {
        PG8_STAGE(PG8_SB(0, 0), cB, voffB); PG8_STAGE(PG8_SB(0, 1), cB + hstep, voffB); PG8_STAGE(PG8_SA(0, 0), cA, va[0]); PG8_STAGE(PG8_SA(0, 1), cA + ah, va[1]);
        if (wr == 1) PG8_BAR;
        PG8_WAIT_V(2); PG8_BAR;
        PG8_STAGE(PG8_SB(1, 0), cB + kstep, voffB); PG8_STAGE(PG8_SA(1, 0), cA + kstep, va[0]); PG8_STAGE(PG8_SB(1, 1), cB + hstep + kstep, voffB);
        PG8_WAIT_V(6); PG8_BAR;
    } else {
        PG8_STAGE(PG8_SB(0, 0), cB, voffB); PG8_STAGE(PG8_SA(0, 0), cA, va[0]); PG8_STAGE(PG8_SB(0, 1), cB + hstep, voffB); PG8_STAGE(PG8_SA(0, 1), cA + ah, va[1]);
        if (wr == 1) PG8_BAR;
        PG8_WAIT_V(4); PG8_BAR;
        PG8_STAGE(PG8_SB(1, 0), cB + kstep, voffB); PG8_STAGE(PG8_SA(1, 0), cA + kstep, va[0]); PG8_STAGE(PG8_SB(1, 1), cB + hstep + kstep, voffB);
        PG8_WAIT_V(6); PG8_BAR;
    }
    for (;;) {
        const bool has_next = S.next(ui + 1, nxt);
        const char* nA = has_next ? (const char*)g.A + (GATHER ? (size_t)0 : (size_t)nxt.pm * tstep) : cA; const char* nB = has_next ? (const char*)g.Bt + (size_t)nxt.pn * tstep : cB;
        const int ubn = (has_next && ui + 1 < IDX_UNITS) ? (ui + 1) : ui;
#pragma unroll 1
        for (int t = 0; t < nt; t += 2) {
            const bool last = (t == nt - 2);
            const char* a1 = cA + (size_t)(t + 1) * kstep;
            const char* a2 = last ? nA : cA + (size_t)(t + 2) * kstep; const char* b2 = last ? nB : cB + (size_t)(t + 2) * kstep;
            const char* a3 = a2 + kstep; const char* b3 = b2 + kstep;
            unsigned v2[2][2];
#pragma unroll
            for (int h = 0; h < 2; ++h)
#pragma unroll
                for (int i = 0; i < 2; ++i) v2[h][i] = va[h][i];
            if constexpr (GATHER) { if (last) PG8_GOFF(v2, ubn); }
            if constexpr (SP2) {
            PG8_LDB(B0, 0, 0); PG8_LDB(B1, 0, 1); PG8_SCHED; PG8_LDA(At, 0, 0); PG8_STAGE(PG8_SA(1, 1), a1 + ah, va[1]);
            PG8_WAIT_V(8); PG8_WAIT_L(0); PG8_BAR; PG8_MMA(0, 0, At, B0); PG8_MMA(0, 1, At, B1); PG8_BAR; PG8_SCHED;
            PG8_LDA(At, 0, 1); PG8_STAGE(PG8_SB(0, 0), b2, voffB); PG8_STAGE(PG8_SB(0, 1), b2 + hstep, voffB); PG8_STAGE(PG8_SA(0, 0), a2, v2[0]);
            PG8_WAIT_V(8); PG8_WAIT_L(0); PG8_BAR; PG8_MMA(1, 0, At, B0); PG8_MMA(1, 1, At, B1); PG8_BAR; PG8_SCHED;
            PG8_LDB(B0, 1, 0); PG8_LDB(B1, 1, 1); PG8_SCHED; PG8_LDA(At, 1, 0); PG8_STAGE(PG8_SA(0, 1), a2 + ah, v2[1]);
            PG8_WAIT_V(8); PG8_WAIT_L(0); PG8_BAR; PG8_MMA(0, 0, At, B0); PG8_MMA(0, 1, At, B1); PG8_BAR; PG8_SCHED;
            PG8_LDA(At, 1, 1); PG8_STAGE(PG8_SB(1, 0), b3, voffB); PG8_STAGE(PG8_SB(1, 1), b3 + hstep, voffB); PG8_STAGE(PG8_SA(1, 0), a3, v2[0]);
            PG8_WAIT_V(8); PG8_WAIT_L(0); PG8_BAR; PG8_MMA(1, 0, At, B0); PG8_MMA(1, 1, At, B1); PG8_BAR; PG8_SCHED;
            } else {
            PG8_LDB(B0, 0, 0); PG8_SCHED; PG8_LDA(At, 0, 0); PG8_STAGE(PG8_SA(1, 1), a1 + ah, va[1]);
            PG8_WAIT_L(8); PG8_BAR; PG8_WAIT_L(0); PG8_MMA(0, 0, At, B0); PG8_BAR; PG8_SCHED;
            PG8_LDB(B1, 0, 1); PG8_STAGE(PG8_SB(0, 0), b2, voffB);
            PG8_BAR; PG8_WAIT_L(0); PG8_MMA(0, 1, At, B1); PG8_BAR;
            PG8_LDA(At, 0, 1); PG8_STAGE(PG8_SA(0, 0), a2, v2[0]);
            PG8_BAR; PG8_WAIT_L(0); PG8_MMA(1, 0, At, B0); PG8_BAR; PG8_SCHED;
            PG8_STAGE(PG8_SB(0, 1), b2 + hstep, voffB);
            PG8_WAIT_V(6); PG8_BAR; PG8_MMA(1, 1, At, B1); PG8_BAR;
            PG8_LDB(B0, 1, 0); PG8_SCHED; PG8_LDA(At, 1, 0); PG8_STAGE(PG8_SA(0, 1), a2 + ah, v2[1]);
            PG8_WAIT_L(8); PG8_BAR; PG8_WAIT_L(0); PG8_MMA(0, 0, At, B0); PG8_BAR; PG8_SCHED;
            PG8_LDB(B1, 1, 1); PG8_STAGE(PG8_SB(1, 0), b3, voffB);
            PG8_BAR; PG8_WAIT_L(0); PG8_MMA(0, 1, At, B1); PG8_BAR;
            PG8_LDA(At, 1, 1); PG8_STAGE(PG8_SA(1, 0), a3, v2[0]);
            PG8_BAR; PG8_WAIT_L(0); PG8_MMA(1, 0, At, B0); PG8_BAR; PG8_SCHED;
            PG8_STAGE(PG8_SB(1, 1), b3 + hstep, voffB);
            PG8_WAIT_V(6); PG8_BAR; PG8_MMA(1, 1, At, B1); PG8_BAR;
            }
        }
        if constexpr (ALIGN_EPI) { if (wr == 0) PG8_BAR; }
        E(acc, cur, wr, wc, fr, fq);
        if (!has_next) break;
#pragma unroll
        for (int a = 0; a < 2; ++a)
#pragma unroll
            for (int b = 0; b < 2; ++b)
#pragma unroll
                for (int m = 0; m < 4; ++m)
#pragma unroll
                    for (int n = 0; n < 2; ++n) acc[a][b][m][n] = (f32x4){0.f, 0.f, 0.f, 0.f};
        cur = nxt; cA = nA; cB = nB; ++ui;
        if constexpr (GATHER) PG8_GOFF(va, ubn);
        if constexpr (ALIGN_EPI) { if (wr == 1) PG8_BAR; }
    }
    PG8_WAIT_V(0);
    if constexpr (!ALIGN_EPI) { if (wr == 0) PG8_BAR; }
    PG8_BAR;
#undef PG8_SA
#undef PG8_GOFF
#undef PG8_SB
#undef PG8_STAGE
#undef PG8_LDA
#undef PG8_LDB
#undef PG8_MMA
#undef PG8_WAIT_V
#undef PG8_WAIT_L
#undef PG8_BAR
#undef PG8_SCHED
}
}

#define XB_TMO      128
#define XB_XCNT(j)  (256  + 64 * (j))
#define XB_XSUB(j)  (1280 + 64 * (j))
#define XB_XGEN(j)  (2304 + 64 * (j))
#define XB_TOP      3328
#define XB_TOPGEN   3392
#define XCD_BAR_WORDS 3456
#define XB_SPIN_CAP (1u << 18)
__device__ __forceinline__ unsigned xb_ld(unsigned* p)              { return __hip_atomic_load(p, __ATOMIC_RELAXED, __HIP_MEMORY_SCOPE_AGENT); }
__device__ __forceinline__ unsigned xb_add(unsigned* p, unsigned v) { return __hip_atomic_fetch_add(p, v, __ATOMIC_RELAXED, __HIP_MEMORY_SCOPE_AGENT); }
__device__ __forceinline__ unsigned xb_xcc_id() { return (unsigned)__builtin_amdgcn_s_getreg((3 << 11) | 20) & 0xFu; }
#define XB_SPIN(cond, bar) do { unsigned _sp = 0; while (cond) { __builtin_amdgcn_s_sleep(1); \
    if ((++_sp & 255u) == 0u) { if (xb_ld(&(bar)[XB_TMO])) break; if (_sp > XB_SPIN_CAP) { atomicAdd(&(bar)[XB_TMO], 1u); break; } } } } while (0)
struct XcdBarrier { unsigned* bar; unsigned x; volatile LAS unsigned* st; };
__device__ __forceinline__ XcdBarrier xcd_barrier_post(unsigned* bar, volatile LAS unsigned* st) {
    XcdBarrier b; b.bar = bar; b.x = xb_xcc_id(); b.st = st;
    if (threadIdx.x == 0) (void)xb_add(&bar[XB_XCNT(b.x)], 1u);
    return b;
}
__device__ __forceinline__ void xcd_barrier_complete(unsigned* bar, unsigned x, unsigned& nloc, unsigned& nx) {
    const unsigned G = gridDim.x * gridDim.y * gridDim.z;
    unsigned sum, cnt, mine, sp = 0u;
    for (;;) {
        sum = 0u; cnt = 0u; mine = 0u;
#pragma unroll
        for (unsigned j = 0; j < 16; ++j) { const unsigned c = xb_ld(&bar[XB_XCNT(j)]); sum += c; cnt += (c > 0u) ? 1u : 0u; mine = (j == x) ? c : mine; }
        if (sum == G) break;
        __builtin_amdgcn_s_sleep(1);
        if ((++sp & 255u) == 0u) { if (xb_ld(&bar[XB_TMO])) break; if (sp > XB_SPIN_CAP) { atomicAdd(&bar[XB_TMO], 1u); break; } }
    }
    nloc = mine > 0u ? mine : 1u; nx = cnt > 0u ? cnt : 1u;
}
__device__ __forceinline__ void xcd_barrier(const XcdBarrier& b) {
    asm volatile("s_waitcnt vmcnt(0)" ::: "memory");
    __syncthreads();
    if (threadIdx.x == 0) {
        unsigned* bar = b.bar;
        __builtin_amdgcn_s_waitcnt(0);
        unsigned nloc = b.st[0], nx = b.st[1];
        if (nloc == 0u) { xcd_barrier_complete(bar, b.x, nloc, nx); b.st[0] = nloc; b.st[1] = nx; }
        const unsigned old = xb_add(&bar[XB_XSUB(b.x)], 1u);
        const unsigned gen = old / nloc;
        if (old + 1u == (gen + 1u) * nloc) {
            __builtin_amdgcn_fence(__ATOMIC_RELEASE, "agent");
            asm volatile("s_waitcnt vmcnt(0)" ::: "memory");
            const unsigned og = xb_add(&bar[XB_TOP], 1u);
            const unsigned tg = og / nx;
            if (og + 1u == (tg + 1u) * nx) xb_add(&bar[XB_TOPGEN], 1u);
            else XB_SPIN(xb_ld(&bar[XB_TOPGEN]) == tg, bar);
            __builtin_amdgcn_fence(__ATOMIC_ACQUIRE, "agent");
            xb_add(&bar[XB_XGEN(b.x)], 1u);
            asm volatile("s_waitcnt vmcnt(0)" ::: "memory");
        } else {
            XB_SPIN(xb_ld(&bar[XB_XGEN(b.x)]) == gen, bar);
            __builtin_amdgcn_fence(__ATOMIC_ACQUIRE, "agent");
            asm volatile("s_waitcnt vmcnt(0)" ::: "memory");
        }
    }
    __syncthreads();
}

constexpr size_t MiB = 1u << 20;
constexpr size_t al(size_t x) { return (x + 4095) & ~(size_t)4095; }
constexpr size_t WS_CTL = 0, CTL_ZERO_BYTES = 1 * MiB;
constexpr int CW_BAR = 4096;
constexpr int CW_CNT = 16384, CNT_STRIDE = 64;
constexpr int CW_NT = CW_CNT + NE * CNT_STRIDE + 64;
static_assert((CW_NT + 1) * 4 <= (int)CTL_ZERO_BYTES, "control words inside the per-call memset");
constexpr size_t WS_MOD = 1 * MiB;
constexpr size_t WS_TILE_E = WS_MOD + 256 * 1024;
constexpr size_t WS_PADSTART = WS_TILE_E + 16 * 1024;
constexpr size_t WS_ROWTOK = 2 * MiB;
constexpr size_t WS_EIDX = 4 * MiB;
constexpr size_t WS_GATE = 5 * MiB;
constexpr size_t WS_DEST = 6 * MiB;
constexpr size_t WS_WIN = 8 * MiB;
constexpr size_t WS_WLORA = WS_WIN + al((size_t)NP * D * 2);
constexpr size_t WS_WBRRW = WS_WLORA + al((size_t)NLORA * KLORA * 2);
constexpr size_t WS_WBRGLA = WS_WBRRW + al((size_t)D * RWW * 2);
constexpr size_t WS_WOUT = WS_WBRGLA + al((size_t)D * RWW * 2);
constexpr size_t WS_WROUTER = WS_WOUT + al((size_t)D * D * 2);
constexpr size_t WS_WGU = WS_WROUTER + al((size_t)NE * D * 2);
constexpr size_t WS_WD = WS_WGU + al((size_t)(NE + 1) * 512 * D * 2);
constexpr size_t WS_PERSIST_END = WS_WD + al((size_t)(NE + 1) * D * FF * 2);
constexpr size_t WS_REGB = WS_PERSIST_END;
constexpr size_t SZ512F = al((size_t)MR * RWW * 4), SZ256F = al((size_t)MR * 256 * 4), SZ512H = al((size_t)MR * RWW * 2);
constexpr size_t WS_A1 = WS_REGB;
constexpr size_t WS_A2 = WS_A1;
constexpr size_t WS_KSUM = WS_A2 + al((size_t)MR * KLORA * 2);
static_assert(WS_KSUM + SZ512H <= WS_A1 + al((size_t)MR * D * 2), "A2 + KSUM fit in the A1 slot");
constexpr size_t WS_P = WS_A1 + al((size_t)MR * D * 2);
constexpr size_t WS_RB = WS_P + al((size_t)MR * NP * 2);
constexpr size_t WS_VB = WS_RB + SZ512H, WS_KKB = WS_VB + SZ512H, WS_KMF = WS_KKB + SZ512H, WS_KMB = WS_KMF + SZ512H, WS_BVF = WS_KMB + SZ512H, WS_BVB = WS_BVF + SZ512H;
constexpr size_t WS_LWF = WS_BVB + SZ512H, WS_LWB = WS_LWF + SZ512F;
constexpr size_t SZ256H = al((size_t)MR * 256 * 2);
constexpr size_t WS_QGB = WS_LWB + SZ512F, WS_KGB = WS_QGB + SZ256H, WS_VGB = WS_KGB + SZ256H, WS_LAF = WS_VGB + SZ512H, WS_LAB = WS_LAF + SZ256F;
constexpr size_t WS_RWG = WS_LAB + SZ256F;
constexpr size_t WS_ORWF = WS_RWG + SZ512H, WS_ORWB = WS_ORWF + SZ512H, WS_OGLF = WS_ORWB + SZ512H, WS_OGLB = WS_OGLF + SZ512H;
constexpr int CH = 64, NCHUNK = (CTXL + SEQ) / CH, NU_RW = 64 * NCHUNK, NU_GL = 32 * NCHUNK;
constexpr size_t WS_RH = WS_OGLB + SZ512H;
constexpr size_t WS_YL = WS_RH + al((size_t)NU_RW * 4096 * 2);
constexpr size_t WS_HH = WS_YL + al((size_t)NU_RW * 4096 * 2);
constexpr size_t WS_INTRA = WS_HH + al((size_t)NU_RW * 4096 * 2);
constexpr size_t WS_KV = WS_INTRA + al((size_t)NU_GL * 8192 * 2);
constexpr size_t WS_DD = WS_KV + al((size_t)NU_GL * 8192 * 2);
constexpr size_t WS_END_MIX = WS_DD + al((size_t)NU_GL * 64 * 4);
constexpr size_t OUT_GT = 0, OUT_QE = (size_t)NU_RW * 4096 * 2;
static_assert(OUT_QE + (size_t)NU_GL * 4096 * 2 <= (size_t)NLAT * D * 4, "scan scratch fits in d_out");
constexpr size_t WS_YRW = WS_LWF, WS_YGLA = WS_LWB, WS_Z = WS_HH;
static_assert((size_t)NLAT * D * 2 <= (size_t)NU_RW * 4096 * 2, "Z fits in the HH slot");
constexpr size_t WS_X1 = WS_REGB;
constexpr size_t WS_A3 = WS_X1 + al((size_t)NLAT * D * 4);
constexpr size_t WS_LOGITS = WS_A3 + al((size_t)NLAT * D * 2);
constexpr size_t WS_ACT = WS_LOGITS + al((size_t)NLAT * NE * 4);
constexpr size_t WS_Y = WS_ACT + al((size_t)NROWS_E * FF * 2);
constexpr size_t WS_A3F = WS_Y + al((size_t)NROWS_E * D);
constexpr size_t WS_END_MOE = WS_A3F + al((size_t)NLAT * D);
constexpr size_t WS_END = WS_END_MIX > WS_END_MOE ? WS_END_MIX : WS_END_MOE;
static_assert(WS_END <= (size_t)2048 * MiB, "workspace map exceeds 2 GiB");

constexpr int RING_BYTES = 131072;
constexpr int IDX_BYTES = pg8::IDX_UNITS * 256 * 4;
constexpr int MISC_OFF = RING_BYTES + IDX_BYTES;
constexpr int LDS_BYTES = MISC_OFF + 256;
static_assert(pg8::IDX_OFF == RING_BYTES, "gather table sits right above the stage buffers");
constexpr int NWAVES = 8, NTHR = 512;

struct Args { const float* in[36]; float* out; unsigned char* ws; int ph_lo, ph_hi; };

struct Frame {
    LAS unsigned char* lds;
    int tid, lane, wave, G, gw, NGW;
    const float* const* in; float* out; unsigned char* ws; unsigned* ctl;
};

__device__ __forceinline__ float wave_sum(float v) {
#pragma unroll
    for (int o = 1; o < 64; o <<= 1) v += __shfl_xor(v, o);
    return v;
}
__device__ __forceinline__ unsigned f2bf(float f) { unsigned u = __builtin_bit_cast(unsigned, f); return (u + 0x7fffu + ((u >> 16) & 1u)) >> 16; }
typedef __bf16 bf16x2v __attribute__((ext_vector_type(2)));
__device__ __forceinline__ unsigned pk2(float lo, float hi) { const f32x2 v = {lo, hi}; return __builtin_bit_cast(unsigned, __builtin_convertvector(v, bf16x2v)); }
__device__ __forceinline__ float bflo(unsigned w) { return __builtin_bit_cast(float, w << 16); }
__device__ __forceinline__ float bfhi(unsigned w) { return __builtin_bit_cast(float, w & 0xffff0000u); }
__device__ __forceinline__ float sigmoidf_(float x) { return __builtin_amdgcn_rcpf(1.0f + __expf(-x)); }
__device__ __forceinline__ float siluf_(float x) { return x * __builtin_amdgcn_rcpf(1.0f + __expf(-x)); }
__device__ __forceinline__ float tanhf_(float x) { return 1.0f - 2.0f * __builtin_amdgcn_rcpf(1.0f + __expf(2.0f * x)); }
__device__ __forceinline__ float logsigmoidf_(float x) { return fminf(x, 0.f) - __logf(1.0f + __expf(-fabsf(x))); }

__device__ __forceinline__ void ln_stats(const f32x4 (&v)[4], float& mean, float& rstd) {
    float s = 0.f;
#pragma unroll
    for (int j = 0; j < 4; ++j) s += (v[j].x + v[j].y) + (v[j].z + v[j].w);
    mean = wave_sum(s) * (1.f / D); float s2 = 0.f;
#pragma unroll
    for (int j = 0; j < 4; ++j) { const f32x4 d = v[j] - mean; s2 += (d.x * d.x + d.y * d.y) + (d.z * d.z + d.w * d.w); }
    rstd = __builtin_amdgcn_rsqf(wave_sum(s2) * (1.f / D) + LN_EPS);
}

__device__ __forceinline__ unsigned pack_fp8x4(const f32x4 v) {
    int w = __builtin_amdgcn_cvt_pk_fp8_f32(__builtin_amdgcn_fmed3f(v[0], -448.f, 448.f), __builtin_amdgcn_fmed3f(v[1], -448.f, 448.f), 0, false);
    return (unsigned)__builtin_amdgcn_cvt_pk_fp8_f32(__builtin_amdgcn_fmed3f(v[2], -448.f, 448.f), __builtin_amdgcn_fmed3f(v[3], -448.f, 448.f), w, true); }
__device__ __forceinline__ void ld_row_bf16(const bf16* row, int lane, f32x4 (&v)[4]) {
    const v4u a = *(const v4u*)(row + 8 * lane), b = *(const v4u*)(row + 512 + 8 * lane);
    v[0] = (f32x4){bflo(a.x), bfhi(a.x), bflo(a.y), bfhi(a.y)}; v[1] = (f32x4){bflo(a.z), bfhi(a.z), bflo(a.w), bfhi(a.w)};
    v[2] = (f32x4){bflo(b.x), bfhi(b.x), bflo(b.y), bfhi(b.y)}; v[3] = (f32x4){bflo(b.z), bfhi(b.z), bflo(b.w), bfhi(b.w)};
}
__device__ __forceinline__ int rowcol(int lane, int j) { return 512 * (j >> 1) + 8 * lane + 4 * (j & 1); }
__device__ __forceinline__ void ph_x1pre_nomix(Frame& F) {
    const float* x = F.in[0];
    for (int m = F.gw; m < NLAT; m += F.NGW) {
        bf16* o = (bf16*)(F.ws + WS_X1) + (size_t)m * D;
#pragma unroll
        for (int h = 0; h < 2; ++h) { const float* xr = x + (size_t)m * D + 512 * h + 8 * F.lane; const f32x4 a = *(const f32x4*)xr * ALPHA, b = *(const f32x4*)(xr + 4) * ALPHA;
            v4u w; w.x = pk2(a.x, a.y); w.y = pk2(a.z, a.w); w.z = pk2(b.x, b.y); w.w = pk2(b.z, b.w); *(v4u*)(o + 512 * h + 8 * F.lane) = w; }
    }
}
__device__ __forceinline__ void ph_ln1(Frame& F) {
    const float* lw = F.in[26]; const float* lb = F.in[27]; const float* mod = (const float*)(F.ws + WS_MOD);
    bf16* A3 = (bf16*)(F.ws + WS_A3); const bf16* X1P = (const bf16*)(F.ws + WS_X1);
    constexpr int NR = 4;
    for (int m0 = F.gw; m0 < NLAT; m0 += NR * F.NGW) {
        v4u w[NR][2];
#pragma unroll
        for (int r = 0; r < NR; ++r) { const int mm = m0 + r * F.NGW; const bf16* row = X1P + (size_t)(mm < NLAT ? mm : m0) * D; w[r][0] = *(const v4u*)(row + 8 * F.lane); w[r][1] = *(const v4u*)(row + 512 + 8 * F.lane); }
        __builtin_amdgcn_sched_barrier(0);
#pragma unroll
        for (int r = 0; r < NR; ++r) { const int mm = m0 + r * F.NGW; const int m = mm < NLAT ? mm : m0; const int b = m / SEQ;
            f32x4 v[4];
            v[0] = (f32x4){bflo(w[r][0].x), bfhi(w[r][0].x), bflo(w[r][0].y), bfhi(w[r][0].y)}; v[1] = (f32x4){bflo(w[r][0].z), bfhi(w[r][0].z), bflo(w[r][0].w), bfhi(w[r][0].w)};
            v[2] = (f32x4){bflo(w[r][1].x), bfhi(w[r][1].x), bflo(w[r][1].y), bfhi(w[r][1].y)}; v[3] = (f32x4){bflo(w[r][1].z), bfhi(w[r][1].z), bflo(w[r][1].w), bfhi(w[r][1].w)};
            float mean, rstd; ln_stats(v, mean, rstd);
#if MS >= 2
            f32x4 h[4];
#pragma unroll
            for (int j = 0; j < 4; ++j) { const int c = rowcol(F.lane, j);
                const f32x4 x1 = (v[j] - mean) * rstd * *(const f32x4*)(lw + c) + *(const f32x4*)(lb + c);
                h[j] = x1 * (*(const f32x4*)(mod + b * 6144 + 4096 + c) + 1.0f) + *(const f32x4*)(mod + b * 6144 + 3072 + c); }
            bf16* ao = A3 + (size_t)m * D;
            { v4u o; o.x = pk2(h[0].x, h[0].y); o.y = pk2(h[0].z, h[0].w); o.z = pk2(h[1].x, h[1].y); o.w = pk2(h[1].z, h[1].w); *(v4u*)(ao + 8 * F.lane) = o;
              o.x = pk2(h[2].x, h[2].y); o.y = pk2(h[2].z, h[2].w); o.z = pk2(h[3].x, h[3].y); o.w = pk2(h[3].z, h[3].w); *(v4u*)(ao + 512 + 8 * F.lane) = o; }
            { unsigned char* af = F.ws + WS_A3F + (size_t)m * D; v2u o8;
              o8.x = pack_fp8x4(h[0]); o8.y = pack_fp8x4(h[1]); *(v2u*)(af + 8 * F.lane) = o8; o8.x = pack_fp8x4(h[2]); o8.y = pack_fp8x4(h[3]); *(v2u*)(af + 512 + 8 * F.lane) = o8; }
#endif
        }
    }
}
__device__ __forceinline__ f32x4 fp8x4(unsigned w) { const f32x2 lo = __builtin_amdgcn_cvt_pk_f32_fp8((int)w, false), hi = __builtin_amdgcn_cvt_pk_f32_fp8((int)w, true); return (f32x4){lo.x, lo.y, hi.x, hi.y}; }
__device__ __forceinline__ void ph_final(Frame& F) {
    const float* lw = F.in[34]; const float* lb = F.in[35]; const float* mod = (const float*)(F.ws + WS_MOD);
    const float* lw1 = F.in[26]; const float* lb1 = F.in[27]; const bf16* X1P = (const bf16*)(F.ws + WS_X1);
    const unsigned char* Y = F.ws + WS_Y; const int* DEST = (const int*)(F.ws + WS_DEST); const float* GATE = (const float*)(F.ws + WS_GATE);
    const int c0 = 16 * F.lane;
    for (int m0 = F.gw; m0 < NLAT; m0 += 2 * F.NGW) {
        int mm[2]; mm[0] = m0; mm[1] = (m0 + F.NGW < NLAT) ? m0 + F.NGW : m0;
        v4u xw[2][2];
#if MS >= 2
        v4u dw[2][2]; f32x4 gw[2][2];
#pragma unroll
        for (int r = 0; r < 2; ++r) { dw[r][0] = *(const v4u*)(DEST + mm[r] * 8); dw[r][1] = *(const v4u*)(DEST + mm[r] * 8 + 4); gw[r][0] = *(const f32x4*)(GATE + mm[r] * 8); gw[r][1] = *(const f32x4*)(GATE + mm[r] * 8 + 4); }
#endif
#pragma unroll
        for (int r = 0; r < 2; ++r) { const bf16* row = X1P + (size_t)mm[r] * D + c0; xw[r][0] = *(const v4u*)row; xw[r][1] = *(const v4u*)(row + 8); }
#if MS >= 2
        v4u yw[2][TOPK + 1];
#pragma unroll
        for (int r = 0; r < 2; ++r) {
            int dr[TOPK]; dr[0] = (int)dw[r][0].x; dr[1] = (int)dw[r][0].y; dr[2] = (int)dw[r][0].z; dr[3] = (int)dw[r][0].w; dr[4] = (int)dw[r][1].x; dr[5] = (int)dw[r][1].y; dr[6] = (int)dw[r][1].z; dr[7] = (int)dw[r][1].w;
#pragma unroll
            for (int k = 0; k <= TOPK; ++k) yw[r][k] = *(const v4u*)(Y + (size_t)(k < TOPK ? dr[k < TOPK ? k : 0] : SH_ROW0 + mm[r]) * D + c0); }
        __builtin_amdgcn_sched_barrier(0);
#endif
#pragma unroll
        for (int r = 0; r < 2; ++r) { const int m = mm[r]; const int b = m / SEQ;
            f32x4 v[4];
            v[0] = (f32x4){bflo(xw[r][0].x), bfhi(xw[r][0].x), bflo(xw[r][0].y), bfhi(xw[r][0].y)}; v[1] = (f32x4){bflo(xw[r][0].z), bfhi(xw[r][0].z), bflo(xw[r][0].w), bfhi(xw[r][0].w)};
            v[2] = (f32x4){bflo(xw[r][1].x), bfhi(xw[r][1].x), bflo(xw[r][1].y), bfhi(xw[r][1].y)}; v[3] = (f32x4){bflo(xw[r][1].z), bfhi(xw[r][1].z), bflo(xw[r][1].w), bfhi(xw[r][1].w)};
            { float mean1, rstd1; ln_stats(v, mean1, rstd1);
#pragma unroll
              for (int j = 0; j < 4; ++j) { const int c = c0 + 4 * j; v[j] = ((v[j] - mean1) * rstd1 * *(const f32x4*)(lw1 + c) + *(const f32x4*)(lb1 + c)) * ALPHA; } }
#if MS >= 2
            const float gt[TOPK] = {gw[r][0].x * 0.0625f, gw[r][0].y * 0.0625f, gw[r][0].z * 0.0625f, gw[r][0].w * 0.0625f, gw[r][1].x * 0.0625f, gw[r][1].y * 0.0625f, gw[r][1].z * 0.0625f, gw[r][1].w * 0.0625f};
#pragma unroll
            for (int j = 0; j < 4; ++j) { const unsigned ws8 = j == 0 ? yw[r][TOPK].x : (j == 1 ? yw[r][TOPK].y : (j == 2 ? yw[r][TOPK].z : yw[r][TOPK].w));
                f32x4 mo = fp8x4(ws8) * 0.0625f;
#pragma unroll
                for (int k = 0; k < TOPK; ++k) { const unsigned wk = j == 0 ? yw[r][k].x : (j == 1 ? yw[r][k].y : (j == 2 ? yw[r][k].z : yw[r][k].w)); mo += fp8x4(wk) * gt[k]; }
                v[j] += *(const f32x4*)(mod + b * 6144 + 5120 + c0 + 4 * j) * mo; }
#endif
            float mean, rstd; ln_stats(v, mean, rstd);
            float* o = F.out + (size_t)m * D + c0;
#pragma unroll
            for (int j = 0; j < 4; ++j) { const int c = c0 + 4 * j; *(f32x4*)(o + 4 * j) = (v[j] - mean) * rstd * *(const f32x4*)(lw + c) + *(const f32x4*)(lb + c); }
        }
    }
}


#if MS >= 2
template <int MODE, bool FP8 = false>
__device__ __forceinline__ void cvt_item(const float* W, int Nsrc, int nblk, bf16* WT, int row_off, int dpitch, LAS float* scr, int item, int lane) {
    const int kb = item / nblk, nb = item - kb * nblk, k0 = 64 * kb, n0 = 32 * nb;
    const int nn = n0 + (lane & 31);
#pragma unroll 8
    for (int i = 0; i < 32; ++i) { const int kk = 2 * i + (lane >> 5); scr[kk * 33 + (lane & 31)] = (nn < Nsrc) ? W[(size_t)(k0 + kk) * Nsrc + nn] : 0.f; }
    LDS_WAIT(); asm volatile("" ::: "memory");
    const int c = lane & 7;
#pragma unroll
    for (int j = 0; j < 4; ++j) { const int n = (lane >> 3) + 8 * j; const LAS float* s = scr + (8 * c) * 33 + n;
        v4u o; o.x = pk2(s[0 * 33], s[1 * 33]); o.y = pk2(s[2 * 33], s[3 * 33]); o.z = pk2(s[4 * 33], s[5 * 33]); o.w = pk2(s[6 * 33], s[7 * 33]);
        const int ng = n0 + n; int dr = ng;
        if (MODE == 1) { const int i2 = ng & 255; dr = 8 * (i2 >> 2) + (i2 & 3) + ((ng >= 256) ? 4 : 0); }
        if constexpr (FP8) { v2u o8; o8.x = pack_fp8x4((f32x4){s[0 * 33], s[1 * 33], s[2 * 33], s[3 * 33]} * W8S); o8.y = pack_fp8x4((f32x4){s[4 * 33], s[5 * 33], s[6 * 33], s[7 * 33]} * W8S);
            *(v2u*)((unsigned char*)WT + (size_t)(row_off + dr) * dpitch + k0 + 8 * c) = o8; }
        else *(v4u*)(WT + (size_t)(row_off + dr) * dpitch + k0 + 8 * c) = o; }
    LDS_WAIT(); asm volatile("" ::: "memory");
}

template <int MODE>
__device__ __forceinline__ void cvt_item_reg(const float* W, int Nsrc, bf16* WT, int row_off, int dpitch, int k0, int n0, int lane) {
    const float* src = W + (size_t)k0 * Nsrc + n0 + 4 * lane;
    f32x4 v[32];
#pragma unroll
    for (int i = 0; i < 32; ++i) v[i] = __builtin_nontemporal_load((const f32x4*)(src + (size_t)i * Nsrc));
#pragma unroll
    for (int j = 0; j < 4; ++j) {
        const int ng = n0 + 4 * lane + j; int dr = ng;
        if (MODE == 1) { const int i2 = ng & 255; dr = 8 * (i2 >> 2) + (i2 & 3) + ((ng >= 256) ? 4 : 0); }
        v4u* dst = (v4u*)(WT + (size_t)(row_off + dr) * dpitch + k0);
#pragma unroll
        for (int q = 0; q < 4; ++q) { v4u o; o.x = pk2(v[8 * q][j], v[8 * q + 1][j]); o.y = pk2(v[8 * q + 2][j], v[8 * q + 3][j]); o.z = pk2(v[8 * q + 4][j], v[8 * q + 5][j]); o.w = pk2(v[8 * q + 6][j], v[8 * q + 7][j]); dst[q] = o; }
    }
}

constexpr int CVK = 32;
__device__ __forceinline__ void cvt_reg_load(const float* W, int Nsrc, int k0, int n0, int lane, f32x4 (&v)[CVK]) {
    const float* src = W + (size_t)k0 * Nsrc + n0 + 4 * lane;
#pragma unroll
    for (int i = 0; i < CVK; ++i) v[i] = __builtin_nontemporal_load((const f32x4*)(src + (size_t)i * Nsrc));
}
template <int MODE, bool FP8 = false>
__device__ __forceinline__ void cvt_reg_store(bf16* WT, int row_off, int dpitch, int k0, int n0, int lane, const f32x4 (&v)[CVK]) {
#pragma unroll
    for (int j = 0; j < 4; ++j) {
        const int ng = n0 + 4 * lane + j; int dr = ng;
        if (MODE == 1) { const int i2 = ng & 255; dr = 8 * (i2 >> 2) + (i2 & 3) + ((ng >= 256) ? 4 : 0); }
        if constexpr (FP8) { v4u* dst8 = (v4u*)((unsigned char*)WT + (size_t)(row_off + dr) * dpitch + k0);
#pragma unroll
            for (int q = 0; q < CVK / 16; ++q) { v4u o;
                o.x = pack_fp8x4((f32x4){v[16 * q][j], v[16 * q + 1][j], v[16 * q + 2][j], v[16 * q + 3][j]} * W8S); o.y = pack_fp8x4((f32x4){v[16 * q + 4][j], v[16 * q + 5][j], v[16 * q + 6][j], v[16 * q + 7][j]} * W8S);
                o.z = pack_fp8x4((f32x4){v[16 * q + 8][j], v[16 * q + 9][j], v[16 * q + 10][j], v[16 * q + 11][j]} * W8S); o.w = pack_fp8x4((f32x4){v[16 * q + 12][j], v[16 * q + 13][j], v[16 * q + 14][j], v[16 * q + 15][j]} * W8S); dst8[q] = o; }
            continue; }
        v4u* dst = (v4u*)(WT + (size_t)(row_off + dr) * dpitch + k0);
#pragma unroll
        for (int q = 0; q < CVK / 8; ++q) { v4u o; o.x = pg8::cvt_pk_bf16(v[8 * q][j], v[8 * q + 1][j]); o.y = pg8::cvt_pk_bf16(v[8 * q + 2][j], v[8 * q + 3][j]); o.z = pg8::cvt_pk_bf16(v[8 * q + 4][j], v[8 * q + 5][j]); o.w = pg8::cvt_pk_bf16(v[8 * q + 6][j], v[8 * q + 7][j]); dst[q] = o; }
    }
}
constexpr int CV_GU = (D / CVK) * 2, CV_DN = (FF / CVK) * 4, CV_NGU = (NE + 1) * CV_GU, CV_NITEM = CV_NGU + (NE + 1) * CV_DN;
__device__ __forceinline__ void cvx_load(const float* const* in, int it, int lane, f32x4 (&v)[CVK]) {
    if (it < CV_NGU) { const int e = it / CV_GU, ii = it - e * CV_GU; const float* src = (e < NE) ? in[30] + (size_t)e * D * 512 : in[32];
        cvt_reg_load(src, 512, CVK * (ii >> 1), 256 * (ii & 1), lane, v); }
    else { const int r = it - CV_NGU, e = r / CV_DN, ii = r - e * CV_DN; const float* src = (e < NE) ? in[31] + (size_t)e * FF * D : in[33];
        cvt_reg_load(src, D, CVK * (ii >> 2), 256 * (ii & 3), lane, v); }
}
__device__ __forceinline__ void cvx_store(unsigned char* ws, int it, int lane, const f32x4 (&v)[CVK]) {
    if (it < CV_NGU) { const int e = it / CV_GU, ii = it - e * CV_GU; cvt_reg_store<1, true>((bf16*)(ws + WS_WGU), e * 512, D, CVK * (ii >> 1), 256 * (ii & 1), lane, v); }
    else { const int r = it - CV_NGU, e = r / CV_DN, ii = r - e * CV_DN; cvt_reg_store<0, true>((bf16*)(ws + WS_WD), e * D, FF, CVK * (ii >> 2), 256 * (ii & 3), lane, v); }
}

#if MS >= 3
__device__ __forceinline__ float lora_val(const float* const* in, int n, int k) {
    if (n < 1024) { const int q = n >> 3, e8 = n & 7, dir = e8 >> 2, ch = q * 4 + (e8 & 3); return (k < 32) ? in[9][(size_t)(dir * 32 + k) * 512 + ch] : 0.f; }
    if (n < 2048) { const int m = n - 1024, q = m >> 3, e8 = m & 7, dir = e8 >> 2, ch = q * 4 + (e8 & 3); return (k >= 32 && k < 64) ? in[11][(size_t)(dir * 32 + (k - 32)) * 512 + ch] : 0.f; }
    if (n < 2560) { const int ch = n - 2048; return (k >= 64 && k < 160) ? in[12][(size_t)(k - 64) * 512 + ch] : 0.f; }
    { const int m = n - 2560, q = m >> 3, e8 = m & 7, dir = e8 >> 2, ch = q * 4 + (e8 & 3); return (k >= 160 && k < 176) ? in[19][(size_t)(dir * 16 + (k - 160)) * 256 + ch] : 0.f; }
}
#endif

__device__ __forceinline__ void ph_prologue(Frame& F) {
    {
        const float* c = F.in[1]; const float* cc = F.in[3]; const float* wa = F.in[4]; const float* ba = F.in[5];
        float* MOD = (float*)(F.ws + WS_MOD);
        LAS float* S = (LAS float*)F.lds; LAS float* red = (LAS float*)(F.lds + 32768);
        for (int it = blockIdx.x; it < 96; it += F.G) {
            for (int i = F.tid; i < 5120; i += NTHR) { const int r = i >> 10, k = i & 1023; const float cv = r < 4 ? c[r * 1024 + k] : cc[k]; S[i] = siluf_(cv); }
            __syncthreads();
            const int n = it * 64 + F.lane; float acc[5] = {0.f, 0.f, 0.f, 0.f, 0.f};
            for (int kk = 0; kk < 128; ++kk) { const int k = F.wave * 128 + kk; const float wv = wa[(size_t)k * 6144 + n];
#pragma unroll
                for (int r = 0; r < 5; ++r) acc[r] += S[r * 1024 + k] * wv; }
#pragma unroll
            for (int r = 0; r < 5; ++r) red[(F.wave * 5 + r) * 64 + F.lane] = acc[r];
            __syncthreads();
            if (F.wave == 0) {
#pragma unroll
                for (int r = 0; r < 5; ++r) { float s = 0.f;
#pragma unroll
                    for (int w = 0; w < 8; ++w) s += red[(w * 5 + r) * 64 + F.lane];
                    MOD[r * 6144 + n] = s + ba[n]; }
            }
            __syncthreads();
        }
    }
    {
        LAS float* scr = (LAS float*)(F.lds + F.wave * 16384);
        constexpr int I_IN = 16 * 168, I_BR = 8 * 32, I_OUT = 16 * 32, I_RT = 16 * 8, I_GU = 32 * 2, I_DN = 8 * 4;
        constexpr int T0 = I_IN, T1 = T0 + I_BR, T2 = T1 + I_BR, T3 = T2 + I_OUT, T4 = T3 + I_RT, T5 = T4 + (NE + 1) * I_GU, T6 = T5 + (NE + 1) * I_DN;
        unsigned char* ws = F.ws;
        for (int it = F.gw; it < T6; it += F.NGW) {
#if MS >= 3
            if (it < T0) { cvt_item<0, true>(F.in[6], IN_COLS, 168, (bf16*)(ws + WS_WIN), 0, D, scr, it, F.lane); continue; }
            if (it < T1) { cvt_item<0>(F.in[23], D, 32, (bf16*)(ws + WS_WBRRW), 0, RWW, scr, it - T0, F.lane); continue; }
            if (it < T2) { cvt_item<0>(F.in[24], D, 32, (bf16*)(ws + WS_WBRGLA), 0, RWW, scr, it - T1, F.lane); continue; }
            if (it < T3) { cvt_item<0>(F.in[25], D, 32, (bf16*)(ws + WS_WOUT), 0, D, scr, it - T2, F.lane); continue; }
#else
            if (it < T3) continue;
#endif
            if (it < T4) { cvt_item<0>(F.in[28], NE, 8, (bf16*)(ws + WS_WROUTER), 0, D, scr, it - T3, F.lane); continue; }
#if MS >= 3
            break;
#endif
            if (it < T5) { const int r = it - T4, e = r / I_GU, ii = r - e * I_GU;
                const float* src = (e < NE) ? F.in[30] + (size_t)e * D * 512 : F.in[32];
                cvt_item_reg<1>(src, 512, (bf16*)(ws + WS_WGU), e * 512, D, 32 * (ii >> 1), 256 * (ii & 1), F.lane); continue; }
            { const int r = it - T5, e = r / I_DN, ii = r - e * I_DN;
                const float* src = (e < NE) ? F.in[31] + (size_t)e * FF * D : F.in[33];
                cvt_item_reg<0>(src, D, (bf16*)(ws + WS_WD), e * D, FF, 32 * (ii >> 2), 256 * (ii & 3), F.lane); }
        }
    }
#if MS >= 3
    {
        bf16* WL = (bf16*)(F.ws + WS_WLORA);
        for (int idx = blockIdx.x * NTHR + F.tid; idx < NLORA * (KLORA / 8); idx += F.G * NTHR) {
            const int n = idx >> 5, k0 = (idx & 31) * 8; float v[8];
#pragma unroll
            for (int e = 0; e < 8; ++e) v[e] = lora_val(F.in, n, k0 + e);
            v4u o; o.x = pk2(v[0], v[1]); o.y = pk2(v[2], v[3]); o.z = pk2(v[4], v[5]); o.w = pk2(v[6], v[7]);
            *(v4u*)(WL + (size_t)n * KLORA + k0) = o;
        }
    }
#endif
}

struct EpiF32 {
    static constexpr bool PERM = false;
    float* C; int ldc;
    __device__ __forceinline__ void operator()(const f32x4 (&acc)[2][2][4][2], const pg8::Unit& u, int wr, int wc, int fr, int fq) const {
        const int row0 = u.pm * 256 + wr * 64 + fr, col0 = u.pn * 256 + wc * 32 + 4 * fq;
#pragma unroll
        for (int ai = 0; ai < 2; ++ai)
#pragma unroll
            for (int m = 0; m < 4; ++m) { float* rowp = C + (size_t)(row0 + ai * 128 + m * 16) * ldc + col0;
#pragma unroll
                for (int bj = 0; bj < 2; ++bj)
#pragma unroll
                    for (int n = 0; n < 2; ++n) *(f32x4*)(rowp + bj * 128 + n * 16) = acc[ai][bj][m][n]; }
    }
};
struct EpiSwiglu {
    static constexpr bool PERM = true;
    unsigned char* ACT;
    __device__ __forceinline__ void operator()(const f32x4 (&acc)[2][2][4][2], const pg8::Unit& u, int wr, int wc, int fr, int fq) const {
        const int row0 = u.pm * 256 + wr * 64 + fr, h0 = u.j * 128 + wc * 16 + 4 * fq;
#pragma unroll
        for (int ai = 0; ai < 2; ++ai)
#pragma unroll
            for (int m = 0; m < 4; ++m) { unsigned char* rowp = ACT + (size_t)(row0 + ai * 128 + m * 16) * FF + h0;
#pragma unroll
                for (int bj = 0; bj < 2; ++bj) { const f32x4 a = acc[ai][bj][m][0] * W8I, b = acc[ai][bj][m][1] * W8I;
                    *(unsigned*)(rowp + bj * 64) = pack_fp8x4((f32x4){siluf_(a[0]) * b[0], siluf_(a[1]) * b[1], siluf_(a[2]) * b[2], siluf_(a[3]) * b[3]}); } }
    }
};
struct EpiRowsBf16 {
    static constexpr bool PERM = true;
    bf16* O; int ldc; float sc;
    __device__ __forceinline__ void operator()(const f32x4 (&acc)[2][2][4][2], const pg8::Unit& u, int wr, int wc, int fr, int fq) const {
        const int row0 = u.pm * 256 + wr * 64 + fr, col0 = u.j * 256 + wc * 32 + 8 * fq;
#pragma unroll
        for (int ai = 0; ai < 2; ++ai)
#pragma unroll
            for (int m = 0; m < 4; ++m) { bf16* rowp = O + (size_t)(row0 + ai * 128 + m * 16) * ldc + col0;
#pragma unroll
                for (int bj = 0; bj < 2; ++bj) { const f32x4 v0 = acc[ai][bj][m][0] * sc, v1 = acc[ai][bj][m][1] * sc;
                    v4u w; w.x = pg8::cvt_pk_bf16(v0[0], v0[1]); w.y = pg8::cvt_pk_bf16(v0[2], v0[3]); w.z = pg8::cvt_pk_bf16(v1[0], v1[1]); w.w = pg8::cvt_pk_bf16(v1[2], v1[3]);
                    *(v4u*)(rowp + bj * 128) = w;
#ifdef PROBE_ST2
                    asm volatile("" ::: "memory"); *(volatile v4u*)(rowp + bj * 128) = w;
#endif
                    } }
    }
};

struct EpiRowsFp8 {
    static constexpr bool PERM = true;
    unsigned char* O;
    __device__ __forceinline__ void operator()(const f32x4 (&acc)[2][2][4][2], const pg8::Unit& u, int wr, int wc, int fr, int fq) const {
        const int row0 = u.pm * 256 + wr * 64 + fr, col0 = u.j * 256 + wc * 32 + 8 * fq;
#pragma unroll
        for (int ai = 0; ai < 2; ++ai)
#pragma unroll
            for (int m = 0; m < 4; ++m) { unsigned char* rowp = O + (size_t)(row0 + ai * 128 + m * 16) * D + col0;
#pragma unroll
                for (int bj = 0; bj < 2; ++bj) { f32x4 v0 = acc[ai][bj][m][0] * (16.0f * W8I), v1 = acc[ai][bj][m][1] * (16.0f * W8I);
#pragma unroll
                    for (int e = 0; e < 4; ++e) { v0[e] = __builtin_amdgcn_fmed3f(v0[e], -448.0f, 448.0f); v1[e] = __builtin_amdgcn_fmed3f(v1[e], -448.0f, 448.0f); }
                    int w0 = __builtin_amdgcn_cvt_pk_fp8_f32(v0[0], v0[1], 0, false); w0 = __builtin_amdgcn_cvt_pk_fp8_f32(v0[2], v0[3], w0, true);
                    int w1 = __builtin_amdgcn_cvt_pk_fp8_f32(v1[0], v1[1], 0, false); w1 = __builtin_amdgcn_cvt_pk_fp8_f32(v1[2], v1[3], w1, true);
                    v2u w; w.x = (unsigned)w0; w.y = (unsigned)w1; *(v2u*)(rowp + bj * 128) = w; } }
    }
};

__device__ __forceinline__ void ph_router(Frame& F) {
    pg8::Gemm g{(const bf16*)(F.ws + WS_A3), (const bf16*)(F.ws + WS_WROUTER), NLAT, NE, D, nullptr};
    pg8::StaticOrder S; S.init(NLAT, NE, F.G, (int)blockIdx.x);
    EpiF32 E{(float*)(F.ws + WS_LOGITS), NE};
    pg8::gemm_phase<EpiF32, pg8::StaticOrder, true, true, false>(F.lds, g, S, E);
}

#define RT_DPP(x, ctrl) __builtin_amdgcn_update_dpp(0, (x), (ctrl), 0xf, 0xf, false)
__device__ __forceinline__ unsigned wave_max_u32(unsigned k) {
    k = max(k, (unsigned)RT_DPP((int)k, 0xB1)); k = max(k, (unsigned)RT_DPP((int)k, 0x4E));
    k = max(k, (unsigned)RT_DPP((int)k, 0x124)); k = max(k, (unsigned)RT_DPP((int)k, 0x128));
    const unsigned a = (unsigned)__builtin_amdgcn_readlane((int)k, 0), b = (unsigned)__builtin_amdgcn_readlane((int)k, 16), c = (unsigned)__builtin_amdgcn_readlane((int)k, 32), d = (unsigned)__builtin_amdgcn_readlane((int)k, 48);
    return max(max(a, b), max(c, d));
}
__device__ __forceinline__ void ph_route(Frame& F) {
    const float* LOG = (const float*)(F.ws + WS_LOGITS); const float* rb = F.in[29];
    int* EIDX = (int*)(F.ws + WS_EIDX); float* GATE = (float*)(F.ws + WS_GATE); int* DEST = (int*)(F.ws + WS_DEST);
    unsigned* CNT = F.ctl + CW_CNT;
    const f32x4 bias = *(const f32x4*)(rb + 4 * F.lane);
    f32x4 lgn = *(const f32x4*)(LOG + (size_t)(F.gw < NLAT ? F.gw : 0) * NE + 4 * F.lane);
    for (int m = F.gw; m < NLAT; m += F.NGW) {
        const f32x4 lg = lgn;
        { const int mn = (m + F.NGW < NLAT) ? m + F.NGW : m; lgn = *(const f32x4*)(LOG + (size_t)mn * NE + 4 * F.lane); }
        float sc[4], sel[4];
#pragma unroll
        for (int i = 0; i < 4; ++i) { sc[i] = sigmoidf_(lg[i]); sel[i] = sc[i] + bias[i]; }
        float m1 = fmaxf(sel[0], sel[1]), m2 = fminf(sel[0], sel[1]);
        { const float a = sel[2]; const float n1 = fmaxf(m1, a); m2 = fmaxf(m2, fminf(m1, a)); m1 = n1; }
        { const float a = sel[3]; const float n1 = fmaxf(m1, a); m2 = fmaxf(m2, fminf(m1, a)); m1 = n1; }
#define RT_MERGE(ctrl) do { const float b1 = __builtin_bit_cast(float, RT_DPP(__builtin_bit_cast(int, m1), ctrl)), b2 = __builtin_bit_cast(float, RT_DPP(__builtin_bit_cast(int, m2), ctrl)); \
            const float n1 = fmaxf(m1, b1); m2 = fmaxf(fminf(m1, b1), fmaxf(m2, b2)); m1 = n1; } while (0)
        RT_MERGE(0xB1); RT_MERGE(0x4E); RT_MERGE(0x141);
#undef RT_MERGE
        const float gs = m1 + m2; const int g = F.lane >> 3;
        int rank = 0;
#pragma unroll
        for (int gg = 0; gg < 8; ++gg) { const float og = __builtin_bit_cast(float, __builtin_amdgcn_readlane(__builtin_bit_cast(int, gs), gg * 8)); rank += (og > gs || (og == gs && gg < g)) ? 1 : 0; }
        const bool keep = rank < 4;
        unsigned key[4];
#pragma unroll
        for (int i = 0; i < 4; ++i) { unsigned u = __builtin_bit_cast(unsigned, sel[i]); u ^= (u >> 31) ? 0xffffffffu : 0x80000000u;
            key[i] = keep ? ((u & 0xffffff00u) | (unsigned)(255 - (4 * F.lane + i))) : 0u; }
        int my_e = 0; float my_s = 0.f; float ssum = 0.f;
#pragma unroll
        for (int k = 0; k < TOPK; ++k) {
            const unsigned best = wave_max_u32(max(max(key[0], key[1]), max(key[2], key[3])));
            const int e = 255 - (int)(best & 255u), owner = e >> 2;
            float s_own = 0.f;
#pragma unroll
            for (int i = 0; i < 4; ++i) if (key[i] == best) { s_own = sc[i]; key[i] = 0u; }
            const float s = __builtin_bit_cast(float, __builtin_amdgcn_readlane(__builtin_bit_cast(int, s_own), owner));
            ssum += s;
            if (F.lane == k) { my_e = e; my_s = s; }
        }
        if (F.lane < TOPK) {
            const unsigned pos = __hip_atomic_fetch_add(CNT + my_e * CNT_STRIDE, 1u, __ATOMIC_RELAXED, __HIP_MEMORY_SCOPE_AGENT);
            EIDX[m * 8 + F.lane] = my_e; GATE[m * 8 + F.lane] = my_s * __builtin_amdgcn_rcpf(ssum) * 2.5f; DEST[m * 8 + F.lane] = (int)pos;
        }
    }
}
#undef RT_DPP

__device__ __forceinline__ void ph_scatter(Frame& F) {
    LAS int* tstart = (LAS int*)F.lds;
    LAS int* scan = (LAS int*)(F.lds + 2048);
    LAS int* cnts = (LAS int*)(F.lds + 4096);
    int* EIDX = (int*)(F.ws + WS_EIDX); int* DEST = (int*)(F.ws + WS_DEST); int* ROWTOK = (int*)(F.ws + WS_ROWTOK); int* TILE_E = (int*)(F.ws + WS_TILE_E);
    unsigned* CNT = F.ctl + CW_CNT;
    int tiles = 0, cnt = 0;
    if (F.tid < NE) { cnt = (int)__hip_atomic_load(CNT + F.tid * CNT_STRIDE, __ATOMIC_RELAXED, __HIP_MEMORY_SCOPE_AGENT); tiles = (cnt + 255) >> 8; scan[F.tid] = tiles; cnts[F.tid] = cnt; }
    __syncthreads();
    for (int o = 1; o < NE; o <<= 1) { int v = 0; if (F.tid < NE && F.tid >= o) v = scan[F.tid - o]; __syncthreads(); if (F.tid < NE) scan[F.tid] += v; __syncthreads(); }
    if (F.tid < NE) { tstart[F.tid + 1] = scan[F.tid]; if (F.tid == 0) tstart[0] = 0; }
    __syncthreads();
    const int NT = tstart[NE];
    if (blockIdx.x == 0) {
        if (F.tid == 0) F.ctl[CW_NT] = (unsigned)NT;
        if (F.tid < NE) for (int t = tstart[F.tid]; t < tstart[F.tid + 1]; ++t) TILE_E[t] = F.tid;
    }
    for (int e = blockIdx.x; e < NE; e += F.G) { const int c0 = cnts[e], c1 = (tstart[e + 1] - tstart[e]) * 256, base = tstart[e] * 256;
        for (int p = c0 + F.tid; p < c1; p += NTHR) ROWTOK[base + p] = 0; }
    for (int i = blockIdx.x * NTHR + F.tid; i < NLAT; i += F.G * NTHR) ROWTOK[SH_ROW0 + i] = i;
    for (int i = blockIdx.x * NTHR + F.tid; i < NLAT * TOPK; i += F.G * NTHR) {
        const int e = EIDX[i], pos = DEST[i]; const int dr = tstart[e] * 256 + pos;
        DEST[i] = dr; ROWTOK[dr] = i >> 3;
    }
}

__device__ __forceinline__ void ph_exp1(Frame& F) {
    const int NT = (int)__hip_atomic_load(F.ctl + CW_NT, __ATOMIC_RELAXED, __HIP_MEMORY_SCOPE_AGENT);
    pg8::Gemm g{(const bf16*)(F.ws + WS_A3F), (const bf16*)(F.ws + WS_WGU), 0, 0, D / 2, (const int*)(F.ws + WS_ROWTOK)};
    pg8::MoeOrder S{2, F.G, (int)blockIdx.x, NT, (const int*)(F.ws + WS_TILE_E)};
    EpiSwiglu E{F.ws + WS_ACT};
    pg8::gemm_phase<EpiSwiglu, pg8::MoeOrder, true, true, true, true>(F.lds, g, S, E);
}
__device__ __forceinline__ void ph_exp2(Frame& F) {
    const int NT = (int)__hip_atomic_load(F.ctl + CW_NT, __ATOMIC_RELAXED, __HIP_MEMORY_SCOPE_AGENT);
    pg8::Gemm g{(const bf16*)(F.ws + WS_ACT), (const bf16*)(F.ws + WS_WD), 0, 0, FF / 2, nullptr};
    pg8::MoeOrder S{4, F.G, (int)blockIdx.x, NT, (const int*)(F.ws + WS_TILE_E)};
    EpiRowsFp8 E{F.ws + WS_Y};
    pg8::gemm_phase<EpiRowsFp8, pg8::MoeOrder, true, true, false, true>(F.lds, g, S, E);
}
#endif

#if MS >= 3
__device__ __forceinline__ void unp8(const v4u w, float (&f)[8]) { f[0] = bflo(w.x); f[1] = bfhi(w.x); f[2] = bflo(w.y); f[3] = bfhi(w.y); f[4] = bflo(w.z); f[5] = bfhi(w.z); f[6] = bflo(w.w); f[7] = bfhi(w.w); }
__device__ __forceinline__ void unp8f8(const v2u w, float (&f)[8]) { const f32x2 a = __builtin_amdgcn_cvt_pk_f32_fp8((int)w.x, false), b = __builtin_amdgcn_cvt_pk_f32_fp8((int)w.x, true), c = __builtin_amdgcn_cvt_pk_f32_fp8((int)w.y, false), d = __builtin_amdgcn_cvt_pk_f32_fp8((int)w.y, true);
    f[0] = a.x; f[1] = a.y; f[2] = b.x; f[3] = b.y; f[4] = c.x; f[5] = c.y; f[6] = d.x; f[7] = d.y; }
__device__ __forceinline__ v4u pk8(const float (&f)[8]) { v4u o; o.x = pk2(f[0], f[1]); o.y = pk2(f[2], f[3]); o.z = pk2(f[4], f[5]); o.w = pk2(f[6], f[7]); return o; }
__device__ __forceinline__ void st8(float* p, const float (&f)[8]) { *(f32x4*)p = (f32x4){f[0], f[1], f[2], f[3]}; *(f32x4*)(p + 4) = (f32x4){f[4], f[5], f[6], f[7]}; }
__device__ __forceinline__ void ld8(const float* p, float (&f)[8]) { const f32x4 a = *(const f32x4*)p, b = *(const f32x4*)(p + 4); f[0] = a.x; f[1] = a.y; f[2] = a.z; f[3] = a.w; f[4] = b.x; f[5] = b.y; f[6] = b.z; f[7] = b.w; }

__device__ __forceinline__ void ph_a1(Frame& F) {
    const float* mod = (const float*)(F.ws + WS_MOD); unsigned char* A1 = F.ws + WS_A1;
    constexpr int NR = 4;
    for (int m0 = F.gw; m0 < MR; m0 += NR * F.NGW) {
        f32x4 xv[NR][4];
#pragma unroll
        for (int r = 0; r < NR; ++r) { const int mm = m0 + r * F.NGW; const int m = mm < MR ? mm : m0;
            const float* src = (m < NLAT) ? F.in[0] + (size_t)m * D : F.in[2] + (size_t)(m - NLAT) * D;
            const f32x4* xr = (const f32x4*)src + F.lane;
#pragma unroll
            for (int j = 0; j < 4; ++j) xv[r][j] = __builtin_nontemporal_load(xr + 64 * j); }
        __builtin_amdgcn_sched_barrier(0);
#pragma unroll
        for (int r = 0; r < NR; ++r) { const int mm = m0 + r * F.NGW; const int m = mm < MR ? mm : m0; const int mr = (m < NLAT) ? (m / SEQ) : 4;
            unsigned* ao = (unsigned*)(A1 + (size_t)m * D) + F.lane;
#pragma unroll
            for (int j = 0; j < 4; ++j) { const int c = 4 * F.lane + 256 * j;
                const f32x4 sh = *(const f32x4*)(mod + mr * 6144 + c), sc = *(const f32x4*)(mod + mr * 6144 + 1024 + c);
                const f32x4 h = xv[r][j] * (sc + 1.0f) + sh; ao[64 * j] = pack_fp8x4(h); } }
    }
}

__device__ __forceinline__ void ph_inproj(Frame& F) {
    pg8::Gemm g{(const bf16*)(F.ws + WS_A1), (const bf16*)(F.ws + WS_WIN), MR, NP, D / 2, nullptr};
    pg8::StaticOrder S; S.init(MR, NP, F.G, (int)blockIdx.x);
    EpiRowsBf16 E{(bf16*)(F.ws + WS_P), NP, W8I};
    pg8::gemm_phase<EpiRowsBf16, pg8::StaticOrder, true, true, false, true>(F.lds, g, S, E);
}

struct FeatOut { bf16 *R, *V, *KK, *KP, *QG, *KGB, *VGB, *A2; const float *mu, *kkw, *cw; };
__device__ __forceinline__ void feat_rw(const FeatOut& O, int p, size_t m, int lane, const v4u own_w, const v4u (&nbw)[4], const float (&muv)[8]) {
    float own[8], sh[4][8], val[8];
    unp8(own_w, own);
#pragma unroll
    for (int q = 0; q < 4; ++q) unp8(nbw[q], sh[q]);
#pragma unroll
    for (int e = 0; e < 8; ++e) val[e] = own[e] + muv[e] * (sh[e & 3][e] - own[e]);
    if (p == 0) *(v4u*)(O.R + m * RWW + 8 * lane) = pk8(val);
    else if (p == 2) *(v4u*)(O.V + m * RWW + 8 * lane) = pk8(val);
    else if (p == 1) {
        *(v4u*)(O.KP + m * RWW + 8 * lane) = pk8(val);
        float kw[8]; ld8(O.kkw + 8 * lane, kw); float kkv[8]; float ss = 0.f;
#pragma unroll
        for (int e = 0; e < 8; ++e) { kkv[e] = val[e] * kw[e]; ss += kkv[e] * kkv[e]; }
        ss += __shfl_xor(ss, 1); ss += __shfl_xor(ss, 2); ss += __shfl_xor(ss, 4);
        const float inv = 1.0f / fmaxf(sqrtf(ss), 1e-12f);
#pragma unroll
        for (int e = 0; e < 8; ++e) kkv[e] *= inv;
        *(v4u*)(O.KK + m * RWW + 8 * lane) = pk8(kkv);
    } else {
        float o[8];
#pragma unroll
        for (int e = 0; e < 8; ++e) o[e] = (lane < 4) ? tanhf_(val[e]) : ((lane < 8) ? val[e] : sigmoidf_(val[e]));
        *(v4u*)(O.A2 + m * KLORA + 8 * lane) = pk8(o);
    }
}
__device__ __forceinline__ void feat_gla_store(const FeatOut& O, int p, size_t m, int lane, const float (&acc)[8]) {
    const int cq = p * 512 + 8 * lane; float o[8];
#pragma unroll
    for (int e = 0; e < 8; ++e) o[e] = siluf_(acc[e]);
    if (p == 0) {
        if (lane < 32) {
#pragma unroll
            for (int e = 0; e < 8; ++e) o[e] *= 0.125f;
            *(v4u*)(O.QG + m * 256 + cq) = pk8(o);
        } else *(v4u*)(O.KGB + m * 256 + (cq - 256)) = pk8(o);
    } else *(v4u*)(O.VGB + m * RWW + (cq - 512)) = pk8(o);
}
__device__ __forceinline__ void ph_feat(Frame& F) {
    const bf16* P = (const bf16*)(F.ws + WS_P);
    FeatOut O{(bf16*)(F.ws + WS_RB), (bf16*)(F.ws + WS_VB), (bf16*)(F.ws + WS_KKB), (bf16*)(F.ws + WS_KMF), (bf16*)(F.ws + WS_QGB), (bf16*)(F.ws + WS_KGB), (bf16*)(F.ws + WS_VGB), (bf16*)(F.ws + WS_A2), F.in[7], F.in[13], F.in[18]};
    const v4u Z4 = (v4u){0u, 0u, 0u, 0u};
    for (int blk = F.gw; blk < NB * (GRIDH / 2) * (GRIDW / 2); blk += F.NGW) {
        int lane = F.lane; asm volatile("" : "+v"(lane));
        const int b = blk >> 11, r0 = 2 * ((blk >> 5) & 63), c0 = 2 * (blk & 31); const int mb = b * SEQ + r0 * GRIDW + c0;
        const bool vu = r0 > 0, vd = r0 + 2 < GRIDH, vl = c0 > 0, vr = c0 + 2 < GRIDW;
#pragma unroll
        for (int p = 0; p < 4; ++p) {
            const int cb = p * 512 + 8 * lane; const bool act = (p < 3) || lane < 20;
            v4u own[2][2], up[2], dn[2], lf[2], rt[2];
#pragma unroll
            for (int i = 0; i < 2; ++i) { up[i] = Z4; dn[i] = Z4; lf[i] = Z4; rt[i] = Z4; own[i][0] = Z4; own[i][1] = Z4; }
            if (act) {
#pragma unroll
                for (int i = 0; i < 2; ++i) {
#pragma unroll
                    for (int j = 0; j < 2; ++j) own[i][j] = *(const v4u*)(P + (size_t)(mb + 64 * i + j) * NP + cb);
                    if (vu) up[i] = *(const v4u*)(P + (size_t)(mb - 64 + i) * NP + cb);
                    if (vd) dn[i] = *(const v4u*)(P + (size_t)(mb + 128 + i) * NP + cb);
                    if (vl) lf[i] = *(const v4u*)(P + (size_t)(mb + 64 * i - 1) * NP + cb);
                    if (vr) rt[i] = *(const v4u*)(P + (size_t)(mb + 64 * i + 2) * NP + cb); }
            } else if (p == 3 && lane >= 20 && lane < 22) {
#pragma unroll
                for (int i = 0; i < 2; ++i)
#pragma unroll
                    for (int j = 0; j < 2; ++j) own[i][j] = *(const v4u*)(P + (size_t)(mb + 64 * i + j) * NP + C_PGL + 8 * (lane - 20));
            }
            float muv[8] = {0.f, 0.f, 0.f, 0.f, 0.f, 0.f, 0.f, 0.f}; if (act) ld8(O.mu + cb, muv);
            __builtin_amdgcn_sched_barrier(0);
#pragma unroll
            for (int i = 0; i < 2; ++i)
#pragma unroll
                for (int j = 0; j < 2; ++j) { const size_t m = (size_t)(mb + 64 * i + j);
                    if (act) { const v4u nbw[4] = {j == 0 ? lf[i] : own[i][0], j == 1 ? rt[i] : own[i][1], i == 0 ? up[j] : own[0][j], i == 1 ? dn[j] : own[1][j]};
                        feat_rw(O, p, m, lane, own[i][j], nbw, muv); }
                    else if (p == 3 && lane < 32) *(v4u*)(O.A2 + m * KLORA + 8 * lane) = own[i][j]; }
        }
#pragma unroll
        for (int p = 0; p < 2; ++p) {
            const int cq = p * 512 + 8 * lane, cb = C_Q + cq;
            v4u g[4][4];
#pragma unroll
            for (int a2 = 0; a2 < 4; ++a2)
#pragma unroll
                for (int b2 = 0; b2 < 4; ++b2) { const bool ok = (a2 == 0 ? vu : (a2 == 3 ? vd : true)) && (b2 == 0 ? vl : (b2 == 3 ? vr : true));
                    g[a2][b2] = Z4; if (ok) g[a2][b2] = *(const v4u*)(P + (size_t)(mb + 64 * (a2 - 1) + (b2 - 1)) * NP + cb); }
            __builtin_amdgcn_sched_barrier(0);
            float acc[2][2][8];
#pragma unroll
            for (int i = 0; i < 2; ++i)
#pragma unroll
                for (int j = 0; j < 2; ++j)
#pragma unroll
                    for (int e = 0; e < 8; ++e) acc[i][j][e] = 0.f;
#pragma unroll
            for (int dy = 0; dy < 3; ++dy)
#pragma unroll
                for (int dx = 0; dx < 3; ++dx) { float wv[8]; ld8(O.cw + (dy * 3 + dx) * 1024 + cq, wv);
#pragma unroll
                    for (int i = 0; i < 2; ++i)
#pragma unroll
                        for (int j = 0; j < 2; ++j) { float pv[8]; unp8(g[i + dy][j + dx], pv);
#pragma unroll
                            for (int e = 0; e < 8; ++e) acc[i][j][e] += pv[e] * wv[e]; } }
#pragma unroll
            for (int i = 0; i < 2; ++i)
#pragma unroll
                for (int j = 0; j < 2; ++j) feat_gla_store(O, p, (size_t)(mb + 64 * i + j), lane, acc[i][j]);
        }
    }
    for (int m = NLAT + F.gw; m < MR; m += F.NGW) {
        int lane = F.lane; asm volatile("" : "+v"(lane));
        const int t = (m - NLAT) & (CTXL - 1); const bool vp = t > 0, vn = t < CTXL - 1;
#pragma unroll
        for (int p = 0; p < 4; ++p) {
            const int cb = p * 512 + 8 * lane; const bool act = (p < 3) || lane < 20;
            if (act) { const v4u own = *(const v4u*)(P + (size_t)m * NP + cb); v4u pv = Z4, nv = Z4;
                if (vp) pv = *(const v4u*)(P + (size_t)(m - 1) * NP + cb); if (vn) nv = *(const v4u*)(P + (size_t)(m + 1) * NP + cb);
                float muv[8]; ld8(O.mu + cb, muv); const v4u nbw[4] = {pv, nv, pv, nv};
                feat_rw(O, p, (size_t)m, lane, own, nbw, muv); }
            else if (p == 3 && lane < 32) { v4u w = Z4; if (lane < 22) w = *(const v4u*)(P + (size_t)m * NP + C_PGL + 8 * (lane - 20)); *(v4u*)(O.A2 + (size_t)m * KLORA + 8 * lane) = w; }
        }
#pragma unroll
        for (int p = 0; p < 2; ++p) {
            const int cq = p * 512 + 8 * lane, cb = C_Q + cq; float acc[8] = {0.f, 0.f, 0.f, 0.f, 0.f, 0.f, 0.f, 0.f};
#pragma unroll
            for (int dx = -1; dx <= 1; ++dx) { const bool ok = (dx < 0) ? vp : ((dx > 0) ? vn : true);
                if (ok) { float pv[8], wv[8]; unp8(*(const v4u*)(P + (size_t)(m + dx) * NP + cb), pv); ld8(O.cw + (3 + dx + 1) * 1024 + cq, wv);
#pragma unroll
                    for (int e = 0; e < 8; ++e) acc[e] += pv[e] * wv[e]; } }
            feat_gla_store(O, p, (size_t)m, lane, acc);
        }
    }
}

struct EpiLora {
    static constexpr bool PERM = true;
    unsigned char* ws; const float* const* in;
    __device__ __forceinline__ void grp_w(const f32x4 (&acc)[2][2][4][2], int row0, int c0) const {
        bf16* Wf = (bf16*)(ws + WS_LWF); bf16* Wb = (bf16*)(ws + WS_LWB);
#pragma unroll
        for (int bj = 0; bj < 2; ++bj) { const int ch = (c0 + bj * 128) >> 1; const f32x4 w0f = *(const f32x4*)(in[8] + ch), w0b = *(const f32x4*)(in[8] + 512 + ch);
#pragma unroll
            for (int ai = 0; ai < 2; ++ai)
#pragma unroll
                for (int m = 0; m < 4; ++m) { const size_t row = (size_t)(row0 + ai * 128 + m * 16);
                    const f32x4 xf = acc[ai][bj][m][0] + w0f, xb = acc[ai][bj][m][1] + w0b; f32x4 df, db;
#pragma unroll
                    for (int e = 0; e < 4; ++e) { df[e] = -0.60653066f * sigmoidf_(xf[e]); db[e] = -0.60653066f * sigmoidf_(xb[e]); }
                    { v2u o; o.x = pk2(df[0], df[1]); o.y = pk2(df[2], df[3]); *(v2u*)(Wf + row * RWW + ch) = o; o.x = pk2(db[0], db[1]); o.y = pk2(db[2], db[3]); *(v2u*)(Wb + row * RWW + ch) = o; } } }
    }
    __device__ __forceinline__ void grp_a(const f32x4 (&acc)[2][2][4][2], int row0, int c0) const {
        bf16* KMf = (bf16*)(ws + WS_KMF); bf16* KMb = (bf16*)(ws + WS_KMB); bf16* BVf = (bf16*)(ws + WS_BVF); bf16* BVb = (bf16*)(ws + WS_BVB);
        const bf16* KK = (const bf16*)(ws + WS_KKB); bf16* KSUM = (bf16*)(ws + WS_KSUM);
#pragma unroll
        for (int bj = 0; bj < 2; ++bj) { const int ch = (c0 + bj * 128 - 1024) >> 1; const f32x4 a0f = *(const f32x4*)(in[10] + ch), a0b = *(const f32x4*)(in[10] + 512 + ch), ka = *(const f32x4*)(in[14] + ch);
#pragma unroll
            for (int ai = 0; ai < 2; ++ai) {
            v2u kpw[2][4], kkw[2][4];
#pragma unroll
                for (int m = 0; m < 4; ++m) { const size_t row = (size_t)(row0 + ai * 128 + m * 16); kpw[ai][m] = *(const v2u*)(KMf + row * RWW + ch); kkw[ai][m] = *(const v2u*)(KK + row * RWW + ch); }
            __builtin_amdgcn_sched_barrier(0);
#pragma unroll
                for (int m = 0; m < 4; ++m) { const size_t row = (size_t)(row0 + ai * 128 + m * 16);
                    const f32x4 xf = acc[ai][bj][m][0] + a0f, xb = acc[ai][bj][m][1] + a0b;
                    const f32x4 kp = (f32x4){bflo(kpw[ai][m].x), bfhi(kpw[ai][m].x), bflo(kpw[ai][m].y), bfhi(kpw[ai][m].y)}, kk = (f32x4){bflo(kkw[ai][m].x), bfhi(kkw[ai][m].x), bflo(kkw[ai][m].y), bfhi(kkw[ai][m].y)};
                    f32x4 kmf, kmb, bvf, bvb;
#pragma unroll
                    for (int e = 0; e < 4; ++e) { const float af = sigmoidf_(xf[e]), ab = sigmoidf_(xb[e]);
                        kmf[e] = kp[e] * (1.0f + (af - 1.0f) * ka[e]); kmb[e] = kp[e] * (1.0f + (ab - 1.0f) * ka[e]); bvf[e] = kk[e] * af; bvb[e] = kk[e] * ab; }
                    { v2u o; o.x = pk2(kmf[0], kmf[1]); o.y = pk2(kmf[2], kmf[3]); *(v2u*)(KMf + row * RWW + ch) = o; o.x = pk2(kmb[0], kmb[1]); o.y = pk2(kmb[2], kmb[3]); *(v2u*)(KMb + row * RWW + ch) = o;
                      o.x = pk2(bvf[0], bvf[1]); o.y = pk2(bvf[2], bvf[3]); *(v2u*)(BVf + row * RWW + ch) = o; o.x = pk2(bvb[0], bvb[1]); o.y = pk2(bvb[2], bvb[3]); *(v2u*)(BVb + row * RWW + ch) = o; }
                    v2u ks; ks.x = pk2(kmf[0] + kmb[0], kmf[1] + kmb[1]); ks.y = pk2(kmf[2] + kmb[2], kmf[3] + kmb[3]); *(v2u*)(KSUM + row * RWW + ch) = ks; } } }
    }
    __device__ __forceinline__ void grp_g(const f32x4 (&acc)[2][2][4][2], int row0, int c0) const {
        bf16* RWG = (bf16*)(ws + WS_RWG);
#pragma unroll
        for (int bj = 0; bj < 2; ++bj) { const int ch = c0 + bj * 128 - 2048;
#pragma unroll
            for (int ai = 0; ai < 2; ++ai)
#pragma unroll
                for (int m = 0; m < 4; ++m) { const size_t row = (size_t)(row0 + ai * 128 + m * 16); const f32x4 v0 = acc[ai][bj][m][0], v1 = acc[ai][bj][m][1];
                    v4u w; w.x = pk2(v0[0], v0[1]); w.y = pk2(v0[2], v0[3]); w.z = pk2(v1[0], v1[1]); w.w = pk2(v1[2], v1[3]); *(v4u*)(RWG + row * RWW + ch) = w; } }
    }
    __device__ __forceinline__ void grp_l(const f32x4 (&acc)[2][2][4][2], int row0, int c0) const {
        bf16* GAf = (bf16*)(ws + WS_LAF); bf16* GAb = (bf16*)(ws + WS_LAB);
#pragma unroll
        for (int bj = 0; bj < 2; ++bj) { const int ch = (c0 + bj * 128 - 2560) >> 1; const f32x4 gbf = *(const f32x4*)(in[20] + ch), gbb = *(const f32x4*)(in[20] + 256 + ch);
#pragma unroll
            for (int ai = 0; ai < 2; ++ai)
#pragma unroll
                for (int m = 0; m < 4; ++m) { const size_t row = (size_t)(row0 + ai * 128 + m * 16);
                    const f32x4 xf = acc[ai][bj][m][0] + gbf, xb = acc[ai][bj][m][1] + gbb; f32x4 af, ab;
#pragma unroll
                    for (int e = 0; e < 4; ++e) { const float lf = logsigmoidf_(xf[e]), lb = logsigmoidf_(xb[e]);
                        af[e] = lf * 0.0625f; ab[e] = lb * 0.0625f; }
                    { v2u o; o.x = pk2(af[0], af[1]); o.y = pk2(af[2], af[3]); *(v2u*)(GAf + row * 256 + ch) = o; o.x = pk2(ab[0], ab[1]); o.y = pk2(ab[2], ab[3]); *(v2u*)(GAb + row * 256 + ch) = o; } } }
    }
    __device__ __forceinline__ void operator()(const f32x4 (&acc)[2][2][4][2], const pg8::Unit& u, int wr, int wc, int fr, int fq) const {
        const int row0 = u.pm * 256 + wr * 64 + fr, c0 = u.pn * 256 + wc * 32 + 8 * fq;
        if (u.pn < 4) grp_w(acc, row0, c0); else if (u.pn < 8) grp_a(acc, row0, c0); else if (u.pn < 10) grp_g(acc, row0, c0); else grp_l(acc, row0, c0);
    }
};
__device__ __forceinline__ void ph_lora(Frame& F) {
    pg8::Gemm g{(const bf16*)(F.ws + WS_A2), (const bf16*)(F.ws + WS_WLORA), MR, NLORA, KLORA, nullptr};
    pg8::StaticOrder S; S.init(MR, NLORA, F.G, (int)blockIdx.x);
    EpiLora E{F.ws, F.in};
    pg8::gemm_phase<EpiLora, pg8::StaticOrder, true, true, false>(F.lds, g, S, E);
}

__device__ __forceinline__ void ph_merge(Frame& F) {
    unsigned char* ws = F.ws; const int lane = F.lane;
    const bf16* ORf = (const bf16*)(ws + WS_ORWF); const bf16* ORb = (const bf16*)(ws + WS_ORWB); const bf16* OGf = (const bf16*)(ws + WS_OGLF); const bf16* OGb = (const bf16*)(ws + WS_OGLB);
    const bf16* R = (const bf16*)(ws + WS_RB); const bf16* V = (const bf16*)(ws + WS_VB); const bf16* KSUM = (const bf16*)(ws + WS_KSUM); const bf16* RWG = (const bf16*)(ws + WS_RWG);
    const bf16* P = (const bf16*)(ws + WS_P);
    bf16* YRW = (bf16*)(ws + WS_YRW); bf16* YGLA = (bf16*)(ws + WS_YGLA);
    float rk[8], gw[8], gbv[8], ggw[8], ggb[8];
    ld8(F.in[15] + 8 * lane, rk); ld8(F.in[16] + 8 * lane, gw); ld8(F.in[17] + 8 * lane, gbv); ld8(F.in[21] + 8 * lane, ggw); ld8(F.in[22] + 8 * lane, ggb);
    for (int m0 = F.gw; m0 < NLAT; m0 += 2 * F.NGW) {
        const int m1 = (m0 + F.NGW < NLAT) ? m0 + F.NGW : m0;
        v4u wa[2], wb[2], wc[2], wd[2], wr[2], wv[2], wk[2], wg[2], wo[2];
#pragma unroll
        for (int r2 = 0; r2 < 2; ++r2) { const int m = r2 ? m1 : m0; const size_t ro = (size_t)m * RWW + 8 * lane;
            wa[r2] = *(const v4u*)(ORf + ro); wb[r2] = *(const v4u*)(ORb + ro); wc[r2] = *(const v4u*)(OGf + ro); wd[r2] = *(const v4u*)(OGb + ro);
            wr[r2] = *(const v4u*)(R + ro); wv[r2] = *(const v4u*)(V + ro); wk[r2] = *(const v4u*)(KSUM + ro); wg[r2] = *(const v4u*)(RWG + ro);
            wo[r2] = *(const v4u*)(P + (size_t)m * NP + C_OG + 8 * lane); }
#pragma unroll
        for (int r2 = 0; r2 < 2; ++r2) { const int m = r2 ? m1 : m0; const size_t ro = (size_t)m * RWW + 8 * lane;
        {
            float a[8], b[8], o[8]; unp8(wa[r2], a); unp8(wb[r2], b);
            float s = 0.f;
#pragma unroll
            for (int e = 0; e < 8; ++e) { o[e] = a[e] + b[e]; s += o[e]; }
            s += __shfl_xor(s, 1); s += __shfl_xor(s, 2); s += __shfl_xor(s, 4);
            const float mean = s * (1.f / 64.f); float q = 0.f;
#pragma unroll
            for (int e = 0; e < 8; ++e) { o[e] -= mean; q += o[e] * o[e]; }
            q += __shfl_xor(q, 1); q += __shfl_xor(q, 2); q += __shfl_xor(q, 4);
            const float rstd = __builtin_amdgcn_rsqf(q * (1.f / 64.f) + RW_GN_EPS);
            float r[8], v[8], ksm[8], g[8]; unp8(wr[r2], r); unp8(wv[r2], v); unp8(wk[r2], ksm); unp8(wg[r2], g);
            float bs = 0.f;
#pragma unroll
            for (int e = 0; e < 8; ++e) bs += r[e] * ksm[e] * rk[e];
            bs += __shfl_xor(bs, 1); bs += __shfl_xor(bs, 2); bs += __shfl_xor(bs, 4);
            float y[8];
#pragma unroll
            for (int e = 0; e < 8; ++e) y[e] = (o[e] * rstd * gw[e] + gbv[e] + bs * v[e]) * g[e];
            *(v4u*)(YRW + ro) = pk8(y);
        }
        {
            float a[8], b[8], o[8]; unp8(wc[r2], a); unp8(wd[r2], b);
            float s = 0.f;
#pragma unroll
            for (int e = 0; e < 8; ++e) { o[e] = a[e] + b[e]; s += o[e]; }
            s += __shfl_xor(s, 1); s += __shfl_xor(s, 2); s += __shfl_xor(s, 4); s += __shfl_xor(s, 8);
            const float mean = s * (1.f / 128.f); float q = 0.f;
#pragma unroll
            for (int e = 0; e < 8; ++e) { o[e] -= mean; q += o[e] * o[e]; }
            q += __shfl_xor(q, 1); q += __shfl_xor(q, 2); q += __shfl_xor(q, 4); q += __shfl_xor(q, 8);
            const float rstd = __builtin_amdgcn_rsqf(q * (1.f / 128.f) + LN_EPS);
            float og[8]; unp8(wo[r2], og);
            float y[8];
#pragma unroll
            for (int e = 0; e < 8; ++e) y[e] = (o[e] * rstd * ggw[e] + ggb[e]) * siluf_(og[e]);
            *(v4u*)(YGLA + ro) = pk8(y);
        }
        }
    }
}

template <int WHICH> struct EpiBranch {
    static constexpr bool PERM = true;
    bf16* Z; const bf16* P;
    __device__ __forceinline__ void operator()(const f32x4 (&acc)[2][2][4][2], const pg8::Unit& u, int wr, int wc, int fr, int fq) const {
        const int row0 = u.pm * 256 + wr * 64 + fr, col0 = u.pn * 256 + wc * 32 + 8 * fq;
#pragma unroll
        for (int ah = 0; ah < 4; ++ah) { const int ai = ah >> 1, mb = 2 * (ah & 1);
            v4u gw[2][2], zw[2][2];
#pragma unroll
            for (int m = 0; m < 2; ++m) { const size_t row = (size_t)(row0 + ai * 128 + (mb + m) * 16);
#pragma unroll
                for (int bj = 0; bj < 2; ++bj) { const int c = col0 + bj * 128;
                    gw[m][bj] = *(const v4u*)(P + row * NP + (WHICH ? C_GGLA : C_GRW) + c);
                    if (WHICH) zw[m][bj] = *(const v4u*)(Z + row * D + c); } }
            __builtin_amdgcn_sched_barrier(0);
#pragma unroll
            for (int m = 0; m < 2; ++m) { const size_t row = (size_t)(row0 + ai * 128 + (mb + m) * 16);
#pragma unroll
                for (int bj = 0; bj < 2; ++bj) { const int c = col0 + bj * 128;
                    float g[8]; unp8(gw[m][bj], g);
                    const f32x4 v0 = acc[ai][bj][mb + m][0], v1 = acc[ai][bj][mb + m][1];
                    float z[8];
#pragma unroll
                    for (int e = 0; e < 4; ++e) { z[e] = sigmoidf_(g[e]) * v0[e]; z[4 + e] = sigmoidf_(g[4 + e]) * v1[e]; }
                    if (WHICH) { float zo[8]; unp8(zw[m][bj], zo);
#pragma unroll
                        for (int e = 0; e < 8; ++e) z[e] += zo[e]; }
                    *(v4u*)(Z + row * D + c) = pk8(z); } }
        }
    }
};
__device__ __forceinline__ void ph_branch(Frame& F) {
    pg8::StaticOrder S; S.init(NLAT, D, F.G, (int)blockIdx.x);
    { pg8::Gemm g{(const bf16*)(F.ws + WS_YRW), (const bf16*)(F.ws + WS_WBRRW), NLAT, D, RWW, nullptr};
      EpiBranch<0> E{(bf16*)(F.ws + WS_Z), (const bf16*)(F.ws + WS_P)};
      pg8::gemm_phase<EpiBranch<0>, pg8::StaticOrder, true, true, false>(F.lds, g, S, E); }
    { pg8::Gemm g{(const bf16*)(F.ws + WS_YGLA), (const bf16*)(F.ws + WS_WBRGLA), NLAT, D, RWW, nullptr};
      EpiBranch<1> E{(bf16*)(F.ws + WS_Z), (const bf16*)(F.ws + WS_P)};
      pg8::gemm_phase<EpiBranch<1>, pg8::StaticOrder, true, true, false>(F.lds, g, S, E); }
}
struct EpiOut {
    static constexpr bool PERM = true;
    bf16* X1P; const float* x; const float* mod;
    __device__ __forceinline__ void operator()(const f32x4 (&acc)[2][2][4][2], const pg8::Unit& u, int wr, int wc, int fr, int fq) const {
        const int row0 = u.pm * 256 + wr * 64 + fr, col0 = u.pn * 256 + wc * 32 + 8 * fq; const float* g1 = mod + (u.pm / (SEQ / 256)) * 6144 + 2048;
        f32x4 gv[2][2];
#pragma unroll
        for (int bj = 0; bj < 2; ++bj)
#pragma unroll
            for (int n = 0; n < 2; ++n) gv[bj][n] = *(const f32x4*)(g1 + col0 + bj * 128 + 4 * n);
#pragma unroll
        for (int ah = 0; ah < 4; ++ah) { const int ai = ah >> 1, mb = 2 * (ah & 1);
            f32x4 xv[2][2][2];
#pragma unroll
            for (int m = 0; m < 2; ++m) { const size_t ro = (size_t)(row0 + ai * 128 + (mb + m) * 16) * D;
#pragma unroll
                for (int bj = 0; bj < 2; ++bj)
#pragma unroll
                    for (int n = 0; n < 2; ++n) xv[m][bj][n] = *(const f32x4*)(x + ro + col0 + bj * 128 + 4 * n); }
            __builtin_amdgcn_sched_barrier(0);
#pragma unroll
            for (int m = 0; m < 2; ++m) { const size_t ro = (size_t)(row0 + ai * 128 + (mb + m) * 16) * D;
#pragma unroll
                for (int bj = 0; bj < 2; ++bj) { const f32x4 a = xv[m][bj][0] * ALPHA + gv[bj][0] * acc[ai][bj][mb + m][0], b = xv[m][bj][1] * ALPHA + gv[bj][1] * acc[ai][bj][mb + m][1];
                    v4u w; w.x = pk2(a.x, a.y); w.y = pk2(a.z, a.w); w.z = pk2(b.x, b.y); w.w = pk2(b.z, b.w); *(v4u*)(X1P + ro + col0 + bj * 128) = w; } }
        }
    }
};
__device__ __forceinline__ void ph_outproj(Frame& F) {
    pg8::Gemm g{(const bf16*)(F.ws + WS_Z), (const bf16*)(F.ws + WS_WOUT), NLAT, D, D, nullptr};
    pg8::StaticOrder S; S.init(NLAT, D, F.G, (int)blockIdx.x);
    EpiOut E{(bf16*)(F.ws + WS_X1), F.in[0], (const float*)(F.ws + WS_MOD)};
    pg8::gemm_phase<EpiOut, pg8::StaticOrder, true, true, false>(F.lds, g, S, E);
}
#endif

#if MS >= 3
constexpr int LP = 72, SLOTB = 64 * LP * 2, LPF = 68, AUX_OFF = 13 * SLOTB;
static_assert(AUX_OFF + 4096 <= MISC_OFF, "scan LDS map");
#define SLOT(n) ((LAS bf16*)(lds + (n) * SLOTB))
__device__ __forceinline__ int scan_row(int s, int b, int dir) {
    if (s < CTXL) return NLAT + b * CTXL + (dir ? (CTXL - 1 - s) : s);
    const int lt = s - CTXL; return b * SEQ + (dir ? (SEQ - 1 - lt) : lt);
}
__device__ __forceinline__ unsigned pk2z(float x) { return pk2(x, 0.f); }
__device__ __forceinline__ float bf2f(bf16 h) { return __builtin_bit_cast(float, (unsigned)h << 16); }
__device__ __forceinline__ v2u pack4(const f32x4 v) { v2u o; o.x = pk2(v[0], v[1]); o.y = pk2(v[2], v[3]); return o; }
__device__ __forceinline__ float clamp8(float x) { return __builtin_amdgcn_fmed3f(x, -448.0f, 448.0f); }
__device__ __forceinline__ unsigned pack4_fp8(const f32x4 v) { int w = __builtin_amdgcn_cvt_pk_fp8_f32(clamp8(v[0]), clamp8(v[1]), 0, false); return (unsigned)__builtin_amdgcn_cvt_pk_fp8_f32(clamp8(v[2]), clamp8(v[3]), w, true); }
__device__ __forceinline__ f32x4 unpack4_fp8(unsigned w) { const f32x2 lo = __builtin_amdgcn_cvt_pk_f32_fp8((int)w, false), hi = __builtin_amdgcn_cvt_pk_f32_fp8((int)w, true); return (f32x4){lo.x, lo.y, hi.x, hi.y}; }
__device__ __forceinline__ f32x4 unpack4(const v2u w) { return (f32x4){bflo(w.x), bfhi(w.x), bflo(w.y), bfhi(w.y)}; }
__device__ __forceinline__ f32x4 mm_tile(const LAS bf16* X, int r0, const LAS bf16* Y, int c0, int lane) {
    const int rr = lane & 15, q = lane >> 4;
    const LAS bf16* xp = X + (r0 + rr) * LP + 8 * q; const LAS bf16* yp = Y + (c0 + rr) * LP + 8 * q;
    const bf16x8 a0 = *(const LAS bf16x8*)xp, a1 = *(const LAS bf16x8*)(xp + 32), b0 = *(const LAS bf16x8*)yp, b1 = *(const LAS bf16x8*)(yp + 32);
    f32x4 acc = (f32x4){0.f, 0.f, 0.f, 0.f};
    acc = __builtin_amdgcn_mfma_f32_16x16x32_bf16(a0, b0, acc, 0, 0, 0);
    acc = __builtin_amdgcn_mfma_f32_16x16x32_bf16(a1, b1, acc, 0, 0, 0);
    return acc;
}
__device__ __forceinline__ float red8(float x) {
    x += __builtin_bit_cast(float, __builtin_amdgcn_update_dpp(0, __builtin_bit_cast(int, x), 0x141, 0xf, 0xf, false));
    x += __builtin_bit_cast(float, __builtin_amdgcn_update_dpp(0, __builtin_bit_cast(int, x), 0xB1, 0xf, 0xf, false));
    x += __builtin_bit_cast(float, __builtin_amdgcn_update_dpp(0, __builtin_bit_cast(int, x), 0x4E, 0xf, 0xf, false));
    return x;
}

#define S1_BAR() do { asm volatile("s_waitcnt lgkmcnt(0)" ::: "memory"); __builtin_amdgcn_s_barrier(); asm volatile("" ::: "memory"); } while (0)
struct RwIn { bf16 lw[8], r[8], k[8], a[8], b[8], v[8]; };
__device__ __forceinline__ void s1_rwkv_load(Frame& F, int u, RwIn& I) {
    const int sr = u / NCHUNK, c = u - sr * NCHUNK, rb = sr >> 4, rdir = (sr >> 3) & 1, rh = sr & 7; unsigned char* ws = F.ws;
    const bf16* RBp = (const bf16*)(ws + WS_RB); const bf16* VBp = (const bf16*)(ws + WS_VB); const bf16* KKp = (const bf16*)(ws + WS_KKB);
    const bf16* KMp = (const bf16*)(ws + (rdir ? WS_KMB : WS_KMF)); const bf16* BVp = (const bf16*)(ws + (rdir ? WS_BVB : WS_BVF)); const bf16* LWp = (const bf16*)(ws + (rdir ? WS_LWB : WS_LWF));
#pragma unroll
    for (int i = 0; i < 8; ++i) { const int row = scan_row(c * CH + 8 * F.wave + i, rb, rdir); const size_t base = (size_t)row * RWW + rh * 64 + F.lane;
        I.lw[i] = LWp[base]; I.r[i] = RBp[base]; I.k[i] = KMp[base]; I.a[i] = KKp[base]; I.b[i] = BVp[base]; I.v[i] = VBp[base]; }
}
__device__ __forceinline__ void s1_rwkv(Frame& F, int u, const RwIn& I, int un, RwIn& Inext, int cvi) {
    const int sr = u / NCHUNK, c = u - sr * NCHUNK;
    const bool emit = c >= CTXL / CH;
    LAS unsigned char* lds = F.lds; unsigned char* ws = F.ws;
    int lane_ = F.lane; asm volatile("" : "+v"(lane_));
    const int lane = lane_, wave = F.wave, rr = lane & 15, q = lane >> 4;
    LAS float* tot = (LAS float*)(lds + AUX_OFF); LAS float* gCs = tot + 512;
    {
        float lw[8], xr[8], xk[8], xa[8], xb[8], xv[8];
#pragma unroll
        for (int i = 0; i < 8; ++i) { lw[i] = bf2f(I.lw[i]); xr[i] = bf2f(I.r[i]); xk[i] = bf2f(I.k[i]); xa[i] = -bf2f(I.a[i]); xb[i] = bf2f(I.b[i]); xv[i] = bf2f(I.v[i]); }
        float p[8]; p[0] = lw[0];
#pragma unroll
        for (int i = 1; i < 8; ++i) p[i] = p[i - 1] + lw[i];
        tot[wave * 64 + lane] = p[7];
        S1_BAR();
        float off = 0.f, all = 0.f;
#pragma unroll
        for (int w = 0; w < 8; ++w) { const float t = tot[w * 64 + lane]; all += t; off += (w < wave) ? t : 0.f; }
        if (wave == 0) gCs[lane] = __expf(all);
        float at[8], bb[8], kb[8];
#pragma unroll
        for (int i = 0; i < 8; ++i) { const float cum = off + p[i]; const float g = __expf(cum), gi = __expf(-cum), gp = __expf(cum - lw[i]), gc = __expf(all - cum);
            const int t = 8 * wave + i;
            at[i] = xa[i] * gp; bb[i] = xb[i] * gc; kb[i] = xk[i] * gc;
            SLOT(0)[t * LP + lane] = (bf16)pk2z(at[i]);
            SLOT(1)[t * LP + lane] = (bf16)pk2z(xr[i] * g);
            SLOT(2)[t * LP + lane] = (bf16)pk2z(xb[i] * gi);
            SLOT(3)[t * LP + lane] = (bf16)pk2z(xk[i] * gi); }
        *(LAS v4u*)(SLOT(4) + lane * LP + 8 * wave) = pk8(at);
        *(LAS v4u*)(SLOT(5) + lane * LP + 8 * wave) = pk8(xv);
        *(LAS v4u*)(SLOT(6) + lane * LP + 8 * wave) = pk8(bb);
        *(LAS v4u*)(SLOT(7) + lane * LP + 8 * wave) = pk8(kb);
        S1_BAR();
    }
    s1_rwkv_load(F, un, Inext);
    LAS float* Lp = (LAS float*)(lds + 8 * SLOTB);
#pragma unroll
    for (int tix = 0; tix < 2; ++tix) { const int ti = 2 * wave + tix, r0 = 16 * (ti >> 2), c0 = 16 * (ti & 3), ci = c0 + rr;
        { const f32x4 acc = mm_tile(SLOT(2), r0, SLOT(0), c0, lane);
#pragma unroll
            for (int e = 0; e < 4; ++e) { const int i = r0 + 4 * q + e; Lp[ci * LPF + (i & 3) * 16 + (i >> 2)] = (i < ci) ? acc[e] : 0.f; } }
        { f32x4 acc = mm_tile(SLOT(0), r0, SLOT(3), c0, lane);
#pragma unroll
            for (int e = 0; e < 4; ++e) acc[e] = (ci < r0 + 4 * q + e) ? acc[e] : 0.f;
            *(LAS v2u*)(SLOT(10) + ci * LP + r0 + 4 * q) = pack4(acc); }
        if (emit) {
            { f32x4 acc = mm_tile(SLOT(2), r0, SLOT(1), c0, lane);
#pragma unroll
                for (int e = 0; e < 4; ++e) acc[e] = (r0 + 4 * q + e <= ci) ? acc[e] : 0.f;
                *(LAS v2u*)(SLOT(11) + ci * LP + r0 + 4 * q) = pack4(acc); }
            { f32x4 acc = mm_tile(SLOT(3), r0, SLOT(1), c0, lane);
#pragma unroll
                for (int e = 0; e < 4; ++e) acc[e] = (r0 + 4 * q + e <= ci) ? acc[e] : 0.f;
                *(LAS v2u*)(SLOT(12) + ci * LP + r0 + 4 * q) = pack4(acc); }
        }
    }
    S1_BAR();
    if (wave < 4) {
        const int j = 16 * wave + (lane >> 2), s = lane & 3;
        float Tr[16];
#pragma unroll
        for (int m = 0; m < 16; ++m) Tr[m] = 0.f;
        const LAS float* lrow = Lp + s * 16;
        f32x4 lb[3][4];
#pragma unroll
        for (int t = 0; t < 2; ++t) lb[t][0] = *(const LAS f32x4*)(lrow + t * LPF);
#pragma unroll
        for (int t = 0; t < 64; ++t) {
            if (t + 2 < 64) {
#pragma unroll
                for (int k = 0; k < 4; ++k) if (4 * k <= (t + 2) / 4) lb[(t + 2) % 3][k] = *(const LAS f32x4*)(lrow + (t + 2) * LPF + 4 * k);
            }
            __builtin_amdgcn_sched_barrier(0);
            float acc0 = 0.f, acc1 = 0.f;
#pragma unroll
            for (int m = 0; m < 16; ++m) if (m <= t / 4) { const float lv = lb[t % 3][m >> 2][m & 3]; if (m & 1) acc1 += lv * Tr[m]; else acc0 += lv * Tr[m]; }
            float acc = acc0 + acc1;
            acc += __builtin_bit_cast(float, __builtin_amdgcn_update_dpp(0, __builtin_bit_cast(int, acc), 0xB1, 0xf, 0xf, false));
            acc += __builtin_bit_cast(float, __builtin_amdgcn_update_dpp(0, __builtin_bit_cast(int, acc), 0x4E, 0xf, 0xf, false));
            int jj = j, ss = s; asm volatile("" : "+v"(jj), "+v"(ss));
            const float val = acc + ((t == jj) ? 1.f : 0.f);
            Tr[t >> 2] = (ss == (t & 3)) ? val : Tr[t >> 2];
            SLOT(0)[t * LP + j] = (bf16)pk2z(val);
        }
    } else if (cvi >= 0) { f32x4 cv[CVK]; cvx_load(F.in, cvi, lane, cv); cvx_store(ws, cvi, lane, cv); }
    S1_BAR();
#pragma unroll
    for (int tix = 0; tix < 2; ++tix) { const int ti = 2 * wave + tix, r0 = 16 * (ti >> 2), c0 = 16 * (ti & 3), ci = c0 + rr;
        { const f32x4 acc = mm_tile(SLOT(0), r0, SLOT(4), c0, lane); *(LAS v2u*)(SLOT(2) + ci * LP + r0 + 4 * q) = pack4(acc); }
        { const f32x4 acc = mm_tile(SLOT(0), r0, SLOT(10), c0, lane); *(LAS v2u*)(SLOT(3) + ci * LP + r0 + 4 * q) = pack4(acc); }
    }
    S1_BAR();
    unsigned char* RH = ws + WS_RH + (size_t)u * 4096; bf16* GT = (bf16*)((unsigned char*)F.out + OUT_GT) + (size_t)u * 4096;
#pragma unroll
    for (int tix = 0; tix < 2; ++tix) { const int ti = 2 * wave + tix, tr = ti >> 2, r0 = 16 * tr, c0 = 16 * (ti & 3), ci = c0 + rr;
        const int pos = (tr >> 1) * 32 + q * 8 + 4 * (tr & 1);
        if (emit) {
            { f32x4 acc = mm_tile(SLOT(2), r0, SLOT(11), c0, lane);
                acc += unpack4(*(const LAS v2u*)(SLOT(1) + ci * LP + r0 + 4 * q));
                *(unsigned*)(RH + ci * 64 + pos) = pack4_fp8(acc); }
            { f32x4 acc = mm_tile(SLOT(3), r0, SLOT(11), c0, lane);
                acc += unpack4(*(const LAS v2u*)(SLOT(12) + ci * LP + r0 + 4 * q));
                *(LAS v2u*)(SLOT(4) + ci * LP + r0 + 4 * q) = pack4(acc); }
        }
        { f32x4 acc = mm_tile(SLOT(2), r0, SLOT(6), c0, lane);
            const float gc = gCs[ci];
#pragma unroll
            for (int e = 0; e < 4; ++e) acc[e] += (r0 + 4 * q + e == ci) ? gc : 0.f;
            *(v2u*)(GT + ci * 64 + pos) = pack4(acc); }
    }
    S1_BAR();
    unsigned char* YL = ws + WS_YL + (size_t)u * 4096;
#pragma unroll
    for (int tix = 0; tix < 2; ++tix) { const int ti = 2 * wave + tix, r0 = 16 * (ti >> 2), c0 = 16 * (ti & 3), ci = c0 + rr;
        if (emit) { const f32x4 acc = mm_tile(SLOT(5), r0, SLOT(4), c0, lane); *(unsigned*)(YL + ci * 64 + r0 + 4 * q) = pack4_fp8(acc); }
        { f32x4 acc = mm_tile(SLOT(3), r0, SLOT(6), c0, lane);
            acc += unpack4(*(const LAS v2u*)(SLOT(7) + ci * LP + r0 + 4 * q));
            *(LAS v2u*)(SLOT(8) + ci * LP + r0 + 4 * q) = pack4(acc); }
    }
    S1_BAR();
    bf16* HH = (bf16*)(ws + WS_HH) + (size_t)u * 4096;
#pragma unroll
    for (int tix = 0; tix < 2; ++tix) { const int ti = 2 * wave + tix, r0 = 16 * (ti >> 2), c0 = 16 * (ti & 3), ci = c0 + rr;
        const f32x4 acc = mm_tile(SLOT(8), r0, SLOT(5), c0, lane);
        *(v2u*)(HH + ci * 64 + r0 + 4 * q) = pack4(acc); }
    S1_BAR();
}

struct GlIn { bf16 la[8], q[8], k[8], v0[8], v1[8]; };
__device__ __forceinline__ void s1_gla_load(Frame& F, int u, GlIn& I) {
    const int sg = u / NCHUNK, c = u - sg * NCHUNK, gb = sg >> 3, gdir = (sg >> 2) & 1, gh = sg & 3; unsigned char* ws = F.ws;
    const bf16* Qp = (const bf16*)(ws + WS_QGB); const bf16* Kp = (const bf16*)(ws + WS_KGB); const bf16* Vp = (const bf16*)(ws + WS_VGB); const bf16* LAp = (const bf16*)(ws + (gdir ? WS_LAB : WS_LAF));
#pragma unroll
    for (int i = 0; i < 8; ++i) { const int row = scan_row(c * CH + 8 * F.wave + i, gb, gdir); const size_t b2 = (size_t)row * 256 + gh * 64 + F.lane, b5 = (size_t)row * RWW + gh * 128 + F.lane;
        I.la[i] = LAp[b2]; I.q[i] = Qp[b2]; I.k[i] = Kp[b2]; I.v0[i] = Vp[b5]; I.v1[i] = Vp[b5 + 64]; }
}
__device__ __forceinline__ void s1_gla(Frame& F, int u, const GlIn& I) {
    const int sg = u / NCHUNK, c = u - sg * NCHUNK;
    const bool emit = c >= CTXL / CH;
    LAS unsigned char* lds = F.lds; unsigned char* ws = F.ws;
    int lane_ = F.lane; asm volatile("" : "+v"(lane_));
    const int lane = lane_, wave = F.wave, rr = lane & 15, q = lane >> 4;
    LAS float* tot = (LAS float*)(lds + AUX_OFF);
    unsigned char* QE = (unsigned char*)F.out + OUT_QE + (size_t)u * 4096;
    {
        float la[8], xq[8], xk[8], v0[8], v1[8];
#pragma unroll
        for (int i = 0; i < 8; ++i) { la[i] = bf2f(I.la[i]); xq[i] = bf2f(I.q[i]); xk[i] = bf2f(I.k[i]); v0[i] = bf2f(I.v0[i]); v1[i] = bf2f(I.v1[i]); }
        float p[8]; p[0] = la[0];
#pragma unroll
        for (int i = 1; i < 8; ++i) p[i] = p[i - 1] + la[i];
        tot[wave * 64 + lane] = p[7];
        S1_BAR();
        float off = 0.f, all = 0.f;
#pragma unroll
        for (int w = 0; w < 8; ++w) { const float t = tot[w * 64 + lane]; all += t; off += (w < wave) ? t : 0.f; }
        if (wave == 0) ((float*)(ws + WS_DD))[(size_t)u * 64 + lane] = __expf(all);
        float kl[8];
#pragma unroll
        for (int i = 0; i < 8; ++i) { const float cum = off + p[i]; const int t = 8 * wave + i;
            const float qef = xq[i] * __expf(cum);
            SLOT(0)[t * LP + lane] = (bf16)pk2z(qef);
            if (emit) QE[t * 64 + lane] = (unsigned char)__builtin_amdgcn_cvt_pk_fp8_f32(clamp8(qef), 0.f, 0, false);
            SLOT(1)[t * LP + lane] = (bf16)pk2z(xk[i] * __expf(-cum));
            kl[i] = xk[i] * __expf(all - cum); }
        *(LAS v4u*)(SLOT(2) + lane * LP + 8 * wave) = pk8(kl);
        *(LAS v4u*)(SLOT(3) + lane * LP + 8 * wave) = pk8(v0);
        *(LAS v4u*)(SLOT(3) + (64 + lane) * LP + 8 * wave) = pk8(v1);
        S1_BAR();
    }
    if (emit) {
#pragma unroll
        for (int tix = 0; tix < 2; ++tix) { const int ti = 2 * wave + tix, r0 = 16 * (ti >> 2), c0 = 16 * (ti & 3), ci = c0 + rr;
            f32x4 acc = mm_tile(SLOT(1), r0, SLOT(0), c0, lane);
#pragma unroll
            for (int e = 0; e < 4; ++e) acc[e] = (r0 + 4 * q + e <= ci) ? acc[e] : 0.f;
            *(LAS v2u*)(SLOT(5) + ci * LP + r0 + 4 * q) = pack4(acc); }
    }
    bf16* KV = (bf16*)(ws + WS_KV) + (size_t)u * 8192;
#pragma unroll
    for (int tix = 0; tix < 4; ++tix) { const int ti = 4 * wave + tix, r0 = 16 * (ti >> 3), c0 = 16 * (ti & 7), ci = c0 + rr;
        const f32x4 acc = mm_tile(SLOT(2), r0, SLOT(3), c0, lane);
        *(v2u*)(KV + ci * 64 + r0 + 4 * q) = pack4(acc); }
    S1_BAR();
    if (emit) {
        unsigned char* IN = ws + WS_INTRA + (size_t)u * 8192;
#pragma unroll
        for (int tix = 0; tix < 4; ++tix) { const int ti = 4 * wave + tix, r0 = 16 * (ti >> 2), c0 = 16 * (ti & 3), ci = c0 + rr;
            const f32x4 acc = mm_tile(SLOT(3), r0, SLOT(5), c0, lane);
            *(unsigned*)(IN + ci * 128 + r0 + 4 * q) = pack4_fp8(acc); }
    }
    S1_BAR();
}

__device__ __forceinline__ void ph_scan1(Frame& F) {
    { RwIn cur, nxt; if ((int)blockIdx.x < NU_RW) s1_rwkv_load(F, blockIdx.x, cur);
#pragma unroll 1
      for (int u = blockIdx.x; u < NU_RW; u += F.G) { const int un = (u + F.G < NU_RW) ? u + F.G : u; const int cvi = ((u - (int)blockIdx.x) / F.G) * (F.G * 4) + (int)blockIdx.x * 4 + (F.wave & 3);
          s1_rwkv(F, u, cur, un, nxt, cvi < CV_NITEM ? cvi : -1); cur = nxt; } }
    { GlIn cur, nxt; if ((int)blockIdx.x < NU_GL) s1_gla_load(F, blockIdx.x, cur);
#pragma unroll 1
      for (int u = blockIdx.x; u < NU_GL; u += F.G) { const int un = (u + F.G < NU_GL) ? u + F.G : u; s1_gla_load(F, un, nxt); s1_gla(F, u, cur); cur = nxt; } }
}

__device__ __forceinline__ bf16x8 pack_frag(const f32x4 lo, const f32x4 hi) {
    v4u w; w.x = pk2(lo[0], lo[1]); w.y = pk2(lo[2], lo[3]); w.z = pk2(hi[0], hi[1]); w.w = pk2(hi[2], hi[3]); return __builtin_bit_cast(bf16x8, w);
}
constexpr int S2_D = 5, S2_R = 6, S2_RW = 8192 + 4096 + 2048 + 1024, S2_GL = 4096 + 2048 + 1024 + 1024, S2_SLOT = S2_RW + S2_GL;
static_assert(S2_R * S2_SLOT <= MISC_OFF, "S2 ring fits in LDS");
__device__ __forceinline__ void s2_issue(LAS unsigned char* lds, int sb, int lw, int lane, size_t ur, size_t ug, int v0r, int v0g,
                                         const unsigned char* GTb, const unsigned char* RHb, const unsigned char* HHb, const unsigned char* YLb,
                                         const unsigned char* QEb, const unsigned char* KVb, const unsigned char* INb, const unsigned char* DDb) {
#pragma unroll
    for (int j = 0; j < 4; ++j) {
        int k = lw * 4 + j; if (k >= 23) k -= 1;
        const unsigned char* src; int ldo;
        if (k < 8) { const int n = k, pu = n * 64 + lane, row = pu >> 3, c16 = (pu & 7) ^ (row & 7);
            src = GTb + ur * 8192 + row * 128 + c16 * 16; ldo = n * 1024; }
        else if (k < 12) { const int n = k - 8, pu = n * 64 + lane, row = pu >> 2, c16 = (pu & 3) ^ (row & 3);
            src = RHb + ur * 4096 + row * 64 + c16 * 16; ldo = 8192 + n * 1024; }
        else if (k < 14) { const int n = k - 12, pu = n * 64 + lane, v = pu >> 3, c16 = (pu & 7) ^ (v & 7);
            src = HHb + ur * 8192 + (size_t)(v0r + v) * 128 + c16 * 16; ldo = 12288 + n * 1024; }
        else if (k < 15) { const int t = lane;
            src = YLb + ur * 4096 + t * 64 + v0r; ldo = 14336; }
        else if (k < 19) { const int n = k - 15, pu = n * 64 + lane, row = pu >> 2, c16 = (pu & 3) ^ (row & 3);
            src = QEb + ug * 4096 + row * 64 + c16 * 16; ldo = S2_RW + n * 1024; }
        else if (k < 21) { const int n = k - 19, pu = n * 64 + lane, v = pu >> 3, c16 = (pu & 7) ^ (v & 7);
            src = KVb + ug * 16384 + (size_t)(v0g + v) * 128 + c16 * 16; ldo = S2_RW + 4096 + n * 1024; }
        else if (k < 22) { const int t = lane;
            src = INb + ug * 8192 + t * 128 + v0g; ldo = S2_RW + 6144; }
        else { src = DDb + ug * 256 + (lane & 15) * 16; ldo = S2_RW + 7168; }
        __builtin_amdgcn_global_load_lds((const unsigned*)src, (LAS unsigned*)(lds + sb + ldo), 16, 0, 0);
    }
}
__device__ __forceinline__ void ph_scan2(Frame& F) {
    const int lane = F.lane, wave = F.wave, rr = lane & 15, q = lane >> 4; unsigned char* ws = F.ws; LAS unsigned char* lds = F.lds;
    const int it = (F.G == 256) ? (int)(blockIdx.x & 7) * 32 + (int)(blockIdx.x >> 3) : (int)blockIdx.x;
    const int sr = it >> 2, v0r = 16 * (it & 3), rb = sr >> 4, rdir = (sr >> 3) & 1, rh = sr & 7;
    const int sg = it >> 3, v0g = 16 * (it & 7), gb = sg >> 3, gdir = (sg >> 2) & 1, gh = sg & 3;
#define S2_BAR() do { asm volatile("s_waitcnt lgkmcnt(0)" ::: "memory"); __builtin_amdgcn_s_barrier(); asm volatile("" ::: "memory"); } while (0)
    if (wave >= 2) {
        const unsigned char* GTb = (const unsigned char*)F.out + OUT_GT; const unsigned char* QEb = (const unsigned char*)F.out + OUT_QE;
        const unsigned char* RHb = ws + WS_RH; const unsigned char* YLb = ws + WS_YL; const unsigned char* HHb = ws + WS_HH; const unsigned char* KVb = ws + WS_KV; const unsigned char* INb = ws + WS_INTRA;
        const unsigned char* DDb = ws + WS_DD;
#define S2_ISSUE(cc) s2_issue(lds, ((cc) % S2_R) * S2_SLOT, wave - 2, lane, (size_t)(sr * NCHUNK + ((cc) < NCHUNK ? (cc) : NCHUNK - 1)), (size_t)(sg * NCHUNK + ((cc) < NCHUNK ? (cc) : NCHUNK - 1)), v0r, v0g, GTb, RHb, HHb, YLb, QEb, KVb, INb, DDb)
        S2_ISSUE(0); S2_ISSUE(1); S2_ISSUE(2); S2_ISSUE(3); S2_ISSUE(4);
#pragma unroll 1
        for (int c = 0; c < NCHUNK; ++c) {
            asm volatile("s_waitcnt vmcnt(16) ; S2WAIT" ::: "memory");
            S2_BAR();
            S2_ISSUE(c + S2_D);
        }
#undef S2_ISSUE
    } else if (wave == 0) {
        bf16* ORW = (bf16*)(ws + (rdir ? WS_ORWB : WS_ORWF));
        f32x4 S[4];
#pragma unroll
        for (int m = 0; m < 4; ++m) S[m] = (f32x4){0.f, 0.f, 0.f, 0.f};
#pragma unroll 1
        for (int c = 0; c < NCHUNK; ++c) {
            S2_BAR();
            const LAS unsigned char* sl = lds + (c % S2_R) * S2_SLOT;
            const bool emit = c >= CTXL / CH;
            bf16x8 G0[4], G1[4]; v2u Hw[4], Rw0[4], Rw1[4]; unsigned Yw[4];
#pragma unroll
            for (int m = 0; m < 4; ++m) { const int k2 = 16 * m + rr;
                G0[m] = *(const LAS bf16x8*)(sl + (k2 * 8 + (q ^ (k2 & 7))) * 16); G1[m] = *(const LAS bf16x8*)(sl + (k2 * 8 + ((4 + q) ^ (k2 & 7))) * 16);
                Hw[m] = *(const LAS v2u*)(sl + 12288 + (rr * 8 + ((2 * m + (q >> 1)) ^ (rr & 7))) * 16 + (q & 1) * 8); }
            if (emit) {
#pragma unroll
                for (int tt = 0; tt < 4; ++tt) { const int t = 16 * tt + rr;
                    Rw0[tt] = *(const LAS v2u*)(sl + 8192 + (t * 4 + ((q >> 1) ^ (t & 3))) * 16 + (q & 1) * 8); Rw1[tt] = *(const LAS v2u*)(sl + 8192 + (t * 4 + ((2 + (q >> 1)) ^ (t & 3))) * 16 + (q & 1) * 8);
                    Yw[tt] = *(const LAS unsigned*)(sl + 14336 + t * 16 + q * 4); }
            }
            const bf16x8 Sf0 = pack_frag(S[0], S[1]), Sf1 = pack_frag(S[2], S[3]);
            __builtin_amdgcn_sched_barrier(0);
#pragma unroll
            for (int m = 0; m < 4; ++m) { f32x4 acc = unpack4(Hw[m]);
                acc = __builtin_amdgcn_mfma_f32_16x16x32_bf16(G0[m], Sf0, acc, 0, 0, 0);
                acc = __builtin_amdgcn_mfma_f32_16x16x32_bf16(G1[m], Sf1, acc, 0, 0, 0);
                S[m] = acc; }
            if (emit) {
#pragma unroll
                for (int tt = 0; tt < 4; ++tt) { const int t = 16 * tt + rr;
                    const bf16x8 R0 = pack_frag(unpack4_fp8(Rw0[tt].x), unpack4_fp8(Rw0[tt].y)), R1 = pack_frag(unpack4_fp8(Rw1[tt].x), unpack4_fp8(Rw1[tt].y));
                    f32x4 acc = unpack4_fp8(Yw[tt]);
                    acc = __builtin_amdgcn_mfma_f32_16x16x32_bf16(Sf0, R0, acc, 0, 0, 0);
                    acc = __builtin_amdgcn_mfma_f32_16x16x32_bf16(Sf1, R1, acc, 0, 0, 0);
                    const int row = scan_row(c * CH + t, rb, rdir);
                    *(v2u*)(ORW + (size_t)row * RWW + rh * 64 + v0r + 4 * q) = pack4(acc); }
            }
        }
    } else {
        bf16* OGL = (bf16*)(ws + (gdir ? WS_OGLB : WS_OGLF));
        f32x4 S[4];
#pragma unroll
        for (int m = 0; m < 4; ++m) S[m] = (f32x4){0.f, 0.f, 0.f, 0.f};
#pragma unroll 1
        for (int c = 0; c < NCHUNK; ++c) {
            S2_BAR();
            const LAS unsigned char* sl = lds + (c % S2_R) * S2_SLOT + S2_RW;
            const bool emit = c >= CTXL / CH;
            v2u Qw0[4], Qw1[4]; unsigned Iw[4]; v4u kw[2]; f32x4 d0[2], d1[2];
#pragma unroll
            for (int s2 = 0; s2 < 2; ++s2) { kw[s2] = *(const LAS v4u*)(sl + 4096 + (rr * 8 + ((4 * s2 + q) ^ (rr & 7))) * 16);
                d0[s2] = *(const LAS f32x4*)(sl + 7168 + 128 * s2 + 32 * q); d1[s2] = *(const LAS f32x4*)(sl + 7168 + 128 * s2 + 32 * q + 16); }
            if (emit) {
#pragma unroll
                for (int tt = 0; tt < 4; ++tt) { const int t = 16 * tt + rr;
                    Qw0[tt] = *(const LAS v2u*)(sl + (t * 4 + ((q >> 1) ^ (t & 3))) * 16 + (q & 1) * 8); Qw1[tt] = *(const LAS v2u*)(sl + (t * 4 + ((2 + (q >> 1)) ^ (t & 3))) * 16 + (q & 1) * 8);
                    Iw[tt] = *(const LAS unsigned*)(sl + 6144 + t * 16 + q * 4); }
            }
            const bf16x8 Sf0 = pack_frag(S[0], S[1]), Sf1 = pack_frag(S[2], S[3]);
            __builtin_amdgcn_sched_barrier(0);
#pragma unroll
            for (int s2 = 0; s2 < 2; ++s2) { S[2 * s2] = S[2 * s2] * d0[s2] + unpack4((v2u){kw[s2].x, kw[s2].y}); S[2 * s2 + 1] = S[2 * s2 + 1] * d1[s2] + unpack4((v2u){kw[s2].z, kw[s2].w}); }
            if (emit) {
#pragma unroll
                for (int tt = 0; tt < 4; ++tt) { const int t = 16 * tt + rr;
                    const bf16x8 Q0 = pack_frag(unpack4_fp8(Qw0[tt].x), unpack4_fp8(Qw0[tt].y)), Q1 = pack_frag(unpack4_fp8(Qw1[tt].x), unpack4_fp8(Qw1[tt].y));
                    f32x4 acc = unpack4_fp8(Iw[tt]);
                    acc = __builtin_amdgcn_mfma_f32_16x16x32_bf16(Sf0, Q0, acc, 0, 0, 0);
                    acc = __builtin_amdgcn_mfma_f32_16x16x32_bf16(Sf1, Q1, acc, 0, 0, 0);
                    const int row = scan_row(c * CH + t, gb, gdir);
                    *(v2u*)(OGL + (size_t)row * RWW + gh * 128 + v0g + 4 * q) = pack4(acc); }
            }
        }
    }
#undef S2_BAR
}
#endif

#ifndef ML
#define ML 0
#endif
enum Phase { PH_PROLOGUE = 0, PH_A1, PH_INPROJ, PH_FEAT, PH_LORA, PH_SCAN1, PH_SCAN2, PH_MERGE, PH_BRANCH, PH_OUTPROJ, PH_LN1, PH_ROUTER, PH_ROUTE, PH_SCATTER, PH_EXP1, PH_EXP2, PH_FINAL, PH_COUNT };

__global__ void __launch_bounds__(NTHR, 2) mega(Args args) {
    extern __shared__ __attribute__((aligned(16))) unsigned char lds_raw[];
    Frame F;
    F.lds = (LAS unsigned char*)lds_raw;
    F.tid = threadIdx.x; F.lane = F.tid & 63; F.wave = __builtin_amdgcn_readfirstlane(F.tid >> 6);
    F.G = gridDim.x; F.gw = blockIdx.x * NWAVES + F.wave; F.NGW = F.G * NWAVES;
    F.in = args.in; F.out = args.out; F.ws = args.ws; F.ctl = (unsigned*)(args.ws + WS_CTL);
    volatile LAS unsigned* MISC = (volatile LAS unsigned*)(F.lds + MISC_OFF);
    if (F.tid < 64) MISC[F.tid] = 0u;
    __syncthreads();
    XcdBarrier bar; bar.bar = F.ctl + CW_BAR; bar.x = 0; bar.st = nullptr;
#if !ML
    bar = xcd_barrier_post(F.ctl + CW_BAR, MISC + 8);
#endif
    const int lo = args.ph_lo, hi = args.ph_hi;
#define IN(k) (lo <= (k) && (k) < hi)
#ifndef DUP
#define DUP -1
#endif
#define RUN(k, call) do { if (IN(k)) { call; GRID_BAR(); if (DUP == (k)) { call; GRID_BAR(); } } } while (0)
#if ML
#define GRID_BAR() do { } while (0)
#else
#define GRID_BAR() xcd_barrier(bar)
#endif

#if MS >= 2
    RUN(PH_PROLOGUE, ph_prologue(F));
#endif
#if MS >= 3
    RUN(PH_A1, ph_a1(F));
    RUN(PH_INPROJ, ph_inproj(F));
    RUN(PH_FEAT, ph_feat(F));
    RUN(PH_LORA, ph_lora(F));
    RUN(PH_SCAN1, ph_scan1(F));
    RUN(PH_SCAN2, ph_scan2(F));
    RUN(PH_MERGE, ph_merge(F));
    RUN(PH_BRANCH, ph_branch(F));
    RUN(PH_OUTPROJ, ph_outproj(F));
#else
    RUN(PH_OUTPROJ, ph_x1pre_nomix(F));
#endif
    RUN(PH_LN1, ph_ln1(F));
#if MS >= 2
    RUN(PH_ROUTER, ph_router(F));
    RUN(PH_ROUTE, ph_route(F));
    RUN(PH_SCATTER, ph_scatter(F));
    RUN(PH_EXP1, ph_exp1(F));
    RUN(PH_EXP2, ph_exp2(F));
#endif
    if (IN(PH_FINAL)) { ph_final(F); }
#undef IN
}

extern "C" void kernel_launch(void* const* d_in, const int* in_sizes, int n_in, void* d_out, int out_size, void* d_ws, size_t ws_size, hipStream_t stream) {
    static int grid = 0;
    if (grid == 0) {
        if (n_in != 36 || out_size != NLAT * D || ws_size < WS_END) { fprintf(stderr, "kernel_launch: unexpected problem shape (n_in %d, out %d)\n", n_in, out_size); grid = -1; return; }
        int dev = 0, cus = 0, per_cu = 0;
        if (hipGetDevice(&dev) != hipSuccess || hipDeviceGetAttribute(&cus, hipDeviceAttributeMultiprocessorCount, dev) != hipSuccess) { grid = -1; return; }
        if (hipFuncSetAttribute((const void*)mega, hipFuncAttributeMaxDynamicSharedMemorySize, LDS_BYTES) != hipSuccess) { fprintf(stderr, "kernel_launch: hipFuncSetAttribute failed\n"); grid = -1; return; }
        if (hipOccupancyMaxActiveBlocksPerMultiprocessor(&per_cu, (const void*)mega, NTHR, LDS_BYTES) != hipSuccess || per_cu < 1) { fprintf(stderr, "kernel_launch: occupancy query says %d\n", per_cu); }
        (void)hipGetLastError();
        grid = cus > 0 ? cus : 256;
        if (grid > 256) grid = 256;
    }
    if (grid < 0) return;
    (void)hipMemsetAsync((char*)d_ws + WS_CTL, 0, CTL_ZERO_BYTES, stream);
    Args a{};
    for (int i = 0; i < 36; ++i) a.in[i] = (const float*)d_in[i];
    a.out = (float*)d_out; a.ws = (unsigned char*)d_ws;
#if ML
    for (int p = 0; p < PH_COUNT; ++p) { a.ph_lo = p; a.ph_hi = p + 1; hipLaunchKernelGGL(mega, dim3(grid), dim3(NTHR), LDS_BYTES, stream, a); }
#else
    a.ph_lo = 0; a.ph_hi = PH_COUNT;
    hipLaunchKernelGGL(mega, dim3(grid), dim3(NTHR), LDS_BYTES, stream, a);
#endif
}
```

```cpp
#include <hip/hip_runtime.h>
#include <cstdio>
#include <cstdint>

#ifndef MS
#define MS 3
#endif

#define GAS __attribute__((address_space(1)))
#define LAS __attribute__((address_space(3)))
typedef unsigned short bf16;
typedef unsigned v4u __attribute__((ext_vector_type(4)));
typedef unsigned v2u __attribute__((ext_vector_type(2)));
typedef float f32x4 __attribute__((ext_vector_type(4)));
typedef float f32x2 __attribute__((ext_vector_type(2)));
typedef short bf16x8 __attribute__((ext_vector_type(8)));
#define LDS_WAIT() asm volatile("s_waitcnt lgkmcnt(0)" ::: "memory")
#define VM_WAIT() asm volatile("s_waitcnt vmcnt(0)" ::: "memory")

constexpr int D = 1024, NB = 4, SEQ = 8192, CTXL = 256, GRIDW = 64, GRIDH = 128;
constexpr int NLAT = NB * SEQ, NCTX = NB * CTXL, MR = NLAT + NCTX;
constexpr int RWW = 512, RWH = 8, HD = 64;
constexpr int C_R = 0, C_K = 512, C_V = 1024, C_PW = 1536, C_PA = 1568, C_PG = 1600, C_Q = 1696, C_KG = 1952, C_VG = 2208, C_PGL = 2720, C_OG = 2736, C_GRW = 3248, C_GGLA = 4272;
constexpr int IN_COLS = 5296, NP = 5376;
constexpr int NE = 256, TOPK = 8, FF = 256;
constexpr float LN_EPS = 1e-5f, RW_GN_EPS = 64e-5f;
constexpr float ALPHA = 1.189207115f;
constexpr float W8S = 64.0f, W8I = 1.0f / 64.0f;
constexpr int NLORA = 3072, KLORA = 256;
constexpr int MAXTILES = 1280, SH_ROW0 = MAXTILES * 256, NROWS_E = SH_ROW0 + NLAT;

namespace pg8 {
#define PG8_LAS __attribute__((address_space(3)))
typedef unsigned short bf16_t;
typedef unsigned u32x4 __attribute__((ext_vector_type(4)));
typedef unsigned u32x2 __attribute__((ext_vector_type(2)));
typedef long i64x2 __attribute__((ext_vector_type(2)));
constexpr int BM = 256, BK = 64, HALF = 128, HTB = HALF * BK * 2, STAGE_BYTES = 8 * HTB, NXCD = 8, WGM = 8;
constexpr int IDX_OFF = STAGE_BYTES, IDX_UNITS = 12;

__host__ __device__ __forceinline__ int lds_byte(int r, int c) { const int st = (r >> 4) * 2 + (c >> 5), rr = r & 15, cc = c & 31, ob = rr * 64 + cc * 2; return st * 1024 + (ob ^ (((ob >> 9) & 1) << 5)); }
__host__ __device__ __forceinline__ void stage_rc(int b, int& R, int& C) { const int st = b / 1024, sb = b % 1024, swz = sb ^ (((sb >> 9) & 1) << 5); R = (st >> 1) * 16 + swz / 64; C = (st & 1) * 32 + (swz % 64) / 2; }
__host__ __device__ __forceinline__ int perm32(int rho) { const int n = rho >> 4, i = rho & 15; return 8 * (i >> 2) + 4 * n + (i & 3); }

struct Unit { int pm, pn, e, j; };
struct Gemm { const bf16_t* A; const bf16_t* Bt; int M, N, K; const int* rowidx; };

struct StaticOrder {
    int nM, nN, nwg, G, c;
    __host__ __device__ void init(int M, int N, int G_, int c_) { nM = M / BM; nN = N / BM; nwg = nM * nN; G = G_; c = c_; }
    __host__ __device__ bool next(int i, Unit& u) const {
        const long L = (long)i * G + c; if (L >= nwg) return false;
        int wgid = (int)L; { const int q = nwg / NXCD, r = nwg % NXCD, xcd = wgid % NXCD, off = wgid / NXCD; wgid = (xcd < r ? xcd * (q + 1) : r * (q + 1) + (xcd - r) * q) + off; }
        const int nig = WGM * nN, gid = wgid / nig, fm = gid * WGM, gsz = (nM - fm) < WGM ? (nM - fm) : WGM;
        u.pm = fm + ((wgid % nig) % gsz); u.pn = (wgid % nig) / gsz; u.e = 0; u.j = u.pn; return true;
    }
};
struct MoeOrder {
    int nN, G, c, NT; const int* tile_e;
    __device__ bool next(int i, Unit& u) const {
        const int L = i * G + c; const int total = (NT + NLAT / 256) * nN; if (L >= total) return false;
        const int tile = L / nN, j = L - tile * nN; int e, pm;
        if (tile < NT) { e = tile_e[tile]; pm = tile; } else { e = NE; pm = MAXTILES + (tile - NT); }
        u.pm = pm; u.pn = e * nN + j; u.e = e; u.j = j; return true;
    }
};

typedef __bf16 bf16x2n __attribute__((ext_vector_type(2))); typedef float f32x2n __attribute__((ext_vector_type(2)));
__device__ __forceinline__ unsigned cvt_pk_bf16(float lo, float hi) { const f32x2n v = {lo, hi}; return __builtin_bit_cast(unsigned, __builtin_convertvector(v, bf16x2n)); }

template <class Epi, class Sched, bool ALIGN_EPI, bool SP2, bool GATHER, bool FP8 = false>
__device__ __forceinline__ void gemm_phase(PG8_LAS unsigned char* lds, const Gemm g, const Sched& S, const Epi& E) {
    const int tid = threadIdx.x, wid = __builtin_amdgcn_readfirstlane(tid >> 6), lane = tid & 63, wr = wid >> 2, wc = wid & 3, fr = lane & 15, fq = lane >> 4;
    const int K = g.K, nt = K / BK;
    const size_t kstep = (size_t)(BK * 2);
    const size_t hstep = (size_t)HALF * K * 2;
    const size_t tstep = 2 * hstep;
    unsigned voffB[2]; unsigned va[2][2];
#pragma unroll
    for (int i = 0; i < 2; ++i) { int R, C; stage_rc(tid * 16 + i * 8192, R, C); const int Rb = Epi::PERM ? ((R & ~31) + perm32(R & 31)) : R;
        voffB[i] = (unsigned)(Rb * K + C) * 2u;
        va[0][i] = (unsigned)(R * K + C) * 2u; va[1][i] = va[0][i]; }
    const size_t ah = GATHER ? (size_t)0 : hstep;
#define PG8_GOFF(dst, ub) do { _Pragma("unroll") for (int _h = 0; _h < 2; ++_h) _Pragma("unroll") for (int _i = 0; _i < 2; ++_i) { int _R, _C; stage_rc(tid * 16 + _i * 8192, _R, _C); \
        dst[_h][_i] = (unsigned)(idxt[(ub) * 256 + _h * 128 + _R] * K + _C) * 2u; } } while (0)
    const unsigned ldsw = (unsigned)wid * 1024u;
    const int aoff = lds_byte(wr * 64 + fr, fq * 8), boff = lds_byte(wc * 32 + fr, fq * 8);
    PG8_LAS int* idxt = (PG8_LAS int*)(lds + IDX_OFF);
#define PG8_SA(b, h) (((b) * 2 + (h)) * HTB)
#define PG8_SB(b, h) ((4 + (b) * 2 + (h)) * HTB)
#define PG8_STAGE(bufoff, gbase, voff) do { _Pragma("unroll") for (int _i = 0; _i < 2; ++_i) \
        __builtin_amdgcn_global_load_lds((const unsigned*)((const char*)(gbase) + (voff)[_i]), (PG8_LAS unsigned*)(lds + (bufoff) + ldsw + _i * 8192), 16, 0, 0); } while (0)
#define PG8_LDA(dst, b, h) do { _Pragma("unroll") for (int m = 0; m < 4; ++m) _Pragma("unroll") for (int k = 0; k < 2; ++k) dst[m][k] = *(const PG8_LAS bf16x8*)(lds + PG8_SA(b, h) + aoff + m * 2048 + k * 1024); } while (0)
#define PG8_LDB(dst, b, h) do { _Pragma("unroll") for (int n = 0; n < 2; ++n) _Pragma("unroll") for (int k = 0; k < 2; ++k) dst[n][k] = *(const PG8_LAS bf16x8*)(lds + PG8_SB(b, h) + boff + n * 2048 + k * 1024); } while (0)
#define PG8_MMA(ai, bj, At, Bt) do { __builtin_amdgcn_s_setprio(1); _Pragma("unroll") for (int m = 0; m < 4; ++m) _Pragma("unroll") for (int n = 0; n < 2; ++n) _Pragma("unroll") for (int k = 0; k < 2; ++k) { \
        if constexpr (FP8) { const i64x2 _b = __builtin_bit_cast(i64x2, Bt[n][k]), _a = __builtin_bit_cast(i64x2, At[m][k]); \
            acc[ai][bj][m][n] = __builtin_amdgcn_mfma_f32_16x16x32_fp8_fp8(_b[0], _a[0], acc[ai][bj][m][n], 0, 0, 0); acc[ai][bj][m][n] = __builtin_amdgcn_mfma_f32_16x16x32_fp8_fp8(_b[1], _a[1], acc[ai][bj][m][n], 0, 0, 0); } \
        else acc[ai][bj][m][n] = __builtin_amdgcn_mfma_f32_16x16x32_bf16(Bt[n][k], At[m][k], acc[ai][bj][m][n], 0, 0, 0); } __builtin_amdgcn_s_setprio(0); } while (0)
#define PG8_WAIT_V(n) asm volatile("s_waitcnt vmcnt(" #n ")" ::: "memory")
#define PG8_WAIT_L(n) asm volatile("s_waitcnt lgkmcnt(" #n ")" ::: "memory")
#define PG8_BAR __builtin_amdgcn_s_barrier()
#define PG8_SCHED __builtin_amdgcn_sched_barrier(0)
    Unit cur, nxt; int ui = 0;
    if (!S.next(0, cur)) return;
#ifdef GEMM_STAGGER
    if constexpr (FP8) {
        const unsigned long long t0 = __builtin_amdgcn_s_memrealtime(); const unsigned long long dl = (unsigned long long)(blockIdx.x & 3) * GEMM_STAGGER;
        while (__builtin_amdgcn_s_memrealtime() - t0 < dl) __builtin_amdgcn_s_sleep(8);
    }
#endif
    if constexpr (GATHER) {
        Unit uu;
        for (int i = 0; i < IDX_UNITS; ++i) { if (!S.next(i, uu)) break; if (tid < 256) idxt[i * 256 + tid] = g.rowidx[(size_t)uu.pm * 256 + tid]; }
        asm volatile("s_waitcnt vmcnt(0) lgkmcnt(0)" ::: "memory"); PG8_BAR; asm volatile("" ::: "memory");
        PG8_GOFF(va, 0);
    }
    f32x4 acc[2][2][4][2];
#pragma unroll
    for (int a = 0; a < 2; ++a)
#pragma unroll
        for (int b = 0; b < 2; ++b)
#pragma unroll
            for (int m = 0; m < 4; ++m)
#pragma unroll
                for (int n = 0; n < 2; ++n) acc[a][b][m][n] = (f32x4){0.f, 0.f, 0.f, 0.f};
    bf16x8 At[4][2], B0[2][2], B1[2][2];
    const char* cA = (const char*)g.A + (GATHER ? (size_t)0 : (size_t)cur.pm * tstep); const char* cB = (const char*)g.Bt + (size_t)cur.pn * tstep;
    if constexpr (SP2) {
        PG8_STAGE(PG8_SB(0, 0), cB, voffB); PG8_STAGE(PG8_SB(0, 1), cB + hstep, voffB); PG8_STAGE(PG8_SA(0, 0), cA, va[0]); PG8_STAGE(PG8_SA(0, 1), cA + ah, va[1]);
        if (wr == 1) PG8_BAR;
        PG8_WAIT_V(2); PG8_BAR;
        PG8_STAGE(PG8_SB(1, 0), cB + kstep, voffB); PG8_STAGE(PG8_SA(1, 0), cA + kstep, va[0]); PG8_STAGE(PG8_SB(1, 1), cB + hstep + kstep, voffB);
        PG8_WAIT_V(6); PG8_BAR;
    } else {
        PG8_STAGE(PG8_SB(0, 0), cB, voffB); PG8_STAGE(PG8_SA(0, 0), cA, va[0]); PG8_STAGE(PG8_SB(0, 1), cB + hstep, voffB); PG8_STAGE(PG8_SA(0, 1), cA + ah, va[1]);
        if (wr == 1) PG8_BAR;
        PG8_WAIT_V(4); PG8_BAR;
        PG8_STAGE(PG8_SB(1, 0), cB + kstep, voffB); PG8_STAGE(PG8_SA(1, 0), cA + kstep, va[0]); PG8_STAGE(PG8_SB(1, 1), cB + hstep + kstep, voffB);
        PG8_WAIT_V(6); PG8_BAR;
    }
    for (;;) {
        const bool has_next = S.next(ui + 1, nxt);
        const char* nA = has_next ? (const char*)g.A + (GATHER ? (size_t)0 : (size_t)nxt.pm * tstep) : cA; const char* nB = has_next ? (const char*)g.Bt + (size_t)nxt.pn * tstep : cB;
        const int ubn = (has_next && ui + 1 < IDX_UNITS) ? (ui + 1) : ui;
#pragma unroll 1
        for (int t = 0; t < nt; t += 2) {
            const bool last = (t == nt - 2);
            const char* a1 = cA + (size_t)(t + 1) * kstep;
            const char* a2 = last ? nA : cA + (size_t)(t + 2) * kstep; const char* b2 = last ? nB : cB + (size_t)(t + 2) * kstep;
            const char* a3 = a2 + kstep; const char* b3 = b2 + kstep;
            unsigned v2[2][2];
#pragma unroll
            for (int h = 0; h < 2; ++h)
#pragma unroll
                for (int i = 0; i < 2; ++i) v2[h][i] = va[h][i];
            if constexpr (GATHER) { if (last) PG8_GOFF(v2, ubn); }
            if constexpr (SP2) {
            PG8_LDB(B0, 0, 0); PG8_LDB(B1, 0, 1); PG8_SCHED; PG8_LDA(At, 0, 0); PG8_STAGE(PG8_SA(1, 1), a1 + ah, va[1]);
            PG8_WAIT_V(8); PG8_WAIT_L(0); PG8_BAR; PG8_MMA(0, 0, At, B0); PG8_MMA(0, 1, At, B1); PG8_BAR; PG8_SCHED;
            PG8_LDA(At, 0, 1); PG8_STAGE(PG8_SB(0, 0), b2, voffB); PG8_STAGE(PG8_SB(0, 1), b2 + hstep, voffB); PG8_STAGE(PG8_SA(0, 0), a2, v2[0]);
            PG8_WAIT_V(8); PG8_WAIT_L(0); PG8_BAR; PG8_MMA(1, 0, At, B0); PG8_MMA(1, 1, At, B1); PG8_BAR; PG8_SCHED;
            PG8_LDB(B0, 1, 0); PG8_LDB(B1, 1, 1); PG8_SCHED; PG8_LDA(At, 1, 0); PG8_STAGE(PG8_SA(0, 1), a2 + ah, v2[1]);
            PG8_WAIT_V(8); PG8_WAIT_L(0); PG8_BAR; PG8_MMA(0, 0, At, B0); PG8_MMA(0, 1, At, B1); PG8_BAR; PG8_SCHED;
            PG8_LDA(At, 1, 1); PG8_STAGE(PG8_SB(1, 0), b3, voffB); PG8_STAGE(PG8_SB(1, 1), b3 + hstep, voffB); PG8_STAGE(PG8_SA(1, 0), a3, v2[0]);
            PG8_WAIT_V(8); PG8_WAIT_L(0); PG8_BAR; PG8_MMA(1, 0, At, B0); PG8_MMA(1, 1, At, B1); PG8_BAR; PG8_SCHED;
            } else {
            PG8_LDB(B0, 0, 0); PG8_SCHED; PG8_LDA(At, 0, 0); PG8_STAGE(PG8_SA(1, 1), a1 + ah, va[1]);
            PG8_WAIT_L(8); PG8_BAR; PG8_WAIT_L(0); PG8_MMA(0, 0, At, B0); PG8_BAR; PG8_SCHED;
            PG8_LDB(B1, 0, 1); PG8_STAGE(PG8_SB(0, 0), b2, voffB);
            PG8_BAR; PG8_WAIT_L(0); PG8_MMA(0, 1, At, B1); PG8_BAR;
            PG8_LDA(At, 0, 1); PG8_STAGE(PG8_SA(0, 0), a2, v2[0]);
            PG8_BAR; PG8_WAIT_L(0); PG8_MMA(1, 0, At, B0); PG8_BAR; PG8_SCHED;
            PG8_STAGE(PG8_SB(0, 1), b2 + hstep, voffB);
            PG8_WAIT_V(6); PG8_BAR; PG8_MMA(1, 1, At, B1); PG8_BAR;
            PG8_LDB(B0, 1, 0); PG8_SCHED; PG8_LDA(At, 1, 0); PG8_STAGE(PG8_SA(0, 1), a2 + ah, v2[1]);
            PG8_WAIT_L(8); PG8_BAR; PG8_WAIT_L(0); PG8_MMA(0, 0, At, B0); PG8_BAR; PG8_SCHED;
            PG8_LDB(B1, 1, 1); PG8_STAGE(PG8_SB(1, 0), b3, voffB);
            PG8_BAR; PG8_WAIT_L(0); PG8_MMA(0, 1, At, B1); PG8_BAR;
            PG8_LDA(At, 1, 1); PG8_STAGE(PG8_SA(1, 0), a3, v2[0]);
            PG8_BAR; PG8_WAIT_L(0); PG8_MMA(1, 0, At, B0); PG8_BAR; PG8_SCHED;
            PG8_STAGE(PG8_SB(1, 1), b3 + hstep, voffB);
            PG8_WAIT_V(6); PG8_BAR; PG8_MMA(1, 1, At, B1); PG8_BAR;
            }
        }
        if constexpr (ALIGN_EPI) { if (wr == 0) PG8_BAR; }
        E(acc, cur, wr, wc, fr, fq);
        if (!has_next) break;
#pragma unroll
        for (int a = 0; a < 2; ++a)
#pragma unroll
            for (int b = 0; b < 2; ++b)
#pragma unroll
                for (int m = 0; m < 4; ++m)
#pragma unroll
                    for (int n = 0; n < 2; ++n) acc[a][b][m][n] = (f32x4){0.f, 0.f, 0.f, 0.f};
        cur = nxt; cA = nA; cB = nB; ++ui;
        if constexpr (GATHER) PG8_GOFF(va, ubn);
        if constexpr (ALIGN_EPI) { if (wr == 1) PG8_BAR; }
    }
    PG8_WAIT_V(0);
    if constexpr (!ALIGN_EPI) { if (wr == 0) PG8_BAR; }
    PG8_BAR;
#undef PG8_SA
#undef PG8_GOFF
#undef PG8_SB
#undef PG8_STAGE
#undef PG8_LDA
#undef PG8_LDB
#undef PG8_MMA
#undef PG8_WAIT_V
#undef PG8_WAIT_L
#undef PG8_BAR
#undef PG8_SCHED
}
}

#define XB_TMO      128
#define XB_XCNT(j)  (256  + 64 * (j))
#define XB_XSUB(j)  (1280 + 64 * (j))
#define XB_XGEN(j)  (2304 + 64 * (j))
#define XB_TOP      3328
#define XB_TOPGEN   3392
#define XCD_BAR_WORDS 3456
#define XB_SPIN_CAP (1u << 18)
__device__ __forceinline__ unsigned xb_ld(unsigned* p)              { return __hip_atomic_load(p, __ATOMIC_RELAXED, __HIP_MEMORY_SCOPE_AGENT); }
__device__ __forceinline__ unsigned xb_add(unsigned* p, unsigned v) { return __hip_atomic_fetch_add(p, v, __ATOMIC_RELAXED, __HIP_MEMORY_SCOPE_AGENT); }
__device__ __forceinline__ unsigned xb_xcc_id() { return (unsigned)__builtin_amdgcn_s_getreg((3 << 11) | 20) & 0xFu; }
#define XB_SPIN(cond, bar) do { unsigned _sp = 0; while (cond) { __builtin_amdgcn_s_sleep(1); \
    if ((++_sp & 255u) == 0u) { if (xb_ld(&(bar)[XB_TMO])) break; if (_sp > XB_SPIN_CAP) { atomicAdd(&(bar)[XB_TMO], 1u); break; } } } } while (0)
struct XcdBarrier { unsigned* bar; unsigned x; volatile LAS unsigned* st; };
__device__ __forceinline__ XcdBarrier xcd_barrier_post(unsigned* bar, volatile LAS unsigned* st) {
    XcdBarrier b; b.bar = bar; b.x = xb_xcc_id(); b.st = st;
    if (threadIdx.x == 0) (void)xb_add(&bar[XB_XCNT(b.x)], 1u);
    return b;
}
__device__ __forceinline__ void xcd_barrier_complete(unsigned* bar, unsigned x, unsigned& nloc, unsigned& nx) {
    const unsigned G = gridDim.x * gridDim.y * gridDim.z;
    unsigned sum, cnt, mine, sp = 0u;
    for (;;) {
        sum = 0u; cnt = 0u; mine = 0u;
#pragma unroll
        for (unsigned j = 0; j < 16; ++j) { const unsigned c = xb_ld(&bar[XB_XCNT(j)]); sum += c; cnt += (c > 0u) ? 1u : 0u; mine = (j == x) ? c : mine; }
        if (sum == G) break;
        __builtin_amdgcn_s_sleep(1);
        if ((++sp & 255u) == 0u) { if (xb_ld(&bar[XB_TMO])) break; if (sp > XB_SPIN_CAP) { atomicAdd(&bar[XB_TMO], 1u); break; } }
    }
    nloc = mine > 0u ? mine : 1u; nx = cnt > 0u ? cnt : 1u;
}
__device__ __forceinline__ void xcd_barrier(const XcdBarrier& b) {
    asm volatile("s_waitcnt vmcnt(0)" ::: "memory");
    __syncthreads();
    if (threadIdx.x == 0) {
        unsigned* bar = b.bar;
        __builtin_amdgcn_s_waitcnt(0);
        unsigned nloc = b.st[0], nx = b.st[1];
        if (nloc == 0u) { xcd_barrier_complete(bar, b.x, nloc, nx); b.st[0] = nloc; b.st[1] = nx; }
        const unsigned old = xb_add(&bar[XB_XSUB(b.x)], 1u);
        const unsigned gen = old / nloc;
        if (old + 1u == (gen + 1u) * nloc) {
            __builtin_amdgcn_fence(__ATOMIC_RELEASE, "agent");
            asm volatile("s_waitcnt vmcnt(0)" ::: "memory");
            const unsigned og = xb_add(&bar[XB_TOP], 1u);
            const unsigned tg = og / nx;
            if (og + 1u == (tg + 1u) * nx) xb_add(&bar[XB_TOPGEN], 1u);
            else XB_SPIN(xb_ld(&bar[XB_TOPGEN]) == tg, bar);
            __builtin_amdgcn_fence(__ATOMIC_ACQUIRE, "agent");
            xb_add(&bar[XB_XGEN(b.x)], 1u);
            asm volatile("s_waitcnt vmcnt(0)" ::: "memory");
        } else {
            XB_SPIN(xb_ld(&bar[XB_XGEN(b.x)]) == gen, bar);
            __builtin_amdgcn_fence(__ATOMIC_ACQUIRE, "agent");
            asm volatile("s_waitcnt vmcnt(0)" ::: "memory");
        }
    }
    __syncthreads();
}

constexpr size_t MiB = 1u << 20;
constexpr size_t al(size_t x) { return (x + 4095) & ~(size_t)4095; }
constexpr size_t WS_CTL = 0, CTL_ZERO_BYTES = 1 * MiB;
constexpr int CW_BAR = 4096;
constexpr int CW_CNT = 16384, CNT_STRIDE = 64;
constexpr int CW_NT = CW_CNT + NE * CNT_STRIDE + 64;
static_assert((CW_NT + 1) * 4 <= (int)CTL_ZERO_BYTES, "control words inside the per-call memset");
constexpr size_t WS_MOD = 1 * MiB;
constexpr size_t WS_TILE_E = WS_MOD + 256 * 1024;
constexpr size_t WS_PADSTART = WS_TILE_E + 16 * 1024;
constexpr size_t WS_ROWTOK = 2 * MiB;
constexpr size_t WS_EIDX = 4 * MiB;
constexpr size_t WS_GATE = 5 * MiB;
constexpr size_t WS_DEST = 6 * MiB;
constexpr size_t WS_WIN = 8 * MiB;
constexpr size_t WS_WLORA = WS_WIN + al((size_t)NP * D * 2);
constexpr size_t WS_WBRRW = WS_WLORA + al((size_t)NLORA * KLORA * 2);
constexpr size_t WS_WBRGLA = WS_WBRRW + al((size_t)D * RWW * 2);
constexpr size_t WS_WOUT = WS_WBRGLA + al((size_t)D * RWW * 2);
constexpr size_t WS_WROUTER = WS_WOUT + al((size_t)D * D * 2);
constexpr size_t WS_WGU = WS_WROUTER + al((size_t)NE * D * 2);
constexpr size_t WS_WD = WS_WGU + al((size_t)(NE + 1) * 512 * D * 2);
constexpr size_t WS_PERSIST_END = WS_WD + al((size_t)(NE + 1) * D * FF * 2);
constexpr size_t WS_REGB = WS_PERSIST_END;
constexpr size_t SZ512F = al((size_t)MR * RWW * 4), SZ256F = al((size_t)MR * 256 * 4), SZ512H = al((size_t)MR * RWW * 2);
constexpr size_t WS_A1 = WS_REGB;
constexpr size_t WS_A2 = WS_A1;
constexpr size_t WS_KSUM = WS_A2 + al((size_t)MR * KLORA * 2);
static_assert(WS_KSUM + SZ512H <= WS_A1 + al((size_t)MR * D * 2), "A2 + KSUM fit in the A1 slot");
constexpr size_t WS_P = WS_A1 + al((size_t)MR * D * 2);
constexpr size_t WS_RB = WS_P + al((size_t)MR * NP * 2);
constexpr size_t WS_VB = WS_RB + SZ512H, WS_KKB = WS_VB + SZ512H, WS_KMF = WS_KKB + SZ512H, WS_KMB = WS_KMF + SZ512H, WS_BVF = WS_KMB + SZ512H, WS_BVB = WS_BVF + SZ512H;
constexpr size_t WS_LWF = WS_BVB + SZ512H, WS_LWB = WS_LWF + SZ512F;
constexpr size_t SZ256H = al((size_t)MR * 256 * 2);
constexpr size_t WS_QGB = WS_LWB + SZ512F, WS_KGB = WS_QGB + SZ256H, WS_VGB = WS_KGB + SZ256H, WS_LAF = WS_VGB + SZ512H, WS_LAB = WS_LAF + SZ256F;
constexpr size_t WS_RWG = WS_LAB + SZ256F;
constexpr size_t WS_ORWF = WS_RWG + SZ512H, WS_ORWB = WS_ORWF + SZ512H, WS_OGLF = WS_ORWB + SZ512H, WS_OGLB = WS_OGLF + SZ512H;
constexpr int CH = 64, NCHUNK = (CTXL + SEQ) / CH, NU_RW = 64 * NCHUNK, NU_GL = 32 * NCHUNK;
constexpr size_t WS_RH = WS_OGLB + SZ512H;
constexpr size_t WS_YL = WS_RH + al((size_t)NU_RW * 4096 * 2);
constexpr size_t WS_HH = WS_YL + al((size_t)NU_RW * 4096 * 2);
constexpr size_t WS_INTRA = WS_HH + al((size_t)NU_RW * 4096 * 2);
constexpr size_t WS_KV = WS_INTRA + al((size_t)NU_GL * 8192 * 2);
constexpr size_t WS_DD = WS_KV + al((size_t)NU_GL * 8192 * 2);
constexpr size_t WS_END_MIX = WS_DD + al((size_t)NU_GL * 64 * 4);
constexpr size_t OUT_GT = 0, OUT_QE = (size_t)NU_RW * 4096 * 2;
static_assert(OUT_QE + (size_t)NU_GL * 4096 * 2 <= (size_t)NLAT * D * 4, "scan scratch fits in d_out");
constexpr size_t WS_YRW = WS_LWF, WS_YGLA = WS_LWB, WS_Z = WS_HH;
static_assert((size_t)NLAT * D * 2 <= (size_t)NU_RW * 4096 * 2, "Z fits in the HH slot");
constexpr size_t WS_X1 = WS_REGB;
constexpr size_t WS_A3 = WS_X1 + al((size_t)NLAT * D * 4);
constexpr size_t WS_LOGITS = WS_A3 + al((size_t)NLAT * D * 2);
constexpr size_t WS_ACT = WS_LOGITS + al((size_t)NLAT * NE * 4);
constexpr size_t WS_Y = WS_ACT + al((size_t)NROWS_E * FF * 2);
constexpr size_t WS_A3F = WS_Y + al((size_t)NROWS_E * D);
constexpr size_t WS_END_MOE = WS_A3F + al((size_t)NLAT * D);
constexpr size_t WS_END = WS_END_MIX > WS_END_MOE ? WS_END_MIX : WS_END_MOE;
static_assert(WS_END <= (size_t)2048 * MiB, "workspace map exceeds 2 GiB");

constexpr int RING_BYTES = 131072;
constexpr int IDX_BYTES = pg8::IDX_UNITS * 256 * 4;
constexpr int MISC_OFF = RING_BYTES + IDX_BYTES;
constexpr int LDS_BYTES = MISC_OFF + 256;
static_assert(pg8::IDX_OFF == RING_BYTES, "gather table sits right above the stage buffers");
constexpr int NWAVES = 8, NTHR = 512;

struct Args { const float* in[36]; float* out; unsigned char* ws; int ph_lo, ph_hi; };

struct Frame {
    LAS unsigned char* lds;
    int tid, lane, wave, G, gw, NGW;
    const float* const* in; float* out; unsigned char* ws; unsigned* ctl;
};

__device__ __forceinline__ float wave_sum(float v) {
#pragma unroll
    for (int o = 1; o < 64; o <<= 1) v += __shfl_xor(v, o);
    return v;
}
__device__ __forceinline__ unsigned f2bf(float f) { unsigned u = __builtin_bit_cast(unsigned, f); return (u + 0x7fffu + ((u >> 16) & 1u)) >> 16; }
typedef __bf16 bf16x2v __attribute__((ext_vector_type(2)));
__device__ __forceinline__ unsigned pk2(float lo, float hi) { const f32x2 v = {lo, hi}; return __builtin_bit_cast(unsigned, __builtin_convertvector(v, bf16x2v)); }
__device__ __forceinline__ float bflo(unsigned w) { return __builtin_bit_cast(float, w << 16); }
__device__ __forceinline__ float bfhi(unsigned w) { return __builtin_bit_cast(float, w & 0xffff0000u); }
__device__ __forceinline__ float sigmoidf_(float x) { return __builtin_amdgcn_rcpf(1.0f + __expf(-x)); }
__device__ __forceinline__ float siluf_(float x) { return x * __builtin_amdgcn_rcpf(1.0f + __expf(-x)); }
__device__ __forceinline__ float tanhf_(float x) { return 1.0f - 2.0f * __builtin_amdgcn_rcpf(1.0f + __expf(2.0f * x)); }
__device__ __forceinline__ float logsigmoidf_(float x) { return fminf(x, 0.f) - __logf(1.0f + __expf(-fabsf(x))); }

__device__ __forceinline__ void ln_stats(const f32x4 (&v)[4], float& mean, float& rstd) {
    float s = 0.f;
#pragma unroll
    for (int j = 0; j < 4; ++j) s += (v[j].x + v[j].y) + (v[j].z + v[j].w);
    mean = wave_sum(s) * (1.f / D); float s2 = 0.f;
#pragma unroll
    for (int j = 0; j < 4; ++j) { const f32x4 d = v[j] - mean; s2 += (d.x * d.x + d.y * d.y) + (d.z * d.z + d.w * d.w); }
    rstd = __builtin_amdgcn_rsqf(wave_sum(s2) * (1.f / D) + LN_EPS);
}

__device__ __forceinline__ unsigned pack_fp8x4(const f32x4 v) {
    int w = __builtin_amdgcn_cvt_pk_fp8_f32(__builtin_amdgcn_fmed3f(v[0], -448.f, 448.f), __builtin_amdgcn_fmed3f(v[1], -448.f, 448.f), 0, false);
    return (unsigned)__builtin_amdgcn_cvt_pk_fp8_f32(__builtin_amdgcn_fmed3f(v[2], -448.f, 448.f), __builtin_amdgcn_fmed3f(v[3], -448.f, 448.f), w, true); }
__device__ __forceinline__ void ld_row_bf16(const bf16* row, int lane, f32x4 (&v)[4]) {
    const v4u a = *(const v4u*)(row + 8 * lane), b = *(const v4u*)(row + 512 + 8 * lane);
    v[0] = (f32x4){bflo(a.x), bfhi(a.x), bflo(a.y), bfhi(a.y)}; v[1] = (f32x4){bflo(a.z), bfhi(a.z), bflo(a.w), bfhi(a.w)};
    v[2] = (f32x4){bflo(b.x), bfhi(b.x), bflo(b.y), bfhi(b.y)}; v[3] = (f32x4){bflo(b.z), bfhi(b.z), bflo(b.w), bfhi(b.w)};
}
__device__ __forceinline__ int rowcol(int lane, int j) { return 512 * (j >> 1) + 8 * lane + 4 * (j & 1); }
__device__ __forceinline__ void ph_x1pre_nomix(Frame& F) {
    const float* x = F.in[0];
    for (int m = F.gw; m < NLAT; m += F.NGW) {
        bf16* o = (bf16*)(F.ws + WS_X1) + (size_t)m * D;
#pragma unroll
        for (int h = 0; h < 2; ++h) { const float* xr = x + (size_t)m * D + 512 * h + 8 * F.lane; const f32x4 a = *(const f32x4*)xr * ALPHA, b = *(const f32x4*)(xr + 4) * ALPHA;
            v4u w; w.x = pk2(a.x, a.y); w.y = pk2(a.z, a.w); w.z = pk2(b.x, b.y); w.w = pk2(b.z, b.w); *(v4u*)(o + 512 * h + 8 * F.lane) = w; }
    }
}
__device__ __forceinline__ void ph_ln1(Frame& F) {
    const float* lw = F.in[26]; const float* lb = F.in[27]; const float* mod = (const float*)(F.ws + WS_MOD);
    bf16* A3 = (bf16*)(F.ws + WS_A3); const bf16* X1P = (const bf16*)(F.ws + WS_X1);
    constexpr int NR = 4;
    for (int m0 = F.gw; m0 < NLAT; m0 += NR * F.NGW) {
        v4u w[NR][2];
#pragma unroll
        for (int r = 0; r < NR; ++r) { const int mm = m0 + r * F.NGW; const bf16* row = X1P + (size_t)(mm < NLAT ? mm : m0) * D; w[r][0] = *(const v4u*)(row + 8 * F.lane); w[r][1] = *(const v4u*)(row + 512 + 8 * F.lane); }
        __builtin_amdgcn_sched_barrier(0);
#pragma unroll
        for (int r = 0; r < NR; ++r) { const int mm = m0 + r * F.NGW; const int m = mm < NLAT ? mm : m0; const int b = m / SEQ;
            f32x4 v[4];
            v[0] = (f32x4){bflo(w[r][0].x), bfhi(w[r][0].x), bflo(w[r][0].y), bfhi(w[r][0].y)}; v[1] = (f32x4){bflo(w[r][0].z), bfhi(w[r][0].z), bflo(w[r][0].w), bfhi(w[r][0].w)};
            v[2] = (f32x4){bflo(w[r][1].x), bfhi(w[r][1].x), bflo(w[r][1].y), bfhi(w[r][1].y)}; v[3] = (f32x4){bflo(w[r][1].z), bfhi(w[r][1].z), bflo(w[r][1].w), bfhi(w[r][1].w)};
            float mean, rstd; ln_stats(v, mean, rstd);
#if MS >= 2
            f32x4 h[4];
#pragma unroll
            for (int j = 0; j < 4; ++j) { const int c = rowcol(F.lane, j);
                const f32x4 x1 = (v[j] - mean) * rstd * *(const f32x4*)(lw + c) + *(const f32x4*)(lb + c);
                h[j] = x1 * (*(const f32x4*)(mod + b * 6144 + 4096 + c) + 1.0f) + *(const f32x4*)(mod + b * 6144 + 3072 + c); }
            bf16* ao = A3 + (size_t)m * D;
            { v4u o; o.x = pk2(h[0].x, h[0].y); o.y = pk2(h[0].z, h[0].w); o.z = pk2(h[1].x, h[1].y); o.w = pk2(h[1].z, h[1].w); *(v4u*)(ao + 8 * F.lane) = o;
              o.x = pk2(h[2].x, h[2].y); o.y = pk2(h[2].z, h[2].w); o.z = pk2(h[3].x, h[3].y); o.w = pk2(h[3].z, h[3].w); *(v4u*)(ao + 512 + 8 * F.lane) = o; }
            { unsigned char* af = F.ws + WS_A3F + (size_t)m * D; v2u o8;
              o8.x = pack_fp8x4(h[0]); o8.y = pack_fp8x4(h[1]); *(v2u*)(af + 8 * F.lane) = o8; o8.x = pack_fp8x4(h[2]); o8.y = pack_fp8x4(h[3]); *(v2u*)(af + 512 + 8 * F.lane) = o8; }
#endif
        }
    }
}
__device__ __forceinline__ f32x4 fp8x4(unsigned w) { const f32x2 lo = __builtin_amdgcn_cvt_pk_f32_fp8((int)w, false), hi = __builtin_amdgcn_cvt_pk_f32_fp8((int)w, true); return (f32x4){lo.x, lo.y, hi.x, hi.y}; }
__device__ __forceinline__ void ph_final(Frame& F) {
    const float* lw = F.in[34]; const float* lb = F.in[35]; const float* mod = (const float*)(F.ws + WS_MOD);
    const float* lw1 = F.in[26]; const float* lb1 = F.in[27]; const bf16* X1P = (const bf16*)(F.ws + WS_X1);
    const unsigned char* Y = F.ws + WS_Y; const int* DEST = (const int*)(F.ws + WS_DEST); const float* GATE = (const float*)(F.ws + WS_GATE);
    const int c0 = 16 * F.lane;
    for (int m0 = F.gw; m0 < NLAT; m0 += 2 * F.NGW) {
        int mm[2]; mm[0] = m0; mm[1] = (m0 + F.NGW < NLAT) ? m0 + F.NGW : m0;
        v4u xw[2][2];
#if MS >= 2
        v4u dw[2][2]; f32x4 gw[2][2];
#pragma unroll
        for (int r = 0; r < 2; ++r) { dw[r][0] = *(const v4u*)(DEST + mm[r] * 8); dw[r][1] = *(const v4u*)(DEST + mm[r] * 8 + 4); gw[r][0] = *(const f32x4*)(GATE + mm[r] * 8); gw[r][1] = *(const f32x4*)(GATE + mm[r] * 8 + 4); }
#endif
#pragma unroll
        for (int r = 0; r < 2; ++r) { const bf16* row = X1P + (size_t)mm[r] * D + c0; xw[r][0] = *(const v4u*)row; xw[r][1] = *(const v4u*)(row + 8); }
#if MS >= 2
        v4u yw[2][TOPK + 1];
#pragma unroll
        for (int r = 0; r < 2; ++r) {
            int dr[TOPK]; dr[0] = (int)dw[r][0].x; dr[1] = (int)dw[r][0].y; dr[2] = (int)dw[r][0].z; dr[3] = (int)dw[r][0].w; dr[4] = (int)dw[r][1].x; dr[5] = (int)dw[r][1].y; dr[6] = (int)dw[r][1].z; dr[7] = (int)dw[r][1].w;
#pragma unroll
            for (int k = 0; k <= TOPK; ++k) yw[r][k] = *(const v4u*)(Y + (size_t)(k < TOPK ? dr[k < TOPK ? k : 0] : SH_ROW0 + mm[r]) * D + c0); }
        __builtin_amdgcn_sched_barrier(0);
#endif
#pragma unroll
        for (int r = 0; r < 2; ++r) { const int m = mm[r]; const int b = m / SEQ;
            f32x4 v[4];
            v[0] = (f32x4){bflo(xw[r][0].x), bfhi(xw[r][0].x), bflo(xw[r][0].y), bfhi(xw[r][0].y)}; v[1] = (f32x4){bflo(xw[r][0].z), bfhi(xw[r][0].z), bflo(xw[r][0].w), bfhi(xw[r][0].w)};
            v[2] = (f32x4){bflo(xw[r][1].x), bfhi(xw[r][1].x), bflo(xw[r][1].y), bfhi(xw[r][1].y)}; v[3] = (f32x4){bflo(xw[r][1].z), bfhi(xw[r][1].z), bflo(xw[r][1].w), bfhi(xw[r][1].w)};
            { float mean1, rstd1; ln_stats(v, mean1, rstd1);
#pragma unroll
              for (int j = 0; j < 4; ++j) { const int c = c0 + 4 * j; v[j] = ((v[j] - mean1) * rstd1 * *(const f32x4*)(lw1 + c) + *(const f32x4*)(lb1 + c)) * ALPHA; } }
#if MS >= 2
            const float gt[TOPK] = {gw[r][0].x * 0.0625f, gw[r][0].y * 0.0625f, gw[r][0].z * 0.0625f, gw[r][0].w * 0.0625f, gw[r][1].x * 0.0625f, gw[r][1].y * 0.0625f, gw[r][1].z * 0.0625f, gw[r][1].w * 0.0625f};
#pragma unroll
            for (int j = 0; j < 4; ++j) { const unsigned ws8 = j == 0 ? yw[r][TOPK].x : (j == 1 ? yw[r][TOPK].y : (j == 2 ? yw[r][TOPK].z : yw[r][TOPK].w));
                f32x4 mo = fp8x4(ws8) * 0.0625f;
#pragma unroll
                for (int k = 0; k < TOPK; ++k) { const unsigned wk = j == 0 ? yw[r][k].x : (j == 1 ? yw[r][k].y : (j == 2 ? yw[r][k].z : yw[r][k].w)); mo += fp8x4(wk) * gt[k]; }
                v[j] += *(const f32x4*)(mod + b * 6144 + 5120 + c0 + 4 * j) * mo; }
#endif
            float mean, rstd; ln_stats(v, mean, rstd);
            float* o = F.out + (size_t)m * D + c0;
#pragma unroll
            for (int j = 0; j < 4; ++j) { const int c = c0 + 4 * j; *(f32x4*)(o + 4 * j) = (v[j] - mean) * rstd * *(const f32x4*)(lw + c) + *(const f32x4*)(lb + c); }
        }
    }
}


#if MS >= 2
template <int MODE, bool FP8 = false>
__device__ __forceinline__ void cvt_item(const float* W, int Nsrc, int nblk, bf16* WT, int row_off, int dpitch, LAS float* scr, int item, int lane) {
    const int kb = item / nblk, nb = item - kb * nblk, k0 = 64 * kb, n0 = 32 * nb;
    const int nn = n0 + (lane & 31);
#pragma unroll 8
    for (int i = 0; i < 32; ++i) { const int kk = 2 * i + (lane >> 5); scr[kk * 33 + (lane & 31)] = (nn < Nsrc) ? W[(size_t)(k0 + kk) * Nsrc + nn] : 0.f; }
    LDS_WAIT(); asm volatile("" ::: "memory");
    const int c = lane & 7;
#pragma unroll
    for (int j = 0; j < 4; ++j) { const int n = (lane >> 3) + 8 * j; const LAS float* s = scr + (8 * c) * 33 + n;
        v4u o; o.x = pk2(s[0 * 33], s[1 * 33]); o.y = pk2(s[2 * 33], s[3 * 33]); o.z = pk2(s[4 * 33], s[5 * 33]); o.w = pk2(s[6 * 33], s[7 * 33]);
        const int ng = n0 + n; int dr = ng;
        if (MODE == 1) { const int i2 = ng & 255; dr = 8 * (i2 >> 2) + (i2 & 3) + ((ng >= 256) ? 4 : 0); }
        if constexpr (FP8) { v2u o8; o8.x = pack_fp8x4((f32x4){s[0 * 33], s[1 * 33], s[2 * 33], s[3 * 33]} * W8S); o8.y = pack_fp8x4((f32x4){s[4 * 33], s[5 * 33], s[6 * 33], s[7 * 33]} * W8S);
            *(v2u*)((unsigned char*)WT + (size_t)(row_off + dr) * dpitch + k0 + 8 * c) = o8; }
        else *(v4u*)(WT + (size_t)(row_off + dr) * dpitch + k0 + 8 * c) = o; }
    LDS_WAIT(); asm volatile("" ::: "memory");
}

template <int MODE>
__device__ __forceinline__ void cvt_item_reg(const float* W, int Nsrc, bf16* WT, int row_off, int dpitch, int k0, int n0, int lane) {
    const float* src = W + (size_t)k0 * Nsrc + n0 + 4 * lane;
    f32x4 v[32];
#pragma unroll
    for (int i = 0; i < 32; ++i) v[i] = __builtin_nontemporal_load((const f32x4*)(src + (size_t)i * Nsrc));
#pragma unroll
    for (int j = 0; j < 4; ++j) {
        const int ng = n0 + 4 * lane + j; int dr = ng;
        if (MODE == 1) { const int i2 = ng & 255; dr = 8 * (i2 >> 2) + (i2 & 3) + ((ng >= 256) ? 4 : 0); }
        v4u* dst = (v4u*)(WT + (size_t)(row_off + dr) * dpitch + k0);
#pragma unroll
        for (int q = 0; q < 4; ++q) { v4u o; o.x = pk2(v[8 * q][j], v[8 * q + 1][j]); o.y = pk2(v[8 * q + 2][j], v[8 * q + 3][j]); o.z = pk2(v[8 * q + 4][j], v[8 * q + 5][j]); o.w = pk2(v[8 * q + 6][j], v[8 * q + 7][j]); dst[q] = o; }
    }
}

constexpr int CVK = 32;
__device__ __forceinline__ void cvt_reg_load(const float* W, int Nsrc, int k0, int n0, int lane, f32x4 (&v)[CVK]) {
    const float* src = W + (size_t)k0 * Nsrc + n0 + 4 * lane;
#pragma unroll
    for (int i = 0; i < CVK; ++i) v[i] = __builtin_nontemporal_load((const f32x4*)(src + (size_t)i * Nsrc));
}
template <int MODE, bool FP8 = false>
__device__ __forceinline__ void cvt_reg_store(bf16* WT, int row_off, int dpitch, int k0, int n0, int lane, const f32x4 (&v)[CVK]) {
#pragma unroll
    for (int j = 0; j < 4; ++j) {
        const int ng = n0 + 4 * lane + j; int dr = ng;
        if (MODE == 1) { const int i2 = ng & 255; dr = 8 * (i2 >> 2) + (i2 & 3) + ((ng >= 256) ? 4 : 0); }
        if constexpr (FP8) { v4u* dst8 = (v4u*)((unsigned char*)WT + (size_t)(row_off + dr) * dpitch + k0);
#pragma unroll
            for (int q = 0; q < CVK / 16; ++q) { v4u o;
                o.x = pack_fp8x4((f32x4){v[16 * q][j], v[16 * q + 1][j], v[16 * q + 2][j], v[16 * q + 3][j]} * W8S); o.y = pack_fp8x4((f32x4){v[16 * q + 4][j], v[16 * q + 5][j], v[16 * q + 6][j], v[16 * q + 7][j]} * W8S);
                o.z = pack_fp8x4((f32x4){v[16 * q + 8][j], v[16 * q + 9][j], v[16 * q + 10][j], v[16 * q + 11][j]} * W8S); o.w = pack_fp8x4((f32x4){v[16 * q + 12][j], v[16 * q + 13][j], v[16 * q + 14][j], v[16 * q + 15][j]} * W8S); dst8[q] = o; }
            continue; }
        v4u* dst = (v4u*)(WT + (size_t)(row_off + dr) * dpitch + k0);
#pragma unroll
        for (int q = 0; q < CVK / 8; ++q) { v4u o; o.x = pg8::cvt_pk_bf16(v[8 * q][j], v[8 * q + 1][j]); o.y = pg8::cvt_pk_bf16(v[8 * q + 2][j], v[8 * q + 3][j]); o.z = pg8::cvt_pk_bf16(v[8 * q + 4][j], v[8 * q + 5][j]); o.w = pg8::cvt_pk_bf16(v[8 * q + 6][j], v[8 * q + 7][j]); dst[q] = o; }
    }
}
constexpr int CV_GU = (D / CVK) * 2, CV_DN = (FF / CVK) * 4, CV_NGU = (NE + 1) * CV_GU, CV_NITEM = CV_NGU + (NE + 1) * CV_DN;
__device__ __forceinline__ void cvx_load(const float* const* in, int it, int lane, f32x4 (&v)[CVK]) {
    if (it < CV_NGU) { const int e = it / CV_GU, ii = it - e * CV_GU; const float* src = (e < NE) ? in[30] + (size_t)e * D * 512 : in[32];
        cvt_reg_load(src, 512, CVK * (ii >> 1), 256 * (ii & 1), lane, v); }
    else { const int r = it - CV_NGU, e = r / CV_DN, ii = r - e * CV_DN; const float* src = (e < NE) ? in[31] + (size_t)e * FF * D : in[33];
        cvt_reg_load(src, D, CVK * (ii >> 2), 256 * (ii & 3), lane, v); }
}
__device__ __forceinline__ void cvx_store(unsigned char* ws, int it, int lane, const f32x4 (&v)[CVK]) {
    if (it < CV_NGU) { const int e = it / CV_GU, ii = it - e * CV_GU; cvt_reg_store<1, true>((bf16*)(ws + WS_WGU), e * 512, D, CVK * (ii >> 1), 256 * (ii & 1), lane, v); }
    else { const int r = it - CV_NGU, e = r / CV_DN, ii = r - e * CV_DN; cvt_reg_store<0, true>((bf16*)(ws + WS_WD), e * D, FF, CVK * (ii >> 2), 256 * (ii & 3), lane, v); }
}

typedef float f32x2v __attribute__((ext_vector_type(2)));
constexpr int CY_GU = (D / 32) * 4, CY_DN = (FF / 32) * 8, CY_NGU = (NE + 1) * CY_GU, CY_NITEM = CY_NGU + (NE + 1) * CY_DN;
__device__ __forceinline__ void cvy_load(const float* const* in, int it, int lane, f32x2v (&v)[32]) {
    const float* p;  int Nsrc;
    if (it < CY_NGU) { const int e = it / CY_GU, ii = it - e * CY_GU; const float* src = (e < NE) ? in[30] + (size_t)e * D * 512 : in[32]; Nsrc = 512; p = src + (size_t)(32 * (ii >> 2)) * 512 + 128 * (ii & 3) + 2 * lane; }
    else { const int r = it - CY_NGU, e = r / CY_DN, ii = r - e * CY_DN; const float* src = (e < NE) ? in[31] + (size_t)e * FF * D : in[33]; Nsrc = D; p = src + (size_t)(32 * (ii >> 3)) * D + 128 * (ii & 7) + 2 * lane; }
#pragma unroll
    for (int i = 0; i < 32; ++i) v[i] = __builtin_nontemporal_load((const f32x2v*)(p + (size_t)i * Nsrc));
}
__device__ __forceinline__ void cvy_store(unsigned char* ws, int it, int lane, const f32x2v (&v)[32]) {
    unsigned char* base; int dpitch, n0; bool gu = it < CY_NGU;
    if (gu) { const int e = it / CY_GU, ii = it - e * CY_GU; base = ws + WS_WGU + (size_t)(e * 512) * D + 32 * (ii >> 2); dpitch = D; n0 = 128 * (ii & 3); }
    else { const int r = it - CY_NGU, e = r / CY_DN, ii = r - e * CY_DN; base = ws + WS_WD + (size_t)(e * D) * FF + 32 * (ii >> 3); dpitch = FF; n0 = 128 * (ii & 7); }
#pragma unroll
    for (int j = 0; j < 2; ++j) {
        const int ng = n0 + 2 * lane + j; int dr = ng;
        if (gu) { const int i2 = ng & 255; dr = 8 * (i2 >> 2) + (i2 & 3) + ((ng >= 256) ? 4 : 0); }
        v4u* dst8 = (v4u*)(base + (size_t)dr * dpitch);
#pragma unroll
        for (int q = 0; q < 2; ++q) { v4u o;
            o.x = pack_fp8x4((f32x4){v[16 * q][j], v[16 * q + 1][j], v[16 * q + 2][j], v[16 * q + 3][j]} * W8S); o.y = pack_fp8x4((f32x4){v[16 * q + 4][j], v[16 * q + 5][j], v[16 * q + 6][j], v[16 * q + 7][j]} * W8S);
            o.z = pack_fp8x4((f32x4){v[16 * q + 8][j], v[16 * q + 9][j], v[16 * q + 10][j], v[16 * q + 11][j]} * W8S); o.w = pack_fp8x4((f32x4){v[16 * q + 12][j], v[16 * q + 13][j], v[16 * q + 14][j], v[16 * q + 15][j]} * W8S); dst8[q] = o; }
    }
}
#define CVY_FLUSH() do { if (cpend >= 0) cvy_store(F.ws, cpend, lane, cv); cpend = -1; } while (0)
#define CVY_START(item) do { if ((item) < CY_NITEM) { cvy_load(F.in, (item), lane, cv); cpend = (item); } } while (0)

#if MS >= 3
__device__ __forceinline__ float lora_val(const float* const* in, int n, int k) {
    if (n < 1024) { const int q = n >> 3, e8 = n & 7, dir = e8 >> 2, ch = q * 4 + (e8 & 3); return (k < 32) ? in[9][(size_t)(dir * 32 + k) * 512 + ch] : 0.f; }
    if (n < 2048) { const int m = n - 1024, q = m >> 3, e8 = m & 7, dir = e8 >> 2, ch = q * 4 + (e8 & 3); return (k >= 32 && k < 64) ? in[11][(size_t)(dir * 32 + (k - 32)) * 512 + ch] : 0.f; }
    if (n < 2560) { const int ch = n - 2048; return (k >= 64 && k < 160) ? in[12][(size_t)(k - 64) * 512 + ch] : 0.f; }
    { const int m = n - 2560, q = m >> 3, e8 = m & 7, dir = e8 >> 2, ch = q * 4 + (e8 & 3); return (k >= 160 && k < 176) ? in[19][(size_t)(dir * 16 + (k - 160)) * 256 + ch] : 0.f; }
}
#endif

__device__ __forceinline__ void ph_prologue(Frame& F) {
    {
        const float* c = F.in[1]; const float* cc = F.in[3]; const float* wa = F.in[4]; const float* ba = F.in[5];
        float* MOD = (float*)(F.ws + WS_MOD);
        LAS float* S = (LAS float*)F.lds; LAS float* red = (LAS float*)(F.lds + 32768);
        for (int it = blockIdx.x; it < 96; it += F.G) {
            for (int i = F.tid; i < 5120; i += NTHR) { const int r = i >> 10, k = i & 1023; const float cv = r < 4 ? c[r * 1024 + k] : cc[k]; S[i] = siluf_(cv); }
            __syncthreads();
            const int n = it * 64 + F.lane; float acc[5] = {0.f, 0.f, 0.f, 0.f, 0.f};
            for (int kk = 0; kk < 128; ++kk) { const int k = F.wave * 128 + kk; const float wv = wa[(size_t)k * 6144 + n];
#pragma unroll
                for (int r = 0; r < 5; ++r) acc[r] += S[r * 1024 + k] * wv; }
#pragma unroll
            for (int r = 0; r < 5; ++r) red[(F.wave * 5 + r) * 64 + F.lane] = acc[r];
            __syncthreads();
            if (F.wave == 0) {
#pragma unroll
                for (int r = 0; r < 5; ++r) { float s = 0.f;
#pragma unroll
                    for (int w = 0; w < 8; ++w) s += red[(w * 5 + r) * 64 + F.lane];
                    MOD[r * 6144 + n] = s + ba[n]; }
            }
            __syncthreads();
        }
    }
    {
        LAS float* scr = (LAS float*)(F.lds + F.wave * 16384);
        constexpr int I_IN = 16 * 168, I_BR = 8 * 32, I_OUT = 16 * 32, I_RT = 16 * 8, I_GU = 32 * 2, I_DN = 8 * 4;
        constexpr int T0 = I_IN, T1 = T0 + I_BR, T2 = T1 + I_BR, T3 = T2 + I_OUT, T4 = T3 + I_RT, T5 = T4 + (NE + 1) * I_GU, T6 = T5 + (NE + 1) * I_DN;
        unsigned char* ws = F.ws;
        for (int it = F.gw; it < T6; it += F.NGW) {
#if MS >= 3
            if (it < T0) { cvt_item<0, true>(F.in[6], IN_COLS, 168, (bf16*)(ws + WS_WIN), 0, D, scr, it, F.lane); continue; }
            if (it < T1) { cvt_item<0>(F.in[23], D, 32, (bf16*)(ws + WS_WBRRW), 0, RWW, scr, it - T0, F.lane); continue; }
            if (it < T2) { cvt_item<0>(F.in[24], D, 32, (bf16*)(ws + WS_WBRGLA), 0, RWW, scr, it - T1, F.lane); continue; }
            if (it < T3) { cvt_item<0>(F.in[25], D, 32, (bf16*)(ws + WS_WOUT), 0, D, scr, it - T2, F.lane); continue; }
#else
            if (it < T3) continue;
#endif
            if (it < T4) { cvt_item<0>(F.in[28], NE, 8, (bf16*)(ws + WS_WROUTER), 0, D, scr, it - T3, F.lane); continue; }
#if MS >= 3
            break;
#endif
            if (it < T5) { const int r = it - T4, e = r / I_GU, ii = r - e * I_GU;
                const float* src = (e < NE) ? F.in[30] + (size_t)e * D * 512 : F.in[32];
                cvt_item_reg<1>(src, 512, (bf16*)(ws + WS_WGU), e * 512, D, 32 * (ii >> 1), 256 * (ii & 1), F.lane); continue; }
            { const int r = it - T5, e = r / I_DN, ii = r - e * I_DN;
                const float* src = (e < NE) ? F.in[31] + (size_t)e * FF * D : F.in[33];
                cvt_item_reg<0>(src, D, (bf16*)(ws + WS_WD), e * D, FF, 32 * (ii >> 2), 256 * (ii & 3), F.lane); }
        }
    }
#if MS >= 3
    {
        bf16* WL = (bf16*)(F.ws + WS_WLORA);
        for (int idx = blockIdx.x * NTHR + F.tid; idx < NLORA * (KLORA / 8); idx += F.G * NTHR) {
            const int n = idx >> 5, k0 = (idx & 31) * 8; float v[8];
#pragma unroll
            for (int e = 0; e < 8; ++e) v[e] = lora_val(F.in, n, k0 + e);
            v4u o; o.x = pk2(v[0], v[1]); o.y = pk2(v[2], v[3]); o.z = pk2(v[4], v[5]); o.w = pk2(v[6], v[7]);
            *(v4u*)(WL + (size_t)n * KLORA + k0) = o;
        }
    }
#endif
}

struct EpiF32 {
    static constexpr bool PERM = false;
    float* C; int ldc;
    __device__ __forceinline__ void operator()(const f32x4 (&acc)[2][2][4][2], const pg8::Unit& u, int wr, int wc, int fr, int fq) const {
        const int row0 = u.pm * 256 + wr * 64 + fr, col0 = u.pn * 256 + wc * 32 + 4 * fq;
#pragma unroll
        for (int ai = 0; ai < 2; ++ai)
#pragma unroll
            for (int m = 0; m < 4; ++m) { float* rowp = C + (size_t)(row0 + ai * 128 + m * 16) * ldc + col0;
#pragma unroll
                for (int bj = 0; bj < 2; ++bj)
#pragma unroll
                    for (int n = 0; n < 2; ++n) *(f32x4*)(rowp + bj * 128 + n * 16) = acc[ai][bj][m][n]; }
    }
};
struct EpiSwiglu {
    static constexpr bool PERM = true;
    unsigned char* ACT;
    __device__ __forceinline__ void operator()(const f32x4 (&acc)[2][2][4][2], const pg8::Unit& u, int wr, int wc, int fr, int fq) const {
        const int row0 = u.pm * 256 + wr * 64 + fr, h0 = u.j * 128 + wc * 16 + 4 * fq;
#pragma unroll
        for (int ai = 0; ai < 2; ++ai)
#pragma unroll
            for (int m = 0; m < 4; ++m) { unsigned char* rowp = ACT + (size_t)(row0 + ai * 128 + m * 16) * FF + h0;
#pragma unroll
                for (int bj = 0; bj < 2; ++bj) { const f32x4 a = acc[ai][bj][m][0] * W8I, b = acc[ai][bj][m][1] * W8I;
                    *(unsigned*)(rowp + bj * 64) = pack_fp8x4((f32x4){siluf_(a[0]) * b[0], siluf_(a[1]) * b[1], siluf_(a[2]) * b[2], siluf_(a[3]) * b[3]}); } }
    }
};
struct EpiRowsBf16 {
    static constexpr bool PERM = true;
    bf16* O; int ldc; float sc;
    __device__ __forceinline__ void operator()(const f32x4 (&acc)[2][2][4][2], const pg8::Unit& u, int wr, int wc, int fr, int fq) const {
        const int row0 = u.pm * 256 + wr * 64 + fr, col0 = u.j * 256 + wc * 32 + 8 * fq;
#pragma unroll
        for (int ai = 0; ai < 2; ++ai)
#pragma unroll
            for (int m = 0; m < 4; ++m) { bf16* rowp = O + (size_t)(row0 + ai * 128 + m * 16) * ldc + col0;
#pragma unroll
                for (int bj = 0; bj < 2; ++bj) { const f32x4 v0 = acc[ai][bj][m][0] * sc, v1 = acc[ai][bj][m][1] * sc;
                    v4u w; w.x = pg8::cvt_pk_bf16(v0[0], v0[1]); w.y = pg8::cvt_pk_bf16(v0[2], v0[3]); w.z = pg8::cvt_pk_bf16(v1[0], v1[1]); w.w = pg8::cvt_pk_bf16(v1[2], v1[3]);
                    *(v4u*)(rowp + bj * 128) = w;
#ifdef PROBE_ST2
                    asm volatile("" ::: "memory"); *(volatile v4u*)(rowp + bj * 128) = w;
#endif
                    } }
    }
};

struct EpiRowsFp8 {
    static constexpr bool PERM = true;
    unsigned char* O;
    __device__ __forceinline__ void operator()(const f32x4 (&acc)[2][2][4][2], const pg8::Unit& u, int wr, int wc, int fr, int fq) const {
        const int row0 = u.pm * 256 + wr * 64 + fr, col0 = u.j * 256 + wc * 32 + 8 * fq;
#pragma unroll
        for (int ai = 0; ai < 2; ++ai)
#pragma unroll
            for (int m = 0; m < 4; ++m) { unsigned char* rowp = O + (size_t)(row0 + ai * 128 + m * 16) * D + col0;
#pragma unroll
                for (int bj = 0; bj < 2; ++bj) { f32x4 v0 = acc[ai][bj][m][0] * (16.0f * W8I), v1 = acc[ai][bj][m][1] * (16.0f * W8I);
#pragma unroll
                    for (int e = 0; e < 4; ++e) { v0[e] = __builtin_amdgcn_fmed3f(v0[e], -448.0f, 448.0f); v1[e] = __builtin_amdgcn_fmed3f(v1[e], -448.0f, 448.0f); }
                    int w0 = __builtin_amdgcn_cvt_pk_fp8_f32(v0[0], v0[1], 0, false); w0 = __builtin_amdgcn_cvt_pk_fp8_f32(v0[2], v0[3], w0, true);
                    int w1 = __builtin_amdgcn_cvt_pk_fp8_f32(v1[0], v1[1], 0, false); w1 = __builtin_amdgcn_cvt_pk_fp8_f32(v1[2], v1[3], w1, true);
                    v2u w; w.x = (unsigned)w0; w.y = (unsigned)w1; *(v2u*)(rowp + bj * 128) = w; } }
    }
};

__device__ __forceinline__ void ph_router(Frame& F) {
    pg8::Gemm g{(const bf16*)(F.ws + WS_A3), (const bf16*)(F.ws + WS_WROUTER), NLAT, NE, D, nullptr};
    pg8::StaticOrder S; S.init(NLAT, NE, F.G, (int)blockIdx.x);
    EpiF32 E{(float*)(F.ws + WS_LOGITS), NE};
    pg8::gemm_phase<EpiF32, pg8::StaticOrder, true, true, false>(F.lds, g, S, E);
}

#define RT_DPP(x, ctrl) __builtin_amdgcn_update_dpp(0, (x), (ctrl), 0xf, 0xf, false)
__device__ __forceinline__ unsigned wave_max_u32(unsigned k) {
    k = max(k, (unsigned)RT_DPP((int)k, 0xB1)); k = max(k, (unsigned)RT_DPP((int)k, 0x4E));
    k = max(k, (unsigned)RT_DPP((int)k, 0x124)); k = max(k, (unsigned)RT_DPP((int)k, 0x128));
    const unsigned a = (unsigned)__builtin_amdgcn_readlane((int)k, 0), b = (unsigned)__builtin_amdgcn_readlane((int)k, 16), c = (unsigned)__builtin_amdgcn_readlane((int)k, 32), d = (unsigned)__builtin_amdgcn_readlane((int)k, 48);
    return max(max(a, b), max(c, d));
}
__device__ __forceinline__ void ph_route(Frame& F) {
    const float* LOG = (const float*)(F.ws + WS_LOGITS); const float* rb = F.in[29];
    int* EIDX = (int*)(F.ws + WS_EIDX); float* GATE = (float*)(F.ws + WS_GATE); int* DEST = (int*)(F.ws + WS_DEST);
    unsigned* CNT = F.ctl + CW_CNT;
    const f32x4 bias = *(const f32x4*)(rb + 4 * F.lane);
    f32x4 lgn = *(const f32x4*)(LOG + (size_t)(F.gw < NLAT ? F.gw : 0) * NE + 4 * F.lane);
    for (int m = F.gw; m < NLAT; m += F.NGW) {
        const f32x4 lg = lgn;
        { const int mn = (m + F.NGW < NLAT) ? m + F.NGW : m; lgn = *(const f32x4*)(LOG + (size_t)mn * NE + 4 * F.lane); }
        float sc[4], sel[4];
#pragma unroll
        for (int i = 0; i < 4; ++i) { sc[i] = sigmoidf_(lg[i]); sel[i] = sc[i] + bias[i]; }
        float m1 = fmaxf(sel[0], sel[1]), m2 = fminf(sel[0], sel[1]);
        { const float a = sel[2]; const float n1 = fmaxf(m1, a); m2 = fmaxf(m2, fminf(m1, a)); m1 = n1; }
        { const float a = sel[3]; const float n1 = fmaxf(m1, a); m2 = fmaxf(m2, fminf(m1, a)); m1 = n1; }
#define RT_MERGE(ctrl) do { const float b1 = __builtin_bit_cast(float, RT_DPP(__builtin_bit_cast(int, m1), ctrl)), b2 = __builtin_bit_cast(float, RT_DPP(__builtin_bit_cast(int, m2), ctrl)); \
            const float n1 = fmaxf(m1, b1); m2 = fmaxf(fminf(m1, b1), fmaxf(m2, b2)); m1 = n1; } while (0)
        RT_MERGE(0xB1); RT_MERGE(0x4E); RT_MERGE(0x141);
#undef RT_MERGE
        const float gs = m1 + m2; const int g = F.lane >> 3;
        int rank = 0;
#pragma unroll
        for (int gg = 0; gg < 8; ++gg) { const float og = __builtin_bit_cast(float, __builtin_amdgcn_readlane(__builtin_bit_cast(int, gs), gg * 8)); rank += (og > gs || (og == gs && gg < g)) ? 1 : 0; }
        const bool keep = rank < 4;
        unsigned key[4];
#pragma unroll
        for (int i = 0; i < 4; ++i) { unsigned u = __builtin_bit_cast(unsigned, sel[i]); u ^= (u >> 31) ? 0xffffffffu : 0x80000000u;
            key[i] = keep ? ((u & 0xffffff00u) | (unsigned)(255 - (4 * F.lane + i))) : 0u; }
        int my_e = 0; float my_s = 0.f; float ssum = 0.f;
#pragma unroll
        for (int k = 0; k < TOPK; ++k) {
            const unsigned best = wave_max_u32(max(max(key[0], key[1]), max(key[2], key[3])));
            const int e = 255 - (int)(best & 255u), owner = e >> 2;
            float s_own = 0.f;
#pragma unroll
            for (int i = 0; i < 4; ++i) if (key[i] == best) { s_own = sc[i]; key[i] = 0u; }
            const float s = __builtin_bit_cast(float, __builtin_amdgcn_readlane(__builtin_bit_cast(int, s_own), owner));
            ssum += s;
            if (F.lane == k) { my_e = e; my_s = s; }
        }
        if (F.lane < TOPK) {
            const unsigned pos = __hip_atomic_fetch_add(CNT + my_e * CNT_STRIDE, 1u, __ATOMIC_RELAXED, __HIP_MEMORY_SCOPE_AGENT);
            EIDX[m * 8 + F.lane] = my_e; GATE[m * 8 + F.lane] = my_s * __builtin_amdgcn_rcpf(ssum) * 2.5f; DEST[m * 8 + F.lane] = (int)pos;
        }
    }
}
#undef RT_DPP

__device__ __forceinline__ void ph_scatter(Frame& F) {
    LAS int* tstart = (LAS int*)F.lds;
    LAS int* scan = (LAS int*)(F.lds + 2048);
    LAS int* cnts = (LAS int*)(F.lds + 4096);
    int* EIDX = (int*)(F.ws + WS_EIDX); int* DEST = (int*)(F.ws + WS_DEST); int* ROWTOK = (int*)(F.ws + WS_ROWTOK); int* TILE_E = (int*)(F.ws + WS_TILE_E);
    unsigned* CNT = F.ctl + CW_CNT;
    int tiles = 0, cnt = 0;
    if (F.tid < NE) { cnt = (int)__hip_atomic_load(CNT + F.tid * CNT_STRIDE, __ATOMIC_RELAXED, __HIP_MEMORY_SCOPE_AGENT); tiles = (cnt + 255) >> 8; scan[F.tid] = tiles; cnts[F.tid] = cnt; }
    __syncthreads();
    for (int o = 1; o < NE; o <<= 1) { int v = 0; if (F.tid < NE && F.tid >= o) v = scan[F.tid - o]; __syncthreads(); if (F.tid < NE) scan[F.tid] += v; __syncthreads(); }
    if (F.tid < NE) { tstart[F.tid + 1] = scan[F.tid]; if (F.tid == 0) tstart[0] = 0; }
    __syncthreads();
    const int NT = tstart[NE];
    if (blockIdx.x == 0) {
        if (F.tid == 0) F.ctl[CW_NT] = (unsigned)NT;
        if (F.tid < NE) for (int t = tstart[F.tid]; t < tstart[F.tid + 1]; ++t) TILE_E[t] = F.tid;
    }
    for (int e = blockIdx.x; e < NE; e += F.G) { const int c0 = cnts[e], c1 = (tstart[e + 1] - tstart[e]) * 256, base = tstart[e] * 256;
        for (int p = c0 + F.tid; p < c1; p += NTHR) ROWTOK[base + p] = 0; }
    for (int i = blockIdx.x * NTHR + F.tid; i < NLAT; i += F.G * NTHR) ROWTOK[SH_ROW0 + i] = i;
    for (int i = blockIdx.x * NTHR + F.tid; i < NLAT * TOPK; i += F.G * NTHR) {
        const int e = EIDX[i], pos = DEST[i]; const int dr = tstart[e] * 256 + pos;
        DEST[i] = dr; ROWTOK[dr] = i >> 3;
    }
}

__device__ __forceinline__ void ph_exp1(Frame& F) {
    const int NT = (int)__hip_atomic_load(F.ctl + CW_NT, __ATOMIC_RELAXED, __HIP_MEMORY_SCOPE_AGENT);
    pg8::Gemm g{(const bf16*)(F.ws + WS_A3F), (const bf16*)(F.ws + WS_WGU), 0, 0, D / 2, (const int*)(F.ws + WS_ROWTOK)};
    pg8::MoeOrder S{2, F.G, (int)blockIdx.x, NT, (const int*)(F.ws + WS_TILE_E)};
    EpiSwiglu E{F.ws + WS_ACT};
    pg8::gemm_phase<EpiSwiglu, pg8::MoeOrder, true, true, true, true>(F.lds, g, S, E);
}
__device__ __forceinline__ void ph_exp2(Frame& F) {
    const int NT = (int)__hip_atomic_load(F.ctl + CW_NT, __ATOMIC_RELAXED, __HIP_MEMORY_SCOPE_AGENT);
    pg8::Gemm g{(const bf16*)(F.ws + WS_ACT), (const bf16*)(F.ws + WS_WD), 0, 0, FF / 2, nullptr};
    pg8::MoeOrder S{4, F.G, (int)blockIdx.x, NT, (const int*)(F.ws + WS_TILE_E)};
    EpiRowsFp8 E{F.ws + WS_Y};
    pg8::gemm_phase<EpiRowsFp8, pg8::MoeOrder, true, true, false, true>(F.lds, g, S, E);
}
#endif

#if MS >= 3
__device__ __forceinline__ void unp8(const v4u w, float (&f)[8]) { f[0] = bflo(w.x); f[1] = bfhi(w.x); f[2] = bflo(w.y); f[3] = bfhi(w.y); f[4] = bflo(w.z); f[5] = bfhi(w.z); f[6] = bflo(w.w); f[7] = bfhi(w.w); }
__device__ __forceinline__ void unp8f8(const v2u w, float (&f)[8]) { const f32x2 a = __builtin_amdgcn_cvt_pk_f32_fp8((int)w.x, false), b = __builtin_amdgcn_cvt_pk_f32_fp8((int)w.x, true), c = __builtin_amdgcn_cvt_pk_f32_fp8((int)w.y, false), d = __builtin_amdgcn_cvt_pk_f32_fp8((int)w.y, true);
    f[0] = a.x; f[1] = a.y; f[2] = b.x; f[3] = b.y; f[4] = c.x; f[5] = c.y; f[6] = d.x; f[7] = d.y; }
__device__ __forceinline__ v4u pk8(const float (&f)[8]) { v4u o; o.x = pk2(f[0], f[1]); o.y = pk2(f[2], f[3]); o.z = pk2(f[4], f[5]); o.w = pk2(f[6], f[7]); return o; }
__device__ __forceinline__ void st8(float* p, const float (&f)[8]) { *(f32x4*)p = (f32x4){f[0], f[1], f[2], f[3]}; *(f32x4*)(p + 4) = (f32x4){f[4], f[5], f[6], f[7]}; }
__device__ __forceinline__ void ld8(const float* p, float (&f)[8]) { const f32x4 a = *(const f32x4*)p, b = *(const f32x4*)(p + 4); f[0] = a.x; f[1] = a.y; f[2] = a.z; f[3] = a.w; f[4] = b.x; f[5] = b.y; f[6] = b.z; f[7] = b.w; }

__device__ __forceinline__ void ph_a1(Frame& F) {
    const float* mod = (const float*)(F.ws + WS_MOD); unsigned char* A1 = F.ws + WS_A1;
    constexpr int NR = 4;
    for (int m0 = F.gw; m0 < MR; m0 += NR * F.NGW) {
        f32x4 xv[NR][4];
#pragma unroll
        for (int r = 0; r < NR; ++r) { const int mm = m0 + r * F.NGW; const int m = mm < MR ? mm : m0;
            const float* src = (m < NLAT) ? F.in[0] + (size_t)m * D : F.in[2] + (size_t)(m - NLAT) * D;
            const f32x4* xr = (const f32x4*)src + F.lane;
#pragma unroll
            for (int j = 0; j < 4; ++j) xv[r][j] = __builtin_nontemporal_load(xr + 64 * j); }
        __builtin_amdgcn_sched_barrier(0);
#pragma unroll
        for (int r = 0; r < NR; ++r) { const int mm = m0 + r * F.NGW; const int m = mm < MR ? mm : m0; const int mr = (m < NLAT) ? (m / SEQ) : 4;
            unsigned* ao = (unsigned*)(A1 + (size_t)m * D) + F.lane;
#pragma unroll
            for (int j = 0; j < 4; ++j) { const int c = 4 * F.lane + 256 * j;
                const f32x4 sh = *(const f32x4*)(mod + mr * 6144 + c), sc = *(const f32x4*)(mod + mr * 6144 + 1024 + c);
                const f32x4 h = xv[r][j] * (sc + 1.0f) + sh; ao[64 * j] = pack_fp8x4(h); } }
    }
}

__device__ __forceinline__ void ph_inproj(Frame& F) {
    pg8::Gemm g{(const bf16*)(F.ws + WS_A1), (const bf16*)(F.ws + WS_WIN), MR, NP, D / 2, nullptr};
    pg8::StaticOrder S; S.init(MR, NP, F.G, (int)blockIdx.x);
    EpiRowsBf16 E{(bf16*)(F.ws + WS_P), NP, W8I};
    pg8::gemm_phase<EpiRowsBf16, pg8::StaticOrder, true, true, false, true>(F.lds, g, S, E);
}

struct FeatOut { bf16 *R, *V, *KK, *KP, *QG, *KGB, *VGB, *A2; const float *mu, *kkw, *cw; };
__device__ __forceinline__ void feat_rw(const FeatOut& O, int p, size_t m, int lane, const v4u own_w, const v4u (&nbw)[4], const float (&muv)[8]) {
    float own[8], sh[4][8], val[8];
    unp8(own_w, own);
#pragma unroll
    for (int q = 0; q < 4; ++q) unp8(nbw[q], sh[q]);
#pragma unroll
    for (int e = 0; e < 8; ++e) val[e] = own[e] + muv[e] * (sh[e & 3][e] - own[e]);
    if (p == 0) *(v4u*)(O.R + m * RWW + 8 * lane) = pk8(val);
    else if (p == 2) *(v4u*)(O.V + m * RWW + 8 * lane) = pk8(val);
    else if (p == 1) {
        *(v4u*)(O.KP + m * RWW + 8 * lane) = pk8(val);
        float kw[8]; ld8(O.kkw + 8 * lane, kw); float kkv[8]; float ss = 0.f;
#pragma unroll
        for (int e = 0; e < 8; ++e) { kkv[e] = val[e] * kw[e]; ss += kkv[e] * kkv[e]; }
        ss += __shfl_xor(ss, 1); ss += __shfl_xor(ss, 2); ss += __shfl_xor(ss, 4);
        const float inv = 1.0f / fmaxf(sqrtf(ss), 1e-12f);
#pragma unroll
        for (int e = 0; e < 8; ++e) kkv[e] *= inv;
        *(v4u*)(O.KK + m * RWW + 8 * lane) = pk8(kkv);
    } else {
        float o[8];
#pragma unroll
        for (int e = 0; e < 8; ++e) o[e] = (lane < 4) ? tanhf_(val[e]) : ((lane < 8) ? val[e] : sigmoidf_(val[e]));
        *(v4u*)(O.A2 + m * KLORA + 8 * lane) = pk8(o);
    }
}
__device__ __forceinline__ void feat_gla_store(const FeatOut& O, int p, size_t m, int lane, const float (&acc)[8]) {
    const int cq = p * 512 + 8 * lane; float o[8];
#pragma unroll
    for (int e = 0; e < 8; ++e) o[e] = siluf_(acc[e]);
    if (p == 0) {
        if (lane < 32) {
#pragma unroll
            for (int e = 0; e < 8; ++e) o[e] *= 0.125f;
            *(v4u*)(O.QG + m * 256 + cq) = pk8(o);
        } else *(v4u*)(O.KGB + m * 256 + (cq - 256)) = pk8(o);
    } else *(v4u*)(O.VGB + m * RWW + (cq - 512)) = pk8(o);
}
__device__ __forceinline__ void ph_feat(Frame& F) {
    const bf16* P = (const bf16*)(F.ws + WS_P);
    FeatOut O{(bf16*)(F.ws + WS_RB), (bf16*)(F.ws + WS_VB), (bf16*)(F.ws + WS_KKB), (bf16*)(F.ws + WS_KMF), (bf16*)(F.ws + WS_QGB), (bf16*)(F.ws + WS_KGB), (bf16*)(F.ws + WS_VGB), (bf16*)(F.ws + WS_A2), F.in[7], F.in[13], F.in[18]};
    const v4u Z4 = (v4u){0u, 0u, 0u, 0u};
    for (int blk = F.gw; blk < NB * (GRIDH / 2) * (GRIDW / 2); blk += F.NGW) {
        int lane = F.lane; asm volatile("" : "+v"(lane));
        const int b = blk >> 11, r0 = 2 * ((blk >> 5) & 63), c0 = 2 * (blk & 31); const int mb = b * SEQ + r0 * GRIDW + c0;
        const bool vu = r0 > 0, vd = r0 + 2 < GRIDH, vl = c0 > 0, vr = c0 + 2 < GRIDW;
#pragma unroll
        for (int p = 0; p < 4; ++p) {
            const int cb = p * 512 + 8 * lane; const bool act = (p < 3) || lane < 20;
            v4u own[2][2], up[2], dn[2], lf[2], rt[2];
#pragma unroll
            for (int i = 0; i < 2; ++i) { up[i] = Z4; dn[i] = Z4; lf[i] = Z4; rt[i] = Z4; own[i][0] = Z4; own[i][1] = Z4; }
            if (act) {
#pragma unroll
                for (int i = 0; i < 2; ++i) {
#pragma unroll
                    for (int j = 0; j < 2; ++j) own[i][j] = *(const v4u*)(P + (size_t)(mb + 64 * i + j) * NP + cb);
                    if (vu) up[i] = *(const v4u*)(P + (size_t)(mb - 64 + i) * NP + cb);
                    if (vd) dn[i] = *(const v4u*)(P + (size_t)(mb + 128 + i) * NP + cb);
                    if (vl) lf[i] = *(const v4u*)(P + (size_t)(mb + 64 * i - 1) * NP + cb);
                    if (vr) rt[i] = *(const v4u*)(P + (size_t)(mb + 64 * i + 2) * NP + cb); }
            } else if (p == 3 && lane >= 20 && lane < 22) {
#pragma unroll
                for (int i = 0; i < 2; ++i)
#pragma unroll
                    for (int j = 0; j < 2; ++j) own[i][j] = *(const v4u*)(P + (size_t)(mb + 64 * i + j) * NP + C_PGL + 8 * (lane - 20));
            }
            float muv[8] = {0.f, 0.f, 0.f, 0.f, 0.f, 0.f, 0.f, 0.f}; if (act) ld8(O.mu + cb, muv);
            __builtin_amdgcn_sched_barrier(0);
#pragma unroll
            for (int i = 0; i < 2; ++i)
#pragma unroll
                for (int j = 0; j < 2; ++j) { const size_t m = (size_t)(mb + 64 * i + j);
                    if (act) { const v4u nbw[4] = {j == 0 ? lf[i] : own[i][0], j == 1 ? rt[i] : own[i][1], i == 0 ? up[j] : own[0][j], i == 1 ? dn[j] : own[1][j]};
                        feat_rw(O, p, m, lane, own[i][j], nbw, muv); }
                    else if (p == 3 && lane < 32) *(v4u*)(O.A2 + m * KLORA + 8 * lane) = own[i][j]; }
        }
#pragma unroll
        for (int p = 0; p < 2; ++p) {
            const int cq = p * 512 + 8 * lane, cb = C_Q + cq;
            v4u g[4][4];
#pragma unroll
            for (int a2 = 0; a2 < 4; ++a2)
#pragma unroll
                for (int b2 = 0; b2 < 4; ++b2) { const bool ok = (a2 == 0 ? vu : (a2 == 3 ? vd : true)) && (b2 == 0 ? vl : (b2 == 3 ? vr : true));
                    g[a2][b2] = Z4; if (ok) g[a2][b2] = *(const v4u*)(P + (size_t)(mb + 64 * (a2 - 1) + (b2 - 1)) * NP + cb); }
            __builtin_amdgcn_sched_barrier(0);
            float acc[2][2][8];
#pragma unroll
            for (int i = 0; i < 2; ++i)
#pragma unroll
                for (int j = 0; j < 2; ++j)
#pragma unroll
                    for (int e = 0; e < 8; ++e) acc[i][j][e] = 0.f;
#pragma unroll
            for (int dy = 0; dy < 3; ++dy)
#pragma unroll
                for (int dx = 0; dx < 3; ++dx) { float wv[8]; ld8(O.cw + (dy * 3 + dx) * 1024 + cq, wv);
#pragma unroll
                    for (int i = 0; i < 2; ++i)
#pragma unroll
                        for (int j = 0; j < 2; ++j) { float pv[8]; unp8(g[i + dy][j + dx], pv);
#pragma unroll
                            for (int e = 0; e < 8; ++e) acc[i][j][e] += pv[e] * wv[e]; } }
#pragma unroll
            for (int i = 0; i < 2; ++i)
#pragma unroll
                for (int j = 0; j < 2; ++j) feat_gla_store(O, p, (size_t)(mb + 64 * i + j), lane, acc[i][j]);
        }
    }
    for (int m = NLAT + F.gw; m < MR; m += F.NGW) {
        int lane = F.lane; asm volatile("" : "+v"(lane));
        const int t = (m - NLAT) & (CTXL - 1); const bool vp = t > 0, vn = t < CTXL - 1;
#pragma unroll
        for (int p = 0; p < 4; ++p) {
            const int cb = p * 512 + 8 * lane; const bool act = (p < 3) || lane < 20;
            if (act) { const v4u own = *(const v4u*)(P + (size_t)m * NP + cb); v4u pv = Z4, nv = Z4;
                if (vp) pv = *(const v4u*)(P + (size_t)(m - 1) * NP + cb); if (vn) nv = *(const v4u*)(P + (size_t)(m + 1) * NP + cb);
                float muv[8]; ld8(O.mu + cb, muv); const v4u nbw[4] = {pv, nv, pv, nv};
                feat_rw(O, p, (size_t)m, lane, own, nbw, muv); }
            else if (p == 3 && lane < 32) { v4u w = Z4; if (lane < 22) w = *(const v4u*)(P + (size_t)m * NP + C_PGL + 8 * (lane - 20)); *(v4u*)(O.A2 + (size_t)m * KLORA + 8 * lane) = w; }
        }
#pragma unroll
        for (int p = 0; p < 2; ++p) {
            const int cq = p * 512 + 8 * lane, cb = C_Q + cq; float acc[8] = {0.f, 0.f, 0.f, 0.f, 0.f, 0.f, 0.f, 0.f};
#pragma unroll
            for (int dx = -1; dx <= 1; ++dx) { const bool ok = (dx < 0) ? vp : ((dx > 0) ? vn : true);
                if (ok) { float pv[8], wv[8]; unp8(*(const v4u*)(P + (size_t)(m + dx) * NP + cb), pv); ld8(O.cw + (3 + dx + 1) * 1024 + cq, wv);
#pragma unroll
                    for (int e = 0; e < 8; ++e) acc[e] += pv[e] * wv[e]; } }
            feat_gla_store(O, p, (size_t)m, lane, acc);
        }
    }
}

struct EpiLora {
    static constexpr bool PERM = true;
    unsigned char* ws; const float* const* in;
    __device__ __forceinline__ void grp_w(const f32x4 (&acc)[2][2][4][2], int row0, int c0) const {
        bf16* Wf = (bf16*)(ws + WS_LWF); bf16* Wb = (bf16*)(ws + WS_LWB);
#pragma unroll
        for (int bj = 0; bj < 2; ++bj) { const int ch = (c0 + bj * 128) >> 1; const f32x4 w0f = *(const f32x4*)(in[8] + ch), w0b = *(const f32x4*)(in[8] + 512 + ch);
#pragma unroll
            for (int ai = 0; ai < 2; ++ai)
#pragma unroll
                for (int m = 0; m < 4; ++m) { const size_t row = (size_t)(row0 + ai * 128 + m * 16);
                    const f32x4 xf = acc[ai][bj][m][0] + w0f, xb = acc[ai][bj][m][1] + w0b; f32x4 df, db;
#pragma unroll
                    for (int e = 0; e < 4; ++e) { df[e] = -0.60653066f * sigmoidf_(xf[e]); db[e] = -0.60653066f * sigmoidf_(xb[e]); }
                    { v2u o; o.x = pk2(df[0], df[1]); o.y = pk2(df[2], df[3]); *(v2u*)(Wf + row * RWW + ch) = o; o.x = pk2(db[0], db[1]); o.y = pk2(db[2], db[3]); *(v2u*)(Wb + row * RWW + ch) = o; } } }
    }
    __device__ __forceinline__ void grp_a(const f32x4 (&acc)[2][2][4][2], int row0, int c0) const {
        bf16* KMf = (bf16*)(ws + WS_KMF); bf16* KMb = (bf16*)(ws + WS_KMB); bf16* BVf = (bf16*)(ws + WS_BVF); bf16* BVb = (bf16*)(ws + WS_BVB);
        const bf16* KK = (const bf16*)(ws + WS_KKB); bf16* KSUM = (bf16*)(ws + WS_KSUM);
#pragma unroll
        for (int bj = 0; bj < 2; ++bj) { const int ch = (c0 + bj * 128 - 1024) >> 1; const f32x4 a0f = *(const f32x4*)(in[10] + ch), a0b = *(const f32x4*)(in[10] + 512 + ch), ka = *(const f32x4*)(in[14] + ch);
#pragma unroll
            for (int ai = 0; ai < 2; ++ai) {
            v2u kpw[2][4], kkw[2][4];
#pragma unroll
                for (int m = 0; m < 4; ++m) { const size_t row = (size_t)(row0 + ai * 128 + m * 16); kpw[ai][m] = *(const v2u*)(KMf + row * RWW + ch); kkw[ai][m] = *(const v2u*)(KK + row * RWW + ch); }
            __builtin_amdgcn_sched_barrier(0);
#pragma unroll
                for (int m = 0; m < 4; ++m) { const size_t row = (size_t)(row0 + ai * 128 + m * 16);
                    const f32x4 xf = acc[ai][bj][m][0] + a0f, xb = acc[ai][bj][m][1] + a0b;
                    const f32x4 kp = (f32x4){bflo(kpw[ai][m].x), bfhi(kpw[ai][m].x), bflo(kpw[ai][m].y), bfhi(kpw[ai][m].y)}, kk = (f32x4){bflo(kkw[ai][m].x), bfhi(kkw[ai][m].x), bflo(kkw[ai][m].y), bfhi(kkw[ai][m].y)};
                    f32x4 kmf, kmb, bvf, bvb;
#pragma unroll
                    for (int e = 0; e < 4; ++e) { const float af = sigmoidf_(xf[e]), ab = sigmoidf_(xb[e]);
                        kmf[e] = kp[e] * (1.0f + (af - 1.0f) * ka[e]); kmb[e] = kp[e] * (1.0f + (ab - 1.0f) * ka[e]); bvf[e] = kk[e] * af; bvb[e] = kk[e] * ab; }
                    { v2u o; o.x = pk2(kmf[0], kmf[1]); o.y = pk2(kmf[2], kmf[3]); *(v2u*)(KMf + row * RWW + ch) = o; o.x = pk2(kmb[0], kmb[1]); o.y = pk2(kmb[2], kmb[3]); *(v2u*)(KMb + row * RWW + ch) = o;
                      o.x = pk2(bvf[0], bvf[1]); o.y = pk2(bvf[2], bvf[3]); *(v2u*)(BVf + row * RWW + ch) = o; o.x = pk2(bvb[0], bvb[1]); o.y = pk2(bvb[2], bvb[3]); *(v2u*)(BVb + row * RWW + ch) = o; }
                    v2u ks; ks.x = pk2(kmf[0] + kmb[0], kmf[1] + kmb[1]); ks.y = pk2(kmf[2] + kmb[2], kmf[3] + kmb[3]); *(v2u*)(KSUM + row * RWW + ch) = ks; } } }
    }
    __device__ __forceinline__ void grp_g(const f32x4 (&acc)[2][2][4][2], int row0, int c0) const {
        bf16* RWG = (bf16*)(ws + WS_RWG);
#pragma unroll
        for (int bj = 0; bj < 2; ++bj) { const int ch = c0 + bj * 128 - 2048;
#pragma unroll
            for (int ai = 0; ai < 2; ++ai)
#pragma unroll
                for (int m = 0; m < 4; ++m) { const size_t row = (size_t)(row0 + ai * 128 + m * 16); const f32x4 v0 = acc[ai][bj][m][0], v1 = acc[ai][bj][m][1];
                    v4u w; w.x = pk2(v0[0], v0[1]); w.y = pk2(v0[2], v0[3]); w.z = pk2(v1[0], v1[1]); w.w = pk2(v1[2], v1[3]); *(v4u*)(RWG + row * RWW + ch) = w; } }
    }
    __device__ __forceinline__ void grp_l(const f32x4 (&acc)[2][2][4][2], int row0, int c0) const {
        bf16* GAf = (bf16*)(ws + WS_LAF); bf16* GAb = (bf16*)(ws + WS_LAB);
#pragma unroll
        for (int bj = 0; bj < 2; ++bj) { const int ch = (c0 + bj * 128 - 2560) >> 1; const f32x4 gbf = *(const f32x4*)(in[20] + ch), gbb = *(const f32x4*)(in[20] + 256 + ch);
#pragma unroll
            for (int ai = 0; ai < 2; ++ai)
#pragma unroll
                for (int m = 0; m < 4; ++m) { const size_t row = (size_t)(row0 + ai * 128 + m * 16);
                    const f32x4 xf = acc[ai][bj][m][0] + gbf, xb = acc[ai][bj][m][1] + gbb; f32x4 af, ab;
#pragma unroll
                    for (int e = 0; e < 4; ++e) { const float lf = logsigmoidf_(xf[e]), lb = logsigmoidf_(xb[e]);
                        af[e] = lf * 0.0625f; ab[e] = lb * 0.0625f; }
                    { v2u o; o.x = pk2(af[0], af[1]); o.y = pk2(af[2], af[3]); *(v2u*)(GAf + row * 256 + ch) = o; o.x = pk2(ab[0], ab[1]); o.y = pk2(ab[2], ab[3]); *(v2u*)(GAb + row * 256 + ch) = o; } } }
    }
    __device__ __forceinline__ void operator()(const f32x4 (&acc)[2][2][4][2], const pg8::Unit& u, int wr, int wc, int fr, int fq) const {
        const int row0 = u.pm * 256 + wr * 64 + fr, c0 = u.pn * 256 + wc * 32 + 8 * fq;
        if (u.pn < 4) grp_w(acc, row0, c0); else if (u.pn < 8) grp_a(acc, row0, c0); else if (u.pn < 10) grp_g(acc, row0, c0); else grp_l(acc, row0, c0);
    }
};
__device__ __forceinline__ void ph_lora(Frame& F) {
    pg8::Gemm g{(const bf16*)(F.ws + WS_A2), (const bf16*)(F.ws + WS_WLORA), MR, NLORA, KLORA, nullptr};
    pg8::StaticOrder S; S.init(MR, NLORA, F.G, (int)blockIdx.x);
    EpiLora E{F.ws, F.in};
    pg8::gemm_phase<EpiLora, pg8::StaticOrder, true, true, false>(F.lds, g, S, E);
}

__device__ __forceinline__ void ph_merge(Frame& F) {
    unsigned char* ws = F.ws; const int lane = F.lane;
    const bf16* ORf = (const bf16*)(ws + WS_ORWF); const bf16* ORb = (const bf16*)(ws + WS_ORWB); const bf16* OGf = (const bf16*)(ws + WS_OGLF); const bf16* OGb = (const bf16*)(ws + WS_OGLB);
    const bf16* R = (const bf16*)(ws + WS_RB); const bf16* V = (const bf16*)(ws + WS_VB); const bf16* KSUM = (const bf16*)(ws + WS_KSUM); const bf16* RWG = (const bf16*)(ws + WS_RWG);
    const bf16* P = (const bf16*)(ws + WS_P);
    bf16* YRW = (bf16*)(ws + WS_YRW); bf16* YGLA = (bf16*)(ws + WS_YGLA);
    float rk[8], gw[8], gbv[8], ggw[8], ggb[8];
    ld8(F.in[15] + 8 * lane, rk); ld8(F.in[16] + 8 * lane, gw); ld8(F.in[17] + 8 * lane, gbv); ld8(F.in[21] + 8 * lane, ggw); ld8(F.in[22] + 8 * lane, ggb);
    for (int m0 = F.gw; m0 < NLAT; m0 += 2 * F.NGW) {
        const int m1 = (m0 + F.NGW < NLAT) ? m0 + F.NGW : m0;
        v4u wa[2], wb[2], wc[2], wd[2], wr[2], wv[2], wk[2], wg[2], wo[2];
#pragma unroll
        for (int r2 = 0; r2 < 2; ++r2) { const int m = r2 ? m1 : m0; const size_t ro = (size_t)m * RWW + 8 * lane;
            wa[r2] = *(const v4u*)(ORf + ro); wb[r2] = *(const v4u*)(ORb + ro); wc[r2] = *(const v4u*)(OGf + ro); wd[r2] = *(const v4u*)(OGb + ro);
            wr[r2] = *(const v4u*)(R + ro); wv[r2] = *(const v4u*)(V + ro); wk[r2] = *(const v4u*)(KSUM + ro); wg[r2] = *(const v4u*)(RWG + ro);
            wo[r2] = *(const v4u*)(P + (size_t)m * NP + C_OG + 8 * lane); }
#pragma unroll
        for (int r2 = 0; r2 < 2; ++r2) { const int m = r2 ? m1 : m0; const size_t ro = (size_t)m * RWW + 8 * lane;
        {
            float a[8], b[8], o[8]; unp8(wa[r2], a); unp8(wb[r2], b);
            float s = 0.f;
#pragma unroll
            for (int e = 0; e < 8; ++e) { o[e] = a[e] + b[e]; s += o[e]; }
            s += __shfl_xor(s, 1); s += __shfl_xor(s, 2); s += __shfl_xor(s, 4);
            const float mean = s * (1.f / 64.f); float q = 0.f;
#pragma unroll
            for (int e = 0; e < 8; ++e) { o[e] -= mean; q += o[e] * o[e]; }
            q += __shfl_xor(q, 1); q += __shfl_xor(q, 2); q += __shfl_xor(q, 4);
            const float rstd = __builtin_amdgcn_rsqf(q * (1.f / 64.f) + RW_GN_EPS);
            float r[8], v[8], ksm[8], g[8]; unp8(wr[r2], r); unp8(wv[r2], v); unp8(wk[r2], ksm); unp8(wg[r2], g);
            float bs = 0.f;
#pragma unroll
            for (int e = 0; e < 8; ++e) bs += r[e] * ksm[e] * rk[e];
            bs += __shfl_xor(bs, 1); bs += __shfl_xor(bs, 2); bs += __shfl_xor(bs, 4);
            float y[8];
#pragma unroll
            for (int e = 0; e < 8; ++e) y[e] = (o[e] * rstd * gw[e] + gbv[e] + bs * v[e]) * g[e];
            *(v4u*)(YRW + ro) = pk8(y);
        }
        {
            float a[8], b[8], o[8]; unp8(wc[r2], a); unp8(wd[r2], b);
            float s = 0.f;
#pragma unroll
            for (int e = 0; e < 8; ++e) { o[e] = a[e] + b[e]; s += o[e]; }
            s += __shfl_xor(s, 1); s += __shfl_xor(s, 2); s += __shfl_xor(s, 4); s += __shfl_xor(s, 8);
            const float mean = s * (1.f / 128.f); float q = 0.f;
#pragma unroll
            for (int e = 0; e < 8; ++e) { o[e] -= mean; q += o[e] * o[e]; }
            q += __shfl_xor(q, 1); q += __shfl_xor(q, 2); q += __shfl_xor(q, 4); q += __shfl_xor(q, 8);
            const float rstd = __builtin_amdgcn_rsqf(q * (1.f / 128.f) + LN_EPS);
            float og[8]; unp8(wo[r2], og);
            float y[8];
#pragma unroll
            for (int e = 0; e < 8; ++e) y[e] = (o[e] * rstd * ggw[e] + ggb[e]) * siluf_(og[e]);
            *(v4u*)(YGLA + ro) = pk8(y);
        }
        }
    }
}

template <int WHICH> struct EpiBranch {
    static constexpr bool PERM = true;
    bf16* Z; const bf16* P;
    __device__ __forceinline__ void operator()(const f32x4 (&acc)[2][2][4][2], const pg8::Unit& u, int wr, int wc, int fr, int fq) const {
        const int row0 = u.pm * 256 + wr * 64 + fr, col0 = u.pn * 256 + wc * 32 + 8 * fq;
#pragma unroll
        for (int ah = 0; ah < 4; ++ah) { const int ai = ah >> 1, mb = 2 * (ah & 1);
            v4u gw[2][2], zw[2][2];
#pragma unroll
            for (int m = 0; m < 2; ++m) { const size_t row = (size_t)(row0 + ai * 128 + (mb + m) * 16);
#pragma unroll
                for (int bj = 0; bj < 2; ++bj) { const int c = col0 + bj * 128;
                    gw[m][bj] = *(const v4u*)(P + row * NP + (WHICH ? C_GGLA : C_GRW) + c);
                    if (WHICH) zw[m][bj] = *(const v4u*)(Z + row * D + c); } }
            __builtin_amdgcn_sched_barrier(0);
#pragma unroll
            for (int m = 0; m < 2; ++m) { const size_t row = (size_t)(row0 + ai * 128 + (mb + m) * 16);
#pragma unroll
                for (int bj = 0; bj < 2; ++bj) { const int c = col0 + bj * 128;
                    float g[8]; unp8(gw[m][bj], g);
                    const f32x4 v0 = acc[ai][bj][mb + m][0], v1 = acc[ai][bj][mb + m][1];
                    float z[8];
#pragma unroll
                    for (int e = 0; e < 4; ++e) { z[e] = sigmoidf_(g[e]) * v0[e]; z[4 + e] = sigmoidf_(g[4 + e]) * v1[e]; }
                    if (WHICH) { float zo[8]; unp8(zw[m][bj], zo);
#pragma unroll
                        for (int e = 0; e < 8; ++e) z[e] += zo[e]; }
                    *(v4u*)(Z + row * D + c) = pk8(z); } }
        }
    }
};
__device__ __forceinline__ void ph_branch(Frame& F) {
    pg8::StaticOrder S; S.init(NLAT, D, F.G, (int)blockIdx.x);
    { pg8::Gemm g{(const bf16*)(F.ws + WS_YRW), (const bf16*)(F.ws + WS_WBRRW), NLAT, D, RWW, nullptr};
      EpiBranch<0> E{(bf16*)(F.ws + WS_Z), (const bf16*)(F.ws + WS_P)};
      pg8::gemm_phase<EpiBranch<0>, pg8::StaticOrder, true, true, false>(F.lds, g, S, E); }
    { pg8::Gemm g{(const bf16*)(F.ws + WS_YGLA), (const bf16*)(F.ws + WS_WBRGLA), NLAT, D, RWW, nullptr};
      EpiBranch<1> E{(bf16*)(F.ws + WS_Z), (const bf16*)(F.ws + WS_P)};
      pg8::gemm_phase<EpiBranch<1>, pg8::StaticOrder, true, true, false>(F.lds, g, S, E); }
}
struct EpiOut {
    static constexpr bool PERM = true;
    bf16* X1P; const float* x; const float* mod;
    __device__ __forceinline__ void operator()(const f32x4 (&acc)[2][2][4][2], const pg8::Unit& u, int wr, int wc, int fr, int fq) const {
        const int row0 = u.pm * 256 + wr * 64 + fr, col0 = u.pn * 256 + wc * 32 + 8 * fq; const float* g1 = mod + (u.pm / (SEQ / 256)) * 6144 + 2048;
        f32x4 gv[2][2];
#pragma unroll
        for (int bj = 0; bj < 2; ++bj)
#pragma unroll
            for (int n = 0; n < 2; ++n) gv[bj][n] = *(const f32x4*)(g1 + col0 + bj * 128 + 4 * n);
#pragma unroll
        for (int ah = 0; ah < 4; ++ah) { const int ai = ah >> 1, mb = 2 * (ah & 1);
            f32x4 xv[2][2][2];
#pragma unroll
            for (int m = 0; m < 2; ++m) { const size_t ro = (size_t)(row0 + ai * 128 + (mb + m) * 16) * D;
#pragma unroll
                for (int bj = 0; bj < 2; ++bj)
#pragma unroll
                    for (int n = 0; n < 2; ++n) xv[m][bj][n] = *(const f32x4*)(x + ro + col0 + bj * 128 + 4 * n); }
            __builtin_amdgcn_sched_barrier(0);
#pragma unroll
            for (int m = 0; m < 2; ++m) { const size_t ro = (size_t)(row0 + ai * 128 + (mb + m) * 16) * D;
#pragma unroll
                for (int bj = 0; bj < 2; ++bj) { const f32x4 a = xv[m][bj][0] * ALPHA + gv[bj][0] * acc[ai][bj][mb + m][0], b = xv[m][bj][1] * ALPHA + gv[bj][1] * acc[ai][bj][mb + m][1];
                    v4u w; w.x = pk2(a.x, a.y); w.y = pk2(a.z, a.w); w.z = pk2(b.x, b.y); w.w = pk2(b.z, b.w); *(v4u*)(X1P + ro + col0 + bj * 128) = w; } }
        }
    }
};
__device__ __forceinline__ void ph_outproj(Frame& F) {
    pg8::Gemm g{(const bf16*)(F.ws + WS_Z), (const bf16*)(F.ws + WS_WOUT), NLAT, D, D, nullptr};
    pg8::StaticOrder S; S.init(NLAT, D, F.G, (int)blockIdx.x);
    EpiOut E{(bf16*)(F.ws + WS_X1), F.in[0], (const float*)(F.ws + WS_MOD)};
    pg8::gemm_phase<EpiOut, pg8::StaticOrder, true, true, false>(F.lds, g, S, E);
}
#endif

#if MS >= 3
constexpr int LP = 72, SLOTB = 64 * LP * 2, LPF = 68, AUX_OFF = 13 * SLOTB;
static_assert(AUX_OFF + 4096 <= MISC_OFF, "scan LDS map");
#define SLOT(n) ((LAS bf16*)(lds + (n) * SLOTB))
__device__ __forceinline__ int scan_row(int s, int b, int dir) {
    if (s < CTXL) return NLAT + b * CTXL + (dir ? (CTXL - 1 - s) : s);
    const int lt = s - CTXL; return b * SEQ + (dir ? (SEQ - 1 - lt) : lt);
}
__device__ __forceinline__ unsigned pk2z(float x) { return pk2(x, 0.f); }
__device__ __forceinline__ float bf2f(bf16 h) { return __builtin_bit_cast(float, (unsigned)h << 16); }
__device__ __forceinline__ v2u pack4(const f32x4 v) { v2u o; o.x = pk2(v[0], v[1]); o.y = pk2(v[2], v[3]); return o; }
__device__ __forceinline__ float clamp8(float x) { return __builtin_amdgcn_fmed3f(x, -448.0f, 448.0f); }
__device__ __forceinline__ unsigned pack4_fp8(const f32x4 v) { int w = __builtin_amdgcn_cvt_pk_fp8_f32(clamp8(v[0]), clamp8(v[1]), 0, false); return (unsigned)__builtin_amdgcn_cvt_pk_fp8_f32(clamp8(v[2]), clamp8(v[3]), w, true); }
__device__ __forceinline__ f32x4 unpack4_fp8(unsigned w) { const f32x2 lo = __builtin_amdgcn_cvt_pk_f32_fp8((int)w, false), hi = __builtin_amdgcn_cvt_pk_f32_fp8((int)w, true); return (f32x4){lo.x, lo.y, hi.x, hi.y}; }
__device__ __forceinline__ f32x4 unpack4(const v2u w) { return (f32x4){bflo(w.x), bfhi(w.x), bflo(w.y), bfhi(w.y)}; }
__device__ __forceinline__ f32x4 mm_tile(const LAS bf16* X, int r0, const LAS bf16* Y, int c0, int lane) {
    const int rr = lane & 15, q = lane >> 4;
    const LAS bf16* xp = X + (r0 + rr) * LP + 8 * q; const LAS bf16* yp = Y + (c0 + rr) * LP + 8 * q;
    const bf16x8 a0 = *(const LAS bf16x8*)xp, a1 = *(const LAS bf16x8*)(xp + 32), b0 = *(const LAS bf16x8*)yp, b1 = *(const LAS bf16x8*)(yp + 32);
    f32x4 acc = (f32x4){0.f, 0.f, 0.f, 0.f};
    acc = __builtin_amdgcn_mfma_f32_16x16x32_bf16(a0, b0, acc, 0, 0, 0);
    acc = __builtin_amdgcn_mfma_f32_16x16x32_bf16(a1, b1, acc, 0, 0, 0);
    return acc;
}
__device__ __forceinline__ float red8(float x) {
    x += __builtin_bit_cast(float, __builtin_amdgcn_update_dpp(0, __builtin_bit_cast(int, x), 0x141, 0xf, 0xf, false));
    x += __builtin_bit_cast(float, __builtin_amdgcn_update_dpp(0, __builtin_bit_cast(int, x), 0xB1, 0xf, 0xf, false));
    x += __builtin_bit_cast(float, __builtin_amdgcn_update_dpp(0, __builtin_bit_cast(int, x), 0x4E, 0xf, 0xf, false));
    return x;
}

#define S1_BAR() do { asm volatile("s_waitcnt lgkmcnt(0)" ::: "memory"); __builtin_amdgcn_s_barrier(); asm volatile("" ::: "memory"); } while (0)
struct RwIn { bf16 lw[8], r[8], k[8], a[8], b[8], v[8]; };
__device__ __forceinline__ void s1_rwkv_load(Frame& F, int u, RwIn& I) {
    const int sr = u / NCHUNK, c = u - sr * NCHUNK, rb = sr >> 4, rdir = (sr >> 3) & 1, rh = sr & 7; unsigned char* ws = F.ws;
    const bf16* RBp = (const bf16*)(ws + WS_RB); const bf16* VBp = (const bf16*)(ws + WS_VB); const bf16* KKp = (const bf16*)(ws + WS_KKB);
    const bf16* KMp = (const bf16*)(ws + (rdir ? WS_KMB : WS_KMF)); const bf16* BVp = (const bf16*)(ws + (rdir ? WS_BVB : WS_BVF)); const bf16* LWp = (const bf16*)(ws + (rdir ? WS_LWB : WS_LWF));
#pragma unroll
    for (int i = 0; i < 8; ++i) { const int row = scan_row(c * CH + 8 * F.wave + i, rb, rdir); const size_t base = (size_t)row * RWW + rh * 64 + F.lane;
        I.lw[i] = LWp[base]; I.r[i] = RBp[base]; I.k[i] = KMp[base]; I.a[i] = KKp[base]; I.b[i] = BVp[base]; I.v[i] = VBp[base]; }
}
__device__ __forceinline__ void s1_rwkv(Frame& F, int u, const RwIn& I, int un, RwIn& Inext, f32x2v (&cv)[32], int& cpend, int cvi) {
    const int sr = u / NCHUNK, c = u - sr * NCHUNK;
    const bool emit = c >= CTXL / CH;
    LAS unsigned char* lds = F.lds; unsigned char* ws = F.ws;
    int lane_ = F.lane; asm volatile("" : "+v"(lane_));
    const int lane = lane_, wave = F.wave, rr = lane & 15, q = lane >> 4;
    LAS float* tot = (LAS float*)(lds + AUX_OFF); LAS float* gCs = tot + 512;
    {
        float lw[8], xr[8], xk[8], xa[8], xb[8], xv[8];
#pragma unroll
        for (int i = 0; i < 8; ++i) { lw[i] = bf2f(I.lw[i]); xr[i] = bf2f(I.r[i]); xk[i] = bf2f(I.k[i]); xa[i] = -bf2f(I.a[i]); xb[i] = bf2f(I.b[i]); xv[i] = bf2f(I.v[i]); }
        float p[8]; p[0] = lw[0];
#pragma unroll
        for (int i = 1; i < 8; ++i) p[i] = p[i - 1] + lw[i];
        tot[wave * 64 + lane] = p[7];
        S1_BAR();
        float off = 0.f, all = 0.f;
#pragma unroll
        for (int w = 0; w < 8; ++w) { const float t = tot[w * 64 + lane]; all += t; off += (w < wave) ? t : 0.f; }
        if (wave == 0) gCs[lane] = __expf(all);
        float at[8], bb[8], kb[8];
#pragma unroll
        for (int i = 0; i < 8; ++i) { const float cum = off + p[i]; const float g = __expf(cum), gi = __expf(-cum), gp = __expf(cum - lw[i]), gc = __expf(all - cum);
            const int t = 8 * wave + i;
            at[i] = xa[i] * gp; bb[i] = xb[i] * gc; kb[i] = xk[i] * gc;
            SLOT(0)[t * LP + lane] = (bf16)pk2z(at[i]);
            SLOT(1)[t * LP + lane] = (bf16)pk2z(xr[i] * g);
            SLOT(2)[t * LP + lane] = (bf16)pk2z(xb[i] * gi);
            SLOT(3)[t * LP + lane] = (bf16)pk2z(xk[i] * gi); }
        *(LAS v4u*)(SLOT(4) + lane * LP + 8 * wave) = pk8(at);
        *(LAS v4u*)(SLOT(5) + lane * LP + 8 * wave) = pk8(xv);
        *(LAS v4u*)(SLOT(6) + lane * LP + 8 * wave) = pk8(bb);
        *(LAS v4u*)(SLOT(7) + lane * LP + 8 * wave) = pk8(kb);
        S1_BAR();
    }
    if (wave < 4) s1_rwkv_load(F, un, Inext);
    LAS float* Lp = (LAS float*)(lds + 8 * SLOTB);
#pragma unroll
    for (int tix = 0; tix < 2; ++tix) { const int ti = 2 * wave + tix, r0 = 16 * (ti >> 2), c0 = 16 * (ti & 3), ci = c0 + rr;
        { const f32x4 acc = mm_tile(SLOT(2), r0, SLOT(0), c0, lane);
#pragma unroll
            for (int e = 0; e < 4; ++e) { const int i = r0 + 4 * q + e; Lp[ci * LPF + (i & 3) * 16 + (i >> 2)] = (i < ci) ? acc[e] : 0.f; } }
        { f32x4 acc = mm_tile(SLOT(0), r0, SLOT(3), c0, lane);
#pragma unroll
            for (int e = 0; e < 4; ++e) acc[e] = (ci < r0 + 4 * q + e) ? acc[e] : 0.f;
            *(LAS v2u*)(SLOT(10) + ci * LP + r0 + 4 * q) = pack4(acc); }
        if (emit) {
            { f32x4 acc = mm_tile(SLOT(2), r0, SLOT(1), c0, lane);
#pragma unroll
                for (int e = 0; e < 4; ++e) acc[e] = (r0 + 4 * q + e <= ci) ? acc[e] : 0.f;
                *(LAS v2u*)(SLOT(11) + ci * LP + r0 + 4 * q) = pack4(acc); }
            { f32x4 acc = mm_tile(SLOT(3), r0, SLOT(1), c0, lane);
#pragma unroll
                for (int e = 0; e < 4; ++e) acc[e] = (r0 + 4 * q + e <= ci) ? acc[e] : 0.f;
                *(LAS v2u*)(SLOT(12) + ci * LP + r0 + 4 * q) = pack4(acc); }
        }
    }
    S1_BAR();
    if (wave < 4) {
        const int j = 16 * wave + (lane >> 2), s = lane & 3;
        float Tr[16];
#pragma unroll
        for (int m = 0; m < 16; ++m) Tr[m] = 0.f;
        const LAS float* lrow = Lp + s * 16;
        f32x4 lb[3][4];
#pragma unroll
        for (int t = 0; t < 2; ++t) lb[t][0] = *(const LAS f32x4*)(lrow + t * LPF);
#pragma unroll
        for (int t = 0; t < 64; ++t) {
            if (t + 2 < 64) {
#pragma unroll
                for (int k = 0; k < 4; ++k) if (4 * k <= (t + 2) / 4) lb[(t + 2) % 3][k] = *(const LAS f32x4*)(lrow + (t + 2) * LPF + 4 * k);
            }
            __builtin_amdgcn_sched_barrier(0);
            float acc0 = 0.f, acc1 = 0.f;
#pragma unroll
            for (int m = 0; m < 16; ++m) if (m <= t / 4) { const float lv = lb[t % 3][m >> 2][m & 3]; if (m & 1) acc1 += lv * Tr[m]; else acc0 += lv * Tr[m]; }
            float acc = acc0 + acc1;
            acc += __builtin_bit_cast(float, __builtin_amdgcn_update_dpp(0, __builtin_bit_cast(int, acc), 0xB1, 0xf, 0xf, false));
            acc += __builtin_bit_cast(float, __builtin_amdgcn_update_dpp(0, __builtin_bit_cast(int, acc), 0x4E, 0xf, 0xf, false));
            int jj = j, ss = s; asm volatile("" : "+v"(jj), "+v"(ss));
            const float val = acc + ((t == jj) ? 1.f : 0.f);
            Tr[t >> 2] = (ss == (t & 3)) ? val : Tr[t >> 2];
            SLOT(0)[t * LP + j] = (bf16)pk2z(val);
        }
    } else { CVY_FLUSH(); s1_rwkv_load(F, un, Inext); CVY_START(cvi); }
    S1_BAR();
#pragma unroll
    for (int tix = 0; tix < 2; ++tix) { const int ti = 2 * wave + tix, r0 = 16 * (ti >> 2), c0 = 16 * (ti & 3), ci = c0 + rr;
        { const f32x4 acc = mm_tile(SLOT(0), r0, SLOT(4), c0, lane); *(LAS v2u*)(SLOT(2) + ci * LP + r0 + 4 * q) = pack4(acc); }
        { const f32x4 acc = mm_tile(SLOT(0), r0, SLOT(10), c0, lane); *(LAS v2u*)(SLOT(3) + ci * LP + r0 + 4 * q) = pack4(acc); }
    }
    S1_BAR();
    unsigned char* RH = ws + WS_RH + (size_t)u * 4096; bf16* GT = (bf16*)((unsigned char*)F.out + OUT_GT) + (size_t)u * 4096;
#pragma unroll
    for (int tix = 0; tix < 2; ++tix) { const int ti = 2 * wave + tix, tr = ti >> 2, r0 = 16 * tr, c0 = 16 * (ti & 3), ci = c0 + rr;
        const int pos = (tr >> 1) * 32 + q * 8 + 4 * (tr & 1);
        if (emit) {
            { f32x4 acc = mm_tile(SLOT(2), r0, SLOT(11), c0, lane);
                acc += unpack4(*(const LAS v2u*)(SLOT(1) + ci * LP + r0 + 4 * q));
                *(unsigned*)(RH + ci * 64 + pos) = pack4_fp8(acc); }
            { f32x4 acc = mm_tile(SLOT(3), r0, SLOT(11), c0, lane);
                acc += unpack4(*(const LAS v2u*)(SLOT(12) + ci * LP + r0 + 4 * q));
                *(LAS v2u*)(SLOT(4) + ci * LP + r0 + 4 * q) = pack4(acc); }
        }
        { f32x4 acc = mm_tile(SLOT(2), r0, SLOT(6), c0, lane);
            const float gc = gCs[ci];
#pragma unroll
            for (int e = 0; e < 4; ++e) acc[e] += (r0 + 4 * q + e == ci) ? gc : 0.f;
            *(v2u*)(GT + ci * 64 + pos) = pack4(acc); }
    }
    S1_BAR();
    unsigned char* YL = ws + WS_YL + (size_t)u * 4096;
#pragma unroll
    for (int tix = 0; tix < 2; ++tix) { const int ti = 2 * wave + tix, r0 = 16 * (ti >> 2), c0 = 16 * (ti & 3), ci = c0 + rr;
        if (emit) { const f32x4 acc = mm_tile(SLOT(5), r0, SLOT(4), c0, lane); *(unsigned*)(YL + ci * 64 + r0 + 4 * q) = pack4_fp8(acc); }
        { f32x4 acc = mm_tile(SLOT(3), r0, SLOT(6), c0, lane);
            acc += unpack4(*(const LAS v2u*)(SLOT(7) + ci * LP + r0 + 4 * q));
            *(LAS v2u*)(SLOT(8) + ci * LP + r0 + 4 * q) = pack4(acc); }
    }
    S1_BAR();
    bf16* HH = (bf16*)(ws + WS_HH) + (size_t)u * 4096;
#pragma unroll
    for (int tix = 0; tix < 2; ++tix) { const int ti = 2 * wave + tix, r0 = 16 * (ti >> 2), c0 = 16 * (ti & 3), ci = c0 + rr;
        const f32x4 acc = mm_tile(SLOT(8), r0, SLOT(5), c0, lane);
        *(v2u*)(HH + ci * 64 + r0 + 4 * q) = pack4(acc); }
    S1_BAR();
}

struct GlIn { bf16 la[8], q[8], k[8], v0[8], v1[8]; };
__device__ __forceinline__ void s1_gla_load(Frame& F, int u, GlIn& I) {
    const int sg = u / NCHUNK, c = u - sg * NCHUNK, gb = sg >> 3, gdir = (sg >> 2) & 1, gh = sg & 3; unsigned char* ws = F.ws;
    const bf16* Qp = (const bf16*)(ws + WS_QGB); const bf16* Kp = (const bf16*)(ws + WS_KGB); const bf16* Vp = (const bf16*)(ws + WS_VGB); const bf16* LAp = (const bf16*)(ws + (gdir ? WS_LAB : WS_LAF));
#pragma unroll
    for (int i = 0; i < 8; ++i) { const int row = scan_row(c * CH + 8 * F.wave + i, gb, gdir); const size_t b2 = (size_t)row * 256 + gh * 64 + F.lane, b5 = (size_t)row * RWW + gh * 128 + F.lane;
        I.la[i] = LAp[b2]; I.q[i] = Qp[b2]; I.k[i] = Kp[b2]; I.v0[i] = Vp[b5]; I.v1[i] = Vp[b5 + 64]; }
}
__device__ __forceinline__ void s1_gla(Frame& F, int u, const GlIn& I, int un, GlIn& Inext, f32x2v (&cv)[32], int& cpend, int cvi) {
    const int sg = u / NCHUNK, c = u - sg * NCHUNK;
    const bool emit = c >= CTXL / CH;
    LAS unsigned char* lds = F.lds; unsigned char* ws = F.ws;
    int lane_ = F.lane; asm volatile("" : "+v"(lane_));
    const int lane = lane_, wave = F.wave, rr = lane & 15, q = lane >> 4;
    LAS float* tot = (LAS float*)(lds + AUX_OFF);
    unsigned char* QE = (unsigned char*)F.out + OUT_QE + (size_t)u * 4096;
    {
        float la[8], xq[8], xk[8], v0[8], v1[8];
#pragma unroll
        for (int i = 0; i < 8; ++i) { la[i] = bf2f(I.la[i]); xq[i] = bf2f(I.q[i]); xk[i] = bf2f(I.k[i]); v0[i] = bf2f(I.v0[i]); v1[i] = bf2f(I.v1[i]); }
        float p[8]; p[0] = la[0];
#pragma unroll
        for (int i = 1; i < 8; ++i) p[i] = p[i - 1] + la[i];
        tot[wave * 64 + lane] = p[7];
        S1_BAR();
        float off = 0.f, all = 0.f;
#pragma unroll
        for (int w = 0; w < 8; ++w) { const float t = tot[w * 64 + lane]; all += t; off += (w < wave) ? t : 0.f; }
        if (wave == 0) ((float*)(ws + WS_DD))[(size_t)u * 64 + lane] = __expf(all);
        float kl[8];
#pragma unroll
        for (int i = 0; i < 8; ++i) { const float cum = off + p[i]; const int t = 8 * wave + i;
            const float qef = xq[i] * __expf(cum);
            SLOT(0)[t * LP + lane] = (bf16)pk2z(qef);
            if (emit) QE[t * 64 + lane] = (unsigned char)__builtin_amdgcn_cvt_pk_fp8_f32(clamp8(qef), 0.f, 0, false);
            SLOT(1)[t * LP + lane] = (bf16)pk2z(xk[i] * __expf(-cum));
            kl[i] = xk[i] * __expf(all - cum); }
        *(LAS v4u*)(SLOT(2) + lane * LP + 8 * wave) = pk8(kl);
        *(LAS v4u*)(SLOT(3) + lane * LP + 8 * wave) = pk8(v0);
        *(LAS v4u*)(SLOT(3) + (64 + lane) * LP + 8 * wave) = pk8(v1);
        S1_BAR();
    }
    if (wave >= 4) { CVY_FLUSH(); s1_gla_load(F, un, Inext); CVY_START(cvi); }
    else if (emit) {
#pragma unroll
        for (int tix = 0; tix < 4; ++tix) { const int ti = 4 * wave + tix, r0 = 16 * (ti >> 2), c0 = 16 * (ti & 3), ci = c0 + rr;
            f32x4 acc = mm_tile(SLOT(1), r0, SLOT(0), c0, lane);
#pragma unroll
            for (int e = 0; e < 4; ++e) acc[e] = (r0 + 4 * q + e <= ci) ? acc[e] : 0.f;
            *(LAS v2u*)(SLOT(5) + ci * LP + r0 + 4 * q) = pack4(acc); }
    }
    bf16* KV = (bf16*)(ws + WS_KV) + (size_t)u * 8192;
#pragma unroll
    for (int tix = 0; tix < 4; ++tix) { const int ti = 4 * wave + tix, r0 = 16 * (ti >> 3), c0 = 16 * (ti & 7), ci = c0 + rr;
        const f32x4 acc = mm_tile(SLOT(2), r0, SLOT(3), c0, lane);
        *(v2u*)(KV + ci * 64 + r0 + 4 * q) = pack4(acc); }
    S1_BAR();
    if (emit) {
        unsigned char* IN = ws + WS_INTRA + (size_t)u * 8192;
#pragma unroll
        for (int tix = 0; tix < 4; ++tix) { const int ti = 4 * wave + tix, r0 = 16 * (ti >> 2), c0 = 16 * (ti & 3), ci = c0 + rr;
            const f32x4 acc = mm_tile(SLOT(3), r0, SLOT(5), c0, lane);
            *(unsigned*)(IN + ci * 128 + r0 + 4 * q) = pack4_fp8(acc); }
    }
    S1_BAR();
}

__device__ __forceinline__ void ph_scan1(Frame& F) {
    f32x2v cv[32]; int cpend = -1; const int lane = F.lane;
    int item = (int)blockIdx.x * 4 + (F.wave & 3);
    { RwIn cur, nxt; if ((int)blockIdx.x < NU_RW) s1_rwkv_load(F, blockIdx.x, cur);
#pragma unroll 1
      for (int u = blockIdx.x; u < NU_RW; u += F.G, item += F.G * 4) { const int un = (u + F.G < NU_RW) ? u + F.G : u; s1_rwkv(F, u, cur, un, nxt, cv, cpend, item); cur = nxt; } }
    { GlIn cur, nxt; if ((int)blockIdx.x < NU_GL) s1_gla_load(F, blockIdx.x, cur);
#pragma unroll 1
      for (int u = blockIdx.x; u < NU_GL; u += F.G, item += F.G * 4) { const int un = (u + F.G < NU_GL) ? u + F.G : u; if (F.wave < 4) s1_gla_load(F, un, nxt); s1_gla(F, u, cur, un, nxt, cv, cpend, item); cur = nxt; } }
    if (F.wave >= 4) CVY_FLUSH();
}

__device__ __forceinline__ bf16x8 pack_frag(const f32x4 lo, const f32x4 hi) {
    v4u w; w.x = pk2(lo[0], lo[1]); w.y = pk2(lo[2], lo[3]); w.z = pk2(hi[0], hi[1]); w.w = pk2(hi[2], hi[3]); return __builtin_bit_cast(bf16x8, w);
}
constexpr int S2_D = 5, S2_R = 6, S2_RW = 8192 + 4096 + 2048 + 1024, S2_GL = 4096 + 2048 + 1024 + 1024, S2_SLOT = S2_RW + S2_GL;
static_assert(S2_R * S2_SLOT <= MISC_OFF, "S2 ring fits in LDS");
__device__ __forceinline__ void s2_issue(LAS unsigned char* lds, int sb, int lw, int lane, size_t ur, size_t ug, int v0r, int v0g,
                                         const unsigned char* GTb, const unsigned char* RHb, const unsigned char* HHb, const unsigned char* YLb,
                                         const unsigned char* QEb, const unsigned char* KVb, const unsigned char* INb, const unsigned char* DDb) {
#pragma unroll
    for (int j = 0; j < 4; ++j) {
        int k = lw * 4 + j; if (k >= 23) k -= 1;
        const unsigned char* src; int ldo;
        if (k < 8) { const int n = k, pu = n * 64 + lane, row = pu >> 3, c16 = (pu & 7) ^ (row & 7);
            src = GTb + ur * 8192 + row * 128 + c16 * 16; ldo = n * 1024; }
        else if (k < 12) { const int n = k - 8, pu = n * 64 + lane, row = pu >> 2, c16 = (pu & 3) ^ (row & 3);
            src = RHb + ur * 4096 + row * 64 + c16 * 16; ldo = 8192 + n * 1024; }
        else if (k < 14) { const int n = k - 12, pu = n * 64 + lane, v = pu >> 3, c16 = (pu & 7) ^ (v & 7);
            src = HHb + ur * 8192 + (size_t)(v0r + v) * 128 + c16 * 16; ldo = 12288 + n * 1024; }
        else if (k < 15) { const int t = lane;
            src = YLb + ur * 4096 + t * 64 + v0r; ldo = 14336; }
        else if (k < 19) { const int n = k - 15, pu = n * 64 + lane, row = pu >> 2, c16 = (pu & 3) ^ (row & 3);
            src = QEb + ug * 4096 + row * 64 + c16 * 16; ldo = S2_RW + n * 1024; }
        else if (k < 21) { const int n = k - 19, pu = n * 64 + lane, v = pu >> 3, c16 = (pu & 7) ^ (v & 7);
            src = KVb + ug * 16384 + (size_t)(v0g + v) * 128 + c16 * 16; ldo = S2_RW + 4096 + n * 1024; }
        else if (k < 22) { const int t = lane;
            src = INb + ug * 8192 + t * 128 + v0g; ldo = S2_RW + 6144; }
        else { src = DDb + ug * 256 + (lane & 15) * 16; ldo = S2_RW + 7168; }
        __builtin_amdgcn_global_load_lds((const unsigned*)src, (LAS unsigned*)(lds + sb + ldo), 16, 0, 0);
    }
}
__device__ __forceinline__ void ph_scan2(Frame& F) {
    const int lane = F.lane, wave = F.wave, rr = lane & 15, q = lane >> 4; unsigned char* ws = F.ws; LAS unsigned char* lds = F.lds;
    const int it = (F.G == 256) ? (int)(blockIdx.x & 7) * 32 + (int)(blockIdx.x >> 3) : (int)blockIdx.x;
    const int sr = it >> 2, v0r = 16 * (it & 3), rb = sr >> 4, rdir = (sr >> 3) & 1, rh = sr & 7;
    const int sg = it >> 3, v0g = 16 * (it & 7), gb = sg >> 3, gdir = (sg >> 2) & 1, gh = sg & 3;
#define S2_BAR() do { asm volatile("s_waitcnt lgkmcnt(0)" ::: "memory"); __builtin_amdgcn_s_barrier(); asm volatile("" ::: "memory"); } while (0)
    if (wave >= 2) {
        const unsigned char* GTb = (const unsigned char*)F.out + OUT_GT; const unsigned char* QEb = (const unsigned char*)F.out + OUT_QE;
        const unsigned char* RHb = ws + WS_RH; const unsigned char* YLb = ws + WS_YL; const unsigned char* HHb = ws + WS_HH; const unsigned char* KVb = ws + WS_KV; const unsigned char* INb = ws + WS_INTRA;
        const unsigned char* DDb = ws + WS_DD;
#define S2_ISSUE(cc) s2_issue(lds, ((cc) % S2_R) * S2_SLOT, wave - 2, lane, (size_t)(sr * NCHUNK + ((cc) < NCHUNK ? (cc) : NCHUNK - 1)), (size_t)(sg * NCHUNK + ((cc) < NCHUNK ? (cc) : NCHUNK - 1)), v0r, v0g, GTb, RHb, HHb, YLb, QEb, KVb, INb, DDb)
        S2_ISSUE(0); S2_ISSUE(1); S2_ISSUE(2); S2_ISSUE(3); S2_ISSUE(4);
#pragma unroll 1
        for (int c = 0; c < NCHUNK; ++c) {
            asm volatile("s_waitcnt vmcnt(16) ; S2WAIT" ::: "memory");
            S2_BAR();
            S2_ISSUE(c + S2_D);
        }
#undef S2_ISSUE
    } else if (wave == 0) {
        bf16* ORW = (bf16*)(ws + (rdir ? WS_ORWB : WS_ORWF));
        f32x4 S[4];
#pragma unroll
        for (int m = 0; m < 4; ++m) S[m] = (f32x4){0.f, 0.f, 0.f, 0.f};
#pragma unroll 1
        for (int c = 0; c < NCHUNK; ++c) {
            S2_BAR();
            const LAS unsigned char* sl = lds + (c % S2_R) * S2_SLOT;
            const bool emit = c >= CTXL / CH;
            bf16x8 G0[4], G1[4]; v2u Hw[4], Rw0[4], Rw1[4]; unsigned Yw[4];
#pragma unroll
            for (int m = 0; m < 4; ++m) { const int k2 = 16 * m + rr;
                G0[m] = *(const LAS bf16x8*)(sl + (k2 * 8 + (q ^ (k2 & 7))) * 16); G1[m] = *(const LAS bf16x8*)(sl + (k2 * 8 + ((4 + q) ^ (k2 & 7))) * 16);
                Hw[m] = *(const LAS v2u*)(sl + 12288 + (rr * 8 + ((2 * m + (q >> 1)) ^ (rr & 7))) * 16 + (q & 1) * 8); }
            if (emit) {
#pragma unroll
                for (int tt = 0; tt < 4; ++tt) { const int t = 16 * tt + rr;
                    Rw0[tt] = *(const LAS v2u*)(sl + 8192 + (t * 4 + ((q >> 1) ^ (t & 3))) * 16 + (q & 1) * 8); Rw1[tt] = *(const LAS v2u*)(sl + 8192 + (t * 4 + ((2 + (q >> 1)) ^ (t & 3))) * 16 + (q & 1) * 8);
                    Yw[tt] = *(const LAS unsigned*)(sl + 14336 + t * 16 + q * 4); }
            }
            const bf16x8 Sf0 = pack_frag(S[0], S[1]), Sf1 = pack_frag(S[2], S[3]);
            __builtin_amdgcn_sched_barrier(0);
#pragma unroll
            for (int m = 0; m < 4; ++m) { f32x4 acc = unpack4(Hw[m]);
                acc = __builtin_amdgcn_mfma_f32_16x16x32_bf16(G0[m], Sf0, acc, 0, 0, 0);
                acc = __builtin_amdgcn_mfma_f32_16x16x32_bf16(G1[m], Sf1, acc, 0, 0, 0);
                S[m] = acc; }
            if (emit) {
#pragma unroll
                for (int tt = 0; tt < 4; ++tt) { const int t = 16 * tt + rr;
                    const bf16x8 R0 = pack_frag(unpack4_fp8(Rw0[tt].x), unpack4_fp8(Rw0[tt].y)), R1 = pack_frag(unpack4_fp8(Rw1[tt].x), unpack4_fp8(Rw1[tt].y));
                    f32x4 acc = unpack4_fp8(Yw[tt]);
                    acc = __builtin_amdgcn_mfma_f32_16x16x32_bf16(Sf0, R0, acc, 0, 0, 0);
                    acc = __builtin_amdgcn_mfma_f32_16x16x32_bf16(Sf1, R1, acc, 0, 0, 0);
                    const int row = scan_row(c * CH + t, rb, rdir);
                    *(v2u*)(ORW + (size_t)row * RWW + rh * 64 + v0r + 4 * q) = pack4(acc); }
            }
        }
    } else {
        bf16* OGL = (bf16*)(ws + (gdir ? WS_OGLB : WS_OGLF));
        f32x4 S[4];
#pragma unroll
        for (int m = 0; m < 4; ++m) S[m] = (f32x4){0.f, 0.f, 0.f, 0.f};
#pragma unroll 1
        for (int c = 0; c < NCHUNK; ++c) {
            S2_BAR();
            const LAS unsigned char* sl = lds + (c % S2_R) * S2_SLOT + S2_RW;
            const bool emit = c >= CTXL / CH;
            v2u Qw0[4], Qw1[4]; unsigned Iw[4]; v4u kw[2]; f32x4 d0[2], d1[2];
#pragma unroll
            for (int s2 = 0; s2 < 2; ++s2) { kw[s2] = *(const LAS v4u*)(sl + 4096 + (rr * 8 + ((4 * s2 + q) ^ (rr & 7))) * 16);
                d0[s2] = *(const LAS f32x4*)(sl + 7168 + 128 * s2 + 32 * q); d1[s2] = *(const LAS f32x4*)(sl + 7168 + 128 * s2 + 32 * q + 16); }
            if (emit) {
#pragma unroll
                for (int tt = 0; tt < 4; ++tt) { const int t = 16 * tt + rr;
                    Qw0[tt] = *(const LAS v2u*)(sl + (t * 4 + ((q >> 1) ^ (t & 3))) * 16 + (q & 1) * 8); Qw1[tt] = *(const LAS v2u*)(sl + (t * 4 + ((2 + (q >> 1)) ^ (t & 3))) * 16 + (q & 1) * 8);
                    Iw[tt] = *(const LAS unsigned*)(sl + 6144 + t * 16 + q * 4); }
            }
            const bf16x8 Sf0 = pack_frag(S[0], S[1]), Sf1 = pack_frag(S[2], S[3]);
            __builtin_amdgcn_sched_barrier(0);
#pragma unroll
            for (int s2 = 0; s2 < 2; ++s2) { S[2 * s2] = S[2 * s2] * d0[s2] + unpack4((v2u){kw[s2].x, kw[s2].y}); S[2 * s2 + 1] = S[2 * s2 + 1] * d1[s2] + unpack4((v2u){kw[s2].z, kw[s2].w}); }
            if (emit) {
#pragma unroll
                for (int tt = 0; tt < 4; ++tt) { const int t = 16 * tt + rr;
                    const bf16x8 Q0 = pack_frag(unpack4_fp8(Qw0[tt].x), unpack4_fp8(Qw0[tt].y)), Q1 = pack_frag(unpack4_fp8(Qw1[tt].x), unpack4_fp8(Qw1[tt].y));
                    f32x4 acc = unpack4_fp8(Iw[tt]);
                    acc = __builtin_amdgcn_mfma_f32_16x16x32_bf16(Sf0, Q0, acc, 0, 0, 0);
                    acc = __builtin_amdgcn_mfma_f32_16x16x32_bf16(Sf1, Q1, acc, 0, 0, 0);
                    const int row = scan_row(c * CH + t, gb, gdir);
                    *(v2u*)(OGL + (size_t)row * RWW + gh * 128 + v0g + 4 * q) = pack4(acc); }
            }
        }
    }
#undef S2_BAR
}
#endif

#ifndef ML
#define ML 0
#endif
enum Phase { PH_PROLOGUE = 0, PH_A1, PH_INPROJ, PH_FEAT, PH_LORA, PH_SCAN1, PH_SCAN2, PH_MERGE, PH_BRANCH, PH_OUTPROJ, PH_LN1, PH_ROUTER, PH_ROUTE, PH_SCATTER, PH_EXP1, PH_EXP2, PH_FINAL, PH_COUNT };

__global__ void __launch_bounds__(NTHR, 2) mega(Args args) {
    extern __shared__ __attribute__((aligned(16))) unsigned char lds_raw[];
    Frame F;
    F.lds = (LAS unsigned char*)lds_raw;
    F.tid = threadIdx.x; F.lane = F.tid & 63; F.wave = __builtin_amdgcn_readfirstlane(F.tid >> 6);
    F.G = gridDim.x; F.gw = blockIdx.x * NWAVES + F.wave; F.NGW = F.G * NWAVES;
    F.in = args.in; F.out = args.out; F.ws = args.ws; F.ctl = (unsigned*)(args.ws + WS_CTL);
    volatile LAS unsigned* MISC = (volatile LAS unsigned*)(F.lds + MISC_OFF);
    if (F.tid < 64) MISC[F.tid] = 0u;
    __syncthreads();
    XcdBarrier bar; bar.bar = F.ctl + CW_BAR; bar.x = 0; bar.st = nullptr;
#if !ML
    bar = xcd_barrier_post(F.ctl + CW_BAR, MISC + 8);
#endif
    const int lo = args.ph_lo, hi = args.ph_hi;
#define IN(k) (lo <= (k) && (k) < hi)
#ifndef DUP
#define DUP -1
#endif
#define RUN(k, call) do { if (IN(k)) { call; GRID_BAR(); if (DUP == (k)) { call; GRID_BAR(); } } } while (0)
#if ML
#define GRID_BAR() do { } while (0)
#else
#define GRID_BAR() xcd_barrier(bar)
#endif

#if MS >= 2
    RUN(PH_PROLOGUE, ph_prologue(F));
#endif
#if MS >= 3
    RUN(PH_A1, ph_a1(F));
    RUN(PH_INPROJ, ph_inproj(F));
    RUN(PH_FEAT, ph_feat(F));
    RUN(PH_LORA, ph_lora(F));
    RUN(PH_SCAN1, ph_scan1(F));
    RUN(PH_SCAN2, ph_scan2(F));
    RUN(PH_MERGE, ph_merge(F));
    RUN(PH_BRANCH, ph_branch(F));
    RUN(PH_OUTPROJ, ph_outproj(F));
#else
    RUN(PH_OUTPROJ, ph_x1pre_nomix(F));
#endif
    RUN(PH_LN1, ph_ln1(F));
#if MS >= 2
    RUN(PH_ROUTER, ph_router(F));
    RUN(PH_ROUTE, ph_route(F));
    RUN(PH_SCATTER, ph_scatter(F));
    RUN(PH_EXP1, ph_exp1(F));
    RUN(PH_EXP2, ph_exp2(F));
#endif
    if (IN(PH_FINAL)) { ph_final(F); }
#undef IN
}

extern "C" void kernel_launch(void* const* d_in, const int* in_sizes, int n_in, void* d_out, int out_size, void* d_ws, size_t ws_size, hipStream_t stream) {
    static int grid = 0;
    if (grid == 0) {
        if (n_in != 36 || out_size != NLAT * D || ws_size < WS_END) { fprintf(stderr, "kernel_launch: unexpected problem shape (n_in %d, out %d)\n", n_in, out_size); grid = -1; return; }
        int dev = 0, cus = 0, per_cu = 0;
        if (hipGetDevice(&dev) != hipSuccess || hipDeviceGetAttribute(&cus, hipDeviceAttributeMultiprocessorCount, dev) != hipSuccess) { grid = -1; return; }
        if (hipFuncSetAttribute((const void*)mega, hipFuncAttributeMaxDynamicSharedMemorySize, LDS_BYTES) != hipSuccess) { fprintf(stderr, "kernel_launch: hipFuncSetAttribute failed\n"); grid = -1; return; }
        if (hipOccupancyMaxActiveBlocksPerMultiprocessor(&per_cu, (const void*)mega, NTHR, LDS_BYTES) != hipSuccess || per_cu < 1) { fprintf(stderr, "kernel_launch: occupancy query says %d\n", per_cu); }
        (void)hipGetLastError();
        grid = cus > 0 ? cus : 256;
        if (grid > 256) grid = 256;
    }
    if (grid < 0) return;
    (void)hipMemsetAsync((char*)d_ws + WS_CTL, 0, CTL_ZERO_BYTES, stream);
    Args a{};
    for (int i = 0; i < 36; ++i) a.in[i] = (const float*)d_in[i];
    a.out = (float*)d_out; a.ws = (unsigned char*)d_ws;
#if ML
    for (int p = 0; p < PH_COUNT; ++p) { a.ph_lo = p; a.ph_hi = p + 1; hipLaunchKernelGGL(mega, dim3(grid), dim3(NTHR), LDS_BYTES, stream, a); }
#else
    a.ph_lo = 0; a.ph_hi = PH_COUNT;
    hipLaunchKernelGGL(mega, dim3(grid), dim3(NTHR), LDS_BYTES, stream, a);
#endif
}
```

```cpp
#include <hip/hip_runtime.h>
#include <cstdio>
#include <cstdint>

#ifndef MS
#define MS 3
#endif

#define GAS __attribute__((address_space(1)))
#define LAS __attribute__((address_space(3)))
typedef unsigned short bf16;
typedef unsigned v4u __attribute__((ext_vector_type(4)));
typedef unsigned v2u __attribute__((ext_vector_type(2)));
typedef float f32x4 __attribute__((ext_vector_type(4)));
typedef float f32x2 __attribute__((ext_vector_type(2)));
typedef short bf16x8 __attribute__((ext_vector_type(8)));
#define LDS_WAIT() asm volatile("s_waitcnt lgkmcnt(0)" ::: "memory")
#define VM_WAIT() asm volatile("s_waitcnt vmcnt(0)" ::: "memory")

constexpr int D = 1024, NB = 4, SEQ = 8192, CTXL = 256, GRIDW = 64, GRIDH = 128;
constexpr int NLAT = NB * SEQ, NCTX = NB * CTXL, MR = NLAT + NCTX;
constexpr int RWW = 512, RWH = 8, HD = 64;
constexpr int C_R = 0, C_K = 512, C_V = 1024, C_PW = 1536, C_PA = 1568, C_PG = 1600, C_Q = 1696, C_KG = 1952, C_VG = 2208, C_PGL = 2720, C_OG = 2736, C_GRW = 3248, C_GGLA = 4272;
constexpr int IN_COLS = 5296, NP = 5376;
constexpr int NE = 256, TOPK = 8, FF = 256;
constexpr float LN_EPS = 1e-5f, RW_GN_EPS = 64e-5f;
constexpr float ALPHA = 1.189207115f;
constexpr float W8S = 64.0f, W8I = 1.0f / 64.0f;
constexpr int NLORA = 3072, KLORA = 256;
constexpr int MAXTILES = 1280, SH_ROW0 = MAXTILES * 256, NROWS_E = SH_ROW0 + NLAT;

namespace pg8 {
#define PG8_LAS __attribute__((address_space(3)))
typedef unsigned short bf16_t;
typedef unsigned u32x4 __attribute__((ext_vector_type(4)));
typedef unsigned u32x2 __attribute__((ext_vector_type(2)));
typedef long i64x2 __attribute__((ext_vector_type(2)));
constexpr int BM = 256, BK = 64, HALF = 128, HTB = HALF * BK * 2, STAGE_BYTES = 8 * HTB, NXCD = 8, WGM = 8;
constexpr int IDX_OFF = STAGE_BYTES, IDX_UNITS = 12;

__host__ __device__ __forceinline__ int lds_byte(int r, int c) { const int st = (r >> 4) * 2 + (c >> 5), rr = r & 15, cc = c & 31, ob = rr * 64 + cc * 2; return st * 1024 + (ob ^ (((ob >> 9) & 1) << 5)); }
__host__ __device__ __forceinline__ void stage_rc(int b, int& R, int& C) { const int st = b / 1024, sb = b % 1024, swz = sb ^ (((sb >> 9) & 1) << 5); R = (st >> 1) * 16 + swz / 64; C = (st & 1) * 32 + (swz % 64) / 2; }
__host__ __device__ __forceinline__ int perm32(int rho) { const int n = rho >> 4, i = rho & 15; return 8 * (i >> 2) + 4 * n + (i & 3); }

struct Unit { int pm, pn, e, j; };
struct Gemm { const bf16_t* A; const bf16_t* Bt; int M, N, K; const int* rowidx; };

struct StaticOrder {
    int nM, nN, nwg, G, c;
    __host__ __device__ void init(int M, int N, int G_, int c_) { nM = M / BM; nN = N / BM; nwg = nM * nN; G = G_; c = c_; }
    __host__ __device__ bool next(int i, Unit& u) const {
        const long L = (long)i * G + c; if (L >= nwg) return false;
        int wgid = (int)L; { const int q = nwg / NXCD, r = nwg % NXCD, xcd = wgid % NXCD, off = wgid / NXCD; wgid = (xcd < r ? xcd * (q + 1) : r * (q + 1) + (xcd - r) * q) + off; }
        const int nig = WGM * nN, gid = wgid / nig, fm = gid * WGM, gsz = (nM - fm) < WGM ? (nM - fm) : WGM;
        u.pm = fm + ((wgid % nig) % gsz); u.pn = (wgid % nig) / gsz; u.e = 0; u.j = u.pn; return true;
    }
};
struct MoeOrder {
    int nN, G, c, NT; const int* tile_e;
    __device__ bool next(int i, Unit& u) const {
        int tile, j;
        if (G == 256) { const int x = c & 7, y = c >> 3; tile = i * (256 / nN) + x * (32 / nN) + y / nN; j = y % nN; if (tile >= NT + NLAT / 256) return false; }
        else { const int L = i * G + c; if (L >= (NT + NLAT / 256) * nN) return false; tile = L / nN; j = L - tile * nN; }
        int e, pm;
        if (tile < NT) { e = tile_e[tile]; pm = tile; } else { e = NE; pm = MAXTILES + (tile - NT); }
        u.pm = pm; u.pn = e * nN + j; u.e = e; u.j = j; return true;
    }
};

typedef __bf16 bf16x2n __attribute__((ext_vector_type(2))); typedef float f32x2n __attribute__((ext_vector_type(2)));
__device__ __forceinline__ unsigned cvt_pk_bf16(float lo, float hi) { const f32x2n v = {lo, hi}; return __builtin_bit_cast(unsigned, __builtin_convertvector(v, bf16x2n)); }

template <class Epi, class Sched, bool ALIGN_EPI, bool SP2, bool GATHER, bool FP8 = false>
__device__ __forceinline__ void gemm_phase(PG8_LAS unsigned char* lds, const Gemm g, const Sched& S, const Epi& E) {
    const int tid = threadIdx.x, wid = __builtin_amdgcn_readfirstlane(tid >> 6), lane = tid & 63, wr = wid >> 2, wc = wid & 3, fr = lane & 15, fq = lane >> 4;
    const int K = g.K, nt = K / BK;
    const size_t kstep = (size_t)(BK * 2);
    const size_t hstep = (size_t)HALF * K * 2;
    const size_t tstep = 2 * hstep;
    unsigned voffB[2]; unsigned va[2][2];
#pragma unroll
    for (int i = 0; i < 2; ++i) { int R, C; stage_rc(tid * 16 + i * 8192, R, C); const int Rb = Epi::PERM ? ((R & ~31) + perm32(R & 31)) : R;
        voffB[i] = (unsigned)(Rb * K + C) * 2u;
        va[0][i] = (unsigned)(R * K + C) * 2u; va[1][i] = va[0][i]; }
    const size_t ah = GATHER ? (size_t)0 : hstep;
#define PG8_GOFF(dst, ub) do { _Pragma("unroll") for (int _h = 0; _h < 2; ++_h) _Pragma("unroll") for (int _i = 0; _i < 2; ++_i) { int _R, _C; stage_rc(tid * 16 + _i * 8192, _R, _C); \
        dst[_h][_i] = (unsigned)(idxt[(ub) * 256 + _h * 128 + _R] * K + _C) * 2u; } } while (0)
    const unsigned ldsw = (unsigned)wid * 1024u;
    const int aoff = lds_byte(wr * 64 + fr, fq * 8), boff = lds_byte(wc * 32 + fr, fq * 8);
    PG8_LAS int* idxt = (PG8_LAS int*)(lds + IDX_OFF);
#define PG8_SA(b, h) (((b) * 2 + (h)) * HTB)
#define PG8_SB(b, h) ((4 + (b) * 2 + (h)) * HTB)
#define PG8_STAGE(bufoff, gbase, voff) do { _Pragma("unroll") for (int _i = 0; _i < 2; ++_i) \
        __builtin_amdgcn_global_load_lds((const unsigned*)((const char*)(gbase) + (voff)[_i]), (PG8_LAS unsigned*)(lds + (bufoff) + ldsw + _i * 8192), 16, 0, 0); } while (0)
#define PG8_LDA(dst, b, h) do { _Pragma("unroll") for (int m = 0; m < 4; ++m) _Pragma("unroll") for (int k = 0; k < 2; ++k) dst[m][k] = *(const PG8_LAS bf16x8*)(lds + PG8_SA(b, h) + aoff + m * 2048 + k * 1024); } while (0)
#define PG8_LDB(dst, b, h) do { _Pragma("unroll") for (int n = 0; n < 2; ++n) _Pragma("unroll") for (int k = 0; k < 2; ++k) dst[n][k] = *(const PG8_LAS bf16x8*)(lds + PG8_SB(b, h) + boff + n * 2048 + k * 1024); } while (0)
#define PG8_MMA(ai, bj, At, Bt) do { __builtin_amdgcn_s_setprio(1); _Pragma("unroll") for (int m = 0; m < 4; ++m) _Pragma("unroll") for (int n = 0; n < 2; ++n) _Pragma("unroll") for (int k = 0; k < 2; ++k) { \
        if constexpr (FP8) { const i64x2 _b = __builtin_bit_cast(i64x2, Bt[n][k]), _a = __builtin_bit_cast(i64x2, At[m][k]); \
            acc[ai][bj][m][n] = __builtin_amdgcn_mfma_f32_16x16x32_fp8_fp8(_b[0], _a[0], acc[ai][bj][m][n], 0, 0, 0); acc[ai][bj][m][n] = __builtin_amdgcn_mfma_f32_16x16x32_fp8_fp8(_b[1], _a[1], acc[ai][bj][m][n], 0, 0, 0); } \
        else acc[ai][bj][m][n] = __builtin_amdgcn_mfma_f32_16x16x32_bf16(Bt[n][k], At[m][k], acc[ai][bj][m][n], 0, 0, 0); } __builtin_amdgcn_s_setprio(0); } while (0)
#define PG8_WAIT_V(n) asm volatile("s_waitcnt vmcnt(" #n ")" ::: "memory")
#define PG8_WAIT_L(n) asm volatile("s_waitcnt lgkmcnt(" #n ")" ::: "memory")
#define PG8_BAR __builtin_amdgcn_s_barrier()
#define PG8_SCHED __builtin_amdgcn_sched_barrier(0)
    Unit cur, nxt; int ui = 0;
    if (!S.next(0, cur)) return;
#ifdef GEMM_STAGGER
    if constexpr (FP8) {
        const unsigned long long t0 = __builtin_amdgcn_s_memrealtime(); const unsigned long long dl = (unsigned long long)(blockIdx.x & 3) * GEMM_STAGGER;
        while (__builtin_amdgcn_s_memrealtime() - t0 < dl) __builtin_amdgcn_s_sleep(8);
    }
#endif
    if constexpr (GATHER) {
        Unit uu;
        for (int i = 0; i < IDX_UNITS; ++i) { if (!S.next(i, uu)) break; if (tid < 256) idxt[i * 256 + tid] = g.rowidx[(size_t)uu.pm * 256 + tid]; }
        asm volatile("s_waitcnt vmcnt(0) lgkmcnt(0)" ::: "memory"); PG8_BAR; asm volatile("" ::: "memory");
        PG8_GOFF(va, 0);
    }
    f32x4 acc[2][2][4][2];
#pragma unroll
    for (int a = 0; a < 2; ++a)
#pragma unroll
        for (int b = 0; b < 2; ++b)
#pragma unroll
            for (int m = 0; m < 4; ++m)
#pragma unroll
                for (int n = 0; n < 2; ++n) acc[a][b][m][n] = (f32x4){0.f, 0.f, 0.f, 0.f};
    bf16x8 At[4][2], B0[2][2], B1[2][2];
    const char* cA = (const char*)g.A + (GATHER ? (size_t)0 : (size_t)cur.pm * tstep); const char* cB = (const char*)g.Bt + (size_t)cur.pn * tstep;
    if constexpr (SP2) {
        PG8_STAGE(PG8_SB(0, 0), cB, voffB); PG8_STAGE(PG8_SB(0, 1), cB + hstep, voffB); PG8_STAGE(PG8_SA(0, 0), cA, va[0]); PG8_STAGE(PG8_SA(0, 1), cA + ah, va[1]);
        if (wr == 1) PG8_BAR;
        PG8_WAIT_V(2); PG8_BAR;
        PG8_STAGE(PG8_SB(1, 0), cB + kstep, voffB); PG8_STAGE(PG8_SA(1, 0), cA + kstep, va[0]); PG8_STAGE(PG8_SB(1, 1), cB + hstep + kstep, voffB);
        PG8_WAIT_V(6); PG8_BAR;
    } else {
        PG8_STAGE(PG8_SB(0, 0), cB, voffB); PG8_STAGE(PG8_SA(0, 0), cA, va[0]); PG8_STAGE(PG8_SB(0, 1), cB + hstep, voffB); PG8_STAGE(PG8_SA(0, 1), cA + ah, va[1]);
        if (wr == 1) PG8_BAR;
        PG8_WAIT_V(4); PG8_BAR;
        PG8_STAGE(PG8_SB(1, 0), cB + kstep, voffB); PG8_STAGE(PG8_SA(1, 0), cA + kstep, va[0]); PG8_STAGE(PG8_SB(1, 1), cB + hstep + kstep, voffB);
        PG8_WAIT_V(6); PG8_BAR;
    }
    for (;;) {
        const bool has_next = S.next(ui + 1, nxt);
        const char* nA = has_next ? (const char*)g.A + (GATHER ? (size_t)0 : (size_t)nxt.pm * tstep) : cA; const char* nB = has_next ? (const char*)g.Bt + (size_t)nxt.pn * tstep : cB;
        const int ubn = (has_next && ui + 1 < IDX_UNITS) ? (ui + 1) : ui;
#pragma unroll 1
        for (int t = 0; t < nt; t += 2) {
            const bool last = (t == nt - 2);
            const char* a1 = cA + (size_t)(t + 1) * kstep;
            const char* a2 = last ? nA : cA + (size_t)(t + 2) * kstep; const char* b2 = last ? nB : cB + (size_t)(t + 2) * kstep;
            const char* a3 = a2 + kstep; const char* b3 = b2 + kstep;
            unsigned v2[2][2];
#pragma unroll
            for (int h = 0; h < 2; ++h)
#pragma unroll
                for (int i = 0; i < 2; ++i) v2[h][i] = va[h][i];
            if constexpr (GATHER) { if (last) PG8_GOFF(v2, ubn); }
            if constexpr (SP2) {
            PG8_LDB(B0, 0, 0); PG8_LDB(B1, 0, 1); PG8_SCHED; PG8_LDA(At, 0, 0); PG8_STAGE(PG8_SA(1, 1), a1 + ah, va[1]);
            PG8_WAIT_V(8); PG8_WAIT_L(0); PG8_BAR; PG8_MMA(0, 0, At, B0); PG8_MMA(0, 1, At, B1); PG8_BAR; PG8_SCHED;
            PG8_LDA(At, 0, 1); PG8_STAGE(PG8_SB(0, 0), b2, voffB); PG8_STAGE(PG8_SB(0, 1), b2 + hstep, voffB); PG8_STAGE(PG8_SA(0, 0), a2, v2[0]);
            PG8_WAIT_V(8); PG8_WAIT_L(0); PG8_BAR; PG8_MMA(1, 0, At, B0); PG8_MMA(1, 1, At, B1); PG8_BAR; PG8_SCHED;
            PG8_LDB(B0, 1, 0); PG8_LDB(B1, 1, 1); PG8_SCHED; PG8_LDA(At, 1, 0); PG8_STAGE(PG8_SA(0, 1), a2 + ah, v2[1]);
            PG8_WAIT_V(8); PG8_WAIT_L(0); PG8_BAR; PG8_MMA(0, 0, At, B0); PG8_MMA(0, 1, At, B1); PG8_BAR; PG8_SCHED;
            PG8_LDA(At, 1, 1); PG8_STAGE(PG8_SB(1, 0), b3, voffB); PG8_STAGE(PG8_SB(1, 1), b3 + hstep, voffB); PG8_STAGE(PG8_SA(1, 0), a3, v2[0]);
            PG8_WAIT_V(8); PG8_WAIT_L(0); PG8_BAR; PG8_MMA(1, 0, At, B0); PG8_MMA(1, 1, At, B1); PG8_BAR; PG8_SCHED;
            } else {
            PG8_LDB(B0, 0, 0); PG8_SCHED; PG8_LDA(At, 0, 0); PG8_STAGE(PG8_SA(1, 1), a1 + ah, va[1]);
            PG8_WAIT_L(8); PG8_BAR; PG8_WAIT_L(0); PG8_MMA(0, 0, At, B0); PG8_BAR; PG8_SCHED;
            PG8_LDB(B1, 0, 1); PG8_STAGE(PG8_SB(0, 0), b2, voffB);
            PG8_BAR; PG8_WAIT_L(0); PG8_MMA(0, 1, At, B1); PG8_BAR;
            PG8_LDA(At, 0, 1); PG8_STAGE(PG8_SA(0, 0), a2, v2[0]);
            PG8_BAR; PG8_WAIT_L(0); PG8_MMA(1, 0, At, B0); PG8_BAR; PG8_SCHED;
            PG8_STAGE(PG8_SB(0, 1), b2 + hstep, voffB);
            PG8_WAIT_V(6); PG8_BAR; PG8_MMA(1, 1, At, B1); PG8_BAR;
            PG8_LDB(B0, 1, 0); PG8_SCHED; PG8_LDA(At, 1, 0); PG8_STAGE(PG8_SA(0, 1), a2 + ah, v2[1]);
            PG8_WAIT_L(8); PG8_BAR; PG8_WAIT_L(0); PG8_MMA(0, 0, At, B0); PG8_BAR; PG8_SCHED;
            PG8_LDB(B1, 1, 1); PG8_STAGE(PG8_SB(1, 0), b3, voffB);
            PG8_BAR; PG8_WAIT_L(0); PG8_MMA(0, 1, At, B1); PG8_BAR;
            PG8_LDA(At, 1, 1); PG8_STAGE(PG8_SA(1, 0), a3, v2[0]);
            PG8_BAR; PG8_WAIT_L(0); PG8_MMA(1, 0, At, B0); PG8_BAR; PG8_SCHED;
            PG8_STAGE(PG8_SB(1, 1), b3 + hstep, voffB);
            PG8_WAIT_V(6); PG8_BAR; PG8_MMA(1, 1, At, B1); PG8_BAR;
            }
        }
        if constexpr (ALIGN_EPI) { if (wr == 0) PG8_BAR; }
        E(acc, cur, wr, wc, fr, fq);
        if (!has_next) break;
#pragma unroll
        for (int a = 0; a < 2; ++a)
#pragma unroll
            for (int b = 0; b < 2; ++b)
#pragma unroll
                for (int m = 0; m < 4; ++m)
#pragma unroll
                    for (int n = 0; n < 2; ++n) acc[a][b][m][n] = (f32x4){0.f, 0.f, 0.f, 0.f};
        cur = nxt; cA = nA; cB = nB; ++ui;
        if constexpr (GATHER) PG8_GOFF(va, ubn);
        if constexpr (ALIGN_EPI) { if (wr == 1) PG8_BAR; }
    }
    PG8_WAIT_V(0);
    if constexpr (!ALIGN_EPI) { if (wr == 0) PG8_BAR; }
    PG8_BAR;
#undef PG8_SA
#undef PG8_GOFF
#undef PG8_SB
#undef PG8_STAGE
#undef PG8_LDA
#undef PG8_LDB
#undef PG8_MMA
#undef PG8_WAIT_V
#undef PG8_WAIT_L
#undef PG8_BAR
#undef PG8_SCHED
}
}

#define XB_TMO      128
#define XB_XCNT(j)  (256  + 64 * (j))
#define XB_XSUB(j)  (1280 + 64 * (j))
#define XB_XGEN(j)  (2304 + 64 * (j))
#define XB_TOP      3328
#define XB_TOPGEN   3392
#define XCD_BAR_WORDS 3456
#define XB_SPIN_CAP (1u << 18)
__device__ __forceinline__ unsigned xb_ld(unsigned* p)              { return __hip_atomic_load(p, __ATOMIC_RELAXED, __HIP_MEMORY_SCOPE_AGENT); }
__device__ __forceinline__ unsigned xb_add(unsigned* p, unsigned v) { return __hip_atomic_fetch_add(p, v, __ATOMIC_RELAXED, __HIP_MEMORY_SCOPE_AGENT); }
__device__ __forceinline__ unsigned xb_xcc_id() { return (unsigned)__builtin_amdgcn_s_getreg((3 << 11) | 20) & 0xFu; }
#define XB_SPIN(cond, bar) do { unsigned _sp = 0; while (cond) { __builtin_amdgcn_s_sleep(1); \
    if ((++_sp & 255u) == 0u) { if (xb_ld(&(bar)[XB_TMO])) break; if (_sp > XB_SPIN_CAP) { atomicAdd(&(bar)[XB_TMO], 1u); break; } } } } while (0)
struct XcdBarrier { unsigned* bar; unsigned x; volatile LAS unsigned* st; };
__device__ __forceinline__ XcdBarrier xcd_barrier_post(unsigned* bar, volatile LAS unsigned* st) {
    XcdBarrier b; b.bar = bar; b.x = xb_xcc_id(); b.st = st;
    if (threadIdx.x == 0) (void)xb_add(&bar[XB_XCNT(b.x)], 1u);
    return b;
}
__device__ __forceinline__ void xcd_barrier_complete(unsigned* bar, unsigned x, unsigned& nloc, unsigned& nx) {
    const unsigned G = gridDim.x * gridDim.y * gridDim.z;
    unsigned sum, cnt, mine, sp = 0u;
    for (;;) {
        sum = 0u; cnt = 0u; mine = 0u;
#pragma unroll
        for (unsigned j = 0; j < 16; ++j) { const unsigned c = xb_ld(&bar[XB_XCNT(j)]); sum += c; cnt += (c > 0u) ? 1u : 0u; mine = (j == x) ? c : mine; }
        if (sum == G) break;
        __builtin_amdgcn_s_sleep(1);
        if ((++sp & 255u) == 0u) { if (xb_ld(&bar[XB_TMO])) break; if (sp > XB_SPIN_CAP) { atomicAdd(&bar[XB_TMO], 1u); break; } }
    }
    nloc = mine > 0u ? mine : 1u; nx = cnt > 0u ? cnt : 1u;
}
__device__ __forceinline__ void xcd_barrier(const XcdBarrier& b) {
    asm volatile("s_waitcnt vmcnt(0)" ::: "memory");
    __syncthreads();
    if (threadIdx.x == 0) {
        unsigned* bar = b.bar;
        __builtin_amdgcn_s_waitcnt(0);
        unsigned nloc = b.st[0], nx = b.st[1];
        if (nloc == 0u) { xcd_barrier_complete(bar, b.x, nloc, nx); b.st[0] = nloc; b.st[1] = nx; }
        const unsigned old = xb_add(&bar[XB_XSUB(b.x)], 1u);
        const unsigned gen = old / nloc;
        if (old + 1u == (gen + 1u) * nloc) {
            __builtin_amdgcn_fence(__ATOMIC_RELEASE, "agent");
            asm volatile("s_waitcnt vmcnt(0)" ::: "memory");
            const unsigned og = xb_add(&bar[XB_TOP], 1u);
            const unsigned tg = og / nx;
            if (og + 1u == (tg + 1u) * nx) xb_add(&bar[XB_TOPGEN], 1u);
            else XB_SPIN(xb_ld(&bar[XB_TOPGEN]) == tg, bar);
            __builtin_amdgcn_fence(__ATOMIC_ACQUIRE, "agent");
            xb_add(&bar[XB_XGEN(b.x)], 1u);
            asm volatile("s_waitcnt vmcnt(0)" ::: "memory");
        } else {
            XB_SPIN(xb_ld(&bar[XB_XGEN(b.x)]) == gen, bar);
            __builtin_amdgcn_fence(__ATOMIC_ACQUIRE, "agent");
            asm volatile("s_waitcnt vmcnt(0)" ::: "memory");
        }
    }
    __syncthreads();
}

constexpr size_t MiB = 1u << 20;
constexpr size_t al(size_t x) { return (x + 4095) & ~(size_t)4095; }
constexpr size_t WS_CTL = 0, CTL_ZERO_BYTES = 1 * MiB;
constexpr int CW_BAR = 4096;
constexpr int CW_CNT = 16384, CNT_STRIDE = 64;
constexpr int CW_NT = CW_CNT + NE * CNT_STRIDE + 64;
static_assert((CW_NT + 1) * 4 <= (int)CTL_ZERO_BYTES, "control words inside the per-call memset");
constexpr size_t WS_MOD = 1 * MiB;
constexpr size_t WS_TILE_E = WS_MOD + 256 * 1024;
constexpr size_t WS_PADSTART = WS_TILE_E + 16 * 1024;
constexpr size_t WS_ROWTOK = 2 * MiB;
constexpr size_t WS_EIDX = 4 * MiB;
constexpr size_t WS_GATE = 5 * MiB;
constexpr size_t WS_DEST = 6 * MiB;
constexpr size_t WS_WIN = 8 * MiB;
constexpr size_t WS_WLORA = WS_WIN + al((size_t)NP * D * 2);
constexpr size_t WS_WBRRW = WS_WLORA + al((size_t)NLORA * KLORA * 2);
constexpr size_t WS_WBRGLA = WS_WBRRW + al((size_t)D * RWW * 2);
constexpr size_t WS_WOUT = WS_WBRGLA + al((size_t)D * RWW * 2);
constexpr size_t WS_WROUTER = WS_WOUT + al((size_t)D * D * 2);
constexpr size_t WS_WGU = WS_WROUTER + al((size_t)NE * D * 2);
constexpr size_t WS_WD = WS_WGU + al((size_t)(NE + 1) * 512 * D * 2);
constexpr size_t WS_PERSIST_END = WS_WD + al((size_t)(NE + 1) * D * FF * 2);
constexpr size_t WS_REGB = WS_PERSIST_END;
constexpr size_t SZ512F = al((size_t)MR * RWW * 4), SZ256F = al((size_t)MR * 256 * 4), SZ512H = al((size_t)MR * RWW * 2);
constexpr size_t WS_A1 = WS_REGB;
constexpr size_t WS_A2 = WS_A1;
constexpr size_t WS_KSUM = WS_A2 + al((size_t)MR * KLORA * 2);
static_assert(WS_KSUM + SZ512H <= WS_A1 + al((size_t)MR * D * 2), "A2 + KSUM fit in the A1 slot");
constexpr size_t WS_P = WS_A1 + al((size_t)MR * D * 2);
constexpr size_t WS_RB = WS_P + al((size_t)MR * NP * 2);
constexpr size_t WS_VB = WS_RB + SZ512H, WS_KKB = WS_VB + SZ512H, WS_KMF = WS_KKB + SZ512H, WS_KMB = WS_KMF + SZ512H, WS_BVF = WS_KMB + SZ512H, WS_BVB = WS_BVF + SZ512H;
constexpr size_t WS_LWF = WS_BVB + SZ512H, WS_LWB = WS_LWF + SZ512F;
constexpr size_t SZ256H = al((size_t)MR * 256 * 2);
constexpr size_t WS_QGB = WS_LWB + SZ512F, WS_KGB = WS_QGB + SZ256H, WS_VGB = WS_KGB + SZ256H, WS_LAF = WS_VGB + SZ512H, WS_LAB = WS_LAF + SZ256F;
constexpr size_t WS_RWG = WS_LAB + SZ256F;
constexpr size_t WS_ORWF = WS_RWG + SZ512H, WS_ORWB = WS_ORWF + SZ512H, WS_OGLF = WS_ORWB + SZ512H, WS_OGLB = WS_OGLF + SZ512H;
constexpr int CH = 64, NCHUNK = (CTXL + SEQ) / CH, NU_RW = 64 * NCHUNK, NU_GL = 32 * NCHUNK;
constexpr size_t WS_RH = WS_OGLB + SZ512H;
constexpr size_t WS_YL = WS_RH + al((size_t)NU_RW * 4096 * 2);
constexpr size_t WS_HH = WS_YL + al((size_t)NU_RW * 4096 * 2);
constexpr size_t WS_INTRA = WS_HH + al((size_t)NU_RW * 4096 * 2);
constexpr size_t WS_KV = WS_INTRA + al((size_t)NU_GL * 8192 * 2);
constexpr size_t WS_DD = WS_KV + al((size_t)NU_GL * 8192 * 2);
constexpr size_t WS_END_MIX = WS_DD + al((size_t)NU_GL * 64 * 4);
constexpr size_t OUT_GT = 0, OUT_QE = (size_t)NU_RW * 4096 * 2;
static_assert(OUT_QE + (size_t)NU_GL * 4096 * 2 <= (size_t)NLAT * D * 4, "scan scratch fits in d_out");
constexpr size_t WS_YRW = WS_LWF, WS_YGLA = WS_LWB, WS_Z = WS_HH;
static_assert((size_t)NLAT * D * 2 <= (size_t)NU_RW * 4096 * 2, "Z fits in the HH slot");
constexpr size_t WS_X1 = WS_REGB;
constexpr size_t WS_A3 = WS_X1 + al((size_t)NLAT * D * 4);
constexpr size_t WS_LOGITS = WS_A3 + al((size_t)NLAT * D * 2);
constexpr size_t WS_ACT = WS_LOGITS + al((size_t)NLAT * NE * 4);
constexpr size_t WS_Y = WS_ACT + al((size_t)NROWS_E * FF * 2);
constexpr size_t WS_A3F = WS_Y + al((size_t)NROWS_E * D);
constexpr size_t WS_END_MOE = WS_A3F + al((size_t)NLAT * D);
constexpr size_t WS_END = WS_END_MIX > WS_END_MOE ? WS_END_MIX : WS_END_MOE;
static_assert(WS_END <= (size_t)2048 * MiB, "workspace map exceeds 2 GiB");

constexpr int RING_BYTES = 131072;
constexpr int IDX_BYTES = pg8::IDX_UNITS * 256 * 4;
constexpr int MISC_OFF = RING_BYTES + IDX_BYTES;
constexpr int LDS_BYTES = MISC_OFF + 256;
static_assert(pg8::IDX_OFF == RING_BYTES, "gather table sits right above the stage buffers");
constexpr int NWAVES = 8, NTHR = 512;

struct Args { const float* in[36]; float* out; unsigned char* ws; int ph_lo, ph_hi; };

struct Frame {
    LAS unsigned char* lds;
    int tid, lane, wave, G, gw, NGW;
    const float* const* in; float* out; unsigned char* ws; unsigned* ctl;
};

__device__ __forceinline__ float wave_sum(float v) {
#pragma unroll
    for (int o = 1; o < 64; o <<= 1) v += __shfl_xor(v, o);
    return v;
}
__device__ __forceinline__ unsigned f2bf(float f) { unsigned u = __builtin_bit_cast(unsigned, f); return (u + 0x7fffu + ((u >> 16) & 1u)) >> 16; }
typedef __bf16 bf16x2v __attribute__((ext_vector_type(2)));
__device__ __forceinline__ unsigned pk2(float lo, float hi) { const f32x2 v = {lo, hi}; return __builtin_bit_cast(unsigned, __builtin_convertvector(v, bf16x2v)); }
__device__ __forceinline__ float bflo(unsigned w) { return __builtin_bit_cast(float, w << 16); }
__device__ __forceinline__ float bfhi(unsigned w) { return __builtin_bit_cast(float, w & 0xffff0000u); }
__device__ __forceinline__ float sigmoidf_(float x) { return __builtin_amdgcn_rcpf(1.0f + __expf(-x)); }
__device__ __forceinline__ float siluf_(float x) { return x * __builtin_amdgcn_rcpf(1.0f + __expf(-x)); }
__device__ __forceinline__ float tanhf_(float x) { return 1.0f - 2.0f * __builtin_amdgcn_rcpf(1.0f + __expf(2.0f * x)); }
__device__ __forceinline__ float logsigmoidf_(float x) { return fminf(x, 0.f) - __logf(1.0f + __expf(-fabsf(x))); }

__device__ __forceinline__ void ln_stats(const f32x4 (&v)[4], float& mean, float& rstd) {
    float s = 0.f;
#pragma unroll
    for (int j = 0; j < 4; ++j) s += (v[j].x + v[j].y) + (v[j].z + v[j].w);
    mean = wave_sum(s) * (1.f / D); float s2 = 0.f;
#pragma unroll
    for (int j = 0; j < 4; ++j) { const f32x4 d = v[j] - mean; s2 += (d.x * d.x + d.y * d.y) + (d.z * d.z + d.w * d.w); }
    rstd = __builtin_amdgcn_rsqf(wave_sum(s2) * (1.f / D) + LN_EPS);
}

__device__ __forceinline__ unsigned pack_fp8x4(const f32x4 v) {
    int w = __builtin_amdgcn_cvt_pk_fp8_f32(__builtin_amdgcn_fmed3f(v[0], -448.f, 448.f), __builtin_amdgcn_fmed3f(v[1], -448.f, 448.f), 0, false);
    return (unsigned)__builtin_amdgcn_cvt_pk_fp8_f32(__builtin_amdgcn_fmed3f(v[2], -448.f, 448.f), __builtin_amdgcn_fmed3f(v[3], -448.f, 448.f), w, true); }
__device__ __forceinline__ void ld_row_bf16(const bf16* row, int lane, f32x4 (&v)[4]) {
    const v4u a = *(const v4u*)(row + 8 * lane), b = *(const v4u*)(row + 512 + 8 * lane);
    v[0] = (f32x4){bflo(a.x), bfhi(a.x), bflo(a.y), bfhi(a.y)}; v[1] = (f32x4){bflo(a.z), bfhi(a.z), bflo(a.w), bfhi(a.w)};
    v[2] = (f32x4){bflo(b.x), bfhi(b.x), bflo(b.y), bfhi(b.y)}; v[3] = (f32x4){bflo(b.z), bfhi(b.z), bflo(b.w), bfhi(b.w)};
}
__device__ __forceinline__ int rowcol(int lane, int j) { return 512 * (j >> 1) + 8 * lane + 4 * (j & 1); }
__device__ __forceinline__ void ph_x1pre_nomix(Frame& F) {
    const float* x = F.in[0];
    for (int m = F.gw; m < NLAT; m += F.NGW) {
        bf16* o = (bf16*)(F.ws + WS_X1) + (size_t)m * D;
#pragma unroll
        for (int h = 0; h < 2; ++h) { const float* xr = x + (size_t)m * D + 512 * h + 8 * F.lane; const f32x4 a = *(const f32x4*)xr * ALPHA, b = *(const f32x4*)(xr + 4) * ALPHA;
            v4u w; w.x = pk2(a.x, a.y); w.y = pk2(a.z, a.w); w.z = pk2(b.x, b.y); w.w = pk2(b.z, b.w); *(v4u*)(o + 512 * h + 8 * F.lane) = w; }
    }
}
__device__ __forceinline__ void ph_ln1(Frame& F) {
    const float* lw = F.in[26]; const float* lb = F.in[27]; const float* mod = (const float*)(F.ws + WS_MOD);
    bf16* A3 = (bf16*)(F.ws + WS_A3); const bf16* X1P = (const bf16*)(F.ws + WS_X1);
    constexpr int NR = 4;
    for (int m0 = F.gw; m0 < NLAT; m0 += NR * F.NGW) {
        v4u w[NR][2];
#pragma unroll
        for (int r = 0; r < NR; ++r) { const int mm = m0 + r * F.NGW; const bf16* row = X1P + (size_t)(mm < NLAT ? mm : m0) * D; w[r][0] = *(const v4u*)(row + 8 * F.lane); w[r][1] = *(const v4u*)(row + 512 + 8 * F.lane); }
        __builtin_amdgcn_sched_barrier(0);
#pragma unroll
        for (int r = 0; r < NR; ++r) { const int mm = m0 + r * F.NGW; const int m = mm < NLAT ? mm : m0; const int b = m / SEQ;
            f32x4 v[4];
            v[0] = (f32x4){bflo(w[r][0].x), bfhi(w[r][0].x), bflo(w[r][0].y), bfhi(w[r][0].y)}; v[1] = (f32x4){bflo(w[r][0].z), bfhi(w[r][0].z), bflo(w[r][0].w), bfhi(w[r][0].w)};
            v[2] = (f32x4){bflo(w[r][1].x), bfhi(w[r][1].x), bflo(w[r][1].y), bfhi(w[r][1].y)}; v[3] = (f32x4){bflo(w[r][1].z), bfhi(w[r][1].z), bflo(w[r][1].w), bfhi(w[r][1].w)};
            float mean, rstd; ln_stats(v, mean, rstd);
#if MS >= 2
            f32x4 h[4];
#pragma unroll
            for (int j = 0; j < 4; ++j) { const int c = rowcol(F.lane, j);
                const f32x4 x1 = (v[j] - mean) * rstd * *(const f32x4*)(lw + c) + *(const f32x4*)(lb + c);
                h[j] = x1 * (*(const f32x4*)(mod + b * 6144 + 4096 + c) + 1.0f) + *(const f32x4*)(mod + b * 6144 + 3072 + c); }
            bf16* ao = A3 + (size_t)m * D;
            { v4u o; o.x = pk2(h[0].x, h[0].y); o.y = pk2(h[0].z, h[0].w); o.z = pk2(h[1].x, h[1].y); o.w = pk2(h[1].z, h[1].w); *(v4u*)(ao + 8 * F.lane) = o;
              o.x = pk2(h[2].x, h[2].y); o.y = pk2(h[2].z, h[2].w); o.z = pk2(h[3].x, h[3].y); o.w = pk2(h[3].z, h[3].w); *(v4u*)(ao + 512 + 8 * F.lane) = o; }
            { unsigned char* af = F.ws + WS_A3F + (size_t)m * D; v2u o8;
              o8.x = pack_fp8x4(h[0]); o8.y = pack_fp8x4(h[1]); *(v2u*)(af + 8 * F.lane) = o8; o8.x = pack_fp8x4(h[2]); o8.y = pack_fp8x4(h[3]); *(v2u*)(af + 512 + 8 * F.lane) = o8; }
#endif
        }
    }
}
__device__ __forceinline__ f32x4 fp8x4(unsigned w) { const f32x2 lo = __builtin_amdgcn_cvt_pk_f32_fp8((int)w, false), hi = __builtin_amdgcn_cvt_pk_f32_fp8((int)w, true); return (f32x4){lo.x, lo.y, hi.x, hi.y}; }
__device__ __forceinline__ void ph_final(Frame& F) {
    const float* lw = F.in[34]; const float* lb = F.in[35]; const float* mod = (const float*)(F.ws + WS_MOD);
    const float* lw1 = F.in[26]; const float* lb1 = F.in[27]; const bf16* X1P = (const bf16*)(F.ws + WS_X1);
    const unsigned char* Y = F.ws + WS_Y; const int* DEST = (const int*)(F.ws + WS_DEST); const float* GATE = (const float*)(F.ws + WS_GATE);
    const int c0 = 16 * F.lane;
    for (int m0 = F.gw; m0 < NLAT; m0 += 2 * F.NGW) {
        int mm[2]; mm[0] = m0; mm[1] = (m0 + F.NGW < NLAT) ? m0 + F.NGW : m0;
        v4u xw[2][2];
#if MS >= 2
        v4u dw[2][2]; f32x4 gw[2][2];
#pragma unroll
        for (int r = 0; r < 2; ++r) { dw[r][0] = *(const v4u*)(DEST + mm[r] * 8); dw[r][1] = *(const v4u*)(DEST + mm[r] * 8 + 4); gw[r][0] = *(const f32x4*)(GATE + mm[r] * 8); gw[r][1] = *(const f32x4*)(GATE + mm[r] * 8 + 4); }
#endif
#pragma unroll
        for (int r = 0; r < 2; ++r) { const bf16* row = X1P + (size_t)mm[r] * D + c0; xw[r][0] = *(const v4u*)row; xw[r][1] = *(const v4u*)(row + 8); }
#if MS >= 2
        v4u yw[2][TOPK + 1];
#pragma unroll
        for (int r = 0; r < 2; ++r) {
            int dr[TOPK]; dr[0] = (int)dw[r][0].x; dr[1] = (int)dw[r][0].y; dr[2] = (int)dw[r][0].z; dr[3] = (int)dw[r][0].w; dr[4] = (int)dw[r][1].x; dr[5] = (int)dw[r][1].y; dr[6] = (int)dw[r][1].z; dr[7] = (int)dw[r][1].w;
#pragma unroll
            for (int k = 0; k <= TOPK; ++k) yw[r][k] = *(const v4u*)(Y + (size_t)(k < TOPK ? dr[k < TOPK ? k : 0] : SH_ROW0 + mm[r]) * D + c0); }
        __builtin_amdgcn_sched_barrier(0);
#endif
#pragma unroll
        for (int r = 0; r < 2; ++r) { const int m = mm[r]; const int b = m / SEQ;
            f32x4 v[4];
            v[0] = (f32x4){bflo(xw[r][0].x), bfhi(xw[r][0].x), bflo(xw[r][0].y), bfhi(xw[r][0].y)}; v[1] = (f32x4){bflo(xw[r][0].z), bfhi(xw[r][0].z), bflo(xw[r][0].w), bfhi(xw[r][0].w)};
            v[2] = (f32x4){bflo(xw[r][1].x), bfhi(xw[r][1].x), bflo(xw[r][1].y), bfhi(xw[r][1].y)}; v[3] = (f32x4){bflo(xw[r][1].z), bfhi(xw[r][1].z), bflo(xw[r][1].w), bfhi(xw[r][1].w)};
            { float mean1, rstd1; ln_stats(v, mean1, rstd1);
#pragma unroll
              for (int j = 0; j < 4; ++j) { const int c = c0 + 4 * j; v[j] = ((v[j] - mean1) * rstd1 * *(const f32x4*)(lw1 + c) + *(const f32x4*)(lb1 + c)) * ALPHA; } }
#if MS >= 2
            const float gt[TOPK] = {gw[r][0].x * 0.0625f, gw[r][0].y * 0.0625f, gw[r][0].z * 0.0625f, gw[r][0].w * 0.0625f, gw[r][1].x * 0.0625f, gw[r][1].y * 0.0625f, gw[r][1].z * 0.0625f, gw[r][1].w * 0.0625f};
#pragma unroll
            for (int j = 0; j < 4; ++j) { const unsigned ws8 = j == 0 ? yw[r][TOPK].x : (j == 1 ? yw[r][TOPK].y : (j == 2 ? yw[r][TOPK].z : yw[r][TOPK].w));
                f32x4 mo = fp8x4(ws8) * 0.0625f;
#pragma unroll
                for (int k = 0; k < TOPK; ++k) { const unsigned wk = j == 0 ? yw[r][k].x : (j == 1 ? yw[r][k].y : (j == 2 ? yw[r][k].z : yw[r][k].w)); mo += fp8x4(wk) * gt[k]; }
                v[j] += *(const f32x4*)(mod + b * 6144 + 5120 + c0 + 4 * j) * mo; }
#endif
            float mean, rstd; ln_stats(v, mean, rstd);
            float* o = F.out + (size_t)m * D + c0;
#pragma unroll
            for (int j = 0; j < 4; ++j) { const int c = c0 + 4 * j; *(f32x4*)(o + 4 * j) = (v[j] - mean) * rstd * *(const f32x4*)(lw + c) + *(const f32x4*)(lb + c); }
        }
    }
}


#if MS >= 2
template <int MODE, bool FP8 = false>
__device__ __forceinline__ void cvt_item(const float* W, int Nsrc, int nblk, bf16* WT, int row_off, int dpitch, LAS float* scr, int item, int lane) {
    const int kb = item / nblk, nb = item - kb * nblk, k0 = 64 * kb, n0 = 32 * nb;
    const int nn = n0 + (lane & 31);
#pragma unroll 8
    for (int i = 0; i < 32; ++i) { const int kk = 2 * i + (lane >> 5); scr[kk * 33 + (lane & 31)] = (nn < Nsrc) ? W[(size_t)(k0 + kk) * Nsrc + nn] : 0.f; }
    LDS_WAIT(); asm volatile("" ::: "memory");
    const int c = lane & 7;
#pragma unroll
    for (int j = 0; j < 4; ++j) { const int n = (lane >> 3) + 8 * j; const LAS float* s = scr + (8 * c) * 33 + n;
        v4u o; o.x = pk2(s[0 * 33], s[1 * 33]); o.y = pk2(s[2 * 33], s[3 * 33]); o.z = pk2(s[4 * 33], s[5 * 33]); o.w = pk2(s[6 * 33], s[7 * 33]);
        const int ng = n0 + n; int dr = ng;
        if (MODE == 1) { const int i2 = ng & 255; dr = 8 * (i2 >> 2) + (i2 & 3) + ((ng >= 256) ? 4 : 0); }
        if constexpr (FP8) { v2u o8; o8.x = pack_fp8x4((f32x4){s[0 * 33], s[1 * 33], s[2 * 33], s[3 * 33]} * W8S); o8.y = pack_fp8x4((f32x4){s[4 * 33], s[5 * 33], s[6 * 33], s[7 * 33]} * W8S);
            *(v2u*)((unsigned char*)WT + (size_t)(row_off + dr) * dpitch + k0 + 8 * c) = o8; }
        else *(v4u*)(WT + (size_t)(row_off + dr) * dpitch + k0 + 8 * c) = o; }
    LDS_WAIT(); asm volatile("" ::: "memory");
}

template <int MODE>
__device__ __forceinline__ void cvt_item_reg(const float* W, int Nsrc, bf16* WT, int row_off, int dpitch, int k0, int n0, int lane) {
    const float* src = W + (size_t)k0 * Nsrc + n0 + 4 * lane;
    f32x4 v[32];
#pragma unroll
    for (int i = 0; i < 32; ++i) v[i] = __builtin_nontemporal_load((const f32x4*)(src + (size_t)i * Nsrc));
#pragma unroll
    for (int j = 0; j < 4; ++j) {
        const int ng = n0 + 4 * lane + j; int dr = ng;
        if (MODE == 1) { const int i2 = ng & 255; dr = 8 * (i2 >> 2) + (i2 & 3) + ((ng >= 256) ? 4 : 0); }
        v4u* dst = (v4u*)(WT + (size_t)(row_off + dr) * dpitch + k0);
#pragma unroll
        for (int q = 0; q < 4; ++q) { v4u o; o.x = pk2(v[8 * q][j], v[8 * q + 1][j]); o.y = pk2(v[8 * q + 2][j], v[8 * q + 3][j]); o.z = pk2(v[8 * q + 4][j], v[8 * q + 5][j]); o.w = pk2(v[8 * q + 6][j], v[8 * q + 7][j]); dst[q] = o; }
    }
}

constexpr int CVK = 32;
__device__ __forceinline__ void cvt_reg_load(const float* W, int Nsrc, int k0, int n0, int lane, f32x4 (&v)[CVK]) {
    const float* src = W + (size_t)k0 * Nsrc + n0 + 4 * lane;
#pragma unroll
    for (int i = 0; i < CVK; ++i) v[i] = __builtin_nontemporal_load((const f32x4*)(src + (size_t)i * Nsrc));
}
template <int MODE, bool FP8 = false>
__device__ __forceinline__ void cvt_reg_store(bf16* WT, int row_off, int dpitch, int k0, int n0, int lane, const f32x4 (&v)[CVK]) {
#pragma unroll
    for (int j = 0; j < 4; ++j) {
        const int ng = n0 + 4 * lane + j; int dr = ng;
        if (MODE == 1) { const int i2 = ng & 255; dr = 8 * (i2 >> 2) + (i2 & 3) + ((ng >= 256) ? 4 : 0); }
        if constexpr (FP8) { v4u* dst8 = (v4u*)((unsigned char*)WT + (size_t)(row_off + dr) * dpitch + k0);
#pragma unroll
            for (int q = 0; q < CVK / 16; ++q) { v4u o;
                o.x = pack_fp8x4((f32x4){v[16 * q][j], v[16 * q + 1][j], v[16 * q + 2][j], v[16 * q + 3][j]} * W8S); o.y = pack_fp8x4((f32x4){v[16 * q + 4][j], v[16 * q + 5][j], v[16 * q + 6][j], v[16 * q + 7][j]} * W8S);
                o.z = pack_fp8x4((f32x4){v[16 * q + 8][j], v[16 * q + 9][j], v[16 * q + 10][j], v[16 * q + 11][j]} * W8S); o.w = pack_fp8x4((f32x4){v[16 * q + 12][j], v[16 * q + 13][j], v[16 * q + 14][j], v[16 * q + 15][j]} * W8S); dst8[q] = o; }
            continue; }
        v4u* dst = (v4u*)(WT + (size_t)(row_off + dr) * dpitch + k0);
#pragma unroll
        for (int q = 0; q < CVK / 8; ++q) { v4u o; o.x = pg8::cvt_pk_bf16(v[8 * q][j], v[8 * q + 1][j]); o.y = pg8::cvt_pk_bf16(v[8 * q + 2][j], v[8 * q + 3][j]); o.z = pg8::cvt_pk_bf16(v[8 * q + 4][j], v[8 * q + 5][j]); o.w = pg8::cvt_pk_bf16(v[8 * q + 6][j], v[8 * q + 7][j]); dst[q] = o; }
    }
}
constexpr int CV_GU = (D / CVK) * 2, CV_DN = (FF / CVK) * 4, CV_NGU = (NE + 1) * CV_GU, CV_NITEM = CV_NGU + (NE + 1) * CV_DN;
__device__ __forceinline__ void cvx_load(const float* const* in, int it, int lane, f32x4 (&v)[CVK]) {
    if (it < CV_NGU) { const int e = it / CV_GU, ii = it - e * CV_GU; const float* src = (e < NE) ? in[30] + (size_t)e * D * 512 : in[32];
        cvt_reg_load(src, 512, CVK * (ii >> 1), 256 * (ii & 1), lane, v); }
    else { const int r = it - CV_NGU, e = r / CV_DN, ii = r - e * CV_DN; const float* src = (e < NE) ? in[31] + (size_t)e * FF * D : in[33];
        cvt_reg_load(src, D, CVK * (ii >> 2), 256 * (ii & 3), lane, v); }
}
__device__ __forceinline__ void cvx_store(unsigned char* ws, int it, int lane, const f32x4 (&v)[CVK]) {
    if (it < CV_NGU) { const int e = it / CV_GU, ii = it - e * CV_GU; cvt_reg_store<1, true>((bf16*)(ws + WS_WGU), e * 512, D, CVK * (ii >> 1), 256 * (ii & 1), lane, v); }
    else { const int r = it - CV_NGU, e = r / CV_DN, ii = r - e * CV_DN; cvt_reg_store<0, true>((bf16*)(ws + WS_WD), e * D, FF, CVK * (ii >> 2), 256 * (ii & 3), lane, v); }
}

typedef float f32x2v __attribute__((ext_vector_type(2)));
constexpr int CY_GU = (D / 32) * 4, CY_DN = (FF / 32) * 8, CY_NGU = (NE + 1) * CY_GU, CY_NITEM = CY_NGU + (NE + 1) * CY_DN;
__device__ __forceinline__ void cvy_load(const float* const* in, int it, int lane, f32x2v (&v)[32]) {
    const float* p;  int Nsrc;
    if (it < CY_NGU) { const int e = it / CY_GU, ii = it - e * CY_GU; const float* src = (e < NE) ? in[30] + (size_t)e * D * 512 : in[32]; Nsrc = 512; p = src + (size_t)(32 * (ii >> 2)) * 512 + 128 * (ii & 3) + 2 * lane; }
    else { const int r = it - CY_NGU, e = r / CY_DN, ii = r - e * CY_DN; const float* src = (e < NE) ? in[31] + (size_t)e * FF * D : in[33]; Nsrc = D; p = src + (size_t)(32 * (ii >> 3)) * D + 128 * (ii & 7) + 2 * lane; }
#pragma unroll
    for (int i = 0; i < 32; ++i) v[i] = __builtin_nontemporal_load((const f32x2v*)(p + (size_t)i * Nsrc));
}
__device__ __forceinline__ void cvy_store(unsigned char* ws, int it, int lane, const f32x2v (&v)[32]) {
    unsigned char* base; int dpitch, n0; bool gu = it < CY_NGU;
    if (gu) { const int e = it / CY_GU, ii = it - e * CY_GU; base = ws + WS_WGU + (size_t)(e * 512) * D + 32 * (ii >> 2); dpitch = D; n0 = 128 * (ii & 3); }
    else { const int r = it - CY_NGU, e = r / CY_DN, ii = r - e * CY_DN; base = ws + WS_WD + (size_t)(e * D) * FF + 32 * (ii >> 3); dpitch = FF; n0 = 128 * (ii & 7); }
#pragma unroll
    for (int j = 0; j < 2; ++j) {
        const int ng = n0 + 2 * lane + j; int dr = ng;
        if (gu) { const int i2 = ng & 255; dr = 8 * (i2 >> 2) + (i2 & 3) + ((ng >= 256) ? 4 : 0); }
        v4u* dst8 = (v4u*)(base + (size_t)dr * dpitch);
#pragma unroll
        for (int q = 0; q < 2; ++q) { v4u o;
            o.x = pack_fp8x4((f32x4){v[16 * q][j], v[16 * q + 1][j], v[16 * q + 2][j], v[16 * q + 3][j]} * W8S); o.y = pack_fp8x4((f32x4){v[16 * q + 4][j], v[16 * q + 5][j], v[16 * q + 6][j], v[16 * q + 7][j]} * W8S);
            o.z = pack_fp8x4((f32x4){v[16 * q + 8][j], v[16 * q + 9][j], v[16 * q + 10][j], v[16 * q + 11][j]} * W8S); o.w = pack_fp8x4((f32x4){v[16 * q + 12][j], v[16 * q + 13][j], v[16 * q + 14][j], v[16 * q + 15][j]} * W8S); dst8[q] = o; }
    }
}
#define CVY_FLUSH() do { if (cpend >= 0) cvy_store(F.ws, cpend, lane, cv); cpend = -1; } while (0)
#define CVY_START(item) do { if ((item) < CY_NITEM) { cvy_load(F.in, (item), lane, cv); cpend = (item); } } while (0)

#if MS >= 3
__device__ __forceinline__ float lora_val(const float* const* in, int n, int k) {
    if (n < 1024) { const int q = n >> 3, e8 = n & 7, dir = e8 >> 2, ch = q * 4 + (e8 & 3); return (k < 32) ? in[9][(size_t)(dir * 32 + k) * 512 + ch] : 0.f; }
    if (n < 2048) { const int m = n - 1024, q = m >> 3, e8 = m & 7, dir = e8 >> 2, ch = q * 4 + (e8 & 3); return (k >= 32 && k < 64) ? in[11][(size_t)(dir * 32 + (k - 32)) * 512 + ch] : 0.f; }
    if (n < 2560) { const int ch = n - 2048; return (k >= 64 && k < 160) ? in[12][(size_t)(k - 64) * 512 + ch] : 0.f; }
    { const int m = n - 2560, q = m >> 3, e8 = m & 7, dir = e8 >> 2, ch = q * 4 + (e8 & 3); return (k >= 160 && k < 176) ? in[19][(size_t)(dir * 16 + (k - 160)) * 256 + ch] : 0.f; }
}
#endif

__device__ __forceinline__ void ph_prologue(Frame& F) {
    {
        const float* c = F.in[1]; const float* cc = F.in[3]; const float* wa = F.in[4]; const float* ba = F.in[5];
        float* MOD = (float*)(F.ws + WS_MOD);
        LAS float* S = (LAS float*)F.lds; LAS float* red = (LAS float*)(F.lds + 32768);
        for (int it = blockIdx.x; it < 96; it += F.G) {
            for (int i = F.tid; i < 5120; i += NTHR) { const int r = i >> 10, k = i & 1023; const float cv = r < 4 ? c[r * 1024 + k] : cc[k]; S[i] = siluf_(cv); }
            __syncthreads();
            const int n = it * 64 + F.lane; float acc[5] = {0.f, 0.f, 0.f, 0.f, 0.f};
            for (int kk = 0; kk < 128; ++kk) { const int k = F.wave * 128 + kk; const float wv = wa[(size_t)k * 6144 + n];
#pragma unroll
                for (int r = 0; r < 5; ++r) acc[r] += S[r * 1024 + k] * wv; }
#pragma unroll
            for (int r = 0; r < 5; ++r) red[(F.wave * 5 + r) * 64 + F.lane] = acc[r];
            __syncthreads();
            if (F.wave == 0) {
#pragma unroll
                for (int r = 0; r < 5; ++r) { float s = 0.f;
#pragma unroll
                    for (int w = 0; w < 8; ++w) s += red[(w * 5 + r) * 64 + F.lane];
                    MOD[r * 6144 + n] = s + ba[n]; }
            }
            __syncthreads();
        }
    }
    {
        LAS float* scr = (LAS float*)(F.lds + F.wave * 16384);
        constexpr int I_IN = 16 * 168, I_BR = 8 * 32, I_OUT = 16 * 32, I_RT = 16 * 8, I_GU = 32 * 2, I_DN = 8 * 4;
        constexpr int T0 = I_IN, T1 = T0 + I_BR, T2 = T1 + I_BR, T3 = T2 + I_OUT, T4 = T3 + I_RT, T5 = T4 + (NE + 1) * I_GU, T6 = T5 + (NE + 1) * I_DN;
        unsigned char* ws = F.ws;
        for (int it = F.gw; it < T6; it += F.NGW) {
#if MS >= 3
            if (it < T0) { cvt_item<0, true>(F.in[6], IN_COLS, 168, (bf16*)(ws + WS_WIN), 0, D, scr, it, F.lane); continue; }
            if (it < T1) { cvt_item<0>(F.in[23], D, 32, (bf16*)(ws + WS_WBRRW), 0, RWW, scr, it - T0, F.lane); continue; }
            if (it < T2) { cvt_item<0>(F.in[24], D, 32, (bf16*)(ws + WS_WBRGLA), 0, RWW, scr, it - T1, F.lane); continue; }
            if (it < T3) { cvt_item<0>(F.in[25], D, 32, (bf16*)(ws + WS_WOUT), 0, D, scr, it - T2, F.lane); continue; }
#else
            if (it < T3) continue;
#endif
            if (it < T4) { cvt_item<0>(F.in[28], NE, 8, (bf16*)(ws + WS_WROUTER), 0, D, scr, it - T3, F.lane); continue; }
#if MS >= 3
            break;
#endif
            if (it < T5) { const int r = it - T4, e = r / I_GU, ii = r - e * I_GU;
                const float* src = (e < NE) ? F.in[30] + (size_t)e * D * 512 : F.in[32];
                cvt_item_reg<1>(src, 512, (bf16*)(ws + WS_WGU), e * 512, D, 32 * (ii >> 1), 256 * (ii & 1), F.lane); continue; }
            { const int r = it - T5, e = r / I_DN, ii = r - e * I_DN;
                const float* src = (e < NE) ? F.in[31] + (size_t)e * FF * D : F.in[33];
                cvt_item_reg<0>(src, D, (bf16*)(ws + WS_WD), e * D, FF, 32 * (ii >> 2), 256 * (ii & 3), F.lane); }
        }
    }
#if MS >= 3
    {
        bf16* WL = (bf16*)(F.ws + WS_WLORA);
        for (int idx = blockIdx.x * NTHR + F.tid; idx < NLORA * (KLORA / 8); idx += F.G * NTHR) {
            const int n = idx >> 5, k0 = (idx & 31) * 8; float v[8];
#pragma unroll
            for (int e = 0; e < 8; ++e) v[e] = lora_val(F.in, n, k0 + e);
            v4u o; o.x = pk2(v[0], v[1]); o.y = pk2(v[2], v[3]); o.z = pk2(v[4], v[5]); o.w = pk2(v[6], v[7]);
            *(v4u*)(WL + (size_t)n * KLORA + k0) = o;
        }
    }
#endif
}

struct EpiF32 {
    static constexpr bool PERM = false;
    float* C; int ldc;
    __device__ __forceinline__ void operator()(const f32x4 (&acc)[2][2][4][2], const pg8::Unit& u, int wr, int wc, int fr, int fq) const {
        const int row0 = u.pm * 256 + wr * 64 + fr, col0 = u.pn * 256 + wc * 32 + 4 * fq;
#pragma unroll
        for (int ai = 0; ai < 2; ++ai)
#pragma unroll
            for (int m = 0; m < 4; ++m) { float* rowp = C + (size_t)(row0 + ai * 128 + m * 16) * ldc + col0;
#pragma unroll
                for (int bj = 0; bj < 2; ++bj)
#pragma unroll
                    for (int n = 0; n < 2; ++n) *(f32x4*)(rowp + bj * 128 + n * 16) = acc[ai][bj][m][n]; }
    }
};
struct EpiSwiglu {
    static constexpr bool PERM = true;
    unsigned char* ACT;
    __device__ __forceinline__ void operator()(const f32x4 (&acc)[2][2][4][2], const pg8::Unit& u, int wr, int wc, int fr, int fq) const {
        const int row0 = u.pm * 256 + wr * 64 + fr, h0 = u.j * 128 + wc * 16 + 4 * fq;
#pragma unroll
        for (int ai = 0; ai < 2; ++ai)
#pragma unroll
            for (int m = 0; m < 4; ++m) { unsigned char* rowp = ACT + (size_t)(row0 + ai * 128 + m * 16) * FF + h0;
#pragma unroll
                for (int bj = 0; bj < 2; ++bj) { const f32x4 a = acc[ai][bj][m][0] * W8I, b = acc[ai][bj][m][1] * W8I;
                    *(unsigned*)(rowp + bj * 64) = pack_fp8x4((f32x4){siluf_(a[0]) * b[0], siluf_(a[1]) * b[1], siluf_(a[2]) * b[2], siluf_(a[3]) * b[3]}); } }
    }
};
struct EpiRowsBf16 {
    static constexpr bool PERM = true;
    bf16* O; int ldc; float sc;
    __device__ __forceinline__ void operator()(const f32x4 (&acc)[2][2][4][2], const pg8::Unit& u, int wr, int wc, int fr, int fq) const {
        const int row0 = u.pm * 256 + wr * 64 + fr, col0 = u.j * 256 + wc * 32 + 8 * fq;
#pragma unroll
        for (int ai = 0; ai < 2; ++ai)
#pragma unroll
            for (int m = 0; m < 4; ++m) { bf16* rowp = O + (size_t)(row0 + ai * 128 + m * 16) * ldc + col0;
#pragma unroll
                for (int bj = 0; bj < 2; ++bj) { const f32x4 v0 = acc[ai][bj][m][0] * sc, v1 = acc[ai][bj][m][1] * sc;
                    v4u w; w.x = pg8::cvt_pk_bf16(v0[0], v0[1]); w.y = pg8::cvt_pk_bf16(v0[2], v0[3]); w.z = pg8::cvt_pk_bf16(v1[0], v1[1]); w.w = pg8::cvt_pk_bf16(v1[2], v1[3]);
                    *(v4u*)(rowp + bj * 128) = w;
#ifdef PROBE_ST2
                    asm volatile("" ::: "memory"); *(volatile v4u*)(rowp + bj * 128) = w;
#endif
                    } }
    }
};

struct EpiRowsFp8 {
    static constexpr bool PERM = true;
    unsigned char* O;
    __device__ __forceinline__ void operator()(const f32x4 (&acc)[2][2][4][2], const pg8::Unit& u, int wr, int wc, int fr, int fq) const {
        const int row0 = u.pm * 256 + wr * 64 + fr, col0 = u.j * 256 + wc * 32 + 8 * fq;
#pragma unroll
        for (int ai = 0; ai < 2; ++ai)
#pragma unroll
            for (int m = 0; m < 4; ++m) { unsigned char* rowp = O + (size_t)(row0 + ai * 128 + m * 16) * D + col0;
#pragma unroll
                for (int bj = 0; bj < 2; ++bj) { f32x4 v0 = acc[ai][bj][m][0] * (16.0f * W8I), v1 = acc[ai][bj][m][1] * (16.0f * W8I);
#pragma unroll
                    for (int e = 0; e < 4; ++e) { v0[e] = __builtin_amdgcn_fmed3f(v0[e], -448.0f, 448.0f); v1[e] = __builtin_amdgcn_fmed3f(v1[e], -448.0f, 448.0f); }
                    int w0 = __builtin_amdgcn_cvt_pk_fp8_f32(v0[0], v0[1], 0, false); w0 = __builtin_amdgcn_cvt_pk_fp8_f32(v0[2], v0[3], w0, true);
                    int w1 = __builtin_amdgcn_cvt_pk_fp8_f32(v1[0], v1[1], 0, false); w1 = __builtin_amdgcn_cvt_pk_fp8_f32(v1[2], v1[3], w1, true);
                    v2u w; w.x = (unsigned)w0; w.y = (unsigned)w1; *(v2u*)(rowp + bj * 128) = w; } }
    }
};

__device__ __forceinline__ void ph_router(Frame& F) {
    pg8::Gemm g{(const bf16*)(F.ws + WS_A3), (const bf16*)(F.ws + WS_WROUTER), NLAT, NE, D, nullptr};
    pg8::StaticOrder S; S.init(NLAT, NE, F.G, (int)blockIdx.x);
    EpiF32 E{(float*)(F.ws + WS_LOGITS), NE};
    pg8::gemm_phase<EpiF32, pg8::StaticOrder, true, true, false>(F.lds, g, S, E);
}

#define RT_DPP(x, ctrl) __builtin_amdgcn_update_dpp(0, (x), (ctrl), 0xf, 0xf, false)
__device__ __forceinline__ unsigned wave_max_u32(unsigned k) {
    k = max(k, (unsigned)RT_DPP((int)k, 0xB1)); k = max(k, (unsigned)RT_DPP((int)k, 0x4E));
    k = max(k, (unsigned)RT_DPP((int)k, 0x124)); k = max(k, (unsigned)RT_DPP((int)k, 0x128));
    const unsigned a = (unsigned)__builtin_amdgcn_readlane((int)k, 0), b = (unsigned)__builtin_amdgcn_readlane((int)k, 16), c = (unsigned)__builtin_amdgcn_readlane((int)k, 32), d = (unsigned)__builtin_amdgcn_readlane((int)k, 48);
    return max(max(a, b), max(c, d));
}
__device__ __forceinline__ void ph_route(Frame& F) {
    const float* LOG = (const float*)(F.ws + WS_LOGITS); const float* rb = F.in[29];
    int* EIDX = (int*)(F.ws + WS_EIDX); float* GATE = (float*)(F.ws + WS_GATE); int* DEST = (int*)(F.ws + WS_DEST);
    unsigned* CNT = F.ctl + CW_CNT;
    const f32x4 bias = *(const f32x4*)(rb + 4 * F.lane);
    f32x4 lgn = *(const f32x4*)(LOG + (size_t)(F.gw < NLAT ? F.gw : 0) * NE + 4 * F.lane);
    for (int m = F.gw; m < NLAT; m += F.NGW) {
        const f32x4 lg = lgn;
        { const int mn = (m + F.NGW < NLAT) ? m + F.NGW : m; lgn = *(const f32x4*)(LOG + (size_t)mn * NE + 4 * F.lane); }
        float sc[4], sel[4];
#pragma unroll
        for (int i = 0; i < 4; ++i) { sc[i] = sigmoidf_(lg[i]); sel[i] = sc[i] + bias[i]; }
        float m1 = fmaxf(sel[0], sel[1]), m2 = fminf(sel[0], sel[1]);
        { const float a = sel[2]; const float n1 = fmaxf(m1, a); m2 = fmaxf(m2, fminf(m1, a)); m1 = n1; }
        { const float a = sel[3]; const float n1 = fmaxf(m1, a); m2 = fmaxf(m2, fminf(m1, a)); m1 = n1; }
#define RT_MERGE(ctrl) do { const float b1 = __builtin_bit_cast(float, RT_DPP(__builtin_bit_cast(int, m1), ctrl)), b2 = __builtin_bit_cast(float, RT_DPP(__builtin_bit_cast(int, m2), ctrl)); \
            const float n1 = fmaxf(m1, b1); m2 = fmaxf(fminf(m1, b1), fmaxf(m2, b2)); m1 = n1; } while (0)
        RT_MERGE(0xB1); RT_MERGE(0x4E); RT_MERGE(0x141);
#undef RT_MERGE
        const float gs = m1 + m2; const int g = F.lane >> 3;
        int rank = 0;
#pragma unroll
        for (int gg = 0; gg < 8; ++gg) { const float og = __builtin_bit_cast(float, __builtin_amdgcn_readlane(__builtin_bit_cast(int, gs), gg * 8)); rank += (og > gs || (og == gs && gg < g)) ? 1 : 0; }
        const bool keep = rank < 4;
        unsigned key[4];
#pragma unroll
        for (int i = 0; i < 4; ++i) { unsigned u = __builtin_bit_cast(unsigned, sel[i]); u ^= (u >> 31) ? 0xffffffffu : 0x80000000u;
            key[i] = keep ? ((u & 0xffffff00u) | (unsigned)(255 - (4 * F.lane + i))) : 0u; }
        int my_e = 0; float my_s = 0.f; float ssum = 0.f;
#pragma unroll
        for (int k = 0; k < TOPK; ++k) {
            const unsigned best = wave_max_u32(max(max(key[0], key[1]), max(key[2], key[3])));
            const int e = 255 - (int)(best & 255u), owner = e >> 2;
            float s_own = 0.f;
#pragma unroll
            for (int i = 0; i < 4; ++i) if (key[i] == best) { s_own = sc[i]; key[i] = 0u; }
            const float s = __builtin_bit_cast(float, __builtin_amdgcn_readlane(__builtin_bit_cast(int, s_own), owner));
            ssum += s;
            if (F.lane == k) { my_e = e; my_s = s; }
        }
        if (F.lane < TOPK) {
            const unsigned pos = __hip_atomic_fetch_add(CNT + my_e * CNT_STRIDE, 1u, __ATOMIC_RELAXED, __HIP_MEMORY_SCOPE_AGENT);
            EIDX[m * 8 + F.lane] = my_e; GATE[m * 8 + F.lane] = my_s * __builtin_amdgcn_rcpf(ssum) * 2.5f; DEST[m * 8 + F.lane] = (int)pos;
        }
    }
}
#undef RT_DPP

__device__ __forceinline__ void ph_scatter(Frame& F) {
    LAS int* tstart = (LAS int*)F.lds;
    LAS int* scan = (LAS int*)(F.lds + 2048);
    LAS int* cnts = (LAS int*)(F.lds + 4096);
    int* EIDX = (int*)(F.ws + WS_EIDX); int* DEST = (int*)(F.ws + WS_DEST); int* ROWTOK = (int*)(F.ws + WS_ROWTOK); int* TILE_E = (int*)(F.ws + WS_TILE_E);
    unsigned* CNT = F.ctl + CW_CNT;
    int tiles = 0, cnt = 0;
    if (F.tid < NE) { cnt = (int)__hip_atomic_load(CNT + F.tid * CNT_STRIDE, __ATOMIC_RELAXED, __HIP_MEMORY_SCOPE_AGENT); tiles = (cnt + 255) >> 8; scan[F.tid] = tiles; cnts[F.tid] = cnt; }
    __syncthreads();
    for (int o = 1; o < NE; o <<= 1) { int v = 0; if (F.tid < NE && F.tid >= o) v = scan[F.tid - o]; __syncthreads(); if (F.tid < NE) scan[F.tid] += v; __syncthreads(); }
    if (F.tid < NE) { tstart[F.tid + 1] = scan[F.tid]; if (F.tid == 0) tstart[0] = 0; }
    __syncthreads();
    const int NT = tstart[NE];
    if (blockIdx.x == 0) {
        if (F.tid == 0) F.ctl[CW_NT] = (unsigned)NT;
        if (F.tid < NE) for (int t = tstart[F.tid]; t < tstart[F.tid + 1]; ++t) TILE_E[t] = F.tid;
    }
    for (int e = blockIdx.x; e < NE; e += F.G) { const int c0 = cnts[e], c1 = (tstart[e + 1] - tstart[e]) * 256, base = tstart[e] * 256;
        for (int p = c0 + F.tid; p < c1; p += NTHR) ROWTOK[base + p] = 0; }
    for (int i = blockIdx.x * NTHR + F.tid; i < NLAT; i += F.G * NTHR) ROWTOK[SH_ROW0 + i] = i;
    for (int i = blockIdx.x * NTHR + F.tid; i < NLAT * TOPK; i += F.G * NTHR) {
        const int e = EIDX[i], pos = DEST[i]; const int dr = tstart[e] * 256 + pos;
        DEST[i] = dr; ROWTOK[dr] = i >> 3;
    }
}

__device__ __forceinline__ void ph_exp1(Frame& F) {
    const int NT = (int)__hip_atomic_load(F.ctl + CW_NT, __ATOMIC_RELAXED, __HIP_MEMORY_SCOPE_AGENT);
    pg8::Gemm g{(const bf16*)(F.ws + WS_A3F), (const bf16*)(F.ws + WS_WGU), 0, 0, D / 2, (const int*)(F.ws + WS_ROWTOK)};
    pg8::MoeOrder S{2, F.G, (int)blockIdx.x, NT, (const int*)(F.ws + WS_TILE_E)};
    EpiSwiglu E{F.ws + WS_ACT};
    pg8::gemm_phase<EpiSwiglu, pg8::MoeOrder, true, true, true, true>(F.lds, g, S, E);
}
__device__ __forceinline__ void ph_exp2(Frame& F) {
    const int NT = (int)__hip_atomic_load(F.ctl + CW_NT, __ATOMIC_RELAXED, __HIP_MEMORY_SCOPE_AGENT);
    pg8::Gemm g{(const bf16*)(F.ws + WS_ACT), (const bf16*)(F.ws + WS_WD), 0, 0, FF / 2, nullptr};
    pg8::MoeOrder S{4, F.G, (int)blockIdx.x, NT, (const int*)(F.ws + WS_TILE_E)};
    EpiRowsFp8 E{F.ws + WS_Y};
    pg8::gemm_phase<EpiRowsFp8, pg8::MoeOrder, true, true, false, true>(F.lds, g, S, E);
}
#endif

#if MS >= 3
__device__ __forceinline__ void unp8(const v4u w, float (&f)[8]) { f[0] = bflo(w.x); f[1] = bfhi(w.x); f[2] = bflo(w.y); f[3] = bfhi(w.y); f[4] = bflo(w.z); f[5] = bfhi(w.z); f[6] = bflo(w.w); f[7] = bfhi(w.w); }
__device__ __forceinline__ void unp8f8(const v2u w, float (&f)[8]) { const f32x2 a = __builtin_amdgcn_cvt_pk_f32_fp8((int)w.x, false), b = __builtin_amdgcn_cvt_pk_f32_fp8((int)w.x, true), c = __builtin_amdgcn_cvt_pk_f32_fp8((int)w.y, false), d = __builtin_amdgcn_cvt_pk_f32_fp8((int)w.y, true);
    f[0] = a.x; f[1] = a.y; f[2] = b.x; f[3] = b.y; f[4] = c.x; f[5] = c.y; f[6] = d.x; f[7] = d.y; }
__device__ __forceinline__ v4u pk8(const float (&f)[8]) { v4u o; o.x = pk2(f[0], f[1]); o.y = pk2(f[2], f[3]); o.z = pk2(f[4], f[5]); o.w = pk2(f[6], f[7]); return o; }
__device__ __forceinline__ void st8(float* p, const float (&f)[8]) { *(f32x4*)p = (f32x4){f[0], f[1], f[2], f[3]}; *(f32x4*)(p + 4) = (f32x4){f[4], f[5], f[6], f[7]}; }
__device__ __forceinline__ void ld8(const float* p, float (&f)[8]) { const f32x4 a = *(const f32x4*)p, b = *(const f32x4*)(p + 4); f[0] = a.x; f[1] = a.y; f[2] = a.z; f[3] = a.w; f[4] = b.x; f[5] = b.y; f[6] = b.z; f[7] = b.w; }

__device__ __forceinline__ void ph_a1(Frame& F) {
    const float* mod = (const float*)(F.ws + WS_MOD); unsigned char* A1 = F.ws + WS_A1;
    constexpr int NR = 4;
    for (int m0 = F.gw; m0 < MR; m0 += NR * F.NGW) {
        f32x4 xv[NR][4];
#pragma unroll
        for (int r = 0; r < NR; ++r) { const int mm = m0 + r * F.NGW; const int m = mm < MR ? mm : m0;
            const float* src = (m < NLAT) ? F.in[0] + (size_t)m * D : F.in[2] + (size_t)(m - NLAT) * D;
            const f32x4* xr = (const f32x4*)src + F.lane;
#pragma unroll
            for (int j = 0; j < 4; ++j) xv[r][j] = __builtin_nontemporal_load(xr + 64 * j); }
        __builtin_amdgcn_sched_barrier(0);
#pragma unroll
        for (int r = 0; r < NR; ++r) { const int mm = m0 + r * F.NGW; const int m = mm < MR ? mm : m0; const int mr = (m < NLAT) ? (m / SEQ) : 4;
            unsigned* ao = (unsigned*)(A1 + (size_t)m * D) + F.lane;
#pragma unroll
            for (int j = 0; j < 4; ++j) { const int c = 4 * F.lane + 256 * j;
                const f32x4 sh = *(const f32x4*)(mod + mr * 6144 + c), sc = *(const f32x4*)(mod + mr * 6144 + 1024 + c);
                const f32x4 h = xv[r][j] * (sc + 1.0f) + sh; ao[64 * j] = pack_fp8x4(h); } }
    }
}

__device__ __forceinline__ void ph_inproj(Frame& F) {
    pg8::Gemm g{(const bf16*)(F.ws + WS_A1), (const bf16*)(F.ws + WS_WIN), MR, NP, D / 2, nullptr};
    pg8::StaticOrder S; S.init(MR, NP, F.G, (int)blockIdx.x);
    EpiRowsBf16 E{(bf16*)(F.ws + WS_P), NP, W8I};
    pg8::gemm_phase<EpiRowsBf16, pg8::StaticOrder, true, true, false, true>(F.lds, g, S, E);
}

struct FeatOut { bf16 *R, *V, *KK, *KP, *QG, *KGB, *VGB, *A2; const float *mu, *kkw, *cw; };
__device__ __forceinline__ void feat_rw(const FeatOut& O, int p, size_t m, int lane, const v4u own_w, const v4u (&nbw)[4], const float (&muv)[8]) {
    float own[8], sh[4][8], val[8];
    unp8(own_w, own);
#pragma unroll
    for (int q = 0; q < 4; ++q) unp8(nbw[q], sh[q]);
#pragma unroll
    for (int e = 0; e < 8; ++e) val[e] = own[e] + muv[e] * (sh[e & 3][e] - own[e]);
    if (p == 0) *(v4u*)(O.R + m * RWW + 8 * lane) = pk8(val);
    else if (p == 2) *(v4u*)(O.V + m * RWW + 8 * lane) = pk8(val);
    else if (p == 1) {
        *(v4u*)(O.KP + m * RWW + 8 * lane) = pk8(val);
        float kw[8]; ld8(O.kkw + 8 * lane, kw); float kkv[8]; float ss = 0.f;
#pragma unroll
        for (int e = 0; e < 8; ++e) { kkv[e] = val[e] * kw[e]; ss += kkv[e] * kkv[e]; }
        ss += __shfl_xor(ss, 1); ss += __shfl_xor(ss, 2); ss += __shfl_xor(ss, 4);
        const float inv = 1.0f / fmaxf(sqrtf(ss), 1e-12f);
#pragma unroll
        for (int e = 0; e < 8; ++e) kkv[e] *= inv;
        *(v4u*)(O.KK + m * RWW + 8 * lane) = pk8(kkv);
    } else {
        float o[8];
#pragma unroll
        for (int e = 0; e < 8; ++e) o[e] = (lane < 4) ? tanhf_(val[e]) : ((lane < 8) ? val[e] : sigmoidf_(val[e]));
        *(v4u*)(O.A2 + m * KLORA + 8 * lane) = pk8(o);
    }
}
__device__ __forceinline__ void feat_gla_store(const FeatOut& O, int p, size_t m, int lane, const float (&acc)[8]) {
    const int cq = p * 512 + 8 * lane; float o[8];
#pragma unroll
    for (int e = 0; e < 8; ++e) o[e] = siluf_(acc[e]);
    if (p == 0) {
        if (lane < 32) {
#pragma unroll
            for (int e = 0; e < 8; ++e) o[e] *= 0.125f;
            *(v4u*)(O.QG + m * 256 + cq) = pk8(o);
        } else *(v4u*)(O.KGB + m * 256 + (cq - 256)) = pk8(o);
    } else *(v4u*)(O.VGB + m * RWW + (cq - 512)) = pk8(o);
}
__device__ __forceinline__ void ph_feat(Frame& F) {
    const bf16* P = (const bf16*)(F.ws + WS_P);
    FeatOut O{(bf16*)(F.ws + WS_RB), (bf16*)(F.ws + WS_VB), (bf16*)(F.ws + WS_KKB), (bf16*)(F.ws + WS_KMF), (bf16*)(F.ws + WS_QGB), (bf16*)(F.ws + WS_KGB), (bf16*)(F.ws + WS_VGB), (bf16*)(F.ws + WS_A2), F.in[7], F.in[13], F.in[18]};
    const v4u Z4 = (v4u){0u, 0u, 0u, 0u};
    for (int blk = F.gw; blk < NB * (GRIDH / 2) * (GRIDW / 2); blk += F.NGW) {
        int lane = F.lane; asm volatile("" : "+v"(lane));
        const int b = blk >> 11, r0 = 2 * ((blk >> 5) & 63), c0 = 2 * (blk & 31); const int mb = b * SEQ + r0 * GRIDW + c0;
        const bool vu = r0 > 0, vd = r0 + 2 < GRIDH, vl = c0 > 0, vr = c0 + 2 < GRIDW;
#pragma unroll
        for (int p = 0; p < 4; ++p) {
            const int cb = p * 512 + 8 * lane; const bool act = (p < 3) || lane < 20;
            v4u own[2][2], up[2], dn[2], lf[2], rt[2];
#pragma unroll
            for (int i = 0; i < 2; ++i) { up[i] = Z4; dn[i] = Z4; lf[i] = Z4; rt[i] = Z4; own[i][0] = Z4; own[i][1] = Z4; }
            if (act) {
#pragma unroll
                for (int i = 0; i < 2; ++i) {
#pragma unroll
                    for (int j = 0; j < 2; ++j) own[i][j] = *(const v4u*)(P + (size_t)(mb + 64 * i + j) * NP + cb);
                    if (vu) up[i] = *(const v4u*)(P + (size_t)(mb - 64 + i) * NP + cb);
                    if (vd) dn[i] = *(const v4u*)(P + (size_t)(mb + 128 + i) * NP + cb);
                    if (vl) lf[i] = *(const v4u*)(P + (size_t)(mb + 64 * i - 1) * NP + cb);
                    if (vr) rt[i] = *(const v4u*)(P + (size_t)(mb + 64 * i + 2) * NP + cb); }
            } else if (p == 3 && lane >= 20 && lane < 22) {
#pragma unroll
                for (int i = 0; i < 2; ++i)
#pragma unroll
                    for (int j = 0; j < 2; ++j) own[i][j] = *(const v4u*)(P + (size_t)(mb + 64 * i + j) * NP + C_PGL + 8 * (lane - 20));
            }
            float muv[8] = {0.f, 0.f, 0.f, 0.f, 0.f, 0.f, 0.f, 0.f}; if (act) ld8(O.mu + cb, muv);
            __builtin_amdgcn_sched_barrier(0);
#pragma unroll
            for (int i = 0; i < 2; ++i)
#pragma unroll
                for (int j = 0; j < 2; ++j) { const size_t m = (size_t)(mb + 64 * i + j);
                    if (act) { const v4u nbw[4] = {j == 0 ? lf[i] : own[i][0], j == 1 ? rt[i] : own[i][1], i == 0 ? up[j] : own[0][j], i == 1 ? dn[j] : own[1][j]};
                        feat_rw(O, p, m, lane, own[i][j], nbw, muv); }
                    else if (p == 3 && lane < 32) *(v4u*)(O.A2 + m * KLORA + 8 * lane) = own[i][j]; }
        }
#pragma unroll
        for (int p = 0; p < 2; ++p) {
            const int cq = p * 512 + 8 * lane, cb = C_Q + cq;
            v4u g[4][4];
#pragma unroll
            for (int a2 = 0; a2 < 4; ++a2)
#pragma unroll
                for (int b2 = 0; b2 < 4; ++b2) { const bool ok = (a2 == 0 ? vu : (a2 == 3 ? vd : true)) && (b2 == 0 ? vl : (b2 == 3 ? vr : true));
                    g[a2][b2] = Z4; if (ok) g[a2][b2] = *(const v4u*)(P + (size_t)(mb + 64 * (a2 - 1) + (b2 - 1)) * NP + cb); }
            __builtin_amdgcn_sched_barrier(0);
            float acc[2][2][8];
#pragma unroll
            for (int i = 0; i < 2; ++i)
#pragma unroll
                for (int j = 0; j < 2; ++j)
#pragma unroll
                    for (int e = 0; e < 8; ++e) acc[i][j][e] = 0.f;
#pragma unroll
            for (int dy = 0; dy < 3; ++dy)
#pragma unroll
                for (int dx = 0; dx < 3; ++dx) { float wv[8]; ld8(O.cw + (dy * 3 + dx) * 1024 + cq, wv);
#pragma unroll
                    for (int i = 0; i < 2; ++i)
#pragma unroll
                        for (int j = 0; j < 2; ++j) { float pv[8]; unp8(g[i + dy][j + dx], pv);
#pragma unroll
                            for (int e = 0; e < 8; ++e) acc[i][j][e] += pv[e] * wv[e]; } }
#pragma unroll
            for (int i = 0; i < 2; ++i)
#pragma unroll
                for (int j = 0; j < 2; ++j) feat_gla_store(O, p, (size_t)(mb + 64 * i + j), lane, acc[i][j]);
        }
    }
    for (int m = NLAT + F.gw; m < MR; m += F.NGW) {
        int lane = F.lane; asm volatile("" : "+v"(lane));
        const int t = (m - NLAT) & (CTXL - 1); const bool vp = t > 0, vn = t < CTXL - 1;
#pragma unroll
        for (int p = 0; p < 4; ++p) {
            const int cb = p * 512 + 8 * lane; const bool act = (p < 3) || lane < 20;
            if (act) { const v4u own = *(const v4u*)(P + (size_t)m * NP + cb); v4u pv = Z4, nv = Z4;
                if (vp) pv = *(const v4u*)(P + (size_t)(m - 1) * NP + cb); if (vn) nv = *(const v4u*)(P + (size_t)(m + 1) * NP + cb);
                float muv[8]; ld8(O.mu + cb, muv); const v4u nbw[4] = {pv, nv, pv, nv};
                feat_rw(O, p, (size_t)m, lane, own, nbw, muv); }
            else if (p == 3 && lane < 32) { v4u w = Z4; if (lane < 22) w = *(const v4u*)(P + (size_t)m * NP + C_PGL + 8 * (lane - 20)); *(v4u*)(O.A2 + (size_t)m * KLORA + 8 * lane) = w; }
        }
#pragma unroll
        for (int p = 0; p < 2; ++p) {
            const int cq = p * 512 + 8 * lane, cb = C_Q + cq; float acc[8] = {0.f, 0.f, 0.f, 0.f, 0.f, 0.f, 0.f, 0.f};
#pragma unroll
            for (int dx = -1; dx <= 1; ++dx) { const bool ok = (dx < 0) ? vp : ((dx > 0) ? vn : true);
                if (ok) { float pv[8], wv[8]; unp8(*(const v4u*)(P + (size_t)(m + dx) * NP + cb), pv); ld8(O.cw + (3 + dx + 1) * 1024 + cq, wv);
#pragma unroll
                    for (int e = 0; e < 8; ++e) acc[e] += pv[e] * wv[e]; } }
            feat_gla_store(O, p, (size_t)m, lane, acc);
        }
    }
}

struct EpiLora {
    static constexpr bool PERM = true;
    unsigned char* ws; const float* const* in;
    __device__ __forceinline__ void grp_w(const f32x4 (&acc)[2][2][4][2], int row0, int c0) const {
        bf16* Wf = (bf16*)(ws + WS_LWF); bf16* Wb = (bf16*)(ws + WS_LWB);
#pragma unroll
        for (int bj = 0; bj < 2; ++bj) { const int ch = (c0 + bj * 128) >> 1; const f32x4 w0f = *(const f32x4*)(in[8] + ch), w0b = *(const f32x4*)(in[8] + 512 + ch);
#pragma unroll
            for (int ai = 0; ai < 2; ++ai)
#pragma unroll
                for (int m = 0; m < 4; ++m) { const size_t row = (size_t)(row0 + ai * 128 + m * 16);
                    const f32x4 xf = acc[ai][bj][m][0] + w0f, xb = acc[ai][bj][m][1] + w0b; f32x4 df, db;
#pragma unroll
                    for (int e = 0; e < 4; ++e) { df[e] = -0.60653066f * sigmoidf_(xf[e]); db[e] = -0.60653066f * sigmoidf_(xb[e]); }
                    { v2u o; o.x = pk2(df[0], df[1]); o.y = pk2(df[2], df[3]); *(v2u*)(Wf + row * RWW + ch) = o; o.x = pk2(db[0], db[1]); o.y = pk2(db[2], db[3]); *(v2u*)(Wb + row * RWW + ch) = o; } } }
    }
    __device__ __forceinline__ void grp_a(const f32x4 (&acc)[2][2][4][2], int row0, int c0) const {
        bf16* KMf = (bf16*)(ws + WS_KMF); bf16* KMb = (bf16*)(ws + WS_KMB); bf16* BVf = (bf16*)(ws + WS_BVF); bf16* BVb = (bf16*)(ws + WS_BVB);
        const bf16* KK = (const bf16*)(ws + WS_KKB); bf16* KSUM = (bf16*)(ws + WS_KSUM);
#pragma unroll
        for (int bj = 0; bj < 2; ++bj) { const int ch = (c0 + bj * 128 - 1024) >> 1; const f32x4 a0f = *(const f32x4*)(in[10] + ch), a0b = *(const f32x4*)(in[10] + 512 + ch), ka = *(const f32x4*)(in[14] + ch);
#pragma unroll
            for (int ai = 0; ai < 2; ++ai) {
            v2u kpw[2][4], kkw[2][4];
#pragma unroll
                for (int m = 0; m < 4; ++m) { const size_t row = (size_t)(row0 + ai * 128 + m * 16); kpw[ai][m] = *(const v2u*)(KMf + row * RWW + ch); kkw[ai][m] = *(const v2u*)(KK + row * RWW + ch); }
            __builtin_amdgcn_sched_barrier(0);
#pragma unroll
                for (int m = 0; m < 4; ++m) { const size_t row = (size_t)(row0 + ai * 128 + m * 16);
                    const f32x4 xf = acc[ai][bj][m][0] + a0f, xb = acc[ai][bj][m][1] + a0b;
                    const f32x4 kp = (f32x4){bflo(kpw[ai][m].x), bfhi(kpw[ai][m].x), bflo(kpw[ai][m].y), bfhi(kpw[ai][m].y)}, kk = (f32x4){bflo(kkw[ai][m].x), bfhi(kkw[ai][m].x), bflo(kkw[ai][m].y), bfhi(kkw[ai][m].y)};
                    f32x4 kmf, kmb, bvf, bvb;
#pragma unroll
                    for (int e = 0; e < 4; ++e) { const float af = sigmoidf_(xf[e]), ab = sigmoidf_(xb[e]);
                        kmf[e] = kp[e] * (1.0f + (af - 1.0f) * ka[e]); kmb[e] = kp[e] * (1.0f + (ab - 1.0f) * ka[e]); bvf[e] = kk[e] * af; bvb[e] = kk[e] * ab; }
                    { v2u o; o.x = pk2(kmf[0], kmf[1]); o.y = pk2(kmf[2], kmf[3]); *(v2u*)(KMf + row * RWW + ch) = o; o.x = pk2(kmb[0], kmb[1]); o.y = pk2(kmb[2], kmb[3]); *(v2u*)(KMb + row * RWW + ch) = o;
                      o.x = pk2(bvf[0], bvf[1]); o.y = pk2(bvf[2], bvf[3]); *(v2u*)(BVf + row * RWW + ch) = o; o.x = pk2(bvb[0], bvb[1]); o.y = pk2(bvb[2], bvb[3]); *(v2u*)(BVb + row * RWW + ch) = o; }
                    v2u ks; ks.x = pk2(kmf[0] + kmb[0], kmf[1] + kmb[1]); ks.y = pk2(kmf[2] + kmb[2], kmf[3] + kmb[3]); *(v2u*)(KSUM + row * RWW + ch) = ks; } } }
    }
    __device__ __forceinline__ void grp_g(const f32x4 (&acc)[2][2][4][2], int row0, int c0) const {
        bf16* RWG = (bf16*)(ws + WS_RWG);
#pragma unroll
        for (int bj = 0; bj < 2; ++bj) { const int ch = c0 + bj * 128 - 2048;
#pragma unroll
            for (int ai = 0; ai < 2; ++ai)
#pragma unroll
                for (int m = 0; m < 4; ++m) { const size_t row = (size_t)(row0 + ai * 128 + m * 16); const f32x4 v0 = acc[ai][bj][m][0], v1 = acc[ai][bj][m][1];
                    v4u w; w.x = pk2(v0[0], v0[1]); w.y = pk2(v0[2], v0[3]); w.z = pk2(v1[0], v1[1]); w.w = pk2(v1[2], v1[3]); *(v4u*)(RWG + row * RWW + ch) = w; } }
    }
    __device__ __forceinline__ void grp_l(const f32x4 (&acc)[2][2][4][2], int row0, int c0) const {
        bf16* GAf = (bf16*)(ws + WS_LAF); bf16* GAb = (bf16*)(ws + WS_LAB);
#pragma unroll
        for (int bj = 0; bj < 2; ++bj) { const int ch = (c0 + bj * 128 - 2560) >> 1; const f32x4 gbf = *(const f32x4*)(in[20] + ch), gbb = *(const f32x4*)(in[20] + 256 + ch);
#pragma unroll
            for (int ai = 0; ai < 2; ++ai)
#pragma unroll
                for (int m = 0; m < 4; ++m) { const size_t row = (size_t)(row0 + ai * 128 + m * 16);
                    const f32x4 xf = acc[ai][bj][m][0] + gbf, xb = acc[ai][bj][m][1] + gbb; f32x4 af, ab;
#pragma unroll
                    for (int e = 0; e < 4; ++e) { const float lf = logsigmoidf_(xf[e]), lb = logsigmoidf_(xb[e]);
                        af[e] = lf * 0.0625f; ab[e] = lb * 0.0625f; }
                    { v2u o; o.x = pk2(af[0], af[1]); o.y = pk2(af[2], af[3]); *(v2u*)(GAf + row * 256 + ch) = o; o.x = pk2(ab[0], ab[1]); o.y = pk2(ab[2], ab[3]); *(v2u*)(GAb + row * 256 + ch) = o; } } }
    }
    __device__ __forceinline__ void operator()(const f32x4 (&acc)[2][2][4][2], const pg8::Unit& u, int wr, int wc, int fr, int fq) const {
        const int row0 = u.pm * 256 + wr * 64 + fr, c0 = u.pn * 256 + wc * 32 + 8 * fq;
        if (u.pn < 4) grp_w(acc, row0, c0); else if (u.pn < 8) grp_a(acc, row0, c0); else if (u.pn < 10) grp_g(acc, row0, c0); else grp_l(acc, row0, c0);
    }
};
__device__ __forceinline__ void ph_lora(Frame& F) {
    pg8::Gemm g{(const bf16*)(F.ws + WS_A2), (const bf16*)(F.ws + WS_WLORA), MR, NLORA, KLORA, nullptr};
    pg8::StaticOrder S; S.init(MR, NLORA, F.G, (int)blockIdx.x);
    EpiLora E{F.ws, F.in};
    pg8::gemm_phase<EpiLora, pg8::StaticOrder, true, true, false>(F.lds, g, S, E);
}

__device__ __forceinline__ void ph_merge(Frame& F) {
    unsigned char* ws = F.ws; const int lane = F.lane;
    const bf16* ORf = (const bf16*)(ws + WS_ORWF); const bf16* ORb = (const bf16*)(ws + WS_ORWB); const bf16* OGf = (const bf16*)(ws + WS_OGLF); const bf16* OGb = (const bf16*)(ws + WS_OGLB);
    const bf16* R = (const bf16*)(ws + WS_RB); const bf16* V = (const bf16*)(ws + WS_VB); const bf16* KSUM = (const bf16*)(ws + WS_KSUM); const bf16* RWG = (const bf16*)(ws + WS_RWG);
    const bf16* P = (const bf16*)(ws + WS_P);
    bf16* YRW = (bf16*)(ws + WS_YRW); bf16* YGLA = (bf16*)(ws + WS_YGLA);
    float rk[8], gw[8], gbv[8], ggw[8], ggb[8];
    ld8(F.in[15] + 8 * lane, rk); ld8(F.in[16] + 8 * lane, gw); ld8(F.in[17] + 8 * lane, gbv); ld8(F.in[21] + 8 * lane, ggw); ld8(F.in[22] + 8 * lane, ggb);
    for (int m0 = F.gw; m0 < NLAT; m0 += 2 * F.NGW) {
        const int m1 = (m0 + F.NGW < NLAT) ? m0 + F.NGW : m0;
        v4u wa[2], wb[2], wc[2], wd[2], wr[2], wv[2], wk[2], wg[2], wo[2];
#pragma unroll
        for (int r2 = 0; r2 < 2; ++r2) { const int m = r2 ? m1 : m0; const size_t ro = (size_t)m * RWW + 8 * lane;
            wa[r2] = *(const v4u*)(ORf + ro); wb[r2] = *(const v4u*)(ORb + ro); wc[r2] = *(const v4u*)(OGf + ro); wd[r2] = *(const v4u*)(OGb + ro);
            wr[r2] = *(const v4u*)(R + ro); wv[r2] = *(const v4u*)(V + ro); wk[r2] = *(const v4u*)(KSUM + ro); wg[r2] = *(const v4u*)(RWG + ro);
            wo[r2] = *(const v4u*)(P + (size_t)m * NP + C_OG + 8 * lane); }
#pragma unroll
        for (int r2 = 0; r2 < 2; ++r2) { const int m = r2 ? m1 : m0; const size_t ro = (size_t)m * RWW + 8 * lane;
        {
            float a[8], b[8], o[8]; unp8(wa[r2], a); unp8(wb[r2], b);
            float s = 0.f;
#pragma unroll
            for (int e = 0; e < 8; ++e) { o[e] = a[e] + b[e]; s += o[e]; }
            s += __shfl_xor(s, 1); s += __shfl_xor(s, 2); s += __shfl_xor(s, 4);
            const float mean = s * (1.f / 64.f); float q = 0.f;
#pragma unroll
            for (int e = 0; e < 8; ++e) { o[e] -= mean; q += o[e] * o[e]; }
            q += __shfl_xor(q, 1); q += __shfl_xor(q, 2); q += __shfl_xor(q, 4);
            const float rstd = __builtin_amdgcn_rsqf(q * (1.f / 64.f) + RW_GN_EPS);
            float r[8], v[8], ksm[8], g[8]; unp8(wr[r2], r); unp8(wv[r2], v); unp8(wk[r2], ksm); unp8(wg[r2], g);
            float bs = 0.f;
#pragma unroll
            for (int e = 0; e < 8; ++e) bs += r[e] * ksm[e] * rk[e];
            bs += __shfl_xor(bs, 1); bs += __shfl_xor(bs, 2); bs += __shfl_xor(bs, 4);
            float y[8];
#pragma unroll
            for (int e = 0; e < 8; ++e) y[e] = (o[e] * rstd * gw[e] + gbv[e] + bs * v[e]) * g[e];
            *(v4u*)(YRW + ro) = pk8(y);
        }
        {
            float a[8], b[8], o[8]; unp8(wc[r2], a); unp8(wd[r2], b);
            float s = 0.f;
#pragma unroll
            for (int e = 0; e < 8; ++e) { o[e] = a[e] + b[e]; s += o[e]; }
            s += __shfl_xor(s, 1); s += __shfl_xor(s, 2); s += __shfl_xor(s, 4); s += __shfl_xor(s, 8);
            const float mean = s * (1.f / 128.f); float q = 0.f;
#pragma unroll
            for (int e = 0; e < 8; ++e) { o[e] -= mean; q += o[e] * o[e]; }
            q += __shfl_xor(q, 1); q += __shfl_xor(q, 2); q += __shfl_xor(q, 4); q += __shfl_xor(q, 8);
            const float rstd = __builtin_amdgcn_rsqf(q * (1.f / 128.f) + LN_EPS);
            float og[8]; unp8(wo[r2], og);
            float y[8];
#pragma unroll
            for (int e = 0; e < 8; ++e) y[e] = (o[e] * rstd * ggw[e] + ggb[e]) * siluf_(og[e]);
            *(v4u*)(YGLA + ro) = pk8(y);
        }
        }
    }
}

template <int WHICH> struct EpiBranch {
    static constexpr bool PERM = true;
    bf16* Z; const bf16* P;
    __device__ __forceinline__ void operator()(const f32x4 (&acc)[2][2][4][2], const pg8::Unit& u, int wr, int wc, int fr, int fq) const {
        const int row0 = u.pm * 256 + wr * 64 + fr, col0 = u.pn * 256 + wc * 32 + 8 * fq;
#pragma unroll
        for (int ah = 0; ah < 4; ++ah) { const int ai = ah >> 1, mb = 2 * (ah & 1);
            v4u gw[2][2], zw[2][2];
#pragma unroll
            for (int m = 0; m < 2; ++m) { const size_t row = (size_t)(row0 + ai * 128 + (mb + m) * 16);
#pragma unroll
                for (int bj = 0; bj < 2; ++bj) { const int c = col0 + bj * 128;
                    gw[m][bj] = *(const v4u*)(P + row * NP + (WHICH ? C_GGLA : C_GRW) + c);
                    if (WHICH) zw[m][bj] = *(const v4u*)(Z + row * D + c); } }
            __builtin_amdgcn_sched_barrier(0);
#pragma unroll
            for (int m = 0; m < 2; ++m) { const size_t row = (size_t)(row0 + ai * 128 + (mb + m) * 16);
#pragma unroll
                for (int bj = 0; bj < 2; ++bj) { const int c = col0 + bj * 128;
                    float g[8]; unp8(gw[m][bj], g);
                    const f32x4 v0 = acc[ai][bj][mb + m][0], v1 = acc[ai][bj][mb + m][1];
                    float z[8];
#pragma unroll
                    for (int e = 0; e < 4; ++e) { z[e] = sigmoidf_(g[e]) * v0[e]; z[4 + e] = sigmoidf_(g[4 + e]) * v1[e]; }
                    if (WHICH) { float zo[8]; unp8(zw[m][bj], zo);
#pragma unroll
                        for (int e = 0; e < 8; ++e) z[e] += zo[e]; }
                    *(v4u*)(Z + row * D + c) = pk8(z); } }
        }
    }
};
__device__ __forceinline__ void ph_branch(Frame& F) {
    pg8::StaticOrder S; S.init(NLAT, D, F.G, (int)blockIdx.x);
    { pg8::Gemm g{(const bf16*)(F.ws + WS_YRW), (const bf16*)(F.ws + WS_WBRRW), NLAT, D, RWW, nullptr};
      EpiBranch<0> E{(bf16*)(F.ws + WS_Z), (const bf16*)(F.ws + WS_P)};
      pg8::gemm_phase<EpiBranch<0>, pg8::StaticOrder, true, true, false>(F.lds, g, S, E); }
    { pg8::Gemm g{(const bf16*)(F.ws + WS_YGLA), (const bf16*)(F.ws + WS_WBRGLA), NLAT, D, RWW, nullptr};
      EpiBranch<1> E{(bf16*)(F.ws + WS_Z), (const bf16*)(F.ws + WS_P)};
      pg8::gemm_phase<EpiBranch<1>, pg8::StaticOrder, true, true, false>(F.lds, g, S, E); }
}
struct EpiOut {
    static constexpr bool PERM = true;
    bf16* X1P; const float* x; const float* mod;
    __device__ __forceinline__ void operator()(const f32x4 (&acc)[2][2][4][2], const pg8::Unit& u, int wr, int wc, int fr, int fq) const {
        const int row0 = u.pm * 256 + wr * 64 + fr, col0 = u.pn * 256 + wc * 32 + 8 * fq; const float* g1 = mod + (u.pm / (SEQ / 256)) * 6144 + 2048;
        f32x4 gv[2][2];
#pragma unroll
        for (int bj = 0; bj < 2; ++bj)
#pragma unroll
            for (int n = 0; n < 2; ++n) gv[bj][n] = *(const f32x4*)(g1 + col0 + bj * 128 + 4 * n);
#pragma unroll
        for (int ah = 0; ah < 4; ++ah) { const int ai = ah >> 1, mb = 2 * (ah & 1);
            f32x4 xv[2][2][2];
#pragma unroll
            for (int m = 0; m < 2; ++m) { const size_t ro = (size_t)(row0 + ai * 128 + (mb + m) * 16) * D;
#pragma unroll
                for (int bj = 0; bj < 2; ++bj)
#pragma unroll
                    for (int n = 0; n < 2; ++n) xv[m][bj][n] = *(const f32x4*)(x + ro + col0 + bj * 128 + 4 * n); }
            __builtin_amdgcn_sched_barrier(0);
#pragma unroll
            for (int m = 0; m < 2; ++m) { const size_t ro = (size_t)(row0 + ai * 128 + (mb + m) * 16) * D;
#pragma unroll
                for (int bj = 0; bj < 2; ++bj) { const f32x4 a = xv[m][bj][0] * ALPHA + gv[bj][0] * acc[ai][bj][mb + m][0], b = xv[m][bj][1] * ALPHA + gv[bj][1] * acc[ai][bj][mb + m][1];
                    v4u w; w.x = pk2(a.x, a.y); w.y = pk2(a.z, a.w); w.z = pk2(b.x, b.y); w.w = pk2(b.z, b.w); *(v4u*)(X1P + ro + col0 + bj * 128) = w; } }
        }
    }
};
__device__ __forceinline__ void ph_outproj(Frame& F) {
    pg8::Gemm g{(const bf16*)(F.ws + WS_Z), (const bf16*)(F.ws + WS_WOUT), NLAT, D, D, nullptr};
    pg8::StaticOrder S; S.init(NLAT, D, F.G, (int)blockIdx.x);
    EpiOut E{(bf16*)(F.ws + WS_X1), F.in[0], (const float*)(F.ws + WS_MOD)};
    pg8::gemm_phase<EpiOut, pg8::StaticOrder, true, true, false>(F.lds, g, S, E);
}
#endif

#if MS >= 3
constexpr int LP = 72, SLOTB = 64 * LP * 2, LPF = 68, AUX_OFF = 13 * SLOTB;
static_assert(AUX_OFF + 4096 <= MISC_OFF, "scan LDS map");
#define SLOT(n) ((LAS bf16*)(lds + (n) * SLOTB))
__device__ __forceinline__ int scan_row(int s, int b, int dir) {
    if (s < CTXL) return NLAT + b * CTXL + (dir ? (CTXL - 1 - s) : s);
    const int lt = s - CTXL; return b * SEQ + (dir ? (SEQ - 1 - lt) : lt);
}
__device__ __forceinline__ unsigned pk2z(float x) { return pk2(x, 0.f); }
__device__ __forceinline__ float bf2f(bf16 h) { return __builtin_bit_cast(float, (unsigned)h << 16); }
__device__ __forceinline__ v2u pack4(const f32x4 v) { v2u o; o.x = pk2(v[0], v[1]); o.y = pk2(v[2], v[3]); return o; }
__device__ __forceinline__ float clamp8(float x) { return __builtin_amdgcn_fmed3f(x, -448.0f, 448.0f); }
__device__ __forceinline__ unsigned pack4_fp8(const f32x4 v) { int w = __builtin_amdgcn_cvt_pk_fp8_f32(clamp8(v[0]), clamp8(v[1]), 0, false); return (unsigned)__builtin_amdgcn_cvt_pk_fp8_f32(clamp8(v[2]), clamp8(v[3]), w, true); }
__device__ __forceinline__ f32x4 unpack4_fp8(unsigned w) { const f32x2 lo = __builtin_amdgcn_cvt_pk_f32_fp8((int)w, false), hi = __builtin_amdgcn_cvt_pk_f32_fp8((int)w, true); return (f32x4){lo.x, lo.y, hi.x, hi.y}; }
__device__ __forceinline__ f32x4 unpack4(const v2u w) { return (f32x4){bflo(w.x), bfhi(w.x), bflo(w.y), bfhi(w.y)}; }
__device__ __forceinline__ f32x4 mm_tile(const LAS bf16* X, int r0, const LAS bf16* Y, int c0, int lane) {
    const int rr = lane & 15, q = lane >> 4;
    const LAS bf16* xp = X + (r0 + rr) * LP + 8 * q; const LAS bf16* yp = Y + (c0 + rr) * LP + 8 * q;
    const bf16x8 a0 = *(const LAS bf16x8*)xp, a1 = *(const LAS bf16x8*)(xp + 32), b0 = *(const LAS bf16x8*)yp, b1 = *(const LAS bf16x8*)(yp + 32);
    f32x4 acc = (f32x4){0.f, 0.f, 0.f, 0.f};
    acc = __builtin_amdgcn_mfma_f32_16x16x32_bf16(a0, b0, acc, 0, 0, 0);
    acc = __builtin_amdgcn_mfma_f32_16x16x32_bf16(a1, b1, acc, 0, 0, 0);
    return acc;
}
__device__ __forceinline__ float red8(float x) {
    x += __builtin_bit_cast(float, __builtin_amdgcn_update_dpp(0, __builtin_bit_cast(int, x), 0x141, 0xf, 0xf, false));
    x += __builtin_bit_cast(float, __builtin_amdgcn_update_dpp(0, __builtin_bit_cast(int, x), 0xB1, 0xf, 0xf, false));
    x += __builtin_bit_cast(float, __builtin_amdgcn_update_dpp(0, __builtin_bit_cast(int, x), 0x4E, 0xf, 0xf, false));
    return x;
}

#define S1_BAR() do { asm volatile("s_waitcnt lgkmcnt(0)" ::: "memory"); __builtin_amdgcn_s_barrier(); asm volatile("" ::: "memory"); } while (0)
struct RwIn { bf16 lw[8], r[8], k[8], a[8], b[8], v[8]; };
__device__ __forceinline__ void s1_rwkv_load(Frame& F, int u, RwIn& I) {
    const int sr = u / NCHUNK, c = u - sr * NCHUNK, rb = sr >> 4, rdir = (sr >> 3) & 1, rh = sr & 7; unsigned char* ws = F.ws;
    const bf16* RBp = (const bf16*)(ws + WS_RB); const bf16* VBp = (const bf16*)(ws + WS_VB); const bf16* KKp = (const bf16*)(ws + WS_KKB);
    const bf16* KMp = (const bf16*)(ws + (rdir ? WS_KMB : WS_KMF)); const bf16* BVp = (const bf16*)(ws + (rdir ? WS_BVB : WS_BVF)); const bf16* LWp = (const bf16*)(ws + (rdir ? WS_LWB : WS_LWF));
#pragma unroll
    for (int i = 0; i < 8; ++i) { const int row = scan_row(c * CH + 8 * F.wave + i, rb, rdir); const size_t base = (size_t)row * RWW + rh * 64 + F.lane;
        I.lw[i] = LWp[base]; I.r[i] = RBp[base]; I.k[i] = KMp[base]; I.a[i] = KKp[base]; I.b[i] = BVp[base]; I.v[i] = VBp[base]; }
}
__device__ __forceinline__ void s1_rwkv(Frame& F, int u, const RwIn& I, int un, RwIn& Inext, f32x2v (&cv)[32], int& cpend, int cvi) {
    const int sr = u / NCHUNK, c = u - sr * NCHUNK;
    const bool emit = c >= CTXL / CH;
    LAS unsigned char* lds = F.lds; unsigned char* ws = F.ws;
    int lane_ = F.lane; asm volatile("" : "+v"(lane_));
    const int lane = lane_, wave = F.wave, rr = lane & 15, q = lane >> 4;
    LAS float* tot = (LAS float*)(lds + AUX_OFF); LAS float* gCs = tot + 512;
    {
        float lw[8], xr[8], xk[8], xa[8], xb[8], xv[8];
#pragma unroll
        for (int i = 0; i < 8; ++i) { lw[i] = bf2f(I.lw[i]); xr[i] = bf2f(I.r[i]); xk[i] = bf2f(I.k[i]); xa[i] = -bf2f(I.a[i]); xb[i] = bf2f(I.b[i]); xv[i] = bf2f(I.v[i]); }
        float p[8]; p[0] = lw[0];
#pragma unroll
        for (int i = 1; i < 8; ++i) p[i] = p[i - 1] + lw[i];
        tot[wave * 64 + lane] = p[7];
        S1_BAR();
        float off = 0.f, all = 0.f;
#pragma unroll
        for (int w = 0; w < 8; ++w) { const float t = tot[w * 64 + lane]; all += t; off += (w < wave) ? t : 0.f; }
        if (wave == 0) gCs[lane] = __expf(all);
        float at[8], bb[8], kb[8];
#pragma unroll
        for (int i = 0; i < 8; ++i) { const float cum = off + p[i]; const float g = __expf(cum), gi = __expf(-cum), gp = __expf(cum - lw[i]), gc = __expf(all - cum);
            const int t = 8 * wave + i;
            at[i] = xa[i] * gp; bb[i] = xb[i] * gc; kb[i] = xk[i] * gc;
            SLOT(0)[t * LP + lane] = (bf16)pk2z(at[i]);
            SLOT(1)[t * LP + lane] = (bf16)pk2z(xr[i] * g);
            SLOT(2)[t * LP + lane] = (bf16)pk2z(xb[i] * gi);
            SLOT(3)[t * LP + lane] = (bf16)pk2z(xk[i] * gi); }
        *(LAS v4u*)(SLOT(4) + lane * LP + 8 * wave) = pk8(at);
        *(LAS v4u*)(SLOT(5) + lane * LP + 8 * wave) = pk8(xv);
        *(LAS v4u*)(SLOT(6) + lane * LP + 8 * wave) = pk8(bb);
        *(LAS v4u*)(SLOT(7) + lane * LP + 8 * wave) = pk8(kb);
        S1_BAR();
    }
    if (wave < 4) s1_rwkv_load(F, un, Inext);
    LAS float* Lp = (LAS float*)(lds + 8 * SLOTB);
#pragma unroll
    for (int tix = 0; tix < 2; ++tix) { const int ti = 2 * wave + tix, r0 = 16 * (ti >> 2), c0 = 16 * (ti & 3), ci = c0 + rr;
        { const f32x4 acc = mm_tile(SLOT(2), r0, SLOT(0), c0, lane);
#pragma unroll
            for (int e = 0; e < 4; ++e) { const int i = r0 + 4 * q + e; Lp[ci * LPF + (i & 3) * 16 + (i >> 2)] = (i < ci) ? acc[e] : 0.f; } }
        { f32x4 acc = mm_tile(SLOT(0), r0, SLOT(3), c0, lane);
#pragma unroll
            for (int e = 0; e < 4; ++e) acc[e] = (ci < r0 + 4 * q + e) ? acc[e] : 0.f;
            *(LAS v2u*)(SLOT(10) + ci * LP + r0 + 4 * q) = pack4(acc); }
        if (emit) {
            { f32x4 acc = mm_tile(SLOT(2), r0, SLOT(1), c0, lane);
#pragma unroll
                for (int e = 0; e < 4; ++e) acc[e] = (r0 + 4 * q + e <= ci) ? acc[e] : 0.f;
                *(LAS v2u*)(SLOT(11) + ci * LP + r0 + 4 * q) = pack4(acc); }
            { f32x4 acc = mm_tile(SLOT(3), r0, SLOT(1), c0, lane);
#pragma unroll
                for (int e = 0; e < 4; ++e) acc[e] = (r0 + 4 * q + e <= ci) ? acc[e] : 0.f;
                *(LAS v2u*)(SLOT(12) + ci * LP + r0 + 4 * q) = pack4(acc); }
        }
    }
    S1_BAR();
    if (wave < 4) {
        const int j = 16 * wave + (lane >> 2), s = lane & 3;
        float Tr[16];
#pragma unroll
        for (int m = 0; m < 16; ++m) Tr[m] = 0.f;
        const LAS float* lrow = Lp + s * 16;
        f32x4 lb[3][4];
#pragma unroll
        for (int t = 0; t < 2; ++t) lb[t][0] = *(const LAS f32x4*)(lrow + t * LPF);
#pragma unroll
        for (int t = 0; t < 64; ++t) {
            if (t + 2 < 64) {
#pragma unroll
                for (int k = 0; k < 4; ++k) if (4 * k <= (t + 2) / 4) lb[(t + 2) % 3][k] = *(const LAS f32x4*)(lrow + (t + 2) * LPF + 4 * k);
            }
            __builtin_amdgcn_sched_barrier(0);
            float acc0 = 0.f, acc1 = 0.f;
#pragma unroll
            for (int m = 0; m < 16; ++m) if (m <= t / 4) { const float lv = lb[t % 3][m >> 2][m & 3]; if (m & 1) acc1 += lv * Tr[m]; else acc0 += lv * Tr[m]; }
            float acc = acc0 + acc1;
            acc += __builtin_bit_cast(float, __builtin_amdgcn_update_dpp(0, __builtin_bit_cast(int, acc), 0xB1, 0xf, 0xf, false));
            acc += __builtin_bit_cast(float, __builtin_amdgcn_update_dpp(0, __builtin_bit_cast(int, acc), 0x4E, 0xf, 0xf, false));
            int jj = j, ss = s; asm volatile("" : "+v"(jj), "+v"(ss));
            const float val = acc + ((t == jj) ? 1.f : 0.f);
            Tr[t >> 2] = (ss == (t & 3)) ? val : Tr[t >> 2];
            SLOT(0)[t * LP + j] = (bf16)pk2z(val);
        }
    } else { CVY_FLUSH(); s1_rwkv_load(F, un, Inext); CVY_START(cvi); }
    S1_BAR();
#pragma unroll
    for (int tix = 0; tix < 2; ++tix) { const int ti = 2 * wave + tix, r0 = 16 * (ti >> 2), c0 = 16 * (ti & 3), ci = c0 + rr;
        { const f32x4 acc = mm_tile(SLOT(0), r0, SLOT(4), c0, lane); *(LAS v2u*)(SLOT(2) + ci * LP + r0 + 4 * q) = pack4(acc); }
        { const f32x4 acc = mm_tile(SLOT(0), r0, SLOT(10), c0, lane); *(LAS v2u*)(SLOT(3) + ci * LP + r0 + 4 * q) = pack4(acc); }
    }
    S1_BAR();
    unsigned char* RH = ws + WS_RH + (size_t)u * 4096; bf16* GT = (bf16*)((unsigned char*)F.out + OUT_GT) + (size_t)u * 4096;
#pragma unroll
    for (int tix = 0; tix < 2; ++tix) { const int ti = 2 * wave + tix, tr = ti >> 2, r0 = 16 * tr, c0 = 16 * (ti & 3), ci = c0 + rr;
        const int pos = (tr >> 1) * 32 + q * 8 + 4 * (tr & 1);
        if (emit) {
            { f32x4 acc = mm_tile(SLOT(2), r0, SLOT(11), c0, lane);
                acc += unpack4(*(const LAS v2u*)(SLOT(1) + ci * LP + r0 + 4 * q));
                *(unsigned*)(RH + ci * 64 + pos) = pack4_fp8(acc); }
            { f32x4 acc = mm_tile(SLOT(3), r0, SLOT(11), c0, lane);
                acc += unpack4(*(const LAS v2u*)(SLOT(12) + ci * LP + r0 + 4 * q));
                *(LAS v2u*)(SLOT(4) + ci * LP + r0 + 4 * q) = pack4(acc); }
        }
        { f32x4 acc = mm_tile(SLOT(2), r0, SLOT(6), c0, lane);
            const float gc = gCs[ci];
#pragma unroll
            for (int e = 0; e < 4; ++e) acc[e] += (r0 + 4 * q + e == ci) ? gc : 0.f;
            *(v2u*)(GT + ci * 64 + pos) = pack4(acc); }
    }
    S1_BAR();
    unsigned char* YL = ws + WS_YL + (size_t)u * 4096;
#pragma unroll
    for (int tix = 0; tix < 2; ++tix) { const int ti = 2 * wave + tix, r0 = 16 * (ti >> 2), c0 = 16 * (ti & 3), ci = c0 + rr;
        if (emit) { const f32x4 acc = mm_tile(SLOT(5), r0, SLOT(4), c0, lane); *(unsigned*)(YL + ci * 64 + r0 + 4 * q) = pack4_fp8(acc); }
        { f32x4 acc = mm_tile(SLOT(3), r0, SLOT(6), c0, lane);
            acc += unpack4(*(const LAS v2u*)(SLOT(7) + ci * LP + r0 + 4 * q));
            *(LAS v2u*)(SLOT(8) + ci * LP + r0 + 4 * q) = pack4(acc); }
    }
    S1_BAR();
    bf16* HH = (bf16*)(ws + WS_HH) + (size_t)u * 4096;
#pragma unroll
    for (int tix = 0; tix < 2; ++tix) { const int ti = 2 * wave + tix, r0 = 16 * (ti >> 2), c0 = 16 * (ti & 3), ci = c0 + rr;
        const f32x4 acc = mm_tile(SLOT(8), r0, SLOT(5), c0, lane);
        *(v2u*)(HH + ci * 64 + r0 + 4 * q) = pack4(acc); }
    S1_BAR();
}

struct GlIn { bf16 la[8], q[8], k[8], v0[8], v1[8]; };
__device__ __forceinline__ void s1_gla_load(Frame& F, int u, GlIn& I) {
    const int sg = u / NCHUNK, c = u - sg * NCHUNK, gb = sg >> 3, gdir = (sg >> 2) & 1, gh = sg & 3; unsigned char* ws = F.ws;
    const bf16* Qp = (const bf16*)(ws + WS_QGB); const bf16* Kp = (const bf16*)(ws + WS_KGB); const bf16* Vp = (const bf16*)(ws + WS_VGB); const bf16* LAp = (const bf16*)(ws + (gdir ? WS_LAB : WS_LAF));
#pragma unroll
    for (int i = 0; i < 8; ++i) { const int row = scan_row(c * CH + 8 * F.wave + i, gb, gdir); const size_t b2 = (size_t)row * 256 + gh * 64 + F.lane, b5 = (size_t)row * RWW + gh * 128 + F.lane;
        I.la[i] = LAp[b2]; I.q[i] = Qp[b2]; I.k[i] = Kp[b2]; I.v0[i] = Vp[b5]; I.v1[i] = Vp[b5 + 64]; }
}
__device__ __forceinline__ void s1_gla(Frame& F, int u, const GlIn& I, int un, GlIn& Inext, f32x2v (&cv)[32], int& cpend, int cvi) {
    const int sg = u / NCHUNK, c = u - sg * NCHUNK;
    const bool emit = c >= CTXL / CH;
    LAS unsigned char* lds = F.lds; unsigned char* ws = F.ws;
    int lane_ = F.lane; asm volatile("" : "+v"(lane_));
    const int lane = lane_, wave = F.wave, rr = lane & 15, q = lane >> 4;
    LAS float* tot = (LAS float*)(lds + AUX_OFF);
    unsigned char* QE = (unsigned char*)F.out + OUT_QE + (size_t)u * 4096;
    {
        float la[8], xq[8], xk[8], v0[8], v1[8];
#pragma unroll
        for (int i = 0; i < 8; ++i) { la[i] = bf2f(I.la[i]); xq[i] = bf2f(I.q[i]); xk[i] = bf2f(I.k[i]); v0[i] = bf2f(I.v0[i]); v1[i] = bf2f(I.v1[i]); }
        float p[8]; p[0] = la[0];
#pragma unroll
        for (int i = 1; i < 8; ++i) p[i] = p[i - 1] + la[i];
        tot[wave * 64 + lane] = p[7];
        S1_BAR();
        float off = 0.f, all = 0.f;
#pragma unroll
        for (int w = 0; w < 8; ++w) { const float t = tot[w * 64 + lane]; all += t; off += (w < wave) ? t : 0.f; }
        if (wave == 0) ((float*)(ws + WS_DD))[(size_t)u * 64 + lane] = __expf(all);
        float kl[8];
#pragma unroll
        for (int i = 0; i < 8; ++i) { const float cum = off + p[i]; const int t = 8 * wave + i;
            const float qef = xq[i] * __expf(cum);
            SLOT(0)[t * LP + lane] = (bf16)pk2z(qef);
            if (emit) QE[t * 64 + lane] = (unsigned char)__builtin_amdgcn_cvt_pk_fp8_f32(clamp8(qef), 0.f, 0, false);
            SLOT(1)[t * LP + lane] = (bf16)pk2z(xk[i] * __expf(-cum));
            kl[i] = xk[i] * __expf(all - cum); }
        *(LAS v4u*)(SLOT(2) + lane * LP + 8 * wave) = pk8(kl);
        *(LAS v4u*)(SLOT(3) + lane * LP + 8 * wave) = pk8(v0);
        *(LAS v4u*)(SLOT(3) + (64 + lane) * LP + 8 * wave) = pk8(v1);
        S1_BAR();
    }
    if (wave >= 4) { CVY_FLUSH(); s1_gla_load(F, un, Inext); CVY_START(cvi); }
    else if (emit) {
#pragma unroll
        for (int tix = 0; tix < 4; ++tix) { const int ti = 4 * wave + tix, r0 = 16 * (ti >> 2), c0 = 16 * (ti & 3), ci = c0 + rr;
            f32x4 acc = mm_tile(SLOT(1), r0, SLOT(0), c0, lane);
#pragma unroll
            for (int e = 0; e < 4; ++e) acc[e] = (r0 + 4 * q + e <= ci) ? acc[e] : 0.f;
            *(LAS v2u*)(SLOT(5) + ci * LP + r0 + 4 * q) = pack4(acc); }
    }
    bf16* KV = (bf16*)(ws + WS_KV) + (size_t)u * 8192;
#pragma unroll
    for (int tix = 0; tix < 4; ++tix) { const int ti = 4 * wave + tix, r0 = 16 * (ti >> 3), c0 = 16 * (ti & 7), ci = c0 + rr;
        const f32x4 acc = mm_tile(SLOT(2), r0, SLOT(3), c0, lane);
        *(v2u*)(KV + ci * 64 + r0 + 4 * q) = pack4(acc); }
    S1_BAR();
    if (emit) {
        unsigned char* IN = ws + WS_INTRA + (size_t)u * 8192;
#pragma unroll
        for (int tix = 0; tix < 4; ++tix) { const int ti = 4 * wave + tix, r0 = 16 * (ti >> 2), c0 = 16 * (ti & 3), ci = c0 + rr;
            const f32x4 acc = mm_tile(SLOT(3), r0, SLOT(5), c0, lane);
            *(unsigned*)(IN + ci * 128 + r0 + 4 * q) = pack4_fp8(acc); }
    }
    S1_BAR();
}

__device__ __forceinline__ void ph_scan1(Frame& F) {
    f32x2v cv[32]; int cpend = -1; const int lane = F.lane;
    int item = (int)blockIdx.x * 4 + (F.wave & 3);
    { RwIn cur, nxt; if ((int)blockIdx.x < NU_RW) s1_rwkv_load(F, blockIdx.x, cur);
#pragma unroll 1
      for (int u = blockIdx.x; u < NU_RW; u += F.G, item += F.G * 4) { const int un = (u + F.G < NU_RW) ? u + F.G : u; s1_rwkv(F, u, cur, un, nxt, cv, cpend, item); cur = nxt; } }
    { GlIn cur, nxt; if ((int)blockIdx.x < NU_GL) s1_gla_load(F, blockIdx.x, cur);
#pragma unroll 1
      for (int u = blockIdx.x; u < NU_GL; u += F.G, item += F.G * 4) { const int un = (u + F.G < NU_GL) ? u + F.G : u; if (F.wave < 4) s1_gla_load(F, un, nxt); s1_gla(F, u, cur, un, nxt, cv, cpend, item); cur = nxt; } }
    if (F.wave >= 4) CVY_FLUSH();
}

__device__ __forceinline__ bf16x8 pack_frag(const f32x4 lo, const f32x4 hi) {
    v4u w; w.x = pk2(lo[0], lo[1]); w.y = pk2(lo[2], lo[3]); w.z = pk2(hi[0], hi[1]); w.w = pk2(hi[2], hi[3]); return __builtin_bit_cast(bf16x8, w);
}
constexpr int S2_D = 5, S2_R = 6, S2_RW = 8192 + 4096 + 2048 + 1024, S2_GL = 4096 + 2048 + 1024 + 1024, S2_SLOT = S2_RW + S2_GL;
static_assert(S2_R * S2_SLOT <= MISC_OFF, "S2 ring fits in LDS");
__device__ __forceinline__ void s2_issue(LAS unsigned char* lds, int sb, int lw, int lane, size_t ur, size_t ug, int v0r, int v0g,
                                         const unsigned char* GTb, const unsigned char* RHb, const unsigned char* HHb, const unsigned char* YLb,
                                         const unsigned char* QEb, const unsigned char* KVb, const unsigned char* INb, const unsigned char* DDb) {
#pragma unroll
    for (int j = 0; j < 4; ++j) {
        int k = lw * 4 + j; if (k >= 23) k -= 1;
        const unsigned char* src; int ldo;
        if (k < 8) { const int n = k, pu = n * 64 + lane, row = pu >> 3, c16 = (pu & 7) ^ (row & 7);
            src = GTb + ur * 8192 + row * 128 + c16 * 16; ldo = n * 1024; }
        else if (k < 12) { const int n = k - 8, pu = n * 64 + lane, row = pu >> 2, c16 = (pu & 3) ^ (row & 3);
            src = RHb + ur * 4096 + row * 64 + c16 * 16; ldo = 8192 + n * 1024; }
        else if (k < 14) { const int n = k - 12, pu = n * 64 + lane, v = pu >> 3, c16 = (pu & 7) ^ (v & 7);
            src = HHb + ur * 8192 + (size_t)(v0r + v) * 128 + c16 * 16; ldo = 12288 + n * 1024; }
        else if (k < 15) { const int t = lane;
            src = YLb + ur * 4096 + t * 64 + v0r; ldo = 14336; }
        else if (k < 19) { const int n = k - 15, pu = n * 64 + lane, row = pu >> 2, c16 = (pu & 3) ^ (row & 3);
            src = QEb + ug * 4096 + row * 64 + c16 * 16; ldo = S2_RW + n * 1024; }
        else if (k < 21) { const int n = k - 19, pu = n * 64 + lane, v = pu >> 3, c16 = (pu & 7) ^ (v & 7);
            src = KVb + ug * 16384 + (size_t)(v0g + v) * 128 + c16 * 16; ldo = S2_RW + 4096 + n * 1024; }
        else if (k < 22) { const int t = lane;
            src = INb + ug * 8192 + t * 128 + v0g; ldo = S2_RW + 6144; }
        else { src = DDb + ug * 256 + (lane & 15) * 16; ldo = S2_RW + 7168; }
        __builtin_amdgcn_global_load_lds((const unsigned*)src, (LAS unsigned*)(lds + sb + ldo), 16, 0, 0);
    }
}
__device__ __forceinline__ void ph_scan2(Frame& F) {
    const int lane = F.lane, wave = F.wave, rr = lane & 15, q = lane >> 4; unsigned char* ws = F.ws; LAS unsigned char* lds = F.lds;
    const int it = (F.G == 256) ? (int)(blockIdx.x & 7) * 32 + (int)(blockIdx.x >> 3) : (int)blockIdx.x;
    const int sr = it >> 2, v0r = 16 * (it & 3), rb = sr >> 4, rdir = (sr >> 3) & 1, rh = sr & 7;
    const int sg = it >> 3, v0g = 16 * (it & 7), gb = sg >> 3, gdir = (sg >> 2) & 1, gh = sg & 3;
#define S2_BAR() do { asm volatile("s_waitcnt lgkmcnt(0)" ::: "memory"); __builtin_amdgcn_s_barrier(); asm volatile("" ::: "memory"); } while (0)
    if (wave >= 2) {
        const unsigned char* GTb = (const unsigned char*)F.out + OUT_GT; const unsigned char* QEb = (const unsigned char*)F.out + OUT_QE;
        const unsigned char* RHb = ws + WS_RH; const unsigned char* YLb = ws + WS_YL; const unsigned char* HHb = ws + WS_HH; const unsigned char* KVb = ws + WS_KV; const unsigned char* INb = ws + WS_INTRA;
        const unsigned char* DDb = ws + WS_DD;
#define S2_ISSUE(cc) s2_issue(lds, ((cc) % S2_R) * S2_SLOT, wave - 2, lane, (size_t)(sr * NCHUNK + ((cc) < NCHUNK ? (cc) : NCHUNK - 1)), (size_t)(sg * NCHUNK + ((cc) < NCHUNK ? (cc) : NCHUNK - 1)), v0r, v0g, GTb, RHb, HHb, YLb, QEb, KVb, INb, DDb)
        S2_ISSUE(0); S2_ISSUE(1); S2_ISSUE(2); S2_ISSUE(3); S2_ISSUE(4);
#pragma unroll 1
        for (int c = 0; c < NCHUNK; ++c) {
            asm volatile("s_waitcnt vmcnt(16) ; S2WAIT" ::: "memory");
            S2_BAR();
            S2_ISSUE(c + S2_D);
        }
#undef S2_ISSUE
    } else if (wave == 0) {
        bf16* ORW = (bf16*)(ws + (rdir ? WS_ORWB : WS_ORWF));
        f32x4 S[4];
#pragma unroll
        for (int m = 0; m < 4; ++m) S[m] = (f32x4){0.f, 0.f, 0.f, 0.f};
#pragma unroll 1
        for (int c = 0; c < NCHUNK; ++c) {
            S2_BAR();
            const LAS unsigned char* sl = lds + (c % S2_R) * S2_SLOT;
            const bool emit = c >= CTXL / CH;
            bf16x8 G0[4], G1[4]; v2u Hw[4], Rw0[4], Rw1[4]; unsigned Yw[4];
#pragma unroll
            for (int m = 0; m < 4; ++m) { const int k2 = 16 * m + rr;
                G0[m] = *(const LAS bf16x8*)(sl + (k2 * 8 + (q ^ (k2 & 7))) * 16); G1[m] = *(const LAS bf16x8*)(sl + (k2 * 8 + ((4 + q) ^ (k2 & 7))) * 16);
                Hw[m] = *(const LAS v2u*)(sl + 12288 + (rr * 8 + ((2 * m + (q >> 1)) ^ (rr & 7))) * 16 + (q & 1) * 8); }
            if (emit) {
#pragma unroll
                for (int tt = 0; tt < 4; ++tt) { const int t = 16 * tt + rr;
                    Rw0[tt] = *(const LAS v2u*)(sl + 8192 + (t * 4 + ((q >> 1) ^ (t & 3))) * 16 + (q & 1) * 8); Rw1[tt] = *(const LAS v2u*)(sl + 8192 + (t * 4 + ((2 + (q >> 1)) ^ (t & 3))) * 16 + (q & 1) * 8);
                    Yw[tt] = *(const LAS unsigned*)(sl + 14336 + t * 16 + q * 4); }
            }
            const bf16x8 Sf0 = pack_frag(S[0], S[1]), Sf1 = pack_frag(S[2], S[3]);
            __builtin_amdgcn_sched_barrier(0);
#pragma unroll
            for (int m = 0; m < 4; ++m) { f32x4 acc = unpack4(Hw[m]);
                acc = __builtin_amdgcn_mfma_f32_16x16x32_bf16(G0[m], Sf0, acc, 0, 0, 0);
                acc = __builtin_amdgcn_mfma_f32_16x16x32_bf16(G1[m], Sf1, acc, 0, 0, 0);
                S[m] = acc; }
            if (emit) {
#pragma unroll
                for (int tt = 0; tt < 4; ++tt) { const int t = 16 * tt + rr;
                    const bf16x8 R0 = pack_frag(unpack4_fp8(Rw0[tt].x), unpack4_fp8(Rw0[tt].y)), R1 = pack_frag(unpack4_fp8(Rw1[tt].x), unpack4_fp8(Rw1[tt].y));
                    f32x4 acc = unpack4_fp8(Yw[tt]);
                    acc = __builtin_amdgcn_mfma_f32_16x16x32_bf16(Sf0, R0, acc, 0, 0, 0);
                    acc = __builtin_amdgcn_mfma_f32_16x16x32_bf16(Sf1, R1, acc, 0, 0, 0);
                    const int row = scan_row(c * CH + t, rb, rdir);
                    *(v2u*)(ORW + (size_t)row * RWW + rh * 64 + v0r + 4 * q) = pack4(acc); }
            }
        }
    } else {
        bf16* OGL = (bf16*)(ws + (gdir ? WS_OGLB : WS_OGLF));
        f32x4 S[4];
#pragma unroll
        for (int m = 0; m < 4; ++m) S[m] = (f32x4){0.f, 0.f, 0.f, 0.f};
#pragma unroll 1
        for (int c = 0; c < NCHUNK; ++c) {
            S2_BAR();
            const LAS unsigned char* sl = lds + (c % S2_R) * S2_SLOT + S2_RW;
            const bool emit = c >= CTXL / CH;
            v2u Qw0[4], Qw1[4]; unsigned Iw[4]; v4u kw[2]; f32x4 d0[2], d1[2];
#pragma unroll
            for (int s2 = 0; s2 < 2; ++s2) { kw[s2] = *(const LAS v4u*)(sl + 4096 + (rr * 8 + ((4 * s2 + q) ^ (rr & 7))) * 16);
                d0[s2] = *(const LAS f32x4*)(sl + 7168 + 128 * s2 + 32 * q); d1[s2] = *(const LAS f32x4*)(sl + 7168 + 128 * s2 + 32 * q + 16); }
            if (emit) {
#pragma unroll
                for (int tt = 0; tt < 4; ++tt) { const int t = 16 * tt + rr;
                    Qw0[tt] = *(const LAS v2u*)(sl + (t * 4 + ((q >> 1) ^ (t & 3))) * 16 + (q & 1) * 8); Qw1[tt] = *(const LAS v2u*)(sl + (t * 4 + ((2 + (q >> 1)) ^ (t & 3))) * 16 + (q & 1) * 8);
                    Iw[tt] = *(const LAS unsigned*)(sl + 6144 + t * 16 + q * 4); }
            }
            const bf16x8 Sf0 = pack_frag(S[0], S[1]), Sf1 = pack_frag(S[2], S[3]);
            __builtin_amdgcn_sched_barrier(0);
#pragma unroll
            for (int s2 = 0; s2 < 2; ++s2) { S[2 * s2] = S[2 * s2] * d0[s2] + unpack4((v2u){kw[s2].x, kw[s2].y}); S[2 * s2 + 1] = S[2 * s2 + 1] * d1[s2] + unpack4((v2u){kw[s2].z, kw[s2].w}); }
            if (emit) {
#pragma unroll
                for (int tt = 0; tt < 4; ++tt) { const int t = 16 * tt + rr;
                    const bf16x8 Q0 = pack_frag(unpack4_fp8(Qw0[tt].x), unpack4_fp8(Qw0[tt].y)), Q1 = pack_frag(unpack4_fp8(Qw1[tt].x), unpack4_fp8(Qw1[tt].y));
                    f32x4 acc = unpack4_fp8(Iw[tt]);
                    acc = __builtin_amdgcn_mfma_f32_16x16x32_bf16(Sf0, Q0, acc, 0, 0, 0);
                    acc = __builtin_amdgcn_mfma_f32_16x16x32_bf16(Sf1, Q1, acc, 0, 0, 0);
                    const int row = scan_row(c * CH + t, gb, gdir);
                    *(v2u*)(OGL + (size_t)row * RWW + gh * 128 + v0g + 4 * q) = pack4(acc); }
            }
        }
    }
#undef S2_BAR
}
#endif

#ifndef ML
#define ML 0
#endif
enum Phase { PH_PROLOGUE = 0, PH_A1, PH_INPROJ, PH_FEAT, PH_LORA, PH_SCAN1, PH_SCAN2, PH_MERGE, PH_BRANCH, PH_OUTPROJ, PH_LN1, PH_ROUTER, PH_ROUTE, PH_SCATTER, PH_EXP1, PH_EXP2, PH_FINAL, PH_COUNT };

__global__ void __launch_bounds__(NTHR, 2) mega(Args args) {
    extern __shared__ __attribute__((aligned(16))) unsigned char lds_raw[];
    Frame F;
    F.lds = (LAS unsigned char*)lds_raw;
    F.tid = threadIdx.x; F.lane = F.tid & 63; F.wave = __builtin_amdgcn_readfirstlane(F.tid >> 6);
    F.G = gridDim.x; F.gw = blockIdx.x * NWAVES + F.wave; F.NGW = F.G * NWAVES;
    F.in = args.in; F.out = args.out; F.ws = args.ws; F.ctl = (unsigned*)(args.ws + WS_CTL);
    volatile LAS unsigned* MISC = (volatile LAS unsigned*)(F.lds + MISC_OFF);
    if (F.tid < 64) MISC[F.tid] = 0u;
    __syncthreads();
    XcdBarrier bar; bar.bar = F.ctl + CW_BAR; bar.x = 0; bar.st = nullptr;
#if !ML
    bar = xcd_barrier_post(F.ctl + CW_BAR, MISC + 8);
#endif
    const int lo = args.ph_lo, hi = args.ph_hi;
#define IN(k) (lo <= (k) && (k) < hi)
#ifndef DUP
#define DUP -1
#endif
#define RUN(k, call) do { if (IN(k)) { call; GRID_BAR(); if (DUP == (k)) { call; GRID_BAR(); } } } while (0)
#if ML
#define GRID_BAR() do { } while (0)
#else
#define GRID_BAR() xcd_barrier(bar)
#endif

#if MS >= 2
    RUN(PH_PROLOGUE, ph_prologue(F));
#endif
#if MS >= 3
    RUN(PH_A1, ph_a1(F));
    RUN(PH_INPROJ, ph_inproj(F));
    RUN(PH_FEAT, ph_feat(F));
    RUN(PH_LORA, ph_lora(F));
    RUN(PH_SCAN1, ph_scan1(F));
    RUN(PH_SCAN2, ph_scan2(F));
    RUN(PH_MERGE, ph_merge(F));
    RUN(PH_BRANCH, ph_branch(F));
    RUN(PH_OUTPROJ, ph_outproj(F));
#else
    RUN(PH_OUTPROJ, ph_x1pre_nomix(F));
#endif
    RUN(PH_LN1, ph_ln1(F));
#if MS >= 2
    RUN(PH_ROUTER, ph_router(F));
    RUN(PH_ROUTE, ph_route(F));
    RUN(PH_SCATTER, ph_scatter(F));
    RUN(PH_EXP1, ph_exp1(F));
    RUN(PH_EXP2, ph_exp2(F));
#endif
    if (IN(PH_FINAL)) { ph_final(F); }
#undef IN
}

extern "C" void kernel_launch(void* const* d_in, const int* in_sizes, int n_in, void* d_out, int out_size, void* d_ws, size_t ws_size, hipStream_t stream) {
    static int grid = 0;
    if (grid == 0) {
        if (n_in != 36 || out_size != NLAT * D || ws_size < WS_END) { fprintf(stderr, "kernel_launch: unexpected problem shape (n_in %d, out %d)\n", n_in, out_size); grid = -1; return; }
        int dev = 0, cus = 0, per_cu = 0;
        if (hipGetDevice(&dev) != hipSuccess || hipDeviceGetAttribute(&cus, hipDeviceAttributeMultiprocessorCount, dev) != hipSuccess) { grid = -1; return; }
        if (hipFuncSetAttribute((const void*)mega, hipFuncAttributeMaxDynamicSharedMemorySize, LDS_BYTES) != hipSuccess) { fprintf(stderr, "kernel_launch: hipFuncSetAttribute failed\n"); grid = -1; return; }
        if (hipOccupancyMaxActiveBlocksPerMultiprocessor(&per_cu, (const void*)mega, NTHR, LDS_BYTES) != hipSuccess || per_cu < 1) { fprintf(stderr, "kernel_launch: occupancy query says %d\n", per_cu); }
        (void)hipGetLastError();
        grid = cus > 0 ? cus : 256;
        if (grid > 256) grid = 256;
    }
    if (grid < 0) return;
    (void)hipMemsetAsync((char*)d_ws + WS_CTL, 0, CTL_ZERO_BYTES, stream);
    Args a{};
    for (int i = 0; i < 36; ++i) a.in[i] = (const float*)d_in[i];
    a.out = (float*)d_out; a.ws = (unsigned char*)d_ws;
#if ML
    for (int p = 0; p < PH_COUNT; ++p) { a.ph_lo = p; a.ph_hi = p + 1; hipLaunchKernelGGL(mega, dim3(grid), dim3(NTHR), LDS_BYTES, stream, a); }
#else
    a.ph_lo = 0; a.ph_hi = PH_COUNT;
    hipLaunchKernelGGL(mega, dim3(grid), dim3(NTHR), LDS_BYTES, stream, a);
#endif
}
```

```cpp
#include <hip/hip_runtime.h>
#include <cstdio>
#include <cstdint>

#ifndef MS
#define MS 3
#endif

#define GAS __attribute__((address_space(1)))
#define LAS __attribute__((address_space(3)))
typedef unsigned short bf16;
typedef unsigned v4u __attribute__((ext_vector_type(4)));
typedef unsigned v2u __attribute__((ext_vector_type(2)));
typedef float f32x4 __attribute__((ext_vector_type(4)));
typedef float f32x2 __attribute__((ext_vector_type(2)));
typedef short bf16x8 __attribute__((ext_vector_type(8)));
#define LDS_WAIT() asm volatile("s_waitcnt lgkmcnt(0)" ::: "memory")
#define VM_WAIT() asm volatile("s_waitcnt vmcnt(0)" ::: "memory")

constexpr int D = 1024, NB = 4, SEQ = 8192, CTXL = 256, GRIDW = 64, GRIDH = 128;
constexpr int NLAT = NB * SEQ, NCTX = NB * CTXL, MR = NLAT + NCTX;
constexpr int RWW = 512, RWH = 8, HD = 64;
constexpr int C_R = 0, C_K = 512, C_V = 1024, C_PW = 1536, C_PA = 1568, C_PG = 1600, C_Q = 1696, C_KG = 1952, C_VG = 2208, C_PGL = 2720, C_OG = 2736, C_GRW = 3248, C_GGLA = 4272;
constexpr int IN_COLS = 5296, NP = 5376;
constexpr int NE = 256, TOPK = 8, FF = 256;
constexpr float LN_EPS = 1e-5f, RW_GN_EPS = 64e-5f;
constexpr float ALPHA = 1.189207115f;
constexpr float W8S = 64.0f, W8I = 1.0f / 64.0f;
constexpr int NLORA = 3072, KLORA = 256;
constexpr int MAXTILES = 1280, SH_ROW0 = MAXTILES * 256, NROWS_E = SH_ROW0 + NLAT;

namespace pg8 {
#define PG8_LAS __attribute__((address_space(3)))
typedef unsigned short bf16_t;
typedef unsigned u32x4 __attribute__((ext_vector_type(4)));
typedef unsigned u32x2 __attribute__((ext_vector_type(2)));
typedef long i64x2 __attribute__((ext_vector_type(2)));
constexpr int BM = 256, BK = 64, HALF = 128, HTB = HALF * BK * 2, STAGE_BYTES = 8 * HTB, NXCD = 8, WGM = 8;
constexpr int IDX_OFF = STAGE_BYTES, IDX_UNITS = 12;

__host__ __device__ __forceinline__ int lds_byte(int r, int c) { const int st = (r >> 4) * 2 + (c >> 5), rr = r & 15, cc = c & 31, ob = rr * 64 + cc * 2; return st * 1024 + (ob ^ (((ob >> 9) & 1) << 5)); }
__host__ __device__ __forceinline__ void stage_rc(int b, int& R, int& C) { const int st = b / 1024, sb = b % 1024, swz = sb ^ (((sb >> 9) & 1) << 5); R = (st >> 1) * 16 + swz / 64; C = (st & 1) * 32 + (swz % 64) / 2; }
__host__ __device__ __forceinline__ int perm32(int rho) { const int n = rho >> 4, i = rho & 15; return 8 * (i >> 2) + 4 * n + (i & 3); }

struct Unit { int pm, pn, e, j; };
struct Gemm { const bf16_t* A; const bf16_t* Bt; int M, N, K; const int* rowidx; };

struct StaticOrder {
    int nM, nN, nwg, G, c;
    __host__ __device__ void init(int M, int N, int G_, int c_) { nM = M / BM; nN = N / BM; nwg = nM * nN; G = G_; c = c_; }
    __host__ __device__ bool next(int i, Unit& u) const {
        const long L = (long)i * G + c; if (L >= nwg) return false;
        int wgid = (int)L; { const int q = nwg / NXCD, r = nwg % NXCD, xcd = wgid % NXCD, off = wgid / NXCD; wgid = (xcd < r ? xcd * (q + 1) : r * (q + 1) + (xcd - r) * q) + off; }
        const int nig = WGM * nN, gid = wgid / nig, fm = gid * WGM, gsz = (nM - fm) < WGM ? (nM - fm) : WGM;
        u.pm = fm + ((wgid % nig) % gsz); u.pn = (wgid % nig) / gsz; u.e = 0; u.j = u.pn; return true;
    }
};
struct MoeOrder {
    int nN, G, c, NT; const int* tile_e;
    __device__ bool next(int i, Unit& u) const {
        int tile, j;
        if (G == 256) { const int x = c & 7, y = c >> 3; tile = i * (256 / nN) + x * (32 / nN) + y / nN; j = y % nN; if (tile >= NT + NLAT / 256) return false; }
        else { const int L = i * G + c; if (L >= (NT + NLAT / 256) * nN) return false; tile = L / nN; j = L - tile * nN; }
        int e, pm;
        if (tile < NT) { e = tile_e[tile]; pm = tile; } else { e = NE; pm = MAXTILES + (tile - NT); }
        u.pm = pm; u.pn = e * nN + j; u.e = e; u.j = j; return true;
    }
};

typedef __bf16 bf16x2n __attribute__((ext_vector_type(2))); typedef float f32x2n __attribute__((ext_vector_type(2)));
__device__ __forceinline__ unsigned cvt_pk_bf16(float lo, float hi) { const f32x2n v = {lo, hi}; return __builtin_bit_cast(unsigned, __builtin_convertvector(v, bf16x2n)); }

template <class Epi, class Sched, bool ALIGN_EPI, bool SP2, bool GATHER, bool FP8 = false>
__device__ __forceinline__ void gemm_phase(PG8_LAS unsigned char* lds, const Gemm g, const Sched& S, const Epi& E) {
    const int tid = threadIdx.x, wid = __builtin_amdgcn_readfirstlane(tid >> 6), lane = tid & 63, wr = wid >> 2, wc = wid & 3, fr = lane & 15, fq = lane >> 4;
    const int K = g.K, nt = K / BK;
    const size_t kstep = (size_t)(BK * 2);
    const size_t hstep = (size_t)HALF * K * 2;
    const size_t tstep = 2 * hstep;
    unsigned voffB[2]; unsigned va[2][2];
#pragma unroll
    for (int i = 0; i < 2; ++i) { int R, C; stage_rc(tid * 16 + i * 8192, R, C); const int Rb = Epi::PERM ? ((R & ~31) + perm32(R & 31)) : R;
        voffB[i] = (unsigned)(Rb * K + C) * 2u;
        va[0][i] = (unsigned)(R * K + C) * 2u; va[1][i] = va[0][i]; }
    const size_t ah = GATHER ? (size_t)0 : hstep;
#define PG8_GOFF(dst, ub) do { _Pragma("unroll") for (int _h = 0; _h < 2; ++_h) _Pragma("unroll") for (int _i = 0; _i < 2; ++_i) { int _R, _C; stage_rc(tid * 16 + _i * 8192, _R, _C); \
        dst[_h][_i] = (unsigned)(idxt[(ub) * 256 + _h * 128 + _R] * K + _C) * 2u; } } while (0)
    const unsigned ldsw = (unsigned)wid * 1024u;
    const int aoff = lds_byte(wr * 64 + fr, fq * 8), boff = lds_byte(wc * 32 + fr, fq * 8);
    PG8_LAS int* idxt = (PG8_LAS int*)(lds + IDX_OFF);
#define PG8_SA(b, h) (((b) * 2 + (h)) * HTB)
#define PG8_SB(b, h) ((4 + (b) * 2 + (h)) * HTB)
#define PG8_STAGE(bufoff, gbase, voff) do { _Pragma("unroll") for (int _i = 0; _i < 2; ++_i) \
        __builtin_amdgcn_global_load_lds((const unsigned*)((const char*)(gbase) + (voff)[_i]), (PG8_LAS unsigned*)(lds + (bufoff) + ldsw + _i * 8192), 16, 0, 0); } while (0)
#define PG8_LDA(dst, b, h) do { _Pragma("unroll") for (int m = 0; m < 4; ++m) _Pragma("unroll") for (int k = 0; k < 2; ++k) dst[m][k] = *(const PG8_LAS bf16x8*)(lds + PG8_SA(b, h) + aoff + m * 2048 + k * 1024); } while (0)
#define PG8_LDB(dst, b, h) do { _Pragma("unroll") for (int n = 0; n < 2; ++n) _Pragma("unroll") for (int k = 0; k < 2; ++k) dst[n][k] = *(const PG8_LAS bf16x8*)(lds + PG8_SB(b, h) + boff + n * 2048 + k * 1024); } while (0)
#define PG8_MMA(ai, bj, At, Bt) do { __builtin_amdgcn_s_setprio(1); _Pragma("unroll") for (int m = 0; m < 4; ++m) _Pragma("unroll") for (int n = 0; n < 2; ++n) _Pragma("unroll") for (int k = 0; k < 2; ++k) { \
        if constexpr (FP8) { const i64x2 _b = __builtin_bit_cast(i64x2, Bt[n][k]), _a = __builtin_bit_cast(i64x2, At[m][k]); \
            acc[ai][bj][m][n] = __builtin_amdgcn_mfma_f32_16x16x32_fp8_fp8(_b[0], _a[0], acc[ai][bj][m][n], 0, 0, 0); acc[ai][bj][m][n] = __builtin_amdgcn_mfma_f32_16x16x32_fp8_fp8(_b[1], _a[1], acc[ai][bj][m][n], 0, 0, 0); } \
        else acc[ai][bj][m][n] = __builtin_amdgcn_mfma_f32_16x16x32_bf16(Bt[n][k], At[m][k], acc[ai][bj][m][n], 0, 0, 0); } __builtin_amdgcn_s_setprio(0); } while (0)
#define PG8_WAIT_V(n) asm volatile("s_waitcnt vmcnt(" #n ")" ::: "memory")
#define PG8_WAIT_L(n) asm volatile("s_waitcnt lgkmcnt(" #n ")" ::: "memory")
#define PG8_BAR __builtin_amdgcn_s_barrier()
#define PG8_SCHED __builtin_amdgcn_sched_barrier(0)
    Unit cur, nxt; int ui = 0;
    if (!S.next(0, cur)) return;
#ifdef GEMM_STAGGER
    if constexpr (FP8) {
        const unsigned long long t0 = __builtin_amdgcn_s_memrealtime(); const unsigned long long dl = (unsigned long long)(blockIdx.x & 3) * GEMM_STAGGER;
        while (__builtin_amdgcn_s_memrealtime() - t0 < dl) __builtin_amdgcn_s_sleep(8);
    }
#endif
    if constexpr (GATHER) {
        Unit uu;
        for (int i = 0; i < IDX_UNITS; ++i) { if (!S.next(i, uu)) break; if (tid < 256) idxt[i * 256 + tid] = g.rowidx[(size_t)uu.pm * 256 + tid]; }
        asm volatile("s_waitcnt vmcnt(0) lgkmcnt(0)" ::: "memory"); PG8_BAR; asm volatile("" ::: "memory");
        PG8_GOFF(va, 0);
    }
    f32x4 acc[2][2][4][2];
#pragma unroll
    for (int a = 0; a < 2; ++a)
#pragma unroll
        for (int b = 0; b < 2; ++b)
#pragma unroll
            for (int m = 0; m < 4; ++m)
#pragma unroll
                for (int n = 0; n < 2; ++n) acc[a][b][m][n] = (f32x4){0.f, 0.f, 0.f, 0.f};
    bf16x8 At[4][2], B0[2][2], B1[2][2];
    const char* cA = (const char*)g.A + (GATHER ? (size_t)0 : (size_t)cur.pm * tstep); const char* cB = (const char*)g.Bt + (size_t)cur.pn * tstep;
    if constexpr (SP2) {
        PG8_STAGE(PG8_SB(0, 0), cB, voffB); PG8_STAGE(PG8_SB(0, 1), cB + hstep, voffB); PG8_STAGE(PG8_SA(0, 0), cA, va[0]); PG8_STAGE(PG8_SA(0, 1), cA + ah, va[1]);
        if (wr == 1) PG8_BAR;
        PG8_WAIT_V(2); PG8_BAR;
        PG8_STAGE(PG8_SB(1, 0), cB + kstep, voffB); PG8_STAGE(PG8_SA(1, 0), cA + kstep, va[0]); PG8_STAGE(PG8_SB(1, 1), cB + hstep + kstep, voffB);
        PG8_WAIT_V(6); PG8_BAR;
    } else {
        PG8_STAGE(PG8_SB(0, 0), cB, voffB); PG8_STAGE(PG8_SA(0, 0), cA, va[0]); PG8_STAGE(PG8_SB(0, 1), cB + hstep, voffB); PG8_STAGE(PG8_SA(0, 1), cA + ah, va[1]);
        if (wr == 1) PG8_BAR;
        PG8_WAIT_V(4); PG8_BAR;
        PG8_STAGE(PG8_SB(1, 0), cB + kstep, voffB); PG8_STAGE(PG8_SA(1, 0), cA + kstep, va[0]); PG8_STAGE(PG8_SB(1, 1), cB + hstep + kstep, voffB);
        PG8_WAIT_V(6); PG8_BAR;
    }
    for (;;) {
        const bool has_next = S.next(ui + 1, nxt);
        const char* nA = has_next ? (const char*)g.A + (GATHER ? (size_t)0 : (size_t)nxt.pm * tstep) : cA; const char* nB = has_next ? (const char*)g.Bt + (size_t)nxt.pn * tstep : cB;
        const int ubn = (has_next && ui + 1 < IDX_UNITS) ? (ui + 1) : ui;
#pragma unroll 1
        for (int t = 0; t < nt; t += 2) {
            const bool last = (t == nt - 2);
            const char* a1 = cA + (size_t)(t + 1) * kstep;
            const char* a2 = last ? nA : cA + (size_t)(t + 2) * kstep; const char* b2 = last ? nB : cB + (size_t)(t + 2) * kstep;
            const char* a3 = a2 + kstep; const char* b3 = b2 + kstep;
            unsigned v2[2][2];
#pragma unroll
            for (int h = 0; h < 2; ++h)
#pragma unroll
                for (int i = 0; i < 2; ++i) v2[h][i] = va[h][i];
            if constexpr (GATHER) { if (last) PG8_GOFF(v2, ubn); }
            if constexpr (SP2) {
            PG8_LDB(B0, 0, 0); PG8_LDB(B1, 0, 1); PG8_SCHED; PG8_LDA(At, 0, 0); PG8_STAGE(PG8_SA(1, 1), a1 + ah, va[1]);
            PG8_WAIT_V(8); PG8_WAIT_L(0); PG8_BAR; PG8_MMA(0, 0, At, B0); PG8_MMA(0, 1, At, B1); PG8_BAR; PG8_SCHED;
            PG8_LDA(At, 0, 1); PG8_STAGE(PG8_SB(0, 0), b2, voffB); PG8_STAGE(PG8_SB(0, 1), b2 + hstep, voffB); PG8_STAGE(PG8_SA(0, 0), a2, v2[0]);
            PG8_WAIT_V(8); PG8_WAIT_L(0); PG8_BAR; PG8_MMA(1, 0, At, B0); PG8_MMA(1, 1, At, B1); PG8_BAR; PG8_SCHED;
            PG8_LDB(B0, 1, 0); PG8_LDB(B1, 1, 1); PG8_SCHED; PG8_LDA(At, 1, 0); PG8_STAGE(PG8_SA(0, 1), a2 + ah, v2[1]);
            PG8_WAIT_V(8); PG8_WAIT_L(0); PG8_BAR; PG8_MMA(0, 0, At, B0); PG8_MMA(0, 1, At, B1); PG8_BAR; PG8_SCHED;
            PG8_LDA(At, 1, 1); PG8_STAGE(PG8_SB(1, 0), b3, voffB); PG8_STAGE(PG8_SB(1, 1), b3 + hstep, voffB); PG8_STAGE(PG8_SA(1, 0), a3, v2[0]);
            PG8_WAIT_V(8); PG8_WAIT_L(0); PG8_BAR; PG8_MMA(1, 0, At, B0); PG8_MMA(1, 1, At, B1); PG8_BAR; PG8_SCHED;
            } else {
            PG8_LDB(B0, 0, 0); PG8_SCHED; PG8_LDA(At, 0, 0); PG8_STAGE(PG8_SA(1, 1), a1 + ah, va[1]);
            PG8_WAIT_L(8); PG8_BAR; PG8_WAIT_L(0); PG8_MMA(0, 0, At, B0); PG8_BAR; PG8_SCHED;
            PG8_LDB(B1, 0, 1); PG8_STAGE(PG8_SB(0, 0), b2, voffB);
            PG8_BAR; PG8_WAIT_L(0); PG8_MMA(0, 1, At, B1); PG8_BAR;
            PG8_LDA(At, 0, 1); PG8_STAGE(PG8_SA(0, 0), a2, v2[0]);
            PG8_BAR; PG8_WAIT_L(0); PG8_MMA(1, 0, At, B0); PG8_BAR; PG8_SCHED;
            PG8_STAGE(PG8_SB(0, 1), b2 + hstep, voffB);
            PG8_WAIT_V(6); PG8_BAR; PG8_MMA(1, 1, At, B1); PG8_BAR;
            PG8_LDB(B0, 1, 0); PG8_SCHED; PG8_LDA(At, 1, 0); PG8_STAGE(PG8_SA(0, 1), a2 + ah, v2[1]);
            PG8_WAIT_L(8); PG8_BAR; PG8_WAIT_L(0); PG8_MMA(0, 0, At, B0); PG8_BAR; PG8_SCHED;
            PG8_LDB(B1, 1, 1); PG8_STAGE(PG8_SB(1, 0), b3, voffB);
            PG8_BAR; PG8_WAIT_L(0); PG8_MMA(0, 1, At, B1); PG8_BAR;
            PG8_LDA(At, 1, 1); PG8_STAGE(PG8_SA(1, 0), a3, v2[0]);
            PG8_BAR; PG8_WAIT_L(0); PG8_MMA(1, 0, At, B0); PG8_BAR; PG8_SCHED;
            PG8_STAGE(PG8_SB(1, 1), b3 + hstep, voffB);
            PG8_WAIT_V(6); PG8_BAR; PG8_MMA(1, 1, At, B1); PG8_BAR;
            }
        }
        if constexpr (ALIGN_EPI) { if (wr == 0) PG8_BAR; }
        E(acc, cur, wr, wc, fr, fq);
        if (!has_next) break;
#pragma unroll
        for (int a = 0; a < 2; ++a)
#pragma unroll
            for (int b = 0; b < 2; ++b)
#pragma unroll
                for (int m = 0; m < 4; ++m)
#pragma unroll
                    for (int n = 0; n < 2; ++n) acc[a][b][m][n] = (f32x4){0.f, 0.f, 0.f, 0.f};
        cur = nxt; cA = nA; cB = nB; ++ui;
        if constexpr (GATHER) PG8_GOFF(va, ubn);
        if constexpr (ALIGN_EPI) { if (wr == 1) PG8_BAR; }
    }
    PG8_WAIT_V(0);
    if constexpr (!ALIGN_EPI) { if (wr == 0) PG8_BAR; }
    PG8_BAR;
#undef PG8_SA
#undef PG8_GOFF
#undef PG8_SB
#undef PG8_STAGE
#undef PG8_LDA
#undef PG8_LDB
#undef PG8_MMA
#undef PG8_WAIT_V
#undef PG8_WAIT_L
#undef PG8_BAR
#undef PG8_SCHED
}
}

#define XB_TMO      128
#define XB_XCNT(j)  (256  + 64 * (j))
#define XB_XSUB(j)  (1280 + 64 * (j))
#define XB_XGEN(j)  (2304 + 64 * (j))
#define XB_TOP      3328
#define XB_TOPGEN   3392
#define XCD_BAR_WORDS 3456
#define XB_SPIN_CAP (1u << 18)
__device__ __forceinline__ unsigned xb_ld(unsigned* p)              { return __hip_atomic_load(p, __ATOMIC_RELAXED, __HIP_MEMORY_SCOPE_AGENT); }
__device__ __forceinline__ unsigned xb_add(unsigned* p, unsigned v) { return __hip_atomic_fetch_add(p, v, __ATOMIC_RELAXED, __HIP_MEMORY_SCOPE_AGENT); }
__device__ __forceinline__ unsigned xb_xcc_id() { return (unsigned)__builtin_amdgcn_s_getreg((3 << 11) | 20) & 0xFu; }
#define XB_SPIN(cond, bar) do { unsigned _sp = 0; while (cond) { __builtin_amdgcn_s_sleep(1); \
    if ((++_sp & 255u) == 0u) { if (xb_ld(&(bar)[XB_TMO])) break; if (_sp > XB_SPIN_CAP) { atomicAdd(&(bar)[XB_TMO], 1u); break; } } } } while (0)
struct XcdBarrier { unsigned* bar; unsigned x; volatile LAS unsigned* st; };
__device__ __forceinline__ XcdBarrier xcd_barrier_post(unsigned* bar, volatile LAS unsigned* st) {
    XcdBarrier b; b.bar = bar; b.x = xb_xcc_id(); b.st = st;
    if (threadIdx.x == 0) (void)xb_add(&bar[XB_XCNT(b.x)], 1u);
    return b;
}
__device__ __forceinline__ void xcd_barrier_complete(unsigned* bar, unsigned x, unsigned& nloc, unsigned& nx) {
    const unsigned G = gridDim.x * gridDim.y * gridDim.z;
    unsigned sum, cnt, mine, sp = 0u;
    for (;;) {
        sum = 0u; cnt = 0u; mine = 0u;
#pragma unroll
        for (unsigned j = 0; j < 16; ++j) { const unsigned c = xb_ld(&bar[XB_XCNT(j)]); sum += c; cnt += (c > 0u) ? 1u : 0u; mine = (j == x) ? c : mine; }
        if (sum == G) break;
        __builtin_amdgcn_s_sleep(1);
        if ((++sp & 255u) == 0u) { if (xb_ld(&bar[XB_TMO])) break; if (sp > XB_SPIN_CAP) { atomicAdd(&bar[XB_TMO], 1u); break; } }
    }
    nloc = mine > 0u ? mine : 1u; nx = cnt > 0u ? cnt : 1u;
}
__device__ __forceinline__ void xcd_barrier(const XcdBarrier& b) {
    asm volatile("s_waitcnt vmcnt(0)" ::: "memory");
    __syncthreads();
    if (threadIdx.x == 0) {
        unsigned* bar = b.bar;
        __builtin_amdgcn_s_waitcnt(0);
        unsigned nloc = b.st[0], nx = b.st[1];
        if (nloc == 0u) { xcd_barrier_complete(bar, b.x, nloc, nx); b.st[0] = nloc; b.st[1] = nx; }
        const unsigned old = xb_add(&bar[XB_XSUB(b.x)], 1u);
        const unsigned gen = old / nloc;
        if (old + 1u == (gen + 1u) * nloc) {
            __builtin_amdgcn_fence(__ATOMIC_RELEASE, "agent");
            asm volatile("s_waitcnt vmcnt(0)" ::: "memory");
            const unsigned og = xb_add(&bar[XB_TOP], 1u);
            const unsigned tg = og / nx;
            if (og + 1u == (tg + 1u) * nx) xb_add(&bar[XB_TOPGEN], 1u);
            else XB_SPIN(xb_ld(&bar[XB_TOPGEN]) == tg, bar);
            __builtin_amdgcn_fence(__ATOMIC_ACQUIRE, "agent");
            xb_add(&bar[XB_XGEN(b.x)], 1u);
            asm volatile("s_waitcnt vmcnt(0)" ::: "memory");
        } else {
            XB_SPIN(xb_ld(&bar[XB_XGEN(b.x)]) == gen, bar);
            __builtin_amdgcn_fence(__ATOMIC_ACQUIRE, "agent");
            asm volatile("s_waitcnt vmcnt(0)" ::: "memory");
        }
    }
    __syncthreads();
}

constexpr size_t MiB = 1u << 20;
constexpr size_t al(size_t x) { return (x + 4095) & ~(size_t)4095; }
constexpr size_t WS_CTL = 0, CTL_ZERO_BYTES = 1 * MiB;
constexpr int CW_BAR = 4096;
constexpr int CW_CNT = 16384, CNT_STRIDE = 64;
constexpr int CW_NT = CW_CNT + NE * CNT_STRIDE + 64;
static_assert((CW_NT + 1) * 4 <= (int)CTL_ZERO_BYTES, "control words inside the per-call memset");
constexpr size_t WS_MOD = 1 * MiB;
constexpr size_t WS_TILE_E = WS_MOD + 256 * 1024;
constexpr size_t WS_PADSTART = WS_TILE_E + 16 * 1024;
constexpr size_t WS_ROWTOK = 2 * MiB;
constexpr size_t WS_EIDX = 4 * MiB;
constexpr size_t WS_GATE = 5 * MiB;
constexpr size_t WS_DEST = 6 * MiB;
constexpr size_t WS_WIN = 8 * MiB;
constexpr size_t WS_WLORA = WS_WIN + al((size_t)NP * D * 2);
constexpr size_t WS_WBRRW = WS_WLORA + al((size_t)NLORA * KLORA * 2);
constexpr size_t WS_WBRGLA = WS_WBRRW + al((size_t)D * RWW * 2);
constexpr size_t WS_WOUT = WS_WBRGLA + al((size_t)D * RWW * 2);
constexpr size_t WS_WROUTER = WS_WOUT + al((size_t)D * D * 2);
constexpr size_t WS_WGU = WS_WROUTER + al((size_t)NE * D * 2);
constexpr size_t WS_WD = WS_WGU + al((size_t)(NE + 1) * 512 * D * 2);
constexpr size_t WS_PERSIST_END = WS_WD + al((size_t)(NE + 1) * D * FF * 2);
constexpr size_t WS_REGB = WS_PERSIST_END;
constexpr size_t SZ512F = al((size_t)MR * RWW * 4), SZ256F = al((size_t)MR * 256 * 4), SZ512H = al((size_t)MR * RWW * 2);
constexpr size_t WS_A1 = WS_REGB;
constexpr size_t WS_A2 = WS_A1;
constexpr size_t WS_KSUM = WS_A2 + al((size_t)MR * KLORA * 2);
static_assert(WS_KSUM + SZ512H <= WS_A1 + al((size_t)MR * D * 2), "A2 + KSUM fit in the A1 slot");
constexpr size_t WS_P = WS_A1 + al((size_t)MR * D * 2);
constexpr size_t WS_RB = WS_P + al((size_t)MR * NP * 2);
constexpr size_t WS_VB = WS_RB + SZ512H, WS_KKB = WS_VB + SZ512H, WS_KMF = WS_KKB + SZ512H, WS_KMB = WS_KMF + SZ512H, WS_BVF = WS_KMB + SZ512H, WS_BVB = WS_BVF + SZ512H;
constexpr size_t WS_LWF = WS_BVB + SZ512H, WS_LWB = WS_LWF + SZ512F;
constexpr size_t SZ256H = al((size_t)MR * 256 * 2);
constexpr size_t WS_QGB = WS_LWB + SZ512F, WS_KGB = WS_QGB + SZ256H, WS_VGB = WS_KGB + SZ256H, WS_LAF = WS_VGB + SZ512H, WS_LAB = WS_LAF + SZ256F;
constexpr size_t WS_RWG = WS_LAB + SZ256F;
constexpr size_t WS_ORWF = WS_RWG + SZ512H, WS_ORWB = WS_ORWF + SZ512H, WS_OGLF = WS_ORWB + SZ512H, WS_OGLB = WS_OGLF + SZ512H;
constexpr int CH = 64, NCHUNK = (CTXL + SEQ) / CH, NU_RW = 64 * NCHUNK, NU_GL = 32 * NCHUNK;
constexpr size_t WS_RH = WS_OGLB + SZ512H;
constexpr size_t WS_YL = WS_RH + al((size_t)NU_RW * 4096 * 2);
constexpr size_t WS_HH = WS_YL + al((size_t)NU_RW * 4096 * 2);
constexpr size_t WS_INTRA = WS_HH + al((size_t)NU_RW * 4096 * 2);
constexpr size_t WS_KV = WS_INTRA + al((size_t)NU_GL * 8192 * 2);
constexpr size_t WS_DD = WS_KV + al((size_t)NU_GL * 8192 * 2);
constexpr size_t WS_END_MIX = WS_DD + al((size_t)NU_GL * 64 * 4);
constexpr size_t OUT_GT = 0, OUT_QE = (size_t)NU_RW * 4096 * 2;
static_assert(OUT_QE + (size_t)NU_GL * 4096 * 2 <= (size_t)NLAT * D * 4, "scan scratch fits in d_out");
constexpr size_t WS_YRW = WS_LWF, WS_YGLA = WS_LWB, WS_Z = WS_HH;
static_assert((size_t)NLAT * D * 2 <= (size_t)NU_RW * 4096 * 2, "Z fits in the HH slot");
constexpr size_t WS_X1 = WS_REGB;
constexpr size_t WS_A3 = WS_X1 + al((size_t)NLAT * D * 4);
constexpr size_t WS_LOGITS = WS_A3 + al((size_t)NLAT * D * 2);
constexpr size_t WS_ACT = WS_LOGITS + al((size_t)NLAT * NE * 4);
constexpr size_t WS_Y = WS_ACT + al((size_t)NROWS_E * FF * 2);
constexpr size_t WS_A3F = WS_Y + al((size_t)NROWS_E * D);
constexpr size_t WS_END_MOE = WS_A3F + al((size_t)NLAT * D);
constexpr size_t WS_END = WS_END_MIX > WS_END_MOE ? WS_END_MIX : WS_END_MOE;
static_assert(WS_END <= (size_t)2048 * MiB, "workspace map exceeds 2 GiB");

constexpr int RING_BYTES = 131072;
constexpr int IDX_BYTES = pg8::IDX_UNITS * 256 * 4;
constexpr int MISC_OFF = RING_BYTES + IDX_BYTES;
constexpr int S2_SF_OFF = MISC_OFF + 256;
constexpr int LDS_BYTES = S2_SF_OFF + 8192;
static_assert(pg8::IDX_OFF == RING_BYTES, "gather table sits right above the stage buffers");
constexpr int NWAVES = 8, NTHR = 512;

struct Args { const float* in[36]; float* out; unsigned char* ws; int ph_lo, ph_hi; };

struct Frame {
    LAS unsigned char* lds;
    int tid, lane, wave, G, gw, NGW;
    const float* const* in; float* out; unsigned char* ws; unsigned* ctl;
};

__device__ __forceinline__ float wave_sum(float v) {
#pragma unroll
    for (int o = 1; o < 64; o <<= 1) v += __shfl_xor(v, o);
    return v;
}
__device__ __forceinline__ unsigned f2bf(float f) { unsigned u = __builtin_bit_cast(unsigned, f); return (u + 0x7fffu + ((u >> 16) & 1u)) >> 16; }
typedef __bf16 bf16x2v __attribute__((ext_vector_type(2)));
__device__ __forceinline__ unsigned pk2(float lo, float hi) { const f32x2 v = {lo, hi}; return __builtin_bit_cast(unsigned, __builtin_convertvector(v, bf16x2v)); }
__device__ __forceinline__ float bflo(unsigned w) { return __builtin_bit_cast(float, w << 16); }
__device__ __forceinline__ float bfhi(unsigned w) { return __builtin_bit_cast(float, w & 0xffff0000u); }
__device__ __forceinline__ float sigmoidf_(float x) { return __builtin_amdgcn_rcpf(1.0f + __expf(-x)); }
__device__ __forceinline__ float siluf_(float x) { return x * __builtin_amdgcn_rcpf(1.0f + __expf(-x)); }
__device__ __forceinline__ float tanhf_(float x) { return 1.0f - 2.0f * __builtin_amdgcn_rcpf(1.0f + __expf(2.0f * x)); }
__device__ __forceinline__ float logsigmoidf_(float x) { return fminf(x, 0.f) - __logf(1.0f + __expf(-fabsf(x))); }

__device__ __forceinline__ void ln_stats(const f32x4 (&v)[4], float& mean, float& rstd) {
    float s = 0.f;
#pragma unroll
    for (int j = 0; j < 4; ++j) s += (v[j].x + v[j].y) + (v[j].z + v[j].w);
    mean = wave_sum(s) * (1.f / D); float s2 = 0.f;
#pragma unroll
    for (int j = 0; j < 4; ++j) { const f32x4 d = v[j] - mean; s2 += (d.x * d.x + d.y * d.y) + (d.z * d.z + d.w * d.w); }
    rstd = __builtin_amdgcn_rsqf(wave_sum(s2) * (1.f / D) + LN_EPS);
}

__device__ __forceinline__ unsigned pack_fp8x4(const f32x4 v) {
    int w = __builtin_amdgcn_cvt_pk_fp8_f32(__builtin_amdgcn_fmed3f(v[0], -448.f, 448.f), __builtin_amdgcn_fmed3f(v[1], -448.f, 448.f), 0, false);
    return (unsigned)__builtin_amdgcn_cvt_pk_fp8_f32(__builtin_amdgcn_fmed3f(v[2], -448.f, 448.f), __builtin_amdgcn_fmed3f(v[3], -448.f, 448.f), w, true); }
__device__ __forceinline__ void ld_row_bf16(const bf16* row, int lane, f32x4 (&v)[4]) {
    const v4u a = *(const v4u*)(row + 8 * lane), b = *(const v4u*)(row + 512 + 8 * lane);
    v[0] = (f32x4){bflo(a.x), bfhi(a.x), bflo(a.y), bfhi(a.y)}; v[1] = (f32x4){bflo(a.z), bfhi(a.z), bflo(a.w), bfhi(a.w)};
    v[2] = (f32x4){bflo(b.x), bfhi(b.x), bflo(b.y), bfhi(b.y)}; v[3] = (f32x4){bflo(b.z), bfhi(b.z), bflo(b.w), bfhi(b.w)};
}
__device__ __forceinline__ int rowcol(int lane, int j) { return 512 * (j >> 1) + 8 * lane + 4 * (j & 1); }
__device__ __forceinline__ void ph_x1pre_nomix(Frame& F) {
    const float* x = F.in[0];
    for (int m = F.gw; m < NLAT; m += F.NGW) {
        bf16* o = (bf16*)(F.ws + WS_X1) + (size_t)m * D;
#pragma unroll
        for (int h = 0; h < 2; ++h) { const float* xr = x + (size_t)m * D + 512 * h + 8 * F.lane; const f32x4 a = *(const f32x4*)xr * ALPHA, b = *(const f32x4*)(xr + 4) * ALPHA;
            v4u w; w.x = pk2(a.x, a.y); w.y = pk2(a.z, a.w); w.z = pk2(b.x, b.y); w.w = pk2(b.z, b.w); *(v4u*)(o + 512 * h + 8 * F.lane) = w; }
    }
}
__device__ __forceinline__ void ph_ln1(Frame& F) {
    const float* lw = F.in[26]; const float* lb = F.in[27]; const float* mod = (const float*)(F.ws + WS_MOD);
    bf16* A3 = (bf16*)(F.ws + WS_A3); const bf16* X1P = (const bf16*)(F.ws + WS_X1);
    constexpr int NR = 4;
    for (int m0 = F.gw; m0 < NLAT; m0 += NR * F.NGW) {
        v4u w[NR][2];
#pragma unroll
        for (int r = 0; r < NR; ++r) { const int mm = m0 + r * F.NGW; const bf16* row = X1P + (size_t)(mm < NLAT ? mm : m0) * D; w[r][0] = *(const v4u*)(row + 8 * F.lane); w[r][1] = *(const v4u*)(row + 512 + 8 * F.lane); }
        __builtin_amdgcn_sched_barrier(0);
#pragma unroll
        for (int r = 0; r < NR; ++r) { const int mm = m0 + r * F.NGW; const int m = mm < NLAT ? mm : m0; const int b = m / SEQ;
            f32x4 v[4];
            v[0] = (f32x4){bflo(w[r][0].x), bfhi(w[r][0].x), bflo(w[r][0].y), bfhi(w[r][0].y)}; v[1] = (f32x4){bflo(w[r][0].z), bfhi(w[r][0].z), bflo(w[r][0].w), bfhi(w[r][0].w)};
            v[2] = (f32x4){bflo(w[r][1].x), bfhi(w[r][1].x), bflo(w[r][1].y), bfhi(w[r][1].y)}; v[3] = (f32x4){bflo(w[r][1].z), bfhi(w[r][1].z), bflo(w[r][1].w), bfhi(w[r][1].w)};
            float mean, rstd; ln_stats(v, mean, rstd);
#if MS >= 2
            f32x4 h[4];
#pragma unroll
            for (int j = 0; j < 4; ++j) { const int c = rowcol(F.lane, j);
                const f32x4 x1 = (v[j] - mean) * rstd * *(const f32x4*)(lw + c) + *(const f32x4*)(lb + c);
                h[j] = x1 * (*(const f32x4*)(mod + b * 6144 + 4096 + c) + 1.0f) + *(const f32x4*)(mod + b * 6144 + 3072 + c); }
            bf16* ao = A3 + (size_t)m * D;
            { v4u o; o.x = pk2(h[0].x, h[0].y); o.y = pk2(h[0].z, h[0].w); o.z = pk2(h[1].x, h[1].y); o.w = pk2(h[1].z, h[1].w); *(v4u*)(ao + 8 * F.lane) = o;
              o.x = pk2(h[2].x, h[2].y); o.y = pk2(h[2].z, h[2].w); o.z = pk2(h[3].x, h[3].y); o.w = pk2(h[3].z, h[3].w); *(v4u*)(ao + 512 + 8 * F.lane) = o; }
            { unsigned char* af = F.ws + WS_A3F + (size_t)m * D; v2u o8;
              o8.x = pack_fp8x4(h[0]); o8.y = pack_fp8x4(h[1]); *(v2u*)(af + 8 * F.lane) = o8; o8.x = pack_fp8x4(h[2]); o8.y = pack_fp8x4(h[3]); *(v2u*)(af + 512 + 8 * F.lane) = o8; }
#endif
        }
    }
}
__device__ __forceinline__ f32x4 fp8x4(unsigned w) { const f32x2 lo = __builtin_amdgcn_cvt_pk_f32_fp8((int)w, false), hi = __builtin_amdgcn_cvt_pk_f32_fp8((int)w, true); return (f32x4){lo.x, lo.y, hi.x, hi.y}; }
__device__ __forceinline__ void ph_final(Frame& F) {
    const float* lw = F.in[34]; const float* lb = F.in[35]; const float* mod = (const float*)(F.ws + WS_MOD);
    const float* lw1 = F.in[26]; const float* lb1 = F.in[27]; const bf16* X1P = (const bf16*)(F.ws + WS_X1);
    const unsigned char* Y = F.ws + WS_Y; const int* DEST = (const int*)(F.ws + WS_DEST); const float* GATE = (const float*)(F.ws + WS_GATE);
    const int c0 = 16 * F.lane;
    for (int m0 = F.gw; m0 < NLAT; m0 += 2 * F.NGW) {
        int mm[2]; mm[0] = m0; mm[1] = (m0 + F.NGW < NLAT) ? m0 + F.NGW : m0;
        v4u xw[2][2];
#if MS >= 2
        v4u dw[2][2]; f32x4 gw[2][2];
#pragma unroll
        for (int r = 0; r < 2; ++r) { dw[r][0] = *(const v4u*)(DEST + mm[r] * 8); dw[r][1] = *(const v4u*)(DEST + mm[r] * 8 + 4); gw[r][0] = *(const f32x4*)(GATE + mm[r] * 8); gw[r][1] = *(const f32x4*)(GATE + mm[r] * 8 + 4); }
#endif
#pragma unroll
        for (int r = 0; r < 2; ++r) { const bf16* row = X1P + (size_t)mm[r] * D + c0; xw[r][0] = *(const v4u*)row; xw[r][1] = *(const v4u*)(row + 8); }
#if MS >= 2
        v4u yw[2][TOPK + 1];
#pragma unroll
        for (int r = 0; r < 2; ++r) {
            int dr[TOPK]; dr[0] = (int)dw[r][0].x; dr[1] = (int)dw[r][0].y; dr[2] = (int)dw[r][0].z; dr[3] = (int)dw[r][0].w; dr[4] = (int)dw[r][1].x; dr[5] = (int)dw[r][1].y; dr[6] = (int)dw[r][1].z; dr[7] = (int)dw[r][1].w;
#pragma unroll
            for (int k = 0; k <= TOPK; ++k) yw[r][k] = *(const v4u*)(Y + (size_t)(k < TOPK ? dr[k < TOPK ? k : 0] : SH_ROW0 + mm[r]) * D + c0); }
        __builtin_amdgcn_sched_barrier(0);
#endif
#pragma unroll
        for (int r = 0; r < 2; ++r) { const int m = mm[r]; const int b = m / SEQ;
            f32x4 v[4];
            v[0] = (f32x4){bflo(xw[r][0].x), bfhi(xw[r][0].x), bflo(xw[r][0].y), bfhi(xw[r][0].y)}; v[1] = (f32x4){bflo(xw[r][0].z), bfhi(xw[r][0].z), bflo(xw[r][0].w), bfhi(xw[r][0].w)};
            v[2] = (f32x4){bflo(xw[r][1].x), bfhi(xw[r][1].x), bflo(xw[r][1].y), bfhi(xw[r][1].y)}; v[3] = (f32x4){bflo(xw[r][1].z), bfhi(xw[r][1].z), bflo(xw[r][1].w), bfhi(xw[r][1].w)};
            { float mean1, rstd1; ln_stats(v, mean1, rstd1);
#pragma unroll
              for (int j = 0; j < 4; ++j) { const int c = c0 + 4 * j; v[j] = ((v[j] - mean1) * rstd1 * *(const f32x4*)(lw1 + c) + *(const f32x4*)(lb1 + c)) * ALPHA; } }
#if MS >= 2
            const float gt[TOPK] = {gw[r][0].x * 0.0625f, gw[r][0].y * 0.0625f, gw[r][0].z * 0.0625f, gw[r][0].w * 0.0625f, gw[r][1].x * 0.0625f, gw[r][1].y * 0.0625f, gw[r][1].z * 0.0625f, gw[r][1].w * 0.0625f};
#pragma unroll
            for (int j = 0; j < 4; ++j) { const unsigned ws8 = j == 0 ? yw[r][TOPK].x : (j == 1 ? yw[r][TOPK].y : (j == 2 ? yw[r][TOPK].z : yw[r][TOPK].w));
                f32x4 mo = fp8x4(ws8) * 0.0625f;
#pragma unroll
                for (int k = 0; k < TOPK; ++k) { const unsigned wk = j == 0 ? yw[r][k].x : (j == 1 ? yw[r][k].y : (j == 2 ? yw[r][k].z : yw[r][k].w)); mo += fp8x4(wk) * gt[k]; }
                v[j] += *(const f32x4*)(mod + b * 6144 + 5120 + c0 + 4 * j) * mo; }
#endif
            float mean, rstd; ln_stats(v, mean, rstd);
            float* o = F.out + (size_t)m * D + c0;
#pragma unroll
            for (int j = 0; j < 4; ++j) { const int c = c0 + 4 * j; *(f32x4*)(o + 4 * j) = (v[j] - mean) * rstd * *(const f32x4*)(lw + c) + *(const f32x4*)(lb + c); }
        }
    }
}


#if MS >= 2
template <int MODE, bool FP8 = false>
__device__ __forceinline__ void cvt_item(const float* W, int Nsrc, int nblk, bf16* WT, int row_off, int dpitch, LAS float* scr, int item, int lane) {
    const int kb = item / nblk, nb = item - kb * nblk, k0 = 64 * kb, n0 = 32 * nb;
    const int nn = n0 + (lane & 31);
#pragma unroll 8
    for (int i = 0; i < 32; ++i) { const int kk = 2 * i + (lane >> 5); scr[kk * 33 + (lane & 31)] = (nn < Nsrc) ? W[(size_t)(k0 + kk) * Nsrc + nn] : 0.f; }
    LDS_WAIT(); asm volatile("" ::: "memory");
    const int c = lane & 7;
#pragma unroll
    for (int j = 0; j < 4; ++j) { const int n = (lane >> 3) + 8 * j; const LAS float* s = scr + (8 * c) * 33 + n;
        v4u o; o.x = pk2(s[0 * 33], s[1 * 33]); o.y = pk2(s[2 * 33], s[3 * 33]); o.z = pk2(s[4 * 33], s[5 * 33]); o.w = pk2(s[6 * 33], s[7 * 33]);
        const int ng = n0 + n; int dr = ng;
        if (MODE == 1) { const int i2 = ng & 255; dr = 8 * (i2 >> 2) + (i2 & 3) + ((ng >= 256) ? 4 : 0); }
        if constexpr (FP8) { v2u o8; o8.x = pack_fp8x4((f32x4){s[0 * 33], s[1 * 33], s[2 * 33], s[3 * 33]} * W8S); o8.y = pack_fp8x4((f32x4){s[4 * 33], s[5 * 33], s[6 * 33], s[7 * 33]} * W8S);
            *(v2u*)((unsigned char*)WT + (size_t)(row_off + dr) * dpitch + k0 + 8 * c) = o8; }
        else *(v4u*)(WT + (size_t)(row_off + dr) * dpitch + k0 + 8 * c) = o; }
    LDS_WAIT(); asm volatile("" ::: "memory");
}

template <int MODE>
__device__ __forceinline__ void cvt_item_reg(const float* W, int Nsrc, bf16* WT, int row_off, int dpitch, int k0, int n0, int lane) {
    const float* src = W + (size_t)k0 * Nsrc + n0 + 4 * lane;
    f32x4 v[32];
#pragma unroll
    for (int i = 0; i < 32; ++i) v[i] = __builtin_nontemporal_load((const f32x4*)(src + (size_t)i * Nsrc));
#pragma unroll
    for (int j = 0; j < 4; ++j) {
        const int ng = n0 + 4 * lane + j; int dr = ng;
        if (MODE == 1) { const int i2 = ng & 255; dr = 8 * (i2 >> 2) + (i2 & 3) + ((ng >= 256) ? 4 : 0); }
        v4u* dst = (v4u*)(WT + (size_t)(row_off + dr) * dpitch + k0);
#pragma unroll
        for (int q = 0; q < 4; ++q) { v4u o; o.x = pk2(v[8 * q][j], v[8 * q + 1][j]); o.y = pk2(v[8 * q + 2][j], v[8 * q + 3][j]); o.z = pk2(v[8 * q + 4][j], v[8 * q + 5][j]); o.w = pk2(v[8 * q + 6][j], v[8 * q + 7][j]); dst[q] = o; }
    }
}

constexpr int CVK = 32;
__device__ __forceinline__ void cvt_reg_load(const float* W, int Nsrc, int k0, int n0, int lane, f32x4 (&v)[CVK]) {
    const float* src = W + (size_t)k0 * Nsrc + n0 + 4 * lane;
#pragma unroll
    for (int i = 0; i < CVK; ++i) v[i] = __builtin_nontemporal_load((const f32x4*)(src + (size_t)i * Nsrc));
}
template <int MODE, bool FP8 = false>
__device__ __forceinline__ void cvt_reg_store(bf16* WT, int row_off, int dpitch, int k0, int n0, int lane, const f32x4 (&v)[CVK]) {
#pragma unroll
    for (int j = 0; j < 4; ++j) {
        const int ng = n0 + 4 * lane + j; int dr = ng;
        if (MODE == 1) { const int i2 = ng & 255; dr = 8 * (i2 >> 2) + (i2 & 3) + ((ng >= 256) ? 4 : 0); }
        if constexpr (FP8) { v4u* dst8 = (v4u*)((unsigned char*)WT + (size_t)(row_off + dr) * dpitch + k0);
#pragma unroll
            for (int q = 0; q < CVK / 16; ++q) { v4u o;
                o.x = pack_fp8x4((f32x4){v[16 * q][j], v[16 * q + 1][j], v[16 * q + 2][j], v[16 * q + 3][j]} * W8S); o.y = pack_fp8x4((f32x4){v[16 * q + 4][j], v[16 * q + 5][j], v[16 * q + 6][j], v[16 * q + 7][j]} * W8S);
                o.z = pack_fp8x4((f32x4){v[16 * q + 8][j], v[16 * q + 9][j], v[16 * q + 10][j], v[16 * q + 11][j]} * W8S); o.w = pack_fp8x4((f32x4){v[16 * q + 12][j], v[16 * q + 13][j], v[16 * q + 14][j], v[16 * q + 15][j]} * W8S); dst8[q] = o; }
            continue; }
        v4u* dst = (v4u*)(WT + (size_t)(row_off + dr) * dpitch + k0);
#pragma unroll
        for (int q = 0; q < CVK / 8; ++q) { v4u o; o.x = pg8::cvt_pk_bf16(v[8 * q][j], v[8 * q + 1][j]); o.y = pg8::cvt_pk_bf16(v[8 * q + 2][j], v[8 * q + 3][j]); o.z = pg8::cvt_pk_bf16(v[8 * q + 4][j], v[8 * q + 5][j]); o.w = pg8::cvt_pk_bf16(v[8 * q + 6][j], v[8 * q + 7][j]); dst[q] = o; }
    }
}
constexpr int CV_GU = (D / CVK) * 2, CV_DN = (FF / CVK) * 4, CV_NGU = (NE + 1) * CV_GU, CV_NITEM = CV_NGU + (NE + 1) * CV_DN;
__device__ __forceinline__ void cvx_load(const float* const* in, int it, int lane, f32x4 (&v)[CVK]) {
    if (it < CV_NGU) { const int e = it / CV_GU, ii = it - e * CV_GU; const float* src = (e < NE) ? in[30] + (size_t)e * D * 512 : in[32];
        cvt_reg_load(src, 512, CVK * (ii >> 1), 256 * (ii & 1), lane, v); }
    else { const int r = it - CV_NGU, e = r / CV_DN, ii = r - e * CV_DN; const float* src = (e < NE) ? in[31] + (size_t)e * FF * D : in[33];
        cvt_reg_load(src, D, CVK * (ii >> 2), 256 * (ii & 3), lane, v); }
}
__device__ __forceinline__ void cvx_store(unsigned char* ws, int it, int lane, const f32x4 (&v)[CVK]) {
    if (it < CV_NGU) { const int e = it / CV_GU, ii = it - e * CV_GU; cvt_reg_store<1, true>((bf16*)(ws + WS_WGU), e * 512, D, CVK * (ii >> 1), 256 * (ii & 1), lane, v); }
    else { const int r = it - CV_NGU, e = r / CV_DN, ii = r - e * CV_DN; cvt_reg_store<0, true>((bf16*)(ws + WS_WD), e * D, FF, CVK * (ii >> 2), 256 * (ii & 3), lane, v); }
}

typedef float f32x2v __attribute__((ext_vector_type(2)));
constexpr int CY_GU = (D / 32) * 4, CY_DN = (FF / 32) * 8, CY_NGU = (NE + 1) * CY_GU, CY_NITEM = CY_NGU + (NE + 1) * CY_DN;
__device__ __forceinline__ void cvy_load(const float* const* in, int it, int lane, f32x2v (&v)[32]) {
    const float* p;  int Nsrc;
    if (it < CY_NGU) { const int e = it / CY_GU, ii = it - e * CY_GU; const float* src = (e < NE) ? in[30] + (size_t)e * D * 512 : in[32]; Nsrc = 512; p = src + (size_t)(32 * (ii >> 2)) * 512 + 128 * (ii & 3) + 2 * lane; }
    else { const int r = it - CY_NGU, e = r / CY_DN, ii = r - e * CY_DN; const float* src = (e < NE) ? in[31] + (size_t)e * FF * D : in[33]; Nsrc = D; p = src + (size_t)(32 * (ii >> 3)) * D + 128 * (ii & 7) + 2 * lane; }
#pragma unroll
    for (int i = 0; i < 32; ++i) v[i] = __builtin_nontemporal_load((const f32x2v*)(p + (size_t)i * Nsrc));
}
__device__ __forceinline__ void cvy_store(unsigned char* ws, int it, int lane, const f32x2v (&v)[32]) {
    unsigned char* base; int dpitch, n0; bool gu = it < CY_NGU;
    if (gu) { const int e = it / CY_GU, ii = it - e * CY_GU; base = ws + WS_WGU + (size_t)(e * 512) * D + 32 * (ii >> 2); dpitch = D; n0 = 128 * (ii & 3); }
    else { const int r = it - CY_NGU, e = r / CY_DN, ii = r - e * CY_DN; base = ws + WS_WD + (size_t)(e * D) * FF + 32 * (ii >> 3); dpitch = FF; n0 = 128 * (ii & 7); }
#pragma unroll
    for (int j = 0; j < 2; ++j) {
        const int ng = n0 + 2 * lane + j; int dr = ng;
        if (gu) { const int i2 = ng & 255; dr = 8 * (i2 >> 2) + (i2 & 3) + ((ng >= 256) ? 4 : 0); }
        v4u* dst8 = (v4u*)(base + (size_t)dr * dpitch);
#pragma unroll
        for (int q = 0; q < 2; ++q) { v4u o;
            o.x = pack_fp8x4((f32x4){v[16 * q][j], v[16 * q + 1][j], v[16 * q + 2][j], v[16 * q + 3][j]} * W8S); o.y = pack_fp8x4((f32x4){v[16 * q + 4][j], v[16 * q + 5][j], v[16 * q + 6][j], v[16 * q + 7][j]} * W8S);
            o.z = pack_fp8x4((f32x4){v[16 * q + 8][j], v[16 * q + 9][j], v[16 * q + 10][j], v[16 * q + 11][j]} * W8S); o.w = pack_fp8x4((f32x4){v[16 * q + 12][j], v[16 * q + 13][j], v[16 * q + 14][j], v[16 * q + 15][j]} * W8S); dst8[q] = o; }
    }
}
#define CVY_FLUSH() do { if (cpend >= 0) cvy_store(F.ws, cpend, lane, cv); cpend = -1; } while (0)
#define CVY_START(item) do { if ((item) < CY_NITEM) { cvy_load(F.in, (item), lane, cv); cpend = (item); } } while (0)

#if MS >= 3
__device__ __forceinline__ float lora_val(const float* const* in, int n, int k) {
    if (n < 1024) { const int q = n >> 3, e8 = n & 7, dir = e8 >> 2, ch = q * 4 + (e8 & 3); return (k < 32) ? in[9][(size_t)(dir * 32 + k) * 512 + ch] : 0.f; }
    if (n < 2048) { const int m = n - 1024, q = m >> 3, e8 = m & 7, dir = e8 >> 2, ch = q * 4 + (e8 & 3); return (k >= 32 && k < 64) ? in[11][(size_t)(dir * 32 + (k - 32)) * 512 + ch] : 0.f; }
    if (n < 2560) { const int ch = n - 2048; return (k >= 64 && k < 160) ? in[12][(size_t)(k - 64) * 512 + ch] : 0.f; }
    { const int m = n - 2560, q = m >> 3, e8 = m & 7, dir = e8 >> 2, ch = q * 4 + (e8 & 3); return (k >= 160 && k < 176) ? in[19][(size_t)(dir * 16 + (k - 160)) * 256 + ch] : 0.f; }
}
#endif

__device__ __forceinline__ void ph_prologue(Frame& F) {
    {
        const float* c = F.in[1]; const float* cc = F.in[3]; const float* wa = F.in[4]; const float* ba = F.in[5];
        float* MOD = (float*)(F.ws + WS_MOD);
        LAS float* S = (LAS float*)F.lds; LAS float* red = (LAS float*)(F.lds + 32768);
        for (int it = blockIdx.x; it < 96; it += F.G) {
            for (int i = F.tid; i < 5120; i += NTHR) { const int r = i >> 10, k = i & 1023; const float cv = r < 4 ? c[r * 1024 + k] : cc[k]; S[i] = siluf_(cv); }
            __syncthreads();
            const int n = it * 64 + F.lane; float acc[5] = {0.f, 0.f, 0.f, 0.f, 0.f};
            for (int kk = 0; kk < 128; ++kk) { const int k = F.wave * 128 + kk; const float wv = wa[(size_t)k * 6144 + n];
#pragma unroll
                for (int r = 0; r < 5; ++r) acc[r] += S[r * 1024 + k] * wv; }
#pragma unroll
            for (int r = 0; r < 5; ++r) red[(F.wave * 5 + r) * 64 + F.lane] = acc[r];
            __syncthreads();
            if (F.wave == 0) {
#pragma unroll
                for (int r = 0; r < 5; ++r) { float s = 0.f;
#pragma unroll
                    for (int w = 0; w < 8; ++w) s += red[(w * 5 + r) * 64 + F.lane];
                    MOD[r * 6144 + n] = s + ba[n]; }
            }
            __syncthreads();
        }
    }
    {
        LAS float* scr = (LAS float*)(F.lds + F.wave * 16384);
        constexpr int I_IN = 16 * 168, I_BR = 8 * 32, I_OUT = 16 * 32, I_RT = 16 * 8, I_GU = 32 * 2, I_DN = 8 * 4;
        constexpr int T0 = I_IN, T1 = T0 + I_BR, T2 = T1 + I_BR, T3 = T2 + I_OUT, T4 = T3 + I_RT, T5 = T4 + (NE + 1) * I_GU, T6 = T5 + (NE + 1) * I_DN;
        unsigned char* ws = F.ws;
        for (int it = F.gw; it < T6; it += F.NGW) {
#if MS >= 3
            if (it < T0) { cvt_item<0, true>(F.in[6], IN_COLS, 168, (bf16*)(ws + WS_WIN), 0, D, scr, it, F.lane); continue; }
            if (it < T1) { cvt_item<0>(F.in[23], D, 32, (bf16*)(ws + WS_WBRRW), 0, RWW, scr, it - T0, F.lane); continue; }
            if (it < T2) { cvt_item<0>(F.in[24], D, 32, (bf16*)(ws + WS_WBRGLA), 0, RWW, scr, it - T1, F.lane); continue; }
            if (it < T3) { cvt_item<0>(F.in[25], D, 32, (bf16*)(ws + WS_WOUT), 0, D, scr, it - T2, F.lane); continue; }
#else
            if (it < T3) continue;
#endif
            if (it < T4) { cvt_item<0>(F.in[28], NE, 8, (bf16*)(ws + WS_WROUTER), 0, D, scr, it - T3, F.lane); continue; }
#if MS >= 3
            break;
#endif
            if (it < T5) { const int r = it - T4, e = r / I_GU, ii = r - e * I_GU;
                const float* src = (e < NE) ? F.in[30] + (size_t)e * D * 512 : F.in[32];
                cvt_item_reg<1>(src, 512, (bf16*)(ws + WS_WGU), e * 512, D, 32 * (ii >> 1), 256 * (ii & 1), F.lane); continue; }
            { const int r = it - T5, e = r / I_DN, ii = r - e * I_DN;
                const float* src = (e < NE) ? F.in[31] + (size_t)e * FF * D : F.in[33];
                cvt_item_reg<0>(src, D, (bf16*)(ws + WS_WD), e * D, FF, 32 * (ii >> 2), 256 * (ii & 3), F.lane); }
        }
    }
#if MS >= 3
    {
        bf16* WL = (bf16*)(F.ws + WS_WLORA);
        for (int idx = blockIdx.x * NTHR + F.tid; idx < NLORA * (KLORA / 8); idx += F.G * NTHR) {
            const int n = idx >> 5, k0 = (idx & 31) * 8; float v[8];
#pragma unroll
            for (int e = 0; e < 8; ++e) v[e] = lora_val(F.in, n, k0 + e);
            v4u o; o.x = pk2(v[0], v[1]); o.y = pk2(v[2], v[3]); o.z = pk2(v[4], v[5]); o.w = pk2(v[6], v[7]);
            *(v4u*)(WL + (size_t)n * KLORA + k0) = o;
        }
    }
#endif
}

struct EpiF32 {
    static constexpr bool PERM = false;
    float* C; int ldc;
    __device__ __forceinline__ void operator()(const f32x4 (&acc)[2][2][4][2], const pg8::Unit& u, int wr, int wc, int fr, int fq) const {
        const int row0 = u.pm * 256 + wr * 64 + fr, col0 = u.pn * 256 + wc * 32 + 4 * fq;
#pragma unroll
        for (int ai = 0; ai < 2; ++ai)
#pragma unroll
            for (int m = 0; m < 4; ++m) { float* rowp = C + (size_t)(row0 + ai * 128 + m * 16) * ldc + col0;
#pragma unroll
                for (int bj = 0; bj < 2; ++bj)
#pragma unroll
                    for (int n = 0; n < 2; ++n) *(f32x4*)(rowp + bj * 128 + n * 16) = acc[ai][bj][m][n]; }
    }
};
struct EpiSwiglu {
    static constexpr bool PERM = true;
    unsigned char* ACT;
    __device__ __forceinline__ void operator()(const f32x4 (&acc)[2][2][4][2], const pg8::Unit& u, int wr, int wc, int fr, int fq) const {
        const int row0 = u.pm * 256 + wr * 64 + fr, h0 = u.j * 128 + wc * 16 + 4 * fq;
#pragma unroll
        for (int ai = 0; ai < 2; ++ai)
#pragma unroll
            for (int m = 0; m < 4; ++m) { unsigned char* rowp = ACT + (size_t)(row0 + ai * 128 + m * 16) * FF + h0;
#pragma unroll
                for (int bj = 0; bj < 2; ++bj) { const f32x4 a = acc[ai][bj][m][0] * W8I, b = acc[ai][bj][m][1] * W8I;
                    *(unsigned*)(rowp + bj * 64) = pack_fp8x4((f32x4){siluf_(a[0]) * b[0], siluf_(a[1]) * b[1], siluf_(a[2]) * b[2], siluf_(a[3]) * b[3]}); } }
    }
};
struct EpiRowsBf16 {
    static constexpr bool PERM = true;
    bf16* O; int ldc; float sc;
    __device__ __forceinline__ void operator()(const f32x4 (&acc)[2][2][4][2], const pg8::Unit& u, int wr, int wc, int fr, int fq) const {
        const int row0 = u.pm * 256 + wr * 64 + fr, col0 = u.j * 256 + wc * 32 + 8 * fq;
#pragma unroll
        for (int ai = 0; ai < 2; ++ai)
#pragma unroll
            for (int m = 0; m < 4; ++m) { bf16* rowp = O + (size_t)(row0 + ai * 128 + m * 16) * ldc + col0;
#pragma unroll
                for (int bj = 0; bj < 2; ++bj) { const f32x4 v0 = acc[ai][bj][m][0] * sc, v1 = acc[ai][bj][m][1] * sc;
                    v4u w; w.x = pg8::cvt_pk_bf16(v0[0], v0[1]); w.y = pg8::cvt_pk_bf16(v0[2], v0[3]); w.z = pg8::cvt_pk_bf16(v1[0], v1[1]); w.w = pg8::cvt_pk_bf16(v1[2], v1[3]);
                    *(v4u*)(rowp + bj * 128) = w;
#ifdef PROBE_ST2
                    asm volatile("" ::: "memory"); *(volatile v4u*)(rowp + bj * 128) = w;
#endif
                    } }
    }
};

struct EpiRowsFp8 {
    static constexpr bool PERM = true;
    unsigned char* O;
    __device__ __forceinline__ void operator()(const f32x4 (&acc)[2][2][4][2], const pg8::Unit& u, int wr, int wc, int fr, int fq) const {
        const int row0 = u.pm * 256 + wr * 64 + fr, col0 = u.j * 256 + wc * 32 + 8 * fq;
#pragma unroll
        for (int ai = 0; ai < 2; ++ai)
#pragma unroll
            for (int m = 0; m < 4; ++m) { unsigned char* rowp = O + (size_t)(row0 + ai * 128 + m * 16) * D + col0;
#pragma unroll
                for (int bj = 0; bj < 2; ++bj) { f32x4 v0 = acc[ai][bj][m][0] * (16.0f * W8I), v1 = acc[ai][bj][m][1] * (16.0f * W8I);
#pragma unroll
                    for (int e = 0; e < 4; ++e) { v0[e] = __builtin_amdgcn_fmed3f(v0[e], -448.0f, 448.0f); v1[e] = __builtin_amdgcn_fmed3f(v1[e], -448.0f, 448.0f); }
                    int w0 = __builtin_amdgcn_cvt_pk_fp8_f32(v0[0], v0[1], 0, false); w0 = __builtin_amdgcn_cvt_pk_fp8_f32(v0[2], v0[3], w0, true);
                    int w1 = __builtin_amdgcn_cvt_pk_fp8_f32(v1[0], v1[1], 0, false); w1 = __builtin_amdgcn_cvt_pk_fp8_f32(v1[2], v1[3], w1, true);
                    v2u w; w.x = (unsigned)w0; w.y = (unsigned)w1; *(v2u*)(rowp + bj * 128) = w; } }
    }
};

__device__ __forceinline__ void ph_router(Frame& F) {
    pg8::Gemm g{(const bf16*)(F.ws + WS_A3), (const bf16*)(F.ws + WS_WROUTER), NLAT, NE, D, nullptr};
    pg8::StaticOrder S; S.init(NLAT, NE, F.G, (int)blockIdx.x);
    EpiF32 E{(float*)(F.ws + WS_LOGITS), NE};
    pg8::gemm_phase<EpiF32, pg8::StaticOrder, true, true, false>(F.lds, g, S, E);
}

#define RT_DPP(x, ctrl) __builtin_amdgcn_update_dpp(0, (x), (ctrl), 0xf, 0xf, false)
__device__ __forceinline__ unsigned wave_max_u32(unsigned k) {
    k = max(k, (unsigned)RT_DPP((int)k, 0xB1)); k = max(k, (unsigned)RT_DPP((int)k, 0x4E));
    k = max(k, (unsigned)RT_DPP((int)k, 0x124)); k = max(k, (unsigned)RT_DPP((int)k, 0x128));
    const unsigned a = (unsigned)__builtin_amdgcn_readlane((int)k, 0), b = (unsigned)__builtin_amdgcn_readlane((int)k, 16), c = (unsigned)__builtin_amdgcn_readlane((int)k, 32), d = (unsigned)__builtin_amdgcn_readlane((int)k, 48);
    return max(max(a, b), max(c, d));
}
__device__ __forceinline__ void ph_route(Frame& F) {
    const float* LOG = (const float*)(F.ws + WS_LOGITS); const float* rb = F.in[29];
    int* EIDX = (int*)(F.ws + WS_EIDX); float* GATE = (float*)(F.ws + WS_GATE); int* DEST = (int*)(F.ws + WS_DEST);
    unsigned* CNT = F.ctl + CW_CNT;
    const f32x4 bias = *(const f32x4*)(rb + 4 * F.lane);
    f32x4 lgn = *(const f32x4*)(LOG + (size_t)(F.gw < NLAT ? F.gw : 0) * NE + 4 * F.lane);
    for (int m = F.gw; m < NLAT; m += F.NGW) {
        const f32x4 lg = lgn;
        { const int mn = (m + F.NGW < NLAT) ? m + F.NGW : m; lgn = *(const f32x4*)(LOG + (size_t)mn * NE + 4 * F.lane); }
        float sc[4], sel[4];
#pragma unroll
        for (int i = 0; i < 4; ++i) { sc[i] = sigmoidf_(lg[i]); sel[i] = sc[i] + bias[i]; }
        float m1 = fmaxf(sel[0], sel[1]), m2 = fminf(sel[0], sel[1]);
        { const float a = sel[2]; const float n1 = fmaxf(m1, a); m2 = fmaxf(m2, fminf(m1, a)); m1 = n1; }
        { const float a = sel[3]; const float n1 = fmaxf(m1, a); m2 = fmaxf(m2, fminf(m1, a)); m1 = n1; }
#define RT_MERGE(ctrl) do { const float b1 = __builtin_bit_cast(float, RT_DPP(__builtin_bit_cast(int, m1), ctrl)), b2 = __builtin_bit_cast(float, RT_DPP(__builtin_bit_cast(int, m2), ctrl)); \
            const float n1 = fmaxf(m1, b1); m2 = fmaxf(fminf(m1, b1), fmaxf(m2, b2)); m1 = n1; } while (0)
        RT_MERGE(0xB1); RT_MERGE(0x4E); RT_MERGE(0x141);
#undef RT_MERGE
        const float gs = m1 + m2; const int g = F.lane >> 3;
        int rank = 0;
#pragma unroll
        for (int gg = 0; gg < 8; ++gg) { const float og = __builtin_bit_cast(float, __builtin_amdgcn_readlane(__builtin_bit_cast(int, gs), gg * 8)); rank += (og > gs || (og == gs && gg < g)) ? 1 : 0; }
        const bool keep = rank < 4;
        unsigned key[4];
#pragma unroll
        for (int i = 0; i < 4; ++i) { unsigned u = __builtin_bit_cast(unsigned, sel[i]); u ^= (u >> 31) ? 0xffffffffu : 0x80000000u;
            key[i] = keep ? ((u & 0xffffff00u) | (unsigned)(255 - (4 * F.lane + i))) : 0u; }
        int my_e = 0; float my_s = 0.f; float ssum = 0.f;
#pragma unroll
        for (int k = 0; k < TOPK; ++k) {
            const unsigned best = wave_max_u32(max(max(key[0], key[1]), max(key[2], key[3])));
            const int e = 255 - (int)(best & 255u), owner = e >> 2;
            float s_own = 0.f;
#pragma unroll
            for (int i = 0; i < 4; ++i) if (key[i] == best) { s_own = sc[i]; key[i] = 0u; }
            const float s = __builtin_bit_cast(float, __builtin_amdgcn_readlane(__builtin_bit_cast(int, s_own), owner));
            ssum += s;
            if (F.lane == k) { my_e = e; my_s = s; }
        }
        if (F.lane < TOPK) {
            const unsigned pos = __hip_atomic_fetch_add(CNT + my_e * CNT_STRIDE, 1u, __ATOMIC_RELAXED, __HIP_MEMORY_SCOPE_AGENT);
            EIDX[m * 8 + F.lane] = my_e; GATE[m * 8 + F.lane] = my_s * __builtin_amdgcn_rcpf(ssum) * 2.5f; DEST[m * 8 + F.lane] = (int)pos;
        }
    }
}
#undef RT_DPP

__device__ __forceinline__ void ph_scatter(Frame& F) {
    LAS int* tstart = (LAS int*)F.lds;
    LAS int* scan = (LAS int*)(F.lds + 2048);
    LAS int* cnts = (LAS int*)(F.lds + 4096);
    int* EIDX = (int*)(F.ws + WS_EIDX); int* DEST = (int*)(F.ws + WS_DEST); int* ROWTOK = (int*)(F.ws + WS_ROWTOK); int* TILE_E = (int*)(F.ws + WS_TILE_E);
    unsigned* CNT = F.ctl + CW_CNT;
    int tiles = 0, cnt = 0;
    if (F.tid < NE) { cnt = (int)__hip_atomic_load(CNT + F.tid * CNT_STRIDE, __ATOMIC_RELAXED, __HIP_MEMORY_SCOPE_AGENT); tiles = (cnt + 255) >> 8; scan[F.tid] = tiles; cnts[F.tid] = cnt; }
    __syncthreads();
    for (int o = 1; o < NE; o <<= 1) { int v = 0; if (F.tid < NE && F.tid >= o) v = scan[F.tid - o]; __syncthreads(); if (F.tid < NE) scan[F.tid] += v; __syncthreads(); }
    if (F.tid < NE) { tstart[F.tid + 1] = scan[F.tid]; if (F.tid == 0) tstart[0] = 0; }
    __syncthreads();
    const int NT = tstart[NE];
    if (blockIdx.x == 0) {
        if (F.tid == 0) F.ctl[CW_NT] = (unsigned)NT;
        if (F.tid < NE) for (int t = tstart[F.tid]; t < tstart[F.tid + 1]; ++t) TILE_E[t] = F.tid;
    }
    for (int e = blockIdx.x; e < NE; e += F.G) { const int c0 = cnts[e], c1 = (tstart[e + 1] - tstart[e]) * 256, base = tstart[e] * 256;
        for (int p = c0 + F.tid; p < c1; p += NTHR) ROWTOK[base + p] = 0; }
    for (int i = blockIdx.x * NTHR + F.tid; i < NLAT; i += F.G * NTHR) ROWTOK[SH_ROW0 + i] = i;
    for (int i = blockIdx.x * NTHR + F.tid; i < NLAT * TOPK; i += F.G * NTHR) {
        const int e = EIDX[i], pos = DEST[i]; const int dr = tstart[e] * 256 + pos;
        DEST[i] = dr; ROWTOK[dr] = i >> 3;
    }
}

__device__ __forceinline__ void ph_exp1(Frame& F) {
    const int NT = (int)__hip_atomic_load(F.ctl + CW_NT, __ATOMIC_RELAXED, __HIP_MEMORY_SCOPE_AGENT);
    pg8::Gemm g{(const bf16*)(F.ws + WS_A3F), (const bf16*)(F.ws + WS_WGU), 0, 0, D / 2, (const int*)(F.ws + WS_ROWTOK)};
    pg8::MoeOrder S{2, F.G, (int)blockIdx.x, NT, (const int*)(F.ws + WS_TILE_E)};
    EpiSwiglu E{F.ws + WS_ACT};
    pg8::gemm_phase<EpiSwiglu, pg8::MoeOrder, true, true, true, true>(F.lds, g, S, E);
}
__device__ __forceinline__ void ph_exp2(Frame& F) {
    const int NT = (int)__hip_atomic_load(F.ctl + CW_NT, __ATOMIC_RELAXED, __HIP_MEMORY_SCOPE_AGENT);
    pg8::Gemm g{(const bf16*)(F.ws + WS_ACT), (const bf16*)(F.ws + WS_WD), 0, 0, FF / 2, nullptr};
    pg8::MoeOrder S{4, F.G, (int)blockIdx.x, NT, (const int*)(F.ws + WS_TILE_E)};
    EpiRowsFp8 E{F.ws + WS_Y};
    pg8::gemm_phase<EpiRowsFp8, pg8::MoeOrder, true, true, false, true>(F.lds, g, S, E);
}
#endif

#if MS >= 3
__device__ __forceinline__ void unp8(const v4u w, float (&f)[8]) { f[0] = bflo(w.x); f[1] = bfhi(w.x); f[2] = bflo(w.y); f[3] = bfhi(w.y); f[4] = bflo(w.z); f[5] = bfhi(w.z); f[6] = bflo(w.w); f[7] = bfhi(w.w); }
__device__ __forceinline__ void unp8f8(const v2u w, float (&f)[8]) { const f32x2 a = __builtin_amdgcn_cvt_pk_f32_fp8((int)w.x, false), b = __builtin_amdgcn_cvt_pk_f32_fp8((int)w.x, true), c = __builtin_amdgcn_cvt_pk_f32_fp8((int)w.y, false), d = __builtin_amdgcn_cvt_pk_f32_fp8((int)w.y, true);
    f[0] = a.x; f[1] = a.y; f[2] = b.x; f[3] = b.y; f[4] = c.x; f[5] = c.y; f[6] = d.x; f[7] = d.y; }
__device__ __forceinline__ v4u pk8(const float (&f)[8]) { v4u o; o.x = pk2(f[0], f[1]); o.y = pk2(f[2], f[3]); o.z = pk2(f[4], f[5]); o.w = pk2(f[6], f[7]); return o; }
__device__ __forceinline__ void st8(float* p, const float (&f)[8]) { *(f32x4*)p = (f32x4){f[0], f[1], f[2], f[3]}; *(f32x4*)(p + 4) = (f32x4){f[4], f[5], f[6], f[7]}; }
__device__ __forceinline__ void ld8(const float* p, float (&f)[8]) { const f32x4 a = *(const f32x4*)p, b = *(const f32x4*)(p + 4); f[0] = a.x; f[1] = a.y; f[2] = a.z; f[3] = a.w; f[4] = b.x; f[5] = b.y; f[6] = b.z; f[7] = b.w; }

__device__ __forceinline__ void ph_a1(Frame& F) {
    const float* mod = (const float*)(F.ws + WS_MOD); unsigned char* A1 = F.ws + WS_A1;
    constexpr int NR = 4;
    for (int m0 = F.gw; m0 < MR; m0 += NR * F.NGW) {
        f32x4 xv[NR][4];
#pragma unroll
        for (int r = 0; r < NR; ++r) { const int mm = m0 + r * F.NGW; const int m = mm < MR ? mm : m0;
            const float* src = (m < NLAT) ? F.in[0] + (size_t)m * D : F.in[2] + (size_t)(m - NLAT) * D;
            const f32x4* xr = (const f32x4*)src + F.lane;
#pragma unroll
            for (int j = 0; j < 4; ++j) xv[r][j] = __builtin_nontemporal_load(xr + 64 * j); }
        __builtin_amdgcn_sched_barrier(0);
#pragma unroll
        for (int r = 0; r < NR; ++r) { const int mm = m0 + r * F.NGW; const int m = mm < MR ? mm : m0; const int mr = (m < NLAT) ? (m / SEQ) : 4;
            unsigned* ao = (unsigned*)(A1 + (size_t)m * D) + F.lane;
#pragma unroll
            for (int j = 0; j < 4; ++j) { const int c = 4 * F.lane + 256 * j;
                const f32x4 sh = *(const f32x4*)(mod + mr * 6144 + c), sc = *(const f32x4*)(mod + mr * 6144 + 1024 + c);
                const f32x4 h = xv[r][j] * (sc + 1.0f) + sh; ao[64 * j] = pack_fp8x4(h); } }
    }
}

__device__ __forceinline__ void ph_inproj(Frame& F) {
    pg8::Gemm g{(const bf16*)(F.ws + WS_A1), (const bf16*)(F.ws + WS_WIN), MR, NP, D / 2, nullptr};
    pg8::StaticOrder S; S.init(MR, NP, F.G, (int)blockIdx.x);
    EpiRowsBf16 E{(bf16*)(F.ws + WS_P), NP, W8I};
    pg8::gemm_phase<EpiRowsBf16, pg8::StaticOrder, true, true, false, true>(F.lds, g, S, E);
}

struct FeatOut { bf16 *R, *V, *KK, *KP, *QG, *KGB, *VGB, *A2; const float *mu, *kkw, *cw; };
__device__ __forceinline__ void feat_rw(const FeatOut& O, int p, size_t m, int lane, const v4u own_w, const v4u (&nbw)[4], const float (&muv)[8]) {
    float own[8], sh[4][8], val[8];
    unp8(own_w, own);
#pragma unroll
    for (int q = 0; q < 4; ++q) unp8(nbw[q], sh[q]);
#pragma unroll
    for (int e = 0; e < 8; ++e) val[e] = own[e] + muv[e] * (sh[e & 3][e] - own[e]);
    if (p == 0) *(v4u*)(O.R + m * RWW + 8 * lane) = pk8(val);
    else if (p == 2) *(v4u*)(O.V + m * RWW + 8 * lane) = pk8(val);
    else if (p == 1) {
        *(v4u*)(O.KP + m * RWW + 8 * lane) = pk8(val);
        float kw[8]; ld8(O.kkw + 8 * lane, kw); float kkv[8]; float ss = 0.f;
#pragma unroll
        for (int e = 0; e < 8; ++e) { kkv[e] = val[e] * kw[e]; ss += kkv[e] * kkv[e]; }
        ss += __shfl_xor(ss, 1); ss += __shfl_xor(ss, 2); ss += __shfl_xor(ss, 4);
        const float inv = 1.0f / fmaxf(sqrtf(ss), 1e-12f);
#pragma unroll
        for (int e = 0; e < 8; ++e) kkv[e] *= inv;
        *(v4u*)(O.KK + m * RWW + 8 * lane) = pk8(kkv);
    } else {
        float o[8];
#pragma unroll
        for (int e = 0; e < 8; ++e) o[e] = (lane < 4) ? tanhf_(val[e]) : ((lane < 8) ? val[e] : sigmoidf_(val[e]));
        *(v4u*)(O.A2 + m * KLORA + 8 * lane) = pk8(o);
    }
}
__device__ __forceinline__ void feat_gla_store(const FeatOut& O, int p, size_t m, int lane, const float (&acc)[8]) {
    const int cq = p * 512 + 8 * lane; float o[8];
#pragma unroll
    for (int e = 0; e < 8; ++e) o[e] = siluf_(acc[e]);
    if (p == 0) {
        if (lane < 32) {
#pragma unroll
            for (int e = 0; e < 8; ++e) o[e] *= 0.125f;
            *(v4u*)(O.QG + m * 256 + cq) = pk8(o);
        } else *(v4u*)(O.KGB + m * 256 + (cq - 256)) = pk8(o);
    } else *(v4u*)(O.VGB + m * RWW + (cq - 512)) = pk8(o);
}
__device__ __forceinline__ void ph_feat(Frame& F) {
    const bf16* P = (const bf16*)(F.ws + WS_P);
    FeatOut O{(bf16*)(F.ws + WS_RB), (bf16*)(F.ws + WS_VB), (bf16*)(F.ws + WS_KKB), (bf16*)(F.ws + WS_KMF), (bf16*)(F.ws + WS_QGB), (bf16*)(F.ws + WS_KGB), (bf16*)(F.ws + WS_VGB), (bf16*)(F.ws + WS_A2), F.in[7], F.in[13], F.in[18]};
    const v4u Z4 = (v4u){0u, 0u, 0u, 0u};
    for (int blk = F.gw; blk < NB * (GRIDH / 2) * (GRIDW / 2); blk += F.NGW) {
        int lane = F.lane; asm volatile("" : "+v"(lane));
        const int b = blk >> 11, r0 = 2 * ((blk >> 5) & 63), c0 = 2 * (blk & 31); const int mb = b * SEQ + r0 * GRIDW + c0;
        const bool vu = r0 > 0, vd = r0 + 2 < GRIDH, vl = c0 > 0, vr = c0 + 2 < GRIDW;
#pragma unroll
        for (int p = 0; p < 4; ++p) {
            const int cb = p * 512 + 8 * lane; const bool act = (p < 3) || lane < 20;
            v4u own[2][2], up[2], dn[2], lf[2], rt[2];
#pragma unroll
            for (int i = 0; i < 2; ++i) { up[i] = Z4; dn[i] = Z4; lf[i] = Z4; rt[i] = Z4; own[i][0] = Z4; own[i][1] = Z4; }
            if (act) {
#pragma unroll
                for (int i = 0; i < 2; ++i) {
#pragma unroll
                    for (int j = 0; j < 2; ++j) own[i][j] = *(const v4u*)(P + (size_t)(mb + 64 * i + j) * NP + cb);
                    if (vu) up[i] = *(const v4u*)(P + (size_t)(mb - 64 + i) * NP + cb);
                    if (vd) dn[i] = *(const v4u*)(P + (size_t)(mb + 128 + i) * NP + cb);
                    if (vl) lf[i] = *(const v4u*)(P + (size_t)(mb + 64 * i - 1) * NP + cb);
                    if (vr) rt[i] = *(const v4u*)(P + (size_t)(mb + 64 * i + 2) * NP + cb); }
            } else if (p == 3 && lane >= 20 && lane < 22) {
#pragma unroll
                for (int i = 0; i < 2; ++i)
#pragma unroll
                    for (int j = 0; j < 2; ++j) own[i][j] = *(const v4u*)(P + (size_t)(mb + 64 * i + j) * NP + C_PGL + 8 * (lane - 20));
            }
            float muv[8] = {0.f, 0.f, 0.f, 0.f, 0.f, 0.f, 0.f, 0.f}; if (act) ld8(O.mu + cb, muv);
            __builtin_amdgcn_sched_barrier(0);
#pragma unroll
            for (int i = 0; i < 2; ++i)
#pragma unroll
                for (int j = 0; j < 2; ++j) { const size_t m = (size_t)(mb + 64 * i + j);
                    if (act) { const v4u nbw[4] = {j == 0 ? lf[i] : own[i][0], j == 1 ? rt[i] : own[i][1], i == 0 ? up[j] : own[0][j], i == 1 ? dn[j] : own[1][j]};
                        feat_rw(O, p, m, lane, own[i][j], nbw, muv); }
                    else if (p == 3 && lane < 32) *(v4u*)(O.A2 + m * KLORA + 8 * lane) = own[i][j]; }
        }
#pragma unroll
        for (int p = 0; p < 2; ++p) {
            const int cq = p * 512 + 8 * lane, cb = C_Q + cq;
            v4u g[4][4];
#pragma unroll
            for (int a2 = 0; a2 < 4; ++a2)
#pragma unroll
                for (int b2 = 0; b2 < 4; ++b2) { const bool ok = (a2 == 0 ? vu : (a2 == 3 ? vd : true)) && (b2 == 0 ? vl : (b2 == 3 ? vr : true));
                    g[a2][b2] = Z4; if (ok) g[a2][b2] = *(const v4u*)(P + (size_t)(mb + 64 * (a2 - 1) + (b2 - 1)) * NP + cb); }
            __builtin_amdgcn_sched_barrier(0);
            float acc[2][2][8];
#pragma unroll
            for (int i = 0; i < 2; ++i)
#pragma unroll
                for (int j = 0; j < 2; ++j)
#pragma unroll
                    for (int e = 0; e < 8; ++e) acc[i][j][e] = 0.f;
#pragma unroll
            for (int dy = 0; dy < 3; ++dy)
#pragma unroll
                for (int dx = 0; dx < 3; ++dx) { float wv[8]; ld8(O.cw + (dy * 3 + dx) * 1024 + cq, wv);
#pragma unroll
                    for (int i = 0; i < 2; ++i)
#pragma unroll
                        for (int j = 0; j < 2; ++j) { float pv[8]; unp8(g[i + dy][j + dx], pv);
#pragma unroll
                            for (int e = 0; e < 8; ++e) acc[i][j][e] += pv[e] * wv[e]; } }
#pragma unroll
            for (int i = 0; i < 2; ++i)
#pragma unroll
                for (int j = 0; j < 2; ++j) feat_gla_store(O, p, (size_t)(mb + 64 * i + j), lane, acc[i][j]);
        }
    }
    for (int m = NLAT + F.gw; m < MR; m += F.NGW) {
        int lane = F.lane; asm volatile("" : "+v"(lane));
        const int t = (m - NLAT) & (CTXL - 1); const bool vp = t > 0, vn = t < CTXL - 1;
#pragma unroll
        for (int p = 0; p < 4; ++p) {
            const int cb = p * 512 + 8 * lane; const bool act = (p < 3) || lane < 20;
            if (act) { const v4u own = *(const v4u*)(P + (size_t)m * NP + cb); v4u pv = Z4, nv = Z4;
                if (vp) pv = *(const v4u*)(P + (size_t)(m - 1) * NP + cb); if (vn) nv = *(const v4u*)(P + (size_t)(m + 1) * NP + cb);
                float muv[8]; ld8(O.mu + cb, muv); const v4u nbw[4] = {pv, nv, pv, nv};
                feat_rw(O, p, (size_t)m, lane, own, nbw, muv); }
            else if (p == 3 && lane < 32) { v4u w = Z4; if (lane < 22) w = *(const v4u*)(P + (size_t)m * NP + C_PGL + 8 * (lane - 20)); *(v4u*)(O.A2 + (size_t)m * KLORA + 8 * lane) = w; }
        }
#pragma unroll
        for (int p = 0; p < 2; ++p) {
            const int cq = p * 512 + 8 * lane, cb = C_Q + cq; float acc[8] = {0.f, 0.f, 0.f, 0.f, 0.f, 0.f, 0.f, 0.f};
#pragma unroll
            for (int dx = -1; dx <= 1; ++dx) { const bool ok = (dx < 0) ? vp : ((dx > 0) ? vn : true);
                if (ok) { float pv[8], wv[8]; unp8(*(const v4u*)(P + (size_t)(m + dx) * NP + cb), pv); ld8(O.cw + (3 + dx + 1) * 1024 + cq, wv);
#pragma unroll
                    for (int e = 0; e < 8; ++e) acc[e] += pv[e] * wv[e]; } }
            feat_gla_store(O, p, (size_t)m, lane, acc);
        }
    }
}

struct EpiLora {
    static constexpr bool PERM = true;
    unsigned char* ws; const float* const* in;
    __device__ __forceinline__ void grp_w(const f32x4 (&acc)[2][2][4][2], int row0, int c0) const {
        bf16* Wf = (bf16*)(ws + WS_LWF); bf16* Wb = (bf16*)(ws + WS_LWB);
#pragma unroll
        for (int bj = 0; bj < 2; ++bj) { const int ch = (c0 + bj * 128) >> 1; const f32x4 w0f = *(const f32x4*)(in[8] + ch), w0b = *(const f32x4*)(in[8] + 512 + ch);
#pragma unroll
            for (int ai = 0; ai < 2; ++ai)
#pragma unroll
                for (int m = 0; m < 4; ++m) { const size_t row = (size_t)(row0 + ai * 128 + m * 16);
                    const f32x4 xf = acc[ai][bj][m][0] + w0f, xb = acc[ai][bj][m][1] + w0b; f32x4 df, db;
#pragma unroll
                    for (int e = 0; e < 4; ++e) { df[e] = -0.60653066f * sigmoidf_(xf[e]); db[e] = -0.60653066f * sigmoidf_(xb[e]); }
                    { v2u o; o.x = pk2(df[0], df[1]); o.y = pk2(df[2], df[3]); *(v2u*)(Wf + row * RWW + ch) = o; o.x = pk2(db[0], db[1]); o.y = pk2(db[2], db[3]); *(v2u*)(Wb + row * RWW + ch) = o; } } }
    }
    __device__ __forceinline__ void grp_a(const f32x4 (&acc)[2][2][4][2], int row0, int c0) const {
        bf16* KMf = (bf16*)(ws + WS_KMF); bf16* KMb = (bf16*)(ws + WS_KMB); bf16* BVf = (bf16*)(ws + WS_BVF); bf16* BVb = (bf16*)(ws + WS_BVB);
        const bf16* KK = (const bf16*)(ws + WS_KKB); bf16* KSUM = (bf16*)(ws + WS_KSUM);
#pragma unroll
        for (int bj = 0; bj < 2; ++bj) { const int ch = (c0 + bj * 128 - 1024) >> 1; const f32x4 a0f = *(const f32x4*)(in[10] + ch), a0b = *(const f32x4*)(in[10] + 512 + ch), ka = *(const f32x4*)(in[14] + ch);
#pragma unroll
            for (int ai = 0; ai < 2; ++ai) {
            v2u kpw[2][4], kkw[2][4];
#pragma unroll
                for (int m = 0; m < 4; ++m) { const size_t row = (size_t)(row0 + ai * 128 + m * 16); kpw[ai][m] = *(const v2u*)(KMf + row * RWW + ch); kkw[ai][m] = *(const v2u*)(KK + row * RWW + ch); }
            __builtin_amdgcn_sched_barrier(0);
#pragma unroll
                for (int m = 0; m < 4; ++m) { const size_t row = (size_t)(row0 + ai * 128 + m * 16);
                    const f32x4 xf = acc[ai][bj][m][0] + a0f, xb = acc[ai][bj][m][1] + a0b;
                    const f32x4 kp = (f32x4){bflo(kpw[ai][m].x), bfhi(kpw[ai][m].x), bflo(kpw[ai][m].y), bfhi(kpw[ai][m].y)}, kk = (f32x4){bflo(kkw[ai][m].x), bfhi(kkw[ai][m].x), bflo(kkw[ai][m].y), bfhi(kkw[ai][m].y)};
                    f32x4 kmf, kmb, bvf, bvb;
#pragma unroll
                    for (int e = 0; e < 4; ++e) { const float af = sigmoidf_(xf[e]), ab = sigmoidf_(xb[e]);
                        kmf[e] = kp[e] * (1.0f + (af - 1.0f) * ka[e]); kmb[e] = kp[e] * (1.0f + (ab - 1.0f) * ka[e]); bvf[e] = kk[e] * af; bvb[e] = kk[e] * ab; }
                    { v2u o; o.x = pk2(kmf[0], kmf[1]); o.y = pk2(kmf[2], kmf[3]); *(v2u*)(KMf + row * RWW + ch) = o; o.x = pk2(kmb[0], kmb[1]); o.y = pk2(kmb[2], kmb[3]); *(v2u*)(KMb + row * RWW + ch) = o;
                      o.x = pk2(bvf[0], bvf[1]); o.y = pk2(bvf[2], bvf[3]); *(v2u*)(BVf + row * RWW + ch) = o; o.x = pk2(bvb[0], bvb[1]); o.y = pk2(bvb[2], bvb[3]); *(v2u*)(BVb + row * RWW + ch) = o; }
                    v2u ks; ks.x = pk2(kmf[0] + kmb[0], kmf[1] + kmb[1]); ks.y = pk2(kmf[2] + kmb[2], kmf[3] + kmb[3]); *(v2u*)(KSUM + row * RWW + ch) = ks; } } }
    }
    __device__ __forceinline__ void grp_g(const f32x4 (&acc)[2][2][4][2], int row0, int c0) const {
        bf16* RWG = (bf16*)(ws + WS_RWG);
#pragma unroll
        for (int bj = 0; bj < 2; ++bj) { const int ch = c0 + bj * 128 - 2048;
#pragma unroll
            for (int ai = 0; ai < 2; ++ai)
#pragma unroll
                for (int m = 0; m < 4; ++m) { const size_t row = (size_t)(row0 + ai * 128 + m * 16); const f32x4 v0 = acc[ai][bj][m][0], v1 = acc[ai][bj][m][1];
                    v4u w; w.x = pk2(v0[0], v0[1]); w.y = pk2(v0[2], v0[3]); w.z = pk2(v1[0], v1[1]); w.w = pk2(v1[2], v1[3]); *(v4u*)(RWG + row * RWW + ch) = w; } }
    }
    __device__ __forceinline__ void grp_l(const f32x4 (&acc)[2][2][4][2], int row0, int c0) const {
        bf16* GAf = (bf16*)(ws + WS_LAF); bf16* GAb = (bf16*)(ws + WS_LAB);
#pragma unroll
        for (int bj = 0; bj < 2; ++bj) { const int ch = (c0 + bj * 128 - 2560) >> 1; const f32x4 gbf = *(const f32x4*)(in[20] + ch), gbb = *(const f32x4*)(in[20] + 256 + ch);
#pragma unroll
            for (int ai = 0; ai < 2; ++ai)
#pragma unroll
                for (int m = 0; m < 4; ++m) { const size_t row = (size_t)(row0 + ai * 128 + m * 16);
                    const f32x4 xf = acc[ai][bj][m][0] + gbf, xb = acc[ai][bj][m][1] + gbb; f32x4 af, ab;
#pragma unroll
                    for (int e = 0; e < 4; ++e) { const float lf = logsigmoidf_(xf[e]), lb = logsigmoidf_(xb[e]);
                        af[e] = lf * 0.0625f; ab[e] = lb * 0.0625f; }
                    { v2u o; o.x = pk2(af[0], af[1]); o.y = pk2(af[2], af[3]); *(v2u*)(GAf + row * 256 + ch) = o; o.x = pk2(ab[0], ab[1]); o.y = pk2(ab[2], ab[3]); *(v2u*)(GAb + row * 256 + ch) = o; } } }
    }
    __device__ __forceinline__ void operator()(const f32x4 (&acc)[2][2][4][2], const pg8::Unit& u, int wr, int wc, int fr, int fq) const {
        const int row0 = u.pm * 256 + wr * 64 + fr, c0 = u.pn * 256 + wc * 32 + 8 * fq;
        if (u.pn < 4) grp_w(acc, row0, c0); else if (u.pn < 8) grp_a(acc, row0, c0); else if (u.pn < 10) grp_g(acc, row0, c0); else grp_l(acc, row0, c0);
    }
};
__device__ __forceinline__ void ph_lora(Frame& F) {
    pg8::Gemm g{(const bf16*)(F.ws + WS_A2), (const bf16*)(F.ws + WS_WLORA), MR, NLORA, KLORA, nullptr};
    pg8::StaticOrder S; S.init(MR, NLORA, F.G, (int)blockIdx.x);
    EpiLora E{F.ws, F.in};
    pg8::gemm_phase<EpiLora, pg8::StaticOrder, true, true, false>(F.lds, g, S, E);
}

__device__ __forceinline__ void ph_merge(Frame& F) {
    unsigned char* ws = F.ws; const int lane = F.lane;
    const bf16* ORf = (const bf16*)(ws + WS_ORWF); const bf16* ORb = (const bf16*)(ws + WS_ORWB); const bf16* OGf = (const bf16*)(ws + WS_OGLF); const bf16* OGb = (const bf16*)(ws + WS_OGLB);
    const bf16* R = (const bf16*)(ws + WS_RB); const bf16* V = (const bf16*)(ws + WS_VB); const bf16* KSUM = (const bf16*)(ws + WS_KSUM); const bf16* RWG = (const bf16*)(ws + WS_RWG);
    const bf16* P = (const bf16*)(ws + WS_P);
    bf16* YRW = (bf16*)(ws + WS_YRW); bf16* YGLA = (bf16*)(ws + WS_YGLA);
    float rk[8], gw[8], gbv[8], ggw[8], ggb[8];
    ld8(F.in[15] + 8 * lane, rk); ld8(F.in[16] + 8 * lane, gw); ld8(F.in[17] + 8 * lane, gbv); ld8(F.in[21] + 8 * lane, ggw); ld8(F.in[22] + 8 * lane, ggb);
    for (int m0 = F.gw; m0 < NLAT; m0 += 2 * F.NGW) {
        const int m1 = (m0 + F.NGW < NLAT) ? m0 + F.NGW : m0;
        v4u wa[2], wb[2], wc[2], wd[2], wr[2], wv[2], wk[2], wg[2], wo[2];
#pragma unroll
        for (int r2 = 0; r2 < 2; ++r2) { const int m = r2 ? m1 : m0; const size_t ro = (size_t)m * RWW + 8 * lane;
            wa[r2] = *(const v4u*)(ORf + ro); wb[r2] = *(const v4u*)(ORb + ro); wc[r2] = *(const v4u*)(OGf + ro); wd[r2] = *(const v4u*)(OGb + ro);
            wr[r2] = *(const v4u*)(R + ro); wv[r2] = *(const v4u*)(V + ro); wk[r2] = *(const v4u*)(KSUM + ro); wg[r2] = *(const v4u*)(RWG + ro);
            wo[r2] = *(const v4u*)(P + (size_t)m * NP + C_OG + 8 * lane); }
#pragma unroll
        for (int r2 = 0; r2 < 2; ++r2) { const int m = r2 ? m1 : m0; const size_t ro = (size_t)m * RWW + 8 * lane;
        {
            float a[8], b[8], o[8]; unp8(wa[r2], a); unp8(wb[r2], b);
            float s = 0.f;
#pragma unroll
            for (int e = 0; e < 8; ++e) { o[e] = a[e] + b[e]; s += o[e]; }
            s += __shfl_xor(s, 1); s += __shfl_xor(s, 2); s += __shfl_xor(s, 4);
            const float mean = s * (1.f / 64.f); float q = 0.f;
#pragma unroll
            for (int e = 0; e < 8; ++e) { o[e] -= mean; q += o[e] * o[e]; }
            q += __shfl_xor(q, 1); q += __shfl_xor(q, 2); q += __shfl_xor(q, 4);
            const float rstd = __builtin_amdgcn_rsqf(q * (1.f / 64.f) + RW_GN_EPS);
            float r[8], v[8], ksm[8], g[8]; unp8(wr[r2], r); unp8(wv[r2], v); unp8(wk[r2], ksm); unp8(wg[r2], g);
            float bs = 0.f;
#pragma unroll
            for (int e = 0; e < 8; ++e) bs += r[e] * ksm[e] * rk[e];
            bs += __shfl_xor(bs, 1); bs += __shfl_xor(bs, 2); bs += __shfl_xor(bs, 4);
            float y[8];
#pragma unroll
            for (int e = 0; e < 8; ++e) y[e] = (o[e] * rstd * gw[e] + gbv[e] + bs * v[e]) * g[e];
            *(v4u*)(YRW + ro) = pk8(y);
        }
        {
            float a[8], b[8], o[8]; unp8(wc[r2], a); unp8(wd[r2], b);
            float s = 0.f;
#pragma unroll
            for (int e = 0; e < 8; ++e) { o[e] = a[e] + b[e]; s += o[e]; }
            s += __shfl_xor(s, 1); s += __shfl_xor(s, 2); s += __shfl_xor(s, 4); s += __shfl_xor(s, 8);
            const float mean = s * (1.f / 128.f); float q = 0.f;
#pragma unroll
            for (int e = 0; e < 8; ++e) { o[e] -= mean; q += o[e] * o[e]; }
            q += __shfl_xor(q, 1); q += __shfl_xor(q, 2); q += __shfl_xor(q, 4); q += __shfl_xor(q, 8);
            const float rstd = __builtin_amdgcn_rsqf(q * (1.f / 128.f) + LN_EPS);
            float og[8]; unp8(wo[r2], og);
            float y[8];
#pragma unroll
            for (int e = 0; e < 8; ++e) y[e] = (o[e] * rstd * ggw[e] + ggb[e]) * siluf_(og[e]);
            *(v4u*)(YGLA + ro) = pk8(y);
        }
        }
    }
}

template <int WHICH> struct EpiBranch {
    static constexpr bool PERM = true;
    bf16* Z; const bf16* P;
    __device__ __forceinline__ void operator()(const f32x4 (&acc)[2][2][4][2], const pg8::Unit& u, int wr, int wc, int fr, int fq) const {
        const int row0 = u.pm * 256 + wr * 64 + fr, col0 = u.pn * 256 + wc * 32 + 8 * fq;
#pragma unroll
        for (int ah = 0; ah < 4; ++ah) { const int ai = ah >> 1, mb = 2 * (ah & 1);
            v4u gw[2][2], zw[2][2];
#pragma unroll
            for (int m = 0; m < 2; ++m) { const size_t row = (size_t)(row0 + ai * 128 + (mb + m) * 16);
#pragma unroll
                for (int bj = 0; bj < 2; ++bj) { const int c = col0 + bj * 128;
                    gw[m][bj] = *(const v4u*)(P + row * NP + (WHICH ? C_GGLA : C_GRW) + c);
                    if (WHICH) zw[m][bj] = *(const v4u*)(Z + row * D + c); } }
            __builtin_amdgcn_sched_barrier(0);
#pragma unroll
            for (int m = 0; m < 2; ++m) { const size_t row = (size_t)(row0 + ai * 128 + (mb + m) * 16);
#pragma unroll
                for (int bj = 0; bj < 2; ++bj) { const int c = col0 + bj * 128;
                    float g[8]; unp8(gw[m][bj], g);
                    const f32x4 v0 = acc[ai][bj][mb + m][0], v1 = acc[ai][bj][mb + m][1];
                    float z[8];
#pragma unroll
                    for (int e = 0; e < 4; ++e) { z[e] = sigmoidf_(g[e]) * v0[e]; z[4 + e] = sigmoidf_(g[4 + e]) * v1[e]; }
                    if (WHICH) { float zo[8]; unp8(zw[m][bj], zo);
#pragma unroll
                        for (int e = 0; e < 8; ++e) z[e] += zo[e]; }
                    *(v4u*)(Z + row * D + c) = pk8(z); } }
        }
    }
};
__device__ __forceinline__ void ph_branch(Frame& F) {
    pg8::StaticOrder S; S.init(NLAT, D, F.G, (int)blockIdx.x);
    { pg8::Gemm g{(const bf16*)(F.ws + WS_YRW), (const bf16*)(F.ws + WS_WBRRW), NLAT, D, RWW, nullptr};
      EpiBranch<0> E{(bf16*)(F.ws + WS_Z), (const bf16*)(F.ws + WS_P)};
      pg8::gemm_phase<EpiBranch<0>, pg8::StaticOrder, true, true, false>(F.lds, g, S, E); }
    { pg8::Gemm g{(const bf16*)(F.ws + WS_YGLA), (const bf16*)(F.ws + WS_WBRGLA), NLAT, D, RWW, nullptr};
      EpiBranch<1> E{(bf16*)(F.ws + WS_Z), (const bf16*)(F.ws + WS_P)};
      pg8::gemm_phase<EpiBranch<1>, pg8::StaticOrder, true, true, false>(F.lds, g, S, E); }
}
struct EpiOut {
    static constexpr bool PERM = true;
    bf16* X1P; const float* x; const float* mod;
    __device__ __forceinline__ void operator()(const f32x4 (&acc)[2][2][4][2], const pg8::Unit& u, int wr, int wc, int fr, int fq) const {
        const int row0 = u.pm * 256 + wr * 64 + fr, col0 = u.pn * 256 + wc * 32 + 8 * fq; const float* g1 = mod + (u.pm / (SEQ / 256)) * 6144 + 2048;
        f32x4 gv[2][2];
#pragma unroll
        for (int bj = 0; bj < 2; ++bj)
#pragma unroll
            for (int n = 0; n < 2; ++n) gv[bj][n] = *(const f32x4*)(g1 + col0 + bj * 128 + 4 * n);
#pragma unroll
        for (int ah = 0; ah < 4; ++ah) { const int ai = ah >> 1, mb = 2 * (ah & 1);
            f32x4 xv[2][2][2];
#pragma unroll
            for (int m = 0; m < 2; ++m) { const size_t ro = (size_t)(row0 + ai * 128 + (mb + m) * 16) * D;
#pragma unroll
                for (int bj = 0; bj < 2; ++bj)
#pragma unroll
                    for (int n = 0; n < 2; ++n) xv[m][bj][n] = *(const f32x4*)(x + ro + col0 + bj * 128 + 4 * n); }
            __builtin_amdgcn_sched_barrier(0);
#pragma unroll
            for (int m = 0; m < 2; ++m) { const size_t ro = (size_t)(row0 + ai * 128 + (mb + m) * 16) * D;
#pragma unroll
                for (int bj = 0; bj < 2; ++bj) { const f32x4 a = xv[m][bj][0] * ALPHA + gv[bj][0] * acc[ai][bj][mb + m][0], b = xv[m][bj][1] * ALPHA + gv[bj][1] * acc[ai][bj][mb + m][1];
                    v4u w; w.x = pk2(a.x, a.y); w.y = pk2(a.z, a.w); w.z = pk2(b.x, b.y); w.w = pk2(b.z, b.w); *(v4u*)(X1P + ro + col0 + bj * 128) = w; } }
        }
    }
};
__device__ __forceinline__ void ph_outproj(Frame& F) {
    pg8::Gemm g{(const bf16*)(F.ws + WS_Z), (const bf16*)(F.ws + WS_WOUT), NLAT, D, D, nullptr};
    pg8::StaticOrder S; S.init(NLAT, D, F.G, (int)blockIdx.x);
    EpiOut E{(bf16*)(F.ws + WS_X1), F.in[0], (const float*)(F.ws + WS_MOD)};
    pg8::gemm_phase<EpiOut, pg8::StaticOrder, true, true, false>(F.lds, g, S, E);
}
#endif

#if MS >= 3
constexpr int LP = 72, SLOTB = 64 * LP * 2, LPF = 68, AUX_OFF = 13 * SLOTB;
static_assert(AUX_OFF + 4096 <= MISC_OFF, "scan LDS map");
#define SLOT(n) ((LAS bf16*)(lds + (n) * SLOTB))
__device__ __forceinline__ int scan_row(int s, int b, int dir) {
    if (s < CTXL) return NLAT + b * CTXL + (dir ? (CTXL - 1 - s) : s);
    const int lt = s - CTXL; return b * SEQ + (dir ? (SEQ - 1 - lt) : lt);
}
__device__ __forceinline__ unsigned pk2z(float x) { return pk2(x, 0.f); }
__device__ __forceinline__ float bf2f(bf16 h) { return __builtin_bit_cast(float, (unsigned)h << 16); }
__device__ __forceinline__ v2u pack4(const f32x4 v) { v2u o; o.x = pk2(v[0], v[1]); o.y = pk2(v[2], v[3]); return o; }
__device__ __forceinline__ float clamp8(float x) { return __builtin_amdgcn_fmed3f(x, -448.0f, 448.0f); }
__device__ __forceinline__ unsigned pack4_fp8(const f32x4 v) { int w = __builtin_amdgcn_cvt_pk_fp8_f32(clamp8(v[0]), clamp8(v[1]), 0, false); return (unsigned)__builtin_amdgcn_cvt_pk_fp8_f32(clamp8(v[2]), clamp8(v[3]), w, true); }
__device__ __forceinline__ f32x4 unpack4_fp8(unsigned w) { const f32x2 lo = __builtin_amdgcn_cvt_pk_f32_fp8((int)w, false), hi = __builtin_amdgcn_cvt_pk_f32_fp8((int)w, true); return (f32x4){lo.x, lo.y, hi.x, hi.y}; }
__device__ __forceinline__ f32x4 unpack4(const v2u w) { return (f32x4){bflo(w.x), bfhi(w.x), bflo(w.y), bfhi(w.y)}; }
__device__ __forceinline__ f32x4 mm_tile(const LAS bf16* X, int r0, const LAS bf16* Y, int c0, int lane) {
    const int rr = lane & 15, q = lane >> 4;
    const LAS bf16* xp = X + (r0 + rr) * LP + 8 * q; const LAS bf16* yp = Y + (c0 + rr) * LP + 8 * q;
    const bf16x8 a0 = *(const LAS bf16x8*)xp, a1 = *(const LAS bf16x8*)(xp + 32), b0 = *(const LAS bf16x8*)yp, b1 = *(const LAS bf16x8*)(yp + 32);
    f32x4 acc = (f32x4){0.f, 0.f, 0.f, 0.f};
    acc = __builtin_amdgcn_mfma_f32_16x16x32_bf16(a0, b0, acc, 0, 0, 0);
    acc = __builtin_amdgcn_mfma_f32_16x16x32_bf16(a1, b1, acc, 0, 0, 0);
    return acc;
}
__device__ __forceinline__ float red8(float x) {
    x += __builtin_bit_cast(float, __builtin_amdgcn_update_dpp(0, __builtin_bit_cast(int, x), 0x141, 0xf, 0xf, false));
    x += __builtin_bit_cast(float, __builtin_amdgcn_update_dpp(0, __builtin_bit_cast(int, x), 0xB1, 0xf, 0xf, false));
    x += __builtin_bit_cast(float, __builtin_amdgcn_update_dpp(0, __builtin_bit_cast(int, x), 0x4E, 0xf, 0xf, false));
    return x;
}

#define S1_BAR() do { asm volatile("s_waitcnt lgkmcnt(0)" ::: "memory"); __builtin_amdgcn_s_barrier(); asm volatile("" ::: "memory"); } while (0)
struct RwIn { bf16 lw[8], r[8], k[8], a[8], b[8], v[8]; };
__device__ __forceinline__ void s1_rwkv_load(Frame& F, int u, RwIn& I) {
    const int sr = u / NCHUNK, c = u - sr * NCHUNK, rb = sr >> 4, rdir = (sr >> 3) & 1, rh = sr & 7; unsigned char* ws = F.ws;
    const bf16* RBp = (const bf16*)(ws + WS_RB); const bf16* VBp = (const bf16*)(ws + WS_VB); const bf16* KKp = (const bf16*)(ws + WS_KKB);
    const bf16* KMp = (const bf16*)(ws + (rdir ? WS_KMB : WS_KMF)); const bf16* BVp = (const bf16*)(ws + (rdir ? WS_BVB : WS_BVF)); const bf16* LWp = (const bf16*)(ws + (rdir ? WS_LWB : WS_LWF));
#pragma unroll
    for (int i = 0; i < 8; ++i) { const int row = scan_row(c * CH + 8 * F.wave + i, rb, rdir); const size_t base = (size_t)row * RWW + rh * 64 + F.lane;
        I.lw[i] = LWp[base]; I.r[i] = RBp[base]; I.k[i] = KMp[base]; I.a[i] = KKp[base]; I.b[i] = BVp[base]; I.v[i] = VBp[base]; }
}
__device__ __forceinline__ void s1_rwkv(Frame& F, int u, const RwIn& I, int un, RwIn& Inext, f32x2v (&cv)[32], int& cpend, int cvi) {
    const int sr = u / NCHUNK, c = u - sr * NCHUNK;
    const bool emit = c >= CTXL / CH;
    LAS unsigned char* lds = F.lds; unsigned char* ws = F.ws;
    int lane_ = F.lane; asm volatile("" : "+v"(lane_));
    const int lane = lane_, wave = F.wave, rr = lane & 15, q = lane >> 4;
    LAS float* tot = (LAS float*)(lds + AUX_OFF); LAS float* gCs = tot + 512;
    {
        float lw[8], xr[8], xk[8], xa[8], xb[8], xv[8];
#pragma unroll
        for (int i = 0; i < 8; ++i) { lw[i] = bf2f(I.lw[i]); xr[i] = bf2f(I.r[i]); xk[i] = bf2f(I.k[i]); xa[i] = -bf2f(I.a[i]); xb[i] = bf2f(I.b[i]); xv[i] = bf2f(I.v[i]); }
        float p[8]; p[0] = lw[0];
#pragma unroll
        for (int i = 1; i < 8; ++i) p[i] = p[i - 1] + lw[i];
        tot[wave * 64 + lane] = p[7];
        S1_BAR();
        float off = 0.f, all = 0.f;
#pragma unroll
        for (int w = 0; w < 8; ++w) { const float t = tot[w * 64 + lane]; all += t; off += (w < wave) ? t : 0.f; }
        if (wave == 0) gCs[lane] = __expf(all);
        float at[8], bb[8], kb[8];
#pragma unroll
        for (int i = 0; i < 8; ++i) { const float cum = off + p[i]; const float g = __expf(cum), gi = __expf(-cum), gp = __expf(cum - lw[i]), gc = __expf(all - cum);
            const int t = 8 * wave + i;
            at[i] = xa[i] * gp; bb[i] = xb[i] * gc; kb[i] = xk[i] * gc;
            SLOT(0)[t * LP + lane] = (bf16)pk2z(at[i]);
            SLOT(1)[t * LP + lane] = (bf16)pk2z(xr[i] * g);
            SLOT(2)[t * LP + lane] = (bf16)pk2z(xb[i] * gi);
            SLOT(3)[t * LP + lane] = (bf16)pk2z(xk[i] * gi); }
        *(LAS v4u*)(SLOT(4) + lane * LP + 8 * wave) = pk8(at);
        *(LAS v4u*)(SLOT(5) + lane * LP + 8 * wave) = pk8(xv);
        *(LAS v4u*)(SLOT(6) + lane * LP + 8 * wave) = pk8(bb);
        *(LAS v4u*)(SLOT(7) + lane * LP + 8 * wave) = pk8(kb);
        S1_BAR();
    }
    if (wave < 4) s1_rwkv_load(F, un, Inext);
    LAS float* Lp = (LAS float*)(lds + 8 * SLOTB);
#pragma unroll
    for (int tix = 0; tix < 2; ++tix) { const int ti = 2 * wave + tix, r0 = 16 * (ti >> 2), c0 = 16 * (ti & 3), ci = c0 + rr;
        { const f32x4 acc = mm_tile(SLOT(2), r0, SLOT(0), c0, lane);
#pragma unroll
            for (int e = 0; e < 4; ++e) { const int i = r0 + 4 * q + e; Lp[ci * LPF + (i & 3) * 16 + (i >> 2)] = (i < ci) ? acc[e] : 0.f; } }
        { f32x4 acc = mm_tile(SLOT(0), r0, SLOT(3), c0, lane);
#pragma unroll
            for (int e = 0; e < 4; ++e) acc[e] = (ci < r0 + 4 * q + e) ? acc[e] : 0.f;
            *(LAS v2u*)(SLOT(10) + ci * LP + r0 + 4 * q) = pack4(acc); }
        if (emit) {
            { f32x4 acc = mm_tile(SLOT(2), r0, SLOT(1), c0, lane);
#pragma unroll
                for (int e = 0; e < 4; ++e) acc[e] = (r0 + 4 * q + e <= ci) ? acc[e] : 0.f;
                *(LAS v2u*)(SLOT(11) + ci * LP + r0 + 4 * q) = pack4(acc); }
            { f32x4 acc = mm_tile(SLOT(3), r0, SLOT(1), c0, lane);
#pragma unroll
                for (int e = 0; e < 4; ++e) acc[e] = (r0 + 4 * q + e <= ci) ? acc[e] : 0.f;
                *(LAS v2u*)(SLOT(12) + ci * LP + r0 + 4 * q) = pack4(acc); }
        }
    }
    S1_BAR();
    if (wave < 4) {
        const int j = 16 * wave + (lane >> 2), s = lane & 3;
        float Tr[16];
#pragma unroll
        for (int m = 0; m < 16; ++m) Tr[m] = 0.f;
        const LAS float* lrow = Lp + s * 16;
        f32x4 lb[3][4];
#pragma unroll
        for (int t = 0; t < 2; ++t) lb[t][0] = *(const LAS f32x4*)(lrow + t * LPF);
#pragma unroll
        for (int t = 0; t < 64; ++t) {
            if (t + 2 < 64) {
#pragma unroll
                for (int k = 0; k < 4; ++k) if (4 * k <= (t + 2) / 4) lb[(t + 2) % 3][k] = *(const LAS f32x4*)(lrow + (t + 2) * LPF + 4 * k);
            }
            __builtin_amdgcn_sched_barrier(0);
            float acc0 = 0.f, acc1 = 0.f;
#pragma unroll
            for (int m = 0; m < 16; ++m) if (m <= t / 4) { const float lv = lb[t % 3][m >> 2][m & 3]; if (m & 1) acc1 += lv * Tr[m]; else acc0 += lv * Tr[m]; }
            float acc = acc0 + acc1;
            acc += __builtin_bit_cast(float, __builtin_amdgcn_update_dpp(0, __builtin_bit_cast(int, acc), 0xB1, 0xf, 0xf, false));
            acc += __builtin_bit_cast(float, __builtin_amdgcn_update_dpp(0, __builtin_bit_cast(int, acc), 0x4E, 0xf, 0xf, false));
            int jj = j, ss = s; asm volatile("" : "+v"(jj), "+v"(ss));
            const float val = acc + ((t == jj) ? 1.f : 0.f);
            Tr[t >> 2] = (ss == (t & 3)) ? val : Tr[t >> 2];
            SLOT(0)[t * LP + j] = (bf16)pk2z(val);
        }
    } else { CVY_FLUSH(); s1_rwkv_load(F, un, Inext); CVY_START(cvi); }
    S1_BAR();
#pragma unroll
    for (int tix = 0; tix < 2; ++tix) { const int ti = 2 * wave + tix, r0 = 16 * (ti >> 2), c0 = 16 * (ti & 3), ci = c0 + rr;
        { const f32x4 acc = mm_tile(SLOT(0), r0, SLOT(4), c0, lane); *(LAS v2u*)(SLOT(2) + ci * LP + r0 + 4 * q) = pack4(acc); }
        { const f32x4 acc = mm_tile(SLOT(0), r0, SLOT(10), c0, lane); *(LAS v2u*)(SLOT(3) + ci * LP + r0 + 4 * q) = pack4(acc); }
    }
    S1_BAR();
    unsigned char* RH = ws + WS_RH + (size_t)u * 4096; bf16* GT = (bf16*)((unsigned char*)F.out + OUT_GT) + (size_t)u * 4096;
#pragma unroll
    for (int tix = 0; tix < 2; ++tix) { const int ti = 2 * wave + tix, tr = ti >> 2, r0 = 16 * tr, c0 = 16 * (ti & 3), ci = c0 + rr;
        const int pos = (tr >> 1) * 32 + q * 8 + 4 * (tr & 1);
        if (emit) {
            { f32x4 acc = mm_tile(SLOT(2), r0, SLOT(11), c0, lane);
                acc += unpack4(*(const LAS v2u*)(SLOT(1) + ci * LP + r0 + 4 * q));
                *(unsigned*)(RH + ci * 64 + pos) = pack4_fp8(acc); }
            { f32x4 acc = mm_tile(SLOT(3), r0, SLOT(11), c0, lane);
                acc += unpack4(*(const LAS v2u*)(SLOT(12) + ci * LP + r0 + 4 * q));
                *(LAS v2u*)(SLOT(4) + ci * LP + r0 + 4 * q) = pack4(acc); }
        }
        { f32x4 acc = mm_tile(SLOT(2), r0, SLOT(6), c0, lane);
            const float gc = gCs[ci];
#pragma unroll
            for (int e = 0; e < 4; ++e) acc[e] += (r0 + 4 * q + e == ci) ? gc : 0.f;
            *(v2u*)(GT + ci * 64 + pos) = pack4(acc); }
    }
    S1_BAR();
    unsigned char* YL = ws + WS_YL + (size_t)u * 4096;
#pragma unroll
    for (int tix = 0; tix < 2; ++tix) { const int ti = 2 * wave + tix, r0 = 16 * (ti >> 2), c0 = 16 * (ti & 3), ci = c0 + rr;
        if (emit) { const f32x4 acc = mm_tile(SLOT(5), r0, SLOT(4), c0, lane); *(unsigned*)(YL + ci * 64 + r0 + 4 * q) = pack4_fp8(acc); }
        { f32x4 acc = mm_tile(SLOT(3), r0, SLOT(6), c0, lane);
            acc += unpack4(*(const LAS v2u*)(SLOT(7) + ci * LP + r0 + 4 * q));
            *(LAS v2u*)(SLOT(8) + ci * LP + r0 + 4 * q) = pack4(acc); }
    }
    S1_BAR();
    bf16* HH = (bf16*)(ws + WS_HH) + (size_t)u * 4096;
#pragma unroll
    for (int tix = 0; tix < 2; ++tix) { const int ti = 2 * wave + tix, r0 = 16 * (ti >> 2), c0 = 16 * (ti & 3), ci = c0 + rr;
        const f32x4 acc = mm_tile(SLOT(8), r0, SLOT(5), c0, lane);
        *(v2u*)(HH + ci * 64 + r0 + 4 * q) = pack4(acc); }
    S1_BAR();
}

struct GlIn { bf16 la[8], q[8], k[8], v0[8], v1[8]; };
__device__ __forceinline__ void s1_gla_load(Frame& F, int u, GlIn& I) {
    const int sg = u / NCHUNK, c = u - sg * NCHUNK, gb = sg >> 3, gdir = (sg >> 2) & 1, gh = sg & 3; unsigned char* ws = F.ws;
    const bf16* Qp = (const bf16*)(ws + WS_QGB); const bf16* Kp = (const bf16*)(ws + WS_KGB); const bf16* Vp = (const bf16*)(ws + WS_VGB); const bf16* LAp = (const bf16*)(ws + (gdir ? WS_LAB : WS_LAF));
#pragma unroll
    for (int i = 0; i < 8; ++i) { const int row = scan_row(c * CH + 8 * F.wave + i, gb, gdir); const size_t b2 = (size_t)row * 256 + gh * 64 + F.lane, b5 = (size_t)row * RWW + gh * 128 + F.lane;
        I.la[i] = LAp[b2]; I.q[i] = Qp[b2]; I.k[i] = Kp[b2]; I.v0[i] = Vp[b5]; I.v1[i] = Vp[b5 + 64]; }
}
__device__ __forceinline__ void s1_gla(Frame& F, int u, const GlIn& I, int un, GlIn& Inext, f32x2v (&cv)[32], int& cpend, int cvi) {
    const int sg = u / NCHUNK, c = u - sg * NCHUNK;
    const bool emit = c >= CTXL / CH;
    LAS unsigned char* lds = F.lds; unsigned char* ws = F.ws;
    int lane_ = F.lane; asm volatile("" : "+v"(lane_));
    const int lane = lane_, wave = F.wave, rr = lane & 15, q = lane >> 4;
    LAS float* tot = (LAS float*)(lds + AUX_OFF);
    unsigned char* QE = (unsigned char*)F.out + OUT_QE + (size_t)u * 4096;
    {
        float la[8], xq[8], xk[8], v0[8], v1[8];
#pragma unroll
        for (int i = 0; i < 8; ++i) { la[i] = bf2f(I.la[i]); xq[i] = bf2f(I.q[i]); xk[i] = bf2f(I.k[i]); v0[i] = bf2f(I.v0[i]); v1[i] = bf2f(I.v1[i]); }
        float p[8]; p[0] = la[0];
#pragma unroll
        for (int i = 1; i < 8; ++i) p[i] = p[i - 1] + la[i];
        tot[wave * 64 + lane] = p[7];
        S1_BAR();
        float off = 0.f, all = 0.f;
#pragma unroll
        for (int w = 0; w < 8; ++w) { const float t = tot[w * 64 + lane]; all += t; off += (w < wave) ? t : 0.f; }
        if (wave == 0) ((float*)(ws + WS_DD))[(size_t)u * 64 + lane] = __expf(all);
        float kl[8];
#pragma unroll
        for (int i = 0; i < 8; ++i) { const float cum = off + p[i]; const int t = 8 * wave + i;
            const float qef = xq[i] * __expf(cum);
            SLOT(0)[t * LP + lane] = (bf16)pk2z(qef);
            if (emit) QE[t * 64 + lane] = (unsigned char)__builtin_amdgcn_cvt_pk_fp8_f32(clamp8(qef), 0.f, 0, false);
            SLOT(1)[t * LP + lane] = (bf16)pk2z(xk[i] * __expf(-cum));
            kl[i] = xk[i] * __expf(all - cum); }
        *(LAS v4u*)(SLOT(2) + lane * LP + 8 * wave) = pk8(kl);
        *(LAS v4u*)(SLOT(3) + lane * LP + 8 * wave) = pk8(v0);
        *(LAS v4u*)(SLOT(3) + (64 + lane) * LP + 8 * wave) = pk8(v1);
        S1_BAR();
    }
    if (wave >= 4) { CVY_FLUSH(); s1_gla_load(F, un, Inext); CVY_START(cvi); }
    else if (emit) {
#pragma unroll
        for (int tix = 0; tix < 4; ++tix) { const int ti = 4 * wave + tix, r0 = 16 * (ti >> 2), c0 = 16 * (ti & 3), ci = c0 + rr;
            f32x4 acc = mm_tile(SLOT(1), r0, SLOT(0), c0, lane);
#pragma unroll
            for (int e = 0; e < 4; ++e) acc[e] = (r0 + 4 * q + e <= ci) ? acc[e] : 0.f;
            *(LAS v2u*)(SLOT(5) + ci * LP + r0 + 4 * q) = pack4(acc); }
    }
    bf16* KV = (bf16*)(ws + WS_KV) + (size_t)u * 8192;
#pragma unroll
    for (int tix = 0; tix < 4; ++tix) { const int ti = 4 * wave + tix, r0 = 16 * (ti >> 3), c0 = 16 * (ti & 7), ci = c0 + rr;
        const f32x4 acc = mm_tile(SLOT(2), r0, SLOT(3), c0, lane);
        *(v2u*)(KV + ci * 64 + r0 + 4 * q) = pack4(acc); }
    S1_BAR();
    if (emit) {
        unsigned char* IN = ws + WS_INTRA + (size_t)u * 8192;
#pragma unroll
        for (int tix = 0; tix < 4; ++tix) { const int ti = 4 * wave + tix, r0 = 16 * (ti >> 2), c0 = 16 * (ti & 3), ci = c0 + rr;
            const f32x4 acc = mm_tile(SLOT(3), r0, SLOT(5), c0, lane);
            *(unsigned*)(IN + ci * 128 + r0 + 4 * q) = pack4_fp8(acc); }
    }
    S1_BAR();
}

__device__ __forceinline__ void ph_scan1(Frame& F) {
    f32x2v cv[32]; int cpend = -1; const int lane = F.lane;
    int item = (int)blockIdx.x * 4 + (F.wave & 3);
    { RwIn cur, nxt; if ((int)blockIdx.x < NU_RW) s1_rwkv_load(F, blockIdx.x, cur);
#pragma unroll 1
      for (int u = blockIdx.x; u < NU_RW; u += F.G, item += F.G * 4) { const int un = (u + F.G < NU_RW) ? u + F.G : u; s1_rwkv(F, u, cur, un, nxt, cv, cpend, item); cur = nxt; } }
    { GlIn cur, nxt; if ((int)blockIdx.x < NU_GL) s1_gla_load(F, blockIdx.x, cur);
#pragma unroll 1
      for (int u = blockIdx.x; u < NU_GL; u += F.G, item += F.G * 4) { const int un = (u + F.G < NU_GL) ? u + F.G : u; if (F.wave < 4) s1_gla_load(F, un, nxt); s1_gla(F, u, cur, un, nxt, cv, cpend, item); cur = nxt; } }
    if (F.wave >= 4) CVY_FLUSH();
}

__device__ __forceinline__ bf16x8 pack_frag(const f32x4 lo, const f32x4 hi) {
    v4u w; w.x = pk2(lo[0], lo[1]); w.y = pk2(lo[2], lo[3]); w.z = pk2(hi[0], hi[1]); w.w = pk2(hi[2], hi[3]); return __builtin_bit_cast(bf16x8, w);
}
constexpr int S2_D = 5, S2_R = 6, S2_RW = 8192 + 4096 + 2048 + 1024, S2_GL = 4096 + 2048 + 1024 + 1024, S2_SLOT = S2_RW + S2_GL;
static_assert(S2_R * S2_SLOT <= MISC_OFF, "S2 ring fits in LDS");
__device__ __forceinline__ void s2_piece(int k, int lane, size_t ur0, size_t ug0, int v0r, int v0g,
                                         const unsigned char* GTb, const unsigned char* RHb, const unsigned char* HHb, const unsigned char* YLb,
                                         const unsigned char* QEb, const unsigned char* KVb, const unsigned char* INb, const unsigned char* DDb,
                                         const unsigned char*& src, int& stride, int& ldo) {
    if (k < 8) { const int n = k, pu = n * 64 + lane, row = pu >> 3, c16 = (pu & 7) ^ (row & 7);
        src = GTb + ur0 * 8192 + row * 128 + c16 * 16; stride = 8192; ldo = n * 1024; }
    else if (k < 12) { const int n = k - 8, pu = n * 64 + lane, row = pu >> 2, c16 = (pu & 3) ^ (row & 3);
        src = RHb + ur0 * 4096 + row * 64 + c16 * 16; stride = 4096; ldo = 8192 + n * 1024; }
    else if (k < 14) { const int n = k - 12, pu = n * 64 + lane, v = pu >> 3, c16 = (pu & 7) ^ (v & 7);
        src = HHb + ur0 * 8192 + (size_t)(v0r + v) * 128 + c16 * 16; stride = 8192; ldo = 12288 + n * 1024; }
    else if (k < 15) { const int t = lane;
        src = YLb + ur0 * 4096 + t * 64 + v0r; stride = 4096; ldo = 14336; }
    else if (k < 19) { const int n = k - 15, pu = n * 64 + lane, row = pu >> 2, c16 = (pu & 3) ^ (row & 3);
        src = QEb + ug0 * 4096 + row * 64 + c16 * 16; stride = 4096; ldo = S2_RW + n * 1024; }
    else if (k < 21) { const int n = k - 19, pu = n * 64 + lane, v = pu >> 3, c16 = (pu & 7) ^ (v & 7);
        src = KVb + ug0 * 16384 + (size_t)(v0g + v) * 128 + c16 * 16; stride = 16384; ldo = S2_RW + 4096 + n * 1024; }
    else if (k < 22) { const int t = lane;
        src = INb + ug0 * 8192 + t * 128 + v0g; stride = 8192; ldo = S2_RW + 6144; }
    else { src = DDb + ug0 * 256 + (lane & 15) * 16; stride = 256; ldo = S2_RW + 7168; }
}
__device__ __forceinline__ void ph_scan2(Frame& F) {
    const int lane = F.lane, wave = F.wave, rr = lane & 15, q = lane >> 4; unsigned char* ws = F.ws; LAS unsigned char* lds = F.lds;
    const int it = (F.G == 256) ? (int)(blockIdx.x & 7) * 32 + (int)(blockIdx.x >> 3) : (int)blockIdx.x;
    const int sr = it >> 2, v0r = 16 * (it & 3), rb = sr >> 4, rdir = (sr >> 3) & 1, rh = sr & 7;
    const int sg = it >> 3, v0g = 16 * (it & 7), gb = sg >> 3, gdir = (sg >> 2) & 1, gh = sg & 3;
#define S2_BAR() do { asm volatile("s_waitcnt lgkmcnt(0)" ::: "memory"); __builtin_amdgcn_s_barrier(); asm volatile("" ::: "memory"); } while (0)
#define S2_NEXT_SLOT() do { slot = (slot + 1 == S2_R) ? 0 : slot + 1; } while (0)
    LAS unsigned char* sfr = lds + S2_SF_OFF + lane * 16;
    LAS unsigned char* sfg = sfr + 4096;
    if (wave >= 6) {
        const unsigned char* GTb = (const unsigned char*)F.out + OUT_GT; const unsigned char* QEb = (const unsigned char*)F.out + OUT_QE;
        const unsigned char* RHb = ws + WS_RH; const unsigned char* YLb = ws + WS_YL; const unsigned char* HHb = ws + WS_HH; const unsigned char* KVb = ws + WS_KV; const unsigned char* INb = ws + WS_INTRA;
        const unsigned char* DDb = ws + WS_DD;
        const unsigned char* pj[12]; int sj[12], lj[12];
#pragma unroll
        for (int j = 0; j < 12; ++j) { int k = (wave - 6) * 12 + j; if (k >= 23) k = 22;
            s2_piece(k, lane, (size_t)sr * NCHUNK, (size_t)sg * NCHUNK, v0r, v0g, GTb, RHb, HHb, YLb, QEb, KVb, INb, DDb, pj[j], sj[j], lj[j]);
            sj[j] = __builtin_amdgcn_readfirstlane(sj[j]); lj[j] = __builtin_amdgcn_readfirstlane(lj[j]); }
#define S2_ISSUE(cc, sl_) do { const int _c = (cc) < NCHUNK ? (cc) : NCHUNK - 1; _Pragma("unroll") for (int j = 0; j < 12; ++j) \
            __builtin_amdgcn_global_load_lds((const unsigned*)(pj[j] + (size_t)_c * sj[j]), (LAS unsigned*)(lds + (sl_) * S2_SLOT + lj[j]), 16, 0, 0); } while (0)
        S2_ISSUE(0, 0); S2_ISSUE(1, 1); S2_ISSUE(2, 2); S2_ISSUE(3, 3); S2_ISSUE(4, 4);
        int slot = S2_D % S2_R;
#pragma unroll 1
        for (int c = 0; c < NCHUNK; ++c) {
            asm volatile("s_waitcnt vmcnt(48) ; S2WAIT" ::: "memory");
            S2_BAR();
            S2_ISSUE(c + S2_D, slot);
            S2_NEXT_SLOT();
        }
#undef S2_ISSUE
    } else if (wave == 0) {
        f32x4 S[4];
#pragma unroll
        for (int m = 0; m < 4; ++m) S[m] = (f32x4){0.f, 0.f, 0.f, 0.f};
        bf16x8 Sf0 = pack_frag(S[0], S[1]), Sf1 = pack_frag(S[2], S[3]);
        *(LAS bf16x8*)(sfr) = Sf0; *(LAS bf16x8*)(sfr + 1024) = Sf1;
        int slot = 0;
#pragma unroll 1
        for (int c = 0; c < NCHUNK; ++c) {
            S2_BAR();
            const LAS unsigned char* sl = lds + slot * S2_SLOT;
            bf16x8 G0[4], G1[4]; v2u Hw[4];
#pragma unroll
            for (int m = 0; m < 4; ++m) { const int k2 = 16 * m + rr;
                G0[m] = *(const LAS bf16x8*)(sl + (k2 * 8 + (q ^ (k2 & 7))) * 16); G1[m] = *(const LAS bf16x8*)(sl + (k2 * 8 + ((4 + q) ^ (k2 & 7))) * 16);
                Hw[m] = *(const LAS v2u*)(sl + 12288 + (rr * 8 + ((2 * m + (q >> 1)) ^ (rr & 7))) * 16 + (q & 1) * 8); }
#pragma unroll
            for (int m = 0; m < 4; ++m) { f32x4 acc = unpack4(Hw[m]);
                acc = __builtin_amdgcn_mfma_f32_16x16x32_bf16(G0[m], Sf0, acc, 0, 0, 0);
                acc = __builtin_amdgcn_mfma_f32_16x16x32_bf16(G1[m], Sf1, acc, 0, 0, 0);
                S[m] = acc; }
            Sf0 = pack_frag(S[0], S[1]); Sf1 = pack_frag(S[2], S[3]);
            LAS unsigned char* o = sfr + ((c + 1) & 1) * 2048;
            *(LAS bf16x8*)(o) = Sf0; *(LAS bf16x8*)(o + 1024) = Sf1;
            S2_NEXT_SLOT();
        }
    } else if (wave == 1) {
        f32x4 S[4];
#pragma unroll
        for (int m = 0; m < 4; ++m) S[m] = (f32x4){0.f, 0.f, 0.f, 0.f};
        { const bf16x8 Sf0 = pack_frag(S[0], S[1]); *(LAS bf16x8*)(sfg) = Sf0; *(LAS bf16x8*)(sfg + 1024) = Sf0; }
        int slot = 0;
#pragma unroll 1
        for (int c = 0; c < NCHUNK; ++c) {
            S2_BAR();
            const LAS unsigned char* sl = lds + slot * S2_SLOT + S2_RW;
            v4u kw[2]; f32x4 d0[2], d1[2];
#pragma unroll
            for (int s2 = 0; s2 < 2; ++s2) { kw[s2] = *(const LAS v4u*)(sl + 4096 + (rr * 8 + ((4 * s2 + q) ^ (rr & 7))) * 16);
                d0[s2] = *(const LAS f32x4*)(sl + 7168 + 128 * s2 + 32 * q); d1[s2] = *(const LAS f32x4*)(sl + 7168 + 128 * s2 + 32 * q + 16); }
#pragma unroll
            for (int s2 = 0; s2 < 2; ++s2) { S[2 * s2] = S[2 * s2] * d0[s2] + unpack4((v2u){kw[s2].x, kw[s2].y}); S[2 * s2 + 1] = S[2 * s2 + 1] * d1[s2] + unpack4((v2u){kw[s2].z, kw[s2].w}); }
            LAS unsigned char* o = sfg + ((c + 1) & 1) * 2048;
            *(LAS bf16x8*)(o) = pack_frag(S[0], S[1]); *(LAS bf16x8*)(o + 1024) = pack_frag(S[2], S[3]);
            S2_NEXT_SLOT();
        }
    } else if (wave < 4) {
        bf16* ORW = (bf16*)(ws + (rdir ? WS_ORWB : WS_ORWF));
        const int tt0 = 2 * (wave - 2);
        int slot = 0;
#pragma unroll 1
        for (int c = 0; c < NCHUNK; ++c) {
            S2_BAR();
            if (c >= CTXL / CH) {
                const LAS unsigned char* sl = lds + slot * S2_SLOT; const LAS unsigned char* sf = sfr + (c & 1) * 2048;
                const bf16x8 Sf0 = *(const LAS bf16x8*)(sf), Sf1 = *(const LAS bf16x8*)(sf + 1024);
                v2u Rw0[2], Rw1[2]; unsigned Yw[2];
#pragma unroll
                for (int i = 0; i < 2; ++i) { const int t = 16 * (tt0 + i) + rr;
                    Rw0[i] = *(const LAS v2u*)(sl + 8192 + (t * 4 + ((q >> 1) ^ (t & 3))) * 16 + (q & 1) * 8); Rw1[i] = *(const LAS v2u*)(sl + 8192 + (t * 4 + ((2 + (q >> 1)) ^ (t & 3))) * 16 + (q & 1) * 8);
                    Yw[i] = *(const LAS unsigned*)(sl + 14336 + t * 16 + q * 4); }
#pragma unroll
                for (int i = 0; i < 2; ++i) { const int t = 16 * (tt0 + i) + rr;
                    const bf16x8 R0 = pack_frag(unpack4_fp8(Rw0[i].x), unpack4_fp8(Rw0[i].y)), R1 = pack_frag(unpack4_fp8(Rw1[i].x), unpack4_fp8(Rw1[i].y));
                    f32x4 acc = unpack4_fp8(Yw[i]);
                    acc = __builtin_amdgcn_mfma_f32_16x16x32_bf16(Sf0, R0, acc, 0, 0, 0);
                    acc = __builtin_amdgcn_mfma_f32_16x16x32_bf16(Sf1, R1, acc, 0, 0, 0);
                    const int row = scan_row(c * CH + t, rb, rdir);
                    *(v2u*)(ORW + (size_t)row * RWW + rh * 64 + v0r + 4 * q) = pack4(acc); }
            }
            S2_NEXT_SLOT();
        }
    } else {
        bf16* OGL = (bf16*)(ws + (gdir ? WS_OGLB : WS_OGLF));
        const int tt0 = 2 * (wave - 4);
        int slot = 0;
#pragma unroll 1
        for (int c = 0; c < NCHUNK; ++c) {
            S2_BAR();
            if (c >= CTXL / CH) {
                const LAS unsigned char* sl = lds + slot * S2_SLOT + S2_RW; const LAS unsigned char* sf = sfg + (c & 1) * 2048;
                const bf16x8 Sf0 = *(const LAS bf16x8*)(sf), Sf1 = *(const LAS bf16x8*)(sf + 1024);
                v2u Qw0[2], Qw1[2]; unsigned Iw[2];
#pragma unroll
                for (int i = 0; i < 2; ++i) { const int t = 16 * (tt0 + i) + rr;
                    Qw0[i] = *(const LAS v2u*)(sl + (t * 4 + ((q >> 1) ^ (t & 3))) * 16 + (q & 1) * 8); Qw1[i] = *(const LAS v2u*)(sl + (t * 4 + ((2 + (q >> 1)) ^ (t & 3))) * 16 + (q & 1) * 8);
                    Iw[i] = *(const LAS unsigned*)(sl + 6144 + t * 16 + q * 4); }
#pragma unroll
                for (int i = 0; i < 2; ++i) { const int t = 16 * (tt0 + i) + rr;
                    const bf16x8 Q0 = pack_frag(unpack4_fp8(Qw0[i].x), unpack4_fp8(Qw0[i].y)), Q1 = pack_frag(unpack4_fp8(Qw1[i].x), unpack4_fp8(Qw1[i].y));
                    f32x4 acc = unpack4_fp8(Iw[i]);
                    acc = __builtin_amdgcn_mfma_f32_16x16x32_bf16(Sf0, Q0, acc, 0, 0, 0);
                    acc = __builtin_amdgcn_mfma_f32_16x16x32_bf16(Sf1, Q1, acc, 0, 0, 0);
                    const int row = scan_row(c * CH + t, gb, gdir);
                    *(v2u*)(OGL + (size_t)row * RWW + gh * 128 + v0g + 4 * q) = pack4(acc); }
            }
            S2_NEXT_SLOT();
        }
    }
#undef S2_BAR
#undef S2_NEXT_SLOT
}
#endif

#ifndef ML
#define ML 0
#endif
enum Phase { PH_PROLOGUE = 0, PH_A1, PH_INPROJ, PH_FEAT, PH_LORA, PH_SCAN1, PH_SCAN2, PH_MERGE, PH_BRANCH, PH_OUTPROJ, PH_LN1, PH_ROUTER, PH_ROUTE, PH_SCATTER, PH_EXP1, PH_EXP2, PH_FINAL, PH_COUNT };

__global__ void __launch_bounds__(NTHR, 2) mega(Args args) {
    extern __shared__ __attribute__((aligned(16))) unsigned char lds_raw[];
    Frame F;
    F.lds = (LAS unsigned char*)lds_raw;
    F.tid = threadIdx.x; F.lane = F.tid & 63; F.wave = __builtin_amdgcn_readfirstlane(F.tid >> 6);
    F.G = gridDim.x; F.gw = blockIdx.x * NWAVES + F.wave; F.NGW = F.G * NWAVES;
    F.in = args.in; F.out = args.out; F.ws = args.ws; F.ctl = (unsigned*)(args.ws + WS_CTL);
    volatile LAS unsigned* MISC = (volatile LAS unsigned*)(F.lds + MISC_OFF);
    if (F.tid < 64) MISC[F.tid] = 0u;
    __syncthreads();
    XcdBarrier bar; bar.bar = F.ctl + CW_BAR; bar.x = 0; bar.st = nullptr;
#if !ML
    bar = xcd_barrier_post(F.ctl + CW_BAR, MISC + 8);
#endif
    const int lo = args.ph_lo, hi = args.ph_hi;
#define IN(k) (lo <= (k) && (k) < hi)
#ifndef DUP
#define DUP -1
#endif
#define RUN(k, call) do { if (IN(k)) { call; GRID_BAR(); if (DUP == (k)) { call; GRID_BAR(); } } } while (0)
#if ML
#define GRID_BAR() do { } while (0)
#else
#define GRID_BAR() xcd_barrier(bar)
#endif

#if MS >= 2
    RUN(PH_PROLOGUE, ph_prologue(F));
#endif
#if MS >= 3
    RUN(PH_A1, ph_a1(F));
    RUN(PH_INPROJ, ph_inproj(F));
    RUN(PH_FEAT, ph_feat(F));
    RUN(PH_LORA, ph_lora(F));
    RUN(PH_SCAN1, ph_scan1(F));
    RUN(PH_SCAN2, ph_scan2(F));
    RUN(PH_MERGE, ph_merge(F));
    RUN(PH_BRANCH, ph_branch(F));
    RUN(PH_OUTPROJ, ph_outproj(F));
#else
    RUN(PH_OUTPROJ, ph_x1pre_nomix(F));
#endif
    RUN(PH_LN1, ph_ln1(F));
#if MS >= 2
    RUN(PH_ROUTER, ph_router(F));
    RUN(PH_ROUTE, ph_route(F));
    RUN(PH_SCATTER, ph_scatter(F));
    RUN(PH_EXP1, ph_exp1(F));
    RUN(PH_EXP2, ph_exp2(F));
#endif
    if (IN(PH_FINAL)) { ph_final(F); }
#undef IN
}

extern "C" void kernel_launch(void* const* d_in, const int* in_sizes, int n_in, void* d_out, int out_size, void* d_ws, size_t ws_size, hipStream_t stream) {
    static int grid = 0;
    if (grid == 0) {
        if (n_in != 36 || out_size != NLAT * D || ws_size < WS_END) { fprintf(stderr, "kernel_launch: unexpected problem shape (n_in %d, out %d)\n", n_in, out_size); grid = -1; return; }
        int dev = 0, cus = 0, per_cu = 0;
        if (hipGetDevice(&dev) != hipSuccess || hipDeviceGetAttribute(&cus, hipDeviceAttributeMultiprocessorCount, dev) != hipSuccess) { grid = -1; return; }
        if (hipFuncSetAttribute((const void*)mega, hipFuncAttributeMaxDynamicSharedMemorySize, LDS_BYTES) != hipSuccess) { fprintf(stderr, "kernel_launch: hipFuncSetAttribute failed\n"); grid = -1; return; }
        if (hipOccupancyMaxActiveBlocksPerMultiprocessor(&per_cu, (const void*)mega, NTHR, LDS_BYTES) != hipSuccess || per_cu < 1) { fprintf(stderr, "kernel_launch: occupancy query says %d\n", per_cu); }
        (void)hipGetLastError();
        grid = cus > 0 ? cus : 256;
        if (grid > 256) grid = 256;
    }
    if (grid < 0) return;
    (void)hipMemsetAsync((char*)d_ws + WS_CTL, 0, CTL_ZERO_BYTES, stream);
    Args a{};
    for (int i = 0; i < 36; ++i) a.in[i] = (const float*)d_in[i];
    a.out = (float*)d_out; a.ws = (unsigned char*)d_ws;
#if ML
    for (int p = 0; p < PH_COUNT; ++p) { a.ph_lo = p; a.ph_hi = p + 1; hipLaunchKernelGGL(mega, dim3(grid), dim3(NTHR), LDS_BYTES, stream, a); }
#else
    a.ph_lo = 0; a.ph_hi = PH_COUNT;
    hipLaunchKernelGGL(mega, dim3(grid), dim3(NTHR), LDS_BYTES, stream, a);
#endif
}
```

```cpp
#include <hip/hip_runtime.h>
#include <cstdio>
#include <cstdint>

#ifndef MS
#define MS 3
#endif

#define GAS __attribute__((address_space(1)))
#define LAS __attribute__((address_space(3)))
typedef unsigned short bf16;
typedef unsigned v4u __attribute__((ext_vector_type(4)));
typedef unsigned v2u __attribute__((ext_vector_type(2)));
typedef float f32x4 __attribute__((ext_vector_type(4)));
typedef float f32x2 __attribute__((ext_vector_type(2)));
typedef short bf16x8 __attribute__((ext_vector_type(8)));
#define LDS_WAIT() asm volatile("s_waitcnt lgkmcnt(0)" ::: "memory")
#define VM_WAIT() asm volatile("s_waitcnt vmcnt(0)" ::: "memory")

constexpr int D = 1024, NB = 4, SEQ = 8192, CTXL = 256, GRIDW = 64, GRIDH = 128;
constexpr int NLAT = NB * SEQ, NCTX = NB * CTXL, MR = NLAT + NCTX;
constexpr int RWW = 512, RWH = 8, HD = 64;
constexpr int C_R = 0, C_K = 512, C_V = 1024, C_PW = 1536, C_PA = 1568, C_PG = 1600, C_Q = 1696, C_KG = 1952, C_VG = 2208, C_PGL = 2720, C_OG = 2736, C_GRW = 3248, C_GGLA = 4272;
constexpr int IN_COLS = 5296, NP = 5376;
constexpr int NE = 256, TOPK = 8, FF = 256;
constexpr float LN_EPS = 1e-5f, RW_GN_EPS = 64e-5f;
constexpr float ALPHA = 1.189207115f;
constexpr float W8S = 64.0f, W8I = 1.0f / 64.0f;
constexpr int NLORA = 3072, KLORA = 256;
constexpr int MAXTILES = 1280, SH_ROW0 = MAXTILES * 256, NROWS_E = SH_ROW0 + NLAT;

namespace pg8 {
#define PG8_LAS __attribute__((address_space(3)))
typedef unsigned short bf16_t;
typedef unsigned u32x4 __attribute__((ext_vector_type(4)));
typedef unsigned u32x2 __attribute__((ext_vector_type(2)));
typedef long i64x2 __attribute__((ext_vector_type(2)));
constexpr int BM = 256, BK = 64, HALF = 128, HTB = HALF * BK * 2, STAGE_BYTES = 8 * HTB, NXCD = 8, WGM = 8;
constexpr int IDX_OFF = STAGE_BYTES, IDX_UNITS = 12;

__host__ __device__ __forceinline__ int lds_byte(int r, int c) { const int st = (r >> 4) * 2 + (c >> 5), rr = r & 15, cc = c & 31, ob = rr * 64 + cc * 2; return st * 1024 + (ob ^ (((ob >> 9) & 1) << 5)); }
__host__ __device__ __forceinline__ void stage_rc(int b, int& R, int& C) { const int st = b / 1024, sb = b % 1024, swz = sb ^ (((sb >> 9) & 1) << 5); R = (st >> 1) * 16 + swz / 64; C = (st & 1) * 32 + (swz % 64) / 2; }
__host__ __device__ __forceinline__ int perm32(int rho) { const int n = rho >> 4, i = rho & 15; return 8 * (i >> 2) + 4 * n + (i & 3); }

struct Unit { int pm, pn, e, j; };
struct Gemm { const bf16_t* A; const bf16_t* Bt; int M, N, K; const int* rowidx; };

struct StaticOrder {
    int nM, nN, nwg, G, c;
    __host__ __device__ void init(int M, int N, int G_, int c_) { nM = M / BM; nN = N / BM; nwg = nM * nN; G = G_; c = c_; }
    __host__ __device__ bool next(int i, Unit& u) const {
        const long L = (long)i * G + c; if (L >= nwg) return false;
        int wgid = (int)L; { const int q = nwg / NXCD, r = nwg % NXCD, xcd = wgid % NXCD, off = wgid / NXCD; wgid = (xcd < r ? xcd * (q + 1) : r * (q + 1) + (xcd - r) * q) + off; }
        const int nig = WGM * nN, gid = wgid / nig, fm = gid * WGM, gsz = (nM - fm) < WGM ? (nM - fm) : WGM;
        u.pm = fm + ((wgid % nig) % gsz); u.pn = (wgid % nig) / gsz; u.e = 0; u.j = u.pn; return true;
    }
};
struct MoeOrder {
    int nN, G, c, NT; const int* tile_e;
    __device__ bool next(int i, Unit& u) const {
        int tile, j;
        if (G == 256) { const int x = c & 7, y = c >> 3; tile = i * (256 / nN) + x * (32 / nN) + y / nN; j = y % nN; if (tile >= NT + NLAT / 256) return false; }
        else { const int L = i * G + c; if (L >= (NT + NLAT / 256) * nN) return false; tile = L / nN; j = L - tile * nN; }
        int e, pm;
        if (tile < NT) { e = tile_e[tile]; pm = tile; } else { e = NE; pm = MAXTILES + (tile - NT); }
        u.pm = pm; u.pn = e * nN + j; u.e = e; u.j = j; return true;
    }
};

typedef __bf16 bf16x2n __attribute__((ext_vector_type(2))); typedef float f32x2n __attribute__((ext_vector_type(2)));
__device__ __forceinline__ unsigned cvt_pk_bf16(float lo, float hi) { const f32x2n v = {lo, hi}; return __builtin_bit_cast(unsigned, __builtin_convertvector(v, bf16x2n)); }

template <class Epi, class Sched, bool ALIGN_EPI, bool SP2, bool GATHER, bool FP8 = false>
__device__ __forceinline__ void gemm_phase(PG8_LAS unsigned char* lds, const Gemm g, const Sched& S, const Epi& E) {
    const int tid = threadIdx.x, wid = __builtin_amdgcn_readfirstlane(tid >> 6), lane = tid & 63, wr = wid >> 2, wc = wid & 3, fr = lane & 15, fq = lane >> 4;
    const int K = g.K, nt = K / BK;
    const size_t kstep = (size_t)(BK * 2);
    const size_t hstep = (size_t)HALF * K * 2;
    const size_t tstep = 2 * hstep;
    unsigned voffB[2]; unsigned va[2][2];
#pragma unroll
    for (int i = 0; i < 2; ++i) { int R, C; stage_rc(tid * 16 + i * 8192, R, C); const int Rb = Epi::PERM ? ((R & ~31) + perm32(R & 31)) : R;
        voffB[i] = (unsigned)(Rb * K + C) * 2u;
        va[0][i] = (unsigned)(R * K + C) * 2u; va[1][i] = va[0][i]; }
    const size_t ah = GATHER ? (size_t)0 : hstep;
#define PG8_GOFF(dst, ub) do { _Pragma("unroll") for (int _h = 0; _h < 2; ++_h) _Pragma("unroll") for (int _i = 0; _i < 2; ++_i) { int _R, _C; stage_rc(tid * 16 + _i * 8192, _R, _C); \
        dst[_h][_i] = (unsigned)(idxt[(ub) * 256 + _h * 128 + _R] * K + _C) * 2u; } } while (0)
    const unsigned ldsw = (unsigned)wid * 1024u;
    const int aoff = lds_byte(wr * 64 + fr, fq * 8), boff = lds_byte(wc * 32 + fr, fq * 8);
    PG8_LAS int* idxt = (PG8_LAS int*)(lds + IDX_OFF);
#define PG8_SA(b, h) (((b) * 2 + (h)) * HTB)
#define PG8_SB(b, h) ((4 + (b) * 2 + (h)) * HTB)
#define PG8_STAGE(bufoff, gbase, voff) do { _Pragma("unroll") for (int _i = 0; _i < 2; ++_i) \
        __builtin_amdgcn_global_load_lds((const unsigned*)((const char*)(gbase) + (voff)[_i]), (PG8_LAS unsigned*)(lds + (bufoff) + ldsw + _i * 8192), 16, 0, 0); } while (0)
#define PG8_LDA(dst, b, h) do { _Pragma("unroll") for (int m = 0; m < 4; ++m) _Pragma("unroll") for (int k = 0; k < 2; ++k) dst[m][k] = *(const PG8_LAS bf16x8*)(lds + PG8_SA(b, h) + aoff + m * 2048 + k * 1024); } while (0)
#define PG8_LDB(dst, b, h) do { _Pragma("unroll") for (int n = 0; n < 2; ++n) _Pragma("unroll") for (int k = 0; k < 2; ++k) dst[n][k] = *(const PG8_LAS bf16x8*)(lds + PG8_SB(b, h) + boff + n * 2048 + k * 1024); } while (0)
#define PG8_MMA(ai, bj, At, Bt) do { __builtin_amdgcn_s_setprio(1); _Pragma("unroll") for (int m = 0; m < 4; ++m) _Pragma("unroll") for (int n = 0; n < 2; ++n) _Pragma("unroll") for (int k = 0; k < 2; ++k) { \
        if constexpr (FP8) { const i64x2 _b = __builtin_bit_cast(i64x2, Bt[n][k]), _a = __builtin_bit_cast(i64x2, At[m][k]); \
            acc[ai][bj][m][n] = __builtin_amdgcn_mfma_f32_16x16x32_fp8_fp8(_b[0], _a[0], acc[ai][bj][m][n], 0, 0, 0); acc[ai][bj][m][n] = __builtin_amdgcn_mfma_f32_16x16x32_fp8_fp8(_b[1], _a[1], acc[ai][bj][m][n], 0, 0, 0); } \
        else acc[ai][bj][m][n] = __builtin_amdgcn_mfma_f32_16x16x32_bf16(Bt[n][k], At[m][k], acc[ai][bj][m][n], 0, 0, 0); } __builtin_amdgcn_s_setprio(0); } while (0)
#define PG8_WAIT_V(n) asm volatile("s_waitcnt vmcnt(" #n ")" ::: "memory")
#define PG8_WAIT_L(n) asm volatile("s_waitcnt lgkmcnt(" #n ")" ::: "memory")
#define PG8_BAR __builtin_amdgcn_s_barrier()
#define PG8_SCHED __builtin_amdgcn_sched_barrier(0)
    Unit cur, nxt; int ui = 0;
    if (!S.next(0, cur)) return;
#ifdef GEMM_STAGGER
    if constexpr (FP8) {
        const unsigned long long t0 = __builtin_amdgcn_s_memrealtime(); const unsigned long long dl = (unsigned long long)(blockIdx.x & 3) * GEMM_STAGGER;
        while (__builtin_amdgcn_s_memrealtime() - t0 < dl) __builtin_amdgcn_s_sleep(8);
    }
#endif
    if constexpr (GATHER) {
        Unit uu;
        for (int i = 0; i < IDX_UNITS; ++i) { if (!S.next(i, uu)) break; if (tid < 256) idxt[i * 256 + tid] = g.rowidx[(size_t)uu.pm * 256 + tid]; }
        asm volatile("s_waitcnt vmcnt(0) lgkmcnt(0)" ::: "memory"); PG8_BAR; asm volatile("" ::: "memory");
        PG8_GOFF(va, 0);
    }
    f32x4 acc[2][2][4][2];
#pragma unroll
    for (int a = 0; a < 2; ++a)
#pragma unroll
        for (int b = 0; b < 2; ++b)
#pragma unroll
            for (int m = 0; m < 4; ++m)
#pragma unroll
                for (int n = 0; n < 2; ++n) acc[a][b][m][n] = (f32x4){0.f, 0.f, 0.f, 0.f};
    bf16x8 At[4][2], B0[2][2], B1[2][2];
    const char* cA = (const char*)g.A + (GATHER ? (size_t)0 : (size_t)cur.pm * tstep); const char* cB = (const char*)g.Bt + (size_t)cur.pn * tstep;
    if constexpr (SP2) {
        PG8_STAGE(PG8_SB(0, 0), cB, voffB); PG8_STAGE(PG8_SB(0, 1), cB + hstep, voffB); PG8_STAGE(PG8_SA(0, 0), cA, va[0]); PG8_STAGE(PG8_SA(0, 1), cA + ah, va[1]);
        if (wr == 1) PG8_BAR;
        PG8_WAIT_V(2); PG8_BAR;
        PG8_STAGE(PG8_SB(1, 0), cB + kstep, voffB); PG8_STAGE(PG8_SA(1, 0), cA + kstep, va[0]); PG8_STAGE(PG8_SB(1, 1), cB + hstep + kstep, voffB);
        PG8_WAIT_V(6); PG8_BAR;
    } else {
        PG8_STAGE(PG8_SB(0, 0), cB, voffB); PG8_STAGE(PG8_SA(0, 0), cA, va[0]); PG8_STAGE(PG8_SB(0, 1), cB + hstep, voffB); PG8_STAGE(PG8_SA(0, 1), cA + ah, va[1]);
        if (wr == 1) PG8_BAR;
        PG8_WAIT_V(4); PG8_BAR;
        PG8_STAGE(PG8_SB(1, 0), cB + kstep, voffB); PG8_STAGE(PG8_SA(1, 0), cA + kstep, va[0]); PG8_STAGE(PG8_SB(1, 1), cB + hstep + kstep, voffB);
        PG8_WAIT_V(6); PG8_BAR;
    }
    for (;;) {
        const bool has_next = S.next(ui + 1, nxt);
        const char* nA = has_next ? (const char*)g.A + (GATHER ? (size_t)0 : (size_t)nxt.pm * tstep) : cA; const char* nB = has_next ? (const char*)g.Bt + (size_t)nxt.pn * tstep : cB;
        const int ubn = (has_next && ui + 1 < IDX_UNITS) ? (ui + 1) : ui;
#pragma unroll 1
        for (int t = 0; t < nt; t += 2) {
            const bool last = (t == nt - 2);
            const char* a1 = cA + (size_t)(t + 1) * kstep;
            const char* a2 = last ? nA : cA + (size_t)(t + 2) * kstep; const char* b2 = last ? nB : cB + (size_t)(t + 2) * kstep;
            const char* a3 = a2 + kstep; const char* b3 = b2 + kstep;
            unsigned v2[2][2];
#pragma unroll
            for (int h = 0; h < 2; ++h)
#pragma unroll
                for (int i = 0; i < 2; ++i) v2[h][i] = va[h][i];
            if constexpr (GATHER) { if (last) PG8_GOFF(v2, ubn); }
            if constexpr (SP2) {
            PG8_LDB(B0, 0, 0); PG8_LDB(B1, 0, 1); PG8_SCHED; PG8_LDA(At, 0, 0); PG8_STAGE(PG8_SA(1, 1), a1 + ah, va[1]);
            PG8_WAIT_V(8); PG8_WAIT_L(0); PG8_BAR; PG8_MMA(0, 0, At, B0); PG8_MMA(0, 1, At, B1); PG8_BAR; PG8_SCHED;
            PG8_LDA(At, 0, 1); PG8_STAGE(PG8_SB(0, 0), b2, voffB); PG8_STAGE(PG8_SB(0, 1), b2 + hstep, voffB); PG8_STAGE(PG8_SA(0, 0), a2, v2[0]);
            PG8_WAIT_V(8); PG8_WAIT_L(0); PG8_BAR; PG8_MMA(1, 0, At, B0); PG8_MMA(1, 1, At, B1); PG8_BAR; PG8_SCHED;
            PG8_LDB(B0, 1, 0); PG8_LDB(B1, 1, 1); PG8_SCHED; PG8_LDA(At, 1, 0); PG8_STAGE(PG8_SA(0, 1), a2 + ah, v2[1]);
            PG8_WAIT_V(8); PG8_WAIT_L(0); PG8_BAR; PG8_MMA(0, 0, At, B0); PG8_MMA(0, 1, At, B1); PG8_BAR; PG8_SCHED;
            PG8_LDA(At, 1, 1); PG8_STAGE(PG8_SB(1, 0), b3, voffB); PG8_STAGE(PG8_SB(1, 1), b3 + hstep, voffB); PG8_STAGE(PG8_SA(1, 0), a3, v2[0]);
            PG8_WAIT_V(8); PG8_WAIT_L(0); PG8_BAR; PG8_MMA(1, 0, At, B0); PG8_MMA(1, 1, At, B1); PG8_BAR; PG8_SCHED;
            } else {
            PG8_LDB(B0, 0, 0); PG8_SCHED; PG8_LDA(At, 0, 0); PG8_STAGE(PG8_SA(1, 1), a1 + ah, va[1]);
            PG8_WAIT_L(8); PG8_BAR; PG8_WAIT_L(0); PG8_MMA(0, 0, At, B0); PG8_BAR; PG8_SCHED;
            PG8_LDB(B1, 0, 1); PG8_STAGE(PG8_SB(0, 0), b2, voffB);
            PG8_BAR; PG8_WAIT_L(0); PG8_MMA(0, 1, At, B1); PG8_BAR;
            PG8_LDA(At, 0, 1); PG8_STAGE(PG8_SA(0, 0), a2, v2[0]);
            PG8_BAR; PG8_WAIT_L(0); PG8_MMA(1, 0, At, B0); PG8_BAR; PG8_SCHED;
            PG8_STAGE(PG8_SB(0, 1), b2 + hstep, voffB);
            PG8_WAIT_V(6); PG8_BAR; PG8_MMA(1, 1, At, B1); PG8_BAR;
            PG8_LDB(B0, 1, 0); PG8_SCHED; PG8_LDA(At, 1, 0); PG8_STAGE(PG8_SA(0, 1), a2 + ah, v2[1]);
            PG8_WAIT_L(8); PG8_BAR; PG8_WAIT_L(0); PG8_MMA(0, 0, At, B0); PG8_BAR; PG8_SCHED;
            PG8_LDB(B1, 1, 1); PG8_STAGE(PG8_SB(1, 0), b3, voffB);
            PG8_BAR; PG8_WAIT_L(0); PG8_MMA(0, 1, At, B1); PG8_BAR;
            PG8_LDA(At, 1, 1); PG8_STAGE(PG8_SA(1, 0), a3, v2[0]);
            PG8_BAR; PG8_WAIT_L(0); PG8_MMA(1, 0, At, B0); PG8_BAR; PG8_SCHED;
            PG8_STAGE(PG8_SB(1, 1), b3 + hstep, voffB);
            PG8_WAIT_V(6); PG8_BAR; PG8_MMA(1, 1, At, B1); PG8_BAR;
            }
        }
        if constexpr (ALIGN_EPI) { if (wr == 0) PG8_BAR; }
        E(acc, cur, wr, wc, fr, fq);
        if (!has_next) break;
#pragma unroll
        for (int a = 0; a < 2; ++a)
#pragma unroll
            for (int b = 0; b < 2; ++b)
#pragma unroll
                for (int m = 0; m < 4; ++m)
#pragma unroll
                    for (int n = 0; n < 2; ++n) acc[a][b][m][n] = (f32x4){0.f, 0.f, 0.f, 0.f};
        cur = nxt; cA = nA; cB = nB; ++ui;
        if constexpr (GATHER) PG8_GOFF(va, ubn);
        if constexpr (ALIGN_EPI) { if (wr == 1) PG8_BAR; }
    }
    PG8_WAIT_V(0);
    if constexpr (!ALIGN_EPI) { if (wr == 0) PG8_BAR; }
    PG8_BAR;
#undef PG8_SA
#undef PG8_GOFF
#undef PG8_SB
#undef PG8_STAGE
#undef PG8_LDA
#undef PG8_LDB
#undef PG8_MMA
#undef PG8_WAIT_V
#undef PG8_WAIT_L
#undef PG8_BAR
#undef PG8_SCHED
}
}

#define XB_TMO      128
#define XB_XCNT(j)  (256  + 64 * (j))
#define XB_XSUB(j)  (1280 + 64 * (j))
#define XB_XGEN(j)  (2304 + 64 * (j))
#define XB_TOP      3328
#define XB_TOPGEN   3392
#define XCD_BAR_WORDS 3456
#define XB_SPIN_CAP (1u << 18)
__device__ __forceinline__ unsigned xb_ld(unsigned* p)              { return __hip_atomic_load(p, __ATOMIC_RELAXED, __HIP_MEMORY_SCOPE_AGENT); }
__device__ __forceinline__ unsigned xb_add(unsigned* p, unsigned v) { return __hip_atomic_fetch_add(p, v, __ATOMIC_RELAXED, __HIP_MEMORY_SCOPE_AGENT); }
__device__ __forceinline__ unsigned xb_xcc_id() { return (unsigned)__builtin_amdgcn_s_getreg((3 << 11) | 20) & 0xFu; }
#define XB_SPIN(cond, bar) do { unsigned _sp = 0; while (cond) { __builtin_amdgcn_s_sleep(1); \
    if ((++_sp & 255u) == 0u) { if (xb_ld(&(bar)[XB_TMO])) break; if (_sp > XB_SPIN_CAP) { atomicAdd(&(bar)[XB_TMO], 1u); break; } } } } while (0)
struct XcdBarrier { unsigned* bar; unsigned x; volatile LAS unsigned* st; };
__device__ __forceinline__ XcdBarrier xcd_barrier_post(unsigned* bar, volatile LAS unsigned* st) {
    XcdBarrier b; b.bar = bar; b.x = xb_xcc_id(); b.st = st;
    if (threadIdx.x == 0) (void)xb_add(&bar[XB_XCNT(b.x)], 1u);
    return b;
}
__device__ __forceinline__ void xcd_barrier_complete(unsigned* bar, unsigned x, unsigned& nloc, unsigned& nx) {
    const unsigned G = gridDim.x * gridDim.y * gridDim.z;
    unsigned sum, cnt, mine, sp = 0u;
    for (;;) {
        sum = 0u; cnt = 0u; mine = 0u;
#pragma unroll
        for (unsigned j = 0; j < 16; ++j) { const unsigned c = xb_ld(&bar[XB_XCNT(j)]); sum += c; cnt += (c > 0u) ? 1u : 0u; mine = (j == x) ? c : mine; }
        if (sum == G) break;
        __builtin_amdgcn_s_sleep(1);
        if ((++sp & 255u) == 0u) { if (xb_ld(&bar[XB_TMO])) break; if (sp > XB_SPIN_CAP) { atomicAdd(&bar[XB_TMO], 1u); break; } }
    }
    nloc = mine > 0u ? mine : 1u; nx = cnt > 0u ? cnt : 1u;
}
__device__ __forceinline__ void xcd_barrier(const XcdBarrier& b) {
    asm volatile("s_waitcnt vmcnt(0)" ::: "memory");
    __syncthreads();
    if (threadIdx.x == 0) {
        unsigned* bar = b.bar;
        __builtin_amdgcn_s_waitcnt(0);
        unsigned nloc = b.st[0], nx = b.st[1];
        if (nloc == 0u) { xcd_barrier_complete(bar, b.x, nloc, nx); b.st[0] = nloc; b.st[1] = nx; }
        const unsigned old = xb_add(&bar[XB_XSUB(b.x)], 1u);
        const unsigned gen = old / nloc;
        if (old + 1u == (gen + 1u) * nloc) {
            __builtin_amdgcn_fence(__ATOMIC_RELEASE, "agent");
            asm volatile("s_waitcnt vmcnt(0)" ::: "memory");
            const unsigned og = xb_add(&bar[XB_TOP], 1u);
            const unsigned tg = og / nx;
            if (og + 1u == (tg + 1u) * nx) xb_add(&bar[XB_TOPGEN], 1u);
            else XB_SPIN(xb_ld(&bar[XB_TOPGEN]) == tg, bar);
            __builtin_amdgcn_fence(__ATOMIC_ACQUIRE, "agent");
            xb_add(&bar[XB_XGEN(b.x)], 1u);
            asm volatile("s_waitcnt vmcnt(0)" ::: "memory");
        } else {
            XB_SPIN(xb_ld(&bar[XB_XGEN(b.x)]) == gen, bar);
            __builtin_amdgcn_fence(__ATOMIC_ACQUIRE, "agent");
            asm volatile("s_waitcnt vmcnt(0)" ::: "memory");
        }
    }
    __syncthreads();
}

constexpr size_t MiB = 1u << 20;
constexpr size_t al(size_t x) { return (x + 4095) & ~(size_t)4095; }
constexpr size_t WS_CTL = 0, CTL_ZERO_BYTES = 1 * MiB;
constexpr int CW_BAR = 4096;
constexpr int CW_CNT = 16384, CNT_STRIDE = 64;
constexpr int CW_NT = CW_CNT + NE * CNT_STRIDE + 64;
static_assert((CW_NT + 1) * 4 <= (int)CTL_ZERO_BYTES, "control words inside the per-call memset");
constexpr size_t WS_MOD = 1 * MiB;
constexpr size_t WS_TILE_E = WS_MOD + 256 * 1024;
constexpr size_t WS_PADSTART = WS_TILE_E + 16 * 1024;
constexpr size_t WS_ROWTOK = 2 * MiB;
constexpr size_t WS_EIDX = 4 * MiB;
constexpr size_t WS_GATE = 5 * MiB;
constexpr size_t WS_DEST = 6 * MiB;
constexpr size_t WS_WIN = 8 * MiB;
constexpr size_t WS_WLORA = WS_WIN + al((size_t)NP * D * 2);
constexpr size_t WS_WBRRW = WS_WLORA + al((size_t)NLORA * KLORA * 2);
constexpr size_t WS_WBRGLA = WS_WBRRW + al((size_t)D * RWW * 2);
constexpr size_t WS_WOUT = WS_WBRGLA + al((size_t)D * RWW * 2);
constexpr size_t WS_WROUTER = WS_WOUT + al((size_t)D * D * 2);
constexpr size_t WS_WGU = WS_WROUTER + al((size_t)NE * D * 2);
constexpr size_t WS_WD = WS_WGU + al((size_t)(NE + 1) * 512 * D * 2);
constexpr size_t WS_PERSIST_END = WS_WD + al((size_t)(NE + 1) * D * FF * 2);
constexpr size_t WS_REGB = WS_PERSIST_END;
constexpr size_t SZ512F = al((size_t)MR * RWW * 4), SZ256F = al((size_t)MR * 256 * 4), SZ512H = al((size_t)MR * RWW * 2);
constexpr size_t WS_A1 = WS_REGB;
constexpr size_t WS_A2 = WS_A1;
constexpr size_t WS_KSUM = WS_A2 + al((size_t)MR * KLORA * 2);
static_assert(WS_KSUM + SZ512H <= WS_A1 + al((size_t)MR * D * 2), "A2 + KSUM fit in the A1 slot");
constexpr size_t WS_P = WS_A1 + al((size_t)MR * D * 2);
constexpr size_t WS_RB = WS_P + al((size_t)MR * NP * 2);
constexpr size_t WS_VB = WS_RB + SZ512H, WS_KKB = WS_VB + SZ512H, WS_KMF = WS_KKB + SZ512H, WS_KMB = WS_KMF + SZ512H, WS_BVF = WS_KMB + SZ512H, WS_BVB = WS_BVF + SZ512H;
constexpr size_t WS_LWF = WS_BVB + SZ512H, WS_LWB = WS_LWF + SZ512F;
constexpr size_t SZ256H = al((size_t)MR * 256 * 2);
constexpr size_t WS_QGB = WS_LWB + SZ512F, WS_KGB = WS_QGB + SZ256H, WS_VGB = WS_KGB + SZ256H, WS_LAF = WS_VGB + SZ512H, WS_LAB = WS_LAF + SZ256F;
constexpr size_t WS_RWG = WS_LAB + SZ256F;
constexpr size_t WS_ORWF = WS_RWG + SZ512H, WS_ORWB = WS_ORWF + SZ512H, WS_OGLF = WS_ORWB + SZ512H, WS_OGLB = WS_OGLF + SZ512H;
constexpr int CH = 64, NCHUNK = (CTXL + SEQ) / CH, NU_RW = 64 * NCHUNK, NU_GL = 32 * NCHUNK;
constexpr size_t WS_RH = WS_OGLB + SZ512H;
constexpr size_t WS_YL = WS_RH + al((size_t)NU_RW * 4096 * 2);
constexpr size_t WS_HH = WS_YL + al((size_t)NU_RW * 4096 * 2);
constexpr size_t WS_INTRA = WS_HH + al((size_t)NU_RW * 4096 * 2);
constexpr size_t WS_KV = WS_INTRA + al((size_t)NU_GL * 8192 * 2);
constexpr size_t WS_DD = WS_KV + al((size_t)NU_GL * 8192 * 2);
constexpr size_t WS_END_MIX = WS_DD + al((size_t)NU_GL * 64 * 4);
constexpr size_t OUT_GT = 0, OUT_QE = (size_t)NU_RW * 4096 * 2;
static_assert(OUT_QE + (size_t)NU_GL * 4096 * 2 <= (size_t)NLAT * D * 4, "scan scratch fits in d_out");
constexpr size_t WS_YRW = WS_LWF, WS_YGLA = WS_LWB, WS_Z = WS_HH;
static_assert((size_t)NLAT * D * 2 <= (size_t)NU_RW * 4096 * 2, "Z fits in the HH slot");
constexpr size_t WS_X1 = WS_REGB;
constexpr size_t WS_A3 = WS_X1 + al((size_t)NLAT * D * 4);
constexpr size_t WS_LOGITS = WS_A3 + al((size_t)NLAT * D * 2);
constexpr size_t WS_ACT = WS_LOGITS + al((size_t)NLAT * NE * 4);
constexpr size_t WS_Y = WS_ACT + al((size_t)NROWS_E * FF * 2);
constexpr size_t WS_A3F = WS_Y + al((size_t)NROWS_E * D);
constexpr size_t WS_END_MOE = WS_A3F + al((size_t)NLAT * D);
constexpr size_t WS_END = WS_END_MIX > WS_END_MOE ? WS_END_MIX : WS_END_MOE;
static_assert(WS_END <= (size_t)2048 * MiB, "workspace map exceeds 2 GiB");

constexpr int RING_BYTES = 131072;
constexpr int IDX_BYTES = pg8::IDX_UNITS * 256 * 4;
constexpr int MISC_OFF = RING_BYTES + IDX_BYTES;
constexpr int S2_SF_OFF = MISC_OFF + 256;
constexpr int LDS_BYTES = S2_SF_OFF + 8192;
static_assert(pg8::IDX_OFF == RING_BYTES, "gather table sits right above the stage buffers");
constexpr int NWAVES = 8, NTHR = 512;

struct Args { const float* in[36]; float* out; unsigned char* ws; int ph_lo, ph_hi; };

struct Frame {
    LAS unsigned char* lds;
    int tid, lane, wave, G, gw, NGW;
    const float* const* in; float* out; unsigned char* ws; unsigned* ctl;
};

__device__ __forceinline__ float wave_sum(float v) {
#pragma unroll
    for (int o = 1; o < 64; o <<= 1) v += __shfl_xor(v, o);
    return v;
}
__device__ __forceinline__ unsigned f2bf(float f) { unsigned u = __builtin_bit_cast(unsigned, f); return (u + 0x7fffu + ((u >> 16) & 1u)) >> 16; }
typedef __bf16 bf16x2v __attribute__((ext_vector_type(2)));
__device__ __forceinline__ unsigned pk2(float lo, float hi) { const f32x2 v = {lo, hi}; return __builtin_bit_cast(unsigned, __builtin_convertvector(v, bf16x2v)); }
__device__ __forceinline__ float bflo(unsigned w) { return __builtin_bit_cast(float, w << 16); }
__device__ __forceinline__ float bfhi(unsigned w) { return __builtin_bit_cast(float, w & 0xffff0000u); }
__device__ __forceinline__ float sigmoidf_(float x) { return __builtin_amdgcn_rcpf(1.0f + __expf(-x)); }
__device__ __forceinline__ float siluf_(float x) { return x * __builtin_amdgcn_rcpf(1.0f + __expf(-x)); }
__device__ __forceinline__ float tanhf_(float x) { return 1.0f - 2.0f * __builtin_amdgcn_rcpf(1.0f + __expf(2.0f * x)); }
__device__ __forceinline__ float logsigmoidf_(float x) { return fminf(x, 0.f) - __logf(1.0f + __expf(-fabsf(x))); }

__device__ __forceinline__ void ln_stats(const f32x4 (&v)[4], float& mean, float& rstd) {
    float s = 0.f;
#pragma unroll
    for (int j = 0; j < 4; ++j) s += (v[j].x + v[j].y) + (v[j].z + v[j].w);
    mean = wave_sum(s) * (1.f / D); float s2 = 0.f;
#pragma unroll
    for (int j = 0; j < 4; ++j) { const f32x4 d = v[j] - mean; s2 += (d.x * d.x + d.y * d.y) + (d.z * d.z + d.w * d.w); }
    rstd = __builtin_amdgcn_rsqf(wave_sum(s2) * (1.f / D) + LN_EPS);
}

__device__ __forceinline__ unsigned pack_fp8x4(const f32x4 v) {
    int w = __builtin_amdgcn_cvt_pk_fp8_f32(__builtin_amdgcn_fmed3f(v[0], -448.f, 448.f), __builtin_amdgcn_fmed3f(v[1], -448.f, 448.f), 0, false);
    return (unsigned)__builtin_amdgcn_cvt_pk_fp8_f32(__builtin_amdgcn_fmed3f(v[2], -448.f, 448.f), __builtin_amdgcn_fmed3f(v[3], -448.f, 448.f), w, true); }
__device__ __forceinline__ void ld_row_bf16(const bf16* row, int lane, f32x4 (&v)[4]) {
    const v4u a = *(const v4u*)(row + 8 * lane), b = *(const v4u*)(row + 512 + 8 * lane);
    v[0] = (f32x4){bflo(a.x), bfhi(a.x), bflo(a.y), bfhi(a.y)}; v[1] = (f32x4){bflo(a.z), bfhi(a.z), bflo(a.w), bfhi(a.w)};
    v[2] = (f32x4){bflo(b.x), bfhi(b.x), bflo(b.y), bfhi(b.y)}; v[3] = (f32x4){bflo(b.z), bfhi(b.z), bflo(b.w), bfhi(b.w)};
}
__device__ __forceinline__ int rowcol(int lane, int j) { return 512 * (j >> 1) + 8 * lane + 4 * (j & 1); }
__device__ __forceinline__ void ph_x1pre_nomix(Frame& F) {
    const float* x = F.in[0];
    for (int m = F.gw; m < NLAT; m += F.NGW) {
        bf16* o = (bf16*)(F.ws + WS_X1) + (size_t)m * D;
#pragma unroll
        for (int h = 0; h < 2; ++h) { const float* xr = x + (size_t)m * D + 512 * h + 8 * F.lane; const f32x4 a = *(const f32x4*)xr * ALPHA, b = *(const f32x4*)(xr + 4) * ALPHA;
            v4u w; w.x = pk2(a.x, a.y); w.y = pk2(a.z, a.w); w.z = pk2(b.x, b.y); w.w = pk2(b.z, b.w); *(v4u*)(o + 512 * h + 8 * F.lane) = w; }
    }
}
__device__ __forceinline__ void ph_ln1(Frame& F) {
    const float* lw = F.in[26]; const float* lb = F.in[27]; const float* mod = (const float*)(F.ws + WS_MOD);
    bf16* A3 = (bf16*)(F.ws + WS_A3); const bf16* X1P = (const bf16*)(F.ws + WS_X1);
    constexpr int NR = 4;
    for (int m0 = F.gw; m0 < NLAT; m0 += NR * F.NGW) {
        v4u w[NR][2];
#pragma unroll
        for (int r = 0; r < NR; ++r) { const int mm = m0 + r * F.NGW; const bf16* row = X1P + (size_t)(mm < NLAT ? mm : m0) * D; w[r][0] = *(const v4u*)(row + 8 * F.lane); w[r][1] = *(const v4u*)(row + 512 + 8 * F.lane); }
        __builtin_amdgcn_sched_barrier(0);
#pragma unroll
        for (int r = 0; r < NR; ++r) { const int mm = m0 + r * F.NGW; const int m = mm < NLAT ? mm : m0; const int b = m / SEQ;
            f32x4 v[4];
            v[0] = (f32x4){bflo(w[r][0].x), bfhi(w[r][0].x), bflo(w[r][0].y), bfhi(w[r][0].y)}; v[1] = (f32x4){bflo(w[r][0].z), bfhi(w[r][0].z), bflo(w[r][0].w), bfhi(w[r][0].w)};
            v[2] = (f32x4){bflo(w[r][1].x), bfhi(w[r][1].x), bflo(w[r][1].y), bfhi(w[r][1].y)}; v[3] = (f32x4){bflo(w[r][1].z), bfhi(w[r][1].z), bflo(w[r][1].w), bfhi(w[r][1].w)};
            float mean, rstd; ln_stats(v, mean, rstd);
#if MS >= 2
            f32x4 h[4];
#pragma unroll
            for (int j = 0; j < 4; ++j) { const int c = rowcol(F.lane, j);
                const f32x4 x1 = (v[j] - mean) * rstd * *(const f32x4*)(lw + c) + *(const f32x4*)(lb + c);
                h[j] = x1 * (*(const f32x4*)(mod + b * 6144 + 4096 + c) + 1.0f) + *(const f32x4*)(mod + b * 6144 + 3072 + c); }
            bf16* ao = A3 + (size_t)m * D;
            { v4u o; o.x = pk2(h[0].x, h[0].y); o.y = pk2(h[0].z, h[0].w); o.z = pk2(h[1].x, h[1].y); o.w = pk2(h[1].z, h[1].w); *(v4u*)(ao + 8 * F.lane) = o;
              o.x = pk2(h[2].x, h[2].y); o.y = pk2(h[2].z, h[2].w); o.z = pk2(h[3].x, h[3].y); o.w = pk2(h[3].z, h[3].w); *(v4u*)(ao + 512 + 8 * F.lane) = o; }
            { unsigned char* af = F.ws + WS_A3F + (size_t)m * D; v2u o8;
              o8.x = pack_fp8x4(h[0]); o8.y = pack_fp8x4(h[1]); *(v2u*)(af + 8 * F.lane) = o8; o8.x = pack_fp8x4(h[2]); o8.y = pack_fp8x4(h[3]); *(v2u*)(af + 512 + 8 * F.lane) = o8; }
#endif
        }
    }
}
__device__ __forceinline__ f32x4 fp8x4(unsigned w) { const f32x2 lo = __builtin_amdgcn_cvt_pk_f32_fp8((int)w, false), hi = __builtin_amdgcn_cvt_pk_f32_fp8((int)w, true); return (f32x4){lo.x, lo.y, hi.x, hi.y}; }
__device__ __forceinline__ void ph_final(Frame& F) {
    const float* lw = F.in[34]; const float* lb = F.in[35]; const float* mod = (const float*)(F.ws + WS_MOD);
    const float* lw1 = F.in[26]; const float* lb1 = F.in[27]; const bf16* X1P = (const bf16*)(F.ws + WS_X1);
    const unsigned char* Y = F.ws + WS_Y; const int* DEST = (const int*)(F.ws + WS_DEST); const float* GATE = (const float*)(F.ws + WS_GATE);
    const int c0 = 16 * F.lane;
    for (int m0 = F.gw; m0 < NLAT; m0 += 2 * F.NGW) {
        int mm[2]; mm[0] = m0; mm[1] = (m0 + F.NGW < NLAT) ? m0 + F.NGW : m0;
        v4u xw[2][2];
#if MS >= 2
        v4u dw[2][2]; f32x4 gw[2][2];
#pragma unroll
        for (int r = 0; r < 2; ++r) { dw[r][0] = *(const v4u*)(DEST + mm[r] * 8); dw[r][1] = *(const v4u*)(DEST + mm[r] * 8 + 4); gw[r][0] = *(const f32x4*)(GATE + mm[r] * 8); gw[r][1] = *(const f32x4*)(GATE + mm[r] * 8 + 4); }
#endif
#pragma unroll
        for (int r = 0; r < 2; ++r) { const bf16* row = X1P + (size_t)mm[r] * D + c0; xw[r][0] = *(const v4u*)row; xw[r][1] = *(const v4u*)(row + 8); }
#if MS >= 2
        v4u yw[2][TOPK + 1];
#pragma unroll
        for (int r = 0; r < 2; ++r) {
            int dr[TOPK]; dr[0] = (int)dw[r][0].x; dr[1] = (int)dw[r][0].y; dr[2] = (int)dw[r][0].z; dr[3] = (int)dw[r][0].w; dr[4] = (int)dw[r][1].x; dr[5] = (int)dw[r][1].y; dr[6] = (int)dw[r][1].z; dr[7] = (int)dw[r][1].w;
#pragma unroll
            for (int k = 0; k <= TOPK; ++k) yw[r][k] = *(const v4u*)(Y + (size_t)(k < TOPK ? dr[k < TOPK ? k : 0] : SH_ROW0 + mm[r]) * D + c0); }
        __builtin_amdgcn_sched_barrier(0);
#endif
#pragma unroll
        for (int r = 0; r < 2; ++r) { const int m = mm[r]; const int b = m / SEQ;
            f32x4 v[4];
            v[0] = (f32x4){bflo(xw[r][0].x), bfhi(xw[r][0].x), bflo(xw[r][0].y), bfhi(xw[r][0].y)}; v[1] = (f32x4){bflo(xw[r][0].z), bfhi(xw[r][0].z), bflo(xw[r][0].w), bfhi(xw[r][0].w)};
            v[2] = (f32x4){bflo(xw[r][1].x), bfhi(xw[r][1].x), bflo(xw[r][1].y), bfhi(xw[r][1].y)}; v[3] = (f32x4){bflo(xw[r][1].z), bfhi(xw[r][1].z), bflo(xw[r][1].w), bfhi(xw[r][1].w)};
            { float mean1, rstd1; ln_stats(v, mean1, rstd1);
#pragma unroll
              for (int j = 0; j < 4; ++j) { const int c = c0 + 4 * j; v[j] = ((v[j] - mean1) * rstd1 * *(const f32x4*)(lw1 + c) + *(const f32x4*)(lb1 + c)) * ALPHA; } }
#if MS >= 2
            const float gt[TOPK] = {gw[r][0].x * 0.0625f, gw[r][0].y * 0.0625f, gw[r][0].z * 0.0625f, gw[r][0].w * 0.0625f, gw[r][1].x * 0.0625f, gw[r][1].y * 0.0625f, gw[r][1].z * 0.0625f, gw[r][1].w * 0.0625f};
#pragma unroll
            for (int j = 0; j < 4; ++j) { const unsigned ws8 = j == 0 ? yw[r][TOPK].x : (j == 1 ? yw[r][TOPK].y : (j == 2 ? yw[r][TOPK].z : yw[r][TOPK].w));
                f32x4 mo = fp8x4(ws8) * 0.0625f;
#pragma unroll
                for (int k = 0; k < TOPK; ++k) { const unsigned wk = j == 0 ? yw[r][k].x : (j == 1 ? yw[r][k].y : (j == 2 ? yw[r][k].z : yw[r][k].w)); mo += fp8x4(wk) * gt[k]; }
                v[j] += *(const f32x4*)(mod + b * 6144 + 5120 + c0 + 4 * j) * mo; }
#endif
            float mean, rstd; ln_stats(v, mean, rstd);
            float* o = F.out + (size_t)m * D + c0;
#pragma unroll
            for (int j = 0; j < 4; ++j) { const int c = c0 + 4 * j; *(f32x4*)(o + 4 * j) = (v[j] - mean) * rstd * *(const f32x4*)(lw + c) + *(const f32x4*)(lb + c); }
        }
    }
}


#if MS >= 2
template <int MODE, bool FP8 = false>
__device__ __forceinline__ void cvt_item(const float* W, int Nsrc, int nblk, bf16* WT, int row_off, int dpitch, LAS float* scr, int item, int lane) {
    const int kb = item / nblk, nb = item - kb * nblk, k0 = 64 * kb, n0 = 32 * nb;
    const int nn = n0 + (lane & 31);
#pragma unroll 8
    for (int i = 0; i < 32; ++i) { const int kk = 2 * i + (lane >> 5); scr[kk * 33 + (lane & 31)] = (nn < Nsrc) ? W[(size_t)(k0 + kk) * Nsrc + nn] : 0.f; }
    LDS_WAIT(); asm volatile("" ::: "memory");
    const int c = lane & 7;
#pragma unroll
    for (int j = 0; j < 4; ++j) { const int n = (lane >> 3) + 8 * j; const LAS float* s = scr + (8 * c) * 33 + n;
        v4u o; o.x = pk2(s[0 * 33], s[1 * 33]); o.y = pk2(s[2 * 33], s[3 * 33]); o.z = pk2(s[4 * 33], s[5 * 33]); o.w = pk2(s[6 * 33], s[7 * 33]);
        const int ng = n0 + n; int dr = ng;
        if (MODE == 1) { const int i2 = ng & 255; dr = 8 * (i2 >> 2) + (i2 & 3) + ((ng >= 256) ? 4 : 0); }
        if constexpr (FP8) { v2u o8; o8.x = pack_fp8x4((f32x4){s[0 * 33], s[1 * 33], s[2 * 33], s[3 * 33]} * W8S); o8.y = pack_fp8x4((f32x4){s[4 * 33], s[5 * 33], s[6 * 33], s[7 * 33]} * W8S);
            *(v2u*)((unsigned char*)WT + (size_t)(row_off + dr) * dpitch + k0 + 8 * c) = o8; }
        else *(v4u*)(WT + (size_t)(row_off + dr) * dpitch + k0 + 8 * c) = o; }
    LDS_WAIT(); asm volatile("" ::: "memory");
}

template <int MODE>
__device__ __forceinline__ void cvt_item_reg(const float* W, int Nsrc, bf16* WT, int row_off, int dpitch, int k0, int n0, int lane) {
    const float* src = W + (size_t)k0 * Nsrc + n0 + 4 * lane;
    f32x4 v[32];
#pragma unroll
    for (int i = 0; i < 32; ++i) v[i] = __builtin_nontemporal_load((const f32x4*)(src + (size_t)i * Nsrc));
#pragma unroll
    for (int j = 0; j < 4; ++j) {
        const int ng = n0 + 4 * lane + j; int dr = ng;
        if (MODE == 1) { const int i2 = ng & 255; dr = 8 * (i2 >> 2) + (i2 & 3) + ((ng >= 256) ? 4 : 0); }
        v4u* dst = (v4u*)(WT + (size_t)(row_off + dr) * dpitch + k0);
#pragma unroll
        for (int q = 0; q < 4; ++q) { v4u o; o.x = pk2(v[8 * q][j], v[8 * q + 1][j]); o.y = pk2(v[8 * q + 2][j], v[8 * q + 3][j]); o.z = pk2(v[8 * q + 4][j], v[8 * q + 5][j]); o.w = pk2(v[8 * q + 6][j], v[8 * q + 7][j]); dst[q] = o; }
    }
}

constexpr int CVK = 32;
__device__ __forceinline__ void cvt_reg_load(const float* W, int Nsrc, int k0, int n0, int lane, f32x4 (&v)[CVK]) {
    const float* src = W + (size_t)k0 * Nsrc + n0 + 4 * lane;
#pragma unroll
    for (int i = 0; i < CVK; ++i) v[i] = __builtin_nontemporal_load((const f32x4*)(src + (size_t)i * Nsrc));
}
template <int MODE, bool FP8 = false>
__device__ __forceinline__ void cvt_reg_store(bf16* WT, int row_off, int dpitch, int k0, int n0, int lane, const f32x4 (&v)[CVK]) {
#pragma unroll
    for (int j = 0; j < 4; ++j) {
        const int ng = n0 + 4 * lane + j; int dr = ng;
        if (MODE == 1) { const int i2 = ng & 255; dr = 8 * (i2 >> 2) + (i2 & 3) + ((ng >= 256) ? 4 : 0); }
        if constexpr (FP8) { v4u* dst8 = (v4u*)((unsigned char*)WT + (size_t)(row_off + dr) * dpitch + k0);
#pragma unroll
            for (int q = 0; q < CVK / 16; ++q) { v4u o;
                o.x = pack_fp8x4((f32x4){v[16 * q][j], v[16 * q + 1][j], v[16 * q + 2][j], v[16 * q + 3][j]} * W8S); o.y = pack_fp8x4((f32x4){v[16 * q + 4][j], v[16 * q + 5][j], v[16 * q + 6][j], v[16 * q + 7][j]} * W8S);
                o.z = pack_fp8x4((f32x4){v[16 * q + 8][j], v[16 * q + 9][j], v[16 * q + 10][j], v[16 * q + 11][j]} * W8S); o.w = pack_fp8x4((f32x4){v[16 * q + 12][j], v[16 * q + 13][j], v[16 * q + 14][j], v[16 * q + 15][j]} * W8S); dst8[q] = o; }
            continue; }
        v4u* dst = (v4u*)(WT + (size_t)(row_off + dr) * dpitch + k0);
#pragma unroll
        for (int q = 0; q < CVK / 8; ++q) { v4u o; o.x = pg8::cvt_pk_bf16(v[8 * q][j], v[8 * q + 1][j]); o.y = pg8::cvt_pk_bf16(v[8 * q + 2][j], v[8 * q + 3][j]); o.z = pg8::cvt_pk_bf16(v[8 * q + 4][j], v[8 * q + 5][j]); o.w = pg8::cvt_pk_bf16(v[8 * q + 6][j], v[8 * q + 7][j]); dst[q] = o; }
    }
}
constexpr int CV_GU = (D / CVK) * 2, CV_DN = (FF / CVK) * 4, CV_NGU = (NE + 1) * CV_GU, CV_NITEM = CV_NGU + (NE + 1) * CV_DN;
__device__ __forceinline__ void cvx_load(const float* const* in, int it, int lane, f32x4 (&v)[CVK]) {
    if (it < CV_NGU) { const int e = it / CV_GU, ii = it - e * CV_GU; const float* src = (e < NE) ? in[30] + (size_t)e * D * 512 : in[32];
        cvt_reg_load(src, 512, CVK * (ii >> 1), 256 * (ii & 1), lane, v); }
    else { const int r = it - CV_NGU, e = r / CV_DN, ii = r - e * CV_DN; const float* src = (e < NE) ? in[31] + (size_t)e * FF * D : in[33];
        cvt_reg_load(src, D, CVK * (ii >> 2), 256 * (ii & 3), lane, v); }
}
__device__ __forceinline__ void cvx_store(unsigned char* ws, int it, int lane, const f32x4 (&v)[CVK]) {
    if (it < CV_NGU) { const int e = it / CV_GU, ii = it - e * CV_GU; cvt_reg_store<1, true>((bf16*)(ws + WS_WGU), e * 512, D, CVK * (ii >> 1), 256 * (ii & 1), lane, v); }
    else { const int r = it - CV_NGU, e = r / CV_DN, ii = r - e * CV_DN; cvt_reg_store<0, true>((bf16*)(ws + WS_WD), e * D, FF, CVK * (ii >> 2), 256 * (ii & 3), lane, v); }
}

typedef float f32x2v __attribute__((ext_vector_type(2)));
constexpr int CY_GU = (D / 32) * 4, CY_DN = (FF / 32) * 8, CY_NGU = (NE + 1) * CY_GU, CY_NITEM = CY_NGU + (NE + 1) * CY_DN;
#define CY_KB_GU(ii) ((((ii) >> 4) << 2) | ((ii) & 3))
#define CY_NB_GU(ii) (((ii) >> 2) & 3)
#define CY_KB_DN(ii) ((((ii) >> 5) << 2) | ((ii) & 3))
#define CY_NB_DN(ii) (((ii) >> 2) & 7)
__device__ __forceinline__ void cvy_load(const float* const* in, int it, int lane, f32x2v (&v)[32]) {
    const float* p;  int Nsrc;
    if (it < CY_NGU) { const int e = it / CY_GU, ii = it - e * CY_GU; const float* src = (e < NE) ? in[30] + (size_t)e * D * 512 : in[32]; Nsrc = 512; p = src + (size_t)(32 * CY_KB_GU(ii)) * 512 + 128 * CY_NB_GU(ii) + 2 * lane; }
    else { const int r = it - CY_NGU, e = r / CY_DN, ii = r - e * CY_DN; const float* src = (e < NE) ? in[31] + (size_t)e * FF * D : in[33]; Nsrc = D; p = src + (size_t)(32 * CY_KB_DN(ii)) * D + 128 * CY_NB_DN(ii) + 2 * lane; }
#pragma unroll
    for (int i = 0; i < 32; ++i) v[i] = __builtin_nontemporal_load((const f32x2v*)(p + (size_t)i * Nsrc));
}
__device__ __forceinline__ void cvy_store(unsigned char* ws, int it, int lane, const f32x2v (&v)[32]) {
    unsigned char* base; int dpitch, n0; bool gu = it < CY_NGU;
    if (gu) { const int e = it / CY_GU, ii = it - e * CY_GU; base = ws + WS_WGU + (size_t)(e * 512) * D + 32 * CY_KB_GU(ii); dpitch = D; n0 = 128 * CY_NB_GU(ii); }
    else { const int r = it - CY_NGU, e = r / CY_DN, ii = r - e * CY_DN; base = ws + WS_WD + (size_t)(e * D) * FF + 32 * CY_KB_DN(ii); dpitch = FF; n0 = 128 * CY_NB_DN(ii); }
#pragma unroll
    for (int j = 0; j < 2; ++j) {
        const int ng = n0 + 2 * lane + j; int dr = ng;
        if (gu) { const int i2 = ng & 255; dr = 8 * (i2 >> 2) + (i2 & 3) + ((ng >= 256) ? 4 : 0); }
        v4u* dst8 = (v4u*)(base + (size_t)dr * dpitch);
#pragma unroll
        for (int q = 0; q < 2; ++q) { v4u o;
            o.x = pack_fp8x4((f32x4){v[16 * q][j], v[16 * q + 1][j], v[16 * q + 2][j], v[16 * q + 3][j]} * W8S); o.y = pack_fp8x4((f32x4){v[16 * q + 4][j], v[16 * q + 5][j], v[16 * q + 6][j], v[16 * q + 7][j]} * W8S);
            o.z = pack_fp8x4((f32x4){v[16 * q + 8][j], v[16 * q + 9][j], v[16 * q + 10][j], v[16 * q + 11][j]} * W8S); o.w = pack_fp8x4((f32x4){v[16 * q + 12][j], v[16 * q + 13][j], v[16 * q + 14][j], v[16 * q + 15][j]} * W8S); dst8[q] = o; }
    }
}
#define CVY_FLUSH() do { if (cpend >= 0) cvy_store(F.ws, cpend, lane, cv); cpend = -1; } while (0)
#define CVY_START(item) do { if ((item) < CY_NITEM) { cvy_load(F.in, (item), lane, cv); cpend = (item); } } while (0)

#if MS >= 3
__device__ __forceinline__ float lora_val(const float* const* in, int n, int k) {
    if (n < 1024) { const int q = n >> 3, e8 = n & 7, dir = e8 >> 2, ch = q * 4 + (e8 & 3); return (k < 32) ? in[9][(size_t)(dir * 32 + k) * 512 + ch] : 0.f; }
    if (n < 2048) { const int m = n - 1024, q = m >> 3, e8 = m & 7, dir = e8 >> 2, ch = q * 4 + (e8 & 3); return (k >= 32 && k < 64) ? in[11][(size_t)(dir * 32 + (k - 32)) * 512 + ch] : 0.f; }
    if (n < 2560) { const int ch = n - 2048; return (k >= 64 && k < 160) ? in[12][(size_t)(k - 64) * 512 + ch] : 0.f; }
    { const int m = n - 2560, q = m >> 3, e8 = m & 7, dir = e8 >> 2, ch = q * 4 + (e8 & 3); return (k >= 160 && k < 176) ? in[19][(size_t)(dir * 16 + (k - 160)) * 256 + ch] : 0.f; }
}
#endif

__device__ __forceinline__ void ph_prologue(Frame& F) {
    {
        const float* c = F.in[1]; const float* cc = F.in[3]; const float* wa = F.in[4]; const float* ba = F.in[5];
        float* MOD = (float*)(F.ws + WS_MOD);
        LAS float* S = (LAS float*)F.lds; LAS float* red = (LAS float*)(F.lds + 32768);
        for (int it = blockIdx.x; it < 96; it += F.G) {
            for (int i = F.tid; i < 5120; i += NTHR) { const int r = i >> 10, k = i & 1023; const float cv = r < 4 ? c[r * 1024 + k] : cc[k]; S[i] = siluf_(cv); }
            __syncthreads();
            const int n = it * 64 + F.lane; float acc[5] = {0.f, 0.f, 0.f, 0.f, 0.f};
            for (int kk = 0; kk < 128; ++kk) { const int k = F.wave * 128 + kk; const float wv = wa[(size_t)k * 6144 + n];
#pragma unroll
                for (int r = 0; r < 5; ++r) acc[r] += S[r * 1024 + k] * wv; }
#pragma unroll
            for (int r = 0; r < 5; ++r) red[(F.wave * 5 + r) * 64 + F.lane] = acc[r];
            __syncthreads();
            if (F.wave == 0) {
#pragma unroll
                for (int r = 0; r < 5; ++r) { float s = 0.f;
#pragma unroll
                    for (int w = 0; w < 8; ++w) s += red[(w * 5 + r) * 64 + F.lane];
                    MOD[r * 6144 + n] = s + ba[n]; }
            }
            __syncthreads();
        }
    }
    {
        LAS float* scr = (LAS float*)(F.lds + F.wave * 16384);
        constexpr int I_IN = 16 * 168, I_BR = 8 * 32, I_OUT = 16 * 32, I_RT = 16 * 8, I_GU = 32 * 2, I_DN = 8 * 4;
        constexpr int T0 = I_IN, T1 = T0 + I_BR, T2 = T1 + I_BR, T3 = T2 + I_OUT, T4 = T3 + I_RT, T5 = T4 + (NE + 1) * I_GU, T6 = T5 + (NE + 1) * I_DN;
        unsigned char* ws = F.ws;
        for (int it = F.gw; it < T6; it += F.NGW) {
#if MS >= 3
            if (it < T0) { cvt_item<0, true>(F.in[6], IN_COLS, 168, (bf16*)(ws + WS_WIN), 0, D, scr, it, F.lane); continue; }
            if (it < T1) { cvt_item<0>(F.in[23], D, 32, (bf16*)(ws + WS_WBRRW), 0, RWW, scr, it - T0, F.lane); continue; }
            if (it < T2) { cvt_item<0>(F.in[24], D, 32, (bf16*)(ws + WS_WBRGLA), 0, RWW, scr, it - T1, F.lane); continue; }
            if (it < T3) { cvt_item<0>(F.in[25], D, 32, (bf16*)(ws + WS_WOUT), 0, D, scr, it - T2, F.lane); continue; }
#else
            if (it < T3) continue;
#endif
            if (it < T4) { cvt_item<0>(F.in[28], NE, 8, (bf16*)(ws + WS_WROUTER), 0, D, scr, it - T3, F.lane); continue; }
#if MS >= 3
            break;
#endif
            if (it < T5) { const int r = it - T4, e = r / I_GU, ii = r - e * I_GU;
                const float* src = (e < NE) ? F.in[30] + (size_t)e * D * 512 : F.in[32];
                cvt_item_reg<1>(src, 512, (bf16*)(ws + WS_WGU), e * 512, D, 32 * (ii >> 1), 256 * (ii & 1), F.lane); continue; }
            { const int r = it - T5, e = r / I_DN, ii = r - e * I_DN;
                const float* src = (e < NE) ? F.in[31] + (size_t)e * FF * D : F.in[33];
                cvt_item_reg<0>(src, D, (bf16*)(ws + WS_WD), e * D, FF, 32 * (ii >> 2), 256 * (ii & 3), F.lane); }
        }
    }
#if MS >= 3
    {
        bf16* WL = (bf16*)(F.ws + WS_WLORA);
        for (int idx = blockIdx.x * NTHR + F.tid; idx < NLORA * (KLORA / 8); idx += F.G * NTHR) {
            const int n = idx >> 5, k0 = (idx & 31) * 8; float v[8];
#pragma unroll
            for (int e = 0; e < 8; ++e) v[e] = lora_val(F.in, n, k0 + e);
            v4u o; o.x = pk2(v[0], v[1]); o.y = pk2(v[2], v[3]); o.z = pk2(v[4], v[5]); o.w = pk2(v[6], v[7]);
            *(v4u*)(WL + (size_t)n * KLORA + k0) = o;
        }
    }
#endif
}

struct EpiF32 {
    static constexpr bool PERM = false;
    float* C; int ldc;
    __device__ __forceinline__ void operator()(const f32x4 (&acc)[2][2][4][2], const pg8::Unit& u, int wr, int wc, int fr, int fq) const {
        const int row0 = u.pm * 256 + wr * 64 + fr, col0 = u.pn * 256 + wc * 32 + 4 * fq;
#pragma unroll
        for (int ai = 0; ai < 2; ++ai)
#pragma unroll
            for (int m = 0; m < 4; ++m) { float* rowp = C + (size_t)(row0 + ai * 128 + m * 16) * ldc + col0;
#pragma unroll
                for (int bj = 0; bj < 2; ++bj)
#pragma unroll
                    for (int n = 0; n < 2; ++n) *(f32x4*)(rowp + bj * 128 + n * 16) = acc[ai][bj][m][n]; }
    }
};
struct EpiSwiglu {
    static constexpr bool PERM = true;
    unsigned char* ACT;
    __device__ __forceinline__ void operator()(const f32x4 (&acc)[2][2][4][2], const pg8::Unit& u, int wr, int wc, int fr, int fq) const {
        const int row0 = u.pm * 256 + wr * 64 + fr, h0 = u.j * 128 + wc * 16 + 4 * fq;
#pragma unroll
        for (int ai = 0; ai < 2; ++ai)
#pragma unroll
            for (int m = 0; m < 4; ++m) { unsigned char* rowp = ACT + (size_t)(row0 + ai * 128 + m * 16) * FF + h0;
#pragma unroll
                for (int bj = 0; bj < 2; ++bj) { const f32x4 a = acc[ai][bj][m][0] * W8I, b = acc[ai][bj][m][1] * W8I;
                    *(unsigned*)(rowp + bj * 64) = pack_fp8x4((f32x4){siluf_(a[0]) * b[0], siluf_(a[1]) * b[1], siluf_(a[2]) * b[2], siluf_(a[3]) * b[3]}); } }
    }
};
struct EpiRowsBf16 {
    static constexpr bool PERM = true;
    bf16* O; int ldc; float sc;
    __device__ __forceinline__ void operator()(const f32x4 (&acc)[2][2][4][2], const pg8::Unit& u, int wr, int wc, int fr, int fq) const {
        const int row0 = u.pm * 256 + wr * 64 + fr, col0 = u.j * 256 + wc * 32 + 8 * fq;
#pragma unroll
        for (int ai = 0; ai < 2; ++ai)
#pragma unroll
            for (int m = 0; m < 4; ++m) { bf16* rowp = O + (size_t)(row0 + ai * 128 + m * 16) * ldc + col0;
#pragma unroll
                for (int bj = 0; bj < 2; ++bj) { const f32x4 v0 = acc[ai][bj][m][0] * sc, v1 = acc[ai][bj][m][1] * sc;
                    v4u w; w.x = pg8::cvt_pk_bf16(v0[0], v0[1]); w.y = pg8::cvt_pk_bf16(v0[2], v0[3]); w.z = pg8::cvt_pk_bf16(v1[0], v1[1]); w.w = pg8::cvt_pk_bf16(v1[2], v1[3]);
                    *(v4u*)(rowp + bj * 128) = w;
#ifdef PROBE_ST2
                    asm volatile("" ::: "memory"); *(volatile v4u*)(rowp + bj * 128) = w;
#endif
                    } }
    }
};

struct EpiRowsFp8 {
    static constexpr bool PERM = true;
    unsigned char* O;
    __device__ __forceinline__ void operator()(const f32x4 (&acc)[2][2][4][2], const pg8::Unit& u, int wr, int wc, int fr, int fq) const {
        const int row0 = u.pm * 256 + wr * 64 + fr, col0 = u.j * 256 + wc * 32 + 8 * fq;
#pragma unroll
        for (int ai = 0; ai < 2; ++ai)
#pragma unroll
            for (int m = 0; m < 4; ++m) { unsigned char* rowp = O + (size_t)(row0 + ai * 128 + m * 16) * D + col0;
#pragma unroll
                for (int bj = 0; bj < 2; ++bj) { f32x4 v0 = acc[ai][bj][m][0] * (16.0f * W8I), v1 = acc[ai][bj][m][1] * (16.0f * W8I);
#pragma unroll
                    for (int e = 0; e < 4; ++e) { v0[e] = __builtin_amdgcn_fmed3f(v0[e], -448.0f, 448.0f); v1[e] = __builtin_amdgcn_fmed3f(v1[e], -448.0f, 448.0f); }
                    int w0 = __builtin_amdgcn_cvt_pk_fp8_f32(v0[0], v0[1], 0, false); w0 = __builtin_amdgcn_cvt_pk_fp8_f32(v0[2], v0[3], w0, true);
                    int w1 = __builtin_amdgcn_cvt_pk_fp8_f32(v1[0], v1[1], 0, false); w1 = __builtin_amdgcn_cvt_pk_fp8_f32(v1[2], v1[3], w1, true);
                    v2u w; w.x = (unsigned)w0; w.y = (unsigned)w1; *(v2u*)(rowp + bj * 128) = w; } }
    }
};

__device__ __forceinline__ void ph_router(Frame& F) {
    pg8::Gemm g{(const bf16*)(F.ws + WS_A3), (const bf16*)(F.ws + WS_WROUTER), NLAT, NE, D, nullptr};
    pg8::StaticOrder S; S.init(NLAT, NE, F.G, (int)blockIdx.x);
    EpiF32 E{(float*)(F.ws + WS_LOGITS), NE};
    pg8::gemm_phase<EpiF32, pg8::StaticOrder, true, true, false>(F.lds, g, S, E);
}

#define RT_DPP(x, ctrl) __builtin_amdgcn_update_dpp(0, (x), (ctrl), 0xf, 0xf, false)
__device__ __forceinline__ unsigned wave_max_u32(unsigned k) {
    k = max(k, (unsigned)RT_DPP((int)k, 0xB1)); k = max(k, (unsigned)RT_DPP((int)k, 0x4E));
    k = max(k, (unsigned)RT_DPP((int)k, 0x124)); k = max(k, (unsigned)RT_DPP((int)k, 0x128));
    const unsigned a = (unsigned)__builtin_amdgcn_readlane((int)k, 0), b = (unsigned)__builtin_amdgcn_readlane((int)k, 16), c = (unsigned)__builtin_amdgcn_readlane((int)k, 32), d = (unsigned)__builtin_amdgcn_readlane((int)k, 48);
    return max(max(a, b), max(c, d));
}
__device__ __forceinline__ void ph_route(Frame& F) {
    const float* LOG = (const float*)(F.ws + WS_LOGITS); const float* rb = F.in[29];
    int* EIDX = (int*)(F.ws + WS_EIDX); float* GATE = (float*)(F.ws + WS_GATE); int* DEST = (int*)(F.ws + WS_DEST);
    unsigned* CNT = F.ctl + CW_CNT;
    const f32x4 bias = *(const f32x4*)(rb + 4 * F.lane);
    f32x4 lgn = *(const f32x4*)(LOG + (size_t)(F.gw < NLAT ? F.gw : 0) * NE + 4 * F.lane);
    for (int m = F.gw; m < NLAT; m += F.NGW) {
        const f32x4 lg = lgn;
        { const int mn = (m + F.NGW < NLAT) ? m + F.NGW : m; lgn = *(const f32x4*)(LOG + (size_t)mn * NE + 4 * F.lane); }
        float sc[4], sel[4];
#pragma unroll
        for (int i = 0; i < 4; ++i) { sc[i] = sigmoidf_(lg[i]); sel[i] = sc[i] + bias[i]; }
        float m1 = fmaxf(sel[0], sel[1]), m2 = fminf(sel[0], sel[1]);
        { const float a = sel[2]; const float n1 = fmaxf(m1, a); m2 = fmaxf(m2, fminf(m1, a)); m1 = n1; }
        { const float a = sel[3]; const float n1 = fmaxf(m1, a); m2 = fmaxf(m2, fminf(m1, a)); m1 = n1; }
#define RT_MERGE(ctrl) do { const float b1 = __builtin_bit_cast(float, RT_DPP(__builtin_bit_cast(int, m1), ctrl)), b2 = __builtin_bit_cast(float, RT_DPP(__builtin_bit_cast(int, m2), ctrl)); \
            const float n1 = fmaxf(m1, b1); m2 = fmaxf(fminf(m1, b1), fmaxf(m2, b2)); m1 = n1; } while (0)
        RT_MERGE(0xB1); RT_MERGE(0x4E); RT_MERGE(0x141);
#undef RT_MERGE
        const float gs = m1 + m2; const int g = F.lane >> 3;
        int rank = 0;
#pragma unroll
        for (int gg = 0; gg < 8; ++gg) { const float og = __builtin_bit_cast(float, __builtin_amdgcn_readlane(__builtin_bit_cast(int, gs), gg * 8)); rank += (og > gs || (og == gs && gg < g)) ? 1 : 0; }
        const bool keep = rank < 4;
        unsigned key[4];
#pragma unroll
        for (int i = 0; i < 4; ++i) { unsigned u = __builtin_bit_cast(unsigned, sel[i]); u ^= (u >> 31) ? 0xffffffffu : 0x80000000u;
            key[i] = keep ? ((u & 0xffffff00u) | (unsigned)(255 - (4 * F.lane + i))) : 0u; }
        int my_e = 0; float my_s = 0.f; float ssum = 0.f;
#pragma unroll
        for (int k = 0; k < TOPK; ++k) {
            const unsigned best = wave_max_u32(max(max(key[0], key[1]), max(key[2], key[3])));
            const int e = 255 - (int)(best & 255u), owner = e >> 2;
            float s_own = 0.f;
#pragma unroll
            for (int i = 0; i < 4; ++i) if (key[i] == best) { s_own = sc[i]; key[i] = 0u; }
            const float s = __builtin_bit_cast(float, __builtin_amdgcn_readlane(__builtin_bit_cast(int, s_own), owner));
            ssum += s;
            if (F.lane == k) { my_e = e; my_s = s; }
        }
        if (F.lane < TOPK) {
            const unsigned pos = __hip_atomic_fetch_add(CNT + my_e * CNT_STRIDE, 1u, __ATOMIC_RELAXED, __HIP_MEMORY_SCOPE_AGENT);
            EIDX[m * 8 + F.lane] = my_e; GATE[m * 8 + F.lane] = my_s * __builtin_amdgcn_rcpf(ssum) * 2.5f; DEST[m * 8 + F.lane] = (int)pos;
        }
    }
}
#undef RT_DPP

__device__ __forceinline__ void ph_scatter(Frame& F) {
    LAS int* tstart = (LAS int*)F.lds;
    LAS int* scan = (LAS int*)(F.lds + 2048);
    LAS int* cnts = (LAS int*)(F.lds + 4096);
    int* EIDX = (int*)(F.ws + WS_EIDX); int* DEST = (int*)(F.ws + WS_DEST); int* ROWTOK = (int*)(F.ws + WS_ROWTOK); int* TILE_E = (int*)(F.ws + WS_TILE_E);
    unsigned* CNT = F.ctl + CW_CNT;
    int tiles = 0, cnt = 0;
    if (F.tid < NE) { cnt = (int)__hip_atomic_load(CNT + F.tid * CNT_STRIDE, __ATOMIC_RELAXED, __HIP_MEMORY_SCOPE_AGENT); tiles = (cnt + 255) >> 8; scan[F.tid] = tiles; cnts[F.tid] = cnt; }
    __syncthreads();
    for (int o = 1; o < NE; o <<= 1) { int v = 0; if (F.tid < NE && F.tid >= o) v = scan[F.tid - o]; __syncthreads(); if (F.tid < NE) scan[F.tid] += v; __syncthreads(); }
    if (F.tid < NE) { tstart[F.tid + 1] = scan[F.tid]; if (F.tid == 0) tstart[0] = 0; }
    __syncthreads();
    const int NT = tstart[NE];
    if (blockIdx.x == 0) {
        if (F.tid == 0) F.ctl[CW_NT] = (unsigned)NT;
        if (F.tid < NE) for (int t = tstart[F.tid]; t < tstart[F.tid + 1]; ++t) TILE_E[t] = F.tid;
    }
    for (int e = blockIdx.x; e < NE; e += F.G) { const int c0 = cnts[e], c1 = (tstart[e + 1] - tstart[e]) * 256, base = tstart[e] * 256;
        for (int p = c0 + F.tid; p < c1; p += NTHR) ROWTOK[base + p] = 0; }
    for (int i = blockIdx.x * NTHR + F.tid; i < NLAT; i += F.G * NTHR) ROWTOK[SH_ROW0 + i] = i;
    for (int i = blockIdx.x * NTHR + F.tid; i < NLAT * TOPK; i += F.G * NTHR) {
        const int e = EIDX[i], pos = DEST[i]; const int dr = tstart[e] * 256 + pos;
        DEST[i] = dr; ROWTOK[dr] = i >> 3;
    }
}

__device__ __forceinline__ void ph_exp1(Frame& F) {
    const int NT = (int)__hip_atomic_load(F.ctl + CW_NT, __ATOMIC_RELAXED, __HIP_MEMORY_SCOPE_AGENT);
    pg8::Gemm g{(const bf16*)(F.ws + WS_A3F), (const bf16*)(F.ws + WS_WGU), 0, 0, D / 2, (const int*)(F.ws + WS_ROWTOK)};
    pg8::MoeOrder S{2, F.G, (int)blockIdx.x, NT, (const int*)(F.ws + WS_TILE_E)};
    EpiSwiglu E{F.ws + WS_ACT};
    pg8::gemm_phase<EpiSwiglu, pg8::MoeOrder, true, true, true, true>(F.lds, g, S, E);
}
__device__ __forceinline__ void ph_exp2(Frame& F) {
    const int NT = (int)__hip_atomic_load(F.ctl + CW_NT, __ATOMIC_RELAXED, __HIP_MEMORY_SCOPE_AGENT);
    pg8::Gemm g{(const bf16*)(F.ws + WS_ACT), (const bf16*)(F.ws + WS_WD), 0, 0, FF / 2, nullptr};
    pg8::MoeOrder S{4, F.G, (int)blockIdx.x, NT, (const int*)(F.ws + WS_TILE_E)};
    EpiRowsFp8 E{F.ws + WS_Y};
    pg8::gemm_phase<EpiRowsFp8, pg8::MoeOrder, true, true, false, true>(F.lds, g, S, E);
}
#endif

#if MS >= 3
__device__ __forceinline__ void unp8(const v4u w, float (&f)[8]) { f[0] = bflo(w.x); f[1] = bfhi(w.x); f[2] = bflo(w.y); f[3] = bfhi(w.y); f[4] = bflo(w.z); f[5] = bfhi(w.z); f[6] = bflo(w.w); f[7] = bfhi(w.w); }
__device__ __forceinline__ void unp8f8(const v2u w, float (&f)[8]) { const f32x2 a = __builtin_amdgcn_cvt_pk_f32_fp8((int)w.x, false), b = __builtin_amdgcn_cvt_pk_f32_fp8((int)w.x, true), c = __builtin_amdgcn_cvt_pk_f32_fp8((int)w.y, false), d = __builtin_amdgcn_cvt_pk_f32_fp8((int)w.y, true);
    f[0] = a.x; f[1] = a.y; f[2] = b.x; f[3] = b.y; f[4] = c.x; f[5] = c.y; f[6] = d.x; f[7] = d.y; }
__device__ __forceinline__ v4u pk8(const float (&f)[8]) { v4u o; o.x = pk2(f[0], f[1]); o.y = pk2(f[2], f[3]); o.z = pk2(f[4], f[5]); o.w = pk2(f[6], f[7]); return o; }
__device__ __forceinline__ void st8(float* p, const float (&f)[8]) { *(f32x4*)p = (f32x4){f[0], f[1], f[2], f[3]}; *(f32x4*)(p + 4) = (f32x4){f[4], f[5], f[6], f[7]}; }
__device__ __forceinline__ void ld8(const float* p, float (&f)[8]) { const f32x4 a = *(const f32x4*)p, b = *(const f32x4*)(p + 4); f[0] = a.x; f[1] = a.y; f[2] = a.z; f[3] = a.w; f[4] = b.x; f[5] = b.y; f[6] = b.z; f[7] = b.w; }

__device__ __forceinline__ void ph_a1(Frame& F) {
    const float* mod = (const float*)(F.ws + WS_MOD); unsigned char* A1 = F.ws + WS_A1;
    constexpr int NR = 4;
    for (int m0 = F.gw; m0 < MR; m0 += NR * F.NGW) {
        f32x4 xv[NR][4];
#pragma unroll
        for (int r = 0; r < NR; ++r) { const int mm = m0 + r * F.NGW; const int m = mm < MR ? mm : m0;
            const float* src = (m < NLAT) ? F.in[0] + (size_t)m * D : F.in[2] + (size_t)(m - NLAT) * D;
            const f32x4* xr = (const f32x4*)src + F.lane;
#pragma unroll
            for (int j = 0; j < 4; ++j) xv[r][j] = __builtin_nontemporal_load(xr + 64 * j); }
        __builtin_amdgcn_sched_barrier(0);
#pragma unroll
        for (int r = 0; r < NR; ++r) { const int mm = m0 + r * F.NGW; const int m = mm < MR ? mm : m0; const int mr = (m < NLAT) ? (m / SEQ) : 4;
            unsigned* ao = (unsigned*)(A1 + (size_t)m * D) + F.lane;
#pragma unroll
            for (int j = 0; j < 4; ++j) { const int c = 4 * F.lane + 256 * j;
                const f32x4 sh = *(const f32x4*)(mod + mr * 6144 + c), sc = *(const f32x4*)(mod + mr * 6144 + 1024 + c);
                const f32x4 h = xv[r][j] * (sc + 1.0f) + sh; ao[64 * j] = pack_fp8x4(h); } }
    }
}

__device__ __forceinline__ void ph_inproj(Frame& F) {
    pg8::Gemm g{(const bf16*)(F.ws + WS_A1), (const bf16*)(F.ws + WS_WIN), MR, NP, D / 2, nullptr};
    pg8::StaticOrder S; S.init(MR, NP, F.G, (int)blockIdx.x);
    EpiRowsBf16 E{(bf16*)(F.ws + WS_P), NP, W8I};
    pg8::gemm_phase<EpiRowsBf16, pg8::StaticOrder, true, true, false, true>(F.lds, g, S, E);
}

struct FeatOut { bf16 *R, *V, *KK, *KP, *QG, *KGB, *VGB, *A2; const float *mu, *kkw, *cw; };
__device__ __forceinline__ void feat_rw(const FeatOut& O, int p, size_t m, int lane, const v4u own_w, const v4u (&nbw)[4], const float (&muv)[8]) {
    float own[8], sh[4][8], val[8];
    unp8(own_w, own);
#pragma unroll
    for (int q = 0; q < 4; ++q) unp8(nbw[q], sh[q]);
#pragma unroll
    for (int e = 0; e < 8; ++e) val[e] = own[e] + muv[e] * (sh[e & 3][e] - own[e]);
    if (p == 0) *(v4u*)(O.R + m * RWW + 8 * lane) = pk8(val);
    else if (p == 2) *(v4u*)(O.V + m * RWW + 8 * lane) = pk8(val);
    else if (p == 1) {
        *(v4u*)(O.KP + m * RWW + 8 * lane) = pk8(val);
        float kw[8]; ld8(O.kkw + 8 * lane, kw); float kkv[8]; float ss = 0.f;
#pragma unroll
        for (int e = 0; e < 8; ++e) { kkv[e] = val[e] * kw[e]; ss += kkv[e] * kkv[e]; }
        ss += __shfl_xor(ss, 1); ss += __shfl_xor(ss, 2); ss += __shfl_xor(ss, 4);
        const float inv = 1.0f / fmaxf(sqrtf(ss), 1e-12f);
#pragma unroll
        for (int e = 0; e < 8; ++e) kkv[e] *= inv;
        *(v4u*)(O.KK + m * RWW + 8 * lane) = pk8(kkv);
    } else {
        float o[8];
#pragma unroll
        for (int e = 0; e < 8; ++e) o[e] = (lane < 4) ? tanhf_(val[e]) : ((lane < 8) ? val[e] : sigmoidf_(val[e]));
        *(v4u*)(O.A2 + m * KLORA + 8 * lane) = pk8(o);
    }
}
__device__ __forceinline__ void feat_gla_store(const FeatOut& O, int p, size_t m, int lane, const float (&acc)[8]) {
    const int cq = p * 512 + 8 * lane; float o[8];
#pragma unroll
    for (int e = 0; e < 8; ++e) o[e] = siluf_(acc[e]);
    if (p == 0) {
        if (lane < 32) {
#pragma unroll
            for (int e = 0; e < 8; ++e) o[e] *= 0.125f;
            *(v4u*)(O.QG + m * 256 + cq) = pk8(o);
        } else *(v4u*)(O.KGB + m * 256 + (cq - 256)) = pk8(o);
    } else *(v4u*)(O.VGB + m * RWW + (cq - 512)) = pk8(o);
}
__device__ __forceinline__ void ph_feat(Frame& F) {
    const bf16* P = (const bf16*)(F.ws + WS_P);
    FeatOut O{(bf16*)(F.ws + WS_RB), (bf16*)(F.ws + WS_VB), (bf16*)(F.ws + WS_KKB), (bf16*)(F.ws + WS_KMF), (bf16*)(F.ws + WS_QGB), (bf16*)(F.ws + WS_KGB), (bf16*)(F.ws + WS_VGB), (bf16*)(F.ws + WS_A2), F.in[7], F.in[13], F.in[18]};
    const v4u Z4 = (v4u){0u, 0u, 0u, 0u};
    for (int blk = F.gw; blk < NB * (GRIDH / 2) * (GRIDW / 2); blk += F.NGW) {
        int lane = F.lane; asm volatile("" : "+v"(lane));
        const int b = blk >> 11, r0 = 2 * ((blk >> 5) & 63), c0 = 2 * (blk & 31); const int mb = b * SEQ + r0 * GRIDW + c0;
        const bool vu = r0 > 0, vd = r0 + 2 < GRIDH, vl = c0 > 0, vr = c0 + 2 < GRIDW;
#pragma unroll
        for (int p = 0; p < 4; ++p) {
            const int cb = p * 512 + 8 * lane; const bool act = (p < 3) || lane < 20;
            v4u own[2][2], up[2], dn[2], lf[2], rt[2];
#pragma unroll
            for (int i = 0; i < 2; ++i) { up[i] = Z4; dn[i] = Z4; lf[i] = Z4; rt[i] = Z4; own[i][0] = Z4; own[i][1] = Z4; }
            if (act) {
#pragma unroll
                for (int i = 0; i < 2; ++i) {
#pragma unroll
                    for (int j = 0; j < 2; ++j) own[i][j] = *(const v4u*)(P + (size_t)(mb + 64 * i + j) * NP + cb);
                    if (vu) up[i] = *(const v4u*)(P + (size_t)(mb - 64 + i) * NP + cb);
                    if (vd) dn[i] = *(const v4u*)(P + (size_t)(mb + 128 + i) * NP + cb);
                    if (vl) lf[i] = *(const v4u*)(P + (size_t)(mb + 64 * i - 1) * NP + cb);
                    if (vr) rt[i] = *(const v4u*)(P + (size_t)(mb + 64 * i + 2) * NP + cb); }
            } else if (p == 3 && lane >= 20 && lane < 22) {
#pragma unroll
                for (int i = 0; i < 2; ++i)
#pragma unroll
                    for (int j = 0; j < 2; ++j) own[i][j] = *(const v4u*)(P + (size_t)(mb + 64 * i + j) * NP + C_PGL + 8 * (lane - 20));
            }
            float muv[8] = {0.f, 0.f, 0.f, 0.f, 0.f, 0.f, 0.f, 0.f}; if (act) ld8(O.mu + cb, muv);
            __builtin_amdgcn_sched_barrier(0);
#pragma unroll
            for (int i = 0; i < 2; ++i)
#pragma unroll
                for (int j = 0; j < 2; ++j) { const size_t m = (size_t)(mb + 64 * i + j);
                    if (act) { const v4u nbw[4] = {j == 0 ? lf[i] : own[i][0], j == 1 ? rt[i] : own[i][1], i == 0 ? up[j] : own[0][j], i == 1 ? dn[j] : own[1][j]};
                        feat_rw(O, p, m, lane, own[i][j], nbw, muv); }
                    else if (p == 3 && lane < 32) *(v4u*)(O.A2 + m * KLORA + 8 * lane) = own[i][j]; }
        }
#pragma unroll
        for (int p = 0; p < 2; ++p) {
            const int cq = p * 512 + 8 * lane, cb = C_Q + cq;
            v4u g[4][4];
#pragma unroll
            for (int a2 = 0; a2 < 4; ++a2)
#pragma unroll
                for (int b2 = 0; b2 < 4; ++b2) { const bool ok = (a2 == 0 ? vu : (a2 == 3 ? vd : true)) && (b2 == 0 ? vl : (b2 == 3 ? vr : true));
                    g[a2][b2] = Z4; if (ok) g[a2][b2] = *(const v4u*)(P + (size_t)(mb + 64 * (a2 - 1) + (b2 - 1)) * NP + cb); }
            __builtin_amdgcn_sched_barrier(0);
            float acc[2][2][8];
#pragma unroll
            for (int i = 0; i < 2; ++i)
#pragma unroll
                for (int j = 0; j < 2; ++j)
#pragma unroll
                    for (int e = 0; e < 8; ++e) acc[i][j][e] = 0.f;
#pragma unroll
            for (int dy = 0; dy < 3; ++dy)
#pragma unroll
                for (int dx = 0; dx < 3; ++dx) { float wv[8]; ld8(O.cw + (dy * 3 + dx) * 1024 + cq, wv);
#pragma unroll
                    for (int i = 0; i < 2; ++i)
#pragma unroll
                        for (int j = 0; j < 2; ++j) { float pv[8]; unp8(g[i + dy][j + dx], pv);
#pragma unroll
                            for (int e = 0; e < 8; ++e) acc[i][j][e] += pv[e] * wv[e]; } }
#pragma unroll
            for (int i = 0; i < 2; ++i)
#pragma unroll
                for (int j = 0; j < 2; ++j) feat_gla_store(O, p, (size_t)(mb + 64 * i + j), lane, acc[i][j]);
        }
    }
    for (int m = NLAT + F.gw; m < MR; m += F.NGW) {
        int lane = F.lane; asm volatile("" : "+v"(lane));
        const int t = (m - NLAT) & (CTXL - 1); const bool vp = t > 0, vn = t < CTXL - 1;
#pragma unroll
        for (int p = 0; p < 4; ++p) {
            const int cb = p * 512 + 8 * lane; const bool act = (p < 3) || lane < 20;
            if (act) { const v4u own = *(const v4u*)(P + (size_t)m * NP + cb); v4u pv = Z4, nv = Z4;
                if (vp) pv = *(const v4u*)(P + (size_t)(m - 1) * NP + cb); if (vn) nv = *(const v4u*)(P + (size_t)(m + 1) * NP + cb);
                float muv[8]; ld8(O.mu + cb, muv); const v4u nbw[4] = {pv, nv, pv, nv};
                feat_rw(O, p, (size_t)m, lane, own, nbw, muv); }
            else if (p == 3 && lane < 32) { v4u w = Z4; if (lane < 22) w = *(const v4u*)(P + (size_t)m * NP + C_PGL + 8 * (lane - 20)); *(v4u*)(O.A2 + (size_t)m * KLORA + 8 * lane) = w; }
        }
#pragma unroll
        for (int p = 0; p < 2; ++p) {
            const int cq = p * 512 + 8 * lane, cb = C_Q + cq; float acc[8] = {0.f, 0.f, 0.f, 0.f, 0.f, 0.f, 0.f, 0.f};
#pragma unroll
            for (int dx = -1; dx <= 1; ++dx) { const bool ok = (dx < 0) ? vp : ((dx > 0) ? vn : true);
                if (ok) { float pv[8], wv[8]; unp8(*(const v4u*)(P + (size_t)(m + dx) * NP + cb), pv); ld8(O.cw + (3 + dx + 1) * 1024 + cq, wv);
#pragma unroll
                    for (int e = 0; e < 8; ++e) acc[e] += pv[e] * wv[e]; } }
            feat_gla_store(O, p, (size_t)m, lane, acc);
        }
    }
}

struct EpiLora {
    static constexpr bool PERM = true;
    unsigned char* ws; const float* const* in;
    __device__ __forceinline__ void grp_w(const f32x4 (&acc)[2][2][4][2], int row0, int c0) const {
        bf16* Wf = (bf16*)(ws + WS_LWF); bf16* Wb = (bf16*)(ws + WS_LWB);
#pragma unroll
        for (int bj = 0; bj < 2; ++bj) { const int ch = (c0 + bj * 128) >> 1; const f32x4 w0f = *(const f32x4*)(in[8] + ch), w0b = *(const f32x4*)(in[8] + 512 + ch);
#pragma unroll
            for (int ai = 0; ai < 2; ++ai)
#pragma unroll
                for (int m = 0; m < 4; ++m) { const size_t row = (size_t)(row0 + ai * 128 + m * 16);
                    const f32x4 xf = acc[ai][bj][m][0] + w0f, xb = acc[ai][bj][m][1] + w0b; f32x4 df, db;
#pragma unroll
                    for (int e = 0; e < 4; ++e) { df[e] = -0.60653066f * sigmoidf_(xf[e]); db[e] = -0.60653066f * sigmoidf_(xb[e]); }
                    { v2u o; o.x = pk2(df[0], df[1]); o.y = pk2(df[2], df[3]); *(v2u*)(Wf + row * RWW + ch) = o; o.x = pk2(db[0], db[1]); o.y = pk2(db[2], db[3]); *(v2u*)(Wb + row * RWW + ch) = o; } } }
    }
    __device__ __forceinline__ void grp_a(const f32x4 (&acc)[2][2][4][2], int row0, int c0) const {
        bf16* KMf = (bf16*)(ws + WS_KMF); bf16* KMb = (bf16*)(ws + WS_KMB); bf16* BVf = (bf16*)(ws + WS_BVF); bf16* BVb = (bf16*)(ws + WS_BVB);
        const bf16* KK = (const bf16*)(ws + WS_KKB); bf16* KSUM = (bf16*)(ws + WS_KSUM);
#pragma unroll
        for (int bj = 0; bj < 2; ++bj) { const int ch = (c0 + bj * 128 - 1024) >> 1; const f32x4 a0f = *(const f32x4*)(in[10] + ch), a0b = *(const f32x4*)(in[10] + 512 + ch), ka = *(const f32x4*)(in[14] + ch);
#pragma unroll
            for (int ai = 0; ai < 2; ++ai) {
            v2u kpw[2][4], kkw[2][4];
#pragma unroll
                for (int m = 0; m < 4; ++m) { const size_t row = (size_t)(row0 + ai * 128 + m * 16); kpw[ai][m] = *(const v2u*)(KMf + row * RWW + ch); kkw[ai][m] = *(const v2u*)(KK + row * RWW + ch); }
            __builtin_amdgcn_sched_barrier(0);
#pragma unroll
                for (int m = 0; m < 4; ++m) { const size_t row = (size_t)(row0 + ai * 128 + m * 16);
                    const f32x4 xf = acc[ai][bj][m][0] + a0f, xb = acc[ai][bj][m][1] + a0b;
                    const f32x4 kp = (f32x4){bflo(kpw[ai][m].x), bfhi(kpw[ai][m].x), bflo(kpw[ai][m].y), bfhi(kpw[ai][m].y)}, kk = (f32x4){bflo(kkw[ai][m].x), bfhi(kkw[ai][m].x), bflo(kkw[ai][m].y), bfhi(kkw[ai][m].y)};
                    f32x4 kmf, kmb, bvf, bvb;
#pragma unroll
                    for (int e = 0; e < 4; ++e) { const float af = sigmoidf_(xf[e]), ab = sigmoidf_(xb[e]);
                        kmf[e] = kp[e] * (1.0f + (af - 1.0f) * ka[e]); kmb[e] = kp[e] * (1.0f + (ab - 1.0f) * ka[e]); bvf[e] = kk[e] * af; bvb[e] = kk[e] * ab; }
                    { v2u o; o.x = pk2(kmf[0], kmf[1]); o.y = pk2(kmf[2], kmf[3]); *(v2u*)(KMf + row * RWW + ch) = o; o.x = pk2(kmb[0], kmb[1]); o.y = pk2(kmb[2], kmb[3]); *(v2u*)(KMb + row * RWW + ch) = o;
                      o.x = pk2(bvf[0], bvf[1]); o.y = pk2(bvf[2], bvf[3]); *(v2u*)(BVf + row * RWW + ch) = o; o.x = pk2(bvb[0], bvb[1]); o.y = pk2(bvb[2], bvb[3]); *(v2u*)(BVb + row * RWW + ch) = o; }
                    v2u ks; ks.x = pk2(kmf[0] + kmb[0], kmf[1] + kmb[1]); ks.y = pk2(kmf[2] + kmb[2], kmf[3] + kmb[3]); *(v2u*)(KSUM + row * RWW + ch) = ks; } } }
    }
    __device__ __forceinline__ void grp_g(const f32x4 (&acc)[2][2][4][2], int row0, int c0) const {
        bf16* RWG = (bf16*)(ws + WS_RWG);
#pragma unroll
        for (int bj = 0; bj < 2; ++bj) { const int ch = c0 + bj * 128 - 2048;
#pragma unroll
            for (int ai = 0; ai < 2; ++ai)
#pragma unroll
                for (int m = 0; m < 4; ++m) { const size_t row = (size_t)(row0 + ai * 128 + m * 16); const f32x4 v0 = acc[ai][bj][m][0], v1 = acc[ai][bj][m][1];
                    v4u w; w.x = pk2(v0[0], v0[1]); w.y = pk2(v0[2], v0[3]); w.z = pk2(v1[0], v1[1]); w.w = pk2(v1[2], v1[3]); *(v4u*)(RWG + row * RWW + ch) = w; } }
    }
    __device__ __forceinline__ void grp_l(const f32x4 (&acc)[2][2][4][2], int row0, int c0) const {
        bf16* GAf = (bf16*)(ws + WS_LAF); bf16* GAb = (bf16*)(ws + WS_LAB);
#pragma unroll
        for (int bj = 0; bj < 2; ++bj) { const int ch = (c0 + bj * 128 - 2560) >> 1; const f32x4 gbf = *(const f32x4*)(in[20] + ch), gbb = *(const f32x4*)(in[20] + 256 + ch);
#pragma unroll
            for (int ai = 0; ai < 2; ++ai)
#pragma unroll
                for (int m = 0; m < 4; ++m) { const size_t row = (size_t)(row0 + ai * 128 + m * 16);
                    const f32x4 xf = acc[ai][bj][m][0] + gbf, xb = acc[ai][bj][m][1] + gbb; f32x4 af, ab;
#pragma unroll
                    for (int e = 0; e < 4; ++e) { const float lf = logsigmoidf_(xf[e]), lb = logsigmoidf_(xb[e]);
                        af[e] = lf * 0.0625f; ab[e] = lb * 0.0625f; }
                    { v2u o; o.x = pk2(af[0], af[1]); o.y = pk2(af[2], af[3]); *(v2u*)(GAf + row * 256 + ch) = o; o.x = pk2(ab[0], ab[1]); o.y = pk2(ab[2], ab[3]); *(v2u*)(GAb + row * 256 + ch) = o; } } }
    }
    __device__ __forceinline__ void operator()(const f32x4 (&acc)[2][2][4][2], const pg8::Unit& u, int wr, int wc, int fr, int fq) const {
        const int row0 = u.pm * 256 + wr * 64 + fr, c0 = u.pn * 256 + wc * 32 + 8 * fq;
        if (u.pn < 4) grp_w(acc, row0, c0); else if (u.pn < 8) grp_a(acc, row0, c0); else if (u.pn < 10) grp_g(acc, row0, c0); else grp_l(acc, row0, c0);
    }
};
__device__ __forceinline__ void ph_lora(Frame& F) {
    pg8::Gemm g{(const bf16*)(F.ws + WS_A2), (const bf16*)(F.ws + WS_WLORA), MR, NLORA, KLORA, nullptr};
    pg8::StaticOrder S; S.init(MR, NLORA, F.G, (int)blockIdx.x);
    EpiLora E{F.ws, F.in};
    pg8::gemm_phase<EpiLora, pg8::StaticOrder, true, true, false>(F.lds, g, S, E);
}

__device__ __forceinline__ void ph_merge(Frame& F) {
    unsigned char* ws = F.ws; const int lane = F.lane;
    const bf16* ORf = (const bf16*)(ws + WS_ORWF); const bf16* ORb = (const bf16*)(ws + WS_ORWB); const bf16* OGf = (const bf16*)(ws + WS_OGLF); const bf16* OGb = (const bf16*)(ws + WS_OGLB);
    const bf16* R = (const bf16*)(ws + WS_RB); const bf16* V = (const bf16*)(ws + WS_VB); const bf16* KSUM = (const bf16*)(ws + WS_KSUM); const bf16* RWG = (const bf16*)(ws + WS_RWG);
    const bf16* P = (const bf16*)(ws + WS_P);
    bf16* YRW = (bf16*)(ws + WS_YRW); bf16* YGLA = (bf16*)(ws + WS_YGLA);
    float rk[8], gw[8], gbv[8], ggw[8], ggb[8];
    ld8(F.in[15] + 8 * lane, rk); ld8(F.in[16] + 8 * lane, gw); ld8(F.in[17] + 8 * lane, gbv); ld8(F.in[21] + 8 * lane, ggw); ld8(F.in[22] + 8 * lane, ggb);
    for (int m0 = F.gw; m0 < NLAT; m0 += 2 * F.NGW) {
        const int m1 = (m0 + F.NGW < NLAT) ? m0 + F.NGW : m0;
        v4u wa[2], wb[2], wc[2], wd[2], wr[2], wv[2], wk[2], wg[2], wo[2];
#pragma unroll
        for (int r2 = 0; r2 < 2; ++r2) { const int m = r2 ? m1 : m0; const size_t ro = (size_t)m * RWW + 8 * lane;
            wa[r2] = *(const v4u*)(ORf + ro); wb[r2] = *(const v4u*)(ORb + ro); wc[r2] = *(const v4u*)(OGf + ro); wd[r2] = *(const v4u*)(OGb + ro);
            wr[r2] = *(const v4u*)(R + ro); wv[r2] = *(const v4u*)(V + ro); wk[r2] = *(const v4u*)(KSUM + ro); wg[r2] = *(const v4u*)(RWG + ro);
            wo[r2] = *(const v4u*)(P + (size_t)m * NP + C_OG + 8 * lane); }
#pragma unroll
        for (int r2 = 0; r2 < 2; ++r2) { const int m = r2 ? m1 : m0; const size_t ro = (size_t)m * RWW + 8 * lane;
        {
            float a[8], b[8], o[8]; unp8(wa[r2], a); unp8(wb[r2], b);
            float s = 0.f;
#pragma unroll
            for (int e = 0; e < 8; ++e) { o[e] = a[e] + b[e]; s += o[e]; }
            s += __shfl_xor(s, 1); s += __shfl_xor(s, 2); s += __shfl_xor(s, 4);
            const float mean = s * (1.f / 64.f); float q = 0.f;
#pragma unroll
            for (int e = 0; e < 8; ++e) { o[e] -= mean; q += o[e] * o[e]; }
            q += __shfl_xor(q, 1); q += __shfl_xor(q, 2); q += __shfl_xor(q, 4);
            const float rstd = __builtin_amdgcn_rsqf(q * (1.f / 64.f) + RW_GN_EPS);
            float r[8], v[8], ksm[8], g[8]; unp8(wr[r2], r); unp8(wv[r2], v); unp8(wk[r2], ksm); unp8(wg[r2], g);
            float bs = 0.f;
#pragma unroll
            for (int e = 0; e < 8; ++e) bs += r[e] * ksm[e] * rk[e];
            bs += __shfl_xor(bs, 1); bs += __shfl_xor(bs, 2); bs += __shfl_xor(bs, 4);
            float y[8];
#pragma unroll
            for (int e = 0; e < 8; ++e) y[e] = (o[e] * rstd * gw[e] + gbv[e] + bs * v[e]) * g[e];
            *(v4u*)(YRW + ro) = pk8(y);
        }
        {
            float a[8], b[8], o[8]; unp8(wc[r2], a); unp8(wd[r2], b);
            float s = 0.f;
#pragma unroll
            for (int e = 0; e < 8; ++e) { o[e] = a[e] + b[e]; s += o[e]; }
            s += __shfl_xor(s, 1); s += __shfl_xor(s, 2); s += __shfl_xor(s, 4); s += __shfl_xor(s, 8);
            const float mean = s * (1.f / 128.f); float q = 0.f;
#pragma unroll
            for (int e = 0; e < 8; ++e) { o[e] -= mean; q += o[e] * o[e]; }
            q += __shfl_xor(q, 1); q += __shfl_xor(q, 2); q += __shfl_xor(q, 4); q += __shfl_xor(q, 8);
            const float rstd = __builtin_amdgcn_rsqf(q * (1.f / 128.f) + LN_EPS);
            float og[8]; unp8(wo[r2], og);
            float y[8];
#pragma unroll
            for (int e = 0; e < 8; ++e) y[e] = (o[e] * rstd * ggw[e] + ggb[e]) * siluf_(og[e]);
            *(v4u*)(YGLA + ro) = pk8(y);
        }
        }
    }
}

template <int WHICH> struct EpiBranch {
    static constexpr bool PERM = true;
    bf16* Z; const bf16* P;
    __device__ __forceinline__ void operator()(const f32x4 (&acc)[2][2][4][2], const pg8::Unit& u, int wr, int wc, int fr, int fq) const {
        const int row0 = u.pm * 256 + wr * 64 + fr, col0 = u.pn * 256 + wc * 32 + 8 * fq;
#pragma unroll
        for (int ah = 0; ah < 4; ++ah) { const int ai = ah >> 1, mb = 2 * (ah & 1);
            v4u gw[2][2], zw[2][2];
#pragma unroll
            for (int m = 0; m < 2; ++m) { const size_t row = (size_t)(row0 + ai * 128 + (mb + m) * 16);
#pragma unroll
                for (int bj = 0; bj < 2; ++bj) { const int c = col0 + bj * 128;
                    gw[m][bj] = *(const v4u*)(P + row * NP + (WHICH ? C_GGLA : C_GRW) + c);
                    if (WHICH) zw[m][bj] = *(const v4u*)(Z + row * D + c); } }
            __builtin_amdgcn_sched_barrier(0);
#pragma unroll
            for (int m = 0; m < 2; ++m) { const size_t row = (size_t)(row0 + ai * 128 + (mb + m) * 16);
#pragma unroll
                for (int bj = 0; bj < 2; ++bj) { const int c = col0 + bj * 128;
                    float g[8]; unp8(gw[m][bj], g);
                    const f32x4 v0 = acc[ai][bj][mb + m][0], v1 = acc[ai][bj][mb + m][1];
                    float z[8];
#pragma unroll
                    for (int e = 0; e < 4; ++e) { z[e] = sigmoidf_(g[e]) * v0[e]; z[4 + e] = sigmoidf_(g[4 + e]) * v1[e]; }
                    if (WHICH) { float zo[8]; unp8(zw[m][bj], zo);
#pragma unroll
                        for (int e = 0; e < 8; ++e) z[e] += zo[e]; }
                    *(v4u*)(Z + row * D + c) = pk8(z); } }
        }
    }
};
__device__ __forceinline__ void ph_branch(Frame& F) {
    pg8::StaticOrder S; S.init(NLAT, D, F.G, (int)blockIdx.x);
    { pg8::Gemm g{(const bf16*)(F.ws + WS_YRW), (const bf16*)(F.ws + WS_WBRRW), NLAT, D, RWW, nullptr};
      EpiBranch<0> E{(bf16*)(F.ws + WS_Z), (const bf16*)(F.ws + WS_P)};
      pg8::gemm_phase<EpiBranch<0>, pg8::StaticOrder, true, true, false>(F.lds, g, S, E); }
    { pg8::Gemm g{(const bf16*)(F.ws + WS_YGLA), (const bf16*)(F.ws + WS_WBRGLA), NLAT, D, RWW, nullptr};
      EpiBranch<1> E{(bf16*)(F.ws + WS_Z), (const bf16*)(F.ws + WS_P)};
      pg8::gemm_phase<EpiBranch<1>, pg8::StaticOrder, true, true, false>(F.lds, g, S, E); }
}
struct EpiOut {
    static constexpr bool PERM = true;
    bf16* X1P; const float* x; const float* mod;
    __device__ __forceinline__ void operator()(const f32x4 (&acc)[2][2][4][2], const pg8::Unit& u, int wr, int wc, int fr, int fq) const {
        const int row0 = u.pm * 256 + wr * 64 + fr, col0 = u.pn * 256 + wc * 32 + 8 * fq; const float* g1 = mod + (u.pm / (SEQ / 256)) * 6144 + 2048;
        f32x4 gv[2][2];
#pragma unroll
        for (int bj = 0; bj < 2; ++bj)
#pragma unroll
            for (int n = 0; n < 2; ++n) gv[bj][n] = *(const f32x4*)(g1 + col0 + bj * 128 + 4 * n);
#pragma unroll
        for (int ah = 0; ah < 4; ++ah) { const int ai = ah >> 1, mb = 2 * (ah & 1);
            f32x4 xv[2][2][2];
#pragma unroll
            for (int m = 0; m < 2; ++m) { const size_t ro = (size_t)(row0 + ai * 128 + (mb + m) * 16) * D;
#pragma unroll
                for (int bj = 0; bj < 2; ++bj)
#pragma unroll
                    for (int n = 0; n < 2; ++n) xv[m][bj][n] = *(const f32x4*)(x + ro + col0 + bj * 128 + 4 * n); }
            __builtin_amdgcn_sched_barrier(0);
#pragma unroll
            for (int m = 0; m < 2; ++m) { const size_t ro = (size_t)(row0 + ai * 128 + (mb + m) * 16) * D;
#pragma unroll
                for (int bj = 0; bj < 2; ++bj) { const f32x4 a = xv[m][bj][0] * ALPHA + gv[bj][0] * acc[ai][bj][mb + m][0], b = xv[m][bj][1] * ALPHA + gv[bj][1] * acc[ai][bj][mb + m][1];
                    v4u w; w.x = pk2(a.x, a.y); w.y = pk2(a.z, a.w); w.z = pk2(b.x, b.y); w.w = pk2(b.z, b.w); *(v4u*)(X1P + ro + col0 + bj * 128) = w; } }
        }
    }
};
__device__ __forceinline__ void ph_outproj(Frame& F) {
    pg8::Gemm g{(const bf16*)(F.ws + WS_Z), (const bf16*)(F.ws + WS_WOUT), NLAT, D, D, nullptr};
    pg8::StaticOrder S; S.init(NLAT, D, F.G, (int)blockIdx.x);
    EpiOut E{(bf16*)(F.ws + WS_X1), F.in[0], (const float*)(F.ws + WS_MOD)};
    pg8::gemm_phase<EpiOut, pg8::StaticOrder, true, true, false>(F.lds, g, S, E);
}
#endif

#if MS >= 3
constexpr int LP = 72, SLOTB = 64 * LP * 2, LPF = 68, AUX_OFF = 13 * SLOTB;
static_assert(AUX_OFF + 4096 <= MISC_OFF, "scan LDS map");
#define SLOT(n) ((LAS bf16*)(lds + (n) * SLOTB))
__device__ __forceinline__ int scan_row(int s, int b, int dir) {
    if (s < CTXL) return NLAT + b * CTXL + (dir ? (CTXL - 1 - s) : s);
    const int lt = s - CTXL; return b * SEQ + (dir ? (SEQ - 1 - lt) : lt);
}
__device__ __forceinline__ unsigned pk2z(float x) { return pk2(x, 0.f); }
__device__ __forceinline__ float bf2f(bf16 h) { return __builtin_bit_cast(float, (unsigned)h << 16); }
__device__ __forceinline__ v2u pack4(const f32x4 v) { v2u o; o.x = pk2(v[0], v[1]); o.y = pk2(v[2], v[3]); return o; }
__device__ __forceinline__ float clamp8(float x) { return __builtin_amdgcn_fmed3f(x, -448.0f, 448.0f); }
__device__ __forceinline__ unsigned pack4_fp8(const f32x4 v) { int w = __builtin_amdgcn_cvt_pk_fp8_f32(clamp8(v[0]), clamp8(v[1]), 0, false); return (unsigned)__builtin_amdgcn_cvt_pk_fp8_f32(clamp8(v[2]), clamp8(v[3]), w, true); }
__device__ __forceinline__ f32x4 unpack4_fp8(unsigned w) { const f32x2 lo = __builtin_amdgcn_cvt_pk_f32_fp8((int)w, false), hi = __builtin_amdgcn_cvt_pk_f32_fp8((int)w, true); return (f32x4){lo.x, lo.y, hi.x, hi.y}; }
__device__ __forceinline__ f32x4 unpack4(const v2u w) { return (f32x4){bflo(w.x), bfhi(w.x), bflo(w.y), bfhi(w.y)}; }
__device__ __forceinline__ f32x4 mm_tile(const LAS bf16* X, int r0, const LAS bf16* Y, int c0, int lane) {
    const int rr = lane & 15, q = lane >> 4;
    const LAS bf16* xp = X + (r0 + rr) * LP + 8 * q; const LAS bf16* yp = Y + (c0 + rr) * LP + 8 * q;
    const bf16x8 a0 = *(const LAS bf16x8*)xp, a1 = *(const LAS bf16x8*)(xp + 32), b0 = *(const LAS bf16x8*)yp, b1 = *(const LAS bf16x8*)(yp + 32);
    f32x4 acc = (f32x4){0.f, 0.f, 0.f, 0.f};
    acc = __builtin_amdgcn_mfma_f32_16x16x32_bf16(a0, b0, acc, 0, 0, 0);
    acc = __builtin_amdgcn_mfma_f32_16x16x32_bf16(a1, b1, acc, 0, 0, 0);
    return acc;
}
__device__ __forceinline__ float red8(float x) {
    x += __builtin_bit_cast(float, __builtin_amdgcn_update_dpp(0, __builtin_bit_cast(int, x), 0x141, 0xf, 0xf, false));
    x += __builtin_bit_cast(float, __builtin_amdgcn_update_dpp(0, __builtin_bit_cast(int, x), 0xB1, 0xf, 0xf, false));
    x += __builtin_bit_cast(float, __builtin_amdgcn_update_dpp(0, __builtin_bit_cast(int, x), 0x4E, 0xf, 0xf, false));
    return x;
}

#define S1_BAR() do { asm volatile("s_waitcnt lgkmcnt(0)" ::: "memory"); __builtin_amdgcn_s_barrier(); asm volatile("" ::: "memory"); } while (0)
struct RwIn { bf16 lw[8], r[8], k[8], a[8], b[8], v[8]; };
__device__ __forceinline__ void s1_rwkv_load(Frame& F, int u, RwIn& I) {
    const int sr = u / NCHUNK, c = u - sr * NCHUNK, rb = sr >> 4, rdir = (sr >> 3) & 1, rh = sr & 7; unsigned char* ws = F.ws;
    const bf16* RBp = (const bf16*)(ws + WS_RB); const bf16* VBp = (const bf16*)(ws + WS_VB); const bf16* KKp = (const bf16*)(ws + WS_KKB);
    const bf16* KMp = (const bf16*)(ws + (rdir ? WS_KMB : WS_KMF)); const bf16* BVp = (const bf16*)(ws + (rdir ? WS_BVB : WS_BVF)); const bf16* LWp = (const bf16*)(ws + (rdir ? WS_LWB : WS_LWF));
#pragma unroll
    for (int i = 0; i < 8; ++i) { const int row = scan_row(c * CH + 8 * F.wave + i, rb, rdir); const size_t base = (size_t)row * RWW + rh * 64 + F.lane;
        I.lw[i] = LWp[base]; I.r[i] = RBp[base]; I.k[i] = KMp[base]; I.a[i] = KKp[base]; I.b[i] = BVp[base]; I.v[i] = VBp[base]; }
}
__device__ __forceinline__ void s1_rwkv(Frame& F, int u, const RwIn& I, int un, RwIn& Inext, f32x2v (&cv)[32], int& cpend, int cvi) {
    const int sr = u / NCHUNK, c = u - sr * NCHUNK;
    const bool emit = c >= CTXL / CH;
    LAS unsigned char* lds = F.lds; unsigned char* ws = F.ws;
    int lane_ = F.lane; asm volatile("" : "+v"(lane_));
    const int lane = lane_, wave = F.wave, rr = lane & 15, q = lane >> 4;
    LAS float* tot = (LAS float*)(lds + AUX_OFF); LAS float* gCs = tot + 512;
    {
        float lw[8], xr[8], xk[8], xa[8], xb[8], xv[8];
#pragma unroll
        for (int i = 0; i < 8; ++i) { lw[i] = bf2f(I.lw[i]); xr[i] = bf2f(I.r[i]); xk[i] = bf2f(I.k[i]); xa[i] = -bf2f(I.a[i]); xb[i] = bf2f(I.b[i]); xv[i] = bf2f(I.v[i]); }
        float p[8]; p[0] = lw[0];
#pragma unroll
        for (int i = 1; i < 8; ++i) p[i] = p[i - 1] + lw[i];
        tot[wave * 64 + lane] = p[7];
        S1_BAR();
        float off = 0.f, all = 0.f;
#pragma unroll
        for (int w = 0; w < 8; ++w) { const float t = tot[w * 64 + lane]; all += t; off += (w < wave) ? t : 0.f; }
        if (wave == 0) gCs[lane] = __expf(all);
        float at[8], bb[8], kb[8];
#pragma unroll
        for (int i = 0; i < 8; ++i) { const float cum = off + p[i]; const float g = __expf(cum), gi = __expf(-cum), gp = __expf(cum - lw[i]), gc = __expf(all - cum);
            const int t = 8 * wave + i;
            at[i] = xa[i] * gp; bb[i] = xb[i] * gc; kb[i] = xk[i] * gc;
            SLOT(0)[t * LP + lane] = (bf16)pk2z(at[i]);
            SLOT(1)[t * LP + lane] = (bf16)pk2z(xr[i] * g);
            SLOT(2)[t * LP + lane] = (bf16)pk2z(xb[i] * gi);
            SLOT(3)[t * LP + lane] = (bf16)pk2z(xk[i] * gi); }
        *(LAS v4u*)(SLOT(4) + lane * LP + 8 * wave) = pk8(at);
        *(LAS v4u*)(SLOT(5) + lane * LP + 8 * wave) = pk8(xv);
        *(LAS v4u*)(SLOT(6) + lane * LP + 8 * wave) = pk8(bb);
        *(LAS v4u*)(SLOT(7) + lane * LP + 8 * wave) = pk8(kb);
        S1_BAR();
    }
    if (wave < 4) s1_rwkv_load(F, un, Inext);
    LAS float* Lp = (LAS float*)(lds + 8 * SLOTB);
#pragma unroll
    for (int tix = 0; tix < 2; ++tix) { const int ti = 2 * wave + tix, r0 = 16 * (ti >> 2), c0 = 16 * (ti & 3), ci = c0 + rr;
        { const f32x4 acc = mm_tile(SLOT(2), r0, SLOT(0), c0, lane);
#pragma unroll
            for (int e = 0; e < 4; ++e) { const int i = r0 + 4 * q + e; Lp[ci * LPF + (i & 3) * 16 + (i >> 2)] = (i < ci) ? acc[e] : 0.f; } }
        { f32x4 acc = mm_tile(SLOT(0), r0, SLOT(3), c0, lane);
#pragma unroll
            for (int e = 0; e < 4; ++e) acc[e] = (ci < r0 + 4 * q + e) ? acc[e] : 0.f;
            *(LAS v2u*)(SLOT(10) + ci * LP + r0 + 4 * q) = pack4(acc); }
        if (emit) {
            { f32x4 acc = mm_tile(SLOT(2), r0, SLOT(1), c0, lane);
#pragma unroll
                for (int e = 0; e < 4; ++e) acc[e] = (r0 + 4 * q + e <= ci) ? acc[e] : 0.f;
                *(LAS v2u*)(SLOT(11) + ci * LP + r0 + 4 * q) = pack4(acc); }
            { f32x4 acc = mm_tile(SLOT(3), r0, SLOT(1), c0, lane);
#pragma unroll
                for (int e = 0; e < 4; ++e) acc[e] = (r0 + 4 * q + e <= ci) ? acc[e] : 0.f;
                *(LAS v2u*)(SLOT(12) + ci * LP + r0 + 4 * q) = pack4(acc); }
        }
    }
    S1_BAR();
    if (wave < 4) {
        const int j = 16 * wave + (lane >> 2), s = lane & 3;
        float Tr[16];
#pragma unroll
        for (int m = 0; m < 16; ++m) Tr[m] = 0.f;
        const LAS float* lrow = Lp + s * 16;
        f32x4 lb[3][4];
#pragma unroll
        for (int t = 0; t < 2; ++t) lb[t][0] = *(const LAS f32x4*)(lrow + t * LPF);
#pragma unroll
        for (int t = 0; t < 64; ++t) {
            if (t + 2 < 64) {
#pragma unroll
                for (int k = 0; k < 4; ++k) if (4 * k <= (t + 2) / 4) lb[(t + 2) % 3][k] = *(const LAS f32x4*)(lrow + (t + 2) * LPF + 4 * k);
            }
            __builtin_amdgcn_sched_barrier(0);
            float acc0 = 0.f, acc1 = 0.f;
#pragma unroll
            for (int m = 0; m < 16; ++m) if (m <= t / 4) { const float lv = lb[t % 3][m >> 2][m & 3]; if (m & 1) acc1 += lv * Tr[m]; else acc0 += lv * Tr[m]; }
            float acc = acc0 + acc1;
            acc += __builtin_bit_cast(float, __builtin_amdgcn_update_dpp(0, __builtin_bit_cast(int, acc), 0xB1, 0xf, 0xf, false));
            acc += __builtin_bit_cast(float, __builtin_amdgcn_update_dpp(0, __builtin_bit_cast(int, acc), 0x4E, 0xf, 0xf, false));
            int jj = j, ss = s; asm volatile("" : "+v"(jj), "+v"(ss));
            const float val = acc + ((t == jj) ? 1.f : 0.f);
            Tr[t >> 2] = (ss == (t & 3)) ? val : Tr[t >> 2];
            SLOT(0)[t * LP + j] = (bf16)pk2z(val);
        }
    } else { CVY_FLUSH(); s1_rwkv_load(F, un, Inext); CVY_START(cvi); }
    S1_BAR();
#pragma unroll
    for (int tix = 0; tix < 2; ++tix) { const int ti = 2 * wave + tix, r0 = 16 * (ti >> 2), c0 = 16 * (ti & 3), ci = c0 + rr;
        { const f32x4 acc = mm_tile(SLOT(0), r0, SLOT(4), c0, lane); *(LAS v2u*)(SLOT(2) + ci * LP + r0 + 4 * q) = pack4(acc); }
        { const f32x4 acc = mm_tile(SLOT(0), r0, SLOT(10), c0, lane); *(LAS v2u*)(SLOT(3) + ci * LP + r0 + 4 * q) = pack4(acc); }
    }
    S1_BAR();
    unsigned char* RH = ws + WS_RH + (size_t)u * 4096; bf16* GT = (bf16*)((unsigned char*)F.out + OUT_GT) + (size_t)u * 4096;
#pragma unroll
    for (int tix = 0; tix < 2; ++tix) { const int ti = 2 * wave + tix, tr = ti >> 2, r0 = 16 * tr, c0 = 16 * (ti & 3), ci = c0 + rr;
        const int pos = (tr >> 1) * 32 + q * 8 + 4 * (tr & 1);
        if (emit) {
            { f32x4 acc = mm_tile(SLOT(2), r0, SLOT(11), c0, lane);
                acc += unpack4(*(const LAS v2u*)(SLOT(1) + ci * LP + r0 + 4 * q));
                *(unsigned*)(RH + ci * 64 + pos) = pack4_fp8(acc); }
            { f32x4 acc = mm_tile(SLOT(3), r0, SLOT(11), c0, lane);
                acc += unpack4(*(const LAS v2u*)(SLOT(12) + ci * LP + r0 + 4 * q));
                *(LAS v2u*)(SLOT(4) + ci * LP + r0 + 4 * q) = pack4(acc); }
        }
        { f32x4 acc = mm_tile(SLOT(2), r0, SLOT(6), c0, lane);
            const float gc = gCs[ci];
#pragma unroll
            for (int e = 0; e < 4; ++e) acc[e] += (r0 + 4 * q + e == ci) ? gc : 0.f;
            *(v2u*)(GT + ci * 64 + pos) = pack4(acc); }
    }
    S1_BAR();
    unsigned char* YL = ws + WS_YL + (size_t)u * 4096;
#pragma unroll
    for (int tix = 0; tix < 2; ++tix) { const int ti = 2 * wave + tix, r0 = 16 * (ti >> 2), c0 = 16 * (ti & 3), ci = c0 + rr;
        if (emit) { const f32x4 acc = mm_tile(SLOT(5), r0, SLOT(4), c0, lane); *(unsigned*)(YL + ci * 64 + r0 + 4 * q) = pack4_fp8(acc); }
        { f32x4 acc = mm_tile(SLOT(3), r0, SLOT(6), c0, lane);
            acc += unpack4(*(const LAS v2u*)(SLOT(7) + ci * LP + r0 + 4 * q));
            *(LAS v2u*)(SLOT(8) + ci * LP + r0 + 4 * q) = pack4(acc); }
    }
    S1_BAR();
    bf16* HH = (bf16*)(ws + WS_HH) + (size_t)u * 4096;
#pragma unroll
    for (int tix = 0; tix < 2; ++tix) { const int ti = 2 * wave + tix, r0 = 16 * (ti >> 2), c0 = 16 * (ti & 3), ci = c0 + rr;
        const f32x4 acc = mm_tile(SLOT(8), r0, SLOT(5), c0, lane);
        *(v2u*)(HH + ci * 64 + r0 + 4 * q) = pack4(acc); }
    S1_BAR();
}

struct GlIn { bf16 la[8], q[8], k[8], v0[8], v1[8]; };
__device__ __forceinline__ void s1_gla_load(Frame& F, int u, GlIn& I) {
    const int sg = u / NCHUNK, c = u - sg * NCHUNK, gb = sg >> 3, gdir = (sg >> 2) & 1, gh = sg & 3; unsigned char* ws = F.ws;
    const bf16* Qp = (const bf16*)(ws + WS_QGB); const bf16* Kp = (const bf16*)(ws + WS_KGB); const bf16* Vp = (const bf16*)(ws + WS_VGB); const bf16* LAp = (const bf16*)(ws + (gdir ? WS_LAB : WS_LAF));
#pragma unroll
    for (int i = 0; i < 8; ++i) { const int row = scan_row(c * CH + 8 * F.wave + i, gb, gdir); const size_t b2 = (size_t)row * 256 + gh * 64 + F.lane, b5 = (size_t)row * RWW + gh * 128 + F.lane;
        I.la[i] = LAp[b2]; I.q[i] = Qp[b2]; I.k[i] = Kp[b2]; I.v0[i] = Vp[b5]; I.v1[i] = Vp[b5 + 64]; }
}
__device__ __forceinline__ void s1_gla(Frame& F, int u, const GlIn& I, int un, GlIn& Inext, f32x2v (&cv)[32], int& cpend, int cvi) {
    const int sg = u / NCHUNK, c = u - sg * NCHUNK;
    const bool emit = c >= CTXL / CH;
    LAS unsigned char* lds = F.lds; unsigned char* ws = F.ws;
    int lane_ = F.lane; asm volatile("" : "+v"(lane_));
    const int lane = lane_, wave = F.wave, rr = lane & 15, q = lane >> 4;
    LAS float* tot = (LAS float*)(lds + AUX_OFF);
    unsigned char* QE = (unsigned char*)F.out + OUT_QE + (size_t)u * 4096;
    {
        float la[8], xq[8], xk[8], v0[8], v1[8];
#pragma unroll
        for (int i = 0; i < 8; ++i) { la[i] = bf2f(I.la[i]); xq[i] = bf2f(I.q[i]); xk[i] = bf2f(I.k[i]); v0[i] = bf2f(I.v0[i]); v1[i] = bf2f(I.v1[i]); }
        float p[8]; p[0] = la[0];
#pragma unroll
        for (int i = 1; i < 8; ++i) p[i] = p[i - 1] + la[i];
        tot[wave * 64 + lane] = p[7];
        S1_BAR();
        float off = 0.f, all = 0.f;
#pragma unroll
        for (int w = 0; w < 8; ++w) { const float t = tot[w * 64 + lane]; all += t; off += (w < wave) ? t : 0.f; }
        if (wave == 0) ((float*)(ws + WS_DD))[(size_t)u * 64 + lane] = __expf(all);
        float kl[8];
#pragma unroll
        for (int i = 0; i < 8; ++i) { const float cum = off + p[i]; const int t = 8 * wave + i;
            const float qef = xq[i] * __expf(cum);
            SLOT(0)[t * LP + lane] = (bf16)pk2z(qef);
            if (emit) QE[t * 64 + lane] = (unsigned char)__builtin_amdgcn_cvt_pk_fp8_f32(clamp8(qef), 0.f, 0, false);
            SLOT(1)[t * LP + lane] = (bf16)pk2z(xk[i] * __expf(-cum));
            kl[i] = xk[i] * __expf(all - cum); }
        *(LAS v4u*)(SLOT(2) + lane * LP + 8 * wave) = pk8(kl);
        *(LAS v4u*)(SLOT(3) + lane * LP + 8 * wave) = pk8(v0);
        *(LAS v4u*)(SLOT(3) + (64 + lane) * LP + 8 * wave) = pk8(v1);
        S1_BAR();
    }
    if (wave >= 4) { CVY_FLUSH(); s1_gla_load(F, un, Inext); CVY_START(cvi); }
    else if (emit) {
#pragma unroll
        for (int tix = 0; tix < 4; ++tix) { const int ti = 4 * wave + tix, r0 = 16 * (ti >> 2), c0 = 16 * (ti & 3), ci = c0 + rr;
            f32x4 acc = mm_tile(SLOT(1), r0, SLOT(0), c0, lane);
#pragma unroll
            for (int e = 0; e < 4; ++e) acc[e] = (r0 + 4 * q + e <= ci) ? acc[e] : 0.f;
            *(LAS v2u*)(SLOT(5) + ci * LP + r0 + 4 * q) = pack4(acc); }
    }
    bf16* KV = (bf16*)(ws + WS_KV) + (size_t)u * 8192;
#pragma unroll
    for (int tix = 0; tix < 4; ++tix) { const int ti = 4 * wave + tix, r0 = 16 * (ti >> 3), c0 = 16 * (ti & 7), ci = c0 + rr;
        const f32x4 acc = mm_tile(SLOT(2), r0, SLOT(3), c0, lane);
        *(v2u*)(KV + ci * 64 + r0 + 4 * q) = pack4(acc); }
    S1_BAR();
    if (emit) {
        unsigned char* IN = ws + WS_INTRA + (size_t)u * 8192;
#pragma unroll
        for (int tix = 0; tix < 4; ++tix) { const int ti = 4 * wave + tix, r0 = 16 * (ti >> 2), c0 = 16 * (ti & 3), ci = c0 + rr;
            const f32x4 acc = mm_tile(SLOT(3), r0, SLOT(5), c0, lane);
            *(unsigned*)(IN + ci * 128 + r0 + 4 * q) = pack4_fp8(acc); }
    }
    S1_BAR();
}

__device__ __forceinline__ void ph_scan1(Frame& F) {
    f32x2v cv[32]; int cpend = -1; const int lane = F.lane;
    int item = (int)blockIdx.x * 4 + (F.wave & 3);
    { RwIn cur, nxt; if ((int)blockIdx.x < NU_RW) s1_rwkv_load(F, blockIdx.x, cur);
#pragma unroll 1
      for (int u = blockIdx.x; u < NU_RW; u += F.G, item += F.G * 4) { const int un = (u + F.G < NU_RW) ? u + F.G : u; s1_rwkv(F, u, cur, un, nxt, cv, cpend, item); cur = nxt; } }
    { GlIn cur, nxt; if ((int)blockIdx.x < NU_GL) s1_gla_load(F, blockIdx.x, cur);
#pragma unroll 1
      for (int u = blockIdx.x; u < NU_GL; u += F.G, item += F.G * 4) { const int un = (u + F.G < NU_GL) ? u + F.G : u; if (F.wave < 4) s1_gla_load(F, un, nxt); s1_gla(F, u, cur, un, nxt, cv, cpend, item); cur = nxt; } }
    if (F.wave >= 4) CVY_FLUSH();
}

__device__ __forceinline__ bf16x8 pack_frag(const f32x4 lo, const f32x4 hi) {
    v4u w; w.x = pk2(lo[0], lo[1]); w.y = pk2(lo[2], lo[3]); w.z = pk2(hi[0], hi[1]); w.w = pk2(hi[2], hi[3]); return __builtin_bit_cast(bf16x8, w);
}
constexpr int S2_D = 5, S2_R = 6, S2_RW = 8192 + 4096 + 2048 + 1024, S2_GL = 4096 + 2048 + 1024 + 1024, S2_SLOT = S2_RW + S2_GL;
static_assert(S2_R * S2_SLOT <= MISC_OFF, "S2 ring fits in LDS");
__device__ __forceinline__ void s2_piece(int k, int lane, size_t ur0, size_t ug0, int v0r, int v0g,
                                         const unsigned char* GTb, const unsigned char* RHb, const unsigned char* HHb, const unsigned char* YLb,
                                         const unsigned char* QEb, const unsigned char* KVb, const unsigned char* INb, const unsigned char* DDb,
                                         const unsigned char*& src, int& stride, int& ldo) {
    if (k < 8) { const int n = k, pu = n * 64 + lane, row = pu >> 3, c16 = (pu & 7) ^ (row & 7);
        src = GTb + ur0 * 8192 + row * 128 + c16 * 16; stride = 8192; ldo = n * 1024; }
    else if (k < 12) { const int n = k - 8, pu = n * 64 + lane, row = pu >> 2, c16 = (pu & 3) ^ (row & 3);
        src = RHb + ur0 * 4096 + row * 64 + c16 * 16; stride = 4096; ldo = 8192 + n * 1024; }
    else if (k < 14) { const int n = k - 12, pu = n * 64 + lane, v = pu >> 3, c16 = (pu & 7) ^ (v & 7);
        src = HHb + ur0 * 8192 + (size_t)(v0r + v) * 128 + c16 * 16; stride = 8192; ldo = 12288 + n * 1024; }
    else if (k < 15) { const int t = lane;
        src = YLb + ur0 * 4096 + t * 64 + v0r; stride = 4096; ldo = 14336; }
    else if (k < 19) { const int n = k - 15, pu = n * 64 + lane, row = pu >> 2, c16 = (pu & 3) ^ (row & 3);
        src = QEb + ug0 * 4096 + row * 64 + c16 * 16; stride = 4096; ldo = S2_RW + n * 1024; }
    else if (k < 21) { const int n = k - 19, pu = n * 64 + lane, v = pu >> 3, c16 = (pu & 7) ^ (v & 7);
        src = KVb + ug0 * 16384 + (size_t)(v0g + v) * 128 + c16 * 16; stride = 16384; ldo = S2_RW + 4096 + n * 1024; }
    else if (k < 22) { const int t = lane;
        src = INb + ug0 * 8192 + t * 128 + v0g; stride = 8192; ldo = S2_RW + 6144; }
    else { src = DDb + ug0 * 256 + (lane & 15) * 16; stride = 256; ldo = S2_RW + 7168; }
}
__device__ __forceinline__ void ph_scan2(Frame& F) {
    const int lane = F.lane, wave = F.wave, rr = lane & 15, q = lane >> 4; unsigned char* ws = F.ws; LAS unsigned char* lds = F.lds;
    const int it = (F.G == 256) ? (int)(blockIdx.x & 7) * 32 + (int)(blockIdx.x >> 3) : (int)blockIdx.x;
    const int sr = it >> 2, v0r = 16 * (it & 3), rb = sr >> 4, rdir = (sr >> 3) & 1, rh = sr & 7;
    const int sg = it >> 3, v0g = 16 * (it & 7), gb = sg >> 3, gdir = (sg >> 2) & 1, gh = sg & 3;
#define S2_BAR() do { asm volatile("s_waitcnt lgkmcnt(0)" ::: "memory"); __builtin_amdgcn_s_barrier(); asm volatile("" ::: "memory"); } while (0)
#define S2_NEXT_SLOT() do { slot = (slot + 1 == S2_R) ? 0 : slot + 1; } while (0)
    LAS unsigned char* sfr = lds + S2_SF_OFF + lane * 16;
    LAS unsigned char* sfg = sfr + 4096;
    if (wave >= 6) {
        const unsigned char* GTb = (const unsigned char*)F.out + OUT_GT; const unsigned char* QEb = (const unsigned char*)F.out + OUT_QE;
        const unsigned char* RHb = ws + WS_RH; const unsigned char* YLb = ws + WS_YL; const unsigned char* HHb = ws + WS_HH; const unsigned char* KVb = ws + WS_KV; const unsigned char* INb = ws + WS_INTRA;
        const unsigned char* DDb = ws + WS_DD;
        const unsigned char* pj[12]; int sj[12], lj[12];
#pragma unroll
        for (int j = 0; j < 12; ++j) { int k = (wave - 6) * 12 + j; if (k >= 23) k = 22;
            s2_piece(k, lane, (size_t)sr * NCHUNK, (size_t)sg * NCHUNK, v0r, v0g, GTb, RHb, HHb, YLb, QEb, KVb, INb, DDb, pj[j], sj[j], lj[j]);
            sj[j] = __builtin_amdgcn_readfirstlane(sj[j]); lj[j] = __builtin_amdgcn_readfirstlane(lj[j]); }
#define S2_ISSUE(cc, sl_) do { const int _c = (cc) < NCHUNK ? (cc) : NCHUNK - 1; _Pragma("unroll") for (int j = 0; j < 12; ++j) \
            __builtin_amdgcn_global_load_lds((const unsigned*)(pj[j] + (size_t)_c * sj[j]), (LAS unsigned*)(lds + (sl_) * S2_SLOT + lj[j]), 16, 0, 0); } while (0)
        S2_ISSUE(0, 0); S2_ISSUE(1, 1); S2_ISSUE(2, 2); S2_ISSUE(3, 3); S2_ISSUE(4, 4);
        int slot = S2_D % S2_R;
#pragma unroll 1
        for (int c = 0; c < NCHUNK; ++c) {
            asm volatile("s_waitcnt vmcnt(48) ; S2WAIT" ::: "memory");
            S2_BAR();
            S2_ISSUE(c + S2_D, slot);
            S2_NEXT_SLOT();
        }
#undef S2_ISSUE
    } else if (wave == 0) {
        f32x4 S[4];
#pragma unroll
        for (int m = 0; m < 4; ++m) S[m] = (f32x4){0.f, 0.f, 0.f, 0.f};
        bf16x8 Sf0 = pack_frag(S[0], S[1]), Sf1 = pack_frag(S[2], S[3]);
        *(LAS bf16x8*)(sfr) = Sf0; *(LAS bf16x8*)(sfr + 1024) = Sf1;
        int slot = 0;
#pragma unroll 1
        for (int c = 0; c < NCHUNK; ++c) {
            S2_BAR();
            const LAS unsigned char* sl = lds + slot * S2_SLOT;
            bf16x8 G0[4], G1[4]; v2u Hw[4];
#pragma unroll
            for (int m = 0; m < 4; ++m) { const int k2 = 16 * m + rr;
                G0[m] = *(const LAS bf16x8*)(sl + (k2 * 8 + (q ^ (k2 & 7))) * 16); G1[m] = *(const LAS bf16x8*)(sl + (k2 * 8 + ((4 + q) ^ (k2 & 7))) * 16);
                Hw[m] = *(const LAS v2u*)(sl + 12288 + (rr * 8 + ((2 * m + (q >> 1)) ^ (rr & 7))) * 16 + (q & 1) * 8); }
#pragma unroll
            for (int m = 0; m < 4; ++m) { f32x4 acc = unpack4(Hw[m]);
                acc = __builtin_amdgcn_mfma_f32_16x16x32_bf16(G0[m], Sf0, acc, 0, 0, 0);
                acc = __builtin_amdgcn_mfma_f32_16x16x32_bf16(G1[m], Sf1, acc, 0, 0, 0);
                S[m] = acc; }
            Sf0 = pack_frag(S[0], S[1]); Sf1 = pack_frag(S[2], S[3]);
            LAS unsigned char* o = sfr + ((c + 1) & 1) * 2048;
            *(LAS bf16x8*)(o) = Sf0; *(LAS bf16x8*)(o + 1024) = Sf1;
            S2_NEXT_SLOT();
        }
    } else if (wave == 1) {
        f32x4 S[4];
#pragma unroll
        for (int m = 0; m < 4; ++m) S[m] = (f32x4){0.f, 0.f, 0.f, 0.f};
        { const bf16x8 Sf0 = pack_frag(S[0], S[1]); *(LAS bf16x8*)(sfg) = Sf0; *(LAS bf16x8*)(sfg + 1024) = Sf0; }
        int slot = 0;
#pragma unroll 1
        for (int c = 0; c < NCHUNK; ++c) {
            S2_BAR();
            const LAS unsigned char* sl = lds + slot * S2_SLOT + S2_RW;
            v4u kw[2]; f32x4 d0[2], d1[2];
#pragma unroll
            for (int s2 = 0; s2 < 2; ++s2) { kw[s2] = *(const LAS v4u*)(sl + 4096 + (rr * 8 + ((4 * s2 + q) ^ (rr & 7))) * 16);
                d0[s2] = *(const LAS f32x4*)(sl + 7168 + 128 * s2 + 32 * q); d1[s2] = *(const LAS f32x4*)(sl + 7168 + 128 * s2 + 32 * q + 16); }
#pragma unroll
            for (int s2 = 0; s2 < 2; ++s2) { S[2 * s2] = S[2 * s2] * d0[s2] + unpack4((v2u){kw[s2].x, kw[s2].y}); S[2 * s2 + 1] = S[2 * s2 + 1] * d1[s2] + unpack4((v2u){kw[s2].z, kw[s2].w}); }
            LAS unsigned char* o = sfg + ((c + 1) & 1) * 2048;
            *(LAS bf16x8*)(o) = pack_frag(S[0], S[1]); *(LAS bf16x8*)(o + 1024) = pack_frag(S[2], S[3]);
            S2_NEXT_SLOT();
        }
    } else if (wave < 4) {
        bf16* ORW = (bf16*)(ws + (rdir ? WS_ORWB : WS_ORWF));
        const int tt0 = 2 * (wave - 2);
        int slot = 0;
#pragma unroll 1
        for (int c = 0; c < NCHUNK; ++c) {
            S2_BAR();
            if (c >= CTXL / CH) {
                const LAS unsigned char* sl = lds + slot * S2_SLOT; const LAS unsigned char* sf = sfr + (c & 1) * 2048;
                const bf16x8 Sf0 = *(const LAS bf16x8*)(sf), Sf1 = *(const LAS bf16x8*)(sf + 1024);
                v2u Rw0[2], Rw1[2]; unsigned Yw[2];
#pragma unroll
                for (int i = 0; i < 2; ++i) { const int t = 16 * (tt0 + i) + rr;
                    Rw0[i] = *(const LAS v2u*)(sl + 8192 + (t * 4 + ((q >> 1) ^ (t & 3))) * 16 + (q & 1) * 8); Rw1[i] = *(const LAS v2u*)(sl + 8192 + (t * 4 + ((2 + (q >> 1)) ^ (t & 3))) * 16 + (q & 1) * 8);
                    Yw[i] = *(const LAS unsigned*)(sl + 14336 + t * 16 + q * 4); }
#pragma unroll
                for (int i = 0; i < 2; ++i) { const int t = 16 * (tt0 + i) + rr;
                    const bf16x8 R0 = pack_frag(unpack4_fp8(Rw0[i].x), unpack4_fp8(Rw0[i].y)), R1 = pack_frag(unpack4_fp8(Rw1[i].x), unpack4_fp8(Rw1[i].y));
                    f32x4 acc = unpack4_fp8(Yw[i]);
                    acc = __builtin_amdgcn_mfma_f32_16x16x32_bf16(Sf0, R0, acc, 0, 0, 0);
                    acc = __builtin_amdgcn_mfma_f32_16x16x32_bf16(Sf1, R1, acc, 0, 0, 0);
                    const int row = scan_row(c * CH + t, rb, rdir);
                    *(v2u*)(ORW + (size_t)row * RWW + rh * 64 + v0r + 4 * q) = pack4(acc); }
            }
            S2_NEXT_SLOT();
        }
    } else {
        bf16* OGL = (bf16*)(ws + (gdir ? WS_OGLB : WS_OGLF));
        const int tt0 = 2 * (wave - 4);
        int slot = 0;
#pragma unroll 1
        for (int c = 0; c < NCHUNK; ++c) {
            S2_BAR();
            if (c >= CTXL / CH) {
                const LAS unsigned char* sl = lds + slot * S2_SLOT + S2_RW; const LAS unsigned char* sf = sfg + (c & 1) * 2048;
                const bf16x8 Sf0 = *(const LAS bf16x8*)(sf), Sf1 = *(const LAS bf16x8*)(sf + 1024);
                v2u Qw0[2], Qw1[2]; unsigned Iw[2];
#pragma unroll
                for (int i = 0; i < 2; ++i) { const int t = 16 * (tt0 + i) + rr;
                    Qw0[i] = *(const LAS v2u*)(sl + (t * 4 + ((q >> 1) ^ (t & 3))) * 16 + (q & 1) * 8); Qw1[i] = *(const LAS v2u*)(sl + (t * 4 + ((2 + (q >> 1)) ^ (t & 3))) * 16 + (q & 1) * 8);
                    Iw[i] = *(const LAS unsigned*)(sl + 6144 + t * 16 + q * 4); }
#pragma unroll
                for (int i = 0; i < 2; ++i) { const int t = 16 * (tt0 + i) + rr;
                    const bf16x8 Q0 = pack_frag(unpack4_fp8(Qw0[i].x), unpack4_fp8(Qw0[i].y)), Q1 = pack_frag(unpack4_fp8(Qw1[i].x), unpack4_fp8(Qw1[i].y));
                    f32x4 acc = unpack4_fp8(Iw[i]);
                    acc = __builtin_amdgcn_mfma_f32_16x16x32_bf16(Sf0, Q0, acc, 0, 0, 0);
                    acc = __builtin_amdgcn_mfma_f32_16x16x32_bf16(Sf1, Q1, acc, 0, 0, 0);
                    const int row = scan_row(c * CH + t, gb, gdir);
                    *(v2u*)(OGL + (size_t)row * RWW + gh * 128 + v0g + 4 * q) = pack4(acc); }
            }
            S2_NEXT_SLOT();
        }
    }
#undef S2_BAR
#undef S2_NEXT_SLOT
}
#endif

#ifndef ML
#define ML 0
#endif
enum Phase { PH_PROLOGUE = 0, PH_A1, PH_INPROJ, PH_FEAT, PH_LORA, PH_SCAN1, PH_SCAN2, PH_MERGE, PH_BRANCH, PH_OUTPROJ, PH_LN1, PH_ROUTER, PH_ROUTE, PH_SCATTER, PH_EXP1, PH_EXP2, PH_FINAL, PH_COUNT };

__global__ void __launch_bounds__(NTHR, 2) mega(Args args) {
    extern __shared__ __attribute__((aligned(16))) unsigned char lds_raw[];
    Frame F;
    F.lds = (LAS unsigned char*)lds_raw;
    F.tid = threadIdx.x; F.lane = F.tid & 63; F.wave = __builtin_amdgcn_readfirstlane(F.tid >> 6);
    F.G = gridDim.x; F.gw = blockIdx.x * NWAVES + F.wave; F.NGW = F.G * NWAVES;
    F.in = args.in; F.out = args.out; F.ws = args.ws; F.ctl = (unsigned*)(args.ws + WS_CTL);
    volatile LAS unsigned* MISC = (volatile LAS unsigned*)(F.lds + MISC_OFF);
    if (F.tid < 64) MISC[F.tid] = 0u;
    __syncthreads();
    XcdBarrier bar; bar.bar = F.ctl + CW_BAR; bar.x = 0; bar.st = nullptr;
#if !ML
    bar = xcd_barrier_post(F.ctl + CW_BAR, MISC + 8);
#endif
    const int lo = args.ph_lo, hi = args.ph_hi;
#define IN(k) (lo <= (k) && (k) < hi)
#ifndef DUP
#define DUP -1
#endif
#define RUN(k, call) do { if (IN(k)) { call; GRID_BAR(); if (DUP == (k)) { call; GRID_BAR(); } } } while (0)
#if ML
#define GRID_BAR() do { } while (0)
#else
#define GRID_BAR() xcd_barrier(bar)
#endif

#if MS >= 2
    RUN(PH_PROLOGUE, ph_prologue(F));
#endif
#if MS >= 3
    RUN(PH_A1, ph_a1(F));
    RUN(PH_INPROJ, ph_inproj(F));
    RUN(PH_FEAT, ph_feat(F));
    RUN(PH_LORA, ph_lora(F));
    RUN(PH_SCAN1, ph_scan1(F));
    RUN(PH_SCAN2, ph_scan2(F));
    RUN(PH_MERGE, ph_merge(F));
    RUN(PH_BRANCH, ph_branch(F));
    RUN(PH_OUTPROJ, ph_outproj(F));
#else
    RUN(PH_OUTPROJ, ph_x1pre_nomix(F));
#endif
    RUN(PH_LN1, ph_ln1(F));
#if MS >= 2
    RUN(PH_ROUTER, ph_router(F));
    RUN(PH_ROUTE, ph_route(F));
    RUN(PH_SCATTER, ph_scatter(F));
    RUN(PH_EXP1, ph_exp1(F));
    RUN(PH_EXP2, ph_exp2(F));
#endif
    if (IN(PH_FINAL)) { ph_final(F); }
#undef IN
}

extern "C" void kernel_launch(void* const* d_in, const int* in_sizes, int n_in, void* d_out, int out_size, void* d_ws, size_t ws_size, hipStream_t stream) {
    static int grid = 0;
    if (grid == 0) {
        if (n_in != 36 || out_size != NLAT * D || ws_size < WS_END) { fprintf(stderr, "kernel_launch: unexpected problem shape (n_in %d, out %d)\n", n_in, out_size); grid = -1; return; }
        int dev = 0, cus = 0, per_cu = 0;
        if (hipGetDevice(&dev) != hipSuccess || hipDeviceGetAttribute(&cus, hipDeviceAttributeMultiprocessorCount, dev) != hipSuccess) { grid = -1; return; }
        if (hipFuncSetAttribute((const void*)mega, hipFuncAttributeMaxDynamicSharedMemorySize, LDS_BYTES) != hipSuccess) { fprintf(stderr, "kernel_launch: hipFuncSetAttribute failed\n"); grid = -1; return; }
        if (hipOccupancyMaxActiveBlocksPerMultiprocessor(&per_cu, (const void*)mega, NTHR, LDS_BYTES) != hipSuccess || per_cu < 1) { fprintf(stderr, "kernel_launch: occupancy query says %d\n", per_cu); }
        (void)hipGetLastError();
        grid = cus > 0 ? cus : 256;
        if (grid > 256) grid = 256;
    }
    if (grid < 0) return;
    (void)hipMemsetAsync((char*)d_ws + WS_CTL, 0, CTL_ZERO_BYTES, stream);
    Args a{};
    for (int i = 0; i < 36; ++i) a.in[i] = (const float*)d_in[i];
    a.out = (float*)d_out; a.ws = (unsigned char*)d_ws;
#if ML
    for (int p = 0; p < PH_COUNT; ++p) { a.ph_lo = p; a.ph_hi = p + 1; hipLaunchKernelGGL(mega, dim3(grid), dim3(NTHR), LDS_BYTES, stream, a); }
#else
    a.ph_lo = 0; a.ph_hi = PH_COUNT;
    hipLaunchKernelGGL(mega, dim3(grid), dim3(NTHR), LDS_BYTES, stream, a);
#endif
}
```

```cpp
#include <hip/hip_runtime.h>
#include <cstdio>
#include <cstdint>

#ifndef MS
#define MS 3
#endif

#define GAS __attribute__((address_space(1)))
#define LAS __attribute__((address_space(3)))
typedef unsigned short bf16;
typedef unsigned v4u __attribute__((ext_vector_type(4)));
typedef unsigned v2u __attribute__((ext_vector_type(2)));
typedef float f32x4 __attribute__((ext_vector_type(4)));
typedef float f32x2 __attribute__((ext_vector_type(2)));
typedef short bf16x8 __attribute__((ext_vector_type(8)));
#define LDS_WAIT() asm volatile("s_waitcnt lgkmcnt(0)" ::: "memory")
#define VM_WAIT() asm volatile("s_waitcnt vmcnt(0)" ::: "memory")

constexpr int D = 1024, NB = 4, SEQ = 8192, CTXL = 256, GRIDW = 64, GRIDH = 128;
constexpr int NLAT = NB * SEQ, NCTX = NB * CTXL, MR = NLAT + NCTX;
constexpr int RWW = 512, RWH = 8, HD = 64;
constexpr int C_R = 0, C_K = 512, C_V = 1024, C_PW = 1536, C_PA = 1568, C_PG = 1600, C_Q = 1696, C_KG = 1952, C_VG = 2208, C_PGL = 2720, C_OG = 2736, C_GRW = 3248, C_GGLA = 4272;
constexpr int IN_COLS = 5296, NP = 5376;
constexpr int NE = 256, TOPK = 8, FF = 256;
constexpr float LN_EPS = 1e-5f, RW_GN_EPS = 64e-5f;
constexpr float ALPHA = 1.189207115f;
constexpr float W8S = 64.0f, W8I = 1.0f / 64.0f;
constexpr int NLORA = 3072, KLORA = 256;
constexpr int MAXTILES = 1280, SH_ROW0 = MAXTILES * 256, NROWS_E = SH_ROW0 + NLAT;

namespace pg8 {
#define PG8_LAS __attribute__((address_space(3)))
typedef unsigned short bf16_t;
typedef unsigned u32x4 __attribute__((ext_vector_type(4)));
typedef unsigned u32x2 __attribute__((ext_vector_type(2)));
typedef long i64x2 __attribute__((ext_vector_type(2)));
typedef int i32x4v __attribute__((ext_vector_type(4))); typedef int i32x8v __attribute__((ext_vector_type(8)));
constexpr int BM = 256, BK = 64, HALF = 128, HTB = HALF * BK * 2, STAGE_BYTES = 8 * HTB, NXCD = 8, WGM = 8;
constexpr int IDX_OFF = STAGE_BYTES, IDX_UNITS = 12;

__host__ __device__ __forceinline__ int lds_byte(int r, int c) { const int st = (r >> 4) * 2 + (c >> 5), rr = r & 15, cc = c & 31, ob = rr * 64 + cc * 2; return st * 1024 + (ob ^ (((ob >> 9) & 1) << 5)); }
__host__ __device__ __forceinline__ void stage_rc(int b, int& R, int& C) { const int st = b / 1024, sb = b % 1024, swz = sb ^ (((sb >> 9) & 1) << 5); R = (st >> 1) * 16 + swz / 64; C = (st & 1) * 32 + (swz % 64) / 2; }
__host__ __device__ __forceinline__ int perm32(int rho) { const int n = rho >> 4, i = rho & 15; return 8 * (i >> 2) + 4 * n + (i & 3); }

struct Unit { int pm, pn, e, j; };
struct Gemm { const bf16_t* A; const bf16_t* Bt; int M, N, K; const int* rowidx; };

struct StaticOrder {
    int nM, nN, nwg, G, c;
    __host__ __device__ void init(int M, int N, int G_, int c_) { nM = M / BM; nN = N / BM; nwg = nM * nN; G = G_; c = c_; }
    __host__ __device__ bool next(int i, Unit& u) const {
        const long L = (long)i * G + c; if (L >= nwg) return false;
        int wgid = (int)L; { const int q = nwg / NXCD, r = nwg % NXCD, xcd = wgid % NXCD, off = wgid / NXCD; wgid = (xcd < r ? xcd * (q + 1) : r * (q + 1) + (xcd - r) * q) + off; }
        const int nig = WGM * nN, gid = wgid / nig, fm = gid * WGM, gsz = (nM - fm) < WGM ? (nM - fm) : WGM;
        u.pm = fm + ((wgid % nig) % gsz); u.pn = (wgid % nig) / gsz; u.e = 0; u.j = u.pn; return true;
    }
};
struct MoeOrder {
    int nN, G, c, NT; const int* tile_e;
    __device__ bool next(int i, Unit& u) const {
        int tile, j;
        if (G == 256) { const int x = c & 7, y = c >> 3; tile = i * (256 / nN) + x * (32 / nN) + y / nN; j = y % nN; if (tile >= NT + NLAT / 256) return false; }
        else { const int L = i * G + c; if (L >= (NT + NLAT / 256) * nN) return false; tile = L / nN; j = L - tile * nN; }
        int e, pm;
        if (tile < NT) { e = tile_e[tile]; pm = tile; } else { e = NE; pm = MAXTILES + (tile - NT); }
        u.pm = pm; u.pn = e * nN + j; u.e = e; u.j = j; return true;
    }
};

typedef __bf16 bf16x2n __attribute__((ext_vector_type(2))); typedef float f32x2n __attribute__((ext_vector_type(2)));
__device__ __forceinline__ unsigned cvt_pk_bf16(float lo, float hi) { const f32x2n v = {lo, hi}; return __builtin_bit_cast(unsigned, __builtin_convertvector(v, bf16x2n)); }

template <class Epi, class Sched, bool ALIGN_EPI, bool SP2, bool GATHER, bool FP8 = false>
__device__ __forceinline__ void gemm_phase(PG8_LAS unsigned char* lds, const Gemm g, const Sched& S, const Epi& E) {
    const int tid = threadIdx.x, wid = __builtin_amdgcn_readfirstlane(tid >> 6), lane = tid & 63, wr = wid >> 2, wc = wid & 3, fr = lane & 15, fq = lane >> 4;
    const int K = g.K, nt = K / BK;
    const size_t kstep = (size_t)(BK * 2);
    const size_t hstep = (size_t)HALF * K * 2;
    const size_t tstep = 2 * hstep;
    unsigned voffB[2]; unsigned va[2][2];
#pragma unroll
    for (int i = 0; i < 2; ++i) { int R, C; stage_rc(tid * 16 + i * 8192, R, C); const int Rb = Epi::PERM ? ((R & ~31) + perm32(R & 31)) : R;
        voffB[i] = (unsigned)(Rb * K + C) * 2u;
        va[0][i] = (unsigned)(R * K + C) * 2u; va[1][i] = va[0][i]; }
    const size_t ah = GATHER ? (size_t)0 : hstep;
#define PG8_GOFF(dst, ub) do { _Pragma("unroll") for (int _h = 0; _h < 2; ++_h) _Pragma("unroll") for (int _i = 0; _i < 2; ++_i) { int _R, _C; stage_rc(tid * 16 + _i * 8192, _R, _C); \
        dst[_h][_i] = (unsigned)(idxt[(ub) * 256 + _h * 128 + _R] * K + _C) * 2u; } } while (0)
    const unsigned ldsw = (unsigned)wid * 1024u;
    const int aoff = lds_byte(wr * 64 + fr, fq * 8), boff = lds_byte(wc * 32 + fr, fq * 8);
    PG8_LAS int* idxt = (PG8_LAS int*)(lds + IDX_OFF);
#define PG8_SA(b, h) (((b) * 2 + (h)) * HTB)
#define PG8_SB(b, h) ((4 + (b) * 2 + (h)) * HTB)
#define PG8_STAGE(bufoff, gbase, voff) do { _Pragma("unroll") for (int _i = 0; _i < 2; ++_i) \
        __builtin_amdgcn_global_load_lds((const unsigned*)((const char*)(gbase) + (voff)[_i]), (PG8_LAS unsigned*)(lds + (bufoff) + ldsw + _i * 8192), 16, 0, 0); } while (0)
#define PG8_LD32(dst, addr) do { const i32x4v _lo = *(const PG8_LAS i32x4v*)(addr), _hi = *(const PG8_LAS i32x4v*)((addr) + 1024); dst = __builtin_shufflevector(_lo, _hi, 0, 1, 2, 3, 4, 5, 6, 7); } while (0)
#define PG8_LDA(dst, b, h) do { _Pragma("unroll") for (int m = 0; m < 4; ++m) PG8_LD32(dst[m], lds + PG8_SA(b, h) + aoff + m * 2048); } while (0)
#define PG8_LDB(dst, b, h) do { _Pragma("unroll") for (int n = 0; n < 2; ++n) PG8_LD32(dst[n], lds + PG8_SB(b, h) + boff + n * 2048); } while (0)
#define PG8_HALF(v, k) __builtin_bit_cast(bf16x8, (k) ? __builtin_shufflevector(v, v, 4, 5, 6, 7) : __builtin_shufflevector(v, v, 0, 1, 2, 3))
#define PG8_MMA(ai, bj, At, Bt) do { __builtin_amdgcn_s_setprio(1); _Pragma("unroll") for (int m = 0; m < 4; ++m) _Pragma("unroll") for (int n = 0; n < 2; ++n) { \
        if constexpr (FP8) asm volatile("v_mfma_f32_16x16x128_f8f6f4 %0, %1, %2, %0" : "+v"(acc[ai][bj][m][n]) : "v"(Bt[n]), "v"(At[m])); \
        else { _Pragma("unroll") for (int k = 0; k < 2; ++k) acc[ai][bj][m][n] = __builtin_amdgcn_mfma_f32_16x16x32_bf16(PG8_HALF(Bt[n], k), PG8_HALF(At[m], k), acc[ai][bj][m][n], 0, 0, 0); } } __builtin_amdgcn_s_setprio(0); } while (0)
#define PG8_WAIT_V(n) asm volatile("s_waitcnt vmcnt(" #n ")" ::: "memory")
#define PG8_WAIT_L(n) asm volatile("s_waitcnt lgkmcnt(" #n ")" ::: "memory")
#define PG8_BAR __builtin_amdgcn_s_barrier()
#define PG8_SCHED __builtin_amdgcn_sched_barrier(0)
    Unit cur, nxt; int ui = 0;
    if (!S.next(0, cur)) return;
#ifdef GEMM_STAGGER
    if constexpr (FP8) {
        const unsigned long long t0 = __builtin_amdgcn_s_memrealtime(); const unsigned long long dl = (unsigned long long)(blockIdx.x & 3) * GEMM_STAGGER;
        while (__builtin_amdgcn_s_memrealtime() - t0 < dl) __builtin_amdgcn_s_sleep(8);
    }
#endif
    if constexpr (GATHER) {
        Unit uu;
        for (int i = 0; i < IDX_UNITS; ++i) { if (!S.next(i, uu)) break; if (tid < 256) idxt[i * 256 + tid] = g.rowidx[(size_t)uu.pm * 256 + tid]; }
        asm volatile("s_waitcnt vmcnt(0) lgkmcnt(0)" ::: "memory"); PG8_BAR; asm volatile("" ::: "memory");
        PG8_GOFF(va, 0);
    }
    f32x4 acc[2][2][4][2];
#pragma unroll
    for (int a = 0; a < 2; ++a)
#pragma unroll
        for (int b = 0; b < 2; ++b)
#pragma unroll
            for (int m = 0; m < 4; ++m)
#pragma unroll
                for (int n = 0; n < 2; ++n) acc[a][b][m][n] = (f32x4){0.f, 0.f, 0.f, 0.f};
    i32x8v At[4], B0[2], B1[2];
    const char* cA = (const char*)g.A + (GATHER ? (size_t)0 : (size_t)cur.pm * tstep); const char* cB = (const char*)g.Bt + (size_t)cur.pn * tstep;
    if constexpr (SP2) {
        PG8_STAGE(PG8_SB(0, 0), cB, voffB); PG8_STAGE(PG8_SB(0, 1), cB + hstep, voffB); PG8_STAGE(PG8_SA(0, 0), cA, va[0]); PG8_STAGE(PG8_SA(0, 1), cA + ah, va[1]);
        if (wr == 1) PG8_BAR;
        PG8_WAIT_V(2); PG8_BAR;
        PG8_STAGE(PG8_SB(1, 0), cB + kstep, voffB); PG8_STAGE(PG8_SA(1, 0), cA + kstep, va[0]); PG8_STAGE(PG8_SB(1, 1), cB + hstep + kstep, voffB);
        PG8_WAIT_V(6); PG8_BAR;
    } else {
        PG8_STAGE(PG8_SB(0, 0), cB, voffB); PG8_STAGE(PG8_SA(0, 0), cA, va[0]); PG8_STAGE(PG8_SB(0, 1), cB + hstep, voffB); PG8_STAGE(PG8_SA(0, 1), cA + ah, va[1]);
        if (wr == 1) PG8_BAR;
        PG8_WAIT_V(4); PG8_BAR;
        PG8_STAGE(PG8_SB(1, 0), cB + kstep, voffB); PG8_STAGE(PG8_SA(1, 0), cA + kstep, va[0]); PG8_STAGE(PG8_SB(1, 1), cB + hstep + kstep, voffB);
        PG8_WAIT_V(6); PG8_BAR;
    }
    for (;;) {
        const bool has_next = S.next(ui + 1, nxt);
        const char* nA = has_next ? (const char*)g.A + (GATHER ? (size_t)0 : (size_t)nxt.pm * tstep) : cA; const char* nB = has_next ? (const char*)g.Bt + (size_t)nxt.pn * tstep : cB;
        const int ubn = (has_next && ui + 1 < IDX_UNITS) ? (ui + 1) : ui;
#pragma unroll 1
        for (int t = 0; t < nt; t += 2) {
            const bool last = (t == nt - 2);
            const char* a1 = cA + (size_t)(t + 1) * kstep;
            const char* a2 = last ? nA : cA + (size_t)(t + 2) * kstep; const char* b2 = last ? nB : cB + (size_t)(t + 2) * kstep;
            const char* a3 = a2 + kstep; const char* b3 = b2 + kstep;
            unsigned v2[2][2];
#pragma unroll
            for (int h = 0; h < 2; ++h)
#pragma unroll
                for (int i = 0; i < 2; ++i) v2[h][i] = va[h][i];
            if constexpr (GATHER) { if (last) PG8_GOFF(v2, ubn); }
            if constexpr (SP2) {
            PG8_LDB(B0, 0, 0); PG8_LDB(B1, 0, 1); PG8_SCHED; PG8_LDA(At, 0, 0); PG8_STAGE(PG8_SA(1, 1), a1 + ah, va[1]);
            PG8_WAIT_V(8); PG8_WAIT_L(0); PG8_BAR; PG8_MMA(0, 0, At, B0); PG8_MMA(0, 1, At, B1); PG8_BAR; PG8_SCHED;
            PG8_LDA(At, 0, 1); PG8_STAGE(PG8_SB(0, 0), b2, voffB); PG8_STAGE(PG8_SB(0, 1), b2 + hstep, voffB); PG8_STAGE(PG8_SA(0, 0), a2, v2[0]);
            PG8_WAIT_V(8); PG8_WAIT_L(0); PG8_BAR; PG8_MMA(1, 0, At, B0); PG8_MMA(1, 1, At, B1); PG8_BAR; PG8_SCHED;
            PG8_LDB(B0, 1, 0); PG8_LDB(B1, 1, 1); PG8_SCHED; PG8_LDA(At, 1, 0); PG8_STAGE(PG8_SA(0, 1), a2 + ah, v2[1]);
            PG8_WAIT_V(8); PG8_WAIT_L(0); PG8_BAR; PG8_MMA(0, 0, At, B0); PG8_MMA(0, 1, At, B1); PG8_BAR; PG8_SCHED;
            PG8_LDA(At, 1, 1); PG8_STAGE(PG8_SB(1, 0), b3, voffB); PG8_STAGE(PG8_SB(1, 1), b3 + hstep, voffB); PG8_STAGE(PG8_SA(1, 0), a3, v2[0]);
            PG8_WAIT_V(8); PG8_WAIT_L(0); PG8_BAR; PG8_MMA(1, 0, At, B0); PG8_MMA(1, 1, At, B1); PG8_BAR; PG8_SCHED;
            } else {
            PG8_LDB(B0, 0, 0); PG8_SCHED; PG8_LDA(At, 0, 0); PG8_STAGE(PG8_SA(1, 1), a1 + ah, va[1]);
            PG8_WAIT_L(8); PG8_BAR; PG8_WAIT_L(0); PG8_MMA(0, 0, At, B0); PG8_BAR; PG8_SCHED;
            PG8_LDB(B1, 0, 1); PG8_STAGE(PG8_SB(0, 0), b2, voffB);
            PG8_BAR; PG8_WAIT_L(0); PG8_MMA(0, 1, At, B1); PG8_BAR;
            PG8_LDA(At, 0, 1); PG8_STAGE(PG8_SA(0, 0), a2, v2[0]);
            PG8_BAR; PG8_WAIT_L(0); PG8_MMA(1, 0, At, B0); PG8_BAR; PG8_SCHED;
            PG8_STAGE(PG8_SB(0, 1), b2 + hstep, voffB);
            PG8_WAIT_V(6); PG8_BAR; PG8_MMA(1, 1, At, B1); PG8_BAR;
            PG8_LDB(B0, 1, 0); PG8_SCHED; PG8_LDA(At, 1, 0); PG8_STAGE(PG8_SA(0, 1), a2 + ah, v2[1]);
            PG8_WAIT_L(8); PG8_BAR; PG8_WAIT_L(0); PG8_MMA(0, 0, At, B0); PG8_BAR; PG8_SCHED;
            PG8_LDB(B1, 1, 1); PG8_STAGE(PG8_SB(1, 0), b3, voffB);
            PG8_BAR; PG8_WAIT_L(0); PG8_MMA(0, 1, At, B1); PG8_BAR;
            PG8_LDA(At, 1, 1); PG8_STAGE(PG8_SA(1, 0), a3, v2[0]);
            PG8_BAR; PG8_WAIT_L(0); PG8_MMA(1, 0, At, B0); PG8_BAR; PG8_SCHED;
            PG8_STAGE(PG8_SB(1, 1), b3 + hstep, voffB);
            PG8_WAIT_V(6); PG8_BAR; PG8_MMA(1, 1, At, B1); PG8_BAR;
            }
        }
        if constexpr (ALIGN_EPI) { if (wr == 0) PG8_BAR; }
        if constexpr (FP8) asm volatile("s_nop 15\n\ts_nop 15" ::: "memory");
        E(acc, cur, wr, wc, fr, fq);
        if (!has_next) break;
#pragma unroll
        for (int a = 0; a < 2; ++a)
#pragma unroll
            for (int b = 0; b < 2; ++b)
#pragma unroll
                for (int m = 0; m < 4; ++m)
#pragma unroll
                    for (int n = 0; n < 2; ++n) acc[a][b][m][n] = (f32x4){0.f, 0.f, 0.f, 0.f};
        cur = nxt; cA = nA; cB = nB; ++ui;
        if constexpr (GATHER) PG8_GOFF(va, ubn);
        if constexpr (ALIGN_EPI) { if (wr == 1) PG8_BAR; }
    }
    PG8_WAIT_V(0);
    if constexpr (!ALIGN_EPI) { if (wr == 0) PG8_BAR; }
    PG8_BAR;
#undef PG8_SA
#undef PG8_GOFF
#undef PG8_SB
#undef PG8_STAGE
#undef PG8_LDA
#undef PG8_LD32
#undef PG8_HALF
#undef PG8_LDB
#undef PG8_MMA
#undef PG8_WAIT_V
#undef PG8_WAIT_L
#undef PG8_BAR
#undef PG8_SCHED
}
}

#define XB_TMO      128
#define XB_XCNT(j)  (256  + 64 * (j))
#define XB_XSUB(j)  (1280 + 64 * (j))
#define XB_XGEN(j)  (2304 + 64 * (j))
#define XB_TOP      3328
#define XB_TOPGEN   3392
#define XCD_BAR_WORDS 3456
#define XB_SPIN_CAP (1u << 18)
__device__ __forceinline__ unsigned xb_ld(unsigned* p)              { return __hip_atomic_load(p, __ATOMIC_RELAXED, __HIP_MEMORY_SCOPE_AGENT); }
__device__ __forceinline__ unsigned xb_add(unsigned* p, unsigned v) { return __hip_atomic_fetch_add(p, v, __ATOMIC_RELAXED, __HIP_MEMORY_SCOPE_AGENT); }
__device__ __forceinline__ unsigned xb_xcc_id() { return (unsigned)__builtin_amdgcn_s_getreg((3 << 11) | 20) & 0xFu; }
#define XB_SPIN(cond, bar) do { unsigned _sp = 0; while (cond) { __builtin_amdgcn_s_sleep(1); \
    if ((++_sp & 255u) == 0u) { if (xb_ld(&(bar)[XB_TMO])) break; if (_sp > XB_SPIN_CAP) { atomicAdd(&(bar)[XB_TMO], 1u); break; } } } } while (0)
struct XcdBarrier { unsigned* bar; unsigned x; volatile LAS unsigned* st; };
__device__ __forceinline__ XcdBarrier xcd_barrier_post(unsigned* bar, volatile LAS unsigned* st) {
    XcdBarrier b; b.bar = bar; b.x = xb_xcc_id(); b.st = st;
    if (threadIdx.x == 0) (void)xb_add(&bar[XB_XCNT(b.x)], 1u);
    return b;
}
__device__ __forceinline__ void xcd_barrier_complete(unsigned* bar, unsigned x, unsigned& nloc, unsigned& nx) {
    const unsigned G = gridDim.x * gridDim.y * gridDim.z;
    unsigned sum, cnt, mine, sp = 0u;
    for (;;) {
        sum = 0u; cnt = 0u; mine = 0u;
#pragma unroll
        for (unsigned j = 0; j < 16; ++j) { const unsigned c = xb_ld(&bar[XB_XCNT(j)]); sum += c; cnt += (c > 0u) ? 1u : 0u; mine = (j == x) ? c : mine; }
        if (sum == G) break;
        __builtin_amdgcn_s_sleep(1);
        if ((++sp & 255u) == 0u) { if (xb_ld(&bar[XB_TMO])) break; if (sp > XB_SPIN_CAP) { atomicAdd(&bar[XB_TMO], 1u); break; } }
    }
    nloc = mine > 0u ? mine : 1u; nx = cnt > 0u ? cnt : 1u;
}
__device__ __forceinline__ void xcd_barrier(const XcdBarrier& b) {
    asm volatile("s_waitcnt vmcnt(0)" ::: "memory");
    __syncthreads();
    if (threadIdx.x == 0) {
        unsigned* bar = b.bar;
        __builtin_amdgcn_s_waitcnt(0);
        unsigned nloc = b.st[0], nx = b.st[1];
        if (nloc == 0u) { xcd_barrier_complete(bar, b.x, nloc, nx); b.st[0] = nloc; b.st[1] = nx; }
        const unsigned old = xb_add(&bar[XB_XSUB(b.x)], 1u);
        const unsigned gen = old / nloc;
        if (old + 1u == (gen + 1u) * nloc) {
            __builtin_amdgcn_fence(__ATOMIC_RELEASE, "agent");
            asm volatile("s_waitcnt vmcnt(0)" ::: "memory");
            const unsigned og = xb_add(&bar[XB_TOP], 1u);
            const unsigned tg = og / nx;
            if (og + 1u == (tg + 1u) * nx) xb_add(&bar[XB_TOPGEN], 1u);
            else XB_SPIN(xb_ld(&bar[XB_TOPGEN]) == tg, bar);
            __builtin_amdgcn_fence(__ATOMIC_ACQUIRE, "agent");
            xb_add(&bar[XB_XGEN(b.x)], 1u);
            asm volatile("s_waitcnt vmcnt(0)" ::: "memory");
        } else {
            XB_SPIN(xb_ld(&bar[XB_XGEN(b.x)]) == gen, bar);
            __builtin_amdgcn_fence(__ATOMIC_ACQUIRE, "agent");
            asm volatile("s_waitcnt vmcnt(0)" ::: "memory");
        }
    }
    __syncthreads();
}

constexpr size_t MiB = 1u << 20;
constexpr size_t al(size_t x) { return (x + 4095) & ~(size_t)4095; }
constexpr size_t WS_CTL = 0, CTL_ZERO_BYTES = 1 * MiB;
constexpr int CW_BAR = 4096;
constexpr int CW_CNT = 16384, CNT_STRIDE = 64;
constexpr int CW_NT = CW_CNT + NE * CNT_STRIDE + 64;
static_assert((CW_NT + 1) * 4 <= (int)CTL_ZERO_BYTES, "control words inside the per-call memset");
constexpr size_t WS_MOD = 1 * MiB;
constexpr size_t WS_TILE_E = WS_MOD + 256 * 1024;
constexpr size_t WS_PADSTART = WS_TILE_E + 16 * 1024;
constexpr size_t WS_ROWTOK = 2 * MiB;
constexpr size_t WS_EIDX = 4 * MiB;
constexpr size_t WS_GATE = 5 * MiB;
constexpr size_t WS_DEST = 6 * MiB;
constexpr size_t WS_WIN = 8 * MiB;
constexpr size_t WS_WLORA = WS_WIN + al((size_t)NP * D * 2);
constexpr size_t WS_WBRRW = WS_WLORA + al((size_t)NLORA * KLORA * 2);
constexpr size_t WS_WBRGLA = WS_WBRRW + al((size_t)D * RWW * 2);
constexpr size_t WS_WOUT = WS_WBRGLA + al((size_t)D * RWW * 2);
constexpr size_t WS_WROUTER = WS_WOUT + al((size_t)D * D * 2);
constexpr size_t WS_WGU = WS_WROUTER + al((size_t)NE * D * 2);
constexpr size_t WS_WD = WS_WGU + al((size_t)(NE + 1) * 512 * D * 2);
constexpr size_t WS_PERSIST_END = WS_WD + al((size_t)(NE + 1) * D * FF * 2);
constexpr size_t WS_REGB = WS_PERSIST_END;
constexpr size_t SZ512F = al((size_t)MR * RWW * 4), SZ256F = al((size_t)MR * 256 * 4), SZ512H = al((size_t)MR * RWW * 2);
constexpr size_t WS_A1 = WS_REGB;
constexpr size_t WS_A2 = WS_A1;
constexpr size_t WS_KSUM = WS_A2 + al((size_t)MR * KLORA * 2);
static_assert(WS_KSUM + SZ512H <= WS_A1 + al((size_t)MR * D * 2), "A2 + KSUM fit in the A1 slot");
constexpr size_t WS_P = WS_A1 + al((size_t)MR * D * 2);
constexpr size_t WS_RB = WS_P + al((size_t)MR * NP * 2);
constexpr size_t WS_VB = WS_RB + SZ512H, WS_KKB = WS_VB + SZ512H, WS_KMF = WS_KKB + SZ512H, WS_KMB = WS_KMF + SZ512H, WS_BVF = WS_KMB + SZ512H, WS_BVB = WS_BVF + SZ512H;
constexpr size_t WS_LWF = WS_BVB + SZ512H, WS_LWB = WS_LWF + SZ512F;
constexpr size_t SZ256H = al((size_t)MR * 256 * 2);
constexpr size_t WS_QGB = WS_LWB + SZ512F, WS_KGB = WS_QGB + SZ256H, WS_VGB = WS_KGB + SZ256H, WS_LAF = WS_VGB + SZ512H, WS_LAB = WS_LAF + SZ256F;
constexpr size_t WS_RWG = WS_LAB + SZ256F;
constexpr size_t WS_ORWF = WS_RWG + SZ512H, WS_ORWB = WS_ORWF + SZ512H, WS_OGLF = WS_ORWB + SZ512H, WS_OGLB = WS_OGLF + SZ512H;
constexpr int CH = 64, NCHUNK = (CTXL + SEQ) / CH, NU_RW = 64 * NCHUNK, NU_GL = 32 * NCHUNK;
constexpr size_t WS_RH = WS_OGLB + SZ512H;
constexpr size_t WS_YL = WS_RH + al((size_t)NU_RW * 4096 * 2);
constexpr size_t WS_HH = WS_YL + al((size_t)NU_RW * 4096 * 2);
constexpr size_t WS_INTRA = WS_HH + al((size_t)NU_RW * 4096 * 2);
constexpr size_t WS_KV = WS_INTRA + al((size_t)NU_GL * 8192 * 2);
constexpr size_t WS_DD = WS_KV + al((size_t)NU_GL * 8192 * 2);
constexpr size_t WS_END_MIX = WS_DD + al((size_t)NU_GL * 64 * 4);
constexpr size_t OUT_GT = 0, OUT_QE = (size_t)NU_RW * 4096 * 2;
static_assert(OUT_QE + (size_t)NU_GL * 4096 * 2 <= (size_t)NLAT * D * 4, "scan scratch fits in d_out");
constexpr size_t WS_YRW = WS_LWF, WS_YGLA = WS_LWB, WS_Z = WS_HH;
static_assert((size_t)NLAT * D * 2 <= (size_t)NU_RW * 4096 * 2, "Z fits in the HH slot");
constexpr size_t WS_X1 = WS_REGB;
constexpr size_t WS_A3 = WS_X1 + al((size_t)NLAT * D * 4);
constexpr size_t WS_LOGITS = WS_A3 + al((size_t)NLAT * D * 2);
constexpr size_t WS_ACT = WS_LOGITS + al((size_t)NLAT * NE * 4);
constexpr size_t WS_Y = WS_ACT + al((size_t)NROWS_E * FF * 2);
constexpr size_t WS_A3F = WS_Y + al((size_t)NROWS_E * D);
constexpr size_t WS_END_MOE = WS_A3F + al((size_t)NLAT * D);
constexpr size_t WS_END = WS_END_MIX > WS_END_MOE ? WS_END_MIX : WS_END_MOE;
static_assert(WS_END <= (size_t)2048 * MiB, "workspace map exceeds 2 GiB");

constexpr int RING_BYTES = 131072;
constexpr int IDX_BYTES = pg8::IDX_UNITS * 256 * 4;
constexpr int MISC_OFF = RING_BYTES + IDX_BYTES;
constexpr int S2_SF_OFF = MISC_OFF + 256;
constexpr int LDS_BYTES = S2_SF_OFF + 8192;
static_assert(pg8::IDX_OFF == RING_BYTES, "gather table sits right above the stage buffers");
constexpr int NWAVES = 8, NTHR = 512;

struct Args { const float* in[36]; float* out; unsigned char* ws; int ph_lo, ph_hi; };

struct Frame {
    LAS unsigned char* lds;
    int tid, lane, wave, G, gw, NGW;
    const float* const* in; float* out; unsigned char* ws; unsigned* ctl;
};

__device__ __forceinline__ float wave_sum(float v) {
#pragma unroll
    for (int o = 1; o < 64; o <<= 1) v += __shfl_xor(v, o);
    return v;
}
__device__ __forceinline__ unsigned f2bf(float f) { unsigned u = __builtin_bit_cast(unsigned, f); return (u + 0x7fffu + ((u >> 16) & 1u)) >> 16; }
typedef __bf16 bf16x2v __attribute__((ext_vector_type(2)));
__device__ __forceinline__ unsigned pk2(float lo, float hi) { const f32x2 v = {lo, hi}; return __builtin_bit_cast(unsigned, __builtin_convertvector(v, bf16x2v)); }
__device__ __forceinline__ float bflo(unsigned w) { return __builtin_bit_cast(float, w << 16); }
__device__ __forceinline__ float bfhi(unsigned w) { return __builtin_bit_cast(float, w & 0xffff0000u); }
__device__ __forceinline__ float sigmoidf_(float x) { return __builtin_amdgcn_rcpf(1.0f + __expf(-x)); }
__device__ __forceinline__ float siluf_(float x) { return x * __builtin_amdgcn_rcpf(1.0f + __expf(-x)); }
__device__ __forceinline__ float tanhf_(float x) { return 1.0f - 2.0f * __builtin_amdgcn_rcpf(1.0f + __expf(2.0f * x)); }
__device__ __forceinline__ float logsigmoidf_(float x) { return fminf(x, 0.f) - __logf(1.0f + __expf(-fabsf(x))); }

__device__ __forceinline__ void ln_stats(const f32x4 (&v)[4], float& mean, float& rstd) {
    float s = 0.f;
#pragma unroll
    for (int j = 0; j < 4; ++j) s += (v[j].x + v[j].y) + (v[j].z + v[j].w);
    mean = wave_sum(s) * (1.f / D); float s2 = 0.f;
#pragma unroll
    for (int j = 0; j < 4; ++j) { const f32x4 d = v[j] - mean; s2 += (d.x * d.x + d.y * d.y) + (d.z * d.z + d.w * d.w); }
    rstd = __builtin_amdgcn_rsqf(wave_sum(s2) * (1.f / D) + LN_EPS);
}

__device__ __forceinline__ unsigned pack_fp8x4(const f32x4 v) {
    int w = __builtin_amdgcn_cvt_pk_fp8_f32(__builtin_amdgcn_fmed3f(v[0], -448.f, 448.f), __builtin_amdgcn_fmed3f(v[1], -448.f, 448.f), 0, false);
    return (unsigned)__builtin_amdgcn_cvt_pk_fp8_f32(__builtin_amdgcn_fmed3f(v[2], -448.f, 448.f), __builtin_amdgcn_fmed3f(v[3], -448.f, 448.f), w, true); }
__device__ __forceinline__ void ld_row_bf16(const bf16* row, int lane, f32x4 (&v)[4]) {
    const v4u a = *(const v4u*)(row + 8 * lane), b = *(const v4u*)(row + 512 + 8 * lane);
    v[0] = (f32x4){bflo(a.x), bfhi(a.x), bflo(a.y), bfhi(a.y)}; v[1] = (f32x4){bflo(a.z), bfhi(a.z), bflo(a.w), bfhi(a.w)};
    v[2] = (f32x4){bflo(b.x), bfhi(b.x), bflo(b.y), bfhi(b.y)}; v[3] = (f32x4){bflo(b.z), bfhi(b.z), bflo(b.w), bfhi(b.w)};
}
__device__ __forceinline__ int rowcol(int lane, int j) { return 512 * (j >> 1) + 8 * lane + 4 * (j & 1); }
__device__ __forceinline__ void ph_x1pre_nomix(Frame& F) {
    const float* x = F.in[0];
    for (int m = F.gw; m < NLAT; m += F.NGW) {
        bf16* o = (bf16*)(F.ws + WS_X1) + (size_t)m * D;
#pragma unroll
        for (int h = 0; h < 2; ++h) { const float* xr = x + (size_t)m * D + 512 * h + 8 * F.lane; const f32x4 a = *(const f32x4*)xr * ALPHA, b = *(const f32x4*)(xr + 4) * ALPHA;
            v4u w; w.x = pk2(a.x, a.y); w.y = pk2(a.z, a.w); w.z = pk2(b.x, b.y); w.w = pk2(b.z, b.w); *(v4u*)(o + 512 * h + 8 * F.lane) = w; }
    }
}
__device__ __forceinline__ void ph_ln1(Frame& F) {
    const float* lw = F.in[26]; const float* lb = F.in[27]; const float* mod = (const float*)(F.ws + WS_MOD);
    bf16* A3 = (bf16*)(F.ws + WS_A3); const bf16* X1P = (const bf16*)(F.ws + WS_X1);
    constexpr int NR = 4;
    for (int m0 = F.gw; m0 < NLAT; m0 += NR * F.NGW) {
        v4u w[NR][2];
#pragma unroll
        for (int r = 0; r < NR; ++r) { const int mm = m0 + r * F.NGW; const bf16* row = X1P + (size_t)(mm < NLAT ? mm : m0) * D; w[r][0] = *(const v4u*)(row + 8 * F.lane); w[r][1] = *(const v4u*)(row + 512 + 8 * F.lane); }
        __builtin_amdgcn_sched_barrier(0);
#pragma unroll
        for (int r = 0; r < NR; ++r) { const int mm = m0 + r * F.NGW; const int m = mm < NLAT ? mm : m0; const int b = m / SEQ;
            f32x4 v[4];
            v[0] = (f32x4){bflo(w[r][0].x), bfhi(w[r][0].x), bflo(w[r][0].y), bfhi(w[r][0].y)}; v[1] = (f32x4){bflo(w[r][0].z), bfhi(w[r][0].z), bflo(w[r][0].w), bfhi(w[r][0].w)};
            v[2] = (f32x4){bflo(w[r][1].x), bfhi(w[r][1].x), bflo(w[r][1].y), bfhi(w[r][1].y)}; v[3] = (f32x4){bflo(w[r][1].z), bfhi(w[r][1].z), bflo(w[r][1].w), bfhi(w[r][1].w)};
            float mean, rstd; ln_stats(v, mean, rstd);
#if MS >= 2
            f32x4 h[4];
#pragma unroll
            for (int j = 0; j < 4; ++j) { const int c = rowcol(F.lane, j);
                const f32x4 x1 = (v[j] - mean) * rstd * *(const f32x4*)(lw + c) + *(const f32x4*)(lb + c);
                h[j] = x1 * (*(const f32x4*)(mod + b * 6144 + 4096 + c) + 1.0f) + *(const f32x4*)(mod + b * 6144 + 3072 + c); }
            bf16* ao = A3 + (size_t)m * D;
            { v4u o; o.x = pk2(h[0].x, h[0].y); o.y = pk2(h[0].z, h[0].w); o.z = pk2(h[1].x, h[1].y); o.w = pk2(h[1].z, h[1].w); *(v4u*)(ao + 8 * F.lane) = o;
              o.x = pk2(h[2].x, h[2].y); o.y = pk2(h[2].z, h[2].w); o.z = pk2(h[3].x, h[3].y); o.w = pk2(h[3].z, h[3].w); *(v4u*)(ao + 512 + 8 * F.lane) = o; }
            { unsigned char* af = F.ws + WS_A3F + (size_t)m * D; v2u o8;
              o8.x = pack_fp8x4(h[0]); o8.y = pack_fp8x4(h[1]); *(v2u*)(af + 8 * F.lane) = o8; o8.x = pack_fp8x4(h[2]); o8.y = pack_fp8x4(h[3]); *(v2u*)(af + 512 + 8 * F.lane) = o8; }
#endif
        }
    }
}
__device__ __forceinline__ f32x4 fp8x4(unsigned w) { const f32x2 lo = __builtin_amdgcn_cvt_pk_f32_fp8((int)w, false), hi = __builtin_amdgcn_cvt_pk_f32_fp8((int)w, true); return (f32x4){lo.x, lo.y, hi.x, hi.y}; }
__device__ __forceinline__ void ph_final(Frame& F) {
    const float* lw = F.in[34]; const float* lb = F.in[35]; const float* mod = (const float*)(F.ws + WS_MOD);
    const float* lw1 = F.in[26]; const float* lb1 = F.in[27]; const bf16* X1P = (const bf16*)(F.ws + WS_X1);
    const unsigned char* Y = F.ws + WS_Y; const int* DEST = (const int*)(F.ws + WS_DEST); const float* GATE = (const float*)(F.ws + WS_GATE);
    const int c0 = 16 * F.lane;
    for (int m0 = F.gw; m0 < NLAT; m0 += 2 * F.NGW) {
        int mm[2]; mm[0] = m0; mm[1] = (m0 + F.NGW < NLAT) ? m0 + F.NGW : m0;
        v4u xw[2][2];
#if MS >= 2
        v4u dw[2][2]; f32x4 gw[2][2];
#pragma unroll
        for (int r = 0; r < 2; ++r) { dw[r][0] = *(const v4u*)(DEST + mm[r] * 8); dw[r][1] = *(const v4u*)(DEST + mm[r] * 8 + 4); gw[r][0] = *(const f32x4*)(GATE + mm[r] * 8); gw[r][1] = *(const f32x4*)(GATE + mm[r] * 8 + 4); }
#endif
#pragma unroll
        for (int r = 0; r < 2; ++r) { const bf16* row = X1P + (size_t)mm[r] * D + c0; xw[r][0] = *(const v4u*)row; xw[r][1] = *(const v4u*)(row + 8); }
#if MS >= 2
        v4u yw[2][TOPK + 1];
#pragma unroll
        for (int r = 0; r < 2; ++r) {
            int dr[TOPK]; dr[0] = (int)dw[r][0].x; dr[1] = (int)dw[r][0].y; dr[2] = (int)dw[r][0].z; dr[3] = (int)dw[r][0].w; dr[4] = (int)dw[r][1].x; dr[5] = (int)dw[r][1].y; dr[6] = (int)dw[r][1].z; dr[7] = (int)dw[r][1].w;
#pragma unroll
            for (int k = 0; k <= TOPK; ++k) yw[r][k] = *(const v4u*)(Y + (size_t)(k < TOPK ? dr[k < TOPK ? k : 0] : SH_ROW0 + mm[r]) * D + c0); }
        __builtin_amdgcn_sched_barrier(0);
#endif
#pragma unroll
        for (int r = 0; r < 2; ++r) { const int m = mm[r]; const int b = m / SEQ;
            f32x4 v[4];
            v[0] = (f32x4){bflo(xw[r][0].x), bfhi(xw[r][0].x), bflo(xw[r][0].y), bfhi(xw[r][0].y)}; v[1] = (f32x4){bflo(xw[r][0].z), bfhi(xw[r][0].z), bflo(xw[r][0].w), bfhi(xw[r][0].w)};
            v[2] = (f32x4){bflo(xw[r][1].x), bfhi(xw[r][1].x), bflo(xw[r][1].y), bfhi(xw[r][1].y)}; v[3] = (f32x4){bflo(xw[r][1].z), bfhi(xw[r][1].z), bflo(xw[r][1].w), bfhi(xw[r][1].w)};
            { float mean1, rstd1; ln_stats(v, mean1, rstd1);
#pragma unroll
              for (int j = 0; j < 4; ++j) { const int c = c0 + 4 * j; v[j] = ((v[j] - mean1) * rstd1 * *(const f32x4*)(lw1 + c) + *(const f32x4*)(lb1 + c)) * ALPHA; } }
#if MS >= 2
            const float gt[TOPK] = {gw[r][0].x * 0.0625f, gw[r][0].y * 0.0625f, gw[r][0].z * 0.0625f, gw[r][0].w * 0.0625f, gw[r][1].x * 0.0625f, gw[r][1].y * 0.0625f, gw[r][1].z * 0.0625f, gw[r][1].w * 0.0625f};
#pragma unroll
            for (int j = 0; j < 4; ++j) { const unsigned ws8 = j == 0 ? yw[r][TOPK].x : (j == 1 ? yw[r][TOPK].y : (j == 2 ? yw[r][TOPK].z : yw[r][TOPK].w));
                f32x4 mo = fp8x4(ws8) * 0.0625f;
#pragma unroll
                for (int k = 0; k < TOPK; ++k) { const unsigned wk = j == 0 ? yw[r][k].x : (j == 1 ? yw[r][k].y : (j == 2 ? yw[r][k].z : yw[r][k].w)); mo += fp8x4(wk) * gt[k]; }
                v[j] += *(const f32x4*)(mod + b * 6144 + 5120 + c0 + 4 * j) * mo; }
#endif
            float mean, rstd; ln_stats(v, mean, rstd);
            float* o = F.out + (size_t)m * D + c0;
#pragma unroll
            for (int j = 0; j < 4; ++j) { const int c = c0 + 4 * j; *(f32x4*)(o + 4 * j) = (v[j] - mean) * rstd * *(const f32x4*)(lw + c) + *(const f32x4*)(lb + c); }
        }
    }
}


#if MS >= 2
template <int MODE, bool FP8 = false>
__device__ __forceinline__ void cvt_item(const float* W, int Nsrc, int nblk, bf16* WT, int row_off, int dpitch, LAS float* scr, int item, int lane) {
    const int kb = item / nblk, nb = item - kb * nblk, k0 = 64 * kb, n0 = 32 * nb;
    const int nn = n0 + (lane & 31);
#pragma unroll 8
    for (int i = 0; i < 32; ++i) { const int kk = 2 * i + (lane >> 5); scr[kk * 33 + (lane & 31)] = (nn < Nsrc) ? W[(size_t)(k0 + kk) * Nsrc + nn] : 0.f; }
    LDS_WAIT(); asm volatile("" ::: "memory");
    const int c = lane & 7;
#pragma unroll
    for (int j = 0; j < 4; ++j) { const int n = (lane >> 3) + 8 * j; const LAS float* s = scr + (8 * c) * 33 + n;
        v4u o; o.x = pk2(s[0 * 33], s[1 * 33]); o.y = pk2(s[2 * 33], s[3 * 33]); o.z = pk2(s[4 * 33], s[5 * 33]); o.w = pk2(s[6 * 33], s[7 * 33]);
        const int ng = n0 + n; int dr = ng;
        if (MODE == 1) { const int i2 = ng & 255; dr = 8 * (i2 >> 2) + (i2 & 3) + ((ng >= 256) ? 4 : 0); }
        if constexpr (FP8) { v2u o8; o8.x = pack_fp8x4((f32x4){s[0 * 33], s[1 * 33], s[2 * 33], s[3 * 33]} * W8S); o8.y = pack_fp8x4((f32x4){s[4 * 33], s[5 * 33], s[6 * 33], s[7 * 33]} * W8S);
            *(v2u*)((unsigned char*)WT + (size_t)(row_off + dr) * dpitch + k0 + 8 * c) = o8; }
        else *(v4u*)(WT + (size_t)(row_off + dr) * dpitch + k0 + 8 * c) = o; }
    LDS_WAIT(); asm volatile("" ::: "memory");
}

template <int MODE>
__device__ __forceinline__ void cvt_item_reg(const float* W, int Nsrc, bf16* WT, int row_off, int dpitch, int k0, int n0, int lane) {
    const float* src = W + (size_t)k0 * Nsrc + n0 + 4 * lane;
    f32x4 v[32];
#pragma unroll
    for (int i = 0; i < 32; ++i) v[i] = __builtin_nontemporal_load((const f32x4*)(src + (size_t)i * Nsrc));
#pragma unroll
    for (int j = 0; j < 4; ++j) {
        const int ng = n0 + 4 * lane + j; int dr = ng;
        if (MODE == 1) { const int i2 = ng & 255; dr = 8 * (i2 >> 2) + (i2 & 3) + ((ng >= 256) ? 4 : 0); }
        v4u* dst = (v4u*)(WT + (size_t)(row_off + dr) * dpitch + k0);
#pragma unroll
        for (int q = 0; q < 4; ++q) { v4u o; o.x = pk2(v[8 * q][j], v[8 * q + 1][j]); o.y = pk2(v[8 * q + 2][j], v[8 * q + 3][j]); o.z = pk2(v[8 * q + 4][j], v[8 * q + 5][j]); o.w = pk2(v[8 * q + 6][j], v[8 * q + 7][j]); dst[q] = o; }
    }
}

constexpr int CVK = 32;
__device__ __forceinline__ void cvt_reg_load(const float* W, int Nsrc, int k0, int n0, int lane, f32x4 (&v)[CVK]) {
    const float* src = W + (size_t)k0 * Nsrc + n0 + 4 * lane;
#pragma unroll
    for (int i = 0; i < CVK; ++i) v[i] = __builtin_nontemporal_load((const f32x4*)(src + (size_t)i * Nsrc));
}
template <int MODE, bool FP8 = false>
__device__ __forceinline__ void cvt_reg_store(bf16* WT, int row_off, int dpitch, int k0, int n0, int lane, const f32x4 (&v)[CVK]) {
#pragma unroll
    for (int j = 0; j < 4; ++j) {
        const int ng = n0 + 4 * lane + j; int dr = ng;
        if (MODE == 1) { const int i2 = ng & 255; dr = 8 * (i2 >> 2) + (i2 & 3) + ((ng >= 256) ? 4 : 0); }
        if constexpr (FP8) { v4u* dst8 = (v4u*)((unsigned char*)WT + (size_t)(row_off + dr) * dpitch + k0);
#pragma unroll
            for (int q = 0; q < CVK / 16; ++q) { v4u o;
                o.x = pack_fp8x4((f32x4){v[16 * q][j], v[16 * q + 1][j], v[16 * q + 2][j], v[16 * q + 3][j]} * W8S); o.y = pack_fp8x4((f32x4){v[16 * q + 4][j], v[16 * q + 5][j], v[16 * q + 6][j], v[16 * q + 7][j]} * W8S);
                o.z = pack_fp8x4((f32x4){v[16 * q + 8][j], v[16 * q + 9][j], v[16 * q + 10][j], v[16 * q + 11][j]} * W8S); o.w = pack_fp8x4((f32x4){v[16 * q + 12][j], v[16 * q + 13][j], v[16 * q + 14][j], v[16 * q + 15][j]} * W8S); dst8[q] = o; }
            continue; }
        v4u* dst = (v4u*)(WT + (size_t)(row_off + dr) * dpitch + k0);
#pragma unroll
        for (int q = 0; q < CVK / 8; ++q) { v4u o; o.x = pg8::cvt_pk_bf16(v[8 * q][j], v[8 * q + 1][j]); o.y = pg8::cvt_pk_bf16(v[8 * q + 2][j], v[8 * q + 3][j]); o.z = pg8::cvt_pk_bf16(v[8 * q + 4][j], v[8 * q + 5][j]); o.w = pg8::cvt_pk_bf16(v[8 * q + 6][j], v[8 * q + 7][j]); dst[q] = o; }
    }
}
constexpr int CV_GU = (D / CVK) * 2, CV_DN = (FF / CVK) * 4, CV_NGU = (NE + 1) * CV_GU, CV_NITEM = CV_NGU + (NE + 1) * CV_DN;
__device__ __forceinline__ void cvx_load(const float* const* in, int it, int lane, f32x4 (&v)[CVK]) {
    if (it < CV_NGU) { const int e = it / CV_GU, ii = it - e * CV_GU; const float* src = (e < NE) ? in[30] + (size_t)e * D * 512 : in[32];
        cvt_reg_load(src, 512, CVK * (ii >> 1), 256 * (ii & 1), lane, v); }
    else { const int r = it - CV_NGU, e = r / CV_DN, ii = r - e * CV_DN; const float* src = (e < NE) ? in[31] + (size_t)e * FF * D : in[33];
        cvt_reg_load(src, D, CVK * (ii >> 2), 256 * (ii & 3), lane, v); }
}
__device__ __forceinline__ void cvx_store(unsigned char* ws, int it, int lane, const f32x4 (&v)[CVK]) {
    if (it < CV_NGU) { const int e = it / CV_GU, ii = it - e * CV_GU; cvt_reg_store<1, true>((bf16*)(ws + WS_WGU), e * 512, D, CVK * (ii >> 1), 256 * (ii & 1), lane, v); }
    else { const int r = it - CV_NGU, e = r / CV_DN, ii = r - e * CV_DN; cvt_reg_store<0, true>((bf16*)(ws + WS_WD), e * D, FF, CVK * (ii >> 2), 256 * (ii & 3), lane, v); }
}

typedef float f32x2v __attribute__((ext_vector_type(2)));
constexpr int CY_GU = (D / 32) * 4, CY_DN = (FF / 32) * 8, CY_NGU = (NE + 1) * CY_GU, CY_NITEM = CY_NGU + (NE + 1) * CY_DN;
#define CY_KB_GU(ii) ((((ii) >> 4) << 2) | ((ii) & 3))
#define CY_NB_GU(ii) (((ii) >> 2) & 3)
#define CY_KB_DN(ii) ((((ii) >> 5) << 2) | ((ii) & 3))
#define CY_NB_DN(ii) (((ii) >> 2) & 7)
__device__ __forceinline__ void cvy_load(const float* const* in, int it, int lane, f32x2v (&v)[32]) {
    const float* p;  int Nsrc;
    if (it < CY_NGU) { const int e = it / CY_GU, ii = it - e * CY_GU; const float* src = (e < NE) ? in[30] + (size_t)e * D * 512 : in[32]; Nsrc = 512; p = src + (size_t)(32 * CY_KB_GU(ii)) * 512 + 128 * CY_NB_GU(ii) + 2 * lane; }
    else { const int r = it - CY_NGU, e = r / CY_DN, ii = r - e * CY_DN; const float* src = (e < NE) ? in[31] + (size_t)e * FF * D : in[33]; Nsrc = D; p = src + (size_t)(32 * CY_KB_DN(ii)) * D + 128 * CY_NB_DN(ii) + 2 * lane; }
#pragma unroll
    for (int i = 0; i < 32; ++i) v[i] = __builtin_nontemporal_load((const f32x2v*)(p + (size_t)i * Nsrc));
}
__device__ __forceinline__ void cvy_store(unsigned char* ws, int it, int lane, const f32x2v (&v)[32]) {
    unsigned char* base; int dpitch, n0; bool gu = it < CY_NGU;
    if (gu) { const int e = it / CY_GU, ii = it - e * CY_GU; base = ws + WS_WGU + (size_t)(e * 512) * D + 32 * CY_KB_GU(ii); dpitch = D; n0 = 128 * CY_NB_GU(ii); }
    else { const int r = it - CY_NGU, e = r / CY_DN, ii = r - e * CY_DN; base = ws + WS_WD + (size_t)(e * D) * FF + 32 * CY_KB_DN(ii); dpitch = FF; n0 = 128 * CY_NB_DN(ii); }
#pragma unroll
    for (int j = 0; j < 2; ++j) {
        const int ng = n0 + 2 * lane + j; int dr = ng;
        if (gu) { const int i2 = ng & 255; dr = 8 * (i2 >> 2) + (i2 & 3) + ((ng >= 256) ? 4 : 0); }
        v4u* dst8 = (v4u*)(base + (size_t)dr * dpitch);
#pragma unroll
        for (int q = 0; q < 2; ++q) { v4u o;
            o.x = pack_fp8x4((f32x4){v[16 * q][j], v[16 * q + 1][j], v[16 * q + 2][j], v[16 * q + 3][j]} * W8S); o.y = pack_fp8x4((f32x4){v[16 * q + 4][j], v[16 * q + 5][j], v[16 * q + 6][j], v[16 * q + 7][j]} * W8S);
            o.z = pack_fp8x4((f32x4){v[16 * q + 8][j], v[16 * q + 9][j], v[16 * q + 10][j], v[16 * q + 11][j]} * W8S); o.w = pack_fp8x4((f32x4){v[16 * q + 12][j], v[16 * q + 13][j], v[16 * q + 14][j], v[16 * q + 15][j]} * W8S); dst8[q] = o; }
    }
}
#define CVY_FLUSH() do { if (cpend >= 0) cvy_store(F.ws, cpend, lane, cv); cpend = -1; } while (0)
#define CVY_START(item) do { if ((item) < CY_NITEM) { cvy_load(F.in, (item), lane, cv); cpend = (item); } } while (0)

#if MS >= 3
__device__ __forceinline__ float lora_val(const float* const* in, int n, int k) {
    if (n < 1024) { const int q = n >> 3, e8 = n & 7, dir = e8 >> 2, ch = q * 4 + (e8 & 3); return (k < 32) ? in[9][(size_t)(dir * 32 + k) * 512 + ch] : 0.f; }
    if (n < 2048) { const int m = n - 1024, q = m >> 3, e8 = m & 7, dir = e8 >> 2, ch = q * 4 + (e8 & 3); return (k >= 32 && k < 64) ? in[11][(size_t)(dir * 32 + (k - 32)) * 512 + ch] : 0.f; }
    if (n < 2560) { const int ch = n - 2048; return (k >= 64 && k < 160) ? in[12][(size_t)(k - 64) * 512 + ch] : 0.f; }
    { const int m = n - 2560, q = m >> 3, e8 = m & 7, dir = e8 >> 2, ch = q * 4 + (e8 & 3); return (k >= 160 && k < 176) ? in[19][(size_t)(dir * 16 + (k - 160)) * 256 + ch] : 0.f; }
}
#endif

__device__ __forceinline__ void ph_prologue(Frame& F) {
    {
        const float* c = F.in[1]; const float* cc = F.in[3]; const float* wa = F.in[4]; const float* ba = F.in[5];
        float* MOD = (float*)(F.ws + WS_MOD);
        LAS float* S = (LAS float*)F.lds; LAS float* red = (LAS float*)(F.lds + 32768);
        for (int it = blockIdx.x; it < 96; it += F.G) {
            for (int i = F.tid; i < 5120; i += NTHR) { const int r = i >> 10, k = i & 1023; const float cv = r < 4 ? c[r * 1024 + k] : cc[k]; S[i] = siluf_(cv); }
            __syncthreads();
            const int n = it * 64 + F.lane; float acc[5] = {0.f, 0.f, 0.f, 0.f, 0.f};
            for (int kk = 0; kk < 128; ++kk) { const int k = F.wave * 128 + kk; const float wv = wa[(size_t)k * 6144 + n];
#pragma unroll
                for (int r = 0; r < 5; ++r) acc[r] += S[r * 1024 + k] * wv; }
#pragma unroll
            for (int r = 0; r < 5; ++r) red[(F.wave * 5 + r) * 64 + F.lane] = acc[r];
            __syncthreads();
            if (F.wave == 0) {
#pragma unroll
                for (int r = 0; r < 5; ++r) { float s = 0.f;
#pragma unroll
                    for (int w = 0; w < 8; ++w) s += red[(w * 5 + r) * 64 + F.lane];
                    MOD[r * 6144 + n] = s + ba[n]; }
            }
            __syncthreads();
        }
    }
    {
        LAS float* scr = (LAS float*)(F.lds + F.wave * 16384);
        constexpr int I_IN = 16 * 168, I_BR = 8 * 32, I_OUT = 16 * 32, I_RT = 16 * 8, I_GU = 32 * 2, I_DN = 8 * 4;
        constexpr int T0 = I_IN, T1 = T0 + I_BR, T2 = T1 + I_BR, T3 = T2 + I_OUT, T4 = T3 + I_RT, T5 = T4 + (NE + 1) * I_GU, T6 = T5 + (NE + 1) * I_DN;
        unsigned char* ws = F.ws;
        for (int it = F.gw; it < T6; it += F.NGW) {
#if MS >= 3
            if (it < T0) { cvt_item<0, true>(F.in[6], IN_COLS, 168, (bf16*)(ws + WS_WIN), 0, D, scr, it, F.lane); continue; }
            if (it < T1) { cvt_item<0>(F.in[23], D, 32, (bf16*)(ws + WS_WBRRW), 0, RWW, scr, it - T0, F.lane); continue; }
            if (it < T2) { cvt_item<0>(F.in[24], D, 32, (bf16*)(ws + WS_WBRGLA), 0, RWW, scr, it - T1, F.lane); continue; }
            if (it < T3) { cvt_item<0>(F.in[25], D, 32, (bf16*)(ws + WS_WOUT), 0, D, scr, it - T2, F.lane); continue; }
#else
            if (it < T3) continue;
#endif
            if (it < T4) { cvt_item<0>(F.in[28], NE, 8, (bf16*)(ws + WS_WROUTER), 0, D, scr, it - T3, F.lane); continue; }
#if MS >= 3
            break;
#endif
            if (it < T5) { const int r = it - T4, e = r / I_GU, ii = r - e * I_GU;
                const float* src = (e < NE) ? F.in[30] + (size_t)e * D * 512 : F.in[32];
                cvt_item_reg<1>(src, 512, (bf16*)(ws + WS_WGU), e * 512, D, 32 * (ii >> 1), 256 * (ii & 1), F.lane); continue; }
            { const int r = it - T5, e = r / I_DN, ii = r - e * I_DN;
                const float* src = (e < NE) ? F.in[31] + (size_t)e * FF * D : F.in[33];
                cvt_item_reg<0>(src, D, (bf16*)(ws + WS_WD), e * D, FF, 32 * (ii >> 2), 256 * (ii & 3), F.lane); }
        }
    }
#if MS >= 3
    {
        bf16* WL = (bf16*)(F.ws + WS_WLORA);
        for (int idx = blockIdx.x * NTHR + F.tid; idx < NLORA * (KLORA / 8); idx += F.G * NTHR) {
            const int n = idx >> 5, k0 = (idx & 31) * 8; float v[8];
#pragma unroll
            for (int e = 0; e < 8; ++e) v[e] = lora_val(F.in, n, k0 + e);
            v4u o; o.x = pk2(v[0], v[1]); o.y = pk2(v[2], v[3]); o.z = pk2(v[4], v[5]); o.w = pk2(v[6], v[7]);
            *(v4u*)(WL + (size_t)n * KLORA + k0) = o;
        }
    }
#endif
}

struct EpiF32 {
    static constexpr bool PERM = false;
    float* C; int ldc;
    __device__ __forceinline__ void operator()(const f32x4 (&acc)[2][2][4][2], const pg8::Unit& u, int wr, int wc, int fr, int fq) const {
        const int row0 = u.pm * 256 + wr * 64 + fr, col0 = u.pn * 256 + wc * 32 + 4 * fq;
#pragma unroll
        for (int ai = 0; ai < 2; ++ai)
#pragma unroll
            for (int m = 0; m < 4; ++m) { float* rowp = C + (size_t)(row0 + ai * 128 + m * 16) * ldc + col0;
#pragma unroll
                for (int bj = 0; bj < 2; ++bj)
#pragma unroll
                    for (int n = 0; n < 2; ++n) *(f32x4*)(rowp + bj * 128 + n * 16) = acc[ai][bj][m][n]; }
    }
};
struct EpiSwiglu {
    static constexpr bool PERM = true;
    unsigned char* ACT;
    __device__ __forceinline__ void operator()(const f32x4 (&acc)[2][2][4][2], const pg8::Unit& u, int wr, int wc, int fr, int fq) const {
        const int row0 = u.pm * 256 + wr * 64 + fr, h0 = u.j * 128 + wc * 16 + 4 * fq;
#pragma unroll
        for (int ai = 0; ai < 2; ++ai)
#pragma unroll
            for (int m = 0; m < 4; ++m) { unsigned char* rowp = ACT + (size_t)(row0 + ai * 128 + m * 16) * FF + h0;
#pragma unroll
                for (int bj = 0; bj < 2; ++bj) { const f32x4 a = acc[ai][bj][m][0] * W8I, b = acc[ai][bj][m][1] * W8I;
                    *(unsigned*)(rowp + bj * 64) = pack_fp8x4((f32x4){siluf_(a[0]) * b[0], siluf_(a[1]) * b[1], siluf_(a[2]) * b[2], siluf_(a[3]) * b[3]}); } }
    }
};
struct EpiRowsBf16 {
    static constexpr bool PERM = true;
    bf16* O; int ldc; float sc;
    __device__ __forceinline__ void operator()(const f32x4 (&acc)[2][2][4][2], const pg8::Unit& u, int wr, int wc, int fr, int fq) const {
        const int row0 = u.pm * 256 + wr * 64 + fr, col0 = u.j * 256 + wc * 32 + 8 * fq;
#pragma unroll
        for (int ai = 0; ai < 2; ++ai)
#pragma unroll
            for (int m = 0; m < 4; ++m) { bf16* rowp = O + (size_t)(row0 + ai * 128 + m * 16) * ldc + col0;
#pragma unroll
                for (int bj = 0; bj < 2; ++bj) { const f32x4 v0 = acc[ai][bj][m][0] * sc, v1 = acc[ai][bj][m][1] * sc;
                    v4u w; w.x = pg8::cvt_pk_bf16(v0[0], v0[1]); w.y = pg8::cvt_pk_bf16(v0[2], v0[3]); w.z = pg8::cvt_pk_bf16(v1[0], v1[1]); w.w = pg8::cvt_pk_bf16(v1[2], v1[3]);
                    *(v4u*)(rowp + bj * 128) = w;
#ifdef PROBE_ST2
                    asm volatile("" ::: "memory"); *(volatile v4u*)(rowp + bj * 128) = w;
#endif
                    } }
    }
};

struct EpiRowsFp8 {
    static constexpr bool PERM = true;
    unsigned char* O;
    __device__ __forceinline__ void operator()(const f32x4 (&acc)[2][2][4][2], const pg8::Unit& u, int wr, int wc, int fr, int fq) const {
        const int row0 = u.pm * 256 + wr * 64 + fr, col0 = u.j * 256 + wc * 32 + 8 * fq;
#pragma unroll
        for (int ai = 0; ai < 2; ++ai)
#pragma unroll
            for (int m = 0; m < 4; ++m) { unsigned char* rowp = O + (size_t)(row0 + ai * 128 + m * 16) * D + col0;
#pragma unroll
                for (int bj = 0; bj < 2; ++bj) { f32x4 v0 = acc[ai][bj][m][0] * (16.0f * W8I), v1 = acc[ai][bj][m][1] * (16.0f * W8I);
#pragma unroll
                    for (int e = 0; e < 4; ++e) { v0[e] = __builtin_amdgcn_fmed3f(v0[e], -448.0f, 448.0f); v1[e] = __builtin_amdgcn_fmed3f(v1[e], -448.0f, 448.0f); }
                    int w0 = __builtin_amdgcn_cvt_pk_fp8_f32(v0[0], v0[1], 0, false); w0 = __builtin_amdgcn_cvt_pk_fp8_f32(v0[2], v0[3], w0, true);
                    int w1 = __builtin_amdgcn_cvt_pk_fp8_f32(v1[0], v1[1], 0, false); w1 = __builtin_amdgcn_cvt_pk_fp8_f32(v1[2], v1[3], w1, true);
                    v2u w; w.x = (unsigned)w0; w.y = (unsigned)w1; *(v2u*)(rowp + bj * 128) = w; } }
    }
};

__device__ __forceinline__ void ph_router(Frame& F) {
    pg8::Gemm g{(const bf16*)(F.ws + WS_A3), (const bf16*)(F.ws + WS_WROUTER), NLAT, NE, D, nullptr};
    pg8::StaticOrder S; S.init(NLAT, NE, F.G, (int)blockIdx.x);
    EpiF32 E{(float*)(F.ws + WS_LOGITS), NE};
    pg8::gemm_phase<EpiF32, pg8::StaticOrder, true, true, false>(F.lds, g, S, E);
}

#define RT_DPP(x, ctrl) __builtin_amdgcn_update_dpp(0, (x), (ctrl), 0xf, 0xf, false)
__device__ __forceinline__ unsigned wave_max_u32(unsigned k) {
    k = max(k, (unsigned)RT_DPP((int)k, 0xB1)); k = max(k, (unsigned)RT_DPP((int)k, 0x4E));
    k = max(k, (unsigned)RT_DPP((int)k, 0x124)); k = max(k, (unsigned)RT_DPP((int)k, 0x128));
    const unsigned a = (unsigned)__builtin_amdgcn_readlane((int)k, 0), b = (unsigned)__builtin_amdgcn_readlane((int)k, 16), c = (unsigned)__builtin_amdgcn_readlane((int)k, 32), d = (unsigned)__builtin_amdgcn_readlane((int)k, 48);
    return max(max(a, b), max(c, d));
}
__device__ __forceinline__ void ph_route(Frame& F) {
    const float* LOG = (const float*)(F.ws + WS_LOGITS); const float* rb = F.in[29];
    int* EIDX = (int*)(F.ws + WS_EIDX); float* GATE = (float*)(F.ws + WS_GATE); int* DEST = (int*)(F.ws + WS_DEST);
    unsigned* CNT = F.ctl + CW_CNT;
    const f32x4 bias = *(const f32x4*)(rb + 4 * F.lane);
    f32x4 lgn = *(const f32x4*)(LOG + (size_t)(F.gw < NLAT ? F.gw : 0) * NE + 4 * F.lane);
    for (int m = F.gw; m < NLAT; m += F.NGW) {
        const f32x4 lg = lgn;
        { const int mn = (m + F.NGW < NLAT) ? m + F.NGW : m; lgn = *(const f32x4*)(LOG + (size_t)mn * NE + 4 * F.lane); }
        float sc[4], sel[4];
#pragma unroll
        for (int i = 0; i < 4; ++i) { sc[i] = sigmoidf_(lg[i]); sel[i] = sc[i] + bias[i]; }
        float m1 = fmaxf(sel[0], sel[1]), m2 = fminf(sel[0], sel[1]);
        { const float a = sel[2]; const float n1 = fmaxf(m1, a); m2 = fmaxf(m2, fminf(m1, a)); m1 = n1; }
        { const float a = sel[3]; const float n1 = fmaxf(m1, a); m2 = fmaxf(m2, fminf(m1, a)); m1 = n1; }
#define RT_MERGE(ctrl) do { const float b1 = __builtin_bit_cast(float, RT_DPP(__builtin_bit_cast(int, m1), ctrl)), b2 = __builtin_bit_cast(float, RT_DPP(__builtin_bit_cast(int, m2), ctrl)); \
            const float n1 = fmaxf(m1, b1); m2 = fmaxf(fminf(m1, b1), fmaxf(m2, b2)); m1 = n1; } while (0)
        RT_MERGE(0xB1); RT_MERGE(0x4E); RT_MERGE(0x141);
#undef RT_MERGE
        const float gs = m1 + m2; const int g = F.lane >> 3;
        int rank = 0;
#pragma unroll
        for (int gg = 0; gg < 8; ++gg) { const float og = __builtin_bit_cast(float, __builtin_amdgcn_readlane(__builtin_bit_cast(int, gs), gg * 8)); rank += (og > gs || (og == gs && gg < g)) ? 1 : 0; }
        const bool keep = rank < 4;
        unsigned key[4];
#pragma unroll
        for (int i = 0; i < 4; ++i) { unsigned u = __builtin_bit_cast(unsigned, sel[i]); u ^= (u >> 31) ? 0xffffffffu : 0x80000000u;
            key[i] = keep ? ((u & 0xffffff00u) | (unsigned)(255 - (4 * F.lane + i))) : 0u; }
        int my_e = 0; float my_s = 0.f; float ssum = 0.f;
#pragma unroll
        for (int k = 0; k < TOPK; ++k) {
            const unsigned best = wave_max_u32(max(max(key[0], key[1]), max(key[2], key[3])));
            const int e = 255 - (int)(best & 255u), owner = e >> 2;
            float s_own = 0.f;
#pragma unroll
            for (int i = 0; i < 4; ++i) if (key[i] == best) { s_own = sc[i]; key[i] = 0u; }
            const float s = __builtin_bit_cast(float, __builtin_amdgcn_readlane(__builtin_bit_cast(int, s_own), owner));
            ssum += s;
            if (F.lane == k) { my_e = e; my_s = s; }
        }
        if (F.lane < TOPK) {
            const unsigned pos = __hip_atomic_fetch_add(CNT + my_e * CNT_STRIDE, 1u, __ATOMIC_RELAXED, __HIP_MEMORY_SCOPE_AGENT);
            EIDX[m * 8 + F.lane] = my_e; GATE[m * 8 + F.lane] = my_s * __builtin_amdgcn_rcpf(ssum) * 2.5f; DEST[m * 8 + F.lane] = (int)pos;
        }
    }
}
#undef RT_DPP

__device__ __forceinline__ void ph_scatter(Frame& F) {
    LAS int* tstart = (LAS int*)F.lds;
    LAS int* scan = (LAS int*)(F.lds + 2048);
    LAS int* cnts = (LAS int*)(F.lds + 4096);
    int* EIDX = (int*)(F.ws + WS_EIDX); int* DEST = (int*)(F.ws + WS_DEST); int* ROWTOK = (int*)(F.ws + WS_ROWTOK); int* TILE_E = (int*)(F.ws + WS_TILE_E);
    unsigned* CNT = F.ctl + CW_CNT;
    int tiles = 0, cnt = 0;
    if (F.tid < NE) { cnt = (int)__hip_atomic_load(CNT + F.tid * CNT_STRIDE, __ATOMIC_RELAXED, __HIP_MEMORY_SCOPE_AGENT); tiles = (cnt + 255) >> 8; scan[F.tid] = tiles; cnts[F.tid] = cnt; }
    __syncthreads();
    for (int o = 1; o < NE; o <<= 1) { int v = 0; if (F.tid < NE && F.tid >= o) v = scan[F.tid - o]; __syncthreads(); if (F.tid < NE) scan[F.tid] += v; __syncthreads(); }
    if (F.tid < NE) { tstart[F.tid + 1] = scan[F.tid]; if (F.tid == 0) tstart[0] = 0; }
    __syncthreads();
    const int NT = tstart[NE];
    if (blockIdx.x == 0) {
        if (F.tid == 0) F.ctl[CW_NT] = (unsigned)NT;
        if (F.tid < NE) for (int t = tstart[F.tid]; t < tstart[F.tid + 1]; ++t) TILE_E[t] = F.tid;
    }
    for (int e = blockIdx.x; e < NE; e += F.G) { const int c0 = cnts[e], c1 = (tstart[e + 1] - tstart[e]) * 256, base = tstart[e] * 256;
        for (int p = c0 + F.tid; p < c1; p += NTHR) ROWTOK[base + p] = 0; }
    for (int i = blockIdx.x * NTHR + F.tid; i < NLAT; i += F.G * NTHR) ROWTOK[SH_ROW0 + i] = i;
    for (int i = blockIdx.x * NTHR + F.tid; i < NLAT * TOPK; i += F.G * NTHR) {
        const int e = EIDX[i], pos = DEST[i]; const int dr = tstart[e] * 256 + pos;
        DEST[i] = dr; ROWTOK[dr] = i >> 3;
    }
}

__device__ __forceinline__ void ph_exp1(Frame& F) {
    const int NT = (int)__hip_atomic_load(F.ctl + CW_NT, __ATOMIC_RELAXED, __HIP_MEMORY_SCOPE_AGENT);
    pg8::Gemm g{(const bf16*)(F.ws + WS_A3F), (const bf16*)(F.ws + WS_WGU), 0, 0, D / 2, (const int*)(F.ws + WS_ROWTOK)};
    pg8::MoeOrder S{2, F.G, (int)blockIdx.x, NT, (const int*)(F.ws + WS_TILE_E)};
    EpiSwiglu E{F.ws + WS_ACT};
    pg8::gemm_phase<EpiSwiglu, pg8::MoeOrder, true, true, true, true>(F.lds, g, S, E);
}
__device__ __forceinline__ void ph_exp2(Frame& F) {
    const int NT = (int)__hip_atomic_load(F.ctl + CW_NT, __ATOMIC_RELAXED, __HIP_MEMORY_SCOPE_AGENT);
    pg8::Gemm g{(const bf16*)(F.ws + WS_ACT), (const bf16*)(F.ws + WS_WD), 0, 0, FF / 2, nullptr};
    pg8::MoeOrder S{4, F.G, (int)blockIdx.x, NT, (const int*)(F.ws + WS_TILE_E)};
    EpiRowsFp8 E{F.ws + WS_Y};
    pg8::gemm_phase<EpiRowsFp8, pg8::MoeOrder, true, true, false, true>(F.lds, g, S, E);
}
#endif

#if MS >= 3
__device__ __forceinline__ void unp8(const v4u w, float (&f)[8]) { f[0] = bflo(w.x); f[1] = bfhi(w.x); f[2] = bflo(w.y); f[3] = bfhi(w.y); f[4] = bflo(w.z); f[5] = bfhi(w.z); f[6] = bflo(w.w); f[7] = bfhi(w.w); }
__device__ __forceinline__ void unp8f8(const v2u w, float (&f)[8]) { const f32x2 a = __builtin_amdgcn_cvt_pk_f32_fp8((int)w.x, false), b = __builtin_amdgcn_cvt_pk_f32_fp8((int)w.x, true), c = __builtin_amdgcn_cvt_pk_f32_fp8((int)w.y, false), d = __builtin_amdgcn_cvt_pk_f32_fp8((int)w.y, true);
    f[0] = a.x; f[1] = a.y; f[2] = b.x; f[3] = b.y; f[4] = c.x; f[5] = c.y; f[6] = d.x; f[7] = d.y; }
__device__ __forceinline__ v4u pk8(const float (&f)[8]) { v4u o; o.x = pk2(f[0], f[1]); o.y = pk2(f[2], f[3]); o.z = pk2(f[4], f[5]); o.w = pk2(f[6], f[7]); return o; }
__device__ __forceinline__ void st8(float* p, const float (&f)[8]) { *(f32x4*)p = (f32x4){f[0], f[1], f[2], f[3]}; *(f32x4*)(p + 4) = (f32x4){f[4], f[5], f[6], f[7]}; }
__device__ __forceinline__ void ld8(const float* p, float (&f)[8]) { const f32x4 a = *(const f32x4*)p, b = *(const f32x4*)(p + 4); f[0] = a.x; f[1] = a.y; f[2] = a.z; f[3] = a.w; f[4] = b.x; f[5] = b.y; f[6] = b.z; f[7] = b.w; }

__device__ __forceinline__ void ph_a1(Frame& F) {
    const float* mod = (const float*)(F.ws + WS_MOD); unsigned char* A1 = F.ws + WS_A1;
    constexpr int NR = 4;
    for (int m0 = F.gw; m0 < MR; m0 += NR * F.NGW) {
        f32x4 xv[NR][4];
#pragma unroll
        for (int r = 0; r < NR; ++r) { const int mm = m0 + r * F.NGW; const int m = mm < MR ? mm : m0;
            const float* src = (m < NLAT) ? F.in[0] + (size_t)m * D : F.in[2] + (size_t)(m - NLAT) * D;
            const f32x4* xr = (const f32x4*)src + F.lane;
#pragma unroll
            for (int j = 0; j < 4; ++j) xv[r][j] = __builtin_nontemporal_load(xr + 64 * j); }
        __builtin_amdgcn_sched_barrier(0);
#pragma unroll
        for (int r = 0; r < NR; ++r) { const int mm = m0 + r * F.NGW; const int m = mm < MR ? mm : m0; const int mr = (m < NLAT) ? (m / SEQ) : 4;
            unsigned* ao = (unsigned*)(A1 + (size_t)m * D) + F.lane;
#pragma unroll
            for (int j = 0; j < 4; ++j) { const int c = 4 * F.lane + 256 * j;
                const f32x4 sh = *(const f32x4*)(mod + mr * 6144 + c), sc = *(const f32x4*)(mod + mr * 6144 + 1024 + c);
                const f32x4 h = xv[r][j] * (sc + 1.0f) + sh; ao[64 * j] = pack_fp8x4(h); } }
    }
}

__device__ __forceinline__ void ph_inproj(Frame& F) {
    pg8::Gemm g{(const bf16*)(F.ws + WS_A1), (const bf16*)(F.ws + WS_WIN), MR, NP, D / 2, nullptr};
    pg8::StaticOrder S; S.init(MR, NP, F.G, (int)blockIdx.x);
    EpiRowsBf16 E{(bf16*)(F.ws + WS_P), NP, W8I};
    pg8::gemm_phase<EpiRowsBf16, pg8::StaticOrder, true, true, false, true>(F.lds, g, S, E);
}

struct FeatOut { bf16 *R, *V, *KK, *KP, *QG, *KGB, *VGB, *A2; const float *mu, *kkw, *cw; };
__device__ __forceinline__ void feat_rw(const FeatOut& O, int p, size_t m, int lane, const v4u own_w, const v4u (&nbw)[4], const float (&muv)[8]) {
    float own[8], sh[4][8], val[8];
    unp8(own_w, own);
#pragma unroll
    for (int q = 0; q < 4; ++q) unp8(nbw[q], sh[q]);
#pragma unroll
    for (int e = 0; e < 8; ++e) val[e] = own[e] + muv[e] * (sh[e & 3][e] - own[e]);
    if (p == 0) *(v4u*)(O.R + m * RWW + 8 * lane) = pk8(val);
    else if (p == 2) *(v4u*)(O.V + m * RWW + 8 * lane) = pk8(val);
    else if (p == 1) {
        *(v4u*)(O.KP + m * RWW + 8 * lane) = pk8(val);
        float kw[8]; ld8(O.kkw + 8 * lane, kw); float kkv[8]; float ss = 0.f;
#pragma unroll
        for (int e = 0; e < 8; ++e) { kkv[e] = val[e] * kw[e]; ss += kkv[e] * kkv[e]; }
        ss += __shfl_xor(ss, 1); ss += __shfl_xor(ss, 2); ss += __shfl_xor(ss, 4);
        const float inv = 1.0f / fmaxf(sqrtf(ss), 1e-12f);
#pragma unroll
        for (int e = 0; e < 8; ++e) kkv[e] *= inv;
        *(v4u*)(O.KK + m * RWW + 8 * lane) = pk8(kkv);
    } else {
        float o[8];
#pragma unroll
        for (int e = 0; e < 8; ++e) o[e] = (lane < 4) ? tanhf_(val[e]) : ((lane < 8) ? val[e] : sigmoidf_(val[e]));
        *(v4u*)(O.A2 + m * KLORA + 8 * lane) = pk8(o);
    }
}
__device__ __forceinline__ void feat_gla_store(const FeatOut& O, int p, size_t m, int lane, const float (&acc)[8]) {
    const int cq = p * 512 + 8 * lane; float o[8];
#pragma unroll
    for (int e = 0; e < 8; ++e) o[e] = siluf_(acc[e]);
    if (p == 0) {
        if (lane < 32) {
#pragma unroll
            for (int e = 0; e < 8; ++e) o[e] *= 0.125f;
            *(v4u*)(O.QG + m * 256 + cq) = pk8(o);
        } else *(v4u*)(O.KGB + m * 256 + (cq - 256)) = pk8(o);
    } else *(v4u*)(O.VGB + m * RWW + (cq - 512)) = pk8(o);
}
__device__ __forceinline__ void ph_feat(Frame& F) {
    const bf16* P = (const bf16*)(F.ws + WS_P);
    FeatOut O{(bf16*)(F.ws + WS_RB), (bf16*)(F.ws + WS_VB), (bf16*)(F.ws + WS_KKB), (bf16*)(F.ws + WS_KMF), (bf16*)(F.ws + WS_QGB), (bf16*)(F.ws + WS_KGB), (bf16*)(F.ws + WS_VGB), (bf16*)(F.ws + WS_A2), F.in[7], F.in[13], F.in[18]};
    const v4u Z4 = (v4u){0u, 0u, 0u, 0u};
    for (int blk = F.gw; blk < NB * (GRIDH / 2) * (GRIDW / 2); blk += F.NGW) {
        int lane = F.lane; asm volatile("" : "+v"(lane));
        const int b = blk >> 11, r0 = 2 * ((blk >> 5) & 63), c0 = 2 * (blk & 31); const int mb = b * SEQ + r0 * GRIDW + c0;
        const bool vu = r0 > 0, vd = r0 + 2 < GRIDH, vl = c0 > 0, vr = c0 + 2 < GRIDW;
#pragma unroll
        for (int p = 0; p < 4; ++p) {
            const int cb = p * 512 + 8 * lane; const bool act = (p < 3) || lane < 20;
            v4u own[2][2], up[2], dn[2], lf[2], rt[2];
#pragma unroll
            for (int i = 0; i < 2; ++i) { up[i] = Z4; dn[i] = Z4; lf[i] = Z4; rt[i] = Z4; own[i][0] = Z4; own[i][1] = Z4; }
            if (act) {
#pragma unroll
                for (int i = 0; i < 2; ++i) {
#pragma unroll
                    for (int j = 0; j < 2; ++j) own[i][j] = *(const v4u*)(P + (size_t)(mb + 64 * i + j) * NP + cb);
                    if (vu) up[i] = *(const v4u*)(P + (size_t)(mb - 64 + i) * NP + cb);
                    if (vd) dn[i] = *(const v4u*)(P + (size_t)(mb + 128 + i) * NP + cb);
                    if (vl) lf[i] = *(const v4u*)(P + (size_t)(mb + 64 * i - 1) * NP + cb);
                    if (vr) rt[i] = *(const v4u*)(P + (size_t)(mb + 64 * i + 2) * NP + cb); }
            } else if (p == 3 && lane >= 20 && lane < 22) {
#pragma unroll
                for (int i = 0; i < 2; ++i)
#pragma unroll
                    for (int j = 0; j < 2; ++j) own[i][j] = *(const v4u*)(P + (size_t)(mb + 64 * i + j) * NP + C_PGL + 8 * (lane - 20));
            }
            float muv[8] = {0.f, 0.f, 0.f, 0.f, 0.f, 0.f, 0.f, 0.f}; if (act) ld8(O.mu + cb, muv);
            __builtin_amdgcn_sched_barrier(0);
#pragma unroll
            for (int i = 0; i < 2; ++i)
#pragma unroll
                for (int j = 0; j < 2; ++j) { const size_t m = (size_t)(mb + 64 * i + j);
                    if (act) { const v4u nbw[4] = {j == 0 ? lf[i] : own[i][0], j == 1 ? rt[i] : own[i][1], i == 0 ? up[j] : own[0][j], i == 1 ? dn[j] : own[1][j]};
                        feat_rw(O, p, m, lane, own[i][j], nbw, muv); }
                    else if (p == 3 && lane < 32) *(v4u*)(O.A2 + m * KLORA + 8 * lane) = own[i][j]; }
        }
#pragma unroll
        for (int p = 0; p < 2; ++p) {
            const int cq = p * 512 + 8 * lane, cb = C_Q + cq;
            v4u g[4][4];
#pragma unroll
            for (int a2 = 0; a2 < 4; ++a2)
#pragma unroll
                for (int b2 = 0; b2 < 4; ++b2) { const bool ok = (a2 == 0 ? vu : (a2 == 3 ? vd : true)) && (b2 == 0 ? vl : (b2 == 3 ? vr : true));
                    g[a2][b2] = Z4; if (ok) g[a2][b2] = *(const v4u*)(P + (size_t)(mb + 64 * (a2 - 1) + (b2 - 1)) * NP + cb); }
            __builtin_amdgcn_sched_barrier(0);
            float acc[2][2][8];
#pragma unroll
            for (int i = 0; i < 2; ++i)
#pragma unroll
                for (int j = 0; j < 2; ++j)
#pragma unroll
                    for (int e = 0; e < 8; ++e) acc[i][j][e] = 0.f;
#pragma unroll
            for (int dy = 0; dy < 3; ++dy)
#pragma unroll
                for (int dx = 0; dx < 3; ++dx) { float wv[8]; ld8(O.cw + (dy * 3 + dx) * 1024 + cq, wv);
#pragma unroll
                    for (int i = 0; i < 2; ++i)
#pragma unroll
                        for (int j = 0; j < 2; ++j) { float pv[8]; unp8(g[i + dy][j + dx], pv);
#pragma unroll
                            for (int e = 0; e < 8; ++e) acc[i][j][e] += pv[e] * wv[e]; } }
#pragma unroll
            for (int i = 0; i < 2; ++i)
#pragma unroll
                for (int j = 0; j < 2; ++j) feat_gla_store(O, p, (size_t)(mb + 64 * i + j), lane, acc[i][j]);
        }
    }
    for (int m = NLAT + F.gw; m < MR; m += F.NGW) {
        int lane = F.lane; asm volatile("" : "+v"(lane));
        const int t = (m - NLAT) & (CTXL - 1); const bool vp = t > 0, vn = t < CTXL - 1;
#pragma unroll
        for (int p = 0; p < 4; ++p) {
            const int cb = p * 512 + 8 * lane; const bool act = (p < 3) || lane < 20;
            if (act) { const v4u own = *(const v4u*)(P + (size_t)m * NP + cb); v4u pv = Z4, nv = Z4;
                if (vp) pv = *(const v4u*)(P + (size_t)(m - 1) * NP + cb); if (vn) nv = *(const v4u*)(P + (size_t)(m + 1) * NP + cb);
                float muv[8]; ld8(O.mu + cb, muv); const v4u nbw[4] = {pv, nv, pv, nv};
                feat_rw(O, p, (size_t)m, lane, own, nbw, muv); }
            else if (p == 3 && lane < 32) { v4u w = Z4; if (lane < 22) w = *(const v4u*)(P + (size_t)m * NP + C_PGL + 8 * (lane - 20)); *(v4u*)(O.A2 + (size_t)m * KLORA + 8 * lane) = w; }
        }
#pragma unroll
        for (int p = 0; p < 2; ++p) {
            const int cq = p * 512 + 8 * lane, cb = C_Q + cq; float acc[8] = {0.f, 0.f, 0.f, 0.f, 0.f, 0.f, 0.f, 0.f};
#pragma unroll
            for (int dx = -1; dx <= 1; ++dx) { const bool ok = (dx < 0) ? vp : ((dx > 0) ? vn : true);
                if (ok) { float pv[8], wv[8]; unp8(*(const v4u*)(P + (size_t)(m + dx) * NP + cb), pv); ld8(O.cw + (3 + dx + 1) * 1024 + cq, wv);
#pragma unroll
                    for (int e = 0; e < 8; ++e) acc[e] += pv[e] * wv[e]; } }
            feat_gla_store(O, p, (size_t)m, lane, acc);
        }
    }
}

struct EpiLora {
    static constexpr bool PERM = true;
    unsigned char* ws; const float* const* in;
    __device__ __forceinline__ void grp_w(const f32x4 (&acc)[2][2][4][2], int row0, int c0) const {
        bf16* Wf = (bf16*)(ws + WS_LWF); bf16* Wb = (bf16*)(ws + WS_LWB);
#pragma unroll
        for (int bj = 0; bj < 2; ++bj) { const int ch = (c0 + bj * 128) >> 1; const f32x4 w0f = *(const f32x4*)(in[8] + ch), w0b = *(const f32x4*)(in[8] + 512 + ch);
#pragma unroll
            for (int ai = 0; ai < 2; ++ai)
#pragma unroll
                for (int m = 0; m < 4; ++m) { const size_t row = (size_t)(row0 + ai * 128 + m * 16);
                    const f32x4 xf = acc[ai][bj][m][0] + w0f, xb = acc[ai][bj][m][1] + w0b; f32x4 df, db;
#pragma unroll
                    for (int e = 0; e < 4; ++e) { df[e] = -0.60653066f * sigmoidf_(xf[e]); db[e] = -0.60653066f * sigmoidf_(xb[e]); }
                    { v2u o; o.x = pk2(df[0], df[1]); o.y = pk2(df[2], df[3]); *(v2u*)(Wf + row * RWW + ch) = o; o.x = pk2(db[0], db[1]); o.y = pk2(db[2], db[3]); *(v2u*)(Wb + row * RWW + ch) = o; } } }
    }
    __device__ __forceinline__ void grp_a(const f32x4 (&acc)[2][2][4][2], int row0, int c0) const {
        bf16* KMf = (bf16*)(ws + WS_KMF); bf16* KMb = (bf16*)(ws + WS_KMB); bf16* BVf = (bf16*)(ws + WS_BVF); bf16* BVb = (bf16*)(ws + WS_BVB);
        const bf16* KK = (const bf16*)(ws + WS_KKB); bf16* KSUM = (bf16*)(ws + WS_KSUM);
#pragma unroll
        for (int bj = 0; bj < 2; ++bj) { const int ch = (c0 + bj * 128 - 1024) >> 1; const f32x4 a0f = *(const f32x4*)(in[10] + ch), a0b = *(const f32x4*)(in[10] + 512 + ch), ka = *(const f32x4*)(in[14] + ch);
#pragma unroll
            for (int ai = 0; ai < 2; ++ai) {
            v2u kpw[2][4], kkw[2][4];
#pragma unroll
                for (int m = 0; m < 4; ++m) { const size_t row = (size_t)(row0 + ai * 128 + m * 16); kpw[ai][m] = *(const v2u*)(KMf + row * RWW + ch); kkw[ai][m] = *(const v2u*)(KK + row * RWW + ch); }
            __builtin_amdgcn_sched_barrier(0);
#pragma unroll
                for (int m = 0; m < 4; ++m) { const size_t row = (size_t)(row0 + ai * 128 + m * 16);
                    const f32x4 xf = acc[ai][bj][m][0] + a0f, xb = acc[ai][bj][m][1] + a0b;
                    const f32x4 kp = (f32x4){bflo(kpw[ai][m].x), bfhi(kpw[ai][m].x), bflo(kpw[ai][m].y), bfhi(kpw[ai][m].y)}, kk = (f32x4){bflo(kkw[ai][m].x), bfhi(kkw[ai][m].x), bflo(kkw[ai][m].y), bfhi(kkw[ai][m].y)};
                    f32x4 kmf, kmb, bvf, bvb;
#pragma unroll
                    for (int e = 0; e < 4; ++e) { const float af = sigmoidf_(xf[e]), ab = sigmoidf_(xb[e]);
                        kmf[e] = kp[e] * (1.0f + (af - 1.0f) * ka[e]); kmb[e] = kp[e] * (1.0f + (ab - 1.0f) * ka[e]); bvf[e] = kk[e] * af; bvb[e] = kk[e] * ab; }
                    { v2u o; o.x = pk2(kmf[0], kmf[1]); o.y = pk2(kmf[2], kmf[3]); *(v2u*)(KMf + row * RWW + ch) = o; o.x = pk2(kmb[0], kmb[1]); o.y = pk2(kmb[2], kmb[3]); *(v2u*)(KMb + row * RWW + ch) = o;
                      o.x = pk2(bvf[0], bvf[1]); o.y = pk2(bvf[2], bvf[3]); *(v2u*)(BVf + row * RWW + ch) = o; o.x = pk2(bvb[0], bvb[1]); o.y = pk2(bvb[2], bvb[3]); *(v2u*)(BVb + row * RWW + ch) = o; }
                    v2u ks; ks.x = pk2(kmf[0] + kmb[0], kmf[1] + kmb[1]); ks.y = pk2(kmf[2] + kmb[2], kmf[3] + kmb[3]); *(v2u*)(KSUM + row * RWW + ch) = ks; } } }
    }
    __device__ __forceinline__ void grp_g(const f32x4 (&acc)[2][2][4][2], int row0, int c0) const {
        bf16* RWG = (bf16*)(ws + WS_RWG);
#pragma unroll
        for (int bj = 0; bj < 2; ++bj) { const int ch = c0 + bj * 128 - 2048;
#pragma unroll
            for (int ai = 0; ai < 2; ++ai)
#pragma unroll
                for (int m = 0; m < 4; ++m) { const size_t row = (size_t)(row0 + ai * 128 + m * 16); const f32x4 v0 = acc[ai][bj][m][0], v1 = acc[ai][bj][m][1];
                    v4u w; w.x = pk2(v0[0], v0[1]); w.y = pk2(v0[2], v0[3]); w.z = pk2(v1[0], v1[1]); w.w = pk2(v1[2], v1[3]); *(v4u*)(RWG + row * RWW + ch) = w; } }
    }
    __device__ __forceinline__ void grp_l(const f32x4 (&acc)[2][2][4][2], int row0, int c0) const {
        bf16* GAf = (bf16*)(ws + WS_LAF); bf16* GAb = (bf16*)(ws + WS_LAB);
#pragma unroll
        for (int bj = 0; bj < 2; ++bj) { const int ch = (c0 + bj * 128 - 2560) >> 1; const f32x4 gbf = *(const f32x4*)(in[20] + ch), gbb = *(const f32x4*)(in[20] + 256 + ch);
#pragma unroll
            for (int ai = 0; ai < 2; ++ai)
#pragma unroll
                for (int m = 0; m < 4; ++m) { const size_t row = (size_t)(row0 + ai * 128 + m * 16);
                    const f32x4 xf = acc[ai][bj][m][0] + gbf, xb = acc[ai][bj][m][1] + gbb; f32x4 af, ab;
#pragma unroll
                    for (int e = 0; e < 4; ++e) { const float lf = logsigmoidf_(xf[e]), lb = logsigmoidf_(xb[e]);
                        af[e] = lf * 0.0625f; ab[e] = lb * 0.0625f; }
                    { v2u o; o.x = pk2(af[0], af[1]); o.y = pk2(af[2], af[3]); *(v2u*)(GAf + row * 256 + ch) = o; o.x = pk2(ab[0], ab[1]); o.y = pk2(ab[2], ab[3]); *(v2u*)(GAb + row * 256 + ch) = o; } } }
    }
    __device__ __forceinline__ void operator()(const f32x4 (&acc)[2][2][4][2], const pg8::Unit& u, int wr, int wc, int fr, int fq) const {
        const int row0 = u.pm * 256 + wr * 64 + fr, c0 = u.pn * 256 + wc * 32 + 8 * fq;
        if (u.pn < 4) grp_w(acc, row0, c0); else if (u.pn < 8) grp_a(acc, row0, c0); else if (u.pn < 10) grp_g(acc, row0, c0); else grp_l(acc, row0, c0);
    }
};
__device__ __forceinline__ void ph_lora(Frame& F) {
    pg8::Gemm g{(const bf16*)(F.ws + WS_A2), (const bf16*)(F.ws + WS_WLORA), MR, NLORA, KLORA, nullptr};
    pg8::StaticOrder S; S.init(MR, NLORA, F.G, (int)blockIdx.x);
    EpiLora E{F.ws, F.in};
    pg8::gemm_phase<EpiLora, pg8::StaticOrder, true, true, false>(F.lds, g, S, E);
}

__device__ __forceinline__ void ph_merge(Frame& F) {
    unsigned char* ws = F.ws; const int lane = F.lane;
    const bf16* ORf = (const bf16*)(ws + WS_ORWF); const bf16* ORb = (const bf16*)(ws + WS_ORWB); const bf16* OGf = (const bf16*)(ws + WS_OGLF); const bf16* OGb = (const bf16*)(ws + WS_OGLB);
    const bf16* R = (const bf16*)(ws + WS_RB); const bf16* V = (const bf16*)(ws + WS_VB); const bf16* KSUM = (const bf16*)(ws + WS_KSUM); const bf16* RWG = (const bf16*)(ws + WS_RWG);
    const bf16* P = (const bf16*)(ws + WS_P);
    bf16* YRW = (bf16*)(ws + WS_YRW); bf16* YGLA = (bf16*)(ws + WS_YGLA);
    float rk[8], gw[8], gbv[8], ggw[8], ggb[8];
    ld8(F.in[15] + 8 * lane, rk); ld8(F.in[16] + 8 * lane, gw); ld8(F.in[17] + 8 * lane, gbv); ld8(F.in[21] + 8 * lane, ggw); ld8(F.in[22] + 8 * lane, ggb);
    for (int m0 = F.gw; m0 < NLAT; m0 += 2 * F.NGW) {
        const int m1 = (m0 + F.NGW < NLAT) ? m0 + F.NGW : m0;
        v4u wa[2], wb[2], wc[2], wd[2], wr[2], wv[2], wk[2], wg[2], wo[2];
#pragma unroll
        for (int r2 = 0; r2 < 2; ++r2) { const int m = r2 ? m1 : m0; const size_t ro = (size_t)m * RWW + 8 * lane;
            wa[r2] = *(const v4u*)(ORf + ro); wb[r2] = *(const v4u*)(ORb + ro); wc[r2] = *(const v4u*)(OGf + ro); wd[r2] = *(const v4u*)(OGb + ro);
            wr[r2] = *(const v4u*)(R + ro); wv[r2] = *(const v4u*)(V + ro); wk[r2] = *(const v4u*)(KSUM + ro); wg[r2] = *(const v4u*)(RWG + ro);
            wo[r2] = *(const v4u*)(P + (size_t)m * NP + C_OG + 8 * lane); }
#pragma unroll
        for (int r2 = 0; r2 < 2; ++r2) { const int m = r2 ? m1 : m0; const size_t ro = (size_t)m * RWW + 8 * lane;
        {
            float a[8], b[8], o[8]; unp8(wa[r2], a); unp8(wb[r2], b);
            float s = 0.f;
#pragma unroll
            for (int e = 0; e < 8; ++e) { o[e] = a[e] + b[e]; s += o[e]; }
            s += __shfl_xor(s, 1); s += __shfl_xor(s, 2); s += __shfl_xor(s, 4);
            const float mean = s * (1.f / 64.f); float q = 0.f;
#pragma unroll
            for (int e = 0; e < 8; ++e) { o[e] -= mean; q += o[e] * o[e]; }
            q += __shfl_xor(q, 1); q += __shfl_xor(q, 2); q += __shfl_xor(q, 4);
            const float rstd = __builtin_amdgcn_rsqf(q * (1.f / 64.f) + RW_GN_EPS);
            float r[8], v[8], ksm[8], g[8]; unp8(wr[r2], r); unp8(wv[r2], v); unp8(wk[r2], ksm); unp8(wg[r2], g);
            float bs = 0.f;
#pragma unroll
            for (int e = 0; e < 8; ++e) bs += r[e] * ksm[e] * rk[e];
            bs += __shfl_xor(bs, 1); bs += __shfl_xor(bs, 2); bs += __shfl_xor(bs, 4);
            float y[8];
#pragma unroll
            for (int e = 0; e < 8; ++e) y[e] = (o[e] * rstd * gw[e] + gbv[e] + bs * v[e]) * g[e];
            *(v4u*)(YRW + ro) = pk8(y);
        }
        {
            float a[8], b[8], o[8]; unp8(wc[r2], a); unp8(wd[r2], b);
            float s = 0.f;
#pragma unroll
            for (int e = 0; e < 8; ++e) { o[e] = a[e] + b[e]; s += o[e]; }
            s += __shfl_xor(s, 1); s += __shfl_xor(s, 2); s += __shfl_xor(s, 4); s += __shfl_xor(s, 8);
            const float mean = s * (1.f / 128.f); float q = 0.f;
#pragma unroll
            for (int e = 0; e < 8; ++e) { o[e] -= mean; q += o[e] * o[e]; }
            q += __shfl_xor(q, 1); q += __shfl_xor(q, 2); q += __shfl_xor(q, 4); q += __shfl_xor(q, 8);
            const float rstd = __builtin_amdgcn_rsqf(q * (1.f / 128.f) + LN_EPS);
            float og[8]; unp8(wo[r2], og);
            float y[8];
#pragma unroll
            for (int e = 0; e < 8; ++e) y[e] = (o[e] * rstd * ggw[e] + ggb[e]) * siluf_(og[e]);
            *(v4u*)(YGLA + ro) = pk8(y);
        }
        }
    }
}

template <int WHICH> struct EpiBranch {
    static constexpr bool PERM = true;
    bf16* Z; const bf16* P;
    __device__ __forceinline__ void operator()(const f32x4 (&acc)[2][2][4][2], const pg8::Unit& u, int wr, int wc, int fr, int fq) const {
        const int row0 = u.pm * 256 + wr * 64 + fr, col0 = u.pn * 256 + wc * 32 + 8 * fq;
#pragma unroll
        for (int ah = 0; ah < 4; ++ah) { const int ai = ah >> 1, mb = 2 * (ah & 1);
            v4u gw[2][2], zw[2][2];
#pragma unroll
            for (int m = 0; m < 2; ++m) { const size_t row = (size_t)(row0 + ai * 128 + (mb + m) * 16);
#pragma unroll
                for (int bj = 0; bj < 2; ++bj) { const int c = col0 + bj * 128;
                    gw[m][bj] = *(const v4u*)(P + row * NP + (WHICH ? C_GGLA : C_GRW) + c);
                    if (WHICH) zw[m][bj] = *(const v4u*)(Z + row * D + c); } }
            __builtin_amdgcn_sched_barrier(0);
#pragma unroll
            for (int m = 0; m < 2; ++m) { const size_t row = (size_t)(row0 + ai * 128 + (mb + m) * 16);
#pragma unroll
                for (int bj = 0; bj < 2; ++bj) { const int c = col0 + bj * 128;
                    float g[8]; unp8(gw[m][bj], g);
                    const f32x4 v0 = acc[ai][bj][mb + m][0], v1 = acc[ai][bj][mb + m][1];
                    float z[8];
#pragma unroll
                    for (int e = 0; e < 4; ++e) { z[e] = sigmoidf_(g[e]) * v0[e]; z[4 + e] = sigmoidf_(g[4 + e]) * v1[e]; }
                    if (WHICH) { float zo[8]; unp8(zw[m][bj], zo);
#pragma unroll
                        for (int e = 0; e < 8; ++e) z[e] += zo[e]; }
                    *(v4u*)(Z + row * D + c) = pk8(z); } }
        }
    }
};
__device__ __forceinline__ void ph_branch(Frame& F) {
    pg8::StaticOrder S; S.init(NLAT, D, F.G, (int)blockIdx.x);
    { pg8::Gemm g{(const bf16*)(F.ws + WS_YRW), (const bf16*)(F.ws + WS_WBRRW), NLAT, D, RWW, nullptr};
      EpiBranch<0> E{(bf16*)(F.ws + WS_Z), (const bf16*)(F.ws + WS_P)};
      pg8::gemm_phase<EpiBranch<0>, pg8::StaticOrder, true, true, false>(F.lds, g, S, E); }
    { pg8::Gemm g{(const bf16*)(F.ws + WS_YGLA), (const bf16*)(F.ws + WS_WBRGLA), NLAT, D, RWW, nullptr};
      EpiBranch<1> E{(bf16*)(F.ws + WS_Z), (const bf16*)(F.ws + WS_P)};
      pg8::gemm_phase<EpiBranch<1>, pg8::StaticOrder, true, true, false>(F.lds, g, S, E); }
}
struct EpiOut {
    static constexpr bool PERM = true;
    bf16* X1P; const float* x; const float* mod;
    __device__ __forceinline__ void operator()(const f32x4 (&acc)[2][2][4][2], const pg8::Unit& u, int wr, int wc, int fr, int fq) const {
        const int row0 = u.pm * 256 + wr * 64 + fr, col0 = u.pn * 256 + wc * 32 + 8 * fq; const float* g1 = mod + (u.pm / (SEQ / 256)) * 6144 + 2048;
        f32x4 gv[2][2];
#pragma unroll
        for (int bj = 0; bj < 2; ++bj)
#pragma unroll
            for (int n = 0; n < 2; ++n) gv[bj][n] = *(const f32x4*)(g1 + col0 + bj * 128 + 4 * n);
#pragma unroll
        for (int ah = 0; ah < 4; ++ah) { const int ai = ah >> 1, mb = 2 * (ah & 1);
            f32x4 xv[2][2][2];
#pragma unroll
            for (int m = 0; m < 2; ++m) { const size_t ro = (size_t)(row0 + ai * 128 + (mb + m) * 16) * D;
#pragma unroll
                for (int bj = 0; bj < 2; ++bj)
#pragma unroll
                    for (int n = 0; n < 2; ++n) xv[m][bj][n] = *(const f32x4*)(x + ro + col0 + bj * 128 + 4 * n); }
            __builtin_amdgcn_sched_barrier(0);
#pragma unroll
            for (int m = 0; m < 2; ++m) { const size_t ro = (size_t)(row0 + ai * 128 + (mb + m) * 16) * D;
#pragma unroll
                for (int bj = 0; bj < 2; ++bj) { const f32x4 a = xv[m][bj][0] * ALPHA + gv[bj][0] * acc[ai][bj][mb + m][0], b = xv[m][bj][1] * ALPHA + gv[bj][1] * acc[ai][bj][mb + m][1];
                    v4u w; w.x = pk2(a.x, a.y); w.y = pk2(a.z, a.w); w.z = pk2(b.x, b.y); w.w = pk2(b.z, b.w); *(v4u*)(X1P + ro + col0 + bj * 128) = w; } }
        }
    }
};
__device__ __forceinline__ void ph_outproj(Frame& F) {
    pg8::Gemm g{(const bf16*)(F.ws + WS_Z), (const bf16*)(F.ws + WS_WOUT), NLAT, D, D, nullptr};
    pg8::StaticOrder S; S.init(NLAT, D, F.G, (int)blockIdx.x);
    EpiOut E{(bf16*)(F.ws + WS_X1), F.in[0], (const float*)(F.ws + WS_MOD)};
    pg8::gemm_phase<EpiOut, pg8::StaticOrder, true, true, false>(F.lds, g, S, E);
}
#endif

#if MS >= 3
constexpr int LP = 72, SLOTB = 64 * LP * 2, LPF = 68, AUX_OFF = 13 * SLOTB;
static_assert(AUX_OFF + 4096 <= MISC_OFF, "scan LDS map");
#define SLOT(n) ((LAS bf16*)(lds + (n) * SLOTB))
__device__ __forceinline__ int scan_row(int s, int b, int dir) {
    if (s < CTXL) return NLAT + b * CTXL + (dir ? (CTXL - 1 - s) : s);
    const int lt = s - CTXL; return b * SEQ + (dir ? (SEQ - 1 - lt) : lt);
}
__device__ __forceinline__ unsigned pk2z(float x) { return pk2(x, 0.f); }
__device__ __forceinline__ float bf2f(bf16 h) { return __builtin_bit_cast(float, (unsigned)h << 16); }
__device__ __forceinline__ v2u pack4(const f32x4 v) { v2u o; o.x = pk2(v[0], v[1]); o.y = pk2(v[2], v[3]); return o; }
__device__ __forceinline__ float clamp8(float x) { return __builtin_amdgcn_fmed3f(x, -448.0f, 448.0f); }
__device__ __forceinline__ unsigned pack4_fp8(const f32x4 v) { int w = __builtin_amdgcn_cvt_pk_fp8_f32(clamp8(v[0]), clamp8(v[1]), 0, false); return (unsigned)__builtin_amdgcn_cvt_pk_fp8_f32(clamp8(v[2]), clamp8(v[3]), w, true); }
__device__ __forceinline__ f32x4 unpack4_fp8(unsigned w) { const f32x2 lo = __builtin_amdgcn_cvt_pk_f32_fp8((int)w, false), hi = __builtin_amdgcn_cvt_pk_f32_fp8((int)w, true); return (f32x4){lo.x, lo.y, hi.x, hi.y}; }
__device__ __forceinline__ f32x4 unpack4(const v2u w) { return (f32x4){bflo(w.x), bfhi(w.x), bflo(w.y), bfhi(w.y)}; }
__device__ __forceinline__ f32x4 mm_tile(const LAS bf16* X, int r0, const LAS bf16* Y, int c0, int lane) {
    const int rr = lane & 15, q = lane >> 4;
    const LAS bf16* xp = X + (r0 + rr) * LP + 8 * q; const LAS bf16* yp = Y + (c0 + rr) * LP + 8 * q;
    const bf16x8 a0 = *(const LAS bf16x8*)xp, a1 = *(const LAS bf16x8*)(xp + 32), b0 = *(const LAS bf16x8*)yp, b1 = *(const LAS bf16x8*)(yp + 32);
    f32x4 acc = (f32x4){0.f, 0.f, 0.f, 0.f};
    acc = __builtin_amdgcn_mfma_f32_16x16x32_bf16(a0, b0, acc, 0, 0, 0);
    acc = __builtin_amdgcn_mfma_f32_16x16x32_bf16(a1, b1, acc, 0, 0, 0);
    return acc;
}
__device__ __forceinline__ float red8(float x) {
    x += __builtin_bit_cast(float, __builtin_amdgcn_update_dpp(0, __builtin_bit_cast(int, x), 0x141, 0xf, 0xf, false));
    x += __builtin_bit_cast(float, __builtin_amdgcn_update_dpp(0, __builtin_bit_cast(int, x), 0xB1, 0xf, 0xf, false));
    x += __builtin_bit_cast(float, __builtin_amdgcn_update_dpp(0, __builtin_bit_cast(int, x), 0x4E, 0xf, 0xf, false));
    return x;
}

#define S1_BAR() do { asm volatile("s_waitcnt lgkmcnt(0)" ::: "memory"); __builtin_amdgcn_s_barrier(); asm volatile("" ::: "memory"); } while (0)
struct RwIn { bf16 lw[8], r[8], k[8], a[8], b[8], v[8]; };
__device__ __forceinline__ void s1_rwkv_load(Frame& F, int u, RwIn& I) {
    const int sr = u / NCHUNK, c = u - sr * NCHUNK, rb = sr >> 4, rdir = (sr >> 3) & 1, rh = sr & 7; unsigned char* ws = F.ws;
    const bf16* RBp = (const bf16*)(ws + WS_RB); const bf16* VBp = (const bf16*)(ws + WS_VB); const bf16* KKp = (const bf16*)(ws + WS_KKB);
    const bf16* KMp = (const bf16*)(ws + (rdir ? WS_KMB : WS_KMF)); const bf16* BVp = (const bf16*)(ws + (rdir ? WS_BVB : WS_BVF)); const bf16* LWp = (const bf16*)(ws + (rdir ? WS_LWB : WS_LWF));
#pragma unroll
    for (int i = 0; i < 8; ++i) { const int row = scan_row(c * CH + 8 * F.wave + i, rb, rdir); const size_t base = (size_t)row * RWW + rh * 64 + F.lane;
        I.lw[i] = LWp[base]; I.r[i] = RBp[base]; I.k[i] = KMp[base]; I.a[i] = KKp[base]; I.b[i] = BVp[base]; I.v[i] = VBp[base]; }
}
__device__ __forceinline__ void s1_rwkv(Frame& F, int u, const RwIn& I, int un, RwIn& Inext, f32x2v (&cv)[32], int& cpend, int cvi) {
    const int sr = u / NCHUNK, c = u - sr * NCHUNK;
    const bool emit = c >= CTXL / CH;
    LAS unsigned char* lds = F.lds; unsigned char* ws = F.ws;
    int lane_ = F.lane; asm volatile("" : "+v"(lane_));
    const int lane = lane_, wave = F.wave, rr = lane & 15, q = lane >> 4;
    LAS float* tot = (LAS float*)(lds + AUX_OFF); LAS float* gCs = tot + 512;
    {
        float lw[8], xr[8], xk[8], xa[8], xb[8], xv[8];
#pragma unroll
        for (int i = 0; i < 8; ++i) { lw[i] = bf2f(I.lw[i]); xr[i] = bf2f(I.r[i]); xk[i] = bf2f(I.k[i]); xa[i] = -bf2f(I.a[i]); xb[i] = bf2f(I.b[i]); xv[i] = bf2f(I.v[i]); }
        float p[8]; p[0] = lw[0];
#pragma unroll
        for (int i = 1; i < 8; ++i) p[i] = p[i - 1] + lw[i];
        tot[wave * 64 + lane] = p[7];
        S1_BAR();
        float off = 0.f, all = 0.f;
#pragma unroll
        for (int w = 0; w < 8; ++w) { const float t = tot[w * 64 + lane]; all += t; off += (w < wave) ? t : 0.f; }
        if (wave == 0) gCs[lane] = __expf(all);
        float at[8], bb[8], kb[8];
#pragma unroll
        for (int i = 0; i < 8; ++i) { const float cum = off + p[i]; const float g = __expf(cum), gi = __expf(-cum), gp = __expf(cum - lw[i]), gc = __expf(all - cum);
            const int t = 8 * wave + i;
            at[i] = xa[i] * gp; bb[i] = xb[i] * gc; kb[i] = xk[i] * gc;
            SLOT(0)[t * LP + lane] = (bf16)pk2z(at[i]);
            SLOT(1)[t * LP + lane] = (bf16)pk2z(xr[i] * g);
            SLOT(2)[t * LP + lane] = (bf16)pk2z(xb[i] * gi);
            SLOT(3)[t * LP + lane] = (bf16)pk2z(xk[i] * gi); }
        *(LAS v4u*)(SLOT(4) + lane * LP + 8 * wave) = pk8(at);
        *(LAS v4u*)(SLOT(5) + lane * LP + 8 * wave) = pk8(xv);
        *(LAS v4u*)(SLOT(6) + lane * LP + 8 * wave) = pk8(bb);
        *(LAS v4u*)(SLOT(7) + lane * LP + 8 * wave) = pk8(kb);
        S1_BAR();
    }
    if (wave < 4) s1_rwkv_load(F, un, Inext);
    LAS float* Lp = (LAS float*)(lds + 8 * SLOTB);
#pragma unroll
    for (int tix = 0; tix < 2; ++tix) { const int ti = 2 * wave + tix, r0 = 16 * (ti >> 2), c0 = 16 * (ti & 3), ci = c0 + rr;
        { const f32x4 acc = mm_tile(SLOT(2), r0, SLOT(0), c0, lane);
#pragma unroll
            for (int e = 0; e < 4; ++e) { const int i = r0 + 4 * q + e; Lp[ci * LPF + (i & 3) * 16 + (i >> 2)] = (i < ci) ? acc[e] : 0.f; } }
        { f32x4 acc = mm_tile(SLOT(0), r0, SLOT(3), c0, lane);
#pragma unroll
            for (int e = 0; e < 4; ++e) acc[e] = (ci < r0 + 4 * q + e) ? acc[e] : 0.f;
            *(LAS v2u*)(SLOT(10) + ci * LP + r0 + 4 * q) = pack4(acc); }
        if (emit) {
            { f32x4 acc = mm_tile(SLOT(2), r0, SLOT(1), c0, lane);
#pragma unroll
                for (int e = 0; e < 4; ++e) acc[e] = (r0 + 4 * q + e <= ci) ? acc[e] : 0.f;
                *(LAS v2u*)(SLOT(11) + ci * LP + r0 + 4 * q) = pack4(acc); }
            { f32x4 acc = mm_tile(SLOT(3), r0, SLOT(1), c0, lane);
#pragma unroll
                for (int e = 0; e < 4; ++e) acc[e] = (r0 + 4 * q + e <= ci) ? acc[e] : 0.f;
                *(LAS v2u*)(SLOT(12) + ci * LP + r0 + 4 * q) = pack4(acc); }
        }
    }
    S1_BAR();
    if (wave < 4) {
        const int j = 16 * wave + (lane >> 2), s = lane & 3;
        float Tr[16];
#pragma unroll
        for (int m = 0; m < 16; ++m) Tr[m] = 0.f;
        const LAS float* lrow = Lp + s * 16;
        f32x4 lb[3][4];
#pragma unroll
        for (int t = 0; t < 2; ++t) lb[t][0] = *(const LAS f32x4*)(lrow + t * LPF);
#pragma unroll
        for (int t = 0; t < 64; ++t) {
            if (t + 2 < 64) {
#pragma unroll
                for (int k = 0; k < 4; ++k) if (4 * k <= (t + 2) / 4) lb[(t + 2) % 3][k] = *(const LAS f32x4*)(lrow + (t + 2) * LPF + 4 * k);
            }
            __builtin_amdgcn_sched_barrier(0);
            float acc0 = 0.f, acc1 = 0.f;
#pragma unroll
            for (int m = 0; m < 16; ++m) if (m <= t / 4) { const float lv = lb[t % 3][m >> 2][m & 3]; if (m & 1) acc1 += lv * Tr[m]; else acc0 += lv * Tr[m]; }
            float acc = acc0 + acc1;
            acc += __builtin_bit_cast(float, __builtin_amdgcn_update_dpp(0, __builtin_bit_cast(int, acc), 0xB1, 0xf, 0xf, false));
            acc += __builtin_bit_cast(float, __builtin_amdgcn_update_dpp(0, __builtin_bit_cast(int, acc), 0x4E, 0xf, 0xf, false));
            int jj = j, ss = s; asm volatile("" : "+v"(jj), "+v"(ss));
            const float val = acc + ((t == jj) ? 1.f : 0.f);
            Tr[t >> 2] = (ss == (t & 3)) ? val : Tr[t >> 2];
            SLOT(0)[t * LP + j] = (bf16)pk2z(val);
        }
    } else { CVY_FLUSH(); s1_rwkv_load(F, un, Inext); CVY_START(cvi); }
    S1_BAR();
#pragma unroll
    for (int tix = 0; tix < 2; ++tix) { const int ti = 2 * wave + tix, r0 = 16 * (ti >> 2), c0 = 16 * (ti & 3), ci = c0 + rr;
        { const f32x4 acc = mm_tile(SLOT(0), r0, SLOT(4), c0, lane); *(LAS v2u*)(SLOT(2) + ci * LP + r0 + 4 * q) = pack4(acc); }
        { const f32x4 acc = mm_tile(SLOT(0), r0, SLOT(10), c0, lane); *(LAS v2u*)(SLOT(3) + ci * LP + r0 + 4 * q) = pack4(acc); }
    }
    S1_BAR();
    unsigned char* RH = ws + WS_RH + (size_t)u * 4096; bf16* GT = (bf16*)((unsigned char*)F.out + OUT_GT) + (size_t)u * 4096;
#pragma unroll
    for (int tix = 0; tix < 2; ++tix) { const int ti = 2 * wave + tix, tr = ti >> 2, r0 = 16 * tr, c0 = 16 * (ti & 3), ci = c0 + rr;
        const int pos = (tr >> 1) * 32 + q * 8 + 4 * (tr & 1);
        if (emit) {
            { f32x4 acc = mm_tile(SLOT(2), r0, SLOT(11), c0, lane);
                acc += unpack4(*(const LAS v2u*)(SLOT(1) + ci * LP + r0 + 4 * q));
                *(unsigned*)(RH + ci * 64 + pos) = pack4_fp8(acc); }
            { f32x4 acc = mm_tile(SLOT(3), r0, SLOT(11), c0, lane);
                acc += unpack4(*(const LAS v2u*)(SLOT(12) + ci * LP + r0 + 4 * q));
                *(LAS v2u*)(SLOT(4) + ci * LP + r0 + 4 * q) = pack4(acc); }
        }
        { f32x4 acc = mm_tile(SLOT(2), r0, SLOT(6), c0, lane);
            const float gc = gCs[ci];
#pragma unroll
            for (int e = 0; e < 4; ++e) acc[e] += (r0 + 4 * q + e == ci) ? gc : 0.f;
            *(v2u*)(GT + ci * 64 + pos) = pack4(acc); }
    }
    S1_BAR();
    unsigned char* YL = ws + WS_YL + (size_t)u * 4096;
#pragma unroll
    for (int tix = 0; tix < 2; ++tix) { const int ti = 2 * wave + tix, r0 = 16 * (ti >> 2), c0 = 16 * (ti & 3), ci = c0 + rr;
        if (emit) { const f32x4 acc = mm_tile(SLOT(5), r0, SLOT(4), c0, lane); *(unsigned*)(YL + ci * 64 + r0 + 4 * q) = pack4_fp8(acc); }
        { f32x4 acc = mm_tile(SLOT(3), r0, SLOT(6), c0, lane);
            acc += unpack4(*(const LAS v2u*)(SLOT(7) + ci * LP + r0 + 4 * q));
            *(LAS v2u*)(SLOT(8) + ci * LP + r0 + 4 * q) = pack4(acc); }
    }
    S1_BAR();
    bf16* HH = (bf16*)(ws + WS_HH) + (size_t)u * 4096;
#pragma unroll
    for (int tix = 0; tix < 2; ++tix) { const int ti = 2 * wave + tix, r0 = 16 * (ti >> 2), c0 = 16 * (ti & 3), ci = c0 + rr;
        const f32x4 acc = mm_tile(SLOT(8), r0, SLOT(5), c0, lane);
        *(v2u*)(HH + ci * 64 + r0 + 4 * q) = pack4(acc); }
    S1_BAR();
}

struct GlIn { bf16 la[8], q[8], k[8], v0[8], v1[8]; };
__device__ __forceinline__ void s1_gla_load(Frame& F, int u, GlIn& I) {
    const int sg = u / NCHUNK, c = u - sg * NCHUNK, gb = sg >> 3, gdir = (sg >> 2) & 1, gh = sg & 3; unsigned char* ws = F.ws;
    const bf16* Qp = (const bf16*)(ws + WS_QGB); const bf16* Kp = (const bf16*)(ws + WS_KGB); const bf16* Vp = (const bf16*)(ws + WS_VGB); const bf16* LAp = (const bf16*)(ws + (gdir ? WS_LAB : WS_LAF));
#pragma unroll
    for (int i = 0; i < 8; ++i) { const int row = scan_row(c * CH + 8 * F.wave + i, gb, gdir); const size_t b2 = (size_t)row * 256 + gh * 64 + F.lane, b5 = (size_t)row * RWW + gh * 128 + F.lane;
        I.la[i] = LAp[b2]; I.q[i] = Qp[b2]; I.k[i] = Kp[b2]; I.v0[i] = Vp[b5]; I.v1[i] = Vp[b5 + 64]; }
}
__device__ __forceinline__ void s1_gla(Frame& F, int u, const GlIn& I, int un, GlIn& Inext, f32x2v (&cv)[32], int& cpend, int cvi) {
    const int sg = u / NCHUNK, c = u - sg * NCHUNK;
    const bool emit = c >= CTXL / CH;
    LAS unsigned char* lds = F.lds; unsigned char* ws = F.ws;
    int lane_ = F.lane; asm volatile("" : "+v"(lane_));
    const int lane = lane_, wave = F.wave, rr = lane & 15, q = lane >> 4;
    LAS float* tot = (LAS float*)(lds + AUX_OFF);
    unsigned char* QE = (unsigned char*)F.out + OUT_QE + (size_t)u * 4096;
    {
        float la[8], xq[8], xk[8], v0[8], v1[8];
#pragma unroll
        for (int i = 0; i < 8; ++i) { la[i] = bf2f(I.la[i]); xq[i] = bf2f(I.q[i]); xk[i] = bf2f(I.k[i]); v0[i] = bf2f(I.v0[i]); v1[i] = bf2f(I.v1[i]); }
        float p[8]; p[0] = la[0];
#pragma unroll
        for (int i = 1; i < 8; ++i) p[i] = p[i - 1] + la[i];
        tot[wave * 64 + lane] = p[7];
        S1_BAR();
        float off = 0.f, all = 0.f;
#pragma unroll
        for (int w = 0; w < 8; ++w) { const float t = tot[w * 64 + lane]; all += t; off += (w < wave) ? t : 0.f; }
        if (wave == 0) ((float*)(ws + WS_DD))[(size_t)u * 64 + lane] = __expf(all);
        float kl[8];
#pragma unroll
        for (int i = 0; i < 8; ++i) { const float cum = off + p[i]; const int t = 8 * wave + i;
            const float qef = xq[i] * __expf(cum);
            SLOT(0)[t * LP + lane] = (bf16)pk2z(qef);
            if (emit) QE[t * 64 + lane] = (unsigned char)__builtin_amdgcn_cvt_pk_fp8_f32(clamp8(qef), 0.f, 0, false);
            SLOT(1)[t * LP + lane] = (bf16)pk2z(xk[i] * __expf(-cum));
            kl[i] = xk[i] * __expf(all - cum); }
        *(LAS v4u*)(SLOT(2) + lane * LP + 8 * wave) = pk8(kl);
        *(LAS v4u*)(SLOT(3) + lane * LP + 8 * wave) = pk8(v0);
        *(LAS v4u*)(SLOT(3) + (64 + lane) * LP + 8 * wave) = pk8(v1);
        S1_BAR();
    }
    if (wave >= 4) { CVY_FLUSH(); s1_gla_load(F, un, Inext); CVY_START(cvi); }
    else if (emit) {
#pragma unroll
        for (int tix = 0; tix < 4; ++tix) { const int ti = 4 * wave + tix, r0 = 16 * (ti >> 2), c0 = 16 * (ti & 3), ci = c0 + rr;
            f32x4 acc = mm_tile(SLOT(1), r0, SLOT(0), c0, lane);
#pragma unroll
            for (int e = 0; e < 4; ++e) acc[e] = (r0 + 4 * q + e <= ci) ? acc[e] : 0.f;
            *(LAS v2u*)(SLOT(5) + ci * LP + r0 + 4 * q) = pack4(acc); }
    }
    bf16* KV = (bf16*)(ws + WS_KV) + (size_t)u * 8192;
#pragma unroll
    for (int tix = 0; tix < 4; ++tix) { const int ti = 4 * wave + tix, r0 = 16 * (ti >> 3), c0 = 16 * (ti & 7), ci = c0 + rr;
        const f32x4 acc = mm_tile(SLOT(2), r0, SLOT(3), c0, lane);
        *(v2u*)(KV + ci * 64 + r0 + 4 * q) = pack4(acc); }
    S1_BAR();
    if (emit) {
        unsigned char* IN = ws + WS_INTRA + (size_t)u * 8192;
#pragma unroll
        for (int tix = 0; tix < 4; ++tix) { const int ti = 4 * wave + tix, r0 = 16 * (ti >> 2), c0 = 16 * (ti & 3), ci = c0 + rr;
            const f32x4 acc = mm_tile(SLOT(3), r0, SLOT(5), c0, lane);
            *(unsigned*)(IN + ci * 128 + r0 + 4 * q) = pack4_fp8(acc); }
    }
    S1_BAR();
}

__device__ __forceinline__ void ph_scan1(Frame& F) {
    f32x2v cv[32]; int cpend = -1; const int lane = F.lane;
    int item = (int)blockIdx.x * 4 + (F.wave & 3);
    { RwIn cur, nxt; if ((int)blockIdx.x < NU_RW) s1_rwkv_load(F, blockIdx.x, cur);
#pragma unroll 1
      for (int u = blockIdx.x; u < NU_RW; u += F.G, item += F.G * 4) { const int un = (u + F.G < NU_RW) ? u + F.G : u; s1_rwkv(F, u, cur, un, nxt, cv, cpend, item); cur = nxt; } }
    { GlIn cur, nxt; if ((int)blockIdx.x < NU_GL) s1_gla_load(F, blockIdx.x, cur);
#pragma unroll 1
      for (int u = blockIdx.x; u < NU_GL; u += F.G, item += F.G * 4) { const int un = (u + F.G < NU_GL) ? u + F.G : u; if (F.wave < 4) s1_gla_load(F, un, nxt); s1_gla(F, u, cur, un, nxt, cv, cpend, item); cur = nxt; } }
    if (F.wave >= 4) CVY_FLUSH();
}

__device__ __forceinline__ bf16x8 pack_frag(const f32x4 lo, const f32x4 hi) {
    v4u w; w.x = pk2(lo[0], lo[1]); w.y = pk2(lo[2], lo[3]); w.z = pk2(hi[0], hi[1]); w.w = pk2(hi[2], hi[3]); return __builtin_bit_cast(bf16x8, w);
}
constexpr int S2_D = 5, S2_R = 6, S2_RW = 8192 + 4096 + 2048 + 1024, S2_GL = 4096 + 2048 + 1024 + 1024, S2_SLOT = S2_RW + S2_GL;
static_assert(S2_R * S2_SLOT <= MISC_OFF, "S2 ring fits in LDS");
__device__ __forceinline__ void s2_piece(int k, int lane, size_t ur0, size_t ug0, int v0r, int v0g,
                                         const unsigned char* GTb, const unsigned char* RHb, const unsigned char* HHb, const unsigned char* YLb,
                                         const unsigned char* QEb, const unsigned char* KVb, const unsigned char* INb, const unsigned char* DDb,
                                         const unsigned char*& src, int& stride, int& ldo) {
    if (k < 8) { const int n = k, pu = n * 64 + lane, row = pu >> 3, c16 = (pu & 7) ^ (row & 7);
        src = GTb + ur0 * 8192 + row * 128 + c16 * 16; stride = 8192; ldo = n * 1024; }
    else if (k < 12) { const int n = k - 8, pu = n * 64 + lane, row = pu >> 2, c16 = (pu & 3) ^ (row & 3);
        src = RHb + ur0 * 4096 + row * 64 + c16 * 16; stride = 4096; ldo = 8192 + n * 1024; }
    else if (k < 14) { const int n = k - 12, pu = n * 64 + lane, v = pu >> 3, c16 = (pu & 7) ^ (v & 7);
        src = HHb + ur0 * 8192 + (size_t)(v0r + v) * 128 + c16 * 16; stride = 8192; ldo = 12288 + n * 1024; }
    else if (k < 15) { const int t = lane;
        src = YLb + ur0 * 4096 + t * 64 + v0r; stride = 4096; ldo = 14336; }
    else if (k < 19) { const int n = k - 15, pu = n * 64 + lane, row = pu >> 2, c16 = (pu & 3) ^ (row & 3);
        src = QEb + ug0 * 4096 + row * 64 + c16 * 16; stride = 4096; ldo = S2_RW + n * 1024; }
    else if (k < 21) { const int n = k - 19, pu = n * 64 + lane, v = pu >> 3, c16 = (pu & 7) ^ (v & 7);
        src = KVb + ug0 * 16384 + (size_t)(v0g + v) * 128 + c16 * 16; stride = 16384; ldo = S2_RW + 4096 + n * 1024; }
    else if (k < 22) { const int t = lane;
        src = INb + ug0 * 8192 + t * 128 + v0g; stride = 8192; ldo = S2_RW + 6144; }
    else { src = DDb + ug0 * 256 + (lane & 15) * 16; stride = 256; ldo = S2_RW + 7168; }
}
__device__ __forceinline__ void ph_scan2(Frame& F) {
    const int lane = F.lane, wave = F.wave, rr = lane & 15, q = lane >> 4; unsigned char* ws = F.ws; LAS unsigned char* lds = F.lds;
    const int it = (F.G == 256) ? (int)(blockIdx.x & 7) * 32 + (int)(blockIdx.x >> 3) : (int)blockIdx.x;
    const int sr = it >> 2, v0r = 16 * (it & 3), rb = sr >> 4, rdir = (sr >> 3) & 1, rh = sr & 7;
    const int sg = it >> 3, v0g = 16 * (it & 7), gb = sg >> 3, gdir = (sg >> 2) & 1, gh = sg & 3;
#define S2_BAR() do { asm volatile("s_waitcnt lgkmcnt(0)" ::: "memory"); __builtin_amdgcn_s_barrier(); asm volatile("" ::: "memory"); } while (0)
#define S2_NEXT_SLOT() do { slot = (slot + 1 == S2_R) ? 0 : slot + 1; } while (0)
    LAS unsigned char* sfr = lds + S2_SF_OFF + lane * 16;
    LAS unsigned char* sfg = sfr + 4096;
    if (wave >= 6) {
        const unsigned char* GTb = (const unsigned char*)F.out + OUT_GT; const unsigned char* QEb = (const unsigned char*)F.out + OUT_QE;
        const unsigned char* RHb = ws + WS_RH; const unsigned char* YLb = ws + WS_YL; const unsigned char* HHb = ws + WS_HH; const unsigned char* KVb = ws + WS_KV; const unsigned char* INb = ws + WS_INTRA;
        const unsigned char* DDb = ws + WS_DD;
        const unsigned char* pj[12]; int sj[12], lj[12];
#pragma unroll
        for (int j = 0; j < 12; ++j) { int k = (wave - 6) * 12 + j; if (k >= 23) k = 22;
            s2_piece(k, lane, (size_t)sr * NCHUNK, (size_t)sg * NCHUNK, v0r, v0g, GTb, RHb, HHb, YLb, QEb, KVb, INb, DDb, pj[j], sj[j], lj[j]);
            sj[j] = __builtin_amdgcn_readfirstlane(sj[j]); lj[j] = __builtin_amdgcn_readfirstlane(lj[j]); }
#define S2_ISSUE(cc, sl_) do { const int _c = (cc) < NCHUNK ? (cc) : NCHUNK - 1; _Pragma("unroll") for (int j = 0; j < 12; ++j) \
            __builtin_amdgcn_global_load_lds((const unsigned*)(pj[j] + (size_t)_c * sj[j]), (LAS unsigned*)(lds + (sl_) * S2_SLOT + lj[j]), 16, 0, 0); } while (0)
        S2_ISSUE(0, 0); S2_ISSUE(1, 1); S2_ISSUE(2, 2); S2_ISSUE(3, 3); S2_ISSUE(4, 4);
        int slot = S2_D % S2_R;
#pragma unroll 1
        for (int c = 0; c < NCHUNK; ++c) {
            asm volatile("s_waitcnt vmcnt(48) ; S2WAIT" ::: "memory");
            S2_BAR();
            S2_ISSUE(c + S2_D, slot);
            S2_NEXT_SLOT();
        }
#undef S2_ISSUE
    } else if (wave == 0) {
        f32x4 S[4];
#pragma unroll
        for (int m = 0; m < 4; ++m) S[m] = (f32x4){0.f, 0.f, 0.f, 0.f};
        bf16x8 Sf0 = pack_frag(S[0], S[1]), Sf1 = pack_frag(S[2], S[3]);
        *(LAS bf16x8*)(sfr) = Sf0; *(LAS bf16x8*)(sfr + 1024) = Sf1;
        int slot = 0;
#pragma unroll 1
        for (int c = 0; c < NCHUNK; ++c) {
            S2_BAR();
            const LAS unsigned char* sl = lds + slot * S2_SLOT;
            bf16x8 G0[4], G1[4]; v2u Hw[4];
#pragma unroll
            for (int m = 0; m < 4; ++m) { const int k2 = 16 * m + rr;
                G0[m] = *(const LAS bf16x8*)(sl + (k2 * 8 + (q ^ (k2 & 7))) * 16); G1[m] = *(const LAS bf16x8*)(sl + (k2 * 8 + ((4 + q) ^ (k2 & 7))) * 16);
                Hw[m] = *(const LAS v2u*)(sl + 12288 + (rr * 8 + ((2 * m + (q >> 1)) ^ (rr & 7))) * 16 + (q & 1) * 8); }
#pragma unroll
            for (int m = 0; m < 4; ++m) { f32x4 acc = unpack4(Hw[m]);
                acc = __builtin_amdgcn_mfma_f32_16x16x32_bf16(G0[m], Sf0, acc, 0, 0, 0);
                acc = __builtin_amdgcn_mfma_f32_16x16x32_bf16(G1[m], Sf1, acc, 0, 0, 0);
                S[m] = acc; }
            Sf0 = pack_frag(S[0], S[1]); Sf1 = pack_frag(S[2], S[3]);
            LAS unsigned char* o = sfr + ((c + 1) & 1) * 2048;
            *(LAS bf16x8*)(o) = Sf0; *(LAS bf16x8*)(o + 1024) = Sf1;
            S2_NEXT_SLOT();
        }
    } else if (wave == 1) {
        f32x4 S[4];
#pragma unroll
        for (int m = 0; m < 4; ++m) S[m] = (f32x4){0.f, 0.f, 0.f, 0.f};
        { const bf16x8 Sf0 = pack_frag(S[0], S[1]); *(LAS bf16x8*)(sfg) = Sf0; *(LAS bf16x8*)(sfg + 1024) = Sf0; }
        int slot = 0;
#pragma unroll 1
        for (int c = 0; c < NCHUNK; ++c) {
            S2_BAR();
            const LAS unsigned char* sl = lds + slot * S2_SLOT + S2_RW;
            v4u kw[2]; f32x4 d0[2], d1[2];
#pragma unroll
            for (int s2 = 0; s2 < 2; ++s2) { kw[s2] = *(const LAS v4u*)(sl + 4096 + (rr * 8 + ((4 * s2 + q) ^ (rr & 7))) * 16);
                d0[s2] = *(const LAS f32x4*)(sl + 7168 + 128 * s2 + 32 * q); d1[s2] = *(const LAS f32x4*)(sl + 7168 + 128 * s2 + 32 * q + 16); }
#pragma unroll
            for (int s2 = 0; s2 < 2; ++s2) { S[2 * s2] = S[2 * s2] * d0[s2] + unpack4((v2u){kw[s2].x, kw[s2].y}); S[2 * s2 + 1] = S[2 * s2 + 1] * d1[s2] + unpack4((v2u){kw[s2].z, kw[s2].w}); }
            LAS unsigned char* o = sfg + ((c + 1) & 1) * 2048;
            *(LAS bf16x8*)(o) = pack_frag(S[0], S[1]); *(LAS bf16x8*)(o + 1024) = pack_frag(S[2], S[3]);
            S2_NEXT_SLOT();
        }
    } else if (wave < 4) {
        bf16* ORW = (bf16*)(ws + (rdir ? WS_ORWB : WS_ORWF));
        const int tt0 = 2 * (wave - 2);
        int slot = 0;
#pragma unroll 1
        for (int c = 0; c < NCHUNK; ++c) {
            S2_BAR();
            if (c >= CTXL / CH) {
                const LAS unsigned char* sl = lds + slot * S2_SLOT; const LAS unsigned char* sf = sfr + (c & 1) * 2048;
                const bf16x8 Sf0 = *(const LAS bf16x8*)(sf), Sf1 = *(const LAS bf16x8*)(sf + 1024);
                v2u Rw0[2], Rw1[2]; unsigned Yw[2];
#pragma unroll
                for (int i = 0; i < 2; ++i) { const int t = 16 * (tt0 + i) + rr;
                    Rw0[i] = *(const LAS v2u*)(sl + 8192 + (t * 4 + ((q >> 1) ^ (t & 3))) * 16 + (q & 1) * 8); Rw1[i] = *(const LAS v2u*)(sl + 8192 + (t * 4 + ((2 + (q >> 1)) ^ (t & 3))) * 16 + (q & 1) * 8);
                    Yw[i] = *(const LAS unsigned*)(sl + 14336 + t * 16 + q * 4); }
#pragma unroll
                for (int i = 0; i < 2; ++i) { const int t = 16 * (tt0 + i) + rr;
                    const bf16x8 R0 = pack_frag(unpack4_fp8(Rw0[i].x), unpack4_fp8(Rw0[i].y)), R1 = pack_frag(unpack4_fp8(Rw1[i].x), unpack4_fp8(Rw1[i].y));
                    f32x4 acc = unpack4_fp8(Yw[i]);
                    acc = __builtin_amdgcn_mfma_f32_16x16x32_bf16(Sf0, R0, acc, 0, 0, 0);
                    acc = __builtin_amdgcn_mfma_f32_16x16x32_bf16(Sf1, R1, acc, 0, 0, 0);
                    const int row = scan_row(c * CH + t, rb, rdir);
                    *(v2u*)(ORW + (size_t)row * RWW + rh * 64 + v0r + 4 * q) = pack4(acc); }
            }
            S2_NEXT_SLOT();
        }
    } else {
        bf16* OGL = (bf16*)(ws + (gdir ? WS_OGLB : WS_OGLF));
        const int tt0 = 2 * (wave - 4);
        int slot = 0;
#pragma unroll 1
        for (int c = 0; c < NCHUNK; ++c) {
            S2_BAR();
            if (c >= CTXL / CH) {
                const LAS unsigned char* sl = lds + slot * S2_SLOT + S2_RW; const LAS unsigned char* sf = sfg + (c & 1) * 2048;
                const bf16x8 Sf0 = *(const LAS bf16x8*)(sf), Sf1 = *(const LAS bf16x8*)(sf + 1024);
                v2u Qw0[2], Qw1[2]; unsigned Iw[2];
#pragma unroll
                for (int i = 0; i < 2; ++i) { const int t = 16 * (tt0 + i) + rr;
                    Qw0[i] = *(const LAS v2u*)(sl + (t * 4 + ((q >> 1) ^ (t & 3))) * 16 + (q & 1) * 8); Qw1[i] = *(const LAS v2u*)(sl + (t * 4 + ((2 + (q >> 1)) ^ (t & 3))) * 16 + (q & 1) * 8);
                    Iw[i] = *(const LAS unsigned*)(sl + 6144 + t * 16 + q * 4); }
#pragma unroll
                for (int i = 0; i < 2; ++i) { const int t = 16 * (tt0 + i) + rr;
                    const bf16x8 Q0 = pack_frag(unpack4_fp8(Qw0[i].x), unpack4_fp8(Qw0[i].y)), Q1 = pack_frag(unpack4_fp8(Qw1[i].x), unpack4_fp8(Qw1[i].y));
                    f32x4 acc = unpack4_fp8(Iw[i]);
                    acc = __builtin_amdgcn_mfma_f32_16x16x32_bf16(Sf0, Q0, acc, 0, 0, 0);
                    acc = __builtin_amdgcn_mfma_f32_16x16x32_bf16(Sf1, Q1, acc, 0, 0, 0);
                    const int row = scan_row(c * CH + t, gb, gdir);
                    *(v2u*)(OGL + (size_t)row * RWW + gh * 128 + v0g + 4 * q) = pack4(acc); }
            }
            S2_NEXT_SLOT();
        }
    }
#undef S2_BAR
#undef S2_NEXT_SLOT
}
#endif

#ifndef ML
#define ML 0
#endif
enum Phase { PH_PROLOGUE = 0, PH_A1, PH_INPROJ, PH_FEAT, PH_LORA, PH_SCAN1, PH_SCAN2, PH_MERGE, PH_BRANCH, PH_OUTPROJ, PH_LN1, PH_ROUTER, PH_ROUTE, PH_SCATTER, PH_EXP1, PH_EXP2, PH_FINAL, PH_COUNT };

__global__ void __launch_bounds__(NTHR, 2) mega(Args args) {
    extern __shared__ __attribute__((aligned(16))) unsigned char lds_raw[];
    Frame F;
    F.lds = (LAS unsigned char*)lds_raw;
    F.tid = threadIdx.x; F.lane = F.tid & 63; F.wave = __builtin_amdgcn_readfirstlane(F.tid >> 6);
    F.G = gridDim.x; F.gw = blockIdx.x * NWAVES + F.wave; F.NGW = F.G * NWAVES;
    F.in = args.in; F.out = args.out; F.ws = args.ws; F.ctl = (unsigned*)(args.ws + WS_CTL);
    volatile LAS unsigned* MISC = (volatile LAS unsigned*)(F.lds + MISC_OFF);
    if (F.tid < 64) MISC[F.tid] = 0u;
    __syncthreads();
    XcdBarrier bar; bar.bar = F.ctl + CW_BAR; bar.x = 0; bar.st = nullptr;
#if !ML
    bar = xcd_barrier_post(F.ctl + CW_BAR, MISC + 8);
#endif
    const int lo = args.ph_lo, hi = args.ph_hi;
#define IN(k) (lo <= (k) && (k) < hi)
#ifndef DUP
#define DUP -1
#endif
#define RUN(k, call) do { if (IN(k)) { call; GRID_BAR(); if (DUP == (k)) { call; GRID_BAR(); } } } while (0)
#if ML
#define GRID_BAR() do { } while (0)
#else
#define GRID_BAR() xcd_barrier(bar)
#endif

#if MS >= 2
    RUN(PH_PROLOGUE, ph_prologue(F));
#endif
#if MS >= 3
    RUN(PH_A1, ph_a1(F));
    RUN(PH_INPROJ, ph_inproj(F));
    RUN(PH_FEAT, ph_feat(F));
    RUN(PH_LORA, ph_lora(F));
    RUN(PH_SCAN1, ph_scan1(F));
    RUN(PH_SCAN2, ph_scan2(F));
    RUN(PH_MERGE, ph_merge(F));
    RUN(PH_BRANCH, ph_branch(F));
    RUN(PH_OUTPROJ, ph_outproj(F));
#else
    RUN(PH_OUTPROJ, ph_x1pre_nomix(F));
#endif
    RUN(PH_LN1, ph_ln1(F));
#if MS >= 2
    RUN(PH_ROUTER, ph_router(F));
    RUN(PH_ROUTE, ph_route(F));
    RUN(PH_SCATTER, ph_scatter(F));
    RUN(PH_EXP1, ph_exp1(F));
    RUN(PH_EXP2, ph_exp2(F));
#endif
    if (IN(PH_FINAL)) { ph_final(F); }
#undef IN
}

extern "C" void kernel_launch(void* const* d_in, const int* in_sizes, int n_in, void* d_out, int out_size, void* d_ws, size_t ws_size, hipStream_t stream) {
    static int grid = 0;
    if (grid == 0) {
        if (n_in != 36 || out_size != NLAT * D || ws_size < WS_END) { fprintf(stderr, "kernel_launch: unexpected problem shape (n_in %d, out %d)\n", n_in, out_size); grid = -1; return; }
        int dev = 0, cus = 0, per_cu = 0;
        if (hipGetDevice(&dev) != hipSuccess || hipDeviceGetAttribute(&cus, hipDeviceAttributeMultiprocessorCount, dev) != hipSuccess) { grid = -1; return; }
        if (hipFuncSetAttribute((const void*)mega, hipFuncAttributeMaxDynamicSharedMemorySize, LDS_BYTES) != hipSuccess) { fprintf(stderr, "kernel_launch: hipFuncSetAttribute failed\n"); grid = -1; return; }
        if (hipOccupancyMaxActiveBlocksPerMultiprocessor(&per_cu, (const void*)mega, NTHR, LDS_BYTES) != hipSuccess || per_cu < 1) { fprintf(stderr, "kernel_launch: occupancy query says %d\n", per_cu); }
        (void)hipGetLastError();
        grid = cus > 0 ? cus : 256;
        if (grid > 256) grid = 256;
    }
    if (grid < 0) return;
    (void)hipMemsetAsync((char*)d_ws + WS_CTL, 0, CTL_ZERO_BYTES, stream);
    Args a{};
    for (int i = 0; i < 36; ++i) a.in[i] = (const float*)d_in[i];
    a.out = (float*)d_out; a.ws = (unsigned char*)d_ws;
#if ML
    for (int p = 0; p < PH_COUNT; ++p) { a.ph_lo = p; a.ph_hi = p + 1; hipLaunchKernelGGL(mega, dim3(grid), dim3(NTHR), LDS_BYTES, stream, a); }
#else
    a.ph_lo = 0; a.ph_hi = PH_COUNT;
    hipLaunchKernelGGL(mega, dim3(grid), dim3(NTHR), LDS_BYTES, stream, a);
#endif
}
```

```cpp
#include <hip/hip_runtime.h>
#include <cstdio>
#include <cstdint>

#ifndef MS
#define MS 3
#endif

#define GAS __attribute__((address_space(1)))
#define LAS __attribute__((address_space(3)))
typedef unsigned short bf16;
typedef unsigned v4u __attribute__((ext_vector_type(4)));
typedef unsigned v2u __attribute__((ext_vector_type(2)));
typedef float f32x4 __attribute__((ext_vector_type(4)));
typedef float f32x2 __attribute__((ext_vector_type(2)));
typedef short bf16x8 __attribute__((ext_vector_type(8)));
#define LDS_WAIT() asm volatile("s_waitcnt lgkmcnt(0)" ::: "memory")
#define VM_WAIT() asm volatile("s_waitcnt vmcnt(0)" ::: "memory")

constexpr int D = 1024, NB = 4, SEQ = 8192, CTXL = 256, GRIDW = 64, GRIDH = 128;
constexpr int NLAT = NB * SEQ, NCTX = NB * CTXL, MR = NLAT + NCTX;
constexpr int RWW = 512, RWH = 8, HD = 64;
constexpr int C_R = 0, C_K = 512, C_V = 1024, C_PW = 1536, C_PA = 1568, C_PG = 1600, C_Q = 1696, C_KG = 1952, C_VG = 2208, C_PGL = 2720, C_OG = 2736, C_GRW = 3248, C_GGLA = 4272;
constexpr int IN_COLS = 5296, NP = 5376;
constexpr int NE = 256, TOPK = 8, FF = 256;
constexpr float LN_EPS = 1e-5f, RW_GN_EPS = 64e-5f;
constexpr float ALPHA = 1.189207115f;
constexpr float W8S = 64.0f, W8I = 1.0f / 64.0f;
constexpr int NLORA = 3072, KLORA = 256;
constexpr int MAXTILES = 1280, SH_ROW0 = MAXTILES * 256, NROWS_E = SH_ROW0 + NLAT;

namespace pg8 {
#define PG8_LAS __attribute__((address_space(3)))
typedef unsigned short bf16_t;
typedef unsigned u32x4 __attribute__((ext_vector_type(4)));
typedef unsigned u32x2 __attribute__((ext_vector_type(2)));
typedef long i64x2 __attribute__((ext_vector_type(2)));
typedef int i32x4v __attribute__((ext_vector_type(4))); typedef int i32x8v __attribute__((ext_vector_type(8)));
constexpr int BM = 256, BK = 64, HALF = 128, HTB = HALF * BK * 2, STAGE_BYTES = 8 * HTB, NXCD = 8, WGM = 8;
constexpr int IDX_OFF = STAGE_BYTES, IDX_UNITS = 12;

__host__ __device__ __forceinline__ int lds_byte(int r, int c) { const int st = (r >> 4) * 2 + (c >> 5), rr = r & 15, cc = c & 31, ob = rr * 64 + cc * 2; return st * 1024 + (ob ^ (((ob >> 9) & 1) << 5)); }
__host__ __device__ __forceinline__ void stage_rc(int b, int& R, int& C) { const int st = b / 1024, sb = b % 1024, swz = sb ^ (((sb >> 9) & 1) << 5); R = (st >> 1) * 16 + swz / 64; C = (st & 1) * 32 + (swz % 64) / 2; }
__host__ __device__ __forceinline__ int perm32(int rho) { const int n = rho >> 4, i = rho & 15; return 8 * (i >> 2) + 4 * n + (i & 3); }

struct Unit { int pm, pn, e, j; };
struct Gemm { const bf16_t* A; const bf16_t* Bt; int M, N, K; const int* rowidx; };

struct StaticOrder {
    int nM, nN, nwg, G, c;
    __host__ __device__ void init(int M, int N, int G_, int c_) { nM = M / BM; nN = N / BM; nwg = nM * nN; G = G_; c = c_; }
    __host__ __device__ bool next(int i, Unit& u) const {
        const long L = (long)i * G + c; if (L >= nwg) return false;
        int wgid = (int)L; { const int q = nwg / NXCD, r = nwg % NXCD, xcd = wgid % NXCD, off = wgid / NXCD; wgid = (xcd < r ? xcd * (q + 1) : r * (q + 1) + (xcd - r) * q) + off; }
        const int nig = WGM * nN, gid = wgid / nig, fm = gid * WGM, gsz = (nM - fm) < WGM ? (nM - fm) : WGM;
        u.pm = fm + ((wgid % nig) % gsz); u.pn = (wgid % nig) / gsz; u.e = 0; u.j = u.pn; return true;
    }
};
struct MoeOrder {
    int nN, G, c, NT; const int* tile_e;
    __device__ bool next(int i, Unit& u) const {
        int tile, j;
        if (G == 256) { const int x = c & 7, y = c >> 3; tile = i * (256 / nN) + x * (32 / nN) + y / nN; j = y % nN; if (tile >= NT + NLAT / 256) return false; }
        else { const int L = i * G + c; if (L >= (NT + NLAT / 256) * nN) return false; tile = L / nN; j = L - tile * nN; }
        int e, pm;
        if (tile < NT) { e = tile_e[tile]; pm = tile; } else { e = NE; pm = MAXTILES + (tile - NT); }
        u.pm = pm; u.pn = e * nN + j; u.e = e; u.j = j; return true;
    }
};

typedef __bf16 bf16x2n __attribute__((ext_vector_type(2))); typedef float f32x2n __attribute__((ext_vector_type(2)));
__device__ __forceinline__ unsigned cvt_pk_bf16(float lo, float hi) { const f32x2n v = {lo, hi}; return __builtin_bit_cast(unsigned, __builtin_convertvector(v, bf16x2n)); }

template <class Epi, class Sched, bool ALIGN_EPI, bool SP2, bool GATHER, bool FP8 = false>
__device__ __forceinline__ void gemm_phase(PG8_LAS unsigned char* lds, const Gemm g, const Sched& S, const Epi& E) {
    const int tid = threadIdx.x, wid = __builtin_amdgcn_readfirstlane(tid >> 6), lane = tid & 63, wr = wid >> 2, wc = wid & 3, fr = lane & 15, fq = lane >> 4;
    const int K = g.K, nt = K / BK;
    const size_t kstep = (size_t)(BK * 2);
    const size_t hstep = (size_t)HALF * K * 2;
    const size_t tstep = 2 * hstep;
    unsigned voffB[2]; unsigned va[2][2];
#pragma unroll
    for (int i = 0; i < 2; ++i) { int R, C; stage_rc(tid * 16 + i * 8192, R, C); const int Rb = Epi::PERM ? ((R & ~31) + perm32(R & 31)) : R;
        voffB[i] = (unsigned)(Rb * K + C) * 2u;
        va[0][i] = (unsigned)(R * K + C) * 2u; va[1][i] = va[0][i]; }
    const size_t ah = GATHER ? (size_t)0 : hstep;
#define PG8_GOFF(dst, ub) do { _Pragma("unroll") for (int _h = 0; _h < 2; ++_h) _Pragma("unroll") for (int _i = 0; _i < 2; ++_i) { int _R, _C; stage_rc(tid * 16 + _i * 8192, _R, _C); \
        dst[_h][_i] = (unsigned)(idxt[(ub) * 256 + _h * 128 + _R] * K + _C) * 2u; } } while (0)
    const unsigned ldsw = (unsigned)wid * 1024u;
    const int aoff = lds_byte(wr * 64 + fr, fq * 8), boff = lds_byte(wc * 32 + fr, fq * 8);
    PG8_LAS int* idxt = (PG8_LAS int*)(lds + IDX_OFF);
#define PG8_SA(b, h) (((b) * 2 + (h)) * HTB)
#define PG8_SB(b, h) ((4 + (b) * 2 + (h)) * HTB)
#define PG8_STAGE(bufoff, gbase, voff) do { _Pragma("unroll") for (int _i = 0; _i < 2; ++_i) \
        __builtin_amdgcn_global_load_lds((const unsigned*)((const char*)(gbase) + (voff)[_i]), (PG8_LAS unsigned*)(lds + (bufoff) + ldsw + _i * 8192), 16, 0, 0); } while (0)
#define PG8_LD32(dst, addr) do { const i32x4v _lo = *(const PG8_LAS i32x4v*)(addr), _hi = *(const PG8_LAS i32x4v*)((addr) + 1024); dst = __builtin_shufflevector(_lo, _hi, 0, 1, 2, 3, 4, 5, 6, 7); } while (0)
#define PG8_LDA(dst, b, h) do { _Pragma("unroll") for (int m = 0; m < 4; ++m) PG8_LD32(dst[m], lds + PG8_SA(b, h) + aoff + m * 2048); } while (0)
#define PG8_LDB(dst, b, h) do { _Pragma("unroll") for (int n = 0; n < 2; ++n) PG8_LD32(dst[n], lds + PG8_SB(b, h) + boff + n * 2048); } while (0)
#define PG8_HALF(v, k) __builtin_bit_cast(bf16x8, (k) ? __builtin_shufflevector(v, v, 4, 5, 6, 7) : __builtin_shufflevector(v, v, 0, 1, 2, 3))
#define PG8_MMA(ai, bj, At, Bt) do { __builtin_amdgcn_s_setprio(1); _Pragma("unroll") for (int m = 0; m < 4; ++m) _Pragma("unroll") for (int n = 0; n < 2; ++n) { \
        if constexpr (FP8) asm volatile("v_mfma_f32_16x16x128_f8f6f4 %0, %1, %2, %0" : "+v"(acc[ai][bj][m][n]) : "v"(Bt[n]), "v"(At[m])); \
        else { _Pragma("unroll") for (int k = 0; k < 2; ++k) acc[ai][bj][m][n] = __builtin_amdgcn_mfma_f32_16x16x32_bf16(PG8_HALF(Bt[n], k), PG8_HALF(At[m], k), acc[ai][bj][m][n], 0, 0, 0); } } __builtin_amdgcn_s_setprio(0); } while (0)
#define PG8_WAIT_V(n) asm volatile("s_waitcnt vmcnt(" #n ")" ::: "memory")
#define PG8_WAIT_L(n) asm volatile("s_waitcnt lgkmcnt(" #n ")" ::: "memory")
#define PG8_BAR __builtin_amdgcn_s_barrier()
#define PG8_SCHED __builtin_amdgcn_sched_barrier(0)
    Unit cur, nxt; int ui = 0;
    if (!S.next(0, cur)) return;
#ifdef GEMM_STAGGER
    if constexpr (FP8) {
        const unsigned long long t0 = __builtin_amdgcn_s_memrealtime(); const unsigned long long dl = (unsigned long long)(blockIdx.x & 3) * GEMM_STAGGER;
        while (__builtin_amdgcn_s_memrealtime() - t0 < dl) __builtin_amdgcn_s_sleep(8);
    }
#endif
    if constexpr (GATHER) {
        Unit uu;
        for (int i = 0; i < IDX_UNITS; ++i) { if (!S.next(i, uu)) break; if (tid < 256) idxt[i * 256 + tid] = g.rowidx[(size_t)uu.pm * 256 + tid]; }
        asm volatile("s_waitcnt vmcnt(0) lgkmcnt(0)" ::: "memory"); PG8_BAR; asm volatile("" ::: "memory");
        PG8_GOFF(va, 0);
    }
    f32x4 acc[2][2][4][2];
#pragma unroll
    for (int a = 0; a < 2; ++a)
#pragma unroll
        for (int b = 0; b < 2; ++b)
#pragma unroll
            for (int m = 0; m < 4; ++m)
#pragma unroll
                for (int n = 0; n < 2; ++n) acc[a][b][m][n] = (f32x4){0.f, 0.f, 0.f, 0.f};
    i32x8v At[4], B0[2], B1[2];
    const char* cA = (const char*)g.A + (GATHER ? (size_t)0 : (size_t)cur.pm * tstep); const char* cB = (const char*)g.Bt + (size_t)cur.pn * tstep;
    if constexpr (SP2) {
        PG8_STAGE(PG8_SB(0, 0), cB, voffB); PG8_STAGE(PG8_SB(0, 1), cB + hstep, voffB); PG8_STAGE(PG8_SA(0, 0), cA, va[0]); PG8_STAGE(PG8_SA(0, 1), cA + ah, va[1]);
        if (wr == 1) PG8_BAR;
        PG8_WAIT_V(2); PG8_BAR;
        PG8_STAGE(PG8_SB(1, 0), cB + kstep, voffB); PG8_STAGE(PG8_SA(1, 0), cA + kstep, va[0]); PG8_STAGE(PG8_SB(1, 1), cB + hstep + kstep, voffB);
        PG8_WAIT_V(6); PG8_BAR;
    } else {
        PG8_STAGE(PG8_SB(0, 0), cB, voffB); PG8_STAGE(PG8_SA(0, 0), cA, va[0]); PG8_STAGE(PG8_SB(0, 1), cB + hstep, voffB); PG8_STAGE(PG8_SA(0, 1), cA + ah, va[1]);
        if (wr == 1) PG8_BAR;
        PG8_WAIT_V(4); PG8_BAR;
        PG8_STAGE(PG8_SB(1, 0), cB + kstep, voffB); PG8_STAGE(PG8_SA(1, 0), cA + kstep, va[0]); PG8_STAGE(PG8_SB(1, 1), cB + hstep + kstep, voffB);
        PG8_WAIT_V(6); PG8_BAR;
    }
    for (;;) {
        const bool has_next = S.next(ui + 1, nxt);
        const char* nA = has_next ? (const char*)g.A + (GATHER ? (size_t)0 : (size_t)nxt.pm * tstep) : cA; const char* nB = has_next ? (const char*)g.Bt + (size_t)nxt.pn * tstep : cB;
        const int ubn = (has_next && ui + 1 < IDX_UNITS) ? (ui + 1) : ui;
#pragma unroll 1
        for (int t = 0; t < nt; t += 2) {
            const bool last = (t == nt - 2);
            const char* a1 = cA + (size_t)(t + 1) * kstep;
            const char* a2 = last ? nA : cA + (size_t)(t + 2) * kstep; const char* b2 = last ? nB : cB + (size_t)(t + 2) * kstep;
            const char* a3 = a2 + kstep; const char* b3 = b2 + kstep;
            unsigned v2[2][2];
#pragma unroll
            for (int h = 0; h < 2; ++h)
#pragma unroll
                for (int i = 0; i < 2; ++i) v2[h][i] = va[h][i];
            if constexpr (GATHER) { if (last) PG8_GOFF(v2, ubn); }
            if constexpr (SP2) {
            PG8_LDB(B0, 0, 0); PG8_LDB(B1, 0, 1); PG8_SCHED; PG8_LDA(At, 0, 0); PG8_STAGE(PG8_SA(1, 1), a1 + ah, va[1]);
            PG8_WAIT_V(8); PG8_WAIT_L(0); PG8_BAR; PG8_MMA(0, 0, At, B0); PG8_MMA(0, 1, At, B1); PG8_BAR; PG8_SCHED;
            PG8_LDA(At, 0, 1); PG8_STAGE(PG8_SB(0, 0), b2, voffB); PG8_STAGE(PG8_SB(0, 1), b2 + hstep, voffB); PG8_STAGE(PG8_SA(0, 0), a2, v2[0]);
            PG8_WAIT_V(8); PG8_WAIT_L(0); PG8_BAR; PG8_MMA(1, 0, At, B0); PG8_MMA(1, 1, At, B1); PG8_BAR; PG8_SCHED;
            PG8_LDB(B0, 1, 0); PG8_LDB(B1, 1, 1); PG8_SCHED; PG8_LDA(At, 1, 0); PG8_STAGE(PG8_SA(0, 1), a2 + ah, v2[1]);
            PG8_WAIT_V(8); PG8_WAIT_L(0); PG8_BAR; PG8_MMA(0, 0, At, B0); PG8_MMA(0, 1, At, B1); PG8_BAR; PG8_SCHED;
            PG8_LDA(At, 1, 1); PG8_STAGE(PG8_SB(1, 0), b3, voffB); PG8_STAGE(PG8_SB(1, 1), b3 + hstep, voffB); PG8_STAGE(PG8_SA(1, 0), a3, v2[0]);
            PG8_WAIT_V(8); PG8_WAIT_L(0); PG8_BAR; PG8_MMA(1, 0, At, B0); PG8_MMA(1, 1, At, B1); PG8_BAR; PG8_SCHED;
            } else {
            PG8_LDB(B0, 0, 0); PG8_SCHED; PG8_LDA(At, 0, 0); PG8_STAGE(PG8_SA(1, 1), a1 + ah, va[1]);
            PG8_WAIT_L(8); PG8_BAR; PG8_WAIT_L(0); PG8_MMA(0, 0, At, B0); PG8_BAR; PG8_SCHED;
            PG8_LDB(B1, 0, 1); PG8_STAGE(PG8_SB(0, 0), b2, voffB);
            PG8_BAR; PG8_WAIT_L(0); PG8_MMA(0, 1, At, B1); PG8_BAR;
            PG8_LDA(At, 0, 1); PG8_STAGE(PG8_SA(0, 0), a2, v2[0]);
            PG8_BAR; PG8_WAIT_L(0); PG8_MMA(1, 0, At, B0); PG8_BAR; PG8_SCHED;
            PG8_STAGE(PG8_SB(0, 1), b2 + hstep, voffB);
            PG8_WAIT_V(6); PG8_BAR; PG8_MMA(1, 1, At, B1); PG8_BAR;
            PG8_LDB(B0, 1, 0); PG8_SCHED; PG8_LDA(At, 1, 0); PG8_STAGE(PG8_SA(0, 1), a2 + ah, v2[1]);
            PG8_WAIT_L(8); PG8_BAR; PG8_WAIT_L(0); PG8_MMA(0, 0, At, B0); PG8_BAR; PG8_SCHED;
            PG8_LDB(B1, 1, 1); PG8_STAGE(PG8_SB(1, 0), b3, voffB);
            PG8_BAR; PG8_WAIT_L(0); PG8_MMA(0, 1, At, B1); PG8_BAR;
            PG8_LDA(At, 1, 1); PG8_STAGE(PG8_SA(1, 0), a3, v2[0]);
            PG8_BAR; PG8_WAIT_L(0); PG8_MMA(1, 0, At, B0); PG8_BAR; PG8_SCHED;
            PG8_STAGE(PG8_SB(1, 1), b3 + hstep, voffB);
            PG8_WAIT_V(6); PG8_BAR; PG8_MMA(1, 1, At, B1); PG8_BAR;
            }
        }
        if constexpr (ALIGN_EPI) { if (wr == 0) PG8_BAR; }
        if constexpr (FP8) asm volatile("s_nop 15\n\ts_nop 15" ::: "memory");
        E(acc, cur, wr, wc, fr, fq);
        if (!has_next) break;
#pragma unroll
        for (int a = 0; a < 2; ++a)
#pragma unroll
            for (int b = 0; b < 2; ++b)
#pragma unroll
                for (int m = 0; m < 4; ++m)
#pragma unroll
                    for (int n = 0; n < 2; ++n) acc[a][b][m][n] = (f32x4){0.f, 0.f, 0.f, 0.f};
        cur = nxt; cA = nA; cB = nB; ++ui;
        if constexpr (GATHER) PG8_GOFF(va, ubn);
        if constexpr (ALIGN_EPI) { if (wr == 1) PG8_BAR; }
    }
    PG8_WAIT_V(0);
    if constexpr (!ALIGN_EPI) { if (wr == 0) PG8_BAR; }
    PG8_BAR;
#undef PG8_SA
#undef PG8_GOFF
#undef PG8_SB
#undef PG8_STAGE
#undef PG8_LDA
#undef PG8_LD32
#undef PG8_HALF
#undef PG8_LDB
#undef PG8_MMA
#undef PG8_WAIT_V
#undef PG8_WAIT_L
#undef PG8_BAR
#undef PG8_SCHED
}
}

#define XB_TMO      128
#define XB_XCNT(j)  (256  + 64 * (j))
#define XB_XSUB(j)  (1280 + 64 * (j))
#define XB_XGEN(j)  (2304 + 64 * (j))
#define XB_TOP      3328
#define XB_TOPGEN   3392
#define XCD_BAR_WORDS 3456
#define XB_SPIN_CAP (1u << 18)
__device__ __forceinline__ unsigned xb_ld(unsigned* p)              { return __hip_atomic_load(p, __ATOMIC_RELAXED, __HIP_MEMORY_SCOPE_AGENT); }
__device__ __forceinline__ unsigned xb_add(unsigned* p, unsigned v) { return __hip_atomic_fetch_add(p, v, __ATOMIC_RELAXED, __HIP_MEMORY_SCOPE_AGENT); }
__device__ __forceinline__ unsigned xb_xcc_id() { return (unsigned)__builtin_amdgcn_s_getreg((3 << 11) | 20) & 0xFu; }
#define XB_SPIN(cond, bar) do { unsigned _sp = 0; while (cond) { __builtin_amdgcn_s_sleep(1); \
    if ((++_sp & 255u) == 0u) { if (xb_ld(&(bar)[XB_TMO])) break; if (_sp > XB_SPIN_CAP) { atomicAdd(&(bar)[XB_TMO], 1u); break; } } } } while (0)
struct XcdBarrier { unsigned* bar; unsigned x; volatile LAS unsigned* st; };
__device__ __forceinline__ XcdBarrier xcd_barrier_post(unsigned* bar, volatile LAS unsigned* st) {
    XcdBarrier b; b.bar = bar; b.x = xb_xcc_id(); b.st = st;
    if (threadIdx.x == 0) (void)xb_add(&bar[XB_XCNT(b.x)], 1u);
    return b;
}
__device__ __forceinline__ void xcd_barrier_complete(unsigned* bar, unsigned x, unsigned& nloc, unsigned& nx) {
    const unsigned G = gridDim.x * gridDim.y * gridDim.z;
    unsigned sum, cnt, mine, sp = 0u;
    for (;;) {
        sum = 0u; cnt = 0u; mine = 0u;
#pragma unroll
        for (unsigned j = 0; j < 16; ++j) { const unsigned c = xb_ld(&bar[XB_XCNT(j)]); sum += c; cnt += (c > 0u) ? 1u : 0u; mine = (j == x) ? c : mine; }
        if (sum == G) break;
        __builtin_amdgcn_s_sleep(1);
        if ((++sp & 255u) == 0u) { if (xb_ld(&bar[XB_TMO])) break; if (sp > XB_SPIN_CAP) { atomicAdd(&bar[XB_TMO], 1u); break; } }
    }
    nloc = mine > 0u ? mine : 1u; nx = cnt > 0u ? cnt : 1u;
}
__device__ __forceinline__ void xcd_barrier(const XcdBarrier& b) {
    asm volatile("s_waitcnt vmcnt(0)" ::: "memory");
    __syncthreads();
    if (threadIdx.x == 0) {
        unsigned* bar = b.bar;
        __builtin_amdgcn_s_waitcnt(0);
        unsigned nloc = b.st[0], nx = b.st[1];
        if (nloc == 0u) { xcd_barrier_complete(bar, b.x, nloc, nx); b.st[0] = nloc; b.st[1] = nx; }
        const unsigned old = xb_add(&bar[XB_XSUB(b.x)], 1u);
        const unsigned gen = old / nloc;
        if (old + 1u == (gen + 1u) * nloc) {
            __builtin_amdgcn_fence(__ATOMIC_RELEASE, "agent");
            asm volatile("s_waitcnt vmcnt(0)" ::: "memory");
            const unsigned og = xb_add(&bar[XB_TOP], 1u);
            const unsigned tg = og / nx;
            if (og + 1u == (tg + 1u) * nx) xb_add(&bar[XB_TOPGEN], 1u);
            else XB_SPIN(xb_ld(&bar[XB_TOPGEN]) == tg, bar);
            __builtin_amdgcn_fence(__ATOMIC_ACQUIRE, "agent");
            xb_add(&bar[XB_XGEN(b.x)], 1u);
            asm volatile("s_waitcnt vmcnt(0)" ::: "memory");
        } else {
            XB_SPIN(xb_ld(&bar[XB_XGEN(b.x)]) == gen, bar);
            __builtin_amdgcn_fence(__ATOMIC_ACQUIRE, "agent");
            asm volatile("s_waitcnt vmcnt(0)" ::: "memory");
        }
    }
    __syncthreads();
}

constexpr size_t MiB = 1u << 20;
constexpr size_t al(size_t x) { return (x + 4095) & ~(size_t)4095; }
constexpr size_t WS_CTL = 0, CTL_ZERO_BYTES = 1 * MiB;
constexpr int CW_BAR = 4096;
constexpr int CW_CNT = 16384, CNT_STRIDE = 64;
constexpr int CW_NT = CW_CNT + NE * CNT_STRIDE + 64;
static_assert((CW_NT + 1) * 4 <= (int)CTL_ZERO_BYTES, "control words inside the per-call memset");
constexpr size_t WS_MOD = 1 * MiB;
constexpr size_t WS_TILE_E = WS_MOD + 256 * 1024;
constexpr size_t WS_PADSTART = WS_TILE_E + 16 * 1024;
constexpr size_t WS_ROWTOK = 2 * MiB;
constexpr size_t WS_EIDX = 4 * MiB;
constexpr size_t WS_GATE = 5 * MiB;
constexpr size_t WS_DEST = 6 * MiB;
constexpr size_t WS_WIN = 8 * MiB;
constexpr size_t WS_WLORA = WS_WIN + al((size_t)NP * D * 2);
constexpr size_t WS_WBRRW = WS_WLORA + al((size_t)NLORA * KLORA * 2);
constexpr size_t WS_WBRGLA = WS_WBRRW + al((size_t)D * RWW * 2);
constexpr size_t WS_WOUT = WS_WBRGLA + al((size_t)D * RWW * 2);
constexpr size_t WS_WROUTER = WS_WOUT + al((size_t)D * D * 2);
constexpr size_t WS_WGU = WS_WROUTER + al((size_t)NE * D * 2);
constexpr size_t WS_WD = WS_WGU + al((size_t)(NE + 1) * 512 * D * 2);
constexpr size_t WS_PERSIST_END = WS_WD + al((size_t)(NE + 1) * D * FF * 2);
constexpr size_t WS_REGB = WS_PERSIST_END;
constexpr size_t SZ512F = al((size_t)MR * RWW * 4), SZ256F = al((size_t)MR * 256 * 4), SZ512H = al((size_t)MR * RWW * 2);
constexpr size_t WS_A1 = WS_REGB;
constexpr size_t WS_A2 = WS_A1;
constexpr size_t WS_KSUM = WS_A2 + al((size_t)MR * KLORA * 2);
static_assert(WS_KSUM + SZ512H <= WS_A1 + al((size_t)MR * D * 2), "A2 + KSUM fit in the A1 slot");
constexpr size_t WS_P = WS_A1 + al((size_t)MR * D * 2);
constexpr size_t WS_RB = WS_P + al((size_t)MR * NP * 2);
constexpr size_t WS_VB = WS_RB + SZ512H, WS_KKB = WS_VB + SZ512H, WS_KMF = WS_KKB + SZ512H, WS_KMB = WS_KMF + SZ512H, WS_BVF = WS_KMB + SZ512H, WS_BVB = WS_BVF + SZ512H;
constexpr size_t WS_LWF = WS_BVB + SZ512H, WS_LWB = WS_LWF + SZ512F;
constexpr size_t SZ256H = al((size_t)MR * 256 * 2);
constexpr size_t WS_QGB = WS_LWB + SZ512F, WS_KGB = WS_QGB + SZ256H, WS_VGB = WS_KGB + SZ256H, WS_LAF = WS_VGB + SZ512H, WS_LAB = WS_LAF + SZ256F;
constexpr size_t WS_RWG = WS_LAB + SZ256F;
constexpr size_t WS_ORWF = WS_RWG + SZ512H, WS_ORWB = WS_ORWF + SZ512H, WS_OGLF = WS_ORWB + SZ512H, WS_OGLB = WS_OGLF + SZ512H;
constexpr int CH = 64, NCHUNK = (CTXL + SEQ) / CH, NU_RW = 64 * NCHUNK, NU_GL = 32 * NCHUNK;
constexpr size_t WS_RH = WS_OGLB + SZ512H;
constexpr size_t WS_YL = WS_RH + al((size_t)NU_RW * 4096 * 2);
constexpr size_t WS_HH = WS_YL + al((size_t)NU_RW * 4096 * 2);
constexpr size_t WS_INTRA = WS_HH + al((size_t)NU_RW * 4096 * 2);
constexpr size_t WS_KV = WS_INTRA + al((size_t)NU_GL * 8192 * 2);
constexpr size_t WS_DD = WS_KV + al((size_t)NU_GL * 8192 * 2);
constexpr size_t WS_END_MIX = WS_DD + al((size_t)NU_GL * 64 * 4);
constexpr size_t OUT_GT = 0, OUT_QE = (size_t)NU_RW * 4096 * 2;
static_assert(OUT_QE + (size_t)NU_GL * 4096 * 2 <= (size_t)NLAT * D * 4, "scan scratch fits in d_out");
constexpr size_t WS_YRW = WS_LWF, WS_YGLA = WS_LWB, WS_Z = WS_HH, WS_Z8 = WS_ORWF;
static_assert((size_t)NLAT * D <= SZ512H, "Z8 fits in the forward RWKV scan output slot");
static_assert((size_t)NLAT * D * 2 <= (size_t)NU_RW * 4096 * 2, "Z fits in the HH slot");
constexpr size_t WS_X1 = WS_REGB;
constexpr size_t WS_A3 = WS_X1 + al((size_t)NLAT * D * 4);
constexpr size_t WS_LOGITS = WS_A3 + al((size_t)NLAT * D * 2);
constexpr size_t WS_ACT = WS_LOGITS + al((size_t)NLAT * NE * 4);
constexpr size_t WS_Y = WS_ACT + al((size_t)NROWS_E * FF * 2);
constexpr size_t WS_A3F = WS_Y + al((size_t)NROWS_E * D);
constexpr size_t WS_END_MOE = WS_A3F + al((size_t)NLAT * D);
constexpr size_t WS_END = WS_END_MIX > WS_END_MOE ? WS_END_MIX : WS_END_MOE;
static_assert(WS_END <= (size_t)2048 * MiB, "workspace map exceeds 2 GiB");

constexpr int RING_BYTES = 131072;
constexpr int IDX_BYTES = pg8::IDX_UNITS * 256 * 4;
constexpr int MISC_OFF = RING_BYTES + IDX_BYTES;
constexpr int S2_SF_OFF = MISC_OFF + 256;
constexpr int LDS_BYTES = S2_SF_OFF + 8192;
static_assert(pg8::IDX_OFF == RING_BYTES, "gather table sits right above the stage buffers");
constexpr int NWAVES = 8, NTHR = 512;

struct Args { const float* in[36]; float* out; unsigned char* ws; int ph_lo, ph_hi; };

struct Frame {
    LAS unsigned char* lds;
    int tid, lane, wave, G, gw, NGW;
    const float* const* in; float* out; unsigned char* ws; unsigned* ctl;
};

__device__ __forceinline__ float wave_sum(float v) {
#pragma unroll
    for (int o = 1; o < 64; o <<= 1) v += __shfl_xor(v, o);
    return v;
}
__device__ __forceinline__ unsigned f2bf(float f) { unsigned u = __builtin_bit_cast(unsigned, f); return (u + 0x7fffu + ((u >> 16) & 1u)) >> 16; }
typedef __bf16 bf16x2v __attribute__((ext_vector_type(2)));
__device__ __forceinline__ unsigned pk2(float lo, float hi) { const f32x2 v = {lo, hi}; return __builtin_bit_cast(unsigned, __builtin_convertvector(v, bf16x2v)); }
__device__ __forceinline__ float bflo(unsigned w) { return __builtin_bit_cast(float, w << 16); }
__device__ __forceinline__ float bfhi(unsigned w) { return __builtin_bit_cast(float, w & 0xffff0000u); }
__device__ __forceinline__ float sigmoidf_(float x) { return __builtin_amdgcn_rcpf(1.0f + __expf(-x)); }
__device__ __forceinline__ float siluf_(float x) { return x * __builtin_amdgcn_rcpf(1.0f + __expf(-x)); }
__device__ __forceinline__ float tanhf_(float x) { return 1.0f - 2.0f * __builtin_amdgcn_rcpf(1.0f + __expf(2.0f * x)); }
__device__ __forceinline__ float logsigmoidf_(float x) { return fminf(x, 0.f) - __logf(1.0f + __expf(-fabsf(x))); }

__device__ __forceinline__ void ln_stats(const f32x4 (&v)[4], float& mean, float& rstd) {
    float s = 0.f;
#pragma unroll
    for (int j = 0; j < 4; ++j) s += (v[j].x + v[j].y) + (v[j].z + v[j].w);
    mean = wave_sum(s) * (1.f / D); float s2 = 0.f;
#pragma unroll
    for (int j = 0; j < 4; ++j) { const f32x4 d = v[j] - mean; s2 += (d.x * d.x + d.y * d.y) + (d.z * d.z + d.w * d.w); }
    rstd = __builtin_amdgcn_rsqf(wave_sum(s2) * (1.f / D) + LN_EPS);
}

__device__ __forceinline__ unsigned pack_fp8x4(const f32x4 v) {
    int w = __builtin_amdgcn_cvt_pk_fp8_f32(__builtin_amdgcn_fmed3f(v[0], -448.f, 448.f), __builtin_amdgcn_fmed3f(v[1], -448.f, 448.f), 0, false);
    return (unsigned)__builtin_amdgcn_cvt_pk_fp8_f32(__builtin_amdgcn_fmed3f(v[2], -448.f, 448.f), __builtin_amdgcn_fmed3f(v[3], -448.f, 448.f), w, true); }
__device__ __forceinline__ void ld_row_bf16(const bf16* row, int lane, f32x4 (&v)[4]) {
    const v4u a = *(const v4u*)(row + 8 * lane), b = *(const v4u*)(row + 512 + 8 * lane);
    v[0] = (f32x4){bflo(a.x), bfhi(a.x), bflo(a.y), bfhi(a.y)}; v[1] = (f32x4){bflo(a.z), bfhi(a.z), bflo(a.w), bfhi(a.w)};
    v[2] = (f32x4){bflo(b.x), bfhi(b.x), bflo(b.y), bfhi(b.y)}; v[3] = (f32x4){bflo(b.z), bfhi(b.z), bflo(b.w), bfhi(b.w)};
}
__device__ __forceinline__ int rowcol(int lane, int j) { return 512 * (j >> 1) + 8 * lane + 4 * (j & 1); }
__device__ __forceinline__ void ph_x1pre_nomix(Frame& F) {
    const float* x = F.in[0];
    for (int m = F.gw; m < NLAT; m += F.NGW) {
        bf16* o = (bf16*)(F.ws + WS_X1) + (size_t)m * D;
#pragma unroll
        for (int h = 0; h < 2; ++h) { const float* xr = x + (size_t)m * D + 512 * h + 8 * F.lane; const f32x4 a = *(const f32x4*)xr * ALPHA, b = *(const f32x4*)(xr + 4) * ALPHA;
            v4u w; w.x = pk2(a.x, a.y); w.y = pk2(a.z, a.w); w.z = pk2(b.x, b.y); w.w = pk2(b.z, b.w); *(v4u*)(o + 512 * h + 8 * F.lane) = w; }
    }
}
__device__ __forceinline__ void ph_ln1(Frame& F) {
    const float* lw = F.in[26]; const float* lb = F.in[27]; const float* mod = (const float*)(F.ws + WS_MOD);
    bf16* A3 = (bf16*)(F.ws + WS_A3); const bf16* X1P = (const bf16*)(F.ws + WS_X1);
    constexpr int NR = 4;
    for (int m0 = F.gw; m0 < NLAT; m0 += NR * F.NGW) {
        v4u w[NR][2];
#pragma unroll
        for (int r = 0; r < NR; ++r) { const int mm = m0 + r * F.NGW; const bf16* row = X1P + (size_t)(mm < NLAT ? mm : m0) * D; w[r][0] = *(const v4u*)(row + 8 * F.lane); w[r][1] = *(const v4u*)(row + 512 + 8 * F.lane); }
        __builtin_amdgcn_sched_barrier(0);
#pragma unroll
        for (int r = 0; r < NR; ++r) { const int mm = m0 + r * F.NGW; const int m = mm < NLAT ? mm : m0; const int b = m / SEQ;
            f32x4 v[4];
            v[0] = (f32x4){bflo(w[r][0].x), bfhi(w[r][0].x), bflo(w[r][0].y), bfhi(w[r][0].y)}; v[1] = (f32x4){bflo(w[r][0].z), bfhi(w[r][0].z), bflo(w[r][0].w), bfhi(w[r][0].w)};
            v[2] = (f32x4){bflo(w[r][1].x), bfhi(w[r][1].x), bflo(w[r][1].y), bfhi(w[r][1].y)}; v[3] = (f32x4){bflo(w[r][1].z), bfhi(w[r][1].z), bflo(w[r][1].w), bfhi(w[r][1].w)};
            float mean, rstd; ln_stats(v, mean, rstd);
#if MS >= 2
            f32x4 h[4];
#pragma unroll
            for (int j = 0; j < 4; ++j) { const int c = rowcol(F.lane, j);
                const f32x4 x1 = (v[j] - mean) * rstd * *(const f32x4*)(lw + c) + *(const f32x4*)(lb + c);
                h[j] = x1 * (*(const f32x4*)(mod + b * 6144 + 4096 + c) + 1.0f) + *(const f32x4*)(mod + b * 6144 + 3072 + c); }
            bf16* ao = A3 + (size_t)m * D;
            { v4u o; o.x = pk2(h[0].x, h[0].y); o.y = pk2(h[0].z, h[0].w); o.z = pk2(h[1].x, h[1].y); o.w = pk2(h[1].z, h[1].w); *(v4u*)(ao + 8 * F.lane) = o;
              o.x = pk2(h[2].x, h[2].y); o.y = pk2(h[2].z, h[2].w); o.z = pk2(h[3].x, h[3].y); o.w = pk2(h[3].z, h[3].w); *(v4u*)(ao + 512 + 8 * F.lane) = o; }
            { unsigned char* af = F.ws + WS_A3F + (size_t)m * D; v2u o8;
              o8.x = pack_fp8x4(h[0]); o8.y = pack_fp8x4(h[1]); *(v2u*)(af + 8 * F.lane) = o8; o8.x = pack_fp8x4(h[2]); o8.y = pack_fp8x4(h[3]); *(v2u*)(af + 512 + 8 * F.lane) = o8; }
#endif
        }
    }
}
__device__ __forceinline__ f32x4 fp8x4(unsigned w) { const f32x2 lo = __builtin_amdgcn_cvt_pk_f32_fp8((int)w, false), hi = __builtin_amdgcn_cvt_pk_f32_fp8((int)w, true); return (f32x4){lo.x, lo.y, hi.x, hi.y}; }
__device__ __forceinline__ void ph_final(Frame& F) {
    const float* lw = F.in[34]; const float* lb = F.in[35]; const float* mod = (const float*)(F.ws + WS_MOD);
    const float* lw1 = F.in[26]; const float* lb1 = F.in[27]; const bf16* X1P = (const bf16*)(F.ws + WS_X1);
    const unsigned char* Y = F.ws + WS_Y; const int* DEST = (const int*)(F.ws + WS_DEST); const float* GATE = (const float*)(F.ws + WS_GATE);
    const int c0 = 16 * F.lane;
    for (int m0 = F.gw; m0 < NLAT; m0 += 2 * F.NGW) {
        int mm[2]; mm[0] = m0; mm[1] = (m0 + F.NGW < NLAT) ? m0 + F.NGW : m0;
        v4u xw[2][2];
#if MS >= 2
        v4u dw[2][2]; f32x4 gw[2][2];
#pragma unroll
        for (int r = 0; r < 2; ++r) { dw[r][0] = *(const v4u*)(DEST + mm[r] * 8); dw[r][1] = *(const v4u*)(DEST + mm[r] * 8 + 4); gw[r][0] = *(const f32x4*)(GATE + mm[r] * 8); gw[r][1] = *(const f32x4*)(GATE + mm[r] * 8 + 4); }
#endif
#pragma unroll
        for (int r = 0; r < 2; ++r) { const bf16* row = X1P + (size_t)mm[r] * D + c0; xw[r][0] = *(const v4u*)row; xw[r][1] = *(const v4u*)(row + 8); }
#if MS >= 2
        v4u yw[2][TOPK + 1];
#pragma unroll
        for (int r = 0; r < 2; ++r) {
            int dr[TOPK]; dr[0] = (int)dw[r][0].x; dr[1] = (int)dw[r][0].y; dr[2] = (int)dw[r][0].z; dr[3] = (int)dw[r][0].w; dr[4] = (int)dw[r][1].x; dr[5] = (int)dw[r][1].y; dr[6] = (int)dw[r][1].z; dr[7] = (int)dw[r][1].w;
#pragma unroll
            for (int k = 0; k <= TOPK; ++k) yw[r][k] = *(const v4u*)(Y + (size_t)(k < TOPK ? dr[k < TOPK ? k : 0] : SH_ROW0 + mm[r]) * D + c0); }
        __builtin_amdgcn_sched_barrier(0);
#endif
#pragma unroll
        for (int r = 0; r < 2; ++r) { const int m = mm[r]; const int b = m / SEQ;
            f32x4 v[4];
            v[0] = (f32x4){bflo(xw[r][0].x), bfhi(xw[r][0].x), bflo(xw[r][0].y), bfhi(xw[r][0].y)}; v[1] = (f32x4){bflo(xw[r][0].z), bfhi(xw[r][0].z), bflo(xw[r][0].w), bfhi(xw[r][0].w)};
            v[2] = (f32x4){bflo(xw[r][1].x), bfhi(xw[r][1].x), bflo(xw[r][1].y), bfhi(xw[r][1].y)}; v[3] = (f32x4){bflo(xw[r][1].z), bfhi(xw[r][1].z), bflo(xw[r][1].w), bfhi(xw[r][1].w)};
            { float mean1, rstd1; ln_stats(v, mean1, rstd1);
#pragma unroll
              for (int j = 0; j < 4; ++j) { const int c = c0 + 4 * j; v[j] = ((v[j] - mean1) * rstd1 * *(const f32x4*)(lw1 + c) + *(const f32x4*)(lb1 + c)) * ALPHA; } }
#if MS >= 2
            const float gt[TOPK] = {gw[r][0].x * 0.0625f, gw[r][0].y * 0.0625f, gw[r][0].z * 0.0625f, gw[r][0].w * 0.0625f, gw[r][1].x * 0.0625f, gw[r][1].y * 0.0625f, gw[r][1].z * 0.0625f, gw[r][1].w * 0.0625f};
#pragma unroll
            for (int j = 0; j < 4; ++j) { const unsigned ws8 = j == 0 ? yw[r][TOPK].x : (j == 1 ? yw[r][TOPK].y : (j == 2 ? yw[r][TOPK].z : yw[r][TOPK].w));
                f32x4 mo = fp8x4(ws8) * 0.0625f;
#pragma unroll
                for (int k = 0; k < TOPK; ++k) { const unsigned wk = j == 0 ? yw[r][k].x : (j == 1 ? yw[r][k].y : (j == 2 ? yw[r][k].z : yw[r][k].w)); mo += fp8x4(wk) * gt[k]; }
                v[j] += *(const f32x4*)(mod + b * 6144 + 5120 + c0 + 4 * j) * mo; }
#endif
            float mean, rstd; ln_stats(v, mean, rstd);
            float* o = F.out + (size_t)m * D + c0;
#pragma unroll
            for (int j = 0; j < 4; ++j) { const int c = c0 + 4 * j; *(f32x4*)(o + 4 * j) = (v[j] - mean) * rstd * *(const f32x4*)(lw + c) + *(const f32x4*)(lb + c); }
        }
    }
}


#if MS >= 2
template <int MODE, bool FP8 = false>
__device__ __forceinline__ void cvt_item(const float* W, int Nsrc, int nblk, bf16* WT, int row_off, int dpitch, LAS float* scr, int item, int lane) {
    const int kb = item / nblk, nb = item - kb * nblk, k0 = 64 * kb, n0 = 32 * nb;
    const int nn = n0 + (lane & 31);
#pragma unroll 8
    for (int i = 0; i < 32; ++i) { const int kk = 2 * i + (lane >> 5); scr[kk * 33 + (lane & 31)] = (nn < Nsrc) ? W[(size_t)(k0 + kk) * Nsrc + nn] : 0.f; }
    LDS_WAIT(); asm volatile("" ::: "memory");
    const int c = lane & 7;
#pragma unroll
    for (int j = 0; j < 4; ++j) { const int n = (lane >> 3) + 8 * j; const LAS float* s = scr + (8 * c) * 33 + n;
        v4u o; o.x = pk2(s[0 * 33], s[1 * 33]); o.y = pk2(s[2 * 33], s[3 * 33]); o.z = pk2(s[4 * 33], s[5 * 33]); o.w = pk2(s[6 * 33], s[7 * 33]);
        const int ng = n0 + n; int dr = ng;
        if (MODE == 1) { const int i2 = ng & 255; dr = 8 * (i2 >> 2) + (i2 & 3) + ((ng >= 256) ? 4 : 0); }
        if constexpr (FP8) { v2u o8; o8.x = pack_fp8x4((f32x4){s[0 * 33], s[1 * 33], s[2 * 33], s[3 * 33]} * W8S); o8.y = pack_fp8x4((f32x4){s[4 * 33], s[5 * 33], s[6 * 33], s[7 * 33]} * W8S);
            *(v2u*)((unsigned char*)WT + (size_t)(row_off + dr) * dpitch + k0 + 8 * c) = o8; }
        else *(v4u*)(WT + (size_t)(row_off + dr) * dpitch + k0 + 8 * c) = o; }
    LDS_WAIT(); asm volatile("" ::: "memory");
}

template <int MODE>
__device__ __forceinline__ void cvt_item_reg(const float* W, int Nsrc, bf16* WT, int row_off, int dpitch, int k0, int n0, int lane) {
    const float* src = W + (size_t)k0 * Nsrc + n0 + 4 * lane;
    f32x4 v[32];
#pragma unroll
    for (int i = 0; i < 32; ++i) v[i] = __builtin_nontemporal_load((const f32x4*)(src + (size_t)i * Nsrc));
#pragma unroll
    for (int j = 0; j < 4; ++j) {
        const int ng = n0 + 4 * lane + j; int dr = ng;
        if (MODE == 1) { const int i2 = ng & 255; dr = 8 * (i2 >> 2) + (i2 & 3) + ((ng >= 256) ? 4 : 0); }
        v4u* dst = (v4u*)(WT + (size_t)(row_off + dr) * dpitch + k0);
#pragma unroll
        for (int q = 0; q < 4; ++q) { v4u o; o.x = pk2(v[8 * q][j], v[8 * q + 1][j]); o.y = pk2(v[8 * q + 2][j], v[8 * q + 3][j]); o.z = pk2(v[8 * q + 4][j], v[8 * q + 5][j]); o.w = pk2(v[8 * q + 6][j], v[8 * q + 7][j]); dst[q] = o; }
    }
}

constexpr int CVK = 32;
__device__ __forceinline__ void cvt_reg_load(const float* W, int Nsrc, int k0, int n0, int lane, f32x4 (&v)[CVK]) {
    const float* src = W + (size_t)k0 * Nsrc + n0 + 4 * lane;
#pragma unroll
    for (int i = 0; i < CVK; ++i) v[i] = __builtin_nontemporal_load((const f32x4*)(src + (size_t)i * Nsrc));
}
template <int MODE, bool FP8 = false>
__device__ __forceinline__ void cvt_reg_store(bf16* WT, int row_off, int dpitch, int k0, int n0, int lane, const f32x4 (&v)[CVK]) {
#pragma unroll
    for (int j = 0; j < 4; ++j) {
        const int ng = n0 + 4 * lane + j; int dr = ng;
        if (MODE == 1) { const int i2 = ng & 255; dr = 8 * (i2 >> 2) + (i2 & 3) + ((ng >= 256) ? 4 : 0); }
        if constexpr (FP8) { v4u* dst8 = (v4u*)((unsigned char*)WT + (size_t)(row_off + dr) * dpitch + k0);
#pragma unroll
            for (int q = 0; q < CVK / 16; ++q) { v4u o;
                o.x = pack_fp8x4((f32x4){v[16 * q][j], v[16 * q + 1][j], v[16 * q + 2][j], v[16 * q + 3][j]} * W8S); o.y = pack_fp8x4((f32x4){v[16 * q + 4][j], v[16 * q + 5][j], v[16 * q + 6][j], v[16 * q + 7][j]} * W8S);
                o.z = pack_fp8x4((f32x4){v[16 * q + 8][j], v[16 * q + 9][j], v[16 * q + 10][j], v[16 * q + 11][j]} * W8S); o.w = pack_fp8x4((f32x4){v[16 * q + 12][j], v[16 * q + 13][j], v[16 * q + 14][j], v[16 * q + 15][j]} * W8S); dst8[q] = o; }
            continue; }
        v4u* dst = (v4u*)(WT + (size_t)(row_off + dr) * dpitch + k0);
#pragma unroll
        for (int q = 0; q < CVK / 8; ++q) { v4u o; o.x = pg8::cvt_pk_bf16(v[8 * q][j], v[8 * q + 1][j]); o.y = pg8::cvt_pk_bf16(v[8 * q + 2][j], v[8 * q + 3][j]); o.z = pg8::cvt_pk_bf16(v[8 * q + 4][j], v[8 * q + 5][j]); o.w = pg8::cvt_pk_bf16(v[8 * q + 6][j], v[8 * q + 7][j]); dst[q] = o; }
    }
}
constexpr int CV_GU = (D / CVK) * 2, CV_DN = (FF / CVK) * 4, CV_NGU = (NE + 1) * CV_GU, CV_NITEM = CV_NGU + (NE + 1) * CV_DN;
__device__ __forceinline__ void cvx_load(const float* const* in, int it, int lane, f32x4 (&v)[CVK]) {
    if (it < CV_NGU) { const int e = it / CV_GU, ii = it - e * CV_GU; const float* src = (e < NE) ? in[30] + (size_t)e * D * 512 : in[32];
        cvt_reg_load(src, 512, CVK * (ii >> 1), 256 * (ii & 1), lane, v); }
    else { const int r = it - CV_NGU, e = r / CV_DN, ii = r - e * CV_DN; const float* src = (e < NE) ? in[31] + (size_t)e * FF * D : in[33];
        cvt_reg_load(src, D, CVK * (ii >> 2), 256 * (ii & 3), lane, v); }
}
__device__ __forceinline__ void cvx_store(unsigned char* ws, int it, int lane, const f32x4 (&v)[CVK]) {
    if (it < CV_NGU) { const int e = it / CV_GU, ii = it - e * CV_GU; cvt_reg_store<1, true>((bf16*)(ws + WS_WGU), e * 512, D, CVK * (ii >> 1), 256 * (ii & 1), lane, v); }
    else { const int r = it - CV_NGU, e = r / CV_DN, ii = r - e * CV_DN; cvt_reg_store<0, true>((bf16*)(ws + WS_WD), e * D, FF, CVK * (ii >> 2), 256 * (ii & 3), lane, v); }
}

typedef float f32x2v __attribute__((ext_vector_type(2)));
constexpr int CY_GU = (D / 32) * 4, CY_DN = (FF / 32) * 8, CY_NGU = (NE + 1) * CY_GU, CY_NITEM = CY_NGU + (NE + 1) * CY_DN;
#define CY_KB_GU(ii) ((((ii) >> 4) << 2) | ((ii) & 3))
#define CY_NB_GU(ii) (((ii) >> 2) & 3)
#define CY_KB_DN(ii) ((((ii) >> 5) << 2) | ((ii) & 3))
#define CY_NB_DN(ii) (((ii) >> 2) & 7)
__device__ __forceinline__ void cvy_load(const float* const* in, int it, int lane, f32x2v (&v)[32]) {
    const float* p;  int Nsrc;
    if (it < CY_NGU) { const int e = it / CY_GU, ii = it - e * CY_GU; const float* src = (e < NE) ? in[30] + (size_t)e * D * 512 : in[32]; Nsrc = 512; p = src + (size_t)(32 * CY_KB_GU(ii)) * 512 + 128 * CY_NB_GU(ii) + 2 * lane; }
    else { const int r = it - CY_NGU, e = r / CY_DN, ii = r - e * CY_DN; const float* src = (e < NE) ? in[31] + (size_t)e * FF * D : in[33]; Nsrc = D; p = src + (size_t)(32 * CY_KB_DN(ii)) * D + 128 * CY_NB_DN(ii) + 2 * lane; }
#pragma unroll
    for (int i = 0; i < 32; ++i) v[i] = __builtin_nontemporal_load((const f32x2v*)(p + (size_t)i * Nsrc));
}
__device__ __forceinline__ void cvy_store(unsigned char* ws, int it, int lane, const f32x2v (&v)[32]) {
    unsigned char* base; int dpitch, n0; bool gu = it < CY_NGU;
    if (gu) { const int e = it / CY_GU, ii = it - e * CY_GU; base = ws + WS_WGU + (size_t)(e * 512) * D + 32 * CY_KB_GU(ii); dpitch = D; n0 = 128 * CY_NB_GU(ii); }
    else { const int r = it - CY_NGU, e = r / CY_DN, ii = r - e * CY_DN; base = ws + WS_WD + (size_t)(e * D) * FF + 32 * CY_KB_DN(ii); dpitch = FF; n0 = 128 * CY_NB_DN(ii); }
#pragma unroll
    for (int j = 0; j < 2; ++j) {
        const int ng = n0 + 2 * lane + j; int dr = ng;
        if (gu) { const int i2 = ng & 255; dr = 8 * (i2 >> 2) + (i2 & 3) + ((ng >= 256) ? 4 : 0); }
        v4u* dst8 = (v4u*)(base + (size_t)dr * dpitch);
#pragma unroll
        for (int q = 0; q < 2; ++q) { v4u o;
            o.x = pack_fp8x4((f32x4){v[16 * q][j], v[16 * q + 1][j], v[16 * q + 2][j], v[16 * q + 3][j]} * W8S); o.y = pack_fp8x4((f32x4){v[16 * q + 4][j], v[16 * q + 5][j], v[16 * q + 6][j], v[16 * q + 7][j]} * W8S);
            o.z = pack_fp8x4((f32x4){v[16 * q + 8][j], v[16 * q + 9][j], v[16 * q + 10][j], v[16 * q + 11][j]} * W8S); o.w = pack_fp8x4((f32x4){v[16 * q + 12][j], v[16 * q + 13][j], v[16 * q + 14][j], v[16 * q + 15][j]} * W8S); dst8[q] = o; }
    }
}
#define CVY_FLUSH() do { if (cpend >= 0) cvy_store(F.ws, cpend, lane, cv); cpend = -1; } while (0)
#define CVY_START(item) do { if ((item) < CY_NITEM) { cvy_load(F.in, (item), lane, cv); cpend = (item); } } while (0)

#if MS >= 3
__device__ __forceinline__ float lora_val(const float* const* in, int n, int k) {
    if (n < 1024) { const int q = n >> 3, e8 = n & 7, dir = e8 >> 2, ch = q * 4 + (e8 & 3); return (k < 32) ? in[9][(size_t)(dir * 32 + k) * 512 + ch] : 0.f; }
    if (n < 2048) { const int m = n - 1024, q = m >> 3, e8 = m & 7, dir = e8 >> 2, ch = q * 4 + (e8 & 3); return (k >= 32 && k < 64) ? in[11][(size_t)(dir * 32 + (k - 32)) * 512 + ch] : 0.f; }
    if (n < 2560) { const int ch = n - 2048; return (k >= 64 && k < 160) ? in[12][(size_t)(k - 64) * 512 + ch] : 0.f; }
    { const int m = n - 2560, q = m >> 3, e8 = m & 7, dir = e8 >> 2, ch = q * 4 + (e8 & 3); return (k >= 160 && k < 176) ? in[19][(size_t)(dir * 16 + (k - 160)) * 256 + ch] : 0.f; }
}
#endif

__device__ __forceinline__ void ph_prologue(Frame& F) {
    {
        const float* c = F.in[1]; const float* cc = F.in[3]; const float* wa = F.in[4]; const float* ba = F.in[5];
        float* MOD = (float*)(F.ws + WS_MOD);
        LAS float* S = (LAS float*)F.lds; LAS float* red = (LAS float*)(F.lds + 32768);
        for (int it = blockIdx.x; it < 96; it += F.G) {
            for (int i = F.tid; i < 5120; i += NTHR) { const int r = i >> 10, k = i & 1023; const float cv = r < 4 ? c[r * 1024 + k] : cc[k]; S[i] = siluf_(cv); }
            __syncthreads();
            const int n = it * 64 + F.lane; float acc[5] = {0.f, 0.f, 0.f, 0.f, 0.f};
            for (int kk = 0; kk < 128; ++kk) { const int k = F.wave * 128 + kk; const float wv = wa[(size_t)k * 6144 + n];
#pragma unroll
                for (int r = 0; r < 5; ++r) acc[r] += S[r * 1024 + k] * wv; }
#pragma unroll
            for (int r = 0; r < 5; ++r) red[(F.wave * 5 + r) * 64 + F.lane] = acc[r];
            __syncthreads();
            if (F.wave == 0) {
#pragma unroll
                for (int r = 0; r < 5; ++r) { float s = 0.f;
#pragma unroll
                    for (int w = 0; w < 8; ++w) s += red[(w * 5 + r) * 64 + F.lane];
                    MOD[r * 6144 + n] = s + ba[n]; }
            }
            __syncthreads();
        }
    }
    {
        LAS float* scr = (LAS float*)(F.lds + F.wave * 16384);
        constexpr int I_IN = 16 * 168, I_BR = 8 * 32, I_OUT = 16 * 32, I_RT = 16 * 8, I_GU = 32 * 2, I_DN = 8 * 4;
        constexpr int T0 = I_IN, T1 = T0 + I_BR, T2 = T1 + I_BR, T3 = T2 + I_OUT, T4 = T3 + I_RT, T5 = T4 + (NE + 1) * I_GU, T6 = T5 + (NE + 1) * I_DN;
        unsigned char* ws = F.ws;
        for (int it = F.gw; it < T6; it += F.NGW) {
#if MS >= 3
            if (it < T0) { cvt_item<0, true>(F.in[6], IN_COLS, 168, (bf16*)(ws + WS_WIN), 0, D, scr, it, F.lane); continue; }
            if (it < T1) { cvt_item<0, true>(F.in[23], D, 32, (bf16*)(ws + WS_WBRRW), 0, RWW, scr, it - T0, F.lane); continue; }
            if (it < T2) { cvt_item<0, true>(F.in[24], D, 32, (bf16*)(ws + WS_WBRGLA), 0, RWW, scr, it - T1, F.lane); continue; }
            if (it < T3) { cvt_item<0, true>(F.in[25], D, 32, (bf16*)(ws + WS_WOUT), 0, D, scr, it - T2, F.lane); continue; }
#else
            if (it < T3) continue;
#endif
            if (it < T4) { cvt_item<0>(F.in[28], NE, 8, (bf16*)(ws + WS_WROUTER), 0, D, scr, it - T3, F.lane); continue; }
#if MS >= 3
            break;
#endif
            if (it < T5) { const int r = it - T4, e = r / I_GU, ii = r - e * I_GU;
                const float* src = (e < NE) ? F.in[30] + (size_t)e * D * 512 : F.in[32];
                cvt_item_reg<1>(src, 512, (bf16*)(ws + WS_WGU), e * 512, D, 32 * (ii >> 1), 256 * (ii & 1), F.lane); continue; }
            { const int r = it - T5, e = r / I_DN, ii = r - e * I_DN;
                const float* src = (e < NE) ? F.in[31] + (size_t)e * FF * D : F.in[33];
                cvt_item_reg<0>(src, D, (bf16*)(ws + WS_WD), e * D, FF, 32 * (ii >> 2), 256 * (ii & 3), F.lane); }
        }
    }
#if MS >= 3
    {
        bf16* WL = (bf16*)(F.ws + WS_WLORA);
        for (int idx = blockIdx.x * NTHR + F.tid; idx < NLORA * (KLORA / 8); idx += F.G * NTHR) {
            const int n = idx >> 5, k0 = (idx & 31) * 8; float v[8];
#pragma unroll
            for (int e = 0; e < 8; ++e) v[e] = lora_val(F.in, n, k0 + e);
            v4u o; o.x = pk2(v[0], v[1]); o.y = pk2(v[2], v[3]); o.z = pk2(v[4], v[5]); o.w = pk2(v[6], v[7]);
            *(v4u*)(WL + (size_t)n * KLORA + k0) = o;
        }
    }
#endif
}

struct EpiF32 {
    static constexpr bool PERM = false;
    float* C; int ldc;
    __device__ __forceinline__ void operator()(const f32x4 (&acc)[2][2][4][2], const pg8::Unit& u, int wr, int wc, int fr, int fq) const {
        const int row0 = u.pm * 256 + wr * 64 + fr, col0 = u.pn * 256 + wc * 32 + 4 * fq;
#pragma unroll
        for (int ai = 0; ai < 2; ++ai)
#pragma unroll
            for (int m = 0; m < 4; ++m) { float* rowp = C + (size_t)(row0 + ai * 128 + m * 16) * ldc + col0;
#pragma unroll
                for (int bj = 0; bj < 2; ++bj)
#pragma unroll
                    for (int n = 0; n < 2; ++n) *(f32x4*)(rowp + bj * 128 + n * 16) = acc[ai][bj][m][n]; }
    }
};
struct EpiSwiglu {
    static constexpr bool PERM = true;
    unsigned char* ACT;
    __device__ __forceinline__ void operator()(const f32x4 (&acc)[2][2][4][2], const pg8::Unit& u, int wr, int wc, int fr, int fq) const {
        const int row0 = u.pm * 256 + wr * 64 + fr, h0 = u.j * 128 + wc * 16 + 4 * fq;
#pragma unroll
        for (int ai = 0; ai < 2; ++ai)
#pragma unroll
            for (int m = 0; m < 4; ++m) { unsigned char* rowp = ACT + (size_t)(row0 + ai * 128 + m * 16) * FF + h0;
#pragma unroll
                for (int bj = 0; bj < 2; ++bj) { const f32x4 a = acc[ai][bj][m][0] * W8I, b = acc[ai][bj][m][1] * W8I;
                    *(unsigned*)(rowp + bj * 64) = pack_fp8x4((f32x4){siluf_(a[0]) * b[0], siluf_(a[1]) * b[1], siluf_(a[2]) * b[2], siluf_(a[3]) * b[3]}); } }
    }
};
struct EpiRowsBf16 {
    static constexpr bool PERM = true;
    bf16* O; int ldc; float sc;
    __device__ __forceinline__ void operator()(const f32x4 (&acc)[2][2][4][2], const pg8::Unit& u, int wr, int wc, int fr, int fq) const {
        const int row0 = u.pm * 256 + wr * 64 + fr, col0 = u.j * 256 + wc * 32 + 8 * fq;
#pragma unroll
        for (int ai = 0; ai < 2; ++ai)
#pragma unroll
            for (int m = 0; m < 4; ++m) { bf16* rowp = O + (size_t)(row0 + ai * 128 + m * 16) * ldc + col0;
#pragma unroll
                for (int bj = 0; bj < 2; ++bj) { const f32x4 v0 = acc[ai][bj][m][0] * sc, v1 = acc[ai][bj][m][1] * sc;
                    v4u w; w.x = pg8::cvt_pk_bf16(v0[0], v0[1]); w.y = pg8::cvt_pk_bf16(v0[2], v0[3]); w.z = pg8::cvt_pk_bf16(v1[0], v1[1]); w.w = pg8::cvt_pk_bf16(v1[2], v1[3]);
                    *(v4u*)(rowp + bj * 128) = w;
#ifdef PROBE_ST2
                    asm volatile("" ::: "memory"); *(volatile v4u*)(rowp + bj * 128) = w;
#endif
                    } }
    }
};

struct EpiRowsFp8 {
    static constexpr bool PERM = true;
    unsigned char* O;
    __device__ __forceinline__ void operator()(const f32x4 (&acc)[2][2][4][2], const pg8::Unit& u, int wr, int wc, int fr, int fq) const {
        const int row0 = u.pm * 256 + wr * 64 + fr, col0 = u.j * 256 + wc * 32 + 8 * fq;
#pragma unroll
        for (int ai = 0; ai < 2; ++ai)
#pragma unroll
            for (int m = 0; m < 4; ++m) { unsigned char* rowp = O + (size_t)(row0 + ai * 128 + m * 16) * D + col0;
#pragma unroll
                for (int bj = 0; bj < 2; ++bj) { f32x4 v0 = acc[ai][bj][m][0] * (16.0f * W8I), v1 = acc[ai][bj][m][1] * (16.0f * W8I);
#pragma unroll
                    for (int e = 0; e < 4; ++e) { v0[e] = __builtin_amdgcn_fmed3f(v0[e], -448.0f, 448.0f); v1[e] = __builtin_amdgcn_fmed3f(v1[e], -448.0f, 448.0f); }
                    int w0 = __builtin_amdgcn_cvt_pk_fp8_f32(v0[0], v0[1], 0, false); w0 = __builtin_amdgcn_cvt_pk_fp8_f32(v0[2], v0[3], w0, true);
                    int w1 = __builtin_amdgcn_cvt_pk_fp8_f32(v1[0], v1[1], 0, false); w1 = __builtin_amdgcn_cvt_pk_fp8_f32(v1[2], v1[3], w1, true);
                    v2u w; w.x = (unsigned)w0; w.y = (unsigned)w1; *(v2u*)(rowp + bj * 128) = w; } }
    }
};

__device__ __forceinline__ void ph_router(Frame& F) {
    pg8::Gemm g{(const bf16*)(F.ws + WS_A3), (const bf16*)(F.ws + WS_WROUTER), NLAT, NE, D, nullptr};
    pg8::StaticOrder S; S.init(NLAT, NE, F.G, (int)blockIdx.x);
    EpiF32 E{(float*)(F.ws + WS_LOGITS), NE};
    pg8::gemm_phase<EpiF32, pg8::StaticOrder, true, true, false>(F.lds, g, S, E);
}

#define RT_DPP(x, ctrl) __builtin_amdgcn_update_dpp(0, (x), (ctrl), 0xf, 0xf, false)
__device__ __forceinline__ unsigned wave_max_u32(unsigned k) {
    k = max(k, (unsigned)RT_DPP((int)k, 0xB1)); k = max(k, (unsigned)RT_DPP((int)k, 0x4E));
    k = max(k, (unsigned)RT_DPP((int)k, 0x124)); k = max(k, (unsigned)RT_DPP((int)k, 0x128));
    const unsigned a = (unsigned)__builtin_amdgcn_readlane((int)k, 0), b = (unsigned)__builtin_amdgcn_readlane((int)k, 16), c = (unsigned)__builtin_amdgcn_readlane((int)k, 32), d = (unsigned)__builtin_amdgcn_readlane((int)k, 48);
    return max(max(a, b), max(c, d));
}
__device__ __forceinline__ void ph_route(Frame& F) {
    const float* LOG = (const float*)(F.ws + WS_LOGITS); const float* rb = F.in[29];
    int* EIDX = (int*)(F.ws + WS_EIDX); float* GATE = (float*)(F.ws + WS_GATE); int* DEST = (int*)(F.ws + WS_DEST);
    unsigned* CNT = F.ctl + CW_CNT;
    const f32x4 bias = *(const f32x4*)(rb + 4 * F.lane);
    f32x4 lgn = *(const f32x4*)(LOG + (size_t)(F.gw < NLAT ? F.gw : 0) * NE + 4 * F.lane);
    for (int m = F.gw; m < NLAT; m += F.NGW) {
        const f32x4 lg = lgn;
        { const int mn = (m + F.NGW < NLAT) ? m + F.NGW : m; lgn = *(const f32x4*)(LOG + (size_t)mn * NE + 4 * F.lane); }
        float sc[4], sel[4];
#pragma unroll
        for (int i = 0; i < 4; ++i) { sc[i] = sigmoidf_(lg[i]); sel[i] = sc[i] + bias[i]; }
        float m1 = fmaxf(sel[0], sel[1]), m2 = fminf(sel[0], sel[1]);
        { const float a = sel[2]; const float n1 = fmaxf(m1, a); m2 = fmaxf(m2, fminf(m1, a)); m1 = n1; }
        { const float a = sel[3]; const float n1 = fmaxf(m1, a); m2 = fmaxf(m2, fminf(m1, a)); m1 = n1; }
#define RT_MERGE(ctrl) do { const float b1 = __builtin_bit_cast(float, RT_DPP(__builtin_bit_cast(int, m1), ctrl)), b2 = __builtin_bit_cast(float, RT_DPP(__builtin_bit_cast(int, m2), ctrl)); \
            const float n1 = fmaxf(m1, b1); m2 = fmaxf(fminf(m1, b1), fmaxf(m2, b2)); m1 = n1; } while (0)
        RT_MERGE(0xB1); RT_MERGE(0x4E); RT_MERGE(0x141);
#undef RT_MERGE
        const float gs = m1 + m2; const int g = F.lane >> 3;
        int rank = 0;
#pragma unroll
        for (int gg = 0; gg < 8; ++gg) { const float og = __builtin_bit_cast(float, __builtin_amdgcn_readlane(__builtin_bit_cast(int, gs), gg * 8)); rank += (og > gs || (og == gs && gg < g)) ? 1 : 0; }
        const bool keep = rank < 4;
        unsigned key[4];
#pragma unroll
        for (int i = 0; i < 4; ++i) { unsigned u = __builtin_bit_cast(unsigned, sel[i]); u ^= (u >> 31) ? 0xffffffffu : 0x80000000u;
            key[i] = keep ? ((u & 0xffffff00u) | (unsigned)(255 - (4 * F.lane + i))) : 0u; }
        int my_e = 0; float my_s = 0.f; float ssum = 0.f;
#pragma unroll
        for (int k = 0; k < TOPK; ++k) {
            const unsigned best = wave_max_u32(max(max(key[0], key[1]), max(key[2], key[3])));
            const int e = 255 - (int)(best & 255u), owner = e >> 2;
            float s_own = 0.f;
#pragma unroll
            for (int i = 0; i < 4; ++i) if (key[i] == best) { s_own = sc[i]; key[i] = 0u; }
            const float s = __builtin_bit_cast(float, __builtin_amdgcn_readlane(__builtin_bit_cast(int, s_own), owner));
            ssum += s;
            if (F.lane == k) { my_e = e; my_s = s; }
        }
        if (F.lane < TOPK) {
            const unsigned pos = __hip_atomic_fetch_add(CNT + my_e * CNT_STRIDE, 1u, __ATOMIC_RELAXED, __HIP_MEMORY_SCOPE_AGENT);
            EIDX[m * 8 + F.lane] = my_e; GATE[m * 8 + F.lane] = my_s * __builtin_amdgcn_rcpf(ssum) * 2.5f; DEST[m * 8 + F.lane] = (int)pos;
        }
    }
}
#undef RT_DPP

__device__ __forceinline__ void ph_scatter(Frame& F) {
    LAS int* tstart = (LAS int*)F.lds;
    LAS int* scan = (LAS int*)(F.lds + 2048);
    LAS int* cnts = (LAS int*)(F.lds + 4096);
    int* EIDX = (int*)(F.ws + WS_EIDX); int* DEST = (int*)(F.ws + WS_DEST); int* ROWTOK = (int*)(F.ws + WS_ROWTOK); int* TILE_E = (int*)(F.ws + WS_TILE_E);
    unsigned* CNT = F.ctl + CW_CNT;
    int tiles = 0, cnt = 0;
    if (F.tid < NE) { cnt = (int)__hip_atomic_load(CNT + F.tid * CNT_STRIDE, __ATOMIC_RELAXED, __HIP_MEMORY_SCOPE_AGENT); tiles = (cnt + 255) >> 8; scan[F.tid] = tiles; cnts[F.tid] = cnt; }
    __syncthreads();
    for (int o = 1; o < NE; o <<= 1) { int v = 0; if (F.tid < NE && F.tid >= o) v = scan[F.tid - o]; __syncthreads(); if (F.tid < NE) scan[F.tid] += v; __syncthreads(); }
    if (F.tid < NE) { tstart[F.tid + 1] = scan[F.tid]; if (F.tid == 0) tstart[0] = 0; }
    __syncthreads();
    const int NT = tstart[NE];
    if (blockIdx.x == 0) {
        if (F.tid == 0) F.ctl[CW_NT] = (unsigned)NT;
        if (F.tid < NE) for (int t = tstart[F.tid]; t < tstart[F.tid + 1]; ++t) TILE_E[t] = F.tid;
    }
    for (int e = blockIdx.x; e < NE; e += F.G) { const int c0 = cnts[e], c1 = (tstart[e + 1] - tstart[e]) * 256, base = tstart[e] * 256;
        for (int p = c0 + F.tid; p < c1; p += NTHR) ROWTOK[base + p] = 0; }
    for (int i = blockIdx.x * NTHR + F.tid; i < NLAT; i += F.G * NTHR) ROWTOK[SH_ROW0 + i] = i;
    for (int i = blockIdx.x * NTHR + F.tid; i < NLAT * TOPK; i += F.G * NTHR) {
        const int e = EIDX[i], pos = DEST[i]; const int dr = tstart[e] * 256 + pos;
        DEST[i] = dr; ROWTOK[dr] = i >> 3;
    }
}

__device__ __forceinline__ void ph_exp1(Frame& F) {
    const int NT = (int)__hip_atomic_load(F.ctl + CW_NT, __ATOMIC_RELAXED, __HIP_MEMORY_SCOPE_AGENT);
    pg8::Gemm g{(const bf16*)(F.ws + WS_A3F), (const bf16*)(F.ws + WS_WGU), 0, 0, D / 2, (const int*)(F.ws + WS_ROWTOK)};
    pg8::MoeOrder S{2, F.G, (int)blockIdx.x, NT, (const int*)(F.ws + WS_TILE_E)};
    EpiSwiglu E{F.ws + WS_ACT};
    pg8::gemm_phase<EpiSwiglu, pg8::MoeOrder, true, true, true, true>(F.lds, g, S, E);
}
__device__ __forceinline__ void ph_exp2(Frame& F) {
    const int NT = (int)__hip_atomic_load(F.ctl + CW_NT, __ATOMIC_RELAXED, __HIP_MEMORY_SCOPE_AGENT);
    pg8::Gemm g{(const bf16*)(F.ws + WS_ACT), (const bf16*)(F.ws + WS_WD), 0, 0, FF / 2, nullptr};
    pg8::MoeOrder S{4, F.G, (int)blockIdx.x, NT, (const int*)(F.ws + WS_TILE_E)};
    EpiRowsFp8 E{F.ws + WS_Y};
    pg8::gemm_phase<EpiRowsFp8, pg8::MoeOrder, true, true, false, true>(F.lds, g, S, E);
}
#endif

#if MS >= 3
__device__ __forceinline__ void unp8(const v4u w, float (&f)[8]) { f[0] = bflo(w.x); f[1] = bfhi(w.x); f[2] = bflo(w.y); f[3] = bfhi(w.y); f[4] = bflo(w.z); f[5] = bfhi(w.z); f[6] = bflo(w.w); f[7] = bfhi(w.w); }
__device__ __forceinline__ void unp8f8(const v2u w, float (&f)[8]) { const f32x2 a = __builtin_amdgcn_cvt_pk_f32_fp8((int)w.x, false), b = __builtin_amdgcn_cvt_pk_f32_fp8((int)w.x, true), c = __builtin_amdgcn_cvt_pk_f32_fp8((int)w.y, false), d = __builtin_amdgcn_cvt_pk_f32_fp8((int)w.y, true);
    f[0] = a.x; f[1] = a.y; f[2] = b.x; f[3] = b.y; f[4] = c.x; f[5] = c.y; f[6] = d.x; f[7] = d.y; }
__device__ __forceinline__ v4u pk8(const float (&f)[8]) { v4u o; o.x = pk2(f[0], f[1]); o.y = pk2(f[2], f[3]); o.z = pk2(f[4], f[5]); o.w = pk2(f[6], f[7]); return o; }
__device__ __forceinline__ void st8(float* p, const float (&f)[8]) { *(f32x4*)p = (f32x4){f[0], f[1], f[2], f[3]}; *(f32x4*)(p + 4) = (f32x4){f[4], f[5], f[6], f[7]}; }
__device__ __forceinline__ void ld8(const float* p, float (&f)[8]) { const f32x4 a = *(const f32x4*)p, b = *(const f32x4*)(p + 4); f[0] = a.x; f[1] = a.y; f[2] = a.z; f[3] = a.w; f[4] = b.x; f[5] = b.y; f[6] = b.z; f[7] = b.w; }

__device__ __forceinline__ void ph_a1(Frame& F) {
    const float* mod = (const float*)(F.ws + WS_MOD); unsigned char* A1 = F.ws + WS_A1;
    constexpr int NR = 4;
    for (int m0 = F.gw; m0 < MR; m0 += NR * F.NGW) {
        f32x4 xv[NR][4];
#pragma unroll
        for (int r = 0; r < NR; ++r) { const int mm = m0 + r * F.NGW; const int m = mm < MR ? mm : m0;
            const float* src = (m < NLAT) ? F.in[0] + (size_t)m * D : F.in[2] + (size_t)(m - NLAT) * D;
            const f32x4* xr = (const f32x4*)src + F.lane;
#pragma unroll
            for (int j = 0; j < 4; ++j) xv[r][j] = __builtin_nontemporal_load(xr + 64 * j); }
        __builtin_amdgcn_sched_barrier(0);
#pragma unroll
        for (int r = 0; r < NR; ++r) { const int mm = m0 + r * F.NGW; const int m = mm < MR ? mm : m0; const int mr = (m < NLAT) ? (m / SEQ) : 4;
            unsigned* ao = (unsigned*)(A1 + (size_t)m * D) + F.lane;
#pragma unroll
            for (int j = 0; j < 4; ++j) { const int c = 4 * F.lane + 256 * j;
                const f32x4 sh = *(const f32x4*)(mod + mr * 6144 + c), sc = *(const f32x4*)(mod + mr * 6144 + 1024 + c);
                const f32x4 h = xv[r][j] * (sc + 1.0f) + sh; ao[64 * j] = pack_fp8x4(h); } }
    }
}

__device__ __forceinline__ void ph_inproj(Frame& F) {
    pg8::Gemm g{(const bf16*)(F.ws + WS_A1), (const bf16*)(F.ws + WS_WIN), MR, NP, D / 2, nullptr};
    pg8::StaticOrder S; S.init(MR, NP, F.G, (int)blockIdx.x);
    EpiRowsBf16 E{(bf16*)(F.ws + WS_P), NP, W8I};
    pg8::gemm_phase<EpiRowsBf16, pg8::StaticOrder, true, true, false, true>(F.lds, g, S, E);
}

__device__ __forceinline__ v2u pk8f8(const float (&v)[8]) { v2u o; o.x = pack_fp8x4((f32x4){v[0], v[1], v[2], v[3]}); o.y = pack_fp8x4((f32x4){v[4], v[5], v[6], v[7]}); return o; }
struct FeatOut { bf16 *R, *V, *KK, *KP, *QG, *KGB, *VGB, *A2; const float *mu, *kkw, *cw; };
__device__ __forceinline__ void feat_rw(const FeatOut& O, int p, size_t m, int lane, const v4u own_w, const v4u (&nbw)[4], const float (&muv)[8]) {
    float own[8], sh[4][8], val[8];
    unp8(own_w, own);
#pragma unroll
    for (int q = 0; q < 4; ++q) unp8(nbw[q], sh[q]);
#pragma unroll
    for (int e = 0; e < 8; ++e) val[e] = own[e] + muv[e] * (sh[e & 3][e] - own[e]);
    if (p == 0) *(v4u*)(O.R + m * RWW + 8 * lane) = pk8(val);
    else if (p == 2) *(v4u*)(O.V + m * RWW + 8 * lane) = pk8(val);
    else if (p == 1) {
        *(v4u*)(O.KP + m * RWW + 8 * lane) = pk8(val);
        float kw[8]; ld8(O.kkw + 8 * lane, kw); float kkv[8]; float ss = 0.f;
#pragma unroll
        for (int e = 0; e < 8; ++e) { kkv[e] = val[e] * kw[e]; ss += kkv[e] * kkv[e]; }
        ss += __shfl_xor(ss, 1); ss += __shfl_xor(ss, 2); ss += __shfl_xor(ss, 4);
        const float inv = 1.0f / fmaxf(sqrtf(ss), 1e-12f);
#pragma unroll
        for (int e = 0; e < 8; ++e) kkv[e] *= inv;
        *(v4u*)(O.KK + m * RWW + 8 * lane) = pk8(kkv);
    } else {
        float o[8];
#pragma unroll
        for (int e = 0; e < 8; ++e) o[e] = (lane < 4) ? tanhf_(val[e]) : ((lane < 8) ? val[e] : sigmoidf_(val[e]));
        *(v4u*)(O.A2 + m * KLORA + 8 * lane) = pk8(o);
    }
}
__device__ __forceinline__ void feat_gla_store(const FeatOut& O, int p, size_t m, int lane, const float (&acc)[8]) {
    const int cq = p * 512 + 8 * lane; float o[8];
#pragma unroll
    for (int e = 0; e < 8; ++e) o[e] = siluf_(acc[e]);
    if (p == 0) {
        if (lane < 32) {
#pragma unroll
            for (int e = 0; e < 8; ++e) o[e] *= 0.125f;
            *(v4u*)(O.QG + m * 256 + cq) = pk8(o);
        } else *(v4u*)(O.KGB + m * 256 + (cq - 256)) = pk8(o);
    } else *(v4u*)(O.VGB + m * RWW + (cq - 512)) = pk8(o);
}
__device__ __forceinline__ void ph_feat(Frame& F) {
    const bf16* P = (const bf16*)(F.ws + WS_P);
    FeatOut O{(bf16*)(F.ws + WS_RB), (bf16*)(F.ws + WS_VB), (bf16*)(F.ws + WS_KKB), (bf16*)(F.ws + WS_KMF), (bf16*)(F.ws + WS_QGB), (bf16*)(F.ws + WS_KGB), (bf16*)(F.ws + WS_VGB), (bf16*)(F.ws + WS_A2), F.in[7], F.in[13], F.in[18]};
    const v4u Z4 = (v4u){0u, 0u, 0u, 0u};
    for (int blk = F.gw; blk < NB * (GRIDH / 2) * (GRIDW / 2); blk += F.NGW) {
        int lane = F.lane; asm volatile("" : "+v"(lane));
        const int b = blk >> 11, r0 = 2 * ((blk >> 5) & 63), c0 = 2 * (blk & 31); const int mb = b * SEQ + r0 * GRIDW + c0;
        const bool vu = r0 > 0, vd = r0 + 2 < GRIDH, vl = c0 > 0, vr = c0 + 2 < GRIDW;
#pragma unroll
        for (int p = 0; p < 4; ++p) {
            const int cb = p * 512 + 8 * lane; const bool act = (p < 3) || lane < 20;
            v4u own[2][2], up[2], dn[2], lf[2], rt[2];
#pragma unroll
            for (int i = 0; i < 2; ++i) { up[i] = Z4; dn[i] = Z4; lf[i] = Z4; rt[i] = Z4; own[i][0] = Z4; own[i][1] = Z4; }
            if (act) {
#pragma unroll
                for (int i = 0; i < 2; ++i) {
#pragma unroll
                    for (int j = 0; j < 2; ++j) own[i][j] = *(const v4u*)(P + (size_t)(mb + 64 * i + j) * NP + cb);
                    if (vu) up[i] = *(const v4u*)(P + (size_t)(mb - 64 + i) * NP + cb);
                    if (vd) dn[i] = *(const v4u*)(P + (size_t)(mb + 128 + i) * NP + cb);
                    if (vl) lf[i] = *(const v4u*)(P + (size_t)(mb + 64 * i - 1) * NP + cb);
                    if (vr) rt[i] = *(const v4u*)(P + (size_t)(mb + 64 * i + 2) * NP + cb); }
            } else if (p == 3 && lane >= 20 && lane < 22) {
#pragma unroll
                for (int i = 0; i < 2; ++i)
#pragma unroll
                    for (int j = 0; j < 2; ++j) own[i][j] = *(const v4u*)(P + (size_t)(mb + 64 * i + j) * NP + C_PGL + 8 * (lane - 20));
            }
            float muv[8] = {0.f, 0.f, 0.f, 0.f, 0.f, 0.f, 0.f, 0.f}; if (act) ld8(O.mu + cb, muv);
            __builtin_amdgcn_sched_barrier(0);
#pragma unroll
            for (int i = 0; i < 2; ++i)
#pragma unroll
                for (int j = 0; j < 2; ++j) { const size_t m = (size_t)(mb + 64 * i + j);
                    if (act) { const v4u nbw[4] = {j == 0 ? lf[i] : own[i][0], j == 1 ? rt[i] : own[i][1], i == 0 ? up[j] : own[0][j], i == 1 ? dn[j] : own[1][j]};
                        feat_rw(O, p, m, lane, own[i][j], nbw, muv); }
                    else if (p == 3 && lane < 32) *(v4u*)(O.A2 + m * KLORA + 8 * lane) = own[i][j]; }
        }
#pragma unroll
        for (int p = 0; p < 2; ++p) {
            const int cq = p * 512 + 8 * lane, cb = C_Q + cq;
            v4u g[4][4];
#pragma unroll
            for (int a2 = 0; a2 < 4; ++a2)
#pragma unroll
                for (int b2 = 0; b2 < 4; ++b2) { const bool ok = (a2 == 0 ? vu : (a2 == 3 ? vd : true)) && (b2 == 0 ? vl : (b2 == 3 ? vr : true));
                    g[a2][b2] = Z4; if (ok) g[a2][b2] = *(const v4u*)(P + (size_t)(mb + 64 * (a2 - 1) + (b2 - 1)) * NP + cb); }
            __builtin_amdgcn_sched_barrier(0);
            float acc[2][2][8];
#pragma unroll
            for (int i = 0; i < 2; ++i)
#pragma unroll
                for (int j = 0; j < 2; ++j)
#pragma unroll
                    for (int e = 0; e < 8; ++e) acc[i][j][e] = 0.f;
#pragma unroll
            for (int dy = 0; dy < 3; ++dy)
#pragma unroll
                for (int dx = 0; dx < 3; ++dx) { float wv[8]; ld8(O.cw + (dy * 3 + dx) * 1024 + cq, wv);
#pragma unroll
                    for (int i = 0; i < 2; ++i)
#pragma unroll
                        for (int j = 0; j < 2; ++j) { float pv[8]; unp8(g[i + dy][j + dx], pv);
#pragma unroll
                            for (int e = 0; e < 8; ++e) acc[i][j][e] += pv[e] * wv[e]; } }
#pragma unroll
            for (int i = 0; i < 2; ++i)
#pragma unroll
                for (int j = 0; j < 2; ++j) feat_gla_store(O, p, (size_t)(mb + 64 * i + j), lane, acc[i][j]);
        }
    }
    for (int m = NLAT + F.gw; m < MR; m += F.NGW) {
        int lane = F.lane; asm volatile("" : "+v"(lane));
        const int t = (m - NLAT) & (CTXL - 1); const bool vp = t > 0, vn = t < CTXL - 1;
#pragma unroll
        for (int p = 0; p < 4; ++p) {
            const int cb = p * 512 + 8 * lane; const bool act = (p < 3) || lane < 20;
            if (act) { const v4u own = *(const v4u*)(P + (size_t)m * NP + cb); v4u pv = Z4, nv = Z4;
                if (vp) pv = *(const v4u*)(P + (size_t)(m - 1) * NP + cb); if (vn) nv = *(const v4u*)(P + (size_t)(m + 1) * NP + cb);
                float muv[8]; ld8(O.mu + cb, muv); const v4u nbw[4] = {pv, nv, pv, nv};
                feat_rw(O, p, (size_t)m, lane, own, nbw, muv); }
            else if (p == 3 && lane < 32) { v4u w = Z4; if (lane < 22) w = *(const v4u*)(P + (size_t)m * NP + C_PGL + 8 * (lane - 20)); *(v4u*)(O.A2 + (size_t)m * KLORA + 8 * lane) = w; }
        }
#pragma unroll
        for (int p = 0; p < 2; ++p) {
            const int cq = p * 512 + 8 * lane, cb = C_Q + cq; float acc[8] = {0.f, 0.f, 0.f, 0.f, 0.f, 0.f, 0.f, 0.f};
#pragma unroll
            for (int dx = -1; dx <= 1; ++dx) { const bool ok = (dx < 0) ? vp : ((dx > 0) ? vn : true);
                if (ok) { float pv[8], wv[8]; unp8(*(const v4u*)(P + (size_t)(m + dx) * NP + cb), pv); ld8(O.cw + (3 + dx + 1) * 1024 + cq, wv);
#pragma unroll
                    for (int e = 0; e < 8; ++e) acc[e] += pv[e] * wv[e]; } }
            feat_gla_store(O, p, (size_t)m, lane, acc);
        }
    }
}

struct EpiLora {
    static constexpr bool PERM = true;
    unsigned char* ws; const float* const* in;
    __device__ __forceinline__ void grp_w(const f32x4 (&acc)[2][2][4][2], int row0, int c0) const {
        bf16* Wf = (bf16*)(ws + WS_LWF); bf16* Wb = (bf16*)(ws + WS_LWB);
#pragma unroll
        for (int bj = 0; bj < 2; ++bj) { const int ch = (c0 + bj * 128) >> 1; const f32x4 w0f = *(const f32x4*)(in[8] + ch), w0b = *(const f32x4*)(in[8] + 512 + ch);
#pragma unroll
            for (int ai = 0; ai < 2; ++ai)
#pragma unroll
                for (int m = 0; m < 4; ++m) { const size_t row = (size_t)(row0 + ai * 128 + m * 16);
                    const f32x4 xf = acc[ai][bj][m][0] + w0f, xb = acc[ai][bj][m][1] + w0b; f32x4 df, db;
#pragma unroll
                    for (int e = 0; e < 4; ++e) { df[e] = -0.60653066f * sigmoidf_(xf[e]); db[e] = -0.60653066f * sigmoidf_(xb[e]); }
                    { v2u o; o.x = pk2(df[0], df[1]); o.y = pk2(df[2], df[3]); *(v2u*)(Wf + row * RWW + ch) = o; o.x = pk2(db[0], db[1]); o.y = pk2(db[2], db[3]); *(v2u*)(Wb + row * RWW + ch) = o; } } }
    }
    __device__ __forceinline__ void grp_a(const f32x4 (&acc)[2][2][4][2], int row0, int c0) const {
        bf16* KMf = (bf16*)(ws + WS_KMF); bf16* KMb = (bf16*)(ws + WS_KMB); bf16* BVf = (bf16*)(ws + WS_BVF); bf16* BVb = (bf16*)(ws + WS_BVB);
        const bf16* KK = (const bf16*)(ws + WS_KKB); bf16* KSUM = (bf16*)(ws + WS_KSUM);
#pragma unroll
        for (int bj = 0; bj < 2; ++bj) { const int ch = (c0 + bj * 128 - 1024) >> 1; const f32x4 a0f = *(const f32x4*)(in[10] + ch), a0b = *(const f32x4*)(in[10] + 512 + ch), ka = *(const f32x4*)(in[14] + ch);
#pragma unroll
            for (int ai = 0; ai < 2; ++ai) {
            v2u kpw[2][4], kkw[2][4];
#pragma unroll
                for (int m = 0; m < 4; ++m) { const size_t row = (size_t)(row0 + ai * 128 + m * 16); kpw[ai][m] = *(const v2u*)(KMf + row * RWW + ch); kkw[ai][m] = *(const v2u*)(KK + row * RWW + ch); }
            __builtin_amdgcn_sched_barrier(0);
#pragma unroll
                for (int m = 0; m < 4; ++m) { const size_t row = (size_t)(row0 + ai * 128 + m * 16);
                    const f32x4 xf = acc[ai][bj][m][0] + a0f, xb = acc[ai][bj][m][1] + a0b;
                    const f32x4 kp = (f32x4){bflo(kpw[ai][m].x), bfhi(kpw[ai][m].x), bflo(kpw[ai][m].y), bfhi(kpw[ai][m].y)}, kk = (f32x4){bflo(kkw[ai][m].x), bfhi(kkw[ai][m].x), bflo(kkw[ai][m].y), bfhi(kkw[ai][m].y)};
                    f32x4 kmf, kmb, bvf, bvb;
#pragma unroll
                    for (int e = 0; e < 4; ++e) { const float af = sigmoidf_(xf[e]), ab = sigmoidf_(xb[e]);
                        kmf[e] = kp[e] * (1.0f + (af - 1.0f) * ka[e]); kmb[e] = kp[e] * (1.0f + (ab - 1.0f) * ka[e]); bvf[e] = kk[e] * af; bvb[e] = kk[e] * ab; }
                    { v2u o; o.x = pk2(kmf[0], kmf[1]); o.y = pk2(kmf[2], kmf[3]); *(v2u*)(KMf + row * RWW + ch) = o; o.x = pk2(kmb[0], kmb[1]); o.y = pk2(kmb[2], kmb[3]); *(v2u*)(KMb + row * RWW + ch) = o;
                      o.x = pk2(bvf[0], bvf[1]); o.y = pk2(bvf[2], bvf[3]); *(v2u*)(BVf + row * RWW + ch) = o; o.x = pk2(bvb[0], bvb[1]); o.y = pk2(bvb[2], bvb[3]); *(v2u*)(BVb + row * RWW + ch) = o; }
                    v2u ks; ks.x = pk2(kmf[0] + kmb[0], kmf[1] + kmb[1]); ks.y = pk2(kmf[2] + kmb[2], kmf[3] + kmb[3]); *(v2u*)(KSUM + row * RWW + ch) = ks; } } }
    }
    __device__ __forceinline__ void grp_g(const f32x4 (&acc)[2][2][4][2], int row0, int c0) const {
        bf16* RWG = (bf16*)(ws + WS_RWG);
#pragma unroll
        for (int bj = 0; bj < 2; ++bj) { const int ch = c0 + bj * 128 - 2048;
#pragma unroll
            for (int ai = 0; ai < 2; ++ai)
#pragma unroll
                for (int m = 0; m < 4; ++m) { const size_t row = (size_t)(row0 + ai * 128 + m * 16); const f32x4 v0 = acc[ai][bj][m][0], v1 = acc[ai][bj][m][1];
                    v4u w; w.x = pk2(v0[0], v0[1]); w.y = pk2(v0[2], v0[3]); w.z = pk2(v1[0], v1[1]); w.w = pk2(v1[2], v1[3]); *(v4u*)(RWG + row * RWW + ch) = w; } }
    }
    __device__ __forceinline__ void grp_l(const f32x4 (&acc)[2][2][4][2], int row0, int c0) const {
        bf16* GAf = (bf16*)(ws + WS_LAF); bf16* GAb = (bf16*)(ws + WS_LAB);
#pragma unroll
        for (int bj = 0; bj < 2; ++bj) { const int ch = (c0 + bj * 128 - 2560) >> 1; const f32x4 gbf = *(const f32x4*)(in[20] + ch), gbb = *(const f32x4*)(in[20] + 256 + ch);
#pragma unroll
            for (int ai = 0; ai < 2; ++ai)
#pragma unroll
                for (int m = 0; m < 4; ++m) { const size_t row = (size_t)(row0 + ai * 128 + m * 16);
                    const f32x4 xf = acc[ai][bj][m][0] + gbf, xb = acc[ai][bj][m][1] + gbb; f32x4 af, ab;
#pragma unroll
                    for (int e = 0; e < 4; ++e) { const float lf = logsigmoidf_(xf[e]), lb = logsigmoidf_(xb[e]);
                        af[e] = lf * 0.0625f; ab[e] = lb * 0.0625f; }
                    { v2u o; o.x = pk2(af[0], af[1]); o.y = pk2(af[2], af[3]); *(v2u*)(GAf + row * 256 + ch) = o; o.x = pk2(ab[0], ab[1]); o.y = pk2(ab[2], ab[3]); *(v2u*)(GAb + row * 256 + ch) = o; } } }
    }
    __device__ __forceinline__ void operator()(const f32x4 (&acc)[2][2][4][2], const pg8::Unit& u, int wr, int wc, int fr, int fq) const {
        const int row0 = u.pm * 256 + wr * 64 + fr, c0 = u.pn * 256 + wc * 32 + 8 * fq;
        if (u.pn < 4) grp_w(acc, row0, c0); else if (u.pn < 8) grp_a(acc, row0, c0); else if (u.pn < 10) grp_g(acc, row0, c0); else grp_l(acc, row0, c0);
    }
};
__device__ __forceinline__ void ph_lora(Frame& F) {
    pg8::Gemm g{(const bf16*)(F.ws + WS_A2), (const bf16*)(F.ws + WS_WLORA), MR, NLORA, KLORA, nullptr};
    pg8::StaticOrder S; S.init(MR, NLORA, F.G, (int)blockIdx.x);
    EpiLora E{F.ws, F.in};
    pg8::gemm_phase<EpiLora, pg8::StaticOrder, true, true, false>(F.lds, g, S, E);
}

__device__ __forceinline__ void ph_merge(Frame& F) {
    unsigned char* ws = F.ws; const int lane = F.lane;
    const bf16* ORf = (const bf16*)(ws + WS_ORWF); const bf16* ORb = (const bf16*)(ws + WS_ORWB); const bf16* OGf = (const bf16*)(ws + WS_OGLF); const bf16* OGb = (const bf16*)(ws + WS_OGLB);
    const bf16* R = (const bf16*)(ws + WS_RB); const bf16* V = (const bf16*)(ws + WS_VB); const bf16* KSUM = (const bf16*)(ws + WS_KSUM); const bf16* RWG = (const bf16*)(ws + WS_RWG);
    const bf16* P = (const bf16*)(ws + WS_P);
    bf16* YRW = (bf16*)(ws + WS_YRW); bf16* YGLA = (bf16*)(ws + WS_YGLA);
    float rk[8], gw[8], gbv[8], ggw[8], ggb[8];
    ld8(F.in[15] + 8 * lane, rk); ld8(F.in[16] + 8 * lane, gw); ld8(F.in[17] + 8 * lane, gbv); ld8(F.in[21] + 8 * lane, ggw); ld8(F.in[22] + 8 * lane, ggb);
    for (int m0 = F.gw; m0 < NLAT; m0 += 2 * F.NGW) {
        const int m1 = (m0 + F.NGW < NLAT) ? m0 + F.NGW : m0;
        v4u wa[2], wb[2], wc[2], wd[2], wr[2], wv[2], wk[2], wg[2], wo[2];
#pragma unroll
        for (int r2 = 0; r2 < 2; ++r2) { const int m = r2 ? m1 : m0; const size_t ro = (size_t)m * RWW + 8 * lane;
            wa[r2] = *(const v4u*)(ORf + ro); wb[r2] = *(const v4u*)(ORb + ro); wc[r2] = *(const v4u*)(OGf + ro); wd[r2] = *(const v4u*)(OGb + ro);
            wr[r2] = *(const v4u*)(R + ro); wv[r2] = *(const v4u*)(V + ro); wk[r2] = *(const v4u*)(KSUM + ro); wg[r2] = *(const v4u*)(RWG + ro);
            wo[r2] = *(const v4u*)(P + (size_t)m * NP + C_OG + 8 * lane); }
#pragma unroll
        for (int r2 = 0; r2 < 2; ++r2) { const int m = r2 ? m1 : m0; const size_t ro = (size_t)m * RWW + 8 * lane;
        {
            float a[8], b[8], o[8]; unp8(wa[r2], a); unp8(wb[r2], b);
            float s = 0.f;
#pragma unroll
            for (int e = 0; e < 8; ++e) { o[e] = a[e] + b[e]; s += o[e]; }
            s += __shfl_xor(s, 1); s += __shfl_xor(s, 2); s += __shfl_xor(s, 4);
            const float mean = s * (1.f / 64.f); float q = 0.f;
#pragma unroll
            for (int e = 0; e < 8; ++e) { o[e] -= mean; q += o[e] * o[e]; }
            q += __shfl_xor(q, 1); q += __shfl_xor(q, 2); q += __shfl_xor(q, 4);
            const float rstd = __builtin_amdgcn_rsqf(q * (1.f / 64.f) + RW_GN_EPS);
            float r[8], v[8], ksm[8], g[8]; unp8(wr[r2], r); unp8(wv[r2], v); unp8(wk[r2], ksm); unp8(wg[r2], g);
            float bs = 0.f;
#pragma unroll
            for (int e = 0; e < 8; ++e) bs += r[e] * ksm[e] * rk[e];
            bs += __shfl_xor(bs, 1); bs += __shfl_xor(bs, 2); bs += __shfl_xor(bs, 4);
            float y[8];
#pragma unroll
            for (int e = 0; e < 8; ++e) y[e] = (o[e] * rstd * gw[e] + gbv[e] + bs * v[e]) * g[e];
            *(v2u*)((unsigned char*)YRW + ro) = pk8f8(y);
        }
        {
            float a[8], b[8], o[8]; unp8(wc[r2], a); unp8(wd[r2], b);
            float s = 0.f;
#pragma unroll
            for (int e = 0; e < 8; ++e) { o[e] = a[e] + b[e]; s += o[e]; }
            s += __shfl_xor(s, 1); s += __shfl_xor(s, 2); s += __shfl_xor(s, 4); s += __shfl_xor(s, 8);
            const float mean = s * (1.f / 128.f); float q = 0.f;
#pragma unroll
            for (int e = 0; e < 8; ++e) { o[e] -= mean; q += o[e] * o[e]; }
            q += __shfl_xor(q, 1); q += __shfl_xor(q, 2); q += __shfl_xor(q, 4); q += __shfl_xor(q, 8);
            const float rstd = __builtin_amdgcn_rsqf(q * (1.f / 128.f) + LN_EPS);
            float og[8]; unp8(wo[r2], og);
            float y[8];
#pragma unroll
            for (int e = 0; e < 8; ++e) y[e] = (o[e] * rstd * ggw[e] + ggb[e]) * siluf_(og[e]);
            *(v2u*)((unsigned char*)YGLA + ro) = pk8f8(y);
        }
        }
    }
}

template <int WHICH> struct EpiBranch {
    static constexpr bool PERM = true;
    bf16* Z; const bf16* P; unsigned char* Z8;
    __device__ __forceinline__ void operator()(const f32x4 (&acc)[2][2][4][2], const pg8::Unit& u, int wr, int wc, int fr, int fq) const {
        const int row0 = u.pm * 256 + wr * 64 + fr, col0 = u.pn * 256 + wc * 32 + 8 * fq;
#pragma unroll
        for (int ah = 0; ah < 4; ++ah) { const int ai = ah >> 1, mb = 2 * (ah & 1);
            v4u gw[2][2], zw[2][2];
#pragma unroll
            for (int m = 0; m < 2; ++m) { const size_t row = (size_t)(row0 + ai * 128 + (mb + m) * 16);
#pragma unroll
                for (int bj = 0; bj < 2; ++bj) { const int c = col0 + bj * 128;
                    gw[m][bj] = *(const v4u*)(P + row * NP + (WHICH ? C_GGLA : C_GRW) + c);
                    if (WHICH) zw[m][bj] = *(const v4u*)(Z + row * D + c); } }
            __builtin_amdgcn_sched_barrier(0);
#pragma unroll
            for (int m = 0; m < 2; ++m) { const size_t row = (size_t)(row0 + ai * 128 + (mb + m) * 16);
#pragma unroll
                for (int bj = 0; bj < 2; ++bj) { const int c = col0 + bj * 128;
                    float g[8]; unp8(gw[m][bj], g);
                    const f32x4 v0 = acc[ai][bj][mb + m][0], v1 = acc[ai][bj][mb + m][1];
                    float z[8];
#pragma unroll
                    for (int e = 0; e < 4; ++e) { z[e] = sigmoidf_(g[e]) * (v0[e] * W8I); z[4 + e] = sigmoidf_(g[4 + e]) * (v1[e] * W8I); }
                    if (WHICH) { float zo[8]; unp8(zw[m][bj], zo);
#pragma unroll
                        for (int e = 0; e < 8; ++e) z[e] += zo[e];
                        *(v2u*)(Z8 + row * D + c) = pk8f8(z); }
                    else *(v4u*)(Z + row * D + c) = pk8(z); } }
        }
    }
};
__device__ __forceinline__ void ph_branch(Frame& F) {
    pg8::StaticOrder S; S.init(NLAT, D, F.G, (int)blockIdx.x);
    { pg8::Gemm g{(const bf16*)(F.ws + WS_YRW), (const bf16*)(F.ws + WS_WBRRW), NLAT, D, RWW / 2, nullptr};
      EpiBranch<0> E{(bf16*)(F.ws + WS_Z), (const bf16*)(F.ws + WS_P), F.ws + WS_Z8};
      pg8::gemm_phase<EpiBranch<0>, pg8::StaticOrder, true, true, false, true>(F.lds, g, S, E); }
    { pg8::Gemm g{(const bf16*)(F.ws + WS_YGLA), (const bf16*)(F.ws + WS_WBRGLA), NLAT, D, RWW / 2, nullptr};
      EpiBranch<1> E{(bf16*)(F.ws + WS_Z), (const bf16*)(F.ws + WS_P), F.ws + WS_Z8};
      pg8::gemm_phase<EpiBranch<1>, pg8::StaticOrder, true, true, false, true>(F.lds, g, S, E); }
}
struct EpiOut {
    static constexpr bool PERM = true;
    bf16* X1P; const float* x; const float* mod;
    __device__ __forceinline__ void operator()(const f32x4 (&acc)[2][2][4][2], const pg8::Unit& u, int wr, int wc, int fr, int fq) const {
        const int row0 = u.pm * 256 + wr * 64 + fr, col0 = u.pn * 256 + wc * 32 + 8 * fq; const float* g1 = mod + (u.pm / (SEQ / 256)) * 6144 + 2048;
        f32x4 gv[2][2];
#pragma unroll
        for (int bj = 0; bj < 2; ++bj)
#pragma unroll
            for (int n = 0; n < 2; ++n) gv[bj][n] = *(const f32x4*)(g1 + col0 + bj * 128 + 4 * n);
#pragma unroll
        for (int ah = 0; ah < 4; ++ah) { const int ai = ah >> 1, mb = 2 * (ah & 1);
            f32x4 xv[2][2][2];
#pragma unroll
            for (int m = 0; m < 2; ++m) { const size_t ro = (size_t)(row0 + ai * 128 + (mb + m) * 16) * D;
#pragma unroll
                for (int bj = 0; bj < 2; ++bj)
#pragma unroll
                    for (int n = 0; n < 2; ++n) xv[m][bj][n] = *(const f32x4*)(x + ro + col0 + bj * 128 + 4 * n); }
            __builtin_amdgcn_sched_barrier(0);
#pragma unroll
            for (int m = 0; m < 2; ++m) { const size_t ro = (size_t)(row0 + ai * 128 + (mb + m) * 16) * D;
#pragma unroll
                for (int bj = 0; bj < 2; ++bj) { const f32x4 a = xv[m][bj][0] * ALPHA + gv[bj][0] * (acc[ai][bj][mb + m][0] * W8I), b = xv[m][bj][1] * ALPHA + gv[bj][1] * (acc[ai][bj][mb + m][1] * W8I);
                    v4u w; w.x = pk2(a.x, a.y); w.y = pk2(a.z, a.w); w.z = pk2(b.x, b.y); w.w = pk2(b.z, b.w); *(v4u*)(X1P + ro + col0 + bj * 128) = w; } }
        }
    }
};
__device__ __forceinline__ void ph_outproj(Frame& F) {
    pg8::Gemm g{(const bf16*)(F.ws + WS_Z8), (const bf16*)(F.ws + WS_WOUT), NLAT, D, D / 2, nullptr};
    pg8::StaticOrder S; S.init(NLAT, D, F.G, (int)blockIdx.x);
    EpiOut E{(bf16*)(F.ws + WS_X1), F.in[0], (const float*)(F.ws + WS_MOD)};
    pg8::gemm_phase<EpiOut, pg8::StaticOrder, true, true, false, true>(F.lds, g, S, E);
}
#endif

#if MS >= 3
constexpr int LP = 72, SLOTB = 64 * LP * 2, LPF = 68, AUX_OFF = 13 * SLOTB;
static_assert(AUX_OFF + 4096 <= MISC_OFF, "scan LDS map");
#define SLOT(n) ((LAS bf16*)(lds + (n) * SLOTB))
__device__ __forceinline__ int scan_row(int s, int b, int dir) {
    if (s < CTXL) return NLAT + b * CTXL + (dir ? (CTXL - 1 - s) : s);
    const int lt = s - CTXL; return b * SEQ + (dir ? (SEQ - 1 - lt) : lt);
}
__device__ __forceinline__ unsigned pk2z(float x) { return pk2(x, 0.f); }
__device__ __forceinline__ float bf2f(bf16 h) { return __builtin_bit_cast(float, (unsigned)h << 16); }
__device__ __forceinline__ v2u pack4(const f32x4 v) { v2u o; o.x = pk2(v[0], v[1]); o.y = pk2(v[2], v[3]); return o; }
__device__ __forceinline__ float clamp8(float x) { return __builtin_amdgcn_fmed3f(x, -448.0f, 448.0f); }
__device__ __forceinline__ unsigned pack4_fp8(const f32x4 v) { int w = __builtin_amdgcn_cvt_pk_fp8_f32(clamp8(v[0]), clamp8(v[1]), 0, false); return (unsigned)__builtin_amdgcn_cvt_pk_fp8_f32(clamp8(v[2]), clamp8(v[3]), w, true); }
__device__ __forceinline__ f32x4 unpack4_fp8(unsigned w) { const f32x2 lo = __builtin_amdgcn_cvt_pk_f32_fp8((int)w, false), hi = __builtin_amdgcn_cvt_pk_f32_fp8((int)w, true); return (f32x4){lo.x, lo.y, hi.x, hi.y}; }
__device__ __forceinline__ f32x4 unpack4(const v2u w) { return (f32x4){bflo(w.x), bfhi(w.x), bflo(w.y), bfhi(w.y)}; }
__device__ __forceinline__ f32x4 mm_tile(const LAS bf16* X, int r0, const LAS bf16* Y, int c0, int lane) {
    const int rr = lane & 15, q = lane >> 4;
    const LAS bf16* xp = X + (r0 + rr) * LP + 8 * q; const LAS bf16* yp = Y + (c0 + rr) * LP + 8 * q;
    const bf16x8 a0 = *(const LAS bf16x8*)xp, a1 = *(const LAS bf16x8*)(xp + 32), b0 = *(const LAS bf16x8*)yp, b1 = *(const LAS bf16x8*)(yp + 32);
    f32x4 acc = (f32x4){0.f, 0.f, 0.f, 0.f};
    acc = __builtin_amdgcn_mfma_f32_16x16x32_bf16(a0, b0, acc, 0, 0, 0);
    acc = __builtin_amdgcn_mfma_f32_16x16x32_bf16(a1, b1, acc, 0, 0, 0);
    return acc;
}
__device__ __forceinline__ float red8(float x) {
    x += __builtin_bit_cast(float, __builtin_amdgcn_update_dpp(0, __builtin_bit_cast(int, x), 0x141, 0xf, 0xf, false));
    x += __builtin_bit_cast(float, __builtin_amdgcn_update_dpp(0, __builtin_bit_cast(int, x), 0xB1, 0xf, 0xf, false));
    x += __builtin_bit_cast(float, __builtin_amdgcn_update_dpp(0, __builtin_bit_cast(int, x), 0x4E, 0xf, 0xf, false));
    return x;
}

#define S1_BAR() do { asm volatile("s_waitcnt lgkmcnt(0)" ::: "memory"); __builtin_amdgcn_s_barrier(); asm volatile("" ::: "memory"); } while (0)
struct RwIn { bf16 lw[8], r[8], k[8], a[8], b[8], v[8]; };
__device__ __forceinline__ void s1_rwkv_load(Frame& F, int u, RwIn& I) {
    const int sr = u / NCHUNK, c = u - sr * NCHUNK, rb = sr >> 4, rdir = (sr >> 3) & 1, rh = sr & 7; unsigned char* ws = F.ws;
    const bf16* RBp = (const bf16*)(ws + WS_RB); const bf16* VBp = (const bf16*)(ws + WS_VB); const bf16* KKp = (const bf16*)(ws + WS_KKB);
    const bf16* KMp = (const bf16*)(ws + (rdir ? WS_KMB : WS_KMF)); const bf16* BVp = (const bf16*)(ws + (rdir ? WS_BVB : WS_BVF)); const bf16* LWp = (const bf16*)(ws + (rdir ? WS_LWB : WS_LWF));
#pragma unroll
    for (int i = 0; i < 8; ++i) { const int row = scan_row(c * CH + 8 * F.wave + i, rb, rdir); const size_t base = (size_t)row * RWW + rh * 64 + F.lane;
        I.lw[i] = LWp[base]; I.r[i] = RBp[base]; I.k[i] = KMp[base]; I.a[i] = KKp[base]; I.b[i] = BVp[base]; I.v[i] = VBp[base]; }
}
__device__ __forceinline__ void s1_rwkv(Frame& F, int u, const RwIn& I, int un, RwIn& Inext, f32x2v (&cv)[32], int& cpend, int cvi) {
    const int sr = u / NCHUNK, c = u - sr * NCHUNK;
    const bool emit = c >= CTXL / CH;
    LAS unsigned char* lds = F.lds; unsigned char* ws = F.ws;
    int lane_ = F.lane; asm volatile("" : "+v"(lane_));
    const int lane = lane_, wave = F.wave, rr = lane & 15, q = lane >> 4;
    LAS float* tot = (LAS float*)(lds + AUX_OFF); LAS float* gCs = tot + 512;
    {
        float lw[8], xr[8], xk[8], xa[8], xb[8], xv[8];
#pragma unroll
        for (int i = 0; i < 8; ++i) { lw[i] = bf2f(I.lw[i]); xr[i] = bf2f(I.r[i]); xk[i] = bf2f(I.k[i]); xa[i] = -bf2f(I.a[i]); xb[i] = bf2f(I.b[i]); xv[i] = bf2f(I.v[i]); }
        float p[8]; p[0] = lw[0];
#pragma unroll
        for (int i = 1; i < 8; ++i) p[i] = p[i - 1] + lw[i];
        tot[wave * 64 + lane] = p[7];
        S1_BAR();
        float off = 0.f, all = 0.f;
#pragma unroll
        for (int w = 0; w < 8; ++w) { const float t = tot[w * 64 + lane]; all += t; off += (w < wave) ? t : 0.f; }
        if (wave == 0) gCs[lane] = __expf(all);
        float at[8], bb[8], kb[8];
#pragma unroll
        for (int i = 0; i < 8; ++i) { const float cum = off + p[i]; const float g = __expf(cum), gi = __expf(-cum), gp = __expf(cum - lw[i]), gc = __expf(all - cum);
            const int t = 8 * wave + i;
            at[i] = xa[i] * gp; bb[i] = xb[i] * gc; kb[i] = xk[i] * gc;
            SLOT(0)[t * LP + lane] = (bf16)pk2z(at[i]);
            SLOT(1)[t * LP + lane] = (bf16)pk2z(xr[i] * g);
            SLOT(2)[t * LP + lane] = (bf16)pk2z(xb[i] * gi);
            SLOT(3)[t * LP + lane] = (bf16)pk2z(xk[i] * gi); }
        *(LAS v4u*)(SLOT(4) + lane * LP + 8 * wave) = pk8(at);
        *(LAS v4u*)(SLOT(5) + lane * LP + 8 * wave) = pk8(xv);
        *(LAS v4u*)(SLOT(6) + lane * LP + 8 * wave) = pk8(bb);
        *(LAS v4u*)(SLOT(7) + lane * LP + 8 * wave) = pk8(kb);
        S1_BAR();
    }
    if (wave < 4) s1_rwkv_load(F, un, Inext);
    LAS float* Lp = (LAS float*)(lds + 8 * SLOTB);
#pragma unroll
    for (int tix = 0; tix < 2; ++tix) { const int ti = 2 * wave + tix, r0 = 16 * (ti >> 2), c0 = 16 * (ti & 3), ci = c0 + rr;
        { const f32x4 acc = mm_tile(SLOT(2), r0, SLOT(0), c0, lane);
#pragma unroll
            for (int e = 0; e < 4; ++e) { const int i = r0 + 4 * q + e; Lp[ci * LPF + (i & 3) * 16 + (i >> 2)] = (i < ci) ? acc[e] : 0.f; } }
        { f32x4 acc = mm_tile(SLOT(0), r0, SLOT(3), c0, lane);
#pragma unroll
            for (int e = 0; e < 4; ++e) acc[e] = (ci < r0 + 4 * q + e) ? acc[e] : 0.f;
            *(LAS v2u*)(SLOT(10) + ci * LP + r0 + 4 * q) = pack4(acc); }
        if (emit) {
            { f32x4 acc = mm_tile(SLOT(2), r0, SLOT(1), c0, lane);
#pragma unroll
                for (int e = 0; e < 4; ++e) acc[e] = (r0 + 4 * q + e <= ci) ? acc[e] : 0.f;
                *(LAS v2u*)(SLOT(11) + ci * LP + r0 + 4 * q) = pack4(acc); }
            { f32x4 acc = mm_tile(SLOT(3), r0, SLOT(1), c0, lane);
#pragma unroll
                for (int e = 0; e < 4; ++e) acc[e] = (r0 + 4 * q + e <= ci) ? acc[e] : 0.f;
                *(LAS v2u*)(SLOT(12) + ci * LP + r0 + 4 * q) = pack4(acc); }
        }
    }
    S1_BAR();
    if (wave < 4) {
        const int j = 16 * wave + (lane >> 2), s = lane & 3;
        float Tr[16];
#pragma unroll
        for (int m = 0; m < 16; ++m) Tr[m] = 0.f;
        const LAS float* lrow = Lp + s * 16;
        f32x4 lb[3][4];
#pragma unroll
        for (int t = 0; t < 2; ++t) lb[t][0] = *(const LAS f32x4*)(lrow + t * LPF);
#pragma unroll
        for (int t = 0; t < 64; ++t) {
            if (t + 2 < 64) {
#pragma unroll
                for (int k = 0; k < 4; ++k) if (4 * k <= (t + 2) / 4) lb[(t + 2) % 3][k] = *(const LAS f32x4*)(lrow + (t + 2) * LPF + 4 * k);
            }
            __builtin_amdgcn_sched_barrier(0);
            float acc0 = 0.f, acc1 = 0.f;
#pragma unroll
            for (int m = 0; m < 16; ++m) if (m <= t / 4) { const float lv = lb[t % 3][m >> 2][m & 3]; if (m & 1) acc1 += lv * Tr[m]; else acc0 += lv * Tr[m]; }
            float acc = acc0 + acc1;
            acc += __builtin_bit_cast(float, __builtin_amdgcn_update_dpp(0, __builtin_bit_cast(int, acc), 0xB1, 0xf, 0xf, false));
            acc += __builtin_bit_cast(float, __builtin_amdgcn_update_dpp(0, __builtin_bit_cast(int, acc), 0x4E, 0xf, 0xf, false));
            int jj = j, ss = s; asm volatile("" : "+v"(jj), "+v"(ss));
            const float val = acc + ((t == jj) ? 1.f : 0.f);
            Tr[t >> 2] = (ss == (t & 3)) ? val : Tr[t >> 2];
            SLOT(0)[t * LP + j] = (bf16)pk2z(val);
        }
    } else { CVY_FLUSH(); s1_rwkv_load(F, un, Inext); CVY_START(cvi); }
    S1_BAR();
#pragma unroll
    for (int tix = 0; tix < 2; ++tix) { const int ti = 2 * wave + tix, r0 = 16 * (ti >> 2), c0 = 16 * (ti & 3), ci = c0 + rr;
        { const f32x4 acc = mm_tile(SLOT(0), r0, SLOT(4), c0, lane); *(LAS v2u*)(SLOT(2) + ci * LP + r0 + 4 * q) = pack4(acc); }
        { const f32x4 acc = mm_tile(SLOT(0), r0, SLOT(10), c0, lane); *(LAS v2u*)(SLOT(3) + ci * LP + r0 + 4 * q) = pack4(acc); }
    }
    S1_BAR();
    unsigned char* RH = ws + WS_RH + (size_t)u * 4096; bf16* GT = (bf16*)((unsigned char*)F.out + OUT_GT) + (size_t)u * 4096;
#pragma unroll
    for (int tix = 0; tix < 2; ++tix) { const int ti = 2 * wave + tix, tr = ti >> 2, r0 = 16 * tr, c0 = 16 * (ti & 3), ci = c0 + rr;
        const int pos = (tr >> 1) * 32 + q * 8 + 4 * (tr & 1);
        if (emit) {
            { f32x4 acc = mm_tile(SLOT(2), r0, SLOT(11), c0, lane);
                acc += unpack4(*(const LAS v2u*)(SLOT(1) + ci * LP + r0 + 4 * q));
                *(unsigned*)(RH + ci * 64 + pos) = pack4_fp8(acc); }
            { f32x4 acc = mm_tile(SLOT(3), r0, SLOT(11), c0, lane);
                acc += unpack4(*(const LAS v2u*)(SLOT(12) + ci * LP + r0 + 4 * q));
                *(LAS v2u*)(SLOT(4) + ci * LP + r0 + 4 * q) = pack4(acc); }
        }
        { f32x4 acc = mm_tile(SLOT(2), r0, SLOT(6), c0, lane);
            const float gc = gCs[ci];
#pragma unroll
            for (int e = 0; e < 4; ++e) acc[e] += (r0 + 4 * q + e == ci) ? gc : 0.f;
            *(v2u*)(GT + ci * 64 + pos) = pack4(acc); }
    }
    S1_BAR();
    unsigned char* YL = ws + WS_YL + (size_t)u * 4096;
#pragma unroll
    for (int tix = 0; tix < 2; ++tix) { const int ti = 2 * wave + tix, r0 = 16 * (ti >> 2), c0 = 16 * (ti & 3), ci = c0 + rr;
        if (emit) { const f32x4 acc = mm_tile(SLOT(5), r0, SLOT(4), c0, lane); *(unsigned*)(YL + ci * 64 + r0 + 4 * q) = pack4_fp8(acc); }
        { f32x4 acc = mm_tile(SLOT(3), r0, SLOT(6), c0, lane);
            acc += unpack4(*(const LAS v2u*)(SLOT(7) + ci * LP + r0 + 4 * q));
            *(LAS v2u*)(SLOT(8) + ci * LP + r0 + 4 * q) = pack4(acc); }
    }
    S1_BAR();
    bf16* HH = (bf16*)(ws + WS_HH) + (size_t)u * 4096;
#pragma unroll
    for (int tix = 0; tix < 2; ++tix) { const int ti = 2 * wave + tix, r0 = 16 * (ti >> 2), c0 = 16 * (ti & 3), ci = c0 + rr;
        const f32x4 acc = mm_tile(SLOT(8), r0, SLOT(5), c0, lane);
        *(v2u*)(HH + ci * 64 + r0 + 4 * q) = pack4(acc); }
    S1_BAR();
}

struct GlIn { bf16 la[8], q[8], k[8], v0[8], v1[8]; };
__device__ __forceinline__ void s1_gla_load(Frame& F, int u, GlIn& I) {
    const int sg = u / NCHUNK, c = u - sg * NCHUNK, gb = sg >> 3, gdir = (sg >> 2) & 1, gh = sg & 3; unsigned char* ws = F.ws;
    const bf16* Qp = (const bf16*)(ws + WS_QGB); const bf16* Kp = (const bf16*)(ws + WS_KGB); const bf16* Vp = (const bf16*)(ws + WS_VGB); const bf16* LAp = (const bf16*)(ws + (gdir ? WS_LAB : WS_LAF));
#pragma unroll
    for (int i = 0; i < 8; ++i) { const int row = scan_row(c * CH + 8 * F.wave + i, gb, gdir); const size_t b2 = (size_t)row * 256 + gh * 64 + F.lane, b5 = (size_t)row * RWW + gh * 128 + F.lane;
        I.la[i] = LAp[b2]; I.q[i] = Qp[b2]; I.k[i] = Kp[b2]; I.v0[i] = Vp[b5]; I.v1[i] = Vp[b5 + 64]; }
}
__device__ __forceinline__ void s1_gla(Frame& F, int u, const GlIn& I, int un, GlIn& Inext, f32x2v (&cv)[32], int& cpend, int cvi) {
    const int sg = u / NCHUNK, c = u - sg * NCHUNK;
    const bool emit = c >= CTXL / CH;
    LAS unsigned char* lds = F.lds; unsigned char* ws = F.ws;
    int lane_ = F.lane; asm volatile("" : "+v"(lane_));
    const int lane = lane_, wave = F.wave, rr = lane & 15, q = lane >> 4;
    LAS float* tot = (LAS float*)(lds + AUX_OFF);
    unsigned char* QE = (unsigned char*)F.out + OUT_QE + (size_t)u * 4096;
    {
        float la[8], xq[8], xk[8], v0[8], v1[8];
#pragma unroll
        for (int i = 0; i < 8; ++i) { la[i] = bf2f(I.la[i]); xq[i] = bf2f(I.q[i]); xk[i] = bf2f(I.k[i]); v0[i] = bf2f(I.v0[i]); v1[i] = bf2f(I.v1[i]); }
        float p[8]; p[0] = la[0];
#pragma unroll
        for (int i = 1; i < 8; ++i) p[i] = p[i - 1] + la[i];
        tot[wave * 64 + lane] = p[7];
        S1_BAR();
        float off = 0.f, all = 0.f;
#pragma unroll
        for (int w = 0; w < 8; ++w) { const float t = tot[w * 64 + lane]; all += t; off += (w < wave) ? t : 0.f; }
        if (wave == 0) ((float*)(ws + WS_DD))[(size_t)u * 64 + lane] = __expf(all);
        float kl[8];
#pragma unroll
        for (int i = 0; i < 8; ++i) { const float cum = off + p[i]; const int t = 8 * wave + i;
            const float qef = xq[i] * __expf(cum);
            SLOT(0)[t * LP + lane] = (bf16)pk2z(qef);
            if (emit) QE[t * 64 + lane] = (unsigned char)__builtin_amdgcn_cvt_pk_fp8_f32(clamp8(qef), 0.f, 0, false);
            SLOT(1)[t * LP + lane] = (bf16)pk2z(xk[i] * __expf(-cum));
            kl[i] = xk[i] * __expf(all - cum); }
        *(LAS v4u*)(SLOT(2) + lane * LP + 8 * wave) = pk8(kl);
        *(LAS v4u*)(SLOT(3) + lane * LP + 8 * wave) = pk8(v0);
        *(LAS v4u*)(SLOT(3) + (64 + lane) * LP + 8 * wave) = pk8(v1);
        S1_BAR();
    }
    if (wave >= 4) { CVY_FLUSH(); s1_gla_load(F, un, Inext); CVY_START(cvi); }
    else if (emit) {
#pragma unroll
        for (int tix = 0; tix < 4; ++tix) { const int ti = 4 * wave + tix, r0 = 16 * (ti >> 2), c0 = 16 * (ti & 3), ci = c0 + rr;
            f32x4 acc = mm_tile(SLOT(1), r0, SLOT(0), c0, lane);
#pragma unroll
            for (int e = 0; e < 4; ++e) acc[e] = (r0 + 4 * q + e <= ci) ? acc[e] : 0.f;
            *(LAS v2u*)(SLOT(5) + ci * LP + r0 + 4 * q) = pack4(acc); }
    }
    bf16* KV = (bf16*)(ws + WS_KV) + (size_t)u * 8192;
#pragma unroll
    for (int tix = 0; tix < 4; ++tix) { const int ti = 4 * wave + tix, r0 = 16 * (ti >> 3), c0 = 16 * (ti & 7), ci = c0 + rr;
        const f32x4 acc = mm_tile(SLOT(2), r0, SLOT(3), c0, lane);
        *(v2u*)(KV + ci * 64 + r0 + 4 * q) = pack4(acc); }
    S1_BAR();
    if (emit) {
        unsigned char* IN = ws + WS_INTRA + (size_t)u * 8192;
#pragma unroll
        for (int tix = 0; tix < 4; ++tix) { const int ti = 4 * wave + tix, r0 = 16 * (ti >> 2), c0 = 16 * (ti & 3), ci = c0 + rr;
            const f32x4 acc = mm_tile(SLOT(3), r0, SLOT(5), c0, lane);
            *(unsigned*)(IN + ci * 128 + r0 + 4 * q) = pack4_fp8(acc); }
    }
    S1_BAR();
}

__device__ __forceinline__ void ph_scan1(Frame& F) {
    f32x2v cv[32]; int cpend = -1; const int lane = F.lane;
    int item = (int)blockIdx.x * 4 + (F.wave & 3);
    { RwIn cur, nxt; if ((int)blockIdx.x < NU_RW) s1_rwkv_load(F, blockIdx.x, cur);
#pragma unroll 1
      for (int u = blockIdx.x; u < NU_RW; u += F.G, item += F.G * 4) { const int un = (u + F.G < NU_RW) ? u + F.G : u; s1_rwkv(F, u, cur, un, nxt, cv, cpend, item); cur = nxt; } }
    { GlIn cur, nxt; if ((int)blockIdx.x < NU_GL) s1_gla_load(F, blockIdx.x, cur);
#pragma unroll 1
      for (int u = blockIdx.x; u < NU_GL; u += F.G, item += F.G * 4) { const int un = (u + F.G < NU_GL) ? u + F.G : u; if (F.wave < 4) s1_gla_load(F, un, nxt); s1_gla(F, u, cur, un, nxt, cv, cpend, item); cur = nxt; } }
    if (F.wave >= 4) CVY_FLUSH();
}

__device__ __forceinline__ bf16x8 pack_frag(const f32x4 lo, const f32x4 hi) {
    v4u w; w.x = pk2(lo[0], lo[1]); w.y = pk2(lo[2], lo[3]); w.z = pk2(hi[0], hi[1]); w.w = pk2(hi[2], hi[3]); return __builtin_bit_cast(bf16x8, w);
}
constexpr int S2_D = 5, S2_R = 6, S2_RW = 8192 + 4096 + 2048 + 1024, S2_GL = 4096 + 2048 + 1024 + 1024, S2_SLOT = S2_RW + S2_GL;
static_assert(S2_R * S2_SLOT <= MISC_OFF, "S2 ring fits in LDS");
__device__ __forceinline__ void s2_piece(int k, int lane, size_t ur0, size_t ug0, int v0r, int v0g,
                                         const unsigned char* GTb, const unsigned char* RHb, const unsigned char* HHb, const unsigned char* YLb,
                                         const unsigned char* QEb, const unsigned char* KVb, const unsigned char* INb, const unsigned char* DDb,
                                         const unsigned char*& src, int& stride, int& ldo) {
    if (k < 8) { const int n = k, pu = n * 64 + lane, row = pu >> 3, c16 = (pu & 7) ^ (row & 7);
        src = GTb + ur0 * 8192 + row * 128 + c16 * 16; stride = 8192; ldo = n * 1024; }
    else if (k < 12) { const int n = k - 8, pu = n * 64 + lane, row = pu >> 2, c16 = (pu & 3) ^ (row & 3);
        src = RHb + ur0 * 4096 + row * 64 + c16 * 16; stride = 4096; ldo = 8192 + n * 1024; }
    else if (k < 14) { const int n = k - 12, pu = n * 64 + lane, v = pu >> 3, c16 = (pu & 7) ^ (v & 7);
        src = HHb + ur0 * 8192 + (size_t)(v0r + v) * 128 + c16 * 16; stride = 8192; ldo = 12288 + n * 1024; }
    else if (k < 15) { const int t = lane;
        src = YLb + ur0 * 4096 + t * 64 + v0r; stride = 4096; ldo = 14336; }
    else if (k < 19) { const int n = k - 15, pu = n * 64 + lane, row = pu >> 2, c16 = (pu & 3) ^ (row & 3);
        src = QEb + ug0 * 4096 + row * 64 + c16 * 16; stride = 4096; ldo = S2_RW + n * 1024; }
    else if (k < 21) { const int n = k - 19, pu = n * 64 + lane, v = pu >> 3, c16 = (pu & 7) ^ (v & 7);
        src = KVb + ug0 * 16384 + (size_t)(v0g + v) * 128 + c16 * 16; stride = 16384; ldo = S2_RW + 4096 + n * 1024; }
    else if (k < 22) { const int t = lane;
        src = INb + ug0 * 8192 + t * 128 + v0g; stride = 8192; ldo = S2_RW + 6144; }
    else { src = DDb + ug0 * 256 + (lane & 15) * 16; stride = 256; ldo = S2_RW + 7168; }
}
__device__ __forceinline__ void ph_scan2(Frame& F) {
    const int lane = F.lane, wave = F.wave, rr = lane & 15, q = lane >> 4; unsigned char* ws = F.ws; LAS unsigned char* lds = F.lds;
    const int it = (F.G == 256) ? (int)(blockIdx.x & 7) * 32 + (int)(blockIdx.x >> 3) : (int)blockIdx.x;
    const int sr = it >> 2, v0r = 16 * (it & 3), rb = sr >> 4, rdir = (sr >> 3) & 1, rh = sr & 7;
    const int sg = it >> 3, v0g = 16 * (it & 7), gb = sg >> 3, gdir = (sg >> 2) & 1, gh = sg & 3;
#define S2_BAR() do { asm volatile("s_waitcnt lgkmcnt(0)" ::: "memory"); __builtin_amdgcn_s_barrier(); asm volatile("" ::: "memory"); } while (0)
#define S2_NEXT_SLOT() do { slot = (slot + 1 == S2_R) ? 0 : slot + 1; } while (0)
    LAS unsigned char* sfr = lds + S2_SF_OFF + lane * 16;
    LAS unsigned char* sfg = sfr + 4096;
    if (wave >= 6) {
        const unsigned char* GTb = (const unsigned char*)F.out + OUT_GT; const unsigned char* QEb = (const unsigned char*)F.out + OUT_QE;
        const unsigned char* RHb = ws + WS_RH; const unsigned char* YLb = ws + WS_YL; const unsigned char* HHb = ws + WS_HH; const unsigned char* KVb = ws + WS_KV; const unsigned char* INb = ws + WS_INTRA;
        const unsigned char* DDb = ws + WS_DD;
        const unsigned char* pj[12]; int sj[12], lj[12];
#pragma unroll
        for (int j = 0; j < 12; ++j) { int k = (wave - 6) * 12 + j; if (k >= 23) k = 22;
            s2_piece(k, lane, (size_t)sr * NCHUNK, (size_t)sg * NCHUNK, v0r, v0g, GTb, RHb, HHb, YLb, QEb, KVb, INb, DDb, pj[j], sj[j], lj[j]);
            sj[j] = __builtin_amdgcn_readfirstlane(sj[j]); lj[j] = __builtin_amdgcn_readfirstlane(lj[j]); }
#define S2_ISSUE(cc, sl_) do { const int _c = (cc) < NCHUNK ? (cc) : NCHUNK - 1; _Pragma("unroll") for (int j = 0; j < 12; ++j) \
            __builtin_amdgcn_global_load_lds((const unsigned*)(pj[j] + (size_t)_c * sj[j]), (LAS unsigned*)(lds + (sl_) * S2_SLOT + lj[j]), 16, 0, 0); } while (0)
        S2_ISSUE(0, 0); S2_ISSUE(1, 1); S2_ISSUE(2, 2); S2_ISSUE(3, 3); S2_ISSUE(4, 4);
        int slot = S2_D % S2_R;
#pragma unroll 1
        for (int c = 0; c < NCHUNK; ++c) {
            asm volatile("s_waitcnt vmcnt(48) ; S2WAIT" ::: "memory");
            S2_BAR();
            S2_ISSUE(c + S2_D, slot);
            S2_NEXT_SLOT();
        }
#undef S2_ISSUE
    } else if (wave == 0) {
        f32x4 S[4];
#pragma unroll
        for (int m = 0; m < 4; ++m) S[m] = (f32x4){0.f, 0.f, 0.f, 0.f};
        bf16x8 Sf0 = pack_frag(S[0], S[1]), Sf1 = pack_frag(S[2], S[3]);
        *(LAS bf16x8*)(sfr) = Sf0; *(LAS bf16x8*)(sfr + 1024) = Sf1;
        int slot = 0;
#pragma unroll 1
        for (int c = 0; c < NCHUNK; ++c) {
            S2_BAR();
            const LAS unsigned char* sl = lds + slot * S2_SLOT;
            bf16x8 G0[4], G1[4]; v2u Hw[4];
#pragma unroll
            for (int m = 0; m < 4; ++m) { const int k2 = 16 * m + rr;
                G0[m] = *(const LAS bf16x8*)(sl + (k2 * 8 + (q ^ (k2 & 7))) * 16); G1[m] = *(const LAS bf16x8*)(sl + (k2 * 8 + ((4 + q) ^ (k2 & 7))) * 16);
                Hw[m] = *(const LAS v2u*)(sl + 12288 + (rr * 8 + ((2 * m + (q >> 1)) ^ (rr & 7))) * 16 + (q & 1) * 8); }
#pragma unroll
            for (int m = 0; m < 4; ++m) { f32x4 acc = unpack4(Hw[m]);
                acc = __builtin_amdgcn_mfma_f32_16x16x32_bf16(G0[m], Sf0, acc, 0, 0, 0);
                acc = __builtin_amdgcn_mfma_f32_16x16x32_bf16(G1[m], Sf1, acc, 0, 0, 0);
                S[m] = acc; }
            Sf0 = pack_frag(S[0], S[1]); Sf1 = pack_frag(S[2], S[3]);
            LAS unsigned char* o = sfr + ((c + 1) & 1) * 2048;
            *(LAS bf16x8*)(o) = Sf0; *(LAS bf16x8*)(o + 1024) = Sf1;
            S2_NEXT_SLOT();
        }
    } else if (wave == 1) {
        f32x4 S[4];
#pragma unroll
        for (int m = 0; m < 4; ++m) S[m] = (f32x4){0.f, 0.f, 0.f, 0.f};
        { const bf16x8 Sf0 = pack_frag(S[0], S[1]); *(LAS bf16x8*)(sfg) = Sf0; *(LAS bf16x8*)(sfg + 1024) = Sf0; }
        int slot = 0;
#pragma unroll 1
        for (int c = 0; c < NCHUNK; ++c) {
            S2_BAR();
            const LAS unsigned char* sl = lds + slot * S2_SLOT + S2_RW;
            v4u kw[2]; f32x4 d0[2], d1[2];
#pragma unroll
            for (int s2 = 0; s2 < 2; ++s2) { kw[s2] = *(const LAS v4u*)(sl + 4096 + (rr * 8 + ((4 * s2 + q) ^ (rr & 7))) * 16);
                d0[s2] = *(const LAS f32x4*)(sl + 7168 + 128 * s2 + 32 * q); d1[s2] = *(const LAS f32x4*)(sl + 7168 + 128 * s2 + 32 * q + 16); }
#pragma unroll
            for (int s2 = 0; s2 < 2; ++s2) { S[2 * s2] = S[2 * s2] * d0[s2] + unpack4((v2u){kw[s2].x, kw[s2].y}); S[2 * s2 + 1] = S[2 * s2 + 1] * d1[s2] + unpack4((v2u){kw[s2].z, kw[s2].w}); }
            LAS unsigned char* o = sfg + ((c + 1) & 1) * 2048;
            *(LAS bf16x8*)(o) = pack_frag(S[0], S[1]); *(LAS bf16x8*)(o + 1024) = pack_frag(S[2], S[3]);
            S2_NEXT_SLOT();
        }
    } else if (wave < 4) {
        bf16* ORW = (bf16*)(ws + (rdir ? WS_ORWB : WS_ORWF));
        const int tt0 = 2 * (wave - 2);
        int slot = 0;
#pragma unroll 1
        for (int c = 0; c < NCHUNK; ++c) {
            S2_BAR();
            if (c >= CTXL / CH) {
                const LAS unsigned char* sl = lds + slot * S2_SLOT; const LAS unsigned char* sf = sfr + (c & 1) * 2048;
                const bf16x8 Sf0 = *(const LAS bf16x8*)(sf), Sf1 = *(const LAS bf16x8*)(sf + 1024);
                v2u Rw0[2], Rw1[2]; unsigned Yw[2];
#pragma unroll
                for (int i = 0; i < 2; ++i) { const int t = 16 * (tt0 + i) + rr;
                    Rw0[i] = *(const LAS v2u*)(sl + 8192 + (t * 4 + ((q >> 1) ^ (t & 3))) * 16 + (q & 1) * 8); Rw1[i] = *(const LAS v2u*)(sl + 8192 + (t * 4 + ((2 + (q >> 1)) ^ (t & 3))) * 16 + (q & 1) * 8);
                    Yw[i] = *(const LAS unsigned*)(sl + 14336 + t * 16 + q * 4); }
#pragma unroll
                for (int i = 0; i < 2; ++i) { const int t = 16 * (tt0 + i) + rr;
                    const bf16x8 R0 = pack_frag(unpack4_fp8(Rw0[i].x), unpack4_fp8(Rw0[i].y)), R1 = pack_frag(unpack4_fp8(Rw1[i].x), unpack4_fp8(Rw1[i].y));
                    f32x4 acc = unpack4_fp8(Yw[i]);
                    acc = __builtin_amdgcn_mfma_f32_16x16x32_bf16(Sf0, R0, acc, 0, 0, 0);
                    acc = __builtin_amdgcn_mfma_f32_16x16x32_bf16(Sf1, R1, acc, 0, 0, 0);
                    const int row = scan_row(c * CH + t, rb, rdir);
                    *(v2u*)(ORW + (size_t)row * RWW + rh * 64 + v0r + 4 * q) = pack4(acc); }
            }
            S2_NEXT_SLOT();
        }
    } else {
        bf16* OGL = (bf16*)(ws + (gdir ? WS_OGLB : WS_OGLF));
        const int tt0 = 2 * (wave - 4);
        int slot = 0;
#pragma unroll 1
        for (int c = 0; c < NCHUNK; ++c) {
            S2_BAR();
            if (c >= CTXL / CH) {
                const LAS unsigned char* sl = lds + slot * S2_SLOT + S2_RW; const LAS unsigned char* sf = sfg + (c & 1) * 2048;
                const bf16x8 Sf0 = *(const LAS bf16x8*)(sf), Sf1 = *(const LAS bf16x8*)(sf + 1024);
                v2u Qw0[2], Qw1[2]; unsigned Iw[2];
#pragma unroll
                for (int i = 0; i < 2; ++i) { const int t = 16 * (tt0 + i) + rr;
                    Qw0[i] = *(const LAS v2u*)(sl + (t * 4 + ((q >> 1) ^ (t & 3))) * 16 + (q & 1) * 8); Qw1[i] = *(const LAS v2u*)(sl + (t * 4 + ((2 + (q >> 1)) ^ (t & 3))) * 16 + (q & 1) * 8);
                    Iw[i] = *(const LAS unsigned*)(sl + 6144 + t * 16 + q * 4); }
#pragma unroll
                for (int i = 0; i < 2; ++i) { const int t = 16 * (tt0 + i) + rr;
                    const bf16x8 Q0 = pack_frag(unpack4_fp8(Qw0[i].x), unpack4_fp8(Qw0[i].y)), Q1 = pack_frag(unpack4_fp8(Qw1[i].x), unpack4_fp8(Qw1[i].y));
                    f32x4 acc = unpack4_fp8(Iw[i]);
                    acc = __builtin_amdgcn_mfma_f32_16x16x32_bf16(Sf0, Q0, acc, 0, 0, 0);
                    acc = __builtin_amdgcn_mfma_f32_16x16x32_bf16(Sf1, Q1, acc, 0, 0, 0);
                    const int row = scan_row(c * CH + t, gb, gdir);
                    *(v2u*)(OGL + (size_t)row * RWW + gh * 128 + v0g + 4 * q) = pack4(acc); }
            }
            S2_NEXT_SLOT();
        }
    }
#undef S2_BAR
#undef S2_NEXT_SLOT
}
#endif

#ifndef ML
#define ML 0
#endif
enum Phase { PH_PROLOGUE = 0, PH_A1, PH_INPROJ, PH_FEAT, PH_LORA, PH_SCAN1, PH_SCAN2, PH_MERGE, PH_BRANCH, PH_OUTPROJ, PH_LN1, PH_ROUTER, PH_ROUTE, PH_SCATTER, PH_EXP1, PH_EXP2, PH_FINAL, PH_COUNT };

__global__ void __launch_bounds__(NTHR, 2) mega(Args args) {
    extern __shared__ __attribute__((aligned(16))) unsigned char lds_raw[];
    Frame F;
    F.lds = (LAS unsigned char*)lds_raw;
    F.tid = threadIdx.x; F.lane = F.tid & 63; F.wave = __builtin_amdgcn_readfirstlane(F.tid >> 6);
    F.G = gridDim.x; F.gw = blockIdx.x * NWAVES + F.wave; F.NGW = F.G * NWAVES;
    F.in = args.in; F.out = args.out; F.ws = args.ws; F.ctl = (unsigned*)(args.ws + WS_CTL);
    volatile LAS unsigned* MISC = (volatile LAS unsigned*)(F.lds + MISC_OFF);
    if (F.tid < 64) MISC[F.tid] = 0u;
    __syncthreads();
    XcdBarrier bar; bar.bar = F.ctl + CW_BAR; bar.x = 0; bar.st = nullptr;
#if !ML
    bar = xcd_barrier_post(F.ctl + CW_BAR, MISC + 8);
#endif
    const int lo = args.ph_lo, hi = args.ph_hi;
#define IN(k) (lo <= (k) && (k) < hi)
#ifndef DUP
#define DUP -1
#endif
#define RUN(k, call) do { if (IN(k)) { call; GRID_BAR(); if (DUP == (k)) { call; GRID_BAR(); } } } while (0)
#if ML
#define GRID_BAR() do { } while (0)
#else
#define GRID_BAR() xcd_barrier(bar)
#endif

#if MS >= 2
    RUN(PH_PROLOGUE, ph_prologue(F));
#endif
#if MS >= 3
    RUN(PH_A1, ph_a1(F));
    RUN(PH_INPROJ, ph_inproj(F));
    RUN(PH_FEAT, ph_feat(F));
    RUN(PH_LORA, ph_lora(F));
    RUN(PH_SCAN1, ph_scan1(F));
    RUN(PH_SCAN2, ph_scan2(F));
    RUN(PH_MERGE, ph_merge(F));
    RUN(PH_BRANCH, ph_branch(F));
    RUN(PH_OUTPROJ, ph_outproj(F));
#else
    RUN(PH_OUTPROJ, ph_x1pre_nomix(F));
#endif
    RUN(PH_LN1, ph_ln1(F));
#if MS >= 2
    RUN(PH_ROUTER, ph_router(F));
    RUN(PH_ROUTE, ph_route(F));
    RUN(PH_SCATTER, ph_scatter(F));
    RUN(PH_EXP1, ph_exp1(F));
    RUN(PH_EXP2, ph_exp2(F));
#endif
    if (IN(PH_FINAL)) { ph_final(F); }
#undef IN
}

extern "C" void kernel_launch(void* const* d_in, const int* in_sizes, int n_in, void* d_out, int out_size, void* d_ws, size_t ws_size, hipStream_t stream) {
    static int grid = 0;
    if (grid == 0) {
        if (n_in != 36 || out_size != NLAT * D || ws_size < WS_END) { fprintf(stderr, "kernel_launch: unexpected problem shape (n_in %d, out %d)\n", n_in, out_size); grid = -1; return; }
        int dev = 0, cus = 0, per_cu = 0;
        if (hipGetDevice(&dev) != hipSuccess || hipDeviceGetAttribute(&cus, hipDeviceAttributeMultiprocessorCount, dev) != hipSuccess) { grid = -1; return; }
        if (hipFuncSetAttribute((const void*)mega, hipFuncAttributeMaxDynamicSharedMemorySize, LDS_BYTES) != hipSuccess) { fprintf(stderr, "kernel_launch: hipFuncSetAttribute failed\n"); grid = -1; return; }
        if (hipOccupancyMaxActiveBlocksPerMultiprocessor(&per_cu, (const void*)mega, NTHR, LDS_BYTES) != hipSuccess || per_cu < 1) { fprintf(stderr, "kernel_launch: occupancy query says %d\n", per_cu); }
        (void)hipGetLastError();
        grid = cus > 0 ? cus : 256;
        if (grid > 256) grid = 256;
    }
    if (grid < 0) return;
    (void)hipMemsetAsync((char*)d_ws + WS_CTL, 0, CTL_ZERO_BYTES, stream);
    Args a{};
    for (int i = 0; i < 36; ++i) a.in[i] = (const float*)d_in[i];
    a.out = (float*)d_out; a.ws = (unsigned char*)d_ws;
#if ML
    for (int p = 0; p < PH_COUNT; ++p) { a.ph_lo = p; a.ph_hi = p + 1; hipLaunchKernelGGL(mega, dim3(grid), dim3(NTHR), LDS_BYTES, stream, a); }
#else
    a.ph_lo = 0; a.ph_hi = PH_COUNT;
    hipLaunchKernelGGL(mega, dim3(grid), dim3(NTHR), LDS_BYTES, stream, a);
#endif
}
```

```cpp
#include <hip/hip_runtime.h>
#include <cstdio>
#include <cstdint>

#ifndef MS
#define MS 3
#endif

#define GAS __attribute__((address_space(1)))
#define LAS __attribute__((address_space(3)))
typedef unsigned short bf16;
typedef unsigned v4u __attribute__((ext_vector_type(4)));
typedef unsigned v2u __attribute__((ext_vector_type(2)));
typedef float f32x4 __attribute__((ext_vector_type(4)));
typedef float f32x2 __attribute__((ext_vector_type(2)));
typedef short bf16x8 __attribute__((ext_vector_type(8)));
#define LDS_WAIT() asm volatile("s_waitcnt lgkmcnt(0)" ::: "memory")
#define VM_WAIT() asm volatile("s_waitcnt vmcnt(0)" ::: "memory")

constexpr int D = 1024, NB = 4, SEQ = 8192, CTXL = 256, GRIDW = 64, GRIDH = 128;
constexpr int NLAT = NB * SEQ, NCTX = NB * CTXL, MR = NLAT + NCTX;
constexpr int RWW = 512, RWH = 8, HD = 64;
constexpr int C_R = 0, C_K = 512, C_V = 1024, C_PW = 1536, C_PA = 1568, C_PG = 1600, C_Q = 1696, C_KG = 1952, C_VG = 2208, C_PGL = 2720, C_OG = 2736, C_GRW = 3248, C_GGLA = 4272;
constexpr int IN_COLS = 5296, NP = 5376;
constexpr int NE = 256, TOPK = 8, FF = 256;
constexpr float LN_EPS = 1e-5f, RW_GN_EPS = 64e-5f;
constexpr float ALPHA = 1.189207115f;
constexpr float W8S = 64.0f, W8I = 1.0f / 64.0f;
constexpr int NLORA = 3072, KLORA = 256;
constexpr int MAXTILES = 1280, SH_ROW0 = MAXTILES * 256, NROWS_E = SH_ROW0 + NLAT;

namespace pg8 {
#define PG8_LAS __attribute__((address_space(3)))
typedef unsigned short bf16_t;
typedef unsigned u32x4 __attribute__((ext_vector_type(4)));
typedef unsigned u32x2 __attribute__((ext_vector_type(2)));
typedef long i64x2 __attribute__((ext_vector_type(2)));
typedef int i32x4v __attribute__((ext_vector_type(4))); typedef int i32x8v __attribute__((ext_vector_type(8)));
constexpr int BM = 256, BK = 64, HALF = 128, HTB = HALF * BK * 2, STAGE_BYTES = 8 * HTB, NXCD = 8, WGM = 8;
constexpr int IDX_OFF = STAGE_BYTES, IDX_UNITS = 12;

__host__ __device__ __forceinline__ int lds_byte(int r, int c) { const int st = (r >> 4) * 2 + (c >> 5), rr = r & 15, cc = c & 31, ob = rr * 64 + cc * 2; return st * 1024 + (ob ^ (((ob >> 9) & 1) << 5)); }
__host__ __device__ __forceinline__ void stage_rc(int b, int& R, int& C) { const int st = b / 1024, sb = b % 1024, swz = sb ^ (((sb >> 9) & 1) << 5); R = (st >> 1) * 16 + swz / 64; C = (st & 1) * 32 + (swz % 64) / 2; }
__host__ __device__ __forceinline__ int perm32(int rho) { const int n = rho >> 4, i = rho & 15; return 8 * (i >> 2) + 4 * n + (i & 3); }

struct Unit { int pm, pn, e, j; };
struct Gemm { const bf16_t* A; const bf16_t* Bt; int M, N, K; const int* rowidx; };

struct StaticOrder {
    int nM, nN, nwg, G, c;
    __host__ __device__ void init(int M, int N, int G_, int c_) { nM = M / BM; nN = N / BM; nwg = nM * nN; G = G_; c = c_; }
    __host__ __device__ bool next(int i, Unit& u) const {
        const long L = (long)i * G + c; if (L >= nwg) return false;
        int wgid = (int)L; { const int q = nwg / NXCD, r = nwg % NXCD, xcd = wgid % NXCD, off = wgid / NXCD; wgid = (xcd < r ? xcd * (q + 1) : r * (q + 1) + (xcd - r) * q) + off; }
        const int nig = WGM * nN, gid = wgid / nig, fm = gid * WGM, gsz = (nM - fm) < WGM ? (nM - fm) : WGM;
        u.pm = fm + ((wgid % nig) % gsz); u.pn = (wgid % nig) / gsz; u.e = 0; u.j = u.pn; return true;
    }
};
struct MoeOrder {
    int nN, G, c, NT; const int* tile_e;
    __device__ bool next(int i, Unit& u) const {
        int tile, j;
        if (G == 256) { const int x = c & 7, y = c >> 3; tile = i * (256 / nN) + x * (32 / nN) + y / nN; j = y % nN; if (tile >= NT + NLAT / 256) return false; }
        else { const int L = i * G + c; if (L >= (NT + NLAT / 256) * nN) return false; tile = L / nN; j = L - tile * nN; }
        int e, pm;
        if (tile < NT) { e = tile_e[tile]; pm = tile; } else { e = NE; pm = MAXTILES + (tile - NT); }
        u.pm = pm; u.pn = e * nN + j; u.e = e; u.j = j; return true;
    }
};

typedef __bf16 bf16x2n __attribute__((ext_vector_type(2))); typedef float f32x2n __attribute__((ext_vector_type(2)));
__device__ __forceinline__ unsigned cvt_pk_bf16(float lo, float hi) { const f32x2n v = {lo, hi}; return __builtin_bit_cast(unsigned, __builtin_convertvector(v, bf16x2n)); }

template <class Epi, class Sched, bool ALIGN_EPI, bool SP2, bool GATHER, bool FP8 = false>
__device__ __forceinline__ void gemm_phase(PG8_LAS unsigned char* lds, const Gemm g, const Sched& S, const Epi& E) {
    const int tid = threadIdx.x, wid = __builtin_amdgcn_readfirstlane(tid >> 6), lane = tid & 63, wr = wid >> 2, wc = wid & 3, fr = lane & 15, fq = lane >> 4;
    const int K = g.K, nt = K / BK;
    const size_t kstep = (size_t)(BK * 2);
    const size_t hstep = (size_t)HALF * K * 2;
    const size_t tstep = 2 * hstep;
    unsigned voffB[2]; unsigned va[2][2];
#pragma unroll
    for (int i = 0; i < 2; ++i) { int R, C; stage_rc(tid * 16 + i * 8192, R, C); const int Rb = Epi::PERM ? ((R & ~31) + perm32(R & 31)) : R;
        voffB[i] = (unsigned)(Rb * K + C) * 2u;
        va[0][i] = (unsigned)(R * K + C) * 2u; va[1][i] = va[0][i]; }
    const size_t ah = GATHER ? (size_t)0 : hstep;
#define PG8_GOFF(dst, ub) do { _Pragma("unroll") for (int _h = 0; _h < 2; ++_h) _Pragma("unroll") for (int _i = 0; _i < 2; ++_i) { int _R, _C; stage_rc(tid * 16 + _i * 8192, _R, _C); \
        dst[_h][_i] = (unsigned)(idxt[(ub) * 256 + _h * 128 + _R] * K + _C) * 2u; } } while (0)
    const unsigned ldsw = (unsigned)wid * 1024u;
    const int aoff = lds_byte(wr * 64 + fr, fq * 8), boff = lds_byte(wc * 32 + fr, fq * 8);
    PG8_LAS int* idxt = (PG8_LAS int*)(lds + IDX_OFF);
#define PG8_SA(b, h) (((b) * 2 + (h)) * HTB)
#define PG8_SB(b, h) ((4 + (b) * 2 + (h)) * HTB)
#define PG8_STAGE(bufoff, gbase, voff) do { _Pragma("unroll") for (int _i = 0; _i < 2; ++_i) \
        __builtin_amdgcn_global_load_lds((const unsigned*)((const char*)(gbase) + (voff)[_i]), (PG8_LAS unsigned*)(lds + (bufoff) + ldsw + _i * 8192), 16, 0, 0); } while (0)
#define PG8_LD32(dst, addr) do { const i32x4v _lo = *(const PG8_LAS i32x4v*)(addr), _hi = *(const PG8_LAS i32x4v*)((addr) + 1024); dst = __builtin_shufflevector(_lo, _hi, 0, 1, 2, 3, 4, 5, 6, 7); } while (0)
#define PG8_LDA(dst, b, h) do { _Pragma("unroll") for (int m = 0; m < 4; ++m) PG8_LD32(dst[m], lds + PG8_SA(b, h) + aoff + m * 2048); } while (0)
#define PG8_LDB(dst, b, h) do { _Pragma("unroll") for (int n = 0; n < 2; ++n) PG8_LD32(dst[n], lds + PG8_SB(b, h) + boff + n * 2048); } while (0)
#define PG8_HALF(v, k) __builtin_bit_cast(bf16x8, (k) ? __builtin_shufflevector(v, v, 4, 5, 6, 7) : __builtin_shufflevector(v, v, 0, 1, 2, 3))
#define PG8_MMA(ai, bj, At, Bt) do { __builtin_amdgcn_s_setprio(1); _Pragma("unroll") for (int m = 0; m < 4; ++m) _Pragma("unroll") for (int n = 0; n < 2; ++n) { \
        if constexpr (FP8) asm volatile("v_mfma_f32_16x16x128_f8f6f4 %0, %1, %2, %0" : "+v"(acc[ai][bj][m][n]) : "v"(Bt[n]), "v"(At[m])); \
        else { _Pragma("unroll") for (int k = 0; k < 2; ++k) acc[ai][bj][m][n] = __builtin_amdgcn_mfma_f32_16x16x32_bf16(PG8_HALF(Bt[n], k), PG8_HALF(At[m], k), acc[ai][bj][m][n], 0, 0, 0); } } __builtin_amdgcn_s_setprio(0); } while (0)
#define PG8_WAIT_V(n) asm volatile("s_waitcnt vmcnt(" #n ")" ::: "memory")
#define PG8_WAIT_L(n) asm volatile("s_waitcnt lgkmcnt(" #n ")" ::: "memory")
#define PG8_BAR __builtin_amdgcn_s_barrier()
#define PG8_SCHED __builtin_amdgcn_sched_barrier(0)
    Unit cur, nxt; int ui = 0;
    if (!S.next(0, cur)) return;
#ifdef GEMM_STAGGER
    if constexpr (FP8) {
        const unsigned long long t0 = __builtin_amdgcn_s_memrealtime(); const unsigned long long dl = (unsigned long long)(blockIdx.x & 3) * GEMM_STAGGER;
        while (__builtin_amdgcn_s_memrealtime() - t0 < dl) __builtin_amdgcn_s_sleep(8);
    }
#endif
    if constexpr (GATHER) {
        Unit uu;
        for (int i = 0; i < IDX_UNITS; ++i) { if (!S.next(i, uu)) break; if (tid < 256) idxt[i * 256 + tid] = g.rowidx[(size_t)uu.pm * 256 + tid]; }
        asm volatile("s_waitcnt vmcnt(0) lgkmcnt(0)" ::: "memory"); PG8_BAR; asm volatile("" ::: "memory");
        PG8_GOFF(va, 0);
    }
    f32x4 acc[2][2][4][2];
#pragma unroll
    for (int a = 0; a < 2; ++a)
#pragma unroll
        for (int b = 0; b < 2; ++b)
#pragma unroll
            for (int m = 0; m < 4; ++m)
#pragma unroll
                for (int n = 0; n < 2; ++n) acc[a][b][m][n] = (f32x4){0.f, 0.f, 0.f, 0.f};
    i32x8v At[4], B0[2], B1[2];
    const char* cA = (const char*)g.A + (GATHER ? (size_t)0 : (size_t)cur.pm * tstep); const char* cB = (const char*)g.Bt + (size_t)cur.pn * tstep;
    if constexpr (SP2) {
        PG8_STAGE(PG8_SB(0, 0), cB, voffB); PG8_STAGE(PG8_SB(0, 1), cB + hstep, voffB); PG8_STAGE(PG8_SA(0, 0), cA, va[0]); PG8_STAGE(PG8_SA(0, 1), cA + ah, va[1]);
        if (wr == 1) PG8_BAR;
        PG8_WAIT_V(2); PG8_BAR;
        PG8_STAGE(PG8_SB(1, 0), cB + kstep, voffB); PG8_STAGE(PG8_SA(1, 0), cA + kstep, va[0]); PG8_STAGE(PG8_SB(1, 1), cB + hstep + kstep, voffB);
        PG8_WAIT_V(6); PG8_BAR;
    } else {
        PG8_STAGE(PG8_SB(0, 0), cB, voffB); PG8_STAGE(PG8_SA(0, 0), cA, va[0]); PG8_STAGE(PG8_SB(0, 1), cB + hstep, voffB); PG8_STAGE(PG8_SA(0, 1), cA + ah, va[1]);
        if (wr == 1) PG8_BAR;
        PG8_WAIT_V(4); PG8_BAR;
        PG8_STAGE(PG8_SB(1, 0), cB + kstep, voffB); PG8_STAGE(PG8_SA(1, 0), cA + kstep, va[0]); PG8_STAGE(PG8_SB(1, 1), cB + hstep + kstep, voffB);
        PG8_WAIT_V(6); PG8_BAR;
    }
    for (;;) {
        const bool has_next = S.next(ui + 1, nxt);
        const char* nA = has_next ? (const char*)g.A + (GATHER ? (size_t)0 : (size_t)nxt.pm * tstep) : cA; const char* nB = has_next ? (const char*)g.Bt + (size_t)nxt.pn * tstep : cB;
        const int ubn = (has_next && ui + 1 < IDX_UNITS) ? (ui + 1) : ui;
#pragma unroll 1
        for (int t = 0; t < nt; t += 2) {
            const bool last = (t == nt - 2);
            const char* a1 = cA + (size_t)(t + 1) * kstep;
            const char* a2 = last ? nA : cA + (size_t)(t + 2) * kstep; const char* b2 = last ? nB : cB + (size_t)(t + 2) * kstep;
            const char* a3 = a2 + kstep; const char* b3 = b2 + kstep;
            unsigned v2[2][2];
#pragma unroll
            for (int h = 0; h < 2; ++h)
#pragma unroll
                for (int i = 0; i < 2; ++i) v2[h][i] = va[h][i];
            if constexpr (GATHER) { if (last) PG8_GOFF(v2, ubn); }
            if constexpr (SP2) {
            PG8_LDB(B0, 0, 0); PG8_LDB(B1, 0, 1); PG8_SCHED; PG8_LDA(At, 0, 0); PG8_STAGE(PG8_SA(1, 1), a1 + ah, va[1]);
            PG8_WAIT_V(8); PG8_WAIT_L(0); PG8_BAR; PG8_MMA(0, 0, At, B0); PG8_MMA(0, 1, At, B1); PG8_BAR; PG8_SCHED;
            PG8_LDA(At, 0, 1); PG8_STAGE(PG8_SB(0, 0), b2, voffB); PG8_STAGE(PG8_SB(0, 1), b2 + hstep, voffB); PG8_STAGE(PG8_SA(0, 0), a2, v2[0]);
            PG8_WAIT_V(8); PG8_WAIT_L(0); PG8_BAR; PG8_MMA(1, 0, At, B0); PG8_MMA(1, 1, At, B1); PG8_BAR; PG8_SCHED;
            PG8_LDB(B0, 1, 0); PG8_LDB(B1, 1, 1); PG8_SCHED; PG8_LDA(At, 1, 0); PG8_STAGE(PG8_SA(0, 1), a2 + ah, v2[1]);
            PG8_WAIT_V(8); PG8_WAIT_L(0); PG8_BAR; PG8_MMA(0, 0, At, B0); PG8_MMA(0, 1, At, B1); PG8_BAR; PG8_SCHED;
            PG8_LDA(At, 1, 1); PG8_STAGE(PG8_SB(1, 0), b3, voffB); PG8_STAGE(PG8_SB(1, 1), b3 + hstep, voffB); PG8_STAGE(PG8_SA(1, 0), a3, v2[0]);
            PG8_WAIT_V(8); PG8_WAIT_L(0); PG8_BAR; PG8_MMA(1, 0, At, B0); PG8_MMA(1, 1, At, B1); PG8_BAR; PG8_SCHED;
            } else {
            PG8_LDB(B0, 0, 0); PG8_SCHED; PG8_LDA(At, 0, 0); PG8_STAGE(PG8_SA(1, 1), a1 + ah, va[1]);
            PG8_WAIT_L(8); PG8_BAR; PG8_WAIT_L(0); PG8_MMA(0, 0, At, B0); PG8_BAR; PG8_SCHED;
            PG8_LDB(B1, 0, 1); PG8_STAGE(PG8_SB(0, 0), b2, voffB);
            PG8_BAR; PG8_WAIT_L(0); PG8_MMA(0, 1, At, B1); PG8_BAR;
            PG8_LDA(At, 0, 1); PG8_STAGE(PG8_SA(0, 0), a2, v2[0]);
            PG8_BAR; PG8_WAIT_L(0); PG8_MMA(1, 0, At, B0); PG8_BAR; PG8_SCHED;
            PG8_STAGE(PG8_SB(0, 1), b2 + hstep, voffB);
            PG8_WAIT_V(6); PG8_BAR; PG8_MMA(1, 1, At, B1); PG8_BAR;
            PG8_LDB(B0, 1, 0); PG8_SCHED; PG8_LDA(At, 1, 0); PG8_STAGE(PG8_SA(0, 1), a2 + ah, v2[1]);
            PG8_WAIT_L(8); PG8_BAR; PG8_WAIT_L(0); PG8_MMA(0, 0, At, B0); PG8_BAR; PG8_SCHED;
            PG8_LDB(B1, 1, 1); PG8_STAGE(PG8_SB(1, 0), b3, voffB);
            PG8_BAR; PG8_WAIT_L(0); PG8_MMA(0, 1, At, B1); PG8_BAR;
            PG8_LDA(At, 1, 1); PG8_STAGE(PG8_SA(1, 0), a3, v2[0]);
            PG8_BAR; PG8_WAIT_L(0); PG8_MMA(1, 0, At, B0); PG8_BAR; PG8_SCHED;
            PG8_STAGE(PG8_SB(1, 1), b3 + hstep, voffB);
            PG8_WAIT_V(6); PG8_BAR; PG8_MMA(1, 1, At, B1); PG8_BAR;
            }
        }
        if constexpr (ALIGN_EPI) { if (wr == 0) PG8_BAR; }
        if constexpr (FP8) asm volatile("s_nop 15\n\ts_nop 15" ::: "memory");
        E(acc, cur, wr, wc, fr, fq);
        if (!has_next) break;
#pragma unroll
        for (int a = 0; a < 2; ++a)
#pragma unroll
            for (int b = 0; b < 2; ++b)
#pragma unroll
                for (int m = 0; m < 4; ++m)
#pragma unroll
                    for (int n = 0; n < 2; ++n) acc[a][b][m][n] = (f32x4){0.f, 0.f, 0.f, 0.f};
        cur = nxt; cA = nA; cB = nB; ++ui;
        if constexpr (GATHER) PG8_GOFF(va, ubn);
        if constexpr (ALIGN_EPI) { if (wr == 1) PG8_BAR; }
    }
    PG8_WAIT_V(0);
    if constexpr (!ALIGN_EPI) { if (wr == 0) PG8_BAR; }
    PG8_BAR;
#undef PG8_SA
#undef PG8_GOFF
#undef PG8_SB
#undef PG8_STAGE
#undef PG8_LDA
#undef PG8_LD32
#undef PG8_HALF
#undef PG8_LDB
#undef PG8_MMA
#undef PG8_WAIT_V
#undef PG8_WAIT_L
#undef PG8_BAR
#undef PG8_SCHED
}
}

#define XB_TMO      128
#define XB_XCNT(j)  (256  + 64 * (j))
#define XB_XSUB(j)  (1280 + 64 * (j))
#define XB_XGEN(j)  (2304 + 64 * (j))
#define XB_TOP      3328
#define XB_TOPGEN   3392
#define XCD_BAR_WORDS 3456
#define XB_SPIN_CAP (1u << 18)
__device__ __forceinline__ unsigned xb_ld(unsigned* p)              { return __hip_atomic_load(p, __ATOMIC_RELAXED, __HIP_MEMORY_SCOPE_AGENT); }
__device__ __forceinline__ unsigned xb_add(unsigned* p, unsigned v) { return __hip_atomic_fetch_add(p, v, __ATOMIC_RELAXED, __HIP_MEMORY_SCOPE_AGENT); }
__device__ __forceinline__ unsigned xb_xcc_id() { return (unsigned)__builtin_amdgcn_s_getreg((3 << 11) | 20) & 0xFu; }
#define XB_SPIN(cond, bar) do { unsigned _sp = 0; while (cond) { __builtin_amdgcn_s_sleep(1); \
    if ((++_sp & 255u) == 0u) { if (xb_ld(&(bar)[XB_TMO])) break; if (_sp > XB_SPIN_CAP) { atomicAdd(&(bar)[XB_TMO], 1u); break; } } } } while (0)
struct XcdBarrier { unsigned* bar; unsigned x; volatile LAS unsigned* st; };
__device__ __forceinline__ XcdBarrier xcd_barrier_post(unsigned* bar, volatile LAS unsigned* st) {
    XcdBarrier b; b.bar = bar; b.x = xb_xcc_id(); b.st = st;
    if (threadIdx.x == 0) (void)xb_add(&bar[XB_XCNT(b.x)], 1u);
    return b;
}
__device__ __forceinline__ void xcd_barrier_complete(unsigned* bar, unsigned x, unsigned& nloc, unsigned& nx) {
    const unsigned G = gridDim.x * gridDim.y * gridDim.z;
    unsigned sum, cnt, mine, sp = 0u;
    for (;;) {
        sum = 0u; cnt = 0u; mine = 0u;
#pragma unroll
        for (unsigned j = 0; j < 16; ++j) { const unsigned c = xb_ld(&bar[XB_XCNT(j)]); sum += c; cnt += (c > 0u) ? 1u : 0u; mine = (j == x) ? c : mine; }
        if (sum == G) break;
        __builtin_amdgcn_s_sleep(1);
        if ((++sp & 255u) == 0u) { if (xb_ld(&bar[XB_TMO])) break; if (sp > XB_SPIN_CAP) { atomicAdd(&bar[XB_TMO], 1u); break; } }
    }
    nloc = mine > 0u ? mine : 1u; nx = cnt > 0u ? cnt : 1u;
}
__device__ __forceinline__ void xcd_barrier(const XcdBarrier& b) {
    asm volatile("s_waitcnt vmcnt(0)" ::: "memory");
    __syncthreads();
    if (threadIdx.x == 0) {
        unsigned* bar = b.bar;
        __builtin_amdgcn_s_waitcnt(0);
        unsigned nloc = b.st[0], nx = b.st[1];
        if (nloc == 0u) { xcd_barrier_complete(bar, b.x, nloc, nx); b.st[0] = nloc; b.st[1] = nx; }
        const unsigned old = xb_add(&bar[XB_XSUB(b.x)], 1u);
        const unsigned gen = old / nloc;
        if (old + 1u == (gen + 1u) * nloc) {
            __builtin_amdgcn_fence(__ATOMIC_RELEASE, "agent");
            asm volatile("s_waitcnt vmcnt(0)" ::: "memory");
            const unsigned og = xb_add(&bar[XB_TOP], 1u);
            const unsigned tg = og / nx;
            if (og + 1u == (tg + 1u) * nx) xb_add(&bar[XB_TOPGEN], 1u);
            else XB_SPIN(xb_ld(&bar[XB_TOPGEN]) == tg, bar);
            __builtin_amdgcn_fence(__ATOMIC_ACQUIRE, "agent");
            xb_add(&bar[XB_XGEN(b.x)], 1u);
            asm volatile("s_waitcnt vmcnt(0)" ::: "memory");
        } else {
            XB_SPIN(xb_ld(&bar[XB_XGEN(b.x)]) == gen, bar);
            __builtin_amdgcn_fence(__ATOMIC_ACQUIRE, "agent");
            asm volatile("s_waitcnt vmcnt(0)" ::: "memory");
        }
    }
    __syncthreads();
}

constexpr size_t MiB = 1u << 20;
constexpr size_t al(size_t x) { return (x + 4095) & ~(size_t)4095; }
constexpr size_t WS_CTL = 0, CTL_ZERO_BYTES = 1 * MiB;
constexpr int CW_BAR = 4096;
constexpr int CW_CNT = 16384, CNT_STRIDE = 64;
constexpr int CW_NT = CW_CNT + NE * CNT_STRIDE + 64;
static_assert((CW_NT + 1) * 4 <= (int)CTL_ZERO_BYTES, "control words inside the per-call memset");
constexpr size_t WS_MOD = 1 * MiB;
constexpr size_t WS_TILE_E = WS_MOD + 256 * 1024;
constexpr size_t WS_PADSTART = WS_TILE_E + 16 * 1024;
constexpr size_t WS_ROWTOK = 2 * MiB;
constexpr size_t WS_EIDX = 4 * MiB;
constexpr size_t WS_GATE = 5 * MiB;
constexpr size_t WS_DEST = 6 * MiB;
constexpr size_t WS_WIN = 8 * MiB;
constexpr size_t WS_WLORA = WS_WIN + al((size_t)NP * D * 2);
constexpr size_t WS_WBRRW = WS_WLORA + al((size_t)NLORA * KLORA * 2);
constexpr size_t WS_WBRGLA = WS_WBRRW + al((size_t)D * RWW * 2);
constexpr size_t WS_WOUT = WS_WBRGLA + al((size_t)D * RWW * 2);
constexpr size_t WS_WROUTER = WS_WOUT + al((size_t)D * D * 2);
constexpr size_t WS_WGU = WS_WROUTER + al((size_t)NE * D * 2);
constexpr size_t WS_WD = WS_WGU + al((size_t)(NE + 1) * 512 * D * 2);
constexpr size_t WS_PERSIST_END = WS_WD + al((size_t)(NE + 1) * D * FF * 2);
constexpr size_t WS_REGB = WS_PERSIST_END;
constexpr size_t SZ512F = al((size_t)MR * RWW * 4), SZ256F = al((size_t)MR * 256 * 4), SZ512H = al((size_t)MR * RWW * 2);
constexpr size_t WS_A1 = WS_REGB;
constexpr size_t WS_A2 = WS_A1;
constexpr size_t WS_KSUM = WS_A2 + al((size_t)MR * KLORA * 2);
static_assert(WS_KSUM + SZ512H <= WS_A1 + al((size_t)MR * D * 2), "A2 + KSUM fit in the A1 slot");
constexpr size_t WS_P = WS_A1 + al((size_t)MR * D * 2);
constexpr size_t WS_RB = WS_P + al((size_t)MR * NP * 2);
constexpr size_t WS_VB = WS_RB + SZ512H, WS_KKB = WS_VB + SZ512H, WS_KMF = WS_KKB + SZ512H, WS_KMB = WS_KMF + SZ512H, WS_BVF = WS_KMB + SZ512H, WS_BVB = WS_BVF + SZ512H;
constexpr size_t WS_LWF = WS_BVB + SZ512H, WS_LWB = WS_LWF + SZ512F;
constexpr size_t SZ256H = al((size_t)MR * 256 * 2);
constexpr size_t WS_QGB = WS_LWB + SZ512F, WS_KGB = WS_QGB + SZ256H, WS_VGB = WS_KGB + SZ256H, WS_LAF = WS_VGB + SZ512H, WS_LAB = WS_LAF + SZ256F;
constexpr size_t WS_RWG = WS_LAB + SZ256F;
constexpr size_t WS_ORWF = WS_RWG + SZ512H, WS_ORWB = WS_ORWF + SZ512H, WS_OGLF = WS_ORWB + SZ512H, WS_OGLB = WS_OGLF + SZ512H;
constexpr int CH = 64, NCHUNK = (CTXL + SEQ) / CH, NU_RW = 64 * NCHUNK, NU_GL = 32 * NCHUNK;
constexpr size_t WS_RH = WS_OGLB + SZ512H;
constexpr size_t WS_YL = WS_RH + al((size_t)NU_RW * 4096 * 2);
constexpr size_t WS_HH = WS_YL + al((size_t)NU_RW * 4096 * 2);
constexpr size_t WS_INTRA = WS_HH + al((size_t)NU_RW * 4096 * 2);
constexpr size_t WS_KV = WS_INTRA + al((size_t)NU_GL * 8192 * 2);
constexpr size_t WS_DD = WS_KV + al((size_t)NU_GL * 8192 * 2);
constexpr size_t WS_END_MIX = WS_DD + al((size_t)NU_GL * 64 * 4);
constexpr size_t OUT_GT = 0, OUT_QE = (size_t)NU_RW * 4096 * 2;
static_assert(OUT_QE + (size_t)NU_GL * 4096 * 2 <= (size_t)NLAT * D * 4, "scan scratch fits in d_out");
constexpr size_t WS_YRW = WS_LWF, WS_YGLA = WS_LWB, WS_Z = WS_HH, WS_Z8 = WS_ORWF;
static_assert((size_t)NLAT * D <= SZ512H, "Z8 fits in the forward RWKV scan output slot");
static_assert((size_t)NLAT * D * 2 <= (size_t)NU_RW * 4096 * 2, "Z fits in the HH slot");
constexpr size_t WS_X1 = WS_REGB;
constexpr size_t WS_A3 = WS_X1 + al((size_t)NLAT * D * 4);
constexpr size_t WS_LOGITS = WS_A3 + al((size_t)NLAT * D * 2);
constexpr size_t WS_ACT = WS_LOGITS + al((size_t)NLAT * NE * 4);
constexpr size_t WS_Y = WS_ACT + al((size_t)NROWS_E * FF * 2);
constexpr size_t WS_A3F = WS_Y + al((size_t)NROWS_E * D);
constexpr size_t WS_END_MOE = WS_A3F + al((size_t)NLAT * D);
constexpr size_t WS_END = WS_END_MIX > WS_END_MOE ? WS_END_MIX : WS_END_MOE;
static_assert(WS_END <= (size_t)2048 * MiB, "workspace map exceeds 2 GiB");

constexpr int RING_BYTES = 131072;
constexpr int IDX_BYTES = pg8::IDX_UNITS * 256 * 4;
constexpr int MISC_OFF = RING_BYTES + IDX_BYTES;
constexpr int S2_SF_OFF = MISC_OFF + 256;
constexpr int LDS_BYTES = S2_SF_OFF + 8192;
static_assert(pg8::IDX_OFF == RING_BYTES, "gather table sits right above the stage buffers");
constexpr int NWAVES = 8, NTHR = 512;

struct Args { const float* in[36]; float* out; unsigned char* ws; int ph_lo, ph_hi; };

struct Frame {
    LAS unsigned char* lds;
    int tid, lane, wave, G, gw, NGW;
    const float* const* in; float* out; unsigned char* ws; unsigned* ctl;
};

__device__ __forceinline__ float wave_sum(float v) {
#pragma unroll
    for (int o = 1; o < 64; o <<= 1) v += __shfl_xor(v, o);
    return v;
}
__device__ __forceinline__ unsigned f2bf(float f) { unsigned u = __builtin_bit_cast(unsigned, f); return (u + 0x7fffu + ((u >> 16) & 1u)) >> 16; }
typedef __bf16 bf16x2v __attribute__((ext_vector_type(2)));
__device__ __forceinline__ unsigned pk2(float lo, float hi) { const f32x2 v = {lo, hi}; return __builtin_bit_cast(unsigned, __builtin_convertvector(v, bf16x2v)); }
__device__ __forceinline__ float bflo(unsigned w) { return __builtin_bit_cast(float, w << 16); }
__device__ __forceinline__ float bfhi(unsigned w) { return __builtin_bit_cast(float, w & 0xffff0000u); }
__device__ __forceinline__ float sigmoidf_(float x) { return __builtin_amdgcn_rcpf(1.0f + __expf(-x)); }
__device__ __forceinline__ float siluf_(float x) { return x * __builtin_amdgcn_rcpf(1.0f + __expf(-x)); }
__device__ __forceinline__ float tanhf_(float x) { return 1.0f - 2.0f * __builtin_amdgcn_rcpf(1.0f + __expf(2.0f * x)); }
__device__ __forceinline__ float logsigmoidf_(float x) { return fminf(x, 0.f) - __logf(1.0f + __expf(-fabsf(x))); }

__device__ __forceinline__ void ln_stats(const f32x4 (&v)[4], float& mean, float& rstd) {
    float s = 0.f;
#pragma unroll
    for (int j = 0; j < 4; ++j) s += (v[j].x + v[j].y) + (v[j].z + v[j].w);
    mean = wave_sum(s) * (1.f / D); float s2 = 0.f;
#pragma unroll
    for (int j = 0; j < 4; ++j) { const f32x4 d = v[j] - mean; s2 += (d.x * d.x + d.y * d.y) + (d.z * d.z + d.w * d.w); }
    rstd = __builtin_amdgcn_rsqf(wave_sum(s2) * (1.f / D) + LN_EPS);
}

__device__ __forceinline__ unsigned pack_fp8x4(const f32x4 v) {
    int w = __builtin_amdgcn_cvt_pk_fp8_f32(__builtin_amdgcn_fmed3f(v[0], -448.f, 448.f), __builtin_amdgcn_fmed3f(v[1], -448.f, 448.f), 0, false);
    return (unsigned)__builtin_amdgcn_cvt_pk_fp8_f32(__builtin_amdgcn_fmed3f(v[2], -448.f, 448.f), __builtin_amdgcn_fmed3f(v[3], -448.f, 448.f), w, true); }
__device__ __forceinline__ void ld_row_bf16(const bf16* row, int lane, f32x4 (&v)[4]) {
    const v4u a = *(const v4u*)(row + 8 * lane), b = *(const v4u*)(row + 512 + 8 * lane);
    v[0] = (f32x4){bflo(a.x), bfhi(a.x), bflo(a.y), bfhi(a.y)}; v[1] = (f32x4){bflo(a.z), bfhi(a.z), bflo(a.w), bfhi(a.w)};
    v[2] = (f32x4){bflo(b.x), bfhi(b.x), bflo(b.y), bfhi(b.y)}; v[3] = (f32x4){bflo(b.z), bfhi(b.z), bflo(b.w), bfhi(b.w)};
}
__device__ __forceinline__ int rowcol(int lane, int j) { return 512 * (j >> 1) + 8 * lane + 4 * (j & 1); }
__device__ __forceinline__ void ph_x1pre_nomix(Frame& F) {
    const float* x = F.in[0];
    for (int m = F.gw; m < NLAT; m += F.NGW) {
        bf16* o = (bf16*)(F.ws + WS_X1) + (size_t)m * D;
#pragma unroll
        for (int h = 0; h < 2; ++h) { const float* xr = x + (size_t)m * D + 512 * h + 8 * F.lane; const f32x4 a = *(const f32x4*)xr * ALPHA, b = *(const f32x4*)(xr + 4) * ALPHA;
            v4u w; w.x = pk2(a.x, a.y); w.y = pk2(a.z, a.w); w.z = pk2(b.x, b.y); w.w = pk2(b.z, b.w); *(v4u*)(o + 512 * h + 8 * F.lane) = w; }
    }
}
__device__ __forceinline__ void ph_ln1(Frame& F) {
    const float* lw = F.in[26]; const float* lb = F.in[27]; const float* mod = (const float*)(F.ws + WS_MOD);
    bf16* A3 = (bf16*)(F.ws + WS_A3); const bf16* X1P = (const bf16*)(F.ws + WS_X1);
    constexpr int NR = 4;
    for (int m0 = F.gw; m0 < NLAT; m0 += NR * F.NGW) {
        v4u w[NR][2];
#pragma unroll
        for (int r = 0; r < NR; ++r) { const int mm = m0 + r * F.NGW; const bf16* row = X1P + (size_t)(mm < NLAT ? mm : m0) * D; w[r][0] = *(const v4u*)(row + 8 * F.lane); w[r][1] = *(const v4u*)(row + 512 + 8 * F.lane); }
        __builtin_amdgcn_sched_barrier(0);
#pragma unroll
        for (int r = 0; r < NR; ++r) { const int mm = m0 + r * F.NGW; const int m = mm < NLAT ? mm : m0; const int b = m / SEQ;
            f32x4 v[4];
            v[0] = (f32x4){bflo(w[r][0].x), bfhi(w[r][0].x), bflo(w[r][0].y), bfhi(w[r][0].y)}; v[1] = (f32x4){bflo(w[r][0].z), bfhi(w[r][0].z), bflo(w[r][0].w), bfhi(w[r][0].w)};
            v[2] = (f32x4){bflo(w[r][1].x), bfhi(w[r][1].x), bflo(w[r][1].y), bfhi(w[r][1].y)}; v[3] = (f32x4){bflo(w[r][1].z), bfhi(w[r][1].z), bflo(w[r][1].w), bfhi(w[r][1].w)};
            float mean, rstd; ln_stats(v, mean, rstd);
#if MS >= 2
            f32x4 h[4];
#pragma unroll
            for (int j = 0; j < 4; ++j) { const int c = rowcol(F.lane, j);
                const f32x4 x1 = (v[j] - mean) * rstd * *(const f32x4*)(lw + c) + *(const f32x4*)(lb + c);
                h[j] = x1 * (*(const f32x4*)(mod + b * 6144 + 4096 + c) + 1.0f) + *(const f32x4*)(mod + b * 6144 + 3072 + c); }
            bf16* ao = A3 + (size_t)m * D;
            { v4u o; o.x = pk2(h[0].x, h[0].y); o.y = pk2(h[0].z, h[0].w); o.z = pk2(h[1].x, h[1].y); o.w = pk2(h[1].z, h[1].w); *(v4u*)(ao + 8 * F.lane) = o;
              o.x = pk2(h[2].x, h[2].y); o.y = pk2(h[2].z, h[2].w); o.z = pk2(h[3].x, h[3].y); o.w = pk2(h[3].z, h[3].w); *(v4u*)(ao + 512 + 8 * F.lane) = o; }
            { unsigned char* af = F.ws + WS_A3F + (size_t)m * D; v2u o8;
              o8.x = pack_fp8x4(h[0]); o8.y = pack_fp8x4(h[1]); *(v2u*)(af + 8 * F.lane) = o8; o8.x = pack_fp8x4(h[2]); o8.y = pack_fp8x4(h[3]); *(v2u*)(af + 512 + 8 * F.lane) = o8; }
#endif
        }
    }
}
__device__ __forceinline__ f32x4 fp8x4(unsigned w) { const f32x2 lo = __builtin_amdgcn_cvt_pk_f32_fp8((int)w, false), hi = __builtin_amdgcn_cvt_pk_f32_fp8((int)w, true); return (f32x4){lo.x, lo.y, hi.x, hi.y}; }
__device__ __forceinline__ void ph_final(Frame& F) {
    const float* lw = F.in[34]; const float* lb = F.in[35]; const float* mod = (const float*)(F.ws + WS_MOD);
    const float* lw1 = F.in[26]; const float* lb1 = F.in[27]; const bf16* X1P = (const bf16*)(F.ws + WS_X1);
    const unsigned char* Y = F.ws + WS_Y; const int* DEST = (const int*)(F.ws + WS_DEST); const float* GATE = (const float*)(F.ws + WS_GATE);
    const int c0 = 16 * F.lane;
    for (int m0 = F.gw; m0 < NLAT; m0 += 2 * F.NGW) {
        int mm[2]; mm[0] = m0; mm[1] = (m0 + F.NGW < NLAT) ? m0 + F.NGW : m0;
        v4u xw[2][2];
#if MS >= 2
        v4u dw[2][2]; f32x4 gw[2][2];
#pragma unroll
        for (int r = 0; r < 2; ++r) { dw[r][0] = *(const v4u*)(DEST + mm[r] * 8); dw[r][1] = *(const v4u*)(DEST + mm[r] * 8 + 4); gw[r][0] = *(const f32x4*)(GATE + mm[r] * 8); gw[r][1] = *(const f32x4*)(GATE + mm[r] * 8 + 4); }
#endif
#pragma unroll
        for (int r = 0; r < 2; ++r) { const bf16* row = X1P + (size_t)mm[r] * D + c0; xw[r][0] = *(const v4u*)row; xw[r][1] = *(const v4u*)(row + 8); }
#if MS >= 2
        v4u yw[2][TOPK + 1];
#pragma unroll
        for (int r = 0; r < 2; ++r) {
            int dr[TOPK]; dr[0] = (int)dw[r][0].x; dr[1] = (int)dw[r][0].y; dr[2] = (int)dw[r][0].z; dr[3] = (int)dw[r][0].w; dr[4] = (int)dw[r][1].x; dr[5] = (int)dw[r][1].y; dr[6] = (int)dw[r][1].z; dr[7] = (int)dw[r][1].w;
#pragma unroll
            for (int k = 0; k <= TOPK; ++k) yw[r][k] = *(const v4u*)(Y + (size_t)(k < TOPK ? dr[k < TOPK ? k : 0] : SH_ROW0 + mm[r]) * D + c0); }
        __builtin_amdgcn_sched_barrier(0);
#endif
#pragma unroll
        for (int r = 0; r < 2; ++r) { const int m = mm[r]; const int b = m / SEQ;
            f32x4 v[4];
            v[0] = (f32x4){bflo(xw[r][0].x), bfhi(xw[r][0].x), bflo(xw[r][0].y), bfhi(xw[r][0].y)}; v[1] = (f32x4){bflo(xw[r][0].z), bfhi(xw[r][0].z), bflo(xw[r][0].w), bfhi(xw[r][0].w)};
            v[2] = (f32x4){bflo(xw[r][1].x), bfhi(xw[r][1].x), bflo(xw[r][1].y), bfhi(xw[r][1].y)}; v[3] = (f32x4){bflo(xw[r][1].z), bfhi(xw[r][1].z), bflo(xw[r][1].w), bfhi(xw[r][1].w)};
            { float mean1, rstd1; ln_stats(v, mean1, rstd1);
#pragma unroll
              for (int j = 0; j < 4; ++j) { const int c = c0 + 4 * j; v[j] = ((v[j] - mean1) * rstd1 * *(const f32x4*)(lw1 + c) + *(const f32x4*)(lb1 + c)) * ALPHA; } }
#if MS >= 2
            const float gt[TOPK] = {gw[r][0].x * 0.0625f, gw[r][0].y * 0.0625f, gw[r][0].z * 0.0625f, gw[r][0].w * 0.0625f, gw[r][1].x * 0.0625f, gw[r][1].y * 0.0625f, gw[r][1].z * 0.0625f, gw[r][1].w * 0.0625f};
#pragma unroll
            for (int j = 0; j < 4; ++j) { const unsigned ws8 = j == 0 ? yw[r][TOPK].x : (j == 1 ? yw[r][TOPK].y : (j == 2 ? yw[r][TOPK].z : yw[r][TOPK].w));
                f32x4 mo = fp8x4(ws8) * 0.0625f;
#pragma unroll
                for (int k = 0; k < TOPK; ++k) { const unsigned wk = j == 0 ? yw[r][k].x : (j == 1 ? yw[r][k].y : (j == 2 ? yw[r][k].z : yw[r][k].w)); mo += fp8x4(wk) * gt[k]; }
                v[j] += *(const f32x4*)(mod + b * 6144 + 5120 + c0 + 4 * j) * mo; }
#endif
            float mean, rstd; ln_stats(v, mean, rstd);
            float* o = F.out + (size_t)m * D + c0;
#pragma unroll
            for (int j = 0; j < 4; ++j) { const int c = c0 + 4 * j; *(f32x4*)(o + 4 * j) = (v[j] - mean) * rstd * *(const f32x4*)(lw + c) + *(const f32x4*)(lb + c); }
        }
    }
}


#if MS >= 2
template <int MODE, bool FP8 = false>
__device__ __forceinline__ void cvt_item(const float* W, int Nsrc, int nblk, bf16* WT, int row_off, int dpitch, LAS float* scr, int item, int lane) {
    const int kb = item / nblk, nb = item - kb * nblk, k0 = 64 * kb, n0 = 32 * nb;
    const int nn = n0 + (lane & 31);
#pragma unroll 8
    for (int i = 0; i < 32; ++i) { const int kk = 2 * i + (lane >> 5); scr[kk * 33 + (lane & 31)] = (nn < Nsrc) ? W[(size_t)(k0 + kk) * Nsrc + nn] : 0.f; }
    LDS_WAIT(); asm volatile("" ::: "memory");
    const int c = lane & 7;
#pragma unroll
    for (int j = 0; j < 4; ++j) { const int n = (lane >> 3) + 8 * j; const LAS float* s = scr + (8 * c) * 33 + n;
        v4u o; o.x = pk2(s[0 * 33], s[1 * 33]); o.y = pk2(s[2 * 33], s[3 * 33]); o.z = pk2(s[4 * 33], s[5 * 33]); o.w = pk2(s[6 * 33], s[7 * 33]);
        const int ng = n0 + n; int dr = ng;
        if (MODE == 1) { const int i2 = ng & 255; dr = 8 * (i2 >> 2) + (i2 & 3) + ((ng >= 256) ? 4 : 0); }
        if constexpr (FP8) { v2u o8; o8.x = pack_fp8x4((f32x4){s[0 * 33], s[1 * 33], s[2 * 33], s[3 * 33]} * W8S); o8.y = pack_fp8x4((f32x4){s[4 * 33], s[5 * 33], s[6 * 33], s[7 * 33]} * W8S);
            *(v2u*)((unsigned char*)WT + (size_t)(row_off + dr) * dpitch + k0 + 8 * c) = o8; }
        else *(v4u*)(WT + (size_t)(row_off + dr) * dpitch + k0 + 8 * c) = o; }
    LDS_WAIT(); asm volatile("" ::: "memory");
}

template <int MODE>
__device__ __forceinline__ void cvt_item_reg(const float* W, int Nsrc, bf16* WT, int row_off, int dpitch, int k0, int n0, int lane) {
    const float* src = W + (size_t)k0 * Nsrc + n0 + 4 * lane;
    f32x4 v[32];
#pragma unroll
    for (int i = 0; i < 32; ++i) v[i] = __builtin_nontemporal_load((const f32x4*)(src + (size_t)i * Nsrc));
#pragma unroll
    for (int j = 0; j < 4; ++j) {
        const int ng = n0 + 4 * lane + j; int dr = ng;
        if (MODE == 1) { const int i2 = ng & 255; dr = 8 * (i2 >> 2) + (i2 & 3) + ((ng >= 256) ? 4 : 0); }
        v4u* dst = (v4u*)(WT + (size_t)(row_off + dr) * dpitch + k0);
#pragma unroll
        for (int q = 0; q < 4; ++q) { v4u o; o.x = pk2(v[8 * q][j], v[8 * q + 1][j]); o.y = pk2(v[8 * q + 2][j], v[8 * q + 3][j]); o.z = pk2(v[8 * q + 4][j], v[8 * q + 5][j]); o.w = pk2(v[8 * q + 6][j], v[8 * q + 7][j]); dst[q] = o; }
    }
}

constexpr int CVK = 32;
__device__ __forceinline__ void cvt_reg_load(const float* W, int Nsrc, int k0, int n0, int lane, f32x4 (&v)[CVK]) {
    const float* src = W + (size_t)k0 * Nsrc + n0 + 4 * lane;
#pragma unroll
    for (int i = 0; i < CVK; ++i) v[i] = __builtin_nontemporal_load((const f32x4*)(src + (size_t)i * Nsrc));
}
template <int MODE, bool FP8 = false>
__device__ __forceinline__ void cvt_reg_store(bf16* WT, int row_off, int dpitch, int k0, int n0, int lane, const f32x4 (&v)[CVK]) {
#pragma unroll
    for (int j = 0; j < 4; ++j) {
        const int ng = n0 + 4 * lane + j; int dr = ng;
        if (MODE == 1) { const int i2 = ng & 255; dr = 8 * (i2 >> 2) + (i2 & 3) + ((ng >= 256) ? 4 : 0); }
        if constexpr (FP8) { v4u* dst8 = (v4u*)((unsigned char*)WT + (size_t)(row_off + dr) * dpitch + k0);
#pragma unroll
            for (int q = 0; q < CVK / 16; ++q) { v4u o;
                o.x = pack_fp8x4((f32x4){v[16 * q][j], v[16 * q + 1][j], v[16 * q + 2][j], v[16 * q + 3][j]} * W8S); o.y = pack_fp8x4((f32x4){v[16 * q + 4][j], v[16 * q + 5][j], v[16 * q + 6][j], v[16 * q + 7][j]} * W8S);
                o.z = pack_fp8x4((f32x4){v[16 * q + 8][j], v[16 * q + 9][j], v[16 * q + 10][j], v[16 * q + 11][j]} * W8S); o.w = pack_fp8x4((f32x4){v[16 * q + 12][j], v[16 * q + 13][j], v[16 * q + 14][j], v[16 * q + 15][j]} * W8S); dst8[q] = o; }
            continue; }
        v4u* dst = (v4u*)(WT + (size_t)(row_off + dr) * dpitch + k0);
#pragma unroll
        for (int q = 0; q < CVK / 8; ++q) { v4u o; o.x = pg8::cvt_pk_bf16(v[8 * q][j], v[8 * q + 1][j]); o.y = pg8::cvt_pk_bf16(v[8 * q + 2][j], v[8 * q + 3][j]); o.z = pg8::cvt_pk_bf16(v[8 * q + 4][j], v[8 * q + 5][j]); o.w = pg8::cvt_pk_bf16(v[8 * q + 6][j], v[8 * q + 7][j]); dst[q] = o; }
    }
}
constexpr int CV_GU = (D / CVK) * 2, CV_DN = (FF / CVK) * 4, CV_NGU = (NE + 1) * CV_GU, CV_NITEM = CV_NGU + (NE + 1) * CV_DN;
__device__ __forceinline__ void cvx_load(const float* const* in, int it, int lane, f32x4 (&v)[CVK]) {
    if (it < CV_NGU) { const int e = it / CV_GU, ii = it - e * CV_GU; const float* src = (e < NE) ? in[30] + (size_t)e * D * 512 : in[32];
        cvt_reg_load(src, 512, CVK * (ii >> 1), 256 * (ii & 1), lane, v); }
    else { const int r = it - CV_NGU, e = r / CV_DN, ii = r - e * CV_DN; const float* src = (e < NE) ? in[31] + (size_t)e * FF * D : in[33];
        cvt_reg_load(src, D, CVK * (ii >> 2), 256 * (ii & 3), lane, v); }
}
__device__ __forceinline__ void cvx_store(unsigned char* ws, int it, int lane, const f32x4 (&v)[CVK]) {
    if (it < CV_NGU) { const int e = it / CV_GU, ii = it - e * CV_GU; cvt_reg_store<1, true>((bf16*)(ws + WS_WGU), e * 512, D, CVK * (ii >> 1), 256 * (ii & 1), lane, v); }
    else { const int r = it - CV_NGU, e = r / CV_DN, ii = r - e * CV_DN; cvt_reg_store<0, true>((bf16*)(ws + WS_WD), e * D, FF, CVK * (ii >> 2), 256 * (ii & 3), lane, v); }
}

typedef float f32x2v __attribute__((ext_vector_type(2)));
constexpr int CY_GU = (D / 32) * 4, CY_DN = (FF / 32) * 8, CY_NGU = (NE + 1) * CY_GU, CY_NITEM = CY_NGU + (NE + 1) * CY_DN;
#define CY_KB_GU(ii) ((((ii) >> 4) << 2) | ((ii) & 3))
#define CY_NB_GU(ii) (((ii) >> 2) & 3)
#define CY_KB_DN(ii) ((((ii) >> 5) << 2) | ((ii) & 3))
#define CY_NB_DN(ii) (((ii) >> 2) & 7)
__device__ __forceinline__ void cvy_load(const float* const* in, int it, int lane, f32x2v (&v)[32]) {
    const float* p;  int Nsrc;
    if (it < CY_NGU) { const int e = it / CY_GU, ii = it - e * CY_GU; const float* src = (e < NE) ? in[30] + (size_t)e * D * 512 : in[32]; Nsrc = 512; p = src + (size_t)(32 * CY_KB_GU(ii)) * 512 + 128 * CY_NB_GU(ii) + 2 * lane; }
    else { const int r = it - CY_NGU, e = r / CY_DN, ii = r - e * CY_DN; const float* src = (e < NE) ? in[31] + (size_t)e * FF * D : in[33]; Nsrc = D; p = src + (size_t)(32 * CY_KB_DN(ii)) * D + 128 * CY_NB_DN(ii) + 2 * lane; }
#pragma unroll
    for (int i = 0; i < 32; ++i) v[i] = __builtin_nontemporal_load((const f32x2v*)(p + (size_t)i * Nsrc));
}
__device__ __forceinline__ void cvy_store(unsigned char* ws, int it, int lane, const f32x2v (&v)[32]) {
    unsigned char* base; int dpitch, n0; bool gu = it < CY_NGU;
    if (gu) { const int e = it / CY_GU, ii = it - e * CY_GU; base = ws + WS_WGU + (size_t)(e * 512) * D + 32 * CY_KB_GU(ii); dpitch = D; n0 = 128 * CY_NB_GU(ii); }
    else { const int r = it - CY_NGU, e = r / CY_DN, ii = r - e * CY_DN; base = ws + WS_WD + (size_t)(e * D) * FF + 32 * CY_KB_DN(ii); dpitch = FF; n0 = 128 * CY_NB_DN(ii); }
#pragma unroll
    for (int j = 0; j < 2; ++j) {
        const int ng = n0 + 2 * lane + j; int dr = ng;
        if (gu) { const int i2 = ng & 255; dr = 8 * (i2 >> 2) + (i2 & 3) + ((ng >= 256) ? 4 : 0); }
        v4u* dst8 = (v4u*)(base + (size_t)dr * dpitch);
#pragma unroll
        for (int q = 0; q < 2; ++q) { v4u o;
            o.x = pack_fp8x4((f32x4){v[16 * q][j], v[16 * q + 1][j], v[16 * q + 2][j], v[16 * q + 3][j]} * W8S); o.y = pack_fp8x4((f32x4){v[16 * q + 4][j], v[16 * q + 5][j], v[16 * q + 6][j], v[16 * q + 7][j]} * W8S);
            o.z = pack_fp8x4((f32x4){v[16 * q + 8][j], v[16 * q + 9][j], v[16 * q + 10][j], v[16 * q + 11][j]} * W8S); o.w = pack_fp8x4((f32x4){v[16 * q + 12][j], v[16 * q + 13][j], v[16 * q + 14][j], v[16 * q + 15][j]} * W8S); dst8[q] = o; }
    }
}
#define CVY_FLUSH() do { if (cpend >= 0) cvy_store(F.ws, cpend, lane, cv); cpend = -1; } while (0)
#define CVY_START(item) do { if ((item) < CY_NITEM) { cvy_load(F.in, (item), lane, cv); cpend = (item); } } while (0)

#if MS >= 3
__device__ __forceinline__ float lora_val(const float* const* in, int n, int k) {
    if (n < 1024) { const int q = n >> 3, e8 = n & 7, dir = e8 >> 2, ch = q * 4 + (e8 & 3); return (k < 32) ? in[9][(size_t)(dir * 32 + k) * 512 + ch] : 0.f; }
    if (n < 2048) { const int m = n - 1024, q = m >> 3, e8 = m & 7, dir = e8 >> 2, ch = q * 4 + (e8 & 3); return (k >= 32 && k < 64) ? in[11][(size_t)(dir * 32 + (k - 32)) * 512 + ch] : 0.f; }
    if (n < 2560) { const int ch = n - 2048; return (k >= 64 && k < 160) ? in[12][(size_t)(k - 64) * 512 + ch] : 0.f; }
    { const int m = n - 2560, q = m >> 3, e8 = m & 7, dir = e8 >> 2, ch = q * 4 + (e8 & 3); return (k >= 160 && k < 176) ? in[19][(size_t)(dir * 16 + (k - 160)) * 256 + ch] : 0.f; }
}
#endif

__device__ __forceinline__ void ph_prologue(Frame& F) {
    {
        const float* c = F.in[1]; const float* cc = F.in[3]; const float* wa = F.in[4]; const float* ba = F.in[5];
        float* MOD = (float*)(F.ws + WS_MOD);
        LAS float* S = (LAS float*)F.lds; LAS float* red = (LAS float*)(F.lds + 32768);
        for (int it = blockIdx.x; it < 96; it += F.G) {
            for (int i = F.tid; i < 5120; i += NTHR) { const int r = i >> 10, k = i & 1023; const float cv = r < 4 ? c[r * 1024 + k] : cc[k]; S[i] = siluf_(cv); }
            __syncthreads();
            const int n = it * 64 + F.lane; float acc[5] = {0.f, 0.f, 0.f, 0.f, 0.f};
            for (int kk = 0; kk < 128; ++kk) { const int k = F.wave * 128 + kk; const float wv = wa[(size_t)k * 6144 + n];
#pragma unroll
                for (int r = 0; r < 5; ++r) acc[r] += S[r * 1024 + k] * wv; }
#pragma unroll
            for (int r = 0; r < 5; ++r) red[(F.wave * 5 + r) * 64 + F.lane] = acc[r];
            __syncthreads();
            if (F.wave == 0) {
#pragma unroll
                for (int r = 0; r < 5; ++r) { float s = 0.f;
#pragma unroll
                    for (int w = 0; w < 8; ++w) s += red[(w * 5 + r) * 64 + F.lane];
                    MOD[r * 6144 + n] = s + ba[n]; }
            }
            __syncthreads();
        }
    }
    {
        LAS float* scr = (LAS float*)(F.lds + F.wave * 16384);
        constexpr int I_IN = 16 * 168, I_BR = 8 * 32, I_OUT = 16 * 32, I_RT = 16 * 8, I_GU = 32 * 2, I_DN = 8 * 4;
        constexpr int T0 = I_IN, T1 = T0 + I_BR, T2 = T1 + I_BR, T3 = T2 + I_OUT, T4 = T3 + I_RT, T5 = T4 + (NE + 1) * I_GU, T6 = T5 + (NE + 1) * I_DN;
        unsigned char* ws = F.ws;
        for (int it = F.gw; it < T6; it += F.NGW) {
#if MS >= 3
            if (it < T0) { cvt_item<0, true>(F.in[6], IN_COLS, 168, (bf16*)(ws + WS_WIN), 0, D, scr, it, F.lane); continue; }
            if (it < T1) { cvt_item<0, true>(F.in[23], D, 32, (bf16*)(ws + WS_WBRRW), 0, RWW, scr, it - T0, F.lane); continue; }
            if (it < T2) { cvt_item<0, true>(F.in[24], D, 32, (bf16*)(ws + WS_WBRGLA), 0, RWW, scr, it - T1, F.lane); continue; }
            if (it < T3) { cvt_item<0, true>(F.in[25], D, 32, (bf16*)(ws + WS_WOUT), 0, D, scr, it - T2, F.lane); continue; }
#else
            if (it < T3) continue;
#endif
            if (it < T4) { cvt_item<0>(F.in[28], NE, 8, (bf16*)(ws + WS_WROUTER), 0, D, scr, it - T3, F.lane); continue; }
#if MS >= 3
            break;
#endif
            if (it < T5) { const int r = it - T4, e = r / I_GU, ii = r - e * I_GU;
                const float* src = (e < NE) ? F.in[30] + (size_t)e * D * 512 : F.in[32];
                cvt_item_reg<1>(src, 512, (bf16*)(ws + WS_WGU), e * 512, D, 32 * (ii >> 1), 256 * (ii & 1), F.lane); continue; }
            { const int r = it - T5, e = r / I_DN, ii = r - e * I_DN;
                const float* src = (e < NE) ? F.in[31] + (size_t)e * FF * D : F.in[33];
                cvt_item_reg<0>(src, D, (bf16*)(ws + WS_WD), e * D, FF, 32 * (ii >> 2), 256 * (ii & 3), F.lane); }
        }
    }
#if MS >= 3
    {
        bf16* WL = (bf16*)(F.ws + WS_WLORA);
        for (int idx = blockIdx.x * NTHR + F.tid; idx < NLORA * (KLORA / 8); idx += F.G * NTHR) {
            const int n = idx >> 5, k0 = (idx & 31) * 8; float v[8];
#pragma unroll
            for (int e = 0; e < 8; ++e) v[e] = lora_val(F.in, n, k0 + e);
            v4u o; o.x = pk2(v[0], v[1]); o.y = pk2(v[2], v[3]); o.z = pk2(v[4], v[5]); o.w = pk2(v[6], v[7]);
            *(v4u*)(WL + (size_t)n * KLORA + k0) = o;
        }
    }
#endif
}

struct EpiF32 {
    static constexpr bool PERM = false;
    float* C; int ldc;
    __device__ __forceinline__ void operator()(const f32x4 (&acc)[2][2][4][2], const pg8::Unit& u, int wr, int wc, int fr, int fq) const {
        const int row0 = u.pm * 256 + wr * 64 + fr, col0 = u.pn * 256 + wc * 32 + 4 * fq;
#pragma unroll
        for (int ai = 0; ai < 2; ++ai)
#pragma unroll
            for (int m = 0; m < 4; ++m) { float* rowp = C + (size_t)(row0 + ai * 128 + m * 16) * ldc + col0;
#pragma unroll
                for (int bj = 0; bj < 2; ++bj)
#pragma unroll
                    for (int n = 0; n < 2; ++n) *(f32x4*)(rowp + bj * 128 + n * 16) = acc[ai][bj][m][n]; }
    }
};
struct EpiSwiglu {
    static constexpr bool PERM = true;
    unsigned char* ACT;
    __device__ __forceinline__ void operator()(const f32x4 (&acc)[2][2][4][2], const pg8::Unit& u, int wr, int wc, int fr, int fq) const {
        const int row0 = u.pm * 256 + wr * 64 + fr, h0 = u.j * 128 + wc * 16 + 4 * fq;
#pragma unroll
        for (int ai = 0; ai < 2; ++ai)
#pragma unroll
            for (int m = 0; m < 4; ++m) { unsigned char* rowp = ACT + (size_t)(row0 + ai * 128 + m * 16) * FF + h0;
#pragma unroll
                for (int bj = 0; bj < 2; ++bj) { const f32x4 a = acc[ai][bj][m][0] * W8I, b = acc[ai][bj][m][1] * W8I;
                    *(unsigned*)(rowp + bj * 64) = pack_fp8x4((f32x4){siluf_(a[0]) * b[0], siluf_(a[1]) * b[1], siluf_(a[2]) * b[2], siluf_(a[3]) * b[3]}); } }
    }
};
struct EpiRowsBf16 {
    static constexpr bool PERM = true;
    bf16* O; int ldc; float sc;
    __device__ __forceinline__ void operator()(const f32x4 (&acc)[2][2][4][2], const pg8::Unit& u, int wr, int wc, int fr, int fq) const {
        const int row0 = u.pm * 256 + wr * 64 + fr, col0 = u.j * 256 + wc * 32 + 8 * fq;
#pragma unroll
        for (int ai = 0; ai < 2; ++ai)
#pragma unroll
            for (int m = 0; m < 4; ++m) { bf16* rowp = O + (size_t)(row0 + ai * 128 + m * 16) * ldc + col0;
#pragma unroll
                for (int bj = 0; bj < 2; ++bj) { const f32x4 v0 = acc[ai][bj][m][0] * sc, v1 = acc[ai][bj][m][1] * sc;
                    v4u w; w.x = pg8::cvt_pk_bf16(v0[0], v0[1]); w.y = pg8::cvt_pk_bf16(v0[2], v0[3]); w.z = pg8::cvt_pk_bf16(v1[0], v1[1]); w.w = pg8::cvt_pk_bf16(v1[2], v1[3]);
                    *(v4u*)(rowp + bj * 128) = w;
#ifdef PROBE_ST2
                    asm volatile("" ::: "memory"); *(volatile v4u*)(rowp + bj * 128) = w;
#endif
                    } }
    }
};

struct EpiRowsFp8 {
    static constexpr bool PERM = true;
    unsigned char* O;
    __device__ __forceinline__ void operator()(const f32x4 (&acc)[2][2][4][2], const pg8::Unit& u, int wr, int wc, int fr, int fq) const {
        const int row0 = u.pm * 256 + wr * 64 + fr, col0 = u.j * 256 + wc * 32 + 8 * fq;
#pragma unroll
        for (int ai = 0; ai < 2; ++ai)
#pragma unroll
            for (int m = 0; m < 4; ++m) { unsigned char* rowp = O + (size_t)(row0 + ai * 128 + m * 16) * D + col0;
#pragma unroll
                for (int bj = 0; bj < 2; ++bj) { f32x4 v0 = acc[ai][bj][m][0] * (16.0f * W8I), v1 = acc[ai][bj][m][1] * (16.0f * W8I);
#pragma unroll
                    for (int e = 0; e < 4; ++e) { v0[e] = __builtin_amdgcn_fmed3f(v0[e], -448.0f, 448.0f); v1[e] = __builtin_amdgcn_fmed3f(v1[e], -448.0f, 448.0f); }
                    int w0 = __builtin_amdgcn_cvt_pk_fp8_f32(v0[0], v0[1], 0, false); w0 = __builtin_amdgcn_cvt_pk_fp8_f32(v0[2], v0[3], w0, true);
                    int w1 = __builtin_amdgcn_cvt_pk_fp8_f32(v1[0], v1[1], 0, false); w1 = __builtin_amdgcn_cvt_pk_fp8_f32(v1[2], v1[3], w1, true);
                    v2u w; w.x = (unsigned)w0; w.y = (unsigned)w1; *(v2u*)(rowp + bj * 128) = w; } }
    }
};

__device__ __forceinline__ void ph_router(Frame& F) {
    pg8::Gemm g{(const bf16*)(F.ws + WS_A3), (const bf16*)(F.ws + WS_WROUTER), NLAT, NE, D, nullptr};
    pg8::StaticOrder S; S.init(NLAT, NE, F.G, (int)blockIdx.x);
    EpiF32 E{(float*)(F.ws + WS_LOGITS), NE};
    pg8::gemm_phase<EpiF32, pg8::StaticOrder, true, true, false>(F.lds, g, S, E);
}

#define RT_DPP(x, ctrl) __builtin_amdgcn_update_dpp(0, (x), (ctrl), 0xf, 0xf, false)
__device__ __forceinline__ unsigned wave_max_u32(unsigned k) {
    k = max(k, (unsigned)RT_DPP((int)k, 0xB1)); k = max(k, (unsigned)RT_DPP((int)k, 0x4E));
    k = max(k, (unsigned)RT_DPP((int)k, 0x124)); k = max(k, (unsigned)RT_DPP((int)k, 0x128));
    const unsigned a = (unsigned)__builtin_amdgcn_readlane((int)k, 0), b = (unsigned)__builtin_amdgcn_readlane((int)k, 16), c = (unsigned)__builtin_amdgcn_readlane((int)k, 32), d = (unsigned)__builtin_amdgcn_readlane((int)k, 48);
    return max(max(a, b), max(c, d));
}
__device__ __forceinline__ void ph_route(Frame& F) {
    const float* LOG = (const float*)(F.ws + WS_LOGITS); const float* rb = F.in[29];
    int* EIDX = (int*)(F.ws + WS_EIDX); float* GATE = (float*)(F.ws + WS_GATE); int* DEST = (int*)(F.ws + WS_DEST);
    unsigned* CNT = F.ctl + CW_CNT;
    const f32x4 bias = *(const f32x4*)(rb + 4 * F.lane);
    f32x4 lgn = *(const f32x4*)(LOG + (size_t)(F.gw < NLAT ? F.gw : 0) * NE + 4 * F.lane);
    for (int m = F.gw; m < NLAT; m += F.NGW) {
        const f32x4 lg = lgn;
        { const int mn = (m + F.NGW < NLAT) ? m + F.NGW : m; lgn = *(const f32x4*)(LOG + (size_t)mn * NE + 4 * F.lane); }
        float sc[4], sel[4];
#pragma unroll
        for (int i = 0; i < 4; ++i) { sc[i] = sigmoidf_(lg[i]); sel[i] = sc[i] + bias[i]; }
        float m1 = fmaxf(sel[0], sel[1]), m2 = fminf(sel[0], sel[1]);
        { const float a = sel[2]; const float n1 = fmaxf(m1, a); m2 = fmaxf(m2, fminf(m1, a)); m1 = n1; }
        { const float a = sel[3]; const float n1 = fmaxf(m1, a); m2 = fmaxf(m2, fminf(m1, a)); m1 = n1; }
#define RT_MERGE(ctrl) do { const float b1 = __builtin_bit_cast(float, RT_DPP(__builtin_bit_cast(int, m1), ctrl)), b2 = __builtin_bit_cast(float, RT_DPP(__builtin_bit_cast(int, m2), ctrl)); \
            const float n1 = fmaxf(m1, b1); m2 = fmaxf(fminf(m1, b1), fmaxf(m2, b2)); m1 = n1; } while (0)
        RT_MERGE(0xB1); RT_MERGE(0x4E); RT_MERGE(0x141);
#undef RT_MERGE
        const float gs = m1 + m2; const int g = F.lane >> 3;
        int rank = 0;
#pragma unroll
        for (int gg = 0; gg < 8; ++gg) { const float og = __builtin_bit_cast(float, __builtin_amdgcn_readlane(__builtin_bit_cast(int, gs), gg * 8)); rank += (og > gs || (og == gs && gg < g)) ? 1 : 0; }
        const bool keep = rank < 4;
        unsigned key[4];
#pragma unroll
        for (int i = 0; i < 4; ++i) { unsigned u = __builtin_bit_cast(unsigned, sel[i]); u ^= (u >> 31) ? 0xffffffffu : 0x80000000u;
            key[i] = keep ? ((u & 0xffffff00u) | (unsigned)(255 - (4 * F.lane + i))) : 0u; }
        int my_e = 0; float my_s = 0.f; float ssum = 0.f;
#pragma unroll
        for (int k = 0; k < TOPK; ++k) {
            const unsigned best = wave_max_u32(max(max(key[0], key[1]), max(key[2], key[3])));
            const int e = 255 - (int)(best & 255u), owner = e >> 2;
            float s_own = 0.f;
#pragma unroll
            for (int i = 0; i < 4; ++i) if (key[i] == best) { s_own = sc[i]; key[i] = 0u; }
            const float s = __builtin_bit_cast(float, __builtin_amdgcn_readlane(__builtin_bit_cast(int, s_own), owner));
            ssum += s;
            if (F.lane == k) { my_e = e; my_s = s; }
        }
        if (F.lane < TOPK) {
            const unsigned pos = __hip_atomic_fetch_add(CNT + my_e * CNT_STRIDE, 1u, __ATOMIC_RELAXED, __HIP_MEMORY_SCOPE_AGENT);
            EIDX[m * 8 + F.lane] = my_e; GATE[m * 8 + F.lane] = my_s * __builtin_amdgcn_rcpf(ssum) * 2.5f; DEST[m * 8 + F.lane] = (int)pos;
        }
    }
}
#undef RT_DPP

__device__ __forceinline__ void ph_scatter(Frame& F) {
    LAS int* tstart = (LAS int*)F.lds;
    LAS int* scan = (LAS int*)(F.lds + 2048);
    LAS int* cnts = (LAS int*)(F.lds + 4096);
    int* EIDX = (int*)(F.ws + WS_EIDX); int* DEST = (int*)(F.ws + WS_DEST); int* ROWTOK = (int*)(F.ws + WS_ROWTOK); int* TILE_E = (int*)(F.ws + WS_TILE_E);
    unsigned* CNT = F.ctl + CW_CNT;
    int tiles = 0, cnt = 0;
    if (F.tid < NE) { cnt = (int)__hip_atomic_load(CNT + F.tid * CNT_STRIDE, __ATOMIC_RELAXED, __HIP_MEMORY_SCOPE_AGENT); tiles = (cnt + 255) >> 8; scan[F.tid] = tiles; cnts[F.tid] = cnt; }
    __syncthreads();
    for (int o = 1; o < NE; o <<= 1) { int v = 0; if (F.tid < NE && F.tid >= o) v = scan[F.tid - o]; __syncthreads(); if (F.tid < NE) scan[F.tid] += v; __syncthreads(); }
    if (F.tid < NE) { tstart[F.tid + 1] = scan[F.tid]; if (F.tid == 0) tstart[0] = 0; }
    __syncthreads();
    const int NT = tstart[NE];
    if (blockIdx.x == 0) {
        if (F.tid == 0) F.ctl[CW_NT] = (unsigned)NT;
        if (F.tid < NE) for (int t = tstart[F.tid]; t < tstart[F.tid + 1]; ++t) TILE_E[t] = F.tid;
    }
    for (int e = blockIdx.x; e < NE; e += F.G) { const int c0 = cnts[e], c1 = (tstart[e + 1] - tstart[e]) * 256, base = tstart[e] * 256;
        for (int p = c0 + F.tid; p < c1; p += NTHR) ROWTOK[base + p] = 0; }
    for (int i = blockIdx.x * NTHR + F.tid; i < NLAT; i += F.G * NTHR) ROWTOK[SH_ROW0 + i] = i;
    for (int i = blockIdx.x * NTHR + F.tid; i < NLAT * TOPK; i += F.G * NTHR) {
        const int e = EIDX[i], pos = DEST[i]; const int dr = tstart[e] * 256 + pos;
        DEST[i] = dr; ROWTOK[dr] = i >> 3;
    }
}

__device__ __forceinline__ void ph_exp1(Frame& F) {
    const int NT = (int)__hip_atomic_load(F.ctl + CW_NT, __ATOMIC_RELAXED, __HIP_MEMORY_SCOPE_AGENT);
    pg8::Gemm g{(const bf16*)(F.ws + WS_A3F), (const bf16*)(F.ws + WS_WGU), 0, 0, D / 2, (const int*)(F.ws + WS_ROWTOK)};
    pg8::MoeOrder S{2, F.G, (int)blockIdx.x, NT, (const int*)(F.ws + WS_TILE_E)};
    EpiSwiglu E{F.ws + WS_ACT};
    pg8::gemm_phase<EpiSwiglu, pg8::MoeOrder, true, true, true, true>(F.lds, g, S, E);
}
__device__ __forceinline__ void ph_exp2(Frame& F) {
    const int NT = (int)__hip_atomic_load(F.ctl + CW_NT, __ATOMIC_RELAXED, __HIP_MEMORY_SCOPE_AGENT);
    pg8::Gemm g{(const bf16*)(F.ws + WS_ACT), (const bf16*)(F.ws + WS_WD), 0, 0, FF / 2, nullptr};
    pg8::MoeOrder S{4, F.G, (int)blockIdx.x, NT, (const int*)(F.ws + WS_TILE_E)};
    EpiRowsFp8 E{F.ws + WS_Y};
    pg8::gemm_phase<EpiRowsFp8, pg8::MoeOrder, true, true, false, true>(F.lds, g, S, E);
}
#endif

#if MS >= 3
__device__ __forceinline__ void unp8(const v4u w, float (&f)[8]) { f[0] = bflo(w.x); f[1] = bfhi(w.x); f[2] = bflo(w.y); f[3] = bfhi(w.y); f[4] = bflo(w.z); f[5] = bfhi(w.z); f[6] = bflo(w.w); f[7] = bfhi(w.w); }
__device__ __forceinline__ void unp8f8(const v2u w, float (&f)[8]) { const f32x2 a = __builtin_amdgcn_cvt_pk_f32_fp8((int)w.x, false), b = __builtin_amdgcn_cvt_pk_f32_fp8((int)w.x, true), c = __builtin_amdgcn_cvt_pk_f32_fp8((int)w.y, false), d = __builtin_amdgcn_cvt_pk_f32_fp8((int)w.y, true);
    f[0] = a.x; f[1] = a.y; f[2] = b.x; f[3] = b.y; f[4] = c.x; f[5] = c.y; f[6] = d.x; f[7] = d.y; }
__device__ __forceinline__ v4u pk8(const float (&f)[8]) { v4u o; o.x = pk2(f[0], f[1]); o.y = pk2(f[2], f[3]); o.z = pk2(f[4], f[5]); o.w = pk2(f[6], f[7]); return o; }
__device__ __forceinline__ void st8(float* p, const float (&f)[8]) { *(f32x4*)p = (f32x4){f[0], f[1], f[2], f[3]}; *(f32x4*)(p + 4) = (f32x4){f[4], f[5], f[6], f[7]}; }
__device__ __forceinline__ void ld8(const float* p, float (&f)[8]) { const f32x4 a = *(const f32x4*)p, b = *(const f32x4*)(p + 4); f[0] = a.x; f[1] = a.y; f[2] = a.z; f[3] = a.w; f[4] = b.x; f[5] = b.y; f[6] = b.z; f[7] = b.w; }

__device__ __forceinline__ void ph_a1(Frame& F) {
    const float* mod = (const float*)(F.ws + WS_MOD); unsigned char* A1 = F.ws + WS_A1;
    constexpr int NR = 4;
    for (int m0 = F.gw; m0 < MR; m0 += NR * F.NGW) {
        f32x4 xv[NR][4];
#pragma unroll
        for (int r = 0; r < NR; ++r) { const int mm = m0 + r * F.NGW; const int m = mm < MR ? mm : m0;
            const float* src = (m < NLAT) ? F.in[0] + (size_t)m * D : F.in[2] + (size_t)(m - NLAT) * D;
            const f32x4* xr = (const f32x4*)src + F.lane;
#pragma unroll
            for (int j = 0; j < 4; ++j) xv[r][j] = __builtin_nontemporal_load(xr + 64 * j); }
        __builtin_amdgcn_sched_barrier(0);
#pragma unroll
        for (int r = 0; r < NR; ++r) { const int mm = m0 + r * F.NGW; const int m = mm < MR ? mm : m0; const int mr = (m < NLAT) ? (m / SEQ) : 4;
            unsigned* ao = (unsigned*)(A1 + (size_t)m * D) + F.lane;
#pragma unroll
            for (int j = 0; j < 4; ++j) { const int c = 4 * F.lane + 256 * j;
                const f32x4 sh = *(const f32x4*)(mod + mr * 6144 + c), sc = *(const f32x4*)(mod + mr * 6144 + 1024 + c);
                const f32x4 h = xv[r][j] * (sc + 1.0f) + sh; ao[64 * j] = pack_fp8x4(h); } }
    }
}

__device__ __forceinline__ void ph_inproj(Frame& F) {
    pg8::Gemm g{(const bf16*)(F.ws + WS_A1), (const bf16*)(F.ws + WS_WIN), MR, NP, D / 2, nullptr};
    pg8::StaticOrder S; S.init(MR, NP, F.G, (int)blockIdx.x);
    EpiRowsBf16 E{(bf16*)(F.ws + WS_P), NP, W8I};
    pg8::gemm_phase<EpiRowsBf16, pg8::StaticOrder, true, true, false, true>(F.lds, g, S, E);
}

__device__ __forceinline__ v2u pk8f8(const float (&v)[8]) { v2u o; o.x = pack_fp8x4((f32x4){v[0], v[1], v[2], v[3]}); o.y = pack_fp8x4((f32x4){v[4], v[5], v[6], v[7]}); return o; }
struct FeatOut { bf16 *R, *V, *KK, *KP, *QG, *KGB, *VGB, *A2; const float *mu, *kkw, *cw; };
__device__ __forceinline__ void feat_rw(const FeatOut& O, int p, size_t m, int lane, const v4u own_w, const v4u (&nbw)[4], const float (&muv)[8]) {
    float own[8], sh[4][8], val[8];
    unp8(own_w, own);
#pragma unroll
    for (int q = 0; q < 4; ++q) unp8(nbw[q], sh[q]);
#pragma unroll
    for (int e = 0; e < 8; ++e) val[e] = own[e] + muv[e] * (sh[e & 3][e] - own[e]);
    if (p == 0) *(v4u*)(O.R + m * RWW + 8 * lane) = pk8(val);
    else if (p == 2) *(v4u*)(O.V + m * RWW + 8 * lane) = pk8(val);
    else if (p == 1) {
        *(v4u*)(O.KP + m * RWW + 8 * lane) = pk8(val);
        float kw[8]; ld8(O.kkw + 8 * lane, kw); float kkv[8]; float ss = 0.f;
#pragma unroll
        for (int e = 0; e < 8; ++e) { kkv[e] = val[e] * kw[e]; ss += kkv[e] * kkv[e]; }
        ss += __shfl_xor(ss, 1); ss += __shfl_xor(ss, 2); ss += __shfl_xor(ss, 4);
        const float inv = 1.0f / fmaxf(sqrtf(ss), 1e-12f);
#pragma unroll
        for (int e = 0; e < 8; ++e) kkv[e] *= inv;
        *(v4u*)(O.KK + m * RWW + 8 * lane) = pk8(kkv);
    } else {
        float o[8];
#pragma unroll
        for (int e = 0; e < 8; ++e) o[e] = (lane < 4) ? tanhf_(val[e]) : ((lane < 8) ? val[e] : sigmoidf_(val[e]));
        *(v4u*)(O.A2 + m * KLORA + 8 * lane) = pk8(o);
    }
}
__device__ __forceinline__ void feat_gla_store(const FeatOut& O, int p, size_t m, int lane, const float (&acc)[8]) {
    const int cq = p * 512 + 8 * lane; float o[8];
#pragma unroll
    for (int e = 0; e < 8; ++e) o[e] = siluf_(acc[e]);
    if (p == 0) {
        if (lane < 32) {
#pragma unroll
            for (int e = 0; e < 8; ++e) o[e] *= 0.125f;
            *(v4u*)(O.QG + m * 256 + cq) = pk8(o);
        } else *(v4u*)(O.KGB + m * 256 + (cq - 256)) = pk8(o);
    } else *(v4u*)(O.VGB + m * RWW + (cq - 512)) = pk8(o);
}
__device__ __forceinline__ void ph_feat(Frame& F) {
    const bf16* P = (const bf16*)(F.ws + WS_P);
    FeatOut O{(bf16*)(F.ws + WS_RB), (bf16*)(F.ws + WS_VB), (bf16*)(F.ws + WS_KKB), (bf16*)(F.ws + WS_KMF), (bf16*)(F.ws + WS_QGB), (bf16*)(F.ws + WS_KGB), (bf16*)(F.ws + WS_VGB), (bf16*)(F.ws + WS_A2), F.in[7], F.in[13], F.in[18]};
    const v4u Z4 = (v4u){0u, 0u, 0u, 0u};
    for (int blk = F.gw; blk < NB * (GRIDH / 2) * (GRIDW / 2); blk += F.NGW) {
        int lane = F.lane; asm volatile("" : "+v"(lane));
        const int b = blk >> 11, r0 = 2 * ((blk >> 5) & 63), c0 = 2 * (blk & 31); const int mb = b * SEQ + r0 * GRIDW + c0;
        const bool vu = r0 > 0, vd = r0 + 2 < GRIDH, vl = c0 > 0, vr = c0 + 2 < GRIDW;
#pragma unroll
        for (int p = 0; p < 4; ++p) {
            const int cb = p * 512 + 8 * lane; const bool act = (p < 3) || lane < 20;
            v4u own[2][2], up[2], dn[2], lf[2], rt[2];
#pragma unroll
            for (int i = 0; i < 2; ++i) { up[i] = Z4; dn[i] = Z4; lf[i] = Z4; rt[i] = Z4; own[i][0] = Z4; own[i][1] = Z4; }
            if (act) {
#pragma unroll
                for (int i = 0; i < 2; ++i) {
#pragma unroll
                    for (int j = 0; j < 2; ++j) own[i][j] = *(const v4u*)(P + (size_t)(mb + 64 * i + j) * NP + cb);
                    if (vu) up[i] = *(const v4u*)(P + (size_t)(mb - 64 + i) * NP + cb);
                    if (vd) dn[i] = *(const v4u*)(P + (size_t)(mb + 128 + i) * NP + cb);
                    if (vl) lf[i] = *(const v4u*)(P + (size_t)(mb + 64 * i - 1) * NP + cb);
                    if (vr) rt[i] = *(const v4u*)(P + (size_t)(mb + 64 * i + 2) * NP + cb); }
            } else if (p == 3 && lane >= 20 && lane < 22) {
#pragma unroll
                for (int i = 0; i < 2; ++i)
#pragma unroll
                    for (int j = 0; j < 2; ++j) own[i][j] = *(const v4u*)(P + (size_t)(mb + 64 * i + j) * NP + C_PGL + 8 * (lane - 20));
            }
            float muv[8] = {0.f, 0.f, 0.f, 0.f, 0.f, 0.f, 0.f, 0.f}; if (act) ld8(O.mu + cb, muv);
            __builtin_amdgcn_sched_barrier(0);
#pragma unroll
            for (int i = 0; i < 2; ++i)
#pragma unroll
                for (int j = 0; j < 2; ++j) { const size_t m = (size_t)(mb + 64 * i + j);
                    if (act) { const v4u nbw[4] = {j == 0 ? lf[i] : own[i][0], j == 1 ? rt[i] : own[i][1], i == 0 ? up[j] : own[0][j], i == 1 ? dn[j] : own[1][j]};
                        feat_rw(O, p, m, lane, own[i][j], nbw, muv); }
                    else if (p == 3 && lane < 32) *(v4u*)(O.A2 + m * KLORA + 8 * lane) = own[i][j]; }
        }
#pragma unroll
        for (int p = 0; p < 2; ++p) {
            const int cq = p * 512 + 8 * lane, cb = C_Q + cq;
            v4u g[4][4];
#pragma unroll
            for (int a2 = 0; a2 < 4; ++a2)
#pragma unroll
                for (int b2 = 0; b2 < 4; ++b2) { const bool ok = (a2 == 0 ? vu : (a2 == 3 ? vd : true)) && (b2 == 0 ? vl : (b2 == 3 ? vr : true));
                    g[a2][b2] = Z4; if (ok) g[a2][b2] = *(const v4u*)(P + (size_t)(mb + 64 * (a2 - 1) + (b2 - 1)) * NP + cb); }
            __builtin_amdgcn_sched_barrier(0);
            float acc[2][2][8];
#pragma unroll
            for (int i = 0; i < 2; ++i)
#pragma unroll
                for (int j = 0; j < 2; ++j)
#pragma unroll
                    for (int e = 0; e < 8; ++e) acc[i][j][e] = 0.f;
#pragma unroll
            for (int dy = 0; dy < 3; ++dy)
#pragma unroll
                for (int dx = 0; dx < 3; ++dx) { float wv[8]; ld8(O.cw + (dy * 3 + dx) * 1024 + cq, wv);
#pragma unroll
                    for (int i = 0; i < 2; ++i)
#pragma unroll
                        for (int j = 0; j < 2; ++j) { float pv[8]; unp8(g[i + dy][j + dx], pv);
#pragma unroll
                            for (int e = 0; e < 8; ++e) acc[i][j][e] += pv[e] * wv[e]; } }
#pragma unroll
            for (int i = 0; i < 2; ++i)
#pragma unroll
                for (int j = 0; j < 2; ++j) feat_gla_store(O, p, (size_t)(mb + 64 * i + j), lane, acc[i][j]);
        }
    }
    for (int m = NLAT + F.gw; m < MR; m += F.NGW) {
        int lane = F.lane; asm volatile("" : "+v"(lane));
        const int t = (m - NLAT) & (CTXL - 1); const bool vp = t > 0, vn = t < CTXL - 1;
#pragma unroll
        for (int p = 0; p < 4; ++p) {
            const int cb = p * 512 + 8 * lane; const bool act = (p < 3) || lane < 20;
            if (act) { const v4u own = *(const v4u*)(P + (size_t)m * NP + cb); v4u pv = Z4, nv = Z4;
                if (vp) pv = *(const v4u*)(P + (size_t)(m - 1) * NP + cb); if (vn) nv = *(const v4u*)(P + (size_t)(m + 1) * NP + cb);
                float muv[8]; ld8(O.mu + cb, muv); const v4u nbw[4] = {pv, nv, pv, nv};
                feat_rw(O, p, (size_t)m, lane, own, nbw, muv); }
            else if (p == 3 && lane < 32) { v4u w = Z4; if (lane < 22) w = *(const v4u*)(P + (size_t)m * NP + C_PGL + 8 * (lane - 20)); *(v4u*)(O.A2 + (size_t)m * KLORA + 8 * lane) = w; }
        }
#pragma unroll
        for (int p = 0; p < 2; ++p) {
            const int cq = p * 512 + 8 * lane, cb = C_Q + cq; float acc[8] = {0.f, 0.f, 0.f, 0.f, 0.f, 0.f, 0.f, 0.f};
#pragma unroll
            for (int dx = -1; dx <= 1; ++dx) { const bool ok = (dx < 0) ? vp : ((dx > 0) ? vn : true);
                if (ok) { float pv[8], wv[8]; unp8(*(const v4u*)(P + (size_t)(m + dx) * NP + cb), pv); ld8(O.cw + (3 + dx + 1) * 1024 + cq, wv);
#pragma unroll
                    for (int e = 0; e < 8; ++e) acc[e] += pv[e] * wv[e]; } }
            feat_gla_store(O, p, (size_t)m, lane, acc);
        }
    }
}

struct EpiLora {
    static constexpr bool PERM = true;
    unsigned char* ws; const float* const* in;
    __device__ __forceinline__ void grp_w(const f32x4 (&acc)[2][2][4][2], int row0, int c0) const {
        bf16* Wf = (bf16*)(ws + WS_LWF); bf16* Wb = (bf16*)(ws + WS_LWB);
#pragma unroll
        for (int bj = 0; bj < 2; ++bj) { const int ch = (c0 + bj * 128) >> 1; const f32x4 w0f = *(const f32x4*)(in[8] + ch), w0b = *(const f32x4*)(in[8] + 512 + ch);
#pragma unroll
            for (int ai = 0; ai < 2; ++ai)
#pragma unroll
                for (int m = 0; m < 4; ++m) { const size_t row = (size_t)(row0 + ai * 128 + m * 16);
                    const f32x4 xf = acc[ai][bj][m][0] + w0f, xb = acc[ai][bj][m][1] + w0b; f32x4 df, db;
#pragma unroll
                    for (int e = 0; e < 4; ++e) { df[e] = -0.60653066f * sigmoidf_(xf[e]); db[e] = -0.60653066f * sigmoidf_(xb[e]); }
                    { v2u o; o.x = pk2(df[0], df[1]); o.y = pk2(df[2], df[3]); *(v2u*)(Wf + row * RWW + ch) = o; o.x = pk2(db[0], db[1]); o.y = pk2(db[2], db[3]); *(v2u*)(Wb + row * RWW + ch) = o; } } }
    }
    __device__ __forceinline__ void grp_a(const f32x4 (&acc)[2][2][4][2], int row0, int c0) const {
        bf16* KMf = (bf16*)(ws + WS_KMF); bf16* KMb = (bf16*)(ws + WS_KMB); bf16* BVf = (bf16*)(ws + WS_BVF); bf16* BVb = (bf16*)(ws + WS_BVB);
        const bf16* KK = (const bf16*)(ws + WS_KKB); bf16* KSUM = (bf16*)(ws + WS_KSUM);
#pragma unroll
        for (int bj = 0; bj < 2; ++bj) { const int ch = (c0 + bj * 128 - 1024) >> 1; const f32x4 a0f = *(const f32x4*)(in[10] + ch), a0b = *(const f32x4*)(in[10] + 512 + ch), ka = *(const f32x4*)(in[14] + ch);
#pragma unroll
            for (int ai = 0; ai < 2; ++ai) {
            v2u kpw[2][4], kkw[2][4];
#pragma unroll
                for (int m = 0; m < 4; ++m) { const size_t row = (size_t)(row0 + ai * 128 + m * 16); kpw[ai][m] = *(const v2u*)(KMf + row * RWW + ch); kkw[ai][m] = *(const v2u*)(KK + row * RWW + ch); }
            __builtin_amdgcn_sched_barrier(0);
#pragma unroll
                for (int m = 0; m < 4; ++m) { const size_t row = (size_t)(row0 + ai * 128 + m * 16);
                    const f32x4 xf = acc[ai][bj][m][0] + a0f, xb = acc[ai][bj][m][1] + a0b;
                    const f32x4 kp = (f32x4){bflo(kpw[ai][m].x), bfhi(kpw[ai][m].x), bflo(kpw[ai][m].y), bfhi(kpw[ai][m].y)}, kk = (f32x4){bflo(kkw[ai][m].x), bfhi(kkw[ai][m].x), bflo(kkw[ai][m].y), bfhi(kkw[ai][m].y)};
                    f32x4 kmf, kmb, bvf, bvb;
#pragma unroll
                    for (int e = 0; e < 4; ++e) { const float af = sigmoidf_(xf[e]), ab = sigmoidf_(xb[e]);
                        kmf[e] = kp[e] * (1.0f + (af - 1.0f) * ka[e]); kmb[e] = kp[e] * (1.0f + (ab - 1.0f) * ka[e]); bvf[e] = kk[e] * af; bvb[e] = kk[e] * ab; }
                    { v2u o; o.x = pk2(kmf[0], kmf[1]); o.y = pk2(kmf[2], kmf[3]); *(v2u*)(KMf + row * RWW + ch) = o; o.x = pk2(kmb[0], kmb[1]); o.y = pk2(kmb[2], kmb[3]); *(v2u*)(KMb + row * RWW + ch) = o;
                      o.x = pk2(bvf[0], bvf[1]); o.y = pk2(bvf[2], bvf[3]); *(v2u*)(BVf + row * RWW + ch) = o; o.x = pk2(bvb[0], bvb[1]); o.y = pk2(bvb[2], bvb[3]); *(v2u*)(BVb + row * RWW + ch) = o; }
                    v2u ks; ks.x = pk2(kmf[0] + kmb[0], kmf[1] + kmb[1]); ks.y = pk2(kmf[2] + kmb[2], kmf[3] + kmb[3]); *(v2u*)(KSUM + row * RWW + ch) = ks; } } }
    }
    __device__ __forceinline__ void grp_g(const f32x4 (&acc)[2][2][4][2], int row0, int c0) const {
        bf16* RWG = (bf16*)(ws + WS_RWG);
#pragma unroll
        for (int bj = 0; bj < 2; ++bj) { const int ch = c0 + bj * 128 - 2048;
#pragma unroll
            for (int ai = 0; ai < 2; ++ai)
#pragma unroll
                for (int m = 0; m < 4; ++m) { const size_t row = (size_t)(row0 + ai * 128 + m * 16); const f32x4 v0 = acc[ai][bj][m][0], v1 = acc[ai][bj][m][1];
                    v4u w; w.x = pk2(v0[0], v0[1]); w.y = pk2(v0[2], v0[3]); w.z = pk2(v1[0], v1[1]); w.w = pk2(v1[2], v1[3]); *(v4u*)(RWG + row * RWW + ch) = w; } }
    }
    __device__ __forceinline__ void grp_l(const f32x4 (&acc)[2][2][4][2], int row0, int c0) const {
        bf16* GAf = (bf16*)(ws + WS_LAF); bf16* GAb = (bf16*)(ws + WS_LAB);
#pragma unroll
        for (int bj = 0; bj < 2; ++bj) { const int ch = (c0 + bj * 128 - 2560) >> 1; const f32x4 gbf = *(const f32x4*)(in[20] + ch), gbb = *(const f32x4*)(in[20] + 256 + ch);
#pragma unroll
            for (int ai = 0; ai < 2; ++ai)
#pragma unroll
                for (int m = 0; m < 4; ++m) { const size_t row = (size_t)(row0 + ai * 128 + m * 16);
                    const f32x4 xf = acc[ai][bj][m][0] + gbf, xb = acc[ai][bj][m][1] + gbb; f32x4 af, ab;
#pragma unroll
                    for (int e = 0; e < 4; ++e) { const float lf = logsigmoidf_(xf[e]), lb = logsigmoidf_(xb[e]);
                        af[e] = lf * 0.0625f; ab[e] = lb * 0.0625f; }
                    { v2u o; o.x = pk2(af[0], af[1]); o.y = pk2(af[2], af[3]); *(v2u*)(GAf + row * 256 + ch) = o; o.x = pk2(ab[0], ab[1]); o.y = pk2(ab[2], ab[3]); *(v2u*)(GAb + row * 256 + ch) = o; } } }
    }
    __device__ __forceinline__ void operator()(const f32x4 (&acc)[2][2][4][2], const pg8::Unit& u, int wr, int wc, int fr, int fq) const {
        const int row0 = u.pm * 256 + wr * 64 + fr, c0 = u.pn * 256 + wc * 32 + 8 * fq;
        if (u.pn < 4) grp_w(acc, row0, c0); else if (u.pn < 8) grp_a(acc, row0, c0); else if (u.pn < 10) grp_g(acc, row0, c0); else grp_l(acc, row0, c0);
    }
};
__device__ __forceinline__ void ph_lora(Frame& F) {
    pg8::Gemm g{(const bf16*)(F.ws + WS_A2), (const bf16*)(F.ws + WS_WLORA), MR, NLORA, KLORA, nullptr};
    pg8::StaticOrder S; S.init(MR, NLORA, F.G, (int)blockIdx.x);
    EpiLora E{F.ws, F.in};
    pg8::gemm_phase<EpiLora, pg8::StaticOrder, true, true, false>(F.lds, g, S, E);
}

__device__ __forceinline__ void ph_merge(Frame& F) {
    unsigned char* ws = F.ws; const int lane = F.lane;
    const bf16* ORf = (const bf16*)(ws + WS_ORWF); const bf16* ORb = (const bf16*)(ws + WS_ORWB); const bf16* OGf = (const bf16*)(ws + WS_OGLF); const bf16* OGb = (const bf16*)(ws + WS_OGLB);
    const bf16* R = (const bf16*)(ws + WS_RB); const bf16* V = (const bf16*)(ws + WS_VB); const bf16* KSUM = (const bf16*)(ws + WS_KSUM); const bf16* RWG = (const bf16*)(ws + WS_RWG);
    const bf16* P = (const bf16*)(ws + WS_P);
    bf16* YRW = (bf16*)(ws + WS_YRW); bf16* YGLA = (bf16*)(ws + WS_YGLA);
    float rk[8], gw[8], gbv[8], ggw[8], ggb[8];
    ld8(F.in[15] + 8 * lane, rk); ld8(F.in[16] + 8 * lane, gw); ld8(F.in[17] + 8 * lane, gbv); ld8(F.in[21] + 8 * lane, ggw); ld8(F.in[22] + 8 * lane, ggb);
    for (int m0 = F.gw; m0 < NLAT; m0 += 2 * F.NGW) {
        const int m1 = (m0 + F.NGW < NLAT) ? m0 + F.NGW : m0;
        v4u wa[2], wb[2], wc[2], wd[2], wr[2], wv[2], wk[2], wg[2], wo[2];
#pragma unroll
        for (int r2 = 0; r2 < 2; ++r2) { const int m = r2 ? m1 : m0; const size_t ro = (size_t)m * RWW + 8 * lane;
            wa[r2] = *(const v4u*)(ORf + ro); wb[r2] = *(const v4u*)(ORb + ro); wc[r2] = *(const v4u*)(OGf + ro); wd[r2] = *(const v4u*)(OGb + ro);
            wr[r2] = *(const v4u*)(R + ro); wv[r2] = *(const v4u*)(V + ro); wk[r2] = *(const v4u*)(KSUM + ro); wg[r2] = *(const v4u*)(RWG + ro);
            wo[r2] = *(const v4u*)(P + (size_t)m * NP + C_OG + 8 * lane); }
#pragma unroll
        for (int r2 = 0; r2 < 2; ++r2) { const int m = r2 ? m1 : m0; const size_t ro = (size_t)m * RWW + 8 * lane;
        {
            float a[8], b[8], o[8]; unp8(wa[r2], a); unp8(wb[r2], b);
            float s = 0.f;
#pragma unroll
            for (int e = 0; e < 8; ++e) { o[e] = a[e] + b[e]; s += o[e]; }
            s += __shfl_xor(s, 1); s += __shfl_xor(s, 2); s += __shfl_xor(s, 4);
            const float mean = s * (1.f / 64.f); float q = 0.f;
#pragma unroll
            for (int e = 0; e < 8; ++e) { o[e] -= mean; q += o[e] * o[e]; }
            q += __shfl_xor(q, 1); q += __shfl_xor(q, 2); q += __shfl_xor(q, 4);
            const float rstd = __builtin_amdgcn_rsqf(q * (1.f / 64.f) + RW_GN_EPS);
            float r[8], v[8], ksm[8], g[8]; unp8(wr[r2], r); unp8(wv[r2], v); unp8(wk[r2], ksm); unp8(wg[r2], g);
            float bs = 0.f;
#pragma unroll
            for (int e = 0; e < 8; ++e) bs += r[e] * ksm[e] * rk[e];
            bs += __shfl_xor(bs, 1); bs += __shfl_xor(bs, 2); bs += __shfl_xor(bs, 4);
            float y[8];
#pragma unroll
            for (int e = 0; e < 8; ++e) y[e] = (o[e] * rstd * gw[e] + gbv[e] + bs * v[e]) * g[e];
            *(v2u*)((unsigned char*)YRW + ro) = pk8f8(y);
        }
        {
            float a[8], b[8], o[8]; unp8(wc[r2], a); unp8(wd[r2], b);
            float s = 0.f;
#pragma unroll
            for (int e = 0; e < 8; ++e) { o[e] = a[e] + b[e]; s += o[e]; }
            s += __shfl_xor(s, 1); s += __shfl_xor(s, 2); s += __shfl_xor(s, 4); s += __shfl_xor(s, 8);
            const float mean = s * (1.f / 128.f); float q = 0.f;
#pragma unroll
            for (int e = 0; e < 8; ++e) { o[e] -= mean; q += o[e] * o[e]; }
            q += __shfl_xor(q, 1); q += __shfl_xor(q, 2); q += __shfl_xor(q, 4); q += __shfl_xor(q, 8);
            const float rstd = __builtin_amdgcn_rsqf(q * (1.f / 128.f) + LN_EPS);
            float og[8]; unp8(wo[r2], og);
            float y[8];
#pragma unroll
            for (int e = 0; e < 8; ++e) y[e] = (o[e] * rstd * ggw[e] + ggb[e]) * siluf_(og[e]);
            *(v2u*)((unsigned char*)YGLA + ro) = pk8f8(y);
        }
        }
    }
}

template <int WHICH> struct EpiBranch {
    static constexpr bool PERM = true;
    bf16* Z; const bf16* P; unsigned char* Z8;
    __device__ __forceinline__ void operator()(const f32x4 (&acc)[2][2][4][2], const pg8::Unit& u, int wr, int wc, int fr, int fq) const {
        const int row0 = u.pm * 256 + wr * 64 + fr, col0 = u.pn * 256 + wc * 32 + 8 * fq;
#pragma unroll
        for (int ah = 0; ah < 4; ++ah) { const int ai = ah >> 1, mb = 2 * (ah & 1);
            v4u gw[2][2], zw[2][2];
#pragma unroll
            for (int m = 0; m < 2; ++m) { const size_t row = (size_t)(row0 + ai * 128 + (mb + m) * 16);
#pragma unroll
                for (int bj = 0; bj < 2; ++bj) { const int c = col0 + bj * 128;
                    gw[m][bj] = *(const v4u*)(P + row * NP + (WHICH ? C_GGLA : C_GRW) + c);
                    if (WHICH) zw[m][bj] = *(const v4u*)(Z + row * D + c); } }
            __builtin_amdgcn_sched_barrier(0);
#pragma unroll
            for (int m = 0; m < 2; ++m) { const size_t row = (size_t)(row0 + ai * 128 + (mb + m) * 16);
#pragma unroll
                for (int bj = 0; bj < 2; ++bj) { const int c = col0 + bj * 128;
                    float g[8]; unp8(gw[m][bj], g);
                    const f32x4 v0 = acc[ai][bj][mb + m][0], v1 = acc[ai][bj][mb + m][1];
                    float z[8];
#pragma unroll
                    for (int e = 0; e < 4; ++e) { z[e] = sigmoidf_(g[e]) * (v0[e] * W8I); z[4 + e] = sigmoidf_(g[4 + e]) * (v1[e] * W8I); }
                    if (WHICH) { float zo[8]; unp8(zw[m][bj], zo);
#pragma unroll
                        for (int e = 0; e < 8; ++e) z[e] += zo[e];
                        *(v2u*)(Z8 + row * D + c) = pk8f8(z); }
                    else *(v4u*)(Z + row * D + c) = pk8(z); } }
        }
    }
};
__device__ __forceinline__ void ph_branch(Frame& F) {
    pg8::StaticOrder S; S.init(NLAT, D, F.G, (int)blockIdx.x);
    { pg8::Gemm g{(const bf16*)(F.ws + WS_YRW), (const bf16*)(F.ws + WS_WBRRW), NLAT, D, RWW / 2, nullptr};
      EpiBranch<0> E{(bf16*)(F.ws + WS_Z), (const bf16*)(F.ws + WS_P), F.ws + WS_Z8};
      pg8::gemm_phase<EpiBranch<0>, pg8::StaticOrder, true, true, false, true>(F.lds, g, S, E); }
    { pg8::Gemm g{(const bf16*)(F.ws + WS_YGLA), (const bf16*)(F.ws + WS_WBRGLA), NLAT, D, RWW / 2, nullptr};
      EpiBranch<1> E{(bf16*)(F.ws + WS_Z), (const bf16*)(F.ws + WS_P), F.ws + WS_Z8};
      pg8::gemm_phase<EpiBranch<1>, pg8::StaticOrder, true, true, false, true>(F.lds, g, S, E); }
}
struct EpiOut {
    static constexpr bool PERM = true;
    bf16* X1P; const float* x; const float* mod;
    __device__ __forceinline__ void operator()(const f32x4 (&acc)[2][2][4][2], const pg8::Unit& u, int wr, int wc, int fr, int fq) const {
        const int row0 = u.pm * 256 + wr * 64 + fr, col0 = u.pn * 256 + wc * 32 + 8 * fq; const float* g1 = mod + (u.pm / (SEQ / 256)) * 6144 + 2048;
        f32x4 gv[2][2];
#pragma unroll
        for (int bj = 0; bj < 2; ++bj)
#pragma unroll
            for (int n = 0; n < 2; ++n) gv[bj][n] = *(const f32x4*)(g1 + col0 + bj * 128 + 4 * n);
#pragma unroll
        for (int ah = 0; ah < 4; ++ah) { const int ai = ah >> 1, mb = 2 * (ah & 1);
            f32x4 xv[2][2][2];
#pragma unroll
            for (int m = 0; m < 2; ++m) { const size_t ro = (size_t)(row0 + ai * 128 + (mb + m) * 16) * D;
#pragma unroll
                for (int bj = 0; bj < 2; ++bj)
#pragma unroll
                    for (int n = 0; n < 2; ++n) xv[m][bj][n] = *(const f32x4*)(x + ro + col0 + bj * 128 + 4 * n); }
            __builtin_amdgcn_sched_barrier(0);
#pragma unroll
            for (int m = 0; m < 2; ++m) { const size_t ro = (size_t)(row0 + ai * 128 + (mb + m) * 16) * D;
#pragma unroll
                for (int bj = 0; bj < 2; ++bj) { const f32x4 a = xv[m][bj][0] * ALPHA + gv[bj][0] * (acc[ai][bj][mb + m][0] * W8I), b = xv[m][bj][1] * ALPHA + gv[bj][1] * (acc[ai][bj][mb + m][1] * W8I);
                    v4u w; w.x = pk2(a.x, a.y); w.y = pk2(a.z, a.w); w.z = pk2(b.x, b.y); w.w = pk2(b.z, b.w); *(v4u*)(X1P + ro + col0 + bj * 128) = w; } }
        }
    }
};
__device__ __forceinline__ void ph_outproj(Frame& F) {
    pg8::Gemm g{(const bf16*)(F.ws + WS_Z8), (const bf16*)(F.ws + WS_WOUT), NLAT, D, D / 2, nullptr};
    pg8::StaticOrder S; S.init(NLAT, D, F.G, (int)blockIdx.x);
    EpiOut E{(bf16*)(F.ws + WS_X1), F.in[0], (const float*)(F.ws + WS_MOD)};
    pg8::gemm_phase<EpiOut, pg8::StaticOrder, true, true, false, true>(F.lds, g, S, E);
}
#endif

#if MS >= 3
constexpr int LP = 72, SLOTB = 64 * LP * 2, LPF = 68, AUX_OFF = 13 * SLOTB;
static_assert(AUX_OFF + 4096 <= MISC_OFF, "scan LDS map");
#define SLOT(n) ((LAS bf16*)(lds + (n) * SLOTB))
__device__ __forceinline__ int scan_row(int s, int b, int dir) {
    if (s < CTXL) return NLAT + b * CTXL + (dir ? (CTXL - 1 - s) : s);
    const int lt = s - CTXL; return b * SEQ + (dir ? (SEQ - 1 - lt) : lt);
}
__device__ __forceinline__ unsigned pk2z(float x) { return pk2(x, 0.f); }
__device__ __forceinline__ float bf2f(bf16 h) { return __builtin_bit_cast(float, (unsigned)h << 16); }
__device__ __forceinline__ v2u pack4(const f32x4 v) { v2u o; o.x = pk2(v[0], v[1]); o.y = pk2(v[2], v[3]); return o; }
__device__ __forceinline__ float clamp8(float x) { return __builtin_amdgcn_fmed3f(x, -448.0f, 448.0f); }
__device__ __forceinline__ unsigned pack4_fp8(const f32x4 v) { int w = __builtin_amdgcn_cvt_pk_fp8_f32(clamp8(v[0]), clamp8(v[1]), 0, false); return (unsigned)__builtin_amdgcn_cvt_pk_fp8_f32(clamp8(v[2]), clamp8(v[3]), w, true); }
__device__ __forceinline__ f32x4 unpack4_fp8(unsigned w) { const f32x2 lo = __builtin_amdgcn_cvt_pk_f32_fp8((int)w, false), hi = __builtin_amdgcn_cvt_pk_f32_fp8((int)w, true); return (f32x4){lo.x, lo.y, hi.x, hi.y}; }
__device__ __forceinline__ f32x4 unpack4(const v2u w) { return (f32x4){bflo(w.x), bfhi(w.x), bflo(w.y), bfhi(w.y)}; }
__device__ __forceinline__ f32x4 mm_tile(const LAS bf16* X, int r0, const LAS bf16* Y, int c0, int lane) {
    const int rr = lane & 15, q = lane >> 4;
    const LAS bf16* xp = X + (r0 + rr) * LP + 8 * q; const LAS bf16* yp = Y + (c0 + rr) * LP + 8 * q;
    const bf16x8 a0 = *(const LAS bf16x8*)xp, a1 = *(const LAS bf16x8*)(xp + 32), b0 = *(const LAS bf16x8*)yp, b1 = *(const LAS bf16x8*)(yp + 32);
    f32x4 acc = (f32x4){0.f, 0.f, 0.f, 0.f};
    acc = __builtin_amdgcn_mfma_f32_16x16x32_bf16(a0, b0, acc, 0, 0, 0);
    acc = __builtin_amdgcn_mfma_f32_16x16x32_bf16(a1, b1, acc, 0, 0, 0);
    return acc;
}
__device__ __forceinline__ float red8(float x) {
    x += __builtin_bit_cast(float, __builtin_amdgcn_update_dpp(0, __builtin_bit_cast(int, x), 0x141, 0xf, 0xf, false));
    x += __builtin_bit_cast(float, __builtin_amdgcn_update_dpp(0, __builtin_bit_cast(int, x), 0xB1, 0xf, 0xf, false));
    x += __builtin_bit_cast(float, __builtin_amdgcn_update_dpp(0, __builtin_bit_cast(int, x), 0x4E, 0xf, 0xf, false));
    return x;
}

#define S1_BAR() do { asm volatile("s_waitcnt lgkmcnt(0)" ::: "memory"); __builtin_amdgcn_s_barrier(); asm volatile("" ::: "memory"); } while (0)
struct RwIn { bf16 lw[8], r[8], k[8], a[8], b[8], v[8]; };
__device__ __forceinline__ void s1_rwkv_load(Frame& F, int u, RwIn& I) {
    const int sr = u / NCHUNK, c = u - sr * NCHUNK, rb = sr >> 4, rdir = (sr >> 3) & 1, rh = sr & 7; unsigned char* ws = F.ws;
    const bf16* RBp = (const bf16*)(ws + WS_RB); const bf16* VBp = (const bf16*)(ws + WS_VB); const bf16* KKp = (const bf16*)(ws + WS_KKB);
    const bf16* KMp = (const bf16*)(ws + (rdir ? WS_KMB : WS_KMF)); const bf16* BVp = (const bf16*)(ws + (rdir ? WS_BVB : WS_BVF)); const bf16* LWp = (const bf16*)(ws + (rdir ? WS_LWB : WS_LWF));
#pragma unroll
    for (int i = 0; i < 8; ++i) { const int row = scan_row(c * CH + 8 * F.wave + i, rb, rdir); const size_t base = (size_t)row * RWW + rh * 64 + F.lane;
        I.lw[i] = LWp[base]; I.r[i] = RBp[base]; I.k[i] = KMp[base]; I.a[i] = KKp[base]; I.b[i] = BVp[base]; I.v[i] = VBp[base]; }
}
__device__ __forceinline__ void s1_rwkv(Frame& F, int u, const RwIn& I, int un, RwIn& Inext, f32x2v (&cv)[32], int& cpend, int cvi) {
    const int sr = u / NCHUNK, c = u - sr * NCHUNK;
    const bool emit = c >= CTXL / CH;
    LAS unsigned char* lds = F.lds; unsigned char* ws = F.ws;
    int lane_ = F.lane; asm volatile("" : "+v"(lane_));
    const int lane = lane_, wave = F.wave, rr = lane & 15, q = lane >> 4;
    LAS float* tot = (LAS float*)(lds + AUX_OFF); LAS float* gCs = tot + 512;
    {
        float lw[8], xr[8], xk[8], xa[8], xb[8], xv[8];
#pragma unroll
        for (int i = 0; i < 8; ++i) { lw[i] = bf2f(I.lw[i]); xr[i] = bf2f(I.r[i]); xk[i] = bf2f(I.k[i]); xa[i] = -bf2f(I.a[i]); xb[i] = bf2f(I.b[i]); xv[i] = bf2f(I.v[i]); }
        float p[8]; p[0] = lw[0];
#pragma unroll
        for (int i = 1; i < 8; ++i) p[i] = p[i - 1] + lw[i];
        tot[wave * 64 + lane] = p[7];
        S1_BAR();
        float off = 0.f, all = 0.f;
#pragma unroll
        for (int w = 0; w < 8; ++w) { const float t = tot[w * 64 + lane]; all += t; off += (w < wave) ? t : 0.f; }
        if (wave == 0) gCs[lane] = __expf(all);
        float at[8], bb[8], kb[8];
#pragma unroll
        for (int i = 0; i < 8; ++i) { const float cum = off + p[i]; const float g = __expf(cum), gi = __expf(-cum), gp = __expf(cum - lw[i]), gc = __expf(all - cum);
            const int t = 8 * wave + i;
            at[i] = xa[i] * gp; bb[i] = xb[i] * gc; kb[i] = xk[i] * gc;
            SLOT(0)[t * LP + lane] = (bf16)pk2z(at[i]);
            SLOT(1)[t * LP + lane] = (bf16)pk2z(xr[i] * g);
            SLOT(2)[t * LP + lane] = (bf16)pk2z(xb[i] * gi);
            SLOT(3)[t * LP + lane] = (bf16)pk2z(xk[i] * gi); }
        *(LAS v4u*)(SLOT(4) + lane * LP + 8 * wave) = pk8(at);
        *(LAS v4u*)(SLOT(5) + lane * LP + 8 * wave) = pk8(xv);
        *(LAS v4u*)(SLOT(6) + lane * LP + 8 * wave) = pk8(bb);
        *(LAS v4u*)(SLOT(7) + lane * LP + 8 * wave) = pk8(kb);
        S1_BAR();
    }
    if (wave < 4) s1_rwkv_load(F, un, Inext);
    LAS float* Lp = (LAS float*)(lds + 8 * SLOTB);
#pragma unroll
    for (int tix = 0; tix < 2; ++tix) { const int ti = 2 * wave + tix, r0 = 16 * (ti >> 2), c0 = 16 * (ti & 3), ci = c0 + rr;
        { const f32x4 acc = mm_tile(SLOT(2), r0, SLOT(0), c0, lane);
#pragma unroll
            for (int e = 0; e < 4; ++e) { const int i = r0 + 4 * q + e; Lp[ci * LPF + (i & 3) * 16 + (i >> 2)] = (i < ci) ? acc[e] : 0.f; } }
        { f32x4 acc = mm_tile(SLOT(0), r0, SLOT(3), c0, lane);
#pragma unroll
            for (int e = 0; e < 4; ++e) acc[e] = (ci < r0 + 4 * q + e) ? acc[e] : 0.f;
            *(LAS v2u*)(SLOT(10) + ci * LP + r0 + 4 * q) = pack4(acc); }
        if (emit) {
            { f32x4 acc = mm_tile(SLOT(2), r0, SLOT(1), c0, lane);
#pragma unroll
                for (int e = 0; e < 4; ++e) acc[e] = (r0 + 4 * q + e <= ci) ? acc[e] : 0.f;
                *(LAS v2u*)(SLOT(11) + ci * LP + r0 + 4 * q) = pack4(acc); }
            { f32x4 acc = mm_tile(SLOT(3), r0, SLOT(1), c0, lane);
#pragma unroll
                for (int e = 0; e < 4; ++e) acc[e] = (r0 + 4 * q + e <= ci) ? acc[e] : 0.f;
                *(LAS v2u*)(SLOT(12) + ci * LP + r0 + 4 * q) = pack4(acc); }
        }
    }
    S1_BAR();
    if (wave < 4) {
        const int j = 16 * wave + (lane >> 2), s = lane & 3;
        float Tr[16];
#pragma unroll
        for (int m = 0; m < 16; ++m) Tr[m] = 0.f;
        const LAS float* lrow = Lp + s * 16;
        f32x4 lb[3][4];
#pragma unroll
        for (int t = 0; t < 2; ++t) lb[t][0] = *(const LAS f32x4*)(lrow + t * LPF);
#pragma unroll
        for (int t = 0; t < 64; ++t) {
            if (t + 2 < 64) {
#pragma unroll
                for (int k = 0; k < 4; ++k) if (4 * k <= (t + 2) / 4) lb[(t + 2) % 3][k] = *(const LAS f32x4*)(lrow + (t + 2) * LPF + 4 * k);
            }
            __builtin_amdgcn_sched_barrier(0);
            float acc0 = 0.f, acc1 = 0.f;
#pragma unroll
            for (int m = 0; m < 16; ++m) if (m <= t / 4) { const float lv = lb[t % 3][m >> 2][m & 3]; if (m & 1) acc1 += lv * Tr[m]; else acc0 += lv * Tr[m]; }
            float acc = acc0 + acc1;
            acc += __builtin_bit_cast(float, __builtin_amdgcn_update_dpp(0, __builtin_bit_cast(int, acc), 0xB1, 0xf, 0xf, false));
            acc += __builtin_bit_cast(float, __builtin_amdgcn_update_dpp(0, __builtin_bit_cast(int, acc), 0x4E, 0xf, 0xf, false));
            int jj = j, ss = s; asm volatile("" : "+v"(jj), "+v"(ss));
            const float val = acc + ((t == jj) ? 1.f : 0.f);
            Tr[t >> 2] = (ss == (t & 3)) ? val : Tr[t >> 2];
            SLOT(0)[t * LP + j] = (bf16)pk2z(val);
        }
    } else { CVY_FLUSH(); s1_rwkv_load(F, un, Inext); CVY_START(cvi); }
    S1_BAR();
#pragma unroll
    for (int tix = 0; tix < 2; ++tix) { const int ti = 2 * wave + tix, r0 = 16 * (ti >> 2), c0 = 16 * (ti & 3), ci = c0 + rr;
        { const f32x4 acc = mm_tile(SLOT(0), r0, SLOT(4), c0, lane); *(LAS v2u*)(SLOT(2) + ci * LP + r0 + 4 * q) = pack4(acc); }
        { const f32x4 acc = mm_tile(SLOT(0), r0, SLOT(10), c0, lane); *(LAS v2u*)(SLOT(3) + ci * LP + r0 + 4 * q) = pack4(acc); }
    }
    S1_BAR();
    unsigned char* RH = ws + WS_RH + (size_t)u * 4096; bf16* GT = (bf16*)((unsigned char*)F.out + OUT_GT) + (size_t)u * 4096;
#pragma unroll
    for (int tix = 0; tix < 2; ++tix) { const int ti = 2 * wave + tix, tr = ti >> 2, r0 = 16 * tr, c0 = 16 * (ti & 3), ci = c0 + rr;
        const int pos = (tr >> 1) * 32 + q * 8 + 4 * (tr & 1);
        if (emit) {
            { f32x4 acc = mm_tile(SLOT(2), r0, SLOT(11), c0, lane);
                acc += unpack4(*(const LAS v2u*)(SLOT(1) + ci * LP + r0 + 4 * q));
                *(unsigned*)(RH + ci * 64 + pos) = pack4_fp8(acc); }
            { f32x4 acc = mm_tile(SLOT(3), r0, SLOT(11), c0, lane);
                acc += unpack4(*(const LAS v2u*)(SLOT(12) + ci * LP + r0 + 4 * q));
                *(LAS v2u*)(SLOT(4) + ci * LP + r0 + 4 * q) = pack4(acc); }
        }
        { f32x4 acc = mm_tile(SLOT(2), r0, SLOT(6), c0, lane);
            const float gc = gCs[ci];
#pragma unroll
            for (int e = 0; e < 4; ++e) acc[e] += (r0 + 4 * q + e == ci) ? gc : 0.f;
            *(v2u*)(GT + ci * 64 + pos) = pack4(acc); }
    }
    S1_BAR();
    unsigned char* YL = ws + WS_YL + (size_t)u * 4096;
#pragma unroll
    for (int tix = 0; tix < 2; ++tix) { const int ti = 2 * wave + tix, r0 = 16 * (ti >> 2), c0 = 16 * (ti & 3), ci = c0 + rr;
        if (emit) { const f32x4 acc = mm_tile(SLOT(5), r0, SLOT(4), c0, lane); *(unsigned*)(YL + ci * 64 + r0 + 4 * q) = pack4_fp8(acc); }
        { f32x4 acc = mm_tile(SLOT(3), r0, SLOT(6), c0, lane);
            acc += unpack4(*(const LAS v2u*)(SLOT(7) + ci * LP + r0 + 4 * q));
            *(LAS v2u*)(SLOT(8) + ci * LP + r0 + 4 * q) = pack4(acc); }
    }
    S1_BAR();
    unsigned char* HH = ws + WS_HH + (size_t)u * 4096;
#pragma unroll
    for (int tix = 0; tix < 2; ++tix) { const int ti = 2 * wave + tix, r0 = 16 * (ti >> 2), c0 = 16 * (ti & 3), ci = c0 + rr;
        const f32x4 acc = mm_tile(SLOT(8), r0, SLOT(5), c0, lane);
        *(unsigned*)(HH + ci * 64 + r0 + 4 * q) = pack4_fp8(acc); }
    S1_BAR();
}

struct GlIn { bf16 la[8], q[8], k[8], v0[8], v1[8]; };
__device__ __forceinline__ void s1_gla_load(Frame& F, int u, GlIn& I) {
    const int sg = u / NCHUNK, c = u - sg * NCHUNK, gb = sg >> 3, gdir = (sg >> 2) & 1, gh = sg & 3; unsigned char* ws = F.ws;
    const bf16* Qp = (const bf16*)(ws + WS_QGB); const bf16* Kp = (const bf16*)(ws + WS_KGB); const bf16* Vp = (const bf16*)(ws + WS_VGB); const bf16* LAp = (const bf16*)(ws + (gdir ? WS_LAB : WS_LAF));
#pragma unroll
    for (int i = 0; i < 8; ++i) { const int row = scan_row(c * CH + 8 * F.wave + i, gb, gdir); const size_t b2 = (size_t)row * 256 + gh * 64 + F.lane, b5 = (size_t)row * RWW + gh * 128 + F.lane;
        I.la[i] = LAp[b2]; I.q[i] = Qp[b2]; I.k[i] = Kp[b2]; I.v0[i] = Vp[b5]; I.v1[i] = Vp[b5 + 64]; }
}
__device__ __forceinline__ void s1_gla(Frame& F, int u, const GlIn& I, int un, GlIn& Inext, f32x2v (&cv)[32], int& cpend, int cvi) {
    const int sg = u / NCHUNK, c = u - sg * NCHUNK;
    const bool emit = c >= CTXL / CH;
    LAS unsigned char* lds = F.lds; unsigned char* ws = F.ws;
    int lane_ = F.lane; asm volatile("" : "+v"(lane_));
    const int lane = lane_, wave = F.wave, rr = lane & 15, q = lane >> 4;
    LAS float* tot = (LAS float*)(lds + AUX_OFF);
    unsigned char* QE = (unsigned char*)F.out + OUT_QE + (size_t)u * 4096;
    {
        float la[8], xq[8], xk[8], v0[8], v1[8];
#pragma unroll
        for (int i = 0; i < 8; ++i) { la[i] = bf2f(I.la[i]); xq[i] = bf2f(I.q[i]); xk[i] = bf2f(I.k[i]); v0[i] = bf2f(I.v0[i]); v1[i] = bf2f(I.v1[i]); }
        float p[8]; p[0] = la[0];
#pragma unroll
        for (int i = 1; i < 8; ++i) p[i] = p[i - 1] + la[i];
        tot[wave * 64 + lane] = p[7];
        S1_BAR();
        float off = 0.f, all = 0.f;
#pragma unroll
        for (int w = 0; w < 8; ++w) { const float t = tot[w * 64 + lane]; all += t; off += (w < wave) ? t : 0.f; }
        if (wave == 0) ((float*)(ws + WS_DD))[(size_t)u * 64 + lane] = __expf(all);
        float kl[8];
#pragma unroll
        for (int i = 0; i < 8; ++i) { const float cum = off + p[i]; const int t = 8 * wave + i;
            const float qef = xq[i] * __expf(cum);
            SLOT(0)[t * LP + lane] = (bf16)pk2z(qef);
            if (emit) QE[t * 64 + lane] = (unsigned char)__builtin_amdgcn_cvt_pk_fp8_f32(clamp8(qef), 0.f, 0, false);
            SLOT(1)[t * LP + lane] = (bf16)pk2z(xk[i] * __expf(-cum));
            kl[i] = xk[i] * __expf(all - cum); }
        *(LAS v4u*)(SLOT(2) + lane * LP + 8 * wave) = pk8(kl);
        *(LAS v4u*)(SLOT(3) + lane * LP + 8 * wave) = pk8(v0);
        *(LAS v4u*)(SLOT(3) + (64 + lane) * LP + 8 * wave) = pk8(v1);
        S1_BAR();
    }
    if (wave >= 4) { CVY_FLUSH(); s1_gla_load(F, un, Inext); CVY_START(cvi); }
    else if (emit) {
#pragma unroll
        for (int tix = 0; tix < 4; ++tix) { const int ti = 4 * wave + tix, r0 = 16 * (ti >> 2), c0 = 16 * (ti & 3), ci = c0 + rr;
            f32x4 acc = mm_tile(SLOT(1), r0, SLOT(0), c0, lane);
#pragma unroll
            for (int e = 0; e < 4; ++e) acc[e] = (r0 + 4 * q + e <= ci) ? acc[e] : 0.f;
            *(LAS v2u*)(SLOT(5) + ci * LP + r0 + 4 * q) = pack4(acc); }
    }
    unsigned char* KV = ws + WS_KV + (size_t)u * 8192;
#pragma unroll
    for (int tix = 0; tix < 4; ++tix) { const int ti = 4 * wave + tix, r0 = 16 * (ti >> 3), c0 = 16 * (ti & 7), ci = c0 + rr;
        const f32x4 acc = mm_tile(SLOT(2), r0, SLOT(3), c0, lane);
        *(unsigned*)(KV + ci * 64 + r0 + 4 * q) = pack4_fp8(acc); }
    S1_BAR();
    if (emit) {
        unsigned char* IN = ws + WS_INTRA + (size_t)u * 8192;
#pragma unroll
        for (int tix = 0; tix < 4; ++tix) { const int ti = 4 * wave + tix, r0 = 16 * (ti >> 2), c0 = 16 * (ti & 3), ci = c0 + rr;
            const f32x4 acc = mm_tile(SLOT(3), r0, SLOT(5), c0, lane);
            *(unsigned*)(IN + ci * 128 + r0 + 4 * q) = pack4_fp8(acc); }
    }
    S1_BAR();
}

__device__ __forceinline__ void ph_scan1(Frame& F) {
    f32x2v cv[32]; int cpend = -1; const int lane = F.lane;
    int item = (int)blockIdx.x * 4 + (F.wave & 3);
    { RwIn cur, nxt; if ((int)blockIdx.x < NU_RW) s1_rwkv_load(F, blockIdx.x, cur);
#pragma unroll 1
      for (int u = blockIdx.x; u < NU_RW; u += F.G, item += F.G * 4) { const int un = (u + F.G < NU_RW) ? u + F.G : u; s1_rwkv(F, u, cur, un, nxt, cv, cpend, item); cur = nxt; } }
    { GlIn cur, nxt; if ((int)blockIdx.x < NU_GL) s1_gla_load(F, blockIdx.x, cur);
#pragma unroll 1
      for (int u = blockIdx.x; u < NU_GL; u += F.G, item += F.G * 4) { const int un = (u + F.G < NU_GL) ? u + F.G : u; if (F.wave < 4) s1_gla_load(F, un, nxt); s1_gla(F, u, cur, un, nxt, cv, cpend, item); cur = nxt; } }
    if (F.wave >= 4) CVY_FLUSH();
}

__device__ __forceinline__ bf16x8 pack_frag(const f32x4 lo, const f32x4 hi) {
    v4u w; w.x = pk2(lo[0], lo[1]); w.y = pk2(lo[2], lo[3]); w.z = pk2(hi[0], hi[1]); w.w = pk2(hi[2], hi[3]); return __builtin_bit_cast(bf16x8, w);
}
constexpr int S2_D = 5, S2_R = 6, S2_RW = 8192 + 4096 + 2048 + 1024, S2_GL = 4096 + 2048 + 1024 + 1024, S2_SLOT = S2_RW + S2_GL;
static_assert(S2_R * S2_SLOT <= MISC_OFF, "S2 ring fits in LDS");
__device__ __forceinline__ void s2_piece(int k, int lane, size_t ur0, size_t ug0, int v0r, int v0g,
                                         const unsigned char* GTb, const unsigned char* RHb, const unsigned char* HHb, const unsigned char* YLb,
                                         const unsigned char* QEb, const unsigned char* KVb, const unsigned char* INb, const unsigned char* DDb,
                                         const unsigned char*& src, int& stride, int& ldo) {
    if (k < 8) { const int n = k, pu = n * 64 + lane, row = pu >> 3, c16 = (pu & 7) ^ (row & 7);
        src = GTb + ur0 * 8192 + row * 128 + c16 * 16; stride = 8192; ldo = n * 1024; }
    else if (k < 12) { const int n = k - 8, pu = n * 64 + lane, row = pu >> 2, c16 = (pu & 3) ^ (row & 3);
        src = RHb + ur0 * 4096 + row * 64 + c16 * 16; stride = 4096; ldo = 8192 + n * 1024; }
    else if (k < 14) { const int pu = lane, v = pu >> 2, c16 = (pu & 3) ^ (v & 3);
        src = HHb + ur0 * 4096 + (size_t)(v0r + v) * 64 + c16 * 16; stride = 4096; ldo = 12288; }
    else if (k < 15) { const int t = lane;
        src = YLb + ur0 * 4096 + t * 64 + v0r; stride = 4096; ldo = 14336; }
    else if (k < 19) { const int n = k - 15, pu = n * 64 + lane, row = pu >> 2, c16 = (pu & 3) ^ (row & 3);
        src = QEb + ug0 * 4096 + row * 64 + c16 * 16; stride = 4096; ldo = S2_RW + n * 1024; }
    else if (k < 21) { const int pu = lane, v = pu >> 2, c16 = (pu & 3) ^ (v & 3);
        src = KVb + ug0 * 8192 + (size_t)(v0g + v) * 64 + c16 * 16; stride = 8192; ldo = S2_RW + 4096; }
    else if (k < 22) { const int t = lane;
        src = INb + ug0 * 8192 + t * 128 + v0g; stride = 8192; ldo = S2_RW + 6144; }
    else { src = DDb + ug0 * 256 + (lane & 15) * 16; stride = 256; ldo = S2_RW + 7168; }
}
__device__ __forceinline__ void ph_scan2(Frame& F) {
    const int lane = F.lane, wave = F.wave, rr = lane & 15, q = lane >> 4; unsigned char* ws = F.ws; LAS unsigned char* lds = F.lds;
    const int it = (F.G == 256) ? (int)(blockIdx.x & 7) * 32 + (int)(blockIdx.x >> 3) : (int)blockIdx.x;
    const int sr = it >> 2, v0r = 16 * (it & 3), rb = sr >> 4, rdir = (sr >> 3) & 1, rh = sr & 7;
    const int sg = it >> 3, v0g = 16 * (it & 7), gb = sg >> 3, gdir = (sg >> 2) & 1, gh = sg & 3;
#define S2_BAR() do { asm volatile("s_waitcnt lgkmcnt(0)" ::: "memory"); __builtin_amdgcn_s_barrier(); asm volatile("" ::: "memory"); } while (0)
#define S2_NEXT_SLOT() do { slot = (slot + 1 == S2_R) ? 0 : slot + 1; } while (0)
    LAS unsigned char* sfr = lds + S2_SF_OFF + lane * 16;
    LAS unsigned char* sfg = sfr + 4096;
    if (wave >= 6) {
        const unsigned char* GTb = (const unsigned char*)F.out + OUT_GT; const unsigned char* QEb = (const unsigned char*)F.out + OUT_QE;
        const unsigned char* RHb = ws + WS_RH; const unsigned char* YLb = ws + WS_YL; const unsigned char* HHb = ws + WS_HH; const unsigned char* KVb = ws + WS_KV; const unsigned char* INb = ws + WS_INTRA;
        const unsigned char* DDb = ws + WS_DD;
        const unsigned char* pj[12]; int sj[12], lj[12];
#pragma unroll
        for (int j = 0; j < 12; ++j) { int k = (wave - 6) * 12 + j; if (k >= 23) k = 22;
            s2_piece(k, lane, (size_t)sr * NCHUNK, (size_t)sg * NCHUNK, v0r, v0g, GTb, RHb, HHb, YLb, QEb, KVb, INb, DDb, pj[j], sj[j], lj[j]);
            sj[j] = __builtin_amdgcn_readfirstlane(sj[j]); lj[j] = __builtin_amdgcn_readfirstlane(lj[j]); }
#define S2_ISSUE(cc, sl_) do { const int _c = (cc) < NCHUNK ? (cc) : NCHUNK - 1; _Pragma("unroll") for (int j = 0; j < 12; ++j) \
            __builtin_amdgcn_global_load_lds((const unsigned*)(pj[j] + (size_t)_c * sj[j]), (LAS unsigned*)(lds + (sl_) * S2_SLOT + lj[j]), 16, 0, 0); } while (0)
        S2_ISSUE(0, 0); S2_ISSUE(1, 1); S2_ISSUE(2, 2); S2_ISSUE(3, 3); S2_ISSUE(4, 4);
        int slot = S2_D % S2_R;
#pragma unroll 1
        for (int c = 0; c < NCHUNK; ++c) {
            asm volatile("s_waitcnt vmcnt(48) ; S2WAIT" ::: "memory");
            S2_BAR();
            S2_ISSUE(c + S2_D, slot);
            S2_NEXT_SLOT();
        }
#undef S2_ISSUE
    } else if (wave == 0) {
        f32x4 S[4];
#pragma unroll
        for (int m = 0; m < 4; ++m) S[m] = (f32x4){0.f, 0.f, 0.f, 0.f};
        bf16x8 Sf0 = pack_frag(S[0], S[1]), Sf1 = pack_frag(S[2], S[3]);
        *(LAS bf16x8*)(sfr) = Sf0; *(LAS bf16x8*)(sfr + 1024) = Sf1;
        int slot = 0;
#pragma unroll 1
        for (int c = 0; c < NCHUNK; ++c) {
            S2_BAR();
            const LAS unsigned char* sl = lds + slot * S2_SLOT;
            bf16x8 G0[4], G1[4]; unsigned Hw[4];
#pragma unroll
            for (int m = 0; m < 4; ++m) { const int k2 = 16 * m + rr;
                G0[m] = *(const LAS bf16x8*)(sl + (k2 * 8 + (q ^ (k2 & 7))) * 16); G1[m] = *(const LAS bf16x8*)(sl + (k2 * 8 + ((4 + q) ^ (k2 & 7))) * 16);
                Hw[m] = *(const LAS unsigned*)(sl + 12288 + (rr * 4 + (m ^ (rr & 3))) * 16 + 4 * q); }
#pragma unroll
            for (int m = 0; m < 4; ++m) { f32x4 acc = unpack4_fp8(Hw[m]);
                acc = __builtin_amdgcn_mfma_f32_16x16x32_bf16(G0[m], Sf0, acc, 0, 0, 0);
                acc = __builtin_amdgcn_mfma_f32_16x16x32_bf16(G1[m], Sf1, acc, 0, 0, 0);
                S[m] = acc; }
            Sf0 = pack_frag(S[0], S[1]); Sf1 = pack_frag(S[2], S[3]);
            LAS unsigned char* o = sfr + ((c + 1) & 1) * 2048;
            *(LAS bf16x8*)(o) = Sf0; *(LAS bf16x8*)(o + 1024) = Sf1;
            S2_NEXT_SLOT();
        }
    } else if (wave == 1) {
        f32x4 S[4];
#pragma unroll
        for (int m = 0; m < 4; ++m) S[m] = (f32x4){0.f, 0.f, 0.f, 0.f};
        { const bf16x8 Sf0 = pack_frag(S[0], S[1]); *(LAS bf16x8*)(sfg) = Sf0; *(LAS bf16x8*)(sfg + 1024) = Sf0; }
        int slot = 0;
#pragma unroll 1
        for (int c = 0; c < NCHUNK; ++c) {
            S2_BAR();
            const LAS unsigned char* sl = lds + slot * S2_SLOT + S2_RW;
            v2u kw[2]; f32x4 d0[2], d1[2];
#pragma unroll
            for (int s2 = 0; s2 < 2; ++s2) { kw[s2] = *(const LAS v2u*)(sl + 4096 + (rr * 4 + ((2 * s2 + (q >> 1)) ^ (rr & 3))) * 16 + (q & 1) * 8);
                d0[s2] = *(const LAS f32x4*)(sl + 7168 + 128 * s2 + 32 * q); d1[s2] = *(const LAS f32x4*)(sl + 7168 + 128 * s2 + 32 * q + 16); }
#pragma unroll
            for (int s2 = 0; s2 < 2; ++s2) { S[2 * s2] = S[2 * s2] * d0[s2] + unpack4_fp8(kw[s2].x); S[2 * s2 + 1] = S[2 * s2 + 1] * d1[s2] + unpack4_fp8(kw[s2].y); }
            LAS unsigned char* o = sfg + ((c + 1) & 1) * 2048;
            *(LAS bf16x8*)(o) = pack_frag(S[0], S[1]); *(LAS bf16x8*)(o + 1024) = pack_frag(S[2], S[3]);
            S2_NEXT_SLOT();
        }
    } else if (wave < 4) {
        bf16* ORW = (bf16*)(ws + (rdir ? WS_ORWB : WS_ORWF));
        const int tt0 = 2 * (wave - 2);
        int slot = 0;
#pragma unroll 1
        for (int c = 0; c < NCHUNK; ++c) {
            S2_BAR();
            if (c >= CTXL / CH) {
                const LAS unsigned char* sl = lds + slot * S2_SLOT; const LAS unsigned char* sf = sfr + (c & 1) * 2048;
                const bf16x8 Sf0 = *(const LAS bf16x8*)(sf), Sf1 = *(const LAS bf16x8*)(sf + 1024);
                v2u Rw0[2], Rw1[2]; unsigned Yw[2];
#pragma unroll
                for (int i = 0; i < 2; ++i) { const int t = 16 * (tt0 + i) + rr;
                    Rw0[i] = *(const LAS v2u*)(sl + 8192 + (t * 4 + ((q >> 1) ^ (t & 3))) * 16 + (q & 1) * 8); Rw1[i] = *(const LAS v2u*)(sl + 8192 + (t * 4 + ((2 + (q >> 1)) ^ (t & 3))) * 16 + (q & 1) * 8);
                    Yw[i] = *(const LAS unsigned*)(sl + 14336 + t * 16 + q * 4); }
#pragma unroll
                for (int i = 0; i < 2; ++i) { const int t = 16 * (tt0 + i) + rr;
                    const bf16x8 R0 = pack_frag(unpack4_fp8(Rw0[i].x), unpack4_fp8(Rw0[i].y)), R1 = pack_frag(unpack4_fp8(Rw1[i].x), unpack4_fp8(Rw1[i].y));
                    f32x4 acc = unpack4_fp8(Yw[i]);
                    acc = __builtin_amdgcn_mfma_f32_16x16x32_bf16(Sf0, R0, acc, 0, 0, 0);
                    acc = __builtin_amdgcn_mfma_f32_16x16x32_bf16(Sf1, R1, acc, 0, 0, 0);
                    const int row = scan_row(c * CH + t, rb, rdir);
                    *(v2u*)(ORW + (size_t)row * RWW + rh * 64 + v0r + 4 * q) = pack4(acc); }
            }
            S2_NEXT_SLOT();
        }
    } else {
        bf16* OGL = (bf16*)(ws + (gdir ? WS_OGLB : WS_OGLF));
        const int tt0 = 2 * (wave - 4);
        int slot = 0;
#pragma unroll 1
        for (int c = 0; c < NCHUNK; ++c) {
            S2_BAR();
            if (c >= CTXL / CH) {
                const LAS unsigned char* sl = lds + slot * S2_SLOT + S2_RW; const LAS unsigned char* sf = sfg + (c & 1) * 2048;
                const bf16x8 Sf0 = *(const LAS bf16x8*)(sf), Sf1 = *(const LAS bf16x8*)(sf + 1024);
                v2u Qw0[2], Qw1[2]; unsigned Iw[2];
#pragma unroll
                for (int i = 0; i < 2; ++i) { const int t = 16 * (tt0 + i) + rr;
                    Qw0[i] = *(const LAS v2u*)(sl + (t * 4 + ((q >> 1) ^ (t & 3))) * 16 + (q & 1) * 8); Qw1[i] = *(const LAS v2u*)(sl + (t * 4 + ((2 + (q >> 1)) ^ (t & 3))) * 16 + (q & 1) * 8);
                    Iw[i] = *(const LAS unsigned*)(sl + 6144 + t * 16 + q * 4); }
#pragma unroll
                for (int i = 0; i < 2; ++i) { const int t = 16 * (tt0 + i) + rr;
                    const bf16x8 Q0 = pack_frag(unpack4_fp8(Qw0[i].x), unpack4_fp8(Qw0[i].y)), Q1 = pack_frag(unpack4_fp8(Qw1[i].x), unpack4_fp8(Qw1[i].y));
                    f32x4 acc = unpack4_fp8(Iw[i]);
                    acc = __builtin_amdgcn_mfma_f32_16x16x32_bf16(Sf0, Q0, acc, 0, 0, 0);
                    acc = __builtin_amdgcn_mfma_f32_16x16x32_bf16(Sf1, Q1, acc, 0, 0, 0);
                    const int row = scan_row(c * CH + t, gb, gdir);
                    *(v2u*)(OGL + (size_t)row * RWW + gh * 128 + v0g + 4 * q) = pack4(acc); }
            }
            S2_NEXT_SLOT();
        }
    }
#undef S2_BAR
#undef S2_NEXT_SLOT
}
#endif

#ifndef ML
#define ML 0
#endif
enum Phase { PH_PROLOGUE = 0, PH_A1, PH_INPROJ, PH_FEAT, PH_LORA, PH_SCAN1, PH_SCAN2, PH_MERGE, PH_BRANCH, PH_OUTPROJ, PH_LN1, PH_ROUTER, PH_ROUTE, PH_SCATTER, PH_EXP1, PH_EXP2, PH_FINAL, PH_COUNT };

__global__ void __launch_bounds__(NTHR, 2) mega(Args args) {
    extern __shared__ __attribute__((aligned(16))) unsigned char lds_raw[];
    Frame F;
    F.lds = (LAS unsigned char*)lds_raw;
    F.tid = threadIdx.x; F.lane = F.tid & 63; F.wave = __builtin_amdgcn_readfirstlane(F.tid >> 6);
    F.G = gridDim.x; F.gw = blockIdx.x * NWAVES + F.wave; F.NGW = F.G * NWAVES;
    F.in = args.in; F.out = args.out; F.ws = args.ws; F.ctl = (unsigned*)(args.ws + WS_CTL);
    volatile LAS unsigned* MISC = (volatile LAS unsigned*)(F.lds + MISC_OFF);
    if (F.tid < 64) MISC[F.tid] = 0u;
    __syncthreads();
    XcdBarrier bar; bar.bar = F.ctl + CW_BAR; bar.x = 0; bar.st = nullptr;
#if !ML
    bar = xcd_barrier_post(F.ctl + CW_BAR, MISC + 8);
#endif
    const int lo = args.ph_lo, hi = args.ph_hi;
#define IN(k) (lo <= (k) && (k) < hi)
#ifndef DUP
#define DUP -1
#endif
#define RUN(k, call) do { if (IN(k)) { call; GRID_BAR(); if (DUP == (k)) { call; GRID_BAR(); } } } while (0)
#if ML
#define GRID_BAR() do { } while (0)
#else
#define GRID_BAR() xcd_barrier(bar)
#endif

#if MS >= 2
    RUN(PH_PROLOGUE, ph_prologue(F));
#endif
#if MS >= 3
    RUN(PH_A1, ph_a1(F));
    RUN(PH_INPROJ, ph_inproj(F));
    RUN(PH_FEAT, ph_feat(F));
    RUN(PH_LORA, ph_lora(F));
    RUN(PH_SCAN1, ph_scan1(F));
    RUN(PH_SCAN2, ph_scan2(F));
    RUN(PH_MERGE, ph_merge(F));
    RUN(PH_BRANCH, ph_branch(F));
    RUN(PH_OUTPROJ, ph_outproj(F));
#else
    RUN(PH_OUTPROJ, ph_x1pre_nomix(F));
#endif
    RUN(PH_LN1, ph_ln1(F));
#if MS >= 2
    RUN(PH_ROUTER, ph_router(F));
    RUN(PH_ROUTE, ph_route(F));
    RUN(PH_SCATTER, ph_scatter(F));
    RUN(PH_EXP1, ph_exp1(F));
    RUN(PH_EXP2, ph_exp2(F));
#endif
    if (IN(PH_FINAL)) { ph_final(F); }
#undef IN
}

extern "C" void kernel_launch(void* const* d_in, const int* in_sizes, int n_in, void* d_out, int out_size, void* d_ws, size_t ws_size, hipStream_t stream) {
    static int grid = 0;
    if (grid == 0) {
        if (n_in != 36 || out_size != NLAT * D || ws_size < WS_END) { fprintf(stderr, "kernel_launch: unexpected problem shape (n_in %d, out %d)\n", n_in, out_size); grid = -1; return; }
        int dev = 0, cus = 0, per_cu = 0;
        if (hipGetDevice(&dev) != hipSuccess || hipDeviceGetAttribute(&cus, hipDeviceAttributeMultiprocessorCount, dev) != hipSuccess) { grid = -1; return; }
        if (hipFuncSetAttribute((const void*)mega, hipFuncAttributeMaxDynamicSharedMemorySize, LDS_BYTES) != hipSuccess) { fprintf(stderr, "kernel_launch: hipFuncSetAttribute failed\n"); grid = -1; return; }
        if (hipOccupancyMaxActiveBlocksPerMultiprocessor(&per_cu, (const void*)mega, NTHR, LDS_BYTES) != hipSuccess || per_cu < 1) { fprintf(stderr, "kernel_launch: occupancy query says %d\n", per_cu); }
        (void)hipGetLastError();
        grid = cus > 0 ? cus : 256;
        if (grid > 256) grid = 256;
    }
    if (grid < 0) return;
    (void)hipMemsetAsync((char*)d_ws + WS_CTL, 0, CTL_ZERO_BYTES, stream);
    Args a{};
    for (int i = 0; i < 36; ++i) a.in[i] = (const float*)d_in[i];
    a.out = (float*)d_out; a.ws = (unsigned char*)d_ws;
#if ML
    for (int p = 0; p < PH_COUNT; ++p) { a.ph_lo = p; a.ph_hi = p + 1; hipLaunchKernelGGL(mega, dim3(grid), dim3(NTHR), LDS_BYTES, stream, a); }
#else
    a.ph_lo = 0; a.ph_hi = PH_COUNT;
    hipLaunchKernelGGL(mega, dim3(grid), dim3(NTHR), LDS_BYTES, stream, a);
#endif
}
```

```cpp
#include <hip/hip_runtime.h>
#include <cstdio>
#include <cstdint>

#ifndef MS
#define MS 3
#endif

#define GAS __attribute__((address_space(1)))
#define LAS __attribute__((address_space(3)))
typedef unsigned short bf16;
typedef unsigned v4u __attribute__((ext_vector_type(4)));
typedef unsigned v2u __attribute__((ext_vector_type(2)));
typedef float f32x4 __attribute__((ext_vector_type(4)));
typedef float f32x2 __attribute__((ext_vector_type(2)));
typedef short bf16x8 __attribute__((ext_vector_type(8)));
#define LDS_WAIT() asm volatile("s_waitcnt lgkmcnt(0)" ::: "memory")
#define VM_WAIT() asm volatile("s_waitcnt vmcnt(0)" ::: "memory")

constexpr int D = 1024, NB = 4, SEQ = 8192, CTXL = 256, GRIDW = 64, GRIDH = 128;
constexpr int NLAT = NB * SEQ, NCTX = NB * CTXL, MR = NLAT + NCTX;
constexpr int RWW = 512, RWH = 8, HD = 64;
constexpr int C_R = 0, C_K = 512, C_V = 1024, C_PW = 1536, C_PA = 1568, C_PG = 1600, C_Q = 1696, C_KG = 1952, C_VG = 2208, C_PGL = 2720, C_OG = 2736, C_GRW = 3248, C_GGLA = 4272;
constexpr int IN_COLS = 5296, NP = 5376;
constexpr int NE = 256, TOPK = 8, FF = 256;
constexpr float LN_EPS = 1e-5f, RW_GN_EPS = 64e-5f;
constexpr float ALPHA = 1.189207115f;
constexpr float W8S = 64.0f, W8I = 1.0f / 64.0f;
constexpr int NLORA = 3072, KLORA = 256;
constexpr int MAXTILES = 1280, SH_ROW0 = MAXTILES * 256, NROWS_E = SH_ROW0 + NLAT;

namespace pg8 {
#define PG8_LAS __attribute__((address_space(3)))
typedef unsigned short bf16_t;
typedef unsigned u32x4 __attribute__((ext_vector_type(4)));
typedef unsigned u32x2 __attribute__((ext_vector_type(2)));
typedef long i64x2 __attribute__((ext_vector_type(2)));
typedef int i32x4v __attribute__((ext_vector_type(4))); typedef int i32x8v __attribute__((ext_vector_type(8)));
constexpr int BM = 256, BK = 64, HALF = 128, HTB = HALF * BK * 2, STAGE_BYTES = 8 * HTB, NXCD = 8, WGM = 8;
constexpr int IDX_OFF = STAGE_BYTES, IDX_UNITS = 12;

__host__ __device__ __forceinline__ int lds_byte(int r, int c) { const int st = (r >> 4) * 2 + (c >> 5), rr = r & 15, cc = c & 31, ob = rr * 64 + cc * 2; return st * 1024 + (ob ^ (((ob >> 9) & 1) << 5)); }
__host__ __device__ __forceinline__ void stage_rc(int b, int& R, int& C) { const int st = b / 1024, sb = b % 1024, swz = sb ^ (((sb >> 9) & 1) << 5); R = (st >> 1) * 16 + swz / 64; C = (st & 1) * 32 + (swz % 64) / 2; }
__host__ __device__ __forceinline__ int perm32(int rho) { const int n = rho >> 4, i = rho & 15; return 8 * (i >> 2) + 4 * n + (i & 3); }

struct Unit { int pm, pn, e, j; };
struct Gemm { const bf16_t* A; const bf16_t* Bt; int M, N, K; const int* rowidx; const bf16_t* A2 = nullptr; const bf16_t* Bt2 = nullptr; };

struct StaticOrder {
    int nM, nN, nwg, G, c;
    __host__ __device__ void init(int M, int N, int G_, int c_) { nM = M / BM; nN = N / BM; nwg = nM * nN; G = G_; c = c_; }
    __host__ __device__ bool next(int i, Unit& u) const {
        const long L = (long)i * G + c; if (L >= nwg) return false;
        int wgid = (int)L; { const int q = nwg / NXCD, r = nwg % NXCD, xcd = wgid % NXCD, off = wgid / NXCD; wgid = (xcd < r ? xcd * (q + 1) : r * (q + 1) + (xcd - r) * q) + off; }
        const int nig = WGM * nN, gid = wgid / nig, fm = gid * WGM, gsz = (nM - fm) < WGM ? (nM - fm) : WGM;
        u.pm = fm + ((wgid % nig) % gsz); u.pn = (wgid % nig) / gsz; u.e = 0; u.j = u.pn; return true;
    }
};
struct MoeOrder {
    int nN, G, c, NT; const int* tile_e; int nsh;
    __device__ bool next(int i, Unit& u) const {
        int tile, j;
        if (G == 256) { const int x = c & 7, y = c >> 3; tile = i * (256 / nN) + x * (32 / nN) + y / nN; j = y % nN; if (tile >= NT + nsh) return false; }
        else { const int L = i * G + c; if (L >= (NT + nsh) * nN) return false; tile = L / nN; j = L - tile * nN; }
        int e, pm, te;
        if (tile < NT) { te = tile_e[tile]; e = te & 0xffff; pm = tile; } else { e = NE; te = NE | (256 << 16); pm = MAXTILES + (tile - NT); }
        u.pm = pm; u.pn = e * nN + j; u.e = te; u.j = j; return true;
    }
};

struct SharedOrder { int c, n;
    __device__ bool next(int i, Unit& u) const { const int L = i * n + c; if (c < 0 || L >= 2 * (NLAT / 256)) return false; const int j = L / (NLAT / 256), s = L - j * (NLAT / 256);
        u.pm = MAXTILES + s; u.pn = NE * 2 + j; u.e = NE | (256 << 16); u.j = j; return true; } };

typedef __bf16 bf16x2n __attribute__((ext_vector_type(2))); typedef float f32x2n __attribute__((ext_vector_type(2)));
__device__ __forceinline__ unsigned cvt_pk_bf16(float lo, float hi) { const f32x2n v = {lo, hi}; return __builtin_bit_cast(unsigned, __builtin_convertvector(v, bf16x2n)); }

struct PairOrder { StaticOrder S;
    __device__ bool next(int i, Unit& u) const { if (!S.next(i >> 1, u)) return false; u.e = i & 1; return true; } };
template <class T, class = void> struct EpiPair { static constexpr bool v = false; };
template <class T> struct EpiPair<T, decltype((void)T::PAIR)> { static constexpr bool v = T::PAIR; };
template <class Epi, class Sched, bool ALIGN_EPI, bool SP2, bool GATHER, bool FP8 = false>
__device__ __forceinline__ void gemm_phase(PG8_LAS unsigned char* lds, const Gemm g, const Sched& S, const Epi& E) {
    const int tid = threadIdx.x, wid = __builtin_amdgcn_readfirstlane(tid >> 6), lane = tid & 63, wr = wid >> 2, wc = wid & 3, fr = lane & 15, fq = lane >> 4;
    const int K = g.K, nt = K / BK;
    const size_t kstep = (size_t)(BK * 2);
    const size_t hstep = (size_t)HALF * K * 2;
    const size_t tstep = 2 * hstep;
    unsigned voffB[2]; unsigned va[2][2];
#pragma unroll
    for (int i = 0; i < 2; ++i) { int R, C; stage_rc(tid * 16 + i * 8192, R, C); const int Rb = Epi::PERM ? ((R & ~31) + perm32(R & 31)) : R;
        voffB[i] = (unsigned)(Rb * K + C) * 2u;
        va[0][i] = (unsigned)(R * K + C) * 2u; va[1][i] = va[0][i]; }
    const size_t ah = GATHER ? (size_t)0 : hstep;
#define PG8_GOFF(dst, ub) do { _Pragma("unroll") for (int _h = 0; _h < 2; ++_h) _Pragma("unroll") for (int _i = 0; _i < 2; ++_i) { int _R, _C; stage_rc(tid * 16 + _i * 8192, _R, _C); \
        dst[_h][_i] = (unsigned)(idxt[(ub) * 256 + _h * 128 + _R] * K + _C) * 2u; } } while (0)
    const unsigned ldsw = (unsigned)wid * 1024u;
    const int aoff = lds_byte(wr * 64 + fr, fq * 8), boff = lds_byte(wc * 32 + fr, fq * 8);
    PG8_LAS int* idxt = (PG8_LAS int*)(lds + IDX_OFF);
#define PG8_SA(b, h) (((b) * 2 + (h)) * HTB)
#define PG8_SB(b, h) ((4 + (b) * 2 + (h)) * HTB)
#define PG8_STAGE(bufoff, gbase, voff) do { _Pragma("unroll") for (int _i = 0; _i < 2; ++_i) \
        __builtin_amdgcn_global_load_lds((const unsigned*)((const char*)(gbase) + (voff)[_i]), (PG8_LAS unsigned*)(lds + (bufoff) + ldsw + _i * 8192), 16, 0, 0); } while (0)
#define PG8_LD32(dst, addr) do { const i32x4v _lo = *(const PG8_LAS i32x4v*)(addr), _hi = *(const PG8_LAS i32x4v*)((addr) + 1024); dst = __builtin_shufflevector(_lo, _hi, 0, 1, 2, 3, 4, 5, 6, 7); } while (0)
#define PG8_LDA(dst, b, h) do { _Pragma("unroll") for (int m = 0; m < 4; ++m) PG8_LD32(dst[m], lds + PG8_SA(b, h) + aoff + m * 2048); } while (0)
#define PG8_LDB(dst, b, h) do { _Pragma("unroll") for (int n = 0; n < 2; ++n) PG8_LD32(dst[n], lds + PG8_SB(b, h) + boff + n * 2048); } while (0)
#define PG8_HALF(v, k) __builtin_bit_cast(bf16x8, (k) ? __builtin_shufflevector(v, v, 4, 5, 6, 7) : __builtin_shufflevector(v, v, 0, 1, 2, 3))
#define PG8_MMA(ai, bj, At, Bt) do { __builtin_amdgcn_s_setprio(1); _Pragma("unroll") for (int m = 0; m < 4; ++m) _Pragma("unroll") for (int n = 0; n < 2; ++n) { \
        if constexpr (FP8) asm volatile("v_mfma_f32_16x16x128_f8f6f4 %0, %1, %2, %0" : "+v"(acc[ai][bj][m][n]) : "v"(Bt[n]), "v"(At[m])); \
        else { _Pragma("unroll") for (int k = 0; k < 2; ++k) acc[ai][bj][m][n] = __builtin_amdgcn_mfma_f32_16x16x32_bf16(PG8_HALF(Bt[n], k), PG8_HALF(At[m], k), acc[ai][bj][m][n], 0, 0, 0); } } __builtin_amdgcn_s_setprio(0); } while (0)
#define PG8_WAIT_V(n) asm volatile("s_waitcnt vmcnt(" #n ")" ::: "memory")
#define PG8_WAIT_L(n) asm volatile("s_waitcnt lgkmcnt(" #n ")" ::: "memory")
#define PG8_BAR __builtin_amdgcn_s_barrier()
#define PG8_SCHED __builtin_amdgcn_sched_barrier(0)
    Unit cur, nxt; int ui = 0;
    if (!S.next(0, cur)) return;
#ifdef GEMM_STAGGER
    if constexpr (FP8) {
        const unsigned long long t0 = __builtin_amdgcn_s_memrealtime(); const unsigned long long dl = (unsigned long long)(blockIdx.x & 3) * GEMM_STAGGER;
        while (__builtin_amdgcn_s_memrealtime() - t0 < dl) __builtin_amdgcn_s_sleep(8);
    }
#endif
    if constexpr (GATHER) {
        Unit uu;
        for (int i = 0; i < IDX_UNITS; ++i) { if (!S.next(i, uu)) break; if (tid < 256) idxt[i * 256 + tid] = g.rowidx[(size_t)uu.pm * 256 + tid]; }
        asm volatile("s_waitcnt vmcnt(0) lgkmcnt(0)" ::: "memory"); PG8_BAR; asm volatile("" ::: "memory");
        PG8_GOFF(va, 0);
    }
    f32x4 acc[2][2][4][2];
#pragma unroll
    for (int a = 0; a < 2; ++a)
#pragma unroll
        for (int b = 0; b < 2; ++b)
#pragma unroll
            for (int m = 0; m < 4; ++m)
#pragma unroll
                for (int n = 0; n < 2; ++n) acc[a][b][m][n] = (f32x4){0.f, 0.f, 0.f, 0.f};
    i32x8v At[4], B0[2], B1[2];
    constexpr bool PAIR = EpiPair<Epi>::v;
    v2u zp[16];
    const char* cA = (const char*)((PAIR && cur.e) ? g.A2 : g.A) + (GATHER ? (size_t)0 : (size_t)cur.pm * tstep); const char* cB = (const char*)((PAIR && cur.e) ? g.Bt2 : g.Bt) + (size_t)cur.pn * tstep;
    if constexpr (SP2) {
        PG8_STAGE(PG8_SB(0, 0), cB, voffB); PG8_STAGE(PG8_SB(0, 1), cB + hstep, voffB); PG8_STAGE(PG8_SA(0, 0), cA, va[0]); PG8_STAGE(PG8_SA(0, 1), cA + ah, va[1]);
        if (wr == 1) PG8_BAR;
        PG8_WAIT_V(2); PG8_BAR;
        PG8_STAGE(PG8_SB(1, 0), cB + kstep, voffB); PG8_STAGE(PG8_SA(1, 0), cA + kstep, va[0]); PG8_STAGE(PG8_SB(1, 1), cB + hstep + kstep, voffB);
        PG8_WAIT_V(6); PG8_BAR;
    } else {
        PG8_STAGE(PG8_SB(0, 0), cB, voffB); PG8_STAGE(PG8_SA(0, 0), cA, va[0]); PG8_STAGE(PG8_SB(0, 1), cB + hstep, voffB); PG8_STAGE(PG8_SA(0, 1), cA + ah, va[1]);
        if (wr == 1) PG8_BAR;
        PG8_WAIT_V(4); PG8_BAR;
        PG8_STAGE(PG8_SB(1, 0), cB + kstep, voffB); PG8_STAGE(PG8_SA(1, 0), cA + kstep, va[0]); PG8_STAGE(PG8_SB(1, 1), cB + hstep + kstep, voffB);
        PG8_WAIT_V(6); PG8_BAR;
    }
    for (;;) {
        const bool has_next = S.next(ui + 1, nxt);
        const char* nA = has_next ? (const char*)((PAIR && nxt.e) ? g.A2 : g.A) + (GATHER ? (size_t)0 : (size_t)nxt.pm * tstep) : cA; const char* nB = has_next ? (const char*)((PAIR && nxt.e) ? g.Bt2 : g.Bt) + (size_t)nxt.pn * tstep : cB;
        const int ubn = (has_next && ui + 1 < IDX_UNITS) ? (ui + 1) : ui;
#pragma unroll 1
        for (int t = 0; t < nt; t += 2) {
            const bool last = (t == nt - 2);
            const char* a1 = cA + (size_t)(t + 1) * kstep;
            const char* a2 = last ? nA : cA + (size_t)(t + 2) * kstep; const char* b2 = last ? nB : cB + (size_t)(t + 2) * kstep;
            const char* a3 = a2 + kstep; const char* b3 = b2 + kstep;
            unsigned v2[2][2];
#pragma unroll
            for (int h = 0; h < 2; ++h)
#pragma unroll
                for (int i = 0; i < 2; ++i) v2[h][i] = va[h][i];
            if constexpr (GATHER) { if (last) PG8_GOFF(v2, ubn); }
            if constexpr (SP2) {
            PG8_LDB(B0, 0, 0); PG8_LDB(B1, 0, 1); PG8_SCHED; PG8_LDA(At, 0, 0); PG8_STAGE(PG8_SA(1, 1), a1 + ah, va[1]);
            PG8_WAIT_V(8); PG8_WAIT_L(0); PG8_BAR; PG8_MMA(0, 0, At, B0); PG8_MMA(0, 1, At, B1); PG8_BAR; PG8_SCHED;
            PG8_LDA(At, 0, 1); PG8_STAGE(PG8_SB(0, 0), b2, voffB); PG8_STAGE(PG8_SB(0, 1), b2 + hstep, voffB); PG8_STAGE(PG8_SA(0, 0), a2, v2[0]);
            PG8_WAIT_V(8); PG8_WAIT_L(0); PG8_BAR; PG8_MMA(1, 0, At, B0); PG8_MMA(1, 1, At, B1); PG8_BAR; PG8_SCHED;
            PG8_LDB(B0, 1, 0); PG8_LDB(B1, 1, 1); PG8_SCHED; PG8_LDA(At, 1, 0); PG8_STAGE(PG8_SA(0, 1), a2 + ah, v2[1]);
            PG8_WAIT_V(8); PG8_WAIT_L(0); PG8_BAR; PG8_MMA(0, 0, At, B0); PG8_MMA(0, 1, At, B1); PG8_BAR; PG8_SCHED;
            PG8_LDA(At, 1, 1); PG8_STAGE(PG8_SB(1, 0), b3, voffB); PG8_STAGE(PG8_SB(1, 1), b3 + hstep, voffB); PG8_STAGE(PG8_SA(1, 0), a3, v2[0]);
            PG8_WAIT_V(8); PG8_WAIT_L(0); PG8_BAR; PG8_MMA(1, 0, At, B0); PG8_MMA(1, 1, At, B1); PG8_BAR; PG8_SCHED;
            } else {
            PG8_LDB(B0, 0, 0); PG8_SCHED; PG8_LDA(At, 0, 0); PG8_STAGE(PG8_SA(1, 1), a1 + ah, va[1]);
            PG8_WAIT_L(8); PG8_BAR; PG8_WAIT_L(0); PG8_MMA(0, 0, At, B0); PG8_BAR; PG8_SCHED;
            PG8_LDB(B1, 0, 1); PG8_STAGE(PG8_SB(0, 0), b2, voffB);
            PG8_BAR; PG8_WAIT_L(0); PG8_MMA(0, 1, At, B1); PG8_BAR;
            PG8_LDA(At, 0, 1); PG8_STAGE(PG8_SA(0, 0), a2, v2[0]);
            PG8_BAR; PG8_WAIT_L(0); PG8_MMA(1, 0, At, B0); PG8_BAR; PG8_SCHED;
            PG8_STAGE(PG8_SB(0, 1), b2 + hstep, voffB);
            PG8_WAIT_V(6); PG8_BAR; PG8_MMA(1, 1, At, B1); PG8_BAR;
            PG8_LDB(B0, 1, 0); PG8_SCHED; PG8_LDA(At, 1, 0); PG8_STAGE(PG8_SA(0, 1), a2 + ah, v2[1]);
            PG8_WAIT_L(8); PG8_BAR; PG8_WAIT_L(0); PG8_MMA(0, 0, At, B0); PG8_BAR; PG8_SCHED;
            PG8_LDB(B1, 1, 1); PG8_STAGE(PG8_SB(1, 0), b3, voffB);
            PG8_BAR; PG8_WAIT_L(0); PG8_MMA(0, 1, At, B1); PG8_BAR;
            PG8_LDA(At, 1, 1); PG8_STAGE(PG8_SA(1, 0), a3, v2[0]);
            PG8_BAR; PG8_WAIT_L(0); PG8_MMA(1, 0, At, B0); PG8_BAR; PG8_SCHED;
            PG8_STAGE(PG8_SB(1, 1), b3 + hstep, voffB);
            PG8_WAIT_V(6); PG8_BAR; PG8_MMA(1, 1, At, B1); PG8_BAR;
            }
        }
        if constexpr (ALIGN_EPI) { if (wr == 0) PG8_BAR; }
        if constexpr (FP8) asm volatile("s_nop 15\n\ts_nop 15" ::: "memory");
        if constexpr (PAIR) { if (cur.e == 0) E.first(acc, cur, wr, wc, fr, fq, zp); else E.second(acc, cur, wr, wc, fr, fq, zp); } else E(acc, cur, wr, wc, fr, fq);
        if (!has_next) break;
#pragma unroll
        for (int a = 0; a < 2; ++a)
#pragma unroll
            for (int b = 0; b < 2; ++b)
#pragma unroll
                for (int m = 0; m < 4; ++m)
#pragma unroll
                    for (int n = 0; n < 2; ++n) acc[a][b][m][n] = (f32x4){0.f, 0.f, 0.f, 0.f};
        cur = nxt; cA = nA; cB = nB; ++ui;
        if constexpr (GATHER) PG8_GOFF(va, ubn);
        if constexpr (ALIGN_EPI) { if (wr == 1) PG8_BAR; }
    }
    PG8_WAIT_V(0);
    if constexpr (!ALIGN_EPI) { if (wr == 0) PG8_BAR; }
    PG8_BAR;
#undef PG8_SA
#undef PG8_GOFF
#undef PG8_SB
#undef PG8_STAGE
#undef PG8_LDA
#undef PG8_LD32
#undef PG8_HALF
#undef PG8_LDB
#undef PG8_MMA
#undef PG8_WAIT_V
#undef PG8_WAIT_L
#undef PG8_BAR
#undef PG8_SCHED
}
}

#define XB_TMO      128
#define XB_XCNT(j)  (256  + 64 * (j))
#define XB_XSUB(j)  (1280 + 64 * (j))
#define XB_XGEN(j)  (2304 + 64 * (j))
#define XB_TOP      3328
#define XB_TOPGEN   3392
#define XCD_BAR_WORDS 3456
#define XB_SPIN_CAP (1u << 18)
__device__ __forceinline__ unsigned xb_ld(unsigned* p)              { return __hip_atomic_load(p, __ATOMIC_RELAXED, __HIP_MEMORY_SCOPE_AGENT); }
__device__ __forceinline__ unsigned xb_add(unsigned* p, unsigned v) { return __hip_atomic_fetch_add(p, v, __ATOMIC_RELAXED, __HIP_MEMORY_SCOPE_AGENT); }
__device__ __forceinline__ unsigned xb_xcc_id() { return (unsigned)__builtin_amdgcn_s_getreg((3 << 11) | 20) & 0xFu; }
#define XB_SPIN(cond, bar) do { unsigned _sp = 0; while (cond) { __builtin_amdgcn_s_sleep(1); \
    if ((++_sp & 255u) == 0u) { if (xb_ld(&(bar)[XB_TMO])) break; if (_sp > XB_SPIN_CAP) { atomicAdd(&(bar)[XB_TMO], 1u); break; } } } } while (0)
struct XcdBarrier { unsigned* bar; unsigned x; volatile LAS unsigned* st; };
__device__ __forceinline__ XcdBarrier xcd_barrier_post(unsigned* bar, volatile LAS unsigned* st) {
    XcdBarrier b; b.bar = bar; b.x = xb_xcc_id(); b.st = st;
    if (threadIdx.x == 0) (void)xb_add(&bar[XB_XCNT(b.x)], 1u);
    return b;
}
__device__ __forceinline__ void xcd_barrier_complete(unsigned* bar, unsigned x, unsigned& nloc, unsigned& nx) {
    const unsigned G = gridDim.x * gridDim.y * gridDim.z;
    unsigned sum, cnt, mine, sp = 0u;
    for (;;) {
        sum = 0u; cnt = 0u; mine = 0u;
#pragma unroll
        for (unsigned j = 0; j < 16; ++j) { const unsigned c = xb_ld(&bar[XB_XCNT(j)]); sum += c; cnt += (c > 0u) ? 1u : 0u; mine = (j == x) ? c : mine; }
        if (sum == G) break;
        __builtin_amdgcn_s_sleep(1);
        if ((++sp & 255u) == 0u) { if (xb_ld(&bar[XB_TMO])) break; if (sp > XB_SPIN_CAP) { atomicAdd(&bar[XB_TMO], 1u); break; } }
    }
    nloc = mine > 0u ? mine : 1u; nx = cnt > 0u ? cnt : 1u;
}
__device__ __forceinline__ void xcd_barrier(const XcdBarrier& b) {
    asm volatile("s_waitcnt vmcnt(0)" ::: "memory");
    __syncthreads();
    if (threadIdx.x == 0) {
        unsigned* bar = b.bar;
        __builtin_amdgcn_s_waitcnt(0);
        unsigned nloc = b.st[0], nx = b.st[1];
        if (nloc == 0u) { xcd_barrier_complete(bar, b.x, nloc, nx); b.st[0] = nloc; b.st[1] = nx; }
        const unsigned old = xb_add(&bar[XB_XSUB(b.x)], 1u);
        const unsigned gen = old / nloc;
        if (old + 1u == (gen + 1u) * nloc) {
            __builtin_amdgcn_fence(__ATOMIC_RELEASE, "agent");
            asm volatile("s_waitcnt vmcnt(0)" ::: "memory");
            const unsigned og = xb_add(&bar[XB_TOP], 1u);
            const unsigned tg = og / nx;
            if (og + 1u == (tg + 1u) * nx) xb_add(&bar[XB_TOPGEN], 1u);
            else XB_SPIN(xb_ld(&bar[XB_TOPGEN]) == tg, bar);
            __builtin_amdgcn_fence(__ATOMIC_ACQUIRE, "agent");
            xb_add(&bar[XB_XGEN(b.x)], 1u);
            asm volatile("s_waitcnt vmcnt(0)" ::: "memory");
        } else {
            XB_SPIN(xb_ld(&bar[XB_XGEN(b.x)]) == gen, bar);
            __builtin_amdgcn_fence(__ATOMIC_ACQUIRE, "agent");
            asm volatile("s_waitcnt vmcnt(0)" ::: "memory");
        }
    }
    __syncthreads();
}

constexpr size_t MiB = 1u << 20;
constexpr size_t al(size_t x) { return (x + 4095) & ~(size_t)4095; }
constexpr size_t WS_CTL = 0, CTL_ZERO_BYTES = 1 * MiB;
constexpr int CW_BAR = 4096;
constexpr int CW_CNT = 16384, CNT_STRIDE = 64;
constexpr int CW_NT = CW_CNT + NE * CNT_STRIDE + 64;
static_assert((CW_NT + 1) * 4 <= (int)CTL_ZERO_BYTES, "control words inside the per-call memset");
constexpr size_t WS_MOD = 1 * MiB;
constexpr size_t WS_TILE_E = WS_MOD + 256 * 1024;
constexpr size_t WS_PADSTART = WS_TILE_E + 16 * 1024;
constexpr size_t WS_ROWTOK = 2 * MiB;
constexpr size_t WS_EIDX = 4 * MiB;
constexpr size_t WS_GATE = 5 * MiB;
constexpr size_t WS_DEST = 6 * MiB;
constexpr size_t WS_WIN = 8 * MiB;
constexpr size_t WS_WLORA = WS_WIN + al((size_t)NP * D * 2);
constexpr size_t WS_WBRRW = WS_WLORA + al((size_t)NLORA * KLORA * 2);
constexpr size_t WS_WBRGLA = WS_WBRRW + al((size_t)D * RWW * 2);
constexpr size_t WS_WOUT = WS_WBRGLA + al((size_t)D * RWW * 2);
constexpr size_t WS_WROUTER = WS_WOUT + al((size_t)D * D * 2);
constexpr size_t WS_WGU = WS_WROUTER + al((size_t)NE * D * 2);
constexpr size_t WS_WD = WS_WGU + al((size_t)(NE + 1) * 512 * D * 2);
constexpr size_t WS_PERSIST_END = WS_WD + al((size_t)(NE + 1) * D * FF * 2);
constexpr size_t WS_REGB = WS_PERSIST_END;
constexpr size_t SZ512F = al((size_t)MR * RWW * 4), SZ256F = al((size_t)MR * 256 * 4), SZ512H = al((size_t)MR * RWW * 2);
constexpr size_t WS_A1 = WS_REGB;
constexpr size_t WS_A2 = WS_A1;
constexpr size_t WS_KSUM = WS_A2 + al((size_t)MR * KLORA * 2);
static_assert(WS_KSUM + SZ512H <= WS_A1 + al((size_t)MR * D * 2), "A2 + KSUM fit in the A1 slot");
constexpr size_t WS_P = WS_A1 + al((size_t)MR * D * 2);
constexpr size_t WS_RB = WS_P + al((size_t)MR * NP * 2);
constexpr size_t WS_VB = WS_RB + SZ512H, WS_KKB = WS_VB + SZ512H, WS_KMF = WS_KKB + SZ512H, WS_KMB = WS_KMF + SZ512H, WS_BVF = WS_KMB + SZ512H, WS_BVB = WS_BVF + SZ512H;
constexpr size_t WS_LWF = WS_BVB + SZ512H, WS_LWB = WS_LWF + SZ512F;
constexpr size_t SZ256H = al((size_t)MR * 256 * 2);
constexpr size_t WS_QGB = WS_LWB + SZ512F, WS_KGB = WS_QGB + SZ256H, WS_VGB = WS_KGB + SZ256H, WS_LAF = WS_VGB + SZ512H, WS_LAB = WS_LAF + SZ256F;
constexpr size_t WS_RWG = WS_LAB + SZ256F;
constexpr size_t WS_ORWF = WS_RWG + SZ512H, WS_ORWB = WS_ORWF + SZ512H, WS_OGLF = WS_ORWB + SZ512H, WS_OGLB = WS_OGLF + SZ512H;
constexpr int CH = 64, NCHUNK = (CTXL + SEQ) / CH, NU_RW = 64 * NCHUNK, NU_GL = 32 * NCHUNK;
constexpr size_t WS_RH = WS_OGLB + SZ512H;
constexpr size_t WS_YL = WS_RH + al((size_t)NU_RW * 4096 * 2);
constexpr size_t WS_HH = WS_YL + al((size_t)NU_RW * 4096 * 2);
constexpr size_t WS_INTRA = WS_HH + al((size_t)NU_RW * 4096 * 2);
constexpr size_t WS_KV = WS_INTRA + al((size_t)NU_GL * 8192 * 2);
constexpr size_t WS_DD = WS_KV + al((size_t)NU_GL * 8192 * 2);
constexpr size_t WS_END_MIX = WS_DD + al((size_t)NU_GL * 64 * 4);
constexpr size_t OUT_GT = 0, OUT_QE = (size_t)NU_RW * 4096 * 2;
static_assert(OUT_QE + (size_t)NU_GL * 4096 * 2 <= (size_t)NLAT * D * 4, "scan scratch fits in d_out");
constexpr size_t WS_YRW = WS_LWF, WS_YGLA = WS_LWB, WS_Z = WS_HH, WS_Z8 = WS_ORWF;
static_assert((size_t)NLAT * D <= SZ512H, "Z8 fits in the forward RWKV scan output slot");
static_assert((size_t)NLAT * D * 2 <= (size_t)NU_RW * 4096 * 2, "Z fits in the HH slot");
constexpr size_t WS_X1 = WS_REGB;
constexpr size_t WS_A3 = WS_X1 + al((size_t)NLAT * D * 4);
constexpr size_t WS_LOGITS = WS_A3 + al((size_t)NLAT * D * 2);
constexpr size_t WS_ACT = WS_LOGITS + al((size_t)NLAT * NE * 4);
constexpr size_t WS_Y = WS_ACT + al((size_t)NROWS_E * FF * 2);
constexpr size_t WS_A3F = WS_Y + al((size_t)NROWS_E * D);
constexpr size_t WS_END_MOE = WS_A3F + al((size_t)NLAT * D);
constexpr size_t WS_END = WS_END_MIX > WS_END_MOE ? WS_END_MIX : WS_END_MOE;
static_assert(WS_END <= (size_t)2048 * MiB, "workspace map exceeds 2 GiB");

constexpr int RING_BYTES = 131072;
constexpr int IDX_BYTES = pg8::IDX_UNITS * 256 * 4;
constexpr int MISC_OFF = RING_BYTES + IDX_BYTES;
constexpr int S2_SF_OFF = MISC_OFF + 256;
constexpr int LDS_BYTES = S2_SF_OFF + 8192;
static_assert(pg8::IDX_OFF == RING_BYTES, "gather table sits right above the stage buffers");
constexpr int NWAVES = 8, NTHR = 512;

struct Args { const float* in[36]; float* out; unsigned char* ws; int ph_lo, ph_hi; };

struct Frame {
    LAS unsigned char* lds;
    int tid, lane, wave, G, gw, NGW;
    const float* const* in; float* out; unsigned char* ws; unsigned* ctl;
};

__device__ __forceinline__ float wave_sum(float v) {
#pragma unroll
    for (int o = 1; o < 64; o <<= 1) v += __shfl_xor(v, o);
    return v;
}
__device__ __forceinline__ unsigned f2bf(float f) { unsigned u = __builtin_bit_cast(unsigned, f); return (u + 0x7fffu + ((u >> 16) & 1u)) >> 16; }
typedef __bf16 bf16x2v __attribute__((ext_vector_type(2)));
__device__ __forceinline__ unsigned pk2(float lo, float hi) { const f32x2 v = {lo, hi}; return __builtin_bit_cast(unsigned, __builtin_convertvector(v, bf16x2v)); }
__device__ __forceinline__ float bflo(unsigned w) { return __builtin_bit_cast(float, w << 16); }
__device__ __forceinline__ float bfhi(unsigned w) { return __builtin_bit_cast(float, w & 0xffff0000u); }
__device__ __forceinline__ float sigmoidf_(float x) { return __builtin_amdgcn_rcpf(1.0f + __expf(-x)); }
__device__ __forceinline__ float siluf_(float x) { return x * __builtin_amdgcn_rcpf(1.0f + __expf(-x)); }
__device__ __forceinline__ float tanhf_(float x) { return 1.0f - 2.0f * __builtin_amdgcn_rcpf(1.0f + __expf(2.0f * x)); }
__device__ __forceinline__ float logsigmoidf_(float x) { return fminf(x, 0.f) - __logf(1.0f + __expf(-fabsf(x))); }

__device__ __forceinline__ void ln_stats(const f32x4 (&v)[4], float& mean, float& rstd) {
    float s = 0.f;
#pragma unroll
    for (int j = 0; j < 4; ++j) s += (v[j].x + v[j].y) + (v[j].z + v[j].w);
    mean = wave_sum(s) * (1.f / D); float s2 = 0.f;
#pragma unroll
    for (int j = 0; j < 4; ++j) { const f32x4 d = v[j] - mean; s2 += (d.x * d.x + d.y * d.y) + (d.z * d.z + d.w * d.w); }
    rstd = __builtin_amdgcn_rsqf(wave_sum(s2) * (1.f / D) + LN_EPS);
}

__device__ __forceinline__ unsigned pack_fp8x4(const f32x4 v) {
    int w = __builtin_amdgcn_cvt_pk_fp8_f32(__builtin_amdgcn_fmed3f(v[0], -448.f, 448.f), __builtin_amdgcn_fmed3f(v[1], -448.f, 448.f), 0, false);
    return (unsigned)__builtin_amdgcn_cvt_pk_fp8_f32(__builtin_amdgcn_fmed3f(v[2], -448.f, 448.f), __builtin_amdgcn_fmed3f(v[3], -448.f, 448.f), w, true); }
__device__ __forceinline__ void ld_row_bf16(const bf16* row, int lane, f32x4 (&v)[4]) {
    const v4u a = *(const v4u*)(row + 8 * lane), b = *(const v4u*)(row + 512 + 8 * lane);
    v[0] = (f32x4){bflo(a.x), bfhi(a.x), bflo(a.y), bfhi(a.y)}; v[1] = (f32x4){bflo(a.z), bfhi(a.z), bflo(a.w), bfhi(a.w)};
    v[2] = (f32x4){bflo(b.x), bfhi(b.x), bflo(b.y), bfhi(b.y)}; v[3] = (f32x4){bflo(b.z), bfhi(b.z), bflo(b.w), bfhi(b.w)};
}
__device__ __forceinline__ int rowcol(int lane, int j) { return 512 * (j >> 1) + 8 * lane + 4 * (j & 1); }
__device__ __forceinline__ void ph_x1pre_nomix(Frame& F) {
    const float* x = F.in[0];
    for (int m = F.gw; m < NLAT; m += F.NGW) {
        bf16* o = (bf16*)(F.ws + WS_X1) + (size_t)m * D;
#pragma unroll
        for (int h = 0; h < 2; ++h) { const float* xr = x + (size_t)m * D + 512 * h + 8 * F.lane; const f32x4 a = *(const f32x4*)xr * ALPHA, b = *(const f32x4*)(xr + 4) * ALPHA;
            v4u w; w.x = pk2(a.x, a.y); w.y = pk2(a.z, a.w); w.z = pk2(b.x, b.y); w.w = pk2(b.z, b.w); *(v4u*)(o + 512 * h + 8 * F.lane) = w; }
    }
}
__device__ __forceinline__ void ph_ln1(Frame& F) {
    const float* lw = F.in[26]; const float* lb = F.in[27]; const float* mod = (const float*)(F.ws + WS_MOD);
    bf16* A3 = (bf16*)(F.ws + WS_A3); const bf16* X1P = (const bf16*)(F.ws + WS_X1);
    constexpr int NR = 4;
    for (int i = blockIdx.x * NTHR + F.tid; i < NLAT; i += F.G * NTHR) ((int*)(F.ws + WS_ROWTOK))[SH_ROW0 + i] = i;
    int bcur = -1; f32x4 pa[4], pb[4];
#pragma unroll
    for (int j = 0; j < 4; ++j) { pa[j] = (f32x4){0.f, 0.f, 0.f, 0.f}; pb[j] = pa[j]; }
    for (int m0 = F.gw; m0 < NLAT; m0 += NR * F.NGW) {
        v4u w[NR][2];
#pragma unroll
        for (int r = 0; r < NR; ++r) { const int mm = m0 + r * F.NGW; const bf16* row = X1P + (size_t)(mm < NLAT ? mm : m0) * D; w[r][0] = *(const v4u*)(row + 8 * F.lane); w[r][1] = *(const v4u*)(row + 512 + 8 * F.lane); }
        __builtin_amdgcn_sched_barrier(0);
#pragma unroll
        for (int r = 0; r < NR; ++r) { const int mm = m0 + r * F.NGW; const int m = mm < NLAT ? mm : m0; const int b = m / SEQ;
            f32x4 v[4];
            v[0] = (f32x4){bflo(w[r][0].x), bfhi(w[r][0].x), bflo(w[r][0].y), bfhi(w[r][0].y)}; v[1] = (f32x4){bflo(w[r][0].z), bfhi(w[r][0].z), bflo(w[r][0].w), bfhi(w[r][0].w)};
            v[2] = (f32x4){bflo(w[r][1].x), bfhi(w[r][1].x), bflo(w[r][1].y), bfhi(w[r][1].y)}; v[3] = (f32x4){bflo(w[r][1].z), bfhi(w[r][1].z), bflo(w[r][1].w), bfhi(w[r][1].w)};
            float mean, rstd; ln_stats(v, mean, rstd);
#if MS >= 2
            if (b != bcur) { bcur = b;
#pragma unroll
                for (int j = 0; j < 4; ++j) { const int c = rowcol(F.lane, j); const f32x4 s1 = *(const f32x4*)(mod + b * 6144 + 4096 + c) + 1.0f;
                    pa[j] = *(const f32x4*)(lw + c) * s1; pb[j] = *(const f32x4*)(lb + c) * s1 + *(const f32x4*)(mod + b * 6144 + 3072 + c); } }
            f32x4 h[4];
#pragma unroll
            for (int j = 0; j < 4; ++j) h[j] = (v[j] - mean) * rstd * pa[j] + pb[j];
            bf16* ao = A3 + (size_t)m * D;
            { v4u o; o.x = pk2(h[0].x, h[0].y); o.y = pk2(h[0].z, h[0].w); o.z = pk2(h[1].x, h[1].y); o.w = pk2(h[1].z, h[1].w); *(v4u*)(ao + 8 * F.lane) = o;
              o.x = pk2(h[2].x, h[2].y); o.y = pk2(h[2].z, h[2].w); o.z = pk2(h[3].x, h[3].y); o.w = pk2(h[3].z, h[3].w); *(v4u*)(ao + 512 + 8 * F.lane) = o; }
            { unsigned char* af = F.ws + WS_A3F + (size_t)m * D; v2u o8;
              o8.x = pack_fp8x4(h[0]); o8.y = pack_fp8x4(h[1]); *(v2u*)(af + 8 * F.lane) = o8; o8.x = pack_fp8x4(h[2]); o8.y = pack_fp8x4(h[3]); *(v2u*)(af + 512 + 8 * F.lane) = o8; }
#endif
        }
    }
}
__device__ __forceinline__ f32x4 fp8x4(unsigned w) { const f32x2 lo = __builtin_amdgcn_cvt_pk_f32_fp8((int)w, false), hi = __builtin_amdgcn_cvt_pk_f32_fp8((int)w, true); return (f32x4){lo.x, lo.y, hi.x, hi.y}; }
__device__ __forceinline__ void ph_final(Frame& F) {
    const float* lw = F.in[34]; const float* lb = F.in[35]; const float* mod = (const float*)(F.ws + WS_MOD);
    const float* lw1 = F.in[26]; const float* lb1 = F.in[27]; const bf16* X1P = (const bf16*)(F.ws + WS_X1);
    const unsigned char* Y = F.ws + WS_Y; const int* DEST = (const int*)(F.ws + WS_DEST); const float* GATE = (const float*)(F.ws + WS_GATE);
    const int c0 = 16 * F.lane;
    f32x4 plw1[4], plb1[4], plw[4], plb[4], pg2[4]; int bcur = -1;
#pragma unroll
    for (int j = 0; j < 4; ++j) { pg2[j] = (f32x4){0.f, 0.f, 0.f, 0.f}; plw1[j] = *(const f32x4*)(lw1 + c0 + 4 * j); plb1[j] = *(const f32x4*)(lb1 + c0 + 4 * j); plw[j] = *(const f32x4*)(lw + c0 + 4 * j); plb[j] = *(const f32x4*)(lb + c0 + 4 * j); }
    for (int m0 = F.gw; m0 < NLAT; m0 += 2 * F.NGW) {
        int mm[2]; mm[0] = m0; mm[1] = (m0 + F.NGW < NLAT) ? m0 + F.NGW : m0;
        v4u xw[2][2];
#if MS >= 2
        v4u dw[2][2]; f32x4 gw[2][2];
#pragma unroll
        for (int r = 0; r < 2; ++r) { dw[r][0] = *(const v4u*)(DEST + mm[r] * 8); dw[r][1] = *(const v4u*)(DEST + mm[r] * 8 + 4); gw[r][0] = *(const f32x4*)(GATE + mm[r] * 8); gw[r][1] = *(const f32x4*)(GATE + mm[r] * 8 + 4); }
#endif
#pragma unroll
        for (int r = 0; r < 2; ++r) {
            const bf16* qrow = X1P + (size_t)mm[r] * D + 64 * (F.lane >> 2) + 8 * (F.lane & 3); xw[r][0] = *(const v4u*)qrow; xw[r][1] = *(const v4u*)(qrow + 32); }
#if MS >= 2
        v4u yw[2][TOPK + 1];
#pragma unroll
        for (int r = 0; r < 2; ++r) {
            int dr[TOPK]; dr[0] = (int)dw[r][0].x; dr[1] = (int)dw[r][0].y; dr[2] = (int)dw[r][0].z; dr[3] = (int)dw[r][0].w; dr[4] = (int)dw[r][1].x; dr[5] = (int)dw[r][1].y; dr[6] = (int)dw[r][1].z; dr[7] = (int)dw[r][1].w;
#pragma unroll
            for (int k = 0; k <= TOPK; ++k) yw[r][k] = *(const v4u*)(Y + (size_t)(k < TOPK ? dr[k < TOPK ? k : 0] : SH_ROW0 + mm[r]) * D + c0); }
        __builtin_amdgcn_sched_barrier(0);
#endif
#pragma unroll
        for (int r = 0; r < 2; ++r) { const int m = mm[r]; const int b = m / SEQ;
            { const unsigned a_[4] = {xw[r][0].x, xw[r][0].y, xw[r][0].z, xw[r][0].w}, b_[4] = {xw[r][1].x, xw[r][1].y, xw[r][1].z, xw[r][1].w}; unsigned u0[4], u1[4]; const bool hi = F.lane & 2;
#pragma unroll
              for (int d = 0; d < 4; ++d) {
                  const unsigned a02 = (unsigned)__builtin_amdgcn_update_dpp(0, (int)a_[d], 0x88, 0xf, 0xf, false), b02 = (unsigned)__builtin_amdgcn_update_dpp(0, (int)b_[d], 0x88, 0xf, 0xf, false);
                  const unsigned a13 = (unsigned)__builtin_amdgcn_update_dpp(0, (int)a_[d], 0xDD, 0xf, 0xf, false), b13 = (unsigned)__builtin_amdgcn_update_dpp(0, (int)b_[d], 0xDD, 0xf, 0xf, false);
                  u0[d] = hi ? b02 : a02; u1[d] = hi ? b13 : a13; }
              xw[r][0] = (v4u){u0[0], u0[1], u0[2], u0[3]}; xw[r][1] = (v4u){u1[0], u1[1], u1[2], u1[3]}; }
            f32x4 v[4];
            v[0] = (f32x4){bflo(xw[r][0].x), bfhi(xw[r][0].x), bflo(xw[r][0].y), bfhi(xw[r][0].y)}; v[1] = (f32x4){bflo(xw[r][0].z), bfhi(xw[r][0].z), bflo(xw[r][0].w), bfhi(xw[r][0].w)};
            v[2] = (f32x4){bflo(xw[r][1].x), bfhi(xw[r][1].x), bflo(xw[r][1].y), bfhi(xw[r][1].y)}; v[3] = (f32x4){bflo(xw[r][1].z), bfhi(xw[r][1].z), bflo(xw[r][1].w), bfhi(xw[r][1].w)};
            { float mean1, rstd1; ln_stats(v, mean1, rstd1);
#pragma unroll
              for (int j = 0; j < 4; ++j) v[j] = ((v[j] - mean1) * rstd1 * plw1[j] + plb1[j]) * ALPHA; }
#if MS >= 2
            if (b != bcur) { bcur = b;
#pragma unroll
                for (int j = 0; j < 4; ++j) pg2[j] = *(const f32x4*)(mod + b * 6144 + 5120 + c0 + 4 * j); }
            const float gt[TOPK] = {gw[r][0].x * 0.0625f, gw[r][0].y * 0.0625f, gw[r][0].z * 0.0625f, gw[r][0].w * 0.0625f, gw[r][1].x * 0.0625f, gw[r][1].y * 0.0625f, gw[r][1].z * 0.0625f, gw[r][1].w * 0.0625f};
#pragma unroll
            for (int j = 0; j < 4; ++j) { const unsigned ws8 = j == 0 ? yw[r][TOPK].x : (j == 1 ? yw[r][TOPK].y : (j == 2 ? yw[r][TOPK].z : yw[r][TOPK].w));
                f32x4 mo = fp8x4(ws8) * 0.0625f;
#pragma unroll
                for (int k = 0; k < TOPK; ++k) { const unsigned wk = j == 0 ? yw[r][k].x : (j == 1 ? yw[r][k].y : (j == 2 ? yw[r][k].z : yw[r][k].w)); mo += fp8x4(wk) * gt[k]; }
                v[j] += pg2[j] * mo; }
#endif
            float mean, rstd; ln_stats(v, mean, rstd);
            f32x4 ov[4];
#pragma unroll
            for (int j = 0; j < 4; ++j) ov[j] = (v[j] - mean) * rstd * plw[j] + plb[j];
            { const bool b0 = F.lane & 1, b1 = F.lane & 2; int tw[4][4];
#pragma unroll
              for (int j = 0; j < 4; ++j) { const float f0 = ov[j].x, f1 = ov[j].y, f2 = ov[j].z, f3 = ov[j].w;
                  tw[j][0] = __builtin_bit_cast(int, f0); tw[j][1] = __builtin_bit_cast(int, f1); tw[j][2] = __builtin_bit_cast(int, f2); tw[j][3] = __builtin_bit_cast(int, f3); }
#pragma unroll
              for (int e = 0; e < 4; ++e) { const int w0 = tw[0][e], w1 = tw[1][e], w2 = tw[2][e], w3 = tw[3][e];
#define QP1(v_) __builtin_amdgcn_update_dpp(0, (v_), 0xB1, 0xf, 0xf, false)
#define QP2(v_) __builtin_amdgcn_update_dpp(0, (v_), 0x4E, 0xf, 0xf, false)
                const int p0 = QP1(w0), p1 = QP1(w1), p2 = QP1(w2), p3 = QP1(w3);
                const int x0 = b0 ? p1 : w0, x1 = b0 ? w1 : p0, y0 = b0 ? p3 : w2, y1 = b0 ? w3 : p2;
                const int q0 = QP2(x0), q1 = QP2(x1), q2 = QP2(y0), q3 = QP2(y1);
                tw[0][e] = b1 ? q2 : x0; tw[1][e] = b1 ? q3 : x1; tw[2][e] = b1 ? y0 : q0; tw[3][e] = b1 ? y1 : q1; }
#undef QP1
#undef QP2
#pragma unroll
              for (int j = 0; j < 4; ++j) ov[j] = (f32x4){__builtin_bit_cast(float, tw[j][0]), __builtin_bit_cast(float, tw[j][1]), __builtin_bit_cast(float, tw[j][2]), __builtin_bit_cast(float, tw[j][3])}; }
            float* o = F.out + (size_t)m * D + 64 * (F.lane >> 2) + 4 * (F.lane & 3);
#pragma unroll
            for (int j = 0; j < 4; ++j) *(f32x4*)(o + 16 * j) = ov[j];
        }
    }
}


#if MS >= 2
template <int MODE, bool FP8 = false>
__device__ __forceinline__ void cvt_item(const float* W, int Nsrc, int nblk, bf16* WT, int row_off, int dpitch, LAS float* scr, int item, int lane) {
    const int kb = item / nblk, nb = item - kb * nblk, k0 = 64 * kb, n0 = 32 * nb;
    const int nn = n0 + (lane & 31);
    float wl[32];
#pragma unroll
    for (int i = 0; i < 32; ++i) { const int kk = 2 * i + (lane >> 5); wl[i] = (nn < Nsrc) ? W[(size_t)(k0 + kk) * Nsrc + nn] : 0.f; }
#pragma unroll
    for (int i = 0; i < 32; ++i) { const int kk = 2 * i + (lane >> 5); scr[kk * 33 + (lane & 31)] = wl[i]; }
    LDS_WAIT(); asm volatile("" ::: "memory");
    const int c = lane & 7;
#pragma unroll
    for (int j = 0; j < 4; ++j) { const int n = (lane >> 3) + 8 * j; const LAS float* s = scr + (8 * c) * 33 + n;
        v4u o; o.x = pk2(s[0 * 33], s[1 * 33]); o.y = pk2(s[2 * 33], s[3 * 33]); o.z = pk2(s[4 * 33], s[5 * 33]); o.w = pk2(s[6 * 33], s[7 * 33]);
        const int ng = n0 + n; int dr = ng;
        if (MODE == 1) { const int i2 = ng & 255; dr = 8 * (i2 >> 2) + (i2 & 3) + ((ng >= 256) ? 4 : 0); }
        if constexpr (FP8) { v2u o8; o8.x = pack_fp8x4((f32x4){s[0 * 33], s[1 * 33], s[2 * 33], s[3 * 33]} * W8S); o8.y = pack_fp8x4((f32x4){s[4 * 33], s[5 * 33], s[6 * 33], s[7 * 33]} * W8S);
            *(v2u*)((unsigned char*)WT + (size_t)(row_off + dr) * dpitch + k0 + 8 * c) = o8; }
        else *(v4u*)(WT + (size_t)(row_off + dr) * dpitch + k0 + 8 * c) = o; }
    LDS_WAIT(); asm volatile("" ::: "memory");
}

template <int MODE>
__device__ __forceinline__ void cvt_item_reg(const float* W, int Nsrc, bf16* WT, int row_off, int dpitch, int k0, int n0, int lane) {
    const float* src = W + (size_t)k0 * Nsrc + n0 + 4 * lane;
    f32x4 v[32];
#pragma unroll
    for (int i = 0; i < 32; ++i) v[i] = __builtin_nontemporal_load((const f32x4*)(src + (size_t)i * Nsrc));
#pragma unroll
    for (int j = 0; j < 4; ++j) {
        const int ng = n0 + 4 * lane + j; int dr = ng;
        if (MODE == 1) { const int i2 = ng & 255; dr = 8 * (i2 >> 2) + (i2 & 3) + ((ng >= 256) ? 4 : 0); }
        v4u* dst = (v4u*)(WT + (size_t)(row_off + dr) * dpitch + k0);
#pragma unroll
        for (int q = 0; q < 4; ++q) { v4u o; o.x = pk2(v[8 * q][j], v[8 * q + 1][j]); o.y = pk2(v[8 * q + 2][j], v[8 * q + 3][j]); o.z = pk2(v[8 * q + 4][j], v[8 * q + 5][j]); o.w = pk2(v[8 * q + 6][j], v[8 * q + 7][j]); dst[q] = o; }
    }
}

constexpr int CVK = 32;
__device__ __forceinline__ void cvt_reg_load(const float* W, int Nsrc, int k0, int n0, int lane, f32x4 (&v)[CVK]) {
    const float* src = W + (size_t)k0 * Nsrc + n0 + 4 * lane;
#pragma unroll
    for (int i = 0; i < CVK; ++i) v[i] = __builtin_nontemporal_load((const f32x4*)(src + (size_t)i * Nsrc));
}
template <int MODE, bool FP8 = false>
__device__ __forceinline__ void cvt_reg_store(bf16* WT, int row_off, int dpitch, int k0, int n0, int lane, const f32x4 (&v)[CVK]) {
#pragma unroll
    for (int j = 0; j < 4; ++j) {
        const int ng = n0 + 4 * lane + j; int dr = ng;
        if (MODE == 1) { const int i2 = ng & 255; dr = 8 * (i2 >> 2) + (i2 & 3) + ((ng >= 256) ? 4 : 0); }
        if constexpr (FP8) { v4u* dst8 = (v4u*)((unsigned char*)WT + (size_t)(row_off + dr) * dpitch + k0);
#pragma unroll
            for (int q = 0; q < CVK / 16; ++q) { v4u o;
                o.x = pack_fp8x4((f32x4){v[16 * q][j], v[16 * q + 1][j], v[16 * q + 2][j], v[16 * q + 3][j]} * W8S); o.y = pack_fp8x4((f32x4){v[16 * q + 4][j], v[16 * q + 5][j], v[16 * q + 6][j], v[16 * q + 7][j]} * W8S);
                o.z = pack_fp8x4((f32x4){v[16 * q + 8][j], v[16 * q + 9][j], v[16 * q + 10][j], v[16 * q + 11][j]} * W8S); o.w = pack_fp8x4((f32x4){v[16 * q + 12][j], v[16 * q + 13][j], v[16 * q + 14][j], v[16 * q + 15][j]} * W8S); dst8[q] = o; }
            continue; }
        v4u* dst = (v4u*)(WT + (size_t)(row_off + dr) * dpitch + k0);
#pragma unroll
        for (int q = 0; q < CVK / 8; ++q) { v4u o; o.x = pg8::cvt_pk_bf16(v[8 * q][j], v[8 * q + 1][j]); o.y = pg8::cvt_pk_bf16(v[8 * q + 2][j], v[8 * q + 3][j]); o.z = pg8::cvt_pk_bf16(v[8 * q + 4][j], v[8 * q + 5][j]); o.w = pg8::cvt_pk_bf16(v[8 * q + 6][j], v[8 * q + 7][j]); dst[q] = o; }
    }
}
constexpr int CV_GU = (D / CVK) * 2, CV_DN = (FF / CVK) * 4, CV_NGU = (NE + 1) * CV_GU, CV_NITEM = CV_NGU + (NE + 1) * CV_DN;
__device__ __forceinline__ void cvx_load(const float* const* in, int it, int lane, f32x4 (&v)[CVK]) {
    if (it < CV_NGU) { const int e = it / CV_GU, ii = it - e * CV_GU; const float* src = (e < NE) ? in[30] + (size_t)e * D * 512 : in[32];
        cvt_reg_load(src, 512, CVK * (ii >> 1), 256 * (ii & 1), lane, v); }
    else { const int r = it - CV_NGU, e = r / CV_DN, ii = r - e * CV_DN; const float* src = (e < NE) ? in[31] + (size_t)e * FF * D : in[33];
        cvt_reg_load(src, D, CVK * (ii >> 2), 256 * (ii & 3), lane, v); }
}
__device__ __forceinline__ void cvx_store(unsigned char* ws, int it, int lane, const f32x4 (&v)[CVK]) {
    if (it < CV_NGU) { const int e = it / CV_GU, ii = it - e * CV_GU; cvt_reg_store<1, true>((bf16*)(ws + WS_WGU), e * 512, D, CVK * (ii >> 1), 256 * (ii & 1), lane, v); }
    else { const int r = it - CV_NGU, e = r / CV_DN, ii = r - e * CV_DN; cvt_reg_store<0, true>((bf16*)(ws + WS_WD), e * D, FF, CVK * (ii >> 2), 256 * (ii & 3), lane, v); }
}

typedef float f32x2v __attribute__((ext_vector_type(2)));
constexpr int CY_GU = (D / 32) * 4, CY_DN = (FF / 32) * 8, CY_NGU = (NE + 1) * CY_GU, CY_NITEM = CY_NGU + (NE + 1) * CY_DN;
#define CY_KB_GU(ii) ((((ii) >> 4) << 2) | ((ii) & 3))
#define CY_NB_GU(ii) (((ii) >> 2) & 3)
#define CY_KB_DN(ii) ((((ii) >> 5) << 2) | ((ii) & 3))
#define CY_NB_DN(ii) (((ii) >> 2) & 7)
__device__ __forceinline__ void cvy_load(const float* const* in, int it, int lane, f32x2v (&v)[32]) {
    const float* p;  int Nsrc;
    if (it < CY_NGU) { const int e = it / CY_GU, ii = it - e * CY_GU; const float* src = (e < NE) ? in[30] + (size_t)e * D * 512 : in[32]; Nsrc = 512; p = src + (size_t)(32 * CY_KB_GU(ii)) * 512 + 128 * CY_NB_GU(ii) + 2 * lane; }
    else { const int r = it - CY_NGU, e = r / CY_DN, ii = r - e * CY_DN; const float* src = (e < NE) ? in[31] + (size_t)e * FF * D : in[33]; Nsrc = D; p = src + (size_t)(32 * CY_KB_DN(ii)) * D + 128 * CY_NB_DN(ii) + 2 * lane; }
#pragma unroll
    for (int i = 0; i < 32; ++i) v[i] = __builtin_nontemporal_load((const f32x2v*)(p + (size_t)i * Nsrc));
}
__device__ __forceinline__ void cvy_store(unsigned char* ws, int it, int lane, const f32x2v (&v)[32]) {
    unsigned char* base; int dpitch, n0; bool gu = it < CY_NGU;
    if (gu) { const int e = it / CY_GU, ii = it - e * CY_GU; base = ws + WS_WGU + (size_t)(e * 512) * D + 32 * CY_KB_GU(ii); dpitch = D; n0 = 128 * CY_NB_GU(ii); }
    else { const int r = it - CY_NGU, e = r / CY_DN, ii = r - e * CY_DN; base = ws + WS_WD + (size_t)(e * D) * FF + 32 * CY_KB_DN(ii); dpitch = FF; n0 = 128 * CY_NB_DN(ii); }
#pragma unroll
    for (int j = 0; j < 2; ++j) {
        const int ng = n0 + 2 * lane + j; int dr = ng;
        if (gu) { const int i2 = ng & 255; dr = 8 * (i2 >> 2) + (i2 & 3) + ((ng >= 256) ? 4 : 0); }
        v4u* dst8 = (v4u*)(base + (size_t)dr * dpitch);
#pragma unroll
        for (int q = 0; q < 2; ++q) { v4u o;
            o.x = pack_fp8x4((f32x4){v[16 * q][j], v[16 * q + 1][j], v[16 * q + 2][j], v[16 * q + 3][j]} * W8S); o.y = pack_fp8x4((f32x4){v[16 * q + 4][j], v[16 * q + 5][j], v[16 * q + 6][j], v[16 * q + 7][j]} * W8S);
            o.z = pack_fp8x4((f32x4){v[16 * q + 8][j], v[16 * q + 9][j], v[16 * q + 10][j], v[16 * q + 11][j]} * W8S); o.w = pack_fp8x4((f32x4){v[16 * q + 12][j], v[16 * q + 13][j], v[16 * q + 14][j], v[16 * q + 15][j]} * W8S); dst8[q] = o; }
    }
}
#define CVY_FLUSH() do { if (cpend >= 0) cvy_store(F.ws, cpend, lane, cv); cpend = -1; } while (0)
#define CVY_START(item) do { if ((item) < CY_NITEM) { cvy_load(F.in, (item), lane, cv); cpend = (item); } } while (0)

#if MS >= 3
__device__ __forceinline__ float lora_val(const float* const* in, int n, int k) {
    if (n < 1024) { const int q = n >> 3, e8 = n & 7, dir = e8 >> 2, ch = q * 4 + (e8 & 3); return (k < 32) ? in[9][(size_t)(dir * 32 + k) * 512 + ch] : 0.f; }
    if (n < 2048) { const int m = n - 1024, q = m >> 3, e8 = m & 7, dir = e8 >> 2, ch = q * 4 + (e8 & 3); return (k >= 32 && k < 64) ? in[11][(size_t)(dir * 32 + (k - 32)) * 512 + ch] : 0.f; }
    if (n < 2560) { const int ch = n - 2048; return (k >= 64 && k < 160) ? in[12][(size_t)(k - 64) * 512 + ch] : 0.f; }
    { const int m = n - 2560, q = m >> 3, e8 = m & 7, dir = e8 >> 2, ch = q * 4 + (e8 & 3); return (k >= 160 && k < 176) ? in[19][(size_t)(dir * 16 + (k - 160)) * 256 + ch] : 0.f; }
}
#endif

__device__ __forceinline__ void ph_prologue(Frame& F) {
    {
        const float* c = F.in[1]; const float* cc = F.in[3]; const float* wa = F.in[4]; const float* ba = F.in[5];
        float* MOD = (float*)(F.ws + WS_MOD);
        LAS float* S = (LAS float*)F.lds; LAS float* red = (LAS float*)(F.lds + 32768);
        for (int it = blockIdx.x; it < 96; it += F.G) {
            { float cv[5120 / NTHR];
#pragma unroll
              for (int q = 0; q < 5120 / NTHR; ++q) { const int i = F.tid + q * NTHR, r = i >> 10, k = i & 1023; cv[q] = r < 4 ? c[r * 1024 + k] : cc[k]; }
#pragma unroll
              for (int q = 0; q < 5120 / NTHR; ++q) S[F.tid + q * NTHR] = siluf_(cv[q]); }
            __syncthreads();
            const int n = it * 64 + F.lane; float acc[5] = {0.f, 0.f, 0.f, 0.f, 0.f};
            for (int kb = 0; kb < 128; kb += 64) {
                float wv[64];
#pragma unroll
                for (int u = 0; u < 64; ++u) wv[u] = wa[(size_t)(F.wave * 128 + kb + u) * 6144 + n];
#pragma unroll
                for (int u = 0; u < 64; ++u) { const int k = F.wave * 128 + kb + u;
#pragma unroll
                    for (int r = 0; r < 5; ++r) acc[r] += S[r * 1024 + k] * wv[u]; }
            }
#pragma unroll
            for (int r = 0; r < 5; ++r) red[(F.wave * 5 + r) * 64 + F.lane] = acc[r];
            __syncthreads();
            if (F.wave == 0) {
#pragma unroll
                for (int r = 0; r < 5; ++r) { float s = 0.f;
#pragma unroll
                    for (int w = 0; w < 8; ++w) s += red[(w * 5 + r) * 64 + F.lane];
                    MOD[r * 6144 + n] = s + ba[n]; }
            }
            __syncthreads();
        }
    }
    {
        LAS float* scr = (LAS float*)(F.lds + F.wave * 16384);
        constexpr int I_IN = 16 * 168, I_BR = 8 * 32, I_OUT = 16 * 32, I_RT = 16 * 8, I_GU = 32 * 2, I_DN = 8 * 4;
        constexpr int T0 = I_IN, T1 = T0 + I_BR, T2 = T1 + I_BR, T3 = T2 + I_OUT, T4 = T3 + I_RT, T5 = T4 + (NE + 1) * I_GU, T6 = T5 + (NE + 1) * I_DN;
        unsigned char* ws = F.ws;
        const bool split = F.G >= 2 * 96;
        const int cw = split ? ((int)blockIdx.x - 96) * (NTHR / 64) + F.wave : F.gw, cn = split ? (F.G - 96) * (NTHR / 64) : F.NGW;
        for (int it = cw < 0 ? T6 : cw; it < T6; it += cn) {
#if MS >= 3
            if (it < T0) { cvt_item<0, true>(F.in[6], IN_COLS, 168, (bf16*)(ws + WS_WIN), 0, D, scr, it, F.lane); continue; }
            if (it < T1) { cvt_item<0, true>(F.in[23], D, 32, (bf16*)(ws + WS_WBRRW), 0, RWW, scr, it - T0, F.lane); continue; }
            if (it < T2) { cvt_item<0, true>(F.in[24], D, 32, (bf16*)(ws + WS_WBRGLA), 0, RWW, scr, it - T1, F.lane); continue; }
            if (it < T3) { cvt_item<0, true>(F.in[25], D, 32, (bf16*)(ws + WS_WOUT), 0, D, scr, it - T2, F.lane); continue; }
#else
            if (it < T3) continue;
#endif
            if (it < T4) { cvt_item<0>(F.in[28], NE, 8, (bf16*)(ws + WS_WROUTER), 0, D, scr, it - T3, F.lane); continue; }
#if MS >= 3
            break;
#endif
            if (it < T5) { const int r = it - T4, e = r / I_GU, ii = r - e * I_GU;
                const float* src = (e < NE) ? F.in[30] + (size_t)e * D * 512 : F.in[32];
                cvt_item_reg<1>(src, 512, (bf16*)(ws + WS_WGU), e * 512, D, 32 * (ii >> 1), 256 * (ii & 1), F.lane); continue; }
            { const int r = it - T5, e = r / I_DN, ii = r - e * I_DN;
                const float* src = (e < NE) ? F.in[31] + (size_t)e * FF * D : F.in[33];
                cvt_item_reg<0>(src, D, (bf16*)(ws + WS_WD), e * D, FF, 32 * (ii >> 2), 256 * (ii & 3), F.lane); }
        }
    }
#if MS >= 3
    {
        bf16* WL = (bf16*)(F.ws + WS_WLORA);
        for (int idx = blockIdx.x * NTHR + F.tid; idx < NLORA * (KLORA / 8); idx += F.G * NTHR) {
            const int n = idx >> 5, k0 = (idx & 31) * 8; float v[8];
#pragma unroll
            for (int e = 0; e < 8; ++e) v[e] = lora_val(F.in, n, k0 + e);
            v4u o; o.x = pk2(v[0], v[1]); o.y = pk2(v[2], v[3]); o.z = pk2(v[4], v[5]); o.w = pk2(v[6], v[7]);
            *(v4u*)(WL + (size_t)n * KLORA + k0) = o;
        }
    }
#endif
}

struct EpiF32 {
    static constexpr bool PERM = false;
    float* C; int ldc;
    __device__ __forceinline__ void operator()(const f32x4 (&acc)[2][2][4][2], const pg8::Unit& u, int wr, int wc, int fr, int fq) const {
        const int row0 = u.pm * 256 + wr * 64 + fr, col0 = u.pn * 256 + wc * 32 + 4 * fq;
#pragma unroll
        for (int ai = 0; ai < 2; ++ai)
#pragma unroll
            for (int m = 0; m < 4; ++m) { float* rowp = C + (size_t)(row0 + ai * 128 + m * 16) * ldc + col0;
#pragma unroll
                for (int bj = 0; bj < 2; ++bj)
#pragma unroll
                    for (int n = 0; n < 2; ++n) *(f32x4*)(rowp + bj * 128 + n * 16) = acc[ai][bj][m][n]; }
    }
};
#define swap16(pa_, pb_) do { const v2u _r = __builtin_amdgcn_permlane16_swap((pa_), (pb_), false, false); (pa_) = _r[0]; (pb_) = _r[1]; } while (0)
#define swap32(pa_, pb_) do { const v2u _r = __builtin_amdgcn_permlane32_swap((pa_), (pb_), false, false); (pa_) = _r[0]; (pb_) = _r[1]; } while (0)
struct EpiSwiglu {
    static constexpr bool PERM = true;
    unsigned char* ACT;
    __device__ __forceinline__ void operator()(const f32x4 (&acc)[2][2][4][2], const pg8::Unit& u, int wr, int wc, int fr, int fq) const {
        const int row0 = u.pm * 256 + wr * 64 + fr, h0 = u.j * 128 + wc * 16;
#pragma unroll
        for (int ai = 0; ai < 2; ++ai)
#pragma unroll
            for (int bj = 0; bj < 2; ++bj) { unsigned w[4];
#pragma unroll
                for (int m = 0; m < 4; ++m) { const f32x4 a = acc[ai][bj][m][0] * W8I, b = acc[ai][bj][m][1] * W8I;
                    w[m] = pack_fp8x4((f32x4){siluf_(a[0]) * b[0], siluf_(a[1]) * b[1], siluf_(a[2]) * b[2], siluf_(a[3]) * b[3]}); }
                swap16(w[0], w[1]); swap16(w[2], w[3]); swap32(w[0], w[2]); swap32(w[1], w[3]);
                if (wr * 64 + fr + ai * 128 + fq * 16 < (u.e >> 16))
                    *(v4u*)(ACT + (size_t)(row0 + ai * 128 + fq * 16) * FF + h0 + bj * 64) = (v4u){w[0], w[1], w[2], w[3]}; }
    }
};
struct EpiRowsBf16 {
    static constexpr bool PERM = true;
    bf16* O; int ldc; float sc;
    __device__ __forceinline__ void operator()(const f32x4 (&acc)[2][2][4][2], const pg8::Unit& u, int wr, int wc, int fr, int fq) const {
        const int row0 = u.pm * 256 + wr * 64 + fr, col0 = u.j * 256 + wc * 32 + 8 * fq;
#pragma unroll
        for (int ai = 0; ai < 2; ++ai)
#pragma unroll
            for (int m = 0; m < 4; ++m) { bf16* rowp = O + (size_t)(row0 + ai * 128 + m * 16) * ldc + col0;
#pragma unroll
                for (int bj = 0; bj < 2; ++bj) { const f32x4 v0 = acc[ai][bj][m][0] * sc, v1 = acc[ai][bj][m][1] * sc;
                    v4u w; w.x = pg8::cvt_pk_bf16(v0[0], v0[1]); w.y = pg8::cvt_pk_bf16(v0[2], v0[3]); w.z = pg8::cvt_pk_bf16(v1[0], v1[1]); w.w = pg8::cvt_pk_bf16(v1[2], v1[3]);
                    *(v4u*)(rowp + bj * 128) = w;
#ifdef PROBE_ST2
                    asm volatile("" ::: "memory"); *(volatile v4u*)(rowp + bj * 128) = w;
#endif
                    } }
    }
};

struct EpiRowsFp8 {
    static constexpr bool PERM = true;
    unsigned char* O;
    __device__ __forceinline__ void operator()(const f32x4 (&acc)[2][2][4][2], const pg8::Unit& u, int wr, int wc, int fr, int fq) const {
        const int row0 = u.pm * 256 + wr * 64 + fr, col0 = u.j * 256 + wc * 32 + 8 * (fq & ~1);
#pragma unroll
        for (int ai = 0; ai < 2; ++ai)
#pragma unroll
            for (int bj = 0; bj < 2; ++bj) { v2u w[4];
#pragma unroll
                for (int m = 0; m < 4; ++m) { f32x4 v0 = acc[ai][bj][m][0] * (16.0f * W8I), v1 = acc[ai][bj][m][1] * (16.0f * W8I);
#pragma unroll
                    for (int e = 0; e < 4; ++e) { v0[e] = __builtin_amdgcn_fmed3f(v0[e], -448.0f, 448.0f); v1[e] = __builtin_amdgcn_fmed3f(v1[e], -448.0f, 448.0f); }
                    int w0 = __builtin_amdgcn_cvt_pk_fp8_f32(v0[0], v0[1], 0, false); w0 = __builtin_amdgcn_cvt_pk_fp8_f32(v0[2], v0[3], w0, true);
                    int w1 = __builtin_amdgcn_cvt_pk_fp8_f32(v1[0], v1[1], 0, false); w1 = __builtin_amdgcn_cvt_pk_fp8_f32(v1[2], v1[3], w1, true);
                    w[m].x = (unsigned)w0; w[m].y = (unsigned)w1; }
#pragma unroll
                for (int mp = 0; mp < 2; ++mp) {
                    swap16(w[2 * mp].x, w[2 * mp + 1].x); swap16(w[2 * mp].y, w[2 * mp + 1].y);
                    if (wr * 64 + fr + ai * 128 + (2 * mp + (fq & 1)) * 16 < (u.e >> 16))
                        *(v4u*)(O + (size_t)(row0 + ai * 128 + (2 * mp + (fq & 1)) * 16) * D + col0 + bj * 128) = (v4u){w[2 * mp].x, w[2 * mp].y, w[2 * mp + 1].x, w[2 * mp + 1].y}; } }
    }
};

__device__ __forceinline__ void ph_router(Frame& F) {
    pg8::Gemm g{(const bf16*)(F.ws + WS_A3), (const bf16*)(F.ws + WS_WROUTER), NLAT, NE, D, nullptr};
    pg8::StaticOrder S; S.init(NLAT, NE, F.G, (int)blockIdx.x);
    EpiF32 E{(float*)(F.ws + WS_LOGITS), NE};
    pg8::gemm_phase<EpiF32, pg8::StaticOrder, true, true, false>(F.lds, g, S, E);
    constexpr int NRU = NLAT / 256; const bool spare = F.G >= 2 * NRU;
    pg8::Gemm g1{(const bf16*)(F.ws + WS_A3F), (const bf16*)(F.ws + WS_WGU), 0, 0, D / 2, (const int*)(F.ws + WS_ROWTOK)};
    pg8::SharedOrder S1{spare ? (int)blockIdx.x - NRU : (int)blockIdx.x, spare ? F.G - NRU : F.G};
    EpiSwiglu E1{F.ws + WS_ACT};
    __syncthreads();
    pg8::gemm_phase<EpiSwiglu, pg8::SharedOrder, true, true, true, true>(F.lds, g1, S1, E1);
}

#define RT_DPP(x, ctrl) __builtin_amdgcn_update_dpp(0, (x), (ctrl), 0xf, 0xf, false)
__device__ __forceinline__ unsigned wave_max_u32(unsigned k) {
    k = max(k, (unsigned)RT_DPP((int)k, 0xB1)); k = max(k, (unsigned)RT_DPP((int)k, 0x4E));
    k = max(k, (unsigned)RT_DPP((int)k, 0x124)); k = max(k, (unsigned)RT_DPP((int)k, 0x128));
    const unsigned a = (unsigned)__builtin_amdgcn_readlane((int)k, 0), b = (unsigned)__builtin_amdgcn_readlane((int)k, 16), c = (unsigned)__builtin_amdgcn_readlane((int)k, 32), d = (unsigned)__builtin_amdgcn_readlane((int)k, 48);
    return max(max(a, b), max(c, d));
}
__device__ __forceinline__ void ph_route(Frame& F) {
    const float* LOG = (const float*)(F.ws + WS_LOGITS); const float* rb = F.in[29];
    int* EIDX = (int*)(F.ws + WS_EIDX); float* GATE = (float*)(F.ws + WS_GATE); int* DEST = (int*)(F.ws + WS_DEST);
    unsigned* CNT = F.ctl + CW_CNT;
    const f32x4 bias = *(const f32x4*)(rb + 4 * F.lane);
    f32x4 lgn = *(const f32x4*)(LOG + (size_t)(F.gw < NLAT ? F.gw : 0) * NE + 4 * F.lane);
    unsigned pos_prev = 0u; int m_prev = -1;
    for (int m = F.gw; m < NLAT; m += F.NGW) {
        const f32x4 lg = lgn;
        { const int mn = (m + F.NGW < NLAT) ? m + F.NGW : m; lgn = *(const f32x4*)(LOG + (size_t)mn * NE + 4 * F.lane); }
        float sc[4], sel[4];
#pragma unroll
        for (int i = 0; i < 4; ++i) { sc[i] = sigmoidf_(lg[i]); sel[i] = sc[i] + bias[i]; }
        float m1 = fmaxf(sel[0], sel[1]), m2 = fminf(sel[0], sel[1]);
        { const float a = sel[2]; const float n1 = fmaxf(m1, a); m2 = fmaxf(m2, fminf(m1, a)); m1 = n1; }
        { const float a = sel[3]; const float n1 = fmaxf(m1, a); m2 = fmaxf(m2, fminf(m1, a)); m1 = n1; }
#define RT_MERGE(ctrl) do { const float b1 = __builtin_bit_cast(float, RT_DPP(__builtin_bit_cast(int, m1), ctrl)), b2 = __builtin_bit_cast(float, RT_DPP(__builtin_bit_cast(int, m2), ctrl)); \
            const float n1 = fmaxf(m1, b1); m2 = fmaxf(fminf(m1, b1), fmaxf(m2, b2)); m1 = n1; } while (0)
        RT_MERGE(0xB1); RT_MERGE(0x4E); RT_MERGE(0x141);
#undef RT_MERGE
        const float gs = m1 + m2; const int g = F.lane >> 3;
        int rank = 0;
#pragma unroll
        for (int gg = 0; gg < 8; ++gg) { const float og = __builtin_bit_cast(float, __builtin_amdgcn_readlane(__builtin_bit_cast(int, gs), gg * 8)); rank += (og > gs || (og == gs && gg < g)) ? 1 : 0; }
        const bool keep = rank < 4;
        unsigned key[4];
#pragma unroll
        for (int i = 0; i < 4; ++i) { unsigned u = __builtin_bit_cast(unsigned, sel[i]); u ^= (u >> 31) ? 0xffffffffu : 0x80000000u;
            key[i] = keep ? ((u & 0xffffff00u) | (unsigned)(255 - (4 * F.lane + i))) : 0u; }
        int my_e = 0; float my_s = 0.f; float ssum = 0.f;
#pragma unroll
        for (int k = 0; k < TOPK; ++k) {
            const unsigned best = wave_max_u32(max(max(key[0], key[1]), max(key[2], key[3])));
            const int e = 255 - (int)(best & 255u), owner = e >> 2;
            float s_own = 0.f;
#pragma unroll
            for (int i = 0; i < 4; ++i) if (key[i] == best) { s_own = sc[i]; key[i] = 0u; }
            const float s = __builtin_bit_cast(float, __builtin_amdgcn_readlane(__builtin_bit_cast(int, s_own), owner));
            ssum += s;
            if (F.lane == k) { my_e = e; my_s = s; }
        }
        if (F.lane < TOPK) {
            if (m_prev >= 0) DEST[m_prev * 8 + F.lane] = (int)pos_prev;
            pos_prev = __hip_atomic_fetch_add(CNT + my_e * CNT_STRIDE, 1u, __ATOMIC_RELAXED, __HIP_MEMORY_SCOPE_AGENT);
            EIDX[m * 8 + F.lane] = my_e; GATE[m * 8 + F.lane] = my_s * __builtin_amdgcn_rcpf(ssum) * 2.5f;
        }
        m_prev = m;
    }
    if (F.lane < TOPK && m_prev >= 0) DEST[m_prev * 8 + F.lane] = (int)pos_prev;
}
#undef RT_DPP

__device__ __forceinline__ void ph_scatter(Frame& F) {
    LAS int* tstart = (LAS int*)F.lds;
    LAS int* scan = (LAS int*)(F.lds + 2048);
    LAS int* cnts = (LAS int*)(F.lds + 4096);
    int* EIDX = (int*)(F.ws + WS_EIDX); int* DEST = (int*)(F.ws + WS_DEST); int* ROWTOK = (int*)(F.ws + WS_ROWTOK); int* TILE_E = (int*)(F.ws + WS_TILE_E);
    unsigned* CNT = F.ctl + CW_CNT;
    int tiles = 0, cnt = 0;
    if (F.tid < NE) { cnt = (int)__hip_atomic_load(CNT + F.tid * CNT_STRIDE, __ATOMIC_RELAXED, __HIP_MEMORY_SCOPE_AGENT); tiles = (cnt + 255) >> 8; scan[F.tid] = tiles; cnts[F.tid] = cnt; }
    __syncthreads();
    for (int o = 1; o < NE; o <<= 1) { int v = 0; if (F.tid < NE && F.tid >= o) v = scan[F.tid - o]; __syncthreads(); if (F.tid < NE) scan[F.tid] += v; __syncthreads(); }
    if (F.tid < NE) { tstart[F.tid + 1] = scan[F.tid]; if (F.tid == 0) tstart[0] = 0; }
    __syncthreads();
    const int NT = tstart[NE];
    if (blockIdx.x == 0) {
        if (F.tid == 0) F.ctl[CW_NT] = (unsigned)NT;
        if (F.tid < NE) for (int t = tstart[F.tid]; t < tstart[F.tid + 1]; ++t) { const int left = cnts[F.tid] - 256 * (t - tstart[F.tid]); TILE_E[t] = F.tid | ((left < 256 ? left : 256) << 16); }
    }
    for (int e = blockIdx.x; e < NE; e += F.G) { const int c0 = cnts[e], c1 = (tstart[e + 1] - tstart[e]) * 256, base = tstart[e] * 256;
        for (int p = c0 + F.tid; p < c1; p += NTHR) ROWTOK[base + p] = 0; }
    for (int i0 = blockIdx.x * NTHR + F.tid; i0 < NLAT * TOPK; i0 += 4 * F.G * NTHR) {
        int e[4], pos[4];
#pragma unroll
        for (int q = 0; q < 4; ++q) { const int i = i0 + q * F.G * NTHR; const bool ok = i < NLAT * TOPK; e[q] = ok ? EIDX[i] : 0; pos[q] = ok ? DEST[i] : 0; }
#pragma unroll
        for (int q = 0; q < 4; ++q) { const int i = i0 + q * F.G * NTHR; if (i < NLAT * TOPK) { const int dr = tstart[e[q]] * 256 + pos[q]; DEST[i] = dr; ROWTOK[dr] = i >> 3; } }
    }
}

__device__ __forceinline__ void ph_exp1(Frame& F) {
    const int NT = (int)__hip_atomic_load(F.ctl + CW_NT, __ATOMIC_RELAXED, __HIP_MEMORY_SCOPE_AGENT);
    pg8::Gemm g{(const bf16*)(F.ws + WS_A3F), (const bf16*)(F.ws + WS_WGU), 0, 0, D / 2, (const int*)(F.ws + WS_ROWTOK)};
    pg8::MoeOrder S{2, F.G, (int)blockIdx.x, NT, (const int*)(F.ws + WS_TILE_E), 0};
    EpiSwiglu E{F.ws + WS_ACT};
    pg8::gemm_phase<EpiSwiglu, pg8::MoeOrder, true, true, true, true>(F.lds, g, S, E);
}
__device__ __forceinline__ void ph_exp2(Frame& F) {
    const int NT = (int)__hip_atomic_load(F.ctl + CW_NT, __ATOMIC_RELAXED, __HIP_MEMORY_SCOPE_AGENT);
    pg8::Gemm g{(const bf16*)(F.ws + WS_ACT), (const bf16*)(F.ws + WS_WD), 0, 0, FF / 2, nullptr};
    pg8::MoeOrder S{4, F.G, (int)blockIdx.x, NT, (const int*)(F.ws + WS_TILE_E), NLAT / 256};
    EpiRowsFp8 E{F.ws + WS_Y};
    pg8::gemm_phase<EpiRowsFp8, pg8::MoeOrder, true, true, false, true>(F.lds, g, S, E);
}
#endif

#if MS >= 3
__device__ __forceinline__ void unp8(const v4u w, float (&f)[8]) { f[0] = bflo(w.x); f[1] = bfhi(w.x); f[2] = bflo(w.y); f[3] = bfhi(w.y); f[4] = bflo(w.z); f[5] = bfhi(w.z); f[6] = bflo(w.w); f[7] = bfhi(w.w); }
__device__ __forceinline__ void unp8f8(const v2u w, float (&f)[8]) { const f32x2 a = __builtin_amdgcn_cvt_pk_f32_fp8((int)w.x, false), b = __builtin_amdgcn_cvt_pk_f32_fp8((int)w.x, true), c = __builtin_amdgcn_cvt_pk_f32_fp8((int)w.y, false), d = __builtin_amdgcn_cvt_pk_f32_fp8((int)w.y, true);
    f[0] = a.x; f[1] = a.y; f[2] = b.x; f[3] = b.y; f[4] = c.x; f[5] = c.y; f[6] = d.x; f[7] = d.y; }
__device__ __forceinline__ v4u pk8(const float (&f)[8]) { v4u o; o.x = pk2(f[0], f[1]); o.y = pk2(f[2], f[3]); o.z = pk2(f[4], f[5]); o.w = pk2(f[6], f[7]); return o; }
__device__ __forceinline__ void st8(float* p, const float (&f)[8]) { *(f32x4*)p = (f32x4){f[0], f[1], f[2], f[3]}; *(f32x4*)(p + 4) = (f32x4){f[4], f[5], f[6], f[7]}; }
__device__ __forceinline__ void ld8(const float* p, float (&f)[8]) { const f32x4 a = *(const f32x4*)p, b = *(const f32x4*)(p + 4); f[0] = a.x; f[1] = a.y; f[2] = a.z; f[3] = a.w; f[4] = b.x; f[5] = b.y; f[6] = b.z; f[7] = b.w; }

__device__ __forceinline__ void ph_a1(Frame& F) {
    const float* mod = (const float*)(F.ws + WS_MOD); unsigned char* A1 = F.ws + WS_A1;
    constexpr int NR = 4;
    int mcur = -1; f32x4 psc[4], psh[4];
#pragma unroll
    for (int j = 0; j < 4; ++j) { psc[j] = (f32x4){0.f, 0.f, 0.f, 0.f}; psh[j] = psc[j]; }
    for (int m0 = F.gw; m0 < MR; m0 += NR * F.NGW) {
        f32x4 xv[NR][4];
#pragma unroll
        for (int r = 0; r < NR; ++r) { const int mm = m0 + r * F.NGW; const int m = mm < MR ? mm : m0;
            const float* src = (m < NLAT) ? F.in[0] + (size_t)m * D : F.in[2] + (size_t)(m - NLAT) * D;
            const f32x4* xr = (const f32x4*)src + F.lane;
#pragma unroll
            for (int j = 0; j < 4; ++j) xv[r][j] = __builtin_nontemporal_load(xr + 64 * j); }
        __builtin_amdgcn_sched_barrier(0);
#pragma unroll
        for (int r = 0; r < NR; ++r) { const int mm = m0 + r * F.NGW; const int m = mm < MR ? mm : m0; const int mr = (m < NLAT) ? (m / SEQ) : 4;
            unsigned* ao = (unsigned*)(A1 + (size_t)m * D) + F.lane;
            if (mr != mcur) { mcur = mr;
#pragma unroll
                for (int j = 0; j < 4; ++j) { const int c = 4 * F.lane + 256 * j; psh[j] = *(const f32x4*)(mod + mr * 6144 + c); psc[j] = *(const f32x4*)(mod + mr * 6144 + 1024 + c) + 1.0f; } }
#pragma unroll
            for (int j = 0; j < 4; ++j) { const f32x4 h = xv[r][j] * psc[j] + psh[j]; ao[64 * j] = pack_fp8x4(h); } }
    }
}

__device__ __forceinline__ void ph_inproj(Frame& F) {
    pg8::Gemm g{(const bf16*)(F.ws + WS_A1), (const bf16*)(F.ws + WS_WIN), MR, NP, D / 2, nullptr};
    pg8::StaticOrder S; S.init(MR, NP, F.G, (int)blockIdx.x);
    EpiRowsBf16 E{(bf16*)(F.ws + WS_P), NP, W8I};
    pg8::gemm_phase<EpiRowsBf16, pg8::StaticOrder, true, true, false, true>(F.lds, g, S, E);
}

__device__ __forceinline__ v2u pk8f8(const float (&v)[8]) { v2u o; o.x = pack_fp8x4((f32x4){v[0], v[1], v[2], v[3]}); o.y = pack_fp8x4((f32x4){v[4], v[5], v[6], v[7]}); return o; }
struct FeatOut { bf16 *R, *V, *KK, *KP, *QG, *KGB, *VGB, *A2; const float *mu, *kkw, *cw; };
__device__ __forceinline__ void feat_rw(const FeatOut& O, int p, size_t m, int lane, const v4u own_w, const v4u (&nbw)[4], const float (&muv)[8]) {
    float own[8], sh[4][8], val[8];
    unp8(own_w, own);
#pragma unroll
    for (int q = 0; q < 4; ++q) unp8(nbw[q], sh[q]);
#pragma unroll
    for (int e = 0; e < 8; ++e) val[e] = own[e] + muv[e] * (sh[e & 3][e] - own[e]);
    if (p == 0) *(v4u*)(O.R + m * RWW + 8 * lane) = pk8(val);
    else if (p == 2) *(v4u*)(O.V + m * RWW + 8 * lane) = pk8(val);
    else if (p == 1) {
        *(v4u*)(O.KP + m * RWW + 8 * lane) = pk8(val);
        float kw[8]; ld8(O.kkw + 8 * lane, kw); float kkv[8]; float ss = 0.f;
#pragma unroll
        for (int e = 0; e < 8; ++e) { kkv[e] = val[e] * kw[e]; ss += kkv[e] * kkv[e]; }
        ss += __shfl_xor(ss, 1); ss += __shfl_xor(ss, 2); ss += __shfl_xor(ss, 4);
        const float inv = 1.0f / fmaxf(sqrtf(ss), 1e-12f);
#pragma unroll
        for (int e = 0; e < 8; ++e) kkv[e] *= inv;
        *(v4u*)(O.KK + m * RWW + 8 * lane) = pk8(kkv);
    } else {
        float o[8];
#pragma unroll
        for (int e = 0; e < 8; ++e) o[e] = (lane < 4) ? tanhf_(val[e]) : ((lane < 8) ? val[e] : sigmoidf_(val[e]));
        *(v4u*)(O.A2 + m * KLORA + 8 * lane) = pk8(o);
    }
}
__device__ __forceinline__ void feat_gla_store(const FeatOut& O, int p, size_t m, int lane, const float (&acc)[8]) {
    const int cq = p * 512 + 8 * lane; float o[8];
#pragma unroll
    for (int e = 0; e < 8; ++e) o[e] = siluf_(acc[e]);
    if (p == 0) {
        if (lane < 32) {
#pragma unroll
            for (int e = 0; e < 8; ++e) o[e] *= 0.125f;
            *(v4u*)(O.QG + m * 256 + cq) = pk8(o);
        } else *(v4u*)(O.KGB + m * 256 + (cq - 256)) = pk8(o);
    } else *(v4u*)(O.VGB + m * RWW + (cq - 512)) = pk8(o);
}
__device__ __forceinline__ void ph_feat(Frame& F) {
    const bf16* P = (const bf16*)(F.ws + WS_P);
    FeatOut O{(bf16*)(F.ws + WS_RB), (bf16*)(F.ws + WS_VB), (bf16*)(F.ws + WS_KKB), (bf16*)(F.ws + WS_KMF), (bf16*)(F.ws + WS_QGB), (bf16*)(F.ws + WS_KGB), (bf16*)(F.ws + WS_VGB), (bf16*)(F.ws + WS_A2), F.in[7], F.in[13], F.in[18]};
    const v4u Z4 = (v4u){0u, 0u, 0u, 0u};
    for (int blk = F.gw; blk < NB * (GRIDH / 2) * (GRIDW / 2); blk += F.NGW) {
        int lane = F.lane; asm volatile("" : "+v"(lane));
        const int b = blk >> 11, r0 = 2 * ((blk >> 5) & 63), c0 = 2 * (blk & 31); const int mb = b * SEQ + r0 * GRIDW + c0;
        const bool vu = r0 > 0, vd = r0 + 2 < GRIDH, vl = c0 > 0, vr = c0 + 2 < GRIDW;
#pragma unroll
        for (int p = 0; p < 4; ++p) {
            const int cb = p * 512 + 8 * lane; const bool act = (p < 3) || lane < 20;
            v4u own[2][2], up[2], dn[2], lf[2], rt[2];
#pragma unroll
            for (int i = 0; i < 2; ++i) { up[i] = Z4; dn[i] = Z4; lf[i] = Z4; rt[i] = Z4; own[i][0] = Z4; own[i][1] = Z4; }
            if (act) {
#pragma unroll
                for (int i = 0; i < 2; ++i) {
#pragma unroll
                    for (int j = 0; j < 2; ++j) own[i][j] = *(const v4u*)(P + (size_t)(mb + 64 * i + j) * NP + cb);
                    if (vu) up[i] = *(const v4u*)(P + (size_t)(mb - 64 + i) * NP + cb);
                    if (vd) dn[i] = *(const v4u*)(P + (size_t)(mb + 128 + i) * NP + cb);
                    if (vl) lf[i] = *(const v4u*)(P + (size_t)(mb + 64 * i - 1) * NP + cb);
                    if (vr) rt[i] = *(const v4u*)(P + (size_t)(mb + 64 * i + 2) * NP + cb); }
            } else if (p == 3 && lane >= 20 && lane < 22) {
#pragma unroll
                for (int i = 0; i < 2; ++i)
#pragma unroll
                    for (int j = 0; j < 2; ++j) own[i][j] = *(const v4u*)(P + (size_t)(mb + 64 * i + j) * NP + C_PGL + 8 * (lane - 20));
            }
            float muv[8] = {0.f, 0.f, 0.f, 0.f, 0.f, 0.f, 0.f, 0.f}; if (act) ld8(O.mu + cb, muv);
            __builtin_amdgcn_sched_barrier(0);
#pragma unroll
            for (int i = 0; i < 2; ++i)
#pragma unroll
                for (int j = 0; j < 2; ++j) { const size_t m = (size_t)(mb + 64 * i + j);
                    if (act) { const v4u nbw[4] = {j == 0 ? lf[i] : own[i][0], j == 1 ? rt[i] : own[i][1], i == 0 ? up[j] : own[0][j], i == 1 ? dn[j] : own[1][j]};
                        feat_rw(O, p, m, lane, own[i][j], nbw, muv); }
                    else if (p == 3 && lane < 32) *(v4u*)(O.A2 + m * KLORA + 8 * lane) = own[i][j]; }
        }
    }
#pragma unroll 1
    for (int p = 0; p < 2; ++p) {
      float cwv[9][8];
      { int lane0 = F.lane; asm volatile("" : "+v"(lane0));
#pragma unroll
        for (int tp = 0; tp < 9; ++tp) ld8(O.cw + tp * 1024 + p * 512 + 8 * lane0, cwv[tp]); }
      for (int blk = F.gw; blk < NB * (GRIDH / 2) * (GRIDW / 2); blk += F.NGW) {
        int lane = F.lane; asm volatile("" : "+v"(lane));
        const int b = blk >> 11, r0 = 2 * ((blk >> 5) & 63), c0 = 2 * (blk & 31); const int mb = b * SEQ + r0 * GRIDW + c0;
        const bool vu = r0 > 0, vd = r0 + 2 < GRIDH, vl = c0 > 0, vr = c0 + 2 < GRIDW;
        {
            const int cq = p * 512 + 8 * lane, cb = C_Q + cq;
            v4u g[4][4];
#pragma unroll
            for (int a2 = 0; a2 < 4; ++a2)
#pragma unroll
                for (int b2 = 0; b2 < 4; ++b2) { const bool ok = (a2 == 0 ? vu : (a2 == 3 ? vd : true)) && (b2 == 0 ? vl : (b2 == 3 ? vr : true));
                    g[a2][b2] = Z4; if (ok) g[a2][b2] = *(const v4u*)(P + (size_t)(mb + 64 * (a2 - 1) + (b2 - 1)) * NP + cb); }
            __builtin_amdgcn_sched_barrier(0);
            float acc[2][2][8];
#pragma unroll
            for (int i = 0; i < 2; ++i)
#pragma unroll
                for (int j = 0; j < 2; ++j)
#pragma unroll
                    for (int e = 0; e < 8; ++e) acc[i][j][e] = 0.f;
#pragma unroll
            for (int dy = 0; dy < 3; ++dy)
#pragma unroll
                for (int dx = 0; dx < 3; ++dx) {
#pragma unroll
                    for (int i = 0; i < 2; ++i)
#pragma unroll
                        for (int j = 0; j < 2; ++j) { float pv[8]; unp8(g[i + dy][j + dx], pv);
#pragma unroll
                            for (int e = 0; e < 8; ++e) acc[i][j][e] += pv[e] * cwv[dy * 3 + dx][e]; } }
#pragma unroll
            for (int i = 0; i < 2; ++i)
#pragma unroll
                for (int j = 0; j < 2; ++j) feat_gla_store(O, p, (size_t)(mb + 64 * i + j), lane, acc[i][j]);
        }
      }
    }
    for (int m = NLAT + F.gw; m < MR; m += F.NGW) {
        int lane = F.lane; asm volatile("" : "+v"(lane));
        const int t = (m - NLAT) & (CTXL - 1); const bool vp = t > 0, vn = t < CTXL - 1;
#pragma unroll
        for (int p = 0; p < 4; ++p) {
            const int cb = p * 512 + 8 * lane; const bool act = (p < 3) || lane < 20;
            if (act) { const v4u own = *(const v4u*)(P + (size_t)m * NP + cb); v4u pv = Z4, nv = Z4;
                if (vp) pv = *(const v4u*)(P + (size_t)(m - 1) * NP + cb); if (vn) nv = *(const v4u*)(P + (size_t)(m + 1) * NP + cb);
                float muv[8]; ld8(O.mu + cb, muv); const v4u nbw[4] = {pv, nv, pv, nv};
                feat_rw(O, p, (size_t)m, lane, own, nbw, muv); }
            else if (p == 3 && lane < 32) { v4u w = Z4; if (lane < 22) w = *(const v4u*)(P + (size_t)m * NP + C_PGL + 8 * (lane - 20)); *(v4u*)(O.A2 + (size_t)m * KLORA + 8 * lane) = w; }
        }
#pragma unroll
        for (int p = 0; p < 2; ++p) {
            const int cq = p * 512 + 8 * lane, cb = C_Q + cq; float acc[8] = {0.f, 0.f, 0.f, 0.f, 0.f, 0.f, 0.f, 0.f};
#pragma unroll
            for (int dx = -1; dx <= 1; ++dx) { const bool ok = (dx < 0) ? vp : ((dx > 0) ? vn : true);
                if (ok) { float pv[8], wv[8]; unp8(*(const v4u*)(P + (size_t)(m + dx) * NP + cb), pv); ld8(O.cw + (3 + dx + 1) * 1024 + cq, wv);
#pragma unroll
                    for (int e = 0; e < 8; ++e) acc[e] += pv[e] * wv[e]; } }
            feat_gla_store(O, p, (size_t)m, lane, acc);
        }
    }
}

#define ST16_PAIRS(base, pitch, W, fq_) do { _Pragma("unroll") for (int _mp = 0; _mp < 2; ++_mp) { \
        swap16(W[2 * _mp].x, W[2 * _mp + 1].x); swap16(W[2 * _mp].y, W[2 * _mp + 1].y); \
        *(v4u*)((base) + (size_t)((2 * _mp + ((fq_) & 1)) * 16) * (pitch)) = (v4u){W[2 * _mp].x, W[2 * _mp].y, W[2 * _mp + 1].x, W[2 * _mp + 1].y}; } } while (0)
#define ST16_PAIR1(base, pitch, W0, W1, mp_, fq_) do { swap16(W0.x, W1.x); swap16(W0.y, W1.y); \
        *(v4u*)((base) + (size_t)((2 * (mp_) + ((fq_) & 1)) * 16) * (pitch)) = (v4u){W0.x, W0.y, W1.x, W1.y}; } while (0)
struct EpiLora {
    static constexpr bool PERM = true;
    unsigned char* ws; const float* const* in;
    __device__ __forceinline__ void grp_w(const f32x4 (&acc)[2][2][4][2], int row0, int c0, int fq) const {
        bf16* Wf = (bf16*)(ws + WS_LWF); bf16* Wb = (bf16*)(ws + WS_LWB);
#pragma unroll
        for (int bj = 0; bj < 2; ++bj) { const int ch = (c0 + bj * 128) >> 1; const f32x4 w0f = *(const f32x4*)(in[8] + ch), w0b = *(const f32x4*)(in[8] + 512 + ch);
#pragma unroll
            for (int ai = 0; ai < 2; ++ai) { v2u of[4], ob[4];
#pragma unroll
                for (int m = 0; m < 4; ++m) {
                    const f32x4 xf = acc[ai][bj][m][0] + w0f, xb = acc[ai][bj][m][1] + w0b; f32x4 df, db;
#pragma unroll
                    for (int e = 0; e < 4; ++e) { df[e] = -0.60653066f * sigmoidf_(xf[e]); db[e] = -0.60653066f * sigmoidf_(xb[e]); }
                    of[m].x = pk2(df[0], df[1]); of[m].y = pk2(df[2], df[3]); ob[m].x = pk2(db[0], db[1]); ob[m].y = pk2(db[2], db[3]); }
                const size_t o0 = (size_t)(row0 + ai * 128) * RWW + (ch - 4 * (fq & 1));
                ST16_PAIRS(Wf + o0, RWW, of, fq); ST16_PAIRS(Wb + o0, RWW, ob, fq); } }
    }
    __device__ __forceinline__ void grp_a(const f32x4 (&acc)[2][2][4][2], int row0, int c0, int fq) const {
        bf16* KMf = (bf16*)(ws + WS_KMF); bf16* KMb = (bf16*)(ws + WS_KMB); bf16* BVf = (bf16*)(ws + WS_BVF); bf16* BVb = (bf16*)(ws + WS_BVB);
        const bf16* KK = (const bf16*)(ws + WS_KKB); bf16* KSUM = (bf16*)(ws + WS_KSUM);
#pragma unroll
        for (int bj = 0; bj < 2; ++bj) { const int ch = (c0 + bj * 128 - 1024) >> 1; const f32x4 a0f = *(const f32x4*)(in[10] + ch), a0b = *(const f32x4*)(in[10] + 512 + ch), ka = *(const f32x4*)(in[14] + ch);
#pragma unroll
            for (int ai = 0; ai < 2; ++ai) {
            v2u kpw[4], kkw[4];
#pragma unroll
                for (int m = 0; m < 4; ++m) { const size_t row = (size_t)(row0 + ai * 128 + m * 16); kpw[m] = *(const v2u*)(KMf + row * RWW + ch); kkw[m] = *(const v2u*)(KK + row * RWW + ch); }
            __builtin_amdgcn_sched_barrier(0);
            const size_t o0 = (size_t)(row0 + ai * 128) * RWW + (ch - 4 * (fq & 1));
#pragma unroll
                for (int mp = 0; mp < 2; ++mp) { v2u okf[2], okb[2], obf[2], obb[2], oks[2];
#pragma unroll
                    for (int h = 0; h < 2; ++h) { const int m = 2 * mp + h;
                        const f32x4 xf = acc[ai][bj][m][0] + a0f, xb = acc[ai][bj][m][1] + a0b;
                        const f32x4 kp = (f32x4){bflo(kpw[m].x), bfhi(kpw[m].x), bflo(kpw[m].y), bfhi(kpw[m].y)}, kk = (f32x4){bflo(kkw[m].x), bfhi(kkw[m].x), bflo(kkw[m].y), bfhi(kkw[m].y)};
                        f32x4 kmf, kmb, bvf, bvb;
#pragma unroll
                        for (int e = 0; e < 4; ++e) { const float af = sigmoidf_(xf[e]), ab = sigmoidf_(xb[e]);
                            kmf[e] = kp[e] * (1.0f + (af - 1.0f) * ka[e]); kmb[e] = kp[e] * (1.0f + (ab - 1.0f) * ka[e]); bvf[e] = kk[e] * af; bvb[e] = kk[e] * ab; }
                        okf[h].x = pk2(kmf[0], kmf[1]); okf[h].y = pk2(kmf[2], kmf[3]); okb[h].x = pk2(kmb[0], kmb[1]); okb[h].y = pk2(kmb[2], kmb[3]);
                        obf[h].x = pk2(bvf[0], bvf[1]); obf[h].y = pk2(bvf[2], bvf[3]); obb[h].x = pk2(bvb[0], bvb[1]); obb[h].y = pk2(bvb[2], bvb[3]);
                        oks[h].x = pk2(kmf[0] + kmb[0], kmf[1] + kmb[1]); oks[h].y = pk2(kmf[2] + kmb[2], kmf[3] + kmb[3]); }
                    ST16_PAIR1(KMf + o0, RWW, okf[0], okf[1], mp, fq); ST16_PAIR1(KMb + o0, RWW, okb[0], okb[1], mp, fq); ST16_PAIR1(BVf + o0, RWW, obf[0], obf[1], mp, fq);
                    ST16_PAIR1(BVb + o0, RWW, obb[0], obb[1], mp, fq); ST16_PAIR1(KSUM + o0, RWW, oks[0], oks[1], mp, fq); } } }
    }
    __device__ __forceinline__ void grp_g(const f32x4 (&acc)[2][2][4][2], int row0, int c0) const {
        bf16* RWG = (bf16*)(ws + WS_RWG);
#pragma unroll
        for (int bj = 0; bj < 2; ++bj) { const int ch = c0 + bj * 128 - 2048;
#pragma unroll
            for (int ai = 0; ai < 2; ++ai)
#pragma unroll
                for (int m = 0; m < 4; ++m) { const size_t row = (size_t)(row0 + ai * 128 + m * 16); const f32x4 v0 = acc[ai][bj][m][0], v1 = acc[ai][bj][m][1];
                    v4u w; w.x = pk2(v0[0], v0[1]); w.y = pk2(v0[2], v0[3]); w.z = pk2(v1[0], v1[1]); w.w = pk2(v1[2], v1[3]); *(v4u*)(RWG + row * RWW + ch) = w; } }
    }
    __device__ __forceinline__ void grp_l(const f32x4 (&acc)[2][2][4][2], int row0, int c0, int fq) const {
        bf16* GAf = (bf16*)(ws + WS_LAF); bf16* GAb = (bf16*)(ws + WS_LAB);
#pragma unroll
        for (int bj = 0; bj < 2; ++bj) { const int ch = (c0 + bj * 128 - 2560) >> 1; const f32x4 gbf = *(const f32x4*)(in[20] + ch), gbb = *(const f32x4*)(in[20] + 256 + ch);
#pragma unroll
            for (int ai = 0; ai < 2; ++ai) { v2u of[4], ob[4];
#pragma unroll
                for (int m = 0; m < 4; ++m) {
                    const f32x4 xf = acc[ai][bj][m][0] + gbf, xb = acc[ai][bj][m][1] + gbb; f32x4 af, ab;
#pragma unroll
                    for (int e = 0; e < 4; ++e) { const float lf = logsigmoidf_(xf[e]), lb = logsigmoidf_(xb[e]);
                        af[e] = lf * 0.0625f; ab[e] = lb * 0.0625f; }
                    of[m].x = pk2(af[0], af[1]); of[m].y = pk2(af[2], af[3]); ob[m].x = pk2(ab[0], ab[1]); ob[m].y = pk2(ab[2], ab[3]); }
                const size_t o0 = (size_t)(row0 + ai * 128) * 256 + (ch - 4 * (fq & 1));
                ST16_PAIRS(GAf + o0, 256, of, fq); ST16_PAIRS(GAb + o0, 256, ob, fq); } }
    }
    __device__ __forceinline__ void operator()(const f32x4 (&acc)[2][2][4][2], const pg8::Unit& u, int wr, int wc, int fr, int fq) const {
        const int row0 = u.pm * 256 + wr * 64 + fr, c0 = u.pn * 256 + wc * 32 + 8 * fq;
        if (u.pn < 4) grp_w(acc, row0, c0, fq); else if (u.pn < 8) grp_a(acc, row0, c0, fq); else if (u.pn < 10) grp_g(acc, row0, c0); else grp_l(acc, row0, c0, fq);
    }
};
__device__ __forceinline__ void ph_lora(Frame& F) {
    pg8::Gemm g{(const bf16*)(F.ws + WS_A2), (const bf16*)(F.ws + WS_WLORA), MR, NLORA, KLORA, nullptr};
    pg8::StaticOrder S; S.init(MR, NLORA, F.G, (int)blockIdx.x);
    EpiLora E{F.ws, F.in};
    pg8::gemm_phase<EpiLora, pg8::StaticOrder, true, true, false>(F.lds, g, S, E);
}

__device__ __forceinline__ void ph_merge(Frame& F) {
    unsigned char* ws = F.ws; const int lane = F.lane;
    const bf16* ORf = (const bf16*)(ws + WS_ORWF); const bf16* ORb = (const bf16*)(ws + WS_ORWB); const bf16* OGf = (const bf16*)(ws + WS_OGLF); const bf16* OGb = (const bf16*)(ws + WS_OGLB);
    const bf16* R = (const bf16*)(ws + WS_RB); const bf16* V = (const bf16*)(ws + WS_VB); const bf16* KSUM = (const bf16*)(ws + WS_KSUM); const bf16* RWG = (const bf16*)(ws + WS_RWG);
    const bf16* P = (const bf16*)(ws + WS_P);
    bf16* YRW = (bf16*)(ws + WS_YRW); bf16* YGLA = (bf16*)(ws + WS_YGLA);
    float rk[8], gw[8], gbv[8], ggw[8], ggb[8];
    ld8(F.in[15] + 8 * lane, rk); ld8(F.in[16] + 8 * lane, gw); ld8(F.in[17] + 8 * lane, gbv); ld8(F.in[21] + 8 * lane, ggw); ld8(F.in[22] + 8 * lane, ggb);
    for (int m0 = F.gw; m0 < NLAT; m0 += 2 * F.NGW) {
        const int m1 = (m0 + F.NGW < NLAT) ? m0 + F.NGW : m0;
        v4u wa[2], wb[2], wc[2], wd[2], wr[2], wv[2], wk[2], wg[2], wo[2];
#pragma unroll
        for (int r2 = 0; r2 < 2; ++r2) { const int m = r2 ? m1 : m0; const size_t ro = (size_t)m * RWW + 8 * lane;
            wa[r2] = *(const v4u*)(ORf + ro); wb[r2] = *(const v4u*)(ORb + ro); wc[r2] = *(const v4u*)(OGf + ro); wd[r2] = *(const v4u*)(OGb + ro);
            wr[r2] = *(const v4u*)(R + ro); wv[r2] = *(const v4u*)(V + ro); wk[r2] = *(const v4u*)(KSUM + ro); wg[r2] = *(const v4u*)(RWG + ro);
            wo[r2] = *(const v4u*)(P + (size_t)m * NP + C_OG + 8 * lane); }
#pragma unroll
        for (int r2 = 0; r2 < 2; ++r2) { const int m = r2 ? m1 : m0; const size_t ro = (size_t)m * RWW + 8 * lane;
        {
            float a[8], b[8], o[8]; unp8(wa[r2], a); unp8(wb[r2], b);
            float s = 0.f;
#pragma unroll
            for (int e = 0; e < 8; ++e) { o[e] = a[e] + b[e]; s += o[e]; }
            s += __shfl_xor(s, 1); s += __shfl_xor(s, 2); s += __shfl_xor(s, 4);
            const float mean = s * (1.f / 64.f); float q = 0.f;
#pragma unroll
            for (int e = 0; e < 8; ++e) { o[e] -= mean; q += o[e] * o[e]; }
            q += __shfl_xor(q, 1); q += __shfl_xor(q, 2); q += __shfl_xor(q, 4);
            const float rstd = __builtin_amdgcn_rsqf(q * (1.f / 64.f) + RW_GN_EPS);
            float r[8], v[8], ksm[8], g[8]; unp8(wr[r2], r); unp8(wv[r2], v); unp8(wk[r2], ksm); unp8(wg[r2], g);
            float bs = 0.f;
#pragma unroll
            for (int e = 0; e < 8; ++e) bs += r[e] * ksm[e] * rk[e];
            bs += __shfl_xor(bs, 1); bs += __shfl_xor(bs, 2); bs += __shfl_xor(bs, 4);
            float y[8];
#pragma unroll
            for (int e = 0; e < 8; ++e) y[e] = (o[e] * rstd * gw[e] + gbv[e] + bs * v[e]) * g[e];
            *(v2u*)((unsigned char*)YRW + ro) = pk8f8(y);
        }
        {
            float a[8], b[8], o[8]; unp8(wc[r2], a); unp8(wd[r2], b);
            float s = 0.f;
#pragma unroll
            for (int e = 0; e < 8; ++e) { o[e] = a[e] + b[e]; s += o[e]; }
            s += __shfl_xor(s, 1); s += __shfl_xor(s, 2); s += __shfl_xor(s, 4); s += __shfl_xor(s, 8);
            const float mean = s * (1.f / 128.f); float q = 0.f;
#pragma unroll
            for (int e = 0; e < 8; ++e) { o[e] -= mean; q += o[e] * o[e]; }
            q += __shfl_xor(q, 1); q += __shfl_xor(q, 2); q += __shfl_xor(q, 4); q += __shfl_xor(q, 8);
            const float rstd = __builtin_amdgcn_rsqf(q * (1.f / 128.f) + LN_EPS);
            float og[8]; unp8(wo[r2], og);
            float y[8];
#pragma unroll
            for (int e = 0; e < 8; ++e) y[e] = (o[e] * rstd * ggw[e] + ggb[e]) * siluf_(og[e]);
            *(v2u*)((unsigned char*)YGLA + ro) = pk8f8(y);
        }
        }
    }
}

struct EpiBranch {
    static constexpr bool PERM = true;
    static constexpr bool PAIR = true;
    const bf16* P; unsigned char* Z8;
    __device__ __forceinline__ void first(const f32x4 (&acc)[2][2][4][2], const pg8::Unit& u, int wr, int wc, int, int, v2u (&zp)[16]) const {
        const int lane_ = (int)__builtin_amdgcn_mbcnt_hi(~0u, __builtin_amdgcn_mbcnt_lo(~0u, 0u)), fr = lane_ & 15, fq = lane_ >> 4;
        const int row0 = u.pm * 256 + wr * 64 + fr, col0 = u.pn * 256 + wc * 32 + 8 * fq;
#pragma unroll
        for (int ah = 0; ah < 4; ++ah) { const int ai = ah >> 1, mb = 2 * (ah & 1);
            v4u gw[2][2];
#pragma unroll
            for (int m = 0; m < 2; ++m) { const size_t row = (size_t)(row0 + ai * 128 + (mb + m) * 16);
#pragma unroll
                for (int bj = 0; bj < 2; ++bj) gw[m][bj] = *(const v4u*)(P + row * NP + C_GRW + col0 + bj * 128); }
            __builtin_amdgcn_sched_barrier(0);
#pragma unroll
            for (int m = 0; m < 2; ++m)
#pragma unroll
                for (int bj = 0; bj < 2; ++bj) { float g[8]; unp8(gw[m][bj], g);
                    const f32x4 v0 = acc[ai][bj][mb + m][0], v1 = acc[ai][bj][mb + m][1]; float z[8];
#pragma unroll
                    for (int e = 0; e < 4; ++e) { z[e] = sigmoidf_(g[e]) * (v0[e] * W8I); z[4 + e] = sigmoidf_(g[4 + e]) * (v1[e] * W8I); }
                    zp[(ai * 4 + mb + m) * 2 + bj] = pk8f8(z); }
        }
    }
    __device__ __forceinline__ void second(const f32x4 (&acc)[2][2][4][2], const pg8::Unit& u, int wr, int wc, int, int, v2u (&zp)[16]) const {
        const int lane_ = (int)__builtin_amdgcn_mbcnt_hi(~0u, __builtin_amdgcn_mbcnt_lo(~0u, 0u)), fr = lane_ & 15, fq = lane_ >> 4;
        const int row0 = u.pm * 256 + wr * 64 + fr, col0 = u.pn * 256 + wc * 32 + 8 * fq;
#pragma unroll
        for (int ah = 0; ah < 4; ++ah) { const int ai = ah >> 1, mb = 2 * (ah & 1);
            v4u gw[2][2]; v2u z8[2][2];
#pragma unroll
            for (int m = 0; m < 2; ++m) { const size_t row = (size_t)(row0 + ai * 128 + (mb + m) * 16);
#pragma unroll
                for (int bj = 0; bj < 2; ++bj) gw[m][bj] = *(const v4u*)(P + row * NP + C_GGLA + col0 + bj * 128); }
            __builtin_amdgcn_sched_barrier(0);
#pragma unroll
            for (int m = 0; m < 2; ++m)
#pragma unroll
                for (int bj = 0; bj < 2; ++bj) { float g[8]; unp8(gw[m][bj], g);
                    const f32x4 v0 = acc[ai][bj][mb + m][0], v1 = acc[ai][bj][mb + m][1]; float z[8], zo[8]; unp8f8(zp[(ai * 4 + mb + m) * 2 + bj], zo);
#pragma unroll
                    for (int e = 0; e < 4; ++e) { z[e] = sigmoidf_(g[e]) * (v0[e] * W8I) + zo[e]; z[4 + e] = sigmoidf_(g[4 + e]) * (v1[e] * W8I) + zo[4 + e]; }
                    z8[m][bj] = pk8f8(z); }
#pragma unroll
            for (int bj = 0; bj < 2; ++bj) { swap16(z8[0][bj].x, z8[1][bj].x); swap16(z8[0][bj].y, z8[1][bj].y);
                *(v4u*)(Z8 + (size_t)(row0 + ai * 128 + (mb + (fq & 1)) * 16) * D + u.pn * 256 + wc * 32 + 8 * (fq & ~1) + bj * 128) = (v4u){z8[0][bj].x, z8[0][bj].y, z8[1][bj].x, z8[1][bj].y}; }
        }
    }
    __device__ __forceinline__ void operator()(const f32x4 (&acc)[2][2][4][2], const pg8::Unit& u, int wr, int wc, int fr, int fq) const { }
};
__device__ __forceinline__ void ph_branch(Frame& F) {
    pg8::PairOrder S; S.S.init(NLAT, D, F.G, (int)blockIdx.x);
    pg8::Gemm g{(const bf16*)(F.ws + WS_YRW), (const bf16*)(F.ws + WS_WBRRW), NLAT, D, RWW / 2, nullptr, (const bf16*)(F.ws + WS_YGLA), (const bf16*)(F.ws + WS_WBRGLA)};
    EpiBranch E{(const bf16*)(F.ws + WS_P), F.ws + WS_Z8};
    pg8::gemm_phase<EpiBranch, pg8::PairOrder, true, true, false, true>(F.lds, g, S, E);
}
struct EpiOut {
    static constexpr bool PERM = true;
    bf16* X1P; const float* x; const float* mod;
    __device__ __forceinline__ void operator()(const f32x4 (&acc)[2][2][4][2], const pg8::Unit& u, int wr, int wc, int fr, int fq) const {
        const int row0 = u.pm * 256 + wr * 64 + fr, col0 = u.pn * 256 + wc * 32 + 8 * fq; const float* g1 = mod + (u.pm / (SEQ / 256)) * 6144 + 2048;
        f32x4 gv[2][2];
#pragma unroll
        for (int bj = 0; bj < 2; ++bj)
#pragma unroll
            for (int n = 0; n < 2; ++n) gv[bj][n] = *(const f32x4*)(g1 + col0 + bj * 128 + 4 * n);
#pragma unroll
        for (int ah = 0; ah < 4; ++ah) { const int ai = ah >> 1, mb = 2 * (ah & 1);
            f32x4 xv[2][2][2];
#pragma unroll
            for (int m = 0; m < 2; ++m) { const size_t ro = (size_t)(row0 + ai * 128 + (mb + m) * 16) * D;
#pragma unroll
                for (int bj = 0; bj < 2; ++bj)
#pragma unroll
                    for (int n = 0; n < 2; ++n) xv[m][bj][n] = *(const f32x4*)(x + ro + col0 + bj * 128 + 4 * n); }
            __builtin_amdgcn_sched_barrier(0);
#pragma unroll
            for (int m = 0; m < 2; ++m) { const size_t ro = (size_t)(row0 + ai * 128 + (mb + m) * 16) * D;
#pragma unroll
                for (int bj = 0; bj < 2; ++bj) { const f32x4 a = xv[m][bj][0] * ALPHA + gv[bj][0] * (acc[ai][bj][mb + m][0] * W8I), b = xv[m][bj][1] * ALPHA + gv[bj][1] * (acc[ai][bj][mb + m][1] * W8I);
                    v4u w; w.x = pk2(a.x, a.y); w.y = pk2(a.z, a.w); w.z = pk2(b.x, b.y); w.w = pk2(b.z, b.w); *(v4u*)(X1P + ro + col0 + bj * 128) = w; } }
        }
    }
};
__device__ __forceinline__ void ph_outproj(Frame& F) {
    pg8::Gemm g{(const bf16*)(F.ws + WS_Z8), (const bf16*)(F.ws + WS_WOUT), NLAT, D, D / 2, nullptr};
    pg8::StaticOrder S; S.init(NLAT, D, F.G, (int)blockIdx.x);
    EpiOut E{(bf16*)(F.ws + WS_X1), F.in[0], (const float*)(F.ws + WS_MOD)};
    pg8::gemm_phase<EpiOut, pg8::StaticOrder, true, true, false, true>(F.lds, g, S, E);
}
#endif

#if MS >= 3
constexpr int LP = 72, SLOTB = 64 * LP * 2, LPF = 68, AUX_OFF = 13 * SLOTB;
static_assert(AUX_OFF + 4096 <= MISC_OFF, "scan LDS map");
#define SLOT(n) ((LAS bf16*)(lds + (n) * SLOTB))
__device__ __forceinline__ int scan_row(int s, int b, int dir) {
    if (s < CTXL) return NLAT + b * CTXL + (dir ? (CTXL - 1 - s) : s);
    const int lt = s - CTXL; return b * SEQ + (dir ? (SEQ - 1 - lt) : lt);
}
__device__ __forceinline__ unsigned pk2z(float x) { return pk2(x, 0.f); }
__device__ __forceinline__ float bf2f(bf16 h) { return __builtin_bit_cast(float, (unsigned)h << 16); }
__device__ __forceinline__ v2u pack4(const f32x4 v) { v2u o; o.x = pk2(v[0], v[1]); o.y = pk2(v[2], v[3]); return o; }
__device__ __forceinline__ float clamp8(float x) { return __builtin_amdgcn_fmed3f(x, -448.0f, 448.0f); }
__device__ __forceinline__ unsigned pack4_fp8(const f32x4 v) { int w = __builtin_amdgcn_cvt_pk_fp8_f32(clamp8(v[0]), clamp8(v[1]), 0, false); return (unsigned)__builtin_amdgcn_cvt_pk_fp8_f32(clamp8(v[2]), clamp8(v[3]), w, true); }
__device__ __forceinline__ f32x4 unpack4_fp8(unsigned w) { const f32x2 lo = __builtin_amdgcn_cvt_pk_f32_fp8((int)w, false), hi = __builtin_amdgcn_cvt_pk_f32_fp8((int)w, true); return (f32x4){lo.x, lo.y, hi.x, hi.y}; }
__device__ __forceinline__ f32x4 unpack4(const v2u w) { return (f32x4){bflo(w.x), bfhi(w.x), bflo(w.y), bfhi(w.y)}; }
__device__ __forceinline__ f32x4 mm_tile(const LAS bf16* X, int r0, const LAS bf16* Y, int c0, int lane) {
    const int rr = lane & 15, q = lane >> 4;
    const LAS bf16* xp = X + (r0 + rr) * LP + 8 * q; const LAS bf16* yp = Y + (c0 + rr) * LP + 8 * q;
    const bf16x8 a0 = *(const LAS bf16x8*)xp, a1 = *(const LAS bf16x8*)(xp + 32), b0 = *(const LAS bf16x8*)yp, b1 = *(const LAS bf16x8*)(yp + 32);
    f32x4 acc = (f32x4){0.f, 0.f, 0.f, 0.f};
    acc = __builtin_amdgcn_mfma_f32_16x16x32_bf16(a0, b0, acc, 0, 0, 0);
    acc = __builtin_amdgcn_mfma_f32_16x16x32_bf16(a1, b1, acc, 0, 0, 0);
    return acc;
}
__device__ __forceinline__ float red8(float x) {
    x += __builtin_bit_cast(float, __builtin_amdgcn_update_dpp(0, __builtin_bit_cast(int, x), 0x141, 0xf, 0xf, false));
    x += __builtin_bit_cast(float, __builtin_amdgcn_update_dpp(0, __builtin_bit_cast(int, x), 0xB1, 0xf, 0xf, false));
    x += __builtin_bit_cast(float, __builtin_amdgcn_update_dpp(0, __builtin_bit_cast(int, x), 0x4E, 0xf, 0xf, false));
    return x;
}

#define S1_BAR() do { asm volatile("s_waitcnt lgkmcnt(0)" ::: "memory"); __builtin_amdgcn_s_barrier(); asm volatile("" ::: "memory"); } while (0)
struct RwIn { bf16 lw[8], r[8], k[8], a[8], b[8], v[8]; };
__device__ __forceinline__ void s1_rwkv_load(Frame& F, int u, RwIn& I) {
    const int sr = u / NCHUNK, c = u - sr * NCHUNK, rb = sr >> 4, rdir = (sr >> 3) & 1, rh = sr & 7; unsigned char* ws = F.ws;
    const bf16* RBp = (const bf16*)(ws + WS_RB); const bf16* VBp = (const bf16*)(ws + WS_VB); const bf16* KKp = (const bf16*)(ws + WS_KKB);
    const bf16* KMp = (const bf16*)(ws + (rdir ? WS_KMB : WS_KMF)); const bf16* BVp = (const bf16*)(ws + (rdir ? WS_BVB : WS_BVF)); const bf16* LWp = (const bf16*)(ws + (rdir ? WS_LWB : WS_LWF));
#pragma unroll
    for (int i = 0; i < 8; ++i) { const int row = scan_row(c * CH + 8 * F.wave + i, rb, rdir); const size_t base = (size_t)row * RWW + rh * 64 + F.lane;
        I.lw[i] = LWp[base]; I.r[i] = RBp[base]; I.k[i] = KMp[base]; I.a[i] = KKp[base]; I.b[i] = BVp[base]; I.v[i] = VBp[base]; }
}
__device__ __forceinline__ void s1_rwkv(Frame& F, int u, const RwIn& I, int un, RwIn& Inext, f32x2v (&cv)[32], int& cpend, int cvi) {
    const int sr = u / NCHUNK, c = u - sr * NCHUNK;
    const bool emit = c >= CTXL / CH;
    LAS unsigned char* lds = F.lds; unsigned char* ws = F.ws;
    int lane_ = F.lane; asm volatile("" : "+v"(lane_));
    const int lane = lane_, wave = F.wave, rr = lane & 15, q = lane >> 4;
    LAS float* tot = (LAS float*)(lds + AUX_OFF); LAS float* gCs = tot + 512;
    {
        float lw[8], xr[8], xk[8], xa[8], xb[8], xv[8];
#pragma unroll
        for (int i = 0; i < 8; ++i) { lw[i] = bf2f(I.lw[i]); xr[i] = bf2f(I.r[i]); xk[i] = bf2f(I.k[i]); xa[i] = -bf2f(I.a[i]); xb[i] = bf2f(I.b[i]); xv[i] = bf2f(I.v[i]); }
        float p[8]; p[0] = lw[0];
#pragma unroll
        for (int i = 1; i < 8; ++i) p[i] = p[i - 1] + lw[i];
        tot[wave * 64 + lane] = p[7];
        S1_BAR();
        float off = 0.f, all = 0.f;
#pragma unroll
        for (int w = 0; w < 8; ++w) { const float t = tot[w * 64 + lane]; all += t; off += (w < wave) ? t : 0.f; }
        if (wave == 0) gCs[lane] = __expf(all);
        float at[8], bb[8], kb[8];
#pragma unroll
        for (int i = 0; i < 8; ++i) { const float cum = off + p[i]; const float g = __expf(cum), gi = __expf(-cum), gp = __expf(cum - lw[i]), gc = __expf(all - cum);
            const int t = 8 * wave + i;
            at[i] = xa[i] * gp; bb[i] = xb[i] * gc; kb[i] = xk[i] * gc;
            SLOT(0)[t * LP + lane] = (bf16)pk2z(at[i]);
            SLOT(1)[t * LP + lane] = (bf16)pk2z(xr[i] * g);
            SLOT(2)[t * LP + lane] = (bf16)pk2z(xb[i] * gi);
            SLOT(3)[t * LP + lane] = (bf16)pk2z(xk[i] * gi); }
        *(LAS v4u*)(SLOT(4) + lane * LP + 8 * wave) = pk8(at);
        *(LAS v4u*)(SLOT(5) + lane * LP + 8 * wave) = pk8(xv);
        *(LAS v4u*)(SLOT(6) + lane * LP + 8 * wave) = pk8(bb);
        *(LAS v4u*)(SLOT(7) + lane * LP + 8 * wave) = pk8(kb);
        S1_BAR();
    }
    if (wave < 4) s1_rwkv_load(F, un, Inext);
    LAS float* Lp = (LAS float*)(lds + 8 * SLOTB);
#pragma unroll
    for (int tix = 0; tix < 2; ++tix) { const int ti = 2 * wave + tix, r0 = 16 * (ti >> 2), c0 = 16 * (ti & 3), ci = c0 + rr;
        { const f32x4 acc = mm_tile(SLOT(2), r0, SLOT(0), c0, lane);
#pragma unroll
            for (int e = 0; e < 4; ++e) { const int i = r0 + 4 * q + e; Lp[ci * LPF + (i & 3) * 16 + (i >> 2)] = (i < ci) ? acc[e] : 0.f; } }
        { f32x4 acc = mm_tile(SLOT(0), r0, SLOT(3), c0, lane);
#pragma unroll
            for (int e = 0; e < 4; ++e) acc[e] = (ci < r0 + 4 * q + e) ? acc[e] : 0.f;
            *(LAS v2u*)(SLOT(10) + ci * LP + r0 + 4 * q) = pack4(acc); }
        if (emit) {
            { f32x4 acc = mm_tile(SLOT(2), r0, SLOT(1), c0, lane);
#pragma unroll
                for (int e = 0; e < 4; ++e) acc[e] = (r0 + 4 * q + e <= ci) ? acc[e] : 0.f;
                *(LAS v2u*)(SLOT(11) + ci * LP + r0 + 4 * q) = pack4(acc); }
            { f32x4 acc = mm_tile(SLOT(3), r0, SLOT(1), c0, lane);
#pragma unroll
                for (int e = 0; e < 4; ++e) acc[e] = (r0 + 4 * q + e <= ci) ? acc[e] : 0.f;
                *(LAS v2u*)(SLOT(12) + ci * LP + r0 + 4 * q) = pack4(acc); }
        }
    }
    S1_BAR();
    if (wave < 4) {
        const int j = 16 * wave + (lane >> 2), s = lane & 3;
        float Tr[16];
#pragma unroll
        for (int m = 0; m < 16; ++m) Tr[m] = 0.f;
        const LAS float* lrow = Lp + s * 16;
        f32x4 lb[3][4];
#pragma unroll
        for (int t = 0; t < 2; ++t) lb[t][0] = *(const LAS f32x4*)(lrow + t * LPF);
#pragma unroll
        for (int t = 0; t < 64; ++t) {
            if (t + 2 < 64) {
#pragma unroll
                for (int k = 0; k < 4; ++k) if (4 * k <= (t + 2) / 4) lb[(t + 2) % 3][k] = *(const LAS f32x4*)(lrow + (t + 2) * LPF + 4 * k);
            }
            __builtin_amdgcn_sched_barrier(0);
            float acc0 = 0.f, acc1 = 0.f;
#pragma unroll
            for (int m = 0; m < 16; ++m) if (m <= t / 4) { const float lv = lb[t % 3][m >> 2][m & 3]; if (m & 1) acc1 += lv * Tr[m]; else acc0 += lv * Tr[m]; }
            float acc = acc0 + acc1;
            acc += __builtin_bit_cast(float, __builtin_amdgcn_update_dpp(0, __builtin_bit_cast(int, acc), 0xB1, 0xf, 0xf, false));
            acc += __builtin_bit_cast(float, __builtin_amdgcn_update_dpp(0, __builtin_bit_cast(int, acc), 0x4E, 0xf, 0xf, false));
            int jj = j, ss = s; asm volatile("" : "+v"(jj), "+v"(ss));
            const float val = acc + ((t == jj) ? 1.f : 0.f);
            Tr[t >> 2] = (ss == (t & 3)) ? val : Tr[t >> 2];
            SLOT(0)[t * LP + j] = (bf16)pk2z(val);
        }
    } else { CVY_FLUSH(); s1_rwkv_load(F, un, Inext); CVY_START(cvi); }
    S1_BAR();
#pragma unroll
    for (int tix = 0; tix < 2; ++tix) { const int ti = 2 * wave + tix, r0 = 16 * (ti >> 2), c0 = 16 * (ti & 3), ci = c0 + rr;
        { const f32x4 acc = mm_tile(SLOT(0), r0, SLOT(4), c0, lane); *(LAS v2u*)(SLOT(2) + ci * LP + r0 + 4 * q) = pack4(acc); }
        { const f32x4 acc = mm_tile(SLOT(0), r0, SLOT(10), c0, lane); *(LAS v2u*)(SLOT(3) + ci * LP + r0 + 4 * q) = pack4(acc); }
    }
    S1_BAR();
    unsigned char* RH = ws + WS_RH + (size_t)u * 4096; bf16* GT = (bf16*)((unsigned char*)F.out + OUT_GT) + (size_t)u * 4096;
    { const int c0 = 16 * (wave & 3), ci = c0 + rr, posb = (wave >> 2) * 32 + q * 8;
      unsigned rh[2]; v2u gt[2];
#pragma unroll
      for (int tix = 0; tix < 2; ++tix) { const int tr = 2 * (wave >> 2) + tix, r0 = 16 * tr;
        if (emit) {
            { f32x4 acc = mm_tile(SLOT(2), r0, SLOT(11), c0, lane);
                acc += unpack4(*(const LAS v2u*)(SLOT(1) + ci * LP + r0 + 4 * q));
                rh[tix] = pack4_fp8(acc); }
            { f32x4 acc = mm_tile(SLOT(3), r0, SLOT(11), c0, lane);
                acc += unpack4(*(const LAS v2u*)(SLOT(12) + ci * LP + r0 + 4 * q));
                *(LAS v2u*)(SLOT(4) + ci * LP + r0 + 4 * q) = pack4(acc); }
        }
        { f32x4 acc = mm_tile(SLOT(2), r0, SLOT(6), c0, lane);
            const float gc = gCs[ci];
#pragma unroll
            for (int e = 0; e < 4; ++e) acc[e] += (r0 + 4 * q + e == ci) ? gc : 0.f;
            gt[tix] = pack4(acc); }
      }
      if (emit) *(v2u*)(RH + ci * 64 + posb) = (v2u){rh[0], rh[1]};
      *(v4u*)(GT + ci * 64 + posb) = (v4u){gt[0].x, gt[0].y, gt[1].x, gt[1].y};
    }
    S1_BAR();
    unsigned char* YL = ws + WS_YL + (size_t)u * 4096;
    unsigned yl[2] = {0u, 0u};
#pragma unroll
    for (int tix = 0; tix < 2; ++tix) { const int ti = 2 * wave + tix, r0 = 16 * (ti >> 2), c0 = 16 * (ti & 3), ci = c0 + rr;
        if (emit) { const f32x4 acc = mm_tile(SLOT(5), r0, SLOT(4), c0, lane); yl[tix] = pack4_fp8(acc); }
        { f32x4 acc = mm_tile(SLOT(3), r0, SLOT(6), c0, lane);
            acc += unpack4(*(const LAS v2u*)(SLOT(7) + ci * LP + r0 + 4 * q));
            *(LAS v2u*)(SLOT(8) + ci * LP + r0 + 4 * q) = pack4(acc); }
    }
    if (emit) { swap16(yl[0], yl[1]);
        const int ti = 2 * wave + (q & 1); *(v2u*)(YL + (16 * (ti & 3) + rr) * 64 + 16 * (ti >> 2) + 4 * (q & ~1)) = (v2u){yl[0], yl[1]}; }
    S1_BAR();
    unsigned char* HH = ws + WS_HH + (size_t)u * 4096;
    unsigned hh[2];
#pragma unroll
    for (int tix = 0; tix < 2; ++tix) { const int ti = 2 * wave + tix, r0 = 16 * (ti >> 2), c0 = 16 * (ti & 3);
        const f32x4 acc = mm_tile(SLOT(8), r0, SLOT(5), c0, lane);
        hh[tix] = pack4_fp8(acc); }
    { swap16(hh[0], hh[1]); const int ti = 2 * wave + (q & 1); *(v2u*)(HH + (16 * (ti & 3) + rr) * 64 + 16 * (ti >> 2) + 4 * (q & ~1)) = (v2u){hh[0], hh[1]}; }
    S1_BAR();
}

struct GlIn { bf16 la[8], q[8], k[8], v0[8], v1[8]; };
__device__ __forceinline__ void s1_gla_load(Frame& F, int u, GlIn& I) {
    const int sg = u / NCHUNK, c = u - sg * NCHUNK, gb = sg >> 3, gdir = (sg >> 2) & 1, gh = sg & 3; unsigned char* ws = F.ws;
    const bf16* Qp = (const bf16*)(ws + WS_QGB); const bf16* Kp = (const bf16*)(ws + WS_KGB); const bf16* Vp = (const bf16*)(ws + WS_VGB); const bf16* LAp = (const bf16*)(ws + (gdir ? WS_LAB : WS_LAF));
#pragma unroll
    for (int i = 0; i < 8; ++i) { const int row = scan_row(c * CH + 8 * F.wave + i, gb, gdir); const size_t b2 = (size_t)row * 256 + gh * 64 + F.lane, b5 = (size_t)row * RWW + gh * 128 + F.lane;
        I.la[i] = LAp[b2]; I.q[i] = Qp[b2]; I.k[i] = Kp[b2]; I.v0[i] = Vp[b5]; I.v1[i] = Vp[b5 + 64]; }
}
__device__ __forceinline__ void s1_gla(Frame& F, int u, const GlIn& I, int un, GlIn& Inext, f32x2v (&cv)[32], int& cpend, int cvi) {
    const int sg = u / NCHUNK, c = u - sg * NCHUNK;
    const bool emit = c >= CTXL / CH;
    LAS unsigned char* lds = F.lds; unsigned char* ws = F.ws;
    int lane_ = F.lane; asm volatile("" : "+v"(lane_));
    const int lane = lane_, wave = F.wave, rr = lane & 15, q = lane >> 4;
    LAS float* tot = (LAS float*)(lds + AUX_OFF);
    unsigned char* QE = (unsigned char*)F.out + OUT_QE + (size_t)u * 4096;
    {
        float la[8], xq[8], xk[8], v0[8], v1[8];
#pragma unroll
        for (int i = 0; i < 8; ++i) { la[i] = bf2f(I.la[i]); xq[i] = bf2f(I.q[i]); xk[i] = bf2f(I.k[i]); v0[i] = bf2f(I.v0[i]); v1[i] = bf2f(I.v1[i]); }
        float p[8]; p[0] = la[0];
#pragma unroll
        for (int i = 1; i < 8; ++i) p[i] = p[i - 1] + la[i];
        tot[wave * 64 + lane] = p[7];
        S1_BAR();
        float off = 0.f, all = 0.f;
#pragma unroll
        for (int w = 0; w < 8; ++w) { const float t = tot[w * 64 + lane]; all += t; off += (w < wave) ? t : 0.f; }
        if (wave == 0) ((float*)(ws + WS_DD))[(size_t)u * 64 + lane] = __expf(all);
        float kl[8];
#pragma unroll
        for (int i = 0; i < 8; ++i) { const float cum = off + p[i]; const int t = 8 * wave + i;
            const float qef = xq[i] * __expf(cum);
            SLOT(0)[t * LP + lane] = (bf16)pk2z(qef);
            SLOT(1)[t * LP + lane] = (bf16)pk2z(xk[i] * __expf(-cum));
            kl[i] = xk[i] * __expf(all - cum); }
        *(LAS v4u*)(SLOT(2) + lane * LP + 8 * wave) = pk8(kl);
        *(LAS v4u*)(SLOT(3) + lane * LP + 8 * wave) = pk8(v0);
        *(LAS v4u*)(SLOT(3) + (64 + lane) * LP + 8 * wave) = pk8(v1);
        S1_BAR();
    }
    if (emit) { const int t = 8 * wave + (lane >> 3), k8 = 8 * (lane & 7);
        const v4u w = *(const LAS v4u*)(SLOT(0) + t * LP + k8);
        v2u o; o.x = pack4_fp8((f32x4){bflo(w.x), bfhi(w.x), bflo(w.y), bfhi(w.y)}); o.y = pack4_fp8((f32x4){bflo(w.z), bfhi(w.z), bflo(w.w), bfhi(w.w)});
        *(v2u*)(QE + t * 64 + k8) = o; }
    if (wave >= 4) { CVY_FLUSH(); s1_gla_load(F, un, Inext); CVY_START(cvi); }
    else if (emit) {
#pragma unroll
        for (int tix = 0; tix < 4; ++tix) { const int ti = 4 * wave + tix, r0 = 16 * (ti >> 2), c0 = 16 * (ti & 3), ci = c0 + rr;
            f32x4 acc = mm_tile(SLOT(1), r0, SLOT(0), c0, lane);
#pragma unroll
            for (int e = 0; e < 4; ++e) acc[e] = (r0 + 4 * q + e <= ci) ? acc[e] : 0.f;
            *(LAS v2u*)(SLOT(5) + ci * LP + r0 + 4 * q) = pack4(acc); }
    }
    unsigned char* KV = ws + WS_KV + (size_t)u * 8192;
    unsigned kv[4];
#pragma unroll
    for (int tix = 0; tix < 4; ++tix) { const int ti = 4 * wave + tix, r0 = 16 * (ti >> 3), c0 = 16 * (ti & 7);
        const f32x4 acc = mm_tile(SLOT(2), r0, SLOT(3), c0, lane);
        kv[tix] = pack4_fp8(acc); }
    { swap16(kv[0], kv[1]); swap16(kv[2], kv[3]); swap32(kv[0], kv[2]); swap32(kv[1], kv[3]);
      const int ti = 4 * wave + q; *(v4u*)(KV + (16 * (ti & 7) + rr) * 64 + 16 * (ti >> 3)) = (v4u){kv[0], kv[1], kv[2], kv[3]}; }
    S1_BAR();
    if (emit) {
        unsigned char* IN = ws + WS_INTRA + (size_t)u * 8192;
        unsigned iw[4];
#pragma unroll
        for (int tix = 0; tix < 4; ++tix) { const int ti = 4 * wave + tix, r0 = 16 * (ti >> 2), c0 = 16 * (ti & 3);
            const f32x4 acc = mm_tile(SLOT(3), r0, SLOT(5), c0, lane);
            iw[tix] = pack4_fp8(acc); }
        swap16(iw[0], iw[1]); swap16(iw[2], iw[3]); swap32(iw[0], iw[2]); swap32(iw[1], iw[3]);
        { const int ti = 4 * wave + q; *(v4u*)(IN + (16 * (ti & 3) + rr) * 128 + 16 * (ti >> 2)) = (v4u){iw[0], iw[1], iw[2], iw[3]}; }
    }
    S1_BAR();
}

__device__ __forceinline__ void ph_scan1(Frame& F) {
    f32x2v cv[32]; int cpend = -1; const int lane = F.lane;
    int item = (int)blockIdx.x * 4 + (F.wave & 3);
    { RwIn cur, nxt; if ((int)blockIdx.x < NU_RW) s1_rwkv_load(F, blockIdx.x, cur);
#pragma unroll 1
      for (int u = blockIdx.x; u < NU_RW; u += F.G, item += F.G * 4) { const int un = (u + F.G < NU_RW) ? u + F.G : u; s1_rwkv(F, u, cur, un, nxt, cv, cpend, item); cur = nxt; } }
    { GlIn cur, nxt; if ((int)blockIdx.x < NU_GL) s1_gla_load(F, blockIdx.x, cur);
#pragma unroll 1
      for (int u = blockIdx.x; u < NU_GL; u += F.G, item += F.G * 4) { const int un = (u + F.G < NU_GL) ? u + F.G : u; if (F.wave < 4) s1_gla_load(F, un, nxt); s1_gla(F, u, cur, un, nxt, cv, cpend, item); cur = nxt; } }
    if (F.wave >= 4) CVY_FLUSH();
}

__device__ __forceinline__ bf16x8 pack_frag(const f32x4 lo, const f32x4 hi) {
    v4u w; w.x = pk2(lo[0], lo[1]); w.y = pk2(lo[2], lo[3]); w.z = pk2(hi[0], hi[1]); w.w = pk2(hi[2], hi[3]); return __builtin_bit_cast(bf16x8, w);
}
constexpr int S2_D = 5, S2_R = 6, S2_RW = 8192 + 4096 + 2048 + 1024, S2_GL = 4096 + 2048 + 1024 + 1024, S2_SLOT = S2_RW + S2_GL;
static_assert(S2_R * S2_SLOT <= MISC_OFF, "S2 ring fits in LDS");
__device__ __forceinline__ void s2_piece(int k, int lane, size_t ur0, size_t ug0, int v0r, int v0g,
                                         const unsigned char* GTb, const unsigned char* RHb, const unsigned char* HHb, const unsigned char* YLb,
                                         const unsigned char* QEb, const unsigned char* KVb, const unsigned char* INb, const unsigned char* DDb,
                                         const unsigned char*& src, int& stride, int& ldo) {
    if (k < 8) { const int n = k, pu = n * 64 + lane, row = pu >> 3, c16 = (pu & 7) ^ (row & 7);
        src = GTb + ur0 * 8192 + row * 128 + c16 * 16; stride = 8192; ldo = n * 1024; }
    else if (k < 12) { const int n = k - 8, pu = n * 64 + lane, row = pu >> 2, c16 = (pu & 3) ^ (row & 3);
        src = RHb + ur0 * 4096 + row * 64 + c16 * 16; stride = 4096; ldo = 8192 + n * 1024; }
    else if (k < 14) { const int pu = lane, v = pu >> 2, c16 = (pu & 3) ^ (v & 3);
        src = HHb + ur0 * 4096 + (size_t)(v0r + v) * 64 + c16 * 16; stride = 4096; ldo = 12288; }
    else if (k < 15) { const int t = lane;
        src = YLb + ur0 * 4096 + t * 64 + v0r; stride = 4096; ldo = 14336; }
    else if (k < 19) { const int n = k - 15, pu = n * 64 + lane, row = pu >> 2, c16 = (pu & 3) ^ (row & 3);
        src = QEb + ug0 * 4096 + row * 64 + c16 * 16; stride = 4096; ldo = S2_RW + n * 1024; }
    else if (k < 21) { const int pu = lane, v = pu >> 2, c16 = (pu & 3) ^ (v & 3);
        src = KVb + ug0 * 8192 + (size_t)(v0g + v) * 64 + c16 * 16; stride = 8192; ldo = S2_RW + 4096; }
    else if (k < 22) { const int t = lane;
        src = INb + ug0 * 8192 + t * 128 + v0g; stride = 8192; ldo = S2_RW + 6144; }
    else { src = DDb + ug0 * 256 + (lane & 15) * 16; stride = 256; ldo = S2_RW + 7168; }
}
__device__ __forceinline__ void ph_scan2(Frame& F) {
    const int lane = F.lane, wave = F.wave, rr = lane & 15, q = lane >> 4; unsigned char* ws = F.ws; LAS unsigned char* lds = F.lds;
    const int it = (F.G == 256) ? (int)(blockIdx.x & 7) * 32 + (int)(blockIdx.x >> 3) : (int)blockIdx.x;
    const int sr = it >> 2, v0r = 16 * (it & 3), rb = sr >> 4, rdir = (sr >> 3) & 1, rh = sr & 7;
    const int sg = it >> 3, v0g = 16 * (it & 7), gb = sg >> 3, gdir = (sg >> 2) & 1, gh = sg & 3;
#define S2_BAR() do { asm volatile("s_waitcnt lgkmcnt(0)" ::: "memory"); __builtin_amdgcn_s_barrier(); asm volatile("" ::: "memory"); } while (0)
#define S2_NEXT_SLOT() do { slot = (slot + 1 == S2_R) ? 0 : slot + 1; } while (0)
    LAS unsigned char* sfr = lds + S2_SF_OFF + lane * 16;
    LAS unsigned char* sfg = sfr + 4096;
    if (wave >= 6) {
        const unsigned char* GTb = (const unsigned char*)F.out + OUT_GT; const unsigned char* QEb = (const unsigned char*)F.out + OUT_QE;
        const unsigned char* RHb = ws + WS_RH; const unsigned char* YLb = ws + WS_YL; const unsigned char* HHb = ws + WS_HH; const unsigned char* KVb = ws + WS_KV; const unsigned char* INb = ws + WS_INTRA;
        const unsigned char* DDb = ws + WS_DD;
        const unsigned char* pj[12]; int sj[12], lj[12];
#pragma unroll
        for (int j = 0; j < 12; ++j) { int k = (wave - 6) * 12 + j; if (k >= 23) k = 22;
            s2_piece(k, lane, (size_t)sr * NCHUNK, (size_t)sg * NCHUNK, v0r, v0g, GTb, RHb, HHb, YLb, QEb, KVb, INb, DDb, pj[j], sj[j], lj[j]);
            sj[j] = __builtin_amdgcn_readfirstlane(sj[j]); lj[j] = __builtin_amdgcn_readfirstlane(lj[j]); }
#define S2_ISSUE(cc, sl_) do { const int _c = (cc) < NCHUNK ? (cc) : NCHUNK - 1; _Pragma("unroll") for (int j = 0; j < 12; ++j) \
            __builtin_amdgcn_global_load_lds((const unsigned*)(pj[j] + (size_t)_c * sj[j]), (LAS unsigned*)(lds + (sl_) * S2_SLOT + lj[j]), 16, 0, 0); } while (0)
        S2_ISSUE(0, 0); S2_ISSUE(1, 1); S2_ISSUE(2, 2); S2_ISSUE(3, 3); S2_ISSUE(4, 4);
        int slot = S2_D % S2_R;
#pragma unroll 1
        for (int c = 0; c < NCHUNK; ++c) {
            asm volatile("s_waitcnt vmcnt(48) ; S2WAIT" ::: "memory");
            S2_BAR();
            S2_ISSUE(c + S2_D, slot);
            S2_NEXT_SLOT();
        }
#undef S2_ISSUE
    } else if (wave == 0) {
        f32x4 S[4];
#pragma unroll
        for (int m = 0; m < 4; ++m) S[m] = (f32x4){0.f, 0.f, 0.f, 0.f};
        bf16x8 Sf0 = pack_frag(S[0], S[1]), Sf1 = pack_frag(S[2], S[3]);
        *(LAS bf16x8*)(sfr) = Sf0; *(LAS bf16x8*)(sfr + 1024) = Sf1;
        int slot = 0;
#pragma unroll 1
        for (int c = 0; c < NCHUNK; ++c) {
            S2_BAR();
            const LAS unsigned char* sl = lds + slot * S2_SLOT;
            bf16x8 G0[4], G1[4]; unsigned Hw[4];
#pragma unroll
            for (int m = 0; m < 4; ++m) { const int k2 = 16 * m + rr;
                G0[m] = *(const LAS bf16x8*)(sl + (k2 * 8 + (q ^ (k2 & 7))) * 16); G1[m] = *(const LAS bf16x8*)(sl + (k2 * 8 + ((4 + q) ^ (k2 & 7))) * 16);
                Hw[m] = *(const LAS unsigned*)(sl + 12288 + (rr * 4 + (m ^ (rr & 3))) * 16 + 4 * q); }
#pragma unroll
            for (int m = 0; m < 4; ++m) { f32x4 acc = unpack4_fp8(Hw[m]);
                acc = __builtin_amdgcn_mfma_f32_16x16x32_bf16(G0[m], Sf0, acc, 0, 0, 0);
                acc = __builtin_amdgcn_mfma_f32_16x16x32_bf16(G1[m], Sf1, acc, 0, 0, 0);
                S[m] = acc; }
            Sf0 = pack_frag(S[0], S[1]); Sf1 = pack_frag(S[2], S[3]);
            LAS unsigned char* o = sfr + ((c + 1) & 1) * 2048;
            *(LAS bf16x8*)(o) = Sf0; *(LAS bf16x8*)(o + 1024) = Sf1;
            S2_NEXT_SLOT();
        }
    } else if (wave == 1) {
        f32x4 S[4];
#pragma unroll
        for (int m = 0; m < 4; ++m) S[m] = (f32x4){0.f, 0.f, 0.f, 0.f};
        { const bf16x8 Sf0 = pack_frag(S[0], S[1]); *(LAS bf16x8*)(sfg) = Sf0; *(LAS bf16x8*)(sfg + 1024) = Sf0; }
        int slot = 0;
#pragma unroll 1
        for (int c = 0; c < NCHUNK; ++c) {
            S2_BAR();
            const LAS unsigned char* sl = lds + slot * S2_SLOT + S2_RW;
            v2u kw[2]; f32x4 d0[2], d1[2];
#pragma unroll
            for (int s2 = 0; s2 < 2; ++s2) { kw[s2] = *(const LAS v2u*)(sl + 4096 + (rr * 4 + ((2 * s2 + (q >> 1)) ^ (rr & 3))) * 16 + (q & 1) * 8);
                d0[s2] = *(const LAS f32x4*)(sl + 7168 + 128 * s2 + 32 * q); d1[s2] = *(const LAS f32x4*)(sl + 7168 + 128 * s2 + 32 * q + 16); }
#pragma unroll
            for (int s2 = 0; s2 < 2; ++s2) { S[2 * s2] = S[2 * s2] * d0[s2] + unpack4_fp8(kw[s2].x); S[2 * s2 + 1] = S[2 * s2 + 1] * d1[s2] + unpack4_fp8(kw[s2].y); }
            LAS unsigned char* o = sfg + ((c + 1) & 1) * 2048;
            *(LAS bf16x8*)(o) = pack_frag(S[0], S[1]); *(LAS bf16x8*)(o + 1024) = pack_frag(S[2], S[3]);
            S2_NEXT_SLOT();
        }
    } else if (wave < 4) {
        bf16* ORW = (bf16*)(ws + (rdir ? WS_ORWB : WS_ORWF));
        const int tt0 = 2 * (wave - 2);
        int slot = 0;
#pragma unroll 1
        for (int c = 0; c < NCHUNK; ++c) {
            S2_BAR();
            if (c >= CTXL / CH) {
                const LAS unsigned char* sl = lds + slot * S2_SLOT; const LAS unsigned char* sf = sfr + (c & 1) * 2048;
                const bf16x8 Sf0 = *(const LAS bf16x8*)(sf), Sf1 = *(const LAS bf16x8*)(sf + 1024);
                v2u Rw0[2], Rw1[2]; unsigned Yw[2];
#pragma unroll
                for (int i = 0; i < 2; ++i) { const int t = 16 * (tt0 + i) + rr;
                    Rw0[i] = *(const LAS v2u*)(sl + 8192 + (t * 4 + ((q >> 1) ^ (t & 3))) * 16 + (q & 1) * 8); Rw1[i] = *(const LAS v2u*)(sl + 8192 + (t * 4 + ((2 + (q >> 1)) ^ (t & 3))) * 16 + (q & 1) * 8);
                    Yw[i] = *(const LAS unsigned*)(sl + 14336 + t * 16 + q * 4); }
#pragma unroll
                for (int i = 0; i < 2; ++i) { const int t = 16 * (tt0 + i) + rr;
                    const bf16x8 R0 = pack_frag(unpack4_fp8(Rw0[i].x), unpack4_fp8(Rw0[i].y)), R1 = pack_frag(unpack4_fp8(Rw1[i].x), unpack4_fp8(Rw1[i].y));
                    f32x4 acc = unpack4_fp8(Yw[i]);
                    acc = __builtin_amdgcn_mfma_f32_16x16x32_bf16(Sf0, R0, acc, 0, 0, 0);
                    acc = __builtin_amdgcn_mfma_f32_16x16x32_bf16(Sf1, R1, acc, 0, 0, 0);
                    const int row = scan_row(c * CH + t, rb, rdir);
                    *(v2u*)(ORW + (size_t)row * RWW + rh * 64 + v0r + 4 * q) = pack4(acc); }
            }
            S2_NEXT_SLOT();
        }
    } else {
        bf16* OGL = (bf16*)(ws + (gdir ? WS_OGLB : WS_OGLF));
        const int tt0 = 2 * (wave - 4);
        int slot = 0;
#pragma unroll 1
        for (int c = 0; c < NCHUNK; ++c) {
            S2_BAR();
            if (c >= CTXL / CH) {
                const LAS unsigned char* sl = lds + slot * S2_SLOT + S2_RW; const LAS unsigned char* sf = sfg + (c & 1) * 2048;
                const bf16x8 Sf0 = *(const LAS bf16x8*)(sf), Sf1 = *(const LAS bf16x8*)(sf + 1024);
                v2u Qw0[2], Qw1[2]; unsigned Iw[2];
#pragma unroll
                for (int i = 0; i < 2; ++i) { const int t = 16 * (tt0 + i) + rr;
                    Qw0[i] = *(const LAS v2u*)(sl + (t * 4 + ((q >> 1) ^ (t & 3))) * 16 + (q & 1) * 8); Qw1[i] = *(const LAS v2u*)(sl + (t * 4 + ((2 + (q >> 1)) ^ (t & 3))) * 16 + (q & 1) * 8);
                    Iw[i] = *(const LAS unsigned*)(sl + 6144 + t * 16 + q * 4); }
#pragma unroll
                for (int i = 0; i < 2; ++i) { const int t = 16 * (tt0 + i) + rr;
                    const bf16x8 Q0 = pack_frag(unpack4_fp8(Qw0[i].x), unpack4_fp8(Qw0[i].y)), Q1 = pack_frag(unpack4_fp8(Qw1[i].x), unpack4_fp8(Qw1[i].y));
                    f32x4 acc = unpack4_fp8(Iw[i]);
                    acc = __builtin_amdgcn_mfma_f32_16x16x32_bf16(Sf0, Q0, acc, 0, 0, 0);
                    acc = __builtin_amdgcn_mfma_f32_16x16x32_bf16(Sf1, Q1, acc, 0, 0, 0);
                    const int row = scan_row(c * CH + t, gb, gdir);
                    *(v2u*)(OGL + (size_t)row * RWW + gh * 128 + v0g + 4 * q) = pack4(acc); }
            }
            S2_NEXT_SLOT();
        }
    }
#undef S2_BAR
#undef S2_NEXT_SLOT
}
#endif

#ifndef ML
#define ML 0
#endif
enum Phase { PH_PROLOGUE = 0, PH_A1, PH_INPROJ, PH_FEAT, PH_LORA, PH_SCAN1, PH_SCAN2, PH_MERGE, PH_BRANCH, PH_OUTPROJ, PH_LN1, PH_ROUTER, PH_ROUTE, PH_SCATTER, PH_EXP1, PH_EXP2, PH_FINAL, PH_COUNT };

__global__ void __launch_bounds__(NTHR, 2) mega(Args args) {
    extern __shared__ __attribute__((aligned(16))) unsigned char lds_raw[];
    Frame F;
    F.lds = (LAS unsigned char*)lds_raw;
    F.tid = threadIdx.x; F.lane = F.tid & 63; F.wave = __builtin_amdgcn_readfirstlane(F.tid >> 6);
    F.G = gridDim.x; F.gw = blockIdx.x * NWAVES + F.wave; F.NGW = F.G * NWAVES;
    F.in = args.in; F.out = args.out; F.ws = args.ws; F.ctl = (unsigned*)(args.ws + WS_CTL);
    volatile LAS unsigned* MISC = (volatile LAS unsigned*)(F.lds + MISC_OFF);
    if (F.tid < 64) MISC[F.tid] = 0u;
    __syncthreads();
    XcdBarrier bar; bar.bar = F.ctl + CW_BAR; bar.x = 0; bar.st = nullptr;
#if !ML
    bar = xcd_barrier_post(F.ctl + CW_BAR, MISC + 8);
#endif
    const int lo = args.ph_lo, hi = args.ph_hi;
#define IN(k) (lo <= (k) && (k) < hi)
#ifndef DUP
#define DUP -1
#endif
#define RUN(k, call) do { if (IN(k)) { call; GRID_BAR(); if (DUP == (k)) { call; GRID_BAR(); } } } while (0)
#if ML
#define GRID_BAR() do { } while (0)
#else
#define GRID_BAR() xcd_barrier(bar)
#endif

#if MS >= 2
    RUN(PH_PROLOGUE, ph_prologue(F));
#endif
#if MS >= 3
    RUN(PH_A1, ph_a1(F));
    RUN(PH_INPROJ, ph_inproj(F));
    RUN(PH_FEAT, ph_feat(F));
    RUN(PH_LORA, ph_lora(F));
    RUN(PH_SCAN1, ph_scan1(F));
    RUN(PH_SCAN2, ph_scan2(F));
    RUN(PH_MERGE, ph_merge(F));
    RUN(PH_BRANCH, ph_branch(F));
    RUN(PH_OUTPROJ, ph_outproj(F));
#else
    RUN(PH_OUTPROJ, ph_x1pre_nomix(F));
#endif
    RUN(PH_LN1, ph_ln1(F));
#if MS >= 2
    RUN(PH_ROUTER, ph_router(F));
    RUN(PH_ROUTE, ph_route(F));
    RUN(PH_SCATTER, ph_scatter(F));
    RUN(PH_EXP1, ph_exp1(F));
    RUN(PH_EXP2, ph_exp2(F));
#endif
    if (IN(PH_FINAL)) { ph_final(F); }
#undef IN
}

extern "C" void kernel_launch(void* const* d_in, const int* in_sizes, int n_in, void* d_out, int out_size, void* d_ws, size_t ws_size, hipStream_t stream) {
    static int grid = 0;
    if (grid == 0) {
        if (n_in != 36 || out_size != NLAT * D || ws_size < WS_END) { fprintf(stderr, "kernel_launch: unexpected problem shape (n_in %d, out %d)\n", n_in, out_size); grid = -1; return; }
        int dev = 0, cus = 0, per_cu = 0;
        if (hipGetDevice(&dev) != hipSuccess || hipDeviceGetAttribute(&cus, hipDeviceAttributeMultiprocessorCount, dev) != hipSuccess) { grid = -1; return; }
        if (hipFuncSetAttribute((const void*)mega, hipFuncAttributeMaxDynamicSharedMemorySize, LDS_BYTES) != hipSuccess) { fprintf(stderr, "kernel_launch: hipFuncSetAttribute failed\n"); grid = -1; return; }
        if (hipOccupancyMaxActiveBlocksPerMultiprocessor(&per_cu, (const void*)mega, NTHR, LDS_BYTES) != hipSuccess || per_cu < 1) { fprintf(stderr, "kernel_launch: occupancy query says %d\n", per_cu); }
        (void)hipGetLastError();
        grid = cus > 0 ? cus : 256;
        if (grid > 256) grid = 256;
    }
    if (grid < 0) return;
    (void)hipMemsetAsync((char*)d_ws + WS_CTL, 0, CTL_ZERO_BYTES, stream);
    Args a{};
    for (int i = 0; i < 36; ++i) a.in[i] = (const float*)d_in[i];
    a.out = (float*)d_out; a.ws = (unsigned char*)d_ws;
#if ML
    for (int p = 0; p < PH_COUNT; ++p) { a.ph_lo = p; a.ph_hi = p + 1; hipLaunchKernelGGL(mega, dim3(grid), dim3(NTHR), LDS_BYTES, stream, a); }
#else
    a.ph_lo = 0; a.ph_hi = PH_COUNT;
    hipLaunchKernelGGL(mega, dim3(grid), dim3(NTHR), LDS_BYTES, stream, a);
#endif
}
```
